# Optimizing an MI355X kernel written in HIP

```python
import jax, jax.numpy as jnp
from jax import lax
import numpy as np

D_MODEL = 1024
BATCH = 2
SEQ = 8192
DEPTH = 2
DEC_BATCH = 32
DEC_SEQ = 4
PAST_LEN = 8192
PAGE_SIZE = 128

N_A_LAYERS = DEPTH // 2
N_B_LAYERS = DEPTH - N_A_LAYERS
GDN_HEADS = 8
GDN_DK = 128
GDN_DV = 128
GDN_QK_DIM = GDN_HEADS * GDN_DK
GDN_V_DIM = GDN_HEADS * GDN_DV
GDN_CONV_DIM = 2 * GDN_QK_DIM + GDN_V_DIM
GDN_PROJ = GDN_CONV_DIM + GDN_V_DIM + 2 * GDN_HEADS
CONV_W = 4
GDN_CHUNK = 64
NSA_HEADS = 16
NSA_KV_HEADS = 4
NSA_HPG = NSA_HEADS // NSA_KV_HEADS
NSA_DH = D_MODEL // NSA_HEADS
CMP_BLOCK = 32
CMP_STRIDE = 16
CMP_HIDDEN = NSA_DH
SEL_BLOCK = 64
N_SEL = 16
WINDOW = 512
Q_BLOCK = 128
NSA_QG = NSA_HEADS * NSA_DH + 3 * NSA_HEADS
NSA_KV_PROJ = 6 * NSA_KV_HEADS * NSA_DH
PEER_HEADS = 8
PEER_DQ = 256
PEER_HALF = PEER_DQ // 2
N_KEYS = 128
N_EXPERTS = N_KEYS * N_KEYS
PEER_TOPK = 16
PEER_TOKEN_BLOCK = 128
EPS = 1e-6
NEG = -1e30
BIG = 1e30

kernel_name = 'yoco_gdn_nsa_peer_step'


def rmsnorm(x, gain):
    xf = x.astype(jnp.float32)
    y = xf * lax.rsqrt(jnp.mean(xf * xf, axis=-1, keepdims=True) + EPS)
    return (y * gain.astype(jnp.float32)).astype(x.dtype)


def l2norm(x):
    xf = x.astype(jnp.float32)
    return xf * lax.rsqrt(jnp.sum(xf * xf, axis=-1, keepdims=True) + EPS)


def masked_softmax(s, mask):
    s = jnp.where(mask, s, NEG)
    m = jnp.max(s, axis=-1, keepdims=True)
    p = jnp.exp(s - m) * mask
    return p / jnp.maximum(jnp.sum(p, axis=-1, keepdims=True), 1e-30)


def alibi_slopes():
    h = jnp.arange(1, NSA_HEADS + 1, dtype=jnp.float32)
    return jnp.exp2(-8.0 * h / NSA_HEADS).reshape(NSA_KV_HEADS, NSA_HPG)


def short_conv(u, buf0, w):
    L = u.shape[1]
    buf = jnp.concatenate([buf0.astype(u.dtype), u], axis=1)
    y = sum(buf[:, i:i + L] * w[i] for i in range(CONV_W))
    return jax.nn.silu(y), buf[:, L:]


def gated_delta_rule(q, k, v, g, beta, s0):
    Bsz, L, H, DK = q.shape
    C = GDN_CHUNK if L % GDN_CHUNK == 0 else L
    n = L // C

    def chunks(t):
        t = t.reshape((Bsz, n, C, H) + t.shape[3:])
        return jnp.moveaxis(t, (1, 3), (0, 2))

    qc, kc, vc, gc, bc = chunks(q), chunks(k), chunks(v), chunks(g), chunks(beta)
    gcum = jnp.cumsum(gc, axis=-1)
    idx = jnp.arange(C)
    lower = idx[:, None] >= idx[None, :]
    strict = idx[:, None] > idx[None, :]
    diff = gcum[..., :, None] - gcum[..., None, :]
    decay = jnp.where(lower, jnp.exp(jnp.where(lower, diff, 0.0)), 0.0)
    kb = kc * bc[..., None]
    a_mat = jnp.where(strict, jnp.einsum('nbhik,nbhjk->nbhij', kb, kc) * decay, 0.0)
    eye = jnp.eye(C, dtype=jnp.float32)
    t_mat = lax.linalg.triangular_solve(eye + a_mat, jnp.broadcast_to(eye, a_mat.shape),
                                        left_side=True, lower=True, unit_diagonal=True)
    u = t_mat @ (vc * bc[..., None])
    w = t_mat @ (kb * jnp.exp(gcum)[..., None])
    qk = jnp.where(lower, jnp.einsum('nbhik,nbhjk->nbhij', qc, kc) * decay, 0.0)

    def step(S, xs):
        q_i, k_i, u_i, w_i, g_i, qk_i = xs
        v_new = u_i - w_i @ S
        o = (q_i * jnp.exp(g_i)[..., None]) @ S + qk_i @ v_new
        g_last = g_i[..., -1]
        k_dec = k_i * jnp.exp(g_last[..., None] - g_i)[..., None]
        S = S * jnp.exp(g_last)[..., None, None] + jnp.einsum('bhck,bhcv->bhkv', k_dec, v_new)
        return S, o

    S, o = lax.scan(step, s0, (qc, kc, u, w, gcum, qk))
    o = jnp.moveaxis(o, (0, 2), (1, 3)).reshape(Bsz, L, H, v.shape[-1])
    return o, S


def gdn_mixer(h, s0, conv0, w_in, conv_w, a_log, dt_bias, o_gain, w_out):
    B, L, _ = h.shape
    proj = h @ w_in
    qkv, conv_state = short_conv(proj[..., :GDN_CONV_DIM], conv0, conv_w)
    z = proj[..., GDN_CONV_DIM:GDN_CONV_DIM + GDN_V_DIM].reshape(B, L, GDN_HEADS, GDN_DV)
    a = proj[..., GDN_CONV_DIM + GDN_V_DIM:GDN_CONV_DIM + GDN_V_DIM + GDN_HEADS].astype(jnp.float32)
    b = proj[..., GDN_CONV_DIM + GDN_V_DIM + GDN_HEADS:].astype(jnp.float32)
    q = l2norm(qkv[..., :GDN_QK_DIM].reshape(B, L, GDN_HEADS, GDN_DK)) * (GDN_DK ** -0.5)
    k = l2norm(qkv[..., GDN_QK_DIM:2 * GDN_QK_DIM].reshape(B, L, GDN_HEADS, GDN_DK))
    v = qkv[..., 2 * GDN_QK_DIM:].reshape(B, L, GDN_HEADS, GDN_DV).astype(jnp.float32)
    g = -jnp.exp(a_log.astype(jnp.float32)) * jax.nn.softplus(a + dt_bias.astype(jnp.float32))
    beta = jax.nn.sigmoid(b)
    o, s_new = gated_delta_rule(q, k, v, g, beta, s0.astype(jnp.float32))
    o = rmsnorm(o, o_gain) * jax.nn.silu(z.astype(jnp.float32))
    return o.reshape(B, L, GDN_V_DIM).astype(h.dtype) @ w_out, s_new, conv_state


def peer(h, w_q, sub_keys, u, v):
    shape = h.shape
    flat = h.reshape(-1, D_MODEL)
    n = flat.shape[0]
    blk = PEER_TOKEN_BLOCK
    nb = -(-n // blk)
    flat = jnp.pad(flat, ((0, nb * blk - n), (0, 0))).reshape(nb, blk, D_MODEL)

    def block(hb):
        q = (hb @ w_q).reshape(blk, PEER_HEADS, 2, PEER_HALF)
        s = jnp.einsum('thpd,hpkd->thpk', q, sub_keys, preferred_element_type=jnp.float32)
        s1, i1 = lax.top_k(s[:, :, 0], PEER_TOPK)
        s2, i2 = lax.top_k(s[:, :, 1], PEER_TOPK)
        cand = (s1[..., :, None] + s2[..., None, :]).reshape(blk, PEER_HEADS, PEER_TOPK * PEER_TOPK)
        cidx = (i1[..., :, None] * N_KEYS + i2[..., None, :]).reshape(blk, PEER_HEADS, PEER_TOPK * PEER_TOPK)
        top_s, pos = lax.top_k(cand, PEER_TOPK)
        eidx = jnp.take_along_axis(cidx, pos, axis=-1)
        gate = jax.nn.softmax(top_s, axis=-1)
        ue = u[eidx]
        ve = v[eidx]
        act = jax.nn.gelu(jnp.einsum('td,thkd->thk', hb, ue, preferred_element_type=jnp.float32))
        return jnp.einsum('thk,thkd->td', (gate * act).astype(ve.dtype), ve,
                          preferred_element_type=jnp.float32)

    out = lax.map(block, flat).reshape(nb * blk, D_MODEL)[:n]
    return out.reshape(shape).astype(h.dtype)


def shared_kv_rows(x, kv_ln, kv_w, k_gain):
    B, L, _ = x.shape
    kv = (rmsnorm(x, kv_ln) @ kv_w).reshape(B, L, 6, NSA_KV_HEADS, NSA_DH)
    k_sel = rmsnorm(kv[:, :, 2], k_gain[1])
    k_win = rmsnorm(kv[:, :, 4], k_gain[2])
    rows = jnp.stack([kv[:, :, 0], kv[:, :, 1], k_sel, kv[:, :, 3]], axis=2)
    win = jnp.stack([k_win, kv[:, :, 5]], axis=2)
    return rows, win


def compress(seq, w1, pe, w2):
    B, T, G, Dh = seq.shape
    n_chunk = T // CMP_STRIDE
    c = seq[:, :n_chunk * CMP_STRIDE].reshape(B, n_chunk, CMP_STRIDE, G, Dh)
    first = jnp.einsum('bcrgd,rdh->bcgh', c, w1[:CMP_STRIDE])
    second = jnp.einsum('bcrgd,rdh->bcgh', c, w1[CMP_STRIDE:])
    pe_term = jnp.einsum('rd,rdh->h', pe, w1)
    hid = jax.nn.gelu(first[:, :-1] + second[:, 1:] + pe_term)
    return jnp.einsum('bcgh,hd->bcgd', hid, w2)


def nsa_context(rows, win_all, win_pos0, q_block, band_len, k_gain, phi_w1, phi_pe, phi_w2):
    B, T = rows.shape[:2]
    k_cmp = rmsnorm(compress(rows[:, :, 0], phi_w1[0], phi_pe[0], phi_w2[0]), k_gain[0])
    v_cmp = compress(rows[:, :, 1], phi_w1[1], phi_pe[1], phi_w2[1])
    n_cmp = k_cmp.shape[1]
    cmp_start = jnp.arange(n_cmp, dtype=jnp.int32) * CMP_STRIDE
    cmp_end = cmp_start + CMP_BLOCK - 1
    n_sel = -(-T // SEL_BLOCK)
    sel = jnp.pad(rows[:, :, 2:], ((0, 0), (0, n_sel * SEL_BLOCK - T), (0, 0), (0, 0), (0, 0)))
    sel = sel.reshape(B, n_sel, SEL_BLOCK, 2, NSA_KV_HEADS, NSA_DH).transpose(3, 0, 4, 1, 2, 5)
    sel_start = jnp.arange(n_sel, dtype=jnp.int32) * SEL_BLOCK
    overlap = ((cmp_start[:, None] < sel_start[None, :] + SEL_BLOCK)
               & (cmp_end[:, None] >= sel_start[None, :])).astype(jnp.float32)
    return (k_cmp, v_cmp, cmp_end, sel[0], sel[1], overlap,
            win_all[:, :, 0], win_all[:, :, 1], win_pos0, q_block, band_len)


def nsa_mixer(h, pos0, ctx, w_qg, q_gain, w_out):
    k_cmp, v_cmp, cmp_end, k_sel, v_sel, overlap, k_win, v_win, win_pos0, q_block, band_len = ctx
    B, L, _ = h.shape
    G, HPG, DH = NSA_KV_HEADS, NSA_HPG, NSA_DH
    nb = L // q_block
    proj = h @ w_qg
    q = rmsnorm(proj[..., :NSA_HEADS * DH].reshape(B, L, G, HPG, DH), q_gain)
    gates = jax.nn.sigmoid(proj[..., NSA_HEADS * DH:].astype(jnp.float32)).reshape(B, L, 3, G, HPG)
    q_b = q.reshape(B, nb, q_block, G, HPG, DH).swapaxes(0, 1)
    g_b = gates.reshape(B, nb, q_block, 3, G, HPG).swapaxes(0, 1)
    t_b = (pos0 + jnp.arange(L, dtype=jnp.int32)).reshape(nb, q_block)
    starts = jnp.arange(nb, dtype=jnp.int32) * q_block
    slopes = alibi_slopes()[None, None, :, :, None]
    n_sel = k_sel.shape[2]
    k_top = min(N_SEL, n_sel)
    blk_ids = jnp.arange(n_sel, dtype=jnp.int32)
    bi = jnp.arange(B)[:, None, None, None]
    gi = jnp.arange(G)[None, None, :, None]
    scale = NSA_DH ** -0.5

    def block(args):
        qq, gg, tt, st = args
        dist_c = (tt[:, None] - cmp_end[None, :]).astype(jnp.float32)
        s_c = jnp.einsum('bqgnd,bcgd->bqgnc', qq, k_cmp, preferred_element_type=jnp.float32) * scale
        s_c = s_c - slopes * dist_c[None, :, None, None, :]
        p_c = masked_softmax(s_c, (dist_c >= 0)[None, :, None, None, :])
        o_c = jnp.einsum('bqgnc,bcgd->bqgnd', p_c.astype(v_cmp.dtype), v_cmp,
                         preferred_element_type=jnp.float32)
        imp = jnp.einsum('bqgnc,cj->bqgj', p_c, overlap)
        cur = tt // SEL_BLOCK
        forced = ((blk_ids[None] == 0) | (blk_ids[None] == cur[:, None])
                  | (blk_ids[None] == cur[:, None] - 1))
        visible = blk_ids[None] * SEL_BLOCK <= tt[:, None]
        score = jnp.where(forced[None, :, None], BIG, jnp.where(visible[None, :, None], imp, NEG))
        _, idx = lax.top_k(score, k_top)
        qb = tt.shape[0]
        ks = k_sel[bi, gi, idx].reshape(B, qb, G, k_top * SEL_BLOCK, DH)
        vs = v_sel[bi, gi, idx].reshape(B, qb, G, k_top * SEL_BLOCK, DH)
        spos = (idx[..., None] * SEL_BLOCK + jnp.arange(SEL_BLOCK, dtype=jnp.int32)).reshape(
            B, qb, G, k_top * SEL_BLOCK)
        dist_s = (tt[None, :, None, None] - spos).astype(jnp.float32)
        s_s = jnp.einsum('bqgnd,bqgkd->bqgnk', qq, ks, preferred_element_type=jnp.float32) * scale
        s_s = s_s - slopes * dist_s[:, :, :, None]
        p_s = masked_softmax(s_s, (dist_s >= 0)[:, :, :, None])
        o_s = jnp.einsum('bqgnk,bqgkd->bqgnd', p_s.astype(vs.dtype), vs,
                         preferred_element_type=jnp.float32)
        kw = lax.dynamic_slice_in_dim(k_win, st, band_len, axis=1)
        vw = lax.dynamic_slice_in_dim(v_win, st, band_len, axis=1)
        wpos = win_pos0 + st + jnp.arange(band_len, dtype=jnp.int32)
        dist_w = tt[:, None] - wpos[None, :]
        mask_w = (wpos[None, :] >= 0) & (dist_w >= 0) & (dist_w < WINDOW)
        s_w = jnp.einsum('bqgnd,blgd->bqgnl', qq, kw, preferred_element_type=jnp.float32) * scale
        s_w = s_w - slopes * dist_w.astype(jnp.float32)[None, :, None, None, :]
        p_w = masked_softmax(s_w, mask_w[None, :, None, None, :])
        o_w = jnp.einsum('bqgnl,blgd->bqgnd', p_w.astype(vw.dtype), vw,
                         preferred_element_type=jnp.float32)
        return (gg[:, :, 0, ..., None] * o_c + gg[:, :, 1, ..., None] * o_s
                + gg[:, :, 2, ..., None] * o_w)

    o = lax.map(block, (q_b, g_b, t_b, starts))
    o = o.swapaxes(0, 1).reshape(B, L, NSA_HEADS * DH).astype(h.dtype)
    return o @ w_out


def setup_inputs(seed: int = 0) -> dict:
    key = jax.random.key(seed)
    ks = jax.random.split(key, 32)
    f32 = jnp.float32

    def nrm(k, shape, scale):
        return jax.random.normal(k, shape, f32) * scale

    def gain(k, shape):
        return 1.0 + 0.05 * jax.random.normal(k, shape, f32)

    n_pages = PAST_LEN // PAGE_SIZE
    n_used = DEC_BATCH * n_pages
    n_pool = n_used + max(1, n_used // 4)
    win_buf = min(WINDOW, PAST_LEN)
    perm = jax.random.permutation(ks[6], n_pool)
    page_table = perm[:n_used].reshape(DEC_BATCH, n_pages).astype(jnp.int32)
    return {
        'x_prompt': nrm(ks[0], (BATCH, SEQ, D_MODEL), 1.0),
        'x_sample': nrm(ks[1], (DEC_BATCH, DEC_SEQ, D_MODEL), 1.0),
        'cache_kv': nrm(ks[2], (n_pool, PAGE_SIZE, 4, NSA_KV_HEADS, NSA_DH), 1.0),
        'cache_win': nrm(ks[3], (DEC_BATCH, win_buf, 2, NSA_KV_HEADS, NSA_DH), 1.0),
        'state_gdn': nrm(ks[4], (N_A_LAYERS, DEC_BATCH, GDN_HEADS, GDN_DK, GDN_DV), 0.1),
        'state_conv': nrm(ks[5], (N_A_LAYERS, DEC_BATCH, CONV_W - 1, GDN_CONV_DIM), 1.0),
        'page_table': page_table,
        'a_ln': gain(ks[7], (N_A_LAYERS, D_MODEL)),
        'a_w_in': nrm(ks[8], (N_A_LAYERS, D_MODEL, GDN_PROJ), D_MODEL ** -0.5),
        'a_conv_w': nrm(ks[9], (N_A_LAYERS, CONV_W, GDN_CONV_DIM), 0.5),
        'a_a_log': jnp.log(jax.random.uniform(ks[10], (N_A_LAYERS, GDN_HEADS), f32, 1.0, 16.0)),
        'a_dt_bias': jax.random.uniform(ks[11], (N_A_LAYERS, GDN_HEADS), f32, -4.0, -2.0),
        'a_o_gain': gain(ks[12], (N_A_LAYERS, GDN_DV)),
        'a_w_out': nrm(ks[13], (N_A_LAYERS, GDN_V_DIM, D_MODEL), GDN_V_DIM ** -0.5),
        'kv_ln': gain(ks[14], (D_MODEL,)),
        'kv_w': nrm(ks[15], (D_MODEL, NSA_KV_PROJ), D_MODEL ** -0.5),
        'kv_k_gain': gain(ks[16], (3, NSA_DH)),
        'phi_w1': nrm(ks[17], (2, CMP_BLOCK, NSA_DH, CMP_HIDDEN), (CMP_BLOCK * NSA_DH) ** -0.5),
        'phi_pe': nrm(ks[18], (2, CMP_BLOCK, NSA_DH), 0.1),
        'phi_w2': nrm(ks[19], (2, CMP_HIDDEN, NSA_DH), CMP_HIDDEN ** -0.5),
        'b_ln': gain(ks[20], (N_B_LAYERS, D_MODEL)),
        'b_w_qg': nrm(ks[21], (N_B_LAYERS, D_MODEL, NSA_QG), D_MODEL ** -0.5),
        'b_q_gain': gain(ks[22], (N_B_LAYERS, NSA_DH)),
        'b_w_out': nrm(ks[23], (N_B_LAYERS, NSA_HEADS * NSA_DH, D_MODEL), (NSA_HEADS * NSA_DH) ** -0.5),
        'p_ln': gain(ks[24], (DEPTH, D_MODEL)),
        'p_w_q': nrm(ks[25], (DEPTH, D_MODEL, PEER_HEADS * PEER_DQ), D_MODEL ** -0.5),
        'p_sub_keys': nrm(ks[26], (DEPTH, PEER_HEADS, 2, N_KEYS, PEER_HALF), PEER_HALF ** -0.5),
        'p_u': nrm(ks[27], (DEPTH, N_EXPERTS, D_MODEL), D_MODEL ** -0.5),
        'p_v': nrm(ks[28], (DEPTH, N_EXPERTS, D_MODEL), (PEER_HEADS * PEER_TOPK) ** -0.5),
    }


def reference(x_prompt, x_sample, cache_kv, cache_win, state_gdn, state_conv, page_table,
              a_ln, a_w_in, a_conv_w, a_a_log, a_dt_bias, a_o_gain, a_w_out,
              kv_ln, kv_w, kv_k_gain, phi_w1, phi_pe, phi_w2,
              b_ln, b_w_qg, b_q_gain, b_w_out,
              p_ln, p_w_q, p_sub_keys, p_u, p_v):
    xp, xs = x_prompt, x_sample
    bp, lp = xp.shape[0], xp.shape[1]
    bs, ls = xs.shape[0], xs.shape[1]
    past_len = page_table.shape[1] * cache_kv.shape[1]
    win_buf = cache_win.shape[1]
    q_block_p = Q_BLOCK if lp % Q_BLOCK == 0 else lp
    s_p, c_p, s_s, c_s = [], [], [], []
    for layer in range(DEPTH):
        if layer < N_A_LAYERS:
            i = layer
            zs = jnp.zeros((bp, GDN_HEADS, GDN_DK, GDN_DV), jnp.float32)
            zc = jnp.zeros((bp, CONV_W - 1, GDN_CONV_DIM), xp.dtype)
            yp, sp, cp = gdn_mixer(rmsnorm(xp, a_ln[i]), zs, zc, a_w_in[i], a_conv_w[i],
                                   a_a_log[i], a_dt_bias[i], a_o_gain[i], a_w_out[i])
            ys, ss, cs = gdn_mixer(rmsnorm(xs, a_ln[i]), state_gdn[i], state_conv[i], a_w_in[i],
                                   a_conv_w[i], a_a_log[i], a_dt_bias[i], a_o_gain[i], a_w_out[i])
            xp = xp + yp
            xs = xs + ys
            s_p.append(sp)
            c_p.append(cp)
            s_s.append(ss)
            c_s.append(cs)
        else:
            j = layer - N_A_LAYERS
            xp = xp + nsa_mixer(rmsnorm(xp, b_ln[j]), 0, ctx_p, b_w_qg[j], b_q_gain[j], b_w_out[j])
            xs = xs + nsa_mixer(rmsnorm(xs, b_ln[j]), past_len, ctx_s, b_w_qg[j], b_q_gain[j], b_w_out[j])
        xp = xp + peer(rmsnorm(xp, p_ln[layer]), p_w_q[layer], p_sub_keys[layer], p_u[layer], p_v[layer])
        xs = xs + peer(rmsnorm(xs, p_ln[layer]), p_w_q[layer], p_sub_keys[layer], p_u[layer], p_v[layer])
        if layer == N_A_LAYERS - 1:
            rows_p, win_p = shared_kv_rows(xp, kv_ln, kv_w, kv_k_gain)
            rows_s, win_s = shared_kv_rows(xs, kv_ln, kv_w, kv_k_gain)
            win_pad_p = jnp.pad(win_p, ((0, 0), (WINDOW, 0), (0, 0), (0, 0), (0, 0)))
            ctx_p = nsa_context(rows_p, win_pad_p, -WINDOW, q_block_p, WINDOW + q_block_p,
                                kv_k_gain, phi_w1, phi_pe, phi_w2)
            past = cache_kv[page_table].reshape((bs, past_len) + cache_kv.shape[2:])
            full_s = jnp.concatenate([past.astype(rows_s.dtype), rows_s], axis=1)
            win_all_s = jnp.concatenate([cache_win.astype(win_s.dtype), win_s], axis=1)
            ctx_s = nsa_context(full_s, win_all_s, past_len - win_buf, ls, win_buf + ls,
                                kv_k_gain, phi_w1, phi_pe, phi_w2)
            win_prompt = win_p[:, lp - min(WINDOW, lp):]
            win_sample = win_all_s[:, ls:]
    return (xp, xs, rows_p, win_prompt, jnp.stack(s_p), jnp.stack(c_p),
            rows_s, win_sample, jnp.stack(s_s), jnp.stack(c_s))
```

```cpp
#include <hip/hip_runtime.h>
#include <cstdio>
#include <cstdint>

constexpr int DM = 1024, PB = 2, PT = 8192, SB = 32, SL = 4, PAST = 8192, PAGE = 128;
constexpr int MP = PB * PT;
constexpr int MS = SB * SL;
constexpr int MTOK = MP + MS;
constexpr int GH = 8, GDK = 128, GDV = 128, GCONV = 3072, GPROJ = 4112, CHUNK = 64, NCH = PT / CHUNK;
constexpr int NH = 16, NG = 4, HPG = 4, DH = 64, NQG = 1072, NKV = 1536, NKVQ = 2816, NKVQ_REAL = 2608;
constexpr int WINDOW = 512, NSELP = 128, NSELS = 129, NCMP = 511;
constexpr int PEH = 8, PEDQ = 256, PEHALF = 128, NKEYS = 128, NEXP = 16384, PETOP = 16;
constexpr int NPAGES = PAST / PAGE;
constexpr float EPS = 1e-6f;

constexpr size_t O_YP = 0;
constexpr size_t O_YS = O_YP + (size_t)MP * DM;
constexpr size_t O_KVP = O_YS + (size_t)MS * DM;
constexpr size_t O_WINP = O_KVP + (size_t)MP * 1024;
constexpr size_t O_GDNP = O_WINP + (size_t)PB * 512 * 512;
constexpr size_t O_CONVP = O_GDNP + (size_t)PB * GH * 128 * 128;
constexpr size_t O_KVS = O_CONVP + (size_t)PB * 3 * GCONV;
constexpr size_t O_WINS = O_KVS + (size_t)MS * 1024;
constexpr size_t O_GDNS = O_WINS + (size_t)SB * 512 * 512;
constexpr size_t O_CONVS = O_GDNS + (size_t)SB * GH * 128 * 128;
constexpr size_t O_END = O_CONVS + (size_t)SB * 3 * GCONV;

constexpr size_t MiB = 1u << 20;
constexpr size_t al(size_t x) { return (x + 4095) & ~(size_t)4095; }
constexpr size_t WS_CTL = 0, CTL_BYTES = 1 * MiB;
constexpr size_t WS_WIN_T = WS_CTL + CTL_BYTES;
constexpr size_t WS_WOA_T = WS_WIN_T + (size_t)4096 * 1024 * 2;
constexpr size_t WS_WKVQ_T = WS_WOA_T + (size_t)1024 * 1024 * 2;
constexpr size_t WS_WOB_T = WS_WKVQ_T + (size_t)NKVQ * 1024 * 2;
constexpr size_t WS_WPQ_T = WS_WOB_T + (size_t)1024 * 1024 * 2;
constexpr size_t WS_WAB = WS_WPQ_T + (size_t)2 * 2048 * 1024 * 2;
constexpr size_t WS_SUBK = WS_WAB + (size_t)16 * 1024 * 4;
constexpr size_t WS_W1T = WS_SUBK + (size_t)2 * 8 * 2 * 128 * 128 * 2;
constexpr size_t WS_PETERM = WS_W1T + (size_t)2 * 128 * 1024 * 2;
constexpr size_t WS_PU = al(WS_PETERM + 512);
constexpr size_t WS_PV = WS_PU + (size_t)2 * NEXP * DM * 2;
constexpr size_t WS_XNA = WS_PV + (size_t)2 * NEXP * DM * 2;
constexpr size_t WS_XNB = al(WS_XNA + (size_t)MTOK * DM * 2);
constexpr size_t WS_PROJ = al(WS_XNB + (size_t)MTOK * DM * 2);
constexpr size_t WS_GW = al(WS_PROJ + (size_t)MTOK * 4096 * 2);
constexpr size_t WS_GQ = WS_GW + (size_t)2048 * 64 * 128 * 2;
constexpr size_t WS_GKT = WS_GQ + (size_t)2048 * 64 * 128 * 2;
constexpr size_t WS_GQK = WS_GKT + (size_t)2048 * 64 * 128 * 2;
constexpr size_t WS_GU = WS_GQK + (size_t)2048 * 64 * 64 * 2;
constexpr size_t WS_GDEC = WS_GU + (size_t)2048 * 64 * 128 * 4;
constexpr size_t WS_OGDN = al(WS_GDEC + 2048 * 4);
constexpr size_t WS_OG = al(WS_OGDN + (size_t)MTOK * DM * 4);
constexpr size_t WS_XS = al(WS_OG + (size_t)MTOK * DM * 2);
constexpr size_t WS_QPEER = al(WS_XS + (size_t)MTOK * DM * 4);
constexpr size_t WS_PEI = al(WS_QPEER + (size_t)MTOK * 2048 * 2);
constexpr size_t WS_PEG = al(WS_PEI + (size_t)MTOK * 128 * 4);
constexpr size_t WS_KVQ = al(WS_PEG + (size_t)MTOK * 128 * 4);
constexpr size_t WS_KSEL = al(WS_KVQ + (size_t)MTOK * NKVQ * 4);
constexpr size_t WS_VSELT = WS_KSEL + (size_t)PB * NG * PT * 64 * 2;
constexpr size_t WS_KWIN = WS_VSELT + (size_t)PB * NG * PT * 64 * 2;
constexpr size_t WS_VWINT = WS_KWIN + (size_t)PB * NG * PT * 64 * 2;
constexpr size_t WS_KCMP = WS_VWINT + (size_t)PB * NG * PT * 64 * 2;
constexpr size_t WS_VCMPT = WS_KCMP + (size_t)PB * NG * 512 * 64 * 2;
constexpr size_t WS_SKCMP = WS_VCMPT + (size_t)PB * NG * 512 * 64 * 2;
constexpr size_t WS_SVCMPT = WS_SKCMP + (size_t)SB * NG * 512 * 64 * 2;
constexpr size_t WS_SKWIN = WS_SVCMPT + (size_t)SB * NG * 512 * 64 * 2;
constexpr size_t WS_SVWINT = WS_SKWIN + (size_t)SB * NG * 544 * 64 * 2;
constexpr size_t WS_SNEW = WS_SVWINT + (size_t)SB * NG * 544 * 64 * 2;
constexpr size_t WS_QN = al(WS_SNEW + (size_t)SB * 4 * 2 * 4 * 64 * 4);
constexpr size_t WS_GATES = al(WS_QN + (size_t)MTOK * 1024 * 2);
constexpr size_t WS_OACC = al(WS_GATES + (size_t)MTOK * 48 * 4);
constexpr size_t WS_END = al(WS_OACC + (size_t)MTOK * DM * 4);

constexpr int RING_BYTES = 143360;
constexpr int LDSCTL_OFF = RING_BYTES, MISC_OFF = LDSCTL_OFF + 320;
constexpr int LDS_BYTES = 147456;

#define GAS __attribute__((address_space(1)))
#define LAS __attribute__((address_space(3)))
typedef unsigned short bf16;
typedef unsigned v4u __attribute__((ext_vector_type(4)));
typedef unsigned v2u __attribute__((ext_vector_type(2)));
typedef float f32x4 __attribute__((ext_vector_type(4)));
typedef float f32x2 __attribute__((ext_vector_type(2)));
typedef short bf16x8 __attribute__((ext_vector_type(8)));
typedef GAS unsigned gu32;
#define RLX_AGENT __ATOMIC_RELAXED, __HIP_MEMORY_SCOPE_AGENT
#define LDS_WAIT() asm volatile("s_waitcnt lgkmcnt(0)" ::: "memory")
#define VM_WAIT() asm volatile("s_waitcnt vmcnt(0)" ::: "memory")

__device__ __forceinline__ unsigned f2bf(float f) { unsigned u = __builtin_bit_cast(unsigned, f); return (u + 0x7fffu + ((u >> 16) & 1u)) >> 16; }
__device__ __forceinline__ unsigned pk2(float lo, float hi) { return f2bf(lo) | (f2bf(hi) << 16); }
__device__ __forceinline__ float bf2f(unsigned b) { return __builtin_bit_cast(float, b << 16); }
__device__ __forceinline__ float bflo(unsigned w) { return __builtin_bit_cast(float, w << 16); }
__device__ __forceinline__ float bfhi(unsigned w) { return __builtin_bit_cast(float, w & 0xffff0000u); }
__device__ __forceinline__ float wave_sum(float v) {
#pragma unroll
    for (int o = 1; o < 64; o <<= 1) v += __shfl_xor(v, o);
    return v;
}
__device__ __forceinline__ float silu_f(float x) { return x / (1.f + __expf(-x)); }
__device__ __forceinline__ float sigmoid_f(float x) { return 1.f / (1.f + __expf(-x)); }
__device__ __forceinline__ float gelu_tanh(float x) {
    const float u = 0.7978845608028654f * (x + 0.044715f * x * x * x);
    const float e = __expf(2.f * u);
    const float th = 1.f - 2.f / (e + 1.f);
    return 0.5f * x * (1.f + th);
}
__device__ __forceinline__ bf16x8 ld8(const bf16* p) { return *(const bf16x8*)p; }
__device__ __forceinline__ bf16x8 ld8l(const LAS bf16* p) { return *(const LAS bf16x8*)p; }
#define MFMA16(a, b, c) __builtin_amdgcn_mfma_f32_16x16x32_bf16((a), (b), (c), 0, 0, 0)
__device__ __forceinline__ bf16x8 cvt8(f32x4 a, f32x4 b) {
    v4u r; r.x = pk2(a.x, a.y); r.y = pk2(a.z, a.w); r.z = pk2(b.x, b.y); r.w = pk2(b.z, b.w); return __builtin_bit_cast(bf16x8, r);
}

struct Frame {
    LAS unsigned char* lds;
    int tid, lane, wave, G, bid;
    const __attribute__((address_space(4))) char* ka;
    float* out;
    unsigned char* ws;
};
#define WSP(T, off) ((T*)(F.ws + (off)))
__device__ __forceinline__ const float* fin_(const __attribute__((address_space(4))) char* ka, int i) {
    const __attribute__((address_space(4))) char* p = ka; asm volatile("" : "+s"(p));
    return *(const float* const __attribute__((address_space(4)))*)(p + 8 * i);
}
#define FIN(i) fin_(F.ka, (i))
namespace pg8 {
#define PG8_LAS __attribute__((address_space(3)))
typedef unsigned short bf16_t;
typedef short bf16x8 __attribute__((ext_vector_type(8)));
typedef float f32x4 __attribute__((ext_vector_type(4)));
typedef unsigned u32x4 __attribute__((ext_vector_type(4)));
constexpr int BM = 256, BK = 64, HALF = 128, HTB = HALF * BK * 2  , STAGE_BYTES = 8 * HTB, NXCD = 8, WGM = 8;

__host__ __device__ __forceinline__ int lds_byte(int r, int c) { const int st = (r >> 4) * 2 + (c >> 5), rr = r & 15, cc = c & 31, ob = rr * 64 + cc * 2; return st * 1024 + (ob ^ (((ob >> 9) & 1) << 5)); }
__host__ __device__ __forceinline__ void stage_rc(int b, int& R, int& C) { const int st = b / 1024, sb = b % 1024, swz = sb ^ (((sb >> 9) & 1) << 5); R = (st >> 1) * 16 + swz / 64; C = (st & 1) * 32 + (swz % 64) / 2; }
__host__ __device__ __forceinline__ int perm32(int rho) { const int n = rho >> 4, i = rho & 15; return 8 * (i >> 2) + 4 * n + (i & 3); }

struct Unit { int pm, pn; };
struct Gemm { const bf16_t* A; const bf16_t* Bt; int M, N, K; };

struct StaticOrder {
    int nM, nN, nwg, G, c;
    __host__ __device__ void init(int M, int N, int G_, int c_) { nM = M / BM; nN = N / BM; nwg = nM * nN; G = G_; c = c_; }
    __host__ __device__ bool next(int i, Unit& u) const {
        const long L = (long)i * G + c; if (L >= nwg) return false;
        int wgid = (int)L; { const int q = nwg / NXCD, r = nwg % NXCD, xcd = wgid % NXCD, off = wgid / NXCD; wgid = (xcd < r ? xcd * (q + 1) : r * (q + 1) + (xcd - r) * q) + off; }
        const int nig = WGM * nN, gid = wgid / nig, fm = gid * WGM, gsz = (nM - fm) < WGM ? (nM - fm) : WGM;
        u.pm = fm + ((wgid % nig) % gsz); u.pn = (wgid % nig) / gsz; return true;
    }
    __device__ __forceinline__ void a_ready(const Unit&) const {}
    __device__ __forceinline__ void done(const Unit&) const {}
};
template <class Epi, class Sched, bool ALIGN_EPI = false, bool SP2 = false>
__device__ __forceinline__ void gemm_phase(PG8_LAS unsigned char* lds, const Gemm g, const Sched& S, const Epi& E) {
    const int tid = threadIdx.x, wid = __builtin_amdgcn_readfirstlane(tid >> 6), lane = tid & 63, wr = wid >> 2, wc = wid & 3, fr = lane & 15, fq = lane >> 4;
    const int K = g.K, nt = K / BK;
    unsigned voffA[2], voffB[2];
#pragma unroll
    for (int i = 0; i < 2; ++i) { int R, C; stage_rc(tid * 16 + i * 8192, R, C); const int Rb = Epi::PERM ? ((R & ~31) + perm32(R & 31)) : R;
        voffA[i] = (unsigned)(R * K + C) * 2u; voffB[i] = (unsigned)(Rb * K + C) * 2u; }
    const size_t kstep = (size_t)(BK * 2);
    const size_t hstep = (size_t)HALF * K * 2;
    const size_t tstep = 2 * hstep;
    const unsigned ldsw = (unsigned)wid * 1024u;
    const int aoff = lds_byte(wr * 64 + fr, fq * 8), boff = lds_byte(wc * 32 + fr, fq * 8);
#define PG8_SA(b, h) (((b) * 2 + (h)) * HTB)
#define PG8_SB(b, h) ((4 + (b) * 2 + (h)) * HTB)
#define PG8_STAGE(bufoff, gbase, voff) do { _Pragma("unroll") for (int _i = 0; _i < 2; ++_i) \
        __builtin_amdgcn_global_load_lds((const unsigned*)((const char*)(gbase) + (voff)[_i]), (PG8_LAS unsigned*)(lds + (bufoff) + ldsw + _i * 8192), 16, 0, 0); } while (0)
#define PG8_LDA(dst, b, h) do { _Pragma("unroll") for (int m = 0; m < 4; ++m) _Pragma("unroll") for (int k = 0; k < 2; ++k) dst[m][k] = *(const PG8_LAS bf16x8*)(lds + PG8_SA(b, h) + aoff + m * 2048 + k * 1024); } while (0)
#define PG8_LDB(dst, b, h) do { _Pragma("unroll") for (int n = 0; n < 2; ++n) _Pragma("unroll") for (int k = 0; k < 2; ++k) dst[n][k] = *(const PG8_LAS bf16x8*)(lds + PG8_SB(b, h) + boff + n * 2048 + k * 1024); } while (0)
#define PG8_MMA(ai, bj, At, Bt) do { __builtin_amdgcn_s_setprio(1); _Pragma("unroll") for (int m = 0; m < 4; ++m) _Pragma("unroll") for (int n = 0; n < 2; ++n) _Pragma("unroll") for (int k = 0; k < 2; ++k) \
        acc[ai][bj][m][n] = __builtin_amdgcn_mfma_f32_16x16x32_bf16(Bt[n][k], At[m][k], acc[ai][bj][m][n], 0, 0, 0); __builtin_amdgcn_s_setprio(0); } while (0)
#define PG8_WAIT_V(n) asm volatile("s_waitcnt vmcnt(" #n ")" ::: "memory")
#define PG8_WAIT_L(n) asm volatile("s_waitcnt lgkmcnt(" #n ")" ::: "memory")
#define PG8_BAR __builtin_amdgcn_s_barrier()
#define PG8_SCHED __builtin_amdgcn_sched_barrier(0)
    Unit cur, nxt; int ui = 0;
    if (!S.next(0, cur)) return;
    f32x4 acc[2][2][4][2];
#pragma unroll
    for (int a = 0; a < 2; ++a)
#pragma unroll
        for (int b = 0; b < 2; ++b)
#pragma unroll
            for (int m = 0; m < 4; ++m)
#pragma unroll
                for (int n = 0; n < 2; ++n) acc[a][b][m][n] = (f32x4){0.f, 0.f, 0.f, 0.f};
    bf16x8 At[4][2], B0[2][2], B1[2][2];
    const char* cA = (const char*)g.A + (size_t)cur.pm * tstep; const char* cB = (const char*)g.Bt + (size_t)cur.pn * tstep;
    S.a_ready(cur);
    if constexpr (SP2) {
        PG8_STAGE(PG8_SB(0, 0), cB, voffB); PG8_STAGE(PG8_SB(0, 1), cB + hstep, voffB); PG8_STAGE(PG8_SA(0, 0), cA, voffA); PG8_STAGE(PG8_SA(0, 1), cA + hstep, voffA);
        if (wr == 1) PG8_BAR;
        PG8_WAIT_V(2); PG8_BAR;
        PG8_STAGE(PG8_SB(1, 0), cB + kstep, voffB); PG8_STAGE(PG8_SA(1, 0), cA + kstep, voffA); PG8_STAGE(PG8_SB(1, 1), cB + hstep + kstep, voffB);
        PG8_WAIT_V(6); PG8_BAR;
    } else {
        PG8_STAGE(PG8_SB(0, 0), cB, voffB); PG8_STAGE(PG8_SA(0, 0), cA, voffA); PG8_STAGE(PG8_SB(0, 1), cB + hstep, voffB); PG8_STAGE(PG8_SA(0, 1), cA + hstep, voffA);
        if (wr == 1) PG8_BAR;
        PG8_WAIT_V(4); PG8_BAR;
        PG8_STAGE(PG8_SB(1, 0), cB + kstep, voffB); PG8_STAGE(PG8_SA(1, 0), cA + kstep, voffA); PG8_STAGE(PG8_SB(1, 1), cB + hstep + kstep, voffB);
        PG8_WAIT_V(6); PG8_BAR;
    }
    for (;;) {
        const bool has_next = S.next(ui + 1, nxt);
        const char* nA = has_next ? (const char*)g.A + (size_t)nxt.pm * tstep : cA; const char* nB = has_next ? (const char*)g.Bt + (size_t)nxt.pn * tstep : cB;
        for (int t = 0; t < nt; t += 2) {
            const bool last = (t == nt - 2);
            const char* a1 = cA + (size_t)(t + 1) * kstep;
            const char* a2 = last ? nA : cA + (size_t)(t + 2) * kstep; const char* b2 = last ? nB : cB + (size_t)(t + 2) * kstep;
            const char* a3 = a2 + kstep; const char* b3 = b2 + kstep;
            if (last && has_next) S.a_ready(nxt);
            if constexpr (SP2) {
            PG8_LDB(B0, 0, 0); PG8_LDB(B1, 0, 1); PG8_SCHED; PG8_LDA(At, 0, 0); PG8_STAGE(PG8_SA(1, 1), a1 + hstep, voffA);
            PG8_WAIT_V(8); PG8_WAIT_L(0); PG8_BAR; PG8_MMA(0, 0, At, B0); PG8_MMA(0, 1, At, B1); PG8_BAR; PG8_SCHED;
            PG8_LDA(At, 0, 1); PG8_STAGE(PG8_SB(0, 0), b2, voffB); PG8_STAGE(PG8_SB(0, 1), b2 + hstep, voffB); PG8_STAGE(PG8_SA(0, 0), a2, voffA);
            PG8_WAIT_V(8); PG8_WAIT_L(0); PG8_BAR; PG8_MMA(1, 0, At, B0); PG8_MMA(1, 1, At, B1); PG8_BAR; PG8_SCHED;
            PG8_LDB(B0, 1, 0); PG8_LDB(B1, 1, 1); PG8_SCHED; PG8_LDA(At, 1, 0); PG8_STAGE(PG8_SA(0, 1), a2 + hstep, voffA);
            PG8_WAIT_V(8); PG8_WAIT_L(0); PG8_BAR; PG8_MMA(0, 0, At, B0); PG8_MMA(0, 1, At, B1); PG8_BAR; PG8_SCHED;
            PG8_LDA(At, 1, 1); PG8_STAGE(PG8_SB(1, 0), b3, voffB); PG8_STAGE(PG8_SB(1, 1), b3 + hstep, voffB); PG8_STAGE(PG8_SA(1, 0), a3, voffA);
            PG8_WAIT_V(8); PG8_WAIT_L(0); PG8_BAR; PG8_MMA(1, 0, At, B0); PG8_MMA(1, 1, At, B1); PG8_BAR; PG8_SCHED;
            } else {
            PG8_LDB(B0, 0, 0); PG8_SCHED; PG8_LDA(At, 0, 0); PG8_STAGE(PG8_SA(1, 1), a1 + hstep, voffA);
            PG8_WAIT_L(8); PG8_BAR; PG8_WAIT_L(0); PG8_MMA(0, 0, At, B0); PG8_BAR; PG8_SCHED;
            PG8_LDB(B1, 0, 1); PG8_STAGE(PG8_SB(0, 0), b2, voffB);
            PG8_BAR; PG8_WAIT_L(0); PG8_MMA(0, 1, At, B1); PG8_BAR;
            PG8_LDA(At, 0, 1); PG8_STAGE(PG8_SA(0, 0), a2, voffA);
            PG8_BAR; PG8_WAIT_L(0); PG8_MMA(1, 0, At, B0); PG8_BAR; PG8_SCHED;
            PG8_STAGE(PG8_SB(0, 1), b2 + hstep, voffB);
            PG8_WAIT_V(6); PG8_BAR; PG8_MMA(1, 1, At, B1); PG8_BAR;
            PG8_LDB(B0, 1, 0); PG8_SCHED; PG8_LDA(At, 1, 0); PG8_STAGE(PG8_SA(0, 1), a2 + hstep, voffA);
            PG8_WAIT_L(8); PG8_BAR; PG8_WAIT_L(0); PG8_MMA(0, 0, At, B0); PG8_BAR; PG8_SCHED;
            PG8_LDB(B1, 1, 1); PG8_STAGE(PG8_SB(1, 0), b3, voffB);
            PG8_BAR; PG8_WAIT_L(0); PG8_MMA(0, 1, At, B1); PG8_BAR;
            PG8_LDA(At, 1, 1); PG8_STAGE(PG8_SA(1, 0), a3, voffA);
            PG8_BAR; PG8_WAIT_L(0); PG8_MMA(1, 0, At, B0); PG8_BAR; PG8_SCHED;
            PG8_STAGE(PG8_SB(1, 1), b3 + hstep, voffB);
            PG8_WAIT_V(6); PG8_BAR; PG8_MMA(1, 1, At, B1); PG8_BAR;
            }
        }
        if constexpr (ALIGN_EPI) { if (wr == 0) PG8_BAR; }
        if constexpr (!Epi::AFTER_DRAIN) { E(acc, cur, wr, wc, fr, fq); S.done(cur); }
        if (!has_next) break;
#pragma unroll
        for (int a = 0; a < 2; ++a)
#pragma unroll
            for (int b = 0; b < 2; ++b)
#pragma unroll
                for (int m = 0; m < 4; ++m)
#pragma unroll
                    for (int n = 0; n < 2; ++n) acc[a][b][m][n] = (f32x4){0.f, 0.f, 0.f, 0.f};
        cur = nxt; cA = nA; cB = nB; ++ui;
        if constexpr (ALIGN_EPI) { if (wr == 1) PG8_BAR; }
    }
    PG8_WAIT_V(0);
    if constexpr (!ALIGN_EPI) { if (wr == 0) PG8_BAR; }
    PG8_BAR;
    if constexpr (Epi::AFTER_DRAIN) { E.fused(acc, cur, wr, wc, fr, fq, lds, wid, lane); S.done(cur); }
#undef PG8_SA
#undef PG8_SB
#undef PG8_STAGE
#undef PG8_LDA
#undef PG8_LDB
#undef PG8_MMA
#undef PG8_WAIT_V
#undef PG8_WAIT_L
#undef PG8_BAR
#undef PG8_SCHED
}
}
#define XB_TMO      128
#define XB_XCNT(j)  (256  + 64 * (j))
#define XB_XSUB(j)  (1280 + 64 * (j))
#define XB_XGEN(j)  (2304 + 64 * (j))
#define XB_TOP      3328
#define XB_TOPGEN   3392
#define XCD_BAR_WORDS 3456
#define XB_SPIN_CAP (1u << 18)

__device__ __forceinline__ unsigned xb_ld(unsigned* p)              { return __hip_atomic_load(p, __ATOMIC_RELAXED, __HIP_MEMORY_SCOPE_AGENT); }
__device__ __forceinline__ unsigned xb_add(unsigned* p, unsigned v) { return __hip_atomic_fetch_add(p, v, __ATOMIC_RELAXED, __HIP_MEMORY_SCOPE_AGENT); }
__device__ __forceinline__ unsigned xb_xcc_id() { return (unsigned)__builtin_amdgcn_s_getreg((3 << 11) | 20) & 0xFu; }
#define XB_SPIN(cond, bar) do { unsigned _sp = 0; while (cond) { __builtin_amdgcn_s_sleep(1); \
    if ((++_sp & 255u) == 0u) { if (xb_ld(&(bar)[XB_TMO])) break; if (_sp > XB_SPIN_CAP) { atomicAdd(&(bar)[XB_TMO], 1u); break; } } } } while (0)

struct XcdBarrier {
    unsigned* bar; unsigned x;
    volatile LAS unsigned* st;
};

__device__ __forceinline__ XcdBarrier xcd_barrier_post(unsigned* bar, volatile LAS unsigned* st) {
    XcdBarrier b; b.bar = bar; b.x = xb_xcc_id(); b.st = st;
    if (threadIdx.x == 0) (void)xb_add(&bar[XB_XCNT(b.x)], 1u);
    return b;
}
__device__ __forceinline__ void xcd_barrier_complete(unsigned* bar, unsigned x, unsigned& nloc, unsigned& nx) {
    const unsigned G = gridDim.x * gridDim.y * gridDim.z;
    unsigned sum, cnt, mine, sp = 0u;
    for (;;) {
        sum = 0u; cnt = 0u; mine = 0u;
#pragma unroll
        for (unsigned j = 0; j < 16; ++j) { const unsigned c = xb_ld(&bar[XB_XCNT(j)]); sum += c; cnt += (c > 0u) ? 1u : 0u; mine = (j == x) ? c : mine; }
        if (sum == G) break;
        __builtin_amdgcn_s_sleep(1);
        if ((++sp & 255u) == 0u) { if (xb_ld(&bar[XB_TMO])) break; if (sp > XB_SPIN_CAP) { atomicAdd(&bar[XB_TMO], 1u); break; } }
    }
    nloc = mine > 0u ? mine : 1u; nx = cnt > 0u ? cnt : 1u;
}

__device__ __forceinline__ void xcd_barrier(const XcdBarrier& b) {
    asm volatile("s_waitcnt vmcnt(0)" ::: "memory");
    __syncthreads();
    if (threadIdx.x == 0) {
        unsigned* bar = b.bar;
        __builtin_amdgcn_s_waitcnt(0);
        unsigned nloc = b.st[0], nx = b.st[1];
        if (nloc == 0u) { xcd_barrier_complete(bar, b.x, nloc, nx); b.st[0] = nloc; b.st[1] = nx; }
        const unsigned old = xb_add(&bar[XB_XSUB(b.x)], 1u);
        const unsigned gen = old / nloc;
        if (old + 1u == (gen + 1u) * nloc) {
            __builtin_amdgcn_fence(__ATOMIC_RELEASE, "agent");
            asm volatile("s_waitcnt vmcnt(0)" ::: "memory");
            const unsigned og = xb_add(&bar[XB_TOP], 1u);
            const unsigned tg = og / nx;
            if (og + 1u == (tg + 1u) * nx) xb_add(&bar[XB_TOPGEN], 1u);
            else XB_SPIN(xb_ld(&bar[XB_TOPGEN]) == tg, bar);
            __builtin_amdgcn_fence(__ATOMIC_ACQUIRE, "agent");
            xb_add(&bar[XB_XGEN(b.x)], 1u);
            asm volatile("s_waitcnt vmcnt(0)" ::: "memory");
        } else {
            XB_SPIN(xb_ld(&bar[XB_XGEN(b.x)]) == gen, bar);
            __builtin_amdgcn_fence(__ATOMIC_ACQUIRE, "agent");
            asm volatile("s_waitcnt vmcnt(0)" ::: "memory");
        }
    }
    __syncthreads();
}

namespace pg8 {
template <class Fn> struct EpiFn {
    static constexpr bool PERM = true, AFTER_DRAIN = false;
    Fn f;
    __device__ __forceinline__ void operator()(const f32x4 (&acc)[2][2][4][2], const Unit& u, int wr, int wc, int fr, int fq) const {
        const int row0 = u.pm * BM + wr * 64 + fr, col0 = u.pn * BM + wc * 32 + 8 * fq;
#pragma unroll
        for (int ai = 0; ai < 2; ++ai)
#pragma unroll
            for (int m = 0; m < 4; ++m)
#pragma unroll
                for (int bj = 0; bj < 2; ++bj) f.e8(row0 + ai * HALF + m * 16, col0 + bj * HALF, acc[ai][bj][m][0], acc[ai][bj][m][1]);
    }
};
}

struct FnBf16 {
    bf16* O; int ld;
    __device__ __forceinline__ void e8(int row, int col, f32x4 a, f32x4 b) const {
        v4u w; w.x = pk2(a.x, a.y); w.y = pk2(a.z, a.w); w.z = pk2(b.x, b.y); w.w = pk2(b.z, b.w);
        *(v4u*)(O + (size_t)row * ld + col) = w;
    }
    __device__ __forceinline__ void e4(int row, int col, f32x4 a) const {
        v2u w; w.x = pk2(a.x, a.y); w.y = pk2(a.z, a.w);
        *(v2u*)(O + (size_t)row * ld + col) = w;
    }
};
struct FnResid {
    float* XS; const float* baseP; const float* baseS;
    __device__ __forceinline__ const float* brow(int row) const { return row < MP ? baseP + (size_t)row * DM : baseS + (size_t)(row - MP) * DM; }
    __device__ __forceinline__ void e8(int row, int col, f32x4 a, f32x4 b) const {
        const float* br = brow(row) + col; float* o = XS + (size_t)row * DM + col;
        const f32x4 x0 = *(const f32x4*)br, x1 = *(const f32x4*)(br + 4);
        *(f32x4*)o = x0 + a; *(f32x4*)(o + 4) = x1 + b;
    }
    __device__ __forceinline__ void e4(int row, int col, f32x4 a) const {
        const float* br = brow(row) + col; float* o = XS + (size_t)row * DM + col;
        *(f32x4*)o = *(const f32x4*)br + a;
    }
};
struct FnKvq {
    float* O;
    __device__ __forceinline__ void e8(int row, int col, f32x4 a, f32x4 b) const {
        if (col < NKVQ_REAL) { float* o = O + (size_t)row * NKVQ + col; *(f32x4*)o = a; *(f32x4*)(o + 4) = b; }
    }
    __device__ __forceinline__ void e4(int row, int col, f32x4 a) const {
        if (col < NKVQ_REAL) *(f32x4*)(O + (size_t)row * NKVQ + col) = a;
    }
};

template <class Fn>
__device__ __forceinline__ void skinny_gemm(Frame& F, const bf16* A, const bf16* Bt, int N, int row_base, const Fn& fn) {
    const int fr = F.lane & 15, fq = F.lane >> 4;
    const int nun = N / 16;
    for (int u = F.bid; u < nun; u += F.G) {
        const bf16* ap = Bt + (size_t)(u * 16 + fr) * DM + fq * 8;
        const bf16* bp = A + (size_t)(F.wave * 16 + fr) * DM + fq * 8;
        f32x4 acc = {0.f, 0.f, 0.f, 0.f};
#pragma unroll 8
        for (int ks = 0; ks < 32; ++ks) acc = MFMA16(ld8(ap + ks * 32), ld8(bp + ks * 32), acc);
        fn.e4(row_base + F.wave * 16 + fr, u * 16 + 4 * fq, acc);
    }
}

template <class Fn>
__device__ __forceinline__ void gemm_all(Frame& F, const bf16* A, const bf16* Bt, int N, const Fn& fn) {
    pg8::Gemm g{A, Bt, MP, N, DM}; pg8::StaticOrder S; S.init(MP, N, F.G, F.bid);
    pg8::EpiFn<Fn> E{fn};
    pg8::gemm_phase<pg8::EpiFn<Fn>, pg8::StaticOrder, true, true>(F.lds, g, S, E);
    skinny_gemm(F, A + (size_t)MP * DM, Bt, N, MP, fn);
}

__device__ __forceinline__ void p0_transpose_item(const float* W, int N, bf16* WT, int row_off, const float* gain, LAS float* scr, int item, int lane) {
    const int nblk = (N + 31) / 32, kb = item / nblk, nb = item % nblk, k0 = 64 * kb, n0 = 32 * nb;
#pragma unroll 8
    for (int i = 0; i < 32; ++i) { const int kk = 2 * i + (lane >> 5); const int n = n0 + (lane & 31);
        float v = 0.f; if (n < N) { v = W[(size_t)(k0 + kk) * N + n]; if (gain) v *= gain[k0 + kk]; }
        scr[kk * 33 + (lane & 31)] = v; }
    LDS_WAIT(); asm volatile("" ::: "memory");
    const int c = lane & 7;
#pragma unroll
    for (int j = 0; j < 4; ++j) { const int n = (lane >> 3) + 8 * j; const LAS float* s = scr + (8 * c) * 33 + n;
        v4u o; o.x = pk2(s[0 * 33], s[1 * 33]); o.y = pk2(s[2 * 33], s[3 * 33]); o.z = pk2(s[4 * 33], s[5 * 33]); o.w = pk2(s[6 * 33], s[7 * 33]);
        if (n0 + n < N) *(v4u*)(WT + (size_t)(row_off + n0 + n) * DM + k0 + 8 * c) = o; }
    LDS_WAIT(); asm volatile("" ::: "memory");
}
__device__ __forceinline__ void rms_row_to_bf16(const float* xrow, bf16* orow, int lane) {
    const f32x4* xr = (const f32x4*)xrow + lane;
    f32x4 v[4]; float s = 0.f;
#pragma unroll
    for (int j = 0; j < 4; ++j) { v[j] = xr[64 * j]; s += (v[j].x * v[j].x + v[j].y * v[j].y) + (v[j].z * v[j].z + v[j].w * v[j].w); }
    const float rstd = 1.f / sqrtf(wave_sum(s) * (1.f / DM) + EPS);
    v2u* o8 = (v2u*)orow + lane;
#pragma unroll
    for (int j = 0; j < 4; ++j) { v2u w; w.x = pk2(v[j].x * rstd, v[j].y * rstd); w.y = pk2(v[j].z * rstd, v[j].w * rstd); o8[64 * j] = w; }
}
__device__ __forceinline__ const float* xin_row(Frame& F, int row) { return row < MP ? FIN(0) + (size_t)row * DM : FIN(1) + (size_t)(row - MP) * DM; }

__device__ __forceinline__ void p0_prologue(Frame& F) {
    LAS float* scr = (LAS float*)(F.lds + F.wave * 16384);
    const int gw = F.bid * 8 + F.wave, NGW = F.G * 8;
    const int gt = F.bid * 512 + F.tid, NGT = F.G * 512;
    {
        constexpr int I_IN = 128 * 16, I_OA = 32 * 16, I_KV = 48 * 16, I_QG = 34 * 16, I_OB = 32 * 16, I_PQ = 64 * 16;
        constexpr int NITEMS = I_IN + I_OA + I_KV + I_QG + I_OB + 2 * I_PQ;
        for (int it = gw; it < NITEMS; it += NGW) {
            int r = it;
            if (r < I_IN) {
                const int kb = r / 128, nb = r % 128, k0 = 64 * kb, n0 = 32 * nb; const float* W = FIN(8); const float* gain = FIN(7);
#pragma unroll 8
                for (int i = 0; i < 32; ++i) { const int kk = 2 * i + (F.lane >> 5); scr[kk * 33 + (F.lane & 31)] = W[(size_t)(k0 + kk) * GPROJ + n0 + (F.lane & 31)] * gain[k0 + kk]; }
                LDS_WAIT(); asm volatile("" ::: "memory");
                const int c = F.lane & 7;
#pragma unroll
                for (int j = 0; j < 4; ++j) { const int n = (F.lane >> 3) + 8 * j; const LAS float* s = scr + (8 * c) * 33 + n;
                    v4u o; o.x = pk2(s[0 * 33], s[1 * 33]); o.y = pk2(s[2 * 33], s[3 * 33]); o.z = pk2(s[4 * 33], s[5 * 33]); o.w = pk2(s[6 * 33], s[7 * 33]);
                    *(v4u*)(WSP(bf16, WS_WIN_T) + (size_t)(n0 + n) * DM + k0 + 8 * c) = o; }
                LDS_WAIT(); asm volatile("" ::: "memory");
                continue; }
            r -= I_IN;
            if (r < I_OA) { p0_transpose_item(FIN(13), 1024, WSP(bf16, WS_WOA_T), 0, nullptr, scr, r, F.lane); continue; } r -= I_OA;
            if (r < I_KV) { p0_transpose_item(FIN(15), NKV, WSP(bf16, WS_WKVQ_T), 0, FIN(14), scr, r, F.lane); continue; } r -= I_KV;
            if (r < I_QG) { p0_transpose_item(FIN(21), NQG, WSP(bf16, WS_WKVQ_T), NKV, FIN(20), scr, r, F.lane); continue; } r -= I_QG;
            if (r < I_OB) { p0_transpose_item(FIN(23), 1024, WSP(bf16, WS_WOB_T), 0, nullptr, scr, r, F.lane); continue; } r -= I_OB;
            if (r < I_PQ) { p0_transpose_item(FIN(25), 2048, WSP(bf16, WS_WPQ_T), 0, FIN(24), scr, r, F.lane); continue; } r -= I_PQ;
            p0_transpose_item(FIN(25) + (size_t)1024 * 2048, 2048, WSP(bf16, WS_WPQ_T) + (size_t)2048 * 1024, 0, FIN(24) + 1024, scr, r, F.lane);
        }
        for (int i = gt; i < (NKVQ - NKVQ_REAL) * DM / 8; i += NGT) ((v4u*)(WSP(bf16, WS_WKVQ_T) + (size_t)NKVQ_REAL * DM))[i] = (v4u){0u, 0u, 0u, 0u};
        for (int i = gt; i < 16 * 1024; i += NGT) { const int j = i >> 10, k = i & 1023; WSP(float, WS_WAB)[i] = FIN(7)[k] * FIN(8)[(size_t)k * GPROJ + 4096 + j]; }
    }
    for (int m = gw; m < MTOK; m += NGW) rms_row_to_bf16(xin_row(F, m), WSP(bf16, WS_XNA) + (size_t)m * DM, F.lane);
    {
        const size_t n8 = (size_t)2 * NEXP * DM / 8;
        for (int t = 0; t < 2; ++t) { const f32x4* src = (const f32x4*)FIN(27 + t); v4u* dst = (v4u*)WSP(bf16, t == 0 ? WS_PU : WS_PV); const float* pln = FIN(24);
            for (size_t i = gt; i < n8; i += NGT) { f32x4 a = src[2 * i], b = src[2 * i + 1];
                if (t == 0) { const float* gp = pln + ((i >> 21) << 10) + ((i & 127) << 3); a = a * *(const f32x4*)gp; b = b * *(const f32x4*)(gp + 4); }
                v4u w; w.x = pk2(a.x, a.y); w.y = pk2(a.z, a.w); w.z = pk2(b.x, b.y); w.w = pk2(b.z, b.w); dst[i] = w; } }
        const f32x4* sk = (const f32x4*)FIN(26); v4u* dk = (v4u*)WSP(bf16, WS_SUBK);
        for (int i = gt; i < 2 * 8 * 2 * 128 * 128 / 8; i += NGT) { const f32x4 a = sk[2 * i], b = sk[2 * i + 1]; v4u w; w.x = pk2(a.x, a.y); w.y = pk2(a.z, a.w); w.z = pk2(b.x, b.y); w.w = pk2(b.z, b.w); dk[i] = w; }
    }
    for (int i = gt; i < 2 * 64 * 2048; i += NGT) { const int kv = i >> 17, hh = (i >> 11) & 63, k = i & 2047;
        WSP(bf16, WS_W1T)[i] = (bf16)f2bf(FIN(17)[((size_t)kv * 2048 + k) * 64 + hh]); }
    for (int it = gw; it < 128; it += NGW) { const int kv = it >> 6, h = it & 63; float s = 0.f;
        for (int k = F.lane; k < 2048; k += 64) s += FIN(18)[(size_t)kv * 2048 + k] * FIN(17)[((size_t)kv * 2048 + k) * 64 + h];
        s = wave_sum(s); if (F.lane == 0) WSP(float, WS_PETERM)[it] = s; }
    {
        const f32x4* src = (const f32x4*)FIN(3); f32x4* dst = (f32x4*)(F.out + O_WINS);
        const int per_b = 508 * 512 / 4;
        for (int i = gt; i < SB * per_b; i += NGT) { const int b = i / per_b, r = i % per_b; dst[(size_t)b * (512 * 512 / 4) + r] = src[(size_t)b * (512 * 512 / 4) + 4 * 512 / 4 + r]; }
    }
    for (int i = gt; i < SB * NG * 544 * 64; i += NGT) {
        const int d = i & 63, r = (i >> 6) % 544, bg = (i >> 6) / 544, g = bg & 3, b = bg >> 2;
        if (r < 512) { const float* cw = FIN(3) + (((size_t)b * 512 + r) * 2) * 256 + g * 64 + d;
            WSP(bf16, WS_SKWIN)[i] = (bf16)f2bf(cw[0]);
            WSP(bf16, WS_SVWINT)[((size_t)bg * 64 + d) * 544 + r] = (bf16)f2bf(cw[256]); }
        else if (r >= 516) { WSP(bf16, WS_SKWIN)[i] = 0; WSP(bf16, WS_SVWINT)[((size_t)bg * 64 + d) * 544 + r] = 0; }
    }
}

constexpr int P2_QS = 0, P2_KS = 17408, P2_KBGT = 34816, P2_VBT = 53248, P2_AM = 71680, P2_TB = 89088, P2_G = 98304;
constexpr int QS_LD = 136, KT_LD = 72, AM_LD = 68, TB_LD = 72;

__device__ __forceinline__ float softplus_f(float x) { return fmaxf(x, 0.f) + log1pf(expf(-fabsf(x))); }

__device__ __forceinline__ void p2_chunk(Frame& F, int unit) {
    const int c = unit & 127, h = (unit >> 7) & 7, b = unit >> 10;
    const int t0 = c * CHUNK, lane = F.lane, w = F.wave, fr = lane & 15, fq = lane >> 4;
    LAS unsigned char* L = F.lds; asm volatile("" : "+v"(L));
    LAS bf16* qs = (LAS bf16*)(L + P2_QS); LAS bf16* ks = (LAS bf16*)(L + P2_KS);
    LAS bf16* kbgT = (LAS bf16*)(L + P2_KBGT); LAS bf16* vbT = (LAS bf16*)(L + P2_VBT);
    LAS float* Am = (LAS float*)(L + P2_AM); LAS bf16* Tb = (LAS bf16*)(L + P2_TB);
    LAS float* Gs = (LAS float*)(L + P2_G);
    const bf16* PROJ = WSP(bf16, WS_PROJ); const bf16* XNA = WSP(bf16, WS_XNA); const float* WAB = WSP(float, WS_WAB);
    const size_t rowb = (size_t)b * PT;
    float beta_r[8];
    {
        f32x4 wa[4], wb[4];
        const float* pa = WAB + (size_t)h * DM + 8 * lane; const float* pb = WAB + (size_t)(8 + h) * DM + 8 * lane;
        wa[0] = *(const f32x4*)pa; wa[1] = *(const f32x4*)(pa + 4); wa[2] = *(const f32x4*)(pa + 512); wa[3] = *(const f32x4*)(pa + 516);
        wb[0] = *(const f32x4*)pb; wb[1] = *(const f32x4*)(pb + 4); wb[2] = *(const f32x4*)(pb + 512); wb[3] = *(const f32x4*)(pb + 516);
        const float Aneg = -expf(FIN(10)[h]), dtb = FIN(11)[h];
#pragma unroll
        for (int tk = 0; tk < 8; ++tk) {
            const int tok = 8 * w + tk; const bf16* xr = XNA + (rowb + t0 + tok) * DM + 8 * lane;
            const v4u x0 = *(const v4u*)xr, x1 = *(const v4u*)(xr + 512);
            float sa = 0.f, sb = 0.f;
#define ACC2(xw, wv0, wv1, i0) { const float lo = bflo(xw), hi = bfhi(xw); sa += lo * wv0[i0] + hi * wv0[i0 + 1]; sb += lo * wv1[i0] + hi * wv1[i0 + 1]; }
            ACC2(x0.x, wa[0], wb[0], 0) ACC2(x0.y, wa[0], wb[0], 2) ACC2(x0.z, wa[1], wb[1], 0) ACC2(x0.w, wa[1], wb[1], 2)
            ACC2(x1.x, wa[2], wb[2], 0) ACC2(x1.y, wa[2], wb[2], 2) ACC2(x1.z, wa[3], wb[3], 0) ACC2(x1.w, wa[3], wb[3], 2)
#undef ACC2
            sa = wave_sum(sa); sb = wave_sum(sb);
            const float g = Aneg * softplus_f(sa + dtb), be = 1.f / (1.f + expf(-sb));
            beta_r[tk] = be;
            if (lane == 0) { Gs[tok] = g; Gs[64 + tok] = be; }
        }
    }
#pragma unroll
    for (int p = 0; p < 3; ++p) {
        const int col0 = p * 1024 + h * 128 + 2 * lane;
        float cw0[4], cw1[4];
#pragma unroll
        for (int i = 0; i < 4; ++i) { const f32x2 cv = *(const f32x2*)(FIN(9) + (size_t)i * GCONV + col0); cw0[i] = cv.x; cw1[i] = cv.y; }
        unsigned xw[11];
#pragma unroll
        for (int rr = 0; rr < 11; ++rr) { const int t = t0 + 8 * w - 3 + rr; xw[rr] = (t >= 0) ? *(const unsigned*)(PROJ + (rowb + t) * 4096 + col0) : 0u; }
        if (c == 127 && w == 7) {
#pragma unroll
            for (int r = 0; r < 3; ++r) { float* o = F.out + O_CONVP + ((size_t)b * 3 + r) * GCONV + col0; o[0] = bflo(xw[8 + r]); o[1] = bfhi(xw[8 + r]); }
        }
#pragma unroll
        for (int tk = 0; tk < 8; ++tk) {
            const int tok = 8 * w + tk;
            float y0 = 0.f, y1 = 0.f;
#pragma unroll
            for (int i = 0; i < 4; ++i) { y0 += cw0[i] * bflo(xw[tk + i]); y1 += cw1[i] * bfhi(xw[tk + i]); }
            y0 = silu_f(y0); y1 = silu_f(y1);
            if (p < 2) {
                const float ss = wave_sum(y0 * y0 + y1 * y1);
                const float rs = (1.f / sqrtf(ss + EPS)) * (p == 0 ? 0.08838834764831845f : 1.f);
                *(LAS unsigned*)((p == 0 ? qs : ks) + tok * QS_LD + 2 * lane) = pk2(y0 * rs, y1 * rs);
            } else {
                vbT[(2 * lane) * KT_LD + tok] = (bf16)f2bf(y0 * beta_r[tk]); vbT[(2 * lane + 1) * KT_LD + tok] = (bf16)f2bf(y1 * beta_r[tk]);
            }
        }
    }
    __syncthreads();
    if (w == 0) { float g = Gs[lane];
#pragma unroll
        for (int o = 1; o < 64; o <<= 1) { const float up = __shfl_up(g, o); if (lane >= o) g += up; }
        Gs[128 + lane] = g; }
    __syncthreads();
    const float glast = Gs[128 + 63];
    const size_t chunk = (size_t)unit;
    if (w < 4) {
        const int mt = w;
        bf16x8 a[4];
#pragma unroll
        for (int kk = 0; kk < 4; ++kk) a[kk] = ld8l(ks + (16 * mt + fr) * QS_LD + 32 * kk + 8 * fq);
#pragma unroll
        for (int nt = 0; nt < 4; ++nt) {
            f32x4 acc = {0.f, 0.f, 0.f, 0.f};
            if (nt <= mt) {
#pragma unroll
                for (int kk = 0; kk < 4; ++kk) acc = MFMA16(a[kk], ld8l(ks + (16 * nt + fr) * QS_LD + 32 * kk + 8 * fq), acc);
            }
            const int j = 16 * nt + fr; const float gj = Gs[128 + j];
#pragma unroll
            for (int r = 0; r < 4; ++r) { const int i = 16 * mt + 4 * fq + r;
                Am[i * AM_LD + j] = (i > j) ? Gs[64 + i] * acc[r] * __expf(Gs[128 + i] - gj) : 0.f; }
        }
    } else {
        const int nt = w - 4;
        bf16x8 bq[4];
#pragma unroll
        for (int kk = 0; kk < 4; ++kk) bq[kk] = ld8l(qs + (16 * nt + fr) * QS_LD + 32 * kk + 8 * fq);
        const int i = 16 * nt + fr; const float gi = Gs[128 + i];
        bf16* gqk = WSP(bf16, WS_GQK) + chunk * 4096 + (size_t)i * 64;
#pragma unroll
        for (int mt = 0; mt < 4; ++mt) {
            f32x4 acc = {0.f, 0.f, 0.f, 0.f};
            if (mt <= nt) {
#pragma unroll
                for (int kk = 0; kk < 4; ++kk) acc = MFMA16(ld8l(ks + (16 * mt + fr) * QS_LD + 32 * kk + 8 * fq), bq[kk], acc);
            }
            float v[4];
#pragma unroll
            for (int r = 0; r < 4; ++r) { const int j = 16 * mt + 4 * fq + r; v[r] = (i >= j) ? acc[r] * __expf(gi - Gs[128 + j]) : 0.f; }
            v2u o; o.x = pk2(v[0], v[1]); o.y = pk2(v[2], v[3]);
            *(v2u*)(gqk + 16 * mt + 4 * fq) = o;
        }
    }
    {
        const int tok = F.tid >> 3, d0 = (F.tid & 7) * 16; const float e = __expf(Gs[128 + tok]);
        bf16* gq = WSP(bf16, WS_GQ) + chunk * 8192 + (size_t)tok * 128 + d0;
#pragma unroll
        for (int hh = 0; hh < 2; ++hh) { const v4u q = *(const LAS v4u*)(qs + tok * QS_LD + d0 + 8 * hh); v4u o;
            o.x = pk2(bflo(q.x) * e, bfhi(q.x) * e); o.y = pk2(bflo(q.y) * e, bfhi(q.y) * e); o.z = pk2(bflo(q.z) * e, bfhi(q.z) * e); o.w = pk2(bflo(q.w) * e, bfhi(q.w) * e);
            *(v4u*)(gq + 8 * hh) = o; }
    }
    {
        const int dk = F.tid & 127, tg = F.tid >> 7;
        unsigned o1[8], o2[8];
#pragma unroll
        for (int i = 0; i < 8; ++i) {
            const int ta = 16 * tg + 2 * i, tb2 = ta + 1;
            const float ka = bf2f(ks[ta * QS_LD + dk]), kb = bf2f(ks[tb2 * QS_LD + dk]);
            const float ga = Gs[128 + ta], gb = Gs[128 + tb2];
            o1[i] = pk2(ka * Gs[64 + ta] * __expf(ga), kb * Gs[64 + tb2] * __expf(gb));
            o2[i] = pk2(ka * __expf(glast - ga), kb * __expf(glast - gb));
        }
        LAS v4u* d1 = (LAS v4u*)(kbgT + dk * KT_LD + 16 * tg); d1[0] = (v4u){o1[0], o1[1], o1[2], o1[3]}; d1[1] = (v4u){o1[4], o1[5], o1[6], o1[7]};
        v4u* d2 = (v4u*)(WSP(bf16, WS_GKT) + chunk * 8192 + (size_t)dk * 64 + 16 * tg); d2[0] = (v4u){o2[0], o2[1], o2[2], o2[3]}; d2[1] = (v4u){o2[4], o2[5], o2[6], o2[7]};
    }
    if (F.tid == 0) WSP(float, WS_GDEC)[chunk] = __expf(glast);
    __syncthreads();
    if (w == 0) {
        float t[64];
#pragma unroll
        for (int i = 0; i < 64; ++i) {
            float acc0 = (i == lane) ? 1.f : 0.f, acc1 = 0.f;
#pragma unroll
            for (int j4 = 0; j4 < (i + 3) / 4; ++j4) {
                const f32x4 a = *(const LAS f32x4*)(Am + i * AM_LD + 4 * j4);
                if (4 * j4 + 0 < i) acc0 = __builtin_fmaf(-a.x, t[4 * j4 + 0], acc0);
                if (4 * j4 + 1 < i) acc1 = __builtin_fmaf(-a.y, t[4 * j4 + 1], acc1);
                if (4 * j4 + 2 < i) acc0 = __builtin_fmaf(-a.z, t[4 * j4 + 2], acc0);
                if (4 * j4 + 3 < i) acc1 = __builtin_fmaf(-a.w, t[4 * j4 + 3], acc1);
            }
            t[i] = acc0 + acc1;
        }
#pragma unroll
        for (int i = 0; i < 64; ++i) Tb[i * TB_LD + lane] = (bf16)f2bf(t[i]);
    }
    __syncthreads();
    {
        bf16x8 tb[4][2];
#pragma unroll
        for (int x = 0; x < 4; ++x)
#pragma unroll
            for (int s = 0; s < 2; ++s) tb[x][s] = ld8l(Tb + (16 * x + fr) * TB_LD + 32 * s + 8 * fq);
        const bf16x8 bv0 = ld8l(vbT + (16 * w + fr) * KT_LD + 8 * fq), bv1 = ld8l(vbT + (16 * w + fr) * KT_LD + 32 + 8 * fq);
        f32x4* gu = (f32x4*)(WSP(float, WS_GU) + chunk * 8192) + (size_t)w * 256 + lane;
#pragma unroll
        for (int mt = 0; mt < 4; ++mt) { f32x4 acc = {0.f, 0.f, 0.f, 0.f}; acc = MFMA16(tb[mt][0], bv0, acc); acc = MFMA16(tb[mt][1], bv1, acc); gu[mt * 64] = acc; }
        const bf16x8 ak0 = ld8l(kbgT + (16 * w + fr) * KT_LD + 8 * fq), ak1 = ld8l(kbgT + (16 * w + fr) * KT_LD + 32 + 8 * fq);
        bf16* gw = WSP(bf16, WS_GW) + chunk * 8192;
#pragma unroll
        for (int nt = 0; nt < 4; ++nt) { f32x4 acc = {0.f, 0.f, 0.f, 0.f}; acc = MFMA16(ak0, tb[nt][0], acc); acc = MFMA16(ak1, tb[nt][1], acc);
            v2u o; o.x = pk2(acc[0], acc[1]); o.y = pk2(acc[2], acc[3]);
            *(v2u*)(gw + (size_t)(16 * nt + fr) * 128 + 16 * w + 4 * fq) = o; }
    }
    __syncthreads();
}

constexpr int S2_Y = 0;
constexpr int S2_AB = 6144;
constexpr int S2_DOT = 6400;
constexpr int S2_U = 6656;
constexpr int S2_W = 8704;
constexpr int S2_VN = 10752;
__device__ __forceinline__ void p2_sample(Frame& F, int unit) {
    const int h = unit & 7, bs = unit >> 3, tid = F.tid, lane = F.lane, w = F.wave;
    LAS unsigned char* L = F.lds; asm volatile("" : "+v"(L));
    LAS float* Y = (LAS float*)(L + S2_Y); LAS float* AB = (LAS float*)(L + S2_AB); LAS float* DOT = (LAS float*)(L + S2_DOT);
    LAS float* U = (LAS float*)(L + S2_U); LAS float* W = (LAS float*)(L + S2_W); LAS float* VN = (LAS float*)(L + S2_VN);
    const bf16* PROJ = WSP(bf16, WS_PROJ); const bf16* XNA = WSP(bf16, WS_XNA); const float* WAB = WSP(float, WS_WAB);
    const size_t row0 = (size_t)MP + bs * 4;
    if (tid < 384) {
        const int part = tid >> 7, cc = tid & 127, col = part * 1024 + h * 128 + cc;
        float buf[7];
#pragma unroll
        for (int r = 0; r < 3; ++r) buf[r] = FIN(5)[((size_t)bs * 3 + r) * GCONV + col];
#pragma unroll
        for (int i = 0; i < 4; ++i) buf[3 + i] = bf2f(PROJ[(row0 + i) * 4096 + col]);
#pragma unroll
        for (int r = 0; r < 3; ++r) F.out[O_CONVS + ((size_t)bs * 3 + r) * GCONV + col] = buf[4 + r];
        float cw[4];
#pragma unroll
        for (int i = 0; i < 4; ++i) cw[i] = FIN(9)[(size_t)i * GCONV + col];
#pragma unroll
        for (int i = 0; i < 4; ++i) { float y = 0.f;
#pragma unroll
            for (int k = 0; k < 4; ++k) y += cw[k] * buf[i + k];
            Y[(part * 4 + i) * 128 + cc] = silu_f(y); }
    }
    {
        const int i = w >> 1, which = w & 1; const bf16* xr = XNA + (row0 + i) * DM; const float* wr = WAB + (size_t)(which * 8 + h) * DM; float s = 0.f;
        for (int k = lane; k < DM; k += 64) s += bf2f(xr[k]) * wr[k];
        s = wave_sum(s); if (lane == 0) AB[which * 4 + i] = s;
    }
    __syncthreads();
    {
        const int part = w >> 2, i = w & 3; LAS float* y = Y + (part * 4 + i) * 128; const float a = y[lane], bq = y[64 + lane];
        const float ss = wave_sum(a * a + bq * bq); const float rs = (1.f / sqrtf(ss + EPS)) * (part == 0 ? 0.08838834764831845f : 1.f);
        y[lane] = a * rs; y[64 + lane] = bq * rs;
    }
    if (tid == 0) { const float Aneg = -expf(FIN(10)[h]), dtb = FIN(11)[h]; float gc = 0.f;
        for (int i = 0; i < 4; ++i) { const float g = Aneg * softplus_f(AB[i] + dtb); gc += g; AB[8 + i] = g; AB[12 + i] = 1.f / (1.f + expf(-AB[4 + i])); AB[16 + i] = gc; } }
    __syncthreads();
    {
#pragma unroll
        for (int pp = 0; pp < 4; ++pp) { const int pr = 4 * w + pp, which = pr >> 4, i = (pr >> 2) & 3, j = pr & 3;
            const LAS float* x = Y + ((which == 0 ? 1 : 0) * 4 + i) * 128; const LAS float* y = Y + (1 * 4 + j) * 128;
            float s = x[lane] * y[lane] + x[64 + lane] * y[64 + lane]; s = wave_sum(s); if (lane == 0) DOT[pr] = s; }
    }
    __syncthreads();
    float g_[4], be[4], gc[4];
#pragma unroll
    for (int i = 0; i < 4; ++i) { g_[i] = AB[8 + i]; be[i] = AB[12 + i]; gc[i] = AB[16 + i]; }
    float Tm[4][4];
    {
        float A[4][4];
#pragma unroll
        for (int i = 0; i < 4; ++i)
#pragma unroll
            for (int j = 0; j < 4; ++j) A[i][j] = (i > j) ? be[i] * DOT[i * 4 + j] * expf(gc[i] - gc[j]) : 0.f;
#pragma unroll
        for (int cc = 0; cc < 4; ++cc)
#pragma unroll
            for (int i = 0; i < 4; ++i) { float acc = (i == cc) ? 1.f : 0.f;
#pragma unroll
                for (int j = 0; j < 4; ++j) if (j < i) acc -= A[i][j] * Tm[j][cc];
                Tm[i][cc] = acc; }
    }
    {
        const int i = tid >> 7, x = tid & 127; float su = 0.f, sw = 0.f;
#pragma unroll
        for (int j = 0; j < 4; ++j) { su += Tm[i][j] * Y[(2 * 4 + j) * 128 + x] * be[j]; sw += Tm[i][j] * Y[(1 * 4 + j) * 128 + x] * be[j] * expf(gc[j]); }
        U[i * 128 + x] = su; W[i * 128 + x] = sw;
    }
    __syncthreads();
    const float* S0 = FIN(4) + ((size_t)bs * GH + h) * 128 * 128;
    float qs_acc;
    {
        const int i = tid >> 7, dv = tid & 127; float p = 0.f, qq = 0.f;
        const LAS float* wr = W + i * 128; const LAS float* qr = Y + (0 * 4 + i) * 128;
        for (int dk = 0; dk < 128; ++dk) { const float s = S0[(size_t)dk * 128 + dv]; p += wr[dk] * s; qq += qr[dk] * s; }
        VN[i * 128 + dv] = U[i * 128 + dv] - p; qs_acc = qq * expf(gc[i]);
    }
    __syncthreads();
    {
        const int i = tid >> 7, dv = tid & 127; float o = qs_acc;
#pragma unroll
        for (int j = 0; j < 4; ++j) if (j <= i) o += DOT[16 + i * 4 + j] * expf(gc[i] - gc[j]) * VN[j * 128 + dv];
        WSP(float, WS_OGDN)[(row0 + i) * DM + h * 128 + dv] = o;
    }
    {
        const int dv = tid & 127, dg = tid >> 7; const float el = expf(gc[3]);
        float kd[4], vn[4];
#pragma unroll
        for (int j = 0; j < 4; ++j) { kd[j] = expf(gc[3] - gc[j]); vn[j] = VN[j * 128 + dv]; }
        float* So = F.out + O_GDNS + ((size_t)bs * GH + h) * 128 * 128;
        for (int dk = dg * 32; dk < dg * 32 + 32; ++dk) { float s = S0[(size_t)dk * 128 + dv] * el;
#pragma unroll
            for (int j = 0; j < 4; ++j) s += Y[(1 * 4 + j) * 128 + dk] * kd[j] * vn[j];
            So[(size_t)dk * 128 + dv] = s; }
    }
    (void)g_;
    __syncthreads();
}

constexpr int P3_S = 0;
constexpr int P3_VN = 8192;
__device__ __forceinline__ void p3_scan(Frame& F, int bh, int s) {
    const int lane = F.lane, w = F.wave, fr = lane & 15, fq = lane >> 4;
    const int b = bh >> 3, h = bh & 7;
    LAS bf16* Sl = (LAS bf16*)(F.lds + P3_S); LAS bf16* Vl = (LAS bf16*)(F.lds + P3_VN);
    const bf16* GW = WSP(bf16, WS_GW); const bf16* GQ = WSP(bf16, WS_GQ); const bf16* GKT = WSP(bf16, WS_GKT); const bf16* GQK = WSP(bf16, WS_GQK);
    const float* GU = WSP(float, WS_GU); const float* GDEC = WSP(float, WS_GDEC);
    float* OG = WSP(float, WS_OGDN);
    f32x4 Sacc = {0.f, 0.f, 0.f, 0.f};
    { v2u z = {0u, 0u}; *(LAS v2u*)(Sl + fr * 136 + 16 * w + 4 * fq) = z; }
    __syncthreads();
    const int m = w & 3;
    for (int c = 0; c < NCH; ++c) {
        const size_t chunk = (size_t)bh * NCH + c;
        bf16x8 a1[4];
        const bf16* p1 = (w < 4 ? GW : GQ) + chunk * 8192 + (size_t)(16 * m + fr) * 128 + 8 * fq;
#pragma unroll
        for (int k = 0; k < 4; ++k) a1[k] = ld8(p1 + 32 * k);
        const bf16* pk = GKT + chunk * 8192 + (size_t)(16 * w + fr) * 64 + 8 * fq;
        const bf16x8 ak0 = ld8(pk), ak1 = ld8(pk + 32);
        bf16x8 aq0, aq1; f32x4 u4 = {0.f, 0.f, 0.f, 0.f};
        if (w >= 4) { const bf16* pq = GQK + chunk * 4096 + (size_t)(16 * m + fr) * 64 + 8 * fq; aq0 = ld8(pq); aq1 = ld8(pq + 32); }
        else u4 = *((const f32x4*)(GU + chunk * 8192) + (size_t)s * 256 + m * 64 + lane);
        const float dec = GDEC[chunk];
        f32x4 acc = {0.f, 0.f, 0.f, 0.f};
#pragma unroll
        for (int k = 0; k < 4; ++k) acc = MFMA16(a1[k], ld8l(Sl + fr * 136 + 32 * k + 8 * fq), acc);
        if (w < 4) { const f32x4 vn = u4 - acc; v2u o; o.x = pk2(vn[0], vn[1]); o.y = pk2(vn[2], vn[3]); *(LAS v2u*)(Vl + fr * 72 + 16 * m + 4 * fq) = o; }
        __syncthreads();
        const bf16x8 v0 = ld8l(Vl + fr * 72 + 8 * fq), v1 = ld8l(Vl + fr * 72 + 32 + 8 * fq);
        if (w >= 4) { acc = MFMA16(aq0, v0, acc); acc = MFMA16(aq1, v1, acc);
            float* o = OG + ((size_t)b * PT + c * CHUNK + 16 * m + 4 * fq) * DM + h * 128 + 16 * s + fr;
#pragma unroll
            for (int r = 0; r < 4; ++r) o[(size_t)r * DM] = acc[r]; }
        Sacc = Sacc * dec; Sacc = MFMA16(ak0, v0, Sacc); Sacc = MFMA16(ak1, v1, Sacc);
        { v2u o; o.x = pk2(Sacc[0], Sacc[1]); o.y = pk2(Sacc[2], Sacc[3]); *(LAS v2u*)(Sl + fr * 136 + 16 * w + 4 * fq) = o; }
        __syncthreads();
    }
    float* So = F.out + O_GDNP + ((size_t)bh * 128) * 128;
#pragma unroll
    for (int r = 0; r < 4; ++r) So[(size_t)(16 * w + 4 * fq + r) * 128 + 16 * s + fr] = Sacc[r];
}

__device__ __forceinline__ void p4_row(Frame& F, int row) {
    const int lane = F.lane;
    const float* o = WSP(float, WS_OGDN) + (size_t)row * DM + 16 * lane;
    const bf16* z = WSP(bf16, WS_PROJ) + (size_t)row * 4096 + 3072 + 16 * lane;
    f32x4 v[4]; float ss = 0.f;
#pragma unroll
    for (int j = 0; j < 4; ++j) { v[j] = *(const f32x4*)(o + 4 * j); ss += (v[j].x * v[j].x + v[j].y * v[j].y) + (v[j].z * v[j].z + v[j].w * v[j].w); }
    ss += __shfl_xor(ss, 1); ss += __shfl_xor(ss, 2); ss += __shfl_xor(ss, 4);
    const float rstd = 1.f / sqrtf(ss * (1.f / 128.f) + EPS);
    const v4u z0 = *(const v4u*)z, z1 = *(const v4u*)(z + 8);
    const float* gn = FIN(12) + (16 * lane & 127);
    float zz[16] = {bflo(z0.x), bfhi(z0.x), bflo(z0.y), bfhi(z0.y), bflo(z0.z), bfhi(z0.z), bflo(z0.w), bfhi(z0.w),
                    bflo(z1.x), bfhi(z1.x), bflo(z1.y), bfhi(z1.y), bflo(z1.z), bfhi(z1.z), bflo(z1.w), bfhi(z1.w)};
    unsigned ow[8];
#pragma unroll
    for (int j = 0; j < 8; ++j) { const float a = v[j >> 1][(2 * j) & 3] * rstd * gn[2 * j] * silu_f(zz[2 * j]), bq = v[j >> 1][(2 * j + 1) & 3] * rstd * gn[2 * j + 1] * silu_f(zz[2 * j + 1]); ow[j] = pk2(a, bq); }
    v4u* dst = (v4u*)(WSP(bf16, WS_OG) + (size_t)row * DM + 16 * lane);
    dst[0] = (v4u){ow[0], ow[1], ow[2], ow[3]}; dst[1] = (v4u){ow[4], ow[5], ow[6], ow[7]};
}

typedef __bf16 bf16x2_t __attribute__((ext_vector_type(2)));
__device__ __forceinline__ float dot2_bf16(unsigned w, unsigned x, float acc) { return __builtin_amdgcn_fdot2_f32_bf16(__builtin_bit_cast(bf16x2_t, w), __builtin_bit_cast(bf16x2_t, x), acc, false); }
__device__ __forceinline__ float u2f(unsigned u) { return __builtin_bit_cast(float, u); }
__device__ __forceinline__ unsigned f2u(float f) { return __builtin_bit_cast(unsigned, f); }

constexpr int P8_TOP = 0;
constexpr int P8_TAB = 16384;
__device__ __forceinline__ void p8_init_tab(Frame& F) {
    LAS unsigned char* tab = F.lds + P8_TAB;
    if (F.tid < 50) { const int k = F.tid; int i, j;
        if (k < 16) { i = 0; j = k; } else if (k < 24) { i = 1; j = k - 16; } else if (k < 29) { i = 2; j = k - 24; } else if (k < 33) { i = 3; j = k - 29; }
        else if (k < 36) { i = 4; j = k - 33; } else if (k < 38) { i = 5; j = k - 36; } else if (k < 40) { i = 6; j = k - 38; } else if (k < 42) { i = 7; j = k - 40; } else { i = k - 34; j = 0; }
        tab[k] = (unsigned char)i; tab[64 + k] = (unsigned char)j; }
    __syncthreads();
}
__device__ __forceinline__ void p8_unit(Frame& F, int unit, int layer) {
    const int lane = F.lane, w = F.wave, fr = lane & 15, fq = lane >> 4;
    LAS unsigned char* L = F.lds; asm volatile("" : "+v"(L));
    LAS unsigned* topl = (LAS unsigned*)(L + P8_TOP + w * 2048);
    const LAS unsigned char* tab = L + P8_TAB;
    const int r0 = unit * 16;
    const bf16* Q = WSP(bf16, WS_QPEER) + (size_t)(r0 + fr) * 2048 + w * 256 + 8 * fq;
    const bf16* SK = WSP(bf16, WS_SUBK) + (size_t)((layer * 8 + w) * 2) * 16384 + (size_t)fr * 128 + 8 * fq;
    const float NEGINF = -__builtin_inff();
#pragma unroll 1
    for (int p = 0; p < 2; ++p) {
        bf16x8 bq[4];
#pragma unroll
        for (int ks = 0; ks < 4; ++ks) bq[ks] = ld8(Q + p * 128 + 32 * ks);
        float v[32];
#pragma unroll
        for (int mt = 0; mt < 8; ++mt) { f32x4 acc = {0.f, 0.f, 0.f, 0.f};
#pragma unroll
            for (int ks = 0; ks < 4; ++ks) acc = MFMA16(ld8(SK + (size_t)p * 16384 + (size_t)mt * 2048 + 32 * ks), bq[ks], acc);
#pragma unroll
            for (int r = 0; r < 4; ++r) v[4 * mt + r] = u2f((f2u(acc[r]) & ~127u) | (unsigned)(16 * mt + 4 * fq + r)); }
#pragma unroll 1
        for (int rd = 0; rd < 16; ++rd) {
            float m = v[0];
#pragma unroll
            for (int i = 1; i < 32; ++i) m = fmaxf(m, v[i]);
            m = fmaxf(m, __shfl_xor(m, 16)); m = fmaxf(m, __shfl_xor(m, 32));
#pragma unroll
            for (int i = 0; i < 32; ++i) v[i] = (f2u(v[i]) == f2u(m)) ? NEGINF : v[i];
            if (fq == 0) topl[(fr * 2 + p) * 16 + rd] = f2u(m);
        }
    }
    LDS_WAIT();
    float c[13];
#pragma unroll
    for (int m = 0; m < 13; ++m) { const int k = fq + 4 * m; float cv = NEGINF;
        if (k < 50) { const int i = tab[k], j = tab[64 + k]; const float s1 = u2f(topl[(fr * 2 + 0) * 16 + i] & ~127u), s2 = u2f(topl[(fr * 2 + 1) * 16 + j] & ~127u);
            cv = u2f((f2u(s1 + s2) & ~63u) | (unsigned)k); }
        c[m] = cv; }
    float win[16];
#pragma unroll
    for (int rd = 0; rd < 16; ++rd) {
        float m = c[0];
#pragma unroll
        for (int i = 1; i < 13; ++i) m = fmaxf(m, c[i]);
        m = fmaxf(m, __shfl_xor(m, 16)); m = fmaxf(m, __shfl_xor(m, 32));
#pragma unroll
        for (int i = 0; i < 13; ++i) c[i] = (f2u(c[i]) == f2u(m)) ? NEGINF : c[i];
        win[rd] = m;
    }
    float den = 0.f, ex[16];
#pragma unroll
    for (int rd = 0; rd < 16; ++rd) { ex[rd] = __expf(win[rd] - win[0]); den += ex[rd]; }
    const float inv = 1.f / den;
    if (fq == 0) {
        int* pei = WSP(int, WS_PEI) + (size_t)(r0 + fr) * 128 + w * 16; float* peg = WSP(float, WS_PEG) + (size_t)(r0 + fr) * 128 + w * 16;
#pragma unroll
        for (int q4 = 0; q4 < 4; ++q4) { int e[4]; float g[4];
#pragma unroll
            for (int x = 0; x < 4; ++x) { const int rd = 4 * q4 + x; const int k = (int)(f2u(win[rd]) & 63u); const int i = tab[k], j = tab[64 + k];
                e[x] = (int)(topl[(fr * 2 + 0) * 16 + i] & 127u) * 128 + (int)(topl[(fr * 2 + 1) * 16 + j] & 127u); g[x] = ex[rd] * inv; }
            *(v4u*)(pei + 4 * q4) = (v4u){(unsigned)e[0], (unsigned)e[1], (unsigned)e[2], (unsigned)e[3]};
            *(f32x4*)(peg + 4 * q4) = (f32x4){g[0], g[1], g[2], g[3]}; }
    }
}

__device__ __forceinline__ void p9_token(Frame& F, int row, int layer, int mode) {
    const int lane = F.lane;
    const bf16* hrow = WSP(bf16, WS_XNB) + (size_t)row * DM + 8 * lane;
    const v4u hA = *(const v4u*)hrow, hB = *(const v4u*)(hrow + 512);
    const int* pei = WSP(int, WS_PEI) + (size_t)row * 128; const float* peg = WSP(float, WS_PEG) + (size_t)row * 128;
    const int e0 = pei[lane], e1 = pei[64 + lane]; const float g0 = peg[lane], g1 = peg[64 + lane];
    const bf16* PU = WSP(bf16, WS_PU) + (size_t)layer * NEXP * DM + 8 * lane; const bf16* PV = WSP(bf16, WS_PV) + (size_t)layer * NEXP * DM + 8 * lane;
    float out[16];
#pragma unroll
    for (int i = 0; i < 16; ++i) out[i] = 0.f;
    v4u U[2][4][2], V[2][4][2];
#define P9_LOAD(buf, bb) do { const int ev_ = (bb) < 16 ? e0 : e1; _Pragma("unroll") for (int j_ = 0; j_ < 4; ++j_) { \
        const size_t off_ = (size_t)__builtin_amdgcn_readlane(ev_, ((bb) & 15) * 4 + j_) * DM; \
        U[buf][j_][0] = *(const v4u*)(PU + off_); U[buf][j_][1] = *(const v4u*)(PU + off_ + 512); \
        V[buf][j_][0] = *(const v4u*)(PV + off_); V[buf][j_][1] = *(const v4u*)(PV + off_ + 512); } } while (0)
#define P9_COMP(buf, bb) do { float d_[4]; _Pragma("unroll") for (int j_ = 0; j_ < 4; ++j_) { float a_ = 0.f, b_ = 0.f; \
            a_ = dot2_bf16(U[buf][j_][0].x, hA.x, a_); b_ = dot2_bf16(U[buf][j_][0].y, hA.y, b_); a_ = dot2_bf16(U[buf][j_][0].z, hA.z, a_); b_ = dot2_bf16(U[buf][j_][0].w, hA.w, b_); \
            a_ = dot2_bf16(U[buf][j_][1].x, hB.x, a_); b_ = dot2_bf16(U[buf][j_][1].y, hB.y, b_); a_ = dot2_bf16(U[buf][j_][1].z, hB.z, a_); b_ = dot2_bf16(U[buf][j_][1].w, hB.w, b_); d_[j_] = a_ + b_; } \
        float x01_ = (lane & 1) ? d_[1] : d_[0], y01_ = (lane & 1) ? d_[0] : d_[1]; x01_ += __shfl_xor(y01_, 1); \
        float x23_ = (lane & 1) ? d_[3] : d_[2], y23_ = (lane & 1) ? d_[2] : d_[3]; x23_ += __shfl_xor(y23_, 1); \
        float x_ = (lane & 2) ? x23_ : x01_, y_ = (lane & 2) ? x01_ : x23_; x_ += __shfl_xor(y_, 2); \
        x_ += __shfl_xor(x_, 4); x_ += __shfl_xor(x_, 8); x_ += __shfl_xor(x_, 16); x_ += __shfl_xor(x_, 32); \
        const float gt_ = __shfl((bb) < 16 ? g0 : g1, ((bb) & 15) * 4 + (lane & 3)); \
        const float cl_ = gelu_tanh(x_) * gt_; \
        _Pragma("unroll") for (int j_ = 0; j_ < 4; ++j_) { const float cj_ = __builtin_bit_cast(float, __builtin_amdgcn_readlane(__builtin_bit_cast(int, cl_), j_)); \
            out[0] += cj_ * bflo(V[buf][j_][0].x); out[1] += cj_ * bfhi(V[buf][j_][0].x); out[2] += cj_ * bflo(V[buf][j_][0].y); out[3] += cj_ * bfhi(V[buf][j_][0].y); \
            out[4] += cj_ * bflo(V[buf][j_][0].z); out[5] += cj_ * bfhi(V[buf][j_][0].z); out[6] += cj_ * bflo(V[buf][j_][0].w); out[7] += cj_ * bfhi(V[buf][j_][0].w); \
            out[8] += cj_ * bflo(V[buf][j_][1].x); out[9] += cj_ * bfhi(V[buf][j_][1].x); out[10] += cj_ * bflo(V[buf][j_][1].y); out[11] += cj_ * bfhi(V[buf][j_][1].y); \
            out[12] += cj_ * bflo(V[buf][j_][1].z); out[13] += cj_ * bfhi(V[buf][j_][1].z); out[14] += cj_ * bflo(V[buf][j_][1].w); out[15] += cj_ * bfhi(V[buf][j_][1].w); } } while (0)
    P9_LOAD(0, 0);
#pragma unroll 1
    for (int bb = 0; bb < 32; bb += 2) {
        P9_LOAD(1, bb + 1);
        P9_COMP(0, bb);
        if (bb + 2 < 32) P9_LOAD(0, bb + 2);
        P9_COMP(1, bb + 1);
    }
#undef P9_LOAD
#undef P9_COMP
    float* xs = WSP(float, WS_XS) + (size_t)row * DM + 8 * lane;
    f32x4 x[4]; x[0] = *(const f32x4*)xs; x[1] = *(const f32x4*)(xs + 4); x[2] = *(const f32x4*)(xs + 512); x[3] = *(const f32x4*)(xs + 516);
#pragma unroll
    for (int i = 0; i < 4; ++i) { x[i].x += out[4 * i]; x[i].y += out[4 * i + 1]; x[i].z += out[4 * i + 2]; x[i].w += out[4 * i + 3]; }
    if (mode == 0) {
        *(f32x4*)xs = x[0]; *(f32x4*)(xs + 4) = x[1]; *(f32x4*)(xs + 512) = x[2]; *(f32x4*)(xs + 516) = x[3];
        float ss = 0.f;
#pragma unroll
        for (int i = 0; i < 4; ++i) ss += (x[i].x * x[i].x + x[i].y * x[i].y) + (x[i].z * x[i].z + x[i].w * x[i].w);
        const float rstd = 1.f / sqrtf(wave_sum(ss) * (1.f / DM) + EPS);
        bf16* xn = WSP(bf16, WS_XNA) + (size_t)row * DM + 8 * lane;
        *(v4u*)xn = (v4u){pk2(x[0].x * rstd, x[0].y * rstd), pk2(x[0].z * rstd, x[0].w * rstd), pk2(x[1].x * rstd, x[1].y * rstd), pk2(x[1].z * rstd, x[1].w * rstd)};
        *(v4u*)(xn + 512) = (v4u){pk2(x[2].x * rstd, x[2].y * rstd), pk2(x[2].z * rstd, x[2].w * rstd), pk2(x[3].x * rstd, x[3].y * rstd), pk2(x[3].z * rstd, x[3].w * rstd)};
    } else {
        float* y = (row < MP ? F.out + O_YP + (size_t)row * DM : F.out + O_YS + (size_t)(row - MP) * DM) + 8 * lane;
        *(f32x4*)y = x[0]; *(f32x4*)(y + 4) = x[1]; *(f32x4*)(y + 512) = x[2]; *(f32x4*)(y + 516) = x[3];
    }
}

constexpr float QSCALE = 0.125f * 1.4426950408889634f;
constexpr int PP_VT = 0;
__device__ __forceinline__ float rms64(float v) { return 1.f / sqrtf(wave_sum(v * v) * (1.f / 64.f) + EPS); }

__device__ __forceinline__ void pp_q_row(Frame& F, int row, const float* kvq, const float qg) {
    const int lane = F.lane;
    bf16* qn = WSP(bf16, WS_QN) + (size_t)row * 1024;
#pragma unroll 4
    for (int hd = 0; hd < 16; ++hd) { const float v = kvq[NKV + hd * 64 + lane]; qn[hd * 64 + lane] = (bf16)f2bf(v * rms64(v) * qg); }
    if (lane < 48) WSP(float, WS_GATES)[(size_t)row * 48 + lane] = sigmoid_f(kvq[NKV + 1024 + lane]);
}
__device__ __forceinline__ void pp_prompt_tile(Frame& F, int unit) {
    const int lane = F.lane, w = F.wave, b = unit >> 7, t0 = (unit & 127) * 64;
    LAS unsigned char* L = F.lds; asm volatile("" : "+v"(L));
    LAS bf16* vt = (LAS bf16*)(L + PP_VT);
    const float kg1 = FIN(16)[64 + lane], kg2 = FIN(16)[128 + lane], qg = FIN(22)[lane] * QSCALE;
    for (int rr = 0; rr < 8; ++rr) {
        const int tl = 8 * w + rr, t = t0 + tl, row = b * PT + t;
        const float* kvq = WSP(float, WS_KVQ) + (size_t)row * NKVQ;
        float* okv = F.out + O_KVP + (size_t)row * 1024;
        const bool inwin = t >= PT - WINDOW;
        float* owin = F.out + O_WINP + ((size_t)b * 512 + (t - (PT - WINDOW))) * 512;
#pragma unroll
        for (int g = 0; g < 4; ++g) {
            const float v0 = kvq[0 * 256 + g * 64 + lane], v1 = kvq[1 * 256 + g * 64 + lane], v2 = kvq[2 * 256 + g * 64 + lane];
            const float v3 = kvq[3 * 256 + g * 64 + lane], v4 = kvq[4 * 256 + g * 64 + lane], v5 = kvq[5 * 256 + g * 64 + lane];
            const float ks = v2 * rms64(v2) * kg1, kw = v4 * rms64(v4) * kg2;
            okv[0 * 256 + g * 64 + lane] = v0; okv[1 * 256 + g * 64 + lane] = v1; okv[2 * 256 + g * 64 + lane] = ks; okv[3 * 256 + g * 64 + lane] = v3;
            if (inwin) { owin[g * 64 + lane] = kw; owin[256 + g * 64 + lane] = v5; }
            const size_t kidx = (((size_t)b * NG + g) * PT + t) * 64 + lane;
            WSP(bf16, WS_KSEL)[kidx] = (bf16)f2bf(ks); WSP(bf16, WS_KWIN)[kidx] = (bf16)f2bf(kw);
            vt[((0 * 4 + g) * 64 + lane) * 72 + tl] = (bf16)f2bf(v3); vt[((1 * 4 + g) * 64 + lane) * 72 + tl] = (bf16)f2bf(v5);
        }
        pp_q_row(F, row, kvq, qg);
    }
    __syncthreads();
    {
        const int which = F.tid >> 8, gd = F.tid & 255;
        bf16* dst = WSP(bf16, which == 0 ? WS_VSELT : WS_VWINT) + (((size_t)b * NG * 64 + gd) * PT + t0);
        const LAS bf16* src = vt + ((which * 256 + gd) * 72);
#pragma unroll
        for (int i = 0; i < 8; ++i) *(v4u*)(dst + 8 * i) = *(const LAS v4u*)(src + 8 * i);
    }
    __syncthreads();
}
__device__ __forceinline__ void pp_sample_row(Frame& F, int sr) {
    const int lane = F.lane, bs = sr >> 2, i = sr & 3, row = MP + sr;
    const float kg1 = FIN(16)[64 + lane], kg2 = FIN(16)[128 + lane], qg = FIN(22)[lane] * QSCALE;
    const float* kvq = WSP(float, WS_KVQ) + (size_t)row * NKVQ;
    float* okv = F.out + O_KVS + (size_t)sr * 1024;
    float* owin = F.out + O_WINS + ((size_t)bs * 512 + 508 + i) * 512;
#pragma unroll
    for (int g = 0; g < 4; ++g) {
        const float v0 = kvq[0 * 256 + g * 64 + lane], v1 = kvq[1 * 256 + g * 64 + lane], v2 = kvq[2 * 256 + g * 64 + lane];
        const float v3 = kvq[3 * 256 + g * 64 + lane], v4 = kvq[4 * 256 + g * 64 + lane], v5 = kvq[5 * 256 + g * 64 + lane];
        const float ks = v2 * rms64(v2) * kg1, kw = v4 * rms64(v4) * kg2;
        okv[0 * 256 + g * 64 + lane] = v0; okv[1 * 256 + g * 64 + lane] = v1; okv[2 * 256 + g * 64 + lane] = ks; okv[3 * 256 + g * 64 + lane] = v3;
        owin[g * 64 + lane] = kw; owin[256 + g * 64 + lane] = v5;
        const size_t bg = (size_t)bs * NG + g;
        WSP(bf16, WS_SKWIN)[(bg * 544 + 512 + i) * 64 + lane] = (bf16)f2bf(kw);
        WSP(bf16, WS_SVWINT)[(bg * 64 + lane) * 544 + 512 + i] = (bf16)f2bf(v5);
        float* sn = WSP(float, WS_SNEW) + (((size_t)bs * 4 + i) * 2) * 256 + g * 64 + lane;
        sn[0] = ks; sn[256] = v3;
    }
    pp_q_row(F, row, kvq, qg);
}

template <class RowP>
__device__ __forceinline__ void compress_tile(Frame& F, const RowP& rowp, int kv, int j, bf16* KC, bf16* VCT) {
    const int lane = F.lane, fr = lane & 15, fq = lane >> 4;
    const bf16* W1 = WSP(bf16, WS_W1T) + (size_t)kv * 64 * 2048 + (size_t)fr * 2048 + 8 * fq;
    const int blk = 16 * j + fr;
    f32x4 acc[4];
#pragma unroll
    for (int mt = 0; mt < 4; ++mt) acc[mt] = (f32x4){0.f, 0.f, 0.f, 0.f};
#pragma unroll 2
    for (int r = 0; r < 32; ++r) {
        int t = 16 * blk + r; t = t < PAST ? t : PAST - 1;
        const float* rp = rowp(t) + 8 * fq;
#pragma unroll
        for (int hf = 0; hf < 2; ++hf) {
            const f32x4 x0 = *(const f32x4*)(rp + 32 * hf), x1 = *(const f32x4*)(rp + 32 * hf + 4);
            const bf16x8 bfrag = cvt8(x0, x1);
            const int ks = 2 * r + hf;
#pragma unroll
            for (int mt = 0; mt < 4; ++mt) acc[mt] = MFMA16(ld8(W1 + (size_t)mt * 16 * 2048 + 32 * ks), bfrag, acc[mt]);
        }
    }
    const float* pet = WSP(float, WS_PETERM) + kv * 64;
    bf16x8 hb[2];
#pragma unroll
    for (int s = 0; s < 2; ++s) { f32x4 h0, h1;
#pragma unroll
        for (int r = 0; r < 4; ++r) { h0[r] = gelu_tanh(acc[2 * s][r] + pet[16 * (2 * s) + 4 * fq + r]); h1[r] = gelu_tanh(acc[2 * s + 1][r] + pet[16 * (2 * s + 1) + 4 * fq + r]); }
        hb[s] = cvt8(h0, h1); }
    const float* w2 = FIN(19) + (size_t)kv * 64 * 64;
    f32x4 o[4];
#pragma unroll
    for (int dt = 0; dt < 4; ++dt) { o[dt] = (f32x4){0.f, 0.f, 0.f, 0.f};
#pragma unroll
        for (int s = 0; s < 2; ++s) { f32x4 a0, a1;
#pragma unroll
            for (int jj = 0; jj < 4; ++jj) { a0[jj] = w2[(size_t)(16 * (2 * s) + 4 * fq + jj) * 64 + 16 * dt + fr]; a1[jj] = w2[(size_t)(16 * (2 * s + 1) + 4 * fq + jj) * 64 + 16 * dt + fr]; }
            o[dt] = MFMA16(cvt8(a0, a1), hb[s], o[dt]); } }
    if (kv == 0) {
        float ss = 0.f;
#pragma unroll
        for (int dt = 0; dt < 4; ++dt) ss += (o[dt][0] * o[dt][0] + o[dt][1] * o[dt][1]) + (o[dt][2] * o[dt][2] + o[dt][3] * o[dt][3]);
        ss += __shfl_xor(ss, 16); ss += __shfl_xor(ss, 32);
        const float rstd = 1.f / sqrtf(ss * (1.f / 64.f) + EPS);
        const float* kg0 = FIN(16);
        if (blk < NCMP) {
#pragma unroll
            for (int dt = 0; dt < 4; ++dt) { const int d = 16 * dt + 4 * fq; v2u ov; ov.x = pk2(o[dt][0] * rstd * kg0[d], o[dt][1] * rstd * kg0[d + 1]); ov.y = pk2(o[dt][2] * rstd * kg0[d + 2], o[dt][3] * rstd * kg0[d + 3]);
                *(v2u*)(KC + (size_t)blk * 64 + d) = ov; }
        } else {
#pragma unroll
            for (int dt = 0; dt < 4; ++dt) *(v2u*)(KC + (size_t)blk * 64 + 16 * dt + 4 * fq) = (v2u){0u, 0u};
        }
    } else {
#pragma unroll
        for (int dt = 0; dt < 4; ++dt)
#pragma unroll
            for (int r = 0; r < 4; ++r) VCT[(size_t)(16 * dt + 4 * fq + r) * 512 + blk] = (blk < NCMP) ? (bf16)f2bf(o[dt][r]) : (bf16)0;
    }
}
struct RowPPrompt { const float* base; __device__ __forceinline__ const float* operator()(int t) const { return base + (size_t)t * NKVQ; } };
struct RowPSample { const float* cache; const int* pt; __device__ __forceinline__ const float* operator()(int t) const { return cache + ((size_t)pt[t >> 7] * PAGE + (t & 127)) * 1024; } };

__device__ __forceinline__ void compress_prompt(Frame& F, int id) {
    const int kv = id & 1, j = (id >> 1) & 31, bg = id >> 6, b = bg >> 2, g = bg & 3;
    RowPPrompt rp{WSP(float, WS_KVQ) + (size_t)b * PT * NKVQ + kv * 256 + g * 64};
    compress_tile(F, rp, kv, j, WSP(bf16, WS_KCMP) + (size_t)bg * 512 * 64, WSP(bf16, WS_VCMPT) + (size_t)bg * 64 * 512);
}
__device__ __forceinline__ void compress_sample(Frame& F, int id) {
    const int kv = id & 1, j = (id >> 1) & 31, bg = id >> 6, bs = bg >> 2, g = bg & 3;
    RowPSample rp{FIN(2) + kv * 256 + g * 64, (const int*)FIN(6) + bs * NPAGES};
    compress_tile(F, rp, kv, j, WSP(bf16, WS_SKCMP) + (size_t)bg * 512 * 64, WSP(bf16, WS_SVCMPT) + (size_t)bg * 64 * 512);
}

constexpr int NSA_IMP = 0;
constexpr int NSA_Q = 67584;
constexpr float LOG2E = 1.4426950408889634f;
__device__ __forceinline__ float ex2(float x) { return __builtin_amdgcn_exp2f(x); }

struct KvBf16 {
    const bf16* K; const bf16* VT; int ld;
    __device__ __forceinline__ void lane_offsets(int fr, int fq, unsigned& ko, unsigned& vo) const {
        ko = (unsigned)((fr * 64 + 8 * fq) * 2); vo = (unsigned)((fr * ld + 4 * fq) * 2);
        asm volatile("" : "+v"(ko), "+v"(vo));
    }
    __device__ __forceinline__ bf16x8 kf(int key0, int mt, int ks, unsigned ko) const {
        return *(const bf16x8*)((const char*)K + (size_t)key0 * 128 + (ko + (unsigned)((16 * mt * 64 + 32 * ks) * 2))); }
    __device__ __forceinline__ bf16x8 vf(int key0, int dt, unsigned vo) const {
        const char* p = (const char*)VT + (size_t)key0 * 2 + (vo + (unsigned)(16 * dt * ld * 2));
        const v2u a = *(const v2u*)p, b = *(const v2u*)(p + 32); return __builtin_bit_cast(bf16x8, (v4u){a.x, a.y, b.x, b.y}); }
};
struct KvSampleSel {
    const float* cache; const int* pt; const float* snew; int g;
    __device__ __forceinline__ const float* krow(int pos, int slot) const {
        if (pos < PAST) return cache + ((size_t)pt[pos >> 7] * PAGE + (pos & 127)) * 1024 + slot * 256;
        int i = pos - PAST; i = i < 3 ? i : 3; return snew + (size_t)i * 512 + (slot - 2) * 256; }
    __device__ __forceinline__ void lane_offsets(int fr, int fq, unsigned& ko, unsigned& vo) const { ko = (unsigned)(fr | (fq << 8)); vo = ko; asm volatile("" : "+v"(ko), "+v"(vo)); }
    __device__ __forceinline__ bf16x8 kf(int key0, int mt, int ks, unsigned ko) const { const int fr = ko & 255, fq = ko >> 8; const float* p = krow(key0 + 16 * mt + fr, 2) + 32 * ks + 8 * fq; return cvt8(*(const f32x4*)p, *(const f32x4*)(p + 4)); }
    __device__ __forceinline__ bf16x8 vf(int key0, int dt, unsigned vo) const { const int fr = vo & 255, fq = vo >> 8; f32x4 a, b;
#pragma unroll
        for (int j = 0; j < 4; ++j) { a[j] = krow(key0 + 4 * fq + j, 3)[16 * dt + fr]; b[j] = krow(key0 + 16 + 4 * fq + j, 3)[16 * dt + fr]; }
        return cvt8(a, b); }
};

template <int NT, int MODE, class KV>
__device__ __forceinline__ void nsa_tile(const KV& kv, int key0, const LAS bf16x8* qf, f32x4 (&O)[NT][4], float (&m)[NT], float (&l)[NT], const float (&invl)[NT], const float (&slope)[NT],
                                         int t, int pmul, int padd, int wlim, bool selok, LAS float* improw, int fr, int fq) {
    unsigned ko, vo; kv.lane_offsets(fr, fq, ko, vo);
    bf16x8 kfr[2][2];
#pragma unroll
    for (int mt = 0; mt < 2; ++mt)
#pragma unroll
        for (int ks = 0; ks < 2; ++ks) kfr[mt][ks] = kv.kf(key0, mt, ks, ko);
    bf16x8 vfr[4];
    if (MODE != 1) {
#pragma unroll
        for (int dt = 0; dt < 4; ++dt) vfr[dt] = kv.vf(key0, dt, vo);
    }
    float dist[2][4]; bool val[2][4];
#pragma unroll
    for (int mt = 0; mt < 2; ++mt)
#pragma unroll
        for (int r = 0; r < 4; ++r) { const int kk = key0 + 16 * mt + 4 * fq + r; const int dd = t - (pmul * kk + padd); dist[mt][r] = (float)dd; val[mt][r] = selok && dd >= 0 && dd < wlim; }
    float imp_main[2] = {0.f, 0.f}, imp_spill[2] = {0.f, 0.f};
#pragma unroll
    for (int nt = 0; nt < NT; ++nt) {
        f32x4 s[2];
        const bf16x8 q0 = qf[(nt * 2 + 0) * 64], q1 = qf[(nt * 2 + 1) * 64];
#pragma unroll
        for (int mt = 0; mt < 2; ++mt) { s[mt] = (f32x4){0.f, 0.f, 0.f, 0.f}; s[mt] = MFMA16(kfr[mt][0], q0, s[mt]); s[mt] = MFMA16(kfr[mt][1], q1, s[mt]); }
        float sv[2][4];
#pragma unroll
        for (int mt = 0; mt < 2; ++mt)
#pragma unroll
            for (int r = 0; r < 4; ++r) sv[mt][r] = val[mt][r] ? (s[mt][r] - slope[nt] * dist[mt][r]) : -1e30f;
        float mref;
        if (MODE != 2) {
            float mx = fmaxf(fmaxf(fmaxf(sv[0][0], sv[0][1]), fmaxf(sv[0][2], sv[0][3])), fmaxf(fmaxf(sv[1][0], sv[1][1]), fmaxf(sv[1][2], sv[1][3])));
            mx = fmaxf(mx, __shfl_xor(mx, 16)); mx = fmaxf(mx, __shfl_xor(mx, 32));
            const float mnew = fmaxf(m[nt], mx), alpha = ex2(m[nt] - mnew);
            m[nt] = mnew; l[nt] *= alpha; mref = mnew;
            if (MODE == 0) {
#pragma unroll
                for (int dt = 0; dt < 4; ++dt) O[nt][dt] = O[nt][dt] * alpha;
            }
        } else mref = m[nt];
        f32x4 p[2]; float ps = 0.f;
#pragma unroll
        for (int mt = 0; mt < 2; ++mt)
#pragma unroll
            for (int r = 0; r < 4; ++r) { float pv = val[mt][r] ? ex2(sv[mt][r] - mref) : 0.f; if (MODE == 2) pv *= invl[nt]; p[mt][r] = pv; ps += pv; }
        if (MODE != 2) l[nt] += ps;
        if (MODE == 2) {
#pragma unroll
            for (int mt = 0; mt < 2; ++mt) { imp_main[mt] += (p[mt][0] + p[mt][1]) + (p[mt][2] + p[mt][3]); imp_spill[mt] += p[mt][3]; }
        }
        if (MODE != 1) {
            const bf16x8 pf = cvt8(p[0], p[1]);
#pragma unroll
            for (int dt = 0; dt < 4; ++dt) O[nt][dt] = MFMA16(vfr[dt], pf, O[nt][dt]);
        }
    }
    if (MODE == 2) {
#pragma unroll
        for (int mt = 0; mt < 2; ++mt) { const int j = (key0 + 16 * mt) / 4 + fq;
            __hip_atomic_fetch_add(improw + j, imp_main[mt], __ATOMIC_RELAXED, __HIP_MEMORY_SCOPE_WORKGROUP);
            __hip_atomic_fetch_add(improw + j + 1, imp_spill[mt], __ATOMIC_RELAXED, __HIP_MEMORY_SCOPE_WORKGROUP); }
    }
}

template <int NT>
__device__ __forceinline__ void nsa_zero(f32x4 (&O)[NT][4], float (&m)[NT], float (&l)[NT]) {
#pragma unroll
    for (int nt = 0; nt < NT; ++nt) { m[nt] = -1e30f; l[nt] = 0.f;
#pragma unroll
        for (int dt = 0; dt < 4; ++dt) O[nt][dt] = (f32x4){0.f, 0.f, 0.f, 0.f}; }
}

template <bool SAMPLE>
__device__ __forceinline__ void nsa_unit(Frame& F, int id) {
    constexpr int NT = SAMPLE ? 1 : 4;
    const int lane = F.lane, fr = lane & 15, fq = lane >> 4;
    LAS unsigned char* L = F.lds; asm volatile("" : "+v"(L));
    LAS float* imp = (LAS float*)(L + NSA_IMP + F.wave * 8448);
    int bg, g, t, row, trow, tmax;
    if (SAMPLE) { bg = id; g = id & 3; t = PAST + (fr >> 2); row = MP + (id >> 2) * 4 + (fr >> 2); trow = fr >> 2; tmax = PAST + 3; }
    else { bg = id >> 9; g = bg & 3; const int tt = id & 511; t = 16 * tt + fr; row = (bg >> 2) * PT + t; trow = fr; tmax = 16 * tt + 15; }
    float slope[NT]; int hd[NT];
    LAS bf16x8* qf = (LAS bf16x8*)(L + NSA_Q + F.wave * 8192) + lane;
#pragma unroll
    for (int nt = 0; nt < NT; ++nt) { hd[nt] = g * 4 + (SAMPLE ? (fr & 3) : nt); slope[nt] = ex2(-0.5f * (float)(hd[nt] + 1)) * LOG2E;
        const bf16* qp = WSP(bf16, WS_QN) + (size_t)row * 1024 + hd[nt] * 64 + 8 * fq; qf[(nt * 2 + 0) * 64] = ld8(qp); qf[(nt * 2 + 1) * 64] = ld8(qp + 32); }
    const float* gates = WSP(float, WS_GATES) + (size_t)row * 48;
    float* oacc = WSP(float, WS_OACC) + (size_t)row * 1024;
    for (int i = lane; i < 16 * 132; i += 64) imp[i] = 0.f;
    LDS_WAIT();
    f32x4 O[NT][4]; float m[NT], l[NT], invl[NT];
    {
        KvBf16 kv{WSP(bf16, SAMPLE ? WS_SKCMP : WS_KCMP) + (size_t)bg * 512 * 64, WSP(bf16, SAMPLE ? WS_SVCMPT : WS_VCMPT) + (size_t)bg * 64 * 512, 512};
        const int cmax = (tmax - 31) >> 4;
        const int ntile = (tmax >= 31) ? ((cmax < 510 ? cmax : 510) / 32 + 1) : 0;
        nsa_zero<NT>(O, m, l);
#pragma unroll
        for (int nt = 0; nt < NT; ++nt) invl[nt] = 0.f;
#pragma unroll 1
        for (int tl = 0; tl < ntile; ++tl) nsa_tile<NT, 1>(kv, 32 * tl, qf, O, m, l, invl, slope, t, 16, 31, 1 << 30, true, imp + trow * 132, fr, fq);
#pragma unroll
        for (int nt = 0; nt < NT; ++nt) { float lt = l[nt]; lt += __shfl_xor(lt, 16); lt += __shfl_xor(lt, 32); invl[nt] = lt > 0.f ? 1.f / lt : 0.f; }
#pragma unroll 1
        for (int tl = 0; tl < ntile; ++tl) nsa_tile<NT, 2>(kv, 32 * tl, qf, O, m, l, invl, slope, t, 16, 31, 1 << 30, true, imp + trow * 132, fr, fq);
#pragma unroll
        for (int nt = 0; nt < NT; ++nt) { const float gc = gates[0 * 16 + hd[nt]];
#pragma unroll
            for (int dt = 0; dt < 4; ++dt) *(f32x4*)(oacc + hd[nt] * 64 + 16 * dt + 4 * fq) = O[nt][dt] * gc; }
    }
    LDS_WAIT();
    unsigned selm[4] = {0u, 0u, 0u, 0u};
    {
        const int cur = t >> 6;
        if (!SAMPLE) {
            unsigned v[32];
#pragma unroll
            for (int i = 0; i < 32; ++i) { const int j = 32 * fq + i; const bool forced = (j == 0) | (j == cur) | (j == cur - 1);
                const unsigned key = ((f2u(imp[trow * 132 + j]) & ~127u) | (unsigned)(127 - j)) + 128u;
                v[i] = (!forced && j <= cur) ? key : 0u;
                if (forced) selm[fq] |= 1u << i; }
            unsigned fw = selm[0] | selm[1] | selm[2] | selm[3];
            const unsigned w16 = __shfl_xor(fw, 16), w32 = __shfl_xor(fw, 32), w48 = __shfl_xor(fw, 48);
#pragma unroll
            for (int wd = 0; wd < 4; ++wd) selm[wd] = (fq == wd) ? fw : ((fq ^ 1) == wd) ? w16 : ((fq ^ 2) == wd) ? w32 : w48;
            const int nforced = cur >= 2 ? 3 : cur + 1;
#pragma unroll 1
            for (int rd = 0; rd < 15; ++rd) {
                unsigned mx = v[0];
#pragma unroll
                for (int i = 1; i < 32; ++i) mx = mx > v[i] ? mx : v[i];
                { const unsigned o = __shfl_xor(mx, 16); mx = mx > o ? mx : o; } { const unsigned o = __shfl_xor(mx, 32); mx = mx > o ? mx : o; }
#pragma unroll
                for (int i = 0; i < 32; ++i) v[i] = (v[i] == mx) ? 0u : v[i];
                if (mx != 0u && rd < 16 - nforced) { const int js = 127 - (int)(mx & 127u);
#pragma unroll
                    for (int wd = 0; wd < 4; ++wd) selm[wd] |= ((js >> 5) == wd) ? (1u << (js & 31)) : 0u; }
            }
        } else {
            const int li = (fr & 3) * 4 + fq;
            unsigned v[8];
#pragma unroll
            for (int i = 0; i < 8; ++i) { const int j = li * 8 + i; v[i] = (j >= 1 && j <= 126) ? (((f2u(imp[trow * 132 + j]) & ~127u) | (unsigned)(127 - j)) + 128u) : 0u; }
            selm[0] = 1u; selm[3] = 1u << 31;
#pragma unroll 1
            for (int rd = 0; rd < 13; ++rd) {
                unsigned mx = v[0];
#pragma unroll
                for (int i = 1; i < 8; ++i) mx = mx > v[i] ? mx : v[i];
                { unsigned o = __shfl_xor(mx, 1); mx = mx > o ? mx : o; o = __shfl_xor(mx, 2); mx = mx > o ? mx : o; o = __shfl_xor(mx, 16); mx = mx > o ? mx : o; o = __shfl_xor(mx, 32); mx = mx > o ? mx : o; }
#pragma unroll
                for (int i = 0; i < 8; ++i) v[i] = (v[i] == mx) ? 0u : v[i];
                if (mx != 0u) { const int js = 127 - (int)(mx & 127u);
#pragma unroll
                    for (int wd = 0; wd < 4; ++wd) selm[wd] |= ((js >> 5) == wd) ? (1u << (js & 31)) : 0u; }
            }
        }
    }
    {
        nsa_zero<NT>(O, m, l);
        unsigned un[4];
#pragma unroll
        for (int wd = 0; wd < 4; ++wd) { unsigned x = selm[wd]; x |= __shfl_xor(x, 1); x |= __shfl_xor(x, 2); x |= __shfl_xor(x, 4); x |= __shfl_xor(x, 8); un[wd] = (unsigned)__builtin_amdgcn_readfirstlane((int)x); }
        KvBf16 kvp{WSP(bf16, WS_KSEL) + (size_t)bg * PT * 64, WSP(bf16, WS_VSELT) + (size_t)bg * 64 * PT, PT};
        KvSampleSel kvs{FIN(2) + g * 64, (const int*)FIN(6) + (SAMPLE ? (id >> 2) : 0) * NPAGES, WSP(float, WS_SNEW) + (size_t)(SAMPLE ? (id >> 2) : 0) * 2048 + g * 64, g};
#pragma unroll 1
        for (int wd = 0; wd < 4; ++wd) {
            unsigned mm = un[wd];
            const unsigned mine = wd == 0 ? selm[0] : wd == 1 ? selm[1] : wd == 2 ? selm[2] : selm[3];
            while (mm) {
                const int bit = __builtin_ctz(mm); mm &= mm - 1u; const int j = 32 * wd + bit;
                const bool ok = (mine >> bit) & 1u;
#pragma unroll 1
                for (int hh = 0; hh < 2; ++hh) {
                    if (SAMPLE) nsa_tile<NT, 0>(kvs, 64 * j + 32 * hh, qf, O, m, l, invl, slope, t, 1, 0, 1 << 30, ok, imp, fr, fq);
                    else nsa_tile<NT, 0>(kvp, 64 * j + 32 * hh, qf, O, m, l, invl, slope, t, 1, 0, 1 << 30, ok, imp, fr, fq);
                    __builtin_amdgcn_sched_barrier(0);
                }
            }
        }
        if (SAMPLE) nsa_tile<NT, 0>(kvs, 64 * 128, qf, O, m, l, invl, slope, t, 1, 0, 1 << 30, true, imp, fr, fq);
#pragma unroll
        for (int nt = 0; nt < NT; ++nt) { float lt = l[nt]; lt += __shfl_xor(lt, 16); lt += __shfl_xor(lt, 32); const float sc = gates[1 * 16 + hd[nt]] / fmaxf(lt, 1e-30f);
#pragma unroll
            for (int dt = 0; dt < 4; ++dt) { f32x4* o = (f32x4*)(oacc + hd[nt] * 64 + 16 * dt + 4 * fq); *o = *o + O[nt][dt] * sc; } }
    }
    {
        nsa_zero<NT>(O, m, l);
        KvBf16 kv = SAMPLE ? KvBf16{WSP(bf16, WS_SKWIN) + (size_t)bg * 544 * 64, WSP(bf16, WS_SVWINT) + (size_t)bg * 64 * 544, 544}
                           : KvBf16{WSP(bf16, WS_KWIN) + (size_t)bg * PT * 64, WSP(bf16, WS_VWINT) + (size_t)bg * 64 * PT, PT};
        int k0, k1, padd;
        if (SAMPLE) { k0 = 0; k1 = 544; padd = PAST - WINDOW; }
        else { const int lo = tmax - 15 - (WINDOW - 1); k0 = (lo > 0 ? lo : 0) & ~31; k1 = tmax + 1; padd = 0; }
#pragma unroll 1
        for (int kk = k0; kk < k1; kk += 32) nsa_tile<NT, 0>(kv, kk, qf, O, m, l, invl, slope, t, 1, padd, WINDOW, true, imp, fr, fq);
        bf16* on = WSP(bf16, WS_OG) + (size_t)row * 1024;
#pragma unroll
        for (int nt = 0; nt < NT; ++nt) { float lt = l[nt]; lt += __shfl_xor(lt, 16); lt += __shfl_xor(lt, 32); const float sc = gates[2 * 16 + hd[nt]] / fmaxf(lt, 1e-30f);
#pragma unroll
            for (int dt = 0; dt < 4; ++dt) { const f32x4 o = *(const f32x4*)(oacc + hd[nt] * 64 + 16 * dt + 4 * fq) + O[nt][dt] * sc;
                *(v2u*)(on + hd[nt] * 64 + 16 * dt + 4 * fq) = (v2u){pk2(o[0], o[1]), pk2(o[2], o[3])}; } }
    }
}
#define NPHASE_USED 18
#define PHASES_REST \
    if (IN(5)) { gemm_all(F, WSP(bf16, WS_OG), WSP(bf16, WS_WOA_T), 1024, FnResid{WSP(float, WS_XS), FIN(0), FIN(1)}); } SEAM(5); \
    if (IN(6)) { for (int r = gw; r < MTOK; r += NGW) rms_row_to_bf16(WSP(float, WS_XS) + (size_t)r * DM, WSP(bf16, WS_XNB) + (size_t)r * DM, F.lane); } SEAM(6); \
    if (IN(7)) { gemm_all(F, WSP(bf16, WS_XNB), WSP(bf16, WS_WPQ_T), 2048, FnBf16{WSP(bf16, WS_QPEER), 2048}); } SEAM(7); \
    if (IN(8)) { p8_init_tab(F); for (int u = F.bid; u < MTOK / 16; u += F.G) p8_unit(F, u, 0); } SEAM(8); \
    if (IN(9)) { for (int r = gw; r < MTOK; r += NGW) p9_token(F, r, 0, 0); } SEAM(9); \
    if (IN(10)) { gemm_all(F, WSP(bf16, WS_XNA), WSP(bf16, WS_WKVQ_T), NKVQ, FnKvq{WSP(float, WS_KVQ)}); } SEAM(10); \
    if (IN(11)) { \
        for (int u = F.bid; u < 256; u += F.G) pp_prompt_tile(F, u); \
        for (int r = gw; r < MS; r += NGW) pp_sample_row(F, r); \
        for (int id = gw; id < 512; id += NGW) compress_prompt(F, id); \
        for (int id = gw; id < 8192; id += NGW) compress_sample(F, id); \
    } SEAM(11); \
    if (IN(12)) { for (int id = gw; id < 128 + 4096; id += NGW) { if (id < 128) nsa_unit<true>(F, id); else nsa_unit<false>(F, id - 128); } } SEAM(12); \
    if (IN(13)) { gemm_all(F, WSP(bf16, WS_OG), WSP(bf16, WS_WOB_T), 1024, FnResid{WSP(float, WS_XS), WSP(float, WS_XS), WSP(float, WS_XS) + (size_t)MP * DM}); } SEAM(13); \
    if (IN(14)) { for (int r = gw; r < MTOK; r += NGW) rms_row_to_bf16(WSP(float, WS_XS) + (size_t)r * DM, WSP(bf16, WS_XNB) + (size_t)r * DM, F.lane); } SEAM(14); \
    if (IN(15)) { gemm_all(F, WSP(bf16, WS_XNB), WSP(bf16, WS_WPQ_T) + (size_t)2048 * 1024, 2048, FnBf16{WSP(bf16, WS_QPEER), 2048}); } SEAM(15); \
    if (IN(16)) { p8_init_tab(F); for (int u = F.bid; u < MTOK / 16; u += F.G) p8_unit(F, u, 1); } SEAM(16); \
    if (IN(17)) { for (int r = gw; r < MTOK; r += NGW) p9_token(F, r, 1, 1); }

#ifndef MK_SINGLE
#define MK_SINGLE 0
#endif
constexpr int NPHASE = 18;
struct Args { const float* in[29]; float* out; unsigned char* ws; int ph_lo, ph_hi; };
static_assert(sizeof(Args) == 31 * 8 + 8, "Args has no padding");

__global__ void __launch_bounds__(512, 2) mk_fwd(Args args) {
    extern __shared__ __attribute__((aligned(16))) unsigned char lds_raw[];
    Frame F;
    F.lds = (LAS unsigned char*)lds_raw;
    F.tid = threadIdx.x; F.lane = F.tid & 63; F.wave = __builtin_amdgcn_readfirstlane(F.tid >> 6);
    F.G = gridDim.x; F.bid = blockIdx.x;
    F.ka = (const __attribute__((address_space(4))) char*)__builtin_amdgcn_kernarg_segment_ptr();
    F.out = args.out; F.ws = args.ws;
    volatile LAS unsigned* MISC = (volatile LAS unsigned*)(F.lds + MISC_OFF);
    for (int u = F.tid; u < (LDS_BYTES - LDSCTL_OFF) / 4; u += 512) ((LAS unsigned*)(F.lds + LDSCTL_OFF))[u] = 0u;
    __syncthreads();
    unsigned* barw = (unsigned*)(F.ws + WS_CTL) + 4096;
    XcdBarrier bar; bar.bar = barw; bar.x = 0; bar.st = nullptr;
    const int lo = args.ph_lo, hi = args.ph_hi;
    if (hi - lo > 1) bar = xcd_barrier_post(barw, MISC + 8);
#ifndef PH_MASK
#define PH_MASK 0xFFFFFFFFu
#endif
#define IN(k) (((PH_MASK >> (k)) & 1u) && lo <= (k) && (k) < hi)
#define SEAM(k) do { if (IN(k) && IN((k) + 1)) xcd_barrier(bar); } while (0)
    const int gw = F.bid * 8 + F.wave, NGW = F.G * 8;

    if (IN(0)) { p0_prologue(F); } SEAM(0);
    if (IN(1)) { gemm_all(F, WSP(bf16, WS_XNA), WSP(bf16, WS_WIN_T), 4096, FnBf16{WSP(bf16, WS_PROJ), 4096}); } SEAM(1);
    if (IN(2)) {
        for (int u = F.bid; u < 2048 + 256; u += F.G) { if (u < 2048) p2_chunk(F, u); else p2_sample(F, u - 2048); }
    } SEAM(2);
    if (IN(3)) {
        if (F.G == 256) { const int x = F.bid & 7, idx = F.bid >> 3; if (idx < 16) p3_scan(F, x * 2 + (idx >> 3), idx & 7); }
        else { for (int u = F.bid; u < 128; u += F.G) p3_scan(F, u >> 3, u & 7); }
    } SEAM(3);
    if (IN(4)) { for (int r = gw; r < MTOK; r += NGW) p4_row(F, r); } SEAM(4);
    PHASES_REST
#undef IN
#undef SEAM
}

extern "C" void kernel_launch(void* const* d_in, const int* in_sizes, int n_in, void* d_out, int out_size, void* d_ws, size_t ws_size, hipStream_t stream) {
    static int grid = 0;
    if (grid == 0) {
        if (n_in != 29 || (size_t)out_size != O_END || ws_size < WS_END) { fprintf(stderr, "kernel_launch: unexpected shapes n_in %d out %d ws %zu (need %zu)\n", n_in, out_size, ws_size, (size_t)WS_END); grid = -1; return; }
        int dev = 0, cus = 0, per_cu = 0;
        if (hipGetDevice(&dev) != hipSuccess || hipDeviceGetAttribute(&cus, hipDeviceAttributeMultiprocessorCount, dev) != hipSuccess) { grid = -1; return; }
        if (hipFuncSetAttribute((const void*)mk_fwd, hipFuncAttributeMaxDynamicSharedMemorySize, LDS_BYTES) != hipSuccess) { fprintf(stderr, "kernel_launch: hipFuncSetAttribute failed\n"); grid = -1; return; }
        if (hipOccupancyMaxActiveBlocksPerMultiprocessor(&per_cu, (const void*)mk_fwd, 512, LDS_BYTES) != hipSuccess || per_cu < 1) fprintf(stderr, "kernel_launch: occupancy query reports %d\n", per_cu);
        (void)hipGetLastError();
        grid = cus;
    }
    if (grid < 0) return;
    if (hipMemsetAsync((char*)d_ws + WS_CTL, 0, CTL_BYTES, stream) != hipSuccess) return;
    Args a{};
    for (int i = 0; i < 29; ++i) a.in[i] = (const float*)d_in[i];
    a.out = (float*)d_out; a.ws = (unsigned char*)d_ws;
#if MK_SINGLE
    a.ph_lo = 0; a.ph_hi = NPHASE;
    hipLaunchKernelGGL(mk_fwd, dim3(grid), dim3(512), LDS_BYTES, stream, a);
#else
    for (int p = 0; p < NPHASE_USED; ++p) { a.ph_lo = p; a.ph_hi = p + 1; hipLaunchKernelGGL(mk_fwd, dim3(grid), dim3(512), LDS_BYTES, stream, a); }
#endif
    const hipError_t le = hipPeekAtLastError();
    if (le != hipSuccess) fprintf(stderr, "kernel_launch: launch failed: %s\n", hipGetErrorName(le));
}
```

```cpp
#include <hip/hip_runtime.h>
#include <cstdio>
#include <cstdint>

constexpr int DM = 1024, PB = 2, PT = 8192, SB = 32, SL = 4, PAST = 8192, PAGE = 128;
constexpr int MP = PB * PT;
constexpr int MS = SB * SL;
constexpr int MTOK = MP + MS;
constexpr int GH = 8, GDK = 128, GDV = 128, GCONV = 3072, GPROJ = 4112, CHUNK = 64, NCH = PT / CHUNK;
constexpr int NH = 16, NG = 4, HPG = 4, DH = 64, NQG = 1072, NKV = 1536, NKVQ = 2816, NKVQ_REAL = 2608;
constexpr int WINDOW = 512, NSELP = 128, NSELS = 129, NCMP = 511;
constexpr int PEH = 8, PEDQ = 256, PEHALF = 128, NKEYS = 128, NEXP = 16384, PETOP = 16;
constexpr int NPAGES = PAST / PAGE;
constexpr float EPS = 1e-6f;

constexpr size_t O_YP = 0;
constexpr size_t O_YS = O_YP + (size_t)MP * DM;
constexpr size_t O_KVP = O_YS + (size_t)MS * DM;
constexpr size_t O_WINP = O_KVP + (size_t)MP * 1024;
constexpr size_t O_GDNP = O_WINP + (size_t)PB * 512 * 512;
constexpr size_t O_CONVP = O_GDNP + (size_t)PB * GH * 128 * 128;
constexpr size_t O_KVS = O_CONVP + (size_t)PB * 3 * GCONV;
constexpr size_t O_WINS = O_KVS + (size_t)MS * 1024;
constexpr size_t O_GDNS = O_WINS + (size_t)SB * 512 * 512;
constexpr size_t O_CONVS = O_GDNS + (size_t)SB * GH * 128 * 128;
constexpr size_t O_END = O_CONVS + (size_t)SB * 3 * GCONV;

constexpr size_t MiB = 1u << 20;
constexpr size_t al(size_t x) { return (x + 4095) & ~(size_t)4095; }
constexpr size_t WS_CTL = 0, CTL_BYTES = 1 * MiB;
constexpr size_t WS_WIN_T = WS_CTL + CTL_BYTES;
constexpr size_t WS_WOA_T = WS_WIN_T + (size_t)4096 * 1024 * 2;
constexpr size_t WS_WKVQ_T = WS_WOA_T + (size_t)1024 * 1024 * 2;
constexpr size_t WS_WOB_T = WS_WKVQ_T + (size_t)NKVQ * 1024 * 2;
constexpr size_t WS_WPQ_T = WS_WOB_T + (size_t)1024 * 1024 * 2;
constexpr size_t WS_WAB = WS_WPQ_T + (size_t)2 * 2048 * 1024 * 2;
constexpr size_t WS_SUBK = WS_WAB + (size_t)16 * 1024 * 4;
constexpr size_t WS_W1T = WS_SUBK + (size_t)2 * 8 * 2 * 128 * 128 * 2;
constexpr size_t WS_PETERM = WS_W1T + (size_t)2 * 128 * 1024 * 2;
constexpr size_t WS_PU = al(WS_PETERM + 512);
constexpr size_t WS_PV = WS_PU + (size_t)2 * NEXP * DM * 2;
constexpr size_t WS_XNA = WS_PV + (size_t)2 * NEXP * DM * 2;
constexpr size_t WS_XNB = al(WS_XNA + (size_t)MTOK * DM * 2);
constexpr size_t WS_PROJ = al(WS_XNB + (size_t)MTOK * DM * 2);
constexpr size_t WS_GW = al(WS_PROJ + (size_t)MTOK * 4096 * 2);
constexpr size_t WS_GQ = WS_GW + (size_t)2048 * 64 * 128 * 2;
constexpr size_t WS_GKT = WS_GQ + (size_t)2048 * 64 * 128 * 2;
constexpr size_t WS_GQK = WS_GKT + (size_t)2048 * 64 * 128 * 2;
constexpr size_t WS_GU = WS_GQK + (size_t)2048 * 64 * 64 * 2;
constexpr size_t WS_GDEC = WS_GU + (size_t)2048 * 64 * 128 * 4;
constexpr size_t WS_OGDN = al(WS_GDEC + 2048 * 4);
constexpr size_t WS_OG = al(WS_OGDN + (size_t)MTOK * DM * 4);
constexpr size_t WS_XS = al(WS_OG + (size_t)MTOK * DM * 2);
constexpr size_t WS_QPEER = al(WS_XS + (size_t)MTOK * DM * 4);
constexpr size_t WS_PEI = al(WS_QPEER + (size_t)MTOK * 2048 * 2);
constexpr size_t WS_PEG = al(WS_PEI + (size_t)MTOK * 128 * 4);
constexpr size_t WS_KVQ = al(WS_PEG + (size_t)MTOK * 128 * 4);
constexpr size_t WS_KSEL = al(WS_KVQ + (size_t)MTOK * NKVQ * 4);
constexpr size_t WS_VSELT = WS_KSEL + (size_t)PB * NG * PT * 64 * 2;
constexpr size_t WS_KWIN = WS_VSELT + (size_t)PB * NG * PT * 64 * 2;
constexpr size_t WS_VWINT = WS_KWIN + (size_t)PB * NG * PT * 64 * 2;
constexpr size_t WS_KCMP = WS_VWINT + (size_t)PB * NG * PT * 64 * 2;
constexpr size_t WS_VCMPT = WS_KCMP + (size_t)PB * NG * 512 * 64 * 2;
constexpr size_t WS_SKCMP = WS_VCMPT + (size_t)PB * NG * 512 * 64 * 2;
constexpr size_t WS_SVCMPT = WS_SKCMP + (size_t)SB * NG * 512 * 64 * 2;
constexpr size_t WS_SKWIN = WS_SVCMPT + (size_t)SB * NG * 512 * 64 * 2;
constexpr size_t WS_SVWINT = WS_SKWIN + (size_t)SB * NG * 544 * 64 * 2;
constexpr size_t WS_SNEW = WS_SVWINT + (size_t)SB * NG * 544 * 64 * 2;
constexpr size_t WS_QN = al(WS_SNEW + (size_t)SB * 4 * 2 * 4 * 64 * 4);
constexpr size_t WS_GATES = al(WS_QN + (size_t)MTOK * 1024 * 2);
constexpr size_t WS_OACC = al(WS_GATES + (size_t)MTOK * 48 * 4);
constexpr size_t WS_END = al(WS_OACC + (size_t)MTOK * DM * 4);

constexpr int RING_BYTES = 143360;
constexpr int LDSCTL_OFF = RING_BYTES, MISC_OFF = LDSCTL_OFF + 320;
constexpr int LDS_BYTES = 147456;

#define GAS __attribute__((address_space(1)))
#define LAS __attribute__((address_space(3)))
typedef unsigned short bf16;
typedef unsigned v4u __attribute__((ext_vector_type(4)));
typedef unsigned v2u __attribute__((ext_vector_type(2)));
typedef float f32x4 __attribute__((ext_vector_type(4)));
typedef float f32x2 __attribute__((ext_vector_type(2)));
typedef short bf16x8 __attribute__((ext_vector_type(8)));
typedef GAS unsigned gu32;
#define RLX_AGENT __ATOMIC_RELAXED, __HIP_MEMORY_SCOPE_AGENT
#define LDS_WAIT() asm volatile("s_waitcnt lgkmcnt(0)" ::: "memory")
#define VM_WAIT() asm volatile("s_waitcnt vmcnt(0)" ::: "memory")

__device__ __forceinline__ unsigned f2bf(float f) { unsigned u = __builtin_bit_cast(unsigned, f); return (u + 0x7fffu + ((u >> 16) & 1u)) >> 16; }
__device__ __forceinline__ unsigned pk2(float lo, float hi) { return f2bf(lo) | (f2bf(hi) << 16); }
__device__ __forceinline__ float bf2f(unsigned b) { return __builtin_bit_cast(float, b << 16); }
__device__ __forceinline__ float bflo(unsigned w) { return __builtin_bit_cast(float, w << 16); }
__device__ __forceinline__ float bfhi(unsigned w) { return __builtin_bit_cast(float, w & 0xffff0000u); }
__device__ __forceinline__ float wave_sum(float v) {
#pragma unroll
    for (int o = 1; o < 64; o <<= 1) v += __shfl_xor(v, o);
    return v;
}
__device__ __forceinline__ float silu_f(float x) { return x / (1.f + __expf(-x)); }
__device__ __forceinline__ float sigmoid_f(float x) { return 1.f / (1.f + __expf(-x)); }
__device__ __forceinline__ float gelu_tanh(float x) {
    const float u = 0.7978845608028654f * (x + 0.044715f * x * x * x);
    const float e = __expf(2.f * u);
    const float th = 1.f - 2.f / (e + 1.f);
    return 0.5f * x * (1.f + th);
}
__device__ __forceinline__ bf16x8 ld8(const bf16* p) { return *(const bf16x8*)p; }
__device__ __forceinline__ bf16x8 ld8l(const LAS bf16* p) { return *(const LAS bf16x8*)p; }
#define MFMA16(a, b, c) __builtin_amdgcn_mfma_f32_16x16x32_bf16((a), (b), (c), 0, 0, 0)
__device__ __forceinline__ bf16x8 cvt8(f32x4 a, f32x4 b) {
    v4u r; r.x = pk2(a.x, a.y); r.y = pk2(a.z, a.w); r.z = pk2(b.x, b.y); r.w = pk2(b.z, b.w); return __builtin_bit_cast(bf16x8, r);
}

struct Frame {
    LAS unsigned char* lds;
    int tid, lane, wave, G, bid;
    const __attribute__((address_space(4))) char* ka;
    float* out;
    unsigned char* ws;
};
#define WSP(T, off) ((T*)(F.ws + (off)))
__device__ __forceinline__ const float* fin_(const __attribute__((address_space(4))) char* ka, int i) {
    const __attribute__((address_space(4))) char* p = ka; asm volatile("" : "+s"(p));
    return *(const float* const __attribute__((address_space(4)))*)(p + 8 * i);
}
#define FIN(i) fin_(F.ka, (i))
namespace pg8 {
#define PG8_LAS __attribute__((address_space(3)))
typedef unsigned short bf16_t;
typedef short bf16x8 __attribute__((ext_vector_type(8)));
typedef float f32x4 __attribute__((ext_vector_type(4)));
typedef unsigned u32x4 __attribute__((ext_vector_type(4)));
constexpr int BM = 256, BK = 64, HALF = 128, HTB = HALF * BK * 2  , STAGE_BYTES = 8 * HTB, NXCD = 8, WGM = 8;

__host__ __device__ __forceinline__ int lds_byte(int r, int c) { const int st = (r >> 4) * 2 + (c >> 5), rr = r & 15, cc = c & 31, ob = rr * 64 + cc * 2; return st * 1024 + (ob ^ (((ob >> 9) & 1) << 5)); }
__host__ __device__ __forceinline__ void stage_rc(int b, int& R, int& C) { const int st = b / 1024, sb = b % 1024, swz = sb ^ (((sb >> 9) & 1) << 5); R = (st >> 1) * 16 + swz / 64; C = (st & 1) * 32 + (swz % 64) / 2; }
__host__ __device__ __forceinline__ int perm32(int rho) { const int n = rho >> 4, i = rho & 15; return 8 * (i >> 2) + 4 * n + (i & 3); }

struct Unit { int pm, pn; };
struct Gemm { const bf16_t* A; const bf16_t* Bt; int M, N, K; };

struct StaticOrder {
    int nM, nN, nwg, G, c;
    __host__ __device__ void init(int M, int N, int G_, int c_) { nM = M / BM; nN = N / BM; nwg = nM * nN; G = G_; c = c_; }
    __host__ __device__ bool next(int i, Unit& u) const {
        const long L = (long)i * G + c; if (L >= nwg) return false;
        int wgid = (int)L; { const int q = nwg / NXCD, r = nwg % NXCD, xcd = wgid % NXCD, off = wgid / NXCD; wgid = (xcd < r ? xcd * (q + 1) : r * (q + 1) + (xcd - r) * q) + off; }
        const int nig = WGM * nN, gid = wgid / nig, fm = gid * WGM, gsz = (nM - fm) < WGM ? (nM - fm) : WGM;
        u.pm = fm + ((wgid % nig) % gsz); u.pn = (wgid % nig) / gsz; return true;
    }
    __device__ __forceinline__ void a_ready(const Unit&) const {}
    __device__ __forceinline__ void done(const Unit&) const {}
};
template <class Epi, class Sched, bool ALIGN_EPI = false, bool SP2 = false>
__device__ __forceinline__ void gemm_phase(PG8_LAS unsigned char* lds, const Gemm g, const Sched& S, const Epi& E) {
    const int tid = threadIdx.x, wid = __builtin_amdgcn_readfirstlane(tid >> 6), lane = tid & 63, wr = wid >> 2, wc = wid & 3, fr = lane & 15, fq = lane >> 4;
    const int K = g.K, nt = K / BK;
    unsigned voffA[2], voffB[2];
#pragma unroll
    for (int i = 0; i < 2; ++i) { int R, C; stage_rc(tid * 16 + i * 8192, R, C); const int Rb = Epi::PERM ? ((R & ~31) + perm32(R & 31)) : R;
        voffA[i] = (unsigned)(R * K + C) * 2u; voffB[i] = (unsigned)(Rb * K + C) * 2u; }
    const size_t kstep = (size_t)(BK * 2);
    const size_t hstep = (size_t)HALF * K * 2;
    const size_t tstep = 2 * hstep;
    const unsigned ldsw = (unsigned)wid * 1024u;
    const int aoff = lds_byte(wr * 64 + fr, fq * 8), boff = lds_byte(wc * 32 + fr, fq * 8);
#define PG8_SA(b, h) (((b) * 2 + (h)) * HTB)
#define PG8_SB(b, h) ((4 + (b) * 2 + (h)) * HTB)
#define PG8_STAGE(bufoff, gbase, voff) do { _Pragma("unroll") for (int _i = 0; _i < 2; ++_i) \
        __builtin_amdgcn_global_load_lds((const unsigned*)((const char*)(gbase) + (voff)[_i]), (PG8_LAS unsigned*)(lds + (bufoff) + ldsw + _i * 8192), 16, 0, 0); } while (0)
#define PG8_LDA(dst, b, h) do { _Pragma("unroll") for (int m = 0; m < 4; ++m) _Pragma("unroll") for (int k = 0; k < 2; ++k) dst[m][k] = *(const PG8_LAS bf16x8*)(lds + PG8_SA(b, h) + aoff + m * 2048 + k * 1024); } while (0)
#define PG8_LDB(dst, b, h) do { _Pragma("unroll") for (int n = 0; n < 2; ++n) _Pragma("unroll") for (int k = 0; k < 2; ++k) dst[n][k] = *(const PG8_LAS bf16x8*)(lds + PG8_SB(b, h) + boff + n * 2048 + k * 1024); } while (0)
#define PG8_MMA(ai, bj, At, Bt) do { __builtin_amdgcn_s_setprio(1); _Pragma("unroll") for (int m = 0; m < 4; ++m) _Pragma("unroll") for (int n = 0; n < 2; ++n) _Pragma("unroll") for (int k = 0; k < 2; ++k) \
        acc[ai][bj][m][n] = __builtin_amdgcn_mfma_f32_16x16x32_bf16(Bt[n][k], At[m][k], acc[ai][bj][m][n], 0, 0, 0); __builtin_amdgcn_s_setprio(0); } while (0)
#define PG8_WAIT_V(n) asm volatile("s_waitcnt vmcnt(" #n ")" ::: "memory")
#define PG8_WAIT_L(n) asm volatile("s_waitcnt lgkmcnt(" #n ")" ::: "memory")
#define PG8_BAR __builtin_amdgcn_s_barrier()
#define PG8_SCHED __builtin_amdgcn_sched_barrier(0)
    Unit cur, nxt; int ui = 0;
    if (!S.next(0, cur)) return;
    f32x4 acc[2][2][4][2];
#pragma unroll
    for (int a = 0; a < 2; ++a)
#pragma unroll
        for (int b = 0; b < 2; ++b)
#pragma unroll
            for (int m = 0; m < 4; ++m)
#pragma unroll
                for (int n = 0; n < 2; ++n) acc[a][b][m][n] = (f32x4){0.f, 0.f, 0.f, 0.f};
    bf16x8 At[4][2], B0[2][2], B1[2][2];
    const char* cA = (const char*)g.A + (size_t)cur.pm * tstep; const char* cB = (const char*)g.Bt + (size_t)cur.pn * tstep;
    S.a_ready(cur);
    if constexpr (SP2) {
        PG8_STAGE(PG8_SB(0, 0), cB, voffB); PG8_STAGE(PG8_SB(0, 1), cB + hstep, voffB); PG8_STAGE(PG8_SA(0, 0), cA, voffA); PG8_STAGE(PG8_SA(0, 1), cA + hstep, voffA);
        if (wr == 1) PG8_BAR;
        PG8_WAIT_V(2); PG8_BAR;
        PG8_STAGE(PG8_SB(1, 0), cB + kstep, voffB); PG8_STAGE(PG8_SA(1, 0), cA + kstep, voffA); PG8_STAGE(PG8_SB(1, 1), cB + hstep + kstep, voffB);
        PG8_WAIT_V(6); PG8_BAR;
    } else {
        PG8_STAGE(PG8_SB(0, 0), cB, voffB); PG8_STAGE(PG8_SA(0, 0), cA, voffA); PG8_STAGE(PG8_SB(0, 1), cB + hstep, voffB); PG8_STAGE(PG8_SA(0, 1), cA + hstep, voffA);
        if (wr == 1) PG8_BAR;
        PG8_WAIT_V(4); PG8_BAR;
        PG8_STAGE(PG8_SB(1, 0), cB + kstep, voffB); PG8_STAGE(PG8_SA(1, 0), cA + kstep, voffA); PG8_STAGE(PG8_SB(1, 1), cB + hstep + kstep, voffB);
        PG8_WAIT_V(6); PG8_BAR;
    }
    for (;;) {
        const bool has_next = S.next(ui + 1, nxt);
        const char* nA = has_next ? (const char*)g.A + (size_t)nxt.pm * tstep : cA; const char* nB = has_next ? (const char*)g.Bt + (size_t)nxt.pn * tstep : cB;
        for (int t = 0; t < nt; t += 2) {
            const bool last = (t == nt - 2);
            const char* a1 = cA + (size_t)(t + 1) * kstep;
            const char* a2 = last ? nA : cA + (size_t)(t + 2) * kstep; const char* b2 = last ? nB : cB + (size_t)(t + 2) * kstep;
            const char* a3 = a2 + kstep; const char* b3 = b2 + kstep;
            if (last && has_next) S.a_ready(nxt);
            if constexpr (SP2) {
            PG8_LDB(B0, 0, 0); PG8_LDB(B1, 0, 1); PG8_SCHED; PG8_LDA(At, 0, 0); PG8_STAGE(PG8_SA(1, 1), a1 + hstep, voffA);
            PG8_WAIT_V(8); PG8_WAIT_L(0); PG8_BAR; PG8_MMA(0, 0, At, B0); PG8_MMA(0, 1, At, B1); PG8_BAR; PG8_SCHED;
            PG8_LDA(At, 0, 1); PG8_STAGE(PG8_SB(0, 0), b2, voffB); PG8_STAGE(PG8_SB(0, 1), b2 + hstep, voffB); PG8_STAGE(PG8_SA(0, 0), a2, voffA);
            PG8_WAIT_V(8); PG8_WAIT_L(0); PG8_BAR; PG8_MMA(1, 0, At, B0); PG8_MMA(1, 1, At, B1); PG8_BAR; PG8_SCHED;
            PG8_LDB(B0, 1, 0); PG8_LDB(B1, 1, 1); PG8_SCHED; PG8_LDA(At, 1, 0); PG8_STAGE(PG8_SA(0, 1), a2 + hstep, voffA);
            PG8_WAIT_V(8); PG8_WAIT_L(0); PG8_BAR; PG8_MMA(0, 0, At, B0); PG8_MMA(0, 1, At, B1); PG8_BAR; PG8_SCHED;
            PG8_LDA(At, 1, 1); PG8_STAGE(PG8_SB(1, 0), b3, voffB); PG8_STAGE(PG8_SB(1, 1), b3 + hstep, voffB); PG8_STAGE(PG8_SA(1, 0), a3, voffA);
            PG8_WAIT_V(8); PG8_WAIT_L(0); PG8_BAR; PG8_MMA(1, 0, At, B0); PG8_MMA(1, 1, At, B1); PG8_BAR; PG8_SCHED;
            } else {
            PG8_LDB(B0, 0, 0); PG8_SCHED; PG8_LDA(At, 0, 0); PG8_STAGE(PG8_SA(1, 1), a1 + hstep, voffA);
            PG8_WAIT_L(8); PG8_BAR; PG8_WAIT_L(0); PG8_MMA(0, 0, At, B0); PG8_BAR; PG8_SCHED;
            PG8_LDB(B1, 0, 1); PG8_STAGE(PG8_SB(0, 0), b2, voffB);
            PG8_BAR; PG8_WAIT_L(0); PG8_MMA(0, 1, At, B1); PG8_BAR;
            PG8_LDA(At, 0, 1); PG8_STAGE(PG8_SA(0, 0), a2, voffA);
            PG8_BAR; PG8_WAIT_L(0); PG8_MMA(1, 0, At, B0); PG8_BAR; PG8_SCHED;
            PG8_STAGE(PG8_SB(0, 1), b2 + hstep, voffB);
            PG8_WAIT_V(6); PG8_BAR; PG8_MMA(1, 1, At, B1); PG8_BAR;
            PG8_LDB(B0, 1, 0); PG8_SCHED; PG8_LDA(At, 1, 0); PG8_STAGE(PG8_SA(0, 1), a2 + hstep, voffA);
            PG8_WAIT_L(8); PG8_BAR; PG8_WAIT_L(0); PG8_MMA(0, 0, At, B0); PG8_BAR; PG8_SCHED;
            PG8_LDB(B1, 1, 1); PG8_STAGE(PG8_SB(1, 0), b3, voffB);
            PG8_BAR; PG8_WAIT_L(0); PG8_MMA(0, 1, At, B1); PG8_BAR;
            PG8_LDA(At, 1, 1); PG8_STAGE(PG8_SA(1, 0), a3, voffA);
            PG8_BAR; PG8_WAIT_L(0); PG8_MMA(1, 0, At, B0); PG8_BAR; PG8_SCHED;
            PG8_STAGE(PG8_SB(1, 1), b3 + hstep, voffB);
            PG8_WAIT_V(6); PG8_BAR; PG8_MMA(1, 1, At, B1); PG8_BAR;
            }
        }
        if constexpr (ALIGN_EPI) { if (wr == 0) PG8_BAR; }
        if constexpr (!Epi::AFTER_DRAIN) { E(acc, cur, wr, wc, fr, fq); S.done(cur); }
        if (!has_next) break;
#pragma unroll
        for (int a = 0; a < 2; ++a)
#pragma unroll
            for (int b = 0; b < 2; ++b)
#pragma unroll
                for (int m = 0; m < 4; ++m)
#pragma unroll
                    for (int n = 0; n < 2; ++n) acc[a][b][m][n] = (f32x4){0.f, 0.f, 0.f, 0.f};
        cur = nxt; cA = nA; cB = nB; ++ui;
        if constexpr (ALIGN_EPI) { if (wr == 1) PG8_BAR; }
    }
    PG8_WAIT_V(0);
    if constexpr (!ALIGN_EPI) { if (wr == 0) PG8_BAR; }
    PG8_BAR;
    if constexpr (Epi::AFTER_DRAIN) { E.fused(acc, cur, wr, wc, fr, fq, lds, wid, lane); S.done(cur); }
#undef PG8_SA
#undef PG8_SB
#undef PG8_STAGE
#undef PG8_LDA
#undef PG8_LDB
#undef PG8_MMA
#undef PG8_WAIT_V
#undef PG8_WAIT_L
#undef PG8_BAR
#undef PG8_SCHED
}
}
#define XB_TMO      128
#define XB_XCNT(j)  (256  + 64 * (j))
#define XB_XSUB(j)  (1280 + 64 * (j))
#define XB_XGEN(j)  (2304 + 64 * (j))
#define XB_TOP      3328
#define XB_TOPGEN   3392
#define XCD_BAR_WORDS 3456
#define XB_SPIN_CAP (1u << 18)

__device__ __forceinline__ unsigned xb_ld(unsigned* p)              { return __hip_atomic_load(p, __ATOMIC_RELAXED, __HIP_MEMORY_SCOPE_AGENT); }
__device__ __forceinline__ unsigned xb_add(unsigned* p, unsigned v) { return __hip_atomic_fetch_add(p, v, __ATOMIC_RELAXED, __HIP_MEMORY_SCOPE_AGENT); }
__device__ __forceinline__ unsigned xb_xcc_id() { return (unsigned)__builtin_amdgcn_s_getreg((3 << 11) | 20) & 0xFu; }
#define XB_SPIN(cond, bar) do { unsigned _sp = 0; while (cond) { __builtin_amdgcn_s_sleep(1); \
    if ((++_sp & 255u) == 0u) { if (xb_ld(&(bar)[XB_TMO])) break; if (_sp > XB_SPIN_CAP) { atomicAdd(&(bar)[XB_TMO], 1u); break; } } } } while (0)

struct XcdBarrier {
    unsigned* bar; unsigned x;
    volatile LAS unsigned* st;
};

__device__ __forceinline__ XcdBarrier xcd_barrier_post(unsigned* bar, volatile LAS unsigned* st) {
    XcdBarrier b; b.bar = bar; b.x = xb_xcc_id(); b.st = st;
    if (threadIdx.x == 0) (void)xb_add(&bar[XB_XCNT(b.x)], 1u);
    return b;
}
__device__ __forceinline__ void xcd_barrier_complete(unsigned* bar, unsigned x, unsigned& nloc, unsigned& nx) {
    const unsigned G = gridDim.x * gridDim.y * gridDim.z;
    unsigned sum, cnt, mine, sp = 0u;
    for (;;) {
        sum = 0u; cnt = 0u; mine = 0u;
#pragma unroll
        for (unsigned j = 0; j < 16; ++j) { const unsigned c = xb_ld(&bar[XB_XCNT(j)]); sum += c; cnt += (c > 0u) ? 1u : 0u; mine = (j == x) ? c : mine; }
        if (sum == G) break;
        __builtin_amdgcn_s_sleep(1);
        if ((++sp & 255u) == 0u) { if (xb_ld(&bar[XB_TMO])) break; if (sp > XB_SPIN_CAP) { atomicAdd(&bar[XB_TMO], 1u); break; } }
    }
    nloc = mine > 0u ? mine : 1u; nx = cnt > 0u ? cnt : 1u;
}

__device__ __forceinline__ void xcd_barrier(const XcdBarrier& b) {
    asm volatile("s_waitcnt vmcnt(0)" ::: "memory");
    __syncthreads();
    if (threadIdx.x == 0) {
        unsigned* bar = b.bar;
        __builtin_amdgcn_s_waitcnt(0);
        unsigned nloc = b.st[0], nx = b.st[1];
        if (nloc == 0u) { xcd_barrier_complete(bar, b.x, nloc, nx); b.st[0] = nloc; b.st[1] = nx; }
        const unsigned old = xb_add(&bar[XB_XSUB(b.x)], 1u);
        const unsigned gen = old / nloc;
        if (old + 1u == (gen + 1u) * nloc) {
            __builtin_amdgcn_fence(__ATOMIC_RELEASE, "agent");
            asm volatile("s_waitcnt vmcnt(0)" ::: "memory");
            const unsigned og = xb_add(&bar[XB_TOP], 1u);
            const unsigned tg = og / nx;
            if (og + 1u == (tg + 1u) * nx) xb_add(&bar[XB_TOPGEN], 1u);
            else XB_SPIN(xb_ld(&bar[XB_TOPGEN]) == tg, bar);
            __builtin_amdgcn_fence(__ATOMIC_ACQUIRE, "agent");
            xb_add(&bar[XB_XGEN(b.x)], 1u);
            asm volatile("s_waitcnt vmcnt(0)" ::: "memory");
        } else {
            XB_SPIN(xb_ld(&bar[XB_XGEN(b.x)]) == gen, bar);
            __builtin_amdgcn_fence(__ATOMIC_ACQUIRE, "agent");
            asm volatile("s_waitcnt vmcnt(0)" ::: "memory");
        }
    }
    __syncthreads();
}

namespace pg8 {
template <class Fn> struct EpiFn {
    static constexpr bool PERM = true, AFTER_DRAIN = false;
    Fn f;
    __device__ __forceinline__ void operator()(const f32x4 (&acc)[2][2][4][2], const Unit& u, int wr, int wc, int fr, int fq) const {
        const int row0 = u.pm * BM + wr * 64 + fr, col0 = u.pn * BM + wc * 32 + 8 * fq;
#pragma unroll
        for (int ai = 0; ai < 2; ++ai)
#pragma unroll
            for (int m = 0; m < 4; ++m)
#pragma unroll
                for (int bj = 0; bj < 2; ++bj) f.e8(row0 + ai * HALF + m * 16, col0 + bj * HALF, acc[ai][bj][m][0], acc[ai][bj][m][1]);
    }
};
}

struct FnBf16 {
    bf16* O; int ld;
    __device__ __forceinline__ void e8(int row, int col, f32x4 a, f32x4 b) const {
        v4u w; w.x = pk2(a.x, a.y); w.y = pk2(a.z, a.w); w.z = pk2(b.x, b.y); w.w = pk2(b.z, b.w);
        *(v4u*)(O + (size_t)row * ld + col) = w;
    }
    __device__ __forceinline__ void e4(int row, int col, f32x4 a) const {
        v2u w; w.x = pk2(a.x, a.y); w.y = pk2(a.z, a.w);
        *(v2u*)(O + (size_t)row * ld + col) = w;
    }
};
struct FnResid {
    float* XS; const float* baseP; const float* baseS;
    __device__ __forceinline__ const float* brow(int row) const { return row < MP ? baseP + (size_t)row * DM : baseS + (size_t)(row - MP) * DM; }
    __device__ __forceinline__ void e8(int row, int col, f32x4 a, f32x4 b) const {
        const float* br = brow(row) + col; float* o = XS + (size_t)row * DM + col;
        const f32x4 x0 = *(const f32x4*)br, x1 = *(const f32x4*)(br + 4);
        *(f32x4*)o = x0 + a; *(f32x4*)(o + 4) = x1 + b;
    }
    __device__ __forceinline__ void e4(int row, int col, f32x4 a) const {
        const float* br = brow(row) + col; float* o = XS + (size_t)row * DM + col;
        *(f32x4*)o = *(const f32x4*)br + a;
    }
};
struct FnKvq {
    float* O;
    __device__ __forceinline__ void e8(int row, int col, f32x4 a, f32x4 b) const {
        if (col < NKVQ_REAL) { float* o = O + (size_t)row * NKVQ + col; *(f32x4*)o = a; *(f32x4*)(o + 4) = b; }
    }
    __device__ __forceinline__ void e4(int row, int col, f32x4 a) const {
        if (col < NKVQ_REAL) *(f32x4*)(O + (size_t)row * NKVQ + col) = a;
    }
};

template <class Fn>
__device__ __forceinline__ void skinny_gemm(Frame& F, const bf16* A, const bf16* Bt, int N, int row_base, const Fn& fn) {
    const int fr = F.lane & 15, fq = F.lane >> 4;
    const int nun = N / 16;
    for (int u = F.bid; u < nun; u += F.G) {
        const bf16* ap = Bt + (size_t)(u * 16 + fr) * DM + fq * 8;
        const bf16* bp = A + (size_t)(F.wave * 16 + fr) * DM + fq * 8;
        f32x4 acc = {0.f, 0.f, 0.f, 0.f};
#pragma unroll 8
        for (int ks = 0; ks < 32; ++ks) acc = MFMA16(ld8(ap + ks * 32), ld8(bp + ks * 32), acc);
        fn.e4(row_base + F.wave * 16 + fr, u * 16 + 4 * fq, acc);
    }
}

template <class Fn>
__device__ __forceinline__ void gemm_all(Frame& F, const bf16* A, const bf16* Bt, int N, const Fn& fn) {
    pg8::Gemm g{A, Bt, MP, N, DM}; pg8::StaticOrder S; S.init(MP, N, F.G, F.bid);
    pg8::EpiFn<Fn> E{fn};
    pg8::gemm_phase<pg8::EpiFn<Fn>, pg8::StaticOrder, true, true>(F.lds, g, S, E);
    skinny_gemm(F, A + (size_t)MP * DM, Bt, N, MP, fn);
}

__device__ __forceinline__ void p0_transpose_item(const float* W, int N, bf16* WT, int row_off, const float* gain, LAS float* scr, int item, int lane) {
    const int nblk = (N + 31) / 32, kb = item / nblk, nb = item % nblk, k0 = 64 * kb, n0 = 32 * nb;
#pragma unroll 8
    for (int i = 0; i < 32; ++i) { const int kk = 2 * i + (lane >> 5); const int n = n0 + (lane & 31);
        float v = 0.f; if (n < N) { v = W[(size_t)(k0 + kk) * N + n]; if (gain) v *= gain[k0 + kk]; }
        scr[kk * 33 + (lane & 31)] = v; }
    LDS_WAIT(); asm volatile("" ::: "memory");
    const int c = lane & 7;
#pragma unroll
    for (int j = 0; j < 4; ++j) { const int n = (lane >> 3) + 8 * j; const LAS float* s = scr + (8 * c) * 33 + n;
        v4u o; o.x = pk2(s[0 * 33], s[1 * 33]); o.y = pk2(s[2 * 33], s[3 * 33]); o.z = pk2(s[4 * 33], s[5 * 33]); o.w = pk2(s[6 * 33], s[7 * 33]);
        if (n0 + n < N) *(v4u*)(WT + (size_t)(row_off + n0 + n) * DM + k0 + 8 * c) = o; }
    LDS_WAIT(); asm volatile("" ::: "memory");
}
__device__ __forceinline__ void rms_row_to_bf16(const float* xrow, bf16* orow, int lane) {
    const f32x4* xr = (const f32x4*)xrow + lane;
    f32x4 v[4]; float s = 0.f;
#pragma unroll
    for (int j = 0; j < 4; ++j) { v[j] = xr[64 * j]; s += (v[j].x * v[j].x + v[j].y * v[j].y) + (v[j].z * v[j].z + v[j].w * v[j].w); }
    const float rstd = 1.f / sqrtf(wave_sum(s) * (1.f / DM) + EPS);
    v2u* o8 = (v2u*)orow + lane;
#pragma unroll
    for (int j = 0; j < 4; ++j) { v2u w; w.x = pk2(v[j].x * rstd, v[j].y * rstd); w.y = pk2(v[j].z * rstd, v[j].w * rstd); o8[64 * j] = w; }
}
__device__ __forceinline__ const float* xin_row(Frame& F, int row) { return row < MP ? FIN(0) + (size_t)row * DM : FIN(1) + (size_t)(row - MP) * DM; }

__device__ __forceinline__ void p0_prologue(Frame& F) {
    LAS float* scr = (LAS float*)(F.lds + F.wave * 16384);
    const int gw = F.bid * 8 + F.wave, NGW = F.G * 8;
    const int gt = F.bid * 512 + F.tid, NGT = F.G * 512;
    {
        constexpr int I_IN = 128 * 16, I_OA = 32 * 16, I_KV = 48 * 16, I_QG = 34 * 16, I_OB = 32 * 16, I_PQ = 64 * 16;
        constexpr int NITEMS = I_IN + I_OA + I_KV + I_QG + I_OB + 2 * I_PQ;
        for (int it = gw; it < NITEMS; it += NGW) {
            int r = it;
            if (r < I_IN) {
                const int kb = r / 128, nb = r % 128, k0 = 64 * kb, n0 = 32 * nb; const float* W = FIN(8); const float* gain = FIN(7);
#pragma unroll 8
                for (int i = 0; i < 32; ++i) { const int kk = 2 * i + (F.lane >> 5); scr[kk * 33 + (F.lane & 31)] = W[(size_t)(k0 + kk) * GPROJ + n0 + (F.lane & 31)] * gain[k0 + kk]; }
                LDS_WAIT(); asm volatile("" ::: "memory");
                const int c = F.lane & 7;
#pragma unroll
                for (int j = 0; j < 4; ++j) { const int n = (F.lane >> 3) + 8 * j; const LAS float* s = scr + (8 * c) * 33 + n;
                    v4u o; o.x = pk2(s[0 * 33], s[1 * 33]); o.y = pk2(s[2 * 33], s[3 * 33]); o.z = pk2(s[4 * 33], s[5 * 33]); o.w = pk2(s[6 * 33], s[7 * 33]);
                    *(v4u*)(WSP(bf16, WS_WIN_T) + (size_t)(n0 + n) * DM + k0 + 8 * c) = o; }
                LDS_WAIT(); asm volatile("" ::: "memory");
                continue; }
            r -= I_IN;
            if (r < I_OA) { p0_transpose_item(FIN(13), 1024, WSP(bf16, WS_WOA_T), 0, nullptr, scr, r, F.lane); continue; } r -= I_OA;
            if (r < I_KV) { p0_transpose_item(FIN(15), NKV, WSP(bf16, WS_WKVQ_T), 0, FIN(14), scr, r, F.lane); continue; } r -= I_KV;
            if (r < I_QG) { p0_transpose_item(FIN(21), NQG, WSP(bf16, WS_WKVQ_T), NKV, FIN(20), scr, r, F.lane); continue; } r -= I_QG;
            if (r < I_OB) { p0_transpose_item(FIN(23), 1024, WSP(bf16, WS_WOB_T), 0, nullptr, scr, r, F.lane); continue; } r -= I_OB;
            if (r < I_PQ) { p0_transpose_item(FIN(25), 2048, WSP(bf16, WS_WPQ_T), 0, FIN(24), scr, r, F.lane); continue; } r -= I_PQ;
            p0_transpose_item(FIN(25) + (size_t)1024 * 2048, 2048, WSP(bf16, WS_WPQ_T) + (size_t)2048 * 1024, 0, FIN(24) + 1024, scr, r, F.lane);
        }
        for (int i = gt; i < (NKVQ - NKVQ_REAL) * DM / 8; i += NGT) ((v4u*)(WSP(bf16, WS_WKVQ_T) + (size_t)NKVQ_REAL * DM))[i] = (v4u){0u, 0u, 0u, 0u};
        for (int i = gt; i < 16 * 1024; i += NGT) { const int j = i >> 10, k = i & 1023; WSP(float, WS_WAB)[i] = FIN(7)[k] * FIN(8)[(size_t)k * GPROJ + 4096 + j]; }
    }
    for (int m = gw; m < MTOK; m += NGW) rms_row_to_bf16(xin_row(F, m), WSP(bf16, WS_XNA) + (size_t)m * DM, F.lane);
    {
        const size_t n8 = (size_t)2 * NEXP * DM / 8;
        for (int t = 0; t < 2; ++t) { const f32x4* src = (const f32x4*)FIN(27 + t); v4u* dst = (v4u*)WSP(bf16, t == 0 ? WS_PU : WS_PV); const float* pln = FIN(24);
            for (size_t i = gt; i < n8; i += NGT) { f32x4 a = src[2 * i], b = src[2 * i + 1];
                if (t == 0) { const float* gp = pln + ((i >> 21) << 10) + ((i & 127) << 3); a = a * *(const f32x4*)gp; b = b * *(const f32x4*)(gp + 4); }
                v4u w; w.x = pk2(a.x, a.y); w.y = pk2(a.z, a.w); w.z = pk2(b.x, b.y); w.w = pk2(b.z, b.w); dst[i] = w; } }
        const f32x4* sk = (const f32x4*)FIN(26); v4u* dk = (v4u*)WSP(bf16, WS_SUBK);
        for (int i = gt; i < 2 * 8 * 2 * 128 * 128 / 8; i += NGT) { const f32x4 a = sk[2 * i], b = sk[2 * i + 1]; v4u w; w.x = pk2(a.x, a.y); w.y = pk2(a.z, a.w); w.z = pk2(b.x, b.y); w.w = pk2(b.z, b.w); dk[i] = w; }
    }
    for (int i = gt; i < 2 * 64 * 2048; i += NGT) { const int kv = i >> 17, hh = (i >> 11) & 63, k = i & 2047;
        WSP(bf16, WS_W1T)[i] = (bf16)f2bf(FIN(17)[((size_t)kv * 2048 + k) * 64 + hh]); }
    for (int it = gw; it < 128; it += NGW) { const int kv = it >> 6, h = it & 63; float s = 0.f;
        for (int k = F.lane; k < 2048; k += 64) s += FIN(18)[(size_t)kv * 2048 + k] * FIN(17)[((size_t)kv * 2048 + k) * 64 + h];
        s = wave_sum(s); if (F.lane == 0) WSP(float, WS_PETERM)[it] = s; }
    {
        const f32x4* src = (const f32x4*)FIN(3); f32x4* dst = (f32x4*)(F.out + O_WINS);
        const int per_b = 508 * 512 / 4;
        for (int i = gt; i < SB * per_b; i += NGT) { const int b = i / per_b, r = i % per_b; dst[(size_t)b * (512 * 512 / 4) + r] = src[(size_t)b * (512 * 512 / 4) + 4 * 512 / 4 + r]; }
    }
    for (int i = gt; i < SB * NG * 544 * 64; i += NGT) {
        const int d = i & 63, r = (i >> 6) % 544, bg = (i >> 6) / 544, g = bg & 3, b = bg >> 2;
        if (r < 512) { const float* cw = FIN(3) + (((size_t)b * 512 + r) * 2) * 256 + g * 64 + d;
            WSP(bf16, WS_SKWIN)[i] = (bf16)f2bf(cw[0]);
            WSP(bf16, WS_SVWINT)[((size_t)bg * 64 + d) * 544 + r] = (bf16)f2bf(cw[256]); }
        else if (r >= 516) { WSP(bf16, WS_SKWIN)[i] = 0; WSP(bf16, WS_SVWINT)[((size_t)bg * 64 + d) * 544 + r] = 0; }
    }
}

constexpr int P2_QS = 0, P2_KS = 17408, P2_KBGT = 34816, P2_VBT = 53248, P2_AM = 71680, P2_TB = 89088, P2_G = 98304;
constexpr int QS_LD = 136, KT_LD = 72, AM_LD = 68, TB_LD = 72;

__device__ __forceinline__ float softplus_f(float x) { return fmaxf(x, 0.f) + log1pf(expf(-fabsf(x))); }

__device__ __forceinline__ void p2_chunk(Frame& F, int unit) {
    const int c = unit & 127, h = (unit >> 7) & 7, b = unit >> 10;
    const int t0 = c * CHUNK, lane = F.lane, w = F.wave, fr = lane & 15, fq = lane >> 4;
    LAS unsigned char* L = F.lds; asm volatile("" : "+v"(L));
    LAS bf16* qs = (LAS bf16*)(L + P2_QS); LAS bf16* ks = (LAS bf16*)(L + P2_KS);
    LAS bf16* kbgT = (LAS bf16*)(L + P2_KBGT); LAS bf16* vbT = (LAS bf16*)(L + P2_VBT);
    LAS float* Am = (LAS float*)(L + P2_AM); LAS bf16* Tb = (LAS bf16*)(L + P2_TB);
    LAS float* Gs = (LAS float*)(L + P2_G);
    const bf16* PROJ = WSP(bf16, WS_PROJ); const bf16* XNA = WSP(bf16, WS_XNA); const float* WAB = WSP(float, WS_WAB);
    const size_t rowb = (size_t)b * PT;
    float beta_r[8];
    {
        f32x4 wa[4], wb[4];
        const float* pa = WAB + (size_t)h * DM + 8 * lane; const float* pb = WAB + (size_t)(8 + h) * DM + 8 * lane;
        wa[0] = *(const f32x4*)pa; wa[1] = *(const f32x4*)(pa + 4); wa[2] = *(const f32x4*)(pa + 512); wa[3] = *(const f32x4*)(pa + 516);
        wb[0] = *(const f32x4*)pb; wb[1] = *(const f32x4*)(pb + 4); wb[2] = *(const f32x4*)(pb + 512); wb[3] = *(const f32x4*)(pb + 516);
        const float Aneg = -expf(FIN(10)[h]), dtb = FIN(11)[h];
#pragma unroll
        for (int tk = 0; tk < 8; ++tk) {
            const int tok = 8 * w + tk; const bf16* xr = XNA + (rowb + t0 + tok) * DM + 8 * lane;
            const v4u x0 = *(const v4u*)xr, x1 = *(const v4u*)(xr + 512);
            float sa = 0.f, sb = 0.f;
#define ACC2(xw, wv0, wv1, i0) { const float lo = bflo(xw), hi = bfhi(xw); sa += lo * wv0[i0] + hi * wv0[i0 + 1]; sb += lo * wv1[i0] + hi * wv1[i0 + 1]; }
            ACC2(x0.x, wa[0], wb[0], 0) ACC2(x0.y, wa[0], wb[0], 2) ACC2(x0.z, wa[1], wb[1], 0) ACC2(x0.w, wa[1], wb[1], 2)
            ACC2(x1.x, wa[2], wb[2], 0) ACC2(x1.y, wa[2], wb[2], 2) ACC2(x1.z, wa[3], wb[3], 0) ACC2(x1.w, wa[3], wb[3], 2)
#undef ACC2
            sa = wave_sum(sa); sb = wave_sum(sb);
            const float g = Aneg * softplus_f(sa + dtb), be = 1.f / (1.f + expf(-sb));
            beta_r[tk] = be;
            if (lane == 0) { Gs[tok] = g; Gs[64 + tok] = be; }
        }
    }
#pragma unroll
    for (int p = 0; p < 3; ++p) {
        const int col0 = p * 1024 + h * 128 + 2 * lane;
        float cw0[4], cw1[4];
#pragma unroll
        for (int i = 0; i < 4; ++i) { const f32x2 cv = *(const f32x2*)(FIN(9) + (size_t)i * GCONV + col0); cw0[i] = cv.x; cw1[i] = cv.y; }
        unsigned xw[11];
#pragma unroll
        for (int rr = 0; rr < 11; ++rr) { const int t = t0 + 8 * w - 3 + rr; xw[rr] = (t >= 0) ? *(const unsigned*)(PROJ + (rowb + t) * 4096 + col0) : 0u; }
        if (c == 127 && w == 7) {
#pragma unroll
            for (int r = 0; r < 3; ++r) { float* o = F.out + O_CONVP + ((size_t)b * 3 + r) * GCONV + col0; o[0] = bflo(xw[8 + r]); o[1] = bfhi(xw[8 + r]); }
        }
#pragma unroll
        for (int tk = 0; tk < 8; ++tk) {
            const int tok = 8 * w + tk;
            float y0 = 0.f, y1 = 0.f;
#pragma unroll
            for (int i = 0; i < 4; ++i) { y0 += cw0[i] * bflo(xw[tk + i]); y1 += cw1[i] * bfhi(xw[tk + i]); }
            y0 = silu_f(y0); y1 = silu_f(y1);
            if (p < 2) {
                const float ss = wave_sum(y0 * y0 + y1 * y1);
                const float rs = (1.f / sqrtf(ss + EPS)) * (p == 0 ? 0.08838834764831845f : 1.f);
                *(LAS unsigned*)((p == 0 ? qs : ks) + tok * QS_LD + 2 * lane) = pk2(y0 * rs, y1 * rs);
            } else {
                vbT[(2 * lane) * KT_LD + tok] = (bf16)f2bf(y0 * beta_r[tk]); vbT[(2 * lane + 1) * KT_LD + tok] = (bf16)f2bf(y1 * beta_r[tk]);
            }
        }
    }
    __syncthreads();
    if (w == 0) { float g = Gs[lane];
#pragma unroll
        for (int o = 1; o < 64; o <<= 1) { const float up = __shfl_up(g, o); if (lane >= o) g += up; }
        Gs[128 + lane] = g; }
    __syncthreads();
    const float glast = Gs[128 + 63];
    const size_t chunk = (size_t)unit;
    if (w < 4) {
        const int mt = w;
        bf16x8 a[4];
#pragma unroll
        for (int kk = 0; kk < 4; ++kk) a[kk] = ld8l(ks + (16 * mt + fr) * QS_LD + 32 * kk + 8 * fq);
#pragma unroll
        for (int nt = 0; nt < 4; ++nt) {
            f32x4 acc = {0.f, 0.f, 0.f, 0.f};
            if (nt <= mt) {
#pragma unroll
                for (int kk = 0; kk < 4; ++kk) acc = MFMA16(a[kk], ld8l(ks + (16 * nt + fr) * QS_LD + 32 * kk + 8 * fq), acc);
            }
            const int j = 16 * nt + fr; const float gj = Gs[128 + j];
#pragma unroll
            for (int r = 0; r < 4; ++r) { const int i = 16 * mt + 4 * fq + r;
                Am[i * AM_LD + j] = (i > j) ? Gs[64 + i] * acc[r] * __expf(Gs[128 + i] - gj) : 0.f; }
        }
    } else {
        const int nt = w - 4;
        bf16x8 bq[4];
#pragma unroll
        for (int kk = 0; kk < 4; ++kk) bq[kk] = ld8l(qs + (16 * nt + fr) * QS_LD + 32 * kk + 8 * fq);
        const int i = 16 * nt + fr; const float gi = Gs[128 + i];
        bf16* gqk = WSP(bf16, WS_GQK) + chunk * 4096 + (size_t)i * 64;
#pragma unroll
        for (int mt = 0; mt < 4; ++mt) {
            f32x4 acc = {0.f, 0.f, 0.f, 0.f};
            if (mt <= nt) {
#pragma unroll
                for (int kk = 0; kk < 4; ++kk) acc = MFMA16(ld8l(ks + (16 * mt + fr) * QS_LD + 32 * kk + 8 * fq), bq[kk], acc);
            }
            float v[4];
#pragma unroll
            for (int r = 0; r < 4; ++r) { const int j = 16 * mt + 4 * fq + r; v[r] = (i >= j) ? acc[r] * __expf(gi - Gs[128 + j]) : 0.f; }
            v2u o; o.x = pk2(v[0], v[1]); o.y = pk2(v[2], v[3]);
            *(v2u*)(gqk + 16 * mt + 4 * fq) = o;
        }
    }
    {
        const int tok = F.tid >> 3, d0 = (F.tid & 7) * 16; const float e = __expf(Gs[128 + tok]);
        bf16* gq = WSP(bf16, WS_GQ) + chunk * 8192 + (size_t)tok * 128 + d0;
#pragma unroll
        for (int hh = 0; hh < 2; ++hh) { const v4u q = *(const LAS v4u*)(qs + tok * QS_LD + d0 + 8 * hh); v4u o;
            o.x = pk2(bflo(q.x) * e, bfhi(q.x) * e); o.y = pk2(bflo(q.y) * e, bfhi(q.y) * e); o.z = pk2(bflo(q.z) * e, bfhi(q.z) * e); o.w = pk2(bflo(q.w) * e, bfhi(q.w) * e);
            *(v4u*)(gq + 8 * hh) = o; }
    }
    {
        const int dk = F.tid & 127, tg = F.tid >> 7;
        unsigned o1[8], o2[8];
#pragma unroll
        for (int i = 0; i < 8; ++i) {
            const int ta = 16 * tg + 2 * i, tb2 = ta + 1;
            const float ka = bf2f(ks[ta * QS_LD + dk]), kb = bf2f(ks[tb2 * QS_LD + dk]);
            const float ga = Gs[128 + ta], gb = Gs[128 + tb2];
            o1[i] = pk2(ka * Gs[64 + ta] * __expf(ga), kb * Gs[64 + tb2] * __expf(gb));
            o2[i] = pk2(ka * __expf(glast - ga), kb * __expf(glast - gb));
        }
        LAS v4u* d1 = (LAS v4u*)(kbgT + dk * KT_LD + 16 * tg); d1[0] = (v4u){o1[0], o1[1], o1[2], o1[3]}; d1[1] = (v4u){o1[4], o1[5], o1[6], o1[7]};
        v4u* d2 = (v4u*)(WSP(bf16, WS_GKT) + chunk * 8192 + (size_t)dk * 64 + 16 * tg); d2[0] = (v4u){o2[0], o2[1], o2[2], o2[3]}; d2[1] = (v4u){o2[4], o2[5], o2[6], o2[7]};
    }
    if (F.tid == 0) WSP(float, WS_GDEC)[chunk] = __expf(glast);
    __syncthreads();
    if (w == 0) {
        float t[64];
#pragma unroll
        for (int i = 0; i < 64; ++i) {
            float acc0 = (i == lane) ? 1.f : 0.f, acc1 = 0.f;
#pragma unroll
            for (int j4 = 0; j4 < (i + 3) / 4; ++j4) {
                const f32x4 a = *(const LAS f32x4*)(Am + i * AM_LD + 4 * j4);
                if (4 * j4 + 0 < i) acc0 = __builtin_fmaf(-a.x, t[4 * j4 + 0], acc0);
                if (4 * j4 + 1 < i) acc1 = __builtin_fmaf(-a.y, t[4 * j4 + 1], acc1);
                if (4 * j4 + 2 < i) acc0 = __builtin_fmaf(-a.z, t[4 * j4 + 2], acc0);
                if (4 * j4 + 3 < i) acc1 = __builtin_fmaf(-a.w, t[4 * j4 + 3], acc1);
            }
            t[i] = acc0 + acc1;
        }
#pragma unroll
        for (int i = 0; i < 64; ++i) Tb[i * TB_LD + lane] = (bf16)f2bf(t[i]);
    }
    __syncthreads();
    {
        bf16x8 tb[4][2];
#pragma unroll
        for (int x = 0; x < 4; ++x)
#pragma unroll
            for (int s = 0; s < 2; ++s) tb[x][s] = ld8l(Tb + (16 * x + fr) * TB_LD + 32 * s + 8 * fq);
        const bf16x8 bv0 = ld8l(vbT + (16 * w + fr) * KT_LD + 8 * fq), bv1 = ld8l(vbT + (16 * w + fr) * KT_LD + 32 + 8 * fq);
        f32x4* gu = (f32x4*)(WSP(float, WS_GU) + chunk * 8192) + (size_t)w * 256 + lane;
#pragma unroll
        for (int mt = 0; mt < 4; ++mt) { f32x4 acc = {0.f, 0.f, 0.f, 0.f}; acc = MFMA16(tb[mt][0], bv0, acc); acc = MFMA16(tb[mt][1], bv1, acc); gu[mt * 64] = acc; }
        const bf16x8 ak0 = ld8l(kbgT + (16 * w + fr) * KT_LD + 8 * fq), ak1 = ld8l(kbgT + (16 * w + fr) * KT_LD + 32 + 8 * fq);
        bf16* gw = WSP(bf16, WS_GW) + chunk * 8192;
#pragma unroll
        for (int nt = 0; nt < 4; ++nt) { f32x4 acc = {0.f, 0.f, 0.f, 0.f}; acc = MFMA16(ak0, tb[nt][0], acc); acc = MFMA16(ak1, tb[nt][1], acc);
            v2u o; o.x = pk2(acc[0], acc[1]); o.y = pk2(acc[2], acc[3]);
            *(v2u*)(gw + (size_t)(16 * nt + fr) * 128 + 16 * w + 4 * fq) = o; }
    }
    __syncthreads();
}

constexpr int S2_Y = 0;
constexpr int S2_AB = 6144;
constexpr int S2_DOT = 6400;
constexpr int S2_U = 6656;
constexpr int S2_W = 8704;
constexpr int S2_VN = 10752;
__device__ __forceinline__ void p2_sample(Frame& F, int unit) {
    const int h = unit & 7, bs = unit >> 3, tid = F.tid, lane = F.lane, w = F.wave;
    LAS unsigned char* L = F.lds; asm volatile("" : "+v"(L));
    LAS float* Y = (LAS float*)(L + S2_Y); LAS float* AB = (LAS float*)(L + S2_AB); LAS float* DOT = (LAS float*)(L + S2_DOT);
    LAS float* U = (LAS float*)(L + S2_U); LAS float* W = (LAS float*)(L + S2_W); LAS float* VN = (LAS float*)(L + S2_VN);
    const bf16* PROJ = WSP(bf16, WS_PROJ); const bf16* XNA = WSP(bf16, WS_XNA); const float* WAB = WSP(float, WS_WAB);
    const size_t row0 = (size_t)MP + bs * 4;
    if (tid < 384) {
        const int part = tid >> 7, cc = tid & 127, col = part * 1024 + h * 128 + cc;
        float buf[7];
#pragma unroll
        for (int r = 0; r < 3; ++r) buf[r] = FIN(5)[((size_t)bs * 3 + r) * GCONV + col];
#pragma unroll
        for (int i = 0; i < 4; ++i) buf[3 + i] = bf2f(PROJ[(row0 + i) * 4096 + col]);
#pragma unroll
        for (int r = 0; r < 3; ++r) F.out[O_CONVS + ((size_t)bs * 3 + r) * GCONV + col] = buf[4 + r];
        float cw[4];
#pragma unroll
        for (int i = 0; i < 4; ++i) cw[i] = FIN(9)[(size_t)i * GCONV + col];
#pragma unroll
        for (int i = 0; i < 4; ++i) { float y = 0.f;
#pragma unroll
            for (int k = 0; k < 4; ++k) y += cw[k] * buf[i + k];
            Y[(part * 4 + i) * 128 + cc] = silu_f(y); }
    }
    {
        const int i = w >> 1, which = w & 1; const bf16* xr = XNA + (row0 + i) * DM; const float* wr = WAB + (size_t)(which * 8 + h) * DM; float s = 0.f;
        for (int k = lane; k < DM; k += 64) s += bf2f(xr[k]) * wr[k];
        s = wave_sum(s); if (lane == 0) AB[which * 4 + i] = s;
    }
    __syncthreads();
    {
        const int part = w >> 2, i = w & 3; LAS float* y = Y + (part * 4 + i) * 128; const float a = y[lane], bq = y[64 + lane];
        const float ss = wave_sum(a * a + bq * bq); const float rs = (1.f / sqrtf(ss + EPS)) * (part == 0 ? 0.08838834764831845f : 1.f);
        y[lane] = a * rs; y[64 + lane] = bq * rs;
    }
    if (tid == 0) { const float Aneg = -expf(FIN(10)[h]), dtb = FIN(11)[h]; float gc = 0.f;
        for (int i = 0; i < 4; ++i) { const float g = Aneg * softplus_f(AB[i] + dtb); gc += g; AB[8 + i] = g; AB[12 + i] = 1.f / (1.f + expf(-AB[4 + i])); AB[16 + i] = gc; } }
    __syncthreads();
    {
#pragma unroll
        for (int pp = 0; pp < 4; ++pp) { const int pr = 4 * w + pp, which = pr >> 4, i = (pr >> 2) & 3, j = pr & 3;
            const LAS float* x = Y + ((which == 0 ? 1 : 0) * 4 + i) * 128; const LAS float* y = Y + (1 * 4 + j) * 128;
            float s = x[lane] * y[lane] + x[64 + lane] * y[64 + lane]; s = wave_sum(s); if (lane == 0) DOT[pr] = s; }
    }
    __syncthreads();
    float g_[4], be[4], gc[4];
#pragma unroll
    for (int i = 0; i < 4; ++i) { g_[i] = AB[8 + i]; be[i] = AB[12 + i]; gc[i] = AB[16 + i]; }
    float Tm[4][4];
    {
        float A[4][4];
#pragma unroll
        for (int i = 0; i < 4; ++i)
#pragma unroll
            for (int j = 0; j < 4; ++j) A[i][j] = (i > j) ? be[i] * DOT[i * 4 + j] * expf(gc[i] - gc[j]) : 0.f;
#pragma unroll
        for (int cc = 0; cc < 4; ++cc)
#pragma unroll
            for (int i = 0; i < 4; ++i) { float acc = (i == cc) ? 1.f : 0.f;
#pragma unroll
                for (int j = 0; j < 4; ++j) if (j < i) acc -= A[i][j] * Tm[j][cc];
                Tm[i][cc] = acc; }
    }
    {
        const int i = tid >> 7, x = tid & 127; float su = 0.f, sw = 0.f;
#pragma unroll
        for (int j = 0; j < 4; ++j) { su += Tm[i][j] * Y[(2 * 4 + j) * 128 + x] * be[j]; sw += Tm[i][j] * Y[(1 * 4 + j) * 128 + x] * be[j] * expf(gc[j]); }
        U[i * 128 + x] = su; W[i * 128 + x] = sw;
    }
    __syncthreads();
    const float* S0 = FIN(4) + ((size_t)bs * GH + h) * 128 * 128;
    float qs_acc;
    {
        const int i = tid >> 7, dv = tid & 127; float p = 0.f, qq = 0.f;
        const LAS float* wr = W + i * 128; const LAS float* qr = Y + (0 * 4 + i) * 128;
        for (int dk = 0; dk < 128; ++dk) { const float s = S0[(size_t)dk * 128 + dv]; p += wr[dk] * s; qq += qr[dk] * s; }
        VN[i * 128 + dv] = U[i * 128 + dv] - p; qs_acc = qq * expf(gc[i]);
    }
    __syncthreads();
    {
        const int i = tid >> 7, dv = tid & 127; float o = qs_acc;
#pragma unroll
        for (int j = 0; j < 4; ++j) if (j <= i) o += DOT[16 + i * 4 + j] * expf(gc[i] - gc[j]) * VN[j * 128 + dv];
        WSP(float, WS_OGDN)[(row0 + i) * DM + h * 128 + dv] = o;
    }
    {
        const int dv = tid & 127, dg = tid >> 7; const float el = expf(gc[3]);
        float kd[4], vn[4];
#pragma unroll
        for (int j = 0; j < 4; ++j) { kd[j] = expf(gc[3] - gc[j]); vn[j] = VN[j * 128 + dv]; }
        float* So = F.out + O_GDNS + ((size_t)bs * GH + h) * 128 * 128;
        for (int dk = dg * 32; dk < dg * 32 + 32; ++dk) { float s = S0[(size_t)dk * 128 + dv] * el;
#pragma unroll
            for (int j = 0; j < 4; ++j) s += Y[(1 * 4 + j) * 128 + dk] * kd[j] * vn[j];
            So[(size_t)dk * 128 + dv] = s; }
    }
    (void)g_;
    __syncthreads();
}

constexpr int P3_S = 0;
constexpr int P3_VN = 8192;
__device__ __forceinline__ void p3_scan(Frame& F, int bh, int s) {
    const int lane = F.lane, w = F.wave, fr = lane & 15, fq = lane >> 4;
    const int b = bh >> 3, h = bh & 7;
    LAS bf16* Sl = (LAS bf16*)(F.lds + P3_S); LAS bf16* Vl = (LAS bf16*)(F.lds + P3_VN);
    const bf16* GW = WSP(bf16, WS_GW); const bf16* GQ = WSP(bf16, WS_GQ); const bf16* GKT = WSP(bf16, WS_GKT); const bf16* GQK = WSP(bf16, WS_GQK);
    const float* GU = WSP(float, WS_GU); const float* GDEC = WSP(float, WS_GDEC);
    float* OG = WSP(float, WS_OGDN);
    f32x4 Sacc = {0.f, 0.f, 0.f, 0.f};
    { v2u z = {0u, 0u}; *(LAS v2u*)(Sl + fr * 136 + 16 * w + 4 * fq) = z; }
    __syncthreads();
    const int m = w & 3;
    for (int c = 0; c < NCH; ++c) {
        const size_t chunk = (size_t)bh * NCH + c;
        bf16x8 a1[4];
        const bf16* p1 = (w < 4 ? GW : GQ) + chunk * 8192 + (size_t)(16 * m + fr) * 128 + 8 * fq;
#pragma unroll
        for (int k = 0; k < 4; ++k) a1[k] = ld8(p1 + 32 * k);
        const bf16* pk = GKT + chunk * 8192 + (size_t)(16 * w + fr) * 64 + 8 * fq;
        const bf16x8 ak0 = ld8(pk), ak1 = ld8(pk + 32);
        bf16x8 aq0, aq1; f32x4 u4 = {0.f, 0.f, 0.f, 0.f};
        if (w >= 4) { const bf16* pq = GQK + chunk * 4096 + (size_t)(16 * m + fr) * 64 + 8 * fq; aq0 = ld8(pq); aq1 = ld8(pq + 32); }
        else u4 = *((const f32x4*)(GU + chunk * 8192) + (size_t)s * 256 + m * 64 + lane);
        const float dec = GDEC[chunk];
        f32x4 acc = {0.f, 0.f, 0.f, 0.f};
#pragma unroll
        for (int k = 0; k < 4; ++k) acc = MFMA16(a1[k], ld8l(Sl + fr * 136 + 32 * k + 8 * fq), acc);
        if (w < 4) { const f32x4 vn = u4 - acc; v2u o; o.x = pk2(vn[0], vn[1]); o.y = pk2(vn[2], vn[3]); *(LAS v2u*)(Vl + fr * 72 + 16 * m + 4 * fq) = o; }
        __syncthreads();
        const bf16x8 v0 = ld8l(Vl + fr * 72 + 8 * fq), v1 = ld8l(Vl + fr * 72 + 32 + 8 * fq);
        if (w >= 4) { acc = MFMA16(aq0, v0, acc); acc = MFMA16(aq1, v1, acc);
            float* o = OG + ((size_t)b * PT + c * CHUNK + 16 * m + 4 * fq) * DM + h * 128 + 16 * s + fr;
#pragma unroll
            for (int r = 0; r < 4; ++r) o[(size_t)r * DM] = acc[r]; }
        Sacc = Sacc * dec; Sacc = MFMA16(ak0, v0, Sacc); Sacc = MFMA16(ak1, v1, Sacc);
        { v2u o; o.x = pk2(Sacc[0], Sacc[1]); o.y = pk2(Sacc[2], Sacc[3]); *(LAS v2u*)(Sl + fr * 136 + 16 * w + 4 * fq) = o; }
        __syncthreads();
    }
    float* So = F.out + O_GDNP + ((size_t)bh * 128) * 128;
#pragma unroll
    for (int r = 0; r < 4; ++r) So[(size_t)(16 * w + 4 * fq + r) * 128 + 16 * s + fr] = Sacc[r];
}

__device__ __forceinline__ void p4_row(Frame& F, int row) {
    const int lane = F.lane;
    const float* o = WSP(float, WS_OGDN) + (size_t)row * DM + 16 * lane;
    const bf16* z = WSP(bf16, WS_PROJ) + (size_t)row * 4096 + 3072 + 16 * lane;
    f32x4 v[4]; float ss = 0.f;
#pragma unroll
    for (int j = 0; j < 4; ++j) { v[j] = *(const f32x4*)(o + 4 * j); ss += (v[j].x * v[j].x + v[j].y * v[j].y) + (v[j].z * v[j].z + v[j].w * v[j].w); }
    ss += __shfl_xor(ss, 1); ss += __shfl_xor(ss, 2); ss += __shfl_xor(ss, 4);
    const float rstd = 1.f / sqrtf(ss * (1.f / 128.f) + EPS);
    const v4u z0 = *(const v4u*)z, z1 = *(const v4u*)(z + 8);
    const float* gn = FIN(12) + (16 * lane & 127);
    float zz[16] = {bflo(z0.x), bfhi(z0.x), bflo(z0.y), bfhi(z0.y), bflo(z0.z), bfhi(z0.z), bflo(z0.w), bfhi(z0.w),
                    bflo(z1.x), bfhi(z1.x), bflo(z1.y), bfhi(z1.y), bflo(z1.z), bfhi(z1.z), bflo(z1.w), bfhi(z1.w)};
    unsigned ow[8];
#pragma unroll
    for (int j = 0; j < 8; ++j) { const float a = v[j >> 1][(2 * j) & 3] * rstd * gn[2 * j] * silu_f(zz[2 * j]), bq = v[j >> 1][(2 * j + 1) & 3] * rstd * gn[2 * j + 1] * silu_f(zz[2 * j + 1]); ow[j] = pk2(a, bq); }
    v4u* dst = (v4u*)(WSP(bf16, WS_OG) + (size_t)row * DM + 16 * lane);
    dst[0] = (v4u){ow[0], ow[1], ow[2], ow[3]}; dst[1] = (v4u){ow[4], ow[5], ow[6], ow[7]};
}

typedef __bf16 bf16x2_t __attribute__((ext_vector_type(2)));
__device__ __forceinline__ float dot2_bf16(unsigned w, unsigned x, float acc) { return __builtin_amdgcn_fdot2_f32_bf16(__builtin_bit_cast(bf16x2_t, w), __builtin_bit_cast(bf16x2_t, x), acc, false); }
__device__ __forceinline__ float u2f(unsigned u) { return __builtin_bit_cast(float, u); }
__device__ __forceinline__ unsigned f2u(float f) { return __builtin_bit_cast(unsigned, f); }

constexpr int P8_TOP = 0;
constexpr int P8_TAB = 16384;
__device__ __forceinline__ void p8_init_tab(Frame& F) {
    LAS unsigned char* tab = F.lds + P8_TAB;
    if (F.tid < 50) { const int k = F.tid; int i, j;
        if (k < 16) { i = 0; j = k; } else if (k < 24) { i = 1; j = k - 16; } else if (k < 29) { i = 2; j = k - 24; } else if (k < 33) { i = 3; j = k - 29; }
        else if (k < 36) { i = 4; j = k - 33; } else if (k < 38) { i = 5; j = k - 36; } else if (k < 40) { i = 6; j = k - 38; } else if (k < 42) { i = 7; j = k - 40; } else { i = k - 34; j = 0; }
        tab[k] = (unsigned char)i; tab[64 + k] = (unsigned char)j; }
    __syncthreads();
}
__device__ __forceinline__ void p8_unit(Frame& F, int unit, int layer) {
    const int lane = F.lane, w = F.wave, fr = lane & 15, fq = lane >> 4;
    LAS unsigned char* L = F.lds; asm volatile("" : "+v"(L));
    LAS unsigned* topl = (LAS unsigned*)(L + P8_TOP + w * 2048);
    const LAS unsigned char* tab = L + P8_TAB;
    const int r0 = unit * 16;
    const bf16* Q = WSP(bf16, WS_QPEER) + (size_t)(r0 + fr) * 2048 + w * 256 + 8 * fq;
    const bf16* SK = WSP(bf16, WS_SUBK) + (size_t)((layer * 8 + w) * 2) * 16384 + (size_t)fr * 128 + 8 * fq;
    const float NEGINF = -__builtin_inff();
#pragma unroll 1
    for (int p = 0; p < 2; ++p) {
        bf16x8 bq[4];
#pragma unroll
        for (int ks = 0; ks < 4; ++ks) bq[ks] = ld8(Q + p * 128 + 32 * ks);
        float v[32];
#pragma unroll
        for (int mt = 0; mt < 8; ++mt) { f32x4 acc = {0.f, 0.f, 0.f, 0.f};
#pragma unroll
            for (int ks = 0; ks < 4; ++ks) acc = MFMA16(ld8(SK + (size_t)p * 16384 + (size_t)mt * 2048 + 32 * ks), bq[ks], acc);
#pragma unroll
            for (int r = 0; r < 4; ++r) v[4 * mt + r] = u2f((f2u(acc[r]) & ~127u) | (unsigned)(16 * mt + 4 * fq + r)); }
#pragma unroll 1
        for (int rd = 0; rd < 16; ++rd) {
            float m = v[0];
#pragma unroll
            for (int i = 1; i < 32; ++i) m = fmaxf(m, v[i]);
            m = fmaxf(m, __shfl_xor(m, 16)); m = fmaxf(m, __shfl_xor(m, 32));
#pragma unroll
            for (int i = 0; i < 32; ++i) v[i] = (f2u(v[i]) == f2u(m)) ? NEGINF : v[i];
            if (fq == 0) topl[(fr * 2 + p) * 16 + rd] = f2u(m);
        }
    }
    LDS_WAIT();
    float c[13];
#pragma unroll
    for (int m = 0; m < 13; ++m) { const int k = fq + 4 * m; float cv = NEGINF;
        if (k < 50) { const int i = tab[k], j = tab[64 + k]; const float s1 = u2f(topl[(fr * 2 + 0) * 16 + i] & ~127u), s2 = u2f(topl[(fr * 2 + 1) * 16 + j] & ~127u);
            cv = u2f((f2u(s1 + s2) & ~63u) | (unsigned)k); }
        c[m] = cv; }
    float win[16];
#pragma unroll
    for (int rd = 0; rd < 16; ++rd) {
        float m = c[0];
#pragma unroll
        for (int i = 1; i < 13; ++i) m = fmaxf(m, c[i]);
        m = fmaxf(m, __shfl_xor(m, 16)); m = fmaxf(m, __shfl_xor(m, 32));
#pragma unroll
        for (int i = 0; i < 13; ++i) c[i] = (f2u(c[i]) == f2u(m)) ? NEGINF : c[i];
        win[rd] = m;
    }
    float den = 0.f, ex[16];
#pragma unroll
    for (int rd = 0; rd < 16; ++rd) { ex[rd] = __expf(win[rd] - win[0]); den += ex[rd]; }
    const float inv = 1.f / den;
    if (fq == 0) {
        int* pei = WSP(int, WS_PEI) + (size_t)(r0 + fr) * 128 + w * 16; float* peg = WSP(float, WS_PEG) + (size_t)(r0 + fr) * 128 + w * 16;
#pragma unroll
        for (int q4 = 0; q4 < 4; ++q4) { int e[4]; float g[4];
#pragma unroll
            for (int x = 0; x < 4; ++x) { const int rd = 4 * q4 + x; const int k = (int)(f2u(win[rd]) & 63u); const int i = tab[k], j = tab[64 + k];
                e[x] = (int)(topl[(fr * 2 + 0) * 16 + i] & 127u) * 128 + (int)(topl[(fr * 2 + 1) * 16 + j] & 127u); g[x] = ex[rd] * inv; }
            *(v4u*)(pei + 4 * q4) = (v4u){(unsigned)e[0], (unsigned)e[1], (unsigned)e[2], (unsigned)e[3]};
            *(f32x4*)(peg + 4 * q4) = (f32x4){g[0], g[1], g[2], g[3]}; }
    }
}

__device__ __forceinline__ void p9_token(Frame& F, int row, int layer, int mode) {
    const int lane = F.lane;
    const bf16* hrow = WSP(bf16, WS_XNB) + (size_t)row * DM + 8 * lane;
    const v4u hA = *(const v4u*)hrow, hB = *(const v4u*)(hrow + 512);
    const int* pei = WSP(int, WS_PEI) + (size_t)row * 128; const float* peg = WSP(float, WS_PEG) + (size_t)row * 128;
    const int e0 = pei[lane], e1 = pei[64 + lane]; const float g0 = peg[lane], g1 = peg[64 + lane];
    const bf16* PU = WSP(bf16, WS_PU) + (size_t)layer * NEXP * DM + 8 * lane; const bf16* PV = WSP(bf16, WS_PV) + (size_t)layer * NEXP * DM + 8 * lane;
    float out[16];
#pragma unroll
    for (int i = 0; i < 16; ++i) out[i] = 0.f;
    v4u U[2][4][2], V[2][4][2];
#define P9_LOAD(buf, bb) do { const int ev_ = (bb) < 16 ? e0 : e1; _Pragma("unroll") for (int j_ = 0; j_ < 4; ++j_) { \
        const size_t off_ = (size_t)__builtin_amdgcn_readlane(ev_, ((bb) & 15) * 4 + j_) * DM; \
        U[buf][j_][0] = *(const v4u*)(PU + off_); U[buf][j_][1] = *(const v4u*)(PU + off_ + 512); \
        V[buf][j_][0] = *(const v4u*)(PV + off_); V[buf][j_][1] = *(const v4u*)(PV + off_ + 512); } } while (0)
#define P9_COMP(buf, bb) do { float d_[4]; _Pragma("unroll") for (int j_ = 0; j_ < 4; ++j_) { float a_ = 0.f, b_ = 0.f; \
            a_ = dot2_bf16(U[buf][j_][0].x, hA.x, a_); b_ = dot2_bf16(U[buf][j_][0].y, hA.y, b_); a_ = dot2_bf16(U[buf][j_][0].z, hA.z, a_); b_ = dot2_bf16(U[buf][j_][0].w, hA.w, b_); \
            a_ = dot2_bf16(U[buf][j_][1].x, hB.x, a_); b_ = dot2_bf16(U[buf][j_][1].y, hB.y, b_); a_ = dot2_bf16(U[buf][j_][1].z, hB.z, a_); b_ = dot2_bf16(U[buf][j_][1].w, hB.w, b_); d_[j_] = a_ + b_; } \
        float x01_ = (lane & 1) ? d_[1] : d_[0], y01_ = (lane & 1) ? d_[0] : d_[1]; x01_ += __shfl_xor(y01_, 1); \
        float x23_ = (lane & 1) ? d_[3] : d_[2], y23_ = (lane & 1) ? d_[2] : d_[3]; x23_ += __shfl_xor(y23_, 1); \
        float x_ = (lane & 2) ? x23_ : x01_, y_ = (lane & 2) ? x01_ : x23_; x_ += __shfl_xor(y_, 2); \
        x_ += __shfl_xor(x_, 4); x_ += __shfl_xor(x_, 8); x_ += __shfl_xor(x_, 16); x_ += __shfl_xor(x_, 32); \
        const float gt_ = __shfl((bb) < 16 ? g0 : g1, ((bb) & 15) * 4 + (lane & 3)); \
        const float cl_ = gelu_tanh(x_) * gt_; \
        _Pragma("unroll") for (int j_ = 0; j_ < 4; ++j_) { const float cj_ = __builtin_bit_cast(float, __builtin_amdgcn_readlane(__builtin_bit_cast(int, cl_), j_)); \
            out[0] += cj_ * bflo(V[buf][j_][0].x); out[1] += cj_ * bfhi(V[buf][j_][0].x); out[2] += cj_ * bflo(V[buf][j_][0].y); out[3] += cj_ * bfhi(V[buf][j_][0].y); \
            out[4] += cj_ * bflo(V[buf][j_][0].z); out[5] += cj_ * bfhi(V[buf][j_][0].z); out[6] += cj_ * bflo(V[buf][j_][0].w); out[7] += cj_ * bfhi(V[buf][j_][0].w); \
            out[8] += cj_ * bflo(V[buf][j_][1].x); out[9] += cj_ * bfhi(V[buf][j_][1].x); out[10] += cj_ * bflo(V[buf][j_][1].y); out[11] += cj_ * bfhi(V[buf][j_][1].y); \
            out[12] += cj_ * bflo(V[buf][j_][1].z); out[13] += cj_ * bfhi(V[buf][j_][1].z); out[14] += cj_ * bflo(V[buf][j_][1].w); out[15] += cj_ * bfhi(V[buf][j_][1].w); } } while (0)
    P9_LOAD(0, 0);
#pragma unroll 1
    for (int bb = 0; bb < 32; bb += 2) {
        P9_LOAD(1, bb + 1);
        P9_COMP(0, bb);
        if (bb + 2 < 32) P9_LOAD(0, bb + 2);
        P9_COMP(1, bb + 1);
    }
#undef P9_LOAD
#undef P9_COMP
    float* xs = WSP(float, WS_XS) + (size_t)row * DM + 8 * lane;
    f32x4 x[4]; x[0] = *(const f32x4*)xs; x[1] = *(const f32x4*)(xs + 4); x[2] = *(const f32x4*)(xs + 512); x[3] = *(const f32x4*)(xs + 516);
#pragma unroll
    for (int i = 0; i < 4; ++i) { x[i].x += out[4 * i]; x[i].y += out[4 * i + 1]; x[i].z += out[4 * i + 2]; x[i].w += out[4 * i + 3]; }
    if (mode == 0) {
        *(f32x4*)xs = x[0]; *(f32x4*)(xs + 4) = x[1]; *(f32x4*)(xs + 512) = x[2]; *(f32x4*)(xs + 516) = x[3];
        float ss = 0.f;
#pragma unroll
        for (int i = 0; i < 4; ++i) ss += (x[i].x * x[i].x + x[i].y * x[i].y) + (x[i].z * x[i].z + x[i].w * x[i].w);
        const float rstd = 1.f / sqrtf(wave_sum(ss) * (1.f / DM) + EPS);
        bf16* xn = WSP(bf16, WS_XNA) + (size_t)row * DM + 8 * lane;
        *(v4u*)xn = (v4u){pk2(x[0].x * rstd, x[0].y * rstd), pk2(x[0].z * rstd, x[0].w * rstd), pk2(x[1].x * rstd, x[1].y * rstd), pk2(x[1].z * rstd, x[1].w * rstd)};
        *(v4u*)(xn + 512) = (v4u){pk2(x[2].x * rstd, x[2].y * rstd), pk2(x[2].z * rstd, x[2].w * rstd), pk2(x[3].x * rstd, x[3].y * rstd), pk2(x[3].z * rstd, x[3].w * rstd)};
    } else {
        float* y = (row < MP ? F.out + O_YP + (size_t)row * DM : F.out + O_YS + (size_t)(row - MP) * DM) + 8 * lane;
        *(f32x4*)y = x[0]; *(f32x4*)(y + 4) = x[1]; *(f32x4*)(y + 512) = x[2]; *(f32x4*)(y + 516) = x[3];
    }
}

constexpr float QSCALE = 0.125f * 1.4426950408889634f;
constexpr int PP_VT = 0;
__device__ __forceinline__ float rms64(float v) { return 1.f / sqrtf(wave_sum(v * v) * (1.f / 64.f) + EPS); }

__device__ __forceinline__ void pp_q_row(Frame& F, int row, const float* kvq, const float qg) {
    const int lane = F.lane;
    bf16* qn = WSP(bf16, WS_QN) + (size_t)row * 1024;
#pragma unroll 4
    for (int hd = 0; hd < 16; ++hd) { const float v = kvq[NKV + hd * 64 + lane]; qn[hd * 64 + lane] = (bf16)f2bf(v * rms64(v) * qg); }
    if (lane < 48) WSP(float, WS_GATES)[(size_t)row * 48 + lane] = sigmoid_f(kvq[NKV + 1024 + lane]);
}
__device__ __forceinline__ void pp_prompt_tile(Frame& F, int unit) {
    const int lane = F.lane, w = F.wave, b = unit >> 7, t0 = (unit & 127) * 64;
    LAS unsigned char* L = F.lds; asm volatile("" : "+v"(L));
    LAS bf16* vt = (LAS bf16*)(L + PP_VT);
    const float kg1 = FIN(16)[64 + lane], kg2 = FIN(16)[128 + lane], qg = FIN(22)[lane] * QSCALE;
    for (int rr = 0; rr < 8; ++rr) {
        const int tl = 8 * w + rr, t = t0 + tl, row = b * PT + t;
        const float* kvq = WSP(float, WS_KVQ) + (size_t)row * NKVQ;
        float* okv = F.out + O_KVP + (size_t)row * 1024;
        const bool inwin = t >= PT - WINDOW;
        float* owin = F.out + O_WINP + ((size_t)b * 512 + (t - (PT - WINDOW))) * 512;
#pragma unroll
        for (int g = 0; g < 4; ++g) {
            const float v0 = kvq[0 * 256 + g * 64 + lane], v1 = kvq[1 * 256 + g * 64 + lane], v2 = kvq[2 * 256 + g * 64 + lane];
            const float v3 = kvq[3 * 256 + g * 64 + lane], v4 = kvq[4 * 256 + g * 64 + lane], v5 = kvq[5 * 256 + g * 64 + lane];
            const float ks = v2 * rms64(v2) * kg1, kw = v4 * rms64(v4) * kg2;
            okv[0 * 256 + g * 64 + lane] = v0; okv[1 * 256 + g * 64 + lane] = v1; okv[2 * 256 + g * 64 + lane] = ks; okv[3 * 256 + g * 64 + lane] = v3;
            if (inwin) { owin[g * 64 + lane] = kw; owin[256 + g * 64 + lane] = v5; }
            const size_t kidx = (((size_t)b * NG + g) * PT + t) * 64 + lane;
            WSP(bf16, WS_KSEL)[kidx] = (bf16)f2bf(ks); WSP(bf16, WS_KWIN)[kidx] = (bf16)f2bf(kw);
            vt[((0 * 4 + g) * 64 + lane) * 72 + tl] = (bf16)f2bf(v3); vt[((1 * 4 + g) * 64 + lane) * 72 + tl] = (bf16)f2bf(v5);
        }
        pp_q_row(F, row, kvq, qg);
    }
    __syncthreads();
    {
        const int which = F.tid >> 8, gd = F.tid & 255;
        bf16* dst = WSP(bf16, which == 0 ? WS_VSELT : WS_VWINT) + (((size_t)b * NG * 64 + gd) * PT + t0);
        const LAS bf16* src = vt + ((which * 256 + gd) * 72);
#pragma unroll
        for (int i = 0; i < 8; ++i) *(v4u*)(dst + 8 * i) = *(const LAS v4u*)(src + 8 * i);
    }
    __syncthreads();
}
__device__ __forceinline__ void pp_sample_row(Frame& F, int sr) {
    const int lane = F.lane, bs = sr >> 2, i = sr & 3, row = MP + sr;
    const float kg1 = FIN(16)[64 + lane], kg2 = FIN(16)[128 + lane], qg = FIN(22)[lane] * QSCALE;
    const float* kvq = WSP(float, WS_KVQ) + (size_t)row * NKVQ;
    float* okv = F.out + O_KVS + (size_t)sr * 1024;
    float* owin = F.out + O_WINS + ((size_t)bs * 512 + 508 + i) * 512;
#pragma unroll
    for (int g = 0; g < 4; ++g) {
        const float v0 = kvq[0 * 256 + g * 64 + lane], v1 = kvq[1 * 256 + g * 64 + lane], v2 = kvq[2 * 256 + g * 64 + lane];
        const float v3 = kvq[3 * 256 + g * 64 + lane], v4 = kvq[4 * 256 + g * 64 + lane], v5 = kvq[5 * 256 + g * 64 + lane];
        const float ks = v2 * rms64(v2) * kg1, kw = v4 * rms64(v4) * kg2;
        okv[0 * 256 + g * 64 + lane] = v0; okv[1 * 256 + g * 64 + lane] = v1; okv[2 * 256 + g * 64 + lane] = ks; okv[3 * 256 + g * 64 + lane] = v3;
        owin[g * 64 + lane] = kw; owin[256 + g * 64 + lane] = v5;
        const size_t bg = (size_t)bs * NG + g;
        WSP(bf16, WS_SKWIN)[(bg * 544 + 512 + i) * 64 + lane] = (bf16)f2bf(kw);
        WSP(bf16, WS_SVWINT)[(bg * 64 + lane) * 544 + 512 + i] = (bf16)f2bf(v5);
        float* sn = WSP(float, WS_SNEW) + (((size_t)bs * 4 + i) * 2) * 256 + g * 64 + lane;
        sn[0] = ks; sn[256] = v3;
    }
    pp_q_row(F, row, kvq, qg);
}

template <class RowP>
__device__ __forceinline__ void compress_tile(Frame& F, const RowP& rowp, int kv, int j, bf16* KC, bf16* VCT) {
    const int lane = F.lane, fr = lane & 15, fq = lane >> 4;
    const bf16* W1 = WSP(bf16, WS_W1T) + (size_t)kv * 64 * 2048 + (size_t)fr * 2048 + 8 * fq;
    const int blk = 16 * j + fr;
    f32x4 acc[4];
#pragma unroll
    for (int mt = 0; mt < 4; ++mt) acc[mt] = (f32x4){0.f, 0.f, 0.f, 0.f};
#pragma unroll 2
    for (int r = 0; r < 32; ++r) {
        int t = 16 * blk + r; t = t < PAST ? t : PAST - 1;
        const float* rp = rowp(t) + 8 * fq;
#pragma unroll
        for (int hf = 0; hf < 2; ++hf) {
            const f32x4 x0 = *(const f32x4*)(rp + 32 * hf), x1 = *(const f32x4*)(rp + 32 * hf + 4);
            const bf16x8 bfrag = cvt8(x0, x1);
            const int ks = 2 * r + hf;
#pragma unroll
            for (int mt = 0; mt < 4; ++mt) acc[mt] = MFMA16(ld8(W1 + (size_t)mt * 16 * 2048 + 32 * ks), bfrag, acc[mt]);
        }
    }
    const float* pet = WSP(float, WS_PETERM) + kv * 64;
    bf16x8 hb[2];
#pragma unroll
    for (int s = 0; s < 2; ++s) { f32x4 h0, h1;
#pragma unroll
        for (int r = 0; r < 4; ++r) { h0[r] = gelu_tanh(acc[2 * s][r] + pet[16 * (2 * s) + 4 * fq + r]); h1[r] = gelu_tanh(acc[2 * s + 1][r] + pet[16 * (2 * s + 1) + 4 * fq + r]); }
        hb[s] = cvt8(h0, h1); }
    const float* w2 = FIN(19) + (size_t)kv * 64 * 64;
    f32x4 o[4];
#pragma unroll
    for (int dt = 0; dt < 4; ++dt) { o[dt] = (f32x4){0.f, 0.f, 0.f, 0.f};
#pragma unroll
        for (int s = 0; s < 2; ++s) { f32x4 a0, a1;
#pragma unroll
            for (int jj = 0; jj < 4; ++jj) { a0[jj] = w2[(size_t)(16 * (2 * s) + 4 * fq + jj) * 64 + 16 * dt + fr]; a1[jj] = w2[(size_t)(16 * (2 * s + 1) + 4 * fq + jj) * 64 + 16 * dt + fr]; }
            o[dt] = MFMA16(cvt8(a0, a1), hb[s], o[dt]); } }
    if (kv == 0) {
        float ss = 0.f;
#pragma unroll
        for (int dt = 0; dt < 4; ++dt) ss += (o[dt][0] * o[dt][0] + o[dt][1] * o[dt][1]) + (o[dt][2] * o[dt][2] + o[dt][3] * o[dt][3]);
        ss += __shfl_xor(ss, 16); ss += __shfl_xor(ss, 32);
        const float rstd = 1.f / sqrtf(ss * (1.f / 64.f) + EPS);
        const float* kg0 = FIN(16);
        if (blk < NCMP) {
#pragma unroll
            for (int dt = 0; dt < 4; ++dt) { const int d = 16 * dt + 4 * fq; v2u ov; ov.x = pk2(o[dt][0] * rstd * kg0[d], o[dt][1] * rstd * kg0[d + 1]); ov.y = pk2(o[dt][2] * rstd * kg0[d + 2], o[dt][3] * rstd * kg0[d + 3]);
                *(v2u*)(KC + (size_t)blk * 64 + d) = ov; }
        } else {
#pragma unroll
            for (int dt = 0; dt < 4; ++dt) *(v2u*)(KC + (size_t)blk * 64 + 16 * dt + 4 * fq) = (v2u){0u, 0u};
        }
    } else {
#pragma unroll
        for (int dt = 0; dt < 4; ++dt)
#pragma unroll
            for (int r = 0; r < 4; ++r) VCT[(size_t)(16 * dt + 4 * fq + r) * 512 + blk] = (blk < NCMP) ? (bf16)f2bf(o[dt][r]) : (bf16)0;
    }
}
struct RowPPrompt { const float* base; __device__ __forceinline__ const float* operator()(int t) const { return base + (size_t)t * NKVQ; } };
struct RowPSample { const float* cache; const int* pt; __device__ __forceinline__ const float* operator()(int t) const { return cache + ((size_t)pt[t >> 7] * PAGE + (t & 127)) * 1024; } };

__device__ __forceinline__ void compress_prompt(Frame& F, int id) {
    const int kv = id & 1, j = (id >> 1) & 31, bg = id >> 6, b = bg >> 2, g = bg & 3;
    RowPPrompt rp{WSP(float, WS_KVQ) + (size_t)b * PT * NKVQ + kv * 256 + g * 64};
    compress_tile(F, rp, kv, j, WSP(bf16, WS_KCMP) + (size_t)bg * 512 * 64, WSP(bf16, WS_VCMPT) + (size_t)bg * 64 * 512);
}
__device__ __forceinline__ void compress_sample(Frame& F, int id) {
    const int kv = id & 1, j = (id >> 1) & 31, bg = id >> 6, bs = bg >> 2, g = bg & 3;
    RowPSample rp{FIN(2) + kv * 256 + g * 64, (const int*)FIN(6) + bs * NPAGES};
    compress_tile(F, rp, kv, j, WSP(bf16, WS_SKCMP) + (size_t)bg * 512 * 64, WSP(bf16, WS_SVCMPT) + (size_t)bg * 64 * 512);
}

constexpr int NSA_IMP = 0;
constexpr int NSA_Q = 67584;
constexpr float LOG2E = 1.4426950408889634f;
__device__ __forceinline__ float ex2(float x) { return __builtin_amdgcn_exp2f(x); }

struct KvBf16 {
    const bf16* K; const bf16* VT; int ld;
    __device__ __forceinline__ void lane_offsets(int fr, int fq, unsigned& ko, unsigned& vo) const {
        ko = (unsigned)((fr * 64 + 8 * fq) * 2); vo = (unsigned)((fr * ld + 4 * fq) * 2);
        asm volatile("" : "+v"(ko), "+v"(vo));
    }
    __device__ __forceinline__ bf16x8 kf(int key0, int mt, int ks, unsigned ko) const {
        return *(const bf16x8*)((const char*)K + (size_t)key0 * 128 + (ko + (unsigned)((16 * mt * 64 + 32 * ks) * 2))); }
    __device__ __forceinline__ bf16x8 vf(int key0, int dt, unsigned vo) const {
        const char* p = (const char*)VT + (size_t)key0 * 2 + (vo + (unsigned)(16 * dt * ld * 2));
        const v2u a = *(const v2u*)p, b = *(const v2u*)(p + 32); return __builtin_bit_cast(bf16x8, (v4u){a.x, a.y, b.x, b.y}); }
};
struct KvSampleSel {
    const float* cache; const int* pt; const float* snew; int g;
    __device__ __forceinline__ const float* krow(int pos, int slot) const {
        if (pos < PAST) return cache + ((size_t)pt[pos >> 7] * PAGE + (pos & 127)) * 1024 + slot * 256;
        int i = pos - PAST; i = i < 3 ? i : 3; return snew + (size_t)i * 512 + (slot - 2) * 256; }
    __device__ __forceinline__ void lane_offsets(int fr, int fq, unsigned& ko, unsigned& vo) const { ko = (unsigned)(fr | (fq << 8)); vo = ko; asm volatile("" : "+v"(ko), "+v"(vo)); }
    __device__ __forceinline__ bf16x8 kf(int key0, int mt, int ks, unsigned ko) const { const int fr = ko & 255, fq = ko >> 8; const float* p = krow(key0 + 16 * mt + fr, 2) + 32 * ks + 8 * fq; return cvt8(*(const f32x4*)p, *(const f32x4*)(p + 4)); }
    __device__ __forceinline__ bf16x8 vf(int key0, int dt, unsigned vo) const { const int fr = vo & 255, fq = vo >> 8; f32x4 a, b;
#pragma unroll
        for (int j = 0; j < 4; ++j) { a[j] = krow(key0 + 4 * fq + j, 3)[16 * dt + fr]; b[j] = krow(key0 + 16 + 4 * fq + j, 3)[16 * dt + fr]; }
        return cvt8(a, b); }
};

template <int NT, int MODE, class KV>
__device__ __forceinline__ void nsa_tile(const KV& kv, int key0, const LAS bf16x8* qf, f32x4 (&O)[NT][4], float (&m)[NT], float (&l)[NT], const float (&invl)[NT], const float (&slope)[NT],
                                         int t, int pmul, int padd, int wlim, bool selok, LAS float* improw, int fr, int fq) {
    unsigned ko, vo; kv.lane_offsets(fr, fq, ko, vo);
    bf16x8 kfr[2][2];
#pragma unroll
    for (int mt = 0; mt < 2; ++mt)
#pragma unroll
        for (int ks = 0; ks < 2; ++ks) kfr[mt][ks] = kv.kf(key0, mt, ks, ko);
    bf16x8 vfr[4];
    if (MODE != 1) {
#pragma unroll
        for (int dt = 0; dt < 4; ++dt) vfr[dt] = kv.vf(key0, dt, vo);
    }
    float dist[2][4]; bool val[2][4];
#pragma unroll
    for (int mt = 0; mt < 2; ++mt)
#pragma unroll
        for (int r = 0; r < 4; ++r) { const int kk = key0 + 16 * mt + 4 * fq + r; const int dd = t - (pmul * kk + padd); dist[mt][r] = (float)dd; val[mt][r] = selok && dd >= 0 && dd < wlim; }
    float imp_main[2] = {0.f, 0.f}, imp_spill[2] = {0.f, 0.f};
#pragma unroll
    for (int nt = 0; nt < NT; ++nt) {
        f32x4 s[2];
        const bf16x8 q0 = qf[(nt * 2 + 0) * 64], q1 = qf[(nt * 2 + 1) * 64];
#pragma unroll
        for (int mt = 0; mt < 2; ++mt) { s[mt] = (f32x4){0.f, 0.f, 0.f, 0.f}; s[mt] = MFMA16(kfr[mt][0], q0, s[mt]); s[mt] = MFMA16(kfr[mt][1], q1, s[mt]); }
        float sv[2][4];
#pragma unroll
        for (int mt = 0; mt < 2; ++mt)
#pragma unroll
            for (int r = 0; r < 4; ++r) sv[mt][r] = val[mt][r] ? (s[mt][r] - slope[nt] * dist[mt][r]) : -1e30f;
        float mref;
        if (MODE != 2) {
            float mx = fmaxf(fmaxf(fmaxf(sv[0][0], sv[0][1]), fmaxf(sv[0][2], sv[0][3])), fmaxf(fmaxf(sv[1][0], sv[1][1]), fmaxf(sv[1][2], sv[1][3])));
            mx = fmaxf(mx, __shfl_xor(mx, 16)); mx = fmaxf(mx, __shfl_xor(mx, 32));
            const float mnew = fmaxf(m[nt], mx), alpha = ex2(m[nt] - mnew);
            m[nt] = mnew; l[nt] *= alpha; mref = mnew;
            if (MODE == 0) {
#pragma unroll
                for (int dt = 0; dt < 4; ++dt) O[nt][dt] = O[nt][dt] * alpha;
            }
        } else mref = m[nt];
        f32x4 p[2]; float ps = 0.f;
#pragma unroll
        for (int mt = 0; mt < 2; ++mt)
#pragma unroll
            for (int r = 0; r < 4; ++r) { float pv = val[mt][r] ? ex2(sv[mt][r] - mref) : 0.f; if (MODE == 2) pv *= invl[nt]; p[mt][r] = pv; ps += pv; }
        if (MODE != 2) l[nt] += ps;
        if (MODE == 2) {
#pragma unroll
            for (int mt = 0; mt < 2; ++mt) { imp_main[mt] += (p[mt][0] + p[mt][1]) + (p[mt][2] + p[mt][3]); imp_spill[mt] += p[mt][3]; }
        }
        if (MODE != 1) {
            const bf16x8 pf = cvt8(p[0], p[1]);
#pragma unroll
            for (int dt = 0; dt < 4; ++dt) O[nt][dt] = MFMA16(vfr[dt], pf, O[nt][dt]);
        }
    }
    if (MODE == 2) {
#pragma unroll
        for (int mt = 0; mt < 2; ++mt) { const int j = (key0 + 16 * mt) / 4 + fq;
            __hip_atomic_fetch_add(improw + j, imp_main[mt], __ATOMIC_RELAXED, __HIP_MEMORY_SCOPE_WORKGROUP);
            __hip_atomic_fetch_add(improw + j + 1, imp_spill[mt], __ATOMIC_RELAXED, __HIP_MEMORY_SCOPE_WORKGROUP); }
    }
}

template <int NT>
__device__ __forceinline__ void nsa_zero(f32x4 (&O)[NT][4], float (&m)[NT], float (&l)[NT]) {
#pragma unroll
    for (int nt = 0; nt < NT; ++nt) { m[nt] = -1e30f; l[nt] = 0.f;
#pragma unroll
        for (int dt = 0; dt < 4; ++dt) O[nt][dt] = (f32x4){0.f, 0.f, 0.f, 0.f}; }
}

template <bool SAMPLE>
__device__ __forceinline__ void nsa_unit(Frame& F, int id) {
    constexpr int NT = SAMPLE ? 1 : 4;
    const int lane = F.lane, fr = lane & 15, fq = lane >> 4;
    LAS unsigned char* L = F.lds; asm volatile("" : "+v"(L));
    LAS float* imp = (LAS float*)(L + NSA_IMP + F.wave * 8448);
    int bg, g, t, row, trow, tmax;
    if (SAMPLE) { bg = id; g = id & 3; t = PAST + (fr >> 2); row = MP + (id >> 2) * 4 + (fr >> 2); trow = fr >> 2; tmax = PAST + 3; }
    else { bg = id >> 9; g = bg & 3; const int tt = id & 511; t = 16 * tt + fr; row = (bg >> 2) * PT + t; trow = fr; tmax = 16 * tt + 15; }
    float slope[NT]; int hd[NT];
    LAS bf16x8* qf = (LAS bf16x8*)(L + NSA_Q + F.wave * 8192) + lane;
#pragma unroll
    for (int nt = 0; nt < NT; ++nt) { hd[nt] = g * 4 + (SAMPLE ? (fr & 3) : nt); slope[nt] = ex2(-0.5f * (float)(hd[nt] + 1)) * LOG2E;
        const bf16* qp = WSP(bf16, WS_QN) + (size_t)row * 1024 + hd[nt] * 64 + 8 * fq; qf[(nt * 2 + 0) * 64] = ld8(qp); qf[(nt * 2 + 1) * 64] = ld8(qp + 32); }
    const float* gates = WSP(float, WS_GATES) + (size_t)row * 48;
    float* oacc = WSP(float, WS_OACC) + (size_t)row * 1024;
    for (int i = lane; i < 16 * 132; i += 64) imp[i] = 0.f;
    LDS_WAIT();
    f32x4 O[NT][4]; float m[NT], l[NT], invl[NT];
    {
        KvBf16 kv{WSP(bf16, SAMPLE ? WS_SKCMP : WS_KCMP) + (size_t)bg * 512 * 64, WSP(bf16, SAMPLE ? WS_SVCMPT : WS_VCMPT) + (size_t)bg * 64 * 512, 512};
        const int cmax = (tmax - 31) >> 4;
        const int ntile = (tmax >= 31) ? ((cmax < 510 ? cmax : 510) / 32 + 1) : 0;
        nsa_zero<NT>(O, m, l);
#pragma unroll
        for (int nt = 0; nt < NT; ++nt) invl[nt] = 0.f;
#pragma unroll 1
        for (int tl = 0; tl < ntile; ++tl) nsa_tile<NT, 1>(kv, 32 * tl, qf, O, m, l, invl, slope, t, 16, 31, 1 << 30, true, imp + trow * 132, fr, fq);
#pragma unroll
        for (int nt = 0; nt < NT; ++nt) { float lt = l[nt]; lt += __shfl_xor(lt, 16); lt += __shfl_xor(lt, 32); invl[nt] = lt > 0.f ? 1.f / lt : 0.f; }
#pragma unroll 1
        for (int tl = 0; tl < ntile; ++tl) nsa_tile<NT, 2>(kv, 32 * tl, qf, O, m, l, invl, slope, t, 16, 31, 1 << 30, true, imp + trow * 132, fr, fq);
#pragma unroll
        for (int nt = 0; nt < NT; ++nt) { const float gc = gates[0 * 16 + hd[nt]];
#pragma unroll
            for (int dt = 0; dt < 4; ++dt) *(f32x4*)(oacc + hd[nt] * 64 + 16 * dt + 4 * fq) = O[nt][dt] * gc; }
    }
    LDS_WAIT();
    unsigned selm[4] = {0u, 0u, 0u, 0u};
    {
        const int cur = t >> 6;
        if (!SAMPLE) {
            unsigned v[32];
#pragma unroll
            for (int i = 0; i < 32; ++i) { const int j = 32 * fq + i; const bool forced = (j == 0) | (j == cur) | (j == cur - 1);
                const unsigned key = ((f2u(imp[trow * 132 + j]) & ~127u) | (unsigned)(127 - j)) + 128u;
                v[i] = (!forced && j <= cur) ? key : 0u;
                if (forced) selm[fq] |= 1u << i; }
            unsigned fw = selm[0] | selm[1] | selm[2] | selm[3];
            const unsigned w16 = __shfl_xor(fw, 16), w32 = __shfl_xor(fw, 32), w48 = __shfl_xor(fw, 48);
#pragma unroll
            for (int wd = 0; wd < 4; ++wd) selm[wd] = (fq == wd) ? fw : ((fq ^ 1) == wd) ? w16 : ((fq ^ 2) == wd) ? w32 : w48;
            const int nforced = cur >= 2 ? 3 : cur + 1;
#pragma unroll 1
            for (int rd = 0; rd < 15; ++rd) {
                unsigned mx = v[0];
#pragma unroll
                for (int i = 1; i < 32; ++i) mx = mx > v[i] ? mx : v[i];
                { const unsigned o = __shfl_xor(mx, 16); mx = mx > o ? mx : o; } { const unsigned o = __shfl_xor(mx, 32); mx = mx > o ? mx : o; }
#pragma unroll
                for (int i = 0; i < 32; ++i) v[i] = (v[i] == mx) ? 0u : v[i];
                if (mx != 0u && rd < 16 - nforced) { const int js = 127 - (int)(mx & 127u);
#pragma unroll
                    for (int wd = 0; wd < 4; ++wd) selm[wd] |= ((js >> 5) == wd) ? (1u << (js & 31)) : 0u; }
            }
        } else {
            const int li = (fr & 3) * 4 + fq;
            unsigned v[8];
#pragma unroll
            for (int i = 0; i < 8; ++i) { const int j = li * 8 + i; v[i] = (j >= 1 && j <= 126) ? (((f2u(imp[trow * 132 + j]) & ~127u) | (unsigned)(127 - j)) + 128u) : 0u; }
            selm[0] = 1u; selm[3] = 1u << 31;
#pragma unroll 1
            for (int rd = 0; rd < 13; ++rd) {
                unsigned mx = v[0];
#pragma unroll
                for (int i = 1; i < 8; ++i) mx = mx > v[i] ? mx : v[i];
                { unsigned o = __shfl_xor(mx, 1); mx = mx > o ? mx : o; o = __shfl_xor(mx, 2); mx = mx > o ? mx : o; o = __shfl_xor(mx, 16); mx = mx > o ? mx : o; o = __shfl_xor(mx, 32); mx = mx > o ? mx : o; }
#pragma unroll
                for (int i = 0; i < 8; ++i) v[i] = (v[i] == mx) ? 0u : v[i];
                if (mx != 0u) { const int js = 127 - (int)(mx & 127u);
#pragma unroll
                    for (int wd = 0; wd < 4; ++wd) selm[wd] |= ((js >> 5) == wd) ? (1u << (js & 31)) : 0u; }
            }
        }
    }
    {
        nsa_zero<NT>(O, m, l);
        unsigned un[4];
#pragma unroll
        for (int wd = 0; wd < 4; ++wd) { unsigned x = selm[wd]; x |= __shfl_xor(x, 1); x |= __shfl_xor(x, 2); x |= __shfl_xor(x, 4); x |= __shfl_xor(x, 8); un[wd] = (unsigned)__builtin_amdgcn_readfirstlane((int)x); }
        KvBf16 kvp{WSP(bf16, WS_KSEL) + (size_t)bg * PT * 64, WSP(bf16, WS_VSELT) + (size_t)bg * 64 * PT, PT};
        KvSampleSel kvs{FIN(2) + g * 64, (const int*)FIN(6) + (SAMPLE ? (id >> 2) : 0) * NPAGES, WSP(float, WS_SNEW) + (size_t)(SAMPLE ? (id >> 2) : 0) * 2048 + g * 64, g};
#pragma unroll 1
        for (int wd = 0; wd < 4; ++wd) {
            unsigned mm = un[wd];
            const unsigned mine = wd == 0 ? selm[0] : wd == 1 ? selm[1] : wd == 2 ? selm[2] : selm[3];
            while (mm) {
                const int bit = __builtin_ctz(mm); mm &= mm - 1u; const int j = 32 * wd + bit;
                const bool ok = (mine >> bit) & 1u;
#pragma unroll 1
                for (int hh = 0; hh < 2; ++hh) {
                    if (SAMPLE) nsa_tile<NT, 0>(kvs, 64 * j + 32 * hh, qf, O, m, l, invl, slope, t, 1, 0, 1 << 30, ok, imp, fr, fq);
                    else nsa_tile<NT, 0>(kvp, 64 * j + 32 * hh, qf, O, m, l, invl, slope, t, 1, 0, 1 << 30, ok, imp, fr, fq);
                    __builtin_amdgcn_sched_barrier(0);
                }
            }
        }
        if (SAMPLE) nsa_tile<NT, 0>(kvs, 64 * 128, qf, O, m, l, invl, slope, t, 1, 0, 1 << 30, true, imp, fr, fq);
#pragma unroll
        for (int nt = 0; nt < NT; ++nt) { float lt = l[nt]; lt += __shfl_xor(lt, 16); lt += __shfl_xor(lt, 32); const float sc = gates[1 * 16 + hd[nt]] / fmaxf(lt, 1e-30f);
#pragma unroll
            for (int dt = 0; dt < 4; ++dt) { f32x4* o = (f32x4*)(oacc + hd[nt] * 64 + 16 * dt + 4 * fq); *o = *o + O[nt][dt] * sc; } }
    }
    {
        nsa_zero<NT>(O, m, l);
        KvBf16 kv = SAMPLE ? KvBf16{WSP(bf16, WS_SKWIN) + (size_t)bg * 544 * 64, WSP(bf16, WS_SVWINT) + (size_t)bg * 64 * 544, 544}
                           : KvBf16{WSP(bf16, WS_KWIN) + (size_t)bg * PT * 64, WSP(bf16, WS_VWINT) + (size_t)bg * 64 * PT, PT};
        int k0, k1, padd;
        if (SAMPLE) { k0 = 0; k1 = 544; padd = PAST - WINDOW; }
        else { const int lo = tmax - 15 - (WINDOW - 1); k0 = (lo > 0 ? lo : 0) & ~31; k1 = tmax + 1; padd = 0; }
#pragma unroll 1
        for (int kk = k0; kk < k1; kk += 32) nsa_tile<NT, 0>(kv, kk, qf, O, m, l, invl, slope, t, 1, padd, WINDOW, true, imp, fr, fq);
        bf16* on = WSP(bf16, WS_OG) + (size_t)row * 1024;
#pragma unroll
        for (int nt = 0; nt < NT; ++nt) { float lt = l[nt]; lt += __shfl_xor(lt, 16); lt += __shfl_xor(lt, 32); const float sc = gates[2 * 16 + hd[nt]] / fmaxf(lt, 1e-30f);
#pragma unroll
            for (int dt = 0; dt < 4; ++dt) { const f32x4 o = *(const f32x4*)(oacc + hd[nt] * 64 + 16 * dt + 4 * fq) + O[nt][dt] * sc;
                *(v2u*)(on + hd[nt] * 64 + 16 * dt + 4 * fq) = (v2u){pk2(o[0], o[1]), pk2(o[2], o[3])}; } }
    }
}
#define NPHASE_USED 18
#define PHASES_REST \
    if (IN(5)) { gemm_all(F, WSP(bf16, WS_OG), WSP(bf16, WS_WOA_T), 1024, FnResid{WSP(float, WS_XS), FIN(0), FIN(1)}); } SEAM(5); \
    if (IN(6)) { for (int r = gw; r < MTOK; r += NGW) rms_row_to_bf16(WSP(float, WS_XS) + (size_t)r * DM, WSP(bf16, WS_XNB) + (size_t)r * DM, F.lane); } SEAM(6); \
    if (IN(7)) { gemm_all(F, WSP(bf16, WS_XNB), WSP(bf16, WS_WPQ_T), 2048, FnBf16{WSP(bf16, WS_QPEER), 2048}); } SEAM(7); \
    if (IN(8)) { p8_init_tab(F); for (int u = F.bid; u < MTOK / 16; u += F.G) p8_unit(F, u, 0); } SEAM(8); \
    if (IN(9)) { for (int r = gw; r < MTOK; r += NGW) p9_token(F, r, 0, 0); } SEAM(9); \
    if (IN(10)) { gemm_all(F, WSP(bf16, WS_XNA), WSP(bf16, WS_WKVQ_T), NKVQ, FnKvq{WSP(float, WS_KVQ)}); } SEAM(10); \
    if (IN(11)) { \
        for (int u = F.bid; u < 256; u += F.G) pp_prompt_tile(F, u); \
        for (int r = gw; r < MS; r += NGW) pp_sample_row(F, r); \
        for (int id = gw; id < 512; id += NGW) compress_prompt(F, id); \
        for (int id = gw; id < 8192; id += NGW) compress_sample(F, id); \
    } SEAM(11); \
    if (IN(12)) { for (int id = gw; id < 128 + 4096; id += NGW) { if (id < 128) nsa_unit<true>(F, id); else nsa_unit<false>(F, id - 128); } } SEAM(12); \
    if (IN(13)) { gemm_all(F, WSP(bf16, WS_OG), WSP(bf16, WS_WOB_T), 1024, FnResid{WSP(float, WS_XS), WSP(float, WS_XS), WSP(float, WS_XS) + (size_t)MP * DM}); } SEAM(13); \
    if (IN(14)) { for (int r = gw; r < MTOK; r += NGW) rms_row_to_bf16(WSP(float, WS_XS) + (size_t)r * DM, WSP(bf16, WS_XNB) + (size_t)r * DM, F.lane); } SEAM(14); \
    if (IN(15)) { gemm_all(F, WSP(bf16, WS_XNB), WSP(bf16, WS_WPQ_T) + (size_t)2048 * 1024, 2048, FnBf16{WSP(bf16, WS_QPEER), 2048}); } SEAM(15); \
    if (IN(16)) { p8_init_tab(F); for (int u = F.bid; u < MTOK / 16; u += F.G) p8_unit(F, u, 1); } SEAM(16); \
    if (IN(17)) { for (int r = gw; r < MTOK; r += NGW) p9_token(F, r, 1, 1); }

#ifndef MK_SINGLE
#define MK_SINGLE 1
#endif
constexpr int NPHASE = 18;
struct Args { const float* in[29]; float* out; unsigned char* ws; int ph_lo, ph_hi; };
static_assert(sizeof(Args) == 31 * 8 + 8, "Args has no padding");

__global__ void __launch_bounds__(512, 2) mk_fwd(Args args) {
    extern __shared__ __attribute__((aligned(16))) unsigned char lds_raw[];
    Frame F;
    F.lds = (LAS unsigned char*)lds_raw;
    F.tid = threadIdx.x; F.lane = F.tid & 63; F.wave = __builtin_amdgcn_readfirstlane(F.tid >> 6);
    F.G = gridDim.x; F.bid = blockIdx.x;
    F.ka = (const __attribute__((address_space(4))) char*)__builtin_amdgcn_kernarg_segment_ptr();
    F.out = args.out; F.ws = args.ws;
    volatile LAS unsigned* MISC = (volatile LAS unsigned*)(F.lds + MISC_OFF);
    for (int u = F.tid; u < (LDS_BYTES - LDSCTL_OFF) / 4; u += 512) ((LAS unsigned*)(F.lds + LDSCTL_OFF))[u] = 0u;
    __syncthreads();
    unsigned* barw = (unsigned*)(F.ws + WS_CTL) + 4096;
    XcdBarrier bar; bar.bar = barw; bar.x = 0; bar.st = nullptr;
    const int lo = args.ph_lo, hi = args.ph_hi;
    if (hi - lo > 1) bar = xcd_barrier_post(barw, MISC + 8);
#ifndef PH_MASK
#define PH_MASK 0xFFFFFFFFu
#endif
#define IN(k) (((PH_MASK >> (k)) & 1u) && lo <= (k) && (k) < hi)
#define SEAM(k) do { if (IN(k) && IN((k) + 1)) xcd_barrier(bar); } while (0)
    const int gw = F.bid * 8 + F.wave, NGW = F.G * 8;

    if (IN(0)) { p0_prologue(F); } SEAM(0);
    if (IN(1)) { gemm_all(F, WSP(bf16, WS_XNA), WSP(bf16, WS_WIN_T), 4096, FnBf16{WSP(bf16, WS_PROJ), 4096}); } SEAM(1);
    if (IN(2)) {
        for (int u = F.bid; u < 2048 + 256; u += F.G) { if (u < 2048) p2_chunk(F, u); else p2_sample(F, u - 2048); }
    } SEAM(2);
    if (IN(3)) {
        if (F.G == 256) { const int x = F.bid & 7, idx = F.bid >> 3; if (idx < 16) p3_scan(F, x * 2 + (idx >> 3), idx & 7); }
        else { for (int u = F.bid; u < 128; u += F.G) p3_scan(F, u >> 3, u & 7); }
    } SEAM(3);
    if (IN(4)) { for (int r = gw; r < MTOK; r += NGW) p4_row(F, r); } SEAM(4);
    PHASES_REST
#undef IN
#undef SEAM
}

extern "C" void kernel_launch(void* const* d_in, const int* in_sizes, int n_in, void* d_out, int out_size, void* d_ws, size_t ws_size, hipStream_t stream) {
    static int grid = 0;
    if (grid == 0) {
        if (n_in != 29 || (size_t)out_size != O_END || ws_size < WS_END) { fprintf(stderr, "kernel_launch: unexpected shapes n_in %d out %d ws %zu (need %zu)\n", n_in, out_size, ws_size, (size_t)WS_END); grid = -1; return; }
        int dev = 0, cus = 0, per_cu = 0;
        if (hipGetDevice(&dev) != hipSuccess || hipDeviceGetAttribute(&cus, hipDeviceAttributeMultiprocessorCount, dev) != hipSuccess) { grid = -1; return; }
        if (hipFuncSetAttribute((const void*)mk_fwd, hipFuncAttributeMaxDynamicSharedMemorySize, LDS_BYTES) != hipSuccess) { fprintf(stderr, "kernel_launch: hipFuncSetAttribute failed\n"); grid = -1; return; }
        if (hipOccupancyMaxActiveBlocksPerMultiprocessor(&per_cu, (const void*)mk_fwd, 512, LDS_BYTES) != hipSuccess || per_cu < 1) fprintf(stderr, "kernel_launch: occupancy query reports %d\n", per_cu);
        (void)hipGetLastError();
        grid = cus;
    }
    if (grid < 0) return;
    if (hipMemsetAsync((char*)d_ws + WS_CTL, 0, CTL_BYTES, stream) != hipSuccess) return;
    Args a{};
    for (int i = 0; i < 29; ++i) a.in[i] = (const float*)d_in[i];
    a.out = (float*)d_out; a.ws = (unsigned char*)d_ws;
#if MK_SINGLE
    a.ph_lo = 0; a.ph_hi = NPHASE;
    hipLaunchKernelGGL(mk_fwd, dim3(grid), dim3(512), LDS_BYTES, stream, a);
#else
    for (int p = 0; p < NPHASE_USED; ++p) { a.ph_lo = p; a.ph_hi = p + 1; hipLaunchKernelGGL(mk_fwd, dim3(grid), dim3(512), LDS_BYTES, stream, a); }
#endif
    const hipError_t le = hipPeekAtLastError();
    if (le != hipSuccess) fprintf(stderr, "kernel_launch: launch failed: %s\n", hipGetErrorName(le));
}
```

```cpp
#include <hip/hip_runtime.h>
#include <cstdio>
#include <cstdint>

constexpr int DM = 1024, PB = 2, PT = 8192, SB = 32, SL = 4, PAST = 8192, PAGE = 128;
constexpr int MP = PB * PT;
constexpr int MS = SB * SL;
constexpr int MTOK = MP + MS;
constexpr int GH = 8, GDK = 128, GDV = 128, GCONV = 3072, GPROJ = 4112, CHUNK = 64, NCH = PT / CHUNK;
constexpr int NH = 16, NG = 4, HPG = 4, DH = 64, NQG = 1072, NKV = 1536, NKVQ = 2816, NKVQ_REAL = 2608;
constexpr int WINDOW = 512, NSELP = 128, NSELS = 129, NCMP = 511;
constexpr int PEH = 8, PEDQ = 256, PEHALF = 128, NKEYS = 128, NEXP = 16384, PETOP = 16;
constexpr int NPAGES = PAST / PAGE;
constexpr float EPS = 1e-6f;

constexpr size_t O_YP = 0;
constexpr size_t O_YS = O_YP + (size_t)MP * DM;
constexpr size_t O_KVP = O_YS + (size_t)MS * DM;
constexpr size_t O_WINP = O_KVP + (size_t)MP * 1024;
constexpr size_t O_GDNP = O_WINP + (size_t)PB * 512 * 512;
constexpr size_t O_CONVP = O_GDNP + (size_t)PB * GH * 128 * 128;
constexpr size_t O_KVS = O_CONVP + (size_t)PB * 3 * GCONV;
constexpr size_t O_WINS = O_KVS + (size_t)MS * 1024;
constexpr size_t O_GDNS = O_WINS + (size_t)SB * 512 * 512;
constexpr size_t O_CONVS = O_GDNS + (size_t)SB * GH * 128 * 128;
constexpr size_t O_END = O_CONVS + (size_t)SB * 3 * GCONV;

constexpr size_t MiB = 1u << 20;
constexpr size_t al(size_t x) { return (x + 4095) & ~(size_t)4095; }
constexpr size_t WS_CTL = 0, CTL_BYTES = 1 * MiB;
constexpr size_t WS_WIN_T = WS_CTL + CTL_BYTES;
constexpr size_t WS_WOA_T = WS_WIN_T + (size_t)4096 * 1024 * 2;
constexpr size_t WS_WKVQ_T = WS_WOA_T + (size_t)1024 * 1024 * 2;
constexpr size_t WS_WOB_T = WS_WKVQ_T + (size_t)NKVQ * 1024 * 2;
constexpr size_t WS_WPQ_T = WS_WOB_T + (size_t)1024 * 1024 * 2;
constexpr size_t WS_WAB = WS_WPQ_T + (size_t)2 * 2048 * 1024 * 2;
constexpr size_t WS_SUBK = WS_WAB + (size_t)16 * 1024 * 4;
constexpr size_t WS_W1T = WS_SUBK + (size_t)2 * 8 * 2 * 128 * 128 * 2;
constexpr size_t WS_PETERM = WS_W1T + (size_t)2 * 128 * 1024 * 2;
constexpr size_t WS_PU = al(WS_PETERM + 512);
constexpr size_t WS_PV = WS_PU + (size_t)2 * NEXP * DM * 2;
constexpr size_t WS_XNA = WS_PV + (size_t)2 * NEXP * DM * 2;
constexpr size_t WS_XNB = al(WS_XNA + (size_t)MTOK * DM * 2);
constexpr size_t WS_PROJ = al(WS_XNB + (size_t)MTOK * DM * 2);
constexpr size_t WS_GW = al(WS_PROJ + (size_t)MTOK * 4096 * 2);
constexpr size_t WS_GQ = WS_GW + (size_t)2048 * 64 * 128 * 2;
constexpr size_t WS_GKT = WS_GQ + (size_t)2048 * 64 * 128 * 2;
constexpr size_t WS_GQK = WS_GKT + (size_t)2048 * 64 * 128 * 2;
constexpr size_t WS_GU = WS_GQK + (size_t)2048 * 64 * 64 * 2;
constexpr size_t WS_GDEC = WS_GU + (size_t)2048 * 64 * 128 * 4;
constexpr size_t WS_OGDN = al(WS_GDEC + 2048 * 4);
constexpr size_t WS_OG = al(WS_OGDN + (size_t)MTOK * DM * 4);
constexpr size_t WS_XS = al(WS_OG + (size_t)MTOK * DM * 2);
constexpr size_t WS_QPEER = al(WS_XS + (size_t)MTOK * DM * 4);
constexpr size_t WS_PEI = al(WS_QPEER + (size_t)MTOK * 2048 * 2);
constexpr size_t WS_PEG = al(WS_PEI + (size_t)MTOK * 128 * 4);
constexpr size_t WS_KVQ = al(WS_PEG + (size_t)MTOK * 128 * 4);
constexpr size_t WS_KSEL = al(WS_KVQ + (size_t)MTOK * NKVQ * 4);
constexpr size_t WS_VSELT = WS_KSEL + (size_t)PB * NG * PT * 64 * 2;
constexpr size_t WS_KWIN = WS_VSELT + (size_t)PB * NG * PT * 64 * 2;
constexpr size_t WS_VWINT = WS_KWIN + (size_t)PB * NG * PT * 64 * 2;
constexpr size_t WS_KCMP = WS_VWINT + (size_t)PB * NG * PT * 64 * 2;
constexpr size_t WS_VCMPT = WS_KCMP + (size_t)PB * NG * 512 * 64 * 2;
constexpr size_t WS_SKCMP = WS_VCMPT + (size_t)PB * NG * 512 * 64 * 2;
constexpr size_t WS_SVCMPT = WS_SKCMP + (size_t)SB * NG * 512 * 64 * 2;
constexpr size_t WS_SKWIN = WS_SVCMPT + (size_t)SB * NG * 512 * 64 * 2;
constexpr size_t WS_SVWINT = WS_SKWIN + (size_t)SB * NG * 544 * 64 * 2;
constexpr size_t WS_SNEW = WS_SVWINT + (size_t)SB * NG * 544 * 64 * 2;
constexpr size_t WS_QN = al(WS_SNEW + (size_t)SB * 4 * 2 * 4 * 64 * 4);
constexpr size_t WS_GATES = al(WS_QN + (size_t)MTOK * 1024 * 2);
constexpr size_t WS_OACC = al(WS_GATES + (size_t)MTOK * 48 * 4);
constexpr size_t WS_CKA = al(WS_OACC + (size_t)MTOK * DM * 4);
constexpr size_t WS_W1BD = al(WS_CKA + (size_t)65536 * 2048 * 2);
constexpr size_t WS_FS = al(WS_W1BD + (size_t)256 * 2048 * 2);
constexpr size_t WS_END = al(WS_FS + (size_t)65536 * 256 * 4);

constexpr int RING_BYTES = 143360;
constexpr int LDSCTL_OFF = RING_BYTES, MISC_OFF = LDSCTL_OFF + 320;
constexpr int LDS_BYTES = 147456;

#define GAS __attribute__((address_space(1)))
#define LAS __attribute__((address_space(3)))
typedef unsigned short bf16;
typedef unsigned v4u __attribute__((ext_vector_type(4)));
typedef unsigned v2u __attribute__((ext_vector_type(2)));
typedef float f32x4 __attribute__((ext_vector_type(4)));
typedef float f32x2 __attribute__((ext_vector_type(2)));
typedef short bf16x8 __attribute__((ext_vector_type(8)));
typedef GAS unsigned gu32;
#define RLX_AGENT __ATOMIC_RELAXED, __HIP_MEMORY_SCOPE_AGENT
#define LDS_WAIT() asm volatile("s_waitcnt lgkmcnt(0)" ::: "memory")
#define VM_WAIT() asm volatile("s_waitcnt vmcnt(0)" ::: "memory")

__device__ __forceinline__ unsigned f2bf(float f) { unsigned u = __builtin_bit_cast(unsigned, f); return (u + 0x7fffu + ((u >> 16) & 1u)) >> 16; }
__device__ __forceinline__ unsigned pk2(float lo, float hi) { return f2bf(lo) | (f2bf(hi) << 16); }
__device__ __forceinline__ float bf2f(unsigned b) { return __builtin_bit_cast(float, b << 16); }
__device__ __forceinline__ float bflo(unsigned w) { return __builtin_bit_cast(float, w << 16); }
__device__ __forceinline__ float bfhi(unsigned w) { return __builtin_bit_cast(float, w & 0xffff0000u); }
__device__ __forceinline__ float wave_sum(float v) {
#pragma unroll
    for (int o = 1; o < 64; o <<= 1) v += __shfl_xor(v, o);
    return v;
}
__device__ __forceinline__ float silu_f(float x) { return x / (1.f + __expf(-x)); }
__device__ __forceinline__ float sigmoid_f(float x) { return 1.f / (1.f + __expf(-x)); }
__device__ __forceinline__ float gelu_tanh(float x) {
    const float u = 0.7978845608028654f * (x + 0.044715f * x * x * x);
    const float e = __expf(2.f * u);
    const float th = 1.f - 2.f / (e + 1.f);
    return 0.5f * x * (1.f + th);
}
__device__ __forceinline__ bf16x8 ld8(const bf16* p) { return *(const bf16x8*)p; }
__device__ __forceinline__ bf16x8 ld8l(const LAS bf16* p) { return *(const LAS bf16x8*)p; }
#define MFMA16(a, b, c) __builtin_amdgcn_mfma_f32_16x16x32_bf16((a), (b), (c), 0, 0, 0)
__device__ __forceinline__ bf16x8 cvt8(f32x4 a, f32x4 b) {
    v4u r; r.x = pk2(a.x, a.y); r.y = pk2(a.z, a.w); r.z = pk2(b.x, b.y); r.w = pk2(b.z, b.w); return __builtin_bit_cast(bf16x8, r);
}

struct Frame {
    LAS unsigned char* lds;
    int tid, lane, wave, G, bid;
    const __attribute__((address_space(4))) char* ka;
    float* out;
    unsigned char* ws;
};
#define WSP(T, off) ((T*)(F.ws + (off)))
__device__ __forceinline__ const float* fin_(const __attribute__((address_space(4))) char* ka, int i) {
    const __attribute__((address_space(4))) char* p = ka; asm volatile("" : "+s"(p));
    return *(const float* const __attribute__((address_space(4)))*)(p + 8 * i);
}
#define FIN(i) fin_(F.ka, (i))
namespace pg8 {
#define PG8_LAS __attribute__((address_space(3)))
typedef unsigned short bf16_t;
typedef short bf16x8 __attribute__((ext_vector_type(8)));
typedef float f32x4 __attribute__((ext_vector_type(4)));
typedef unsigned u32x4 __attribute__((ext_vector_type(4)));
constexpr int BM = 256, BK = 64, HALF = 128, HTB = HALF * BK * 2  , STAGE_BYTES = 8 * HTB, NXCD = 8, WGM = 8;

__host__ __device__ __forceinline__ int lds_byte(int r, int c) { const int st = (r >> 4) * 2 + (c >> 5), rr = r & 15, cc = c & 31, ob = rr * 64 + cc * 2; return st * 1024 + (ob ^ (((ob >> 9) & 1) << 5)); }
__host__ __device__ __forceinline__ void stage_rc(int b, int& R, int& C) { const int st = b / 1024, sb = b % 1024, swz = sb ^ (((sb >> 9) & 1) << 5); R = (st >> 1) * 16 + swz / 64; C = (st & 1) * 32 + (swz % 64) / 2; }
__host__ __device__ __forceinline__ int perm32(int rho) { const int n = rho >> 4, i = rho & 15; return 8 * (i >> 2) + 4 * n + (i & 3); }

struct Unit { int pm, pn; };
struct Gemm { const bf16_t* A; const bf16_t* Bt; int M, N, K; };

struct StaticOrder {
    int nM, nN, nwg, G, c;
    __host__ __device__ void init(int M, int N, int G_, int c_) { nM = M / BM; nN = N / BM; nwg = nM * nN; G = G_; c = c_; }
    __host__ __device__ bool next(int i, Unit& u) const {
        const long L = (long)i * G + c; if (L >= nwg) return false;
        int wgid = (int)L; { const int q = nwg / NXCD, r = nwg % NXCD, xcd = wgid % NXCD, off = wgid / NXCD; wgid = (xcd < r ? xcd * (q + 1) : r * (q + 1) + (xcd - r) * q) + off; }
        const int nig = WGM * nN, gid = wgid / nig, fm = gid * WGM, gsz = (nM - fm) < WGM ? (nM - fm) : WGM;
        u.pm = fm + ((wgid % nig) % gsz); u.pn = (wgid % nig) / gsz; return true;
    }
    __device__ __forceinline__ void a_ready(const Unit&) const {}
    __device__ __forceinline__ void done(const Unit&) const {}
};
template <class Epi, class Sched, bool ALIGN_EPI = false, bool SP2 = false>
__device__ __forceinline__ void gemm_phase(PG8_LAS unsigned char* lds, const Gemm g, const Sched& S, const Epi& E) {
    const int tid = threadIdx.x, wid = __builtin_amdgcn_readfirstlane(tid >> 6), lane = tid & 63, wr = wid >> 2, wc = wid & 3, fr = lane & 15, fq = lane >> 4;
    const int K = g.K, nt = K / BK;
    unsigned voffA[2], voffB[2];
#pragma unroll
    for (int i = 0; i < 2; ++i) { int R, C; stage_rc(tid * 16 + i * 8192, R, C); const int Rb = Epi::PERM ? ((R & ~31) + perm32(R & 31)) : R;
        voffA[i] = (unsigned)(R * K + C) * 2u; voffB[i] = (unsigned)(Rb * K + C) * 2u; }
    const size_t kstep = (size_t)(BK * 2);
    const size_t hstep = (size_t)HALF * K * 2;
    const size_t tstep = 2 * hstep;
    const unsigned ldsw = (unsigned)wid * 1024u;
    const int aoff = lds_byte(wr * 64 + fr, fq * 8), boff = lds_byte(wc * 32 + fr, fq * 8);
#define PG8_SA(b, h) (((b) * 2 + (h)) * HTB)
#define PG8_SB(b, h) ((4 + (b) * 2 + (h)) * HTB)
#define PG8_STAGE(bufoff, gbase, voff) do { _Pragma("unroll") for (int _i = 0; _i < 2; ++_i) \
        __builtin_amdgcn_global_load_lds((const unsigned*)((const char*)(gbase) + (voff)[_i]), (PG8_LAS unsigned*)(lds + (bufoff) + ldsw + _i * 8192), 16, 0, 0); } while (0)
#define PG8_LDA(dst, b, h) do { _Pragma("unroll") for (int m = 0; m < 4; ++m) _Pragma("unroll") for (int k = 0; k < 2; ++k) dst[m][k] = *(const PG8_LAS bf16x8*)(lds + PG8_SA(b, h) + aoff + m * 2048 + k * 1024); } while (0)
#define PG8_LDB(dst, b, h) do { _Pragma("unroll") for (int n = 0; n < 2; ++n) _Pragma("unroll") for (int k = 0; k < 2; ++k) dst[n][k] = *(const PG8_LAS bf16x8*)(lds + PG8_SB(b, h) + boff + n * 2048 + k * 1024); } while (0)
#define PG8_MMA(ai, bj, At, Bt) do { __builtin_amdgcn_s_setprio(1); _Pragma("unroll") for (int m = 0; m < 4; ++m) _Pragma("unroll") for (int n = 0; n < 2; ++n) _Pragma("unroll") for (int k = 0; k < 2; ++k) \
        acc[ai][bj][m][n] = __builtin_amdgcn_mfma_f32_16x16x32_bf16(Bt[n][k], At[m][k], acc[ai][bj][m][n], 0, 0, 0); __builtin_amdgcn_s_setprio(0); } while (0)
#define PG8_WAIT_V(n) asm volatile("s_waitcnt vmcnt(" #n ")" ::: "memory")
#define PG8_WAIT_L(n) asm volatile("s_waitcnt lgkmcnt(" #n ")" ::: "memory")
#define PG8_BAR __builtin_amdgcn_s_barrier()
#define PG8_SCHED __builtin_amdgcn_sched_barrier(0)
    Unit cur, nxt; int ui = 0;
    if (!S.next(0, cur)) return;
    f32x4 acc[2][2][4][2];
#pragma unroll
    for (int a = 0; a < 2; ++a)
#pragma unroll
        for (int b = 0; b < 2; ++b)
#pragma unroll
            for (int m = 0; m < 4; ++m)
#pragma unroll
                for (int n = 0; n < 2; ++n) acc[a][b][m][n] = (f32x4){0.f, 0.f, 0.f, 0.f};
    bf16x8 At[4][2], B0[2][2], B1[2][2];
    const char* cA = (const char*)g.A + (size_t)cur.pm * tstep; const char* cB = (const char*)g.Bt + (size_t)cur.pn * tstep;
    S.a_ready(cur);
    if constexpr (SP2) {
        PG8_STAGE(PG8_SB(0, 0), cB, voffB); PG8_STAGE(PG8_SB(0, 1), cB + hstep, voffB); PG8_STAGE(PG8_SA(0, 0), cA, voffA); PG8_STAGE(PG8_SA(0, 1), cA + hstep, voffA);
        if (wr == 1) PG8_BAR;
        PG8_WAIT_V(2); PG8_BAR;
        PG8_STAGE(PG8_SB(1, 0), cB + kstep, voffB); PG8_STAGE(PG8_SA(1, 0), cA + kstep, voffA); PG8_STAGE(PG8_SB(1, 1), cB + hstep + kstep, voffB);
        PG8_WAIT_V(6); PG8_BAR;
    } else {
        PG8_STAGE(PG8_SB(0, 0), cB, voffB); PG8_STAGE(PG8_SA(0, 0), cA, voffA); PG8_STAGE(PG8_SB(0, 1), cB + hstep, voffB); PG8_STAGE(PG8_SA(0, 1), cA + hstep, voffA);
        if (wr == 1) PG8_BAR;
        PG8_WAIT_V(4); PG8_BAR;
        PG8_STAGE(PG8_SB(1, 0), cB + kstep, voffB); PG8_STAGE(PG8_SA(1, 0), cA + kstep, voffA); PG8_STAGE(PG8_SB(1, 1), cB + hstep + kstep, voffB);
        PG8_WAIT_V(6); PG8_BAR;
    }
    for (;;) {
        const bool has_next = S.next(ui + 1, nxt);
        const char* nA = has_next ? (const char*)g.A + (size_t)nxt.pm * tstep : cA; const char* nB = has_next ? (const char*)g.Bt + (size_t)nxt.pn * tstep : cB;
        for (int t = 0; t < nt; t += 2) {
            const bool last = (t == nt - 2);
            const char* a1 = cA + (size_t)(t + 1) * kstep;
            const char* a2 = last ? nA : cA + (size_t)(t + 2) * kstep; const char* b2 = last ? nB : cB + (size_t)(t + 2) * kstep;
            const char* a3 = a2 + kstep; const char* b3 = b2 + kstep;
            if (last && has_next) S.a_ready(nxt);
            if constexpr (SP2) {
            PG8_LDB(B0, 0, 0); PG8_LDB(B1, 0, 1); PG8_SCHED; PG8_LDA(At, 0, 0); PG8_STAGE(PG8_SA(1, 1), a1 + hstep, voffA);
            PG8_WAIT_V(8); PG8_WAIT_L(0); PG8_BAR; PG8_MMA(0, 0, At, B0); PG8_MMA(0, 1, At, B1); PG8_BAR; PG8_SCHED;
            PG8_LDA(At, 0, 1); PG8_STAGE(PG8_SB(0, 0), b2, voffB); PG8_STAGE(PG8_SB(0, 1), b2 + hstep, voffB); PG8_STAGE(PG8_SA(0, 0), a2, voffA);
            PG8_WAIT_V(8); PG8_WAIT_L(0); PG8_BAR; PG8_MMA(1, 0, At, B0); PG8_MMA(1, 1, At, B1); PG8_BAR; PG8_SCHED;
            PG8_LDB(B0, 1, 0); PG8_LDB(B1, 1, 1); PG8_SCHED; PG8_LDA(At, 1, 0); PG8_STAGE(PG8_SA(0, 1), a2 + hstep, voffA);
            PG8_WAIT_V(8); PG8_WAIT_L(0); PG8_BAR; PG8_MMA(0, 0, At, B0); PG8_MMA(0, 1, At, B1); PG8_BAR; PG8_SCHED;
            PG8_LDA(At, 1, 1); PG8_STAGE(PG8_SB(1, 0), b3, voffB); PG8_STAGE(PG8_SB(1, 1), b3 + hstep, voffB); PG8_STAGE(PG8_SA(1, 0), a3, voffA);
            PG8_WAIT_V(8); PG8_WAIT_L(0); PG8_BAR; PG8_MMA(1, 0, At, B0); PG8_MMA(1, 1, At, B1); PG8_BAR; PG8_SCHED;
            } else {
            PG8_LDB(B0, 0, 0); PG8_SCHED; PG8_LDA(At, 0, 0); PG8_STAGE(PG8_SA(1, 1), a1 + hstep, voffA);
            PG8_WAIT_L(8); PG8_BAR; PG8_WAIT_L(0); PG8_MMA(0, 0, At, B0); PG8_BAR; PG8_SCHED;
            PG8_LDB(B1, 0, 1); PG8_STAGE(PG8_SB(0, 0), b2, voffB);
            PG8_BAR; PG8_WAIT_L(0); PG8_MMA(0, 1, At, B1); PG8_BAR;
            PG8_LDA(At, 0, 1); PG8_STAGE(PG8_SA(0, 0), a2, voffA);
            PG8_BAR; PG8_WAIT_L(0); PG8_MMA(1, 0, At, B0); PG8_BAR; PG8_SCHED;
            PG8_STAGE(PG8_SB(0, 1), b2 + hstep, voffB);
            PG8_WAIT_V(6); PG8_BAR; PG8_MMA(1, 1, At, B1); PG8_BAR;
            PG8_LDB(B0, 1, 0); PG8_SCHED; PG8_LDA(At, 1, 0); PG8_STAGE(PG8_SA(0, 1), a2 + hstep, voffA);
            PG8_WAIT_L(8); PG8_BAR; PG8_WAIT_L(0); PG8_MMA(0, 0, At, B0); PG8_BAR; PG8_SCHED;
            PG8_LDB(B1, 1, 1); PG8_STAGE(PG8_SB(1, 0), b3, voffB);
            PG8_BAR; PG8_WAIT_L(0); PG8_MMA(0, 1, At, B1); PG8_BAR;
            PG8_LDA(At, 1, 1); PG8_STAGE(PG8_SA(1, 0), a3, voffA);
            PG8_BAR; PG8_WAIT_L(0); PG8_MMA(1, 0, At, B0); PG8_BAR; PG8_SCHED;
            PG8_STAGE(PG8_SB(1, 1), b3 + hstep, voffB);
            PG8_WAIT_V(6); PG8_BAR; PG8_MMA(1, 1, At, B1); PG8_BAR;
            }
        }
        if constexpr (ALIGN_EPI) { if (wr == 0) PG8_BAR; }
        if constexpr (!Epi::AFTER_DRAIN) { E(acc, cur, wr, wc, fr, fq); S.done(cur); }
        if (!has_next) break;
#pragma unroll
        for (int a = 0; a < 2; ++a)
#pragma unroll
            for (int b = 0; b < 2; ++b)
#pragma unroll
                for (int m = 0; m < 4; ++m)
#pragma unroll
                    for (int n = 0; n < 2; ++n) acc[a][b][m][n] = (f32x4){0.f, 0.f, 0.f, 0.f};
        cur = nxt; cA = nA; cB = nB; ++ui;
        if constexpr (ALIGN_EPI) { if (wr == 1) PG8_BAR; }
    }
    PG8_WAIT_V(0);
    if constexpr (!ALIGN_EPI) { if (wr == 0) PG8_BAR; }
    PG8_BAR;
    if constexpr (Epi::AFTER_DRAIN) { E.fused(acc, cur, wr, wc, fr, fq, lds, wid, lane); S.done(cur); }
#undef PG8_SA
#undef PG8_SB
#undef PG8_STAGE
#undef PG8_LDA
#undef PG8_LDB
#undef PG8_MMA
#undef PG8_WAIT_V
#undef PG8_WAIT_L
#undef PG8_BAR
#undef PG8_SCHED
}
}
#define XB_TMO      128
#define XB_XCNT(j)  (256  + 64 * (j))
#define XB_XSUB(j)  (1280 + 64 * (j))
#define XB_XGEN(j)  (2304 + 64 * (j))
#define XB_TOP      3328
#define XB_TOPGEN   3392
#define XCD_BAR_WORDS 3456
#define XB_SPIN_CAP (1u << 18)

__device__ __forceinline__ unsigned xb_ld(unsigned* p)              { return __hip_atomic_load(p, __ATOMIC_RELAXED, __HIP_MEMORY_SCOPE_AGENT); }
__device__ __forceinline__ unsigned xb_add(unsigned* p, unsigned v) { return __hip_atomic_fetch_add(p, v, __ATOMIC_RELAXED, __HIP_MEMORY_SCOPE_AGENT); }
__device__ __forceinline__ unsigned xb_xcc_id() { return (unsigned)__builtin_amdgcn_s_getreg((3 << 11) | 20) & 0xFu; }
#define XB_SPIN(cond, bar) do { unsigned _sp = 0; while (cond) { __builtin_amdgcn_s_sleep(1); \
    if ((++_sp & 255u) == 0u) { if (xb_ld(&(bar)[XB_TMO])) break; if (_sp > XB_SPIN_CAP) { atomicAdd(&(bar)[XB_TMO], 1u); break; } } } } while (0)

struct XcdBarrier {
    unsigned* bar; unsigned x;
    volatile LAS unsigned* st;
};

__device__ __forceinline__ XcdBarrier xcd_barrier_post(unsigned* bar, volatile LAS unsigned* st) {
    XcdBarrier b; b.bar = bar; b.x = xb_xcc_id(); b.st = st;
    if (threadIdx.x == 0) (void)xb_add(&bar[XB_XCNT(b.x)], 1u);
    return b;
}
__device__ __forceinline__ void xcd_barrier_complete(unsigned* bar, unsigned x, unsigned& nloc, unsigned& nx) {
    const unsigned G = gridDim.x * gridDim.y * gridDim.z;
    unsigned sum, cnt, mine, sp = 0u;
    for (;;) {
        sum = 0u; cnt = 0u; mine = 0u;
#pragma unroll
        for (unsigned j = 0; j < 16; ++j) { const unsigned c = xb_ld(&bar[XB_XCNT(j)]); sum += c; cnt += (c > 0u) ? 1u : 0u; mine = (j == x) ? c : mine; }
        if (sum == G) break;
        __builtin_amdgcn_s_sleep(1);
        if ((++sp & 255u) == 0u) { if (xb_ld(&bar[XB_TMO])) break; if (sp > XB_SPIN_CAP) { atomicAdd(&bar[XB_TMO], 1u); break; } }
    }
    nloc = mine > 0u ? mine : 1u; nx = cnt > 0u ? cnt : 1u;
}

__device__ __forceinline__ void xcd_barrier(const XcdBarrier& b) {
    asm volatile("s_waitcnt vmcnt(0)" ::: "memory");
    __syncthreads();
    if (threadIdx.x == 0) {
        unsigned* bar = b.bar;
        __builtin_amdgcn_s_waitcnt(0);
        unsigned nloc = b.st[0], nx = b.st[1];
        if (nloc == 0u) { xcd_barrier_complete(bar, b.x, nloc, nx); b.st[0] = nloc; b.st[1] = nx; }
        const unsigned old = xb_add(&bar[XB_XSUB(b.x)], 1u);
        const unsigned gen = old / nloc;
        if (old + 1u == (gen + 1u) * nloc) {
            __builtin_amdgcn_fence(__ATOMIC_RELEASE, "agent");
            asm volatile("s_waitcnt vmcnt(0)" ::: "memory");
            const unsigned og = xb_add(&bar[XB_TOP], 1u);
            const unsigned tg = og / nx;
            if (og + 1u == (tg + 1u) * nx) xb_add(&bar[XB_TOPGEN], 1u);
            else XB_SPIN(xb_ld(&bar[XB_TOPGEN]) == tg, bar);
            __builtin_amdgcn_fence(__ATOMIC_ACQUIRE, "agent");
            xb_add(&bar[XB_XGEN(b.x)], 1u);
            asm volatile("s_waitcnt vmcnt(0)" ::: "memory");
        } else {
            XB_SPIN(xb_ld(&bar[XB_XGEN(b.x)]) == gen, bar);
            __builtin_amdgcn_fence(__ATOMIC_ACQUIRE, "agent");
            asm volatile("s_waitcnt vmcnt(0)" ::: "memory");
        }
    }
    __syncthreads();
}

namespace pg8 {
template <class Fn> struct EpiFn {
    static constexpr bool PERM = true, AFTER_DRAIN = false;
    Fn f;
    __device__ __forceinline__ void operator()(const f32x4 (&acc)[2][2][4][2], const Unit& u, int wr, int wc, int fr, int fq) const {
        const int row0 = u.pm * BM + wr * 64 + fr, col0 = u.pn * BM + wc * 32 + 8 * fq;
#pragma unroll
        for (int ai = 0; ai < 2; ++ai)
#pragma unroll
            for (int m = 0; m < 4; ++m)
#pragma unroll
                for (int bj = 0; bj < 2; ++bj) f.e8(row0 + ai * HALF + m * 16, col0 + bj * HALF, acc[ai][bj][m][0], acc[ai][bj][m][1]);
    }
};
}

struct FnBf16 {
    bf16* O; int ld;
    __device__ __forceinline__ void e8(int row, int col, f32x4 a, f32x4 b) const {
        v4u w; w.x = pk2(a.x, a.y); w.y = pk2(a.z, a.w); w.z = pk2(b.x, b.y); w.w = pk2(b.z, b.w);
        *(v4u*)(O + (size_t)row * ld + col) = w;
    }
    __device__ __forceinline__ void e4(int row, int col, f32x4 a) const {
        v2u w; w.x = pk2(a.x, a.y); w.y = pk2(a.z, a.w);
        *(v2u*)(O + (size_t)row * ld + col) = w;
    }
};
struct FnResid {
    float* XS; const float* baseP; const float* baseS;
    __device__ __forceinline__ const float* brow(int row) const { return row < MP ? baseP + (size_t)row * DM : baseS + (size_t)(row - MP) * DM; }
    __device__ __forceinline__ void e8(int row, int col, f32x4 a, f32x4 b) const {
        const float* br = brow(row) + col; float* o = XS + (size_t)row * DM + col;
        const f32x4 x0 = *(const f32x4*)br, x1 = *(const f32x4*)(br + 4);
        *(f32x4*)o = x0 + a; *(f32x4*)(o + 4) = x1 + b;
    }
    __device__ __forceinline__ void e4(int row, int col, f32x4 a) const {
        const float* br = brow(row) + col; float* o = XS + (size_t)row * DM + col;
        *(f32x4*)o = *(const f32x4*)br + a;
    }
};
struct FnF32 {
    float* O; int ld;
    __device__ __forceinline__ void e8(int row, int col, f32x4 a, f32x4 b) const { float* o = O + (size_t)row * ld + col; *(f32x4*)o = a; *(f32x4*)(o + 4) = b; }
    __device__ __forceinline__ void e4(int row, int col, f32x4 a) const { *(f32x4*)(O + (size_t)row * ld + col) = a; }
};
struct FnKvq {
    float* O;
    __device__ __forceinline__ void e8(int row, int col, f32x4 a, f32x4 b) const {
        if (col < NKVQ_REAL) { float* o = O + (size_t)row * NKVQ + col; *(f32x4*)o = a; *(f32x4*)(o + 4) = b; }
    }
    __device__ __forceinline__ void e4(int row, int col, f32x4 a) const {
        if (col < NKVQ_REAL) *(f32x4*)(O + (size_t)row * NKVQ + col) = a;
    }
};

template <class Fn>
__device__ __forceinline__ void skinny_gemm(Frame& F, const bf16* A, const bf16* Bt, int N, int row_base, const Fn& fn) {
    const int fr = F.lane & 15, fq = F.lane >> 4;
    const int nun = N / 16;
    for (int u = F.bid; u < nun; u += F.G) {
        const bf16* ap = Bt + (size_t)(u * 16 + fr) * DM + fq * 8;
        const bf16* bp = A + (size_t)(F.wave * 16 + fr) * DM + fq * 8;
        f32x4 acc = {0.f, 0.f, 0.f, 0.f};
#pragma unroll 8
        for (int ks = 0; ks < 32; ++ks) acc = MFMA16(ld8(ap + ks * 32), ld8(bp + ks * 32), acc);
        fn.e4(row_base + F.wave * 16 + fr, u * 16 + 4 * fq, acc);
    }
}

template <class Fn>
__device__ __forceinline__ void gemm_all(Frame& F, const bf16* A, const bf16* Bt, int N, const Fn& fn) {
    pg8::Gemm g{A, Bt, MP, N, DM}; pg8::StaticOrder S; S.init(MP, N, F.G, F.bid);
    pg8::EpiFn<Fn> E{fn};
    pg8::gemm_phase<pg8::EpiFn<Fn>, pg8::StaticOrder, true, true>(F.lds, g, S, E);
    skinny_gemm(F, A + (size_t)MP * DM, Bt, N, MP, fn);
}

__device__ __forceinline__ void p0_transpose_item(const float* W, int N, bf16* WT, int row_off, const float* gain, LAS float* scr, int item, int lane) {
    const int nblk = (N + 31) / 32, kb = item / nblk, nb = item % nblk, k0 = 64 * kb, n0 = 32 * nb;
#pragma unroll 8
    for (int i = 0; i < 32; ++i) { const int kk = 2 * i + (lane >> 5); const int n = n0 + (lane & 31);
        float v = 0.f; if (n < N) { v = W[(size_t)(k0 + kk) * N + n]; if (gain) v *= gain[k0 + kk]; }
        scr[kk * 33 + (lane & 31)] = v; }
    LDS_WAIT(); asm volatile("" ::: "memory");
    const int c = lane & 7;
#pragma unroll
    for (int j = 0; j < 4; ++j) { const int n = (lane >> 3) + 8 * j; const LAS float* s = scr + (8 * c) * 33 + n;
        v4u o; o.x = pk2(s[0 * 33], s[1 * 33]); o.y = pk2(s[2 * 33], s[3 * 33]); o.z = pk2(s[4 * 33], s[5 * 33]); o.w = pk2(s[6 * 33], s[7 * 33]);
        if (n0 + n < N) *(v4u*)(WT + (size_t)(row_off + n0 + n) * DM + k0 + 8 * c) = o; }
    LDS_WAIT(); asm volatile("" ::: "memory");
}
__device__ __forceinline__ void rms_row_to_bf16(const float* xrow, bf16* orow, int lane) {
    const f32x4* xr = (const f32x4*)xrow + lane;
    f32x4 v[4]; float s = 0.f;
#pragma unroll
    for (int j = 0; j < 4; ++j) { v[j] = xr[64 * j]; s += (v[j].x * v[j].x + v[j].y * v[j].y) + (v[j].z * v[j].z + v[j].w * v[j].w); }
    const float rstd = 1.f / sqrtf(wave_sum(s) * (1.f / DM) + EPS);
    v2u* o8 = (v2u*)orow + lane;
#pragma unroll
    for (int j = 0; j < 4; ++j) { v2u w; w.x = pk2(v[j].x * rstd, v[j].y * rstd); w.y = pk2(v[j].z * rstd, v[j].w * rstd); o8[64 * j] = w; }
}
__device__ __forceinline__ const float* xin_row(Frame& F, int row) { return row < MP ? FIN(0) + (size_t)row * DM : FIN(1) + (size_t)(row - MP) * DM; }

__device__ __forceinline__ void p0_prologue(Frame& F) {
    LAS float* scr = (LAS float*)(F.lds + F.wave * 16384);
    const int gw = F.bid * 8 + F.wave, NGW = F.G * 8;
    const int gt = F.bid * 512 + F.tid, NGT = F.G * 512;
    {
        constexpr int I_IN = 128 * 16, I_OA = 32 * 16, I_KV = 48 * 16, I_QG = 34 * 16, I_OB = 32 * 16, I_PQ = 64 * 16;
        constexpr int NITEMS = I_IN + I_OA + I_KV + I_QG + I_OB + 2 * I_PQ;
        for (int it = gw; it < NITEMS; it += NGW) {
            int r = it;
            if (r < I_IN) {
                const int kb = r / 128, nb = r % 128, k0 = 64 * kb, n0 = 32 * nb; const float* W = FIN(8); const float* gain = FIN(7);
#pragma unroll 8
                for (int i = 0; i < 32; ++i) { const int kk = 2 * i + (F.lane >> 5); scr[kk * 33 + (F.lane & 31)] = W[(size_t)(k0 + kk) * GPROJ + n0 + (F.lane & 31)] * gain[k0 + kk]; }
                LDS_WAIT(); asm volatile("" ::: "memory");
                const int c = F.lane & 7;
#pragma unroll
                for (int j = 0; j < 4; ++j) { const int n = (F.lane >> 3) + 8 * j; const LAS float* s = scr + (8 * c) * 33 + n;
                    v4u o; o.x = pk2(s[0 * 33], s[1 * 33]); o.y = pk2(s[2 * 33], s[3 * 33]); o.z = pk2(s[4 * 33], s[5 * 33]); o.w = pk2(s[6 * 33], s[7 * 33]);
                    *(v4u*)(WSP(bf16, WS_WIN_T) + (size_t)(n0 + n) * DM + k0 + 8 * c) = o; }
                LDS_WAIT(); asm volatile("" ::: "memory");
                continue; }
            r -= I_IN;
            if (r < I_OA) { p0_transpose_item(FIN(13), 1024, WSP(bf16, WS_WOA_T), 0, nullptr, scr, r, F.lane); continue; } r -= I_OA;
            if (r < I_KV) { p0_transpose_item(FIN(15), NKV, WSP(bf16, WS_WKVQ_T), 0, FIN(14), scr, r, F.lane); continue; } r -= I_KV;
            if (r < I_QG) { p0_transpose_item(FIN(21), NQG, WSP(bf16, WS_WKVQ_T), NKV, FIN(20), scr, r, F.lane); continue; } r -= I_QG;
            if (r < I_OB) { p0_transpose_item(FIN(23), 1024, WSP(bf16, WS_WOB_T), 0, nullptr, scr, r, F.lane); continue; } r -= I_OB;
            if (r < I_PQ) { p0_transpose_item(FIN(25), 2048, WSP(bf16, WS_WPQ_T), 0, FIN(24), scr, r, F.lane); continue; } r -= I_PQ;
            p0_transpose_item(FIN(25) + (size_t)1024 * 2048, 2048, WSP(bf16, WS_WPQ_T) + (size_t)2048 * 1024, 0, FIN(24) + 1024, scr, r, F.lane);
        }
        for (int i = gt; i < (NKVQ - NKVQ_REAL) * DM / 8; i += NGT) ((v4u*)(WSP(bf16, WS_WKVQ_T) + (size_t)NKVQ_REAL * DM))[i] = (v4u){0u, 0u, 0u, 0u};
        for (int i = gt; i < 16 * 1024; i += NGT) { const int j = i >> 10, k = i & 1023; WSP(float, WS_WAB)[i] = FIN(7)[k] * FIN(8)[(size_t)k * GPROJ + 4096 + j]; }
    }
    for (int m = gw; m < MTOK; m += NGW) rms_row_to_bf16(xin_row(F, m), WSP(bf16, WS_XNA) + (size_t)m * DM, F.lane);
    {
        const size_t n8 = (size_t)2 * NEXP * DM / 8;
        for (int t = 0; t < 2; ++t) { const f32x4* src = (const f32x4*)FIN(27 + t); v2u* dst = (v2u*)WSP(unsigned char, t == 0 ? WS_PU : WS_PV); const float* pln = FIN(24);
            for (size_t i = gt; i < n8; i += NGT) { f32x4 a = src[2 * i], b = src[2 * i + 1];
                if (t == 0) { const float* gp = pln + ((i >> 21) << 10) + ((i & 127) << 3); a = a * *(const f32x4*)gp * 32.f; b = b * *(const f32x4*)(gp + 4) * 32.f; }
                else { a = a * 16.f; b = b * 16.f; }
                int w0 = __builtin_amdgcn_cvt_pk_fp8_f32(a.x, a.y, 0, false); w0 = __builtin_amdgcn_cvt_pk_fp8_f32(a.z, a.w, w0, true);
                int w1 = __builtin_amdgcn_cvt_pk_fp8_f32(b.x, b.y, 0, false); w1 = __builtin_amdgcn_cvt_pk_fp8_f32(b.z, b.w, w1, true);
                dst[i] = (v2u){(unsigned)w0, (unsigned)w1}; } }
        const f32x4* sk = (const f32x4*)FIN(26); v4u* dk = (v4u*)WSP(bf16, WS_SUBK);
        for (int i = gt; i < 2 * 8 * 2 * 128 * 128 / 8; i += NGT) { const f32x4 a = sk[2 * i], b = sk[2 * i + 1]; v4u w; w.x = pk2(a.x, a.y); w.y = pk2(a.z, a.w); w.z = pk2(b.x, b.y); w.w = pk2(b.z, b.w); dk[i] = w; }
    }
    for (int i = gt; i < 2 * 64 * 2048; i += NGT) { const int kv = i >> 17, hh = (i >> 11) & 63, k = i & 2047;
        WSP(bf16, WS_W1T)[i] = (bf16)f2bf(FIN(17)[((size_t)kv * 2048 + k) * 64 + hh]); }
    for (int it = gw; it < 128; it += NGW) { const int kv = it >> 6, h = it & 63; float s = 0.f;
        for (int k = F.lane; k < 2048; k += 64) s += FIN(18)[(size_t)kv * 2048 + k] * FIN(17)[((size_t)kv * 2048 + k) * 64 + h];
        s = wave_sum(s); if (F.lane == 0) WSP(float, WS_PETERM)[it] = s; }
    {
        const float* cache = FIN(2); const int* pt = (const int*)FIN(6); bf16* cka = WSP(bf16, WS_CKA);
        const int nitem = SB * PAST * 2 * 4 * 8;
        for (int i = gt; i < nitem; i += NGT) {
            const int d8 = i & 7, g = (i >> 3) & 3, kv = (i >> 5) & 1, t = (i >> 6) & 8191, bs = i >> 19;
            const float* src = cache + ((size_t)pt[bs * NPAGES + (t >> 7)] * PAGE + (t & 127)) * 1024 + kv * 256 + g * 64 + d8 * 8;
            const f32x4 a = *(const f32x4*)src, b = *(const f32x4*)(src + 4);
            v4u w; w.x = pk2(a.x, a.y); w.y = pk2(a.z, a.w); w.z = pk2(b.x, b.y); w.w = pk2(b.z, b.w);
            *(v4u*)(cka + ((size_t)((bs * 4 + g) * 512 + (t >> 4))) * 2048 + kv * 1024 + (t & 15) * 64 + d8 * 8) = w;
        }
        bf16* wbd = WSP(bf16, WS_W1BD);
        for (int i = gt; i < 256 * 2048; i += NGT) { const int n = i >> 11, col = i & 2047, kv = n >> 7, sec = (n >> 6) & 1, hh = n & 63;
            float v = 0.f; if ((col >> 10) == kv) { const int k = col & 1023, r = (k >> 6) + 16 * sec, d = k & 63; v = FIN(17)[(((size_t)kv * 32 + r) * 64 + d) * 64 + hh]; }
            wbd[i] = (bf16)f2bf(v); }
    }
    {
        const f32x4* src = (const f32x4*)FIN(3); f32x4* dst = (f32x4*)(F.out + O_WINS);
        const int per_b = 508 * 512 / 4;
        for (int i = gt; i < SB * per_b; i += NGT) { const int b = i / per_b, r = i % per_b; dst[(size_t)b * (512 * 512 / 4) + r] = src[(size_t)b * (512 * 512 / 4) + 4 * 512 / 4 + r]; }
    }
    for (int i = gt; i < SB * NG * 544 * 64; i += NGT) {
        const int d = i & 63, r = (i >> 6) % 544, bg = (i >> 6) / 544, g = bg & 3, b = bg >> 2;
        if (r < 512) { const float* cw = FIN(3) + (((size_t)b * 512 + r) * 2) * 256 + g * 64 + d;
            WSP(bf16, WS_SKWIN)[i] = (bf16)f2bf(cw[0]);
            WSP(bf16, WS_SVWINT)[((size_t)bg * 64 + d) * 544 + r] = (bf16)f2bf(cw[256]); }
        else if (r >= 516) { WSP(bf16, WS_SKWIN)[i] = 0; WSP(bf16, WS_SVWINT)[((size_t)bg * 64 + d) * 544 + r] = 0; }
    }
}

constexpr int P2_QS = 0, P2_KS = 17408, P2_KBGT = 34816, P2_VBT = 53248, P2_AM = 71680, P2_TB = 89088, P2_G = 98304, P2_TF = 99328, P2_XF = 116736;
constexpr int QS_LD = 136, KT_LD = 72, AM_LD = 68, TB_LD = 72;

__device__ __forceinline__ float softplus_f(float x) { return fmaxf(x, 0.f) + log1pf(expf(-fabsf(x))); }

__device__ __forceinline__ void p2_chunk(Frame& F, int unit) {
    const int c = unit & 127, h = (unit >> 7) & 7, b = unit >> 10;
    const int t0 = c * CHUNK, lane = F.lane, w = F.wave, fr = lane & 15, fq = lane >> 4;
    LAS unsigned char* L = F.lds; asm volatile("" : "+v"(L));
    LAS bf16* qs = (LAS bf16*)(L + P2_QS); LAS bf16* ks = (LAS bf16*)(L + P2_KS);
    LAS bf16* kbgT = (LAS bf16*)(L + P2_KBGT); LAS bf16* vbT = (LAS bf16*)(L + P2_VBT);
    LAS float* Am = (LAS float*)(L + P2_AM); LAS bf16* Tb = (LAS bf16*)(L + P2_TB);
    LAS float* Gs = (LAS float*)(L + P2_G);
    const bf16* PROJ = WSP(bf16, WS_PROJ); const bf16* XNA = WSP(bf16, WS_XNA); const float* WAB = WSP(float, WS_WAB);
    const size_t rowb = (size_t)b * PT;
    float beta_r[8];
    {
        f32x4 wa[4], wb[4];
        const float* pa = WAB + (size_t)h * DM + 8 * lane; const float* pb = WAB + (size_t)(8 + h) * DM + 8 * lane;
        wa[0] = *(const f32x4*)pa; wa[1] = *(const f32x4*)(pa + 4); wa[2] = *(const f32x4*)(pa + 512); wa[3] = *(const f32x4*)(pa + 516);
        wb[0] = *(const f32x4*)pb; wb[1] = *(const f32x4*)(pb + 4); wb[2] = *(const f32x4*)(pb + 512); wb[3] = *(const f32x4*)(pb + 516);
        const float Aneg = -expf(FIN(10)[h]), dtb = FIN(11)[h];
#pragma unroll
        for (int tk = 0; tk < 8; ++tk) {
            const int tok = 8 * w + tk; const bf16* xr = XNA + (rowb + t0 + tok) * DM + 8 * lane;
            const v4u x0 = *(const v4u*)xr, x1 = *(const v4u*)(xr + 512);
            float sa = 0.f, sb = 0.f;
#define ACC2(xw, wv0, wv1, i0) { const float lo = bflo(xw), hi = bfhi(xw); sa += lo * wv0[i0] + hi * wv0[i0 + 1]; sb += lo * wv1[i0] + hi * wv1[i0 + 1]; }
            ACC2(x0.x, wa[0], wb[0], 0) ACC2(x0.y, wa[0], wb[0], 2) ACC2(x0.z, wa[1], wb[1], 0) ACC2(x0.w, wa[1], wb[1], 2)
            ACC2(x1.x, wa[2], wb[2], 0) ACC2(x1.y, wa[2], wb[2], 2) ACC2(x1.z, wa[3], wb[3], 0) ACC2(x1.w, wa[3], wb[3], 2)
#undef ACC2
            sa = wave_sum(sa); sb = wave_sum(sb);
            const float g = Aneg * softplus_f(sa + dtb), be = 1.f / (1.f + expf(-sb));
            beta_r[tk] = be;
            if (lane == 0) { Gs[tok] = g; Gs[64 + tok] = be; }
        }
    }
#pragma unroll
    for (int p = 0; p < 3; ++p) {
        const int col0 = p * 1024 + h * 128 + 2 * lane;
        float cw0[4], cw1[4];
#pragma unroll
        for (int i = 0; i < 4; ++i) { const f32x2 cv = *(const f32x2*)(FIN(9) + (size_t)i * GCONV + col0); cw0[i] = cv.x; cw1[i] = cv.y; }
        unsigned xw[11];
#pragma unroll
        for (int rr = 0; rr < 11; ++rr) { const int t = t0 + 8 * w - 3 + rr; xw[rr] = (t >= 0) ? *(const unsigned*)(PROJ + (rowb + t) * 4096 + col0) : 0u; }
        if (c == 127 && w == 7) {
#pragma unroll
            for (int r = 0; r < 3; ++r) { float* o = F.out + O_CONVP + ((size_t)b * 3 + r) * GCONV + col0; o[0] = bflo(xw[8 + r]); o[1] = bfhi(xw[8 + r]); }
        }
#pragma unroll
        for (int tk = 0; tk < 8; ++tk) {
            const int tok = 8 * w + tk;
            float y0 = 0.f, y1 = 0.f;
#pragma unroll
            for (int i = 0; i < 4; ++i) { y0 += cw0[i] * bflo(xw[tk + i]); y1 += cw1[i] * bfhi(xw[tk + i]); }
            y0 = silu_f(y0); y1 = silu_f(y1);
            if (p < 2) {
                const float ss = wave_sum(y0 * y0 + y1 * y1);
                const float rs = (1.f / sqrtf(ss + EPS)) * (p == 0 ? 0.08838834764831845f : 1.f);
                *(LAS unsigned*)((p == 0 ? qs : ks) + tok * QS_LD + 2 * lane) = pk2(y0 * rs, y1 * rs);
            } else {
                vbT[(2 * lane) * KT_LD + tok] = (bf16)f2bf(y0 * beta_r[tk]); vbT[(2 * lane + 1) * KT_LD + tok] = (bf16)f2bf(y1 * beta_r[tk]);
            }
        }
    }
    __syncthreads();
    if (w == 0) { float g = Gs[lane];
#pragma unroll
        for (int o = 1; o < 64; o <<= 1) { const float up = __shfl_up(g, o); if (lane >= o) g += up; }
        Gs[128 + lane] = g; }
    __syncthreads();
    const float glast = Gs[128 + 63];
    const size_t chunk = (size_t)unit;
    if (w < 4) {
        const int mt = w;
        bf16x8 a[4];
#pragma unroll
        for (int kk = 0; kk < 4; ++kk) a[kk] = ld8l(ks + (16 * mt + fr) * QS_LD + 32 * kk + 8 * fq);
#pragma unroll
        for (int nt = 0; nt < 4; ++nt) {
            f32x4 acc = {0.f, 0.f, 0.f, 0.f};
            if (nt <= mt) {
#pragma unroll
                for (int kk = 0; kk < 4; ++kk) acc = MFMA16(a[kk], ld8l(ks + (16 * nt + fr) * QS_LD + 32 * kk + 8 * fq), acc);
            }
            const int j = 16 * nt + fr; const float gj = Gs[128 + j];
#pragma unroll
            for (int r = 0; r < 4; ++r) { const int i = 16 * mt + 4 * fq + r;
                Am[i * AM_LD + j] = (i > j) ? Gs[64 + i] * acc[r] * __expf(Gs[128 + i] - gj) : 0.f; }
        }
    } else {
        const int nt = w - 4;
        bf16x8 bq[4];
#pragma unroll
        for (int kk = 0; kk < 4; ++kk) bq[kk] = ld8l(qs + (16 * nt + fr) * QS_LD + 32 * kk + 8 * fq);
        const int i = 16 * nt + fr; const float gi = Gs[128 + i];
        bf16* gqk = WSP(bf16, WS_GQK) + chunk * 4096 + (size_t)i * 64;
#pragma unroll
        for (int mt = 0; mt < 4; ++mt) {
            f32x4 acc = {0.f, 0.f, 0.f, 0.f};
            if (mt <= nt) {
#pragma unroll
                for (int kk = 0; kk < 4; ++kk) acc = MFMA16(ld8l(ks + (16 * mt + fr) * QS_LD + 32 * kk + 8 * fq), bq[kk], acc);
            }
            float v[4];
#pragma unroll
            for (int r = 0; r < 4; ++r) { const int j = 16 * mt + 4 * fq + r; v[r] = (i >= j) ? acc[r] * __expf(gi - Gs[128 + j]) : 0.f; }
            v2u o; o.x = pk2(v[0], v[1]); o.y = pk2(v[2], v[3]);
            *(v2u*)(gqk + 16 * mt + 4 * fq) = o;
        }
    }
    {
        const int tok = F.tid >> 3, d0 = (F.tid & 7) * 16; const float e = __expf(Gs[128 + tok]);
        bf16* gq = WSP(bf16, WS_GQ) + chunk * 8192 + (size_t)tok * 128 + d0;
#pragma unroll
        for (int hh = 0; hh < 2; ++hh) { const v4u q = *(const LAS v4u*)(qs + tok * QS_LD + d0 + 8 * hh); v4u o;
            o.x = pk2(bflo(q.x) * e, bfhi(q.x) * e); o.y = pk2(bflo(q.y) * e, bfhi(q.y) * e); o.z = pk2(bflo(q.z) * e, bfhi(q.z) * e); o.w = pk2(bflo(q.w) * e, bfhi(q.w) * e);
            *(v4u*)(gq + 8 * hh) = o; }
    }
    {
        const int dk = F.tid & 127, tg = F.tid >> 7;
        unsigned o1[8], o2[8];
#pragma unroll
        for (int i = 0; i < 8; ++i) {
            const int ta = 16 * tg + 2 * i, tb2 = ta + 1;
            const float ka = bf2f(ks[ta * QS_LD + dk]), kb = bf2f(ks[tb2 * QS_LD + dk]);
            const float ga = Gs[128 + ta], gb = Gs[128 + tb2];
            o1[i] = pk2(ka * Gs[64 + ta] * __expf(ga), kb * Gs[64 + tb2] * __expf(gb));
            o2[i] = pk2(ka * __expf(glast - ga), kb * __expf(glast - gb));
        }
        LAS v4u* d1 = (LAS v4u*)(kbgT + dk * KT_LD + 16 * tg); d1[0] = (v4u){o1[0], o1[1], o1[2], o1[3]}; d1[1] = (v4u){o1[4], o1[5], o1[6], o1[7]};
        v4u* d2 = (v4u*)(WSP(bf16, WS_GKT) + chunk * 8192 + (size_t)dk * 64 + 16 * tg); d2[0] = (v4u){o2[0], o2[1], o2[2], o2[3]}; d2[1] = (v4u){o2[4], o2[5], o2[6], o2[7]};
    }
    if (F.tid == 0) WSP(float, WS_GDEC)[chunk] = __expf(glast);
    __syncthreads();
    LAS float* Tf = (LAS float*)(L + P2_TF); LAS float* Xf = (LAS float*)(L + P2_XF);
    if (w == 0) {
        const int blk = lane >> 5, cc = lane & 31; const LAS float* Ab = Am + (32 * blk) * AM_LD + 32 * blk;
        float t[32];
#pragma unroll
        for (int i = 0; i < 32; ++i) {
            float acc0 = (i == cc) ? 1.f : 0.f, acc1 = 0.f;
#pragma unroll
            for (int j4 = 0; j4 < (i + 3) / 4; ++j4) {
                const f32x4 a = *(const LAS f32x4*)(Ab + i * AM_LD + 4 * j4);
                if (4 * j4 + 0 < i) acc0 = __builtin_fmaf(-a.x, t[4 * j4 + 0], acc0);
                if (4 * j4 + 1 < i) acc1 = __builtin_fmaf(-a.y, t[4 * j4 + 1], acc1);
                if (4 * j4 + 2 < i) acc0 = __builtin_fmaf(-a.z, t[4 * j4 + 2], acc0);
                if (4 * j4 + 3 < i) acc1 = __builtin_fmaf(-a.w, t[4 * j4 + 3], acc1);
            }
            t[i] = acc0 + acc1;
            asm volatile("" : "+v"(t[i]));
            __builtin_amdgcn_sched_barrier(0);
        }
#pragma unroll
        for (int i = 0; i < 32; ++i) { Tf[(32 * blk + i) * AM_LD + 32 * blk + cc] = t[i]; if (blk == 0) Tf[i * AM_LD + 32 + cc] = 0.f; }
    }
    __syncthreads();
    {
        const int i = F.tid >> 4, c0 = (F.tid & 15) * 2; float x0 = 0.f, x1 = 0.f;
#pragma unroll 8
        for (int k = 0; k < 32; ++k) { const float a = Am[(32 + i) * AM_LD + k]; x0 = __builtin_fmaf(a, Tf[k * AM_LD + c0], x0); x1 = __builtin_fmaf(a, Tf[k * AM_LD + c0 + 1], x1); }
        Xf[i * 34 + c0] = x0; Xf[i * 34 + c0 + 1] = x1;
    }
    __syncthreads();
    {
        const int i = F.tid >> 4, c0 = (F.tid & 15) * 2; float x0 = 0.f, x1 = 0.f;
#pragma unroll 8
        for (int k = 0; k < 32; ++k) { const float a = Tf[(32 + i) * AM_LD + 32 + k]; x0 = __builtin_fmaf(a, Xf[k * 34 + c0], x0); x1 = __builtin_fmaf(a, Xf[k * 34 + c0 + 1], x1); }
        Tf[(32 + i) * AM_LD + c0] = -x0; Tf[(32 + i) * AM_LD + c0 + 1] = -x1;
    }
    __syncthreads();
    {
        const int i = F.tid >> 3, c0 = (F.tid & 7) * 8; const f32x4 a = *(const LAS f32x4*)(Tf + i * AM_LD + c0), b2 = *(const LAS f32x4*)(Tf + i * AM_LD + c0 + 4);
        *(LAS v4u*)(Tb + i * TB_LD + c0) = (v4u){pk2(a.x, a.y), pk2(a.z, a.w), pk2(b2.x, b2.y), pk2(b2.z, b2.w)};
    }
    __syncthreads();
    {
        bf16x8 tb[4][2];
#pragma unroll
        for (int x = 0; x < 4; ++x)
#pragma unroll
            for (int s = 0; s < 2; ++s) tb[x][s] = ld8l(Tb + (16 * x + fr) * TB_LD + 32 * s + 8 * fq);
        const bf16x8 bv0 = ld8l(vbT + (16 * w + fr) * KT_LD + 8 * fq), bv1 = ld8l(vbT + (16 * w + fr) * KT_LD + 32 + 8 * fq);
        f32x4* gu = (f32x4*)(WSP(float, WS_GU) + chunk * 8192) + (size_t)w * 256 + lane;
#pragma unroll
        for (int mt = 0; mt < 4; ++mt) { f32x4 acc = {0.f, 0.f, 0.f, 0.f}; acc = MFMA16(tb[mt][0], bv0, acc); acc = MFMA16(tb[mt][1], bv1, acc); gu[mt * 64] = acc; }
        const bf16x8 ak0 = ld8l(kbgT + (16 * w + fr) * KT_LD + 8 * fq), ak1 = ld8l(kbgT + (16 * w + fr) * KT_LD + 32 + 8 * fq);
        bf16* gw = WSP(bf16, WS_GW) + chunk * 8192;
#pragma unroll
        for (int nt = 0; nt < 4; ++nt) { f32x4 acc = {0.f, 0.f, 0.f, 0.f}; acc = MFMA16(ak0, tb[nt][0], acc); acc = MFMA16(ak1, tb[nt][1], acc);
            v2u o; o.x = pk2(acc[0], acc[1]); o.y = pk2(acc[2], acc[3]);
            *(v2u*)(gw + (size_t)(16 * nt + fr) * 128 + 16 * w + 4 * fq) = o; }
    }
    __syncthreads();
}

constexpr int S2_Y = 0;
constexpr int S2_AB = 6144;
constexpr int S2_DOT = 6400;
constexpr int S2_U = 6656;
constexpr int S2_W = 8704;
constexpr int S2_VN = 10752;
__device__ __forceinline__ void p2_sample(Frame& F, int unit) {
    const int h = unit & 7, bs = unit >> 3, tid = F.tid, lane = F.lane, w = F.wave;
    LAS unsigned char* L = F.lds; asm volatile("" : "+v"(L));
    LAS float* Y = (LAS float*)(L + S2_Y); LAS float* AB = (LAS float*)(L + S2_AB); LAS float* DOT = (LAS float*)(L + S2_DOT);
    LAS float* U = (LAS float*)(L + S2_U); LAS float* W = (LAS float*)(L + S2_W); LAS float* VN = (LAS float*)(L + S2_VN);
    const bf16* PROJ = WSP(bf16, WS_PROJ); const bf16* XNA = WSP(bf16, WS_XNA); const float* WAB = WSP(float, WS_WAB);
    const size_t row0 = (size_t)MP + bs * 4;
    if (tid < 384) {
        const int part = tid >> 7, cc = tid & 127, col = part * 1024 + h * 128 + cc;
        float buf[7];
#pragma unroll
        for (int r = 0; r < 3; ++r) buf[r] = FIN(5)[((size_t)bs * 3 + r) * GCONV + col];
#pragma unroll
        for (int i = 0; i < 4; ++i) buf[3 + i] = bf2f(PROJ[(row0 + i) * 4096 + col]);
#pragma unroll
        for (int r = 0; r < 3; ++r) F.out[O_CONVS + ((size_t)bs * 3 + r) * GCONV + col] = buf[4 + r];
        float cw[4];
#pragma unroll
        for (int i = 0; i < 4; ++i) cw[i] = FIN(9)[(size_t)i * GCONV + col];
#pragma unroll
        for (int i = 0; i < 4; ++i) { float y = 0.f;
#pragma unroll
            for (int k = 0; k < 4; ++k) y += cw[k] * buf[i + k];
            Y[(part * 4 + i) * 128 + cc] = silu_f(y); }
    }
    {
        const int i = w >> 1, which = w & 1; const bf16* xr = XNA + (row0 + i) * DM; const float* wr = WAB + (size_t)(which * 8 + h) * DM; float s = 0.f;
        for (int k = lane; k < DM; k += 64) s += bf2f(xr[k]) * wr[k];
        s = wave_sum(s); if (lane == 0) AB[which * 4 + i] = s;
    }
    __syncthreads();
    {
        const int part = w >> 2, i = w & 3; LAS float* y = Y + (part * 4 + i) * 128; const float a = y[lane], bq = y[64 + lane];
        const float ss = wave_sum(a * a + bq * bq); const float rs = (1.f / sqrtf(ss + EPS)) * (part == 0 ? 0.08838834764831845f : 1.f);
        y[lane] = a * rs; y[64 + lane] = bq * rs;
    }
    if (tid == 0) { const float Aneg = -expf(FIN(10)[h]), dtb = FIN(11)[h]; float gc = 0.f;
        for (int i = 0; i < 4; ++i) { const float g = Aneg * softplus_f(AB[i] + dtb); gc += g; AB[8 + i] = g; AB[12 + i] = 1.f / (1.f + expf(-AB[4 + i])); AB[16 + i] = gc; } }
    __syncthreads();
    {
#pragma unroll
        for (int pp = 0; pp < 4; ++pp) { const int pr = 4 * w + pp, which = pr >> 4, i = (pr >> 2) & 3, j = pr & 3;
            const LAS float* x = Y + ((which == 0 ? 1 : 0) * 4 + i) * 128; const LAS float* y = Y + (1 * 4 + j) * 128;
            float s = x[lane] * y[lane] + x[64 + lane] * y[64 + lane]; s = wave_sum(s); if (lane == 0) DOT[pr] = s; }
    }
    __syncthreads();
    float g_[4], be[4], gc[4];
#pragma unroll
    for (int i = 0; i < 4; ++i) { g_[i] = AB[8 + i]; be[i] = AB[12 + i]; gc[i] = AB[16 + i]; }
    float Tm[4][4];
    {
        float A[4][4];
#pragma unroll
        for (int i = 0; i < 4; ++i)
#pragma unroll
            for (int j = 0; j < 4; ++j) A[i][j] = (i > j) ? be[i] * DOT[i * 4 + j] * expf(gc[i] - gc[j]) : 0.f;
#pragma unroll
        for (int cc = 0; cc < 4; ++cc)
#pragma unroll
            for (int i = 0; i < 4; ++i) { float acc = (i == cc) ? 1.f : 0.f;
#pragma unroll
                for (int j = 0; j < 4; ++j) if (j < i) acc -= A[i][j] * Tm[j][cc];
                Tm[i][cc] = acc; }
    }
    {
        const int i = tid >> 7, x = tid & 127; float su = 0.f, sw = 0.f;
#pragma unroll
        for (int j = 0; j < 4; ++j) { su += Tm[i][j] * Y[(2 * 4 + j) * 128 + x] * be[j]; sw += Tm[i][j] * Y[(1 * 4 + j) * 128 + x] * be[j] * expf(gc[j]); }
        U[i * 128 + x] = su; W[i * 128 + x] = sw;
    }
    __syncthreads();
    const float* S0 = FIN(4) + ((size_t)bs * GH + h) * 128 * 128;
    float qs_acc;
    {
        const int i = tid >> 7, dv = tid & 127; float p = 0.f, qq = 0.f;
        const LAS float* wr = W + i * 128; const LAS float* qr = Y + (0 * 4 + i) * 128;
        for (int dk = 0; dk < 128; ++dk) { const float s = S0[(size_t)dk * 128 + dv]; p += wr[dk] * s; qq += qr[dk] * s; }
        VN[i * 128 + dv] = U[i * 128 + dv] - p; qs_acc = qq * expf(gc[i]);
    }
    __syncthreads();
    {
        const int i = tid >> 7, dv = tid & 127; float o = qs_acc;
#pragma unroll
        for (int j = 0; j < 4; ++j) if (j <= i) o += DOT[16 + i * 4 + j] * expf(gc[i] - gc[j]) * VN[j * 128 + dv];
        WSP(float, WS_OGDN)[(row0 + i) * DM + h * 128 + dv] = o;
    }
    {
        const int dv = tid & 127, dg = tid >> 7; const float el = expf(gc[3]);
        float kd[4], vn[4];
#pragma unroll
        for (int j = 0; j < 4; ++j) { kd[j] = expf(gc[3] - gc[j]); vn[j] = VN[j * 128 + dv]; }
        float* So = F.out + O_GDNS + ((size_t)bs * GH + h) * 128 * 128;
        for (int dk = dg * 32; dk < dg * 32 + 32; ++dk) { float s = S0[(size_t)dk * 128 + dv] * el;
#pragma unroll
            for (int j = 0; j < 4; ++j) s += Y[(1 * 4 + j) * 128 + dk] * kd[j] * vn[j];
            So[(size_t)dk * 128 + dv] = s; }
    }
    (void)g_;
    __syncthreads();
}

constexpr int P3_S = 0;
constexpr int P3_VN = 8192;
__device__ __forceinline__ void p3_scan(Frame& F, int bh, int s) {
    const int lane = F.lane, w = F.wave, fr = lane & 15, fq = lane >> 4;
    const int b = bh >> 3, h = bh & 7;
    LAS bf16* Sl = (LAS bf16*)(F.lds + P3_S); LAS bf16* Vl = (LAS bf16*)(F.lds + P3_VN);
    const bf16* GW = WSP(bf16, WS_GW); const bf16* GQ = WSP(bf16, WS_GQ); const bf16* GKT = WSP(bf16, WS_GKT); const bf16* GQK = WSP(bf16, WS_GQK);
    const float* GU = WSP(float, WS_GU); const float* GDEC = WSP(float, WS_GDEC);
    float* OG = WSP(float, WS_OGDN);
    f32x4 Sacc = {0.f, 0.f, 0.f, 0.f};
    { v2u z = {0u, 0u}; *(LAS v2u*)(Sl + fr * 136 + 16 * w + 4 * fq) = z; }
    __syncthreads();
    const int m = w & 3;
    bf16x8 a1n[4], akn0, akn1, aqn0 = {}, aqn1 = {}; f32x4 u4n = {0.f, 0.f, 0.f, 0.f}; float decn;
#define P3_FETCH(cc) do { const size_t ch_ = (size_t)bh * NCH + (cc); \
        const bf16* p1_ = (w < 4 ? GW : GQ) + ch_ * 8192 + (size_t)(16 * m + fr) * 128 + 8 * fq; \
        _Pragma("unroll") for (int k_ = 0; k_ < 4; ++k_) a1n[k_] = ld8(p1_ + 32 * k_); \
        const bf16* pk_ = GKT + ch_ * 8192 + (size_t)(16 * w + fr) * 64 + 8 * fq; akn0 = ld8(pk_); akn1 = ld8(pk_ + 32); \
        if (w >= 4) { const bf16* pq_ = GQK + ch_ * 4096 + (size_t)(16 * m + fr) * 64 + 8 * fq; aqn0 = ld8(pq_); aqn1 = ld8(pq_ + 32); } \
        else u4n = *((const f32x4*)(GU + ch_ * 8192) + (size_t)s * 256 + m * 64 + lane); \
        decn = GDEC[ch_]; } while (0)
    P3_FETCH(0);
    for (int c = 0; c < NCH; ++c) {
        bf16x8 a1[4];
#pragma unroll
        for (int k = 0; k < 4; ++k) a1[k] = a1n[k];
        const bf16x8 ak0 = akn0, ak1 = akn1, aq0 = aqn0, aq1 = aqn1; const f32x4 u4 = u4n; const float dec = decn;
        if (c + 1 < NCH) P3_FETCH(c + 1);
        f32x4 acc = {0.f, 0.f, 0.f, 0.f};
#pragma unroll
        for (int k = 0; k < 4; ++k) acc = MFMA16(a1[k], ld8l(Sl + fr * 136 + 32 * k + 8 * fq), acc);
        if (w < 4) { const f32x4 vn = u4 - acc; v2u o; o.x = pk2(vn[0], vn[1]); o.y = pk2(vn[2], vn[3]); *(LAS v2u*)(Vl + fr * 72 + 16 * m + 4 * fq) = o; }
        asm volatile("s_waitcnt lgkmcnt(0)\n\ts_barrier" ::: "memory");
        const bf16x8 v0 = ld8l(Vl + fr * 72 + 8 * fq), v1 = ld8l(Vl + fr * 72 + 32 + 8 * fq);
        if (w >= 4) { acc = MFMA16(aq0, v0, acc); acc = MFMA16(aq1, v1, acc);
            float* o = OG + ((size_t)b * PT + c * CHUNK + 16 * m + 4 * fq) * DM + h * 128 + 16 * s + fr;
#pragma unroll
            for (int r = 0; r < 4; ++r) o[(size_t)r * DM] = acc[r]; }
        Sacc = Sacc * dec; Sacc = MFMA16(ak0, v0, Sacc); Sacc = MFMA16(ak1, v1, Sacc);
        { v2u o; o.x = pk2(Sacc[0], Sacc[1]); o.y = pk2(Sacc[2], Sacc[3]); *(LAS v2u*)(Sl + fr * 136 + 16 * w + 4 * fq) = o; }
        asm volatile("s_waitcnt lgkmcnt(0)\n\ts_barrier" ::: "memory");
    }
#undef P3_FETCH
    float* So = F.out + O_GDNP + ((size_t)bh * 128) * 128;
#pragma unroll
    for (int r = 0; r < 4; ++r) So[(size_t)(16 * w + 4 * fq + r) * 128 + 16 * s + fr] = Sacc[r];
}

__device__ __forceinline__ void p4_row(Frame& F, int row) {
    const int lane = F.lane;
    const float* o = WSP(float, WS_OGDN) + (size_t)row * DM + 16 * lane;
    const bf16* z = WSP(bf16, WS_PROJ) + (size_t)row * 4096 + 3072 + 16 * lane;
    f32x4 v[4]; float ss = 0.f;
#pragma unroll
    for (int j = 0; j < 4; ++j) { v[j] = *(const f32x4*)(o + 4 * j); ss += (v[j].x * v[j].x + v[j].y * v[j].y) + (v[j].z * v[j].z + v[j].w * v[j].w); }
    ss += __shfl_xor(ss, 1); ss += __shfl_xor(ss, 2); ss += __shfl_xor(ss, 4);
    const float rstd = 1.f / sqrtf(ss * (1.f / 128.f) + EPS);
    const v4u z0 = *(const v4u*)z, z1 = *(const v4u*)(z + 8);
    const float* gn = FIN(12) + (16 * lane & 127);
    float zz[16] = {bflo(z0.x), bfhi(z0.x), bflo(z0.y), bfhi(z0.y), bflo(z0.z), bfhi(z0.z), bflo(z0.w), bfhi(z0.w),
                    bflo(z1.x), bfhi(z1.x), bflo(z1.y), bfhi(z1.y), bflo(z1.z), bfhi(z1.z), bflo(z1.w), bfhi(z1.w)};
    unsigned ow[8];
#pragma unroll
    for (int j = 0; j < 8; ++j) { const float a = v[j >> 1][(2 * j) & 3] * rstd * gn[2 * j] * silu_f(zz[2 * j]), bq = v[j >> 1][(2 * j + 1) & 3] * rstd * gn[2 * j + 1] * silu_f(zz[2 * j + 1]); ow[j] = pk2(a, bq); }
    v4u* dst = (v4u*)(WSP(bf16, WS_OG) + (size_t)row * DM + 16 * lane);
    dst[0] = (v4u){ow[0], ow[1], ow[2], ow[3]}; dst[1] = (v4u){ow[4], ow[5], ow[6], ow[7]};
}

typedef __bf16 bf16x2_t __attribute__((ext_vector_type(2)));
__device__ __forceinline__ float dot2_bf16(unsigned w, unsigned x, float acc) { return __builtin_amdgcn_fdot2_f32_bf16(__builtin_bit_cast(bf16x2_t, w), __builtin_bit_cast(bf16x2_t, x), acc, false); }
__device__ __forceinline__ float u2f(unsigned u) { return __builtin_bit_cast(float, u); }
__device__ __forceinline__ unsigned f2u(float f) { return __builtin_bit_cast(unsigned, f); }

constexpr int P8_TOP = 0;
constexpr int P8_TAB = 16384;
__device__ __forceinline__ void p8_init_tab(Frame& F) {
    LAS unsigned char* tab = F.lds + P8_TAB;
    if (F.tid < 50) { const int k = F.tid; int i, j;
        if (k < 16) { i = 0; j = k; } else if (k < 24) { i = 1; j = k - 16; } else if (k < 29) { i = 2; j = k - 24; } else if (k < 33) { i = 3; j = k - 29; }
        else if (k < 36) { i = 4; j = k - 33; } else if (k < 38) { i = 5; j = k - 36; } else if (k < 40) { i = 6; j = k - 38; } else if (k < 42) { i = 7; j = k - 40; } else { i = k - 34; j = 0; }
        tab[k] = (unsigned char)i; tab[64 + k] = (unsigned char)j; }
    __syncthreads();
}
__device__ __forceinline__ void p8_unit(Frame& F, int unit, int layer) {
    const int lane = F.lane, w = F.wave, fr = lane & 15, fq = lane >> 4;
    LAS unsigned char* L = F.lds; asm volatile("" : "+v"(L));
    LAS unsigned* topl = (LAS unsigned*)(L + P8_TOP + w * 2048);
    const LAS unsigned char* tab = L + P8_TAB;
    const int r0 = unit * 16;
    const bf16* Q = WSP(bf16, WS_QPEER) + (size_t)(r0 + fr) * 2048 + w * 256 + 8 * fq;
    const bf16* SK = WSP(bf16, WS_SUBK) + (size_t)((layer * 8 + w) * 2) * 16384 + (size_t)fr * 128 + 8 * fq;
    const float NEGINF = -__builtin_inff();
#pragma unroll 1
    for (int p = 0; p < 2; ++p) {
        bf16x8 bq[4];
#pragma unroll
        for (int ks = 0; ks < 4; ++ks) bq[ks] = ld8(Q + p * 128 + 32 * ks);
        float v[32];
#pragma unroll
        for (int mt = 0; mt < 8; ++mt) { f32x4 acc = {0.f, 0.f, 0.f, 0.f};
#pragma unroll
            for (int ks = 0; ks < 4; ++ks) acc = MFMA16(ld8(SK + (size_t)p * 16384 + (size_t)mt * 2048 + 32 * ks), bq[ks], acc);
#pragma unroll
            for (int r = 0; r < 4; ++r) v[4 * mt + r] = u2f((f2u(acc[r]) & ~127u) | (unsigned)(16 * mt + 4 * fq + r)); }
#pragma unroll 1
        for (int rd = 0; rd < 16; ++rd) {
            float m = v[0];
#pragma unroll
            for (int i = 1; i < 32; ++i) m = fmaxf(m, v[i]);
            m = fmaxf(m, __shfl_xor(m, 16)); m = fmaxf(m, __shfl_xor(m, 32));
#pragma unroll
            for (int i = 0; i < 32; ++i) v[i] = (f2u(v[i]) == f2u(m)) ? NEGINF : v[i];
            if (fq == 0) topl[(fr * 2 + p) * 16 + rd] = f2u(m);
        }
    }
    LDS_WAIT();
    float c[13];
#pragma unroll
    for (int m = 0; m < 13; ++m) { const int k = fq + 4 * m; float cv = NEGINF;
        if (k < 50) { const int i = tab[k], j = tab[64 + k]; const float s1 = u2f(topl[(fr * 2 + 0) * 16 + i] & ~127u), s2 = u2f(topl[(fr * 2 + 1) * 16 + j] & ~127u);
            cv = u2f((f2u(s1 + s2) & ~63u) | (unsigned)k); }
        c[m] = cv; }
    float win[16];
#pragma unroll
    for (int rd = 0; rd < 16; ++rd) {
        float m = c[0];
#pragma unroll
        for (int i = 1; i < 13; ++i) m = fmaxf(m, c[i]);
        m = fmaxf(m, __shfl_xor(m, 16)); m = fmaxf(m, __shfl_xor(m, 32));
#pragma unroll
        for (int i = 0; i < 13; ++i) c[i] = (f2u(c[i]) == f2u(m)) ? NEGINF : c[i];
        win[rd] = m;
    }
    float den = 0.f, ex[16];
#pragma unroll
    for (int rd = 0; rd < 16; ++rd) { ex[rd] = __expf(win[rd] - win[0]); den += ex[rd]; }
    const float inv = 1.f / den;
    if (fq == 0) {
        int* pei = WSP(int, WS_PEI) + (size_t)(r0 + fr) * 128 + w * 16; float* peg = WSP(float, WS_PEG) + (size_t)(r0 + fr) * 128 + w * 16;
#pragma unroll
        for (int q4 = 0; q4 < 4; ++q4) { int e[4]; float g[4];
#pragma unroll
            for (int x = 0; x < 4; ++x) { const int rd = 4 * q4 + x; const int k = (int)(f2u(win[rd]) & 63u); const int i = tab[k], j = tab[64 + k];
                e[x] = (int)(topl[(fr * 2 + 0) * 16 + i] & 127u) * 128 + (int)(topl[(fr * 2 + 1) * 16 + j] & 127u); g[x] = ex[rd] * inv; }
            *(v4u*)(pei + 4 * q4) = (v4u){(unsigned)e[0], (unsigned)e[1], (unsigned)e[2], (unsigned)e[3]};
            *(f32x4*)(peg + 4 * q4) = (f32x4){g[0], g[1], g[2], g[3]}; }
    }
}

typedef float f32x2_t __attribute__((ext_vector_type(2)));
#define P9_DOT4(w, h0, h1, h2, h3, acc) { const f32x2_t lo_ = __builtin_amdgcn_cvt_pk_f32_fp8((int)(w), false), hi_ = __builtin_amdgcn_cvt_pk_f32_fp8((int)(w), true); \
        acc = __builtin_fmaf(lo_.x, h0, acc); acc = __builtin_fmaf(lo_.y, h1, acc); acc = __builtin_fmaf(hi_.x, h2, acc); acc = __builtin_fmaf(hi_.y, h3, acc); }
#define P9_AXPY4(w, c, o0, o1, o2, o3) { const f32x2_t lo_ = __builtin_amdgcn_cvt_pk_f32_fp8((int)(w), false), hi_ = __builtin_amdgcn_cvt_pk_f32_fp8((int)(w), true); \
        o0 = __builtin_fmaf(c, lo_.x, o0); o1 = __builtin_fmaf(c, lo_.y, o1); o2 = __builtin_fmaf(c, hi_.x, o2); o3 = __builtin_fmaf(c, hi_.y, o3); }
__device__ __forceinline__ void p9_token(Frame& F, int row, int layer, int mode) {
    const int lane = F.lane;
    float h[16];
    { const bf16* hrow = WSP(bf16, WS_XNB) + (size_t)row * DM + 16 * lane; const v4u a = *(const v4u*)hrow, b = *(const v4u*)(hrow + 8);
      h[0] = bflo(a.x); h[1] = bfhi(a.x); h[2] = bflo(a.y); h[3] = bfhi(a.y); h[4] = bflo(a.z); h[5] = bfhi(a.z); h[6] = bflo(a.w); h[7] = bfhi(a.w);
      h[8] = bflo(b.x); h[9] = bfhi(b.x); h[10] = bflo(b.y); h[11] = bfhi(b.y); h[12] = bflo(b.z); h[13] = bfhi(b.z); h[14] = bflo(b.w); h[15] = bfhi(b.w); }
    const int* pei = WSP(int, WS_PEI) + (size_t)row * 128; const float* peg = WSP(float, WS_PEG) + (size_t)row * 128;
    const int e0 = pei[lane], e1 = pei[64 + lane]; const float g0 = peg[lane], g1 = peg[64 + lane];
    const unsigned char* PU = WSP(unsigned char, WS_PU) + (size_t)layer * NEXP * DM + 16 * lane; const unsigned char* PV = WSP(unsigned char, WS_PV) + (size_t)layer * NEXP * DM + 16 * lane;
    float out[16];
#pragma unroll
    for (int i = 0; i < 16; ++i) out[i] = 0.f;
    v4u U[2][4], V[2][4];
#define P9_LOAD(buf, bb) do { const int ev_ = (bb) < 16 ? e0 : e1; _Pragma("unroll") for (int j_ = 0; j_ < 4; ++j_) { \
        const size_t off_ = (size_t)__builtin_amdgcn_readlane(ev_, ((bb) & 15) * 4 + j_) * DM; \
        U[buf][j_] = *(const v4u*)(PU + off_); V[buf][j_] = *(const v4u*)(PV + off_); } } while (0)
#define P9_COMP(buf, bb) do { float d_[4]; _Pragma("unroll") for (int j_ = 0; j_ < 4; ++j_) { float a_ = 0.f, b_ = 0.f; \
            P9_DOT4(U[buf][j_].x, h[0], h[1], h[2], h[3], a_) P9_DOT4(U[buf][j_].y, h[4], h[5], h[6], h[7], b_) P9_DOT4(U[buf][j_].z, h[8], h[9], h[10], h[11], a_) P9_DOT4(U[buf][j_].w, h[12], h[13], h[14], h[15], b_) d_[j_] = a_ + b_; } \
        float f_[2]; _Pragma("unroll") for (int k_ = 0; k_ < 2; ++k_) { const float x_ = (lane & 1) ? d_[2 * k_ + 1] : d_[2 * k_], y_ = (lane & 1) ? d_[2 * k_] : d_[2 * k_ + 1]; f_[k_] = x_ + __shfl_xor(y_, 1); } \
        float g_; { const float x_ = (lane & 2) ? f_[1] : f_[0], y_ = (lane & 2) ? f_[0] : f_[1]; g_ = x_ + __shfl_xor(y_, 2); } \
        g_ += __shfl_xor(g_, 4); g_ += __shfl_xor(g_, 8); g_ += __shfl_xor(g_, 16); g_ += __shfl_xor(g_, 32); \
        const float gt_ = __shfl((bb) < 16 ? g0 : g1, ((bb) & 15) * 4 + (lane & 3)); \
        const float cl_ = gelu_tanh(g_ * 0.03125f) * gt_ * 0.0625f; \
        _Pragma("unroll") for (int j_ = 0; j_ < 4; ++j_) { const float cj_ = __builtin_bit_cast(float, __builtin_amdgcn_readlane(__builtin_bit_cast(int, cl_), j_)); \
            P9_AXPY4(V[buf][j_].x, cj_, out[0], out[1], out[2], out[3]) P9_AXPY4(V[buf][j_].y, cj_, out[4], out[5], out[6], out[7]) \
            P9_AXPY4(V[buf][j_].z, cj_, out[8], out[9], out[10], out[11]) P9_AXPY4(V[buf][j_].w, cj_, out[12], out[13], out[14], out[15]) } } while (0)
    P9_LOAD(0, 0);
#pragma unroll 1
    for (int bb = 0; bb < 32; bb += 2) {
        P9_LOAD(1, bb + 1);
        P9_COMP(0, bb);
        if (bb + 2 < 32) P9_LOAD(0, bb + 2);
        P9_COMP(1, bb + 1);
    }
#undef P9_LOAD
#undef P9_COMP
    float* xs = WSP(float, WS_XS) + (size_t)row * DM + 16 * lane;
    f32x4 x[4];
#pragma unroll
    for (int i = 0; i < 4; ++i) { x[i] = *(const f32x4*)(xs + 4 * i); x[i].x += out[4 * i]; x[i].y += out[4 * i + 1]; x[i].z += out[4 * i + 2]; x[i].w += out[4 * i + 3]; }
    if (mode == 0) {
        float ss = 0.f;
#pragma unroll
        for (int i = 0; i < 4; ++i) { *(f32x4*)(xs + 4 * i) = x[i]; ss += (x[i].x * x[i].x + x[i].y * x[i].y) + (x[i].z * x[i].z + x[i].w * x[i].w); }
        const float rstd = 1.f / sqrtf(wave_sum(ss) * (1.f / DM) + EPS);
        bf16* xn = WSP(bf16, WS_XNA) + (size_t)row * DM + 16 * lane;
        *(v4u*)xn = (v4u){pk2(x[0].x * rstd, x[0].y * rstd), pk2(x[0].z * rstd, x[0].w * rstd), pk2(x[1].x * rstd, x[1].y * rstd), pk2(x[1].z * rstd, x[1].w * rstd)};
        *(v4u*)(xn + 8) = (v4u){pk2(x[2].x * rstd, x[2].y * rstd), pk2(x[2].z * rstd, x[2].w * rstd), pk2(x[3].x * rstd, x[3].y * rstd), pk2(x[3].z * rstd, x[3].w * rstd)};
    } else {
        float* y = (row < MP ? F.out + O_YP + (size_t)row * DM : F.out + O_YS + (size_t)(row - MP) * DM) + 16 * lane;
#pragma unroll
        for (int i = 0; i < 4; ++i) *(f32x4*)(y + 4 * i) = x[i];
    }
}

constexpr float QSCALE = 0.125f * 1.4426950408889634f;
constexpr int PP_VT = 0;
__device__ __forceinline__ float rms64(float v) { return 1.f / sqrtf(wave_sum(v * v) * (1.f / 64.f) + EPS); }

__device__ __forceinline__ void pp_q_row(Frame& F, int row, const float* kvq, const float qg) {
    const int lane = F.lane;
    bf16* qn = WSP(bf16, WS_QN) + (size_t)row * 1024;
#pragma unroll 4
    for (int hd = 0; hd < 16; ++hd) { const float v = kvq[NKV + hd * 64 + lane]; qn[hd * 64 + lane] = (bf16)f2bf(v * rms64(v) * qg); }
    if (lane < 48) WSP(float, WS_GATES)[(size_t)row * 48 + lane] = sigmoid_f(kvq[NKV + 1024 + lane]);
}
__device__ __forceinline__ void pp_prompt_tile(Frame& F, int unit) {
    const int lane = F.lane, w = F.wave, b = unit >> 7, t0 = (unit & 127) * 64;
    LAS unsigned char* L = F.lds; asm volatile("" : "+v"(L));
    LAS bf16* vt = (LAS bf16*)(L + PP_VT);
    const float kg1 = FIN(16)[64 + lane], kg2 = FIN(16)[128 + lane], qg = FIN(22)[lane] * QSCALE;
    for (int rr = 0; rr < 8; ++rr) {
        const int tl = 8 * w + rr, t = t0 + tl, row = b * PT + t;
        const float* kvq = WSP(float, WS_KVQ) + (size_t)row * NKVQ;
        float* okv = F.out + O_KVP + (size_t)row * 1024;
        const bool inwin = t >= PT - WINDOW;
        float* owin = F.out + O_WINP + ((size_t)b * 512 + (t - (PT - WINDOW))) * 512;
#pragma unroll
        for (int g = 0; g < 4; ++g) {
            const float v0 = kvq[0 * 256 + g * 64 + lane], v1 = kvq[1 * 256 + g * 64 + lane], v2 = kvq[2 * 256 + g * 64 + lane];
            const float v3 = kvq[3 * 256 + g * 64 + lane], v4 = kvq[4 * 256 + g * 64 + lane], v5 = kvq[5 * 256 + g * 64 + lane];
            const float ks = v2 * rms64(v2) * kg1, kw = v4 * rms64(v4) * kg2;
            okv[0 * 256 + g * 64 + lane] = v0; okv[1 * 256 + g * 64 + lane] = v1; okv[2 * 256 + g * 64 + lane] = ks; okv[3 * 256 + g * 64 + lane] = v3;
            if (inwin) { owin[g * 64 + lane] = kw; owin[256 + g * 64 + lane] = v5; }
            const size_t kidx = (((size_t)b * NG + g) * PT + t) * 64 + lane;
            WSP(bf16, WS_KSEL)[kidx] = (bf16)f2bf(ks); WSP(bf16, WS_KWIN)[kidx] = (bf16)f2bf(kw);
            vt[((0 * 4 + g) * 64 + lane) * 72 + tl] = (bf16)f2bf(v3); vt[((1 * 4 + g) * 64 + lane) * 72 + tl] = (bf16)f2bf(v5);
        }
        pp_q_row(F, row, kvq, qg);
    }
    __syncthreads();
    {
        const int which = F.tid >> 8, gd = F.tid & 255;
        bf16* dst = WSP(bf16, which == 0 ? WS_VSELT : WS_VWINT) + (((size_t)b * NG * 64 + gd) * PT + t0);
        const LAS bf16* src = vt + ((which * 256 + gd) * 72);
#pragma unroll
        for (int i = 0; i < 8; ++i) *(v4u*)(dst + 8 * i) = *(const LAS v4u*)(src + 8 * i);
    }
    __syncthreads();
}
__device__ __forceinline__ void pp_sample_row(Frame& F, int sr) {
    const int lane = F.lane, bs = sr >> 2, i = sr & 3, row = MP + sr;
    const float kg1 = FIN(16)[64 + lane], kg2 = FIN(16)[128 + lane], qg = FIN(22)[lane] * QSCALE;
    const float* kvq = WSP(float, WS_KVQ) + (size_t)row * NKVQ;
    float* okv = F.out + O_KVS + (size_t)sr * 1024;
    float* owin = F.out + O_WINS + ((size_t)bs * 512 + 508 + i) * 512;
#pragma unroll
    for (int g = 0; g < 4; ++g) {
        const float v0 = kvq[0 * 256 + g * 64 + lane], v1 = kvq[1 * 256 + g * 64 + lane], v2 = kvq[2 * 256 + g * 64 + lane];
        const float v3 = kvq[3 * 256 + g * 64 + lane], v4 = kvq[4 * 256 + g * 64 + lane], v5 = kvq[5 * 256 + g * 64 + lane];
        const float ks = v2 * rms64(v2) * kg1, kw = v4 * rms64(v4) * kg2;
        okv[0 * 256 + g * 64 + lane] = v0; okv[1 * 256 + g * 64 + lane] = v1; okv[2 * 256 + g * 64 + lane] = ks; okv[3 * 256 + g * 64 + lane] = v3;
        owin[g * 64 + lane] = kw; owin[256 + g * 64 + lane] = v5;
        const size_t bg = (size_t)bs * NG + g;
        WSP(bf16, WS_SKWIN)[(bg * 544 + 512 + i) * 64 + lane] = (bf16)f2bf(kw);
        WSP(bf16, WS_SVWINT)[(bg * 64 + lane) * 544 + 512 + i] = (bf16)f2bf(v5);
        float* sn = WSP(float, WS_SNEW) + (((size_t)bs * 4 + i) * 2) * 256 + g * 64 + lane;
        sn[0] = ks; sn[256] = v3;
    }
    pp_q_row(F, row, kvq, qg);
}

__device__ __forceinline__ void compress_finish(Frame& F, const f32x4 (&acc)[4], int kv, int blk, bf16* KC, bf16* VCT) {
    const int lane = F.lane, fr = lane & 15, fq = lane >> 4;
    const float* pet = WSP(float, WS_PETERM) + kv * 64;
    bf16x8 hb[2];
#pragma unroll
    for (int s = 0; s < 2; ++s) { f32x4 h0, h1;
#pragma unroll
        for (int r = 0; r < 4; ++r) { h0[r] = gelu_tanh(acc[2 * s][r] + pet[16 * (2 * s) + 4 * fq + r]); h1[r] = gelu_tanh(acc[2 * s + 1][r] + pet[16 * (2 * s + 1) + 4 * fq + r]); }
        hb[s] = cvt8(h0, h1); }
    const float* w2 = FIN(19) + (size_t)kv * 64 * 64;
    f32x4 o[4];
#pragma unroll
    for (int dt = 0; dt < 4; ++dt) { o[dt] = (f32x4){0.f, 0.f, 0.f, 0.f};
#pragma unroll
        for (int s = 0; s < 2; ++s) { f32x4 a0, a1;
#pragma unroll
            for (int jj = 0; jj < 4; ++jj) { a0[jj] = w2[(size_t)(16 * (2 * s) + 4 * fq + jj) * 64 + 16 * dt + fr]; a1[jj] = w2[(size_t)(16 * (2 * s + 1) + 4 * fq + jj) * 64 + 16 * dt + fr]; }
            o[dt] = MFMA16(cvt8(a0, a1), hb[s], o[dt]); } }
    if (kv == 0) {
        float ss = 0.f;
#pragma unroll
        for (int dt = 0; dt < 4; ++dt) ss += (o[dt][0] * o[dt][0] + o[dt][1] * o[dt][1]) + (o[dt][2] * o[dt][2] + o[dt][3] * o[dt][3]);
        ss += __shfl_xor(ss, 16); ss += __shfl_xor(ss, 32);
        const float rstd = 1.f / sqrtf(ss * (1.f / 64.f) + EPS);
        const float* kg0 = FIN(16);
        if (blk < NCMP) {
#pragma unroll
            for (int dt = 0; dt < 4; ++dt) { const int d = 16 * dt + 4 * fq; v2u ov; ov.x = pk2(o[dt][0] * rstd * kg0[d], o[dt][1] * rstd * kg0[d + 1]); ov.y = pk2(o[dt][2] * rstd * kg0[d + 2], o[dt][3] * rstd * kg0[d + 3]);
                *(v2u*)(KC + (size_t)blk * 64 + d) = ov; }
        } else {
#pragma unroll
            for (int dt = 0; dt < 4; ++dt) *(v2u*)(KC + (size_t)blk * 64 + 16 * dt + 4 * fq) = (v2u){0u, 0u};
        }
    } else {
#pragma unroll
        for (int dt = 0; dt < 4; ++dt)
#pragma unroll
            for (int r = 0; r < 4; ++r) VCT[(size_t)(16 * dt + 4 * fq + r) * 512 + blk] = (blk < NCMP) ? (bf16)f2bf(o[dt][r]) : (bf16)0;
    }
}

template <class RowP>
__device__ __forceinline__ void compress_tile(Frame& F, const RowP& rowp, int kv, int j, bf16* KC, bf16* VCT) {
    const int lane = F.lane, fr = lane & 15, fq = lane >> 4;
    const bf16* W1 = WSP(bf16, WS_W1T) + (size_t)kv * 64 * 2048 + (size_t)fr * 2048 + 8 * fq;
    const int blk = 16 * j + fr;
    f32x4 acc[4];
#pragma unroll
    for (int mt = 0; mt < 4; ++mt) acc[mt] = (f32x4){0.f, 0.f, 0.f, 0.f};
#pragma unroll 2
    for (int r = 0; r < 32; ++r) {
        int t = 16 * blk + r; t = t < PAST ? t : PAST - 1;
        const float* rp = rowp(t) + 8 * fq;
#pragma unroll
        for (int hf = 0; hf < 2; ++hf) {
            const f32x4 x0 = *(const f32x4*)(rp + 32 * hf), x1 = *(const f32x4*)(rp + 32 * hf + 4);
            const bf16x8 bfrag = cvt8(x0, x1);
            const int ks = 2 * r + hf;
#pragma unroll
            for (int mt = 0; mt < 4; ++mt) acc[mt] = MFMA16(ld8(W1 + (size_t)mt * 16 * 2048 + 32 * ks), bfrag, acc[mt]);
        }
    }
    compress_finish(F, acc, kv, blk, KC, VCT);
}
struct RowPPrompt { const float* base; __device__ __forceinline__ const float* operator()(int t) const { return base + (size_t)t * NKVQ; } };
struct RowPSample { const float* cache; const int* pt; __device__ __forceinline__ const float* operator()(int t) const { return cache + ((size_t)pt[t >> 7] * PAGE + (t & 127)) * 1024; } };

__device__ __forceinline__ void compress_prompt(Frame& F, int id) {
    const int kv = id & 1, j = (id >> 1) & 31, bg = id >> 6, b = bg >> 2, g = bg & 3;
    RowPPrompt rp{WSP(float, WS_KVQ) + (size_t)b * PT * NKVQ + kv * 256 + g * 64};
    compress_tile(F, rp, kv, j, WSP(bf16, WS_KCMP) + (size_t)bg * 512 * 64, WSP(bf16, WS_VCMPT) + (size_t)bg * 64 * 512);
}
__device__ __forceinline__ void compress_sample(Frame& F, int id) {
    const int kv = id & 1, j = (id >> 1) & 31, bg = id >> 6, lane = F.lane, fr = lane & 15, fq = lane >> 4;
    const int blk = 16 * j + fr, nb = blk < 511 ? blk + 1 : 511;
    const float* f1 = WSP(float, WS_FS) + ((size_t)bg * 512 + blk) * 256 + kv * 128 + 4 * fq;
    const float* f2 = WSP(float, WS_FS) + ((size_t)bg * 512 + nb) * 256 + kv * 128 + 64 + 4 * fq;
    f32x4 acc[4];
#pragma unroll
    for (int mt = 0; mt < 4; ++mt) acc[mt] = *(const f32x4*)(f1 + 16 * mt) + *(const f32x4*)(f2 + 16 * mt);
    compress_finish(F, acc, kv, blk, WSP(bf16, WS_SKCMP) + (size_t)bg * 512 * 64, WSP(bf16, WS_SVCMPT) + (size_t)bg * 64 * 512);
}

constexpr int NSA_IMP = 0;
constexpr int NSA_Q = 67584;
constexpr float LOG2E = 1.4426950408889634f;
#ifndef NSA_REPC
#define NSA_REPC 0
#endif
#ifndef NSA_REPS
#define NSA_REPS 0
#endif
#ifndef NSA_REPW
#define NSA_REPW 0
#endif
__device__ __forceinline__ float ex2(float x) { return __builtin_amdgcn_exp2f(x); }

struct KvBf16 {
    const bf16* K; const bf16* VT; int ld;
    __device__ __forceinline__ void lane_offsets(int fr, int fq, unsigned& ko, unsigned& vo) const {
        ko = (unsigned)((fr * 64 + 8 * fq) * 2); vo = (unsigned)((fr * ld + 4 * fq) * 2);
        asm volatile("" : "+v"(ko), "+v"(vo));
    }
    __device__ __forceinline__ bf16x8 kf(int key0, int mt, int ks, unsigned ko) const {
        return *(const bf16x8*)((const char*)K + (size_t)key0 * 128 + (ko + (unsigned)((16 * mt * 64 + 32 * ks) * 2))); }
    __device__ __forceinline__ bf16x8 vf(int key0, int dt, unsigned vo) const {
        const char* p = (const char*)VT + (size_t)key0 * 2 + (vo + (unsigned)(16 * dt * ld * 2));
        const v2u a = *(const v2u*)p, b = *(const v2u*)(p + 32); return __builtin_bit_cast(bf16x8, (v4u){a.x, a.y, b.x, b.y}); }
};
struct KvSampleSel {
    const float* cache; const int* pt; const float* snew; int g;
    __device__ __forceinline__ const float* krow(int pos, int slot) const {
        if (pos < PAST) return cache + ((size_t)pt[pos >> 7] * PAGE + (pos & 127)) * 1024 + slot * 256;
        int i = pos - PAST; i = i < 3 ? i : 3; return snew + (size_t)i * 512 + (slot - 2) * 256; }
    __device__ __forceinline__ void lane_offsets(int fr, int fq, unsigned& ko, unsigned& vo) const { ko = (unsigned)(fr | (fq << 8)); vo = ko; asm volatile("" : "+v"(ko), "+v"(vo)); }
    __device__ __forceinline__ bf16x8 kf(int key0, int mt, int ks, unsigned ko) const { const int fr = ko & 255, fq = ko >> 8; const float* p = krow(key0 + 16 * mt + fr, 2) + 32 * ks + 8 * fq; return cvt8(*(const f32x4*)p, *(const f32x4*)(p + 4)); }
    __device__ __forceinline__ bf16x8 vf(int key0, int dt, unsigned vo) const { const int fr = vo & 255, fq = vo >> 8; f32x4 a, b;
#pragma unroll
        for (int j = 0; j < 4; ++j) { a[j] = krow(key0 + 4 * fq + j, 3)[16 * dt + fr]; b[j] = krow(key0 + 16 + 4 * fq + j, 3)[16 * dt + fr]; }
        return cvt8(a, b); }
};

template <int NT, int MODE, class KV>
__device__ __forceinline__ void nsa_tile(const KV& kv, int key0, const LAS bf16x8* qf, f32x4 (&O)[NT][4], float (&m)[NT], float (&l)[NT], const float (&invl)[NT], const float (&slope)[NT],
                                         int t, int pmul, int padd, int wlim, bool selok, LAS float* improw, int fr, int fq) {
    unsigned ko, vo; kv.lane_offsets(fr, fq, ko, vo);
    bf16x8 kfr[2][2];
#pragma unroll
    for (int mt = 0; mt < 2; ++mt)
#pragma unroll
        for (int ks = 0; ks < 2; ++ks) kfr[mt][ks] = kv.kf(key0, mt, ks, ko);
    bf16x8 vfr[4];
    if (MODE != 1) {
#pragma unroll
        for (int dt = 0; dt < 4; ++dt) vfr[dt] = kv.vf(key0, dt, vo);
    }
    float dist[2][4]; bool val[2][4];
#pragma unroll
    for (int mt = 0; mt < 2; ++mt)
#pragma unroll
        for (int r = 0; r < 4; ++r) { const int kk = key0 + 16 * mt + 4 * fq + r; const int dd = t - (pmul * kk + padd); dist[mt][r] = (float)dd; val[mt][r] = selok && dd >= 0 && dd < wlim; }
    float imp_main[2] = {0.f, 0.f}, imp_spill[2] = {0.f, 0.f};
#pragma unroll
    for (int nt = 0; nt < NT; ++nt) {
        f32x4 s[2];
        const bf16x8 q0 = qf[(nt * 2 + 0) * 64], q1 = qf[(nt * 2 + 1) * 64];
#pragma unroll
        for (int mt = 0; mt < 2; ++mt) { s[mt] = (f32x4){0.f, 0.f, 0.f, 0.f}; s[mt] = MFMA16(kfr[mt][0], q0, s[mt]); s[mt] = MFMA16(kfr[mt][1], q1, s[mt]); }
        float sv[2][4];
#pragma unroll
        for (int mt = 0; mt < 2; ++mt)
#pragma unroll
            for (int r = 0; r < 4; ++r) sv[mt][r] = val[mt][r] ? (s[mt][r] - slope[nt] * dist[mt][r]) : -1e30f;
        float mref;
        if (MODE != 2) {
            float mx = fmaxf(fmaxf(fmaxf(sv[0][0], sv[0][1]), fmaxf(sv[0][2], sv[0][3])), fmaxf(fmaxf(sv[1][0], sv[1][1]), fmaxf(sv[1][2], sv[1][3])));
            mx = fmaxf(mx, __shfl_xor(mx, 16)); mx = fmaxf(mx, __shfl_xor(mx, 32));
            const float mnew = fmaxf(m[nt], mx), alpha = ex2(m[nt] - mnew);
            m[nt] = mnew; l[nt] *= alpha; mref = mnew;
            if (MODE == 0) {
#pragma unroll
                for (int dt = 0; dt < 4; ++dt) O[nt][dt] = O[nt][dt] * alpha;
            }
        } else mref = m[nt];
        f32x4 p[2]; float ps = 0.f;
#pragma unroll
        for (int mt = 0; mt < 2; ++mt)
#pragma unroll
            for (int r = 0; r < 4; ++r) { float pv = val[mt][r] ? ex2(sv[mt][r] - mref) : 0.f; if (MODE == 2) pv *= invl[nt]; p[mt][r] = pv; ps += pv; }
        if (MODE != 2) l[nt] += ps;
        if (MODE == 2) {
#pragma unroll
            for (int mt = 0; mt < 2; ++mt) { imp_main[mt] += (p[mt][0] + p[mt][1]) + (p[mt][2] + p[mt][3]); imp_spill[mt] += p[mt][3]; }
        }
        if (MODE != 1) {
            const bf16x8 pf = cvt8(p[0], p[1]);
#pragma unroll
            for (int dt = 0; dt < 4; ++dt) O[nt][dt] = MFMA16(vfr[dt], pf, O[nt][dt]);
        }
    }
    if (MODE == 2) {
#pragma unroll
        for (int mt = 0; mt < 2; ++mt) { const int j = (key0 + 16 * mt) / 4 + fq;
            __hip_atomic_fetch_add(improw + j, imp_main[mt], __ATOMIC_RELAXED, __HIP_MEMORY_SCOPE_WORKGROUP);
            __hip_atomic_fetch_add(improw + j + 1, imp_spill[mt], __ATOMIC_RELAXED, __HIP_MEMORY_SCOPE_WORKGROUP); }
    }
}

template <int NT>
__device__ __forceinline__ void nsa_zero(f32x4 (&O)[NT][4], float (&m)[NT], float (&l)[NT]) {
#pragma unroll
    for (int nt = 0; nt < NT; ++nt) { m[nt] = -1e30f; l[nt] = 0.f;
#pragma unroll
        for (int dt = 0; dt < 4; ++dt) O[nt][dt] = (f32x4){0.f, 0.f, 0.f, 0.f}; }
}

template <bool SAMPLE>
__device__ __forceinline__ void nsa_unit(Frame& F, int id) {
    constexpr int NT = SAMPLE ? 1 : 4;
    const int lane = F.lane, fr = lane & 15, fq = lane >> 4;
    LAS unsigned char* L = F.lds; asm volatile("" : "+v"(L));
    LAS float* imp = (LAS float*)(L + NSA_IMP + F.wave * 8448);
    int bg, g, t, row, trow, tmax;
    if (SAMPLE) { bg = id; g = id & 3; t = PAST + (fr >> 2); row = MP + (id >> 2) * 4 + (fr >> 2); trow = fr >> 2; tmax = PAST + 3; }
    else { bg = id >> 9; g = bg & 3; const int tt = id & 511; t = 16 * tt + fr; row = (bg >> 2) * PT + t; trow = fr; tmax = 16 * tt + 15; }
    float slope[NT]; int hd[NT];
    LAS bf16x8* qf = (LAS bf16x8*)(L + NSA_Q + F.wave * 8192) + lane;
#pragma unroll
    for (int nt = 0; nt < NT; ++nt) { hd[nt] = g * 4 + (SAMPLE ? (fr & 3) : nt); slope[nt] = ex2(-0.5f * (float)(hd[nt] + 1)) * LOG2E;
        const bf16* qp = WSP(bf16, WS_QN) + (size_t)row * 1024 + hd[nt] * 64 + 8 * fq; qf[(nt * 2 + 0) * 64] = ld8(qp); qf[(nt * 2 + 1) * 64] = ld8(qp + 32); }
    const float* gates = WSP(float, WS_GATES) + (size_t)row * 48;
    float* oacc = WSP(float, WS_OACC) + (size_t)row * 1024;
    for (int i = lane; i < 16 * 132; i += 64) imp[i] = 0.f;
    LDS_WAIT();
    f32x4 O[NT][4]; float m[NT], l[NT], invl[NT];
    {
        KvBf16 kv{WSP(bf16, SAMPLE ? WS_SKCMP : WS_KCMP) + (size_t)bg * 512 * 64, WSP(bf16, SAMPLE ? WS_SVCMPT : WS_VCMPT) + (size_t)bg * 64 * 512, 512};
        const int cmax = (tmax - 31) >> 4;
        const int ntile = (tmax >= 31) ? ((cmax < 510 ? cmax : 510) / 32 + 1) : 0;
#pragma unroll
        for (int nt = 0; nt < NT; ++nt) invl[nt] = 0.f;
#pragma unroll 1
        for (int q_ = 0; q_ <= NSA_REPC; ++q_) { nsa_zero<NT>(O, m, l);
#pragma unroll 1
        for (int tl = 0; tl < ntile; ++tl) nsa_tile<NT, 1>(kv, 32 * tl, qf, O, m, l, invl, slope, t, 16, 31, 1 << 30, true, imp + trow * 132, fr, fq); }
#pragma unroll
        for (int nt = 0; nt < NT; ++nt) { float lt = l[nt]; lt += __shfl_xor(lt, 16); lt += __shfl_xor(lt, 32); invl[nt] = lt > 0.f ? 1.f / lt : 0.f; }
#pragma unroll 1
        for (int tl = 0; tl < ntile; ++tl) nsa_tile<NT, 2>(kv, 32 * tl, qf, O, m, l, invl, slope, t, 16, 31, 1 << 30, true, imp + trow * 132, fr, fq);
#pragma unroll
        for (int nt = 0; nt < NT; ++nt) { const float gc = gates[0 * 16 + hd[nt]];
#pragma unroll
            for (int dt = 0; dt < 4; ++dt) *(f32x4*)(oacc + hd[nt] * 64 + 16 * dt + 4 * fq) = O[nt][dt] * gc; }
    }
    LDS_WAIT();
    unsigned selm[4] = {0u, 0u, 0u, 0u};
    {
        const int cur = t >> 6;
        if (!SAMPLE) {
            unsigned v[32];
#pragma unroll
            for (int i = 0; i < 32; ++i) { const int j = 32 * fq + i; const bool forced = (j == 0) | (j == cur) | (j == cur - 1);
                const unsigned key = ((f2u(imp[trow * 132 + j]) & ~127u) | (unsigned)(127 - j)) + 128u;
                v[i] = (!forced && j <= cur) ? key : 0u;
                if (forced) selm[fq] |= 1u << i; }
            unsigned fw = selm[0] | selm[1] | selm[2] | selm[3];
            const unsigned w16 = __shfl_xor(fw, 16), w32 = __shfl_xor(fw, 32), w48 = __shfl_xor(fw, 48);
#pragma unroll
            for (int wd = 0; wd < 4; ++wd) selm[wd] = (fq == wd) ? fw : ((fq ^ 1) == wd) ? w16 : ((fq ^ 2) == wd) ? w32 : w48;
            const int nforced = cur >= 2 ? 3 : cur + 1;
#pragma unroll 1
            for (int rd = 0; rd < 15; ++rd) {
                unsigned mx = v[0];
#pragma unroll
                for (int i = 1; i < 32; ++i) mx = mx > v[i] ? mx : v[i];
                { const unsigned o = __shfl_xor(mx, 16); mx = mx > o ? mx : o; } { const unsigned o = __shfl_xor(mx, 32); mx = mx > o ? mx : o; }
#pragma unroll
                for (int i = 0; i < 32; ++i) v[i] = (v[i] == mx) ? 0u : v[i];
                if (mx != 0u && rd < 16 - nforced) { const int js = 127 - (int)(mx & 127u);
#pragma unroll
                    for (int wd = 0; wd < 4; ++wd) selm[wd] |= ((js >> 5) == wd) ? (1u << (js & 31)) : 0u; }
            }
        } else {
            const int li = (fr & 3) * 4 + fq;
            unsigned v[8];
#pragma unroll
            for (int i = 0; i < 8; ++i) { const int j = li * 8 + i; v[i] = (j >= 1 && j <= 126) ? (((f2u(imp[trow * 132 + j]) & ~127u) | (unsigned)(127 - j)) + 128u) : 0u; }
            selm[0] = 1u; selm[3] = 1u << 31;
#pragma unroll 1
            for (int rd = 0; rd < 13; ++rd) {
                unsigned mx = v[0];
#pragma unroll
                for (int i = 1; i < 8; ++i) mx = mx > v[i] ? mx : v[i];
                { unsigned o = __shfl_xor(mx, 1); mx = mx > o ? mx : o; o = __shfl_xor(mx, 2); mx = mx > o ? mx : o; o = __shfl_xor(mx, 16); mx = mx > o ? mx : o; o = __shfl_xor(mx, 32); mx = mx > o ? mx : o; }
#pragma unroll
                for (int i = 0; i < 8; ++i) v[i] = (v[i] == mx) ? 0u : v[i];
                if (mx != 0u) { const int js = 127 - (int)(mx & 127u);
#pragma unroll
                    for (int wd = 0; wd < 4; ++wd) selm[wd] |= ((js >> 5) == wd) ? (1u << (js & 31)) : 0u; }
            }
        }
    }
    {
        unsigned un[4];
#pragma unroll
        for (int wd = 0; wd < 4; ++wd) { unsigned x = selm[wd]; x |= __shfl_xor(x, 1); x |= __shfl_xor(x, 2); x |= __shfl_xor(x, 4); x |= __shfl_xor(x, 8); un[wd] = (unsigned)__builtin_amdgcn_readfirstlane((int)x); }
        KvBf16 kvp{WSP(bf16, WS_KSEL) + (size_t)bg * PT * 64, WSP(bf16, WS_VSELT) + (size_t)bg * 64 * PT, PT};
        KvSampleSel kvs{FIN(2) + g * 64, (const int*)FIN(6) + (SAMPLE ? (id >> 2) : 0) * NPAGES, WSP(float, WS_SNEW) + (size_t)(SAMPLE ? (id >> 2) : 0) * 2048 + g * 64, g};
#pragma unroll 1
        for (int q_ = 0; q_ <= NSA_REPS; ++q_) { nsa_zero<NT>(O, m, l);
#pragma unroll 1
        for (int wd = 0; wd < 4; ++wd) {
            unsigned mm = un[wd];
            const unsigned mine = wd == 0 ? selm[0] : wd == 1 ? selm[1] : wd == 2 ? selm[2] : selm[3];
            while (mm) {
                const int bit = __builtin_ctz(mm); mm &= mm - 1u; const int j = 32 * wd + bit;
                const bool ok = (mine >> bit) & 1u;
#pragma unroll 1
                for (int hh = 0; hh < 2; ++hh) {
                    if (SAMPLE) nsa_tile<NT, 0>(kvs, 64 * j + 32 * hh, qf, O, m, l, invl, slope, t, 1, 0, 1 << 30, ok, imp, fr, fq);
                    else nsa_tile<NT, 0>(kvp, 64 * j + 32 * hh, qf, O, m, l, invl, slope, t, 1, 0, 1 << 30, ok, imp, fr, fq);
                    __builtin_amdgcn_sched_barrier(0);
                }
            }
        }
        if (SAMPLE) nsa_tile<NT, 0>(kvs, 64 * 128, qf, O, m, l, invl, slope, t, 1, 0, 1 << 30, true, imp, fr, fq);
        }
#pragma unroll
        for (int nt = 0; nt < NT; ++nt) { float lt = l[nt]; lt += __shfl_xor(lt, 16); lt += __shfl_xor(lt, 32); const float sc = gates[1 * 16 + hd[nt]] / fmaxf(lt, 1e-30f);
#pragma unroll
            for (int dt = 0; dt < 4; ++dt) { f32x4* o = (f32x4*)(oacc + hd[nt] * 64 + 16 * dt + 4 * fq); *o = *o + O[nt][dt] * sc; } }
    }
    {
        KvBf16 kv = SAMPLE ? KvBf16{WSP(bf16, WS_SKWIN) + (size_t)bg * 544 * 64, WSP(bf16, WS_SVWINT) + (size_t)bg * 64 * 544, 544}
                           : KvBf16{WSP(bf16, WS_KWIN) + (size_t)bg * PT * 64, WSP(bf16, WS_VWINT) + (size_t)bg * 64 * PT, PT};
        int k0, k1, padd;
        if (SAMPLE) { k0 = 0; k1 = 544; padd = PAST - WINDOW; }
        else { const int lo = tmax - 15 - (WINDOW - 1); k0 = (lo > 0 ? lo : 0) & ~31; k1 = tmax + 1; padd = 0; }
#pragma unroll 1
        for (int q_ = 0; q_ <= NSA_REPW; ++q_) { nsa_zero<NT>(O, m, l);
#pragma unroll 1
        for (int kk = k0; kk < k1; kk += 32) nsa_tile<NT, 0>(kv, kk, qf, O, m, l, invl, slope, t, 1, padd, WINDOW, true, imp, fr, fq); }
        bf16* on = WSP(bf16, WS_OG) + (size_t)row * 1024;
#pragma unroll
        for (int nt = 0; nt < NT; ++nt) { float lt = l[nt]; lt += __shfl_xor(lt, 16); lt += __shfl_xor(lt, 32); const float sc = gates[2 * 16 + hd[nt]] / fmaxf(lt, 1e-30f);
#pragma unroll
            for (int dt = 0; dt < 4; ++dt) { const f32x4 o = *(const f32x4*)(oacc + hd[nt] * 64 + 16 * dt + 4 * fq) + O[nt][dt] * sc;
                *(v2u*)(on + hd[nt] * 64 + 16 * dt + 4 * fq) = (v2u){pk2(o[0], o[1]), pk2(o[2], o[3])}; } }
    }
}


#ifndef MK_SINGLE
#define MK_SINGLE 1
#endif
constexpr int NPHASE = 19;
struct Args { const float* in[29]; float* out; unsigned char* ws; int ph_lo, ph_hi; };
static_assert(sizeof(Args) == 31 * 8 + 8, "Args has no padding");

__global__ void __launch_bounds__(512, 2) mk_fwd(Args args) {
    extern __shared__ __attribute__((aligned(16))) unsigned char lds_raw[];
    Frame F;
    F.lds = (LAS unsigned char*)lds_raw;
    F.tid = threadIdx.x; F.lane = F.tid & 63; F.wave = __builtin_amdgcn_readfirstlane(F.tid >> 6);
    F.G = gridDim.x; F.bid = blockIdx.x;
    F.ka = (const __attribute__((address_space(4))) char*)__builtin_amdgcn_kernarg_segment_ptr();
    F.out = args.out; F.ws = args.ws;
    volatile LAS unsigned* MISC = (volatile LAS unsigned*)(F.lds + MISC_OFF);
    for (int u = F.tid; u < (LDS_BYTES - LDSCTL_OFF) / 4; u += 512) ((LAS unsigned*)(F.lds + LDSCTL_OFF))[u] = 0u;
    __syncthreads();
    unsigned* barw = (unsigned*)(F.ws + WS_CTL) + 4096;
    XcdBarrier bar; bar.bar = barw; bar.x = 0; bar.st = nullptr;
    const int lo = args.ph_lo, hi = args.ph_hi;
    if (hi - lo > 1) bar = xcd_barrier_post(barw, MISC + 8);
#ifndef PH_MASK
#define PH_MASK 0xFFFFFFFFu
#endif
#define IN(k) (((PH_MASK >> (k)) & 1u) && lo <= (k) && (k) < hi)
#define SEAM(k) do { if (IN(k) && IN((k) + 1)) xcd_barrier(bar); } while (0)
    const int gw = F.bid * 8 + F.wave, NGW = F.G * 8;

#ifndef REPX
#define REPX 0
#endif
#ifndef REPY
#define REPY 0
#endif
#ifndef REP_MASK
#define REP_MASK 0u
#endif
#define PHASE(k, ...) if (IN(k)) { _Pragma("unroll 1") for (int rep_ = 0; rep_ < (int)((REP_MASK >> (k)) & 1u) + 1; ++rep_) { if (rep_) xcd_barrier(bar); __VA_ARGS__ } } SEAM(k);
    PHASE(0, p0_prologue(F);)
    PHASE(1, { pg8::Gemm g{WSP(bf16, WS_CKA), WSP(bf16, WS_W1BD), 65536, 256, 2048}; pg8::StaticOrder S; S.init(65536, 256, F.G, F.bid);
               pg8::EpiFn<FnF32> E{FnF32{WSP(float, WS_FS), 256}}; pg8::gemm_phase<pg8::EpiFn<FnF32>, pg8::StaticOrder, true, true>(F.lds, g, S, E); })
    PHASE(2, gemm_all(F, WSP(bf16, WS_XNA), WSP(bf16, WS_WIN_T), 4096, FnBf16{WSP(bf16, WS_PROJ), 4096});)
    PHASE(3, for (int u = F.bid; u < 2048 + 256; u += F.G) { if (u < 2048) p2_chunk(F, u); else p2_sample(F, u - 2048); })
    PHASE(4, if (F.G == 256) { const int x = F.bid & 7, idx = F.bid >> 3; if (idx < 16) p3_scan(F, x * 2 + (idx >> 3), idx & 7); }
             else { for (int u = F.bid; u < 128; u += F.G) p3_scan(F, u >> 3, u & 7); })
    PHASE(5, for (int r = gw; r < MTOK; r += NGW) p4_row(F, r);
             for (int id = gw; id < 8192; id += NGW) compress_sample(F, id);)
    PHASE(6, gemm_all(F, WSP(bf16, WS_OG), WSP(bf16, WS_WOA_T), 1024, FnResid{WSP(float, WS_XS), FIN(0), FIN(1)});)
    PHASE(7, for (int r = gw; r < MTOK; r += NGW) rms_row_to_bf16(WSP(float, WS_XS) + (size_t)r * DM, WSP(bf16, WS_XNB) + (size_t)r * DM, F.lane);)
    PHASE(8, gemm_all(F, WSP(bf16, WS_XNB), WSP(bf16, WS_WPQ_T), 2048, FnBf16{WSP(bf16, WS_QPEER), 2048});)
    PHASE(9, p8_init_tab(F); for (int u = F.bid; u < MTOK / 16; u += F.G) p8_unit(F, u, 0);)
    PHASE(10, for (int r = gw; r < MTOK; r += NGW) p9_token(F, r, 0, 0);)
    PHASE(11, gemm_all(F, WSP(bf16, WS_XNA), WSP(bf16, WS_WKVQ_T), NKVQ, FnKvq{WSP(float, WS_KVQ)});)
    PHASE(12, _Pragma("unroll 1") for (int q_ = 0; q_ < 1 + REPX; ++q_) { for (int u = F.bid; u < 256; u += F.G) pp_prompt_tile(F, u);
              for (int r = gw; r < MS; r += NGW) pp_sample_row(F, r); }
              _Pragma("unroll 1") for (int q_ = 0; q_ < 1 + REPY; ++q_) { for (int id = gw; id < 512; id += NGW) compress_prompt(F, id); })
    PHASE(13, for (int id = gw; id < 128 + 4096; id += NGW) { if (id < 128) nsa_unit<true>(F, id); else nsa_unit<false>(F, id - 128); })
    PHASE(14, gemm_all(F, WSP(bf16, WS_OG), WSP(bf16, WS_WOB_T), 1024, FnResid{WSP(float, WS_XS), WSP(float, WS_XS), WSP(float, WS_XS) + (size_t)MP * DM});)
    PHASE(15, for (int r = gw; r < MTOK; r += NGW) rms_row_to_bf16(WSP(float, WS_XS) + (size_t)r * DM, WSP(bf16, WS_XNB) + (size_t)r * DM, F.lane);)
    PHASE(16, gemm_all(F, WSP(bf16, WS_XNB), WSP(bf16, WS_WPQ_T) + (size_t)2048 * 1024, 2048, FnBf16{WSP(bf16, WS_QPEER), 2048});)
    PHASE(17, p8_init_tab(F); for (int u = F.bid; u < MTOK / 16; u += F.G) p8_unit(F, u, 1);)
    PHASE(18, for (int r = gw; r < MTOK; r += NGW) p9_token(F, r, 1, 1);)
#undef IN
#undef SEAM
}

extern "C" void kernel_launch(void* const* d_in, const int* in_sizes, int n_in, void* d_out, int out_size, void* d_ws, size_t ws_size, hipStream_t stream) {
    static int grid = 0;
    if (grid == 0) {
        if (n_in != 29 || (size_t)out_size != O_END || ws_size < WS_END) { fprintf(stderr, "kernel_launch: unexpected shapes n_in %d out %d ws %zu (need %zu)\n", n_in, out_size, ws_size, (size_t)WS_END); grid = -1; return; }
        int dev = 0, cus = 0, per_cu = 0;
        if (hipGetDevice(&dev) != hipSuccess || hipDeviceGetAttribute(&cus, hipDeviceAttributeMultiprocessorCount, dev) != hipSuccess) { grid = -1; return; }
        if (hipFuncSetAttribute((const void*)mk_fwd, hipFuncAttributeMaxDynamicSharedMemorySize, LDS_BYTES) != hipSuccess) { fprintf(stderr, "kernel_launch: hipFuncSetAttribute failed\n"); grid = -1; return; }
        if (hipOccupancyMaxActiveBlocksPerMultiprocessor(&per_cu, (const void*)mk_fwd, 512, LDS_BYTES) != hipSuccess || per_cu < 1) fprintf(stderr, "kernel_launch: occupancy query reports %d\n", per_cu);
        (void)hipGetLastError();
        grid = cus;
    }
    if (grid < 0) return;
    if (hipMemsetAsync((char*)d_ws + WS_CTL, 0, CTL_BYTES, stream) != hipSuccess) return;
    Args a{};
    for (int i = 0; i < 29; ++i) a.in[i] = (const float*)d_in[i];
    a.out = (float*)d_out; a.ws = (unsigned char*)d_ws;
#if MK_SINGLE
    a.ph_lo = 0; a.ph_hi = NPHASE;
    hipLaunchKernelGGL(mk_fwd, dim3(grid), dim3(512), LDS_BYTES, stream, a);
#else
    for (int p = 0; p < NPHASE; ++p) { a.ph_lo = p; a.ph_hi = p + 1; hipLaunchKernelGGL(mk_fwd, dim3(grid), dim3(512), LDS_BYTES, stream, a); }
#endif
    const hipError_t le = hipPeekAtLastError();
    if (le != hipSuccess) fprintf(stderr, "kernel_launch: launch failed: %s\n", hipGetErrorName(le));
}
```

```cpp
#include <hip/hip_runtime.h>
#include <cstdio>
#include <cstdint>

constexpr int DM = 1024, PB = 2, PT = 8192, SB = 32, SL = 4, PAST = 8192, PAGE = 128;
constexpr int MP = PB * PT;
constexpr int MS = SB * SL;
constexpr int MTOK = MP + MS;
constexpr int GH = 8, GDK = 128, GDV = 128, GCONV = 3072, GPROJ = 4112, CHUNK = 64, NCH = PT / CHUNK;
constexpr int NH = 16, NG = 4, HPG = 4, DH = 64, NQG = 1072, NKV = 1536, NKVQ = 2816, NKVQ_REAL = 2608;
constexpr int WINDOW = 512, NSELP = 128, NSELS = 129, NCMP = 511;
constexpr int PEH = 8, PEDQ = 256, PEHALF = 128, NKEYS = 128, NEXP = 16384, PETOP = 16;
constexpr int NPAGES = PAST / PAGE;
constexpr float EPS = 1e-6f;

constexpr size_t O_YP = 0;
constexpr size_t O_YS = O_YP + (size_t)MP * DM;
constexpr size_t O_KVP = O_YS + (size_t)MS * DM;
constexpr size_t O_WINP = O_KVP + (size_t)MP * 1024;
constexpr size_t O_GDNP = O_WINP + (size_t)PB * 512 * 512;
constexpr size_t O_CONVP = O_GDNP + (size_t)PB * GH * 128 * 128;
constexpr size_t O_KVS = O_CONVP + (size_t)PB * 3 * GCONV;
constexpr size_t O_WINS = O_KVS + (size_t)MS * 1024;
constexpr size_t O_GDNS = O_WINS + (size_t)SB * 512 * 512;
constexpr size_t O_CONVS = O_GDNS + (size_t)SB * GH * 128 * 128;
constexpr size_t O_END = O_CONVS + (size_t)SB * 3 * GCONV;

constexpr size_t MiB = 1u << 20;
constexpr size_t al(size_t x) { return (x + 4095) & ~(size_t)4095; }
constexpr size_t WS_CTL = 0, CTL_BYTES = 1 * MiB;
constexpr size_t WS_WIN_T = WS_CTL + CTL_BYTES;
constexpr size_t WS_WOA_T = WS_WIN_T + (size_t)4096 * 1024 * 2;
constexpr size_t WS_WKVQ_T = WS_WOA_T + (size_t)1024 * 1024 * 2;
constexpr size_t WS_WOB_T = WS_WKVQ_T + (size_t)NKVQ * 1024 * 2;
constexpr size_t WS_WPQ_T = WS_WOB_T + (size_t)1024 * 1024 * 2;
constexpr size_t WS_WAB = WS_WPQ_T + (size_t)2 * 2048 * 1024 * 2;
constexpr size_t WS_SUBK = WS_WAB + (size_t)16 * 1024 * 4;
constexpr size_t WS_W1T = WS_SUBK + (size_t)2 * 8 * 2 * 128 * 128 * 2;
constexpr size_t WS_PETERM = WS_W1T + (size_t)2 * 128 * 1024 * 2;
constexpr size_t WS_PU = al(WS_PETERM + 512);
constexpr size_t WS_PV = WS_PU + (size_t)2 * NEXP * DM * 2;
constexpr size_t WS_XNA = WS_PV + (size_t)2 * NEXP * DM * 2;
constexpr size_t WS_XNB = al(WS_XNA + (size_t)MTOK * DM * 2);
constexpr size_t WS_PROJ = al(WS_XNB + (size_t)MTOK * DM * 2);
constexpr size_t WS_GW = al(WS_PROJ + (size_t)MTOK * 4096 * 2);
constexpr size_t WS_GQ = WS_GW + (size_t)2048 * 64 * 128 * 2;
constexpr size_t WS_GKT = WS_GQ + (size_t)2048 * 64 * 128 * 2;
constexpr size_t WS_GQK = WS_GKT + (size_t)2048 * 64 * 128 * 2;
constexpr size_t WS_GU = WS_GQK + (size_t)2048 * 64 * 64 * 2;
constexpr size_t WS_GDEC = WS_GU + (size_t)2048 * 64 * 128 * 4;
constexpr size_t WS_OGDN = al(WS_GDEC + 2048 * 4);
constexpr size_t WS_OG = al(WS_OGDN + (size_t)MTOK * DM * 4);
constexpr size_t WS_XS = al(WS_OG + (size_t)MTOK * DM * 2);
constexpr size_t WS_QPEER = al(WS_XS + (size_t)MTOK * DM * 4);
constexpr size_t WS_PEI = al(WS_QPEER + (size_t)MTOK * 2048 * 2);
constexpr size_t WS_PEG = al(WS_PEI + (size_t)MTOK * 128 * 4);
constexpr size_t WS_KVQ = al(WS_PEG + (size_t)MTOK * 128 * 4);
constexpr size_t WS_KSEL = al(WS_KVQ + (size_t)MTOK * NKVQ * 4);
constexpr size_t WS_VSELT = WS_KSEL + (size_t)PB * NG * PT * 64 * 2;
constexpr size_t WS_KWIN = WS_VSELT + (size_t)PB * NG * PT * 64 * 2;
constexpr size_t WS_VWINT = WS_KWIN + (size_t)PB * NG * PT * 64 * 2;
constexpr size_t WS_KCMP = WS_VWINT + (size_t)PB * NG * PT * 64 * 2;
constexpr size_t WS_VCMPT = WS_KCMP + (size_t)PB * NG * 512 * 64 * 2;
constexpr size_t WS_SKCMP = WS_VCMPT + (size_t)PB * NG * 512 * 64 * 2;
constexpr size_t WS_SVCMPT = WS_SKCMP + (size_t)SB * NG * 512 * 64 * 2;
constexpr size_t WS_SKWIN = WS_SVCMPT + (size_t)SB * NG * 512 * 64 * 2;
constexpr size_t WS_SVWINT = WS_SKWIN + (size_t)SB * NG * 544 * 64 * 2;
constexpr size_t WS_SNEW = WS_SVWINT + (size_t)SB * NG * 544 * 64 * 2;
constexpr size_t WS_QN = al(WS_SNEW + (size_t)SB * 4 * 2 * 4 * 64 * 4);
constexpr size_t WS_GATES = al(WS_QN + (size_t)MTOK * 1024 * 2);
constexpr size_t WS_OACC = al(WS_GATES + (size_t)MTOK * 48 * 4);
constexpr size_t WS_CKA = al(WS_OACC + (size_t)MTOK * DM * 4);
constexpr size_t WS_W1BD = al(WS_CKA + (size_t)65536 * 2048 * 2);
constexpr size_t WS_FS = al(WS_W1BD + (size_t)256 * 2048 * 2);
constexpr size_t WS_END = al(WS_FS + (size_t)65536 * 256 * 4);

constexpr int RING_BYTES = 143360;
constexpr int LDSCTL_OFF = RING_BYTES, MISC_OFF = LDSCTL_OFF + 320;
constexpr int LDS_BYTES = 147456;

#define GAS __attribute__((address_space(1)))
#define LAS __attribute__((address_space(3)))
typedef unsigned short bf16;
typedef unsigned v4u __attribute__((ext_vector_type(4)));
typedef unsigned v2u __attribute__((ext_vector_type(2)));
typedef float f32x4 __attribute__((ext_vector_type(4)));
typedef float f32x2 __attribute__((ext_vector_type(2)));
typedef short bf16x8 __attribute__((ext_vector_type(8)));
typedef GAS unsigned gu32;
#define RLX_AGENT __ATOMIC_RELAXED, __HIP_MEMORY_SCOPE_AGENT
#define LDS_WAIT() asm volatile("s_waitcnt lgkmcnt(0)" ::: "memory")
#define VM_WAIT() asm volatile("s_waitcnt vmcnt(0)" ::: "memory")

__device__ __forceinline__ unsigned f2bf(float f) { unsigned u = __builtin_bit_cast(unsigned, f); return (u + 0x7fffu + ((u >> 16) & 1u)) >> 16; }
typedef __bf16 hwbf16x2 __attribute__((ext_vector_type(2)));
__device__ __forceinline__ unsigned pk2(float lo, float hi) { const f32x2 v = {lo, hi}; return __builtin_bit_cast(unsigned, __builtin_convertvector(v, hwbf16x2)); }
__device__ __forceinline__ float bf2f(unsigned b) { return __builtin_bit_cast(float, b << 16); }
__device__ __forceinline__ float bflo(unsigned w) { return __builtin_bit_cast(float, w << 16); }
__device__ __forceinline__ float bfhi(unsigned w) { return __builtin_bit_cast(float, w & 0xffff0000u); }
#ifndef USE_PERMSWAP
#define USE_PERMSWAP 1
#endif
template <int CTRL> __device__ __forceinline__ float dpp_f(float x) { return __builtin_bit_cast(float, __builtin_amdgcn_update_dpp(0, __builtin_bit_cast(int, x), CTRL, 0xF, 0xF, true)); }
template <int CTRL> __device__ __forceinline__ unsigned dpp_u(unsigned x) { return (unsigned)__builtin_amdgcn_update_dpp(0, (int)x, CTRL, 0xF, 0xF, true); }
#define DPP_XOR1 0xB1
#define DPP_XOR2 0x4E
#define DPP_HMIR 0x141
#define DPP_MIR 0x140
#define DPP_ROR4 0x124
#define DPP_ROR8 0x128
#if USE_PERMSWAP
#define PSWAP16(a, b) asm volatile("s_nop 1\n\tv_permlane16_swap_b32 %0, %1" : "+v"(a), "+v"(b))
#define PSWAP32(a, b) asm volatile("s_nop 1\n\tv_permlane32_swap_b32 %0, %1" : "+v"(a), "+v"(b))
__device__ __forceinline__ float x16_sum(float x) { unsigned a = __builtin_bit_cast(unsigned, x), b = a; PSWAP16(a, b); return __builtin_bit_cast(float, a) + __builtin_bit_cast(float, b); }
__device__ __forceinline__ float x32_sum(float x) { unsigned a = __builtin_bit_cast(unsigned, x), b = a; PSWAP32(a, b); return __builtin_bit_cast(float, a) + __builtin_bit_cast(float, b); }
__device__ __forceinline__ float x16_max(float x) { unsigned a = __builtin_bit_cast(unsigned, x), b = a; PSWAP16(a, b); return fmaxf(__builtin_bit_cast(float, a), __builtin_bit_cast(float, b)); }
__device__ __forceinline__ float x32_max(float x) { unsigned a = __builtin_bit_cast(unsigned, x), b = a; PSWAP32(a, b); return fmaxf(__builtin_bit_cast(float, a), __builtin_bit_cast(float, b)); }
__device__ __forceinline__ unsigned x16_umax(unsigned u) { unsigned a = u, b = u; PSWAP16(a, b); return a > b ? a : b; }
__device__ __forceinline__ unsigned x32_umax(unsigned u) { unsigned a = u, b = u; PSWAP32(a, b); return a > b ? a : b; }
#else
__device__ __forceinline__ float x16_sum(float x) { return x + __shfl_xor(x, 16); }
__device__ __forceinline__ float x32_sum(float x) { return x + __shfl_xor(x, 32); }
__device__ __forceinline__ float x16_max(float x) { return fmaxf(x, __shfl_xor(x, 16)); }
__device__ __forceinline__ float x32_max(float x) { return fmaxf(x, __shfl_xor(x, 32)); }
__device__ __forceinline__ unsigned x16_umax(unsigned u) { const unsigned o = __shfl_xor(u, 16); return u > o ? u : o; }
__device__ __forceinline__ unsigned x32_umax(unsigned u) { const unsigned o = __shfl_xor(u, 32); return u > o ? u : o; }
#endif
__device__ __forceinline__ float row_sum16(float x) { x += dpp_f<DPP_XOR1>(x); x += dpp_f<DPP_XOR2>(x); x += dpp_f<DPP_HMIR>(x); x += dpp_f<DPP_MIR>(x); return x; }
__device__ __forceinline__ float wave_sum(float v) { return x32_sum(x16_sum(row_sum16(v))); }
__device__ __forceinline__ float silu_f(float x) { return x / (1.f + __expf(-x)); }
__device__ __forceinline__ float sigmoid_f(float x) { return 1.f / (1.f + __expf(-x)); }
__device__ __forceinline__ float gelu_tanh(float x) {
    const float u = 0.7978845608028654f * (x + 0.044715f * x * x * x);
    const float e = __expf(2.f * u);
    const float th = 1.f - 2.f / (e + 1.f);
    return 0.5f * x * (1.f + th);
}
__device__ __forceinline__ bf16x8 ld8(const bf16* p) { return *(const bf16x8*)p; }
__device__ __forceinline__ bf16x8 ld8l(const LAS bf16* p) { return *(const LAS bf16x8*)p; }
#define MFMA16(a, b, c) __builtin_amdgcn_mfma_f32_16x16x32_bf16((a), (b), (c), 0, 0, 0)
__device__ __forceinline__ bf16x8 cvt8(f32x4 a, f32x4 b) {
    v4u r; r.x = pk2(a.x, a.y); r.y = pk2(a.z, a.w); r.z = pk2(b.x, b.y); r.w = pk2(b.z, b.w); return __builtin_bit_cast(bf16x8, r);
}

struct Frame {
    LAS unsigned char* lds;
    int tid, lane, wave, G, bid;
    const __attribute__((address_space(4))) char* ka;
    float* out;
    unsigned char* ws;
};
#define WSP(T, off) ((T*)(F.ws + (off)))
__device__ __forceinline__ const float* fin_(const __attribute__((address_space(4))) char* ka, int i) {
    const __attribute__((address_space(4))) char* p = ka; asm volatile("" : "+s"(p));
    return *(const float* const __attribute__((address_space(4)))*)(p + 8 * i);
}
#define FIN(i) fin_(F.ka, (i))
namespace pg8 {
#define PG8_LAS __attribute__((address_space(3)))
typedef unsigned short bf16_t;
typedef short bf16x8 __attribute__((ext_vector_type(8)));
typedef float f32x4 __attribute__((ext_vector_type(4)));
typedef unsigned u32x4 __attribute__((ext_vector_type(4)));
constexpr int BM = 256, BK = 64, HALF = 128, HTB = HALF * BK * 2  , STAGE_BYTES = 8 * HTB, NXCD = 8, WGM = 8;

__host__ __device__ __forceinline__ int lds_byte(int r, int c) { const int st = (r >> 4) * 2 + (c >> 5), rr = r & 15, cc = c & 31, ob = rr * 64 + cc * 2; return st * 1024 + (ob ^ (((ob >> 9) & 1) << 5)); }
__host__ __device__ __forceinline__ void stage_rc(int b, int& R, int& C) { const int st = b / 1024, sb = b % 1024, swz = sb ^ (((sb >> 9) & 1) << 5); R = (st >> 1) * 16 + swz / 64; C = (st & 1) * 32 + (swz % 64) / 2; }
__host__ __device__ __forceinline__ int perm32(int rho) { const int n = rho >> 4, i = rho & 15; return 8 * (i >> 2) + 4 * n + (i & 3); }

struct Unit { int pm, pn; };
struct Gemm { const bf16_t* A; const bf16_t* Bt; int M, N, K; };

struct StaticOrder {
    int nM, nN, nwg, G, c;
    __host__ __device__ void init(int M, int N, int G_, int c_) { nM = M / BM; nN = N / BM; nwg = nM * nN; G = G_; c = c_; }
    __host__ __device__ bool next(int i, Unit& u) const {
        const long L = (long)i * G + c; if (L >= nwg) return false;
        int wgid = (int)L; { const int q = nwg / NXCD, r = nwg % NXCD, xcd = wgid % NXCD, off = wgid / NXCD; wgid = (xcd < r ? xcd * (q + 1) : r * (q + 1) + (xcd - r) * q) + off; }
        const int nig = WGM * nN, gid = wgid / nig, fm = gid * WGM, gsz = (nM - fm) < WGM ? (nM - fm) : WGM;
        u.pm = fm + ((wgid % nig) % gsz); u.pn = (wgid % nig) / gsz; return true;
    }
    __device__ __forceinline__ void a_ready(const Unit&) const {}
    __device__ __forceinline__ void done(const Unit&) const {}
};
template <class Epi, class Sched, bool ALIGN_EPI = false, bool SP2 = false>
__device__ __forceinline__ void gemm_phase(PG8_LAS unsigned char* lds, const Gemm g, const Sched& S, const Epi& E) {
    const int tid = threadIdx.x, wid = __builtin_amdgcn_readfirstlane(tid >> 6), lane = tid & 63, wr = wid >> 2, wc = wid & 3, fr = lane & 15, fq = lane >> 4;
    const int K = g.K, nt = K / BK;
    unsigned voffA[2], voffB[2];
#pragma unroll
    for (int i = 0; i < 2; ++i) { int R, C; stage_rc(tid * 16 + i * 8192, R, C); const int Rb = Epi::PERM ? ((R & ~31) + perm32(R & 31)) : R;
        voffA[i] = (unsigned)(R * K + C) * 2u; voffB[i] = (unsigned)(Rb * K + C) * 2u; }
    const size_t kstep = (size_t)(BK * 2);
    const size_t hstep = (size_t)HALF * K * 2;
    const size_t tstep = 2 * hstep;
    const unsigned ldsw = (unsigned)wid * 1024u;
    const int aoff = lds_byte(wr * 64 + fr, fq * 8), boff = lds_byte(wc * 32 + fr, fq * 8);
#define PG8_SA(b, h) (((b) * 2 + (h)) * HTB)
#define PG8_SB(b, h) ((4 + (b) * 2 + (h)) * HTB)
#define PG8_STAGE(bufoff, gbase, voff) do { _Pragma("unroll") for (int _i = 0; _i < 2; ++_i) \
        __builtin_amdgcn_global_load_lds((const unsigned*)((const char*)(gbase) + (voff)[_i]), (PG8_LAS unsigned*)(lds + (bufoff) + ldsw + _i * 8192), 16, 0, 0); } while (0)
#define PG8_LDA(dst, b, h) do { _Pragma("unroll") for (int m = 0; m < 4; ++m) _Pragma("unroll") for (int k = 0; k < 2; ++k) dst[m][k] = *(const PG8_LAS bf16x8*)(lds + PG8_SA(b, h) + aoff + m * 2048 + k * 1024); } while (0)
#define PG8_LDB(dst, b, h) do { _Pragma("unroll") for (int n = 0; n < 2; ++n) _Pragma("unroll") for (int k = 0; k < 2; ++k) dst[n][k] = *(const PG8_LAS bf16x8*)(lds + PG8_SB(b, h) + boff + n * 2048 + k * 1024); } while (0)
#define PG8_MMA(ai, bj, At, Bt) do { __builtin_amdgcn_s_setprio(1); _Pragma("unroll") for (int m = 0; m < 4; ++m) _Pragma("unroll") for (int n = 0; n < 2; ++n) _Pragma("unroll") for (int k = 0; k < 2; ++k) \
        acc[ai][bj][m][n] = __builtin_amdgcn_mfma_f32_16x16x32_bf16(Bt[n][k], At[m][k], acc[ai][bj][m][n], 0, 0, 0); __builtin_amdgcn_s_setprio(0); } while (0)
#define PG8_WAIT_V(n) asm volatile("s_waitcnt vmcnt(" #n ")" ::: "memory")
#define PG8_WAIT_L(n) asm volatile("s_waitcnt lgkmcnt(" #n ")" ::: "memory")
#define PG8_BAR __builtin_amdgcn_s_barrier()
#define PG8_SCHED __builtin_amdgcn_sched_barrier(0)
    Unit cur, nxt; int ui = 0;
    if (!S.next(0, cur)) return;
    f32x4 acc[2][2][4][2];
#pragma unroll
    for (int a = 0; a < 2; ++a)
#pragma unroll
        for (int b = 0; b < 2; ++b)
#pragma unroll
            for (int m = 0; m < 4; ++m)
#pragma unroll
                for (int n = 0; n < 2; ++n) acc[a][b][m][n] = (f32x4){0.f, 0.f, 0.f, 0.f};
    bf16x8 At[4][2], B0[2][2], B1[2][2];
    const char* cA = (const char*)g.A + (size_t)cur.pm * tstep; const char* cB = (const char*)g.Bt + (size_t)cur.pn * tstep;
    S.a_ready(cur);
    if constexpr (SP2) {
        PG8_STAGE(PG8_SB(0, 0), cB, voffB); PG8_STAGE(PG8_SB(0, 1), cB + hstep, voffB); PG8_STAGE(PG8_SA(0, 0), cA, voffA); PG8_STAGE(PG8_SA(0, 1), cA + hstep, voffA);
        if (wr == 1) PG8_BAR;
        PG8_WAIT_V(2); PG8_BAR;
        PG8_STAGE(PG8_SB(1, 0), cB + kstep, voffB); PG8_STAGE(PG8_SA(1, 0), cA + kstep, voffA); PG8_STAGE(PG8_SB(1, 1), cB + hstep + kstep, voffB);
        PG8_WAIT_V(6); PG8_BAR;
    } else {
        PG8_STAGE(PG8_SB(0, 0), cB, voffB); PG8_STAGE(PG8_SA(0, 0), cA, voffA); PG8_STAGE(PG8_SB(0, 1), cB + hstep, voffB); PG8_STAGE(PG8_SA(0, 1), cA + hstep, voffA);
        if (wr == 1) PG8_BAR;
        PG8_WAIT_V(4); PG8_BAR;
        PG8_STAGE(PG8_SB(1, 0), cB + kstep, voffB); PG8_STAGE(PG8_SA(1, 0), cA + kstep, voffA); PG8_STAGE(PG8_SB(1, 1), cB + hstep + kstep, voffB);
        PG8_WAIT_V(6); PG8_BAR;
    }
    for (;;) {
        const bool has_next = S.next(ui + 1, nxt);
        const char* nA = has_next ? (const char*)g.A + (size_t)nxt.pm * tstep : cA; const char* nB = has_next ? (const char*)g.Bt + (size_t)nxt.pn * tstep : cB;
        for (int t = 0; t < nt; t += 2) {
            const bool last = (t == nt - 2);
            const char* a1 = cA + (size_t)(t + 1) * kstep;
            const char* a2 = last ? nA : cA + (size_t)(t + 2) * kstep; const char* b2 = last ? nB : cB + (size_t)(t + 2) * kstep;
            const char* a3 = a2 + kstep; const char* b3 = b2 + kstep;
            if (last && has_next) S.a_ready(nxt);
            if constexpr (SP2) {
            PG8_LDB(B0, 0, 0); PG8_LDB(B1, 0, 1); PG8_SCHED; PG8_LDA(At, 0, 0); PG8_STAGE(PG8_SA(1, 1), a1 + hstep, voffA);
            PG8_WAIT_V(8); PG8_WAIT_L(0); PG8_BAR; PG8_MMA(0, 0, At, B0); PG8_MMA(0, 1, At, B1); PG8_BAR; PG8_SCHED;
            PG8_LDA(At, 0, 1); PG8_STAGE(PG8_SB(0, 0), b2, voffB); PG8_STAGE(PG8_SB(0, 1), b2 + hstep, voffB); PG8_STAGE(PG8_SA(0, 0), a2, voffA);
            PG8_WAIT_V(8); PG8_WAIT_L(0); PG8_BAR; PG8_MMA(1, 0, At, B0); PG8_MMA(1, 1, At, B1); PG8_BAR; PG8_SCHED;
            PG8_LDB(B0, 1, 0); PG8_LDB(B1, 1, 1); PG8_SCHED; PG8_LDA(At, 1, 0); PG8_STAGE(PG8_SA(0, 1), a2 + hstep, voffA);
            PG8_WAIT_V(8); PG8_WAIT_L(0); PG8_BAR; PG8_MMA(0, 0, At, B0); PG8_MMA(0, 1, At, B1); PG8_BAR; PG8_SCHED;
            PG8_LDA(At, 1, 1); PG8_STAGE(PG8_SB(1, 0), b3, voffB); PG8_STAGE(PG8_SB(1, 1), b3 + hstep, voffB); PG8_STAGE(PG8_SA(1, 0), a3, voffA);
            PG8_WAIT_V(8); PG8_WAIT_L(0); PG8_BAR; PG8_MMA(1, 0, At, B0); PG8_MMA(1, 1, At, B1); PG8_BAR; PG8_SCHED;
            } else {
            PG8_LDB(B0, 0, 0); PG8_SCHED; PG8_LDA(At, 0, 0); PG8_STAGE(PG8_SA(1, 1), a1 + hstep, voffA);
            PG8_WAIT_L(8); PG8_BAR; PG8_WAIT_L(0); PG8_MMA(0, 0, At, B0); PG8_BAR; PG8_SCHED;
            PG8_LDB(B1, 0, 1); PG8_STAGE(PG8_SB(0, 0), b2, voffB);
            PG8_BAR; PG8_WAIT_L(0); PG8_MMA(0, 1, At, B1); PG8_BAR;
            PG8_LDA(At, 0, 1); PG8_STAGE(PG8_SA(0, 0), a2, voffA);
            PG8_BAR; PG8_WAIT_L(0); PG8_MMA(1, 0, At, B0); PG8_BAR; PG8_SCHED;
            PG8_STAGE(PG8_SB(0, 1), b2 + hstep, voffB);
            PG8_WAIT_V(6); PG8_BAR; PG8_MMA(1, 1, At, B1); PG8_BAR;
            PG8_LDB(B0, 1, 0); PG8_SCHED; PG8_LDA(At, 1, 0); PG8_STAGE(PG8_SA(0, 1), a2 + hstep, voffA);
            PG8_WAIT_L(8); PG8_BAR; PG8_WAIT_L(0); PG8_MMA(0, 0, At, B0); PG8_BAR; PG8_SCHED;
            PG8_LDB(B1, 1, 1); PG8_STAGE(PG8_SB(1, 0), b3, voffB);
            PG8_BAR; PG8_WAIT_L(0); PG8_MMA(0, 1, At, B1); PG8_BAR;
            PG8_LDA(At, 1, 1); PG8_STAGE(PG8_SA(1, 0), a3, voffA);
            PG8_BAR; PG8_WAIT_L(0); PG8_MMA(1, 0, At, B0); PG8_BAR; PG8_SCHED;
            PG8_STAGE(PG8_SB(1, 1), b3 + hstep, voffB);
            PG8_WAIT_V(6); PG8_BAR; PG8_MMA(1, 1, At, B1); PG8_BAR;
            }
        }
        if constexpr (ALIGN_EPI) { if (wr == 0) PG8_BAR; }
        if constexpr (!Epi::AFTER_DRAIN) { E(acc, cur, wr, wc, fr, fq); S.done(cur); }
        if (!has_next) break;
#pragma unroll
        for (int a = 0; a < 2; ++a)
#pragma unroll
            for (int b = 0; b < 2; ++b)
#pragma unroll
                for (int m = 0; m < 4; ++m)
#pragma unroll
                    for (int n = 0; n < 2; ++n) acc[a][b][m][n] = (f32x4){0.f, 0.f, 0.f, 0.f};
        cur = nxt; cA = nA; cB = nB; ++ui;
        if constexpr (ALIGN_EPI) { if (wr == 1) PG8_BAR; }
    }
    PG8_WAIT_V(0);
    if constexpr (!ALIGN_EPI) { if (wr == 0) PG8_BAR; }
    PG8_BAR;
    if constexpr (Epi::AFTER_DRAIN) { E.fused(acc, cur, wr, wc, fr, fq, lds, wid, lane); S.done(cur); }
#undef PG8_SA
#undef PG8_SB
#undef PG8_STAGE
#undef PG8_LDA
#undef PG8_LDB
#undef PG8_MMA
#undef PG8_WAIT_V
#undef PG8_WAIT_L
#undef PG8_BAR
#undef PG8_SCHED
}
}
#define XB_TMO      128
#define XB_XCNT(j)  (256  + 64 * (j))
#define XB_XSUB(j)  (1280 + 64 * (j))
#define XB_XGEN(j)  (2304 + 64 * (j))
#define XB_TOP      3328
#define XB_TOPGEN   3392
#define XCD_BAR_WORDS 3456
#define XB_SPIN_CAP (1u << 18)

__device__ __forceinline__ unsigned xb_ld(unsigned* p)              { return __hip_atomic_load(p, __ATOMIC_RELAXED, __HIP_MEMORY_SCOPE_AGENT); }
__device__ __forceinline__ unsigned xb_add(unsigned* p, unsigned v) { return __hip_atomic_fetch_add(p, v, __ATOMIC_RELAXED, __HIP_MEMORY_SCOPE_AGENT); }
__device__ __forceinline__ unsigned xb_xcc_id() { return (unsigned)__builtin_amdgcn_s_getreg((3 << 11) | 20) & 0xFu; }
#define XB_SPIN(cond, bar) do { unsigned _sp = 0; while (cond) { __builtin_amdgcn_s_sleep(1); \
    if ((++_sp & 255u) == 0u) { if (xb_ld(&(bar)[XB_TMO])) break; if (_sp > XB_SPIN_CAP) { atomicAdd(&(bar)[XB_TMO], 1u); break; } } } } while (0)

struct XcdBarrier {
    unsigned* bar; unsigned x;
    volatile LAS unsigned* st;
};

__device__ __forceinline__ XcdBarrier xcd_barrier_post(unsigned* bar, volatile LAS unsigned* st) {
    XcdBarrier b; b.bar = bar; b.x = xb_xcc_id(); b.st = st;
    if (threadIdx.x == 0) (void)xb_add(&bar[XB_XCNT(b.x)], 1u);
    return b;
}
__device__ __forceinline__ void xcd_barrier_complete(unsigned* bar, unsigned x, unsigned& nloc, unsigned& nx) {
    const unsigned G = gridDim.x * gridDim.y * gridDim.z;
    unsigned sum, cnt, mine, sp = 0u;
    for (;;) {
        sum = 0u; cnt = 0u; mine = 0u;
#pragma unroll
        for (unsigned j = 0; j < 16; ++j) { const unsigned c = xb_ld(&bar[XB_XCNT(j)]); sum += c; cnt += (c > 0u) ? 1u : 0u; mine = (j == x) ? c : mine; }
        if (sum == G) break;
        __builtin_amdgcn_s_sleep(1);
        if ((++sp & 255u) == 0u) { if (xb_ld(&bar[XB_TMO])) break; if (sp > XB_SPIN_CAP) { atomicAdd(&bar[XB_TMO], 1u); break; } }
    }
    nloc = mine > 0u ? mine : 1u; nx = cnt > 0u ? cnt : 1u;
}

__device__ __forceinline__ void xcd_barrier(const XcdBarrier& b) {
    asm volatile("s_waitcnt vmcnt(0)" ::: "memory");
    __syncthreads();
    if (threadIdx.x == 0) {
        unsigned* bar = b.bar;
        __builtin_amdgcn_s_waitcnt(0);
        unsigned nloc = b.st[0], nx = b.st[1];
        if (nloc == 0u) { xcd_barrier_complete(bar, b.x, nloc, nx); b.st[0] = nloc; b.st[1] = nx; }
        const unsigned old = xb_add(&bar[XB_XSUB(b.x)], 1u);
        const unsigned gen = old / nloc;
        if (old + 1u == (gen + 1u) * nloc) {
            __builtin_amdgcn_fence(__ATOMIC_RELEASE, "agent");
            asm volatile("s_waitcnt vmcnt(0)" ::: "memory");
            const unsigned og = xb_add(&bar[XB_TOP], 1u);
            const unsigned tg = og / nx;
            if (og + 1u == (tg + 1u) * nx) xb_add(&bar[XB_TOPGEN], 1u);
            else XB_SPIN(xb_ld(&bar[XB_TOPGEN]) == tg, bar);
            __builtin_amdgcn_fence(__ATOMIC_ACQUIRE, "agent");
            xb_add(&bar[XB_XGEN(b.x)], 1u);
            asm volatile("s_waitcnt vmcnt(0)" ::: "memory");
        } else {
            XB_SPIN(xb_ld(&bar[XB_XGEN(b.x)]) == gen, bar);
            __builtin_amdgcn_fence(__ATOMIC_ACQUIRE, "agent");
            asm volatile("s_waitcnt vmcnt(0)" ::: "memory");
        }
    }
    __syncthreads();
}

namespace pg8 {
template <class Fn> struct EpiFn {
    static constexpr bool PERM = true, AFTER_DRAIN = false;
    Fn f;
    __device__ __forceinline__ void operator()(const f32x4 (&acc)[2][2][4][2], const Unit& u, int wr, int wc, int fr, int fq) const {
        const int row0 = u.pm * BM + wr * 64 + fr, col0 = u.pn * BM + wc * 32 + 8 * fq;
#pragma unroll
        for (int ai = 0; ai < 2; ++ai)
#pragma unroll
            for (int m = 0; m < 4; ++m)
#pragma unroll
                for (int bj = 0; bj < 2; ++bj) f.e8(row0 + ai * HALF + m * 16, col0 + bj * HALF, acc[ai][bj][m][0], acc[ai][bj][m][1]);
    }
};
}

struct FnBf16 {
    bf16* O; int ld;
    __device__ __forceinline__ void e8(int row, int col, f32x4 a, f32x4 b) const {
        v4u w; w.x = pk2(a.x, a.y); w.y = pk2(a.z, a.w); w.z = pk2(b.x, b.y); w.w = pk2(b.z, b.w);
        *(v4u*)(O + (size_t)row * ld + col) = w;
    }
    __device__ __forceinline__ void e4(int row, int col, f32x4 a) const {
        v2u w; w.x = pk2(a.x, a.y); w.y = pk2(a.z, a.w);
        *(v2u*)(O + (size_t)row * ld + col) = w;
    }
};
struct FnResid {
    float* XS; const float* baseP; const float* baseS;
    __device__ __forceinline__ const float* brow(int row) const { return row < MP ? baseP + (size_t)row * DM : baseS + (size_t)(row - MP) * DM; }
    __device__ __forceinline__ void e8(int row, int col, f32x4 a, f32x4 b) const {
        const float* br = brow(row) + col; float* o = XS + (size_t)row * DM + col;
        const f32x4 x0 = *(const f32x4*)br, x1 = *(const f32x4*)(br + 4);
        *(f32x4*)o = x0 + a; *(f32x4*)(o + 4) = x1 + b;
    }
    __device__ __forceinline__ void e4(int row, int col, f32x4 a) const {
        const float* br = brow(row) + col; float* o = XS + (size_t)row * DM + col;
        *(f32x4*)o = *(const f32x4*)br + a;
    }
};
struct FnF32 {
    float* O; int ld;
    __device__ __forceinline__ void e8(int row, int col, f32x4 a, f32x4 b) const { float* o = O + (size_t)row * ld + col; *(f32x4*)o = a; *(f32x4*)(o + 4) = b; }
    __device__ __forceinline__ void e4(int row, int col, f32x4 a) const { *(f32x4*)(O + (size_t)row * ld + col) = a; }
};
struct FnKvq {
    float* O;
    __device__ __forceinline__ void e8(int row, int col, f32x4 a, f32x4 b) const {
        if (col < NKVQ_REAL) { float* o = O + (size_t)row * NKVQ + col; *(f32x4*)o = a; *(f32x4*)(o + 4) = b; }
    }
    __device__ __forceinline__ void e4(int row, int col, f32x4 a) const {
        if (col < NKVQ_REAL) *(f32x4*)(O + (size_t)row * NKVQ + col) = a;
    }
};

template <class Fn>
__device__ __forceinline__ void skinny_gemm(Frame& F, const bf16* A, const bf16* Bt, int N, int row_base, const Fn& fn) {
    const int fr = F.lane & 15, fq = F.lane >> 4;
    const int nun = N / 16;
    for (int u = F.bid; u < nun; u += F.G) {
        const bf16* ap = Bt + (size_t)(u * 16 + fr) * DM + fq * 8;
        const bf16* bp = A + (size_t)(F.wave * 16 + fr) * DM + fq * 8;
        f32x4 acc = {0.f, 0.f, 0.f, 0.f};
#pragma unroll 8
        for (int ks = 0; ks < 32; ++ks) acc = MFMA16(ld8(ap + ks * 32), ld8(bp + ks * 32), acc);
        fn.e4(row_base + F.wave * 16 + fr, u * 16 + 4 * fq, acc);
    }
}

template <class Fn>
__device__ __forceinline__ void gemm_all(Frame& F, const bf16* A, const bf16* Bt, int N, const Fn& fn) {
    pg8::Gemm g{A, Bt, MP, N, DM}; pg8::StaticOrder S; S.init(MP, N, F.G, F.bid);
    pg8::EpiFn<Fn> E{fn};
    pg8::gemm_phase<pg8::EpiFn<Fn>, pg8::StaticOrder, true, true>(F.lds, g, S, E);
    skinny_gemm(F, A + (size_t)MP * DM, Bt, N, MP, fn);
}

__device__ __forceinline__ void p0_transpose_item(const float* W, int N, bf16* WT, int row_off, const float* gain, LAS float* scr, int item, int lane) {
    const int nblk = (N + 31) / 32, kb = item / nblk, nb = item % nblk, k0 = 64 * kb, n0 = 32 * nb;
#pragma unroll 8
    for (int i = 0; i < 32; ++i) { const int kk = 2 * i + (lane >> 5); const int n = n0 + (lane & 31);
        float v = 0.f; if (n < N) { v = W[(size_t)(k0 + kk) * N + n]; if (gain) v *= gain[k0 + kk]; }
        scr[kk * 33 + (lane & 31)] = v; }
    LDS_WAIT(); asm volatile("" ::: "memory");
    const int c = lane & 7;
#pragma unroll
    for (int j = 0; j < 4; ++j) { const int n = (lane >> 3) + 8 * j; const LAS float* s = scr + (8 * c) * 33 + n;
        v4u o; o.x = pk2(s[0 * 33], s[1 * 33]); o.y = pk2(s[2 * 33], s[3 * 33]); o.z = pk2(s[4 * 33], s[5 * 33]); o.w = pk2(s[6 * 33], s[7 * 33]);
        if (n0 + n < N) *(v4u*)(WT + (size_t)(row_off + n0 + n) * DM + k0 + 8 * c) = o; }
    LDS_WAIT(); asm volatile("" ::: "memory");
}
__device__ __forceinline__ void rms_row_to_bf16(const float* xrow, bf16* orow, int lane) {
    const f32x4* xr = (const f32x4*)xrow + lane;
    f32x4 v[4]; float s = 0.f;
#pragma unroll
    for (int j = 0; j < 4; ++j) { v[j] = xr[64 * j]; s += (v[j].x * v[j].x + v[j].y * v[j].y) + (v[j].z * v[j].z + v[j].w * v[j].w); }
    const float rstd = 1.f / sqrtf(wave_sum(s) * (1.f / DM) + EPS);
    v2u* o8 = (v2u*)orow + lane;
#pragma unroll
    for (int j = 0; j < 4; ++j) { v2u w; w.x = pk2(v[j].x * rstd, v[j].y * rstd); w.y = pk2(v[j].z * rstd, v[j].w * rstd); o8[64 * j] = w; }
}
__device__ __forceinline__ const float* xin_row(Frame& F, int row) { return row < MP ? FIN(0) + (size_t)row * DM : FIN(1) + (size_t)(row - MP) * DM; }

__device__ __forceinline__ void p0_prologue(Frame& F) {
    LAS float* scr = (LAS float*)(F.lds + F.wave * 16384);
    const int gw = F.bid * 8 + F.wave, NGW = F.G * 8;
    const int gt = F.bid * 512 + F.tid, NGT = F.G * 512;
    {
        constexpr int I_IN = 128 * 16, I_OA = 32 * 16, I_KV = 48 * 16, I_QG = 34 * 16, I_OB = 32 * 16, I_PQ = 64 * 16;
        constexpr int NITEMS = I_IN + I_OA + I_KV + I_QG + I_OB + 2 * I_PQ;
        for (int it = gw; it < NITEMS; it += NGW) {
            int r = it;
            if (r < I_IN) {
                const int kb = r / 128, nb = r % 128, k0 = 64 * kb, n0 = 32 * nb; const float* W = FIN(8); const float* gain = FIN(7);
#pragma unroll 8
                for (int i = 0; i < 32; ++i) { const int kk = 2 * i + (F.lane >> 5); scr[kk * 33 + (F.lane & 31)] = W[(size_t)(k0 + kk) * GPROJ + n0 + (F.lane & 31)] * gain[k0 + kk]; }
                LDS_WAIT(); asm volatile("" ::: "memory");
                const int c = F.lane & 7;
#pragma unroll
                for (int j = 0; j < 4; ++j) { const int n = (F.lane >> 3) + 8 * j; const LAS float* s = scr + (8 * c) * 33 + n;
                    v4u o; o.x = pk2(s[0 * 33], s[1 * 33]); o.y = pk2(s[2 * 33], s[3 * 33]); o.z = pk2(s[4 * 33], s[5 * 33]); o.w = pk2(s[6 * 33], s[7 * 33]);
                    *(v4u*)(WSP(bf16, WS_WIN_T) + (size_t)(n0 + n) * DM + k0 + 8 * c) = o; }
                LDS_WAIT(); asm volatile("" ::: "memory");
                continue; }
            r -= I_IN;
            if (r < I_OA) { p0_transpose_item(FIN(13), 1024, WSP(bf16, WS_WOA_T), 0, nullptr, scr, r, F.lane); continue; } r -= I_OA;
            if (r < I_KV) { p0_transpose_item(FIN(15), NKV, WSP(bf16, WS_WKVQ_T), 0, FIN(14), scr, r, F.lane); continue; } r -= I_KV;
            if (r < I_QG) { p0_transpose_item(FIN(21), NQG, WSP(bf16, WS_WKVQ_T), NKV, FIN(20), scr, r, F.lane); continue; } r -= I_QG;
            if (r < I_OB) { p0_transpose_item(FIN(23), 1024, WSP(bf16, WS_WOB_T), 0, nullptr, scr, r, F.lane); continue; } r -= I_OB;
            if (r < I_PQ) { p0_transpose_item(FIN(25), 2048, WSP(bf16, WS_WPQ_T), 0, FIN(24), scr, r, F.lane); continue; } r -= I_PQ;
            p0_transpose_item(FIN(25) + (size_t)1024 * 2048, 2048, WSP(bf16, WS_WPQ_T) + (size_t)2048 * 1024, 0, FIN(24) + 1024, scr, r, F.lane);
        }
        for (int i = gt; i < (NKVQ - NKVQ_REAL) * DM / 8; i += NGT) ((v4u*)(WSP(bf16, WS_WKVQ_T) + (size_t)NKVQ_REAL * DM))[i] = (v4u){0u, 0u, 0u, 0u};
        for (int i = gt; i < 16 * 1024; i += NGT) { const int j = i >> 10, k = i & 1023; WSP(float, WS_WAB)[i] = FIN(7)[k] * FIN(8)[(size_t)k * GPROJ + 4096 + j]; }
    }
    for (int m = gw; m < MTOK; m += NGW) rms_row_to_bf16(xin_row(F, m), WSP(bf16, WS_XNA) + (size_t)m * DM, F.lane);
    {
        const size_t n8 = (size_t)2 * NEXP * DM / 8;
        for (int t = 0; t < 2; ++t) { const f32x4* src = (const f32x4*)FIN(27 + t); v2u* dst = (v2u*)WSP(unsigned char, t == 0 ? WS_PU : WS_PV); const float* pln = FIN(24);
            for (size_t i0 = gt; i0 < n8; i0 += (size_t)4 * NGT) {
                f32x4 a[4], b[4];
#pragma unroll
                for (int u = 0; u < 4; ++u) { const size_t i = i0 + (size_t)u * NGT; if (i < n8) { a[u] = src[2 * i]; b[u] = src[2 * i + 1]; } }
#pragma unroll
                for (int u = 0; u < 4; ++u) { const size_t i = i0 + (size_t)u * NGT; if (i < n8) {
                    if (t == 0) { const float* gp = pln + ((i >> 21) << 10) + ((i & 127) << 3); a[u] = a[u] * *(const f32x4*)gp * 32.f; b[u] = b[u] * *(const f32x4*)(gp + 4) * 32.f; }
                    else { a[u] = a[u] * 16.f; b[u] = b[u] * 16.f; }
                    int w0 = __builtin_amdgcn_cvt_pk_fp8_f32(a[u].x, a[u].y, 0, false); w0 = __builtin_amdgcn_cvt_pk_fp8_f32(a[u].z, a[u].w, w0, true);
                    int w1 = __builtin_amdgcn_cvt_pk_fp8_f32(b[u].x, b[u].y, 0, false); w1 = __builtin_amdgcn_cvt_pk_fp8_f32(b[u].z, b[u].w, w1, true);
                    dst[i] = (v2u){(unsigned)w0, (unsigned)w1}; } } } }
        const f32x4* sk = (const f32x4*)FIN(26); v4u* dk = (v4u*)WSP(bf16, WS_SUBK);
        for (int i = gt; i < 2 * 8 * 2 * 128 * 128 / 8; i += NGT) { const f32x4 a = sk[2 * i], b = sk[2 * i + 1]; v4u w; w.x = pk2(a.x, a.y); w.y = pk2(a.z, a.w); w.z = pk2(b.x, b.y); w.w = pk2(b.z, b.w); dk[i] = w; }
    }
    for (int i = gt; i < 2 * 64 * 2048; i += NGT) { const int kv = i >> 17, hh = (i >> 11) & 63, k = i & 2047;
        WSP(bf16, WS_W1T)[i] = (bf16)f2bf(FIN(17)[((size_t)kv * 2048 + k) * 64 + hh]); }
    for (int it = gw; it < 128; it += NGW) { const int kv = it >> 6, h = it & 63; float s = 0.f;
        for (int k = F.lane; k < 2048; k += 64) s += FIN(18)[(size_t)kv * 2048 + k] * FIN(17)[((size_t)kv * 2048 + k) * 64 + h];
        s = wave_sum(s); if (F.lane == 0) WSP(float, WS_PETERM)[it] = s; }
    {
        const float* cache = FIN(2); const int* pt = (const int*)FIN(6); bf16* cka = WSP(bf16, WS_CKA);
        const int nitem = SB * PAST * 2 * 4 * 8;
        for (int i0 = gt; i0 < nitem; i0 += 4 * NGT) {
            f32x4 a[4], b[4];
#pragma unroll
            for (int u = 0; u < 4; ++u) { const int i = i0 + u * NGT; if (i < nitem) {
                const int d8 = i & 7, g = (i >> 3) & 3, kv = (i >> 5) & 1, t = (i >> 6) & 8191, bs = i >> 19;
                const float* src = cache + ((size_t)pt[bs * NPAGES + (t >> 7)] * PAGE + (t & 127)) * 1024 + kv * 256 + g * 64 + d8 * 8;
                a[u] = *(const f32x4*)src; b[u] = *(const f32x4*)(src + 4); } }
#pragma unroll
            for (int u = 0; u < 4; ++u) { const int i = i0 + u * NGT; if (i < nitem) {
                const int d8 = i & 7, g = (i >> 3) & 3, kv = (i >> 5) & 1, t = (i >> 6) & 8191, bs = i >> 19;
                v4u w; w.x = pk2(a[u].x, a[u].y); w.y = pk2(a[u].z, a[u].w); w.z = pk2(b[u].x, b[u].y); w.w = pk2(b[u].z, b[u].w);
                *(v4u*)(cka + ((size_t)((bs * 4 + g) * 512 + (t >> 4))) * 2048 + kv * 1024 + (t & 15) * 64 + d8 * 8) = w; } }
        }
        bf16* wbd = WSP(bf16, WS_W1BD);
        for (int i = gt; i < 256 * 2048; i += NGT) { const int n = i >> 11, col = i & 2047, kv = n >> 7, sec = (n >> 6) & 1, hh = n & 63;
            float v = 0.f; if ((col >> 10) == kv) { const int k = col & 1023, r = (k >> 6) + 16 * sec, d = k & 63; v = FIN(17)[(((size_t)kv * 32 + r) * 64 + d) * 64 + hh]; }
            wbd[i] = (bf16)f2bf(v); }
    }
    {
        const f32x4* src = (const f32x4*)FIN(3); f32x4* dst = (f32x4*)(F.out + O_WINS);
        const int per_b = 508 * 512 / 4;
        for (int i = gt; i < SB * per_b; i += NGT) { const int b = i / per_b, r = i % per_b; dst[(size_t)b * (512 * 512 / 4) + r] = src[(size_t)b * (512 * 512 / 4) + 4 * 512 / 4 + r]; }
    }
    for (int i = gt; i < SB * NG * 544 * 64; i += NGT) {
        const int d = i & 63, r = (i >> 6) % 544, bg = (i >> 6) / 544, g = bg & 3, b = bg >> 2;
        if (r < 512) { const float* cw = FIN(3) + (((size_t)b * 512 + r) * 2) * 256 + g * 64 + d;
            WSP(bf16, WS_SKWIN)[i] = (bf16)f2bf(cw[0]);
            WSP(bf16, WS_SVWINT)[((size_t)bg * 64 + d) * 544 + r] = (bf16)f2bf(cw[256]); }
        else if (r >= 516) { WSP(bf16, WS_SKWIN)[i] = 0; WSP(bf16, WS_SVWINT)[((size_t)bg * 64 + d) * 544 + r] = 0; }
    }
}

constexpr int P2_QS = 0, P2_KS = 17408, P2_KBGT = 34816, P2_VBT = 53248, P2_AM = 71680, P2_TB = 89088, P2_G = 98304, P2_TF = 99328, P2_XF = 116736;
constexpr int QS_LD = 136, KT_LD = 72, AM_LD = 68, TB_LD = 72;

__device__ __forceinline__ float softplus_f(float x) { return fmaxf(x, 0.f) + log1pf(expf(-fabsf(x))); }

__device__ __forceinline__ void p2_chunk(Frame& F, int unit) {
    const int c = unit & 127, h = (unit >> 7) & 7, b = unit >> 10;
    const int t0 = c * CHUNK, lane = F.lane, w = F.wave, fr = lane & 15, fq = lane >> 4;
    LAS unsigned char* L = F.lds; asm volatile("" : "+v"(L));
    LAS bf16* qs = (LAS bf16*)(L + P2_QS); LAS bf16* ks = (LAS bf16*)(L + P2_KS);
    LAS bf16* kbgT = (LAS bf16*)(L + P2_KBGT); LAS bf16* vbT = (LAS bf16*)(L + P2_VBT);
    LAS float* Am = (LAS float*)(L + P2_AM); LAS bf16* Tb = (LAS bf16*)(L + P2_TB);
    LAS float* Gs = (LAS float*)(L + P2_G);
    const bf16* PROJ = WSP(bf16, WS_PROJ); const bf16* XNA = WSP(bf16, WS_XNA); const float* WAB = WSP(float, WS_WAB);
    const size_t rowb = (size_t)b * PT;
    float beta_r[8];
    {
        f32x4 wa[4], wb[4];
        const float* pa = WAB + (size_t)h * DM + 8 * lane; const float* pb = WAB + (size_t)(8 + h) * DM + 8 * lane;
        wa[0] = *(const f32x4*)pa; wa[1] = *(const f32x4*)(pa + 4); wa[2] = *(const f32x4*)(pa + 512); wa[3] = *(const f32x4*)(pa + 516);
        wb[0] = *(const f32x4*)pb; wb[1] = *(const f32x4*)(pb + 4); wb[2] = *(const f32x4*)(pb + 512); wb[3] = *(const f32x4*)(pb + 516);
        const float Aneg = -expf(FIN(10)[h]), dtb = FIN(11)[h];
#pragma unroll
        for (int tk = 0; tk < 8; ++tk) {
            const int tok = 8 * w + tk; const bf16* xr = XNA + (rowb + t0 + tok) * DM + 8 * lane;
            const v4u x0 = *(const v4u*)xr, x1 = *(const v4u*)(xr + 512);
            float sa = 0.f, sb = 0.f;
#define ACC2(xw, wv0, wv1, i0) { const float lo = bflo(xw), hi = bfhi(xw); sa += lo * wv0[i0] + hi * wv0[i0 + 1]; sb += lo * wv1[i0] + hi * wv1[i0 + 1]; }
            ACC2(x0.x, wa[0], wb[0], 0) ACC2(x0.y, wa[0], wb[0], 2) ACC2(x0.z, wa[1], wb[1], 0) ACC2(x0.w, wa[1], wb[1], 2)
            ACC2(x1.x, wa[2], wb[2], 0) ACC2(x1.y, wa[2], wb[2], 2) ACC2(x1.z, wa[3], wb[3], 0) ACC2(x1.w, wa[3], wb[3], 2)
#undef ACC2
            sa = wave_sum(sa); sb = wave_sum(sb);
            const float g = Aneg * softplus_f(sa + dtb), be = 1.f / (1.f + expf(-sb));
            beta_r[tk] = be;
            if (lane == 0) { Gs[tok] = g; Gs[64 + tok] = be; }
        }
    }
#pragma unroll
    for (int p = 0; p < 3; ++p) {
        const int col0 = p * 1024 + h * 128 + 2 * lane;
        float cw0[4], cw1[4];
#pragma unroll
        for (int i = 0; i < 4; ++i) { const f32x2 cv = *(const f32x2*)(FIN(9) + (size_t)i * GCONV + col0); cw0[i] = cv.x; cw1[i] = cv.y; }
        unsigned xw[11];
#pragma unroll
        for (int rr = 0; rr < 11; ++rr) { const int t = t0 + 8 * w - 3 + rr; xw[rr] = (t >= 0) ? *(const unsigned*)(PROJ + (rowb + t) * 4096 + col0) : 0u; }
        if (c == 127 && w == 7) {
#pragma unroll
            for (int r = 0; r < 3; ++r) { float* o = F.out + O_CONVP + ((size_t)b * 3 + r) * GCONV + col0; o[0] = bflo(xw[8 + r]); o[1] = bfhi(xw[8 + r]); }
        }
#pragma unroll
        for (int tk = 0; tk < 8; ++tk) {
            const int tok = 8 * w + tk;
            float y0 = 0.f, y1 = 0.f;
#pragma unroll
            for (int i = 0; i < 4; ++i) { y0 += cw0[i] * bflo(xw[tk + i]); y1 += cw1[i] * bfhi(xw[tk + i]); }
            y0 = silu_f(y0); y1 = silu_f(y1);
            if (p < 2) {
                const float ss = wave_sum(y0 * y0 + y1 * y1);
                const float rs = (1.f / sqrtf(ss + EPS)) * (p == 0 ? 0.08838834764831845f : 1.f);
                *(LAS unsigned*)((p == 0 ? qs : ks) + tok * QS_LD + 2 * lane) = pk2(y0 * rs, y1 * rs);
            } else {
                vbT[(2 * lane) * KT_LD + tok] = (bf16)f2bf(y0 * beta_r[tk]); vbT[(2 * lane + 1) * KT_LD + tok] = (bf16)f2bf(y1 * beta_r[tk]);
            }
        }
    }
    __syncthreads();
    if (w == 0) { float g = Gs[lane];
#pragma unroll
        for (int o = 1; o < 64; o <<= 1) { const float up = __shfl_up(g, o); if (lane >= o) g += up; }
        Gs[128 + lane] = g; }
    __syncthreads();
    const float glast = Gs[128 + 63];
    const size_t chunk = (size_t)unit;
    if (w < 4) {
        const int mt = w;
        bf16x8 a[4];
#pragma unroll
        for (int kk = 0; kk < 4; ++kk) a[kk] = ld8l(ks + (16 * mt + fr) * QS_LD + 32 * kk + 8 * fq);
#pragma unroll
        for (int nt = 0; nt < 4; ++nt) {
            f32x4 acc = {0.f, 0.f, 0.f, 0.f};
            if (nt <= mt) {
#pragma unroll
                for (int kk = 0; kk < 4; ++kk) acc = MFMA16(a[kk], ld8l(ks + (16 * nt + fr) * QS_LD + 32 * kk + 8 * fq), acc);
            }
            const int j = 16 * nt + fr; const float gj = Gs[128 + j];
#pragma unroll
            for (int r = 0; r < 4; ++r) { const int i = 16 * mt + 4 * fq + r;
                Am[i * AM_LD + j] = (i > j) ? Gs[64 + i] * acc[r] * __expf(Gs[128 + i] - gj) : 0.f; }
        }
    } else {
        const int nt = w - 4;
        bf16x8 bq[4];
#pragma unroll
        for (int kk = 0; kk < 4; ++kk) bq[kk] = ld8l(qs + (16 * nt + fr) * QS_LD + 32 * kk + 8 * fq);
        const int i = 16 * nt + fr; const float gi = Gs[128 + i];
        bf16* gqk = WSP(bf16, WS_GQK) + chunk * 4096 + (size_t)i * 64;
#pragma unroll
        for (int mt = 0; mt < 4; ++mt) {
            f32x4 acc = {0.f, 0.f, 0.f, 0.f};
            if (mt <= nt) {
#pragma unroll
                for (int kk = 0; kk < 4; ++kk) acc = MFMA16(ld8l(ks + (16 * mt + fr) * QS_LD + 32 * kk + 8 * fq), bq[kk], acc);
            }
            float v[4];
#pragma unroll
            for (int r = 0; r < 4; ++r) { const int j = 16 * mt + 4 * fq + r; v[r] = (i >= j) ? acc[r] * __expf(gi - Gs[128 + j]) : 0.f; }
            v2u o; o.x = pk2(v[0], v[1]); o.y = pk2(v[2], v[3]);
            *(v2u*)(gqk + 16 * mt + 4 * fq) = o;
        }
    }
    {
        const int tok = F.tid >> 3, d0 = (F.tid & 7) * 16; const float e = __expf(Gs[128 + tok]);
        bf16* gq = WSP(bf16, WS_GQ) + chunk * 8192 + (size_t)tok * 128 + d0;
#pragma unroll
        for (int hh = 0; hh < 2; ++hh) { const v4u q = *(const LAS v4u*)(qs + tok * QS_LD + d0 + 8 * hh); v4u o;
            o.x = pk2(bflo(q.x) * e, bfhi(q.x) * e); o.y = pk2(bflo(q.y) * e, bfhi(q.y) * e); o.z = pk2(bflo(q.z) * e, bfhi(q.z) * e); o.w = pk2(bflo(q.w) * e, bfhi(q.w) * e);
            *(v4u*)(gq + 8 * hh) = o; }
    }
    {
        const int dk = F.tid & 127, tg = F.tid >> 7;
        unsigned o1[8], o2[8];
#pragma unroll
        for (int i = 0; i < 8; ++i) {
            const int ta = 16 * tg + 2 * i, tb2 = ta + 1;
            const float ka = bf2f(ks[ta * QS_LD + dk]), kb = bf2f(ks[tb2 * QS_LD + dk]);
            const float ga = Gs[128 + ta], gb = Gs[128 + tb2];
            o1[i] = pk2(ka * Gs[64 + ta] * __expf(ga), kb * Gs[64 + tb2] * __expf(gb));
            o2[i] = pk2(ka * __expf(glast - ga), kb * __expf(glast - gb));
        }
        LAS v4u* d1 = (LAS v4u*)(kbgT + dk * KT_LD + 16 * tg); d1[0] = (v4u){o1[0], o1[1], o1[2], o1[3]}; d1[1] = (v4u){o1[4], o1[5], o1[6], o1[7]};
        v4u* d2 = (v4u*)(WSP(bf16, WS_GKT) + chunk * 8192 + (size_t)dk * 64 + 16 * tg); d2[0] = (v4u){o2[0], o2[1], o2[2], o2[3]}; d2[1] = (v4u){o2[4], o2[5], o2[6], o2[7]};
    }
    if (F.tid == 0) WSP(float, WS_GDEC)[chunk] = __expf(glast);
    __syncthreads();
    LAS float* Tf = (LAS float*)(L + P2_TF); LAS float* Xf = (LAS float*)(L + P2_XF);
    if (w == 0) {
        const int blk = lane >> 5, cc = lane & 31; const LAS float* Ab = Am + (32 * blk) * AM_LD + 32 * blk;
        float t[32];
#pragma unroll
        for (int i = 0; i < 32; ++i) {
            float acc0 = (i == cc) ? 1.f : 0.f, acc1 = 0.f;
#pragma unroll
            for (int j4 = 0; j4 < (i + 3) / 4; ++j4) {
                const f32x4 a = *(const LAS f32x4*)(Ab + i * AM_LD + 4 * j4);
                if (4 * j4 + 0 < i) acc0 = __builtin_fmaf(-a.x, t[4 * j4 + 0], acc0);
                if (4 * j4 + 1 < i) acc1 = __builtin_fmaf(-a.y, t[4 * j4 + 1], acc1);
                if (4 * j4 + 2 < i) acc0 = __builtin_fmaf(-a.z, t[4 * j4 + 2], acc0);
                if (4 * j4 + 3 < i) acc1 = __builtin_fmaf(-a.w, t[4 * j4 + 3], acc1);
            }
            t[i] = acc0 + acc1;
            asm volatile("" : "+v"(t[i]));
            __builtin_amdgcn_sched_barrier(0);
        }
#pragma unroll
        for (int i = 0; i < 32; ++i) { Tf[(32 * blk + i) * AM_LD + 32 * blk + cc] = t[i]; if (blk == 0) Tf[i * AM_LD + 32 + cc] = 0.f; }
    }
    __syncthreads();
    {
        const int i = F.tid >> 4, c0 = (F.tid & 15) * 2; float x0 = 0.f, x1 = 0.f;
#pragma unroll 8
        for (int k = 0; k < 32; ++k) { const float a = Am[(32 + i) * AM_LD + k]; x0 = __builtin_fmaf(a, Tf[k * AM_LD + c0], x0); x1 = __builtin_fmaf(a, Tf[k * AM_LD + c0 + 1], x1); }
        Xf[i * 34 + c0] = x0; Xf[i * 34 + c0 + 1] = x1;
    }
    __syncthreads();
    {
        const int i = F.tid >> 4, c0 = (F.tid & 15) * 2; float x0 = 0.f, x1 = 0.f;
#pragma unroll 8
        for (int k = 0; k < 32; ++k) { const float a = Tf[(32 + i) * AM_LD + 32 + k]; x0 = __builtin_fmaf(a, Xf[k * 34 + c0], x0); x1 = __builtin_fmaf(a, Xf[k * 34 + c0 + 1], x1); }
        Tf[(32 + i) * AM_LD + c0] = -x0; Tf[(32 + i) * AM_LD + c0 + 1] = -x1;
    }
    __syncthreads();
    {
        const int i = F.tid >> 3, c0 = (F.tid & 7) * 8; const f32x4 a = *(const LAS f32x4*)(Tf + i * AM_LD + c0), b2 = *(const LAS f32x4*)(Tf + i * AM_LD + c0 + 4);
        *(LAS v4u*)(Tb + i * TB_LD + c0) = (v4u){pk2(a.x, a.y), pk2(a.z, a.w), pk2(b2.x, b2.y), pk2(b2.z, b2.w)};
    }
    __syncthreads();
    {
        bf16x8 tb[4][2];
#pragma unroll
        for (int x = 0; x < 4; ++x)
#pragma unroll
            for (int s = 0; s < 2; ++s) tb[x][s] = ld8l(Tb + (16 * x + fr) * TB_LD + 32 * s + 8 * fq);
        const bf16x8 bv0 = ld8l(vbT + (16 * w + fr) * KT_LD + 8 * fq), bv1 = ld8l(vbT + (16 * w + fr) * KT_LD + 32 + 8 * fq);
        f32x4* gu = (f32x4*)(WSP(float, WS_GU) + chunk * 8192) + (size_t)w * 256 + lane;
#pragma unroll
        for (int mt = 0; mt < 4; ++mt) { f32x4 acc = {0.f, 0.f, 0.f, 0.f}; acc = MFMA16(tb[mt][0], bv0, acc); acc = MFMA16(tb[mt][1], bv1, acc); gu[mt * 64] = acc; }
        const bf16x8 ak0 = ld8l(kbgT + (16 * w + fr) * KT_LD + 8 * fq), ak1 = ld8l(kbgT + (16 * w + fr) * KT_LD + 32 + 8 * fq);
        bf16* gw = WSP(bf16, WS_GW) + chunk * 8192;
#pragma unroll
        for (int nt = 0; nt < 4; ++nt) { f32x4 acc = {0.f, 0.f, 0.f, 0.f}; acc = MFMA16(ak0, tb[nt][0], acc); acc = MFMA16(ak1, tb[nt][1], acc);
            v2u o; o.x = pk2(acc[0], acc[1]); o.y = pk2(acc[2], acc[3]);
            *(v2u*)(gw + (size_t)(16 * nt + fr) * 128 + 16 * w + 4 * fq) = o; }
    }
    __syncthreads();
}

constexpr int S2_Y = 0;
constexpr int S2_AB = 6144;
constexpr int S2_DOT = 6400;
constexpr int S2_U = 6656;
constexpr int S2_W = 8704;
constexpr int S2_VN = 10752;
__device__ __forceinline__ void p2_sample(Frame& F, int unit) {
    const int h = unit & 7, bs = unit >> 3, tid = F.tid, lane = F.lane, w = F.wave;
    LAS unsigned char* L = F.lds; asm volatile("" : "+v"(L));
    LAS float* Y = (LAS float*)(L + S2_Y); LAS float* AB = (LAS float*)(L + S2_AB); LAS float* DOT = (LAS float*)(L + S2_DOT);
    LAS float* U = (LAS float*)(L + S2_U); LAS float* W = (LAS float*)(L + S2_W); LAS float* VN = (LAS float*)(L + S2_VN);
    const bf16* PROJ = WSP(bf16, WS_PROJ); const bf16* XNA = WSP(bf16, WS_XNA); const float* WAB = WSP(float, WS_WAB);
    const size_t row0 = (size_t)MP + bs * 4;
    if (tid < 384) {
        const int part = tid >> 7, cc = tid & 127, col = part * 1024 + h * 128 + cc;
        float buf[7];
#pragma unroll
        for (int r = 0; r < 3; ++r) buf[r] = FIN(5)[((size_t)bs * 3 + r) * GCONV + col];
#pragma unroll
        for (int i = 0; i < 4; ++i) buf[3 + i] = bf2f(PROJ[(row0 + i) * 4096 + col]);
#pragma unroll
        for (int r = 0; r < 3; ++r) F.out[O_CONVS + ((size_t)bs * 3 + r) * GCONV + col] = buf[4 + r];
        float cw[4];
#pragma unroll
        for (int i = 0; i < 4; ++i) cw[i] = FIN(9)[(size_t)i * GCONV + col];
#pragma unroll
        for (int i = 0; i < 4; ++i) { float y = 0.f;
#pragma unroll
            for (int k = 0; k < 4; ++k) y += cw[k] * buf[i + k];
            Y[(part * 4 + i) * 128 + cc] = silu_f(y); }
    }
    {
        const int i = w >> 1, which = w & 1; const bf16* xr = XNA + (row0 + i) * DM; const float* wr = WAB + (size_t)(which * 8 + h) * DM; float s = 0.f;
        for (int k = lane; k < DM; k += 64) s += bf2f(xr[k]) * wr[k];
        s = wave_sum(s); if (lane == 0) AB[which * 4 + i] = s;
    }
    __syncthreads();
    {
        const int part = w >> 2, i = w & 3; LAS float* y = Y + (part * 4 + i) * 128; const float a = y[lane], bq = y[64 + lane];
        const float ss = wave_sum(a * a + bq * bq); const float rs = (1.f / sqrtf(ss + EPS)) * (part == 0 ? 0.08838834764831845f : 1.f);
        y[lane] = a * rs; y[64 + lane] = bq * rs;
    }
    if (tid == 0) { const float Aneg = -expf(FIN(10)[h]), dtb = FIN(11)[h]; float gc = 0.f;
        for (int i = 0; i < 4; ++i) { const float g = Aneg * softplus_f(AB[i] + dtb); gc += g; AB[8 + i] = g; AB[12 + i] = 1.f / (1.f + expf(-AB[4 + i])); AB[16 + i] = gc; } }
    __syncthreads();
    {
#pragma unroll
        for (int pp = 0; pp < 4; ++pp) { const int pr = 4 * w + pp, which = pr >> 4, i = (pr >> 2) & 3, j = pr & 3;
            const LAS float* x = Y + ((which == 0 ? 1 : 0) * 4 + i) * 128; const LAS float* y = Y + (1 * 4 + j) * 128;
            float s = x[lane] * y[lane] + x[64 + lane] * y[64 + lane]; s = wave_sum(s); if (lane == 0) DOT[pr] = s; }
    }
    __syncthreads();
    float g_[4], be[4], gc[4];
#pragma unroll
    for (int i = 0; i < 4; ++i) { g_[i] = AB[8 + i]; be[i] = AB[12 + i]; gc[i] = AB[16 + i]; }
    float Tm[4][4];
    {
        float A[4][4];
#pragma unroll
        for (int i = 0; i < 4; ++i)
#pragma unroll
            for (int j = 0; j < 4; ++j) A[i][j] = (i > j) ? be[i] * DOT[i * 4 + j] * expf(gc[i] - gc[j]) : 0.f;
#pragma unroll
        for (int cc = 0; cc < 4; ++cc)
#pragma unroll
            for (int i = 0; i < 4; ++i) { float acc = (i == cc) ? 1.f : 0.f;
#pragma unroll
                for (int j = 0; j < 4; ++j) if (j < i) acc -= A[i][j] * Tm[j][cc];
                Tm[i][cc] = acc; }
    }
    {
        const int i = tid >> 7, x = tid & 127; float su = 0.f, sw = 0.f;
#pragma unroll
        for (int j = 0; j < 4; ++j) { su += Tm[i][j] * Y[(2 * 4 + j) * 128 + x] * be[j]; sw += Tm[i][j] * Y[(1 * 4 + j) * 128 + x] * be[j] * expf(gc[j]); }
        U[i * 128 + x] = su; W[i * 128 + x] = sw;
    }
    __syncthreads();
    const float* S0 = FIN(4) + ((size_t)bs * GH + h) * 128 * 128;
    float qs_acc;
    {
        const int i = tid >> 7, dv = tid & 127; float p = 0.f, qq = 0.f;
        const LAS float* wr = W + i * 128; const LAS float* qr = Y + (0 * 4 + i) * 128;
        for (int dk = 0; dk < 128; ++dk) { const float s = S0[(size_t)dk * 128 + dv]; p += wr[dk] * s; qq += qr[dk] * s; }
        VN[i * 128 + dv] = U[i * 128 + dv] - p; qs_acc = qq * expf(gc[i]);
    }
    __syncthreads();
    {
        const int i = tid >> 7, dv = tid & 127; float o = qs_acc;
#pragma unroll
        for (int j = 0; j < 4; ++j) if (j <= i) o += DOT[16 + i * 4 + j] * expf(gc[i] - gc[j]) * VN[j * 128 + dv];
        WSP(float, WS_OGDN)[(row0 + i) * DM + h * 128 + dv] = o;
    }
    {
        const int dv = tid & 127, dg = tid >> 7; const float el = expf(gc[3]);
        float kd[4], vn[4];
#pragma unroll
        for (int j = 0; j < 4; ++j) { kd[j] = expf(gc[3] - gc[j]); vn[j] = VN[j * 128 + dv]; }
        float* So = F.out + O_GDNS + ((size_t)bs * GH + h) * 128 * 128;
        for (int dk = dg * 32; dk < dg * 32 + 32; ++dk) { float s = S0[(size_t)dk * 128 + dv] * el;
#pragma unroll
            for (int j = 0; j < 4; ++j) s += Y[(1 * 4 + j) * 128 + dk] * kd[j] * vn[j];
            So[(size_t)dk * 128 + dv] = s; }
    }
    (void)g_;
    __syncthreads();
}

constexpr int P3_S = 0;
constexpr int P3_VN = 8192;
__device__ __forceinline__ void p3_scan(Frame& F, int bh, int s) {
    const int lane = F.lane, w = F.wave, fr = lane & 15, fq = lane >> 4;
    const int b = bh >> 3, h = bh & 7;
    LAS bf16* Sl = (LAS bf16*)(F.lds + P3_S); LAS bf16* Vl = (LAS bf16*)(F.lds + P3_VN);
    const bf16* GW = WSP(bf16, WS_GW); const bf16* GQ = WSP(bf16, WS_GQ); const bf16* GKT = WSP(bf16, WS_GKT); const bf16* GQK = WSP(bf16, WS_GQK);
    const float* GU = WSP(float, WS_GU); const float* GDEC = WSP(float, WS_GDEC);
    float* OG = WSP(float, WS_OGDN);
    f32x4 Sacc = {0.f, 0.f, 0.f, 0.f};
    { v2u z = {0u, 0u}; *(LAS v2u*)(Sl + fr * 136 + 16 * w + 4 * fq) = z; }
    __syncthreads();
    const int m = w & 3;
    bf16x8 a1n[4], akn0, akn1, aqn0 = {}, aqn1 = {}; f32x4 u4n = {0.f, 0.f, 0.f, 0.f}; float decn;
#define P3_FETCH(cc) do { const size_t ch_ = (size_t)bh * NCH + (cc); \
        const bf16* p1_ = (w < 4 ? GW : GQ) + ch_ * 8192 + (size_t)(16 * m + fr) * 128 + 8 * fq; \
        _Pragma("unroll") for (int k_ = 0; k_ < 4; ++k_) a1n[k_] = ld8(p1_ + 32 * k_); \
        const bf16* pk_ = GKT + ch_ * 8192 + (size_t)(16 * w + fr) * 64 + 8 * fq; akn0 = ld8(pk_); akn1 = ld8(pk_ + 32); \
        const bf16* pq_ = GQK + ch_ * 4096 + (size_t)(16 * m + fr) * 64 + 8 * fq; aqn0 = ld8(pq_); aqn1 = ld8(pq_ + 32);        \
        u4n = *((const f32x4*)(GU + ch_ * 8192) + (size_t)s * 256 + m * 64 + lane); \
        decn = GDEC[ch_]; } while (0)
    P3_FETCH(0);
    for (int c = 0; c < NCH; ++c) {
        bf16x8 a1[4];
#pragma unroll
        for (int k = 0; k < 4; ++k) a1[k] = a1n[k];
        const bf16x8 ak0 = akn0, ak1 = akn1, aq0 = aqn0, aq1 = aqn1; const f32x4 u4 = u4n; const float dec = decn;
        if (c + 1 < NCH) P3_FETCH(c + 1);
        f32x4 acc = {0.f, 0.f, 0.f, 0.f};
#pragma unroll
        for (int k = 0; k < 4; ++k) acc = MFMA16(a1[k], ld8l(Sl + fr * 136 + 32 * k + 8 * fq), acc);
        if (w < 4) { const f32x4 vn = u4 - acc; v2u o; o.x = pk2(vn[0], vn[1]); o.y = pk2(vn[2], vn[3]); *(LAS v2u*)(Vl + fr * 72 + 16 * m + 4 * fq) = o; }
        asm volatile("s_waitcnt lgkmcnt(0)\n\ts_barrier" ::: "memory");
        const bf16x8 v0 = ld8l(Vl + fr * 72 + 8 * fq), v1 = ld8l(Vl + fr * 72 + 32 + 8 * fq);
        if (w >= 4) { acc = MFMA16(aq0, v0, acc); acc = MFMA16(aq1, v1, acc);
            float* o = OG + ((size_t)b * PT + c * CHUNK + 16 * m + 4 * fq) * DM + h * 128 + 16 * s + fr;
#pragma unroll
            for (int r = 0; r < 4; ++r) o[(size_t)r * DM] = acc[r]; }
        Sacc = Sacc * dec; Sacc = MFMA16(ak0, v0, Sacc); Sacc = MFMA16(ak1, v1, Sacc);
        { v2u o; o.x = pk2(Sacc[0], Sacc[1]); o.y = pk2(Sacc[2], Sacc[3]); *(LAS v2u*)(Sl + fr * 136 + 16 * w + 4 * fq) = o; }
        asm volatile("s_waitcnt lgkmcnt(0)\n\ts_barrier" ::: "memory");
    }
#undef P3_FETCH
    float* So = F.out + O_GDNP + ((size_t)bh * 128) * 128;
#pragma unroll
    for (int r = 0; r < 4; ++r) So[(size_t)(16 * w + 4 * fq + r) * 128 + 16 * s + fr] = Sacc[r];
}

__device__ __forceinline__ void p4_row(Frame& F, int row) {
    const int lane = F.lane;
    const float* o = WSP(float, WS_OGDN) + (size_t)row * DM + 16 * lane;
    const bf16* z = WSP(bf16, WS_PROJ) + (size_t)row * 4096 + 3072 + 16 * lane;
    f32x4 v[4]; float ss = 0.f;
#pragma unroll
    for (int j = 0; j < 4; ++j) { v[j] = *(const f32x4*)(o + 4 * j); ss += (v[j].x * v[j].x + v[j].y * v[j].y) + (v[j].z * v[j].z + v[j].w * v[j].w); }
    ss += dpp_f<DPP_XOR1>(ss); ss += dpp_f<DPP_XOR2>(ss); ss += dpp_f<DPP_HMIR>(ss);
    const float rstd = 1.f / sqrtf(ss * (1.f / 128.f) + EPS);
    const v4u z0 = *(const v4u*)z, z1 = *(const v4u*)(z + 8);
    const float* gn = FIN(12) + (16 * lane & 127);
    float zz[16] = {bflo(z0.x), bfhi(z0.x), bflo(z0.y), bfhi(z0.y), bflo(z0.z), bfhi(z0.z), bflo(z0.w), bfhi(z0.w),
                    bflo(z1.x), bfhi(z1.x), bflo(z1.y), bfhi(z1.y), bflo(z1.z), bfhi(z1.z), bflo(z1.w), bfhi(z1.w)};
    unsigned ow[8];
#pragma unroll
    for (int j = 0; j < 8; ++j) { const float a = v[j >> 1][(2 * j) & 3] * rstd * gn[2 * j] * silu_f(zz[2 * j]), bq = v[j >> 1][(2 * j + 1) & 3] * rstd * gn[2 * j + 1] * silu_f(zz[2 * j + 1]); ow[j] = pk2(a, bq); }
    v4u* dst = (v4u*)(WSP(bf16, WS_OG) + (size_t)row * DM + 16 * lane);
    dst[0] = (v4u){ow[0], ow[1], ow[2], ow[3]}; dst[1] = (v4u){ow[4], ow[5], ow[6], ow[7]};
}

typedef __bf16 bf16x2_t __attribute__((ext_vector_type(2)));
__device__ __forceinline__ float dot2_bf16(unsigned w, unsigned x, float acc) { return __builtin_amdgcn_fdot2_f32_bf16(__builtin_bit_cast(bf16x2_t, w), __builtin_bit_cast(bf16x2_t, x), acc, false); }
__device__ __forceinline__ float u2f(unsigned u) { return __builtin_bit_cast(float, u); }
__device__ __forceinline__ unsigned f2u(float f) { return __builtin_bit_cast(unsigned, f); }

constexpr int P8_TOP = 0;
constexpr int P8_TAB = 24576;
__device__ __forceinline__ void p8_init_tab(Frame& F) {
    LAS unsigned char* tab = F.lds + P8_TAB;
    if (F.tid < 64) { const int k = F.tid; int i = 0, j = 0;
        if (k < 16) { i = 0; j = k; } else if (k < 24) { i = 1; j = k - 16; } else if (k < 29) { i = 2; j = k - 24; } else if (k < 33) { i = 3; j = k - 29; }
        else if (k < 36) { i = 4; j = k - 33; } else if (k < 38) { i = 5; j = k - 36; } else if (k < 40) { i = 6; j = k - 38; } else if (k < 42) { i = 7; j = k - 40; } else if (k < 50) { i = k - 34; j = 0; }
        tab[k] = (unsigned char)i; tab[64 + k] = (unsigned char)j; }
    __syncthreads();
}
template <int CTRL> __device__ __forceinline__ float dppf(float x) { return __builtin_bit_cast(float, __builtin_amdgcn_update_dpp(0, __builtin_bit_cast(int, x), CTRL, 0xF, 0xF, true)); }
__device__ __forceinline__ float row_max16(float x) {
    x = fmaxf(x, dppf<0xB1>(x)); x = fmaxf(x, dppf<0x4E>(x)); x = fmaxf(x, dppf<0x141>(x)); x = fmaxf(x, dppf<0x140>(x)); return x;
}
#define CSWAP(a, b) { const float hi_ = fmaxf(a, b), lo_ = fminf(a, b); a = hi_; b = lo_; }
__device__ __forceinline__ void p8_unit(Frame& F, int unit, int layer) {
    int lane_ = F.lane; asm volatile("" : "+v"(lane_));
    const int lane = lane_, w = F.wave, fr = lane & 15, fq = lane >> 4;
    LAS unsigned char* L = F.lds; asm volatile("" : "+v"(L));
    LAS unsigned* topl = (LAS unsigned*)(L + P8_TOP + w * 3072);
    LAS float* wins = (LAS float*)(L + P8_TOP + w * 3072 + 2048);
    const LAS unsigned char* tab = L + P8_TAB;
    const int r0 = unit * 16;
    const bf16* Q = WSP(bf16, WS_QPEER) + (size_t)(r0 + fr) * 2048 + w * 256 + 8 * fq;
    const bf16* SK = WSP(bf16, WS_SUBK) + (size_t)((layer * 8 + w) * 2) * 16384 + (size_t)fr * 128 + 8 * fq;
    const float NEGINF = -__builtin_inff();
#pragma unroll 1
    for (int p = 0; p < 2; ++p) {
        bf16x8 aq[4];
#pragma unroll
        for (int ks = 0; ks < 4; ++ks) aq[ks] = ld8(Q + p * 128 + 32 * ks);
        float s[4][8];
#pragma unroll
        for (int nt = 0; nt < 8; ++nt) { f32x4 acc = {0.f, 0.f, 0.f, 0.f};
#pragma unroll
            for (int ks = 0; ks < 4; ++ks) acc = MFMA16(aq[ks], ld8(SK + (size_t)p * 16384 + (size_t)nt * 2048 + 32 * ks), acc);
#pragma unroll
            for (int r = 0; r < 4; ++r) s[r][nt] = u2f((f2u(acc[r]) & ~127u) | (unsigned)(16 * nt + fr)); }
#pragma unroll
        for (int r = 0; r < 4; ++r) {
            CSWAP(s[r][0], s[r][1]) CSWAP(s[r][2], s[r][3]) CSWAP(s[r][4], s[r][5]) CSWAP(s[r][6], s[r][7])
            CSWAP(s[r][0], s[r][2]) CSWAP(s[r][1], s[r][3]) CSWAP(s[r][4], s[r][6]) CSWAP(s[r][5], s[r][7])
            CSWAP(s[r][1], s[r][2]) CSWAP(s[r][5], s[r][6]) CSWAP(s[r][0], s[r][4]) CSWAP(s[r][3], s[r][7])
            CSWAP(s[r][1], s[r][5]) CSWAP(s[r][2], s[r][6]) CSWAP(s[r][1], s[r][4]) CSWAP(s[r][3], s[r][6])
            CSWAP(s[r][2], s[r][4]) CSWAP(s[r][3], s[r][5]) CSWAP(s[r][3], s[r][4]) }
#pragma unroll 1
        for (int rd = 0; rd < 16; ++rd) {
#pragma unroll
            for (int r = 0; r < 4; ++r) {
                const float mx = row_max16(s[r][0]);
                const bool pop = f2u(s[r][0]) == f2u(mx);
#pragma unroll
                for (int i = 0; i < 7; ++i) s[r][i] = pop ? s[r][i + 1] : s[r][i];
                s[r][7] = pop ? NEGINF : s[r][7];
                if (fr == 0) topl[((4 * fq + r) * 2 + p) * 16 + rd] = f2u(mx);
            }
        }
    }
    LDS_WAIT();
    float c[4][4];
#pragma unroll
    for (int r = 0; r < 4; ++r) { const int tk = 4 * fq + r;
#pragma unroll
        for (int m = 0; m < 4; ++m) { const int k = fr + 16 * m; float cv = NEGINF;
            if (k < 50) { const int i = tab[k], j = tab[64 + k]; const float s1 = u2f(topl[(tk * 2 + 0) * 16 + i] & ~127u), s2 = u2f(topl[(tk * 2 + 1) * 16 + j] & ~127u);
                cv = u2f((f2u(s1 + s2) & ~63u) | (unsigned)k); }
            c[r][m] = cv; }
        CSWAP(c[r][0], c[r][1]) CSWAP(c[r][2], c[r][3]) CSWAP(c[r][0], c[r][2]) CSWAP(c[r][1], c[r][3]) CSWAP(c[r][1], c[r][2]) }
#pragma unroll 1
    for (int rd = 0; rd < 16; ++rd) {
#pragma unroll
        for (int r = 0; r < 4; ++r) {
            const float mx = row_max16(c[r][0]);
            const bool pop = f2u(c[r][0]) == f2u(mx);
            c[r][0] = pop ? c[r][1] : c[r][0]; c[r][1] = pop ? c[r][2] : c[r][1]; c[r][2] = pop ? c[r][3] : c[r][2]; c[r][3] = pop ? NEGINF : c[r][3];
            if (fr == 0) wins[(4 * fq + r) * 16 + rd] = mx;
        }
    }
    LDS_WAIT();
    {
        const int tk = 4 * fq + (fr >> 2), q4 = fr & 3;
        const float w0 = wins[tk * 16]; float den = 0.f;
#pragma unroll
        for (int rd = 0; rd < 16; ++rd) den += __expf(wins[tk * 16 + rd] - w0);
        const float inv = 1.f / den;
        int e[4]; float g[4];
#pragma unroll
        for (int x = 0; x < 4; ++x) { const float wv = wins[tk * 16 + 4 * q4 + x]; const int k = (int)(f2u(wv) & 63u); const int i = tab[k], j = tab[64 + k];
            e[x] = (int)(topl[(tk * 2 + 0) * 16 + i] & 127u) * 128 + (int)(topl[(tk * 2 + 1) * 16 + j] & 127u); g[x] = __expf(wv - w0) * inv; }
        int* pei = WSP(int, WS_PEI) + (size_t)(r0 + tk) * 128 + w * 16 + 4 * q4; float* peg = WSP(float, WS_PEG) + (size_t)(r0 + tk) * 128 + w * 16 + 4 * q4;
        *(v4u*)pei = (v4u){(unsigned)e[0], (unsigned)e[1], (unsigned)e[2], (unsigned)e[3]};
        *(f32x4*)peg = (f32x4){g[0], g[1], g[2], g[3]};
    }
}

typedef float f32x2_t __attribute__((ext_vector_type(2)));
#define P9_DOT4(w, h0, h1, h2, h3, acc) { const f32x2_t lo_ = __builtin_amdgcn_cvt_pk_f32_fp8((int)(w), false), hi_ = __builtin_amdgcn_cvt_pk_f32_fp8((int)(w), true); \
        acc = __builtin_fmaf(lo_.x, h0, acc); acc = __builtin_fmaf(lo_.y, h1, acc); acc = __builtin_fmaf(hi_.x, h2, acc); acc = __builtin_fmaf(hi_.y, h3, acc); }
#define P9_AXPY4(w, c, o0, o1, o2, o3) { const f32x2_t lo_ = __builtin_amdgcn_cvt_pk_f32_fp8((int)(w), false), hi_ = __builtin_amdgcn_cvt_pk_f32_fp8((int)(w), true); \
        o0 = __builtin_fmaf(c, lo_.x, o0); o1 = __builtin_fmaf(c, lo_.y, o1); o2 = __builtin_fmaf(c, hi_.x, o2); o3 = __builtin_fmaf(c, hi_.y, o3); }
__device__ __forceinline__ void p9_token(Frame& F, int row, int layer, int mode) {
    const int lane = F.lane;
    float h[16];
    { const bf16* hrow = WSP(bf16, WS_XNB) + (size_t)row * DM + 16 * lane; const v4u a = *(const v4u*)hrow, b = *(const v4u*)(hrow + 8);
      h[0] = bflo(a.x); h[1] = bfhi(a.x); h[2] = bflo(a.y); h[3] = bfhi(a.y); h[4] = bflo(a.z); h[5] = bfhi(a.z); h[6] = bflo(a.w); h[7] = bfhi(a.w);
      h[8] = bflo(b.x); h[9] = bfhi(b.x); h[10] = bflo(b.y); h[11] = bfhi(b.y); h[12] = bflo(b.z); h[13] = bfhi(b.z); h[14] = bflo(b.w); h[15] = bfhi(b.w); }
    const int* pei = WSP(int, WS_PEI) + (size_t)row * 128; const float* peg = WSP(float, WS_PEG) + (size_t)row * 128;
    const int e0 = pei[lane], e1 = pei[64 + lane]; const float g0 = peg[lane], g1 = peg[64 + lane];
    const unsigned char* PU = WSP(unsigned char, WS_PU) + (size_t)layer * NEXP * DM + 16 * lane; const unsigned char* PV = WSP(unsigned char, WS_PV) + (size_t)layer * NEXP * DM + 16 * lane;
    float out[16];
#pragma unroll
    for (int i = 0; i < 16; ++i) out[i] = 0.f;
    v4u U[2][4], V[2][4];
#define P9_LOAD(buf, bb) do { const int ev_ = (bb) < 16 ? e0 : e1; _Pragma("unroll") for (int j_ = 0; j_ < 4; ++j_) { \
        const size_t off_ = (size_t)__builtin_amdgcn_readlane(ev_, ((bb) & 15) * 4 + j_) * DM; \
        U[buf][j_] = *(const v4u*)(PU + off_); V[buf][j_] = *(const v4u*)(PV + off_); } } while (0)
#define P9_COMP(buf, bb) do { float d_[4]; _Pragma("unroll") for (int j_ = 0; j_ < 4; ++j_) { float a_ = 0.f, b_ = 0.f; \
            P9_DOT4(U[buf][j_].x, h[0], h[1], h[2], h[3], a_) P9_DOT4(U[buf][j_].y, h[4], h[5], h[6], h[7], b_) P9_DOT4(U[buf][j_].z, h[8], h[9], h[10], h[11], a_) P9_DOT4(U[buf][j_].w, h[12], h[13], h[14], h[15], b_) d_[j_] = a_ + b_; } \
        float f_[2]; _Pragma("unroll") for (int k_ = 0; k_ < 2; ++k_) { const float x_ = (lane & 1) ? d_[2 * k_ + 1] : d_[2 * k_], y_ = (lane & 1) ? d_[2 * k_] : d_[2 * k_ + 1]; f_[k_] = x_ + dpp_f<DPP_XOR1>(y_); } \
        float g_; { const float x_ = (lane & 2) ? f_[1] : f_[0], y_ = (lane & 2) ? f_[0] : f_[1]; g_ = x_ + dpp_f<DPP_XOR2>(y_); } \
        g_ += dpp_f<DPP_ROR4>(g_); g_ += dpp_f<DPP_ROR8>(g_); g_ = x32_sum(x16_sum(g_)); \
        const float gt_ = __shfl((bb) < 16 ? g0 : g1, ((bb) & 15) * 4 + (lane & 3)); \
        const float cl_ = gelu_tanh(g_ * 0.03125f) * gt_ * 0.0625f; \
        _Pragma("unroll") for (int j_ = 0; j_ < 4; ++j_) { const float cj_ = __builtin_bit_cast(float, __builtin_amdgcn_readlane(__builtin_bit_cast(int, cl_), j_)); \
            P9_AXPY4(V[buf][j_].x, cj_, out[0], out[1], out[2], out[3]) P9_AXPY4(V[buf][j_].y, cj_, out[4], out[5], out[6], out[7]) \
            P9_AXPY4(V[buf][j_].z, cj_, out[8], out[9], out[10], out[11]) P9_AXPY4(V[buf][j_].w, cj_, out[12], out[13], out[14], out[15]) } } while (0)
    P9_LOAD(0, 0);
#pragma unroll 1
    for (int bb = 0; bb < 32; bb += 2) {
        P9_LOAD(1, bb + 1);
        P9_COMP(0, bb);
        if (bb + 2 < 32) P9_LOAD(0, bb + 2);
        P9_COMP(1, bb + 1);
    }
#undef P9_LOAD
#undef P9_COMP
    float* xs = WSP(float, WS_XS) + (size_t)row * DM + 16 * lane;
    f32x4 x[4];
#pragma unroll
    for (int i = 0; i < 4; ++i) { x[i] = *(const f32x4*)(xs + 4 * i); x[i].x += out[4 * i]; x[i].y += out[4 * i + 1]; x[i].z += out[4 * i + 2]; x[i].w += out[4 * i + 3]; }
    if (mode == 0) {
        float ss = 0.f;
#pragma unroll
        for (int i = 0; i < 4; ++i) { *(f32x4*)(xs + 4 * i) = x[i]; ss += (x[i].x * x[i].x + x[i].y * x[i].y) + (x[i].z * x[i].z + x[i].w * x[i].w); }
        const float rstd = 1.f / sqrtf(wave_sum(ss) * (1.f / DM) + EPS);
        bf16* xn = WSP(bf16, WS_XNA) + (size_t)row * DM + 16 * lane;
        *(v4u*)xn = (v4u){pk2(x[0].x * rstd, x[0].y * rstd), pk2(x[0].z * rstd, x[0].w * rstd), pk2(x[1].x * rstd, x[1].y * rstd), pk2(x[1].z * rstd, x[1].w * rstd)};
        *(v4u*)(xn + 8) = (v4u){pk2(x[2].x * rstd, x[2].y * rstd), pk2(x[2].z * rstd, x[2].w * rstd), pk2(x[3].x * rstd, x[3].y * rstd), pk2(x[3].z * rstd, x[3].w * rstd)};
    } else {
        float* y = (row < MP ? F.out + O_YP + (size_t)row * DM : F.out + O_YS + (size_t)(row - MP) * DM) + 16 * lane;
#pragma unroll
        for (int i = 0; i < 4; ++i) *(f32x4*)(y + 4 * i) = x[i];
    }
}

constexpr float QSCALE = 0.125f * 1.4426950408889634f;
constexpr int PP_VT = 0;
__device__ __forceinline__ float rms64(float v) { return 1.f / sqrtf(wave_sum(v * v) * (1.f / 64.f) + EPS); }

__device__ __forceinline__ void pp_q_row(Frame& F, int row, const float* kvq, const float qg) {
    const int lane = F.lane;
    bf16* qn = WSP(bf16, WS_QN) + (size_t)row * 1024;
#pragma unroll 4
    for (int hd = 0; hd < 16; ++hd) { const float v = kvq[NKV + hd * 64 + lane]; qn[hd * 64 + lane] = (bf16)f2bf(v * rms64(v) * qg); }
    if (lane < 48) WSP(float, WS_GATES)[(size_t)row * 48 + lane] = sigmoid_f(kvq[NKV + 1024 + lane]);
}
__device__ __forceinline__ void pp_prompt_tile(Frame& F, int unit) {
    const int lane = F.lane, w = F.wave, b = unit >> 7, t0 = (unit & 127) * 64;
    LAS unsigned char* L = F.lds; asm volatile("" : "+v"(L));
    LAS bf16* vt = (LAS bf16*)(L + PP_VT);
    const float kg1 = FIN(16)[64 + lane], kg2 = FIN(16)[128 + lane], qg = FIN(22)[lane] * QSCALE;
    for (int rr = 0; rr < 8; ++rr) {
        const int tl = 8 * w + rr, t = t0 + tl, row = b * PT + t;
        const float* kvq = WSP(float, WS_KVQ) + (size_t)row * NKVQ;
        float* okv = F.out + O_KVP + (size_t)row * 1024;
        const bool inwin = t >= PT - WINDOW;
        float* owin = F.out + O_WINP + ((size_t)b * 512 + (t - (PT - WINDOW))) * 512;
#pragma unroll
        for (int g = 0; g < 4; ++g) {
            const float v0 = kvq[0 * 256 + g * 64 + lane], v1 = kvq[1 * 256 + g * 64 + lane], v2 = kvq[2 * 256 + g * 64 + lane];
            const float v3 = kvq[3 * 256 + g * 64 + lane], v4 = kvq[4 * 256 + g * 64 + lane], v5 = kvq[5 * 256 + g * 64 + lane];
            const float ks = v2 * rms64(v2) * kg1, kw = v4 * rms64(v4) * kg2;
            okv[0 * 256 + g * 64 + lane] = v0; okv[1 * 256 + g * 64 + lane] = v1; okv[2 * 256 + g * 64 + lane] = ks; okv[3 * 256 + g * 64 + lane] = v3;
            if (inwin) { owin[g * 64 + lane] = kw; owin[256 + g * 64 + lane] = v5; }
            const size_t kidx = (((size_t)b * NG + g) * PT + t) * 64 + lane;
            WSP(bf16, WS_KSEL)[kidx] = (bf16)f2bf(ks); WSP(bf16, WS_KWIN)[kidx] = (bf16)f2bf(kw);
            vt[((0 * 4 + g) * 64 + lane) * 72 + tl] = (bf16)f2bf(v3); vt[((1 * 4 + g) * 64 + lane) * 72 + tl] = (bf16)f2bf(v5);
        }
        pp_q_row(F, row, kvq, qg);
    }
    __syncthreads();
    {
        const int which = F.tid >> 8, gd = F.tid & 255;
        bf16* dst = WSP(bf16, which == 0 ? WS_VSELT : WS_VWINT) + (((size_t)b * NG * 64 + gd) * PT + t0);
        const LAS bf16* src = vt + ((which * 256 + gd) * 72);
#pragma unroll
        for (int i = 0; i < 8; ++i) *(v4u*)(dst + 8 * i) = *(const LAS v4u*)(src + 8 * i);
    }
    __syncthreads();
}
__device__ __forceinline__ void pp_sample_row(Frame& F, int sr) {
    const int lane = F.lane, bs = sr >> 2, i = sr & 3, row = MP + sr;
    const float kg1 = FIN(16)[64 + lane], kg2 = FIN(16)[128 + lane], qg = FIN(22)[lane] * QSCALE;
    const float* kvq = WSP(float, WS_KVQ) + (size_t)row * NKVQ;
    float* okv = F.out + O_KVS + (size_t)sr * 1024;
    float* owin = F.out + O_WINS + ((size_t)bs * 512 + 508 + i) * 512;
#pragma unroll
    for (int g = 0; g < 4; ++g) {
        const float v0 = kvq[0 * 256 + g * 64 + lane], v1 = kvq[1 * 256 + g * 64 + lane], v2 = kvq[2 * 256 + g * 64 + lane];
        const float v3 = kvq[3 * 256 + g * 64 + lane], v4 = kvq[4 * 256 + g * 64 + lane], v5 = kvq[5 * 256 + g * 64 + lane];
        const float ks = v2 * rms64(v2) * kg1, kw = v4 * rms64(v4) * kg2;
        okv[0 * 256 + g * 64 + lane] = v0; okv[1 * 256 + g * 64 + lane] = v1; okv[2 * 256 + g * 64 + lane] = ks; okv[3 * 256 + g * 64 + lane] = v3;
        owin[g * 64 + lane] = kw; owin[256 + g * 64 + lane] = v5;
        const size_t bg = (size_t)bs * NG + g;
        WSP(bf16, WS_SKWIN)[(bg * 544 + 512 + i) * 64 + lane] = (bf16)f2bf(kw);
        WSP(bf16, WS_SVWINT)[(bg * 64 + lane) * 544 + 512 + i] = (bf16)f2bf(v5);
        float* sn = WSP(float, WS_SNEW) + (((size_t)bs * 4 + i) * 2) * 256 + g * 64 + lane;
        sn[0] = ks; sn[256] = v3;
    }
    pp_q_row(F, row, kvq, qg);
}

__device__ __forceinline__ void compress_finish(Frame& F, const f32x4 (&acc)[4], int kv, int blk, bf16* KC, bf16* VCT) {
    const int lane = F.lane, fr = lane & 15, fq = lane >> 4;
    const float* pet = WSP(float, WS_PETERM) + kv * 64;
    bf16x8 hb[2];
#pragma unroll
    for (int s = 0; s < 2; ++s) { f32x4 h0, h1;
#pragma unroll
        for (int r = 0; r < 4; ++r) { h0[r] = gelu_tanh(acc[2 * s][r] + pet[16 * (2 * s) + 4 * fq + r]); h1[r] = gelu_tanh(acc[2 * s + 1][r] + pet[16 * (2 * s + 1) + 4 * fq + r]); }
        hb[s] = cvt8(h0, h1); }
    const float* w2 = FIN(19) + (size_t)kv * 64 * 64;
    f32x4 o[4];
#pragma unroll
    for (int dt = 0; dt < 4; ++dt) { o[dt] = (f32x4){0.f, 0.f, 0.f, 0.f};
#pragma unroll
        for (int s = 0; s < 2; ++s) { f32x4 a0, a1;
#pragma unroll
            for (int jj = 0; jj < 4; ++jj) { a0[jj] = w2[(size_t)(16 * (2 * s) + 4 * fq + jj) * 64 + 16 * dt + fr]; a1[jj] = w2[(size_t)(16 * (2 * s + 1) + 4 * fq + jj) * 64 + 16 * dt + fr]; }
            o[dt] = MFMA16(cvt8(a0, a1), hb[s], o[dt]); } }
    if (kv == 0) {
        float ss = 0.f;
#pragma unroll
        for (int dt = 0; dt < 4; ++dt) ss += (o[dt][0] * o[dt][0] + o[dt][1] * o[dt][1]) + (o[dt][2] * o[dt][2] + o[dt][3] * o[dt][3]);
        ss = x32_sum(x16_sum(ss));
        const float rstd = 1.f / sqrtf(ss * (1.f / 64.f) + EPS);
        const float* kg0 = FIN(16);
        if (blk < NCMP) {
#pragma unroll
            for (int dt = 0; dt < 4; ++dt) { const int d = 16 * dt + 4 * fq; v2u ov; ov.x = pk2(o[dt][0] * rstd * kg0[d], o[dt][1] * rstd * kg0[d + 1]); ov.y = pk2(o[dt][2] * rstd * kg0[d + 2], o[dt][3] * rstd * kg0[d + 3]);
                *(v2u*)(KC + (size_t)blk * 64 + d) = ov; }
        } else {
#pragma unroll
            for (int dt = 0; dt < 4; ++dt) *(v2u*)(KC + (size_t)blk * 64 + 16 * dt + 4 * fq) = (v2u){0u, 0u};
        }
    } else {
#pragma unroll
        for (int dt = 0; dt < 4; ++dt)
#pragma unroll
            for (int r = 0; r < 4; ++r) VCT[(size_t)(16 * dt + 4 * fq + r) * 512 + blk] = (blk < NCMP) ? (bf16)f2bf(o[dt][r]) : (bf16)0;
    }
}

template <class RowP>
__device__ __forceinline__ void compress_tile(Frame& F, const RowP& rowp, int kv, int j, bf16* KC, bf16* VCT) {
    const int lane = F.lane, fr = lane & 15, fq = lane >> 4;
    const bf16* W1 = WSP(bf16, WS_W1T) + (size_t)kv * 64 * 2048 + (size_t)fr * 2048 + 8 * fq;
    const int blk = 16 * j + fr;
    f32x4 acc[4];
#pragma unroll
    for (int mt = 0; mt < 4; ++mt) acc[mt] = (f32x4){0.f, 0.f, 0.f, 0.f};
#pragma unroll 2
    for (int r = 0; r < 32; ++r) {
        int t = 16 * blk + r; t = t < PAST ? t : PAST - 1;
        const float* rp = rowp(t) + 8 * fq;
#pragma unroll
        for (int hf = 0; hf < 2; ++hf) {
            const f32x4 x0 = *(const f32x4*)(rp + 32 * hf), x1 = *(const f32x4*)(rp + 32 * hf + 4);
            const bf16x8 bfrag = cvt8(x0, x1);
            const int ks = 2 * r + hf;
#pragma unroll
            for (int mt = 0; mt < 4; ++mt) acc[mt] = MFMA16(ld8(W1 + (size_t)mt * 16 * 2048 + 32 * ks), bfrag, acc[mt]);
        }
    }
    compress_finish(F, acc, kv, blk, KC, VCT);
}
struct RowPPrompt { const float* base; __device__ __forceinline__ const float* operator()(int t) const { return base + (size_t)t * NKVQ; } };
struct RowPSample { const float* cache; const int* pt; __device__ __forceinline__ const float* operator()(int t) const { return cache + ((size_t)pt[t >> 7] * PAGE + (t & 127)) * 1024; } };

__device__ __forceinline__ void compress_prompt(Frame& F, int id) {
    const int kv = id & 1, j = (id >> 1) & 31, bg = id >> 6, b = bg >> 2, g = bg & 3;
    RowPPrompt rp{WSP(float, WS_KVQ) + (size_t)b * PT * NKVQ + kv * 256 + g * 64};
    compress_tile(F, rp, kv, j, WSP(bf16, WS_KCMP) + (size_t)bg * 512 * 64, WSP(bf16, WS_VCMPT) + (size_t)bg * 64 * 512);
}
__device__ __forceinline__ void compress_sample(Frame& F, int id) {
    const int kv = id & 1, j = (id >> 1) & 31, bg = id >> 6, lane = F.lane, fr = lane & 15, fq = lane >> 4;
    const int blk = 16 * j + fr, nb = blk < 511 ? blk + 1 : 511;
    const float* f1 = WSP(float, WS_FS) + ((size_t)bg * 512 + blk) * 256 + kv * 128 + 4 * fq;
    const float* f2 = WSP(float, WS_FS) + ((size_t)bg * 512 + nb) * 256 + kv * 128 + 64 + 4 * fq;
    f32x4 acc[4];
#pragma unroll
    for (int mt = 0; mt < 4; ++mt) acc[mt] = *(const f32x4*)(f1 + 16 * mt) + *(const f32x4*)(f2 + 16 * mt);
    compress_finish(F, acc, kv, blk, WSP(bf16, WS_SKCMP) + (size_t)bg * 512 * 64, WSP(bf16, WS_SVCMPT) + (size_t)bg * 64 * 512);
}

constexpr int NSA_IMP = 0;
constexpr int NSA_Q = 67584;
constexpr int NSA_QLD = 68;
constexpr float LOG2E = 1.4426950408889634f;
#ifndef NSA_SUBUNITS
#define NSA_SUBUNITS 0
#endif
__device__ __forceinline__ float ex2(float x) { return __builtin_amdgcn_exp2f(x); }

struct KvBf16 {
    const bf16* K; const bf16* VT; int ld;
    __device__ __forceinline__ void lane_offsets(int fr, int fq, unsigned& ko, unsigned& vo) const {
        ko = (unsigned)(((8 * (fr >> 2) + (fr & 3)) * 64 + 8 * fq) * 2); vo = (unsigned)((fr * ld + 8 * fq) * 2);
        asm volatile("" : "+v"(ko), "+v"(vo));
    }
    __device__ __forceinline__ bf16x8 kf(int key0, int mt, int ks, unsigned ko) const {
        return *(const bf16x8*)((const char*)K + (size_t)key0 * 128 + (ko + (unsigned)((4 * mt * 64 + 32 * ks) * 2))); }
    __device__ __forceinline__ bf16x8 vf(int key0, int dt, unsigned vo) const {
        return *(const bf16x8*)((const char*)VT + (size_t)key0 * 2 + (vo + (unsigned)(16 * dt * ld * 2))); }
};
struct KvSampleSel {
    const float* cache; const int* pt; const float* snew; int g;
    __device__ __forceinline__ const float* krow(int pos, int slot) const {
        if (pos < PAST) return cache + ((size_t)pt[pos >> 7] * PAGE + (pos & 127)) * 1024 + slot * 256;
        int i = pos - PAST; i = i < 3 ? i : 3; return snew + (size_t)i * 512 + (slot - 2) * 256; }
    __device__ __forceinline__ void lane_offsets(int fr, int fq, unsigned& ko, unsigned& vo) const { ko = (unsigned)(fr | (fq << 8)); vo = ko; asm volatile("" : "+v"(ko), "+v"(vo)); }
    __device__ __forceinline__ bf16x8 kf(int key0, int mt, int ks, unsigned ko) const { const int fr = ko & 255, fq = ko >> 8;
        const float* p = krow(key0 + 8 * (fr >> 2) + 4 * mt + (fr & 3), 2) + 32 * ks + 8 * fq; return cvt8(*(const f32x4*)p, *(const f32x4*)(p + 4)); }
    __device__ __forceinline__ bf16x8 vf(int key0, int dt, unsigned vo) const { const int fr = vo & 255, fq = vo >> 8; f32x4 a, b;
#pragma unroll
        for (int j = 0; j < 4; ++j) { a[j] = krow(key0 + 8 * fq + j, 3)[16 * dt + fr]; b[j] = krow(key0 + 8 * fq + 4 + j, 3)[16 * dt + fr]; }
        return cvt8(a, b); }
};
struct KvFrags { bf16x8 k[2][2]; bf16x8 v[4]; };
template <bool WITHV, class KV>
__device__ __forceinline__ void nsa_load(const KV& kv, int key0, int fr, int fq, KvFrags& f) {
    unsigned ko, vo; kv.lane_offsets(fr, fq, ko, vo);
#pragma unroll
    for (int mt = 0; mt < 2; ++mt)
#pragma unroll
        for (int ks = 0; ks < 2; ++ks) f.k[mt][ks] = kv.kf(key0, mt, ks, ko);
    if (WITHV) {
#pragma unroll
        for (int dt = 0; dt < 4; ++dt) f.v[dt] = kv.vf(key0, dt, vo);
    }
}

template <int NT, int MODE, bool QREG = false>
__device__ __forceinline__ void nsa_core(const KvFrags& f, int key0, const LAS bf16* qrow, int qnt, f32x4 (&O)[NT][4], float (&m)[NT], float (&l)[NT], const float (&invl)[NT], const float (&slope)[NT],
                                         int t, int pmul, int padd, int wlim, bool selok, LAS float* improw, int fq, const bf16x8* qreg = nullptr) {
    float dist[2][4]; bool val[2][4];
#pragma unroll
    for (int mt = 0; mt < 2; ++mt)
#pragma unroll
        for (int r = 0; r < 4; ++r) { const int kk = key0 + 8 * fq + 4 * mt + r; const int dd = t - (pmul * kk + padd); dist[mt][r] = (float)dd; val[mt][r] = selok && dd >= 0 && dd < wlim; }
    float imp_main[2] = {0.f, 0.f}, imp_spill[2] = {0.f, 0.f};
#pragma unroll
    for (int nt = 0; nt < NT; ++nt) {
        f32x4 s[2];
        bf16x8 q0, q1; if (QREG) { q0 = qreg[nt * 2]; q1 = qreg[nt * 2 + 1]; } else { q0 = ld8l(qrow + nt * qnt + 8 * fq); q1 = ld8l(qrow + nt * qnt + 32 + 8 * fq); }
#pragma unroll
        for (int mt = 0; mt < 2; ++mt) { s[mt] = (f32x4){0.f, 0.f, 0.f, 0.f}; s[mt] = MFMA16(f.k[mt][0], q0, s[mt]); s[mt] = MFMA16(f.k[mt][1], q1, s[mt]); }
        f32x4 p[2]; float ps = 0.f;
#pragma unroll
        for (int mt = 0; mt < 2; ++mt)
#pragma unroll
            for (int r = 0; r < 4; ++r) { float pv = ex2(val[mt][r] ? (s[mt][r] - slope[nt] * dist[mt][r]) : -200.f); if (MODE == 2) pv *= invl[nt]; p[mt][r] = pv; ps += pv; }
        if (MODE != 2) l[nt] += ps;
        if (MODE == 2) {
#pragma unroll
            for (int mt = 0; mt < 2; ++mt) { imp_main[mt] += (p[mt][0] + p[mt][1]) + (p[mt][2] + p[mt][3]); imp_spill[mt] += p[mt][3]; }
        }
        if (MODE != 1) {
            const bf16x8 pf = cvt8(p[0], p[1]);
#pragma unroll
            for (int dt = 0; dt < 4; ++dt) O[nt][dt] = MFMA16(f.v[dt], pf, O[nt][dt]);
        }
    }
    if (MODE == 2) {
#pragma unroll
        for (int mt = 0; mt < 2; ++mt) { const int j = key0 / 4 + 2 * fq + mt;
            __hip_atomic_fetch_add(improw + j, imp_main[mt], __ATOMIC_RELAXED, __HIP_MEMORY_SCOPE_WORKGROUP);
            __hip_atomic_fetch_add(improw + j + 1, imp_spill[mt], __ATOMIC_RELAXED, __HIP_MEMORY_SCOPE_WORKGROUP); }
    }
}
template <int NT, int MODE, class KV>
__device__ __forceinline__ void nsa_tile(const KV& kv, int key0, const LAS bf16* qrow, int qnt, f32x4 (&O)[NT][4], float (&m)[NT], float (&l)[NT], const float (&invl)[NT], const float (&slope)[NT],
                                         int t, int pmul, int padd, int wlim, bool selok, LAS float* improw, int fr, int fq) {
    KvFrags f; nsa_load<MODE != 1>(kv, key0, fr, fq, f);
    nsa_core<NT, MODE>(f, key0, qrow, qnt, O, m, l, invl, slope, t, pmul, padd, wlim, selok, improw, fq);
}

template <int NT>
__device__ __forceinline__ void nsa_zero(f32x4 (&O)[NT][4], float (&m)[NT], float (&l)[NT]) {
#pragma unroll
    for (int nt = 0; nt < NT; ++nt) { m[nt] = -1e30f; l[nt] = 0.f;
#pragma unroll
        for (int dt = 0; dt < 4; ++dt) O[nt][dt] = (f32x4){0.f, 0.f, 0.f, 0.f}; }
}

template <bool SAMPLE>
__device__ __forceinline__ void nsa_unit(Frame& F, int id) {
    constexpr int NT = SAMPLE ? 1 : 4;
    int lane_ = F.lane; asm volatile("" : "+v"(lane_));
    const int lane = lane_, fr = lane & 15, fq = lane >> 4;
    LAS unsigned char* L = F.lds; asm volatile("" : "+v"(L));
    LAS float* imp = (LAS float*)(L + NSA_IMP + F.wave * 8448);
    LAS bf16* qw = (LAS bf16*)(L + NSA_Q + F.wave * 8704);
    int bg, g, t, row, trow, tmax, row0;
    if (SAMPLE) { bg = id; g = id & 3; t = PAST + (fr >> 2); row0 = MP + (id >> 2) * 4; row = row0 + (fr >> 2); trow = fr >> 2; tmax = PAST + 3; }
    else { bg = id >> 9; g = bg & 3; const int tt = id & 511; t = 16 * tt + fr; row0 = (bg >> 2) * PT + 16 * tt; row = row0 + fr; trow = fr; tmax = 16 * tt + 15; }
    {
        const int nrow = SAMPLE ? 16 : 64;
        for (int i = lane; i < nrow * 8; i += 64) { const int rr = i >> 3, c8 = i & 7;
            *(LAS v4u*)(qw + rr * NSA_QLD + 8 * c8) = *(const v4u*)(WSP(bf16, WS_QN) + (size_t)(row0 + (rr >> 2)) * 1024 + (g * 4 + (rr & 3)) * 64 + 8 * c8); }
    }
    float slope[NT]; int hd[NT];
#pragma unroll
    for (int nt = 0; nt < NT; ++nt) { hd[nt] = g * 4 + (SAMPLE ? (fr & 3) : nt); slope[nt] = ex2(-0.5f * (float)(hd[nt] + 1)) * LOG2E; }
    const LAS bf16* qrow = qw + (SAMPLE ? fr : fr * 4) * NSA_QLD; const int qnt = SAMPLE ? 0 : NSA_QLD;
    const float* gates = WSP(float, WS_GATES) + (size_t)row * 48;
    float* oacc = WSP(float, WS_OACC) + (size_t)row * 1024;
    for (int i = lane; i < 16 * 132; i += 64) imp[i] = 0.f;
    LDS_WAIT();
    f32x4 O[NT][4]; float m[NT], l[NT], invl[NT];
    {
        KvBf16 kv{WSP(bf16, SAMPLE ? WS_SKCMP : WS_KCMP) + (size_t)bg * 512 * 64, WSP(bf16, SAMPLE ? WS_SVCMPT : WS_VCMPT) + (size_t)bg * 64 * 512, 512};
        const int cmax = (tmax - 31) >> 4;
        const int ntile = (tmax >= 31) ? ((cmax < 510 ? cmax : 510) / 32 + 1) : 0;
#pragma unroll
        for (int nt = 0; nt < NT; ++nt) invl[nt] = 0.f;
        nsa_zero<NT>(O, m, l);
        { KvFrags fa, fb; if (ntile > 0) nsa_load<false>(kv, 0, fr, fq, fa);
#pragma unroll 1
          for (int tl = 0; tl < ntile; ++tl) { if (tl + 1 < ntile) nsa_load<false>(kv, 32 * (tl + 1), fr, fq, fb);
            nsa_core<NT, 1>(fa, 32 * tl, qrow, qnt, O, m, l, invl, slope, t, 16, 31, 1 << 30, true, imp + trow * 132, fq); fa = fb; } }
#pragma unroll
        for (int nt = 0; nt < NT; ++nt) { float lt = l[nt]; lt = x32_sum(x16_sum(lt)); invl[nt] = lt > 0.f ? 1.f / lt : 0.f; }
        { KvFrags fa, fb; if (ntile > 0) nsa_load<true>(kv, 0, fr, fq, fa);
#pragma unroll 1
          for (int tl = 0; tl < ntile; ++tl) { if (tl + 1 < ntile) nsa_load<true>(kv, 32 * (tl + 1), fr, fq, fb);
            nsa_core<NT, 2>(fa, 32 * tl, qrow, qnt, O, m, l, invl, slope, t, 16, 31, 1 << 30, true, imp + trow * 132, fq); fa = fb; } }
#pragma unroll
        for (int nt = 0; nt < NT; ++nt) { const float gc = gates[0 * 16 + hd[nt]];
#pragma unroll
            for (int dt = 0; dt < 4; ++dt) *(f32x4*)(oacc + hd[nt] * 64 + 16 * dt + 4 * fq) = O[nt][dt] * gc; }
    }
    LDS_WAIT();
    unsigned selm[4] = {0u, 0u, 0u, 0u};
    {
        const int cur = t >> 6;
        if (!SAMPLE) {
            unsigned v[32];
#pragma unroll
            for (int i = 0; i < 32; ++i) { const int j = 32 * fq + i; const bool forced = (j == 0) | (j == cur) | (j == cur - 1);
                const unsigned key = ((f2u(imp[trow * 132 + j]) & ~127u) | (unsigned)(127 - j)) + 128u;
                v[i] = (!forced && j <= cur) ? key : 0u;
                if (forced) selm[fq] |= 1u << i; }
            unsigned fw = selm[0] | selm[1] | selm[2] | selm[3];
            const unsigned w16 = __shfl_xor(fw, 16), w32 = __shfl_xor(fw, 32), w48 = __shfl_xor(fw, 48);
#pragma unroll
            for (int wd = 0; wd < 4; ++wd) selm[wd] = (fq == wd) ? fw : ((fq ^ 1) == wd) ? w16 : ((fq ^ 2) == wd) ? w32 : w48;
            const int nforced = cur >= 2 ? 3 : cur + 1;
#pragma unroll 1
            for (int rd = 0; rd < 15; ++rd) {
                unsigned mx = v[0];
#pragma unroll
                for (int i = 1; i < 32; ++i) mx = mx > v[i] ? mx : v[i];
                mx = x32_umax(x16_umax(mx));
#pragma unroll
                for (int i = 0; i < 32; ++i) v[i] = (v[i] == mx) ? 0u : v[i];
                if (mx != 0u && rd < 16 - nforced) { const int js = 127 - (int)(mx & 127u);
#pragma unroll
                    for (int wd = 0; wd < 4; ++wd) selm[wd] |= ((js >> 5) == wd) ? (1u << (js & 31)) : 0u; }
            }
        } else {
            const int li = (fr & 3) * 4 + fq;
            unsigned v[8];
#pragma unroll
            for (int i = 0; i < 8; ++i) { const int j = li * 8 + i; v[i] = (j >= 1 && j <= 126) ? (((f2u(imp[trow * 132 + j]) & ~127u) | (unsigned)(127 - j)) + 128u) : 0u; }
            selm[0] = 1u; selm[3] = 1u << 31;
#pragma unroll 1
            for (int rd = 0; rd < 13; ++rd) {
                unsigned mx = v[0];
#pragma unroll
                for (int i = 1; i < 8; ++i) mx = mx > v[i] ? mx : v[i];
                { unsigned o = dpp_u<DPP_XOR1>(mx); mx = mx > o ? mx : o; o = dpp_u<DPP_XOR2>(mx); mx = mx > o ? mx : o; mx = x32_umax(x16_umax(mx)); }
#pragma unroll
                for (int i = 0; i < 8; ++i) v[i] = (v[i] == mx) ? 0u : v[i];
                if (mx != 0u) { const int js = 127 - (int)(mx & 127u);
#pragma unroll
                    for (int wd = 0; wd < 4; ++wd) selm[wd] |= ((js >> 5) == wd) ? (1u << (js & 31)) : 0u; }
            }
        }
    }
    if (SAMPLE || !NSA_SUBUNITS) {
        nsa_zero<NT>(O, m, l);
        unsigned un[4];
#pragma unroll
        for (int wd = 0; wd < 4; ++wd) { unsigned x = selm[wd]; x |= __shfl_xor(x, 1); x |= __shfl_xor(x, 2); x |= __shfl_xor(x, 4); x |= __shfl_xor(x, 8); un[wd] = (unsigned)__builtin_amdgcn_readfirstlane((int)x); }
        KvSampleSel kvs{FIN(2) + g * 64, (const int*)FIN(6) + (SAMPLE ? (id >> 2) : 0) * NPAGES, WSP(float, WS_SNEW) + (size_t)(SAMPLE ? (id >> 2) : 0) * 2048 + g * 64, g};
        KvBf16 kvp{WSP(bf16, WS_KSEL) + (size_t)bg * PT * 64, WSP(bf16, WS_VSELT) + (size_t)bg * 64 * PT, PT};
        if (SAMPLE) {
#pragma unroll 1
        for (int wd = 0; wd < 4; ++wd) {
            unsigned mm = un[wd];
            const unsigned mine = wd == 0 ? selm[0] : wd == 1 ? selm[1] : wd == 2 ? selm[2] : selm[3];
            while (mm) {
                const int bit = __builtin_ctz(mm); mm &= mm - 1u; const int j = 32 * wd + bit;
                const bool ok = (mine >> bit) & 1u;
#pragma unroll 1
                for (int hh = 0; hh < 2; ++hh) { nsa_tile<NT, 0>(kvs, 64 * j + 32 * hh, qrow, qnt, O, m, l, invl, slope, t, 1, 0, 1 << 30, ok, imp, fr, fq); __builtin_amdgcn_sched_barrier(0); }
            }
        }
        } else {
            int wdc = 0; unsigned mmc = un[0];
            while (wdc < 3 && mmc == 0u) { ++wdc; mmc = wdc == 1 ? un[1] : wdc == 2 ? un[2] : un[3]; }
            KvFrags fa, fb; int jc = -1, hc = 0;
            if (mmc) { jc = 32 * wdc + __builtin_ctz(mmc); mmc &= mmc - 1u; nsa_load<true>(kvp, 64 * jc, fr, fq, fa); }
#pragma unroll 1
            while (jc >= 0) {
                int jn = jc, hn = hc + 1;
                if (hn == 2) { hn = 0;
                    while (wdc < 3 && mmc == 0u) { ++wdc; mmc = wdc == 1 ? un[1] : wdc == 2 ? un[2] : un[3]; }
                    if (mmc) { jn = 32 * wdc + __builtin_ctz(mmc); mmc &= mmc - 1u; } else jn = -1; }
                if (jn >= 0) nsa_load<true>(kvp, 64 * jn + 32 * hn, fr, fq, fb);
                const int wj = jc >> 5, bj = jc & 31;
                const unsigned mine = wj == 0 ? selm[0] : wj == 1 ? selm[1] : wj == 2 ? selm[2] : selm[3];
                nsa_core<NT, 0>(fa, 64 * jc + 32 * hc, qrow, qnt, O, m, l, invl, slope, t, 1, 0, 1 << 30, (mine >> bj) & 1u, imp, fq);
                fa = fb; jc = jn; hc = hn;
            }
        }
        if (SAMPLE) nsa_tile<NT, 0>(kvs, 64 * 128, qrow, qnt, O, m, l, invl, slope, t, 1, 0, 1 << 30, true, imp, fr, fq);
#pragma unroll
        for (int nt = 0; nt < NT; ++nt) { float lt = l[nt]; lt = x32_sum(x16_sum(lt)); const float sc = gates[1 * 16 + hd[nt]] / fmaxf(lt, 1e-30f);
#pragma unroll
            for (int dt = 0; dt < 4; ++dt) { f32x4* o = (f32x4*)(oacc + hd[nt] * 64 + 16 * dt + 4 * fq); *o = *o + O[nt][dt] * sc; } }
    } else {
        unsigned ms[4][4];
#pragma unroll
        for (int s = 0; s < 4; ++s)
#pragma unroll
            for (int wd = 0; wd < 4; ++wd) ms[s][wd] = __shfl(selm[wd], 4 * s + (fr >> 2));
        unsigned su[4][4], un[4];
#pragma unroll
        for (int wd = 0; wd < 4; ++wd) { un[wd] = 0u;
#pragma unroll
            for (int s = 0; s < 4; ++s) { unsigned x = ms[s][wd]; x |= __shfl_xor(x, 4); x |= __shfl_xor(x, 8); su[s][wd] = (unsigned)__builtin_amdgcn_readfirstlane((int)x); un[wd] |= su[s][wd]; } }
        const int hds = g * 4 + (fr & 3); float slp[1]; slp[0] = ex2(-0.5f * (float)(hds + 1)) * LOG2E;
        const int tb = (id & 511) * 16 + (fr >> 2);
        f32x4 Os[4][1][4]; float mS[4][1], lS[4][1]; float inv1[1] = {0.f};
#pragma unroll
        for (int s = 0; s < 4; ++s) nsa_zero<1>(Os[s], mS[s], lS[s]);
        KvBf16 kvp{WSP(bf16, WS_KSEL) + (size_t)bg * PT * 64, WSP(bf16, WS_VSELT) + (size_t)bg * 64 * PT, PT};
        int wdc = 0; unsigned mmc = un[0];
        while (wdc < 3 && mmc == 0u) { ++wdc; mmc = wdc == 1 ? un[1] : wdc == 2 ? un[2] : un[3]; }
        KvFrags fa, fb;
        int jc = -1, hc = 0;
        if (mmc) { jc = 32 * wdc + __builtin_ctz(mmc); mmc &= mmc - 1u; nsa_load<true>(kvp, 64 * jc, fr, fq, fa); }
#pragma unroll 1
        while (jc >= 0) {
            int jn = jc, hn = hc + 1;
            if (hn == 2) { hn = 0;
                while (wdc < 3 && mmc == 0u) { ++wdc; mmc = wdc == 1 ? un[1] : wdc == 2 ? un[2] : un[3]; }
                if (mmc) { jn = 32 * wdc + __builtin_ctz(mmc); mmc &= mmc - 1u; } else jn = -1; }
            if (jn >= 0) nsa_load<true>(kvp, 64 * jn + 32 * hn, fr, fq, fb);
            const int wj = jc >> 5, bj = jc & 31;
#pragma unroll
            for (int s = 0; s < 4; ++s) {
                const unsigned suw = wj == 0 ? su[s][0] : wj == 1 ? su[s][1] : wj == 2 ? su[s][2] : su[s][3];
                if ((suw >> bj) & 1u) {
                    const unsigned mw = wj == 0 ? ms[s][0] : wj == 1 ? ms[s][1] : wj == 2 ? ms[s][2] : ms[s][3];
                    nsa_core<1, 0>(fa, 64 * jc + 32 * hc, qw + (16 * s + fr) * NSA_QLD, 0, Os[s], mS[s], lS[s], inv1, slp, tb + 4 * s, 1, 0, 1 << 30, (mw >> bj) & 1u, imp, fq);
                }
            }
            fa = fb; jc = jn; hc = hn;
        }
#pragma unroll
        for (int s = 0; s < 4; ++s) { float lt = lS[s][0]; lt = x32_sum(x16_sum(lt));
            const size_t rs = (size_t)(row0 + 4 * s + (fr >> 2));
            const float sc = WSP(float, WS_GATES)[rs * 48 + 16 + hds] / fmaxf(lt, 1e-30f);
#pragma unroll
            for (int dt = 0; dt < 4; ++dt) { f32x4* o = (f32x4*)(WSP(float, WS_OACC) + rs * 1024 + hds * 64 + 16 * dt + 4 * fq); *o = *o + Os[s][0][dt] * sc; } }
    }
    {
        nsa_zero<NT>(O, m, l);
        KvBf16 kv = SAMPLE ? KvBf16{WSP(bf16, WS_SKWIN) + (size_t)bg * 544 * 64, WSP(bf16, WS_SVWINT) + (size_t)bg * 64 * 544, 544}
                           : KvBf16{WSP(bf16, WS_KWIN) + (size_t)bg * PT * 64, WSP(bf16, WS_VWINT) + (size_t)bg * 64 * PT, PT};
        int k0, k1, padd;
        if (SAMPLE) { k0 = 0; k1 = 544; padd = PAST - WINDOW; }
        else { const int lo = tmax - 15 - (WINDOW - 1); k0 = (lo > 0 ? lo : 0) & ~31; k1 = tmax + 1; padd = 0; }
        { KvFrags fa, fb; nsa_load<true>(kv, k0, fr, fq, fa);
#pragma unroll 1
          for (int kk = k0; kk < k1; kk += 32) { if (kk + 32 < k1) nsa_load<true>(kv, kk + 32, fr, fq, fb);
            nsa_core<NT, 0>(fa, kk, qrow, qnt, O, m, l, invl, slope, t, 1, padd, WINDOW, true, imp, fq); fa = fb; } }
        bf16* on = WSP(bf16, WS_OG) + (size_t)row * 1024;
#pragma unroll
        for (int nt = 0; nt < NT; ++nt) { float lt = l[nt]; lt = x32_sum(x16_sum(lt)); const float sc = gates[2 * 16 + hd[nt]] / fmaxf(lt, 1e-30f);
#pragma unroll
            for (int dt = 0; dt < 4; ++dt) { const f32x4 o = *(const f32x4*)(oacc + hd[nt] * 64 + 16 * dt + 4 * fq) + O[nt][dt] * sc;
                *(v2u*)(on + hd[nt] * 64 + 16 * dt + 4 * fq) = (v2u){pk2(o[0], o[1]), pk2(o[2], o[3])}; } }
    }
}

constexpr int NW_STG = 67584;
constexpr int NW_STG_BYTES = 18432;
constexpr int NW_UN = NW_STG + 2 * NW_STG_BYTES;
struct NwStage { v4u k, v; };
__device__ __forceinline__ void nw_load(const bf16* K, const bf16* VT, int ld, int key0, int tid, NwStage& s) {
    s.k = *(const v4u*)(K + (size_t)(key0 + (tid >> 3)) * 64 + 8 * (tid & 7));
    s.v = *(const v4u*)(VT + (size_t)(tid >> 3) * ld + key0 + 8 * (tid & 7));
}
__device__ __forceinline__ void nw_store(LAS unsigned char* buf, int tid, const NwStage& s) {
    const int kk = tid >> 3, c8 = tid & 7, k32 = kk & 31;
    const int rho = 32 * (kk >> 5) + 16 * ((k32 >> 2) & 1) + 4 * (k32 >> 3) + (k32 & 3);
    *(LAS v4u*)(buf + rho * 144 + c8 * 16) = s.k;
    *(LAS v4u*)(buf + 9216 + kk * 144 + c8 * 16) = s.v;
}
template <bool WITHV>
__device__ __forceinline__ void nw_frags(const LAS unsigned char* buf, int th, int fr, int fq, KvFrags& f) {
#pragma unroll
    for (int mt = 0; mt < 2; ++mt)
#pragma unroll
        for (int ks = 0; ks < 2; ++ks) f.k[mt][ks] = *(const LAS bf16x8*)(buf + (32 * th + 16 * mt + fr) * 144 + (32 * ks + 8 * fq) * 2);
    if (WITHV) {
#pragma unroll
        for (int dt = 0; dt < 4; ++dt) f.v[dt] = *(const LAS bf16x8*)(buf + 9216 + (16 * dt + fr) * 144 + (32 * th + 8 * fq) * 2);
    }
}
#define NW_PIPE(Kp, VTp, ldv, NB, BLK, BODY) do { const int nb_ = (NB); \
        if (nb_ > 0) { NwStage st_; nw_load(Kp, VTp, ldv, BLK(0), F.tid, st_); nw_store(stg, F.tid, st_); } \
        __syncthreads(); \
        _Pragma("unroll 1") for (int ib_ = 0; ib_ < nb_; ++ib_) { \
            NwStage st_; const bool more_ = ib_ + 1 < nb_; if (more_) nw_load(Kp, VTp, ldv, BLK(ib_ + 1), F.tid, st_); \
            const LAS unsigned char* buf_ = stg + (ib_ & 1) * NW_STG_BYTES; const int key0_ = BLK(ib_); \
            BODY(buf_, key0_) \
            if (more_) nw_store(stg + ((ib_ + 1) & 1) * NW_STG_BYTES, F.tid, st_); \
            __syncthreads(); } } while (0)

__device__ __forceinline__ void nsa_wg(Frame& F, int bg, int qb) {
    int lane_ = F.lane; asm volatile("" : "+v"(lane_));
    const int lane = lane_, fr = lane & 15, fq = lane >> 4, w = F.wave, g = bg & 3;
    LAS unsigned char* L = F.lds; asm volatile("" : "+v"(L));
    LAS float* imp = (LAS float*)(L + NSA_IMP + w * 8448);
    LAS unsigned char* stg = L + NW_STG;
    LAS unsigned* wun = (LAS unsigned*)(L + NW_UN); volatile LAS unsigned char* blist = (volatile LAS unsigned char*)(L + NW_UN + 16);
    const int tt = qb * 8 + w, t = 16 * tt + fr, row0 = (bg >> 2) * PT + 16 * tt, row = row0 + fr, tw0 = 16 * tt, tw1 = tw0 + 15;
    float slope[4]; bf16x8 qreg[8];
#pragma unroll
    for (int nt = 0; nt < 4; ++nt) { slope[nt] = ex2(-0.5f * (float)(g * 4 + nt + 1)) * LOG2E;
        const bf16* qp = WSP(bf16, WS_QN) + (size_t)row * 1024 + (g * 4 + nt) * 64 + 8 * fq; qreg[2 * nt] = ld8(qp); qreg[2 * nt + 1] = ld8(qp + 32); }
    const float* gates = WSP(float, WS_GATES) + (size_t)row * 48;
    float* oacc = WSP(float, WS_OACC) + (size_t)row * 1024;
    for (int i = lane; i < 16 * 132; i += 64) imp[i] = 0.f;
    if (F.tid < 4) wun[F.tid] = 0u;
    f32x4 O[4][4]; float m[4], l[4], invl[4];
    {
        const bf16* Kc = WSP(bf16, WS_KCMP) + (size_t)bg * 512 * 64; const bf16* Vc = WSP(bf16, WS_VCMPT) + (size_t)bg * 64 * 512;
        const int cmax = (128 * qb + 127 - 31) >> 4, ncb = (cmax < 510 ? cmax : 510) / 64 + 1;
#pragma unroll
        for (int nt = 0; nt < 4; ++nt) invl[nt] = 0.f;
        nsa_zero<4>(O, m, l);
#define NW_BLK(i) (64 * (i))
#define NW_CMP1(buf, k0) { _Pragma("unroll 1") for (int th = 0; th < 2; ++th) if (16 * ((k0) + 32 * th) + 31 <= tw1) { KvFrags f; nw_frags<false>(buf, th, fr, fq, f); \
            nsa_core<4, 1, true>(f, (k0) + 32 * th, nullptr, 0, O, m, l, invl, slope, t, 16, 31, 1 << 30, true, imp + fr * 132, fq, qreg); } }
        NW_PIPE(Kc, Vc, 512, ncb, NW_BLK, NW_CMP1);
#pragma unroll
        for (int nt = 0; nt < 4; ++nt) { const float lt = x32_sum(x16_sum(l[nt])); invl[nt] = lt > 0.f ? 1.f / lt : 0.f; }
#define NW_CMP2(buf, k0) { _Pragma("unroll 1") for (int th = 0; th < 2; ++th) if (16 * ((k0) + 32 * th) + 31 <= tw1) { KvFrags f; nw_frags<true>(buf, th, fr, fq, f); \
            nsa_core<4, 2, true>(f, (k0) + 32 * th, nullptr, 0, O, m, l, invl, slope, t, 16, 31, 1 << 30, true, imp + fr * 132, fq, qreg); } }
        NW_PIPE(Kc, Vc, 512, ncb, NW_BLK, NW_CMP2);
#pragma unroll
        for (int nt = 0; nt < 4; ++nt) { const float gc = gates[0 * 16 + g * 4 + nt];
#pragma unroll
            for (int dt = 0; dt < 4; ++dt) *(f32x4*)(oacc + (g * 4 + nt) * 64 + 16 * dt + 4 * fq) = O[nt][dt] * gc; }
    }
    LDS_WAIT();
    unsigned selm[4] = {0u, 0u, 0u, 0u};
    {
        const int cur = t >> 6;
        unsigned v[32];
#pragma unroll
        for (int i = 0; i < 32; ++i) { const int j = 32 * fq + i; const bool forced = (j == 0) | (j == cur) | (j == cur - 1);
            const unsigned key = ((f2u(imp[fr * 132 + j]) & ~127u) | (unsigned)(127 - j)) + 128u;
            v[i] = (!forced && j <= cur) ? key : 0u;
            if (forced) selm[fq] |= 1u << i; }
        unsigned fw = selm[0] | selm[1] | selm[2] | selm[3];
        const unsigned w16 = __shfl_xor(fw, 16), w32 = __shfl_xor(fw, 32), w48 = __shfl_xor(fw, 48);
#pragma unroll
        for (int wd = 0; wd < 4; ++wd) selm[wd] = (fq == wd) ? fw : ((fq ^ 1) == wd) ? w16 : ((fq ^ 2) == wd) ? w32 : w48;
        const int nforced = cur >= 2 ? 3 : cur + 1;
#pragma unroll 1
        for (int rd = 0; rd < 15; ++rd) {
            unsigned mx = v[0];
#pragma unroll
            for (int i = 1; i < 32; ++i) mx = mx > v[i] ? mx : v[i];
            mx = x32_umax(x16_umax(mx));
#pragma unroll
            for (int i = 0; i < 32; ++i) v[i] = (v[i] == mx) ? 0u : v[i];
            if (mx != 0u && rd < 16 - nforced) { const int js = 127 - (int)(mx & 127u);
#pragma unroll
                for (int wd = 0; wd < 4; ++wd) selm[wd] |= ((js >> 5) == wd) ? (1u << (js & 31)) : 0u; }
        }
    }
    unsigned un[4];
#pragma unroll
    for (int wd = 0; wd < 4; ++wd) { unsigned x = selm[wd]; x |= dpp_u<DPP_XOR1>(x); x |= dpp_u<DPP_XOR2>(x); x |= dpp_u<DPP_HMIR>(x); x |= dpp_u<DPP_MIR>(x); un[wd] = (unsigned)__builtin_amdgcn_readfirstlane((int)x); }
    if (lane < 4) __hip_atomic_fetch_or(wun + lane, lane == 0 ? un[0] : lane == 1 ? un[1] : lane == 2 ? un[2] : un[3], __ATOMIC_RELAXED, __HIP_MEMORY_SCOPE_WORKGROUP);
    __syncthreads();
    unsigned wu[4];
#pragma unroll
    for (int wd = 0; wd < 4; ++wd) wu[wd] = (unsigned)__builtin_amdgcn_readfirstlane((int)wun[wd]);
    {
        nsa_zero<4>(O, m, l);
        const bf16* Ks = WSP(bf16, WS_KSEL) + (size_t)bg * PT * 64; const bf16* Vs = WSP(bf16, WS_VSELT) + (size_t)bg * 64 * PT;
        const int nsb = __builtin_popcount(wu[0]) + __builtin_popcount(wu[1]) + __builtin_popcount(wu[2]) + __builtin_popcount(wu[3]);
        if (F.tid < 128) { const int j = F.tid, wj = j >> 5, bj = j & 31; const unsigned ww = wj == 0 ? wu[0] : wj == 1 ? wu[1] : wj == 2 ? wu[2] : wu[3];
            if ((ww >> bj) & 1u) { int pos = __builtin_popcount(ww & ((1u << bj) - 1u)); if (wj > 0) pos += __builtin_popcount(wu[0]); if (wj > 1) pos += __builtin_popcount(wu[1]); if (wj > 2) pos += __builtin_popcount(wu[2]);
                blist[pos] = (unsigned char)j; } }
        __syncthreads();
#define NW_SBLK(i) (64 * (int)blist[(i)])
#define NW_SEL(buf, k0) { const int j_ = (k0) >> 6, wj_ = j_ >> 5, bj_ = j_ & 31; const unsigned uw_ = wj_ == 0 ? un[0] : wj_ == 1 ? un[1] : wj_ == 2 ? un[2] : un[3]; \
            if ((uw_ >> bj_) & 1u) { const unsigned mine_ = wj_ == 0 ? selm[0] : wj_ == 1 ? selm[1] : wj_ == 2 ? selm[2] : selm[3]; const bool ok_ = (mine_ >> bj_) & 1u; \
                _Pragma("unroll 1") for (int th = 0; th < 2; ++th) { KvFrags f; nw_frags<true>(buf, th, fr, fq, f); \
                    nsa_core<4, 0, true>(f, (k0) + 32 * th, nullptr, 0, O, m, l, invl, slope, t, 1, 0, 1 << 30, ok_, imp, fq, qreg); } } }
        NW_PIPE(Ks, Vs, PT, nsb, NW_SBLK, NW_SEL);
#pragma unroll
        for (int nt = 0; nt < 4; ++nt) { const float lt = x32_sum(x16_sum(l[nt])); const float sc = gates[1 * 16 + g * 4 + nt] / fmaxf(lt, 1e-30f);
#pragma unroll
            for (int dt = 0; dt < 4; ++dt) { f32x4* o = (f32x4*)(oacc + (g * 4 + nt) * 64 + 16 * dt + 4 * fq); *o = *o + O[nt][dt] * sc; } }
    }
    {
        nsa_zero<4>(O, m, l);
        const bf16* Kw = WSP(bf16, WS_KWIN) + (size_t)bg * PT * 64; const bf16* Vw = WSP(bf16, WS_VWINT) + (size_t)bg * 64 * PT;
        const int lo = 128 * qb - (WINDOW - 1), kb0 = (lo > 0 ? lo : 0) >> 6, kb1 = (128 * qb + 127) >> 6, nwb = kb1 - kb0 + 1;
#define NW_WBLK(i) (64 * (kb0 + (i)))
#define NW_WIN(buf, k0) { _Pragma("unroll 1") for (int th = 0; th < 2; ++th) { const int kk_ = (k0) + 32 * th; if (kk_ <= tw1 && kk_ + 31 >= tw0 - (WINDOW - 1)) { KvFrags f; nw_frags<true>(buf, th, fr, fq, f); \
                nsa_core<4, 0, true>(f, kk_, nullptr, 0, O, m, l, invl, slope, t, 1, 0, WINDOW, true, imp, fq, qreg); } } }
        NW_PIPE(Kw, Vw, PT, nwb, NW_WBLK, NW_WIN);
        bf16* on = WSP(bf16, WS_OG) + (size_t)row * 1024;
#pragma unroll
        for (int nt = 0; nt < 4; ++nt) { const float lt = x32_sum(x16_sum(l[nt])); const float sc = gates[2 * 16 + g * 4 + nt] / fmaxf(lt, 1e-30f);
#pragma unroll
            for (int dt = 0; dt < 4; ++dt) { const f32x4 o = *(const f32x4*)(oacc + (g * 4 + nt) * 64 + 16 * dt + 4 * fq) + O[nt][dt] * sc;
                *(v2u*)(on + (g * 4 + nt) * 64 + 16 * dt + 4 * fq) = (v2u){pk2(o[0], o[1]), pk2(o[2], o[3])}; } }
    }
    __syncthreads();
}

constexpr int SW_Q = 0;
constexpr int SW_IMPP = 2304;
constexpr int SW_IMPT = SW_IMPP + 8 * 2112;
constexpr int SW_LP = SW_IMPT + 2112;
constexpr int SW_OP = SW_LP + 3 * 8 * 16 * 4;
static_assert(SW_OP + 8 * 3 * 16 * 64 * 4 <= RING_BYTES, "sample NSA LDS map");
__device__ __forceinline__ void nsa_sample_wg(Frame& F, int id) {
    int lane_ = F.lane; asm volatile("" : "+v"(lane_));
    const int lane = lane_, fr = lane & 15, fq = lane >> 4, w = F.wave, g = id & 3, bs = id >> 2;
    LAS unsigned char* L = F.lds; asm volatile("" : "+v"(L));
    LAS bf16* qw = (LAS bf16*)(L + SW_Q);
    LAS float* impP = (LAS float*)(L + SW_IMPP) + w * 528; LAS float* impT = (LAS float*)(L + SW_IMPT);
    LAS float* LP = (LAS float*)(L + SW_LP); LAS float* OP = (LAS float*)(L + SW_OP);
    const int t = PAST + (fr >> 2), row0 = MP + bs * 4, trow = fr >> 2, hd = g * 4 + (fr & 3);
    if (F.tid < 128) { const int rr = F.tid >> 3, c8 = F.tid & 7;
        *(LAS v4u*)(qw + rr * NSA_QLD + 8 * c8) = *(const v4u*)(WSP(bf16, WS_QN) + (size_t)(row0 + (rr >> 2)) * 1024 + (g * 4 + (rr & 3)) * 64 + 8 * c8); }
    for (int i = lane; i < 528; i += 64) impP[i] = 0.f;
    __syncthreads();
    float slope[1] = {ex2(-0.5f * (float)(hd + 1)) * LOG2E};
    const LAS bf16* qrow = qw + fr * NSA_QLD;
    f32x4 O[1][4]; float m[1], l[1], invl[1] = {0.f};
#define SW_PUT_O(br) { _Pragma("unroll") for (int dt = 0; dt < 4; ++dt) *(LAS f32x4*)(OP + ((w * 3 + (br)) * 16 + fr) * 64 + 16 * dt + 4 * fq) = O[0][dt]; }
#define SW_PUT_L(br) { const float lt_ = x32_sum(x16_sum(l[0])); if (fq == 0) LP[((br) * 8 + w) * 16 + fr] = lt_; }
    {
        KvBf16 kv{WSP(bf16, WS_SKCMP) + (size_t)id * 512 * 64, WSP(bf16, WS_SVCMPT) + (size_t)id * 64 * 512, 512};
        nsa_zero<1>(O, m, l);
#pragma unroll 1
        for (int tl = w; tl < 16; tl += 8) nsa_tile<1, 1>(kv, 32 * tl, qrow, 0, O, m, l, invl, slope, t, 16, 31, 1 << 30, true, impP + trow * 132, fr, fq);
        SW_PUT_L(0)
        __syncthreads();
        { float lt = 0.f;
#pragma unroll
          for (int ww = 0; ww < 8; ++ww) lt += LP[(0 * 8 + ww) * 16 + fr];
          invl[0] = lt > 0.f ? 1.f / lt : 0.f; }
#pragma unroll 1
        for (int tl = w; tl < 16; tl += 8) nsa_tile<1, 2>(kv, 32 * tl, qrow, 0, O, m, l, invl, slope, t, 16, 31, 1 << 30, true, impP + trow * 132, fr, fq);
        SW_PUT_O(0)
    }
    __syncthreads();
    for (int i = F.tid; i < 528; i += 512) { float s = 0.f;
#pragma unroll
        for (int ww = 0; ww < 8; ++ww) s += ((LAS float*)(L + SW_IMPP))[ww * 528 + i];
        impT[i] = s; }
    __syncthreads();
    unsigned selm[4] = {1u, 0u, 0u, 1u << 31};
    {
        const int li = (fr & 3) * 4 + fq;
        unsigned v[8];
#pragma unroll
        for (int i = 0; i < 8; ++i) { const int j = li * 8 + i; v[i] = (j >= 1 && j <= 126) ? (((f2u(impT[trow * 132 + j]) & ~127u) | (unsigned)(127 - j)) + 128u) : 0u; }
#pragma unroll 1
        for (int rd = 0; rd < 13; ++rd) {
            unsigned mx = v[0];
#pragma unroll
            for (int i = 1; i < 8; ++i) mx = mx > v[i] ? mx : v[i];
            { unsigned o = dpp_u<DPP_XOR1>(mx); mx = mx > o ? mx : o; o = dpp_u<DPP_XOR2>(mx); mx = mx > o ? mx : o; mx = x32_umax(x16_umax(mx)); }
#pragma unroll
            for (int i = 0; i < 8; ++i) v[i] = (v[i] == mx) ? 0u : v[i];
            if (mx != 0u) { const int js = 127 - (int)(mx & 127u);
#pragma unroll
                for (int wd = 0; wd < 4; ++wd) selm[wd] |= ((js >> 5) == wd) ? (1u << (js & 31)) : 0u; }
        }
    }
    {
        nsa_zero<1>(O, m, l);
        unsigned un[4];
#pragma unroll
        for (int wd = 0; wd < 4; ++wd) { unsigned x = selm[wd]; x |= dpp_u<DPP_XOR1>(x); x |= dpp_u<DPP_XOR2>(x); x |= dpp_u<DPP_HMIR>(x); x |= dpp_u<DPP_MIR>(x); un[wd] = (unsigned)__builtin_amdgcn_readfirstlane((int)x); }
        KvSampleSel kvs{FIN(2) + g * 64, (const int*)FIN(6) + bs * NPAGES, WSP(float, WS_SNEW) + (size_t)bs * 2048 + g * 64, g};
        int q = 0;
#pragma unroll 1
        for (int wd = 0; wd < 4; ++wd) {
            unsigned mm = un[wd];
            const unsigned mine = wd == 0 ? selm[0] : wd == 1 ? selm[1] : wd == 2 ? selm[2] : selm[3];
            while (mm) {
                const int bit = __builtin_ctz(mm); mm &= mm - 1u; const int j = 32 * wd + bit;
                const bool ok = (mine >> bit) & 1u;
#pragma unroll 1
                for (int hh = 0; hh < 2; ++hh, ++q) if ((q & 7) == w) { nsa_tile<1, 0>(kvs, 64 * j + 32 * hh, qrow, 0, O, m, l, invl, slope, t, 1, 0, 1 << 30, ok, impP, fr, fq); __builtin_amdgcn_sched_barrier(0); }
            }
        }
        if ((q & 7) == w) nsa_tile<1, 0>(kvs, 64 * 128, qrow, 0, O, m, l, invl, slope, t, 1, 0, 1 << 30, true, impP, fr, fq);
        SW_PUT_O(1) SW_PUT_L(1)
    }
    {
        nsa_zero<1>(O, m, l);
        KvBf16 kv{WSP(bf16, WS_SKWIN) + (size_t)id * 544 * 64, WSP(bf16, WS_SVWINT) + (size_t)id * 64 * 544, 544};
#pragma unroll 1
        for (int kk = 32 * w; kk < 544; kk += 256) nsa_tile<1, 0>(kv, kk, qrow, 0, O, m, l, invl, slope, t, 1, PAST - WINDOW, WINDOW, true, impP, fr, fq);
        SW_PUT_O(2) SW_PUT_L(2)
    }
    __syncthreads();
    {
        const int r = F.tid >> 5, d0 = (F.tid & 31) * 2, rowg = row0 + (r >> 2), hdr = g * 4 + (r & 3);
        float o0 = 0.f, o1 = 0.f;
#pragma unroll
        for (int br = 0; br < 3; ++br) { float a0 = 0.f, a1 = 0.f, lt = 0.f;
#pragma unroll
            for (int ww = 0; ww < 8; ++ww) { const f32x2 x = *(const LAS f32x2*)(OP + ((ww * 3 + br) * 16 + r) * 64 + d0); a0 += x.x; a1 += x.y; if (br > 0) lt += LP[(br * 8 + ww) * 16 + r]; }
            const float sc = WSP(float, WS_GATES)[(size_t)rowg * 48 + br * 16 + hdr] * (br == 0 ? 1.f : 1.f / fmaxf(lt, 1e-30f));
            o0 += a0 * sc; o1 += a1 * sc; }
        *(unsigned*)(WSP(bf16, WS_OG) + (size_t)rowg * 1024 + hdr * 64 + d0) = pk2(o0, o1);
    }
    __syncthreads();
#undef SW_PUT_O
#undef SW_PUT_L
}


#ifndef MK_SINGLE
#define MK_SINGLE 1
#endif
constexpr int NPHASE = 19;
struct Args { const float* in[29]; float* out; unsigned char* ws; int ph_lo, ph_hi; };
static_assert(sizeof(Args) == 31 * 8 + 8, "Args has no padding");

__global__ void __launch_bounds__(512, 2) mk_fwd(Args args) {
    extern __shared__ __attribute__((aligned(16))) unsigned char lds_raw[];
    Frame F;
    F.lds = (LAS unsigned char*)lds_raw;
    F.tid = threadIdx.x; F.lane = F.tid & 63; F.wave = __builtin_amdgcn_readfirstlane(F.tid >> 6);
    F.G = gridDim.x; F.bid = blockIdx.x;
    F.ka = (const __attribute__((address_space(4))) char*)__builtin_amdgcn_kernarg_segment_ptr();
    F.out = args.out; F.ws = args.ws;
    volatile LAS unsigned* MISC = (volatile LAS unsigned*)(F.lds + MISC_OFF);
    for (int u = F.tid; u < (LDS_BYTES - LDSCTL_OFF) / 4; u += 512) ((LAS unsigned*)(F.lds + LDSCTL_OFF))[u] = 0u;
    __syncthreads();
    unsigned* barw = (unsigned*)(F.ws + WS_CTL) + 4096;
    XcdBarrier bar; bar.bar = barw; bar.x = 0; bar.st = nullptr;
    const int lo = args.ph_lo, hi = args.ph_hi;
    if (hi - lo > 1) bar = xcd_barrier_post(barw, MISC + 8);
#ifndef PH_MASK
#define PH_MASK 0xFFFFFFFFu
#endif
#define IN(k) (((PH_MASK >> (k)) & 1u) && lo <= (k) && (k) < hi)
#define SEAM(k) do { if (IN(k) && IN((k) + 1)) xcd_barrier(bar); } while (0)
    const int gw = F.bid * 8 + F.wave, NGW = F.G * 8;

#ifndef REPX
#define REPX 0
#endif
#ifndef REPY
#define REPY 0
#endif
#ifndef REP_MASK
#define REP_MASK 0u
#endif
#define PHASE(k, ...) if (IN(k)) { _Pragma("unroll 1") for (int rep_ = 0; rep_ < (int)((REP_MASK >> (k)) & 1u) + 1; ++rep_) { if (rep_) xcd_barrier(bar); __VA_ARGS__ } } SEAM(k);
    PHASE(0, p0_prologue(F);)
    PHASE(1, { pg8::Gemm g{WSP(bf16, WS_CKA), WSP(bf16, WS_W1BD), 65536, 256, 2048}; pg8::StaticOrder S; S.init(65536, 256, F.G, F.bid);
               pg8::EpiFn<FnF32> E{FnF32{WSP(float, WS_FS), 256}}; pg8::gemm_phase<pg8::EpiFn<FnF32>, pg8::StaticOrder, true, true>(F.lds, g, S, E); })
    PHASE(2, gemm_all(F, WSP(bf16, WS_XNA), WSP(bf16, WS_WIN_T), 4096, FnBf16{WSP(bf16, WS_PROJ), 4096});)
    PHASE(3, for (int u = F.bid; u < 2048 + 256; u += F.G) { if (u < 2048) p2_chunk(F, u); else p2_sample(F, u - 2048); })
    PHASE(4, if (F.G == 256) { const int x = F.bid & 7, idx = F.bid >> 3; if (idx < 16) p3_scan(F, x * 2 + (idx >> 3), idx & 7); }
             else { for (int u = F.bid; u < 128; u += F.G) p3_scan(F, u >> 3, u & 7); })
    PHASE(5, for (int r = gw; r < MTOK; r += NGW) p4_row(F, r);
             for (int id = gw; id < 8192; id += NGW) compress_sample(F, id);)
    PHASE(6, gemm_all(F, WSP(bf16, WS_OG), WSP(bf16, WS_WOA_T), 1024, FnResid{WSP(float, WS_XS), FIN(0), FIN(1)});)
    PHASE(7, for (int r = gw; r < MTOK; r += NGW) rms_row_to_bf16(WSP(float, WS_XS) + (size_t)r * DM, WSP(bf16, WS_XNB) + (size_t)r * DM, F.lane);)
    PHASE(8, gemm_all(F, WSP(bf16, WS_XNB), WSP(bf16, WS_WPQ_T), 2048, FnBf16{WSP(bf16, WS_QPEER), 2048});)
    PHASE(9, p8_init_tab(F); for (int u = F.bid; u < MTOK / 16; u += F.G) p8_unit(F, u, 0);)
    PHASE(10, for (int r = gw; r < MTOK; r += NGW) p9_token(F, r, 0, 0);)
    PHASE(11, gemm_all(F, WSP(bf16, WS_XNA), WSP(bf16, WS_WKVQ_T), NKVQ, FnKvq{WSP(float, WS_KVQ)});)
    PHASE(12, _Pragma("unroll 1") for (int q_ = 0; q_ < 1 + REPX; ++q_) { for (int u = F.bid; u < 256; u += F.G) pp_prompt_tile(F, u);
              for (int r = gw; r < MS; r += NGW) pp_sample_row(F, r); }
              _Pragma("unroll 1") for (int q_ = 0; q_ < 1 + REPY; ++q_) { for (int id = gw; id < 512; id += NGW) compress_prompt(F, id); })
    PHASE(13, if (F.G == 256) {
                  _Pragma("unroll 1") for (int q_ = 0; q_ < 1 + REPX; ++q_) { if (F.bid < 128) nsa_sample_wg(F, F.bid); }
                  __syncthreads();
                  nsa_wg(F, F.bid & 7, F.bid >> 3); nsa_wg(F, F.bid & 7, 63 - (F.bid >> 3));
              } else { for (int id = gw; id < 128 + 4096; id += NGW) { if (id < 128) nsa_unit<true>(F, id); else nsa_unit<false>(F, id - 128); } })
    PHASE(14, gemm_all(F, WSP(bf16, WS_OG), WSP(bf16, WS_WOB_T), 1024, FnResid{WSP(float, WS_XS), WSP(float, WS_XS), WSP(float, WS_XS) + (size_t)MP * DM});)
    PHASE(15, for (int r = gw; r < MTOK; r += NGW) rms_row_to_bf16(WSP(float, WS_XS) + (size_t)r * DM, WSP(bf16, WS_XNB) + (size_t)r * DM, F.lane);)
    PHASE(16, gemm_all(F, WSP(bf16, WS_XNB), WSP(bf16, WS_WPQ_T) + (size_t)2048 * 1024, 2048, FnBf16{WSP(bf16, WS_QPEER), 2048});)
    PHASE(17, p8_init_tab(F); for (int u = F.bid; u < MTOK / 16; u += F.G) p8_unit(F, u, 1);)
    PHASE(18, for (int r = gw; r < MTOK; r += NGW) p9_token(F, r, 1, 1);)
#undef IN
#undef SEAM
}

extern "C" void kernel_launch(void* const* d_in, const int* in_sizes, int n_in, void* d_out, int out_size, void* d_ws, size_t ws_size, hipStream_t stream) {
    static int grid = 0;
    if (grid == 0) {
        if (n_in != 29 || (size_t)out_size != O_END || ws_size < WS_END) { fprintf(stderr, "kernel_launch: unexpected shapes n_in %d out %d ws %zu (need %zu)\n", n_in, out_size, ws_size, (size_t)WS_END); grid = -1; return; }
        int dev = 0, cus = 0, per_cu = 0;
        if (hipGetDevice(&dev) != hipSuccess || hipDeviceGetAttribute(&cus, hipDeviceAttributeMultiprocessorCount, dev) != hipSuccess) { grid = -1; return; }
        if (hipFuncSetAttribute((const void*)mk_fwd, hipFuncAttributeMaxDynamicSharedMemorySize, LDS_BYTES) != hipSuccess) { fprintf(stderr, "kernel_launch: hipFuncSetAttribute failed\n"); grid = -1; return; }
        if (hipOccupancyMaxActiveBlocksPerMultiprocessor(&per_cu, (const void*)mk_fwd, 512, LDS_BYTES) != hipSuccess || per_cu < 1) fprintf(stderr, "kernel_launch: occupancy query reports %d\n", per_cu);
        (void)hipGetLastError();
        grid = cus;
    }
    if (grid < 0) return;
    if (hipMemsetAsync((char*)d_ws + WS_CTL, 0, CTL_BYTES, stream) != hipSuccess) return;
    Args a{};
    for (int i = 0; i < 29; ++i) a.in[i] = (const float*)d_in[i];
    a.out = (float*)d_out; a.ws = (unsigned char*)d_ws;
#if MK_SINGLE
    a.ph_lo = 0; a.ph_hi = NPHASE;
    hipLaunchKernelGGL(mk_fwd, dim3(grid), dim3(512), LDS_BYTES, stream, a);
#else
    for (int p = 0; p < NPHASE; ++p) { a.ph_lo = p; a.ph_hi = p + 1; hipLaunchKernelGGL(mk_fwd, dim3(grid), dim3(512), LDS_BYTES, stream, a); }
#endif
    const hipError_t le = hipPeekAtLastError();
    if (le != hipSuccess) fprintf(stderr, "kernel_launch: launch failed: %s\n", hipGetErrorName(le));
}
```

```cpp
#include <hip/hip_runtime.h>
#include <cstdio>
#include <cstdint>

constexpr int DM = 1024, PB = 2, PT = 8192, SB = 32, SL = 4, PAST = 8192, PAGE = 128;
constexpr int MP = PB * PT;
constexpr int MS = SB * SL;
constexpr int MTOK = MP + MS;
constexpr int GH = 8, GDK = 128, GDV = 128, GCONV = 3072, GPROJ = 4112, CHUNK = 64, NCH = PT / CHUNK;
constexpr int NH = 16, NG = 4, HPG = 4, DH = 64, NQG = 1072, NKV = 1536, NKVQ = 2816, NKVQ_REAL = 2608;
constexpr int WINDOW = 512, NSELP = 128, NSELS = 129, NCMP = 511;
constexpr int PEH = 8, PEDQ = 256, PEHALF = 128, NKEYS = 128, NEXP = 16384, PETOP = 16;
constexpr int NPAGES = PAST / PAGE;
constexpr float EPS = 1e-6f;

constexpr size_t O_YP = 0;
constexpr size_t O_YS = O_YP + (size_t)MP * DM;
constexpr size_t O_KVP = O_YS + (size_t)MS * DM;
constexpr size_t O_WINP = O_KVP + (size_t)MP * 1024;
constexpr size_t O_GDNP = O_WINP + (size_t)PB * 512 * 512;
constexpr size_t O_CONVP = O_GDNP + (size_t)PB * GH * 128 * 128;
constexpr size_t O_KVS = O_CONVP + (size_t)PB * 3 * GCONV;
constexpr size_t O_WINS = O_KVS + (size_t)MS * 1024;
constexpr size_t O_GDNS = O_WINS + (size_t)SB * 512 * 512;
constexpr size_t O_CONVS = O_GDNS + (size_t)SB * GH * 128 * 128;
constexpr size_t O_END = O_CONVS + (size_t)SB * 3 * GCONV;

constexpr size_t MiB = 1u << 20;
constexpr size_t al(size_t x) { return (x + 4095) & ~(size_t)4095; }
constexpr size_t WS_CTL = 0, CTL_BYTES = 1 * MiB;
constexpr size_t WS_WIN_T = WS_CTL + CTL_BYTES;
constexpr size_t WS_WOA_T = WS_WIN_T + (size_t)4096 * 1024 * 2;
constexpr size_t WS_WKVQ_T = WS_WOA_T + (size_t)1024 * 1024 * 2;
constexpr size_t WS_WOB_T = WS_WKVQ_T + (size_t)NKVQ * 1024 * 2;
constexpr size_t WS_WPQ_T = WS_WOB_T + (size_t)1024 * 1024 * 2;
constexpr size_t WS_WAB = WS_WPQ_T + (size_t)2 * 2048 * 1024 * 2;
constexpr size_t WS_SUBK = WS_WAB + (size_t)16 * 1024 * 4;
constexpr size_t WS_W1T = WS_SUBK + (size_t)2 * 8 * 2 * 128 * 128 * 2;
constexpr size_t WS_PETERM = WS_W1T + (size_t)2 * 128 * 1024 * 2;
constexpr size_t WS_PU = al(WS_PETERM + 512);
constexpr size_t WS_PV = WS_PU + (size_t)2 * NEXP * DM * 2;
constexpr size_t WS_XNA = WS_PV + (size_t)2 * NEXP * DM * 2;
constexpr size_t WS_XNB = al(WS_XNA + (size_t)MTOK * DM * 2);
constexpr size_t WS_PROJ = al(WS_XNB + (size_t)MTOK * DM * 2);
constexpr size_t WS_GW = al(WS_PROJ + (size_t)MTOK * 4096 * 2);
constexpr size_t WS_GQ = WS_GW + (size_t)2048 * 64 * 128 * 2;
constexpr size_t WS_GKT = WS_GQ + (size_t)2048 * 64 * 128 * 2;
constexpr size_t WS_GQK = WS_GKT + (size_t)2048 * 64 * 128 * 2;
constexpr size_t WS_GU = WS_GQK + (size_t)2048 * 64 * 64 * 2;
constexpr size_t WS_GDEC = WS_GU + (size_t)2048 * 64 * 128 * 4;
constexpr size_t WS_OGDN = al(WS_GDEC + 2048 * 4);
constexpr size_t WS_OG = al(WS_OGDN + (size_t)MTOK * DM * 4);
constexpr size_t WS_XS = al(WS_OG + (size_t)MTOK * DM * 2);
constexpr size_t WS_QPEER = al(WS_XS + (size_t)MTOK * DM * 4);
constexpr size_t WS_PEI = al(WS_QPEER + (size_t)MTOK * 2048 * 2);
constexpr size_t WS_PEG = al(WS_PEI + (size_t)MTOK * 128 * 4);
constexpr size_t WS_KVQ = al(WS_PEG + (size_t)MTOK * 128 * 4);
constexpr size_t WS_KSEL = al(WS_KVQ + (size_t)MTOK * NKVQ * 4);
constexpr size_t WS_VSELT = WS_KSEL + (size_t)PB * NG * PT * 64 * 2;
constexpr size_t WS_KWIN = WS_VSELT + (size_t)PB * NG * PT * 64 * 2;
constexpr size_t WS_VWINT = WS_KWIN + (size_t)PB * NG * PT * 64 * 2;
constexpr size_t WS_KCMP = WS_VWINT + (size_t)PB * NG * PT * 64 * 2;
constexpr size_t WS_VCMPT = WS_KCMP + (size_t)PB * NG * 512 * 64 * 2;
constexpr size_t WS_SKCMP = WS_VCMPT + (size_t)PB * NG * 512 * 64 * 2;
constexpr size_t WS_SVCMPT = WS_SKCMP + (size_t)SB * NG * 512 * 64 * 2;
constexpr size_t WS_SKWIN = WS_SVCMPT + (size_t)SB * NG * 512 * 64 * 2;
constexpr size_t WS_SVWINT = WS_SKWIN + (size_t)SB * NG * 544 * 64 * 2;
constexpr size_t WS_SNEW = WS_SVWINT + (size_t)SB * NG * 544 * 64 * 2;
constexpr size_t WS_QN = al(WS_SNEW + (size_t)SB * 4 * 2 * 4 * 64 * 4);
constexpr size_t WS_GATES = al(WS_QN + (size_t)MTOK * 1024 * 2);
constexpr size_t WS_OACC = al(WS_GATES + (size_t)MTOK * 48 * 4);
constexpr size_t WS_CKA = al(WS_OACC + (size_t)MTOK * DM * 4);
constexpr size_t WS_W1BD = al(WS_CKA + (size_t)65536 * 2048 * 2);
constexpr size_t WS_FS = al(WS_W1BD + (size_t)256 * 2048 * 2);
constexpr size_t WS_END = al(WS_FS + (size_t)65536 * 256 * 4);

constexpr int RING_BYTES = 143360;
constexpr int LDSCTL_OFF = RING_BYTES, MISC_OFF = LDSCTL_OFF + 320;
constexpr int LDS_BYTES = 147456;

#define GAS __attribute__((address_space(1)))
#define LAS __attribute__((address_space(3)))
typedef unsigned short bf16;
typedef unsigned v4u __attribute__((ext_vector_type(4)));
typedef unsigned v2u __attribute__((ext_vector_type(2)));
typedef float f32x4 __attribute__((ext_vector_type(4)));
typedef float f32x2 __attribute__((ext_vector_type(2)));
typedef short bf16x8 __attribute__((ext_vector_type(8)));
typedef GAS unsigned gu32;
#define RLX_AGENT __ATOMIC_RELAXED, __HIP_MEMORY_SCOPE_AGENT
#define LDS_WAIT() asm volatile("s_waitcnt lgkmcnt(0)" ::: "memory")
#define VM_WAIT() asm volatile("s_waitcnt vmcnt(0)" ::: "memory")

__device__ __forceinline__ unsigned f2bf(float f) { unsigned u = __builtin_bit_cast(unsigned, f); return (u + 0x7fffu + ((u >> 16) & 1u)) >> 16; }
typedef __bf16 hwbf16x2 __attribute__((ext_vector_type(2)));
__device__ __forceinline__ unsigned pk2(float lo, float hi) { const f32x2 v = {lo, hi}; return __builtin_bit_cast(unsigned, __builtin_convertvector(v, hwbf16x2)); }
__device__ __forceinline__ float bf2f(unsigned b) { return __builtin_bit_cast(float, b << 16); }
__device__ __forceinline__ float bflo(unsigned w) { return __builtin_bit_cast(float, w << 16); }
__device__ __forceinline__ float bfhi(unsigned w) { return __builtin_bit_cast(float, w & 0xffff0000u); }
#ifndef USE_PERMSWAP
#define USE_PERMSWAP 1
#endif
template <int CTRL> __device__ __forceinline__ float dpp_f(float x) { return __builtin_bit_cast(float, __builtin_amdgcn_update_dpp(0, __builtin_bit_cast(int, x), CTRL, 0xF, 0xF, true)); }
template <int CTRL> __device__ __forceinline__ unsigned dpp_u(unsigned x) { return (unsigned)__builtin_amdgcn_update_dpp(0, (int)x, CTRL, 0xF, 0xF, true); }
#define DPP_XOR1 0xB1
#define DPP_XOR2 0x4E
#define DPP_HMIR 0x141
#define DPP_MIR 0x140
#define DPP_ROR4 0x124
#define DPP_ROR8 0x128
#if USE_PERMSWAP
#define PSWAP16(a, b) asm volatile("s_nop 1\n\tv_permlane16_swap_b32 %0, %1" : "+v"(a), "+v"(b))
#define PSWAP32(a, b) asm volatile("s_nop 1\n\tv_permlane32_swap_b32 %0, %1" : "+v"(a), "+v"(b))
__device__ __forceinline__ float x16_sum(float x) { unsigned a = __builtin_bit_cast(unsigned, x), b = a; PSWAP16(a, b); return __builtin_bit_cast(float, a) + __builtin_bit_cast(float, b); }
__device__ __forceinline__ float x32_sum(float x) { unsigned a = __builtin_bit_cast(unsigned, x), b = a; PSWAP32(a, b); return __builtin_bit_cast(float, a) + __builtin_bit_cast(float, b); }
__device__ __forceinline__ float x16_max(float x) { unsigned a = __builtin_bit_cast(unsigned, x), b = a; PSWAP16(a, b); return fmaxf(__builtin_bit_cast(float, a), __builtin_bit_cast(float, b)); }
__device__ __forceinline__ float x32_max(float x) { unsigned a = __builtin_bit_cast(unsigned, x), b = a; PSWAP32(a, b); return fmaxf(__builtin_bit_cast(float, a), __builtin_bit_cast(float, b)); }
__device__ __forceinline__ unsigned x16_umax(unsigned u) { unsigned a = u, b = u; PSWAP16(a, b); return a > b ? a : b; }
__device__ __forceinline__ unsigned x32_umax(unsigned u) { unsigned a = u, b = u; PSWAP32(a, b); return a > b ? a : b; }
#else
__device__ __forceinline__ float x16_sum(float x) { return x + __shfl_xor(x, 16); }
__device__ __forceinline__ float x32_sum(float x) { return x + __shfl_xor(x, 32); }
__device__ __forceinline__ float x16_max(float x) { return fmaxf(x, __shfl_xor(x, 16)); }
__device__ __forceinline__ float x32_max(float x) { return fmaxf(x, __shfl_xor(x, 32)); }
__device__ __forceinline__ unsigned x16_umax(unsigned u) { const unsigned o = __shfl_xor(u, 16); return u > o ? u : o; }
__device__ __forceinline__ unsigned x32_umax(unsigned u) { const unsigned o = __shfl_xor(u, 32); return u > o ? u : o; }
#endif
__device__ __forceinline__ float row_sum16(float x) { x += dpp_f<DPP_XOR1>(x); x += dpp_f<DPP_XOR2>(x); x += dpp_f<DPP_HMIR>(x); x += dpp_f<DPP_MIR>(x); return x; }
__device__ __forceinline__ float wave_sum(float v) { return x32_sum(x16_sum(row_sum16(v))); }
__device__ __forceinline__ float silu_f(float x) { return x / (1.f + __expf(-x)); }
__device__ __forceinline__ float sigmoid_f(float x) { return 1.f / (1.f + __expf(-x)); }
__device__ __forceinline__ float gelu_tanh(float x) {
    const float u = 0.7978845608028654f * (x + 0.044715f * x * x * x);
    const float e = __expf(2.f * u);
    const float th = 1.f - 2.f / (e + 1.f);
    return 0.5f * x * (1.f + th);
}
__device__ __forceinline__ bf16x8 ld8(const bf16* p) { return *(const bf16x8*)p; }
__device__ __forceinline__ bf16x8 ld8l(const LAS bf16* p) { return *(const LAS bf16x8*)p; }
#define MFMA16(a, b, c) __builtin_amdgcn_mfma_f32_16x16x32_bf16((a), (b), (c), 0, 0, 0)
__device__ __forceinline__ bf16x8 cvt8(f32x4 a, f32x4 b) {
    v4u r; r.x = pk2(a.x, a.y); r.y = pk2(a.z, a.w); r.z = pk2(b.x, b.y); r.w = pk2(b.z, b.w); return __builtin_bit_cast(bf16x8, r);
}

struct Frame {
    LAS unsigned char* lds;
    int tid, lane, wave, G, bid;
    const __attribute__((address_space(4))) char* ka;
    float* out;
    unsigned char* ws;
};
#define WSP(T, off) ((T*)(F.ws + (off)))
__device__ __forceinline__ const float* fin_(const __attribute__((address_space(4))) char* ka, int i) {
    const __attribute__((address_space(4))) char* p = ka; asm volatile("" : "+s"(p));
    return *(const float* const __attribute__((address_space(4)))*)(p + 8 * i);
}
#define FIN(i) fin_(F.ka, (i))
namespace pg8 {
#define PG8_LAS __attribute__((address_space(3)))
typedef unsigned short bf16_t;
typedef short bf16x8 __attribute__((ext_vector_type(8)));
typedef float f32x4 __attribute__((ext_vector_type(4)));
typedef unsigned u32x4 __attribute__((ext_vector_type(4)));
constexpr int BM = 256, BK = 64, HALF = 128, HTB = HALF * BK * 2  , STAGE_BYTES = 8 * HTB, NXCD = 8, WGM = 8;

__host__ __device__ __forceinline__ int lds_byte(int r, int c) { const int st = (r >> 4) * 2 + (c >> 5), rr = r & 15, cc = c & 31, ob = rr * 64 + cc * 2; return st * 1024 + (ob ^ (((ob >> 9) & 1) << 5)); }
__host__ __device__ __forceinline__ void stage_rc(int b, int& R, int& C) { const int st = b / 1024, sb = b % 1024, swz = sb ^ (((sb >> 9) & 1) << 5); R = (st >> 1) * 16 + swz / 64; C = (st & 1) * 32 + (swz % 64) / 2; }
__host__ __device__ __forceinline__ int perm32(int rho) { const int n = rho >> 4, i = rho & 15; return 8 * (i >> 2) + 4 * n + (i & 3); }

struct Unit { int pm, pn; };
struct Gemm { const bf16_t* A; const bf16_t* Bt; int M, N, K; };

struct StaticOrder {
    int nM, nN, nwg, G, c;
    __host__ __device__ void init(int M, int N, int G_, int c_) { nM = M / BM; nN = N / BM; nwg = nM * nN; G = G_; c = c_; }
    __host__ __device__ bool next(int i, Unit& u) const {
        const long L = (long)i * G + c; if (L >= nwg) return false;
        int wgid = (int)L; { const int q = nwg / NXCD, r = nwg % NXCD, xcd = wgid % NXCD, off = wgid / NXCD; wgid = (xcd < r ? xcd * (q + 1) : r * (q + 1) + (xcd - r) * q) + off; }
        const int nig = WGM * nN, gid = wgid / nig, fm = gid * WGM, gsz = (nM - fm) < WGM ? (nM - fm) : WGM;
        u.pm = fm + ((wgid % nig) % gsz); u.pn = (wgid % nig) / gsz; return true;
    }
    __device__ __forceinline__ void a_ready(const Unit&) const {}
    __device__ __forceinline__ void done(const Unit&) const {}
};
template <class Epi, class Sched, bool ALIGN_EPI = false, bool SP2 = false>
__device__ __forceinline__ void gemm_phase(PG8_LAS unsigned char* lds, const Gemm g, const Sched& S, const Epi& E) {
    const int tid = threadIdx.x, wid = __builtin_amdgcn_readfirstlane(tid >> 6), lane = tid & 63, wr = wid >> 2, wc = wid & 3, fr = lane & 15, fq = lane >> 4;
    const int K = g.K, nt = K / BK;
    unsigned voffA[2], voffB[2];
#pragma unroll
    for (int i = 0; i < 2; ++i) { int R, C; stage_rc(tid * 16 + i * 8192, R, C); const int Rb = Epi::PERM ? ((R & ~31) + perm32(R & 31)) : R;
        voffA[i] = (unsigned)(R * K + C) * 2u; voffB[i] = (unsigned)(Rb * K + C) * 2u; }
    const size_t kstep = (size_t)(BK * 2);
    const size_t hstep = (size_t)HALF * K * 2;
    const size_t tstep = 2 * hstep;
    const unsigned ldsw = (unsigned)wid * 1024u;
    const int aoff = lds_byte(wr * 64 + fr, fq * 8), boff = lds_byte(wc * 32 + fr, fq * 8);
#define PG8_SA(b, h) (((b) * 2 + (h)) * HTB)
#define PG8_SB(b, h) ((4 + (b) * 2 + (h)) * HTB)
#define PG8_STAGE(bufoff, gbase, voff) do { _Pragma("unroll") for (int _i = 0; _i < 2; ++_i) \
        __builtin_amdgcn_global_load_lds((const unsigned*)((const char*)(gbase) + (voff)[_i]), (PG8_LAS unsigned*)(lds + (bufoff) + ldsw + _i * 8192), 16, 0, 0); } while (0)
#define PG8_LDA(dst, b, h) do { _Pragma("unroll") for (int m = 0; m < 4; ++m) _Pragma("unroll") for (int k = 0; k < 2; ++k) dst[m][k] = *(const PG8_LAS bf16x8*)(lds + PG8_SA(b, h) + aoff + m * 2048 + k * 1024); } while (0)
#define PG8_LDB(dst, b, h) do { _Pragma("unroll") for (int n = 0; n < 2; ++n) _Pragma("unroll") for (int k = 0; k < 2; ++k) dst[n][k] = *(const PG8_LAS bf16x8*)(lds + PG8_SB(b, h) + boff + n * 2048 + k * 1024); } while (0)
#define PG8_MMA(ai, bj, At, Bt) do { __builtin_amdgcn_s_setprio(1); _Pragma("unroll") for (int m = 0; m < 4; ++m) _Pragma("unroll") for (int n = 0; n < 2; ++n) _Pragma("unroll") for (int k = 0; k < 2; ++k) \
        acc[ai][bj][m][n] = __builtin_amdgcn_mfma_f32_16x16x32_bf16(Bt[n][k], At[m][k], acc[ai][bj][m][n], 0, 0, 0); __builtin_amdgcn_s_setprio(0); } while (0)
#define PG8_WAIT_V(n) asm volatile("s_waitcnt vmcnt(" #n ")" ::: "memory")
#define PG8_WAIT_L(n) asm volatile("s_waitcnt lgkmcnt(" #n ")" ::: "memory")
#define PG8_BAR __builtin_amdgcn_s_barrier()
#define PG8_SCHED __builtin_amdgcn_sched_barrier(0)
    Unit cur, nxt; int ui = 0;
    if (!S.next(0, cur)) return;
    f32x4 acc[2][2][4][2];
#pragma unroll
    for (int a = 0; a < 2; ++a)
#pragma unroll
        for (int b = 0; b < 2; ++b)
#pragma unroll
            for (int m = 0; m < 4; ++m)
#pragma unroll
                for (int n = 0; n < 2; ++n) acc[a][b][m][n] = (f32x4){0.f, 0.f, 0.f, 0.f};
    bf16x8 At[4][2], B0[2][2], B1[2][2];
    const char* cA = (const char*)g.A + (size_t)cur.pm * tstep; const char* cB = (const char*)g.Bt + (size_t)cur.pn * tstep;
    S.a_ready(cur);
    if constexpr (SP2) {
        PG8_STAGE(PG8_SB(0, 0), cB, voffB); PG8_STAGE(PG8_SB(0, 1), cB + hstep, voffB); PG8_STAGE(PG8_SA(0, 0), cA, voffA); PG8_STAGE(PG8_SA(0, 1), cA + hstep, voffA);
        if (wr == 1) PG8_BAR;
        PG8_WAIT_V(2); PG8_BAR;
        PG8_STAGE(PG8_SB(1, 0), cB + kstep, voffB); PG8_STAGE(PG8_SA(1, 0), cA + kstep, voffA); PG8_STAGE(PG8_SB(1, 1), cB + hstep + kstep, voffB);
        PG8_WAIT_V(6); PG8_BAR;
    } else {
        PG8_STAGE(PG8_SB(0, 0), cB, voffB); PG8_STAGE(PG8_SA(0, 0), cA, voffA); PG8_STAGE(PG8_SB(0, 1), cB + hstep, voffB); PG8_STAGE(PG8_SA(0, 1), cA + hstep, voffA);
        if (wr == 1) PG8_BAR;
        PG8_WAIT_V(4); PG8_BAR;
        PG8_STAGE(PG8_SB(1, 0), cB + kstep, voffB); PG8_STAGE(PG8_SA(1, 0), cA + kstep, voffA); PG8_STAGE(PG8_SB(1, 1), cB + hstep + kstep, voffB);
        PG8_WAIT_V(6); PG8_BAR;
    }
    for (;;) {
        const bool has_next = S.next(ui + 1, nxt);
        const char* nA = has_next ? (const char*)g.A + (size_t)nxt.pm * tstep : cA; const char* nB = has_next ? (const char*)g.Bt + (size_t)nxt.pn * tstep : cB;
        for (int t = 0; t < nt; t += 2) {
            const bool last = (t == nt - 2);
            const char* a1 = cA + (size_t)(t + 1) * kstep;
            const char* a2 = last ? nA : cA + (size_t)(t + 2) * kstep; const char* b2 = last ? nB : cB + (size_t)(t + 2) * kstep;
            const char* a3 = a2 + kstep; const char* b3 = b2 + kstep;
            if (last && has_next) S.a_ready(nxt);
            if constexpr (SP2) {
            PG8_LDB(B0, 0, 0); PG8_LDB(B1, 0, 1); PG8_SCHED; PG8_LDA(At, 0, 0); PG8_STAGE(PG8_SA(1, 1), a1 + hstep, voffA);
            PG8_WAIT_V(8); PG8_WAIT_L(0); PG8_BAR; PG8_MMA(0, 0, At, B0); PG8_MMA(0, 1, At, B1); PG8_BAR; PG8_SCHED;
            PG8_LDA(At, 0, 1); PG8_STAGE(PG8_SB(0, 0), b2, voffB); PG8_STAGE(PG8_SB(0, 1), b2 + hstep, voffB); PG8_STAGE(PG8_SA(0, 0), a2, voffA);
            PG8_WAIT_V(8); PG8_WAIT_L(0); PG8_BAR; PG8_MMA(1, 0, At, B0); PG8_MMA(1, 1, At, B1); PG8_BAR; PG8_SCHED;
            PG8_LDB(B0, 1, 0); PG8_LDB(B1, 1, 1); PG8_SCHED; PG8_LDA(At, 1, 0); PG8_STAGE(PG8_SA(0, 1), a2 + hstep, voffA);
            PG8_WAIT_V(8); PG8_WAIT_L(0); PG8_BAR; PG8_MMA(0, 0, At, B0); PG8_MMA(0, 1, At, B1); PG8_BAR; PG8_SCHED;
            PG8_LDA(At, 1, 1); PG8_STAGE(PG8_SB(1, 0), b3, voffB); PG8_STAGE(PG8_SB(1, 1), b3 + hstep, voffB); PG8_STAGE(PG8_SA(1, 0), a3, voffA);
            PG8_WAIT_V(8); PG8_WAIT_L(0); PG8_BAR; PG8_MMA(1, 0, At, B0); PG8_MMA(1, 1, At, B1); PG8_BAR; PG8_SCHED;
            } else {
            PG8_LDB(B0, 0, 0); PG8_SCHED; PG8_LDA(At, 0, 0); PG8_STAGE(PG8_SA(1, 1), a1 + hstep, voffA);
            PG8_WAIT_L(8); PG8_BAR; PG8_WAIT_L(0); PG8_MMA(0, 0, At, B0); PG8_BAR; PG8_SCHED;
            PG8_LDB(B1, 0, 1); PG8_STAGE(PG8_SB(0, 0), b2, voffB);
            PG8_BAR; PG8_WAIT_L(0); PG8_MMA(0, 1, At, B1); PG8_BAR;
            PG8_LDA(At, 0, 1); PG8_STAGE(PG8_SA(0, 0), a2, voffA);
            PG8_BAR; PG8_WAIT_L(0); PG8_MMA(1, 0, At, B0); PG8_BAR; PG8_SCHED;
            PG8_STAGE(PG8_SB(0, 1), b2 + hstep, voffB);
            PG8_WAIT_V(6); PG8_BAR; PG8_MMA(1, 1, At, B1); PG8_BAR;
            PG8_LDB(B0, 1, 0); PG8_SCHED; PG8_LDA(At, 1, 0); PG8_STAGE(PG8_SA(0, 1), a2 + hstep, voffA);
            PG8_WAIT_L(8); PG8_BAR; PG8_WAIT_L(0); PG8_MMA(0, 0, At, B0); PG8_BAR; PG8_SCHED;
            PG8_LDB(B1, 1, 1); PG8_STAGE(PG8_SB(1, 0), b3, voffB);
            PG8_BAR; PG8_WAIT_L(0); PG8_MMA(0, 1, At, B1); PG8_BAR;
            PG8_LDA(At, 1, 1); PG8_STAGE(PG8_SA(1, 0), a3, voffA);
            PG8_BAR; PG8_WAIT_L(0); PG8_MMA(1, 0, At, B0); PG8_BAR; PG8_SCHED;
            PG8_STAGE(PG8_SB(1, 1), b3 + hstep, voffB);
            PG8_WAIT_V(6); PG8_BAR; PG8_MMA(1, 1, At, B1); PG8_BAR;
            }
        }
        if constexpr (ALIGN_EPI) { if (wr == 0) PG8_BAR; }
        if constexpr (!Epi::AFTER_DRAIN) { E(acc, cur, wr, wc, fr, fq); S.done(cur); }
        if (!has_next) break;
#pragma unroll
        for (int a = 0; a < 2; ++a)
#pragma unroll
            for (int b = 0; b < 2; ++b)
#pragma unroll
                for (int m = 0; m < 4; ++m)
#pragma unroll
                    for (int n = 0; n < 2; ++n) acc[a][b][m][n] = (f32x4){0.f, 0.f, 0.f, 0.f};
        cur = nxt; cA = nA; cB = nB; ++ui;
        if constexpr (ALIGN_EPI) { if (wr == 1) PG8_BAR; }
    }
    PG8_WAIT_V(0);
    if constexpr (!ALIGN_EPI) { if (wr == 0) PG8_BAR; }
    PG8_BAR;
    if constexpr (Epi::AFTER_DRAIN) { E.fused(acc, cur, wr, wc, fr, fq, lds, wid, lane); S.done(cur); }
#undef PG8_SA
#undef PG8_SB
#undef PG8_STAGE
#undef PG8_LDA
#undef PG8_LDB
#undef PG8_MMA
#undef PG8_WAIT_V
#undef PG8_WAIT_L
#undef PG8_BAR
#undef PG8_SCHED
}
}
#define XB_TMO      128
#define XB_XCNT(j)  (256  + 64 * (j))
#define XB_XSUB(j)  (1280 + 64 * (j))
#define XB_XGEN(j)  (2304 + 64 * (j))
#define XB_TOP      3328
#define XB_TOPGEN   3392
#define XCD_BAR_WORDS 3456
#define XB_SPIN_CAP (1u << 18)

__device__ __forceinline__ unsigned xb_ld(unsigned* p)              { return __hip_atomic_load(p, __ATOMIC_RELAXED, __HIP_MEMORY_SCOPE_AGENT); }
__device__ __forceinline__ unsigned xb_add(unsigned* p, unsigned v) { return __hip_atomic_fetch_add(p, v, __ATOMIC_RELAXED, __HIP_MEMORY_SCOPE_AGENT); }
__device__ __forceinline__ unsigned xb_xcc_id() { return (unsigned)__builtin_amdgcn_s_getreg((3 << 11) | 20) & 0xFu; }
#define XB_SPIN(cond, bar) do { unsigned _sp = 0; while (cond) { __builtin_amdgcn_s_sleep(1); \
    if ((++_sp & 255u) == 0u) { if (xb_ld(&(bar)[XB_TMO])) break; if (_sp > XB_SPIN_CAP) { atomicAdd(&(bar)[XB_TMO], 1u); break; } } } } while (0)

struct XcdBarrier {
    unsigned* bar; unsigned x;
    volatile LAS unsigned* st;
};

__device__ __forceinline__ XcdBarrier xcd_barrier_post(unsigned* bar, volatile LAS unsigned* st) {
    XcdBarrier b; b.bar = bar; b.x = xb_xcc_id(); b.st = st;
    if (threadIdx.x == 0) (void)xb_add(&bar[XB_XCNT(b.x)], 1u);
    return b;
}
__device__ __forceinline__ void xcd_barrier_complete(unsigned* bar, unsigned x, unsigned& nloc, unsigned& nx) {
    const unsigned G = gridDim.x * gridDim.y * gridDim.z;
    unsigned sum, cnt, mine, sp = 0u;
    for (;;) {
        sum = 0u; cnt = 0u; mine = 0u;
#pragma unroll
        for (unsigned j = 0; j < 16; ++j) { const unsigned c = xb_ld(&bar[XB_XCNT(j)]); sum += c; cnt += (c > 0u) ? 1u : 0u; mine = (j == x) ? c : mine; }
        if (sum == G) break;
        __builtin_amdgcn_s_sleep(1);
        if ((++sp & 255u) == 0u) { if (xb_ld(&bar[XB_TMO])) break; if (sp > XB_SPIN_CAP) { atomicAdd(&bar[XB_TMO], 1u); break; } }
    }
    nloc = mine > 0u ? mine : 1u; nx = cnt > 0u ? cnt : 1u;
}

__device__ __forceinline__ void xcd_barrier(const XcdBarrier& b) {
    asm volatile("s_waitcnt vmcnt(0)" ::: "memory");
    __syncthreads();
    if (threadIdx.x == 0) {
        unsigned* bar = b.bar;
        __builtin_amdgcn_s_waitcnt(0);
        unsigned nloc = b.st[0], nx = b.st[1];
        if (nloc == 0u) { xcd_barrier_complete(bar, b.x, nloc, nx); b.st[0] = nloc; b.st[1] = nx; }
        const unsigned old = xb_add(&bar[XB_XSUB(b.x)], 1u);
        const unsigned gen = old / nloc;
        if (old + 1u == (gen + 1u) * nloc) {
            __builtin_amdgcn_fence(__ATOMIC_RELEASE, "agent");
            asm volatile("s_waitcnt vmcnt(0)" ::: "memory");
            const unsigned og = xb_add(&bar[XB_TOP], 1u);
            const unsigned tg = og / nx;
            if (og + 1u == (tg + 1u) * nx) xb_add(&bar[XB_TOPGEN], 1u);
            else XB_SPIN(xb_ld(&bar[XB_TOPGEN]) == tg, bar);
            __builtin_amdgcn_fence(__ATOMIC_ACQUIRE, "agent");
            xb_add(&bar[XB_XGEN(b.x)], 1u);
            asm volatile("s_waitcnt vmcnt(0)" ::: "memory");
        } else {
            XB_SPIN(xb_ld(&bar[XB_XGEN(b.x)]) == gen, bar);
            __builtin_amdgcn_fence(__ATOMIC_ACQUIRE, "agent");
            asm volatile("s_waitcnt vmcnt(0)" ::: "memory");
        }
    }
    __syncthreads();
}

namespace pg8 {
template <class Fn> struct EpiFn {
    static constexpr bool PERM = true, AFTER_DRAIN = false;
    Fn f;
    __device__ __forceinline__ void operator()(const f32x4 (&acc)[2][2][4][2], const Unit& u, int wr, int wc, int fr, int fq) const {
        const int row0 = u.pm * BM + wr * 64 + fr, col0 = u.pn * BM + wc * 32 + 8 * fq;
#pragma unroll
        for (int ai = 0; ai < 2; ++ai)
#pragma unroll
            for (int m = 0; m < 4; ++m)
#pragma unroll
                for (int bj = 0; bj < 2; ++bj) f.e8(row0 + ai * HALF + m * 16, col0 + bj * HALF, acc[ai][bj][m][0], acc[ai][bj][m][1]);
    }
};
}

struct FnBf16 {
    bf16* O; int ld;
    __device__ __forceinline__ void e8(int row, int col, f32x4 a, f32x4 b) const {
        v4u w; w.x = pk2(a.x, a.y); w.y = pk2(a.z, a.w); w.z = pk2(b.x, b.y); w.w = pk2(b.z, b.w);
        *(v4u*)(O + (size_t)row * ld + col) = w;
    }
    __device__ __forceinline__ void e4(int row, int col, f32x4 a) const {
        v2u w; w.x = pk2(a.x, a.y); w.y = pk2(a.z, a.w);
        *(v2u*)(O + (size_t)row * ld + col) = w;
    }
};
struct FnResid {
    float* XS; const float* baseP; const float* baseS;
    __device__ __forceinline__ const float* brow(int row) const { return row < MP ? baseP + (size_t)row * DM : baseS + (size_t)(row - MP) * DM; }
    __device__ __forceinline__ void e8(int row, int col, f32x4 a, f32x4 b) const {
        const float* br = brow(row) + col; float* o = XS + (size_t)row * DM + col;
        const f32x4 x0 = *(const f32x4*)br, x1 = *(const f32x4*)(br + 4);
        *(f32x4*)o = x0 + a; *(f32x4*)(o + 4) = x1 + b;
    }
    __device__ __forceinline__ void e4(int row, int col, f32x4 a) const {
        const float* br = brow(row) + col; float* o = XS + (size_t)row * DM + col;
        *(f32x4*)o = *(const f32x4*)br + a;
    }
};
struct FnF32 {
    float* O; int ld;
    __device__ __forceinline__ void e8(int row, int col, f32x4 a, f32x4 b) const { float* o = O + (size_t)row * ld + col; *(f32x4*)o = a; *(f32x4*)(o + 4) = b; }
    __device__ __forceinline__ void e4(int row, int col, f32x4 a) const { *(f32x4*)(O + (size_t)row * ld + col) = a; }
};
struct FnKvq {
    float* O;
    __device__ __forceinline__ void e8(int row, int col, f32x4 a, f32x4 b) const {
        if (col < NKVQ_REAL) { float* o = O + (size_t)row * NKVQ + col; *(f32x4*)o = a; *(f32x4*)(o + 4) = b; }
    }
    __device__ __forceinline__ void e4(int row, int col, f32x4 a) const {
        if (col < NKVQ_REAL) *(f32x4*)(O + (size_t)row * NKVQ + col) = a;
    }
};

template <class Fn>
__device__ __forceinline__ void skinny_gemm(Frame& F, const bf16* A, const bf16* Bt, int N, int row_base, const Fn& fn) {
    const int fr = F.lane & 15, fq = F.lane >> 4;
    const int nun = N / 16;
    for (int u = F.bid; u < nun; u += F.G) {
        const bf16* ap = Bt + (size_t)(u * 16 + fr) * DM + fq * 8;
        const bf16* bp = A + (size_t)(F.wave * 16 + fr) * DM + fq * 8;
        f32x4 acc = {0.f, 0.f, 0.f, 0.f};
#pragma unroll 8
        for (int ks = 0; ks < 32; ++ks) acc = MFMA16(ld8(ap + ks * 32), ld8(bp + ks * 32), acc);
        fn.e4(row_base + F.wave * 16 + fr, u * 16 + 4 * fq, acc);
    }
}

template <class Fn>
__device__ __forceinline__ void gemm_all(Frame& F, const bf16* A, const bf16* Bt, int N, const Fn& fn) {
    pg8::Gemm g{A, Bt, MP, N, DM}; pg8::StaticOrder S; S.init(MP, N, F.G, F.bid);
    pg8::EpiFn<Fn> E{fn};
    pg8::gemm_phase<pg8::EpiFn<Fn>, pg8::StaticOrder, true, true>(F.lds, g, S, E);
    skinny_gemm(F, A + (size_t)MP * DM, Bt, N, MP, fn);
}

__device__ __forceinline__ void p0_transpose_item(const float* W, int N, bf16* WT, int row_off, const float* gain, LAS float* scr, int item, int lane) {
    const int nblk = (N + 31) / 32, kb = item / nblk, nb = item % nblk, k0 = 64 * kb, n0 = 32 * nb;
#pragma unroll 8
    for (int i = 0; i < 32; ++i) { const int kk = 2 * i + (lane >> 5); const int n = n0 + (lane & 31);
        float v = 0.f; if (n < N) { v = W[(size_t)(k0 + kk) * N + n]; if (gain) v *= gain[k0 + kk]; }
        scr[kk * 33 + (lane & 31)] = v; }
    LDS_WAIT(); asm volatile("" ::: "memory");
    const int c = lane & 7;
#pragma unroll
    for (int j = 0; j < 4; ++j) { const int n = (lane >> 3) + 8 * j; const LAS float* s = scr + (8 * c) * 33 + n;
        v4u o; o.x = pk2(s[0 * 33], s[1 * 33]); o.y = pk2(s[2 * 33], s[3 * 33]); o.z = pk2(s[4 * 33], s[5 * 33]); o.w = pk2(s[6 * 33], s[7 * 33]);
        if (n0 + n < N) *(v4u*)(WT + (size_t)(row_off + n0 + n) * DM + k0 + 8 * c) = o; }
    LDS_WAIT(); asm volatile("" ::: "memory");
}
__device__ __forceinline__ void rms_row_to_bf16(const float* xrow, bf16* orow, int lane) {
    const f32x4* xr = (const f32x4*)xrow + lane;
    f32x4 v[4]; float s = 0.f;
#pragma unroll
    for (int j = 0; j < 4; ++j) { v[j] = xr[64 * j]; s += (v[j].x * v[j].x + v[j].y * v[j].y) + (v[j].z * v[j].z + v[j].w * v[j].w); }
    const float rstd = 1.f / sqrtf(wave_sum(s) * (1.f / DM) + EPS);
    v2u* o8 = (v2u*)orow + lane;
#pragma unroll
    for (int j = 0; j < 4; ++j) { v2u w; w.x = pk2(v[j].x * rstd, v[j].y * rstd); w.y = pk2(v[j].z * rstd, v[j].w * rstd); o8[64 * j] = w; }
}
__device__ __forceinline__ const float* xin_row(Frame& F, int row) { return row < MP ? FIN(0) + (size_t)row * DM : FIN(1) + (size_t)(row - MP) * DM; }

__device__ __forceinline__ void peer_tables_to_fp8(Frame& F, size_t thr, size_t nthr) {
    const size_t gt = thr, NGT = nthr;
        const size_t n8 = (size_t)2 * NEXP * DM / 8;
        for (int t = 0; t < 2; ++t) { const f32x4* src = (const f32x4*)FIN(27 + t); v2u* dst = (v2u*)WSP(unsigned char, t == 0 ? WS_PU : WS_PV); const float* pln = FIN(24);
            for (size_t i0 = gt; i0 < n8; i0 += (size_t)4 * NGT) {
                f32x4 a[4], b[4];
#pragma unroll
                for (int u = 0; u < 4; ++u) { const size_t i = i0 + (size_t)u * NGT; if (i < n8) { a[u] = src[2 * i]; b[u] = src[2 * i + 1]; } }
#pragma unroll
                for (int u = 0; u < 4; ++u) { const size_t i = i0 + (size_t)u * NGT; if (i < n8) {
                    if (t == 0) { const float* gp = pln + ((i >> 21) << 10) + ((i & 127) << 3); a[u] = a[u] * *(const f32x4*)gp * 32.f; b[u] = b[u] * *(const f32x4*)(gp + 4) * 32.f; }
                    else { a[u] = a[u] * 16.f; b[u] = b[u] * 16.f; }
                    int w0 = __builtin_amdgcn_cvt_pk_fp8_f32(a[u].x, a[u].y, 0, false); w0 = __builtin_amdgcn_cvt_pk_fp8_f32(a[u].z, a[u].w, w0, true);
                    int w1 = __builtin_amdgcn_cvt_pk_fp8_f32(b[u].x, b[u].y, 0, false); w1 = __builtin_amdgcn_cvt_pk_fp8_f32(b[u].z, b[u].w, w1, true);
                    dst[i] = (v2u){(unsigned)w0, (unsigned)w1}; } } } }
}

__device__ __forceinline__ void p0_prologue(Frame& F) {
    LAS float* scr = (LAS float*)(F.lds + F.wave * 16384);
    const int gw = F.bid * 8 + F.wave, NGW = F.G * 8;
    const int gt = F.bid * 512 + F.tid, NGT = F.G * 512;
    {
        constexpr int I_IN = 128 * 16, I_OA = 32 * 16, I_KV = 48 * 16, I_QG = 34 * 16, I_OB = 32 * 16, I_PQ = 64 * 16;
        constexpr int NITEMS = I_IN + I_OA + I_KV + I_QG + I_OB + 2 * I_PQ;
        for (int it = gw; it < NITEMS; it += NGW) {
            int r = it;
            if (r < I_IN) {
                const int kb = r / 128, nb = r % 128, k0 = 64 * kb, n0 = 32 * nb; const float* W = FIN(8); const float* gain = FIN(7);
#pragma unroll 8
                for (int i = 0; i < 32; ++i) { const int kk = 2 * i + (F.lane >> 5); scr[kk * 33 + (F.lane & 31)] = W[(size_t)(k0 + kk) * GPROJ + n0 + (F.lane & 31)] * gain[k0 + kk]; }
                LDS_WAIT(); asm volatile("" ::: "memory");
                const int c = F.lane & 7;
#pragma unroll
                for (int j = 0; j < 4; ++j) { const int n = (F.lane >> 3) + 8 * j; const LAS float* s = scr + (8 * c) * 33 + n;
                    v4u o; o.x = pk2(s[0 * 33], s[1 * 33]); o.y = pk2(s[2 * 33], s[3 * 33]); o.z = pk2(s[4 * 33], s[5 * 33]); o.w = pk2(s[6 * 33], s[7 * 33]);
                    *(v4u*)(WSP(bf16, WS_WIN_T) + (size_t)(n0 + n) * DM + k0 + 8 * c) = o; }
                LDS_WAIT(); asm volatile("" ::: "memory");
                continue; }
            r -= I_IN;
            if (r < I_OA) { p0_transpose_item(FIN(13), 1024, WSP(bf16, WS_WOA_T), 0, nullptr, scr, r, F.lane); continue; } r -= I_OA;
            if (r < I_KV) { p0_transpose_item(FIN(15), NKV, WSP(bf16, WS_WKVQ_T), 0, FIN(14), scr, r, F.lane); continue; } r -= I_KV;
            if (r < I_QG) { p0_transpose_item(FIN(21), NQG, WSP(bf16, WS_WKVQ_T), NKV, FIN(20), scr, r, F.lane); continue; } r -= I_QG;
            if (r < I_OB) { p0_transpose_item(FIN(23), 1024, WSP(bf16, WS_WOB_T), 0, nullptr, scr, r, F.lane); continue; } r -= I_OB;
            if (r < I_PQ) { p0_transpose_item(FIN(25), 2048, WSP(bf16, WS_WPQ_T), 0, FIN(24), scr, r, F.lane); continue; } r -= I_PQ;
            p0_transpose_item(FIN(25) + (size_t)1024 * 2048, 2048, WSP(bf16, WS_WPQ_T) + (size_t)2048 * 1024, 0, FIN(24) + 1024, scr, r, F.lane);
        }
        for (int i = gt; i < (NKVQ - NKVQ_REAL) * DM / 8; i += NGT) ((v4u*)(WSP(bf16, WS_WKVQ_T) + (size_t)NKVQ_REAL * DM))[i] = (v4u){0u, 0u, 0u, 0u};
        for (int i = gt; i < 16 * 1024; i += NGT) { const int j = i >> 10, k = i & 1023; WSP(float, WS_WAB)[i] = FIN(7)[k] * FIN(8)[(size_t)k * GPROJ + 4096 + j]; }
    }
    for (int m = gw; m < MTOK; m += NGW) rms_row_to_bf16(xin_row(F, m), WSP(bf16, WS_XNA) + (size_t)m * DM, F.lane);
    {
        if (F.G != 256) peer_tables_to_fp8(F, (size_t)gt, (size_t)NGT);
        const f32x4* sk = (const f32x4*)FIN(26); v4u* dk = (v4u*)WSP(bf16, WS_SUBK);
        for (int i = gt; i < 2 * 8 * 2 * 128 * 128 / 8; i += NGT) { const f32x4 a = sk[2 * i], b = sk[2 * i + 1]; v4u w; w.x = pk2(a.x, a.y); w.y = pk2(a.z, a.w); w.z = pk2(b.x, b.y); w.w = pk2(b.z, b.w); dk[i] = w; }
    }
    for (int i = gt; i < 2 * 64 * 2048; i += NGT) { const int kv = i >> 17, hh = (i >> 11) & 63, k = i & 2047;
        WSP(bf16, WS_W1T)[i] = (bf16)f2bf(FIN(17)[((size_t)kv * 2048 + k) * 64 + hh]); }
    for (int it = gw; it < 128; it += NGW) { const int kv = it >> 6, h = it & 63; float s = 0.f;
        for (int k = F.lane; k < 2048; k += 64) s += FIN(18)[(size_t)kv * 2048 + k] * FIN(17)[((size_t)kv * 2048 + k) * 64 + h];
        s = wave_sum(s); if (F.lane == 0) WSP(float, WS_PETERM)[it] = s; }
    {
        const float* cache = FIN(2); const int* pt = (const int*)FIN(6); bf16* cka = WSP(bf16, WS_CKA);
        const int nitem = SB * PAST * 2 * 4 * 8;
        for (int i0 = gt; i0 < nitem; i0 += 4 * NGT) {
            f32x4 a[4], b[4];
#pragma unroll
            for (int u = 0; u < 4; ++u) { const int i = i0 + u * NGT; if (i < nitem) {
                const int d8 = i & 7, g = (i >> 3) & 3, kv = (i >> 5) & 1, t = (i >> 6) & 8191, bs = i >> 19;
                const float* src = cache + ((size_t)pt[bs * NPAGES + (t >> 7)] * PAGE + (t & 127)) * 1024 + kv * 256 + g * 64 + d8 * 8;
                a[u] = *(const f32x4*)src; b[u] = *(const f32x4*)(src + 4); } }
#pragma unroll
            for (int u = 0; u < 4; ++u) { const int i = i0 + u * NGT; if (i < nitem) {
                const int d8 = i & 7, g = (i >> 3) & 3, kv = (i >> 5) & 1, t = (i >> 6) & 8191, bs = i >> 19;
                v4u w; w.x = pk2(a[u].x, a[u].y); w.y = pk2(a[u].z, a[u].w); w.z = pk2(b[u].x, b[u].y); w.w = pk2(b[u].z, b[u].w);
                *(v4u*)(cka + ((size_t)((bs * 4 + g) * 512 + (t >> 4))) * 2048 + kv * 1024 + (t & 15) * 64 + d8 * 8) = w; } }
        }
        bf16* wbd = WSP(bf16, WS_W1BD);
        for (int i = gt; i < 256 * 2048; i += NGT) { const int n = i >> 11, col = i & 2047, kv = n >> 7, sec = (n >> 6) & 1, hh = n & 63;
            float v = 0.f; if ((col >> 10) == kv) { const int k = col & 1023, r = (k >> 6) + 16 * sec, d = k & 63; v = FIN(17)[(((size_t)kv * 32 + r) * 64 + d) * 64 + hh]; }
            wbd[i] = (bf16)f2bf(v); }
    }
    {
        const f32x4* src = (const f32x4*)FIN(3); f32x4* dst = (f32x4*)(F.out + O_WINS);
        const int per_b = 508 * 512 / 4;
        for (int i = gt; i < SB * per_b; i += NGT) { const int b = i / per_b, r = i % per_b; dst[(size_t)b * (512 * 512 / 4) + r] = src[(size_t)b * (512 * 512 / 4) + 4 * 512 / 4 + r]; }
    }
    for (int i = gt; i < SB * NG * 544 * 64; i += NGT) {
        const int d = i & 63, r = (i >> 6) % 544, bg = (i >> 6) / 544, g = bg & 3, b = bg >> 2;
        if (r < 512) { const float* cw = FIN(3) + (((size_t)b * 512 + r) * 2) * 256 + g * 64 + d;
            WSP(bf16, WS_SKWIN)[i] = (bf16)f2bf(cw[0]);
            WSP(bf16, WS_SVWINT)[((size_t)bg * 64 + d) * 544 + r] = (bf16)f2bf(cw[256]); }
        else if (r >= 516) { WSP(bf16, WS_SKWIN)[i] = 0; WSP(bf16, WS_SVWINT)[((size_t)bg * 64 + d) * 544 + r] = 0; }
    }
}

constexpr int P2_QS = 0, P2_KS = 17408, P2_KBGT = 34816, P2_VBT = 53248, P2_AM = 71680, P2_TB = 89088, P2_G = 98304, P2_TF = 99328, P2_XF = 116736;
constexpr int QS_LD = 136, KT_LD = 72, AM_LD = 68, TB_LD = 72;

__device__ __forceinline__ float softplus_f(float x) { return fmaxf(x, 0.f) + log1pf(expf(-fabsf(x))); }

__device__ __forceinline__ void p2_chunk(Frame& F, int unit) {
    const int c = unit & 127, h = (unit >> 7) & 7, b = unit >> 10;
    const int t0 = c * CHUNK, lane = F.lane, w = F.wave, fr = lane & 15, fq = lane >> 4;
    LAS unsigned char* L = F.lds; asm volatile("" : "+v"(L));
    LAS bf16* qs = (LAS bf16*)(L + P2_QS); LAS bf16* ks = (LAS bf16*)(L + P2_KS);
    LAS bf16* kbgT = (LAS bf16*)(L + P2_KBGT); LAS bf16* vbT = (LAS bf16*)(L + P2_VBT);
    LAS float* Am = (LAS float*)(L + P2_AM); LAS bf16* Tb = (LAS bf16*)(L + P2_TB);
    LAS float* Gs = (LAS float*)(L + P2_G);
    const bf16* PROJ = WSP(bf16, WS_PROJ); const bf16* XNA = WSP(bf16, WS_XNA); const float* WAB = WSP(float, WS_WAB);
    const size_t rowb = (size_t)b * PT;
    float beta_r[8];
    {
        f32x4 wa[4], wb[4];
        const float* pa = WAB + (size_t)h * DM + 8 * lane; const float* pb = WAB + (size_t)(8 + h) * DM + 8 * lane;
        wa[0] = *(const f32x4*)pa; wa[1] = *(const f32x4*)(pa + 4); wa[2] = *(const f32x4*)(pa + 512); wa[3] = *(const f32x4*)(pa + 516);
        wb[0] = *(const f32x4*)pb; wb[1] = *(const f32x4*)(pb + 4); wb[2] = *(const f32x4*)(pb + 512); wb[3] = *(const f32x4*)(pb + 516);
        const float Aneg = -expf(FIN(10)[h]), dtb = FIN(11)[h];
#pragma unroll
        for (int tk = 0; tk < 8; ++tk) {
            const int tok = 8 * w + tk; const bf16* xr = XNA + (rowb + t0 + tok) * DM + 8 * lane;
            const v4u x0 = *(const v4u*)xr, x1 = *(const v4u*)(xr + 512);
            float sa = 0.f, sb = 0.f;
#define ACC2(xw, wv0, wv1, i0) { const float lo = bflo(xw), hi = bfhi(xw); sa += lo * wv0[i0] + hi * wv0[i0 + 1]; sb += lo * wv1[i0] + hi * wv1[i0 + 1]; }
            ACC2(x0.x, wa[0], wb[0], 0) ACC2(x0.y, wa[0], wb[0], 2) ACC2(x0.z, wa[1], wb[1], 0) ACC2(x0.w, wa[1], wb[1], 2)
            ACC2(x1.x, wa[2], wb[2], 0) ACC2(x1.y, wa[2], wb[2], 2) ACC2(x1.z, wa[3], wb[3], 0) ACC2(x1.w, wa[3], wb[3], 2)
#undef ACC2
            sa = wave_sum(sa); sb = wave_sum(sb);
            const float g = Aneg * softplus_f(sa + dtb), be = 1.f / (1.f + expf(-sb));
            beta_r[tk] = be;
            if (lane == 0) { Gs[tok] = g; Gs[64 + tok] = be; }
        }
    }
#pragma unroll
    for (int p = 0; p < 3; ++p) {
        const int col0 = p * 1024 + h * 128 + 2 * lane;
        float cw0[4], cw1[4];
#pragma unroll
        for (int i = 0; i < 4; ++i) { const f32x2 cv = *(const f32x2*)(FIN(9) + (size_t)i * GCONV + col0); cw0[i] = cv.x; cw1[i] = cv.y; }
        unsigned xw[11];
#pragma unroll
        for (int rr = 0; rr < 11; ++rr) { const int t = t0 + 8 * w - 3 + rr; xw[rr] = (t >= 0) ? *(const unsigned*)(PROJ + (rowb + t) * 4096 + col0) : 0u; }
        if (c == 127 && w == 7) {
#pragma unroll
            for (int r = 0; r < 3; ++r) { float* o = F.out + O_CONVP + ((size_t)b * 3 + r) * GCONV + col0; o[0] = bflo(xw[8 + r]); o[1] = bfhi(xw[8 + r]); }
        }
#pragma unroll
        for (int tk = 0; tk < 8; ++tk) {
            const int tok = 8 * w + tk;
            float y0 = 0.f, y1 = 0.f;
#pragma unroll
            for (int i = 0; i < 4; ++i) { y0 += cw0[i] * bflo(xw[tk + i]); y1 += cw1[i] * bfhi(xw[tk + i]); }
            y0 = silu_f(y0); y1 = silu_f(y1);
            if (p < 2) {
                const float ss = wave_sum(y0 * y0 + y1 * y1);
                const float rs = (1.f / sqrtf(ss + EPS)) * (p == 0 ? 0.08838834764831845f : 1.f);
                *(LAS unsigned*)((p == 0 ? qs : ks) + tok * QS_LD + 2 * lane) = pk2(y0 * rs, y1 * rs);
            } else {
                vbT[(2 * lane) * KT_LD + tok] = (bf16)f2bf(y0 * beta_r[tk]); vbT[(2 * lane + 1) * KT_LD + tok] = (bf16)f2bf(y1 * beta_r[tk]);
            }
        }
    }
    __syncthreads();
    if (w == 0) { float g = Gs[lane];
#pragma unroll
        for (int o = 1; o < 64; o <<= 1) { const float up = __shfl_up(g, o); if (lane >= o) g += up; }
        Gs[128 + lane] = g; }
    __syncthreads();
    const float glast = Gs[128 + 63];
    const size_t chunk = (size_t)unit;
    if (w < 4) {
        const int mt = w;
        bf16x8 a[4];
#pragma unroll
        for (int kk = 0; kk < 4; ++kk) a[kk] = ld8l(ks + (16 * mt + fr) * QS_LD + 32 * kk + 8 * fq);
#pragma unroll
        for (int nt = 0; nt < 4; ++nt) {
            f32x4 acc = {0.f, 0.f, 0.f, 0.f};
            if (nt <= mt) {
#pragma unroll
                for (int kk = 0; kk < 4; ++kk) acc = MFMA16(a[kk], ld8l(ks + (16 * nt + fr) * QS_LD + 32 * kk + 8 * fq), acc);
            }
            const int j = 16 * nt + fr; const float gj = Gs[128 + j];
#pragma unroll
            for (int r = 0; r < 4; ++r) { const int i = 16 * mt + 4 * fq + r;
                Am[i * AM_LD + j] = (i > j) ? Gs[64 + i] * acc[r] * __expf(Gs[128 + i] - gj) : 0.f; }
        }
    } else {
        const int nt = w - 4;
        bf16x8 bq[4];
#pragma unroll
        for (int kk = 0; kk < 4; ++kk) bq[kk] = ld8l(qs + (16 * nt + fr) * QS_LD + 32 * kk + 8 * fq);
        const int i = 16 * nt + fr; const float gi = Gs[128 + i];
        bf16* gqk = WSP(bf16, WS_GQK) + chunk * 4096 + (size_t)i * 64;
#pragma unroll
        for (int mt = 0; mt < 4; ++mt) {
            f32x4 acc = {0.f, 0.f, 0.f, 0.f};
            if (mt <= nt) {
#pragma unroll
                for (int kk = 0; kk < 4; ++kk) acc = MFMA16(ld8l(ks + (16 * mt + fr) * QS_LD + 32 * kk + 8 * fq), bq[kk], acc);
            }
            float v[4];
#pragma unroll
            for (int r = 0; r < 4; ++r) { const int j = 16 * mt + 4 * fq + r; v[r] = (i >= j) ? acc[r] * __expf(gi - Gs[128 + j]) : 0.f; }
            v2u o; o.x = pk2(v[0], v[1]); o.y = pk2(v[2], v[3]);
            *(v2u*)(gqk + 16 * mt + 4 * fq) = o;
        }
    }
    {
        const int tok = F.tid >> 3, d0 = (F.tid & 7) * 16; const float e = __expf(Gs[128 + tok]);
        bf16* gq = WSP(bf16, WS_GQ) + chunk * 8192 + (size_t)tok * 128 + d0;
#pragma unroll
        for (int hh = 0; hh < 2; ++hh) { const v4u q = *(const LAS v4u*)(qs + tok * QS_LD + d0 + 8 * hh); v4u o;
            o.x = pk2(bflo(q.x) * e, bfhi(q.x) * e); o.y = pk2(bflo(q.y) * e, bfhi(q.y) * e); o.z = pk2(bflo(q.z) * e, bfhi(q.z) * e); o.w = pk2(bflo(q.w) * e, bfhi(q.w) * e);
            *(v4u*)(gq + 8 * hh) = o; }
    }
    {
        const int dk = F.tid & 127, tg = F.tid >> 7;
        unsigned o1[8], o2[8];
#pragma unroll
        for (int i = 0; i < 8; ++i) {
            const int ta = 16 * tg + 2 * i, tb2 = ta + 1;
            const float ka = bf2f(ks[ta * QS_LD + dk]), kb = bf2f(ks[tb2 * QS_LD + dk]);
            const float ga = Gs[128 + ta], gb = Gs[128 + tb2];
            o1[i] = pk2(ka * Gs[64 + ta] * __expf(ga), kb * Gs[64 + tb2] * __expf(gb));
            o2[i] = pk2(ka * __expf(glast - ga), kb * __expf(glast - gb));
        }
        LAS v4u* d1 = (LAS v4u*)(kbgT + dk * KT_LD + 16 * tg); d1[0] = (v4u){o1[0], o1[1], o1[2], o1[3]}; d1[1] = (v4u){o1[4], o1[5], o1[6], o1[7]};
        v4u* d2 = (v4u*)(WSP(bf16, WS_GKT) + chunk * 8192 + (size_t)dk * 64 + 16 * tg); d2[0] = (v4u){o2[0], o2[1], o2[2], o2[3]}; d2[1] = (v4u){o2[4], o2[5], o2[6], o2[7]};
    }
    if (F.tid == 0) WSP(float, WS_GDEC)[chunk] = __expf(glast);
    __syncthreads();
    LAS float* Tf = (LAS float*)(L + P2_TF); LAS float* Xf = (LAS float*)(L + P2_XF);
    if (w == 0) {
        const int blk = lane >> 5, cc = lane & 31; const LAS float* Ab = Am + (32 * blk) * AM_LD + 32 * blk;
        float t[32];
#pragma unroll
        for (int i = 0; i < 32; ++i) {
            float acc0 = (i == cc) ? 1.f : 0.f, acc1 = 0.f;
#pragma unroll
            for (int j4 = 0; j4 < (i + 3) / 4; ++j4) {
                const f32x4 a = *(const LAS f32x4*)(Ab + i * AM_LD + 4 * j4);
                if (4 * j4 + 0 < i) acc0 = __builtin_fmaf(-a.x, t[4 * j4 + 0], acc0);
                if (4 * j4 + 1 < i) acc1 = __builtin_fmaf(-a.y, t[4 * j4 + 1], acc1);
                if (4 * j4 + 2 < i) acc0 = __builtin_fmaf(-a.z, t[4 * j4 + 2], acc0);
                if (4 * j4 + 3 < i) acc1 = __builtin_fmaf(-a.w, t[4 * j4 + 3], acc1);
            }
            t[i] = acc0 + acc1;
            asm volatile("" : "+v"(t[i]));
            __builtin_amdgcn_sched_barrier(0);
        }
#pragma unroll
        for (int i = 0; i < 32; ++i) { Tf[(32 * blk + i) * AM_LD + 32 * blk + cc] = t[i]; if (blk == 0) Tf[i * AM_LD + 32 + cc] = 0.f; }
    }
    __syncthreads();
    {
        const int i = F.tid >> 4, c0 = (F.tid & 15) * 2; float x0 = 0.f, x1 = 0.f;
#pragma unroll 8
        for (int k = 0; k < 32; ++k) { const float a = Am[(32 + i) * AM_LD + k]; x0 = __builtin_fmaf(a, Tf[k * AM_LD + c0], x0); x1 = __builtin_fmaf(a, Tf[k * AM_LD + c0 + 1], x1); }
        Xf[i * 34 + c0] = x0; Xf[i * 34 + c0 + 1] = x1;
    }
    __syncthreads();
    {
        const int i = F.tid >> 4, c0 = (F.tid & 15) * 2; float x0 = 0.f, x1 = 0.f;
#pragma unroll 8
        for (int k = 0; k < 32; ++k) { const float a = Tf[(32 + i) * AM_LD + 32 + k]; x0 = __builtin_fmaf(a, Xf[k * 34 + c0], x0); x1 = __builtin_fmaf(a, Xf[k * 34 + c0 + 1], x1); }
        Tf[(32 + i) * AM_LD + c0] = -x0; Tf[(32 + i) * AM_LD + c0 + 1] = -x1;
    }
    __syncthreads();
    {
        const int i = F.tid >> 3, c0 = (F.tid & 7) * 8; const f32x4 a = *(const LAS f32x4*)(Tf + i * AM_LD + c0), b2 = *(const LAS f32x4*)(Tf + i * AM_LD + c0 + 4);
        *(LAS v4u*)(Tb + i * TB_LD + c0) = (v4u){pk2(a.x, a.y), pk2(a.z, a.w), pk2(b2.x, b2.y), pk2(b2.z, b2.w)};
    }
    __syncthreads();
    {
        bf16x8 tb[4][2];
#pragma unroll
        for (int x = 0; x < 4; ++x)
#pragma unroll
            for (int s = 0; s < 2; ++s) tb[x][s] = ld8l(Tb + (16 * x + fr) * TB_LD + 32 * s + 8 * fq);
        const bf16x8 bv0 = ld8l(vbT + (16 * w + fr) * KT_LD + 8 * fq), bv1 = ld8l(vbT + (16 * w + fr) * KT_LD + 32 + 8 * fq);
        f32x4* gu = (f32x4*)(WSP(float, WS_GU) + chunk * 8192) + (size_t)w * 256 + lane;
#pragma unroll
        for (int mt = 0; mt < 4; ++mt) { f32x4 acc = {0.f, 0.f, 0.f, 0.f}; acc = MFMA16(tb[mt][0], bv0, acc); acc = MFMA16(tb[mt][1], bv1, acc); gu[mt * 64] = acc; }
        const bf16x8 ak0 = ld8l(kbgT + (16 * w + fr) * KT_LD + 8 * fq), ak1 = ld8l(kbgT + (16 * w + fr) * KT_LD + 32 + 8 * fq);
        bf16* gw = WSP(bf16, WS_GW) + chunk * 8192;
#pragma unroll
        for (int nt = 0; nt < 4; ++nt) { f32x4 acc = {0.f, 0.f, 0.f, 0.f}; acc = MFMA16(ak0, tb[nt][0], acc); acc = MFMA16(ak1, tb[nt][1], acc);
            v2u o; o.x = pk2(acc[0], acc[1]); o.y = pk2(acc[2], acc[3]);
            *(v2u*)(gw + (size_t)(16 * nt + fr) * 128 + 16 * w + 4 * fq) = o; }
    }
    __syncthreads();
}

constexpr int S2_Y = 0;
constexpr int S2_AB = 6144;
constexpr int S2_DOT = 6400;
constexpr int S2_U = 6656;
constexpr int S2_W = 8704;
constexpr int S2_VN = 10752;
__device__ __forceinline__ void p2_sample(Frame& F, int unit) {
    const int h = unit & 7, bs = unit >> 3, tid = F.tid, lane = F.lane, w = F.wave;
    LAS unsigned char* L = F.lds; asm volatile("" : "+v"(L));
    LAS float* Y = (LAS float*)(L + S2_Y); LAS float* AB = (LAS float*)(L + S2_AB); LAS float* DOT = (LAS float*)(L + S2_DOT);
    LAS float* U = (LAS float*)(L + S2_U); LAS float* W = (LAS float*)(L + S2_W); LAS float* VN = (LAS float*)(L + S2_VN);
    const bf16* PROJ = WSP(bf16, WS_PROJ); const bf16* XNA = WSP(bf16, WS_XNA); const float* WAB = WSP(float, WS_WAB);
    const size_t row0 = (size_t)MP + bs * 4;
    if (tid < 384) {
        const int part = tid >> 7, cc = tid & 127, col = part * 1024 + h * 128 + cc;
        float buf[7];
#pragma unroll
        for (int r = 0; r < 3; ++r) buf[r] = FIN(5)[((size_t)bs * 3 + r) * GCONV + col];
#pragma unroll
        for (int i = 0; i < 4; ++i) buf[3 + i] = bf2f(PROJ[(row0 + i) * 4096 + col]);
#pragma unroll
        for (int r = 0; r < 3; ++r) F.out[O_CONVS + ((size_t)bs * 3 + r) * GCONV + col] = buf[4 + r];
        float cw[4];
#pragma unroll
        for (int i = 0; i < 4; ++i) cw[i] = FIN(9)[(size_t)i * GCONV + col];
#pragma unroll
        for (int i = 0; i < 4; ++i) { float y = 0.f;
#pragma unroll
            for (int k = 0; k < 4; ++k) y += cw[k] * buf[i + k];
            Y[(part * 4 + i) * 128 + cc] = silu_f(y); }
    }
    {
        const int i = w >> 1, which = w & 1; const bf16* xr = XNA + (row0 + i) * DM; const float* wr = WAB + (size_t)(which * 8 + h) * DM; float s = 0.f;
        for (int k = lane; k < DM; k += 64) s += bf2f(xr[k]) * wr[k];
        s = wave_sum(s); if (lane == 0) AB[which * 4 + i] = s;
    }
    __syncthreads();
    {
        const int part = w >> 2, i = w & 3; LAS float* y = Y + (part * 4 + i) * 128; const float a = y[lane], bq = y[64 + lane];
        const float ss = wave_sum(a * a + bq * bq); const float rs = (1.f / sqrtf(ss + EPS)) * (part == 0 ? 0.08838834764831845f : 1.f);
        y[lane] = a * rs; y[64 + lane] = bq * rs;
    }
    if (tid == 0) { const float Aneg = -expf(FIN(10)[h]), dtb = FIN(11)[h]; float gc = 0.f;
        for (int i = 0; i < 4; ++i) { const float g = Aneg * softplus_f(AB[i] + dtb); gc += g; AB[8 + i] = g; AB[12 + i] = 1.f / (1.f + expf(-AB[4 + i])); AB[16 + i] = gc; } }
    __syncthreads();
    {
#pragma unroll
        for (int pp = 0; pp < 4; ++pp) { const int pr = 4 * w + pp, which = pr >> 4, i = (pr >> 2) & 3, j = pr & 3;
            const LAS float* x = Y + ((which == 0 ? 1 : 0) * 4 + i) * 128; const LAS float* y = Y + (1 * 4 + j) * 128;
            float s = x[lane] * y[lane] + x[64 + lane] * y[64 + lane]; s = wave_sum(s); if (lane == 0) DOT[pr] = s; }
    }
    __syncthreads();
    float g_[4], be[4], gc[4];
#pragma unroll
    for (int i = 0; i < 4; ++i) { g_[i] = AB[8 + i]; be[i] = AB[12 + i]; gc[i] = AB[16 + i]; }
    float Tm[4][4];
    {
        float A[4][4];
#pragma unroll
        for (int i = 0; i < 4; ++i)
#pragma unroll
            for (int j = 0; j < 4; ++j) A[i][j] = (i > j) ? be[i] * DOT[i * 4 + j] * expf(gc[i] - gc[j]) : 0.f;
#pragma unroll
        for (int cc = 0; cc < 4; ++cc)
#pragma unroll
            for (int i = 0; i < 4; ++i) { float acc = (i == cc) ? 1.f : 0.f;
#pragma unroll
                for (int j = 0; j < 4; ++j) if (j < i) acc -= A[i][j] * Tm[j][cc];
                Tm[i][cc] = acc; }
    }
    {
        const int i = tid >> 7, x = tid & 127; float su = 0.f, sw = 0.f;
#pragma unroll
        for (int j = 0; j < 4; ++j) { su += Tm[i][j] * Y[(2 * 4 + j) * 128 + x] * be[j]; sw += Tm[i][j] * Y[(1 * 4 + j) * 128 + x] * be[j] * expf(gc[j]); }
        U[i * 128 + x] = su; W[i * 128 + x] = sw;
    }
    __syncthreads();
    const float* S0 = FIN(4) + ((size_t)bs * GH + h) * 128 * 128;
    float qs_acc;
    {
        const int i = tid >> 7, dv = tid & 127; float p = 0.f, qq = 0.f;
        const LAS float* wr = W + i * 128; const LAS float* qr = Y + (0 * 4 + i) * 128;
#pragma unroll 16
        for (int dk = 0; dk < 128; ++dk) { const float s = S0[(size_t)dk * 128 + dv]; p += wr[dk] * s; qq += qr[dk] * s; }
        VN[i * 128 + dv] = U[i * 128 + dv] - p; qs_acc = qq * expf(gc[i]);
    }
    __syncthreads();
    {
        const int i = tid >> 7, dv = tid & 127; float o = qs_acc;
#pragma unroll
        for (int j = 0; j < 4; ++j) if (j <= i) o += DOT[16 + i * 4 + j] * expf(gc[i] - gc[j]) * VN[j * 128 + dv];
        WSP(float, WS_OGDN)[(row0 + i) * DM + h * 128 + dv] = o;
    }
    {
        const int dv = tid & 127, dg = tid >> 7; const float el = expf(gc[3]);
        float kd[4], vn[4];
#pragma unroll
        for (int j = 0; j < 4; ++j) { kd[j] = expf(gc[3] - gc[j]); vn[j] = VN[j * 128 + dv]; }
        float* So = F.out + O_GDNS + ((size_t)bs * GH + h) * 128 * 128;
#pragma unroll 8
        for (int dk = dg * 32; dk < dg * 32 + 32; ++dk) { float s = S0[(size_t)dk * 128 + dv] * el;
#pragma unroll
            for (int j = 0; j < 4; ++j) s += Y[(1 * 4 + j) * 128 + dk] * kd[j] * vn[j];
            So[(size_t)dk * 128 + dv] = s; }
    }
    (void)g_;
    __syncthreads();
}

constexpr int P3_S = 0;
constexpr int P3_VN = 8192;
__device__ __forceinline__ void p3_scan(Frame& F, int bh, int s) {
    const int lane = F.lane, w = F.wave, fr = lane & 15, fq = lane >> 4;
    const int b = bh >> 3, h = bh & 7;
    LAS bf16* Sl = (LAS bf16*)(F.lds + P3_S); LAS bf16* Vl = (LAS bf16*)(F.lds + P3_VN);
    const bf16* GW = WSP(bf16, WS_GW); const bf16* GQ = WSP(bf16, WS_GQ); const bf16* GKT = WSP(bf16, WS_GKT); const bf16* GQK = WSP(bf16, WS_GQK);
    const float* GU = WSP(float, WS_GU); const float* GDEC = WSP(float, WS_GDEC);
    float* OG = WSP(float, WS_OGDN);
    f32x4 Sacc = {0.f, 0.f, 0.f, 0.f};
    { v2u z = {0u, 0u}; *(LAS v2u*)(Sl + fr * 136 + 16 * w + 4 * fq) = z; }
    __syncthreads();
    const int m = w & 3;
    struct P3Ops { bf16x8 a1[4], ak0, ak1, aq0, aq1; f32x4 u4; float dec; };
    P3Ops R0, R1, R2;
#define P3_FETCH(R, cc) do { const size_t ch_ = (size_t)bh * NCH + (cc); \
        const bf16* p1_ = (w < 4 ? GW : GQ) + ch_ * 8192 + (size_t)(16 * m + fr) * 128 + 8 * fq; \
        _Pragma("unroll") for (int k_ = 0; k_ < 4; ++k_) R.a1[k_] = ld8(p1_ + 32 * k_); \
        const bf16* pk_ = GKT + ch_ * 8192 + (size_t)(16 * w + fr) * 64 + 8 * fq; R.ak0 = ld8(pk_); R.ak1 = ld8(pk_ + 32); \
        const bf16* pq_ = GQK + ch_ * 4096 + (size_t)(16 * m + fr) * 64 + 8 * fq; R.aq0 = ld8(pq_); R.aq1 = ld8(pq_ + 32);        \
        R.u4 = *((const f32x4*)(GU + ch_ * 8192) + (size_t)s * 256 + m * 64 + lane); \
        R.dec = GDEC[ch_]; } while (0)
#define P3_STEP(R, c) do { \
        f32x4 acc = {0.f, 0.f, 0.f, 0.f}; \
        _Pragma("unroll") for (int k = 0; k < 4; ++k) acc = MFMA16(R.a1[k], ld8l(Sl + fr * 136 + 32 * k + 8 * fq), acc); \
        if (w < 4) { const f32x4 vn = R.u4 - acc; v2u o; o.x = pk2(vn[0], vn[1]); o.y = pk2(vn[2], vn[3]); *(LAS v2u*)(Vl + fr * 72 + 16 * m + 4 * fq) = o; } \
        asm volatile("s_waitcnt lgkmcnt(0)\n\ts_barrier" ::: "memory"); \
        const bf16x8 v0 = ld8l(Vl + fr * 72 + 8 * fq), v1 = ld8l(Vl + fr * 72 + 32 + 8 * fq); \
        if (w >= 4) { acc = MFMA16(R.aq0, v0, acc); acc = MFMA16(R.aq1, v1, acc); \
            float* o = OG + ((size_t)b * PT + (c) * CHUNK + 16 * m + 4 * fq) * DM + h * 128 + 16 * s + fr; \
            _Pragma("unroll") for (int r = 0; r < 4; ++r) o[(size_t)r * DM] = acc[r]; } \
        Sacc = Sacc * R.dec; Sacc = MFMA16(R.ak0, v0, Sacc); Sacc = MFMA16(R.ak1, v1, Sacc); \
        { v2u o; o.x = pk2(Sacc[0], Sacc[1]); o.y = pk2(Sacc[2], Sacc[3]); *(LAS v2u*)(Sl + fr * 136 + 16 * w + 4 * fq) = o; } \
        asm volatile("s_waitcnt lgkmcnt(0)\n\ts_barrier" ::: "memory"); } while (0)
    P3_FETCH(R0, 0); P3_FETCH(R1, 1); P3_FETCH(R2, 2);
    static_assert(NCH % 3 == 2, "ring schedule below assumes NCH = 3k + 2");
#pragma unroll 1
    for (int c = 0; c + 3 <= NCH; c += 3) {
        P3_STEP(R0, c);     P3_FETCH(R0, (c + 3 < NCH ? c + 3 : NCH - 1));
        P3_STEP(R1, c + 1); P3_FETCH(R1, (c + 4 < NCH ? c + 4 : NCH - 1));
        P3_STEP(R2, c + 2); P3_FETCH(R2, (c + 5 < NCH ? c + 5 : NCH - 1));
    }
    P3_STEP(R0, NCH - 2); P3_STEP(R1, NCH - 1);
#undef P3_FETCH
#undef P3_STEP
    float* So = F.out + O_GDNP + ((size_t)bh * 128) * 128;
#pragma unroll
    for (int r = 0; r < 4; ++r) So[(size_t)(16 * w + 4 * fq + r) * 128 + 16 * s + fr] = Sacc[r];
}

__device__ __forceinline__ void p4_row(Frame& F, int row) {
    const int lane = F.lane;
    const float* o = WSP(float, WS_OGDN) + (size_t)row * DM + 16 * lane;
    const bf16* z = WSP(bf16, WS_PROJ) + (size_t)row * 4096 + 3072 + 16 * lane;
    f32x4 v[4]; float ss = 0.f;
#pragma unroll
    for (int j = 0; j < 4; ++j) { v[j] = *(const f32x4*)(o + 4 * j); ss += (v[j].x * v[j].x + v[j].y * v[j].y) + (v[j].z * v[j].z + v[j].w * v[j].w); }
    ss += dpp_f<DPP_XOR1>(ss); ss += dpp_f<DPP_XOR2>(ss); ss += dpp_f<DPP_HMIR>(ss);
    const float rstd = 1.f / sqrtf(ss * (1.f / 128.f) + EPS);
    const v4u z0 = *(const v4u*)z, z1 = *(const v4u*)(z + 8);
    const float* gn = FIN(12) + (16 * lane & 127);
    float zz[16] = {bflo(z0.x), bfhi(z0.x), bflo(z0.y), bfhi(z0.y), bflo(z0.z), bfhi(z0.z), bflo(z0.w), bfhi(z0.w),
                    bflo(z1.x), bfhi(z1.x), bflo(z1.y), bfhi(z1.y), bflo(z1.z), bfhi(z1.z), bflo(z1.w), bfhi(z1.w)};
    unsigned ow[8];
#pragma unroll
    for (int j = 0; j < 8; ++j) { const float a = v[j >> 1][(2 * j) & 3] * rstd * gn[2 * j] * silu_f(zz[2 * j]), bq = v[j >> 1][(2 * j + 1) & 3] * rstd * gn[2 * j + 1] * silu_f(zz[2 * j + 1]); ow[j] = pk2(a, bq); }
    v4u* dst = (v4u*)(WSP(bf16, WS_OG) + (size_t)row * DM + 16 * lane);
    dst[0] = (v4u){ow[0], ow[1], ow[2], ow[3]}; dst[1] = (v4u){ow[4], ow[5], ow[6], ow[7]};
}

typedef __bf16 bf16x2_t __attribute__((ext_vector_type(2)));
__device__ __forceinline__ float dot2_bf16(unsigned w, unsigned x, float acc) { return __builtin_amdgcn_fdot2_f32_bf16(__builtin_bit_cast(bf16x2_t, w), __builtin_bit_cast(bf16x2_t, x), acc, false); }
__device__ __forceinline__ float u2f(unsigned u) { return __builtin_bit_cast(float, u); }
__device__ __forceinline__ unsigned f2u(float f) { return __builtin_bit_cast(unsigned, f); }

constexpr int P8_TOP = 0;
constexpr int P8_TAB = 24576;
__device__ __forceinline__ void p8_init_tab(Frame& F) {
    LAS unsigned char* tab = F.lds + P8_TAB;
    if (F.tid < 64) { const int k = F.tid; int i = 0, j = 0;
        if (k < 16) { i = 0; j = k; } else if (k < 24) { i = 1; j = k - 16; } else if (k < 29) { i = 2; j = k - 24; } else if (k < 33) { i = 3; j = k - 29; }
        else if (k < 36) { i = 4; j = k - 33; } else if (k < 38) { i = 5; j = k - 36; } else if (k < 40) { i = 6; j = k - 38; } else if (k < 42) { i = 7; j = k - 40; } else if (k < 50) { i = k - 34; j = 0; }
        tab[k] = (unsigned char)i; tab[64 + k] = (unsigned char)j; }
    __syncthreads();
}
template <int CTRL> __device__ __forceinline__ float dppf(float x) { return __builtin_bit_cast(float, __builtin_amdgcn_update_dpp(0, __builtin_bit_cast(int, x), CTRL, 0xF, 0xF, true)); }
__device__ __forceinline__ float row_max16(float x) {
    x = fmaxf(x, dppf<0xB1>(x)); x = fmaxf(x, dppf<0x4E>(x)); x = fmaxf(x, dppf<0x141>(x)); x = fmaxf(x, dppf<0x140>(x)); return x;
}
#define CSWAP(a, b) { const float hi_ = fmaxf(a, b), lo_ = fminf(a, b); a = hi_; b = lo_; }
__device__ __forceinline__ void p8_unit(Frame& F, int unit, int layer) {
    int lane_ = F.lane; asm volatile("" : "+v"(lane_));
    const int lane = lane_, w = F.wave, fr = lane & 15, fq = lane >> 4;
    LAS unsigned char* L = F.lds; asm volatile("" : "+v"(L));
    LAS unsigned* topl = (LAS unsigned*)(L + P8_TOP + w * 3072);
    LAS float* wins = (LAS float*)(L + P8_TOP + w * 3072 + 2048);
    const LAS unsigned char* tab = L + P8_TAB;
    const int r0 = unit * 16;
    const bf16* Q = WSP(bf16, WS_QPEER) + (size_t)(r0 + fr) * 2048 + w * 256 + 8 * fq;
    const bf16* SK = WSP(bf16, WS_SUBK) + (size_t)((layer * 8 + w) * 2) * 16384 + (size_t)fr * 128 + 8 * fq;
    const float NEGINF = -__builtin_inff();
#pragma unroll 1
    for (int p = 0; p < 2; ++p) {
        bf16x8 aq[4];
#pragma unroll
        for (int ks = 0; ks < 4; ++ks) aq[ks] = ld8(Q + p * 128 + 32 * ks);
        float s[4][8];
#pragma unroll
        for (int nt = 0; nt < 8; ++nt) { f32x4 acc = {0.f, 0.f, 0.f, 0.f};
#pragma unroll
            for (int ks = 0; ks < 4; ++ks) acc = MFMA16(aq[ks], ld8(SK + (size_t)p * 16384 + (size_t)nt * 2048 + 32 * ks), acc);
#pragma unroll
            for (int r = 0; r < 4; ++r) s[r][nt] = u2f((f2u(acc[r]) & ~127u) | (unsigned)(16 * nt + fr)); }
#pragma unroll
        for (int r = 0; r < 4; ++r) {
            CSWAP(s[r][0], s[r][1]) CSWAP(s[r][2], s[r][3]) CSWAP(s[r][4], s[r][5]) CSWAP(s[r][6], s[r][7])
            CSWAP(s[r][0], s[r][2]) CSWAP(s[r][1], s[r][3]) CSWAP(s[r][4], s[r][6]) CSWAP(s[r][5], s[r][7])
            CSWAP(s[r][1], s[r][2]) CSWAP(s[r][5], s[r][6]) CSWAP(s[r][0], s[r][4]) CSWAP(s[r][3], s[r][7])
            CSWAP(s[r][1], s[r][5]) CSWAP(s[r][2], s[r][6]) CSWAP(s[r][1], s[r][4]) CSWAP(s[r][3], s[r][6])
            CSWAP(s[r][2], s[r][4]) CSWAP(s[r][3], s[r][5]) CSWAP(s[r][3], s[r][4]) }
#pragma unroll 1
        for (int rd = 0; rd < 16; ++rd) {
#pragma unroll
            for (int r = 0; r < 4; ++r) {
                const float mx = row_max16(s[r][0]);
                const bool pop = f2u(s[r][0]) == f2u(mx);
#pragma unroll
                for (int i = 0; i < 7; ++i) s[r][i] = pop ? s[r][i + 1] : s[r][i];
                s[r][7] = pop ? NEGINF : s[r][7];
                if (fr == 0) topl[((4 * fq + r) * 2 + p) * 16 + rd] = f2u(mx);
            }
        }
    }
    LDS_WAIT();
    float c[4][4];
#pragma unroll
    for (int r = 0; r < 4; ++r) { const int tk = 4 * fq + r;
#pragma unroll
        for (int m = 0; m < 4; ++m) { const int k = fr + 16 * m; float cv = NEGINF;
            if (k < 50) { const int i = tab[k], j = tab[64 + k]; const float s1 = u2f(topl[(tk * 2 + 0) * 16 + i] & ~127u), s2 = u2f(topl[(tk * 2 + 1) * 16 + j] & ~127u);
                cv = u2f((f2u(s1 + s2) & ~63u) | (unsigned)k); }
            c[r][m] = cv; }
        CSWAP(c[r][0], c[r][1]) CSWAP(c[r][2], c[r][3]) CSWAP(c[r][0], c[r][2]) CSWAP(c[r][1], c[r][3]) CSWAP(c[r][1], c[r][2]) }
#pragma unroll 1
    for (int rd = 0; rd < 16; ++rd) {
#pragma unroll
        for (int r = 0; r < 4; ++r) {
            const float mx = row_max16(c[r][0]);
            const bool pop = f2u(c[r][0]) == f2u(mx);
            c[r][0] = pop ? c[r][1] : c[r][0]; c[r][1] = pop ? c[r][2] : c[r][1]; c[r][2] = pop ? c[r][3] : c[r][2]; c[r][3] = pop ? NEGINF : c[r][3];
            if (fr == 0) wins[(4 * fq + r) * 16 + rd] = mx;
        }
    }
    LDS_WAIT();
    {
        const int tk = 4 * fq + (fr >> 2), q4 = fr & 3;
        const float w0 = wins[tk * 16]; float den = 0.f;
#pragma unroll
        for (int rd = 0; rd < 16; ++rd) den += __expf(wins[tk * 16 + rd] - w0);
        const float inv = 1.f / den;
        int e[4]; float g[4];
#pragma unroll
        for (int x = 0; x < 4; ++x) { const float wv = wins[tk * 16 + 4 * q4 + x]; const int k = (int)(f2u(wv) & 63u); const int i = tab[k], j = tab[64 + k];
            e[x] = (int)(topl[(tk * 2 + 0) * 16 + i] & 127u) * 128 + (int)(topl[(tk * 2 + 1) * 16 + j] & 127u); g[x] = __expf(wv - w0) * inv; }
        int* pei = WSP(int, WS_PEI) + (size_t)(r0 + tk) * 128 + w * 16 + 4 * q4; float* peg = WSP(float, WS_PEG) + (size_t)(r0 + tk) * 128 + w * 16 + 4 * q4;
        *(v4u*)pei = (v4u){(unsigned)e[0], (unsigned)e[1], (unsigned)e[2], (unsigned)e[3]};
        *(f32x4*)peg = (f32x4){g[0], g[1], g[2], g[3]};
    }
}

typedef float f32x2_t __attribute__((ext_vector_type(2)));
#define P9_DOT4(w, h0, h1, h2, h3, acc) { const f32x2_t lo_ = __builtin_amdgcn_cvt_pk_f32_fp8((int)(w), false), hi_ = __builtin_amdgcn_cvt_pk_f32_fp8((int)(w), true); \
        acc = __builtin_fmaf(lo_.x, h0, acc); acc = __builtin_fmaf(lo_.y, h1, acc); acc = __builtin_fmaf(hi_.x, h2, acc); acc = __builtin_fmaf(hi_.y, h3, acc); }
#define P9_AXPY4(w, c, o0, o1, o2, o3) { const f32x2_t lo_ = __builtin_amdgcn_cvt_pk_f32_fp8((int)(w), false), hi_ = __builtin_amdgcn_cvt_pk_f32_fp8((int)(w), true); \
        o0 = __builtin_fmaf(c, lo_.x, o0); o1 = __builtin_fmaf(c, lo_.y, o1); o2 = __builtin_fmaf(c, hi_.x, o2); o3 = __builtin_fmaf(c, hi_.y, o3); }
__device__ __forceinline__ void p9_token(Frame& F, int row, int layer, int mode) {
    const int lane = F.lane;
    float h[16];
    { const bf16* hrow = WSP(bf16, WS_XNB) + (size_t)row * DM + 16 * lane; const v4u a = *(const v4u*)hrow, b = *(const v4u*)(hrow + 8);
      h[0] = bflo(a.x); h[1] = bfhi(a.x); h[2] = bflo(a.y); h[3] = bfhi(a.y); h[4] = bflo(a.z); h[5] = bfhi(a.z); h[6] = bflo(a.w); h[7] = bfhi(a.w);
      h[8] = bflo(b.x); h[9] = bfhi(b.x); h[10] = bflo(b.y); h[11] = bfhi(b.y); h[12] = bflo(b.z); h[13] = bfhi(b.z); h[14] = bflo(b.w); h[15] = bfhi(b.w); }
    const int* pei = WSP(int, WS_PEI) + (size_t)row * 128; const float* peg = WSP(float, WS_PEG) + (size_t)row * 128;
    const int e0 = pei[lane], e1 = pei[64 + lane]; const float g0 = peg[lane], g1 = peg[64 + lane];
    const unsigned char* PU = WSP(unsigned char, WS_PU) + (size_t)layer * NEXP * DM + 16 * lane; const unsigned char* PV = WSP(unsigned char, WS_PV) + (size_t)layer * NEXP * DM + 16 * lane;
    float out[16];
#pragma unroll
    for (int i = 0; i < 16; ++i) out[i] = 0.f;
    v4u U[2][4], V[2][4];
#define P9_LOAD(buf, bb) do { const int ev_ = (bb) < 16 ? e0 : e1; _Pragma("unroll") for (int j_ = 0; j_ < 4; ++j_) { \
        const size_t off_ = (size_t)__builtin_amdgcn_readlane(ev_, ((bb) & 15) * 4 + j_) * DM; \
        U[buf][j_] = *(const v4u*)(PU + off_); V[buf][j_] = *(const v4u*)(PV + off_); } } while (0)
#define P9_COMP(buf, bb) do { float d_[4]; _Pragma("unroll") for (int j_ = 0; j_ < 4; ++j_) { float a_ = 0.f, b_ = 0.f; \
            P9_DOT4(U[buf][j_].x, h[0], h[1], h[2], h[3], a_) P9_DOT4(U[buf][j_].y, h[4], h[5], h[6], h[7], b_) P9_DOT4(U[buf][j_].z, h[8], h[9], h[10], h[11], a_) P9_DOT4(U[buf][j_].w, h[12], h[13], h[14], h[15], b_) d_[j_] = a_ + b_; } \
        float f_[2]; _Pragma("unroll") for (int k_ = 0; k_ < 2; ++k_) { const float x_ = (lane & 1) ? d_[2 * k_ + 1] : d_[2 * k_], y_ = (lane & 1) ? d_[2 * k_] : d_[2 * k_ + 1]; f_[k_] = x_ + dpp_f<DPP_XOR1>(y_); } \
        float g_; { const float x_ = (lane & 2) ? f_[1] : f_[0], y_ = (lane & 2) ? f_[0] : f_[1]; g_ = x_ + dpp_f<DPP_XOR2>(y_); } \
        g_ += dpp_f<DPP_ROR4>(g_); g_ += dpp_f<DPP_ROR8>(g_); g_ = x32_sum(x16_sum(g_)); \
        const float gt_ = __shfl((bb) < 16 ? g0 : g1, ((bb) & 15) * 4 + (lane & 3)); \
        const float cl_ = gelu_tanh(g_ * 0.03125f) * gt_ * 0.0625f; \
        _Pragma("unroll") for (int j_ = 0; j_ < 4; ++j_) { const float cj_ = __builtin_bit_cast(float, __builtin_amdgcn_readlane(__builtin_bit_cast(int, cl_), j_)); \
            P9_AXPY4(V[buf][j_].x, cj_, out[0], out[1], out[2], out[3]) P9_AXPY4(V[buf][j_].y, cj_, out[4], out[5], out[6], out[7]) \
            P9_AXPY4(V[buf][j_].z, cj_, out[8], out[9], out[10], out[11]) P9_AXPY4(V[buf][j_].w, cj_, out[12], out[13], out[14], out[15]) } } while (0)
    P9_LOAD(0, 0);
#pragma unroll 1
    for (int bb = 0; bb < 32; bb += 2) {
        P9_LOAD(1, bb + 1);
        P9_COMP(0, bb);
        if (bb + 2 < 32) P9_LOAD(0, bb + 2);
        P9_COMP(1, bb + 1);
    }
#undef P9_LOAD
#undef P9_COMP
    float* xs = WSP(float, WS_XS) + (size_t)row * DM + 16 * lane;
    f32x4 x[4];
#pragma unroll
    for (int i = 0; i < 4; ++i) { x[i] = *(const f32x4*)(xs + 4 * i); x[i].x += out[4 * i]; x[i].y += out[4 * i + 1]; x[i].z += out[4 * i + 2]; x[i].w += out[4 * i + 3]; }
    if (mode == 0) {
        float ss = 0.f;
#pragma unroll
        for (int i = 0; i < 4; ++i) { *(f32x4*)(xs + 4 * i) = x[i]; ss += (x[i].x * x[i].x + x[i].y * x[i].y) + (x[i].z * x[i].z + x[i].w * x[i].w); }
        const float rstd = 1.f / sqrtf(wave_sum(ss) * (1.f / DM) + EPS);
        bf16* xn = WSP(bf16, WS_XNA) + (size_t)row * DM + 16 * lane;
        *(v4u*)xn = (v4u){pk2(x[0].x * rstd, x[0].y * rstd), pk2(x[0].z * rstd, x[0].w * rstd), pk2(x[1].x * rstd, x[1].y * rstd), pk2(x[1].z * rstd, x[1].w * rstd)};
        *(v4u*)(xn + 8) = (v4u){pk2(x[2].x * rstd, x[2].y * rstd), pk2(x[2].z * rstd, x[2].w * rstd), pk2(x[3].x * rstd, x[3].y * rstd), pk2(x[3].z * rstd, x[3].w * rstd)};
    } else {
        float* y = (row < MP ? F.out + O_YP + (size_t)row * DM : F.out + O_YS + (size_t)(row - MP) * DM) + 16 * lane;
#pragma unroll
        for (int i = 0; i < 4; ++i) *(f32x4*)(y + 4 * i) = x[i];
    }
}

constexpr float QSCALE = 0.125f * 1.4426950408889634f;
constexpr int PP_VT = 0;
__device__ __forceinline__ float rms64(float v) { return 1.f / sqrtf(wave_sum(v * v) * (1.f / 64.f) + EPS); }

__device__ __forceinline__ void pp_q_row(Frame& F, int row, const float* kvq, const float qg) {
    const int lane = F.lane;
    bf16* qn = WSP(bf16, WS_QN) + (size_t)row * 1024;
#pragma unroll 4
    for (int hd = 0; hd < 16; ++hd) { const float v = kvq[NKV + hd * 64 + lane]; qn[hd * 64 + lane] = (bf16)f2bf(v * rms64(v) * qg); }
    if (lane < 48) WSP(float, WS_GATES)[(size_t)row * 48 + lane] = sigmoid_f(kvq[NKV + 1024 + lane]);
}
__device__ __forceinline__ void pp_prompt_tile(Frame& F, int unit) {
    const int lane = F.lane, w = F.wave, b = unit >> 7, t0 = (unit & 127) * 64;
    LAS unsigned char* L = F.lds; asm volatile("" : "+v"(L));
    LAS bf16* vt = (LAS bf16*)(L + PP_VT);
    const float kg1 = FIN(16)[64 + lane], kg2 = FIN(16)[128 + lane], qg = FIN(22)[lane] * QSCALE;
    for (int rr = 0; rr < 8; ++rr) {
        const int tl = 8 * w + rr, t = t0 + tl, row = b * PT + t;
        const float* kvq = WSP(float, WS_KVQ) + (size_t)row * NKVQ;
        float* okv = F.out + O_KVP + (size_t)row * 1024;
        const bool inwin = t >= PT - WINDOW;
        float* owin = F.out + O_WINP + ((size_t)b * 512 + (t - (PT - WINDOW))) * 512;
#pragma unroll
        for (int g = 0; g < 4; ++g) {
            const float v0 = kvq[0 * 256 + g * 64 + lane], v1 = kvq[1 * 256 + g * 64 + lane], v2 = kvq[2 * 256 + g * 64 + lane];
            const float v3 = kvq[3 * 256 + g * 64 + lane], v4 = kvq[4 * 256 + g * 64 + lane], v5 = kvq[5 * 256 + g * 64 + lane];
            const float ks = v2 * rms64(v2) * kg1, kw = v4 * rms64(v4) * kg2;
            okv[0 * 256 + g * 64 + lane] = v0; okv[1 * 256 + g * 64 + lane] = v1; okv[2 * 256 + g * 64 + lane] = ks; okv[3 * 256 + g * 64 + lane] = v3;
            if (inwin) { owin[g * 64 + lane] = kw; owin[256 + g * 64 + lane] = v5; }
            const size_t kidx = (((size_t)b * NG + g) * PT + t) * 64 + lane;
            WSP(bf16, WS_KSEL)[kidx] = (bf16)f2bf(ks); WSP(bf16, WS_KWIN)[kidx] = (bf16)f2bf(kw);
            vt[((0 * 4 + g) * 64 + lane) * 72 + tl] = (bf16)f2bf(v3); vt[((1 * 4 + g) * 64 + lane) * 72 + tl] = (bf16)f2bf(v5);
        }
        pp_q_row(F, row, kvq, qg);
    }
    __syncthreads();
    {
        const int which = F.tid >> 8, gd = F.tid & 255;
        bf16* dst = WSP(bf16, which == 0 ? WS_VSELT : WS_VWINT) + (((size_t)b * NG * 64 + gd) * PT + t0);
        const LAS bf16* src = vt + ((which * 256 + gd) * 72);
#pragma unroll
        for (int i = 0; i < 8; ++i) *(v4u*)(dst + 8 * i) = *(const LAS v4u*)(src + 8 * i);
    }
    __syncthreads();
}
__device__ __forceinline__ void pp_sample_row(Frame& F, int sr) {
    const int lane = F.lane, bs = sr >> 2, i = sr & 3, row = MP + sr;
    const float kg1 = FIN(16)[64 + lane], kg2 = FIN(16)[128 + lane], qg = FIN(22)[lane] * QSCALE;
    const float* kvq = WSP(float, WS_KVQ) + (size_t)row * NKVQ;
    float* okv = F.out + O_KVS + (size_t)sr * 1024;
    float* owin = F.out + O_WINS + ((size_t)bs * 512 + 508 + i) * 512;
#pragma unroll
    for (int g = 0; g < 4; ++g) {
        const float v0 = kvq[0 * 256 + g * 64 + lane], v1 = kvq[1 * 256 + g * 64 + lane], v2 = kvq[2 * 256 + g * 64 + lane];
        const float v3 = kvq[3 * 256 + g * 64 + lane], v4 = kvq[4 * 256 + g * 64 + lane], v5 = kvq[5 * 256 + g * 64 + lane];
        const float ks = v2 * rms64(v2) * kg1, kw = v4 * rms64(v4) * kg2;
        okv[0 * 256 + g * 64 + lane] = v0; okv[1 * 256 + g * 64 + lane] = v1; okv[2 * 256 + g * 64 + lane] = ks; okv[3 * 256 + g * 64 + lane] = v3;
        owin[g * 64 + lane] = kw; owin[256 + g * 64 + lane] = v5;
        const size_t bg = (size_t)bs * NG + g;
        WSP(bf16, WS_SKWIN)[(bg * 544 + 512 + i) * 64 + lane] = (bf16)f2bf(kw);
        WSP(bf16, WS_SVWINT)[(bg * 64 + lane) * 544 + 512 + i] = (bf16)f2bf(v5);
        float* sn = WSP(float, WS_SNEW) + (((size_t)bs * 4 + i) * 2) * 256 + g * 64 + lane;
        sn[0] = ks; sn[256] = v3;
    }
    pp_q_row(F, row, kvq, qg);
}

__device__ __forceinline__ void compress_finish(Frame& F, const f32x4 (&acc)[4], int kv, int blk, bf16* KC, bf16* VCT) {
    const int lane = F.lane, fr = lane & 15, fq = lane >> 4;
    const float* pet = WSP(float, WS_PETERM) + kv * 64;
    bf16x8 hb[2];
#pragma unroll
    for (int s = 0; s < 2; ++s) { f32x4 h0, h1;
#pragma unroll
        for (int r = 0; r < 4; ++r) { h0[r] = gelu_tanh(acc[2 * s][r] + pet[16 * (2 * s) + 4 * fq + r]); h1[r] = gelu_tanh(acc[2 * s + 1][r] + pet[16 * (2 * s + 1) + 4 * fq + r]); }
        hb[s] = cvt8(h0, h1); }
    const float* w2 = FIN(19) + (size_t)kv * 64 * 64;
    f32x4 o[4];
#pragma unroll
    for (int dt = 0; dt < 4; ++dt) { o[dt] = (f32x4){0.f, 0.f, 0.f, 0.f};
#pragma unroll
        for (int s = 0; s < 2; ++s) { f32x4 a0, a1;
#pragma unroll
            for (int jj = 0; jj < 4; ++jj) { a0[jj] = w2[(size_t)(16 * (2 * s) + 4 * fq + jj) * 64 + 16 * dt + fr]; a1[jj] = w2[(size_t)(16 * (2 * s + 1) + 4 * fq + jj) * 64 + 16 * dt + fr]; }
            o[dt] = MFMA16(cvt8(a0, a1), hb[s], o[dt]); } }
    if (kv == 0) {
        float ss = 0.f;
#pragma unroll
        for (int dt = 0; dt < 4; ++dt) ss += (o[dt][0] * o[dt][0] + o[dt][1] * o[dt][1]) + (o[dt][2] * o[dt][2] + o[dt][3] * o[dt][3]);
        ss = x32_sum(x16_sum(ss));
        const float rstd = 1.f / sqrtf(ss * (1.f / 64.f) + EPS);
        const float* kg0 = FIN(16);
        if (blk < NCMP) {
#pragma unroll
            for (int dt = 0; dt < 4; ++dt) { const int d = 16 * dt + 4 * fq; v2u ov; ov.x = pk2(o[dt][0] * rstd * kg0[d], o[dt][1] * rstd * kg0[d + 1]); ov.y = pk2(o[dt][2] * rstd * kg0[d + 2], o[dt][3] * rstd * kg0[d + 3]);
                *(v2u*)(KC + (size_t)blk * 64 + d) = ov; }
        } else {
#pragma unroll
            for (int dt = 0; dt < 4; ++dt) *(v2u*)(KC + (size_t)blk * 64 + 16 * dt + 4 * fq) = (v2u){0u, 0u};
        }
    } else {
#pragma unroll
        for (int dt = 0; dt < 4; ++dt)
#pragma unroll
            for (int r = 0; r < 4; ++r) VCT[(size_t)(16 * dt + 4 * fq + r) * 512 + blk] = (blk < NCMP) ? (bf16)f2bf(o[dt][r]) : (bf16)0;
    }
}

template <class RowP>
__device__ __forceinline__ void compress_tile(Frame& F, const RowP& rowp, int kv, int j, bf16* KC, bf16* VCT) {
    const int lane = F.lane, fr = lane & 15, fq = lane >> 4;
    const bf16* W1 = WSP(bf16, WS_W1T) + (size_t)kv * 64 * 2048 + (size_t)fr * 2048 + 8 * fq;
    const int blk = 16 * j + fr;
    f32x4 acc[4];
#pragma unroll
    for (int mt = 0; mt < 4; ++mt) acc[mt] = (f32x4){0.f, 0.f, 0.f, 0.f};
#pragma unroll 2
    for (int r = 0; r < 32; ++r) {
        int t = 16 * blk + r; t = t < PAST ? t : PAST - 1;
        const float* rp = rowp(t) + 8 * fq;
#pragma unroll
        for (int hf = 0; hf < 2; ++hf) {
            const f32x4 x0 = *(const f32x4*)(rp + 32 * hf), x1 = *(const f32x4*)(rp + 32 * hf + 4);
            const bf16x8 bfrag = cvt8(x0, x1);
            const int ks = 2 * r + hf;
#pragma unroll
            for (int mt = 0; mt < 4; ++mt) acc[mt] = MFMA16(ld8(W1 + (size_t)mt * 16 * 2048 + 32 * ks), bfrag, acc[mt]);
        }
    }
    compress_finish(F, acc, kv, blk, KC, VCT);
}
struct RowPPrompt { const float* base; __device__ __forceinline__ const float* operator()(int t) const { return base + (size_t)t * NKVQ; } };
struct RowPSample { const float* cache; const int* pt; __device__ __forceinline__ const float* operator()(int t) const { return cache + ((size_t)pt[t >> 7] * PAGE + (t & 127)) * 1024; } };

__device__ __forceinline__ void compress_prompt(Frame& F, int id) {
    const int kv = id & 1, j = (id >> 1) & 31, bg = id >> 6, b = bg >> 2, g = bg & 3;
    RowPPrompt rp{WSP(float, WS_KVQ) + (size_t)b * PT * NKVQ + kv * 256 + g * 64};
    compress_tile(F, rp, kv, j, WSP(bf16, WS_KCMP) + (size_t)bg * 512 * 64, WSP(bf16, WS_VCMPT) + (size_t)bg * 64 * 512);
}
__device__ __forceinline__ void compress_sample(Frame& F, int id) {
    const int kv = id & 1, j = (id >> 1) & 31, bg = id >> 6, lane = F.lane, fr = lane & 15, fq = lane >> 4;
    const int blk = 16 * j + fr, nb = blk < 511 ? blk + 1 : 511;
    const float* f1 = WSP(float, WS_FS) + ((size_t)bg * 512 + blk) * 256 + kv * 128 + 4 * fq;
    const float* f2 = WSP(float, WS_FS) + ((size_t)bg * 512 + nb) * 256 + kv * 128 + 64 + 4 * fq;
    f32x4 acc[4];
#pragma unroll
    for (int mt = 0; mt < 4; ++mt) acc[mt] = *(const f32x4*)(f1 + 16 * mt) + *(const f32x4*)(f2 + 16 * mt);
    compress_finish(F, acc, kv, blk, WSP(bf16, WS_SKCMP) + (size_t)bg * 512 * 64, WSP(bf16, WS_SVCMPT) + (size_t)bg * 64 * 512);
}

constexpr int NSA_IMP = 0;
constexpr int NSA_Q = 67584;
constexpr int NSA_QLD = 68;
constexpr float LOG2E = 1.4426950408889634f;
#ifndef NSA_SUBUNITS
#define NSA_SUBUNITS 0
#endif
__device__ __forceinline__ float ex2(float x) { return __builtin_amdgcn_exp2f(x); }

struct KvBf16 {
    const bf16* K; const bf16* VT; int ld;
    __device__ __forceinline__ void lane_offsets(int fr, int fq, unsigned& ko, unsigned& vo) const {
        ko = (unsigned)(((8 * (fr >> 2) + (fr & 3)) * 64 + 8 * fq) * 2); vo = (unsigned)((fr * ld + 8 * fq) * 2);
        asm volatile("" : "+v"(ko), "+v"(vo));
    }
    __device__ __forceinline__ bf16x8 kf(int key0, int mt, int ks, unsigned ko) const {
        return *(const bf16x8*)((const char*)K + (size_t)key0 * 128 + (ko + (unsigned)((4 * mt * 64 + 32 * ks) * 2))); }
    __device__ __forceinline__ bf16x8 vf(int key0, int dt, unsigned vo) const {
        return *(const bf16x8*)((const char*)VT + (size_t)key0 * 2 + (vo + (unsigned)(16 * dt * ld * 2))); }
};
struct KvSampleSel {
    const float* cache; const int* pt; const float* snew; int g;
    __device__ __forceinline__ const float* krow(int pos, int slot) const {
        if (pos < PAST) return cache + ((size_t)pt[pos >> 7] * PAGE + (pos & 127)) * 1024 + slot * 256;
        int i = pos - PAST; i = i < 3 ? i : 3; return snew + (size_t)i * 512 + (slot - 2) * 256; }
    __device__ __forceinline__ void lane_offsets(int fr, int fq, unsigned& ko, unsigned& vo) const { ko = (unsigned)(fr | (fq << 8)); vo = ko; asm volatile("" : "+v"(ko), "+v"(vo)); }
    __device__ __forceinline__ bf16x8 kf(int key0, int mt, int ks, unsigned ko) const { const int fr = ko & 255, fq = ko >> 8;
        const float* p = krow(key0 + 8 * (fr >> 2) + 4 * mt + (fr & 3), 2) + 32 * ks + 8 * fq; return cvt8(*(const f32x4*)p, *(const f32x4*)(p + 4)); }
    __device__ __forceinline__ bf16x8 vf(int key0, int dt, unsigned vo) const { const int fr = vo & 255, fq = vo >> 8; f32x4 a, b;
#pragma unroll
        for (int j = 0; j < 4; ++j) { a[j] = krow(key0 + 8 * fq + j, 3)[16 * dt + fr]; b[j] = krow(key0 + 8 * fq + 4 + j, 3)[16 * dt + fr]; }
        return cvt8(a, b); }
};
struct KvFrags { bf16x8 k[2][2]; bf16x8 v[4]; };
template <bool WITHV, class KV>
__device__ __forceinline__ void nsa_load(const KV& kv, int key0, int fr, int fq, KvFrags& f) {
    unsigned ko, vo; kv.lane_offsets(fr, fq, ko, vo);
#pragma unroll
    for (int mt = 0; mt < 2; ++mt)
#pragma unroll
        for (int ks = 0; ks < 2; ++ks) f.k[mt][ks] = kv.kf(key0, mt, ks, ko);
    if (WITHV) {
#pragma unroll
        for (int dt = 0; dt < 4; ++dt) f.v[dt] = kv.vf(key0, dt, vo);
    }
}

template <int NT, int MODE, bool QREG = false>
__device__ __forceinline__ void nsa_core(const KvFrags& f, int key0, const LAS bf16* qrow, int qnt, f32x4 (&O)[NT][4], float (&m)[NT], float (&l)[NT], const float (&invl)[NT], const float (&slope)[NT],
                                         int t, int pmul, int padd, int wlim, bool selok, LAS float* improw, int fq, const bf16x8* qreg = nullptr) {
    float dist[2][4]; bool val[2][4];
#pragma unroll
    for (int mt = 0; mt < 2; ++mt)
#pragma unroll
        for (int r = 0; r < 4; ++r) { const int kk = key0 + 8 * fq + 4 * mt + r; const int dd = t - (pmul * kk + padd); dist[mt][r] = (float)dd; val[mt][r] = selok && dd >= 0 && dd < wlim; }
    float imp_main[2] = {0.f, 0.f}, imp_spill[2] = {0.f, 0.f};
#pragma unroll
    for (int nt = 0; nt < NT; ++nt) {
        f32x4 s[2];
        bf16x8 q0, q1; if (QREG) { q0 = qreg[nt * 2]; q1 = qreg[nt * 2 + 1]; } else { q0 = ld8l(qrow + nt * qnt + 8 * fq); q1 = ld8l(qrow + nt * qnt + 32 + 8 * fq); }
#pragma unroll
        for (int mt = 0; mt < 2; ++mt) { s[mt] = (f32x4){0.f, 0.f, 0.f, 0.f}; s[mt] = MFMA16(f.k[mt][0], q0, s[mt]); s[mt] = MFMA16(f.k[mt][1], q1, s[mt]); }
        f32x4 p[2]; float ps = 0.f;
#pragma unroll
        for (int mt = 0; mt < 2; ++mt)
#pragma unroll
            for (int r = 0; r < 4; ++r) { float pv = ex2(val[mt][r] ? (s[mt][r] - slope[nt] * dist[mt][r]) : -200.f); if (MODE == 2) pv *= invl[nt]; p[mt][r] = pv; ps += pv; }
        if (MODE != 2) l[nt] += ps;
        if (MODE == 2) {
#pragma unroll
            for (int mt = 0; mt < 2; ++mt) { imp_main[mt] += (p[mt][0] + p[mt][1]) + (p[mt][2] + p[mt][3]); imp_spill[mt] += p[mt][3]; }
        }
        if (MODE != 1) {
            const bf16x8 pf = cvt8(p[0], p[1]);
#pragma unroll
            for (int dt = 0; dt < 4; ++dt) O[nt][dt] = MFMA16(f.v[dt], pf, O[nt][dt]);
        }
    }
    if (MODE == 2) {
#pragma unroll
        for (int mt = 0; mt < 2; ++mt) { const int j = key0 / 4 + 2 * fq + mt;
            __hip_atomic_fetch_add(improw + j, imp_main[mt], __ATOMIC_RELAXED, __HIP_MEMORY_SCOPE_WORKGROUP);
            __hip_atomic_fetch_add(improw + j + 1, imp_spill[mt], __ATOMIC_RELAXED, __HIP_MEMORY_SCOPE_WORKGROUP); }
    }
}
template <int NT, int MODE, class KV>
__device__ __forceinline__ void nsa_tile(const KV& kv, int key0, const LAS bf16* qrow, int qnt, f32x4 (&O)[NT][4], float (&m)[NT], float (&l)[NT], const float (&invl)[NT], const float (&slope)[NT],
                                         int t, int pmul, int padd, int wlim, bool selok, LAS float* improw, int fr, int fq) {
    KvFrags f; nsa_load<MODE != 1>(kv, key0, fr, fq, f);
    nsa_core<NT, MODE>(f, key0, qrow, qnt, O, m, l, invl, slope, t, pmul, padd, wlim, selok, improw, fq);
}

template <int NT>
__device__ __forceinline__ void nsa_zero(f32x4 (&O)[NT][4], float (&m)[NT], float (&l)[NT]) {
#pragma unroll
    for (int nt = 0; nt < NT; ++nt) { m[nt] = -1e30f; l[nt] = 0.f;
#pragma unroll
        for (int dt = 0; dt < 4; ++dt) O[nt][dt] = (f32x4){0.f, 0.f, 0.f, 0.f}; }
}

template <bool SAMPLE>
__device__ __forceinline__ void nsa_unit(Frame& F, int id) {
    constexpr int NT = SAMPLE ? 1 : 4;
    int lane_ = F.lane; asm volatile("" : "+v"(lane_));
    const int lane = lane_, fr = lane & 15, fq = lane >> 4;
    LAS unsigned char* L = F.lds; asm volatile("" : "+v"(L));
    LAS float* imp = (LAS float*)(L + NSA_IMP + F.wave * 8448);
    LAS bf16* qw = (LAS bf16*)(L + NSA_Q + F.wave * 8704);
    int bg, g, t, row, trow, tmax, row0;
    if (SAMPLE) { bg = id; g = id & 3; t = PAST + (fr >> 2); row0 = MP + (id >> 2) * 4; row = row0 + (fr >> 2); trow = fr >> 2; tmax = PAST + 3; }
    else { bg = id >> 9; g = bg & 3; const int tt = id & 511; t = 16 * tt + fr; row0 = (bg >> 2) * PT + 16 * tt; row = row0 + fr; trow = fr; tmax = 16 * tt + 15; }
    {
        const int nrow = SAMPLE ? 16 : 64;
        for (int i = lane; i < nrow * 8; i += 64) { const int rr = i >> 3, c8 = i & 7;
            *(LAS v4u*)(qw + rr * NSA_QLD + 8 * c8) = *(const v4u*)(WSP(bf16, WS_QN) + (size_t)(row0 + (rr >> 2)) * 1024 + (g * 4 + (rr & 3)) * 64 + 8 * c8); }
    }
    float slope[NT]; int hd[NT];
#pragma unroll
    for (int nt = 0; nt < NT; ++nt) { hd[nt] = g * 4 + (SAMPLE ? (fr & 3) : nt); slope[nt] = ex2(-0.5f * (float)(hd[nt] + 1)) * LOG2E; }
    const LAS bf16* qrow = qw + (SAMPLE ? fr : fr * 4) * NSA_QLD; const int qnt = SAMPLE ? 0 : NSA_QLD;
    const float* gates = WSP(float, WS_GATES) + (size_t)row * 48;
    float* oacc = WSP(float, WS_OACC) + (size_t)row * 1024;
    for (int i = lane; i < 16 * 132; i += 64) imp[i] = 0.f;
    LDS_WAIT();
    f32x4 O[NT][4]; float m[NT], l[NT], invl[NT];
    {
        KvBf16 kv{WSP(bf16, SAMPLE ? WS_SKCMP : WS_KCMP) + (size_t)bg * 512 * 64, WSP(bf16, SAMPLE ? WS_SVCMPT : WS_VCMPT) + (size_t)bg * 64 * 512, 512};
        const int cmax = (tmax - 31) >> 4;
        const int ntile = (tmax >= 31) ? ((cmax < 510 ? cmax : 510) / 32 + 1) : 0;
#pragma unroll
        for (int nt = 0; nt < NT; ++nt) invl[nt] = 0.f;
        nsa_zero<NT>(O, m, l);
        { KvFrags fa, fb; if (ntile > 0) nsa_load<false>(kv, 0, fr, fq, fa);
#pragma unroll 1
          for (int tl = 0; tl < ntile; ++tl) { if (tl + 1 < ntile) nsa_load<false>(kv, 32 * (tl + 1), fr, fq, fb);
            nsa_core<NT, 1>(fa, 32 * tl, qrow, qnt, O, m, l, invl, slope, t, 16, 31, 1 << 30, true, imp + trow * 132, fq); fa = fb; } }
#pragma unroll
        for (int nt = 0; nt < NT; ++nt) { float lt = l[nt]; lt = x32_sum(x16_sum(lt)); invl[nt] = lt > 0.f ? 1.f / lt : 0.f; }
        { KvFrags fa, fb; if (ntile > 0) nsa_load<true>(kv, 0, fr, fq, fa);
#pragma unroll 1
          for (int tl = 0; tl < ntile; ++tl) { if (tl + 1 < ntile) nsa_load<true>(kv, 32 * (tl + 1), fr, fq, fb);
            nsa_core<NT, 2>(fa, 32 * tl, qrow, qnt, O, m, l, invl, slope, t, 16, 31, 1 << 30, true, imp + trow * 132, fq); fa = fb; } }
#pragma unroll
        for (int nt = 0; nt < NT; ++nt) { const float gc = gates[0 * 16 + hd[nt]];
#pragma unroll
            for (int dt = 0; dt < 4; ++dt) *(f32x4*)(oacc + hd[nt] * 64 + 16 * dt + 4 * fq) = O[nt][dt] * gc; }
    }
    LDS_WAIT();
    unsigned selm[4] = {0u, 0u, 0u, 0u};
    {
        const int cur = t >> 6;
        if (!SAMPLE) {
            unsigned v[32];
#pragma unroll
            for (int i = 0; i < 32; ++i) { const int j = 32 * fq + i; const bool forced = (j == 0) | (j == cur) | (j == cur - 1);
                const unsigned key = ((f2u(imp[trow * 132 + j]) & ~127u) | (unsigned)(127 - j)) + 128u;
                v[i] = (!forced && j <= cur) ? key : 0u;
                if (forced) selm[fq] |= 1u << i; }
            unsigned fw = selm[0] | selm[1] | selm[2] | selm[3];
            const unsigned w16 = __shfl_xor(fw, 16), w32 = __shfl_xor(fw, 32), w48 = __shfl_xor(fw, 48);
#pragma unroll
            for (int wd = 0; wd < 4; ++wd) selm[wd] = (fq == wd) ? fw : ((fq ^ 1) == wd) ? w16 : ((fq ^ 2) == wd) ? w32 : w48;
            const int nforced = cur >= 2 ? 3 : cur + 1;
#pragma unroll 1
            for (int rd = 0; rd < 15; ++rd) {
                unsigned mx = v[0];
#pragma unroll
                for (int i = 1; i < 32; ++i) mx = mx > v[i] ? mx : v[i];
                mx = x32_umax(x16_umax(mx));
#pragma unroll
                for (int i = 0; i < 32; ++i) v[i] = (v[i] == mx) ? 0u : v[i];
                if (mx != 0u && rd < 16 - nforced) { const int js = 127 - (int)(mx & 127u);
#pragma unroll
                    for (int wd = 0; wd < 4; ++wd) selm[wd] |= ((js >> 5) == wd) ? (1u << (js & 31)) : 0u; }
            }
        } else {
            const int li = (fr & 3) * 4 + fq;
            unsigned v[8];
#pragma unroll
            for (int i = 0; i < 8; ++i) { const int j = li * 8 + i; v[i] = (j >= 1 && j <= 126) ? (((f2u(imp[trow * 132 + j]) & ~127u) | (unsigned)(127 - j)) + 128u) : 0u; }
            selm[0] = 1u; selm[3] = 1u << 31;
#pragma unroll 1
            for (int rd = 0; rd < 13; ++rd) {
                unsigned mx = v[0];
#pragma unroll
                for (int i = 1; i < 8; ++i) mx = mx > v[i] ? mx : v[i];
                { unsigned o = dpp_u<DPP_XOR1>(mx); mx = mx > o ? mx : o; o = dpp_u<DPP_XOR2>(mx); mx = mx > o ? mx : o; mx = x32_umax(x16_umax(mx)); }
#pragma unroll
                for (int i = 0; i < 8; ++i) v[i] = (v[i] == mx) ? 0u : v[i];
                if (mx != 0u) { const int js = 127 - (int)(mx & 127u);
#pragma unroll
                    for (int wd = 0; wd < 4; ++wd) selm[wd] |= ((js >> 5) == wd) ? (1u << (js & 31)) : 0u; }
            }
        }
    }
    if (SAMPLE || !NSA_SUBUNITS) {
        nsa_zero<NT>(O, m, l);
        unsigned un[4];
#pragma unroll
        for (int wd = 0; wd < 4; ++wd) { unsigned x = selm[wd]; x |= __shfl_xor(x, 1); x |= __shfl_xor(x, 2); x |= __shfl_xor(x, 4); x |= __shfl_xor(x, 8); un[wd] = (unsigned)__builtin_amdgcn_readfirstlane((int)x); }
        KvSampleSel kvs{FIN(2) + g * 64, (const int*)FIN(6) + (SAMPLE ? (id >> 2) : 0) * NPAGES, WSP(float, WS_SNEW) + (size_t)(SAMPLE ? (id >> 2) : 0) * 2048 + g * 64, g};
        KvBf16 kvp{WSP(bf16, WS_KSEL) + (size_t)bg * PT * 64, WSP(bf16, WS_VSELT) + (size_t)bg * 64 * PT, PT};
        if (SAMPLE) {
#pragma unroll 1
        for (int wd = 0; wd < 4; ++wd) {
            unsigned mm = un[wd];
            const unsigned mine = wd == 0 ? selm[0] : wd == 1 ? selm[1] : wd == 2 ? selm[2] : selm[3];
            while (mm) {
                const int bit = __builtin_ctz(mm); mm &= mm - 1u; const int j = 32 * wd + bit;
                const bool ok = (mine >> bit) & 1u;
#pragma unroll 1
                for (int hh = 0; hh < 2; ++hh) { nsa_tile<NT, 0>(kvs, 64 * j + 32 * hh, qrow, qnt, O, m, l, invl, slope, t, 1, 0, 1 << 30, ok, imp, fr, fq); __builtin_amdgcn_sched_barrier(0); }
            }
        }
        } else {
            int wdc = 0; unsigned mmc = un[0];
            while (wdc < 3 && mmc == 0u) { ++wdc; mmc = wdc == 1 ? un[1] : wdc == 2 ? un[2] : un[3]; }
            KvFrags fa, fb; int jc = -1, hc = 0;
            if (mmc) { jc = 32 * wdc + __builtin_ctz(mmc); mmc &= mmc - 1u; nsa_load<true>(kvp, 64 * jc, fr, fq, fa); }
#pragma unroll 1
            while (jc >= 0) {
                int jn = jc, hn = hc + 1;
                if (hn == 2) { hn = 0;
                    while (wdc < 3 && mmc == 0u) { ++wdc; mmc = wdc == 1 ? un[1] : wdc == 2 ? un[2] : un[3]; }
                    if (mmc) { jn = 32 * wdc + __builtin_ctz(mmc); mmc &= mmc - 1u; } else jn = -1; }
                if (jn >= 0) nsa_load<true>(kvp, 64 * jn + 32 * hn, fr, fq, fb);
                const int wj = jc >> 5, bj = jc & 31;
                const unsigned mine = wj == 0 ? selm[0] : wj == 1 ? selm[1] : wj == 2 ? selm[2] : selm[3];
                nsa_core<NT, 0>(fa, 64 * jc + 32 * hc, qrow, qnt, O, m, l, invl, slope, t, 1, 0, 1 << 30, (mine >> bj) & 1u, imp, fq);
                fa = fb; jc = jn; hc = hn;
            }
        }
        if (SAMPLE) nsa_tile<NT, 0>(kvs, 64 * 128, qrow, qnt, O, m, l, invl, slope, t, 1, 0, 1 << 30, true, imp, fr, fq);
#pragma unroll
        for (int nt = 0; nt < NT; ++nt) { float lt = l[nt]; lt = x32_sum(x16_sum(lt)); const float sc = gates[1 * 16 + hd[nt]] / fmaxf(lt, 1e-30f);
#pragma unroll
            for (int dt = 0; dt < 4; ++dt) { f32x4* o = (f32x4*)(oacc + hd[nt] * 64 + 16 * dt + 4 * fq); *o = *o + O[nt][dt] * sc; } }
    } else {
        unsigned ms[4][4];
#pragma unroll
        for (int s = 0; s < 4; ++s)
#pragma unroll
            for (int wd = 0; wd < 4; ++wd) ms[s][wd] = __shfl(selm[wd], 4 * s + (fr >> 2));
        unsigned su[4][4], un[4];
#pragma unroll
        for (int wd = 0; wd < 4; ++wd) { un[wd] = 0u;
#pragma unroll
            for (int s = 0; s < 4; ++s) { unsigned x = ms[s][wd]; x |= __shfl_xor(x, 4); x |= __shfl_xor(x, 8); su[s][wd] = (unsigned)__builtin_amdgcn_readfirstlane((int)x); un[wd] |= su[s][wd]; } }
        const int hds = g * 4 + (fr & 3); float slp[1]; slp[0] = ex2(-0.5f * (float)(hds + 1)) * LOG2E;
        const int tb = (id & 511) * 16 + (fr >> 2);
        f32x4 Os[4][1][4]; float mS[4][1], lS[4][1]; float inv1[1] = {0.f};
#pragma unroll
        for (int s = 0; s < 4; ++s) nsa_zero<1>(Os[s], mS[s], lS[s]);
        KvBf16 kvp{WSP(bf16, WS_KSEL) + (size_t)bg * PT * 64, WSP(bf16, WS_VSELT) + (size_t)bg * 64 * PT, PT};
        int wdc = 0; unsigned mmc = un[0];
        while (wdc < 3 && mmc == 0u) { ++wdc; mmc = wdc == 1 ? un[1] : wdc == 2 ? un[2] : un[3]; }
        KvFrags fa, fb;
        int jc = -1, hc = 0;
        if (mmc) { jc = 32 * wdc + __builtin_ctz(mmc); mmc &= mmc - 1u; nsa_load<true>(kvp, 64 * jc, fr, fq, fa); }
#pragma unroll 1
        while (jc >= 0) {
            int jn = jc, hn = hc + 1;
            if (hn == 2) { hn = 0;
                while (wdc < 3 && mmc == 0u) { ++wdc; mmc = wdc == 1 ? un[1] : wdc == 2 ? un[2] : un[3]; }
                if (mmc) { jn = 32 * wdc + __builtin_ctz(mmc); mmc &= mmc - 1u; } else jn = -1; }
            if (jn >= 0) nsa_load<true>(kvp, 64 * jn + 32 * hn, fr, fq, fb);
            const int wj = jc >> 5, bj = jc & 31;
#pragma unroll
            for (int s = 0; s < 4; ++s) {
                const unsigned suw = wj == 0 ? su[s][0] : wj == 1 ? su[s][1] : wj == 2 ? su[s][2] : su[s][3];
                if ((suw >> bj) & 1u) {
                    const unsigned mw = wj == 0 ? ms[s][0] : wj == 1 ? ms[s][1] : wj == 2 ? ms[s][2] : ms[s][3];
                    nsa_core<1, 0>(fa, 64 * jc + 32 * hc, qw + (16 * s + fr) * NSA_QLD, 0, Os[s], mS[s], lS[s], inv1, slp, tb + 4 * s, 1, 0, 1 << 30, (mw >> bj) & 1u, imp, fq);
                }
            }
            fa = fb; jc = jn; hc = hn;
        }
#pragma unroll
        for (int s = 0; s < 4; ++s) { float lt = lS[s][0]; lt = x32_sum(x16_sum(lt));
            const size_t rs = (size_t)(row0 + 4 * s + (fr >> 2));
            const float sc = WSP(float, WS_GATES)[rs * 48 + 16 + hds] / fmaxf(lt, 1e-30f);
#pragma unroll
            for (int dt = 0; dt < 4; ++dt) { f32x4* o = (f32x4*)(WSP(float, WS_OACC) + rs * 1024 + hds * 64 + 16 * dt + 4 * fq); *o = *o + Os[s][0][dt] * sc; } }
    }
    {
        nsa_zero<NT>(O, m, l);
        KvBf16 kv = SAMPLE ? KvBf16{WSP(bf16, WS_SKWIN) + (size_t)bg * 544 * 64, WSP(bf16, WS_SVWINT) + (size_t)bg * 64 * 544, 544}
                           : KvBf16{WSP(bf16, WS_KWIN) + (size_t)bg * PT * 64, WSP(bf16, WS_VWINT) + (size_t)bg * 64 * PT, PT};
        int k0, k1, padd;
        if (SAMPLE) { k0 = 0; k1 = 544; padd = PAST - WINDOW; }
        else { const int lo = tmax - 15 - (WINDOW - 1); k0 = (lo > 0 ? lo : 0) & ~31; k1 = tmax + 1; padd = 0; }
        { KvFrags fa, fb; nsa_load<true>(kv, k0, fr, fq, fa);
#pragma unroll 1
          for (int kk = k0; kk < k1; kk += 32) { if (kk + 32 < k1) nsa_load<true>(kv, kk + 32, fr, fq, fb);
            nsa_core<NT, 0>(fa, kk, qrow, qnt, O, m, l, invl, slope, t, 1, padd, WINDOW, true, imp, fq); fa = fb; } }
        bf16* on = WSP(bf16, WS_OG) + (size_t)row * 1024;
#pragma unroll
        for (int nt = 0; nt < NT; ++nt) { float lt = l[nt]; lt = x32_sum(x16_sum(lt)); const float sc = gates[2 * 16 + hd[nt]] / fmaxf(lt, 1e-30f);
#pragma unroll
            for (int dt = 0; dt < 4; ++dt) { const f32x4 o = *(const f32x4*)(oacc + hd[nt] * 64 + 16 * dt + 4 * fq) + O[nt][dt] * sc;
                *(v2u*)(on + hd[nt] * 64 + 16 * dt + 4 * fq) = (v2u){pk2(o[0], o[1]), pk2(o[2], o[3])}; } }
    }
}

constexpr int NW_STG = 67584;
constexpr int NW_STG_BYTES = 18432;
constexpr int NW_UN = NW_STG + 2 * NW_STG_BYTES;
struct NwStage { v4u k, v; };
__device__ __forceinline__ void nw_load(const bf16* K, const bf16* VT, int ld, int key0, int tid, NwStage& s) {
    s.k = *(const v4u*)(K + (size_t)(key0 + (tid >> 3)) * 64 + 8 * (tid & 7));
    s.v = *(const v4u*)(VT + (size_t)(tid >> 3) * ld + key0 + 8 * (tid & 7));
}
__device__ __forceinline__ void nw_store(LAS unsigned char* buf, int tid, const NwStage& s) {
    const int kk = tid >> 3, c8 = tid & 7, k32 = kk & 31;
    const int rho = 32 * (kk >> 5) + 16 * ((k32 >> 2) & 1) + 4 * (k32 >> 3) + (k32 & 3);
    *(LAS v4u*)(buf + rho * 144 + c8 * 16) = s.k;
    *(LAS v4u*)(buf + 9216 + kk * 144 + c8 * 16) = s.v;
}
template <bool WITHV>
__device__ __forceinline__ void nw_frags(const LAS unsigned char* buf, int th, int fr, int fq, KvFrags& f) {
#pragma unroll
    for (int mt = 0; mt < 2; ++mt)
#pragma unroll
        for (int ks = 0; ks < 2; ++ks) f.k[mt][ks] = *(const LAS bf16x8*)(buf + (32 * th + 16 * mt + fr) * 144 + (32 * ks + 8 * fq) * 2);
    if (WITHV) {
#pragma unroll
        for (int dt = 0; dt < 4; ++dt) f.v[dt] = *(const LAS bf16x8*)(buf + 9216 + (16 * dt + fr) * 144 + (32 * th + 8 * fq) * 2);
    }
}
#define NW_PIPE(Kp, VTp, ldv, NB, BLK, BODY) do { const int nb_ = (NB); \
        if (nb_ > 0) { NwStage st_; nw_load(Kp, VTp, ldv, BLK(0), F.tid, st_); nw_store(stg, F.tid, st_); } \
        __syncthreads(); \
        _Pragma("unroll 1") for (int ib_ = 0; ib_ < nb_; ++ib_) { \
            NwStage st_; const bool more_ = ib_ + 1 < nb_; if (more_) nw_load(Kp, VTp, ldv, BLK(ib_ + 1), F.tid, st_); \
            const LAS unsigned char* buf_ = stg + (ib_ & 1) * NW_STG_BYTES; const int key0_ = BLK(ib_); \
            BODY(buf_, key0_) \
            if (more_) nw_store(stg + ((ib_ + 1) & 1) * NW_STG_BYTES, F.tid, st_); \
            __syncthreads(); } } while (0)

__device__ __forceinline__ void nsa_wg(Frame& F, int bg, int qb) {
    int lane_ = F.lane; asm volatile("" : "+v"(lane_));
    const int lane = lane_, fr = lane & 15, fq = lane >> 4, w = F.wave, g = bg & 3;
    LAS unsigned char* L = F.lds; asm volatile("" : "+v"(L));
    LAS float* imp = (LAS float*)(L + NSA_IMP + w * 8448);
    LAS unsigned char* stg = L + NW_STG;
    LAS unsigned* wun = (LAS unsigned*)(L + NW_UN); volatile LAS unsigned char* blist = (volatile LAS unsigned char*)(L + NW_UN + 16);
    const int tt = qb * 8 + w, t = 16 * tt + fr, row0 = (bg >> 2) * PT + 16 * tt, row = row0 + fr, tw0 = 16 * tt, tw1 = tw0 + 15;
    float slope[4]; bf16x8 qreg[8];
#pragma unroll
    for (int nt = 0; nt < 4; ++nt) { slope[nt] = ex2(-0.5f * (float)(g * 4 + nt + 1)) * LOG2E;
        const bf16* qp = WSP(bf16, WS_QN) + (size_t)row * 1024 + (g * 4 + nt) * 64 + 8 * fq; qreg[2 * nt] = ld8(qp); qreg[2 * nt + 1] = ld8(qp + 32); }
    const float* gates = WSP(float, WS_GATES) + (size_t)row * 48;
    float* oacc = WSP(float, WS_OACC) + (size_t)row * 1024;
    for (int i = lane; i < 16 * 132; i += 64) imp[i] = 0.f;
    if (F.tid < 4) wun[F.tid] = 0u;
    f32x4 O[4][4]; float m[4], l[4], invl[4];
    {
        const bf16* Kc = WSP(bf16, WS_KCMP) + (size_t)bg * 512 * 64; const bf16* Vc = WSP(bf16, WS_VCMPT) + (size_t)bg * 64 * 512;
        const int cmax = (128 * qb + 127 - 31) >> 4, ncb = (cmax < 510 ? cmax : 510) / 64 + 1;
#pragma unroll
        for (int nt = 0; nt < 4; ++nt) invl[nt] = 0.f;
        nsa_zero<4>(O, m, l);
#define NW_BLK(i) (64 * (i))
#define NW_CMP1(buf, k0) { _Pragma("unroll 1") for (int th = 0; th < 2; ++th) if (16 * ((k0) + 32 * th) + 31 <= tw1) { KvFrags f; nw_frags<false>(buf, th, fr, fq, f); \
            nsa_core<4, 1, true>(f, (k0) + 32 * th, nullptr, 0, O, m, l, invl, slope, t, 16, 31, 1 << 30, true, imp + fr * 132, fq, qreg); } }
        NW_PIPE(Kc, Vc, 512, ncb, NW_BLK, NW_CMP1);
#pragma unroll
        for (int nt = 0; nt < 4; ++nt) { const float lt = x32_sum(x16_sum(l[nt])); invl[nt] = lt > 0.f ? 1.f / lt : 0.f; }
#define NW_CMP2(buf, k0) { _Pragma("unroll 1") for (int th = 0; th < 2; ++th) if (16 * ((k0) + 32 * th) + 31 <= tw1) { KvFrags f; nw_frags<true>(buf, th, fr, fq, f); \
            nsa_core<4, 2, true>(f, (k0) + 32 * th, nullptr, 0, O, m, l, invl, slope, t, 16, 31, 1 << 30, true, imp + fr * 132, fq, qreg); } }
        NW_PIPE(Kc, Vc, 512, ncb, NW_BLK, NW_CMP2);
#pragma unroll
        for (int nt = 0; nt < 4; ++nt) { const float gc = gates[0 * 16 + g * 4 + nt];
#pragma unroll
            for (int dt = 0; dt < 4; ++dt) *(f32x4*)(oacc + (g * 4 + nt) * 64 + 16 * dt + 4 * fq) = O[nt][dt] * gc; }
    }
    LDS_WAIT();
    unsigned selm[4] = {0u, 0u, 0u, 0u};
    {
        const int cur = t >> 6;
        unsigned v[32];
#pragma unroll
        for (int i = 0; i < 32; ++i) { const int j = 32 * fq + i; const bool forced = (j == 0) | (j == cur) | (j == cur - 1);
            const unsigned key = ((f2u(imp[fr * 132 + j]) & ~127u) | (unsigned)(127 - j)) + 128u;
            v[i] = (!forced && j <= cur) ? key : 0u;
            if (forced) selm[fq] |= 1u << i; }
        unsigned fw = selm[0] | selm[1] | selm[2] | selm[3];
        const unsigned w16 = __shfl_xor(fw, 16), w32 = __shfl_xor(fw, 32), w48 = __shfl_xor(fw, 48);
#pragma unroll
        for (int wd = 0; wd < 4; ++wd) selm[wd] = (fq == wd) ? fw : ((fq ^ 1) == wd) ? w16 : ((fq ^ 2) == wd) ? w32 : w48;
        const int nforced = cur >= 2 ? 3 : cur + 1;
#pragma unroll 1
        for (int rd = 0; rd < 15; ++rd) {
            unsigned mx = v[0];
#pragma unroll
            for (int i = 1; i < 32; ++i) mx = mx > v[i] ? mx : v[i];
            mx = x32_umax(x16_umax(mx));
#pragma unroll
            for (int i = 0; i < 32; ++i) v[i] = (v[i] == mx) ? 0u : v[i];
            if (mx != 0u && rd < 16 - nforced) { const int js = 127 - (int)(mx & 127u);
#pragma unroll
                for (int wd = 0; wd < 4; ++wd) selm[wd] |= ((js >> 5) == wd) ? (1u << (js & 31)) : 0u; }
        }
    }
    unsigned un[4];
#pragma unroll
    for (int wd = 0; wd < 4; ++wd) { unsigned x = selm[wd]; x |= dpp_u<DPP_XOR1>(x); x |= dpp_u<DPP_XOR2>(x); x |= dpp_u<DPP_HMIR>(x); x |= dpp_u<DPP_MIR>(x); un[wd] = (unsigned)__builtin_amdgcn_readfirstlane((int)x); }
    if (lane < 4) __hip_atomic_fetch_or(wun + lane, lane == 0 ? un[0] : lane == 1 ? un[1] : lane == 2 ? un[2] : un[3], __ATOMIC_RELAXED, __HIP_MEMORY_SCOPE_WORKGROUP);
    __syncthreads();
    unsigned wu[4];
#pragma unroll
    for (int wd = 0; wd < 4; ++wd) wu[wd] = (unsigned)__builtin_amdgcn_readfirstlane((int)wun[wd]);
    {
        nsa_zero<4>(O, m, l);
        const bf16* Ks = WSP(bf16, WS_KSEL) + (size_t)bg * PT * 64; const bf16* Vs = WSP(bf16, WS_VSELT) + (size_t)bg * 64 * PT;
        const int nsb = __builtin_popcount(wu[0]) + __builtin_popcount(wu[1]) + __builtin_popcount(wu[2]) + __builtin_popcount(wu[3]);
        if (F.tid < 128) { const int j = F.tid, wj = j >> 5, bj = j & 31; const unsigned ww = wj == 0 ? wu[0] : wj == 1 ? wu[1] : wj == 2 ? wu[2] : wu[3];
            if ((ww >> bj) & 1u) { int pos = __builtin_popcount(ww & ((1u << bj) - 1u)); if (wj > 0) pos += __builtin_popcount(wu[0]); if (wj > 1) pos += __builtin_popcount(wu[1]); if (wj > 2) pos += __builtin_popcount(wu[2]);
                blist[pos] = (unsigned char)j; } }
        __syncthreads();
#define NW_SBLK(i) (64 * (int)blist[(i)])
#define NW_SEL(buf, k0) { const int j_ = (k0) >> 6, wj_ = j_ >> 5, bj_ = j_ & 31; const unsigned uw_ = wj_ == 0 ? un[0] : wj_ == 1 ? un[1] : wj_ == 2 ? un[2] : un[3]; \
            if ((uw_ >> bj_) & 1u) { const unsigned mine_ = wj_ == 0 ? selm[0] : wj_ == 1 ? selm[1] : wj_ == 2 ? selm[2] : selm[3]; const bool ok_ = (mine_ >> bj_) & 1u; \
                _Pragma("unroll 1") for (int th = 0; th < 2; ++th) { KvFrags f; nw_frags<true>(buf, th, fr, fq, f); \
                    nsa_core<4, 0, true>(f, (k0) + 32 * th, nullptr, 0, O, m, l, invl, slope, t, 1, 0, 1 << 30, ok_, imp, fq, qreg); } } }
        NW_PIPE(Ks, Vs, PT, nsb, NW_SBLK, NW_SEL);
#pragma unroll
        for (int nt = 0; nt < 4; ++nt) { const float lt = x32_sum(x16_sum(l[nt])); const float sc = gates[1 * 16 + g * 4 + nt] / fmaxf(lt, 1e-30f);
#pragma unroll
            for (int dt = 0; dt < 4; ++dt) { f32x4* o = (f32x4*)(oacc + (g * 4 + nt) * 64 + 16 * dt + 4 * fq); *o = *o + O[nt][dt] * sc; } }
    }
    {
        nsa_zero<4>(O, m, l);
        const bf16* Kw = WSP(bf16, WS_KWIN) + (size_t)bg * PT * 64; const bf16* Vw = WSP(bf16, WS_VWINT) + (size_t)bg * 64 * PT;
        const int lo = 128 * qb - (WINDOW - 1), kb0 = (lo > 0 ? lo : 0) >> 6, kb1 = (128 * qb + 127) >> 6, nwb = kb1 - kb0 + 1;
#define NW_WBLK(i) (64 * (kb0 + (i)))
#define NW_WIN(buf, k0) { _Pragma("unroll 1") for (int th = 0; th < 2; ++th) { const int kk_ = (k0) + 32 * th; if (kk_ <= tw1 && kk_ + 31 >= tw0 - (WINDOW - 1)) { KvFrags f; nw_frags<true>(buf, th, fr, fq, f); \
                nsa_core<4, 0, true>(f, kk_, nullptr, 0, O, m, l, invl, slope, t, 1, 0, WINDOW, true, imp, fq, qreg); } } }
        NW_PIPE(Kw, Vw, PT, nwb, NW_WBLK, NW_WIN);
        bf16* on = WSP(bf16, WS_OG) + (size_t)row * 1024;
#pragma unroll
        for (int nt = 0; nt < 4; ++nt) { const float lt = x32_sum(x16_sum(l[nt])); const float sc = gates[2 * 16 + g * 4 + nt] / fmaxf(lt, 1e-30f);
#pragma unroll
            for (int dt = 0; dt < 4; ++dt) { const f32x4 o = *(const f32x4*)(oacc + (g * 4 + nt) * 64 + 16 * dt + 4 * fq) + O[nt][dt] * sc;
                *(v2u*)(on + (g * 4 + nt) * 64 + 16 * dt + 4 * fq) = (v2u){pk2(o[0], o[1]), pk2(o[2], o[3])}; } }
    }
    __syncthreads();
}

constexpr int SW_Q = 0;
constexpr int SW_IMPP = 2304;
constexpr int SW_IMPT = SW_IMPP + 8 * 2112;
constexpr int SW_LP = SW_IMPT + 2112;
constexpr int SW_OP = SW_LP + 3 * 8 * 16 * 4;
static_assert(SW_OP + 8 * 3 * 16 * 64 * 4 <= RING_BYTES, "sample NSA LDS map");
__device__ __forceinline__ void nsa_sample_wg(Frame& F, int id) {
    int lane_ = F.lane; asm volatile("" : "+v"(lane_));
    const int lane = lane_, fr = lane & 15, fq = lane >> 4, w = F.wave, g = id & 3, bs = id >> 2;
    LAS unsigned char* L = F.lds; asm volatile("" : "+v"(L));
    LAS bf16* qw = (LAS bf16*)(L + SW_Q);
    LAS float* impP = (LAS float*)(L + SW_IMPP) + w * 528; LAS float* impT = (LAS float*)(L + SW_IMPT);
    LAS float* LP = (LAS float*)(L + SW_LP); LAS float* OP = (LAS float*)(L + SW_OP);
    const int t = PAST + (fr >> 2), row0 = MP + bs * 4, trow = fr >> 2, hd = g * 4 + (fr & 3);
    if (F.tid < 128) { const int rr = F.tid >> 3, c8 = F.tid & 7;
        *(LAS v4u*)(qw + rr * NSA_QLD + 8 * c8) = *(const v4u*)(WSP(bf16, WS_QN) + (size_t)(row0 + (rr >> 2)) * 1024 + (g * 4 + (rr & 3)) * 64 + 8 * c8); }
    for (int i = lane; i < 528; i += 64) impP[i] = 0.f;
    __syncthreads();
    float slope[1] = {ex2(-0.5f * (float)(hd + 1)) * LOG2E};
    const LAS bf16* qrow = qw + fr * NSA_QLD;
    f32x4 O[1][4]; float m[1], l[1], invl[1] = {0.f};
#define SW_PUT_O(br) { _Pragma("unroll") for (int dt = 0; dt < 4; ++dt) *(LAS f32x4*)(OP + ((w * 3 + (br)) * 16 + fr) * 64 + 16 * dt + 4 * fq) = O[0][dt]; }
#define SW_PUT_L(br) { const float lt_ = x32_sum(x16_sum(l[0])); if (fq == 0) LP[((br) * 8 + w) * 16 + fr] = lt_; }
    {
        KvBf16 kv{WSP(bf16, WS_SKCMP) + (size_t)id * 512 * 64, WSP(bf16, WS_SVCMPT) + (size_t)id * 64 * 512, 512};
        nsa_zero<1>(O, m, l);
#pragma unroll 1
        for (int tl = w; tl < 16; tl += 8) nsa_tile<1, 1>(kv, 32 * tl, qrow, 0, O, m, l, invl, slope, t, 16, 31, 1 << 30, true, impP + trow * 132, fr, fq);
        SW_PUT_L(0)
        __syncthreads();
        { float lt = 0.f;
#pragma unroll
          for (int ww = 0; ww < 8; ++ww) lt += LP[(0 * 8 + ww) * 16 + fr];
          invl[0] = lt > 0.f ? 1.f / lt : 0.f; }
#pragma unroll 1
        for (int tl = w; tl < 16; tl += 8) nsa_tile<1, 2>(kv, 32 * tl, qrow, 0, O, m, l, invl, slope, t, 16, 31, 1 << 30, true, impP + trow * 132, fr, fq);
        SW_PUT_O(0)
    }
    __syncthreads();
    for (int i = F.tid; i < 528; i += 512) { float s = 0.f;
#pragma unroll
        for (int ww = 0; ww < 8; ++ww) s += ((LAS float*)(L + SW_IMPP))[ww * 528 + i];
        impT[i] = s; }
    __syncthreads();
    unsigned selm[4] = {1u, 0u, 0u, 1u << 31};
    {
        const int li = (fr & 3) * 4 + fq;
        unsigned v[8];
#pragma unroll
        for (int i = 0; i < 8; ++i) { const int j = li * 8 + i; v[i] = (j >= 1 && j <= 126) ? (((f2u(impT[trow * 132 + j]) & ~127u) | (unsigned)(127 - j)) + 128u) : 0u; }
#pragma unroll 1
        for (int rd = 0; rd < 13; ++rd) {
            unsigned mx = v[0];
#pragma unroll
            for (int i = 1; i < 8; ++i) mx = mx > v[i] ? mx : v[i];
            { unsigned o = dpp_u<DPP_XOR1>(mx); mx = mx > o ? mx : o; o = dpp_u<DPP_XOR2>(mx); mx = mx > o ? mx : o; mx = x32_umax(x16_umax(mx)); }
#pragma unroll
            for (int i = 0; i < 8; ++i) v[i] = (v[i] == mx) ? 0u : v[i];
            if (mx != 0u) { const int js = 127 - (int)(mx & 127u);
#pragma unroll
                for (int wd = 0; wd < 4; ++wd) selm[wd] |= ((js >> 5) == wd) ? (1u << (js & 31)) : 0u; }
        }
    }
    {
        nsa_zero<1>(O, m, l);
        unsigned un[4];
#pragma unroll
        for (int wd = 0; wd < 4; ++wd) { unsigned x = selm[wd]; x |= dpp_u<DPP_XOR1>(x); x |= dpp_u<DPP_XOR2>(x); x |= dpp_u<DPP_HMIR>(x); x |= dpp_u<DPP_MIR>(x); un[wd] = (unsigned)__builtin_amdgcn_readfirstlane((int)x); }
        KvSampleSel kvs{FIN(2) + g * 64, (const int*)FIN(6) + bs * NPAGES, WSP(float, WS_SNEW) + (size_t)bs * 2048 + g * 64, g};
        int q = 0;
#pragma unroll 1
        for (int wd = 0; wd < 4; ++wd) {
            unsigned mm = un[wd];
            const unsigned mine = wd == 0 ? selm[0] : wd == 1 ? selm[1] : wd == 2 ? selm[2] : selm[3];
            while (mm) {
                const int bit = __builtin_ctz(mm); mm &= mm - 1u; const int j = 32 * wd + bit;
                const bool ok = (mine >> bit) & 1u;
#pragma unroll 1
                for (int hh = 0; hh < 2; ++hh, ++q) if ((q & 7) == w) { nsa_tile<1, 0>(kvs, 64 * j + 32 * hh, qrow, 0, O, m, l, invl, slope, t, 1, 0, 1 << 30, ok, impP, fr, fq); __builtin_amdgcn_sched_barrier(0); }
            }
        }
        if ((q & 7) == w) nsa_tile<1, 0>(kvs, 64 * 128, qrow, 0, O, m, l, invl, slope, t, 1, 0, 1 << 30, true, impP, fr, fq);
        SW_PUT_O(1) SW_PUT_L(1)
    }
    {
        nsa_zero<1>(O, m, l);
        KvBf16 kv{WSP(bf16, WS_SKWIN) + (size_t)id * 544 * 64, WSP(bf16, WS_SVWINT) + (size_t)id * 64 * 544, 544};
#pragma unroll 1
        for (int kk = 32 * w; kk < 544; kk += 256) nsa_tile<1, 0>(kv, kk, qrow, 0, O, m, l, invl, slope, t, 1, PAST - WINDOW, WINDOW, true, impP, fr, fq);
        SW_PUT_O(2) SW_PUT_L(2)
    }
    __syncthreads();
    {
        const int r = F.tid >> 5, d0 = (F.tid & 31) * 2, rowg = row0 + (r >> 2), hdr = g * 4 + (r & 3);
        float o0 = 0.f, o1 = 0.f;
#pragma unroll
        for (int br = 0; br < 3; ++br) { float a0 = 0.f, a1 = 0.f, lt = 0.f;
#pragma unroll
            for (int ww = 0; ww < 8; ++ww) { const f32x2 x = *(const LAS f32x2*)(OP + ((ww * 3 + br) * 16 + r) * 64 + d0); a0 += x.x; a1 += x.y; if (br > 0) lt += LP[(br * 8 + ww) * 16 + r]; }
            const float sc = WSP(float, WS_GATES)[(size_t)rowg * 48 + br * 16 + hdr] * (br == 0 ? 1.f : 1.f / fmaxf(lt, 1e-30f));
            o0 += a0 * sc; o1 += a1 * sc; }
        *(unsigned*)(WSP(bf16, WS_OG) + (size_t)rowg * 1024 + hdr * 64 + d0) = pk2(o0, o1);
    }
    __syncthreads();
#undef SW_PUT_O
#undef SW_PUT_L
}


#ifndef MK_SINGLE
#define MK_SINGLE 1
#endif
constexpr int NPHASE = 19;
struct Args { const float* in[29]; float* out; unsigned char* ws; int ph_lo, ph_hi; };
static_assert(sizeof(Args) == 31 * 8 + 8, "Args has no padding");

__global__ void __launch_bounds__(512, 2) mk_fwd(Args args) {
    extern __shared__ __attribute__((aligned(16))) unsigned char lds_raw[];
    Frame F;
    F.lds = (LAS unsigned char*)lds_raw;
    F.tid = threadIdx.x; F.lane = F.tid & 63; F.wave = __builtin_amdgcn_readfirstlane(F.tid >> 6);
    F.G = gridDim.x; F.bid = blockIdx.x;
    F.ka = (const __attribute__((address_space(4))) char*)__builtin_amdgcn_kernarg_segment_ptr();
    F.out = args.out; F.ws = args.ws;
    volatile LAS unsigned* MISC = (volatile LAS unsigned*)(F.lds + MISC_OFF);
    for (int u = F.tid; u < (LDS_BYTES - LDSCTL_OFF) / 4; u += 512) ((LAS unsigned*)(F.lds + LDSCTL_OFF))[u] = 0u;
    __syncthreads();
    unsigned* barw = (unsigned*)(F.ws + WS_CTL) + 4096;
    XcdBarrier bar; bar.bar = barw; bar.x = 0; bar.st = nullptr;
    const int lo = args.ph_lo, hi = args.ph_hi;
    if (hi - lo > 1) bar = xcd_barrier_post(barw, MISC + 8);
#ifndef PH_MASK
#define PH_MASK 0xFFFFFFFFu
#endif
#define IN(k) (((PH_MASK >> (k)) & 1u) && lo <= (k) && (k) < hi)
#define SEAM(k) do { if (IN(k) && IN((k) + 1)) xcd_barrier(bar); } while (0)
    const int gw = F.bid * 8 + F.wave, NGW = F.G * 8;

#ifndef REPX
#define REPX 0
#endif
#ifndef REPY
#define REPY 0
#endif
#ifndef REP_MASK
#define REP_MASK 0u
#endif
#define PHASE(k, ...) if (IN(k)) { _Pragma("unroll 1") for (int rep_ = 0; rep_ < (int)((REP_MASK >> (k)) & 1u) + 1; ++rep_) { if (rep_) xcd_barrier(bar); __VA_ARGS__ } } SEAM(k);
    PHASE(0, p0_prologue(F);)
    PHASE(1, { pg8::Gemm g{WSP(bf16, WS_CKA), WSP(bf16, WS_W1BD), 65536, 256, 2048}; pg8::StaticOrder S; S.init(65536, 256, F.G, F.bid);
               pg8::EpiFn<FnF32> E{FnF32{WSP(float, WS_FS), 256}}; pg8::gemm_phase<pg8::EpiFn<FnF32>, pg8::StaticOrder, true, true>(F.lds, g, S, E); })
    PHASE(2, gemm_all(F, WSP(bf16, WS_XNA), WSP(bf16, WS_WIN_T), 4096, FnBf16{WSP(bf16, WS_PROJ), 4096});)
    PHASE(3, for (int u = F.bid; u < 2048 + 256; u += F.G) { if (u < 2048) p2_chunk(F, u); else p2_sample(F, u - 2048); })
    PHASE(4, if (F.G == 256) { const int x = F.bid & 7, idx = F.bid >> 3; if (idx < 16) p3_scan(F, x * 2 + (idx >> 3), idx & 7);
                 else peer_tables_to_fp8(F, (size_t)(((idx - 16) * 8 + x) * 512 + F.tid), (size_t)128 * 512); }
             else { for (int u = F.bid; u < 128; u += F.G) p3_scan(F, u >> 3, u & 7); })
    PHASE(5, for (int r = gw; r < MTOK; r += NGW) p4_row(F, r);
             for (int id = gw; id < 8192; id += NGW) compress_sample(F, id);)
    PHASE(6, gemm_all(F, WSP(bf16, WS_OG), WSP(bf16, WS_WOA_T), 1024, FnResid{WSP(float, WS_XS), FIN(0), FIN(1)});)
    PHASE(7, for (int r = gw; r < MTOK; r += NGW) rms_row_to_bf16(WSP(float, WS_XS) + (size_t)r * DM, WSP(bf16, WS_XNB) + (size_t)r * DM, F.lane);)
    PHASE(8, gemm_all(F, WSP(bf16, WS_XNB), WSP(bf16, WS_WPQ_T), 2048, FnBf16{WSP(bf16, WS_QPEER), 2048});)
    PHASE(9, p8_init_tab(F); for (int u = F.bid; u < MTOK / 16; u += F.G) p8_unit(F, u, 0);)
    PHASE(10, for (int r = gw; r < MTOK; r += NGW) p9_token(F, r, 0, 0);)
    PHASE(11, gemm_all(F, WSP(bf16, WS_XNA), WSP(bf16, WS_WKVQ_T), NKVQ, FnKvq{WSP(float, WS_KVQ)});)
    PHASE(12, for (int u = F.bid; u < 256; u += F.G) pp_prompt_tile(F, u);
              if (F.G == 256) { if (F.wave == 7 && F.bid < MS) pp_sample_row(F, F.bid); if ((F.wave & 3) == 0) compress_prompt(F, F.bid * 2 + (F.wave >> 2)); }
              else { for (int r = gw; r < MS; r += NGW) pp_sample_row(F, r); for (int id = gw; id < 512; id += NGW) compress_prompt(F, id); })
    PHASE(13, if (F.G == 256) {
                  _Pragma("unroll 1") for (int q_ = 0; q_ < 1 + REPX; ++q_) { if (F.bid < 128) nsa_sample_wg(F, F.bid); }
                  __syncthreads();
                  nsa_wg(F, F.bid & 7, F.bid >> 3); nsa_wg(F, F.bid & 7, 63 - (F.bid >> 3));
              } else { for (int id = gw; id < 128 + 4096; id += NGW) { if (id < 128) nsa_unit<true>(F, id); else nsa_unit<false>(F, id - 128); } })
    PHASE(14, gemm_all(F, WSP(bf16, WS_OG), WSP(bf16, WS_WOB_T), 1024, FnResid{WSP(float, WS_XS), WSP(float, WS_XS), WSP(float, WS_XS) + (size_t)MP * DM});)
    PHASE(15, for (int r = gw; r < MTOK; r += NGW) rms_row_to_bf16(WSP(float, WS_XS) + (size_t)r * DM, WSP(bf16, WS_XNB) + (size_t)r * DM, F.lane);)
    PHASE(16, gemm_all(F, WSP(bf16, WS_XNB), WSP(bf16, WS_WPQ_T) + (size_t)2048 * 1024, 2048, FnBf16{WSP(bf16, WS_QPEER), 2048});)
    PHASE(17, p8_init_tab(F); for (int u = F.bid; u < MTOK / 16; u += F.G) p8_unit(F, u, 1);)
    PHASE(18, for (int r = gw; r < MTOK; r += NGW) p9_token(F, r, 1, 1);)
#undef IN
#undef SEAM
}

extern "C" void kernel_launch(void* const* d_in, const int* in_sizes, int n_in, void* d_out, int out_size, void* d_ws, size_t ws_size, hipStream_t stream) {
    static int grid = 0;
    if (grid == 0) {
        if (n_in != 29 || (size_t)out_size != O_END || ws_size < WS_END) { fprintf(stderr, "kernel_launch: unexpected shapes n_in %d out %d ws %zu (need %zu)\n", n_in, out_size, ws_size, (size_t)WS_END); grid = -1; return; }
        int dev = 0, cus = 0, per_cu = 0;
        if (hipGetDevice(&dev) != hipSuccess || hipDeviceGetAttribute(&cus, hipDeviceAttributeMultiprocessorCount, dev) != hipSuccess) { grid = -1; return; }
        if (hipFuncSetAttribute((const void*)mk_fwd, hipFuncAttributeMaxDynamicSharedMemorySize, LDS_BYTES) != hipSuccess) { fprintf(stderr, "kernel_launch: hipFuncSetAttribute failed\n"); grid = -1; return; }
        if (hipOccupancyMaxActiveBlocksPerMultiprocessor(&per_cu, (const void*)mk_fwd, 512, LDS_BYTES) != hipSuccess || per_cu < 1) fprintf(stderr, "kernel_launch: occupancy query reports %d\n", per_cu);
        (void)hipGetLastError();
        grid = cus;
    }
    if (grid < 0) return;
    if (hipMemsetAsync((char*)d_ws + WS_CTL, 0, CTL_BYTES, stream) != hipSuccess) return;
    Args a{};
    for (int i = 0; i < 29; ++i) a.in[i] = (const float*)d_in[i];
    a.out = (float*)d_out; a.ws = (unsigned char*)d_ws;
#if MK_SINGLE
    a.ph_lo = 0; a.ph_hi = NPHASE;
    hipLaunchKernelGGL(mk_fwd, dim3(grid), dim3(512), LDS_BYTES, stream, a);
#else
    for (int p = 0; p < NPHASE; ++p) { a.ph_lo = p; a.ph_hi = p + 1; hipLaunchKernelGGL(mk_fwd, dim3(grid), dim3(512), LDS_BYTES, stream, a); }
#endif
    const hipError_t le = hipPeekAtLastError();
    if (le != hipSuccess) fprintf(stderr, "kernel_launch: launch failed: %s\n", hipGetErrorName(le));
}
```

```cpp
#include <hip/hip_runtime.h>
#include <cstdio>
#include <cstdint>

constexpr int DM = 1024, PB = 2, PT = 8192, SB = 32, SL = 4, PAST = 8192, PAGE = 128;
constexpr int MP = PB * PT;
constexpr int MS = SB * SL;
constexpr int MTOK = MP + MS;
constexpr int GH = 8, GDK = 128, GDV = 128, GCONV = 3072, GPROJ = 4112, CHUNK = 64, NCH = PT / CHUNK;
constexpr int NH = 16, NG = 4, HPG = 4, DH = 64, NQG = 1072, NKV = 1536, NKVQ = 2816, NKVQ_REAL = 2608;
constexpr int WINDOW = 512, NSELP = 128, NSELS = 129, NCMP = 511;
constexpr int PEH = 8, PEDQ = 256, PEHALF = 128, NKEYS = 128, NEXP = 16384, PETOP = 16;
constexpr int NPAGES = PAST / PAGE;
constexpr float EPS = 1e-6f;

constexpr size_t O_YP = 0;
constexpr size_t O_YS = O_YP + (size_t)MP * DM;
constexpr size_t O_KVP = O_YS + (size_t)MS * DM;
constexpr size_t O_WINP = O_KVP + (size_t)MP * 1024;
constexpr size_t O_GDNP = O_WINP + (size_t)PB * 512 * 512;
constexpr size_t O_CONVP = O_GDNP + (size_t)PB * GH * 128 * 128;
constexpr size_t O_KVS = O_CONVP + (size_t)PB * 3 * GCONV;
constexpr size_t O_WINS = O_KVS + (size_t)MS * 1024;
constexpr size_t O_GDNS = O_WINS + (size_t)SB * 512 * 512;
constexpr size_t O_CONVS = O_GDNS + (size_t)SB * GH * 128 * 128;
constexpr size_t O_END = O_CONVS + (size_t)SB * 3 * GCONV;

constexpr size_t MiB = 1u << 20;
constexpr size_t al(size_t x) { return (x + 4095) & ~(size_t)4095; }
constexpr size_t WS_CTL = 0, CTL_BYTES = 1 * MiB;
constexpr size_t WS_WIN_T = WS_CTL + CTL_BYTES;
constexpr size_t WS_WOA_T = WS_WIN_T + (size_t)4096 * 1024 * 2;
constexpr size_t WS_WKVQ_T = WS_WOA_T + (size_t)1024 * 1024 * 2;
constexpr size_t WS_WOB_T = WS_WKVQ_T + (size_t)NKVQ * 1024 * 2;
constexpr size_t WS_WPQ_T = WS_WOB_T + (size_t)1024 * 1024 * 2;
constexpr size_t WS_WAB = WS_WPQ_T + (size_t)2 * 2048 * 1024 * 2;
constexpr size_t WS_SUBK = WS_WAB + (size_t)16 * 1024 * 4;
constexpr size_t WS_W1T = WS_SUBK + (size_t)2 * 8 * 2 * 128 * 128 * 2;
constexpr size_t WS_PETERM = WS_W1T + (size_t)2 * 128 * 1024 * 2;
constexpr size_t WS_PU = al(WS_PETERM + 512);
constexpr size_t WS_PV = WS_PU + (size_t)2 * NEXP * DM * 2;
constexpr size_t WS_XNA = WS_PV + (size_t)2 * NEXP * DM * 2;
constexpr size_t WS_XNB = al(WS_XNA + (size_t)MTOK * DM * 2);
constexpr size_t WS_PROJ = al(WS_XNB + (size_t)MTOK * DM * 2);
constexpr size_t WS_GW = al(WS_PROJ + (size_t)MTOK * 4096 * 2);
constexpr size_t WS_GQ = WS_GW + (size_t)2048 * 64 * 128 * 2;
constexpr size_t WS_GKT = WS_GQ + (size_t)2048 * 64 * 128 * 2;
constexpr size_t WS_GQK = WS_GKT + (size_t)2048 * 64 * 128 * 2;
constexpr size_t WS_GU = WS_GQK + (size_t)2048 * 64 * 64 * 2;
constexpr size_t WS_GDEC = WS_GU + (size_t)2048 * 64 * 128 * 4;
constexpr size_t WS_OGDN = al(WS_GDEC + 2048 * 4);
constexpr size_t WS_OG = al(WS_OGDN + (size_t)MTOK * DM * 4);
constexpr size_t WS_XS = al(WS_OG + (size_t)MTOK * DM * 2);
constexpr size_t WS_QPEER = al(WS_XS + (size_t)MTOK * DM * 4);
constexpr size_t WS_PEI = al(WS_QPEER + (size_t)MTOK * 2048 * 2);
constexpr size_t WS_PEG = al(WS_PEI + (size_t)MTOK * 128 * 4);
constexpr size_t WS_KVQ = al(WS_PEG + (size_t)MTOK * 128 * 4);
constexpr size_t WS_KSEL = al(WS_KVQ + (size_t)MTOK * NKVQ * 4);
constexpr size_t WS_VSELT = WS_KSEL + (size_t)PB * NG * PT * 64 * 2;
constexpr size_t WS_KWIN = WS_VSELT + (size_t)PB * NG * PT * 64 * 2;
constexpr size_t WS_VWINT = WS_KWIN + (size_t)PB * NG * PT * 64 * 2;
constexpr size_t WS_KCMP = WS_VWINT + (size_t)PB * NG * PT * 64 * 2;
constexpr size_t WS_VCMPT = WS_KCMP + (size_t)PB * NG * 512 * 64 * 2;
constexpr size_t WS_SKCMP = WS_VCMPT + (size_t)PB * NG * 512 * 64 * 2;
constexpr size_t WS_SVCMPT = WS_SKCMP + (size_t)SB * NG * 512 * 64 * 2;
constexpr size_t WS_SKWIN = WS_SVCMPT + (size_t)SB * NG * 512 * 64 * 2;
constexpr size_t WS_SVWINT = WS_SKWIN + (size_t)SB * NG * 544 * 64 * 2;
constexpr size_t WS_SNEW = WS_SVWINT + (size_t)SB * NG * 544 * 64 * 2;
constexpr size_t WS_QN = al(WS_SNEW + (size_t)SB * 4 * 2 * 4 * 64 * 4);
constexpr size_t WS_GATES = al(WS_QN + (size_t)MTOK * 1024 * 2);
constexpr size_t WS_OACC = al(WS_GATES + (size_t)MTOK * 48 * 4);
constexpr size_t WS_CKA = al(WS_OACC + (size_t)MTOK * DM * 4);
constexpr size_t WS_W1BD = al(WS_CKA + (size_t)65536 * 2048 * 2);
constexpr size_t WS_FS = al(WS_W1BD + (size_t)256 * 2048 * 2);
constexpr size_t WS_PA = al(WS_FS + (size_t)65536 * 256 * 4);
constexpr size_t WS_SSQ = al(WS_PA + (size_t)MTOK * 8 * 64 * 4);
constexpr size_t WS_END = al(WS_SSQ + (size_t)MTOK * 8 * 4);

constexpr int RING_BYTES = 143360;
constexpr int LDSCTL_OFF = RING_BYTES, MISC_OFF = LDSCTL_OFF + 320;
constexpr int LDS_BYTES = 147456;

#define GAS __attribute__((address_space(1)))
#define LAS __attribute__((address_space(3)))
typedef unsigned short bf16;
typedef unsigned v4u __attribute__((ext_vector_type(4)));
typedef unsigned v2u __attribute__((ext_vector_type(2)));
typedef float f32x4 __attribute__((ext_vector_type(4)));
typedef float f32x2 __attribute__((ext_vector_type(2)));
typedef short bf16x8 __attribute__((ext_vector_type(8)));
typedef GAS unsigned gu32;
#define RLX_AGENT __ATOMIC_RELAXED, __HIP_MEMORY_SCOPE_AGENT
#define LDS_WAIT() asm volatile("s_waitcnt lgkmcnt(0)" ::: "memory")
#define VM_WAIT() asm volatile("s_waitcnt vmcnt(0)" ::: "memory")

__device__ __forceinline__ unsigned f2bf(float f) { unsigned u = __builtin_bit_cast(unsigned, f); return (u + 0x7fffu + ((u >> 16) & 1u)) >> 16; }
typedef __bf16 hwbf16x2 __attribute__((ext_vector_type(2)));
__device__ __forceinline__ unsigned pk2(float lo, float hi) { const f32x2 v = {lo, hi}; return __builtin_bit_cast(unsigned, __builtin_convertvector(v, hwbf16x2)); }
__device__ __forceinline__ float bf2f(unsigned b) { return __builtin_bit_cast(float, b << 16); }
__device__ __forceinline__ float bflo(unsigned w) { return __builtin_bit_cast(float, w << 16); }
__device__ __forceinline__ float bfhi(unsigned w) { return __builtin_bit_cast(float, w & 0xffff0000u); }
#ifndef USE_PERMSWAP
#define USE_PERMSWAP 1
#endif
template <int CTRL> __device__ __forceinline__ float dpp_f(float x) { return __builtin_bit_cast(float, __builtin_amdgcn_update_dpp(0, __builtin_bit_cast(int, x), CTRL, 0xF, 0xF, true)); }
template <int CTRL> __device__ __forceinline__ unsigned dpp_u(unsigned x) { return (unsigned)__builtin_amdgcn_update_dpp(0, (int)x, CTRL, 0xF, 0xF, true); }
#define DPP_XOR1 0xB1
#define DPP_XOR2 0x4E
#define DPP_HMIR 0x141
#define DPP_MIR 0x140
#define DPP_ROR4 0x124
#define DPP_ROR8 0x128
#if USE_PERMSWAP
#define PSWAP16(a, b) asm volatile("s_nop 1\n\tv_permlane16_swap_b32 %0, %1" : "+v"(a), "+v"(b))
#define PSWAP32(a, b) asm volatile("s_nop 1\n\tv_permlane32_swap_b32 %0, %1" : "+v"(a), "+v"(b))
__device__ __forceinline__ float x16_sum(float x) { unsigned a = __builtin_bit_cast(unsigned, x), b = a; PSWAP16(a, b); return __builtin_bit_cast(float, a) + __builtin_bit_cast(float, b); }
__device__ __forceinline__ float x32_sum(float x) { unsigned a = __builtin_bit_cast(unsigned, x), b = a; PSWAP32(a, b); return __builtin_bit_cast(float, a) + __builtin_bit_cast(float, b); }
__device__ __forceinline__ float x16_max(float x) { unsigned a = __builtin_bit_cast(unsigned, x), b = a; PSWAP16(a, b); return fmaxf(__builtin_bit_cast(float, a), __builtin_bit_cast(float, b)); }
__device__ __forceinline__ float x32_max(float x) { unsigned a = __builtin_bit_cast(unsigned, x), b = a; PSWAP32(a, b); return fmaxf(__builtin_bit_cast(float, a), __builtin_bit_cast(float, b)); }
__device__ __forceinline__ unsigned x16_umax(unsigned u) { unsigned a = u, b = u; PSWAP16(a, b); return a > b ? a : b; }
__device__ __forceinline__ unsigned x32_umax(unsigned u) { unsigned a = u, b = u; PSWAP32(a, b); return a > b ? a : b; }
#else
__device__ __forceinline__ float x16_sum(float x) { return x + __shfl_xor(x, 16); }
__device__ __forceinline__ float x32_sum(float x) { return x + __shfl_xor(x, 32); }
__device__ __forceinline__ float x16_max(float x) { return fmaxf(x, __shfl_xor(x, 16)); }
__device__ __forceinline__ float x32_max(float x) { return fmaxf(x, __shfl_xor(x, 32)); }
__device__ __forceinline__ unsigned x16_umax(unsigned u) { const unsigned o = __shfl_xor(u, 16); return u > o ? u : o; }
__device__ __forceinline__ unsigned x32_umax(unsigned u) { const unsigned o = __shfl_xor(u, 32); return u > o ? u : o; }
#endif
__device__ __forceinline__ float row_sum16(float x) { x += dpp_f<DPP_XOR1>(x); x += dpp_f<DPP_XOR2>(x); x += dpp_f<DPP_HMIR>(x); x += dpp_f<DPP_MIR>(x); return x; }
__device__ __forceinline__ float wave_sum(float v) { return x32_sum(x16_sum(row_sum16(v))); }
__device__ __forceinline__ float silu_f(float x) { return x / (1.f + __expf(-x)); }
__device__ __forceinline__ float sigmoid_f(float x) { return 1.f / (1.f + __expf(-x)); }
__device__ __forceinline__ float gelu_tanh(float x) {
    const float u = 0.7978845608028654f * (x + 0.044715f * x * x * x);
    const float e = __expf(2.f * u);
    const float th = 1.f - 2.f / (e + 1.f);
    return 0.5f * x * (1.f + th);
}
__device__ __forceinline__ bf16x8 ld8(const bf16* p) { return *(const bf16x8*)p; }
__device__ __forceinline__ bf16x8 ld8l(const LAS bf16* p) { return *(const LAS bf16x8*)p; }
#define MFMA16(a, b, c) __builtin_amdgcn_mfma_f32_16x16x32_bf16((a), (b), (c), 0, 0, 0)
__device__ __forceinline__ bf16x8 cvt8(f32x4 a, f32x4 b) {
    v4u r; r.x = pk2(a.x, a.y); r.y = pk2(a.z, a.w); r.z = pk2(b.x, b.y); r.w = pk2(b.z, b.w); return __builtin_bit_cast(bf16x8, r);
}

struct Frame {
    LAS unsigned char* lds;
    int tid, lane, wave, G, bid;
    const __attribute__((address_space(4))) char* ka;
    float* out;
    unsigned char* ws;
};
#define WSP(T, off) ((T*)(F.ws + (off)))
__device__ __forceinline__ const float* fin_(const __attribute__((address_space(4))) char* ka, int i) {
    const __attribute__((address_space(4))) char* p = ka; asm volatile("" : "+s"(p));
    return *(const float* const __attribute__((address_space(4)))*)(p + 8 * i);
}
#define FIN(i) fin_(F.ka, (i))
namespace pg8 {
#define PG8_LAS __attribute__((address_space(3)))
typedef unsigned short bf16_t;
typedef short bf16x8 __attribute__((ext_vector_type(8)));
typedef float f32x4 __attribute__((ext_vector_type(4)));
typedef unsigned u32x4 __attribute__((ext_vector_type(4)));
constexpr int BM = 256, BK = 64, HALF = 128, HTB = HALF * BK * 2  , STAGE_BYTES = 8 * HTB, NXCD = 8, WGM = 8;

__host__ __device__ __forceinline__ int lds_byte(int r, int c) { const int st = (r >> 4) * 2 + (c >> 5), rr = r & 15, cc = c & 31, ob = rr * 64 + cc * 2; return st * 1024 + (ob ^ (((ob >> 9) & 1) << 5)); }
__host__ __device__ __forceinline__ void stage_rc(int b, int& R, int& C) { const int st = b / 1024, sb = b % 1024, swz = sb ^ (((sb >> 9) & 1) << 5); R = (st >> 1) * 16 + swz / 64; C = (st & 1) * 32 + (swz % 64) / 2; }
__host__ __device__ __forceinline__ int perm32(int rho) { const int n = rho >> 4, i = rho & 15; return 8 * (i >> 2) + 4 * n + (i & 3); }

struct Unit { int pm, pn; };
struct Gemm { const bf16_t* A; const bf16_t* Bt; int M, N, K; };

struct StaticOrder {
    int nM, nN, nwg, G, c;
    __host__ __device__ void init(int M, int N, int G_, int c_) { nM = M / BM; nN = N / BM; nwg = nM * nN; G = G_; c = c_; }
    __host__ __device__ bool next(int i, Unit& u) const {
        const long L = (long)i * G + c; if (L >= nwg) return false;
        int wgid = (int)L; { const int q = nwg / NXCD, r = nwg % NXCD, xcd = wgid % NXCD, off = wgid / NXCD; wgid = (xcd < r ? xcd * (q + 1) : r * (q + 1) + (xcd - r) * q) + off; }
        const int nig = WGM * nN, gid = wgid / nig, fm = gid * WGM, gsz = (nM - fm) < WGM ? (nM - fm) : WGM;
        u.pm = fm + ((wgid % nig) % gsz); u.pn = (wgid % nig) / gsz; return true;
    }
    __device__ __forceinline__ void a_ready(const Unit&) const {}
    __device__ __forceinline__ void done(const Unit&) const {}
};
template <class Epi, class Sched, bool ALIGN_EPI = false, bool SP2 = false>
__device__ __forceinline__ void gemm_phase(PG8_LAS unsigned char* lds, const Gemm g, const Sched& S, const Epi& E) {
    const int tid = threadIdx.x, wid = __builtin_amdgcn_readfirstlane(tid >> 6), lane = tid & 63, wr = wid >> 2, wc = wid & 3, fr = lane & 15, fq = lane >> 4;
    const int K = g.K, nt = K / BK;
    unsigned voffA[2], voffB[2];
#pragma unroll
    for (int i = 0; i < 2; ++i) { int R, C; stage_rc(tid * 16 + i * 8192, R, C); const int Rb = Epi::PERM ? ((R & ~31) + perm32(R & 31)) : R;
        voffA[i] = (unsigned)(R * K + C) * 2u; voffB[i] = (unsigned)(Rb * K + C) * 2u; }
    const size_t kstep = (size_t)(BK * 2);
    const size_t hstep = (size_t)HALF * K * 2;
    const size_t tstep = 2 * hstep;
    const unsigned ldsw = (unsigned)wid * 1024u;
    const int aoff = lds_byte(wr * 64 + fr, fq * 8), boff = lds_byte(wc * 32 + fr, fq * 8);
#define PG8_SA(b, h) (((b) * 2 + (h)) * HTB)
#define PG8_SB(b, h) ((4 + (b) * 2 + (h)) * HTB)
#define PG8_STAGE(bufoff, gbase, voff) do { _Pragma("unroll") for (int _i = 0; _i < 2; ++_i) \
        __builtin_amdgcn_global_load_lds((const unsigned*)((const char*)(gbase) + (voff)[_i]), (PG8_LAS unsigned*)(lds + (bufoff) + ldsw + _i * 8192), 16, 0, 0); } while (0)
#define PG8_LDA(dst, b, h) do { _Pragma("unroll") for (int m = 0; m < 4; ++m) _Pragma("unroll") for (int k = 0; k < 2; ++k) dst[m][k] = *(const PG8_LAS bf16x8*)(lds + PG8_SA(b, h) + aoff + m * 2048 + k * 1024); } while (0)
#define PG8_LDB(dst, b, h) do { _Pragma("unroll") for (int n = 0; n < 2; ++n) _Pragma("unroll") for (int k = 0; k < 2; ++k) dst[n][k] = *(const PG8_LAS bf16x8*)(lds + PG8_SB(b, h) + boff + n * 2048 + k * 1024); } while (0)
#define PG8_MMA(ai, bj, At, Bt) do { __builtin_amdgcn_s_setprio(1); _Pragma("unroll") for (int m = 0; m < 4; ++m) _Pragma("unroll") for (int n = 0; n < 2; ++n) _Pragma("unroll") for (int k = 0; k < 2; ++k) \
        acc[ai][bj][m][n] = __builtin_amdgcn_mfma_f32_16x16x32_bf16(Bt[n][k], At[m][k], acc[ai][bj][m][n], 0, 0, 0); __builtin_amdgcn_s_setprio(0); } while (0)
#define PG8_WAIT_V(n) asm volatile("s_waitcnt vmcnt(" #n ")" ::: "memory")
#define PG8_WAIT_L(n) asm volatile("s_waitcnt lgkmcnt(" #n ")" ::: "memory")
#define PG8_BAR __builtin_amdgcn_s_barrier()
#define PG8_SCHED __builtin_amdgcn_sched_barrier(0)
    Unit cur, nxt; int ui = 0;
    if (!S.next(0, cur)) return;
    f32x4 acc[2][2][4][2];
#pragma unroll
    for (int a = 0; a < 2; ++a)
#pragma unroll
        for (int b = 0; b < 2; ++b)
#pragma unroll
            for (int m = 0; m < 4; ++m)
#pragma unroll
                for (int n = 0; n < 2; ++n) acc[a][b][m][n] = (f32x4){0.f, 0.f, 0.f, 0.f};
    bf16x8 At[4][2], B0[2][2], B1[2][2];
    const char* cA = (const char*)g.A + (size_t)cur.pm * tstep; const char* cB = (const char*)g.Bt + (size_t)cur.pn * tstep;
    S.a_ready(cur);
    if constexpr (SP2) {
        PG8_STAGE(PG8_SB(0, 0), cB, voffB); PG8_STAGE(PG8_SB(0, 1), cB + hstep, voffB); PG8_STAGE(PG8_SA(0, 0), cA, voffA); PG8_STAGE(PG8_SA(0, 1), cA + hstep, voffA);
        if (wr == 1) PG8_BAR;
        PG8_WAIT_V(2); PG8_BAR;
        PG8_STAGE(PG8_SB(1, 0), cB + kstep, voffB); PG8_STAGE(PG8_SA(1, 0), cA + kstep, voffA); PG8_STAGE(PG8_SB(1, 1), cB + hstep + kstep, voffB);
        PG8_WAIT_V(6); PG8_BAR;
    } else {
        PG8_STAGE(PG8_SB(0, 0), cB, voffB); PG8_STAGE(PG8_SA(0, 0), cA, voffA); PG8_STAGE(PG8_SB(0, 1), cB + hstep, voffB); PG8_STAGE(PG8_SA(0, 1), cA + hstep, voffA);
        if (wr == 1) PG8_BAR;
        PG8_WAIT_V(4); PG8_BAR;
        PG8_STAGE(PG8_SB(1, 0), cB + kstep, voffB); PG8_STAGE(PG8_SA(1, 0), cA + kstep, voffA); PG8_STAGE(PG8_SB(1, 1), cB + hstep + kstep, voffB);
        PG8_WAIT_V(6); PG8_BAR;
    }
    for (;;) {
        const bool has_next = S.next(ui + 1, nxt);
        const char* nA = has_next ? (const char*)g.A + (size_t)nxt.pm * tstep : cA; const char* nB = has_next ? (const char*)g.Bt + (size_t)nxt.pn * tstep : cB;
        for (int t = 0; t < nt; t += 2) {
            const bool last = (t == nt - 2);
            const char* a1 = cA + (size_t)(t + 1) * kstep;
            const char* a2 = last ? nA : cA + (size_t)(t + 2) * kstep; const char* b2 = last ? nB : cB + (size_t)(t + 2) * kstep;
            const char* a3 = a2 + kstep; const char* b3 = b2 + kstep;
            if (last && has_next) S.a_ready(nxt);
            if constexpr (SP2) {
            PG8_LDB(B0, 0, 0); PG8_LDB(B1, 0, 1); PG8_SCHED; PG8_LDA(At, 0, 0); PG8_STAGE(PG8_SA(1, 1), a1 + hstep, voffA);
            PG8_WAIT_V(8); PG8_WAIT_L(0); PG8_BAR; PG8_MMA(0, 0, At, B0); PG8_MMA(0, 1, At, B1); PG8_BAR; PG8_SCHED;
            PG8_LDA(At, 0, 1); PG8_STAGE(PG8_SB(0, 0), b2, voffB); PG8_STAGE(PG8_SB(0, 1), b2 + hstep, voffB); PG8_STAGE(PG8_SA(0, 0), a2, voffA);
            PG8_WAIT_V(8); PG8_WAIT_L(0); PG8_BAR; PG8_MMA(1, 0, At, B0); PG8_MMA(1, 1, At, B1); PG8_BAR; PG8_SCHED;
            PG8_LDB(B0, 1, 0); PG8_LDB(B1, 1, 1); PG8_SCHED; PG8_LDA(At, 1, 0); PG8_STAGE(PG8_SA(0, 1), a2 + hstep, voffA);
            PG8_WAIT_V(8); PG8_WAIT_L(0); PG8_BAR; PG8_MMA(0, 0, At, B0); PG8_MMA(0, 1, At, B1); PG8_BAR; PG8_SCHED;
            PG8_LDA(At, 1, 1); PG8_STAGE(PG8_SB(1, 0), b3, voffB); PG8_STAGE(PG8_SB(1, 1), b3 + hstep, voffB); PG8_STAGE(PG8_SA(1, 0), a3, voffA);
            PG8_WAIT_V(8); PG8_WAIT_L(0); PG8_BAR; PG8_MMA(1, 0, At, B0); PG8_MMA(1, 1, At, B1); PG8_BAR; PG8_SCHED;
            } else {
            PG8_LDB(B0, 0, 0); PG8_SCHED; PG8_LDA(At, 0, 0); PG8_STAGE(PG8_SA(1, 1), a1 + hstep, voffA);
            PG8_WAIT_L(8); PG8_BAR; PG8_WAIT_L(0); PG8_MMA(0, 0, At, B0); PG8_BAR; PG8_SCHED;
            PG8_LDB(B1, 0, 1); PG8_STAGE(PG8_SB(0, 0), b2, voffB);
            PG8_BAR; PG8_WAIT_L(0); PG8_MMA(0, 1, At, B1); PG8_BAR;
            PG8_LDA(At, 0, 1); PG8_STAGE(PG8_SA(0, 0), a2, voffA);
            PG8_BAR; PG8_WAIT_L(0); PG8_MMA(1, 0, At, B0); PG8_BAR; PG8_SCHED;
            PG8_STAGE(PG8_SB(0, 1), b2 + hstep, voffB);
            PG8_WAIT_V(6); PG8_BAR; PG8_MMA(1, 1, At, B1); PG8_BAR;
            PG8_LDB(B0, 1, 0); PG8_SCHED; PG8_LDA(At, 1, 0); PG8_STAGE(PG8_SA(0, 1), a2 + hstep, voffA);
            PG8_WAIT_L(8); PG8_BAR; PG8_WAIT_L(0); PG8_MMA(0, 0, At, B0); PG8_BAR; PG8_SCHED;
            PG8_LDB(B1, 1, 1); PG8_STAGE(PG8_SB(1, 0), b3, voffB);
            PG8_BAR; PG8_WAIT_L(0); PG8_MMA(0, 1, At, B1); PG8_BAR;
            PG8_LDA(At, 1, 1); PG8_STAGE(PG8_SA(1, 0), a3, voffA);
            PG8_BAR; PG8_WAIT_L(0); PG8_MMA(1, 0, At, B0); PG8_BAR; PG8_SCHED;
            PG8_STAGE(PG8_SB(1, 1), b3 + hstep, voffB);
            PG8_WAIT_V(6); PG8_BAR; PG8_MMA(1, 1, At, B1); PG8_BAR;
            }
        }
        if constexpr (ALIGN_EPI) { if (wr == 0) PG8_BAR; }
        if constexpr (!Epi::AFTER_DRAIN) { E(acc, cur, wr, wc, fr, fq); S.done(cur); }
        if (!has_next) break;
#pragma unroll
        for (int a = 0; a < 2; ++a)
#pragma unroll
            for (int b = 0; b < 2; ++b)
#pragma unroll
                for (int m = 0; m < 4; ++m)
#pragma unroll
                    for (int n = 0; n < 2; ++n) acc[a][b][m][n] = (f32x4){0.f, 0.f, 0.f, 0.f};
        cur = nxt; cA = nA; cB = nB; ++ui;
        if constexpr (ALIGN_EPI) { if (wr == 1) PG8_BAR; }
    }
    PG8_WAIT_V(0);
    if constexpr (!ALIGN_EPI) { if (wr == 0) PG8_BAR; }
    PG8_BAR;
    if constexpr (Epi::AFTER_DRAIN) { E.fused(acc, cur, wr, wc, fr, fq, lds, wid, lane); S.done(cur); }
#undef PG8_SA
#undef PG8_SB
#undef PG8_STAGE
#undef PG8_LDA
#undef PG8_LDB
#undef PG8_MMA
#undef PG8_WAIT_V
#undef PG8_WAIT_L
#undef PG8_BAR
#undef PG8_SCHED
}
}
#define XB_TMO      128
#define XB_XCNT(j)  (256  + 64 * (j))
#define XB_XSUB(j)  (1280 + 64 * (j))
#define XB_XGEN(j)  (2304 + 64 * (j))
#define XB_TOP      3328
#define XB_TOPGEN   3392
#define XCD_BAR_WORDS 3456
#define XB_SPIN_CAP (1u << 18)

__device__ __forceinline__ unsigned xb_ld(unsigned* p)              { return __hip_atomic_load(p, __ATOMIC_RELAXED, __HIP_MEMORY_SCOPE_AGENT); }
__device__ __forceinline__ unsigned xb_add(unsigned* p, unsigned v) { return __hip_atomic_fetch_add(p, v, __ATOMIC_RELAXED, __HIP_MEMORY_SCOPE_AGENT); }
__device__ __forceinline__ unsigned xb_xcc_id() { return (unsigned)__builtin_amdgcn_s_getreg((3 << 11) | 20) & 0xFu; }
#define XB_SPIN(cond, bar) do { unsigned _sp = 0; while (cond) { __builtin_amdgcn_s_sleep(1); \
    if ((++_sp & 255u) == 0u) { if (xb_ld(&(bar)[XB_TMO])) break; if (_sp > XB_SPIN_CAP) { atomicAdd(&(bar)[XB_TMO], 1u); break; } } } } while (0)

struct XcdBarrier {
    unsigned* bar; unsigned x;
    volatile LAS unsigned* st;
};

__device__ __forceinline__ XcdBarrier xcd_barrier_post(unsigned* bar, volatile LAS unsigned* st) {
    XcdBarrier b; b.bar = bar; b.x = xb_xcc_id(); b.st = st;
    if (threadIdx.x == 0) { st[2] = xb_add(&bar[XB_XCNT(b.x)], 1u); st[3] = 1u; }
    return b;
}
__device__ __forceinline__ void xcd_barrier_complete(unsigned* bar, unsigned x, unsigned& nloc, unsigned& nx) {
    const unsigned G = gridDim.x * gridDim.y * gridDim.z;
    unsigned sum, cnt, mine, sp = 0u;
    for (;;) {
        sum = 0u; cnt = 0u; mine = 0u;
#pragma unroll
        for (unsigned j = 0; j < 16; ++j) { const unsigned c = xb_ld(&bar[XB_XCNT(j)]); sum += c; cnt += (c > 0u) ? 1u : 0u; mine = (j == x) ? c : mine; }
        if (sum == G) break;
        __builtin_amdgcn_s_sleep(1);
        if ((++sp & 255u) == 0u) { if (xb_ld(&bar[XB_TMO])) break; if (sp > XB_SPIN_CAP) { atomicAdd(&bar[XB_TMO], 1u); break; } }
    }
    nloc = mine > 0u ? mine : 1u; nx = cnt > 0u ? cnt : 1u;
}

__device__ __forceinline__ void xcd_barrier(const XcdBarrier& b) {
    asm volatile("s_waitcnt vmcnt(0)" ::: "memory");
    __syncthreads();
    if (threadIdx.x == 0) {
        unsigned* bar = b.bar;
        __builtin_amdgcn_s_waitcnt(0);
        unsigned nloc = b.st[0], nx = b.st[1];
        if (nloc == 0u) { xcd_barrier_complete(bar, b.x, nloc, nx); b.st[0] = nloc; b.st[1] = nx; }
        const unsigned old = xb_add(&bar[XB_XSUB(b.x)], 1u);
        const unsigned gen = old / nloc;
        if (old + 1u == (gen + 1u) * nloc) {
            __builtin_amdgcn_fence(__ATOMIC_RELEASE, "agent");
            asm volatile("s_waitcnt vmcnt(0)" ::: "memory");
            const unsigned og = xb_add(&bar[XB_TOP], 1u);
            const unsigned tg = og / nx;
            if (og + 1u == (tg + 1u) * nx) xb_add(&bar[XB_TOPGEN], 1u);
            else XB_SPIN(xb_ld(&bar[XB_TOPGEN]) == tg, bar);
            __builtin_amdgcn_fence(__ATOMIC_ACQUIRE, "agent");
            xb_add(&bar[XB_XGEN(b.x)], 1u);
            asm volatile("s_waitcnt vmcnt(0)" ::: "memory");
        } else {
            XB_SPIN(xb_ld(&bar[XB_XGEN(b.x)]) == gen, bar);
            __builtin_amdgcn_fence(__ATOMIC_ACQUIRE, "agent");
            asm volatile("s_waitcnt vmcnt(0)" ::: "memory");
        }
    }
    __syncthreads();
}

namespace pg8 {
template <class Fn> struct EpiFn {
    static constexpr bool PERM = true, AFTER_DRAIN = false;
    Fn f;
    __device__ __forceinline__ void operator()(const f32x4 (&acc)[2][2][4][2], const Unit& u, int wr, int wc, int fr, int fq) const {
        const int row0 = u.pm * BM + wr * 64 + fr, col0 = u.pn * BM + wc * 32 + 8 * fq;
#pragma unroll
        for (int ai = 0; ai < 2; ++ai)
#pragma unroll
            for (int m = 0; m < 4; ++m)
#pragma unroll
                for (int bj = 0; bj < 2; ++bj) f.e8(row0 + ai * HALF + m * 16, col0 + bj * HALF, acc[ai][bj][m][0], acc[ai][bj][m][1]);
    }
};
}

struct FnBf16 {
    bf16* O; int ld;
    __device__ __forceinline__ void e8(int row, int col, f32x4 a, f32x4 b) const {
        v4u w; w.x = pk2(a.x, a.y); w.y = pk2(a.z, a.w); w.z = pk2(b.x, b.y); w.w = pk2(b.z, b.w);
        *(v4u*)(O + (size_t)row * ld + col) = w;
    }
    __device__ __forceinline__ void e4(int row, int col, f32x4 a) const {
        v2u w; w.x = pk2(a.x, a.y); w.y = pk2(a.z, a.w);
        *(v2u*)(O + (size_t)row * ld + col) = w;
    }
};
struct FnResid {
    float* XS; const float* baseP; const float* baseS;
    __device__ __forceinline__ const float* brow(int row) const { return row < MP ? baseP + (size_t)row * DM : baseS + (size_t)(row - MP) * DM; }
    __device__ __forceinline__ void e8(int row, int col, f32x4 a, f32x4 b) const {
        const float* br = brow(row) + col; float* o = XS + (size_t)row * DM + col;
        const f32x4 x0 = *(const f32x4*)br, x1 = *(const f32x4*)(br + 4);
        *(f32x4*)o = x0 + a; *(f32x4*)(o + 4) = x1 + b;
    }
    __device__ __forceinline__ void e4(int row, int col, f32x4 a) const {
        const float* br = brow(row) + col; float* o = XS + (size_t)row * DM + col;
        *(f32x4*)o = *(const f32x4*)br + a;
    }
};
struct FnF32 {
    float* O; int ld;
    __device__ __forceinline__ void e8(int row, int col, f32x4 a, f32x4 b) const { float* o = O + (size_t)row * ld + col; *(f32x4*)o = a; *(f32x4*)(o + 4) = b; }
    __device__ __forceinline__ void e4(int row, int col, f32x4 a) const { *(f32x4*)(O + (size_t)row * ld + col) = a; }
};
struct FnKvq {
    float* O; const float* ssq;
    __device__ __forceinline__ float rstd(int row) const { const f32x4 s0 = *(const f32x4*)(ssq + (size_t)row * 8), s1 = *(const f32x4*)(ssq + (size_t)row * 8 + 4);
        return 1.f / sqrtf((((s0.x + s0.y) + (s0.z + s0.w)) + ((s1.x + s1.y) + (s1.z + s1.w))) * (1.f / DM) + EPS); }
    __device__ __forceinline__ void e8(int row, int col, f32x4 a, f32x4 b) const {
        if (col < NKVQ_REAL) { const float rs = rstd(row); float* o = O + (size_t)row * NKVQ + col; *(f32x4*)o = a * rs; *(f32x4*)(o + 4) = b * rs; }
    }
    __device__ __forceinline__ void e4(int row, int col, f32x4 a) const {
        if (col < NKVQ_REAL) *(f32x4*)(O + (size_t)row * NKVQ + col) = a * rstd(row);
    }
};

template <class Fn>
__device__ __forceinline__ void skinny_gemm(Frame& F, const bf16* A, const bf16* Bt, int N, int row_base, const Fn& fn) {
    const int fr = F.lane & 15, fq = F.lane >> 4;
    const int nun = N / 16;
    for (int u = F.bid; u < nun; u += F.G) {
        const bf16* ap = Bt + (size_t)(u * 16 + fr) * DM + fq * 8;
        const bf16* bp = A + (size_t)(F.wave * 16 + fr) * DM + fq * 8;
        f32x4 acc = {0.f, 0.f, 0.f, 0.f};
#pragma unroll 8
        for (int ks = 0; ks < 32; ++ks) acc = MFMA16(ld8(ap + ks * 32), ld8(bp + ks * 32), acc);
        fn.e4(row_base + F.wave * 16 + fr, u * 16 + 4 * fq, acc);
    }
}

template <class Fn>
__device__ __forceinline__ void gemm_all(Frame& F, const bf16* A, const bf16* Bt, int N, const Fn& fn) {
    pg8::Gemm g{A, Bt, MP, N, DM}; pg8::StaticOrder S; S.init(MP, N, F.G, F.bid);
    pg8::EpiFn<Fn> E{fn};
    pg8::gemm_phase<pg8::EpiFn<Fn>, pg8::StaticOrder, true, true>(F.lds, g, S, E);
    skinny_gemm(F, A + (size_t)MP * DM, Bt, N, MP, fn);
}

__device__ __forceinline__ void p0_transpose_item(const float* W, int N, bf16* WT, int row_off, const float* gain, LAS float* scr, int item, int lane) {
    const int nblk = (N + 31) / 32, kb = item / nblk, nb = item % nblk, k0 = 64 * kb, n0 = 32 * nb;
#pragma unroll 8
    for (int i = 0; i < 32; ++i) { const int kk = 2 * i + (lane >> 5); const int n = n0 + (lane & 31);
        float v = 0.f; if (n < N) { v = W[(size_t)(k0 + kk) * N + n]; if (gain) v *= gain[k0 + kk]; }
        scr[kk * 33 + (lane & 31)] = v; }
    LDS_WAIT(); asm volatile("" ::: "memory");
    const int c = lane & 7;
#pragma unroll
    for (int j = 0; j < 4; ++j) { const int n = (lane >> 3) + 8 * j; const LAS float* s = scr + (8 * c) * 33 + n;
        v4u o; o.x = pk2(s[0 * 33], s[1 * 33]); o.y = pk2(s[2 * 33], s[3 * 33]); o.z = pk2(s[4 * 33], s[5 * 33]); o.w = pk2(s[6 * 33], s[7 * 33]);
        if (n0 + n < N) *(v4u*)(WT + (size_t)(row_off + n0 + n) * DM + k0 + 8 * c) = o; }
    LDS_WAIT(); asm volatile("" ::: "memory");
}
__device__ __forceinline__ void rms_row_to_bf16(const float* xrow, bf16* orow, int lane) {
    const f32x4* xr = (const f32x4*)xrow + lane;
    f32x4 v[4]; float s = 0.f;
#pragma unroll
    for (int j = 0; j < 4; ++j) { v[j] = xr[64 * j]; s += (v[j].x * v[j].x + v[j].y * v[j].y) + (v[j].z * v[j].z + v[j].w * v[j].w); }
    const float rstd = 1.f / sqrtf(wave_sum(s) * (1.f / DM) + EPS);
    v2u* o8 = (v2u*)orow + lane;
#pragma unroll
    for (int j = 0; j < 4; ++j) { v2u w; w.x = pk2(v[j].x * rstd, v[j].y * rstd); w.y = pk2(v[j].z * rstd, v[j].w * rstd); o8[64 * j] = w; }
}
__device__ __forceinline__ const float* xin_row(Frame& F, int row) { return row < MP ? FIN(0) + (size_t)row * DM : FIN(1) + (size_t)(row - MP) * DM; }

__device__ __forceinline__ void peer_tables_to_fp8(Frame& F, size_t thr, size_t nthr) {
    const size_t gt = thr, NGT = nthr;
        const size_t n8 = (size_t)2 * NEXP * DM / 8;
        for (int t = 0; t < 2; ++t) { const f32x4* src = (const f32x4*)FIN(27 + t); v2u* dst = (v2u*)WSP(unsigned char, t == 0 ? WS_PU : WS_PV); const float* pln = FIN(24);
            for (size_t i0 = gt; i0 < n8; i0 += (size_t)4 * NGT) {
                f32x4 a[4], b[4];
#pragma unroll
                for (int u = 0; u < 4; ++u) { const size_t i = i0 + (size_t)u * NGT; if (i < n8) { a[u] = src[2 * i]; b[u] = src[2 * i + 1]; } }
#pragma unroll
                for (int u = 0; u < 4; ++u) { const size_t i = i0 + (size_t)u * NGT; if (i < n8) {
                    if (t == 0) { const float* gp = pln + ((i >> 21) << 10) + ((i & 127) << 3); a[u] = a[u] * *(const f32x4*)gp * 32.f; b[u] = b[u] * *(const f32x4*)(gp + 4) * 32.f; }
                    else { a[u] = a[u] * 16.f; b[u] = b[u] * 16.f; }
                    int w0 = __builtin_amdgcn_cvt_pk_fp8_f32(a[u].x, a[u].y, 0, false); w0 = __builtin_amdgcn_cvt_pk_fp8_f32(a[u].z, a[u].w, w0, true);
                    int w1 = __builtin_amdgcn_cvt_pk_fp8_f32(b[u].x, b[u].y, 0, false); w1 = __builtin_amdgcn_cvt_pk_fp8_f32(b[u].z, b[u].w, w1, true);
                    dst[((((i >> 21) * 8 + ((i & 127) >> 4)) * (size_t)NEXP + ((i >> 7) & (NEXP - 1))) << 4) + (i & 15)] = (v2u){(unsigned)w0, (unsigned)w1}; } } } }
}

__device__ __forceinline__ void p0_prologue(Frame& F) {
    LAS float* scr = (LAS float*)(F.lds + F.wave * 16384);
    const int gw = F.bid * 8 + F.wave, NGW = F.G * 8;
    const int gt = F.bid * 512 + F.tid, NGT = F.G * 512;
    {
        constexpr int I_IN = 128 * 16, I_OA = 32 * 16, I_KV = 48 * 16, I_QG = 34 * 16, I_OB = 32 * 16, I_PQ = 64 * 16;
        constexpr int NITEMS = I_IN + I_OA + I_KV + I_QG + I_OB + 2 * I_PQ;
        for (int it = gw; it < NITEMS; it += NGW) {
            int r = it;
            if (r < I_IN) {
                const int kb = r / 128, nb = r % 128, k0 = 64 * kb, n0 = 32 * nb; const float* W = FIN(8); const float* gain = FIN(7);
#pragma unroll 8
                for (int i = 0; i < 32; ++i) { const int kk = 2 * i + (F.lane >> 5); scr[kk * 33 + (F.lane & 31)] = W[(size_t)(k0 + kk) * GPROJ + n0 + (F.lane & 31)] * gain[k0 + kk]; }
                LDS_WAIT(); asm volatile("" ::: "memory");
                const int c = F.lane & 7;
#pragma unroll
                for (int j = 0; j < 4; ++j) { const int n = (F.lane >> 3) + 8 * j; const LAS float* s = scr + (8 * c) * 33 + n;
                    v4u o; o.x = pk2(s[0 * 33], s[1 * 33]); o.y = pk2(s[2 * 33], s[3 * 33]); o.z = pk2(s[4 * 33], s[5 * 33]); o.w = pk2(s[6 * 33], s[7 * 33]);
                    *(v4u*)(WSP(bf16, WS_WIN_T) + (size_t)(n0 + n) * DM + k0 + 8 * c) = o; }
                LDS_WAIT(); asm volatile("" ::: "memory");
                continue; }
            r -= I_IN;
            if (r < I_OA) { p0_transpose_item(FIN(13), 1024, WSP(bf16, WS_WOA_T), 0, nullptr, scr, r, F.lane); continue; } r -= I_OA;
            if (r < I_KV) { p0_transpose_item(FIN(15), NKV, WSP(bf16, WS_WKVQ_T), 0, FIN(14), scr, r, F.lane); continue; } r -= I_KV;
            if (r < I_QG) { p0_transpose_item(FIN(21), NQG, WSP(bf16, WS_WKVQ_T), NKV, FIN(20), scr, r, F.lane); continue; } r -= I_QG;
            if (r < I_OB) { p0_transpose_item(FIN(23), 1024, WSP(bf16, WS_WOB_T), 0, nullptr, scr, r, F.lane); continue; } r -= I_OB;
            if (r < I_PQ) { p0_transpose_item(FIN(25), 2048, WSP(bf16, WS_WPQ_T), 0, FIN(24), scr, r, F.lane); continue; } r -= I_PQ;
            p0_transpose_item(FIN(25) + (size_t)1024 * 2048, 2048, WSP(bf16, WS_WPQ_T) + (size_t)2048 * 1024, 0, FIN(24) + 1024, scr, r, F.lane);
        }
        for (int i = gt; i < (NKVQ - NKVQ_REAL) * DM / 8; i += NGT) ((v4u*)(WSP(bf16, WS_WKVQ_T) + (size_t)NKVQ_REAL * DM))[i] = (v4u){0u, 0u, 0u, 0u};
        for (int i = gt; i < 16 * 1024; i += NGT) { const int j = i >> 10, k = i & 1023; WSP(float, WS_WAB)[i] = FIN(7)[k] * FIN(8)[(size_t)k * GPROJ + 4096 + j]; }
    }
    for (int m = gw; m < MTOK; m += NGW) rms_row_to_bf16(xin_row(F, m), WSP(bf16, WS_XNA) + (size_t)m * DM, F.lane);
    {
        if (F.G != 256) peer_tables_to_fp8(F, (size_t)gt, (size_t)NGT);
        const f32x4* sk = (const f32x4*)FIN(26); v4u* dk = (v4u*)WSP(bf16, WS_SUBK);
        for (int i = gt; i < 2 * 8 * 2 * 128 * 128 / 8; i += NGT) { const f32x4 a = sk[2 * i], b = sk[2 * i + 1]; v4u w; w.x = pk2(a.x, a.y); w.y = pk2(a.z, a.w); w.z = pk2(b.x, b.y); w.w = pk2(b.z, b.w); dk[i] = w; }
    }
    for (int i = gt; i < 2 * 64 * 2048; i += NGT) { const int kv = i >> 17, hh = (i >> 11) & 63, k = i & 2047;
        WSP(bf16, WS_W1T)[i] = (bf16)f2bf(FIN(17)[((size_t)kv * 2048 + k) * 64 + hh]); }
    for (int it = gw; it < 128; it += NGW) { const int kv = it >> 6, h = it & 63; float s = 0.f;
        for (int k = F.lane; k < 2048; k += 64) s += FIN(18)[(size_t)kv * 2048 + k] * FIN(17)[((size_t)kv * 2048 + k) * 64 + h];
        s = wave_sum(s); if (F.lane == 0) WSP(float, WS_PETERM)[it] = s; }
    {
        const float* cache = FIN(2); const int* pt = (const int*)FIN(6); bf16* cka = WSP(bf16, WS_CKA);
        const int nitem = SB * PAST * 2 * 4 * 8;
        for (int i0 = gt; i0 < nitem; i0 += 4 * NGT) {
            f32x4 a[4], b[4];
#pragma unroll
            for (int u = 0; u < 4; ++u) { const int i = i0 + u * NGT; if (i < nitem) {
                const int d8 = i & 7, g = (i >> 3) & 3, kv = (i >> 5) & 1, t = (i >> 6) & 8191, bs = i >> 19;
                const float* src = cache + ((size_t)pt[bs * NPAGES + (t >> 7)] * PAGE + (t & 127)) * 1024 + kv * 256 + g * 64 + d8 * 8;
                a[u] = *(const f32x4*)src; b[u] = *(const f32x4*)(src + 4); } }
#pragma unroll
            for (int u = 0; u < 4; ++u) { const int i = i0 + u * NGT; if (i < nitem) {
                const int d8 = i & 7, g = (i >> 3) & 3, kv = (i >> 5) & 1, t = (i >> 6) & 8191, bs = i >> 19;
                v4u w; w.x = pk2(a[u].x, a[u].y); w.y = pk2(a[u].z, a[u].w); w.z = pk2(b[u].x, b[u].y); w.w = pk2(b[u].z, b[u].w);
                *(v4u*)(cka + ((size_t)((bs * 4 + g) * 512 + (t >> 4))) * 2048 + kv * 1024 + (t & 15) * 64 + d8 * 8) = w; } }
        }
        bf16* wbd = WSP(bf16, WS_W1BD);
        for (int i = gt; i < 256 * 2048; i += NGT) { const int n = i >> 11, col = i & 2047, kv = n >> 7, sec = (n >> 6) & 1, hh = n & 63;
            float v = 0.f; if ((col >> 10) == kv) { const int k = col & 1023, r = (k >> 6) + 16 * sec, d = k & 63; v = FIN(17)[(((size_t)kv * 32 + r) * 64 + d) * 64 + hh]; }
            wbd[i] = (bf16)f2bf(v); }
    }
    {
        const f32x4* src = (const f32x4*)FIN(3); f32x4* dst = (f32x4*)(F.out + O_WINS);
        const int per_b = 508 * 512 / 4;
        for (int i = gt; i < SB * per_b; i += NGT) { const int b = i / per_b, r = i % per_b; dst[(size_t)b * (512 * 512 / 4) + r] = src[(size_t)b * (512 * 512 / 4) + 4 * 512 / 4 + r]; }
    }
    for (int i = gt; i < SB * NG * 544 * 64; i += NGT) {
        const int d = i & 63, r = (i >> 6) % 544, bg = (i >> 6) / 544, g = bg & 3, b = bg >> 2;
        if (r < 512) { const float* cw = FIN(3) + (((size_t)b * 512 + r) * 2) * 256 + g * 64 + d;
            WSP(bf16, WS_SKWIN)[i] = (bf16)f2bf(cw[0]);
            WSP(bf16, WS_SVWINT)[((size_t)bg * 64 + d) * 544 + r] = (bf16)f2bf(cw[256]); }
        else if (r >= 516) { WSP(bf16, WS_SKWIN)[i] = 0; WSP(bf16, WS_SVWINT)[((size_t)bg * 64 + d) * 544 + r] = 0; }
    }
}

constexpr int P2_QS = 0, P2_KS = 17408, P2_KBGT = 34816, P2_VBT = 53248, P2_AM = 71680, P2_TB = 89088, P2_G = 98304, P2_TF = 99328, P2_XF = 116736;
constexpr int QS_LD = 136, KT_LD = 72, AM_LD = 68, TB_LD = 72;

__device__ __forceinline__ float softplus_f(float x) { return fmaxf(x, 0.f) + log1pf(expf(-fabsf(x))); }

__device__ __forceinline__ void p2_chunk(Frame& F, int unit) {
    const int c = unit & 127, h = (unit >> 7) & 7, b = unit >> 10;
    const int t0 = c * CHUNK, lane = F.lane, w = F.wave, fr = lane & 15, fq = lane >> 4;
    LAS unsigned char* L = F.lds; asm volatile("" : "+v"(L));
    LAS bf16* qs = (LAS bf16*)(L + P2_QS); LAS bf16* ks = (LAS bf16*)(L + P2_KS);
    LAS bf16* kbgT = (LAS bf16*)(L + P2_KBGT); LAS bf16* vbT = (LAS bf16*)(L + P2_VBT);
    LAS float* Am = (LAS float*)(L + P2_AM); LAS bf16* Tb = (LAS bf16*)(L + P2_TB);
    LAS float* Gs = (LAS float*)(L + P2_G);
    const bf16* PROJ = WSP(bf16, WS_PROJ); const bf16* XNA = WSP(bf16, WS_XNA); const float* WAB = WSP(float, WS_WAB);
    const size_t rowb = (size_t)b * PT;
    float beta_r[8];
    {
        f32x4 wa[4], wb[4];
        const float* pa = WAB + (size_t)h * DM + 8 * lane; const float* pb = WAB + (size_t)(8 + h) * DM + 8 * lane;
        wa[0] = *(const f32x4*)pa; wa[1] = *(const f32x4*)(pa + 4); wa[2] = *(const f32x4*)(pa + 512); wa[3] = *(const f32x4*)(pa + 516);
        wb[0] = *(const f32x4*)pb; wb[1] = *(const f32x4*)(pb + 4); wb[2] = *(const f32x4*)(pb + 512); wb[3] = *(const f32x4*)(pb + 516);
        const float Aneg = -expf(FIN(10)[h]), dtb = FIN(11)[h];
#pragma unroll
        for (int tk = 0; tk < 8; ++tk) {
            const int tok = 8 * w + tk; const bf16* xr = XNA + (rowb + t0 + tok) * DM + 8 * lane;
            const v4u x0 = *(const v4u*)xr, x1 = *(const v4u*)(xr + 512);
            float sa = 0.f, sb = 0.f;
#define ACC2(xw, wv0, wv1, i0) { const float lo = bflo(xw), hi = bfhi(xw); sa += lo * wv0[i0] + hi * wv0[i0 + 1]; sb += lo * wv1[i0] + hi * wv1[i0 + 1]; }
            ACC2(x0.x, wa[0], wb[0], 0) ACC2(x0.y, wa[0], wb[0], 2) ACC2(x0.z, wa[1], wb[1], 0) ACC2(x0.w, wa[1], wb[1], 2)
            ACC2(x1.x, wa[2], wb[2], 0) ACC2(x1.y, wa[2], wb[2], 2) ACC2(x1.z, wa[3], wb[3], 0) ACC2(x1.w, wa[3], wb[3], 2)
#undef ACC2
            sa = wave_sum(sa); sb = wave_sum(sb);
            const float g = Aneg * softplus_f(sa + dtb), be = 1.f / (1.f + expf(-sb));
            beta_r[tk] = be;
            if (lane == 0) { Gs[tok] = g; Gs[64 + tok] = be; }
        }
    }
#pragma unroll
    for (int p = 0; p < 3; ++p) {
        const int col0 = p * 1024 + h * 128 + 2 * lane;
        float cw0[4], cw1[4];
#pragma unroll
        for (int i = 0; i < 4; ++i) { const f32x2 cv = *(const f32x2*)(FIN(9) + (size_t)i * GCONV + col0); cw0[i] = cv.x; cw1[i] = cv.y; }
        unsigned xw[11];
#pragma unroll
        for (int rr = 0; rr < 11; ++rr) { const int t = t0 + 8 * w - 3 + rr; xw[rr] = (t >= 0) ? *(const unsigned*)(PROJ + (rowb + t) * 4096 + col0) : 0u; }
        if (c == 127 && w == 7) {
#pragma unroll
            for (int r = 0; r < 3; ++r) { float* o = F.out + O_CONVP + ((size_t)b * 3 + r) * GCONV + col0; o[0] = bflo(xw[8 + r]); o[1] = bfhi(xw[8 + r]); }
        }
#pragma unroll
        for (int tk = 0; tk < 8; ++tk) {
            const int tok = 8 * w + tk;
            float y0 = 0.f, y1 = 0.f;
#pragma unroll
            for (int i = 0; i < 4; ++i) { y0 += cw0[i] * bflo(xw[tk + i]); y1 += cw1[i] * bfhi(xw[tk + i]); }
            y0 = silu_f(y0); y1 = silu_f(y1);
            if (p < 2) {
                const float ss = wave_sum(y0 * y0 + y1 * y1);
                const float rs = (1.f / sqrtf(ss + EPS)) * (p == 0 ? 0.08838834764831845f : 1.f);
                *(LAS unsigned*)((p == 0 ? qs : ks) + tok * QS_LD + 2 * lane) = pk2(y0 * rs, y1 * rs);
            } else {
                vbT[(2 * lane) * KT_LD + tok] = (bf16)f2bf(y0 * beta_r[tk]); vbT[(2 * lane + 1) * KT_LD + tok] = (bf16)f2bf(y1 * beta_r[tk]);
            }
        }
    }
    __syncthreads();
    if (w == 0) { float g = Gs[lane];
#pragma unroll
        for (int o = 1; o < 64; o <<= 1) { const float up = __shfl_up(g, o); if (lane >= o) g += up; }
        Gs[128 + lane] = g; }
    __syncthreads();
    const float glast = Gs[128 + 63];
    const size_t chunk = (size_t)unit;
    if (w < 4) {
        const int mt = w;
        bf16x8 a[4];
#pragma unroll
        for (int kk = 0; kk < 4; ++kk) a[kk] = ld8l(ks + (16 * mt + fr) * QS_LD + 32 * kk + 8 * fq);
#pragma unroll
        for (int nt = 0; nt < 4; ++nt) {
            f32x4 acc = {0.f, 0.f, 0.f, 0.f};
            if (nt <= mt) {
#pragma unroll
                for (int kk = 0; kk < 4; ++kk) acc = MFMA16(a[kk], ld8l(ks + (16 * nt + fr) * QS_LD + 32 * kk + 8 * fq), acc);
            }
            const int j = 16 * nt + fr; const float gj = Gs[128 + j];
#pragma unroll
            for (int r = 0; r < 4; ++r) { const int i = 16 * mt + 4 * fq + r;
                Am[i * AM_LD + j] = (i > j) ? Gs[64 + i] * acc[r] * __expf(Gs[128 + i] - gj) : 0.f; }
        }
    } else {
        const int nt = w - 4;
        bf16x8 bq[4];
#pragma unroll
        for (int kk = 0; kk < 4; ++kk) bq[kk] = ld8l(qs + (16 * nt + fr) * QS_LD + 32 * kk + 8 * fq);
        const int i = 16 * nt + fr; const float gi = Gs[128 + i];
        bf16* gqk = WSP(bf16, WS_GQK) + chunk * 4096 + (size_t)i * 64;
#pragma unroll
        for (int mt = 0; mt < 4; ++mt) {
            f32x4 acc = {0.f, 0.f, 0.f, 0.f};
            if (mt <= nt) {
#pragma unroll
                for (int kk = 0; kk < 4; ++kk) acc = MFMA16(ld8l(ks + (16 * mt + fr) * QS_LD + 32 * kk + 8 * fq), bq[kk], acc);
            }
            float v[4];
#pragma unroll
            for (int r = 0; r < 4; ++r) { const int j = 16 * mt + 4 * fq + r; v[r] = (i >= j) ? acc[r] * __expf(gi - Gs[128 + j]) : 0.f; }
            v2u o; o.x = pk2(v[0], v[1]); o.y = pk2(v[2], v[3]);
            *(v2u*)(gqk + 16 * mt + 4 * fq) = o;
        }
    }
    {
        const int tok = F.tid >> 3, d0 = (F.tid & 7) * 16; const float e = __expf(Gs[128 + tok]);
        bf16* gq = WSP(bf16, WS_GQ) + chunk * 8192 + (size_t)tok * 128 + d0;
#pragma unroll
        for (int hh = 0; hh < 2; ++hh) { const v4u q = *(const LAS v4u*)(qs + tok * QS_LD + d0 + 8 * hh); v4u o;
            o.x = pk2(bflo(q.x) * e, bfhi(q.x) * e); o.y = pk2(bflo(q.y) * e, bfhi(q.y) * e); o.z = pk2(bflo(q.z) * e, bfhi(q.z) * e); o.w = pk2(bflo(q.w) * e, bfhi(q.w) * e);
            *(v4u*)(gq + 8 * hh) = o; }
    }
    {
        const int dk = F.tid & 127, tg = F.tid >> 7;
        unsigned o1[8], o2[8];
#pragma unroll
        for (int i = 0; i < 8; ++i) {
            const int ta = 16 * tg + 2 * i, tb2 = ta + 1;
            const float ka = bf2f(ks[ta * QS_LD + dk]), kb = bf2f(ks[tb2 * QS_LD + dk]);
            const float ga = Gs[128 + ta], gb = Gs[128 + tb2];
            o1[i] = pk2(ka * Gs[64 + ta] * __expf(ga), kb * Gs[64 + tb2] * __expf(gb));
            o2[i] = pk2(ka * __expf(glast - ga), kb * __expf(glast - gb));
        }
        LAS v4u* d1 = (LAS v4u*)(kbgT + dk * KT_LD + 16 * tg); d1[0] = (v4u){o1[0], o1[1], o1[2], o1[3]}; d1[1] = (v4u){o1[4], o1[5], o1[6], o1[7]};
        v4u* d2 = (v4u*)(WSP(bf16, WS_GKT) + chunk * 8192 + (size_t)dk * 64 + 16 * tg); d2[0] = (v4u){o2[0], o2[1], o2[2], o2[3]}; d2[1] = (v4u){o2[4], o2[5], o2[6], o2[7]};
    }
    if (F.tid == 0) WSP(float, WS_GDEC)[chunk] = __expf(glast);
    __syncthreads();
    LAS float* Tf = (LAS float*)(L + P2_TF); LAS float* Xf = (LAS float*)(L + P2_XF);
    if (w == 0) {
        const int blk = lane >> 5, cc = lane & 31; const LAS float* Ab = Am + (32 * blk) * AM_LD + 32 * blk;
        float t[32];
#pragma unroll
        for (int i = 0; i < 32; ++i) {
            float acc0 = (i == cc) ? 1.f : 0.f, acc1 = 0.f;
#pragma unroll
            for (int j4 = 0; j4 < (i + 3) / 4; ++j4) {
                const f32x4 a = *(const LAS f32x4*)(Ab + i * AM_LD + 4 * j4);
                if (4 * j4 + 0 < i) acc0 = __builtin_fmaf(-a.x, t[4 * j4 + 0], acc0);
                if (4 * j4 + 1 < i) acc1 = __builtin_fmaf(-a.y, t[4 * j4 + 1], acc1);
                if (4 * j4 + 2 < i) acc0 = __builtin_fmaf(-a.z, t[4 * j4 + 2], acc0);
                if (4 * j4 + 3 < i) acc1 = __builtin_fmaf(-a.w, t[4 * j4 + 3], acc1);
            }
            t[i] = acc0 + acc1;
            asm volatile("" : "+v"(t[i]));
            __builtin_amdgcn_sched_barrier(0);
        }
#pragma unroll
        for (int i = 0; i < 32; ++i) { Tf[(32 * blk + i) * AM_LD + 32 * blk + cc] = t[i]; if (blk == 0) Tf[i * AM_LD + 32 + cc] = 0.f; }
    }
    __syncthreads();
    {
        const int i = F.tid >> 4, c0 = (F.tid & 15) * 2; float x0 = 0.f, x1 = 0.f;
#pragma unroll 8
        for (int k = 0; k < 32; ++k) { const float a = Am[(32 + i) * AM_LD + k]; x0 = __builtin_fmaf(a, Tf[k * AM_LD + c0], x0); x1 = __builtin_fmaf(a, Tf[k * AM_LD + c0 + 1], x1); }
        Xf[i * 34 + c0] = x0; Xf[i * 34 + c0 + 1] = x1;
    }
    __syncthreads();
    {
        const int i = F.tid >> 4, c0 = (F.tid & 15) * 2; float x0 = 0.f, x1 = 0.f;
#pragma unroll 8
        for (int k = 0; k < 32; ++k) { const float a = Tf[(32 + i) * AM_LD + 32 + k]; x0 = __builtin_fmaf(a, Xf[k * 34 + c0], x0); x1 = __builtin_fmaf(a, Xf[k * 34 + c0 + 1], x1); }
        Tf[(32 + i) * AM_LD + c0] = -x0; Tf[(32 + i) * AM_LD + c0 + 1] = -x1;
    }
    __syncthreads();
    {
        const int i = F.tid >> 3, c0 = (F.tid & 7) * 8; const f32x4 a = *(const LAS f32x4*)(Tf + i * AM_LD + c0), b2 = *(const LAS f32x4*)(Tf + i * AM_LD + c0 + 4);
        *(LAS v4u*)(Tb + i * TB_LD + c0) = (v4u){pk2(a.x, a.y), pk2(a.z, a.w), pk2(b2.x, b2.y), pk2(b2.z, b2.w)};
    }
    __syncthreads();
    {
        bf16x8 tb[4][2];
#pragma unroll
        for (int x = 0; x < 4; ++x)
#pragma unroll
            for (int s = 0; s < 2; ++s) tb[x][s] = ld8l(Tb + (16 * x + fr) * TB_LD + 32 * s + 8 * fq);
        const bf16x8 bv0 = ld8l(vbT + (16 * w + fr) * KT_LD + 8 * fq), bv1 = ld8l(vbT + (16 * w + fr) * KT_LD + 32 + 8 * fq);
        f32x4* gu = (f32x4*)(WSP(float, WS_GU) + chunk * 8192) + (size_t)w * 256 + lane;
#pragma unroll
        for (int mt = 0; mt < 4; ++mt) { f32x4 acc = {0.f, 0.f, 0.f, 0.f}; acc = MFMA16(tb[mt][0], bv0, acc); acc = MFMA16(tb[mt][1], bv1, acc); gu[mt * 64] = acc; }
        const bf16x8 ak0 = ld8l(kbgT + (16 * w + fr) * KT_LD + 8 * fq), ak1 = ld8l(kbgT + (16 * w + fr) * KT_LD + 32 + 8 * fq);
        bf16* gw = WSP(bf16, WS_GW) + chunk * 8192;
#pragma unroll
        for (int nt = 0; nt < 4; ++nt) { f32x4 acc = {0.f, 0.f, 0.f, 0.f}; acc = MFMA16(ak0, tb[nt][0], acc); acc = MFMA16(ak1, tb[nt][1], acc);
            v2u o; o.x = pk2(acc[0], acc[1]); o.y = pk2(acc[2], acc[3]);
            *(v2u*)(gw + (size_t)(16 * nt + fr) * 128 + 16 * w + 4 * fq) = o; }
    }
    __syncthreads();
}

constexpr int S2_Y = 0;
constexpr int S2_AB = 6144;
constexpr int S2_DOT = 6400;
constexpr int S2_U = 6656;
constexpr int S2_W = 8704;
constexpr int S2_VN = 10752;
__device__ __forceinline__ void p2_sample(Frame& F, int unit) {
    const int h = unit & 7, bs = unit >> 3, tid = F.tid, lane = F.lane, w = F.wave;
    LAS unsigned char* L = F.lds; asm volatile("" : "+v"(L));
    LAS float* Y = (LAS float*)(L + S2_Y); LAS float* AB = (LAS float*)(L + S2_AB); LAS float* DOT = (LAS float*)(L + S2_DOT);
    LAS float* U = (LAS float*)(L + S2_U); LAS float* W = (LAS float*)(L + S2_W); LAS float* VN = (LAS float*)(L + S2_VN);
    const bf16* PROJ = WSP(bf16, WS_PROJ); const bf16* XNA = WSP(bf16, WS_XNA); const float* WAB = WSP(float, WS_WAB);
    const size_t row0 = (size_t)MP + bs * 4;
    if (tid < 384) {
        const int part = tid >> 7, cc = tid & 127, col = part * 1024 + h * 128 + cc;
        float buf[7];
#pragma unroll
        for (int r = 0; r < 3; ++r) buf[r] = FIN(5)[((size_t)bs * 3 + r) * GCONV + col];
#pragma unroll
        for (int i = 0; i < 4; ++i) buf[3 + i] = bf2f(PROJ[(row0 + i) * 4096 + col]);
#pragma unroll
        for (int r = 0; r < 3; ++r) F.out[O_CONVS + ((size_t)bs * 3 + r) * GCONV + col] = buf[4 + r];
        float cw[4];
#pragma unroll
        for (int i = 0; i < 4; ++i) cw[i] = FIN(9)[(size_t)i * GCONV + col];
#pragma unroll
        for (int i = 0; i < 4; ++i) { float y = 0.f;
#pragma unroll
            for (int k = 0; k < 4; ++k) y += cw[k] * buf[i + k];
            Y[(part * 4 + i) * 128 + cc] = silu_f(y); }
    }
    {
        const int i = w >> 1, which = w & 1; const bf16* xr = XNA + (row0 + i) * DM; const float* wr = WAB + (size_t)(which * 8 + h) * DM; float s = 0.f;
        for (int k = lane; k < DM; k += 64) s += bf2f(xr[k]) * wr[k];
        s = wave_sum(s); if (lane == 0) AB[which * 4 + i] = s;
    }
    __syncthreads();
    {
        const int part = w >> 2, i = w & 3; LAS float* y = Y + (part * 4 + i) * 128; const float a = y[lane], bq = y[64 + lane];
        const float ss = wave_sum(a * a + bq * bq); const float rs = (1.f / sqrtf(ss + EPS)) * (part == 0 ? 0.08838834764831845f : 1.f);
        y[lane] = a * rs; y[64 + lane] = bq * rs;
    }
    if (tid == 0) { const float Aneg = -expf(FIN(10)[h]), dtb = FIN(11)[h]; float gc = 0.f;
        for (int i = 0; i < 4; ++i) { const float g = Aneg * softplus_f(AB[i] + dtb); gc += g; AB[8 + i] = g; AB[12 + i] = 1.f / (1.f + expf(-AB[4 + i])); AB[16 + i] = gc; } }
    __syncthreads();
    {
#pragma unroll
        for (int pp = 0; pp < 4; ++pp) { const int pr = 4 * w + pp, which = pr >> 4, i = (pr >> 2) & 3, j = pr & 3;
            const LAS float* x = Y + ((which == 0 ? 1 : 0) * 4 + i) * 128; const LAS float* y = Y + (1 * 4 + j) * 128;
            float s = x[lane] * y[lane] + x[64 + lane] * y[64 + lane]; s = wave_sum(s); if (lane == 0) DOT[pr] = s; }
    }
    __syncthreads();
    float g_[4], be[4], gc[4];
#pragma unroll
    for (int i = 0; i < 4; ++i) { g_[i] = AB[8 + i]; be[i] = AB[12 + i]; gc[i] = AB[16 + i]; }
    float Tm[4][4];
    {
        float A[4][4];
#pragma unroll
        for (int i = 0; i < 4; ++i)
#pragma unroll
            for (int j = 0; j < 4; ++j) A[i][j] = (i > j) ? be[i] * DOT[i * 4 + j] * expf(gc[i] - gc[j]) : 0.f;
#pragma unroll
        for (int cc = 0; cc < 4; ++cc)
#pragma unroll
            for (int i = 0; i < 4; ++i) { float acc = (i == cc) ? 1.f : 0.f;
#pragma unroll
                for (int j = 0; j < 4; ++j) if (j < i) acc -= A[i][j] * Tm[j][cc];
                Tm[i][cc] = acc; }
    }
    {
        const int i = tid >> 7, x = tid & 127; float su = 0.f, sw = 0.f;
#pragma unroll
        for (int j = 0; j < 4; ++j) { su += Tm[i][j] * Y[(2 * 4 + j) * 128 + x] * be[j]; sw += Tm[i][j] * Y[(1 * 4 + j) * 128 + x] * be[j] * expf(gc[j]); }
        U[i * 128 + x] = su; W[i * 128 + x] = sw;
    }
    __syncthreads();
    const float* S0 = FIN(4) + ((size_t)bs * GH + h) * 128 * 128;
    float qs_acc;
    {
        const int i = tid >> 7, dv = tid & 127; float p = 0.f, qq = 0.f;
        const LAS float* wr = W + i * 128; const LAS float* qr = Y + (0 * 4 + i) * 128;
#pragma unroll 16
        for (int dk = 0; dk < 128; ++dk) { const float s = S0[(size_t)dk * 128 + dv]; p += wr[dk] * s; qq += qr[dk] * s; }
        VN[i * 128 + dv] = U[i * 128 + dv] - p; qs_acc = qq * expf(gc[i]);
    }
    __syncthreads();
    {
        const int i = tid >> 7, dv = tid & 127; float o = qs_acc;
#pragma unroll
        for (int j = 0; j < 4; ++j) if (j <= i) o += DOT[16 + i * 4 + j] * expf(gc[i] - gc[j]) * VN[j * 128 + dv];
        WSP(float, WS_OGDN)[(row0 + i) * DM + h * 128 + dv] = o;
    }
    {
        const int dv = tid & 127, dg = tid >> 7; const float el = expf(gc[3]);
        float kd[4], vn[4];
#pragma unroll
        for (int j = 0; j < 4; ++j) { kd[j] = expf(gc[3] - gc[j]); vn[j] = VN[j * 128 + dv]; }
        float* So = F.out + O_GDNS + ((size_t)bs * GH + h) * 128 * 128;
#pragma unroll 8
        for (int dk = dg * 32; dk < dg * 32 + 32; ++dk) { float s = S0[(size_t)dk * 128 + dv] * el;
#pragma unroll
            for (int j = 0; j < 4; ++j) s += Y[(1 * 4 + j) * 128 + dk] * kd[j] * vn[j];
            So[(size_t)dk * 128 + dv] = s; }
    }
    (void)g_;
    __syncthreads();
}

constexpr int P3_S = 0;
constexpr int P3_VN = 8192;
__device__ __forceinline__ void p3_scan(Frame& F, int bh, int s) {
    const int lane = F.lane, w = F.wave, fr = lane & 15, fq = lane >> 4;
    const int b = bh >> 3, h = bh & 7;
    LAS bf16* Sl = (LAS bf16*)(F.lds + P3_S); LAS bf16* Vl = (LAS bf16*)(F.lds + P3_VN);
    const bf16* GW = WSP(bf16, WS_GW); const bf16* GQ = WSP(bf16, WS_GQ); const bf16* GKT = WSP(bf16, WS_GKT); const bf16* GQK = WSP(bf16, WS_GQK);
    const float* GU = WSP(float, WS_GU); const float* GDEC = WSP(float, WS_GDEC);
    float* OG = WSP(float, WS_OGDN);
    f32x4 Sacc = {0.f, 0.f, 0.f, 0.f};
    { v2u z = {0u, 0u}; *(LAS v2u*)(Sl + fr * 136 + 16 * w + 4 * fq) = z; }
    __syncthreads();
    const int m = w & 3;
    struct P3Ops { bf16x8 a1[4], ak0, ak1, aq0, aq1; f32x4 u4; float dec; };
    P3Ops R0, R1, R2;
#define P3_FETCH(R, cc) do { const size_t ch_ = (size_t)bh * NCH + (cc); \
        const bf16* p1_ = (w < 4 ? GW : GQ) + ch_ * 8192 + (size_t)(16 * m + fr) * 128 + 8 * fq; \
        _Pragma("unroll") for (int k_ = 0; k_ < 4; ++k_) R.a1[k_] = ld8(p1_ + 32 * k_); \
        const bf16* pk_ = GKT + ch_ * 8192 + (size_t)(16 * w + fr) * 64 + 8 * fq; R.ak0 = ld8(pk_); R.ak1 = ld8(pk_ + 32); \
        const bf16* pq_ = GQK + ch_ * 4096 + (size_t)(16 * m + fr) * 64 + 8 * fq; R.aq0 = ld8(pq_); R.aq1 = ld8(pq_ + 32);        \
        R.u4 = *((const f32x4*)(GU + ch_ * 8192) + (size_t)s * 256 + m * 64 + lane); \
        R.dec = GDEC[ch_]; } while (0)
#define P3_STEP(R, c) do { \
        f32x4 acc = {0.f, 0.f, 0.f, 0.f}; \
        _Pragma("unroll") for (int k = 0; k < 4; ++k) acc = MFMA16(R.a1[k], ld8l(Sl + fr * 136 + 32 * k + 8 * fq), acc); \
        if (w < 4) { const f32x4 vn = R.u4 - acc; v2u o; o.x = pk2(vn[0], vn[1]); o.y = pk2(vn[2], vn[3]); *(LAS v2u*)(Vl + fr * 72 + 16 * m + 4 * fq) = o; } \
        asm volatile("s_waitcnt lgkmcnt(0)\n\ts_barrier" ::: "memory"); \
        const bf16x8 v0 = ld8l(Vl + fr * 72 + 8 * fq), v1 = ld8l(Vl + fr * 72 + 32 + 8 * fq); \
        if (w >= 4) { acc = MFMA16(R.aq0, v0, acc); acc = MFMA16(R.aq1, v1, acc); \
            float* o = OG + ((size_t)b * PT + (c) * CHUNK + 16 * m + 4 * fq) * DM + h * 128 + 16 * s + fr; \
            _Pragma("unroll") for (int r = 0; r < 4; ++r) o[(size_t)r * DM] = acc[r]; } \
        Sacc = Sacc * R.dec; Sacc = MFMA16(R.ak0, v0, Sacc); Sacc = MFMA16(R.ak1, v1, Sacc); \
        { v2u o; o.x = pk2(Sacc[0], Sacc[1]); o.y = pk2(Sacc[2], Sacc[3]); *(LAS v2u*)(Sl + fr * 136 + 16 * w + 4 * fq) = o; } \
        asm volatile("s_waitcnt lgkmcnt(0)\n\ts_barrier" ::: "memory"); } while (0)
    P3_FETCH(R0, 0); P3_FETCH(R1, 1); P3_FETCH(R2, 2);
    static_assert(NCH % 3 == 2, "ring schedule below assumes NCH = 3k + 2");
#pragma unroll 1
    for (int c = 0; c + 3 <= NCH; c += 3) {
        P3_STEP(R0, c);     P3_FETCH(R0, (c + 3 < NCH ? c + 3 : NCH - 1));
        P3_STEP(R1, c + 1); P3_FETCH(R1, (c + 4 < NCH ? c + 4 : NCH - 1));
        P3_STEP(R2, c + 2); P3_FETCH(R2, (c + 5 < NCH ? c + 5 : NCH - 1));
    }
    P3_STEP(R0, NCH - 2); P3_STEP(R1, NCH - 1);
#undef P3_FETCH
#undef P3_STEP
    float* So = F.out + O_GDNP + ((size_t)bh * 128) * 128;
#pragma unroll
    for (int r = 0; r < 4; ++r) So[(size_t)(16 * w + 4 * fq + r) * 128 + 16 * s + fr] = Sacc[r];
}

__device__ __forceinline__ void p4_row(Frame& F, int row) {
    const int lane = F.lane;
    const float* o = WSP(float, WS_OGDN) + (size_t)row * DM + 16 * lane;
    const bf16* z = WSP(bf16, WS_PROJ) + (size_t)row * 4096 + 3072 + 16 * lane;
    f32x4 v[4]; float ss = 0.f;
#pragma unroll
    for (int j = 0; j < 4; ++j) { v[j] = *(const f32x4*)(o + 4 * j); ss += (v[j].x * v[j].x + v[j].y * v[j].y) + (v[j].z * v[j].z + v[j].w * v[j].w); }
    ss += dpp_f<DPP_XOR1>(ss); ss += dpp_f<DPP_XOR2>(ss); ss += dpp_f<DPP_HMIR>(ss);
    const float rstd = 1.f / sqrtf(ss * (1.f / 128.f) + EPS);
    const v4u z0 = *(const v4u*)z, z1 = *(const v4u*)(z + 8);
    const float* gn = FIN(12) + (16 * lane & 127);
    float zz[16] = {bflo(z0.x), bfhi(z0.x), bflo(z0.y), bfhi(z0.y), bflo(z0.z), bfhi(z0.z), bflo(z0.w), bfhi(z0.w),
                    bflo(z1.x), bfhi(z1.x), bflo(z1.y), bfhi(z1.y), bflo(z1.z), bfhi(z1.z), bflo(z1.w), bfhi(z1.w)};
    unsigned ow[8];
#pragma unroll
    for (int j = 0; j < 8; ++j) { const float a = v[j >> 1][(2 * j) & 3] * rstd * gn[2 * j] * silu_f(zz[2 * j]), bq = v[j >> 1][(2 * j + 1) & 3] * rstd * gn[2 * j + 1] * silu_f(zz[2 * j + 1]); ow[j] = pk2(a, bq); }
    v4u* dst = (v4u*)(WSP(bf16, WS_OG) + (size_t)row * DM + 16 * lane);
    dst[0] = (v4u){ow[0], ow[1], ow[2], ow[3]}; dst[1] = (v4u){ow[4], ow[5], ow[6], ow[7]};
}

typedef __bf16 bf16x2_t __attribute__((ext_vector_type(2)));
__device__ __forceinline__ float dot2_bf16(unsigned w, unsigned x, float acc) { return __builtin_amdgcn_fdot2_f32_bf16(__builtin_bit_cast(bf16x2_t, w), __builtin_bit_cast(bf16x2_t, x), acc, false); }
__device__ __forceinline__ float u2f(unsigned u) { return __builtin_bit_cast(float, u); }
__device__ __forceinline__ unsigned f2u(float f) { return __builtin_bit_cast(unsigned, f); }

constexpr int P8_TOP = 0;
constexpr int P8_TAB = 24576;
__device__ __forceinline__ void p8_init_tab(Frame& F) {
    LAS unsigned char* tab = F.lds + P8_TAB;
    if (F.tid < 64) { const int k = F.tid; int i = 0, j = 0;
        if (k < 16) { i = 0; j = k; } else if (k < 24) { i = 1; j = k - 16; } else if (k < 29) { i = 2; j = k - 24; } else if (k < 33) { i = 3; j = k - 29; }
        else if (k < 36) { i = 4; j = k - 33; } else if (k < 38) { i = 5; j = k - 36; } else if (k < 40) { i = 6; j = k - 38; } else if (k < 42) { i = 7; j = k - 40; } else if (k < 50) { i = k - 34; j = 0; }
        tab[k] = (unsigned char)i; tab[64 + k] = (unsigned char)j; }
    __syncthreads();
}
template <int CTRL> __device__ __forceinline__ float dppf(float x) { return __builtin_bit_cast(float, __builtin_amdgcn_update_dpp(0, __builtin_bit_cast(int, x), CTRL, 0xF, 0xF, true)); }
__device__ __forceinline__ float row_max16(float x) {
    x = fmaxf(x, dppf<0xB1>(x)); x = fmaxf(x, dppf<0x4E>(x)); x = fmaxf(x, dppf<0x141>(x)); x = fmaxf(x, dppf<0x140>(x)); return x;
}
#define CSWAP(a, b) { const float hi_ = fmaxf(a, b), lo_ = fminf(a, b); a = hi_; b = lo_; }
__device__ __forceinline__ void p8_unit(Frame& F, int unit, int layer) {
    int lane_ = F.lane; asm volatile("" : "+v"(lane_));
    const int lane = lane_, w = F.wave, fr = lane & 15, fq = lane >> 4;
    LAS unsigned char* L = F.lds; asm volatile("" : "+v"(L));
    LAS unsigned* topl = (LAS unsigned*)(L + P8_TOP + w * 3072);
    LAS float* wins = (LAS float*)(L + P8_TOP + w * 3072 + 2048);
    const LAS unsigned char* tab = L + P8_TAB;
    const int r0 = unit * 16;
    const bf16* Q = WSP(bf16, WS_QPEER) + (size_t)(r0 + fr) * 2048 + w * 256 + 8 * fq;
    const bf16* SK = WSP(bf16, WS_SUBK) + (size_t)((layer * 8 + w) * 2) * 16384 + (size_t)fr * 128 + 8 * fq;
    const float NEGINF = -__builtin_inff();
#pragma unroll 1
    for (int p = 0; p < 2; ++p) {
        bf16x8 aq[4];
#pragma unroll
        for (int ks = 0; ks < 4; ++ks) aq[ks] = ld8(Q + p * 128 + 32 * ks);
        float s[4][8];
#pragma unroll
        for (int nt = 0; nt < 8; ++nt) { f32x4 acc = {0.f, 0.f, 0.f, 0.f};
#pragma unroll
            for (int ks = 0; ks < 4; ++ks) acc = MFMA16(aq[ks], ld8(SK + (size_t)p * 16384 + (size_t)nt * 2048 + 32 * ks), acc);
#pragma unroll
            for (int r = 0; r < 4; ++r) s[r][nt] = u2f((f2u(acc[r]) & ~127u) | (unsigned)(16 * nt + fr)); }
#pragma unroll
        for (int r = 0; r < 4; ++r) {
            CSWAP(s[r][0], s[r][1]) CSWAP(s[r][2], s[r][3]) CSWAP(s[r][4], s[r][5]) CSWAP(s[r][6], s[r][7])
            CSWAP(s[r][0], s[r][2]) CSWAP(s[r][1], s[r][3]) CSWAP(s[r][4], s[r][6]) CSWAP(s[r][5], s[r][7])
            CSWAP(s[r][1], s[r][2]) CSWAP(s[r][5], s[r][6]) CSWAP(s[r][0], s[r][4]) CSWAP(s[r][3], s[r][7])
            CSWAP(s[r][1], s[r][5]) CSWAP(s[r][2], s[r][6]) CSWAP(s[r][1], s[r][4]) CSWAP(s[r][3], s[r][6])
            CSWAP(s[r][2], s[r][4]) CSWAP(s[r][3], s[r][5]) CSWAP(s[r][3], s[r][4]) }
#pragma unroll 1
        for (int rd = 0; rd < 16; ++rd) {
#pragma unroll
            for (int r = 0; r < 4; ++r) {
                const float mx = row_max16(s[r][0]);
                const bool pop = f2u(s[r][0]) == f2u(mx);
#pragma unroll
                for (int i = 0; i < 7; ++i) s[r][i] = pop ? s[r][i + 1] : s[r][i];
                s[r][7] = pop ? NEGINF : s[r][7];
                if (fr == 0) topl[((4 * fq + r) * 2 + p) * 16 + rd] = f2u(mx);
            }
        }
    }
    LDS_WAIT();
    float c[4][4];
#pragma unroll
    for (int r = 0; r < 4; ++r) { const int tk = 4 * fq + r;
#pragma unroll
        for (int m = 0; m < 4; ++m) { const int k = fr + 16 * m; float cv = NEGINF;
            if (k < 50) { const int i = tab[k], j = tab[64 + k]; const float s1 = u2f(topl[(tk * 2 + 0) * 16 + i] & ~127u), s2 = u2f(topl[(tk * 2 + 1) * 16 + j] & ~127u);
                cv = u2f((f2u(s1 + s2) & ~63u) | (unsigned)k); }
            c[r][m] = cv; }
        CSWAP(c[r][0], c[r][1]) CSWAP(c[r][2], c[r][3]) CSWAP(c[r][0], c[r][2]) CSWAP(c[r][1], c[r][3]) CSWAP(c[r][1], c[r][2]) }
#pragma unroll 1
    for (int rd = 0; rd < 16; ++rd) {
#pragma unroll
        for (int r = 0; r < 4; ++r) {
            const float mx = row_max16(c[r][0]);
            const bool pop = f2u(c[r][0]) == f2u(mx);
            c[r][0] = pop ? c[r][1] : c[r][0]; c[r][1] = pop ? c[r][2] : c[r][1]; c[r][2] = pop ? c[r][3] : c[r][2]; c[r][3] = pop ? NEGINF : c[r][3];
            if (fr == 0) wins[(4 * fq + r) * 16 + rd] = mx;
        }
    }
    LDS_WAIT();
    {
        const int tk = 4 * fq + (fr >> 2), q4 = fr & 3;
        const float w0 = wins[tk * 16]; float den = 0.f;
#pragma unroll
        for (int rd = 0; rd < 16; ++rd) den += __expf(wins[tk * 16 + rd] - w0);
        const float inv = 1.f / den;
        int e[4]; float g[4];
#pragma unroll
        for (int x = 0; x < 4; ++x) { const float wv = wins[tk * 16 + 4 * q4 + x]; const int k = (int)(f2u(wv) & 63u); const int i = tab[k], j = tab[64 + k];
            e[x] = (int)(topl[(tk * 2 + 0) * 16 + i] & 127u) * 128 + (int)(topl[(tk * 2 + 1) * 16 + j] & 127u); g[x] = __expf(wv - w0) * inv; }
        unsigned short* pei = WSP(unsigned short, WS_PEI) + (size_t)(r0 + tk) * 128 + w * 16 + 4 * q4; float* peg = WSP(float, WS_PEG) + (size_t)(r0 + tk) * 128 + w * 16 + 4 * q4;
        *(v2u*)pei = (v2u){(unsigned)e[0] | ((unsigned)e[1] << 16), (unsigned)e[2] | ((unsigned)e[3] << 16)};
        *(f32x4*)peg = (f32x4){g[0], g[1], g[2], g[3]};
    }
}

constexpr size_t PE_SLICE_BYTES = (size_t)NEXP * 128;
__device__ __forceinline__ f32x2 p9_cvt(unsigned w, bool hi) { return hi ? __builtin_amdgcn_cvt_pk_f32_fp8((int)w, true) : __builtin_amdgcn_cvt_pk_f32_fp8((int)w, false); }
__device__ __forceinline__ f32x2 fma2(f32x2 a, f32x2 b, f32x2 c) { return __builtin_elementwise_fma(a, b, c); }
__device__ __forceinline__ float p9_dot16(const v4u u, const f32x2 (&h)[8]) {
    f32x2 a = {0.f, 0.f}, b = {0.f, 0.f};
    a = fma2(p9_cvt(u.x, false), h[0], a); b = fma2(p9_cvt(u.x, true), h[1], b); a = fma2(p9_cvt(u.y, false), h[2], a); b = fma2(p9_cvt(u.y, true), h[3], b);
    a = fma2(p9_cvt(u.z, false), h[4], a); b = fma2(p9_cvt(u.z, true), h[5], b); a = fma2(p9_cvt(u.w, false), h[6], a); b = fma2(p9_cvt(u.w, true), h[7], b);
    a = a + b; return a.x + a.y;
}
__device__ __forceinline__ void p9_axpy16(const v4u v, float c, f32x2 (&o)[8]) {
    const f32x2 cc = {c, c};
    o[0] = fma2(p9_cvt(v.x, false), cc, o[0]); o[1] = fma2(p9_cvt(v.x, true), cc, o[1]); o[2] = fma2(p9_cvt(v.y, false), cc, o[2]); o[3] = fma2(p9_cvt(v.y, true), cc, o[3]);
    o[4] = fma2(p9_cvt(v.z, false), cc, o[4]); o[5] = fma2(p9_cvt(v.z, true), cc, o[5]); o[6] = fma2(p9_cvt(v.w, false), cc, o[6]); o[7] = fma2(p9_cvt(v.w, true), cc, o[7]);
}
#define P9_GATHER(S, iw) do { _Pragma("unroll") for (int j_ = 0; j_ < 8; ++j_) { const unsigned w_ = (iw)[j_ >> 1]; const unsigned id_ = (j_ & 1) ? (w_ >> 16) : (w_ & 0xffffu); \
        S[j_] = *(const v4u*)(tab + ((id_ << 7) + sub16)); } } while (0)
__device__ __forceinline__ float swapsum16(float x, float y) { unsigned a = __builtin_bit_cast(unsigned, x), b = __builtin_bit_cast(unsigned, y); PSWAP16(a, b); return __builtin_bit_cast(float, a) + __builtin_bit_cast(float, b); }
__device__ __forceinline__ float swapsum32(float x, float y) { unsigned a = __builtin_bit_cast(unsigned, x), b = __builtin_bit_cast(unsigned, y); PSWAP32(a, b); return __builtin_bit_cast(float, a) + __builtin_bit_cast(float, b); }

__device__ __forceinline__ void p9u_wave(Frame& F, int layer, int slice, int first, int stride) {
    int lane_ = F.lane; asm volatile("" : "+v"(lane_));
    const int lane = lane_, gi = lane >> 3, sub = lane & 7;
    const unsigned char* tab = WSP(unsigned char, WS_PU) + (size_t)(layer * 8 + slice) * PE_SLICE_BYTES;
    const unsigned sub16 = (unsigned)sub * 16u;
    const unsigned char* hbase = (const unsigned char*)(WSP(bf16, WS_XNB) + slice * 128 + sub * 16);
    const unsigned char* ibase = (const unsigned char*)(WSP(unsigned short, WS_PEI) + gi * 16);
    unsigned* pa = WSP(unsigned, WS_PA) + slice * 64 + lane;
    int t = first; if (t >= MTOK) return;
    v4u ia, ib, ha, hb, nia, nib, nha, nhb, A[8], B[8];
#define P9U_META(tt, xa, xb, ya, yb) do { const v4u* ip_ = (const v4u*)(ibase + (size_t)(tt) * 256); xa = ip_[0]; xb = ip_[1]; const v4u* hp_ = (const v4u*)(hbase + (size_t)(tt) * 2048); ya = hp_[0]; yb = hp_[1]; } while (0)
    P9U_META(t, ia, ib, ha, hb);
    P9_GATHER(A, ia);
    const bool b0 = sub & 1, b1 = sub & 2, b2 = sub & 4;
#pragma unroll 1
    for (;;) {
        const int tn = t + stride; const bool more = tn < MTOK; const int tl = more ? tn : t;
        P9U_META(tl, nia, nib, nha, nhb);
        P9_GATHER(B, ib);
        f32x2 h[8];
#pragma unroll
        for (int k = 0; k < 4; ++k) { h[k] = (f32x2){bflo(ha[k]), bfhi(ha[k])}; h[4 + k] = (f32x2){bflo(hb[k]), bfhi(hb[k])}; }
        float p[16];
#pragma unroll
        for (int j = 0; j < 8; ++j) p[j] = p9_dot16(A[j], h);
        P9_GATHER(A, nia);
#pragma unroll
        for (int j = 0; j < 8; ++j) p[8 + j] = p9_dot16(B[j], h);
        float q[8], r[4], sv[2];
#pragma unroll
        for (int i = 0; i < 8; ++i) { const float keep = b2 ? p[8 + i] : p[i], send = b2 ? p[i] : p[8 + i]; q[i] = keep + dpp_f<DPP_HMIR>(send); }
#pragma unroll
        for (int i = 0; i < 4; ++i) { const float keep = b0 ? q[2 * i + 1] : q[2 * i], send = b0 ? q[2 * i] : q[2 * i + 1]; r[i] = keep + dpp_f<DPP_XOR1>(send); }
#pragma unroll
        for (int i = 0; i < 2; ++i) { const float keep = b1 ? r[2 * i + 1] : r[2 * i], send = b1 ? r[2 * i] : r[2 * i + 1]; sv[i] = keep + dpp_f<DPP_XOR2>(send); }
        pa[(size_t)t * 512] = pk2(sv[0], sv[1]);
        if (!more) break;
        t = tn; ia = nia; ib = nib; ha = nha; hb = nhb;
    }
#undef P9U_META
}

__device__ __forceinline__ void p9v_wave(Frame& F, int layer, int slice, int first, int stride, int mode) {
    int lane_ = F.lane; asm volatile("" : "+v"(lane_));
    const int lane = lane_, gi = lane >> 3, sub = lane & 7, j0 = 8 * (sub >> 2) + (sub & 3);
    const unsigned char* tab = WSP(unsigned char, WS_PV) + (size_t)(layer * 8 + slice) * PE_SLICE_BYTES;
    const unsigned sub16 = (unsigned)sub * 16u;
    const unsigned char* ibase = (const unsigned char*)(WSP(unsigned short, WS_PEI) + gi * 16);
    const unsigned* pab = WSP(unsigned, WS_PA) + lane;
    const float* pegb = WSP(float, WS_PEG) + gi * 16 + j0;
    const int eoff = slice * 128 + sub * 16 + gi;
    float* xsb = WSP(float, WS_XS) + eoff;
    int t = first; if (t >= MTOK) return;
    v4u ia, ib, nia, nib, A[8], B[8];
    unsigned pw[8], npw[8]; float g0, g1, ng0, ng1, x0, x1, nx0, nx1;
#define P9V_META(tt, xa, xb, pp, ga, gb, ya, yb) do { const v4u* ip_ = (const v4u*)(ibase + (size_t)(tt) * 256); xa = ip_[0]; xb = ip_[1]; \
        _Pragma("unroll") for (int x_ = 0; x_ < 8; ++x_) pp[x_] = pab[(size_t)(tt) * 512 + x_ * 64]; \
        ga = pegb[(size_t)(tt) * 128]; gb = pegb[(size_t)(tt) * 128 + 4]; ya = xsb[(size_t)(tt) * DM]; yb = xsb[(size_t)(tt) * DM + 8]; } while (0)
    P9V_META(t, ia, ib, pw, g0, g1, x0, x1);
    P9_GATHER(A, ia);
#pragma unroll 1
    for (;;) {
        const int tn = t + stride; const bool more = tn < MTOK; const int tl = more ? tn : t;
        P9V_META(tl, nia, nib, npw, ng0, ng1, nx0, nx1);
        P9_GATHER(B, ib);
        float alo = 0.f, ahi = 0.f;
#pragma unroll
        for (int x = 0; x < 8; ++x) { alo += bflo(pw[x]); ahi += bfhi(pw[x]); }
        const float c0 = gelu_tanh(alo * 0.03125f) * g0 * 0.0625f, c1 = gelu_tanh(ahi * 0.03125f) * g1 * 0.0625f;
        f32x2 o[8];
#pragma unroll
        for (int i = 0; i < 8; ++i) o[i] = (f32x2){0.f, 0.f};
#define P9V_C(j) __builtin_bit_cast(float, __builtin_amdgcn_ds_swizzle(__builtin_bit_cast(int, (((j) >> 2) & 1) ? c1 : c0), ((4 * ((j) >> 3) + ((j) & 3)) << 5) | 0x18))
        { const float cj[8] = {P9V_C(0), P9V_C(1), P9V_C(2), P9V_C(3), P9V_C(4), P9V_C(5), P9V_C(6), P9V_C(7)};
#pragma unroll
          for (int j = 0; j < 8; ++j) p9_axpy16(A[j], cj[j], o); }
        P9_GATHER(A, nia);
        { const float cj[8] = {P9V_C(8), P9V_C(9), P9V_C(10), P9V_C(11), P9V_C(12), P9V_C(13), P9V_C(14), P9V_C(15)};
#pragma unroll
          for (int j = 0; j < 8; ++j) p9_axpy16(B[j], cj[j], o); }
#undef P9V_C
        const bool g0b = lane & 8;
        float q[8], r[4], sv[2];
#pragma unroll
        for (int i = 0; i < 8; ++i) { const float keep = g0b ? o[i].y : o[i].x, send = g0b ? o[i].x : o[i].y; q[i] = keep + dpp_f<DPP_ROR8>(send); }
#pragma unroll
        for (int i = 0; i < 4; ++i) r[i] = swapsum16(q[2 * i], q[2 * i + 1]);
#pragma unroll
        for (int i = 0; i < 2; ++i) sv[i] = swapsum32(r[2 * i], r[2 * i + 1]);
        const float y0 = x0 + sv[0], y1 = x1 + sv[1];
        if (mode == 0) {
            float* xs = xsb + (size_t)t * DM; xs[0] = y0; xs[8] = y1;
            bf16* xn = WSP(bf16, WS_XNA) + (size_t)t * DM + eoff; xn[0] = (bf16)f2bf(y0); xn[8] = (bf16)f2bf(y1);
            const float ss = wave_sum(y0 * y0 + y1 * y1);
            if (lane == 0) WSP(float, WS_SSQ)[(size_t)t * 8 + slice] = ss;
        } else {
            float* y = (t < MP ? F.out + O_YP + (size_t)t * DM : F.out + O_YS + (size_t)(t - MP) * DM) + eoff;
            y[0] = y0; y[8] = y1;
        }
        if (!more) break;
        t = tn; ia = nia; ib = nib; g0 = ng0; g1 = ng1; x0 = nx0; x1 = nx1;
#pragma unroll
        for (int x = 0; x < 8; ++x) pw[x] = npw[x];
    }
#undef P9V_META
}
#undef P9_GATHER

constexpr float QSCALE = 0.125f * 1.4426950408889634f;
constexpr int PP_VT = 0;
__device__ __forceinline__ float rms64(float v) { return 1.f / sqrtf(wave_sum(v * v) * (1.f / 64.f) + EPS); }

__device__ __forceinline__ void pp_q_row(Frame& F, int row, const float* kvq, const float qg) {
    const int lane = F.lane;
    bf16* qn = WSP(bf16, WS_QN) + (size_t)row * 1024;
#pragma unroll 4
    for (int hd = 0; hd < 16; ++hd) { const float v = kvq[NKV + hd * 64 + lane]; qn[hd * 64 + lane] = (bf16)f2bf(v * rms64(v) * qg); }
    if (lane < 48) WSP(float, WS_GATES)[(size_t)row * 48 + lane] = sigmoid_f(kvq[NKV + 1024 + lane]);
}
__device__ __forceinline__ void pp_prompt_tile(Frame& F, int unit) {
    const int lane = F.lane, w = F.wave, b = unit >> 7, t0 = (unit & 127) * 64;
    LAS unsigned char* L = F.lds; asm volatile("" : "+v"(L));
    LAS bf16* vt = (LAS bf16*)(L + PP_VT);
    const float kg1 = FIN(16)[64 + lane], kg2 = FIN(16)[128 + lane], qg = FIN(22)[lane] * QSCALE;
    for (int rr = 0; rr < 8; ++rr) {
        const int tl = 8 * w + rr, t = t0 + tl, row = b * PT + t;
        const float* kvq = WSP(float, WS_KVQ) + (size_t)row * NKVQ;
        float* okv = F.out + O_KVP + (size_t)row * 1024;
        const bool inwin = t >= PT - WINDOW;
        float* owin = F.out + O_WINP + ((size_t)b * 512 + (t - (PT - WINDOW))) * 512;
#pragma unroll
        for (int g = 0; g < 4; ++g) {
            const float v0 = kvq[0 * 256 + g * 64 + lane], v1 = kvq[1 * 256 + g * 64 + lane], v2 = kvq[2 * 256 + g * 64 + lane];
            const float v3 = kvq[3 * 256 + g * 64 + lane], v4 = kvq[4 * 256 + g * 64 + lane], v5 = kvq[5 * 256 + g * 64 + lane];
            const float ks = v2 * rms64(v2) * kg1, kw = v4 * rms64(v4) * kg2;
            okv[0 * 256 + g * 64 + lane] = v0; okv[1 * 256 + g * 64 + lane] = v1; okv[2 * 256 + g * 64 + lane] = ks; okv[3 * 256 + g * 64 + lane] = v3;
            if (inwin) { owin[g * 64 + lane] = kw; owin[256 + g * 64 + lane] = v5; }
            const size_t kidx = (((size_t)b * NG + g) * PT + t) * 64 + lane;
            WSP(bf16, WS_KSEL)[kidx] = (bf16)f2bf(ks); WSP(bf16, WS_KWIN)[kidx] = (bf16)f2bf(kw);
            vt[((0 * 4 + g) * 64 + lane) * 72 + tl] = (bf16)f2bf(v3); vt[((1 * 4 + g) * 64 + lane) * 72 + tl] = (bf16)f2bf(v5);
        }
        pp_q_row(F, row, kvq, qg);
    }
    __syncthreads();
    {
        const int which = F.tid >> 8, gd = F.tid & 255;
        bf16* dst = WSP(bf16, which == 0 ? WS_VSELT : WS_VWINT) + (((size_t)b * NG * 64 + gd) * PT + t0);
        const LAS bf16* src = vt + ((which * 256 + gd) * 72);
#pragma unroll
        for (int i = 0; i < 8; ++i) *(v4u*)(dst + 8 * i) = *(const LAS v4u*)(src + 8 * i);
    }
    __syncthreads();
}
__device__ __forceinline__ void pp_sample_row(Frame& F, int sr) {
    const int lane = F.lane, bs = sr >> 2, i = sr & 3, row = MP + sr;
    const float kg1 = FIN(16)[64 + lane], kg2 = FIN(16)[128 + lane], qg = FIN(22)[lane] * QSCALE;
    const float* kvq = WSP(float, WS_KVQ) + (size_t)row * NKVQ;
    float* okv = F.out + O_KVS + (size_t)sr * 1024;
    float* owin = F.out + O_WINS + ((size_t)bs * 512 + 508 + i) * 512;
#pragma unroll
    for (int g = 0; g < 4; ++g) {
        const float v0 = kvq[0 * 256 + g * 64 + lane], v1 = kvq[1 * 256 + g * 64 + lane], v2 = kvq[2 * 256 + g * 64 + lane];
        const float v3 = kvq[3 * 256 + g * 64 + lane], v4 = kvq[4 * 256 + g * 64 + lane], v5 = kvq[5 * 256 + g * 64 + lane];
        const float ks = v2 * rms64(v2) * kg1, kw = v4 * rms64(v4) * kg2;
        okv[0 * 256 + g * 64 + lane] = v0; okv[1 * 256 + g * 64 + lane] = v1; okv[2 * 256 + g * 64 + lane] = ks; okv[3 * 256 + g * 64 + lane] = v3;
        owin[g * 64 + lane] = kw; owin[256 + g * 64 + lane] = v5;
        const size_t bg = (size_t)bs * NG + g;
        WSP(bf16, WS_SKWIN)[(bg * 544 + 512 + i) * 64 + lane] = (bf16)f2bf(kw);
        WSP(bf16, WS_SVWINT)[(bg * 64 + lane) * 544 + 512 + i] = (bf16)f2bf(v5);
        float* sn = WSP(float, WS_SNEW) + (((size_t)bs * 4 + i) * 2) * 256 + g * 64 + lane;
        sn[0] = ks; sn[256] = v3;
    }
    pp_q_row(F, row, kvq, qg);
}

__device__ __forceinline__ void compress_finish(Frame& F, const f32x4 (&acc)[4], int kv, int blk, bf16* KC, bf16* VCT) {
    const int lane = F.lane, fr = lane & 15, fq = lane >> 4;
    const float* pet = WSP(float, WS_PETERM) + kv * 64;
    bf16x8 hb[2];
#pragma unroll
    for (int s = 0; s < 2; ++s) { f32x4 h0, h1;
#pragma unroll
        for (int r = 0; r < 4; ++r) { h0[r] = gelu_tanh(acc[2 * s][r] + pet[16 * (2 * s) + 4 * fq + r]); h1[r] = gelu_tanh(acc[2 * s + 1][r] + pet[16 * (2 * s + 1) + 4 * fq + r]); }
        hb[s] = cvt8(h0, h1); }
    const float* w2 = FIN(19) + (size_t)kv * 64 * 64;
    f32x4 o[4];
#pragma unroll
    for (int dt = 0; dt < 4; ++dt) { o[dt] = (f32x4){0.f, 0.f, 0.f, 0.f};
#pragma unroll
        for (int s = 0; s < 2; ++s) { f32x4 a0, a1;
#pragma unroll
            for (int jj = 0; jj < 4; ++jj) { a0[jj] = w2[(size_t)(16 * (2 * s) + 4 * fq + jj) * 64 + 16 * dt + fr]; a1[jj] = w2[(size_t)(16 * (2 * s + 1) + 4 * fq + jj) * 64 + 16 * dt + fr]; }
            o[dt] = MFMA16(cvt8(a0, a1), hb[s], o[dt]); } }
    if (kv == 0) {
        float ss = 0.f;
#pragma unroll
        for (int dt = 0; dt < 4; ++dt) ss += (o[dt][0] * o[dt][0] + o[dt][1] * o[dt][1]) + (o[dt][2] * o[dt][2] + o[dt][3] * o[dt][3]);
        ss = x32_sum(x16_sum(ss));
        const float rstd = 1.f / sqrtf(ss * (1.f / 64.f) + EPS);
        const float* kg0 = FIN(16);
        if (blk < NCMP) {
#pragma unroll
            for (int dt = 0; dt < 4; ++dt) { const int d = 16 * dt + 4 * fq; v2u ov; ov.x = pk2(o[dt][0] * rstd * kg0[d], o[dt][1] * rstd * kg0[d + 1]); ov.y = pk2(o[dt][2] * rstd * kg0[d + 2], o[dt][3] * rstd * kg0[d + 3]);
                *(v2u*)(KC + (size_t)blk * 64 + d) = ov; }
        } else {
#pragma unroll
            for (int dt = 0; dt < 4; ++dt) *(v2u*)(KC + (size_t)blk * 64 + 16 * dt + 4 * fq) = (v2u){0u, 0u};
        }
    } else {
#pragma unroll
        for (int dt = 0; dt < 4; ++dt)
#pragma unroll
            for (int r = 0; r < 4; ++r) VCT[(size_t)(16 * dt + 4 * fq + r) * 512 + blk] = (blk < NCMP) ? (bf16)f2bf(o[dt][r]) : (bf16)0;
    }
}

template <class RowP>
__device__ __forceinline__ void compress_tile(Frame& F, const RowP& rowp, int kv, int j, bf16* KC, bf16* VCT) {
    const int lane = F.lane, fr = lane & 15, fq = lane >> 4;
    const bf16* W1 = WSP(bf16, WS_W1T) + (size_t)kv * 64 * 2048 + (size_t)fr * 2048 + 8 * fq;
    const int blk = 16 * j + fr;
    f32x4 acc[4];
#pragma unroll
    for (int mt = 0; mt < 4; ++mt) acc[mt] = (f32x4){0.f, 0.f, 0.f, 0.f};
#pragma unroll 2
    for (int r = 0; r < 32; ++r) {
        int t = 16 * blk + r; t = t < PAST ? t : PAST - 1;
        const float* rp = rowp(t) + 8 * fq;
#pragma unroll
        for (int hf = 0; hf < 2; ++hf) {
            const f32x4 x0 = *(const f32x4*)(rp + 32 * hf), x1 = *(const f32x4*)(rp + 32 * hf + 4);
            const bf16x8 bfrag = cvt8(x0, x1);
            const int ks = 2 * r + hf;
#pragma unroll
            for (int mt = 0; mt < 4; ++mt) acc[mt] = MFMA16(ld8(W1 + (size_t)mt * 16 * 2048 + 32 * ks), bfrag, acc[mt]);
        }
    }
    compress_finish(F, acc, kv, blk, KC, VCT);
}
struct RowPPrompt { const float* base; __device__ __forceinline__ const float* operator()(int t) const { return base + (size_t)t * NKVQ; } };
struct RowPSample { const float* cache; const int* pt; __device__ __forceinline__ const float* operator()(int t) const { return cache + ((size_t)pt[t >> 7] * PAGE + (t & 127)) * 1024; } };

__device__ __forceinline__ void compress_prompt(Frame& F, int id) {
    const int kv = id & 1, j = (id >> 1) & 31, bg = id >> 6, b = bg >> 2, g = bg & 3;
    RowPPrompt rp{WSP(float, WS_KVQ) + (size_t)b * PT * NKVQ + kv * 256 + g * 64};
    compress_tile(F, rp, kv, j, WSP(bf16, WS_KCMP) + (size_t)bg * 512 * 64, WSP(bf16, WS_VCMPT) + (size_t)bg * 64 * 512);
}
__device__ __forceinline__ void compress_sample(Frame& F, int id) {
    const int kv = id & 1, j = (id >> 1) & 31, bg = id >> 6, lane = F.lane, fr = lane & 15, fq = lane >> 4;
    const int blk = 16 * j + fr, nb = blk < 511 ? blk + 1 : 511;
    const float* f1 = WSP(float, WS_FS) + ((size_t)bg * 512 + blk) * 256 + kv * 128 + 4 * fq;
    const float* f2 = WSP(float, WS_FS) + ((size_t)bg * 512 + nb) * 256 + kv * 128 + 64 + 4 * fq;
    f32x4 acc[4];
#pragma unroll
    for (int mt = 0; mt < 4; ++mt) acc[mt] = *(const f32x4*)(f1 + 16 * mt) + *(const f32x4*)(f2 + 16 * mt);
    compress_finish(F, acc, kv, blk, WSP(bf16, WS_SKCMP) + (size_t)bg * 512 * 64, WSP(bf16, WS_SVCMPT) + (size_t)bg * 64 * 512);
}

constexpr int NSA_IMP = 0;
constexpr int NSA_Q = 67584;
constexpr int NSA_QLD = 68;
constexpr float LOG2E = 1.4426950408889634f;
#ifndef NSA_SUBUNITS
#define NSA_SUBUNITS 0
#endif
__device__ __forceinline__ float ex2(float x) { return __builtin_amdgcn_exp2f(x); }

struct KvBf16 {
    const bf16* K; const bf16* VT; int ld;
    __device__ __forceinline__ void lane_offsets(int fr, int fq, unsigned& ko, unsigned& vo) const {
        ko = (unsigned)(((8 * (fr >> 2) + (fr & 3)) * 64 + 8 * fq) * 2); vo = (unsigned)((fr * ld + 8 * fq) * 2);
        asm volatile("" : "+v"(ko), "+v"(vo));
    }
    __device__ __forceinline__ bf16x8 kf(int key0, int mt, int ks, unsigned ko) const {
        return *(const bf16x8*)((const char*)K + (size_t)key0 * 128 + (ko + (unsigned)((4 * mt * 64 + 32 * ks) * 2))); }
    __device__ __forceinline__ bf16x8 vf(int key0, int dt, unsigned vo) const {
        return *(const bf16x8*)((const char*)VT + (size_t)key0 * 2 + (vo + (unsigned)(16 * dt * ld * 2))); }
};
struct KvSampleSel {
    const float* cache; const int* pt; const float* snew; int g;
    __device__ __forceinline__ const float* krow(int pos, int slot) const {
        if (pos < PAST) return cache + ((size_t)pt[pos >> 7] * PAGE + (pos & 127)) * 1024 + slot * 256;
        int i = pos - PAST; i = i < 3 ? i : 3; return snew + (size_t)i * 512 + (slot - 2) * 256; }
    __device__ __forceinline__ void lane_offsets(int fr, int fq, unsigned& ko, unsigned& vo) const { ko = (unsigned)(fr | (fq << 8)); vo = ko; asm volatile("" : "+v"(ko), "+v"(vo)); }
    __device__ __forceinline__ bf16x8 kf(int key0, int mt, int ks, unsigned ko) const { const int fr = ko & 255, fq = ko >> 8;
        const float* p = krow(key0 + 8 * (fr >> 2) + 4 * mt + (fr & 3), 2) + 32 * ks + 8 * fq; return cvt8(*(const f32x4*)p, *(const f32x4*)(p + 4)); }
    __device__ __forceinline__ bf16x8 vf(int key0, int dt, unsigned vo) const { const int fr = vo & 255, fq = vo >> 8; f32x4 a, b;
#pragma unroll
        for (int j = 0; j < 4; ++j) { a[j] = krow(key0 + 8 * fq + j, 3)[16 * dt + fr]; b[j] = krow(key0 + 8 * fq + 4 + j, 3)[16 * dt + fr]; }
        return cvt8(a, b); }
};
struct KvFrags { bf16x8 k[2][2]; bf16x8 v[4]; };
template <bool WITHV, class KV>
__device__ __forceinline__ void nsa_load(const KV& kv, int key0, int fr, int fq, KvFrags& f) {
    unsigned ko, vo; kv.lane_offsets(fr, fq, ko, vo);
#pragma unroll
    for (int mt = 0; mt < 2; ++mt)
#pragma unroll
        for (int ks = 0; ks < 2; ++ks) f.k[mt][ks] = kv.kf(key0, mt, ks, ko);
    if (WITHV) {
#pragma unroll
        for (int dt = 0; dt < 4; ++dt) f.v[dt] = kv.vf(key0, dt, vo);
    }
}

template <int NT, int MODE, bool QREG = false>
__device__ __forceinline__ void nsa_core(const KvFrags& f, int key0, const LAS bf16* qrow, int qnt, f32x4 (&O)[NT][4], float (&m)[NT], float (&l)[NT], const float (&invl)[NT], const float (&slope)[NT],
                                         int t, int pmul, int padd, int wlim, bool selok, LAS float* improw, int fq, const bf16x8* qreg = nullptr) {
    float dist[2][4]; bool val[2][4];
#pragma unroll
    for (int mt = 0; mt < 2; ++mt)
#pragma unroll
        for (int r = 0; r < 4; ++r) { const int kk = key0 + 8 * fq + 4 * mt + r; const int dd = t - (pmul * kk + padd); dist[mt][r] = (float)dd; val[mt][r] = selok && dd >= 0 && dd < wlim; }
    float imp_main[2] = {0.f, 0.f}, imp_spill[2] = {0.f, 0.f};
#pragma unroll
    for (int nt = 0; nt < NT; ++nt) {
        f32x4 s[2];
        bf16x8 q0, q1; if (QREG) { q0 = qreg[nt * 2]; q1 = qreg[nt * 2 + 1]; } else { q0 = ld8l(qrow + nt * qnt + 8 * fq); q1 = ld8l(qrow + nt * qnt + 32 + 8 * fq); }
#pragma unroll
        for (int mt = 0; mt < 2; ++mt) { s[mt] = (f32x4){0.f, 0.f, 0.f, 0.f}; s[mt] = MFMA16(f.k[mt][0], q0, s[mt]); s[mt] = MFMA16(f.k[mt][1], q1, s[mt]); }
        f32x4 p[2]; float ps = 0.f;
#pragma unroll
        for (int mt = 0; mt < 2; ++mt)
#pragma unroll
            for (int r = 0; r < 4; ++r) { float pv = ex2(val[mt][r] ? (s[mt][r] - slope[nt] * dist[mt][r]) : -200.f); if (MODE == 2) pv *= invl[nt]; p[mt][r] = pv; ps += pv; }
        if (MODE != 2) l[nt] += ps;
        if (MODE == 2) {
#pragma unroll
            for (int mt = 0; mt < 2; ++mt) { imp_main[mt] += (p[mt][0] + p[mt][1]) + (p[mt][2] + p[mt][3]); imp_spill[mt] += p[mt][3]; }
        }
        if (MODE != 1) {
            const bf16x8 pf = cvt8(p[0], p[1]);
#pragma unroll
            for (int dt = 0; dt < 4; ++dt) O[nt][dt] = MFMA16(f.v[dt], pf, O[nt][dt]);
        }
    }
    if (MODE == 2) {
#pragma unroll
        for (int mt = 0; mt < 2; ++mt) { const int j = key0 / 4 + 2 * fq + mt;
            __hip_atomic_fetch_add(improw + j, imp_main[mt], __ATOMIC_RELAXED, __HIP_MEMORY_SCOPE_WORKGROUP);
            __hip_atomic_fetch_add(improw + j + 1, imp_spill[mt], __ATOMIC_RELAXED, __HIP_MEMORY_SCOPE_WORKGROUP); }
    }
}
template <int NT, int MODE, class KV>
__device__ __forceinline__ void nsa_tile(const KV& kv, int key0, const LAS bf16* qrow, int qnt, f32x4 (&O)[NT][4], float (&m)[NT], float (&l)[NT], const float (&invl)[NT], const float (&slope)[NT],
                                         int t, int pmul, int padd, int wlim, bool selok, LAS float* improw, int fr, int fq) {
    KvFrags f; nsa_load<MODE != 1>(kv, key0, fr, fq, f);
    nsa_core<NT, MODE>(f, key0, qrow, qnt, O, m, l, invl, slope, t, pmul, padd, wlim, selok, improw, fq);
}

template <int NT>
__device__ __forceinline__ void nsa_zero(f32x4 (&O)[NT][4], float (&m)[NT], float (&l)[NT]) {
#pragma unroll
    for (int nt = 0; nt < NT; ++nt) { m[nt] = -1e30f; l[nt] = 0.f;
#pragma unroll
        for (int dt = 0; dt < 4; ++dt) O[nt][dt] = (f32x4){0.f, 0.f, 0.f, 0.f}; }
}

template <bool SAMPLE>
__device__ __forceinline__ void nsa_unit(Frame& F, int id) {
    constexpr int NT = SAMPLE ? 1 : 4;
    int lane_ = F.lane; asm volatile("" : "+v"(lane_));
    const int lane = lane_, fr = lane & 15, fq = lane >> 4;
    LAS unsigned char* L = F.lds; asm volatile("" : "+v"(L));
    LAS float* imp = (LAS float*)(L + NSA_IMP + F.wave * 8448);
    LAS bf16* qw = (LAS bf16*)(L + NSA_Q + F.wave * 8704);
    int bg, g, t, row, trow, tmax, row0;
    if (SAMPLE) { bg = id; g = id & 3; t = PAST + (fr >> 2); row0 = MP + (id >> 2) * 4; row = row0 + (fr >> 2); trow = fr >> 2; tmax = PAST + 3; }
    else { bg = id >> 9; g = bg & 3; const int tt = id & 511; t = 16 * tt + fr; row0 = (bg >> 2) * PT + 16 * tt; row = row0 + fr; trow = fr; tmax = 16 * tt + 15; }
    {
        const int nrow = SAMPLE ? 16 : 64;
        for (int i = lane; i < nrow * 8; i += 64) { const int rr = i >> 3, c8 = i & 7;
            *(LAS v4u*)(qw + rr * NSA_QLD + 8 * c8) = *(const v4u*)(WSP(bf16, WS_QN) + (size_t)(row0 + (rr >> 2)) * 1024 + (g * 4 + (rr & 3)) * 64 + 8 * c8); }
    }
    float slope[NT]; int hd[NT];
#pragma unroll
    for (int nt = 0; nt < NT; ++nt) { hd[nt] = g * 4 + (SAMPLE ? (fr & 3) : nt); slope[nt] = ex2(-0.5f * (float)(hd[nt] + 1)) * LOG2E; }
    const LAS bf16* qrow = qw + (SAMPLE ? fr : fr * 4) * NSA_QLD; const int qnt = SAMPLE ? 0 : NSA_QLD;
    const float* gates = WSP(float, WS_GATES) + (size_t)row * 48;
    float* oacc = WSP(float, WS_OACC) + (size_t)row * 1024;
    for (int i = lane; i < 16 * 132; i += 64) imp[i] = 0.f;
    LDS_WAIT();
    f32x4 O[NT][4]; float m[NT], l[NT], invl[NT];
    {
        KvBf16 kv{WSP(bf16, SAMPLE ? WS_SKCMP : WS_KCMP) + (size_t)bg * 512 * 64, WSP(bf16, SAMPLE ? WS_SVCMPT : WS_VCMPT) + (size_t)bg * 64 * 512, 512};
        const int cmax = (tmax - 31) >> 4;
        const int ntile = (tmax >= 31) ? ((cmax < 510 ? cmax : 510) / 32 + 1) : 0;
#pragma unroll
        for (int nt = 0; nt < NT; ++nt) invl[nt] = 0.f;
        nsa_zero<NT>(O, m, l);
        { KvFrags fa, fb; if (ntile > 0) nsa_load<false>(kv, 0, fr, fq, fa);
#pragma unroll 1
          for (int tl = 0; tl < ntile; ++tl) { if (tl + 1 < ntile) nsa_load<false>(kv, 32 * (tl + 1), fr, fq, fb);
            nsa_core<NT, 1>(fa, 32 * tl, qrow, qnt, O, m, l, invl, slope, t, 16, 31, 1 << 30, true, imp + trow * 132, fq); fa = fb; } }
#pragma unroll
        for (int nt = 0; nt < NT; ++nt) { float lt = l[nt]; lt = x32_sum(x16_sum(lt)); invl[nt] = lt > 0.f ? 1.f / lt : 0.f; }
        { KvFrags fa, fb; if (ntile > 0) nsa_load<true>(kv, 0, fr, fq, fa);
#pragma unroll 1
          for (int tl = 0; tl < ntile; ++tl) { if (tl + 1 < ntile) nsa_load<true>(kv, 32 * (tl + 1), fr, fq, fb);
            nsa_core<NT, 2>(fa, 32 * tl, qrow, qnt, O, m, l, invl, slope, t, 16, 31, 1 << 30, true, imp + trow * 132, fq); fa = fb; } }
#pragma unroll
        for (int nt = 0; nt < NT; ++nt) { const float gc = gates[0 * 16 + hd[nt]];
#pragma unroll
            for (int dt = 0; dt < 4; ++dt) *(f32x4*)(oacc + hd[nt] * 64 + 16 * dt + 4 * fq) = O[nt][dt] * gc; }
    }
    LDS_WAIT();
    unsigned selm[4] = {0u, 0u, 0u, 0u};
    {
        const int cur = t >> 6;
        if (!SAMPLE) {
            unsigned v[32];
#pragma unroll
            for (int i = 0; i < 32; ++i) { const int j = 32 * fq + i; const bool forced = (j == 0) | (j == cur) | (j == cur - 1);
                const unsigned key = ((f2u(imp[trow * 132 + j]) & ~127u) | (unsigned)(127 - j)) + 128u;
                v[i] = (!forced && j <= cur) ? key : 0u;
                if (forced) selm[fq] |= 1u << i; }
            unsigned fw = selm[0] | selm[1] | selm[2] | selm[3];
            const unsigned w16 = __shfl_xor(fw, 16), w32 = __shfl_xor(fw, 32), w48 = __shfl_xor(fw, 48);
#pragma unroll
            for (int wd = 0; wd < 4; ++wd) selm[wd] = (fq == wd) ? fw : ((fq ^ 1) == wd) ? w16 : ((fq ^ 2) == wd) ? w32 : w48;
            const int nforced = cur >= 2 ? 3 : cur + 1;
#pragma unroll 1
            for (int rd = 0; rd < 15; ++rd) {
                unsigned mx = v[0];
#pragma unroll
                for (int i = 1; i < 32; ++i) mx = mx > v[i] ? mx : v[i];
                mx = x32_umax(x16_umax(mx));
#pragma unroll
                for (int i = 0; i < 32; ++i) v[i] = (v[i] == mx) ? 0u : v[i];
                if (mx != 0u && rd < 16 - nforced) { const int js = 127 - (int)(mx & 127u);
#pragma unroll
                    for (int wd = 0; wd < 4; ++wd) selm[wd] |= ((js >> 5) == wd) ? (1u << (js & 31)) : 0u; }
            }
        } else {
            const int li = (fr & 3) * 4 + fq;
            unsigned v[8];
#pragma unroll
            for (int i = 0; i < 8; ++i) { const int j = li * 8 + i; v[i] = (j >= 1 && j <= 126) ? (((f2u(imp[trow * 132 + j]) & ~127u) | (unsigned)(127 - j)) + 128u) : 0u; }
            selm[0] = 1u; selm[3] = 1u << 31;
#pragma unroll 1
            for (int rd = 0; rd < 13; ++rd) {
                unsigned mx = v[0];
#pragma unroll
                for (int i = 1; i < 8; ++i) mx = mx > v[i] ? mx : v[i];
                { unsigned o = dpp_u<DPP_XOR1>(mx); mx = mx > o ? mx : o; o = dpp_u<DPP_XOR2>(mx); mx = mx > o ? mx : o; mx = x32_umax(x16_umax(mx)); }
#pragma unroll
                for (int i = 0; i < 8; ++i) v[i] = (v[i] == mx) ? 0u : v[i];
                if (mx != 0u) { const int js = 127 - (int)(mx & 127u);
#pragma unroll
                    for (int wd = 0; wd < 4; ++wd) selm[wd] |= ((js >> 5) == wd) ? (1u << (js & 31)) : 0u; }
            }
        }
    }
    if (SAMPLE || !NSA_SUBUNITS) {
        nsa_zero<NT>(O, m, l);
        unsigned un[4];
#pragma unroll
        for (int wd = 0; wd < 4; ++wd) { unsigned x = selm[wd]; x |= __shfl_xor(x, 1); x |= __shfl_xor(x, 2); x |= __shfl_xor(x, 4); x |= __shfl_xor(x, 8); un[wd] = (unsigned)__builtin_amdgcn_readfirstlane((int)x); }
        KvSampleSel kvs{FIN(2) + g * 64, (const int*)FIN(6) + (SAMPLE ? (id >> 2) : 0) * NPAGES, WSP(float, WS_SNEW) + (size_t)(SAMPLE ? (id >> 2) : 0) * 2048 + g * 64, g};
        KvBf16 kvp{WSP(bf16, WS_KSEL) + (size_t)bg * PT * 64, WSP(bf16, WS_VSELT) + (size_t)bg * 64 * PT, PT};
        if (SAMPLE) {
#pragma unroll 1
        for (int wd = 0; wd < 4; ++wd) {
            unsigned mm = un[wd];
            const unsigned mine = wd == 0 ? selm[0] : wd == 1 ? selm[1] : wd == 2 ? selm[2] : selm[3];
            while (mm) {
                const int bit = __builtin_ctz(mm); mm &= mm - 1u; const int j = 32 * wd + bit;
                const bool ok = (mine >> bit) & 1u;
#pragma unroll 1
                for (int hh = 0; hh < 2; ++hh) { nsa_tile<NT, 0>(kvs, 64 * j + 32 * hh, qrow, qnt, O, m, l, invl, slope, t, 1, 0, 1 << 30, ok, imp, fr, fq); __builtin_amdgcn_sched_barrier(0); }
            }
        }
        } else {
            int wdc = 0; unsigned mmc = un[0];
            while (wdc < 3 && mmc == 0u) { ++wdc; mmc = wdc == 1 ? un[1] : wdc == 2 ? un[2] : un[3]; }
            KvFrags fa, fb; int jc = -1, hc = 0;
            if (mmc) { jc = 32 * wdc + __builtin_ctz(mmc); mmc &= mmc - 1u; nsa_load<true>(kvp, 64 * jc, fr, fq, fa); }
#pragma unroll 1
            while (jc >= 0) {
                int jn = jc, hn = hc + 1;
                if (hn == 2) { hn = 0;
                    while (wdc < 3 && mmc == 0u) { ++wdc; mmc = wdc == 1 ? un[1] : wdc == 2 ? un[2] : un[3]; }
                    if (mmc) { jn = 32 * wdc + __builtin_ctz(mmc); mmc &= mmc - 1u; } else jn = -1; }
                if (jn >= 0) nsa_load<true>(kvp, 64 * jn + 32 * hn, fr, fq, fb);
                const int wj = jc >> 5, bj = jc & 31;
                const unsigned mine = wj == 0 ? selm[0] : wj == 1 ? selm[1] : wj == 2 ? selm[2] : selm[3];
                nsa_core<NT, 0>(fa, 64 * jc + 32 * hc, qrow, qnt, O, m, l, invl, slope, t, 1, 0, 1 << 30, (mine >> bj) & 1u, imp, fq);
                fa = fb; jc = jn; hc = hn;
            }
        }
        if (SAMPLE) nsa_tile<NT, 0>(kvs, 64 * 128, qrow, qnt, O, m, l, invl, slope, t, 1, 0, 1 << 30, true, imp, fr, fq);
#pragma unroll
        for (int nt = 0; nt < NT; ++nt) { float lt = l[nt]; lt = x32_sum(x16_sum(lt)); const float sc = gates[1 * 16 + hd[nt]] / fmaxf(lt, 1e-30f);
#pragma unroll
            for (int dt = 0; dt < 4; ++dt) { f32x4* o = (f32x4*)(oacc + hd[nt] * 64 + 16 * dt + 4 * fq); *o = *o + O[nt][dt] * sc; } }
    } else {
        unsigned ms[4][4];
#pragma unroll
        for (int s = 0; s < 4; ++s)
#pragma unroll
            for (int wd = 0; wd < 4; ++wd) ms[s][wd] = __shfl(selm[wd], 4 * s + (fr >> 2));
        unsigned su[4][4], un[4];
#pragma unroll
        for (int wd = 0; wd < 4; ++wd) { un[wd] = 0u;
#pragma unroll
            for (int s = 0; s < 4; ++s) { unsigned x = ms[s][wd]; x |= __shfl_xor(x, 4); x |= __shfl_xor(x, 8); su[s][wd] = (unsigned)__builtin_amdgcn_readfirstlane((int)x); un[wd] |= su[s][wd]; } }
        const int hds = g * 4 + (fr & 3); float slp[1]; slp[0] = ex2(-0.5f * (float)(hds + 1)) * LOG2E;
        const int tb = (id & 511) * 16 + (fr >> 2);
        f32x4 Os[4][1][4]; float mS[4][1], lS[4][1]; float inv1[1] = {0.f};
#pragma unroll
        for (int s = 0; s < 4; ++s) nsa_zero<1>(Os[s], mS[s], lS[s]);
        KvBf16 kvp{WSP(bf16, WS_KSEL) + (size_t)bg * PT * 64, WSP(bf16, WS_VSELT) + (size_t)bg * 64 * PT, PT};
        int wdc = 0; unsigned mmc = un[0];
        while (wdc < 3 && mmc == 0u) { ++wdc; mmc = wdc == 1 ? un[1] : wdc == 2 ? un[2] : un[3]; }
        KvFrags fa, fb;
        int jc = -1, hc = 0;
        if (mmc) { jc = 32 * wdc + __builtin_ctz(mmc); mmc &= mmc - 1u; nsa_load<true>(kvp, 64 * jc, fr, fq, fa); }
#pragma unroll 1
        while (jc >= 0) {
            int jn = jc, hn = hc + 1;
            if (hn == 2) { hn = 0;
                while (wdc < 3 && mmc == 0u) { ++wdc; mmc = wdc == 1 ? un[1] : wdc == 2 ? un[2] : un[3]; }
                if (mmc) { jn = 32 * wdc + __builtin_ctz(mmc); mmc &= mmc - 1u; } else jn = -1; }
            if (jn >= 0) nsa_load<true>(kvp, 64 * jn + 32 * hn, fr, fq, fb);
            const int wj = jc >> 5, bj = jc & 31;
#pragma unroll
            for (int s = 0; s < 4; ++s) {
                const unsigned suw = wj == 0 ? su[s][0] : wj == 1 ? su[s][1] : wj == 2 ? su[s][2] : su[s][3];
                if ((suw >> bj) & 1u) {
                    const unsigned mw = wj == 0 ? ms[s][0] : wj == 1 ? ms[s][1] : wj == 2 ? ms[s][2] : ms[s][3];
                    nsa_core<1, 0>(fa, 64 * jc + 32 * hc, qw + (16 * s + fr) * NSA_QLD, 0, Os[s], mS[s], lS[s], inv1, slp, tb + 4 * s, 1, 0, 1 << 30, (mw >> bj) & 1u, imp, fq);
                }
            }
            fa = fb; jc = jn; hc = hn;
        }
#pragma unroll
        for (int s = 0; s < 4; ++s) { float lt = lS[s][0]; lt = x32_sum(x16_sum(lt));
            const size_t rs = (size_t)(row0 + 4 * s + (fr >> 2));
            const float sc = WSP(float, WS_GATES)[rs * 48 + 16 + hds] / fmaxf(lt, 1e-30f);
#pragma unroll
            for (int dt = 0; dt < 4; ++dt) { f32x4* o = (f32x4*)(WSP(float, WS_OACC) + rs * 1024 + hds * 64 + 16 * dt + 4 * fq); *o = *o + Os[s][0][dt] * sc; } }
    }
    {
        nsa_zero<NT>(O, m, l);
        KvBf16 kv = SAMPLE ? KvBf16{WSP(bf16, WS_SKWIN) + (size_t)bg * 544 * 64, WSP(bf16, WS_SVWINT) + (size_t)bg * 64 * 544, 544}
                           : KvBf16{WSP(bf16, WS_KWIN) + (size_t)bg * PT * 64, WSP(bf16, WS_VWINT) + (size_t)bg * 64 * PT, PT};
        int k0, k1, padd;
        if (SAMPLE) { k0 = 0; k1 = 544; padd = PAST - WINDOW; }
        else { const int lo = tmax - 15 - (WINDOW - 1); k0 = (lo > 0 ? lo : 0) & ~31; k1 = tmax + 1; padd = 0; }
        { KvFrags fa, fb; nsa_load<true>(kv, k0, fr, fq, fa);
#pragma unroll 1
          for (int kk = k0; kk < k1; kk += 32) { if (kk + 32 < k1) nsa_load<true>(kv, kk + 32, fr, fq, fb);
            nsa_core<NT, 0>(fa, kk, qrow, qnt, O, m, l, invl, slope, t, 1, padd, WINDOW, true, imp, fq); fa = fb; } }
        bf16* on = WSP(bf16, WS_OG) + (size_t)row * 1024;
#pragma unroll
        for (int nt = 0; nt < NT; ++nt) { float lt = l[nt]; lt = x32_sum(x16_sum(lt)); const float sc = gates[2 * 16 + hd[nt]] / fmaxf(lt, 1e-30f);
#pragma unroll
            for (int dt = 0; dt < 4; ++dt) { const f32x4 o = *(const f32x4*)(oacc + hd[nt] * 64 + 16 * dt + 4 * fq) + O[nt][dt] * sc;
                *(v2u*)(on + hd[nt] * 64 + 16 * dt + 4 * fq) = (v2u){pk2(o[0], o[1]), pk2(o[2], o[3])}; } }
    }
}

constexpr int NW_STG = 67584;
constexpr int NW_STG_BYTES = 18432;
constexpr int NW_UN = NW_STG + 2 * NW_STG_BYTES;
struct NwStage { v4u k, v; };
__device__ __forceinline__ void nw_load(const bf16* K, const bf16* VT, int ld, int key0, int tid, NwStage& s) {
    s.k = *(const v4u*)(K + (size_t)(key0 + (tid >> 3)) * 64 + 8 * (tid & 7));
    s.v = *(const v4u*)(VT + (size_t)(tid >> 3) * ld + key0 + 8 * (tid & 7));
}
__device__ __forceinline__ void nw_store(LAS unsigned char* buf, int tid, const NwStage& s) {
    const int kk = tid >> 3, c8 = tid & 7, k32 = kk & 31;
    const int rho = 32 * (kk >> 5) + 16 * ((k32 >> 2) & 1) + 4 * (k32 >> 3) + (k32 & 3);
    *(LAS v4u*)(buf + rho * 144 + c8 * 16) = s.k;
    *(LAS v4u*)(buf + 9216 + kk * 144 + c8 * 16) = s.v;
}
template <bool WITHV>
__device__ __forceinline__ void nw_frags(const LAS unsigned char* buf, int th, int fr, int fq, KvFrags& f) {
#pragma unroll
    for (int mt = 0; mt < 2; ++mt)
#pragma unroll
        for (int ks = 0; ks < 2; ++ks) f.k[mt][ks] = *(const LAS bf16x8*)(buf + (32 * th + 16 * mt + fr) * 144 + (32 * ks + 8 * fq) * 2);
    if (WITHV) {
#pragma unroll
        for (int dt = 0; dt < 4; ++dt) f.v[dt] = *(const LAS bf16x8*)(buf + 9216 + (16 * dt + fr) * 144 + (32 * th + 8 * fq) * 2);
    }
}
#define NW_PIPE(Kp, VTp, ldv, NB, BLK, BODY) do { const int nb_ = (NB); \
        if (nb_ > 0) { NwStage st_; nw_load(Kp, VTp, ldv, BLK(0), F.tid, st_); nw_store(stg, F.tid, st_); } \
        __syncthreads(); \
        _Pragma("unroll 1") for (int ib_ = 0; ib_ < nb_; ++ib_) { \
            NwStage st_; const bool more_ = ib_ + 1 < nb_; if (more_) nw_load(Kp, VTp, ldv, BLK(ib_ + 1), F.tid, st_); \
            const LAS unsigned char* buf_ = stg + (ib_ & 1) * NW_STG_BYTES; const int key0_ = BLK(ib_); \
            BODY(buf_, key0_) \
            if (more_) nw_store(stg + ((ib_ + 1) & 1) * NW_STG_BYTES, F.tid, st_); \
            __syncthreads(); } } while (0)

__device__ __forceinline__ void nsa_wg(Frame& F, int bg, int qb) {
    int lane_ = F.lane; asm volatile("" : "+v"(lane_));
    const int lane = lane_, fr = lane & 15, fq = lane >> 4, w = F.wave, g = bg & 3;
    LAS unsigned char* L = F.lds; asm volatile("" : "+v"(L));
    LAS float* imp = (LAS float*)(L + NSA_IMP + w * 8448);
    LAS unsigned char* stg = L + NW_STG;
    LAS unsigned* wun = (LAS unsigned*)(L + NW_UN); volatile LAS unsigned char* blist = (volatile LAS unsigned char*)(L + NW_UN + 16);
    const int tt = qb * 8 + w, t = 16 * tt + fr, row0 = (bg >> 2) * PT + 16 * tt, row = row0 + fr, tw0 = 16 * tt, tw1 = tw0 + 15;
    float slope[4]; bf16x8 qreg[8];
#pragma unroll
    for (int nt = 0; nt < 4; ++nt) { slope[nt] = ex2(-0.5f * (float)(g * 4 + nt + 1)) * LOG2E;
        const bf16* qp = WSP(bf16, WS_QN) + (size_t)row * 1024 + (g * 4 + nt) * 64 + 8 * fq; qreg[2 * nt] = ld8(qp); qreg[2 * nt + 1] = ld8(qp + 32); }
    const float* gates = WSP(float, WS_GATES) + (size_t)row * 48;
    float* oacc = WSP(float, WS_OACC) + (size_t)row * 1024;
    for (int i = lane; i < 16 * 132; i += 64) imp[i] = 0.f;
    if (F.tid < 4) wun[F.tid] = 0u;
    f32x4 O[4][4]; float m[4], l[4], invl[4];
    {
        const bf16* Kc = WSP(bf16, WS_KCMP) + (size_t)bg * 512 * 64; const bf16* Vc = WSP(bf16, WS_VCMPT) + (size_t)bg * 64 * 512;
        const int cmax = (128 * qb + 127 - 31) >> 4, ncb = (cmax < 510 ? cmax : 510) / 64 + 1;
#pragma unroll
        for (int nt = 0; nt < 4; ++nt) invl[nt] = 0.f;
        nsa_zero<4>(O, m, l);
#define NW_BLK(i) (64 * (i))
#define NW_CMP1(buf, k0) { _Pragma("unroll 1") for (int th = 0; th < 2; ++th) if (16 * ((k0) + 32 * th) + 31 <= tw1) { KvFrags f; nw_frags<false>(buf, th, fr, fq, f); \
            nsa_core<4, 1, true>(f, (k0) + 32 * th, nullptr, 0, O, m, l, invl, slope, t, 16, 31, 1 << 30, true, imp + fr * 132, fq, qreg); } }
        NW_PIPE(Kc, Vc, 512, ncb, NW_BLK, NW_CMP1);
#pragma unroll
        for (int nt = 0; nt < 4; ++nt) { const float lt = x32_sum(x16_sum(l[nt])); invl[nt] = lt > 0.f ? 1.f / lt : 0.f; }
#define NW_CMP2(buf, k0) { _Pragma("unroll 1") for (int th = 0; th < 2; ++th) if (16 * ((k0) + 32 * th) + 31 <= tw1) { KvFrags f; nw_frags<true>(buf, th, fr, fq, f); \
            nsa_core<4, 2, true>(f, (k0) + 32 * th, nullptr, 0, O, m, l, invl, slope, t, 16, 31, 1 << 30, true, imp + fr * 132, fq, qreg); } }
        NW_PIPE(Kc, Vc, 512, ncb, NW_BLK, NW_CMP2);
#pragma unroll
        for (int nt = 0; nt < 4; ++nt) { const float gc = gates[0 * 16 + g * 4 + nt];
#pragma unroll
            for (int dt = 0; dt < 4; ++dt) *(f32x4*)(oacc + (g * 4 + nt) * 64 + 16 * dt + 4 * fq) = O[nt][dt] * gc; }
    }
    LDS_WAIT();
    unsigned selm[4] = {0u, 0u, 0u, 0u};
    {
        const int cur = t >> 6;
        unsigned v[32];
#pragma unroll
        for (int i = 0; i < 32; ++i) { const int j = 32 * fq + i; const bool forced = (j == 0) | (j == cur) | (j == cur - 1);
            const unsigned key = ((f2u(imp[fr * 132 + j]) & ~127u) | (unsigned)(127 - j)) + 128u;
            v[i] = (!forced && j <= cur) ? key : 0u;
            if (forced) selm[fq] |= 1u << i; }
        unsigned fw = selm[0] | selm[1] | selm[2] | selm[3];
        const unsigned w16 = __shfl_xor(fw, 16), w32 = __shfl_xor(fw, 32), w48 = __shfl_xor(fw, 48);
#pragma unroll
        for (int wd = 0; wd < 4; ++wd) selm[wd] = (fq == wd) ? fw : ((fq ^ 1) == wd) ? w16 : ((fq ^ 2) == wd) ? w32 : w48;
        const int nforced = cur >= 2 ? 3 : cur + 1;
#pragma unroll 1
        for (int rd = 0; rd < 15; ++rd) {
            unsigned mx = v[0];
#pragma unroll
            for (int i = 1; i < 32; ++i) mx = mx > v[i] ? mx : v[i];
            mx = x32_umax(x16_umax(mx));
#pragma unroll
            for (int i = 0; i < 32; ++i) v[i] = (v[i] == mx) ? 0u : v[i];
            if (mx != 0u && rd < 16 - nforced) { const int js = 127 - (int)(mx & 127u);
#pragma unroll
                for (int wd = 0; wd < 4; ++wd) selm[wd] |= ((js >> 5) == wd) ? (1u << (js & 31)) : 0u; }
        }
    }
    unsigned un[4];
#pragma unroll
    for (int wd = 0; wd < 4; ++wd) { unsigned x = selm[wd]; x |= dpp_u<DPP_XOR1>(x); x |= dpp_u<DPP_XOR2>(x); x |= dpp_u<DPP_HMIR>(x); x |= dpp_u<DPP_MIR>(x); un[wd] = (unsigned)__builtin_amdgcn_readfirstlane((int)x); }
    if (lane < 4) __hip_atomic_fetch_or(wun + lane, lane == 0 ? un[0] : lane == 1 ? un[1] : lane == 2 ? un[2] : un[3], __ATOMIC_RELAXED, __HIP_MEMORY_SCOPE_WORKGROUP);
    __syncthreads();
    unsigned wu[4];
#pragma unroll
    for (int wd = 0; wd < 4; ++wd) wu[wd] = (unsigned)__builtin_amdgcn_readfirstlane((int)wun[wd]);
    {
        nsa_zero<4>(O, m, l);
        const bf16* Ks = WSP(bf16, WS_KSEL) + (size_t)bg * PT * 64; const bf16* Vs = WSP(bf16, WS_VSELT) + (size_t)bg * 64 * PT;
        const int nsb = __builtin_popcount(wu[0]) + __builtin_popcount(wu[1]) + __builtin_popcount(wu[2]) + __builtin_popcount(wu[3]);
        if (F.tid < 128) { const int j = F.tid, wj = j >> 5, bj = j & 31; const unsigned ww = wj == 0 ? wu[0] : wj == 1 ? wu[1] : wj == 2 ? wu[2] : wu[3];
            if ((ww >> bj) & 1u) { int pos = __builtin_popcount(ww & ((1u << bj) - 1u)); if (wj > 0) pos += __builtin_popcount(wu[0]); if (wj > 1) pos += __builtin_popcount(wu[1]); if (wj > 2) pos += __builtin_popcount(wu[2]);
                blist[pos] = (unsigned char)j; } }
        __syncthreads();
#define NW_SBLK(i) (64 * (int)blist[(i)])
#define NW_SEL(buf, k0) { const int j_ = (k0) >> 6, wj_ = j_ >> 5, bj_ = j_ & 31; const unsigned uw_ = wj_ == 0 ? un[0] : wj_ == 1 ? un[1] : wj_ == 2 ? un[2] : un[3]; \
            if ((uw_ >> bj_) & 1u) { const unsigned mine_ = wj_ == 0 ? selm[0] : wj_ == 1 ? selm[1] : wj_ == 2 ? selm[2] : selm[3]; const bool ok_ = (mine_ >> bj_) & 1u; \
                _Pragma("unroll 1") for (int th = 0; th < 2; ++th) { KvFrags f; nw_frags<true>(buf, th, fr, fq, f); \
                    nsa_core<4, 0, true>(f, (k0) + 32 * th, nullptr, 0, O, m, l, invl, slope, t, 1, 0, 1 << 30, ok_, imp, fq, qreg); } } }
        NW_PIPE(Ks, Vs, PT, nsb, NW_SBLK, NW_SEL);
#pragma unroll
        for (int nt = 0; nt < 4; ++nt) { const float lt = x32_sum(x16_sum(l[nt])); const float sc = gates[1 * 16 + g * 4 + nt] / fmaxf(lt, 1e-30f);
#pragma unroll
            for (int dt = 0; dt < 4; ++dt) { f32x4* o = (f32x4*)(oacc + (g * 4 + nt) * 64 + 16 * dt + 4 * fq); *o = *o + O[nt][dt] * sc; } }
    }
    {
        nsa_zero<4>(O, m, l);
        const bf16* Kw = WSP(bf16, WS_KWIN) + (size_t)bg * PT * 64; const bf16* Vw = WSP(bf16, WS_VWINT) + (size_t)bg * 64 * PT;
        const int lo = 128 * qb - (WINDOW - 1), kb0 = (lo > 0 ? lo : 0) >> 6, kb1 = (128 * qb + 127) >> 6, nwb = kb1 - kb0 + 1;
#define NW_WBLK(i) (64 * (kb0 + (i)))
#define NW_WIN(buf, k0) { _Pragma("unroll 1") for (int th = 0; th < 2; ++th) { const int kk_ = (k0) + 32 * th; if (kk_ <= tw1 && kk_ + 31 >= tw0 - (WINDOW - 1)) { KvFrags f; nw_frags<true>(buf, th, fr, fq, f); \
                nsa_core<4, 0, true>(f, kk_, nullptr, 0, O, m, l, invl, slope, t, 1, 0, WINDOW, true, imp, fq, qreg); } } }
        NW_PIPE(Kw, Vw, PT, nwb, NW_WBLK, NW_WIN);
        bf16* on = WSP(bf16, WS_OG) + (size_t)row * 1024;
#pragma unroll
        for (int nt = 0; nt < 4; ++nt) { const float lt = x32_sum(x16_sum(l[nt])); const float sc = gates[2 * 16 + g * 4 + nt] / fmaxf(lt, 1e-30f);
#pragma unroll
            for (int dt = 0; dt < 4; ++dt) { const f32x4 o = *(const f32x4*)(oacc + (g * 4 + nt) * 64 + 16 * dt + 4 * fq) + O[nt][dt] * sc;
                *(v2u*)(on + (g * 4 + nt) * 64 + 16 * dt + 4 * fq) = (v2u){pk2(o[0], o[1]), pk2(o[2], o[3])}; } }
    }
    __syncthreads();
}

constexpr int SW_Q = 0;
constexpr int SW_IMPP = 2304;
constexpr int SW_IMPT = SW_IMPP + 8 * 2112;
constexpr int SW_LP = SW_IMPT + 2112;
constexpr int SW_OP = SW_LP + 3 * 8 * 16 * 4;
static_assert(SW_OP + 8 * 3 * 16 * 64 * 4 <= RING_BYTES, "sample NSA LDS map");
__device__ __forceinline__ void nsa_sample_wg(Frame& F, int id) {
    int lane_ = F.lane; asm volatile("" : "+v"(lane_));
    const int lane = lane_, fr = lane & 15, fq = lane >> 4, w = F.wave, g = id & 3, bs = id >> 2;
    LAS unsigned char* L = F.lds; asm volatile("" : "+v"(L));
    LAS bf16* qw = (LAS bf16*)(L + SW_Q);
    LAS float* impP = (LAS float*)(L + SW_IMPP) + w * 528; LAS float* impT = (LAS float*)(L + SW_IMPT);
    LAS float* LP = (LAS float*)(L + SW_LP); LAS float* OP = (LAS float*)(L + SW_OP);
    const int t = PAST + (fr >> 2), row0 = MP + bs * 4, trow = fr >> 2, hd = g * 4 + (fr & 3);
    if (F.tid < 128) { const int rr = F.tid >> 3, c8 = F.tid & 7;
        *(LAS v4u*)(qw + rr * NSA_QLD + 8 * c8) = *(const v4u*)(WSP(bf16, WS_QN) + (size_t)(row0 + (rr >> 2)) * 1024 + (g * 4 + (rr & 3)) * 64 + 8 * c8); }
    for (int i = lane; i < 528; i += 64) impP[i] = 0.f;
    __syncthreads();
    float slope[1] = {ex2(-0.5f * (float)(hd + 1)) * LOG2E};
    const LAS bf16* qrow = qw + fr * NSA_QLD;
    f32x4 O[1][4]; float m[1], l[1], invl[1] = {0.f};
#define SW_PUT_O(br) { _Pragma("unroll") for (int dt = 0; dt < 4; ++dt) *(LAS f32x4*)(OP + ((w * 3 + (br)) * 16 + fr) * 64 + 16 * dt + 4 * fq) = O[0][dt]; }
#define SW_PUT_L(br) { const float lt_ = x32_sum(x16_sum(l[0])); if (fq == 0) LP[((br) * 8 + w) * 16 + fr] = lt_; }
    {
        KvBf16 kv{WSP(bf16, WS_SKCMP) + (size_t)id * 512 * 64, WSP(bf16, WS_SVCMPT) + (size_t)id * 64 * 512, 512};
        nsa_zero<1>(O, m, l);
#pragma unroll 1
        for (int tl = w; tl < 16; tl += 8) nsa_tile<1, 1>(kv, 32 * tl, qrow, 0, O, m, l, invl, slope, t, 16, 31, 1 << 30, true, impP + trow * 132, fr, fq);
        SW_PUT_L(0)
        __syncthreads();
        { float lt = 0.f;
#pragma unroll
          for (int ww = 0; ww < 8; ++ww) lt += LP[(0 * 8 + ww) * 16 + fr];
          invl[0] = lt > 0.f ? 1.f / lt : 0.f; }
#pragma unroll 1
        for (int tl = w; tl < 16; tl += 8) nsa_tile<1, 2>(kv, 32 * tl, qrow, 0, O, m, l, invl, slope, t, 16, 31, 1 << 30, true, impP + trow * 132, fr, fq);
        SW_PUT_O(0)
    }
    __syncthreads();
    for (int i = F.tid; i < 528; i += 512) { float s = 0.f;
#pragma unroll
        for (int ww = 0; ww < 8; ++ww) s += ((LAS float*)(L + SW_IMPP))[ww * 528 + i];
        impT[i] = s; }
    __syncthreads();
    unsigned selm[4] = {1u, 0u, 0u, 1u << 31};
    {
        const int li = (fr & 3) * 4 + fq;
        unsigned v[8];
#pragma unroll
        for (int i = 0; i < 8; ++i) { const int j = li * 8 + i; v[i] = (j >= 1 && j <= 126) ? (((f2u(impT[trow * 132 + j]) & ~127u) | (unsigned)(127 - j)) + 128u) : 0u; }
#pragma unroll 1
        for (int rd = 0; rd < 13; ++rd) {
            unsigned mx = v[0];
#pragma unroll
            for (int i = 1; i < 8; ++i) mx = mx > v[i] ? mx : v[i];
            { unsigned o = dpp_u<DPP_XOR1>(mx); mx = mx > o ? mx : o; o = dpp_u<DPP_XOR2>(mx); mx = mx > o ? mx : o; mx = x32_umax(x16_umax(mx)); }
#pragma unroll
            for (int i = 0; i < 8; ++i) v[i] = (v[i] == mx) ? 0u : v[i];
            if (mx != 0u) { const int js = 127 - (int)(mx & 127u);
#pragma unroll
                for (int wd = 0; wd < 4; ++wd) selm[wd] |= ((js >> 5) == wd) ? (1u << (js & 31)) : 0u; }
        }
    }
    {
        nsa_zero<1>(O, m, l);
        unsigned un[4];
#pragma unroll
        for (int wd = 0; wd < 4; ++wd) { unsigned x = selm[wd]; x |= dpp_u<DPP_XOR1>(x); x |= dpp_u<DPP_XOR2>(x); x |= dpp_u<DPP_HMIR>(x); x |= dpp_u<DPP_MIR>(x); un[wd] = (unsigned)__builtin_amdgcn_readfirstlane((int)x); }
        KvSampleSel kvs{FIN(2) + g * 64, (const int*)FIN(6) + bs * NPAGES, WSP(float, WS_SNEW) + (size_t)bs * 2048 + g * 64, g};
        int q = 0;
#pragma unroll 1
        for (int wd = 0; wd < 4; ++wd) {
            unsigned mm = un[wd];
            const unsigned mine = wd == 0 ? selm[0] : wd == 1 ? selm[1] : wd == 2 ? selm[2] : selm[3];
            while (mm) {
                const int bit = __builtin_ctz(mm); mm &= mm - 1u; const int j = 32 * wd + bit;
                const bool ok = (mine >> bit) & 1u;
#pragma unroll 1
                for (int hh = 0; hh < 2; ++hh, ++q) if ((q & 7) == w) { nsa_tile<1, 0>(kvs, 64 * j + 32 * hh, qrow, 0, O, m, l, invl, slope, t, 1, 0, 1 << 30, ok, impP, fr, fq); __builtin_amdgcn_sched_barrier(0); }
            }
        }
        if ((q & 7) == w) nsa_tile<1, 0>(kvs, 64 * 128, qrow, 0, O, m, l, invl, slope, t, 1, 0, 1 << 30, true, impP, fr, fq);
        SW_PUT_O(1) SW_PUT_L(1)
    }
    {
        nsa_zero<1>(O, m, l);
        KvBf16 kv{WSP(bf16, WS_SKWIN) + (size_t)id * 544 * 64, WSP(bf16, WS_SVWINT) + (size_t)id * 64 * 544, 544};
#pragma unroll 1
        for (int kk = 32 * w; kk < 544; kk += 256) nsa_tile<1, 0>(kv, kk, qrow, 0, O, m, l, invl, slope, t, 1, PAST - WINDOW, WINDOW, true, impP, fr, fq);
        SW_PUT_O(2) SW_PUT_L(2)
    }
    __syncthreads();
    {
        const int r = F.tid >> 5, d0 = (F.tid & 31) * 2, rowg = row0 + (r >> 2), hdr = g * 4 + (r & 3);
        float o0 = 0.f, o1 = 0.f;
#pragma unroll
        for (int br = 0; br < 3; ++br) { float a0 = 0.f, a1 = 0.f, lt = 0.f;
#pragma unroll
            for (int ww = 0; ww < 8; ++ww) { const f32x2 x = *(const LAS f32x2*)(OP + ((ww * 3 + br) * 16 + r) * 64 + d0); a0 += x.x; a1 += x.y; if (br > 0) lt += LP[(br * 8 + ww) * 16 + r]; }
            const float sc = WSP(float, WS_GATES)[(size_t)rowg * 48 + br * 16 + hdr] * (br == 0 ? 1.f : 1.f / fmaxf(lt, 1e-30f));
            o0 += a0 * sc; o1 += a1 * sc; }
        *(unsigned*)(WSP(bf16, WS_OG) + (size_t)rowg * 1024 + hdr * 64 + d0) = pk2(o0, o1);
    }
    __syncthreads();
#undef SW_PUT_O
#undef SW_PUT_L
}


#ifndef MK_SINGLE
#define MK_SINGLE 1
#endif
constexpr int NPHASE = 21;
struct Args { const float* in[29]; float* out; unsigned char* ws; int ph_lo, ph_hi; };
static_assert(sizeof(Args) == 31 * 8 + 8, "Args has no padding");

__global__ void __launch_bounds__(512, 2) mk_fwd(Args args) {
    extern __shared__ __attribute__((aligned(16))) unsigned char lds_raw[];
    Frame F;
    F.lds = (LAS unsigned char*)lds_raw;
    F.tid = threadIdx.x; F.lane = F.tid & 63; F.wave = __builtin_amdgcn_readfirstlane(F.tid >> 6);
    F.G = gridDim.x; F.bid = blockIdx.x;
    F.ka = (const __attribute__((address_space(4))) char*)__builtin_amdgcn_kernarg_segment_ptr();
    F.out = args.out; F.ws = args.ws;
    volatile LAS unsigned* MISC = (volatile LAS unsigned*)(F.lds + MISC_OFF);
    for (int u = F.tid; u < (LDS_BYTES - LDSCTL_OFF) / 4; u += 512) ((LAS unsigned*)(F.lds + LDSCTL_OFF))[u] = 0u;
    __syncthreads();
    unsigned* barw = (unsigned*)(F.ws + WS_CTL) + 4096;
    XcdBarrier bar; bar.bar = barw; bar.x = 0; bar.st = nullptr;
    const int lo = args.ph_lo, hi = args.ph_hi;
    if (hi - lo > 1) bar = xcd_barrier_post(barw, MISC + 8);
#ifndef PH_MASK
#define PH_MASK 0xFFFFFFFFu
#endif
#define IN(k) (((PH_MASK >> (k)) & 1u) && lo <= (k) && (k) < hi)
#define SEAM(k) do { if (IN(k) && IN((k) + 1)) xcd_barrier(bar); } while (0)
    const int gw = F.bid * 8 + F.wave, NGW = F.G * 8;

#ifndef REPX
#define REPX 0
#endif
#ifndef REPY
#define REPY 0
#endif
#ifndef REP_MASK
#define REP_MASK 0u
#endif
#define PHASE(k, ...) if (IN(k)) { _Pragma("unroll 1") for (int rep_ = 0; rep_ < (int)((REP_MASK >> (k)) & 1u) + 1; ++rep_) { if (rep_) xcd_barrier(bar); __VA_ARGS__ } } SEAM(k);
    PHASE(0, p0_prologue(F);)
    PHASE(1, { pg8::Gemm g{WSP(bf16, WS_CKA), WSP(bf16, WS_W1BD), 65536, 256, 2048}; pg8::StaticOrder S; S.init(65536, 256, F.G, F.bid);
               pg8::EpiFn<FnF32> E{FnF32{WSP(float, WS_FS), 256}}; pg8::gemm_phase<pg8::EpiFn<FnF32>, pg8::StaticOrder, true, true>(F.lds, g, S, E); })
    PHASE(2, gemm_all(F, WSP(bf16, WS_XNA), WSP(bf16, WS_WIN_T), 4096, FnBf16{WSP(bf16, WS_PROJ), 4096});)
    PHASE(3, for (int u = F.bid; u < 2048 + 256; u += F.G) { if (u < 2048) p2_chunk(F, u); else p2_sample(F, u - 2048); })
    PHASE(4, if (F.G == 256) { const int x = F.bid & 7, idx = F.bid >> 3; if (idx < 16) p3_scan(F, x * 2 + (idx >> 3), idx & 7);
                 else peer_tables_to_fp8(F, (size_t)(((idx - 16) * 8 + x) * 512 + F.tid), (size_t)128 * 512); }
             else { for (int u = F.bid; u < 128; u += F.G) p3_scan(F, u >> 3, u & 7); })
    PHASE(5, for (int r = gw; r < MTOK; r += NGW) p4_row(F, r);
             for (int id = gw; id < 8192; id += NGW) compress_sample(F, id);)
    PHASE(6, gemm_all(F, WSP(bf16, WS_OG), WSP(bf16, WS_WOA_T), 1024, FnResid{WSP(float, WS_XS), FIN(0), FIN(1)});)
    PHASE(7, for (int r = gw; r < MTOK; r += NGW) rms_row_to_bf16(WSP(float, WS_XS) + (size_t)r * DM, WSP(bf16, WS_XNB) + (size_t)r * DM, F.lane);)
    PHASE(8, gemm_all(F, WSP(bf16, WS_XNB), WSP(bf16, WS_WPQ_T), 2048, FnBf16{WSP(bf16, WS_QPEER), 2048});)
    PHASE(9, p8_init_tab(F); for (int u = F.bid; u < MTOK / 16; u += F.G) p8_unit(F, u, 0);)
    int pg_slice = F.bid & 7, pg_first = (F.bid >> 3) * 8 + F.wave, pg_stride = ((F.G - (F.bid & 7) + 7) >> 3) * 8;
#define PEER_GROUPS() do { if (MISC[8 + 3] != 0u && (F.G & 7) == 0) { const unsigned c_ = xb_ld(&barw[XB_XCNT(F.lane & 15)]); const bool ok_ = (F.lane & 15) < 8 ? c_ == (unsigned)(F.G >> 3) : c_ == 0u; \
        if (__builtin_amdgcn_ballot_w64(ok_) == ~0ull && bar.x < 8u) { pg_slice = (int)bar.x; pg_first = (int)MISC[8 + 2] * 8 + F.wave; pg_stride = F.G; } } } while (0)
    PHASE(10, PEER_GROUPS(); p9u_wave(F, 0, pg_slice, pg_first, pg_stride);)
    PHASE(11, PEER_GROUPS(); p9v_wave(F, 0, pg_slice, pg_first, pg_stride, 0);)
    PHASE(12, gemm_all(F, WSP(bf16, WS_XNA), WSP(bf16, WS_WKVQ_T), NKVQ, FnKvq{WSP(float, WS_KVQ), WSP(float, WS_SSQ)});)
    PHASE(13, for (int u = F.bid; u < 256; u += F.G) pp_prompt_tile(F, u);
              if (F.G == 256) { if (F.wave == 7 && F.bid < MS) pp_sample_row(F, F.bid); if ((F.wave & 3) == 0) compress_prompt(F, F.bid * 2 + (F.wave >> 2)); }
              else { for (int r = gw; r < MS; r += NGW) pp_sample_row(F, r); for (int id = gw; id < 512; id += NGW) compress_prompt(F, id); })
    PHASE(14, if (F.G == 256) {
                  _Pragma("unroll 1") for (int q_ = 0; q_ < 1 + REPX; ++q_) { if (F.bid < 128) nsa_sample_wg(F, F.bid); }
                  __syncthreads();
                  nsa_wg(F, F.bid & 7, F.bid >> 3); nsa_wg(F, F.bid & 7, 63 - (F.bid >> 3));
              } else { for (int id = gw; id < 128 + 4096; id += NGW) { if (id < 128) nsa_unit<true>(F, id); else nsa_unit<false>(F, id - 128); } })
    PHASE(15, gemm_all(F, WSP(bf16, WS_OG), WSP(bf16, WS_WOB_T), 1024, FnResid{WSP(float, WS_XS), WSP(float, WS_XS), WSP(float, WS_XS) + (size_t)MP * DM});)
    PHASE(16, for (int r = gw; r < MTOK; r += NGW) rms_row_to_bf16(WSP(float, WS_XS) + (size_t)r * DM, WSP(bf16, WS_XNB) + (size_t)r * DM, F.lane);)
    PHASE(17, gemm_all(F, WSP(bf16, WS_XNB), WSP(bf16, WS_WPQ_T) + (size_t)2048 * 1024, 2048, FnBf16{WSP(bf16, WS_QPEER), 2048});)
    PHASE(18, p8_init_tab(F); for (int u = F.bid; u < MTOK / 16; u += F.G) p8_unit(F, u, 1);)
    PHASE(19, PEER_GROUPS(); p9u_wave(F, 1, pg_slice, pg_first, pg_stride);)
    PHASE(20, PEER_GROUPS(); p9v_wave(F, 1, pg_slice, pg_first, pg_stride, 1);)
#undef IN
#undef SEAM
}

extern "C" void kernel_launch(void* const* d_in, const int* in_sizes, int n_in, void* d_out, int out_size, void* d_ws, size_t ws_size, hipStream_t stream) {
    static int grid = 0;
    if (grid == 0) {
        if (n_in != 29 || (size_t)out_size != O_END || ws_size < WS_END) { fprintf(stderr, "kernel_launch: unexpected shapes n_in %d out %d ws %zu (need %zu)\n", n_in, out_size, ws_size, (size_t)WS_END); grid = -1; return; }
        int dev = 0, cus = 0, per_cu = 0;
        if (hipGetDevice(&dev) != hipSuccess || hipDeviceGetAttribute(&cus, hipDeviceAttributeMultiprocessorCount, dev) != hipSuccess) { grid = -1; return; }
        if (hipFuncSetAttribute((const void*)mk_fwd, hipFuncAttributeMaxDynamicSharedMemorySize, LDS_BYTES) != hipSuccess) { fprintf(stderr, "kernel_launch: hipFuncSetAttribute failed\n"); grid = -1; return; }
        if (hipOccupancyMaxActiveBlocksPerMultiprocessor(&per_cu, (const void*)mk_fwd, 512, LDS_BYTES) != hipSuccess || per_cu < 1) fprintf(stderr, "kernel_launch: occupancy query reports %d\n", per_cu);
        (void)hipGetLastError();
        grid = cus;
    }
    if (grid < 0) return;
    if (hipMemsetAsync((char*)d_ws + WS_CTL, 0, CTL_BYTES, stream) != hipSuccess) return;
    Args a{};
    for (int i = 0; i < 29; ++i) a.in[i] = (const float*)d_in[i];
    a.out = (float*)d_out; a.ws = (unsigned char*)d_ws;
#if MK_SINGLE
    a.ph_lo = 0; a.ph_hi = NPHASE;
    hipLaunchKernelGGL(mk_fwd, dim3(grid), dim3(512), LDS_BYTES, stream, a);
#else
    for (int p = 0; p < NPHASE; ++p) { a.ph_lo = p; a.ph_hi = p + 1; hipLaunchKernelGGL(mk_fwd, dim3(grid), dim3(512), LDS_BYTES, stream, a); }
#endif
    const hipError_t le = hipPeekAtLastError();
    if (le != hipSuccess) fprintf(stderr, "kernel_launch: launch failed: %s\n", hipGetErrorName(le));
}
```

```cpp
#include <hip/hip_runtime.h>
#include <cstdio>
#include <cstdint>

constexpr int DM = 1024, PB = 2, PT = 8192, SB = 32, SL = 4, PAST = 8192, PAGE = 128;
constexpr int MP = PB * PT;
constexpr int MS = SB * SL;
constexpr int MTOK = MP + MS;
constexpr int GH = 8, GDK = 128, GDV = 128, GCONV = 3072, GPROJ = 4112, CHUNK = 64, NCH = PT / CHUNK;
constexpr int NH = 16, NG = 4, HPG = 4, DH = 64, NQG = 1072, NKV = 1536, NKVQ = 2816, NKVQ_REAL = 2608;
constexpr int WINDOW = 512, NSELP = 128, NSELS = 129, NCMP = 511;
constexpr int PEH = 8, PEDQ = 256, PEHALF = 128, NKEYS = 128, NEXP = 16384, PETOP = 16;
constexpr int NPAGES = PAST / PAGE;
constexpr float EPS = 1e-6f;

constexpr size_t O_YP = 0;
constexpr size_t O_YS = O_YP + (size_t)MP * DM;
constexpr size_t O_KVP = O_YS + (size_t)MS * DM;
constexpr size_t O_WINP = O_KVP + (size_t)MP * 1024;
constexpr size_t O_GDNP = O_WINP + (size_t)PB * 512 * 512;
constexpr size_t O_CONVP = O_GDNP + (size_t)PB * GH * 128 * 128;
constexpr size_t O_KVS = O_CONVP + (size_t)PB * 3 * GCONV;
constexpr size_t O_WINS = O_KVS + (size_t)MS * 1024;
constexpr size_t O_GDNS = O_WINS + (size_t)SB * 512 * 512;
constexpr size_t O_CONVS = O_GDNS + (size_t)SB * GH * 128 * 128;
constexpr size_t O_END = O_CONVS + (size_t)SB * 3 * GCONV;

constexpr size_t MiB = 1u << 20;
constexpr size_t al(size_t x) { return (x + 4095) & ~(size_t)4095; }
constexpr size_t WS_CTL = 0, CTL_BYTES = 1 * MiB;
constexpr size_t WS_WIN_T = WS_CTL + CTL_BYTES;
constexpr size_t WS_WOA_T = WS_WIN_T + (size_t)4096 * 1024 * 2;
constexpr size_t WS_WKVQ_T = WS_WOA_T + (size_t)1024 * 1024 * 2;
constexpr size_t WS_WOB_T = WS_WKVQ_T + (size_t)NKVQ * 1024 * 2;
constexpr size_t WS_WPQ_T = WS_WOB_T + (size_t)1024 * 1024 * 2;
constexpr size_t WS_WAB = WS_WPQ_T + (size_t)2 * 2048 * 1024 * 2;
constexpr size_t WS_SUBK = WS_WAB + (size_t)16 * 1024 * 4;
constexpr size_t WS_W1T = WS_SUBK + (size_t)2 * 8 * 2 * 128 * 128 * 2;
constexpr size_t WS_PETERM = WS_W1T + (size_t)2 * 128 * 1024 * 2;
constexpr size_t WS_PU = al(WS_PETERM + 512);
constexpr size_t WS_PV = WS_PU + (size_t)2 * NEXP * DM * 2;
constexpr size_t WS_XNA = WS_PV + (size_t)2 * NEXP * DM * 2;
constexpr size_t WS_XNB = al(WS_XNA + (size_t)MTOK * DM * 2);
constexpr size_t WS_PROJ = al(WS_XNB + (size_t)MTOK * DM * 2);
constexpr size_t WS_GW = al(WS_PROJ + (size_t)MTOK * 4096 * 2);
constexpr size_t WS_GQ = WS_GW + (size_t)2048 * 64 * 128 * 2;
constexpr size_t WS_GKT = WS_GQ + (size_t)2048 * 64 * 128 * 2;
constexpr size_t WS_GQK = WS_GKT + (size_t)2048 * 64 * 128 * 2;
constexpr size_t WS_GU = WS_GQK + (size_t)2048 * 64 * 64 * 2;
constexpr size_t WS_GDEC = WS_GU + (size_t)2048 * 64 * 128 * 4;
constexpr size_t WS_OGDN = al(WS_GDEC + 2048 * 4);
constexpr size_t WS_OG = al(WS_OGDN + (size_t)MTOK * DM * 4);
constexpr size_t WS_XS = al(WS_OG + (size_t)MTOK * DM * 2);
constexpr size_t WS_QPEER = al(WS_XS + (size_t)MTOK * DM * 4);
constexpr size_t WS_PEI = al(WS_QPEER + (size_t)MTOK * 2048 * 2);
constexpr size_t WS_PEG = al(WS_PEI + (size_t)MTOK * 128 * 4);
constexpr size_t WS_KVQ = al(WS_PEG + (size_t)MTOK * 128 * 4);
constexpr size_t WS_KSEL = al(WS_KVQ + (size_t)MTOK * NKVQ * 4);
constexpr size_t WS_VSELT = WS_KSEL + (size_t)PB * NG * PT * 64 * 2;
constexpr size_t WS_KWIN = WS_VSELT + (size_t)PB * NG * PT * 64 * 2;
constexpr size_t WS_VWINT = WS_KWIN + (size_t)PB * NG * PT * 64 * 2;
constexpr size_t WS_KCMP = WS_VWINT + (size_t)PB * NG * PT * 64 * 2;
constexpr size_t WS_VCMPT = WS_KCMP + (size_t)PB * NG * 512 * 64 * 2;
constexpr size_t WS_SKCMP = WS_VCMPT + (size_t)PB * NG * 512 * 64 * 2;
constexpr size_t WS_SVCMPT = WS_SKCMP + (size_t)SB * NG * 512 * 64 * 2;
constexpr size_t WS_SKWIN = WS_SVCMPT + (size_t)SB * NG * 512 * 64 * 2;
constexpr size_t WS_SVWINT = WS_SKWIN + (size_t)SB * NG * 544 * 64 * 2;
constexpr size_t WS_SNEW = WS_SVWINT + (size_t)SB * NG * 544 * 64 * 2;
constexpr size_t WS_QN = al(WS_SNEW + (size_t)SB * 4 * 2 * 4 * 64 * 4);
constexpr size_t WS_GATES = al(WS_QN + (size_t)MTOK * 1024 * 2);
constexpr size_t WS_OACC = al(WS_GATES + (size_t)MTOK * 48 * 4);
constexpr size_t WS_CKA = al(WS_OACC + (size_t)MTOK * DM * 4);
constexpr size_t WS_W1BD = al(WS_CKA + (size_t)65536 * 2048 * 2);
constexpr size_t WS_FS = al(WS_W1BD + (size_t)256 * 2048 * 2);
constexpr size_t WS_PA = al(WS_FS + (size_t)65536 * 256 * 4);
constexpr size_t WS_SSQ = al(WS_PA + (size_t)MTOK * 8 * 64 * 4);
constexpr size_t WS_END = al(WS_SSQ + (size_t)MTOK * 8 * 4);

constexpr int RING_BYTES = 143360;
constexpr int LDSCTL_OFF = RING_BYTES, MISC_OFF = LDSCTL_OFF + 320;
constexpr int LDS_BYTES = 147456;

#define GAS __attribute__((address_space(1)))
#define LAS __attribute__((address_space(3)))
typedef unsigned short bf16;
typedef unsigned v4u __attribute__((ext_vector_type(4)));
typedef unsigned v2u __attribute__((ext_vector_type(2)));
typedef float f32x4 __attribute__((ext_vector_type(4)));
typedef float f32x2 __attribute__((ext_vector_type(2)));
typedef short bf16x8 __attribute__((ext_vector_type(8)));
typedef GAS unsigned gu32;
#define RLX_AGENT __ATOMIC_RELAXED, __HIP_MEMORY_SCOPE_AGENT
#define LDS_WAIT() asm volatile("s_waitcnt lgkmcnt(0)" ::: "memory")
#define VM_WAIT() asm volatile("s_waitcnt vmcnt(0)" ::: "memory")

__device__ __forceinline__ unsigned f2bf(float f) { unsigned u = __builtin_bit_cast(unsigned, f); return (u + 0x7fffu + ((u >> 16) & 1u)) >> 16; }
typedef __bf16 hwbf16x2 __attribute__((ext_vector_type(2)));
__device__ __forceinline__ unsigned pk2(float lo, float hi) { const f32x2 v = {lo, hi}; return __builtin_bit_cast(unsigned, __builtin_convertvector(v, hwbf16x2)); }
__device__ __forceinline__ float bf2f(unsigned b) { return __builtin_bit_cast(float, b << 16); }
__device__ __forceinline__ float bflo(unsigned w) { return __builtin_bit_cast(float, w << 16); }
__device__ __forceinline__ float bfhi(unsigned w) { return __builtin_bit_cast(float, w & 0xffff0000u); }
#ifndef USE_PERMSWAP
#define USE_PERMSWAP 1
#endif
template <int CTRL> __device__ __forceinline__ float dpp_f(float x) { return __builtin_bit_cast(float, __builtin_amdgcn_update_dpp(0, __builtin_bit_cast(int, x), CTRL, 0xF, 0xF, true)); }
template <int CTRL> __device__ __forceinline__ unsigned dpp_u(unsigned x) { return (unsigned)__builtin_amdgcn_update_dpp(0, (int)x, CTRL, 0xF, 0xF, true); }
#define DPP_XOR1 0xB1
#define DPP_XOR2 0x4E
#define DPP_HMIR 0x141
#define DPP_MIR 0x140
#define DPP_ROR4 0x124
#define DPP_ROR8 0x128
#if USE_PERMSWAP
#define PSWAP16(a, b) asm volatile("s_nop 1\n\tv_permlane16_swap_b32 %0, %1" : "+v"(a), "+v"(b))
#define PSWAP32(a, b) asm volatile("s_nop 1\n\tv_permlane32_swap_b32 %0, %1" : "+v"(a), "+v"(b))
__device__ __forceinline__ float x16_sum(float x) { unsigned a = __builtin_bit_cast(unsigned, x), b = a; PSWAP16(a, b); return __builtin_bit_cast(float, a) + __builtin_bit_cast(float, b); }
__device__ __forceinline__ float x32_sum(float x) { unsigned a = __builtin_bit_cast(unsigned, x), b = a; PSWAP32(a, b); return __builtin_bit_cast(float, a) + __builtin_bit_cast(float, b); }
__device__ __forceinline__ float x16_max(float x) { unsigned a = __builtin_bit_cast(unsigned, x), b = a; PSWAP16(a, b); return fmaxf(__builtin_bit_cast(float, a), __builtin_bit_cast(float, b)); }
__device__ __forceinline__ float x32_max(float x) { unsigned a = __builtin_bit_cast(unsigned, x), b = a; PSWAP32(a, b); return fmaxf(__builtin_bit_cast(float, a), __builtin_bit_cast(float, b)); }
__device__ __forceinline__ unsigned x16_umax(unsigned u) { unsigned a = u, b = u; PSWAP16(a, b); return a > b ? a : b; }
__device__ __forceinline__ unsigned x32_umax(unsigned u) { unsigned a = u, b = u; PSWAP32(a, b); return a > b ? a : b; }
#else
__device__ __forceinline__ float x16_sum(float x) { return x + __shfl_xor(x, 16); }
__device__ __forceinline__ float x32_sum(float x) { return x + __shfl_xor(x, 32); }
__device__ __forceinline__ float x16_max(float x) { return fmaxf(x, __shfl_xor(x, 16)); }
__device__ __forceinline__ float x32_max(float x) { return fmaxf(x, __shfl_xor(x, 32)); }
__device__ __forceinline__ unsigned x16_umax(unsigned u) { const unsigned o = __shfl_xor(u, 16); return u > o ? u : o; }
__device__ __forceinline__ unsigned x32_umax(unsigned u) { const unsigned o = __shfl_xor(u, 32); return u > o ? u : o; }
#endif
__device__ __forceinline__ float row_sum16(float x) { x += dpp_f<DPP_XOR1>(x); x += dpp_f<DPP_XOR2>(x); x += dpp_f<DPP_HMIR>(x); x += dpp_f<DPP_MIR>(x); return x; }
__device__ __forceinline__ float wave_sum(float v) { return x32_sum(x16_sum(row_sum16(v))); }
__device__ __forceinline__ float silu_f(float x) { return x / (1.f + __expf(-x)); }
__device__ __forceinline__ float sigmoid_f(float x) { return 1.f / (1.f + __expf(-x)); }
__device__ __forceinline__ float gelu_tanh(float x) {
    const float u = 0.7978845608028654f * (x + 0.044715f * x * x * x);
    const float e = __expf(2.f * u);
    const float th = 1.f - 2.f / (e + 1.f);
    return 0.5f * x * (1.f + th);
}
__device__ __forceinline__ bf16x8 ld8(const bf16* p) { return *(const bf16x8*)p; }
__device__ __forceinline__ bf16x8 ld8l(const LAS bf16* p) { return *(const LAS bf16x8*)p; }
#define MFMA16(a, b, c) __builtin_amdgcn_mfma_f32_16x16x32_bf16((a), (b), (c), 0, 0, 0)
__device__ __forceinline__ bf16x8 cvt8(f32x4 a, f32x4 b) {
    v4u r; r.x = pk2(a.x, a.y); r.y = pk2(a.z, a.w); r.z = pk2(b.x, b.y); r.w = pk2(b.z, b.w); return __builtin_bit_cast(bf16x8, r);
}

struct Frame {
    LAS unsigned char* lds;
    int tid, lane, wave, G, bid;
    const __attribute__((address_space(4))) char* ka;
    float* out;
    unsigned char* ws;
};
#define WSP(T, off) ((T*)(F.ws + (off)))
__device__ __forceinline__ const float* fin_(const __attribute__((address_space(4))) char* ka, int i) {
    const __attribute__((address_space(4))) char* p = ka; asm volatile("" : "+s"(p));
    return *(const float* const __attribute__((address_space(4)))*)(p + 8 * i);
}
#define FIN(i) fin_(F.ka, (i))
namespace pg8 {
#define PG8_LAS __attribute__((address_space(3)))
typedef unsigned short bf16_t;
typedef short bf16x8 __attribute__((ext_vector_type(8)));
typedef float f32x4 __attribute__((ext_vector_type(4)));
typedef unsigned u32x4 __attribute__((ext_vector_type(4)));
constexpr int BM = 256, BK = 64, HALF = 128, HTB = HALF * BK * 2  , STAGE_BYTES = 8 * HTB, NXCD = 8, WGM = 8;

__host__ __device__ __forceinline__ int lds_byte(int r, int c) { const int st = (r >> 4) * 2 + (c >> 5), rr = r & 15, cc = c & 31, ob = rr * 64 + cc * 2; return st * 1024 + (ob ^ (((ob >> 9) & 1) << 5)); }
__host__ __device__ __forceinline__ void stage_rc(int b, int& R, int& C) { const int st = b / 1024, sb = b % 1024, swz = sb ^ (((sb >> 9) & 1) << 5); R = (st >> 1) * 16 + swz / 64; C = (st & 1) * 32 + (swz % 64) / 2; }
__host__ __device__ __forceinline__ int perm32(int rho) { const int n = rho >> 4, i = rho & 15; return 8 * (i >> 2) + 4 * n + (i & 3); }

struct Unit { int pm, pn; };
struct Gemm { const bf16_t* A; const bf16_t* Bt; int M, N, K; };

struct StaticOrder {
    int nM, nN, nwg, G, c;
    __host__ __device__ void init(int M, int N, int G_, int c_) { nM = M / BM; nN = N / BM; nwg = nM * nN; G = G_; c = c_; }
    __host__ __device__ bool next(int i, Unit& u) const {
        const long L = (long)i * G + c; if (L >= nwg) return false;
        int wgid = (int)L; { const int q = nwg / NXCD, r = nwg % NXCD, xcd = wgid % NXCD, off = wgid / NXCD; wgid = (xcd < r ? xcd * (q + 1) : r * (q + 1) + (xcd - r) * q) + off; }
        const int nig = WGM * nN, gid = wgid / nig, fm = gid * WGM, gsz = (nM - fm) < WGM ? (nM - fm) : WGM;
        u.pm = fm + ((wgid % nig) % gsz); u.pn = (wgid % nig) / gsz; return true;
    }
    __device__ __forceinline__ void a_ready(const Unit&) const {}
    __device__ __forceinline__ void done(const Unit&) const {}
};
template <class Epi, class Sched, bool ALIGN_EPI = false, bool SP2 = false>
__device__ __forceinline__ void gemm_phase(PG8_LAS unsigned char* lds, const Gemm g, const Sched& S, const Epi& E) {
    const int tid = threadIdx.x, wid = __builtin_amdgcn_readfirstlane(tid >> 6), lane = tid & 63, wr = wid >> 2, wc = wid & 3, fr = lane & 15, fq = lane >> 4;
    const int K = g.K, nt = K / BK;
    unsigned voffA[2], voffB[2];
#pragma unroll
    for (int i = 0; i < 2; ++i) { int R, C; stage_rc(tid * 16 + i * 8192, R, C); const int Rb = Epi::PERM ? ((R & ~31) + perm32(R & 31)) : R;
        voffA[i] = (unsigned)(R * K + C) * 2u; voffB[i] = (unsigned)(Rb * K + C) * 2u; }
    const size_t kstep = (size_t)(BK * 2);
    const size_t hstep = (size_t)HALF * K * 2;
    const size_t tstep = 2 * hstep;
    const unsigned ldsw = (unsigned)wid * 1024u;
    const int aoff = lds_byte(wr * 64 + fr, fq * 8), boff = lds_byte(wc * 32 + fr, fq * 8);
#define PG8_SA(b, h) (((b) * 2 + (h)) * HTB)
#define PG8_SB(b, h) ((4 + (b) * 2 + (h)) * HTB)
#define PG8_STAGE(bufoff, gbase, voff) do { _Pragma("unroll") for (int _i = 0; _i < 2; ++_i) \
        __builtin_amdgcn_global_load_lds((const unsigned*)((const char*)(gbase) + (voff)[_i]), (PG8_LAS unsigned*)(lds + (bufoff) + ldsw + _i * 8192), 16, 0, 0); } while (0)
#define PG8_LDA(dst, b, h) do { _Pragma("unroll") for (int m = 0; m < 4; ++m) _Pragma("unroll") for (int k = 0; k < 2; ++k) dst[m][k] = *(const PG8_LAS bf16x8*)(lds + PG8_SA(b, h) + aoff + m * 2048 + k * 1024); } while (0)
#define PG8_LDB(dst, b, h) do { _Pragma("unroll") for (int n = 0; n < 2; ++n) _Pragma("unroll") for (int k = 0; k < 2; ++k) dst[n][k] = *(const PG8_LAS bf16x8*)(lds + PG8_SB(b, h) + boff + n * 2048 + k * 1024); } while (0)
#define PG8_MMA(ai, bj, At, Bt) do { __builtin_amdgcn_s_setprio(1); _Pragma("unroll") for (int m = 0; m < 4; ++m) _Pragma("unroll") for (int n = 0; n < 2; ++n) _Pragma("unroll") for (int k = 0; k < 2; ++k) \
        acc[ai][bj][m][n] = __builtin_amdgcn_mfma_f32_16x16x32_bf16(Bt[n][k], At[m][k], acc[ai][bj][m][n], 0, 0, 0); __builtin_amdgcn_s_setprio(0); } while (0)
#define PG8_WAIT_V(n) asm volatile("s_waitcnt vmcnt(" #n ")" ::: "memory")
#define PG8_WAIT_L(n) asm volatile("s_waitcnt lgkmcnt(" #n ")" ::: "memory")
#define PG8_BAR __builtin_amdgcn_s_barrier()
#define PG8_SCHED __builtin_amdgcn_sched_barrier(0)
    Unit cur, nxt; int ui = 0;
    if (!S.next(0, cur)) return;
    f32x4 acc[2][2][4][2];
#pragma unroll
    for (int a = 0; a < 2; ++a)
#pragma unroll
        for (int b = 0; b < 2; ++b)
#pragma unroll
            for (int m = 0; m < 4; ++m)
#pragma unroll
                for (int n = 0; n < 2; ++n) acc[a][b][m][n] = (f32x4){0.f, 0.f, 0.f, 0.f};
    bf16x8 At[4][2], B0[2][2], B1[2][2];
    const char* cA = (const char*)g.A + (size_t)cur.pm * tstep; const char* cB = (const char*)g.Bt + (size_t)cur.pn * tstep;
    S.a_ready(cur);
    if constexpr (SP2) {
        PG8_STAGE(PG8_SB(0, 0), cB, voffB); PG8_STAGE(PG8_SB(0, 1), cB + hstep, voffB); PG8_STAGE(PG8_SA(0, 0), cA, voffA); PG8_STAGE(PG8_SA(0, 1), cA + hstep, voffA);
        if (wr == 1) PG8_BAR;
        PG8_WAIT_V(2); PG8_BAR;
        PG8_STAGE(PG8_SB(1, 0), cB + kstep, voffB); PG8_STAGE(PG8_SA(1, 0), cA + kstep, voffA); PG8_STAGE(PG8_SB(1, 1), cB + hstep + kstep, voffB);
        PG8_WAIT_V(6); PG8_BAR;
    } else {
        PG8_STAGE(PG8_SB(0, 0), cB, voffB); PG8_STAGE(PG8_SA(0, 0), cA, voffA); PG8_STAGE(PG8_SB(0, 1), cB + hstep, voffB); PG8_STAGE(PG8_SA(0, 1), cA + hstep, voffA);
        if (wr == 1) PG8_BAR;
        PG8_WAIT_V(4); PG8_BAR;
        PG8_STAGE(PG8_SB(1, 0), cB + kstep, voffB); PG8_STAGE(PG8_SA(1, 0), cA + kstep, voffA); PG8_STAGE(PG8_SB(1, 1), cB + hstep + kstep, voffB);
        PG8_WAIT_V(6); PG8_BAR;
    }
    for (;;) {
        const bool has_next = S.next(ui + 1, nxt);
        const char* nA = has_next ? (const char*)g.A + (size_t)nxt.pm * tstep : cA; const char* nB = has_next ? (const char*)g.Bt + (size_t)nxt.pn * tstep : cB;
        for (int t = 0; t < nt; t += 2) {
            const bool last = (t == nt - 2);
            const char* a1 = cA + (size_t)(t + 1) * kstep;
            const char* a2 = last ? nA : cA + (size_t)(t + 2) * kstep; const char* b2 = last ? nB : cB + (size_t)(t + 2) * kstep;
            const char* a3 = a2 + kstep; const char* b3 = b2 + kstep;
            if (last && has_next) S.a_ready(nxt);
            if constexpr (SP2) {
            PG8_LDB(B0, 0, 0); PG8_LDB(B1, 0, 1); PG8_SCHED; PG8_LDA(At, 0, 0); PG8_STAGE(PG8_SA(1, 1), a1 + hstep, voffA);
            PG8_WAIT_V(8); PG8_WAIT_L(0); PG8_BAR; PG8_MMA(0, 0, At, B0); PG8_MMA(0, 1, At, B1); PG8_BAR; PG8_SCHED;
            PG8_LDA(At, 0, 1); PG8_STAGE(PG8_SB(0, 0), b2, voffB); PG8_STAGE(PG8_SB(0, 1), b2 + hstep, voffB); PG8_STAGE(PG8_SA(0, 0), a2, voffA);
            PG8_WAIT_V(8); PG8_WAIT_L(0); PG8_BAR; PG8_MMA(1, 0, At, B0); PG8_MMA(1, 1, At, B1); PG8_BAR; PG8_SCHED;
            PG8_LDB(B0, 1, 0); PG8_LDB(B1, 1, 1); PG8_SCHED; PG8_LDA(At, 1, 0); PG8_STAGE(PG8_SA(0, 1), a2 + hstep, voffA);
            PG8_WAIT_V(8); PG8_WAIT_L(0); PG8_BAR; PG8_MMA(0, 0, At, B0); PG8_MMA(0, 1, At, B1); PG8_BAR; PG8_SCHED;
            PG8_LDA(At, 1, 1); PG8_STAGE(PG8_SB(1, 0), b3, voffB); PG8_STAGE(PG8_SB(1, 1), b3 + hstep, voffB); PG8_STAGE(PG8_SA(1, 0), a3, voffA);
            PG8_WAIT_V(8); PG8_WAIT_L(0); PG8_BAR; PG8_MMA(1, 0, At, B0); PG8_MMA(1, 1, At, B1); PG8_BAR; PG8_SCHED;
            } else {
            PG8_LDB(B0, 0, 0); PG8_SCHED; PG8_LDA(At, 0, 0); PG8_STAGE(PG8_SA(1, 1), a1 + hstep, voffA);
            PG8_WAIT_L(8); PG8_BAR; PG8_WAIT_L(0); PG8_MMA(0, 0, At, B0); PG8_BAR; PG8_SCHED;
            PG8_LDB(B1, 0, 1); PG8_STAGE(PG8_SB(0, 0), b2, voffB);
            PG8_BAR; PG8_WAIT_L(0); PG8_MMA(0, 1, At, B1); PG8_BAR;
            PG8_LDA(At, 0, 1); PG8_STAGE(PG8_SA(0, 0), a2, voffA);
            PG8_BAR; PG8_WAIT_L(0); PG8_MMA(1, 0, At, B0); PG8_BAR; PG8_SCHED;
            PG8_STAGE(PG8_SB(0, 1), b2 + hstep, voffB);
            PG8_WAIT_V(6); PG8_BAR; PG8_MMA(1, 1, At, B1); PG8_BAR;
            PG8_LDB(B0, 1, 0); PG8_SCHED; PG8_LDA(At, 1, 0); PG8_STAGE(PG8_SA(0, 1), a2 + hstep, voffA);
            PG8_WAIT_L(8); PG8_BAR; PG8_WAIT_L(0); PG8_MMA(0, 0, At, B0); PG8_BAR; PG8_SCHED;
            PG8_LDB(B1, 1, 1); PG8_STAGE(PG8_SB(1, 0), b3, voffB);
            PG8_BAR; PG8_WAIT_L(0); PG8_MMA(0, 1, At, B1); PG8_BAR;
            PG8_LDA(At, 1, 1); PG8_STAGE(PG8_SA(1, 0), a3, voffA);
            PG8_BAR; PG8_WAIT_L(0); PG8_MMA(1, 0, At, B0); PG8_BAR; PG8_SCHED;
            PG8_STAGE(PG8_SB(1, 1), b3 + hstep, voffB);
            PG8_WAIT_V(6); PG8_BAR; PG8_MMA(1, 1, At, B1); PG8_BAR;
            }
        }
        if constexpr (ALIGN_EPI) { if (wr == 0) PG8_BAR; }
        if constexpr (!Epi::AFTER_DRAIN) { E(acc, cur, wr, wc, fr, fq); S.done(cur); }
        if (!has_next) break;
#pragma unroll
        for (int a = 0; a < 2; ++a)
#pragma unroll
            for (int b = 0; b < 2; ++b)
#pragma unroll
                for (int m = 0; m < 4; ++m)
#pragma unroll
                    for (int n = 0; n < 2; ++n) acc[a][b][m][n] = (f32x4){0.f, 0.f, 0.f, 0.f};
        cur = nxt; cA = nA; cB = nB; ++ui;
        if constexpr (ALIGN_EPI) { if (wr == 1) PG8_BAR; }
    }
    PG8_WAIT_V(0);
    if constexpr (!ALIGN_EPI) { if (wr == 0) PG8_BAR; }
    PG8_BAR;
    if constexpr (Epi::AFTER_DRAIN) { E.fused(acc, cur, wr, wc, fr, fq, lds, wid, lane); S.done(cur); }
#undef PG8_SA
#undef PG8_SB
#undef PG8_STAGE
#undef PG8_LDA
#undef PG8_LDB
#undef PG8_MMA
#undef PG8_WAIT_V
#undef PG8_WAIT_L
#undef PG8_BAR
#undef PG8_SCHED
}
}
#define XB_TMO      128
#define XB_XCNT(j)  (256  + 64 * (j))
#define XB_XSUB(j)  (1280 + 64 * (j))
#define XB_XGEN(j)  (2304 + 64 * (j))
#define XB_TOP      3328
#define XB_TOPGEN   3392
#define XCD_BAR_WORDS 3456
#define XB_SPIN_CAP (1u << 18)

__device__ __forceinline__ unsigned xb_ld(unsigned* p)              { return __hip_atomic_load(p, __ATOMIC_RELAXED, __HIP_MEMORY_SCOPE_AGENT); }
__device__ __forceinline__ unsigned xb_add(unsigned* p, unsigned v) { return __hip_atomic_fetch_add(p, v, __ATOMIC_RELAXED, __HIP_MEMORY_SCOPE_AGENT); }
__device__ __forceinline__ unsigned xb_xcc_id() { return (unsigned)__builtin_amdgcn_s_getreg((3 << 11) | 20) & 0xFu; }
#define XB_SPIN(cond, bar) do { unsigned _sp = 0; while (cond) { __builtin_amdgcn_s_sleep(1); \
    if ((++_sp & 255u) == 0u) { if (xb_ld(&(bar)[XB_TMO])) break; if (_sp > XB_SPIN_CAP) { atomicAdd(&(bar)[XB_TMO], 1u); break; } } } } while (0)

struct XcdBarrier {
    unsigned* bar; unsigned x;
    volatile LAS unsigned* st;
};

__device__ __forceinline__ XcdBarrier xcd_barrier_post(unsigned* bar, volatile LAS unsigned* st) {
    XcdBarrier b; b.bar = bar; b.x = xb_xcc_id(); b.st = st;
    if (threadIdx.x == 0) { st[2] = xb_add(&bar[XB_XCNT(b.x)], 1u); st[3] = 1u; }
    return b;
}
__device__ __forceinline__ void xcd_barrier_complete(unsigned* bar, unsigned x, unsigned& nloc, unsigned& nx) {
    const unsigned G = gridDim.x * gridDim.y * gridDim.z;
    unsigned sum, cnt, mine, sp = 0u;
    for (;;) {
        sum = 0u; cnt = 0u; mine = 0u;
#pragma unroll
        for (unsigned j = 0; j < 16; ++j) { const unsigned c = xb_ld(&bar[XB_XCNT(j)]); sum += c; cnt += (c > 0u) ? 1u : 0u; mine = (j == x) ? c : mine; }
        if (sum == G) break;
        __builtin_amdgcn_s_sleep(1);
        if ((++sp & 255u) == 0u) { if (xb_ld(&bar[XB_TMO])) break; if (sp > XB_SPIN_CAP) { atomicAdd(&bar[XB_TMO], 1u); break; } }
    }
    nloc = mine > 0u ? mine : 1u; nx = cnt > 0u ? cnt : 1u;
}

__device__ __forceinline__ void xcd_barrier(const XcdBarrier& b) {
    asm volatile("s_waitcnt vmcnt(0)" ::: "memory");
    __syncthreads();
    if (threadIdx.x == 0) {
        unsigned* bar = b.bar;
        __builtin_amdgcn_s_waitcnt(0);
        unsigned nloc = b.st[0], nx = b.st[1];
        if (nloc == 0u) { xcd_barrier_complete(bar, b.x, nloc, nx); b.st[0] = nloc; b.st[1] = nx; }
        const unsigned old = xb_add(&bar[XB_XSUB(b.x)], 1u);
        const unsigned gen = old / nloc;
        if (old + 1u == (gen + 1u) * nloc) {
            __builtin_amdgcn_fence(__ATOMIC_RELEASE, "agent");
            asm volatile("s_waitcnt vmcnt(0)" ::: "memory");
            const unsigned og = xb_add(&bar[XB_TOP], 1u);
            const unsigned tg = og / nx;
            if (og + 1u == (tg + 1u) * nx) xb_add(&bar[XB_TOPGEN], 1u);
            else XB_SPIN(xb_ld(&bar[XB_TOPGEN]) == tg, bar);
            __builtin_amdgcn_fence(__ATOMIC_ACQUIRE, "agent");
            xb_add(&bar[XB_XGEN(b.x)], 1u);
            asm volatile("s_waitcnt vmcnt(0)" ::: "memory");
        } else {
            XB_SPIN(xb_ld(&bar[XB_XGEN(b.x)]) == gen, bar);
            __builtin_amdgcn_fence(__ATOMIC_ACQUIRE, "agent");
            asm volatile("s_waitcnt vmcnt(0)" ::: "memory");
        }
    }
    __syncthreads();
}

namespace pg8 {
template <class Fn> struct EpiFn {
    static constexpr bool PERM = true, AFTER_DRAIN = false;
    Fn f;
    __device__ __forceinline__ void operator()(const f32x4 (&acc)[2][2][4][2], const Unit& u, int wr, int wc, int fr, int fq) const {
        const int row0 = u.pm * BM + wr * 64 + fr, col0 = u.pn * BM + wc * 32 + 8 * fq;
#pragma unroll
        for (int ai = 0; ai < 2; ++ai)
#pragma unroll
            for (int m = 0; m < 4; ++m)
#pragma unroll
                for (int bj = 0; bj < 2; ++bj) f.e8(row0 + ai * HALF + m * 16, col0 + bj * HALF, acc[ai][bj][m][0], acc[ai][bj][m][1]);
    }
};
}

struct FnBf16 {
    bf16* O; int ld;
    __device__ __forceinline__ void e8(int row, int col, f32x4 a, f32x4 b) const {
        v4u w; w.x = pk2(a.x, a.y); w.y = pk2(a.z, a.w); w.z = pk2(b.x, b.y); w.w = pk2(b.z, b.w);
        *(v4u*)(O + (size_t)row * ld + col) = w;
    }
    __device__ __forceinline__ void e4(int row, int col, f32x4 a) const {
        v2u w; w.x = pk2(a.x, a.y); w.y = pk2(a.z, a.w);
        *(v2u*)(O + (size_t)row * ld + col) = w;
    }
};
struct FnResid {
    float* XS; const float* baseP; const float* baseS;
    __device__ __forceinline__ const float* brow(int row) const { return row < MP ? baseP + (size_t)row * DM : baseS + (size_t)(row - MP) * DM; }
    __device__ __forceinline__ void e8(int row, int col, f32x4 a, f32x4 b) const {
        const float* br = brow(row) + col; float* o = XS + (size_t)row * DM + col;
        const f32x4 x0 = *(const f32x4*)br, x1 = *(const f32x4*)(br + 4);
        *(f32x4*)o = x0 + a; *(f32x4*)(o + 4) = x1 + b;
    }
    __device__ __forceinline__ void e4(int row, int col, f32x4 a) const {
        const float* br = brow(row) + col; float* o = XS + (size_t)row * DM + col;
        *(f32x4*)o = *(const f32x4*)br + a;
    }
};
struct FnF32 {
    float* O; int ld;
    __device__ __forceinline__ void e8(int row, int col, f32x4 a, f32x4 b) const { float* o = O + (size_t)row * ld + col; *(f32x4*)o = a; *(f32x4*)(o + 4) = b; }
    __device__ __forceinline__ void e4(int row, int col, f32x4 a) const { *(f32x4*)(O + (size_t)row * ld + col) = a; }
};
struct FnKvq {
    float* O; const float* ssq;
    __device__ __forceinline__ float rstd(int row) const { const f32x4 s0 = *(const f32x4*)(ssq + (size_t)row * 8), s1 = *(const f32x4*)(ssq + (size_t)row * 8 + 4);
        return 1.f / sqrtf((((s0.x + s0.y) + (s0.z + s0.w)) + ((s1.x + s1.y) + (s1.z + s1.w))) * (1.f / DM) + EPS); }
    __device__ __forceinline__ void e8(int row, int col, f32x4 a, f32x4 b) const {
        if (col < NKVQ_REAL) { const float rs = rstd(row); float* o = O + (size_t)row * NKVQ + col; *(f32x4*)o = a * rs; *(f32x4*)(o + 4) = b * rs; }
    }
    __device__ __forceinline__ void e4(int row, int col, f32x4 a) const {
        if (col < NKVQ_REAL) *(f32x4*)(O + (size_t)row * NKVQ + col) = a * rstd(row);
    }
};

template <class Fn>
__device__ __forceinline__ void skinny_gemm(Frame& F, const bf16* A, const bf16* Bt, int N, int row_base, const Fn& fn) {
    const int fr = F.lane & 15, fq = F.lane >> 4;
    const int nun = N / 16;
    for (int u = F.bid; u < nun; u += F.G) {
        const bf16* ap = Bt + (size_t)(u * 16 + fr) * DM + fq * 8;
        const bf16* bp = A + (size_t)(F.wave * 16 + fr) * DM + fq * 8;
        f32x4 acc = {0.f, 0.f, 0.f, 0.f};
#pragma unroll 8
        for (int ks = 0; ks < 32; ++ks) acc = MFMA16(ld8(ap + ks * 32), ld8(bp + ks * 32), acc);
        fn.e4(row_base + F.wave * 16 + fr, u * 16 + 4 * fq, acc);
    }
}

template <class Fn>
__device__ __forceinline__ void gemm_all(Frame& F, const bf16* A, const bf16* Bt, int N, const Fn& fn) {
    pg8::Gemm g{A, Bt, MP, N, DM}; pg8::StaticOrder S; S.init(MP, N, F.G, F.bid);
    pg8::EpiFn<Fn> E{fn};
    pg8::gemm_phase<pg8::EpiFn<Fn>, pg8::StaticOrder, true, true>(F.lds, g, S, E);
    skinny_gemm(F, A + (size_t)MP * DM, Bt, N, MP, fn);
}

__device__ __forceinline__ void p0_transpose_item(const float* W, int N, bf16* WT, int row_off, const float* gain, LAS float* scr, int item, int lane) {
    const int nblk = (N + 31) / 32, kb = item / nblk, nb = item % nblk, k0 = 64 * kb, n0 = 32 * nb;
#pragma unroll 8
    for (int i = 0; i < 32; ++i) { const int kk = 2 * i + (lane >> 5); const int n = n0 + (lane & 31);
        float v = 0.f; if (n < N) { v = W[(size_t)(k0 + kk) * N + n]; if (gain) v *= gain[k0 + kk]; }
        scr[kk * 33 + (lane & 31)] = v; }
    LDS_WAIT(); asm volatile("" ::: "memory");
    const int c = lane & 7;
#pragma unroll
    for (int j = 0; j < 4; ++j) { const int n = (lane >> 3) + 8 * j; const LAS float* s = scr + (8 * c) * 33 + n;
        v4u o; o.x = pk2(s[0 * 33], s[1 * 33]); o.y = pk2(s[2 * 33], s[3 * 33]); o.z = pk2(s[4 * 33], s[5 * 33]); o.w = pk2(s[6 * 33], s[7 * 33]);
        if (n0 + n < N) *(v4u*)(WT + (size_t)(row_off + n0 + n) * DM + k0 + 8 * c) = o; }
    LDS_WAIT(); asm volatile("" ::: "memory");
}
__device__ __forceinline__ void rms_row_to_bf16(const float* xrow, bf16* orow, int lane) {
    const f32x4* xr = (const f32x4*)xrow + lane;
    f32x4 v[4]; float s = 0.f;
#pragma unroll
    for (int j = 0; j < 4; ++j) { v[j] = xr[64 * j]; s += (v[j].x * v[j].x + v[j].y * v[j].y) + (v[j].z * v[j].z + v[j].w * v[j].w); }
    const float rstd = 1.f / sqrtf(wave_sum(s) * (1.f / DM) + EPS);
    v2u* o8 = (v2u*)orow + lane;
#pragma unroll
    for (int j = 0; j < 4; ++j) { v2u w; w.x = pk2(v[j].x * rstd, v[j].y * rstd); w.y = pk2(v[j].z * rstd, v[j].w * rstd); o8[64 * j] = w; }
}
__device__ __forceinline__ const float* xin_row(Frame& F, int row) { return row < MP ? FIN(0) + (size_t)row * DM : FIN(1) + (size_t)(row - MP) * DM; }

__device__ __forceinline__ void peer_tables_to_fp8(Frame& F, size_t thr, size_t nthr) {
    const size_t gt = thr, NGT = nthr;
        const size_t n8 = (size_t)2 * NEXP * DM / 8;
        for (int t = 0; t < 2; ++t) { const f32x4* src = (const f32x4*)FIN(27 + t); v2u* dst = (v2u*)WSP(unsigned char, t == 0 ? WS_PU : WS_PV); const float* pln = FIN(24);
            for (size_t i0 = gt; i0 < n8; i0 += (size_t)4 * NGT) {
                f32x4 a[4], b[4];
#pragma unroll
                for (int u = 0; u < 4; ++u) { const size_t i = i0 + (size_t)u * NGT; if (i < n8) { a[u] = src[2 * i]; b[u] = src[2 * i + 1]; } }
#pragma unroll
                for (int u = 0; u < 4; ++u) { const size_t i = i0 + (size_t)u * NGT; if (i < n8) {
                    if (t == 0) { const float* gp = pln + ((i >> 21) << 10) + ((i & 127) << 3); a[u] = a[u] * *(const f32x4*)gp * 32.f; b[u] = b[u] * *(const f32x4*)(gp + 4) * 32.f; }
                    else { a[u] = a[u] * 16.f; b[u] = b[u] * 16.f; }
                    int w0 = __builtin_amdgcn_cvt_pk_fp8_f32(a[u].x, a[u].y, 0, false); w0 = __builtin_amdgcn_cvt_pk_fp8_f32(a[u].z, a[u].w, w0, true);
                    int w1 = __builtin_amdgcn_cvt_pk_fp8_f32(b[u].x, b[u].y, 0, false); w1 = __builtin_amdgcn_cvt_pk_fp8_f32(b[u].z, b[u].w, w1, true);
                    dst[((((i >> 21) * 8 + ((i & 127) >> 4)) * (size_t)NEXP + ((i >> 7) & (NEXP - 1))) << 4) + (i & 15)] = (v2u){(unsigned)w0, (unsigned)w1}; } } } }
}

__device__ __forceinline__ void p0_prologue(Frame& F) {
    LAS float* scr = (LAS float*)(F.lds + F.wave * 16384);
    const int gw = F.bid * 8 + F.wave, NGW = F.G * 8;
    const int gt = F.bid * 512 + F.tid, NGT = F.G * 512;
    {
        constexpr int I_IN = 128 * 16, I_OA = 32 * 16, I_KV = 48 * 16, I_QG = 34 * 16, I_OB = 32 * 16, I_PQ = 64 * 16;
        constexpr int NITEMS = I_IN + I_OA + I_KV + I_QG + I_OB + 2 * I_PQ;
        for (int it = gw; it < NITEMS; it += NGW) {
            int r = it;
            if (r < I_IN) {
                const int kb = r / 128, nb = r % 128, k0 = 64 * kb, n0 = 32 * nb; const float* W = FIN(8); const float* gain = FIN(7);
#pragma unroll 8
                for (int i = 0; i < 32; ++i) { const int kk = 2 * i + (F.lane >> 5); scr[kk * 33 + (F.lane & 31)] = W[(size_t)(k0 + kk) * GPROJ + n0 + (F.lane & 31)] * gain[k0 + kk]; }
                LDS_WAIT(); asm volatile("" ::: "memory");
                const int c = F.lane & 7;
#pragma unroll
                for (int j = 0; j < 4; ++j) { const int n = (F.lane >> 3) + 8 * j; const LAS float* s = scr + (8 * c) * 33 + n;
                    v4u o; o.x = pk2(s[0 * 33], s[1 * 33]); o.y = pk2(s[2 * 33], s[3 * 33]); o.z = pk2(s[4 * 33], s[5 * 33]); o.w = pk2(s[6 * 33], s[7 * 33]);
                    *(v4u*)(WSP(bf16, WS_WIN_T) + (size_t)(n0 + n) * DM + k0 + 8 * c) = o; }
                LDS_WAIT(); asm volatile("" ::: "memory");
                continue; }
            r -= I_IN;
            if (r < I_OA) { p0_transpose_item(FIN(13), 1024, WSP(bf16, WS_WOA_T), 0, nullptr, scr, r, F.lane); continue; } r -= I_OA;
            if (r < I_KV) { p0_transpose_item(FIN(15), NKV, WSP(bf16, WS_WKVQ_T), 0, FIN(14), scr, r, F.lane); continue; } r -= I_KV;
            if (r < I_QG) { p0_transpose_item(FIN(21), NQG, WSP(bf16, WS_WKVQ_T), NKV, FIN(20), scr, r, F.lane); continue; } r -= I_QG;
            if (r < I_OB) { p0_transpose_item(FIN(23), 1024, WSP(bf16, WS_WOB_T), 0, nullptr, scr, r, F.lane); continue; } r -= I_OB;
            if (r < I_PQ) { p0_transpose_item(FIN(25), 2048, WSP(bf16, WS_WPQ_T), 0, FIN(24), scr, r, F.lane); continue; } r -= I_PQ;
            p0_transpose_item(FIN(25) + (size_t)1024 * 2048, 2048, WSP(bf16, WS_WPQ_T) + (size_t)2048 * 1024, 0, FIN(24) + 1024, scr, r, F.lane);
        }
        for (int i = gt; i < (NKVQ - NKVQ_REAL) * DM / 8; i += NGT) ((v4u*)(WSP(bf16, WS_WKVQ_T) + (size_t)NKVQ_REAL * DM))[i] = (v4u){0u, 0u, 0u, 0u};
        for (int i = gt; i < 16 * 1024; i += NGT) { const int j = i >> 10, k = i & 1023; WSP(float, WS_WAB)[i] = FIN(7)[k] * FIN(8)[(size_t)k * GPROJ + 4096 + j]; }
    }
    for (int m = gw; m < MTOK; m += NGW) rms_row_to_bf16(xin_row(F, m), WSP(bf16, WS_XNA) + (size_t)m * DM, F.lane);
    {
        if (F.G != 256) peer_tables_to_fp8(F, (size_t)gt, (size_t)NGT);
        const f32x4* sk = (const f32x4*)FIN(26); v4u* dk = (v4u*)WSP(bf16, WS_SUBK);
        for (int i = gt; i < 2 * 8 * 2 * 128 * 128 / 8; i += NGT) { const f32x4 a = sk[2 * i], b = sk[2 * i + 1]; v4u w; w.x = pk2(a.x, a.y); w.y = pk2(a.z, a.w); w.z = pk2(b.x, b.y); w.w = pk2(b.z, b.w); dk[i] = w; }
    }
    for (int i = gt; i < 2 * 64 * 2048; i += NGT) { const int kv = i >> 17, hh = (i >> 11) & 63, k = i & 2047;
        WSP(bf16, WS_W1T)[i] = (bf16)f2bf(FIN(17)[((size_t)kv * 2048 + k) * 64 + hh]); }
    for (int it = gw; it < 128; it += NGW) { const int kv = it >> 6, h = it & 63; float s = 0.f;
        for (int k = F.lane; k < 2048; k += 64) s += FIN(18)[(size_t)kv * 2048 + k] * FIN(17)[((size_t)kv * 2048 + k) * 64 + h];
        s = wave_sum(s); if (F.lane == 0) WSP(float, WS_PETERM)[it] = s; }
    {
        const float* cache = FIN(2); const int* pt = (const int*)FIN(6); bf16* cka = WSP(bf16, WS_CKA);
        const int nitem = SB * PAST * 2 * 4 * 8;
        for (int i0 = gt; i0 < nitem; i0 += 4 * NGT) {
            f32x4 a[4], b[4];
#pragma unroll
            for (int u = 0; u < 4; ++u) { const int i = i0 + u * NGT; if (i < nitem) {
                const int d8 = i & 7, g = (i >> 3) & 3, kv = (i >> 5) & 1, t = (i >> 6) & 8191, bs = i >> 19;
                const float* src = cache + ((size_t)pt[bs * NPAGES + (t >> 7)] * PAGE + (t & 127)) * 1024 + kv * 256 + g * 64 + d8 * 8;
                a[u] = *(const f32x4*)src; b[u] = *(const f32x4*)(src + 4); } }
#pragma unroll
            for (int u = 0; u < 4; ++u) { const int i = i0 + u * NGT; if (i < nitem) {
                const int d8 = i & 7, g = (i >> 3) & 3, kv = (i >> 5) & 1, t = (i >> 6) & 8191, bs = i >> 19;
                v4u w; w.x = pk2(a[u].x, a[u].y); w.y = pk2(a[u].z, a[u].w); w.z = pk2(b[u].x, b[u].y); w.w = pk2(b[u].z, b[u].w);
                *(v4u*)(cka + ((size_t)((bs * 4 + g) * 512 + (t >> 4))) * 2048 + kv * 1024 + (t & 15) * 64 + d8 * 8) = w; } }
        }
        bf16* wbd = WSP(bf16, WS_W1BD);
        for (int i = gt; i < 256 * 2048; i += NGT) { const int n = i >> 11, col = i & 2047, kv = n >> 7, sec = (n >> 6) & 1, hh = n & 63;
            float v = 0.f; if ((col >> 10) == kv) { const int k = col & 1023, r = (k >> 6) + 16 * sec, d = k & 63; v = FIN(17)[(((size_t)kv * 32 + r) * 64 + d) * 64 + hh]; }
            wbd[i] = (bf16)f2bf(v); }
    }
    {
        const f32x4* src = (const f32x4*)FIN(3); f32x4* dst = (f32x4*)(F.out + O_WINS);
        const int per_b = 508 * 512 / 4;
        for (int i = gt; i < SB * per_b; i += NGT) { const int b = i / per_b, r = i % per_b; dst[(size_t)b * (512 * 512 / 4) + r] = src[(size_t)b * (512 * 512 / 4) + 4 * 512 / 4 + r]; }
    }
    for (int i = gt; i < SB * NG * 544 * 64; i += NGT) {
        const int d = i & 63, r = (i >> 6) % 544, bg = (i >> 6) / 544, g = bg & 3, b = bg >> 2;
        if (r < 512) { const float* cw = FIN(3) + (((size_t)b * 512 + r) * 2) * 256 + g * 64 + d;
            WSP(bf16, WS_SKWIN)[i] = (bf16)f2bf(cw[0]);
            WSP(bf16, WS_SVWINT)[((size_t)bg * 64 + d) * 544 + r] = (bf16)f2bf(cw[256]); }
        else if (r >= 516) { WSP(bf16, WS_SKWIN)[i] = 0; WSP(bf16, WS_SVWINT)[((size_t)bg * 64 + d) * 544 + r] = 0; }
    }
}

constexpr int P2_QS = 0, P2_KS = 17408, P2_KBGT = 34816, P2_VBT = 53248, P2_AM = 71680, P2_TB = 89088, P2_G = 98304, P2_TF = 99328, P2_XF = 116736;
constexpr int QS_LD = 136, KT_LD = 72, AM_LD = 68, TB_LD = 72;

__device__ __forceinline__ float softplus_f(float x) { return fmaxf(x, 0.f) + log1pf(expf(-fabsf(x))); }

__device__ __forceinline__ void p2_chunk(Frame& F, int unit) {
    const int c = unit & 127, h = (unit >> 7) & 7, b = unit >> 10;
    const int t0 = c * CHUNK, lane = F.lane, w = F.wave, fr = lane & 15, fq = lane >> 4;
    LAS unsigned char* L = F.lds; asm volatile("" : "+v"(L));
    LAS bf16* qs = (LAS bf16*)(L + P2_QS); LAS bf16* ks = (LAS bf16*)(L + P2_KS);
    LAS bf16* kbgT = (LAS bf16*)(L + P2_KBGT); LAS bf16* vbT = (LAS bf16*)(L + P2_VBT);
    LAS float* Am = (LAS float*)(L + P2_AM); LAS bf16* Tb = (LAS bf16*)(L + P2_TB);
    LAS float* Gs = (LAS float*)(L + P2_G);
    const bf16* PROJ = WSP(bf16, WS_PROJ); const bf16* XNA = WSP(bf16, WS_XNA); const float* WAB = WSP(float, WS_WAB);
    const size_t rowb = (size_t)b * PT;
    float beta_r[8];
    {
        f32x4 wa[4], wb[4];
        const float* pa = WAB + (size_t)h * DM + 8 * lane; const float* pb = WAB + (size_t)(8 + h) * DM + 8 * lane;
        wa[0] = *(const f32x4*)pa; wa[1] = *(const f32x4*)(pa + 4); wa[2] = *(const f32x4*)(pa + 512); wa[3] = *(const f32x4*)(pa + 516);
        wb[0] = *(const f32x4*)pb; wb[1] = *(const f32x4*)(pb + 4); wb[2] = *(const f32x4*)(pb + 512); wb[3] = *(const f32x4*)(pb + 516);
        const float Aneg = -expf(FIN(10)[h]), dtb = FIN(11)[h];
#pragma unroll
        for (int tk = 0; tk < 8; ++tk) {
            const int tok = 8 * w + tk; const bf16* xr = XNA + (rowb + t0 + tok) * DM + 8 * lane;
            const v4u x0 = *(const v4u*)xr, x1 = *(const v4u*)(xr + 512);
            float sa = 0.f, sb = 0.f;
#define ACC2(xw, wv0, wv1, i0) { const float lo = bflo(xw), hi = bfhi(xw); sa += lo * wv0[i0] + hi * wv0[i0 + 1]; sb += lo * wv1[i0] + hi * wv1[i0 + 1]; }
            ACC2(x0.x, wa[0], wb[0], 0) ACC2(x0.y, wa[0], wb[0], 2) ACC2(x0.z, wa[1], wb[1], 0) ACC2(x0.w, wa[1], wb[1], 2)
            ACC2(x1.x, wa[2], wb[2], 0) ACC2(x1.y, wa[2], wb[2], 2) ACC2(x1.z, wa[3], wb[3], 0) ACC2(x1.w, wa[3], wb[3], 2)
#undef ACC2
            sa = wave_sum(sa); sb = wave_sum(sb);
            const float g = Aneg * softplus_f(sa + dtb), be = 1.f / (1.f + expf(-sb));
            beta_r[tk] = be;
            if (lane == 0) { Gs[tok] = g; Gs[64 + tok] = be; }
        }
    }
#pragma unroll
    for (int p = 0; p < 3; ++p) {
        const int col0 = p * 1024 + h * 128 + 2 * lane;
        float cw0[4], cw1[4];
#pragma unroll
        for (int i = 0; i < 4; ++i) { const f32x2 cv = *(const f32x2*)(FIN(9) + (size_t)i * GCONV + col0); cw0[i] = cv.x; cw1[i] = cv.y; }
        unsigned xw[11];
#pragma unroll
        for (int rr = 0; rr < 11; ++rr) { const int t = t0 + 8 * w - 3 + rr; xw[rr] = (t >= 0) ? *(const unsigned*)(PROJ + (rowb + t) * 4096 + col0) : 0u; }
        if (c == 127 && w == 7) {
#pragma unroll
            for (int r = 0; r < 3; ++r) { float* o = F.out + O_CONVP + ((size_t)b * 3 + r) * GCONV + col0; o[0] = bflo(xw[8 + r]); o[1] = bfhi(xw[8 + r]); }
        }
#pragma unroll
        for (int tk = 0; tk < 8; ++tk) {
            const int tok = 8 * w + tk;
            float y0 = 0.f, y1 = 0.f;
#pragma unroll
            for (int i = 0; i < 4; ++i) { y0 += cw0[i] * bflo(xw[tk + i]); y1 += cw1[i] * bfhi(xw[tk + i]); }
            y0 = silu_f(y0); y1 = silu_f(y1);
            if (p < 2) {
                const float ss = wave_sum(y0 * y0 + y1 * y1);
                const float rs = (1.f / sqrtf(ss + EPS)) * (p == 0 ? 0.08838834764831845f : 1.f);
                *(LAS unsigned*)((p == 0 ? qs : ks) + tok * QS_LD + 2 * lane) = pk2(y0 * rs, y1 * rs);
            } else {
                vbT[(2 * lane) * KT_LD + tok] = (bf16)f2bf(y0 * beta_r[tk]); vbT[(2 * lane + 1) * KT_LD + tok] = (bf16)f2bf(y1 * beta_r[tk]);
            }
        }
    }
    __syncthreads();
    if (w == 0) { float g = Gs[lane];
#pragma unroll
        for (int o = 1; o < 64; o <<= 1) { const float up = __shfl_up(g, o); if (lane >= o) g += up; }
        Gs[128 + lane] = g; }
    __syncthreads();
    const float glast = Gs[128 + 63];
    const size_t chunk = (size_t)unit;
    if (w < 4) {
        const int mt = w;
        bf16x8 a[4];
#pragma unroll
        for (int kk = 0; kk < 4; ++kk) a[kk] = ld8l(ks + (16 * mt + fr) * QS_LD + 32 * kk + 8 * fq);
#pragma unroll
        for (int nt = 0; nt < 4; ++nt) {
            f32x4 acc = {0.f, 0.f, 0.f, 0.f};
            if (nt <= mt) {
#pragma unroll
                for (int kk = 0; kk < 4; ++kk) acc = MFMA16(a[kk], ld8l(ks + (16 * nt + fr) * QS_LD + 32 * kk + 8 * fq), acc);
            }
            const int j = 16 * nt + fr; const float gj = Gs[128 + j];
#pragma unroll
            for (int r = 0; r < 4; ++r) { const int i = 16 * mt + 4 * fq + r;
                Am[i * AM_LD + j] = (i > j) ? Gs[64 + i] * acc[r] * __expf(Gs[128 + i] - gj) : 0.f; }
        }
    } else {
        const int nt = w - 4;
        bf16x8 bq[4];
#pragma unroll
        for (int kk = 0; kk < 4; ++kk) bq[kk] = ld8l(qs + (16 * nt + fr) * QS_LD + 32 * kk + 8 * fq);
        const int i = 16 * nt + fr; const float gi = Gs[128 + i];
        bf16* gqk = WSP(bf16, WS_GQK) + chunk * 4096 + (size_t)i * 64;
#pragma unroll
        for (int mt = 0; mt < 4; ++mt) {
            f32x4 acc = {0.f, 0.f, 0.f, 0.f};
            if (mt <= nt) {
#pragma unroll
                for (int kk = 0; kk < 4; ++kk) acc = MFMA16(ld8l(ks + (16 * mt + fr) * QS_LD + 32 * kk + 8 * fq), bq[kk], acc);
            }
            float v[4];
#pragma unroll
            for (int r = 0; r < 4; ++r) { const int j = 16 * mt + 4 * fq + r; v[r] = (i >= j) ? acc[r] * __expf(gi - Gs[128 + j]) : 0.f; }
            v2u o; o.x = pk2(v[0], v[1]); o.y = pk2(v[2], v[3]);
            *(v2u*)(gqk + 16 * mt + 4 * fq) = o;
        }
    }
    {
        const int tok = F.tid >> 3, d0 = (F.tid & 7) * 16; const float e = __expf(Gs[128 + tok]);
        bf16* gq = WSP(bf16, WS_GQ) + chunk * 8192 + (size_t)tok * 128 + d0;
#pragma unroll
        for (int hh = 0; hh < 2; ++hh) { const v4u q = *(const LAS v4u*)(qs + tok * QS_LD + d0 + 8 * hh); v4u o;
            o.x = pk2(bflo(q.x) * e, bfhi(q.x) * e); o.y = pk2(bflo(q.y) * e, bfhi(q.y) * e); o.z = pk2(bflo(q.z) * e, bfhi(q.z) * e); o.w = pk2(bflo(q.w) * e, bfhi(q.w) * e);
            *(v4u*)(gq + 8 * hh) = o; }
    }
    {
        const int dk = F.tid & 127, tg = F.tid >> 7;
        unsigned o1[8], o2[8];
#pragma unroll
        for (int i = 0; i < 8; ++i) {
            const int ta = 16 * tg + 2 * i, tb2 = ta + 1;
            const float ka = bf2f(ks[ta * QS_LD + dk]), kb = bf2f(ks[tb2 * QS_LD + dk]);
            const float ga = Gs[128 + ta], gb = Gs[128 + tb2];
            o1[i] = pk2(ka * Gs[64 + ta] * __expf(ga), kb * Gs[64 + tb2] * __expf(gb));
            o2[i] = pk2(ka * __expf(glast - ga), kb * __expf(glast - gb));
        }
        LAS v4u* d1 = (LAS v4u*)(kbgT + dk * KT_LD + 16 * tg); d1[0] = (v4u){o1[0], o1[1], o1[2], o1[3]}; d1[1] = (v4u){o1[4], o1[5], o1[6], o1[7]};
        v4u* d2 = (v4u*)(WSP(bf16, WS_GKT) + chunk * 8192 + (size_t)dk * 64 + 16 * tg); d2[0] = (v4u){o2[0], o2[1], o2[2], o2[3]}; d2[1] = (v4u){o2[4], o2[5], o2[6], o2[7]};
    }
    if (F.tid == 0) WSP(float, WS_GDEC)[chunk] = __expf(glast);
    __syncthreads();
    LAS float* Tf = (LAS float*)(L + P2_TF); LAS float* Xf = (LAS float*)(L + P2_XF);
    if (w == 0) {
        const int blk = lane >> 5, cc = lane & 31; const LAS float* Ab = Am + (32 * blk) * AM_LD + 32 * blk;
        float t[32];
#pragma unroll
        for (int i = 0; i < 32; ++i) {
            float acc0 = (i == cc) ? 1.f : 0.f, acc1 = 0.f;
#pragma unroll
            for (int j4 = 0; j4 < (i + 3) / 4; ++j4) {
                const f32x4 a = *(const LAS f32x4*)(Ab + i * AM_LD + 4 * j4);
                if (4 * j4 + 0 < i) acc0 = __builtin_fmaf(-a.x, t[4 * j4 + 0], acc0);
                if (4 * j4 + 1 < i) acc1 = __builtin_fmaf(-a.y, t[4 * j4 + 1], acc1);
                if (4 * j4 + 2 < i) acc0 = __builtin_fmaf(-a.z, t[4 * j4 + 2], acc0);
                if (4 * j4 + 3 < i) acc1 = __builtin_fmaf(-a.w, t[4 * j4 + 3], acc1);
            }
            t[i] = acc0 + acc1;
            asm volatile("" : "+v"(t[i]));
            __builtin_amdgcn_sched_barrier(0);
        }
#pragma unroll
        for (int i = 0; i < 32; ++i) { Tf[(32 * blk + i) * AM_LD + 32 * blk + cc] = t[i]; if (blk == 0) Tf[i * AM_LD + 32 + cc] = 0.f; }
    }
    __syncthreads();
    {
        const int i = F.tid >> 4, c0 = (F.tid & 15) * 2; float x0 = 0.f, x1 = 0.f;
#pragma unroll 8
        for (int k = 0; k < 32; ++k) { const float a = Am[(32 + i) * AM_LD + k]; x0 = __builtin_fmaf(a, Tf[k * AM_LD + c0], x0); x1 = __builtin_fmaf(a, Tf[k * AM_LD + c0 + 1], x1); }
        Xf[i * 34 + c0] = x0; Xf[i * 34 + c0 + 1] = x1;
    }
    __syncthreads();
    {
        const int i = F.tid >> 4, c0 = (F.tid & 15) * 2; float x0 = 0.f, x1 = 0.f;
#pragma unroll 8
        for (int k = 0; k < 32; ++k) { const float a = Tf[(32 + i) * AM_LD + 32 + k]; x0 = __builtin_fmaf(a, Xf[k * 34 + c0], x0); x1 = __builtin_fmaf(a, Xf[k * 34 + c0 + 1], x1); }
        Tf[(32 + i) * AM_LD + c0] = -x0; Tf[(32 + i) * AM_LD + c0 + 1] = -x1;
    }
    __syncthreads();
    {
        const int i = F.tid >> 3, c0 = (F.tid & 7) * 8; const f32x4 a = *(const LAS f32x4*)(Tf + i * AM_LD + c0), b2 = *(const LAS f32x4*)(Tf + i * AM_LD + c0 + 4);
        *(LAS v4u*)(Tb + i * TB_LD + c0) = (v4u){pk2(a.x, a.y), pk2(a.z, a.w), pk2(b2.x, b2.y), pk2(b2.z, b2.w)};
    }
    __syncthreads();
    {
        bf16x8 tb[4][2];
#pragma unroll
        for (int x = 0; x < 4; ++x)
#pragma unroll
            for (int s = 0; s < 2; ++s) tb[x][s] = ld8l(Tb + (16 * x + fr) * TB_LD + 32 * s + 8 * fq);
        const bf16x8 bv0 = ld8l(vbT + (16 * w + fr) * KT_LD + 8 * fq), bv1 = ld8l(vbT + (16 * w + fr) * KT_LD + 32 + 8 * fq);
        f32x4* gu = (f32x4*)(WSP(float, WS_GU) + chunk * 8192) + (size_t)w * 256 + lane;
#pragma unroll
        for (int mt = 0; mt < 4; ++mt) { f32x4 acc = {0.f, 0.f, 0.f, 0.f}; acc = MFMA16(tb[mt][0], bv0, acc); acc = MFMA16(tb[mt][1], bv1, acc); gu[mt * 64] = acc; }
        const bf16x8 ak0 = ld8l(kbgT + (16 * w + fr) * KT_LD + 8 * fq), ak1 = ld8l(kbgT + (16 * w + fr) * KT_LD + 32 + 8 * fq);
        bf16* gw = WSP(bf16, WS_GW) + chunk * 8192;
#pragma unroll
        for (int nt = 0; nt < 4; ++nt) { f32x4 acc = {0.f, 0.f, 0.f, 0.f}; acc = MFMA16(ak0, tb[nt][0], acc); acc = MFMA16(ak1, tb[nt][1], acc);
            v2u o; o.x = pk2(acc[0], acc[1]); o.y = pk2(acc[2], acc[3]);
            *(v2u*)(gw + (size_t)(16 * nt + fr) * 128 + 16 * w + 4 * fq) = o; }
    }
    __syncthreads();
}

constexpr int S2_Y = 0;
constexpr int S2_AB = 6144;
constexpr int S2_DOT = 6400;
constexpr int S2_U = 6656;
constexpr int S2_W = 8704;
constexpr int S2_VN = 10752;
__device__ __forceinline__ void p2_sample(Frame& F, int unit) {
    const int h = unit & 7, bs = unit >> 3, tid = F.tid, lane = F.lane, w = F.wave;
    LAS unsigned char* L = F.lds; asm volatile("" : "+v"(L));
    LAS float* Y = (LAS float*)(L + S2_Y); LAS float* AB = (LAS float*)(L + S2_AB); LAS float* DOT = (LAS float*)(L + S2_DOT);
    LAS float* U = (LAS float*)(L + S2_U); LAS float* W = (LAS float*)(L + S2_W); LAS float* VN = (LAS float*)(L + S2_VN);
    const bf16* PROJ = WSP(bf16, WS_PROJ); const bf16* XNA = WSP(bf16, WS_XNA); const float* WAB = WSP(float, WS_WAB);
    const size_t row0 = (size_t)MP + bs * 4;
    if (tid < 384) {
        const int part = tid >> 7, cc = tid & 127, col = part * 1024 + h * 128 + cc;
        float buf[7];
#pragma unroll
        for (int r = 0; r < 3; ++r) buf[r] = FIN(5)[((size_t)bs * 3 + r) * GCONV + col];
#pragma unroll
        for (int i = 0; i < 4; ++i) buf[3 + i] = bf2f(PROJ[(row0 + i) * 4096 + col]);
#pragma unroll
        for (int r = 0; r < 3; ++r) F.out[O_CONVS + ((size_t)bs * 3 + r) * GCONV + col] = buf[4 + r];
        float cw[4];
#pragma unroll
        for (int i = 0; i < 4; ++i) cw[i] = FIN(9)[(size_t)i * GCONV + col];
#pragma unroll
        for (int i = 0; i < 4; ++i) { float y = 0.f;
#pragma unroll
            for (int k = 0; k < 4; ++k) y += cw[k] * buf[i + k];
            Y[(part * 4 + i) * 128 + cc] = silu_f(y); }
    }
    {
        const int i = w >> 1, which = w & 1; const bf16* xr = XNA + (row0 + i) * DM; const float* wr = WAB + (size_t)(which * 8 + h) * DM; float s = 0.f;
        for (int k = lane; k < DM; k += 64) s += bf2f(xr[k]) * wr[k];
        s = wave_sum(s); if (lane == 0) AB[which * 4 + i] = s;
    }
    __syncthreads();
    {
        const int part = w >> 2, i = w & 3; LAS float* y = Y + (part * 4 + i) * 128; const float a = y[lane], bq = y[64 + lane];
        const float ss = wave_sum(a * a + bq * bq); const float rs = (1.f / sqrtf(ss + EPS)) * (part == 0 ? 0.08838834764831845f : 1.f);
        y[lane] = a * rs; y[64 + lane] = bq * rs;
    }
    if (tid == 0) { const float Aneg = -expf(FIN(10)[h]), dtb = FIN(11)[h]; float gc = 0.f;
        for (int i = 0; i < 4; ++i) { const float g = Aneg * softplus_f(AB[i] + dtb); gc += g; AB[8 + i] = g; AB[12 + i] = 1.f / (1.f + expf(-AB[4 + i])); AB[16 + i] = gc; } }
    __syncthreads();
    {
#pragma unroll
        for (int pp = 0; pp < 4; ++pp) { const int pr = 4 * w + pp, which = pr >> 4, i = (pr >> 2) & 3, j = pr & 3;
            const LAS float* x = Y + ((which == 0 ? 1 : 0) * 4 + i) * 128; const LAS float* y = Y + (1 * 4 + j) * 128;
            float s = x[lane] * y[lane] + x[64 + lane] * y[64 + lane]; s = wave_sum(s); if (lane == 0) DOT[pr] = s; }
    }
    __syncthreads();
    float g_[4], be[4], gc[4];
#pragma unroll
    for (int i = 0; i < 4; ++i) { g_[i] = AB[8 + i]; be[i] = AB[12 + i]; gc[i] = AB[16 + i]; }
    float Tm[4][4];
    {
        float A[4][4];
#pragma unroll
        for (int i = 0; i < 4; ++i)
#pragma unroll
            for (int j = 0; j < 4; ++j) A[i][j] = (i > j) ? be[i] * DOT[i * 4 + j] * expf(gc[i] - gc[j]) : 0.f;
#pragma unroll
        for (int cc = 0; cc < 4; ++cc)
#pragma unroll
            for (int i = 0; i < 4; ++i) { float acc = (i == cc) ? 1.f : 0.f;
#pragma unroll
                for (int j = 0; j < 4; ++j) if (j < i) acc -= A[i][j] * Tm[j][cc];
                Tm[i][cc] = acc; }
    }
    {
        const int i = tid >> 7, x = tid & 127; float su = 0.f, sw = 0.f;
#pragma unroll
        for (int j = 0; j < 4; ++j) { su += Tm[i][j] * Y[(2 * 4 + j) * 128 + x] * be[j]; sw += Tm[i][j] * Y[(1 * 4 + j) * 128 + x] * be[j] * expf(gc[j]); }
        U[i * 128 + x] = su; W[i * 128 + x] = sw;
    }
    __syncthreads();
    const float* S0 = FIN(4) + ((size_t)bs * GH + h) * 128 * 128;
    float qs_acc;
    {
        const int i = tid >> 7, dv = tid & 127; float p = 0.f, qq = 0.f;
        const LAS float* wr = W + i * 128; const LAS float* qr = Y + (0 * 4 + i) * 128;
#pragma unroll 16
        for (int dk = 0; dk < 128; ++dk) { const float s = S0[(size_t)dk * 128 + dv]; p += wr[dk] * s; qq += qr[dk] * s; }
        VN[i * 128 + dv] = U[i * 128 + dv] - p; qs_acc = qq * expf(gc[i]);
    }
    __syncthreads();
    {
        const int i = tid >> 7, dv = tid & 127; float o = qs_acc;
#pragma unroll
        for (int j = 0; j < 4; ++j) if (j <= i) o += DOT[16 + i * 4 + j] * expf(gc[i] - gc[j]) * VN[j * 128 + dv];
        WSP(float, WS_OGDN)[(row0 + i) * DM + h * 128 + dv] = o;
    }
    {
        const int dv = tid & 127, dg = tid >> 7; const float el = expf(gc[3]);
        float kd[4], vn[4];
#pragma unroll
        for (int j = 0; j < 4; ++j) { kd[j] = expf(gc[3] - gc[j]); vn[j] = VN[j * 128 + dv]; }
        float* So = F.out + O_GDNS + ((size_t)bs * GH + h) * 128 * 128;
#pragma unroll 8
        for (int dk = dg * 32; dk < dg * 32 + 32; ++dk) { float s = S0[(size_t)dk * 128 + dv] * el;
#pragma unroll
            for (int j = 0; j < 4; ++j) s += Y[(1 * 4 + j) * 128 + dk] * kd[j] * vn[j];
            So[(size_t)dk * 128 + dv] = s; }
    }
    (void)g_;
    __syncthreads();
}

constexpr int P3_S = 0;
constexpr int P3_VN = 8192;
__device__ __forceinline__ void p3_scan(Frame& F, int bh, int s) {
    const int lane = F.lane, w = F.wave, fr = lane & 15, fq = lane >> 4;
    const int b = bh >> 3, h = bh & 7;
    LAS bf16* Sl = (LAS bf16*)(F.lds + P3_S); LAS bf16* Vl = (LAS bf16*)(F.lds + P3_VN);
    const bf16* GW = WSP(bf16, WS_GW); const bf16* GQ = WSP(bf16, WS_GQ); const bf16* GKT = WSP(bf16, WS_GKT); const bf16* GQK = WSP(bf16, WS_GQK);
    const float* GU = WSP(float, WS_GU); const float* GDEC = WSP(float, WS_GDEC);
    float* OG = WSP(float, WS_OGDN);
    f32x4 Sacc = {0.f, 0.f, 0.f, 0.f};
    { v2u z = {0u, 0u}; *(LAS v2u*)(Sl + fr * 136 + 16 * w + 4 * fq) = z; }
    __syncthreads();
    const int m = w & 3;
    struct P3Ops { bf16x8 a1[4], ak0, ak1, aq0, aq1; f32x4 u4; float dec; };
    P3Ops R0, R1, R2;
#define P3_FETCH(R, cc) do { const size_t ch_ = (size_t)bh * NCH + (cc); \
        const bf16* p1_ = (w < 4 ? GW : GQ) + ch_ * 8192 + (size_t)(16 * m + fr) * 128 + 8 * fq; \
        _Pragma("unroll") for (int k_ = 0; k_ < 4; ++k_) R.a1[k_] = ld8(p1_ + 32 * k_); \
        const bf16* pk_ = GKT + ch_ * 8192 + (size_t)(16 * w + fr) * 64 + 8 * fq; R.ak0 = ld8(pk_); R.ak1 = ld8(pk_ + 32); \
        const bf16* pq_ = GQK + ch_ * 4096 + (size_t)(16 * m + fr) * 64 + 8 * fq; R.aq0 = ld8(pq_); R.aq1 = ld8(pq_ + 32);        \
        R.u4 = *((const f32x4*)(GU + ch_ * 8192) + (size_t)s * 256 + m * 64 + lane); \
        R.dec = GDEC[ch_]; } while (0)
#define P3_STEP(R, c) do { \
        f32x4 acc = {0.f, 0.f, 0.f, 0.f}; \
        _Pragma("unroll") for (int k = 0; k < 4; ++k) acc = MFMA16(R.a1[k], ld8l(Sl + fr * 136 + 32 * k + 8 * fq), acc); \
        if (w < 4) { const f32x4 vn = R.u4 - acc; v2u o; o.x = pk2(vn[0], vn[1]); o.y = pk2(vn[2], vn[3]); *(LAS v2u*)(Vl + fr * 72 + 16 * m + 4 * fq) = o; } \
        asm volatile("s_waitcnt lgkmcnt(0)\n\ts_barrier" ::: "memory"); \
        const bf16x8 v0 = ld8l(Vl + fr * 72 + 8 * fq), v1 = ld8l(Vl + fr * 72 + 32 + 8 * fq); \
        if (w >= 4) { acc = MFMA16(R.aq0, v0, acc); acc = MFMA16(R.aq1, v1, acc); \
            float* o = OG + ((size_t)b * PT + (c) * CHUNK + 16 * m + 4 * fq) * DM + h * 128 + 16 * s + fr; \
            _Pragma("unroll") for (int r = 0; r < 4; ++r) o[(size_t)r * DM] = acc[r]; } \
        Sacc = Sacc * R.dec; Sacc = MFMA16(R.ak0, v0, Sacc); Sacc = MFMA16(R.ak1, v1, Sacc); \
        { v2u o; o.x = pk2(Sacc[0], Sacc[1]); o.y = pk2(Sacc[2], Sacc[3]); *(LAS v2u*)(Sl + fr * 136 + 16 * w + 4 * fq) = o; } \
        asm volatile("s_waitcnt lgkmcnt(0)\n\ts_barrier" ::: "memory"); } while (0)
    P3_FETCH(R0, 0); P3_FETCH(R1, 1); P3_FETCH(R2, 2);
    static_assert(NCH % 3 == 2, "ring schedule below assumes NCH = 3k + 2");
#pragma unroll 1
    for (int c = 0; c + 3 <= NCH; c += 3) {
        P3_STEP(R0, c);     P3_FETCH(R0, (c + 3 < NCH ? c + 3 : NCH - 1));
        P3_STEP(R1, c + 1); P3_FETCH(R1, (c + 4 < NCH ? c + 4 : NCH - 1));
        P3_STEP(R2, c + 2); P3_FETCH(R2, (c + 5 < NCH ? c + 5 : NCH - 1));
    }
    P3_STEP(R0, NCH - 2); P3_STEP(R1, NCH - 1);
#undef P3_FETCH
#undef P3_STEP
    float* So = F.out + O_GDNP + ((size_t)bh * 128) * 128;
#pragma unroll
    for (int r = 0; r < 4; ++r) So[(size_t)(16 * w + 4 * fq + r) * 128 + 16 * s + fr] = Sacc[r];
}

__device__ __forceinline__ void p4_row(Frame& F, int row) {
    const int lane = F.lane;
    const float* o = WSP(float, WS_OGDN) + (size_t)row * DM + 16 * lane;
    const bf16* z = WSP(bf16, WS_PROJ) + (size_t)row * 4096 + 3072 + 16 * lane;
    f32x4 v[4]; float ss = 0.f;
#pragma unroll
    for (int j = 0; j < 4; ++j) { v[j] = *(const f32x4*)(o + 4 * j); ss += (v[j].x * v[j].x + v[j].y * v[j].y) + (v[j].z * v[j].z + v[j].w * v[j].w); }
    ss += dpp_f<DPP_XOR1>(ss); ss += dpp_f<DPP_XOR2>(ss); ss += dpp_f<DPP_HMIR>(ss);
    const float rstd = 1.f / sqrtf(ss * (1.f / 128.f) + EPS);
    const v4u z0 = *(const v4u*)z, z1 = *(const v4u*)(z + 8);
    const float* gn = FIN(12) + (16 * lane & 127);
    float zz[16] = {bflo(z0.x), bfhi(z0.x), bflo(z0.y), bfhi(z0.y), bflo(z0.z), bfhi(z0.z), bflo(z0.w), bfhi(z0.w),
                    bflo(z1.x), bfhi(z1.x), bflo(z1.y), bfhi(z1.y), bflo(z1.z), bfhi(z1.z), bflo(z1.w), bfhi(z1.w)};
    unsigned ow[8];
#pragma unroll
    for (int j = 0; j < 8; ++j) { const float a = v[j >> 1][(2 * j) & 3] * rstd * gn[2 * j] * silu_f(zz[2 * j]), bq = v[j >> 1][(2 * j + 1) & 3] * rstd * gn[2 * j + 1] * silu_f(zz[2 * j + 1]); ow[j] = pk2(a, bq); }
    v4u* dst = (v4u*)(WSP(bf16, WS_OG) + (size_t)row * DM + 16 * lane);
    dst[0] = (v4u){ow[0], ow[1], ow[2], ow[3]}; dst[1] = (v4u){ow[4], ow[5], ow[6], ow[7]};
}

typedef __bf16 bf16x2_t __attribute__((ext_vector_type(2)));
__device__ __forceinline__ float dot2_bf16(unsigned w, unsigned x, float acc) { return __builtin_amdgcn_fdot2_f32_bf16(__builtin_bit_cast(bf16x2_t, w), __builtin_bit_cast(bf16x2_t, x), acc, false); }
__device__ __forceinline__ float u2f(unsigned u) { return __builtin_bit_cast(float, u); }
__device__ __forceinline__ unsigned f2u(float f) { return __builtin_bit_cast(unsigned, f); }

constexpr int P8_MAXU = 4;
constexpr int P8_WAVE = P8_MAXU * 2048 + 1024;
constexpr int P8_TOP = 0;
constexpr int P8_TAB = 8 * P8_WAVE;
__device__ __forceinline__ void p8_init_tab(Frame& F) {
    LAS unsigned char* tab = F.lds + P8_TAB;
    if (F.tid < 64) { const int k = F.tid; int i = 0, j = 0;
        if (k < 16) { i = 0; j = k; } else if (k < 24) { i = 1; j = k - 16; } else if (k < 29) { i = 2; j = k - 24; } else if (k < 33) { i = 3; j = k - 29; }
        else if (k < 36) { i = 4; j = k - 33; } else if (k < 38) { i = 5; j = k - 36; } else if (k < 40) { i = 6; j = k - 38; } else if (k < 42) { i = 7; j = k - 40; } else if (k < 50) { i = k - 34; j = 0; }
        tab[k] = (unsigned char)i; tab[64 + k] = (unsigned char)j; }
    __syncthreads();
}
__device__ __forceinline__ int fkey(float x) { const int b = __builtin_bit_cast(int, x); return b ^ ((b >> 31) & 0x7fffffff); }
__device__ __forceinline__ float fkey_inv(int k) { return __builtin_bit_cast(float, k ^ ((k >> 31) & 0x7fffffff)); }
template <int CTRL> __device__ __forceinline__ int dpp_i(int x) { return __builtin_amdgcn_update_dpp(0, x, CTRL, 0xF, 0xF, true); }
__device__ __forceinline__ int imax(int a, int b) { return a > b ? a : b; }
__device__ __forceinline__ int imin(int a, int b) { return a < b ? a : b; }
__device__ __forceinline__ int row_imax16(int x) {
    x = imax(x, dpp_i<0xB1>(x)); x = imax(x, dpp_i<0x4E>(x)); x = imax(x, dpp_i<0x141>(x)); x = imax(x, dpp_i<0x140>(x)); return x;
}
#define ICSWAP(a, b) { const int hi_ = imax(a, b), lo_ = imin(a, b); a = hi_; b = lo_; }
constexpr int IKEY_MIN = (int)0x80000000;
template <int NR>
__device__ __forceinline__ void p8_run(Frame& F, int layer, int w, int rq, int u0, int ustride, int nu) {
    int lane_ = F.lane; asm volatile("" : "+v"(lane_));
    const int lane = lane_, fr = lane & 15, fq = lane >> 4;
    LAS unsigned char* L = F.lds; asm volatile("" : "+v"(L));
    LAS int* toplw = (LAS int*)(L + P8_TOP + F.wave * P8_WAVE);
    LAS float* wins = (LAS float*)(L + P8_TOP + F.wave * P8_WAVE + P8_MAXU * 2048);
    const LAS unsigned char* tab = L + P8_TAB;
    const bf16* Qb = WSP(bf16, WS_QPEER) + (size_t)fr * 2048 + w * 256 + 8 * fq;
    const bf16* SK = WSP(bf16, WS_SUBK) + (size_t)((layer * 8 + w) * 2) * 16384 + (size_t)fr * 128 + 8 * fq;
#pragma unroll 1
    for (int p = 0; p < 2; ++p) {
        bf16x8 bk[32], aq[4];
#pragma unroll
        for (int i = 0; i < 32; ++i) bk[i] = ld8(SK + (size_t)p * 16384 + (size_t)(i >> 2) * 2048 + 32 * (i & 3));
#pragma unroll
        for (int ks = 0; ks < 4; ++ks) aq[ks] = ld8(Qb + (size_t)u0 * 16 * 2048 + p * 128 + 32 * ks);
#pragma unroll 1
        for (int k = 0; k < nu; ++k) {
            LAS int* topl = toplw + k * 512;
            int s[NR][8];
#pragma unroll
            for (int nt = 0; nt < 8; ++nt) { f32x4 acc = {0.f, 0.f, 0.f, 0.f};
#pragma unroll
                for (int ks = 0; ks < 4; ++ks) acc = MFMA16(aq[ks], bk[nt * 4 + ks], acc);
                if (NR == 4) {
#pragma unroll
                    for (int r = 0; r < NR; ++r) s[r][nt] = fkey(u2f((f2u(acc[r]) & ~127u) | (unsigned)(16 * nt + fr)));
                } else { const float av = rq == 0 ? acc[0] : rq == 1 ? acc[1] : rq == 2 ? acc[2] : acc[3]; s[0][nt] = fkey(u2f((f2u(av) & ~127u) | (unsigned)(16 * nt + fr))); } }
            { const int un = u0 + (k + 1 < nu ? k + 1 : k) * ustride;
#pragma unroll
              for (int ks = 0; ks < 4; ++ks) aq[ks] = ld8(Qb + (size_t)un * 16 * 2048 + p * 128 + 32 * ks); }
#pragma unroll
            for (int r = 0; r < NR; ++r) {
                ICSWAP(s[r][0], s[r][1]) ICSWAP(s[r][2], s[r][3]) ICSWAP(s[r][4], s[r][5]) ICSWAP(s[r][6], s[r][7])
                ICSWAP(s[r][0], s[r][2]) ICSWAP(s[r][1], s[r][3]) ICSWAP(s[r][4], s[r][6]) ICSWAP(s[r][5], s[r][7])
                ICSWAP(s[r][1], s[r][2]) ICSWAP(s[r][5], s[r][6]) ICSWAP(s[r][0], s[r][4]) ICSWAP(s[r][3], s[r][7])
                ICSWAP(s[r][1], s[r][5]) ICSWAP(s[r][2], s[r][6]) ICSWAP(s[r][1], s[r][4]) ICSWAP(s[r][3], s[r][6])
                ICSWAP(s[r][2], s[r][4]) ICSWAP(s[r][3], s[r][5]) ICSWAP(s[r][3], s[r][4]) }
            int mine[NR];
#pragma unroll
            for (int r = 0; r < NR; ++r) mine[r] = IKEY_MIN;
#pragma unroll 1
            for (int rd = 0; rd < 16; ++rd) {
                const bool me = fr == rd;
#pragma unroll
                for (int r = 0; r < NR; ++r) {
                    const int mx = row_imax16(s[r][0]);
                    const bool pop = s[r][0] == mx;
#pragma unroll
                    for (int i = 0; i < 7; ++i) s[r][i] = pop ? s[r][i + 1] : s[r][i];
                    s[r][7] = pop ? IKEY_MIN : s[r][7];
                    mine[r] = me ? mx : mine[r];
                }
            }
#pragma unroll
            for (int r = 0; r < NR; ++r) topl[((4 * fq + (NR == 4 ? r : rq)) * 2 + p) * 16 + fr] = mine[r];
        }
    }
    LDS_WAIT();
#pragma unroll 1
    for (int k = 0; k < nu; ++k) {
    LAS int* topl = toplw + k * 512;
    const int r0 = (u0 + k * ustride) * 16;
    int c[NR][4];
#pragma unroll
    for (int r = 0; r < NR; ++r) { const int tk = 4 * fq + (NR == 4 ? r : rq);
#pragma unroll
        for (int m = 0; m < 4; ++m) { const int kc = fr + 16 * m; int cv = IKEY_MIN;
            if (kc < 50) { const int i = tab[kc], j = tab[64 + kc]; const float s1 = u2f(f2u(fkey_inv(topl[(tk * 2 + 0) * 16 + i])) & ~127u), s2 = u2f(f2u(fkey_inv(topl[(tk * 2 + 1) * 16 + j])) & ~127u);
                cv = fkey(u2f((f2u(s1 + s2) & ~63u) | (unsigned)kc)); }
            c[r][m] = cv; }
        ICSWAP(c[r][0], c[r][1]) ICSWAP(c[r][2], c[r][3]) ICSWAP(c[r][0], c[r][2]) ICSWAP(c[r][1], c[r][3]) ICSWAP(c[r][1], c[r][2]) }
    int minec[NR];
#pragma unroll
    for (int r = 0; r < NR; ++r) minec[r] = IKEY_MIN;
#pragma unroll 1
    for (int rd = 0; rd < 16; ++rd) {
        const bool me = fr == rd;
#pragma unroll
        for (int r = 0; r < NR; ++r) {
            const int mx = row_imax16(c[r][0]);
            const bool pop = c[r][0] == mx;
            c[r][0] = pop ? c[r][1] : c[r][0]; c[r][1] = pop ? c[r][2] : c[r][1]; c[r][2] = pop ? c[r][3] : c[r][2]; c[r][3] = pop ? IKEY_MIN : c[r][3];
            minec[r] = me ? mx : minec[r];
        }
    }
#pragma unroll
    for (int r = 0; r < NR; ++r) wins[(4 * fq + (NR == 4 ? r : rq)) * 16 + fr] = fkey_inv(minec[r]);
    LDS_WAIT();
    if (NR == 4 || (fr >> 2) == rq) {
        const int tk = 4 * fq + (fr >> 2), q4 = fr & 3;
        const float w0 = wins[tk * 16]; float den = 0.f;
#pragma unroll
        for (int rd = 0; rd < 16; ++rd) den += __expf(wins[tk * 16 + rd] - w0);
        const float inv = 1.f / den;
        int e[4]; float g[4];
#pragma unroll
        for (int x = 0; x < 4; ++x) { const float wv = wins[tk * 16 + 4 * q4 + x]; const int kc = (int)(f2u(wv) & 63u); const int i = tab[kc], j = tab[64 + kc];
            e[x] = (int)(f2u(fkey_inv(topl[(tk * 2 + 0) * 16 + i])) & 127u) * 128 + (int)(f2u(fkey_inv(topl[(tk * 2 + 1) * 16 + j])) & 127u); g[x] = __expf(wv - w0) * inv; }
        unsigned short* pei = WSP(unsigned short, WS_PEI) + (size_t)(r0 + tk) * 128 + w * 16 + 4 * q4; float* peg = WSP(float, WS_PEG) + (size_t)(r0 + tk) * 128 + w * 16 + 4 * q4;
        *(v2u*)pei = (v2u){(unsigned)e[0] | ((unsigned)e[1] << 16), (unsigned)e[2] | ((unsigned)e[3] << 16)};
        *(f32x4*)peg = (f32x4){g[0], g[1], g[2], g[3]};
    }
    LDS_WAIT();
    }
}
__device__ __forceinline__ void p8_phase(Frame& F, int layer) {
    p8_init_tab(F);
    for (int ub = F.bid; ub < MP / 16; ub += F.G * P8_MAXU) { const int left = (MP / 16 - ub + F.G - 1) / F.G; p8_run<4>(F, layer, F.wave, 0, ub, F.G, left < P8_MAXU ? left : P8_MAXU); }
    for (int qu = F.bid * 8 + F.wave; qu < (MS / 16) * 8 * 4 * 8; qu += F.G * 8) { if ((qu & 7) == 0) { const int x = qu >> 3; p8_run<1>(F, layer, (x >> 2) & 7, x & 3, MP / 16 + (x >> 5), 0, 1); } }
}

constexpr size_t PE_SLICE_BYTES = (size_t)NEXP * 128;
__device__ __forceinline__ f32x2 p9_cvt(unsigned w, bool hi) { return hi ? __builtin_amdgcn_cvt_pk_f32_fp8((int)w, true) : __builtin_amdgcn_cvt_pk_f32_fp8((int)w, false); }
__device__ __forceinline__ f32x2 fma2(f32x2 a, f32x2 b, f32x2 c) { return __builtin_elementwise_fma(a, b, c); }
__device__ __forceinline__ float p9_dot16(const v4u u, const f32x2 (&h)[8]) {
    f32x2 a = {0.f, 0.f}, b = {0.f, 0.f};
    a = fma2(p9_cvt(u.x, false), h[0], a); b = fma2(p9_cvt(u.x, true), h[1], b); a = fma2(p9_cvt(u.y, false), h[2], a); b = fma2(p9_cvt(u.y, true), h[3], b);
    a = fma2(p9_cvt(u.z, false), h[4], a); b = fma2(p9_cvt(u.z, true), h[5], b); a = fma2(p9_cvt(u.w, false), h[6], a); b = fma2(p9_cvt(u.w, true), h[7], b);
    a = a + b; return a.x + a.y;
}
__device__ __forceinline__ void p9_axpy16(const v4u v, float c, f32x2 (&o)[8]) {
    const f32x2 cc = {c, c};
    o[0] = fma2(p9_cvt(v.x, false), cc, o[0]); o[1] = fma2(p9_cvt(v.x, true), cc, o[1]); o[2] = fma2(p9_cvt(v.y, false), cc, o[2]); o[3] = fma2(p9_cvt(v.y, true), cc, o[3]);
    o[4] = fma2(p9_cvt(v.z, false), cc, o[4]); o[5] = fma2(p9_cvt(v.z, true), cc, o[5]); o[6] = fma2(p9_cvt(v.w, false), cc, o[6]); o[7] = fma2(p9_cvt(v.w, true), cc, o[7]);
}
#define P9_GATHER(S, iw) do { _Pragma("unroll") for (int j_ = 0; j_ < 8; ++j_) { const unsigned w_ = (iw)[j_ >> 1]; const unsigned id_ = (j_ & 1) ? (w_ >> 16) : (w_ & 0xffffu); \
        S[j_] = *(const v4u*)(tab + ((id_ << 7) + sub16)); } } while (0)
__device__ __forceinline__ float swapsum16(float x, float y) { unsigned a = __builtin_bit_cast(unsigned, x), b = __builtin_bit_cast(unsigned, y); PSWAP16(a, b); return __builtin_bit_cast(float, a) + __builtin_bit_cast(float, b); }
__device__ __forceinline__ float swapsum32(float x, float y) { unsigned a = __builtin_bit_cast(unsigned, x), b = __builtin_bit_cast(unsigned, y); PSWAP32(a, b); return __builtin_bit_cast(float, a) + __builtin_bit_cast(float, b); }

__device__ __forceinline__ void p9u_wave(Frame& F, int layer, int slice, int first, int stride) {
    int lane_ = F.lane; asm volatile("" : "+v"(lane_));
    const int lane = lane_, gi = lane >> 3, sub = lane & 7;
    const unsigned char* tab = WSP(unsigned char, WS_PU) + (size_t)(layer * 8 + slice) * PE_SLICE_BYTES;
    const unsigned sub16 = (unsigned)sub * 16u;
    const unsigned char* hbase = (const unsigned char*)(WSP(bf16, WS_XNB) + slice * 128 + sub * 16);
    const unsigned char* ibase = (const unsigned char*)(WSP(unsigned short, WS_PEI) + gi * 16);
    unsigned* pa = WSP(unsigned, WS_PA) + slice * 64 + lane;
    int t = first; if (t >= MTOK) return;
    v4u ia, ib, ha, hb, nia, nib, nha, nhb, A[8], B[8];
#define P9U_META(tt, xa, xb, ya, yb) do { const v4u* ip_ = (const v4u*)(ibase + (size_t)(tt) * 256); xa = ip_[0]; xb = ip_[1]; const v4u* hp_ = (const v4u*)(hbase + (size_t)(tt) * 2048); ya = hp_[0]; yb = hp_[1]; } while (0)
    P9U_META(t, ia, ib, ha, hb);
    P9_GATHER(A, ia);
    const bool b0 = sub & 1, b1 = sub & 2, b2 = sub & 4;
#pragma unroll 1
    for (;;) {
        const int tn = t + stride; const bool more = tn < MTOK; const int tl = more ? tn : t;
        P9U_META(tl, nia, nib, nha, nhb);
        P9_GATHER(B, ib);
        f32x2 h[8];
#pragma unroll
        for (int k = 0; k < 4; ++k) { h[k] = (f32x2){bflo(ha[k]), bfhi(ha[k])}; h[4 + k] = (f32x2){bflo(hb[k]), bfhi(hb[k])}; }
        float p[16];
#pragma unroll
        for (int j = 0; j < 8; ++j) p[j] = p9_dot16(A[j], h);
        P9_GATHER(A, nia);
#pragma unroll
        for (int j = 0; j < 8; ++j) p[8 + j] = p9_dot16(B[j], h);
        float q[8], r[4], sv[2];
#pragma unroll
        for (int i = 0; i < 8; ++i) { const float keep = b2 ? p[8 + i] : p[i], send = b2 ? p[i] : p[8 + i]; q[i] = keep + dpp_f<DPP_HMIR>(send); }
#pragma unroll
        for (int i = 0; i < 4; ++i) { const float keep = b0 ? q[2 * i + 1] : q[2 * i], send = b0 ? q[2 * i] : q[2 * i + 1]; r[i] = keep + dpp_f<DPP_XOR1>(send); }
#pragma unroll
        for (int i = 0; i < 2; ++i) { const float keep = b1 ? r[2 * i + 1] : r[2 * i], send = b1 ? r[2 * i] : r[2 * i + 1]; sv[i] = keep + dpp_f<DPP_XOR2>(send); }
        pa[(size_t)t * 512] = pk2(sv[0], sv[1]);
        if (!more) break;
        t = tn; ia = nia; ib = nib; ha = nha; hb = nhb;
    }
#undef P9U_META
}

__device__ __forceinline__ void p9v_wave(Frame& F, int layer, int slice, int first, int stride, int mode) {
    int lane_ = F.lane; asm volatile("" : "+v"(lane_));
    const int lane = lane_, gi = lane >> 3, sub = lane & 7, j0 = 8 * (sub >> 2) + (sub & 3);
    const unsigned char* tab = WSP(unsigned char, WS_PV) + (size_t)(layer * 8 + slice) * PE_SLICE_BYTES;
    const unsigned sub16 = (unsigned)sub * 16u;
    const unsigned char* ibase = (const unsigned char*)(WSP(unsigned short, WS_PEI) + gi * 16);
    const unsigned* pab = WSP(unsigned, WS_PA) + lane;
    const float* pegb = WSP(float, WS_PEG) + gi * 16 + j0;
    const int eoff = slice * 128 + sub * 16 + gi;
    float* xsb = WSP(float, WS_XS) + eoff;
    int t = first; if (t >= MTOK) return;
    v4u ia, ib, nia, nib, A[8], B[8];
    unsigned pw[8], npw[8]; float g0, g1, ng0, ng1, x0, x1, nx0, nx1;
#define P9V_META(tt, xa, xb, pp, ga, gb, ya, yb) do { const v4u* ip_ = (const v4u*)(ibase + (size_t)(tt) * 256); xa = ip_[0]; xb = ip_[1]; \
        _Pragma("unroll") for (int x_ = 0; x_ < 8; ++x_) pp[x_] = pab[(size_t)(tt) * 512 + x_ * 64]; \
        ga = pegb[(size_t)(tt) * 128]; gb = pegb[(size_t)(tt) * 128 + 4]; ya = xsb[(size_t)(tt) * DM]; yb = xsb[(size_t)(tt) * DM + 8]; } while (0)
    P9V_META(t, ia, ib, pw, g0, g1, x0, x1);
    P9_GATHER(A, ia);
#pragma unroll 1
    for (;;) {
        const int tn = t + stride; const bool more = tn < MTOK; const int tl = more ? tn : t;
        P9V_META(tl, nia, nib, npw, ng0, ng1, nx0, nx1);
        P9_GATHER(B, ib);
        float alo = 0.f, ahi = 0.f;
#pragma unroll
        for (int x = 0; x < 8; ++x) { alo += bflo(pw[x]); ahi += bfhi(pw[x]); }
        const float c0 = gelu_tanh(alo * 0.03125f) * g0 * 0.0625f, c1 = gelu_tanh(ahi * 0.03125f) * g1 * 0.0625f;
        f32x2 o[8];
#pragma unroll
        for (int i = 0; i < 8; ++i) o[i] = (f32x2){0.f, 0.f};
#define P9V_C(j) __builtin_bit_cast(float, __builtin_amdgcn_ds_swizzle(__builtin_bit_cast(int, (((j) >> 2) & 1) ? c1 : c0), ((4 * ((j) >> 3) + ((j) & 3)) << 5) | 0x18))
        { const float cj[8] = {P9V_C(0), P9V_C(1), P9V_C(2), P9V_C(3), P9V_C(4), P9V_C(5), P9V_C(6), P9V_C(7)};
#pragma unroll
          for (int j = 0; j < 8; ++j) p9_axpy16(A[j], cj[j], o); }
        P9_GATHER(A, nia);
        { const float cj[8] = {P9V_C(8), P9V_C(9), P9V_C(10), P9V_C(11), P9V_C(12), P9V_C(13), P9V_C(14), P9V_C(15)};
#pragma unroll
          for (int j = 0; j < 8; ++j) p9_axpy16(B[j], cj[j], o); }
#undef P9V_C
        const bool g0b = lane & 8;
        float q[8], r[4], sv[2];
#pragma unroll
        for (int i = 0; i < 8; ++i) { const float keep = g0b ? o[i].y : o[i].x, send = g0b ? o[i].x : o[i].y; q[i] = keep + dpp_f<DPP_ROR8>(send); }
#pragma unroll
        for (int i = 0; i < 4; ++i) r[i] = swapsum16(q[2 * i], q[2 * i + 1]);
#pragma unroll
        for (int i = 0; i < 2; ++i) sv[i] = swapsum32(r[2 * i], r[2 * i + 1]);
        const float y0 = x0 + sv[0], y1 = x1 + sv[1];
        if (mode == 0) {
            float* xs = xsb + (size_t)t * DM; xs[0] = y0; xs[8] = y1;
            bf16* xn = WSP(bf16, WS_XNA) + (size_t)t * DM + eoff; xn[0] = (bf16)f2bf(y0); xn[8] = (bf16)f2bf(y1);
            const float ss = wave_sum(y0 * y0 + y1 * y1);
            if (lane == 0) WSP(float, WS_SSQ)[(size_t)t * 8 + slice] = ss;
        } else {
            float* y = (t < MP ? F.out + O_YP + (size_t)t * DM : F.out + O_YS + (size_t)(t - MP) * DM) + eoff;
            y[0] = y0; y[8] = y1;
        }
        if (!more) break;
        t = tn; ia = nia; ib = nib; g0 = ng0; g1 = ng1; x0 = nx0; x1 = nx1;
#pragma unroll
        for (int x = 0; x < 8; ++x) pw[x] = npw[x];
    }
#undef P9V_META
}
#undef P9_GATHER

constexpr float QSCALE = 0.125f * 1.4426950408889634f;
constexpr int PP_VT = 0;
__device__ __forceinline__ float rms64(float v) { return 1.f / sqrtf(wave_sum(v * v) * (1.f / 64.f) + EPS); }

__device__ __forceinline__ void pp_q_row(Frame& F, int row, const float* kvq, const float qg) {
    const int lane = F.lane;
    bf16* qn = WSP(bf16, WS_QN) + (size_t)row * 1024;
#pragma unroll 4
    for (int hd = 0; hd < 16; ++hd) { const float v = kvq[NKV + hd * 64 + lane]; qn[hd * 64 + lane] = (bf16)f2bf(v * rms64(v) * qg); }
    if (lane < 48) WSP(float, WS_GATES)[(size_t)row * 48 + lane] = sigmoid_f(kvq[NKV + 1024 + lane]);
}
__device__ __forceinline__ void pp_prompt_tile(Frame& F, int unit) {
    const int lane = F.lane, w = F.wave, b = unit >> 7, t0 = (unit & 127) * 64;
    LAS unsigned char* L = F.lds; asm volatile("" : "+v"(L));
    LAS bf16* vt = (LAS bf16*)(L + PP_VT);
    const float kg1 = FIN(16)[64 + lane], kg2 = FIN(16)[128 + lane], qg = FIN(22)[lane] * QSCALE;
    for (int rr = 0; rr < 8; ++rr) {
        const int tl = 8 * w + rr, t = t0 + tl, row = b * PT + t;
        const float* kvq = WSP(float, WS_KVQ) + (size_t)row * NKVQ;
        float* okv = F.out + O_KVP + (size_t)row * 1024;
        const bool inwin = t >= PT - WINDOW;
        float* owin = F.out + O_WINP + ((size_t)b * 512 + (t - (PT - WINDOW))) * 512;
#pragma unroll
        for (int g = 0; g < 4; ++g) {
            const float v0 = kvq[0 * 256 + g * 64 + lane], v1 = kvq[1 * 256 + g * 64 + lane], v2 = kvq[2 * 256 + g * 64 + lane];
            const float v3 = kvq[3 * 256 + g * 64 + lane], v4 = kvq[4 * 256 + g * 64 + lane], v5 = kvq[5 * 256 + g * 64 + lane];
            const float ks = v2 * rms64(v2) * kg1, kw = v4 * rms64(v4) * kg2;
            okv[0 * 256 + g * 64 + lane] = v0; okv[1 * 256 + g * 64 + lane] = v1; okv[2 * 256 + g * 64 + lane] = ks; okv[3 * 256 + g * 64 + lane] = v3;
            if (inwin) { owin[g * 64 + lane] = kw; owin[256 + g * 64 + lane] = v5; }
            const size_t kidx = (((size_t)b * NG + g) * PT + t) * 64 + lane;
            WSP(bf16, WS_KSEL)[kidx] = (bf16)f2bf(ks); WSP(bf16, WS_KWIN)[kidx] = (bf16)f2bf(kw);
            vt[((0 * 4 + g) * 64 + lane) * 72 + tl] = (bf16)f2bf(v3); vt[((1 * 4 + g) * 64 + lane) * 72 + tl] = (bf16)f2bf(v5);
        }
        pp_q_row(F, row, kvq, qg);
    }
    __syncthreads();
    {
        const int which = F.tid >> 8, gd = F.tid & 255;
        bf16* dst = WSP(bf16, which == 0 ? WS_VSELT : WS_VWINT) + (((size_t)b * NG * 64 + gd) * PT + t0);
        const LAS bf16* src = vt + ((which * 256 + gd) * 72);
#pragma unroll
        for (int i = 0; i < 8; ++i) *(v4u*)(dst + 8 * i) = *(const LAS v4u*)(src + 8 * i);
    }
    __syncthreads();
}
__device__ __forceinline__ void pp_sample_row(Frame& F, int sr) {
    const int lane = F.lane, bs = sr >> 2, i = sr & 3, row = MP + sr;
    const float kg1 = FIN(16)[64 + lane], kg2 = FIN(16)[128 + lane], qg = FIN(22)[lane] * QSCALE;
    const float* kvq = WSP(float, WS_KVQ) + (size_t)row * NKVQ;
    float* okv = F.out + O_KVS + (size_t)sr * 1024;
    float* owin = F.out + O_WINS + ((size_t)bs * 512 + 508 + i) * 512;
#pragma unroll
    for (int g = 0; g < 4; ++g) {
        const float v0 = kvq[0 * 256 + g * 64 + lane], v1 = kvq[1 * 256 + g * 64 + lane], v2 = kvq[2 * 256 + g * 64 + lane];
        const float v3 = kvq[3 * 256 + g * 64 + lane], v4 = kvq[4 * 256 + g * 64 + lane], v5 = kvq[5 * 256 + g * 64 + lane];
        const float ks = v2 * rms64(v2) * kg1, kw = v4 * rms64(v4) * kg2;
        okv[0 * 256 + g * 64 + lane] = v0; okv[1 * 256 + g * 64 + lane] = v1; okv[2 * 256 + g * 64 + lane] = ks; okv[3 * 256 + g * 64 + lane] = v3;
        owin[g * 64 + lane] = kw; owin[256 + g * 64 + lane] = v5;
        const size_t bg = (size_t)bs * NG + g;
        WSP(bf16, WS_SKWIN)[(bg * 544 + 512 + i) * 64 + lane] = (bf16)f2bf(kw);
        WSP(bf16, WS_SVWINT)[(bg * 64 + lane) * 544 + 512 + i] = (bf16)f2bf(v5);
        float* sn = WSP(float, WS_SNEW) + (((size_t)bs * 4 + i) * 2) * 256 + g * 64 + lane;
        sn[0] = ks; sn[256] = v3;
    }
    pp_q_row(F, row, kvq, qg);
}

__device__ __forceinline__ void compress_finish(Frame& F, const f32x4 (&acc)[4], int kv, int blk, bf16* KC, bf16* VCT) {
    const int lane = F.lane, fr = lane & 15, fq = lane >> 4;
    const float* pet = WSP(float, WS_PETERM) + kv * 64;
    bf16x8 hb[2];
#pragma unroll
    for (int s = 0; s < 2; ++s) { f32x4 h0, h1;
#pragma unroll
        for (int r = 0; r < 4; ++r) { h0[r] = gelu_tanh(acc[2 * s][r] + pet[16 * (2 * s) + 4 * fq + r]); h1[r] = gelu_tanh(acc[2 * s + 1][r] + pet[16 * (2 * s + 1) + 4 * fq + r]); }
        hb[s] = cvt8(h0, h1); }
    const float* w2 = FIN(19) + (size_t)kv * 64 * 64;
    f32x4 o[4];
#pragma unroll
    for (int dt = 0; dt < 4; ++dt) { o[dt] = (f32x4){0.f, 0.f, 0.f, 0.f};
#pragma unroll
        for (int s = 0; s < 2; ++s) { f32x4 a0, a1;
#pragma unroll
            for (int jj = 0; jj < 4; ++jj) { a0[jj] = w2[(size_t)(16 * (2 * s) + 4 * fq + jj) * 64 + 16 * dt + fr]; a1[jj] = w2[(size_t)(16 * (2 * s + 1) + 4 * fq + jj) * 64 + 16 * dt + fr]; }
            o[dt] = MFMA16(cvt8(a0, a1), hb[s], o[dt]); } }
    if (kv == 0) {
        float ss = 0.f;
#pragma unroll
        for (int dt = 0; dt < 4; ++dt) ss += (o[dt][0] * o[dt][0] + o[dt][1] * o[dt][1]) + (o[dt][2] * o[dt][2] + o[dt][3] * o[dt][3]);
        ss = x32_sum(x16_sum(ss));
        const float rstd = 1.f / sqrtf(ss * (1.f / 64.f) + EPS);
        const float* kg0 = FIN(16);
        if (blk < NCMP) {
#pragma unroll
            for (int dt = 0; dt < 4; ++dt) { const int d = 16 * dt + 4 * fq; v2u ov; ov.x = pk2(o[dt][0] * rstd * kg0[d], o[dt][1] * rstd * kg0[d + 1]); ov.y = pk2(o[dt][2] * rstd * kg0[d + 2], o[dt][3] * rstd * kg0[d + 3]);
                *(v2u*)(KC + (size_t)blk * 64 + d) = ov; }
        } else {
#pragma unroll
            for (int dt = 0; dt < 4; ++dt) *(v2u*)(KC + (size_t)blk * 64 + 16 * dt + 4 * fq) = (v2u){0u, 0u};
        }
    } else {
#pragma unroll
        for (int dt = 0; dt < 4; ++dt)
#pragma unroll
            for (int r = 0; r < 4; ++r) VCT[(size_t)(16 * dt + 4 * fq + r) * 512 + blk] = (blk < NCMP) ? (bf16)f2bf(o[dt][r]) : (bf16)0;
    }
}

template <class RowP>
__device__ __forceinline__ void compress_tile(Frame& F, const RowP& rowp, int kv, int j, bf16* KC, bf16* VCT) {
    const int lane = F.lane, fr = lane & 15, fq = lane >> 4;
    const bf16* W1 = WSP(bf16, WS_W1T) + (size_t)kv * 64 * 2048 + (size_t)fr * 2048 + 8 * fq;
    const int blk = 16 * j + fr;
    f32x4 acc[4];
#pragma unroll
    for (int mt = 0; mt < 4; ++mt) acc[mt] = (f32x4){0.f, 0.f, 0.f, 0.f};
#pragma unroll 2
    for (int r = 0; r < 32; ++r) {
        int t = 16 * blk + r; t = t < PAST ? t : PAST - 1;
        const float* rp = rowp(t) + 8 * fq;
#pragma unroll
        for (int hf = 0; hf < 2; ++hf) {
            const f32x4 x0 = *(const f32x4*)(rp + 32 * hf), x1 = *(const f32x4*)(rp + 32 * hf + 4);
            const bf16x8 bfrag = cvt8(x0, x1);
            const int ks = 2 * r + hf;
#pragma unroll
            for (int mt = 0; mt < 4; ++mt) acc[mt] = MFMA16(ld8(W1 + (size_t)mt * 16 * 2048 + 32 * ks), bfrag, acc[mt]);
        }
    }
    compress_finish(F, acc, kv, blk, KC, VCT);
}
struct RowPPrompt { const float* base; __device__ __forceinline__ const float* operator()(int t) const { return base + (size_t)t * NKVQ; } };
struct RowPSample { const float* cache; const int* pt; __device__ __forceinline__ const float* operator()(int t) const { return cache + ((size_t)pt[t >> 7] * PAGE + (t & 127)) * 1024; } };

__device__ __forceinline__ void compress_prompt(Frame& F, int id) {
    const int kv = id & 1, j = (id >> 1) & 31, bg = id >> 6, b = bg >> 2, g = bg & 3;
    RowPPrompt rp{WSP(float, WS_KVQ) + (size_t)b * PT * NKVQ + kv * 256 + g * 64};
    compress_tile(F, rp, kv, j, WSP(bf16, WS_KCMP) + (size_t)bg * 512 * 64, WSP(bf16, WS_VCMPT) + (size_t)bg * 64 * 512);
}
__device__ __forceinline__ void compress_sample(Frame& F, int id) {
    const int kv = id & 1, j = (id >> 1) & 31, bg = id >> 6, lane = F.lane, fr = lane & 15, fq = lane >> 4;
    const int blk = 16 * j + fr, nb = blk < 511 ? blk + 1 : 511;
    const float* f1 = WSP(float, WS_FS) + ((size_t)bg * 512 + blk) * 256 + kv * 128 + 4 * fq;
    const float* f2 = WSP(float, WS_FS) + ((size_t)bg * 512 + nb) * 256 + kv * 128 + 64 + 4 * fq;
    f32x4 acc[4];
#pragma unroll
    for (int mt = 0; mt < 4; ++mt) acc[mt] = *(const f32x4*)(f1 + 16 * mt) + *(const f32x4*)(f2 + 16 * mt);
    compress_finish(F, acc, kv, blk, WSP(bf16, WS_SKCMP) + (size_t)bg * 512 * 64, WSP(bf16, WS_SVCMPT) + (size_t)bg * 64 * 512);
}

constexpr int NSA_IMP = 0;
constexpr int NSA_Q = 67584;
constexpr int NSA_QLD = 68;
constexpr float LOG2E = 1.4426950408889634f;
#ifndef NSA_SUBUNITS
#define NSA_SUBUNITS 0
#endif
__device__ __forceinline__ float ex2(float x) { return __builtin_amdgcn_exp2f(x); }

struct KvBf16 {
    const bf16* K; const bf16* VT; int ld;
    __device__ __forceinline__ void lane_offsets(int fr, int fq, unsigned& ko, unsigned& vo) const {
        ko = (unsigned)(((8 * (fr >> 2) + (fr & 3)) * 64 + 8 * fq) * 2); vo = (unsigned)((fr * ld + 8 * fq) * 2);
        asm volatile("" : "+v"(ko), "+v"(vo));
    }
    __device__ __forceinline__ bf16x8 kf(int key0, int mt, int ks, unsigned ko) const {
        return *(const bf16x8*)((const char*)K + (size_t)key0 * 128 + (ko + (unsigned)((4 * mt * 64 + 32 * ks) * 2))); }
    __device__ __forceinline__ bf16x8 vf(int key0, int dt, unsigned vo) const {
        return *(const bf16x8*)((const char*)VT + (size_t)key0 * 2 + (vo + (unsigned)(16 * dt * ld * 2))); }
};
struct KvSampleSel {
    const float* cache; const int* pt; const float* snew; int g;
    __device__ __forceinline__ const float* krow(int pos, int slot) const {
        if (pos < PAST) return cache + ((size_t)pt[pos >> 7] * PAGE + (pos & 127)) * 1024 + slot * 256;
        int i = pos - PAST; i = i < 3 ? i : 3; return snew + (size_t)i * 512 + (slot - 2) * 256; }
    __device__ __forceinline__ void lane_offsets(int fr, int fq, unsigned& ko, unsigned& vo) const { ko = (unsigned)(fr | (fq << 8)); vo = ko; asm volatile("" : "+v"(ko), "+v"(vo)); }
    __device__ __forceinline__ bf16x8 kf(int key0, int mt, int ks, unsigned ko) const { const int fr = ko & 255, fq = ko >> 8;
        const float* p = krow(key0 + 8 * (fr >> 2) + 4 * mt + (fr & 3), 2) + 32 * ks + 8 * fq; return cvt8(*(const f32x4*)p, *(const f32x4*)(p + 4)); }
    __device__ __forceinline__ bf16x8 vf(int key0, int dt, unsigned vo) const { const int fr = vo & 255, fq = vo >> 8; f32x4 a, b;
#pragma unroll
        for (int j = 0; j < 4; ++j) { a[j] = krow(key0 + 8 * fq + j, 3)[16 * dt + fr]; b[j] = krow(key0 + 8 * fq + 4 + j, 3)[16 * dt + fr]; }
        return cvt8(a, b); }
};
struct KvFrags { bf16x8 k[2][2]; bf16x8 v[4]; };
template <bool WITHV, class KV>
__device__ __forceinline__ void nsa_load(const KV& kv, int key0, int fr, int fq, KvFrags& f) {
    unsigned ko, vo; kv.lane_offsets(fr, fq, ko, vo);
#pragma unroll
    for (int mt = 0; mt < 2; ++mt)
#pragma unroll
        for (int ks = 0; ks < 2; ++ks) f.k[mt][ks] = kv.kf(key0, mt, ks, ko);
    if (WITHV) {
#pragma unroll
        for (int dt = 0; dt < 4; ++dt) f.v[dt] = kv.vf(key0, dt, vo);
    }
}

template <int NT, int MODE, bool QREG = false>
__device__ __forceinline__ void nsa_core(const KvFrags& f, int key0, const LAS bf16* qrow, int qnt, f32x4 (&O)[NT][4], float (&m)[NT], float (&l)[NT], const float (&invl)[NT], const float (&slope)[NT],
                                         int t, int pmul, int padd, int wlim, bool selok, LAS float* improw, int fq, const bf16x8* qreg = nullptr) {
    float dist[2][4]; bool val[2][4];
#pragma unroll
    for (int mt = 0; mt < 2; ++mt)
#pragma unroll
        for (int r = 0; r < 4; ++r) { const int kk = key0 + 8 * fq + 4 * mt + r; const int dd = t - (pmul * kk + padd); dist[mt][r] = (float)dd; val[mt][r] = selok && dd >= 0 && dd < wlim; }
    float imp_main[2] = {0.f, 0.f}, imp_spill[2] = {0.f, 0.f};
#pragma unroll
    for (int nt = 0; nt < NT; ++nt) {
        f32x4 s[2];
        bf16x8 q0, q1; if (QREG) { q0 = qreg[nt * 2]; q1 = qreg[nt * 2 + 1]; } else { q0 = ld8l(qrow + nt * qnt + 8 * fq); q1 = ld8l(qrow + nt * qnt + 32 + 8 * fq); }
#pragma unroll
        for (int mt = 0; mt < 2; ++mt) { s[mt] = (f32x4){0.f, 0.f, 0.f, 0.f}; s[mt] = MFMA16(f.k[mt][0], q0, s[mt]); s[mt] = MFMA16(f.k[mt][1], q1, s[mt]); }
        f32x4 p[2]; float ps = 0.f;
#pragma unroll
        for (int mt = 0; mt < 2; ++mt)
#pragma unroll
            for (int r = 0; r < 4; ++r) { float pv = ex2(val[mt][r] ? (s[mt][r] - slope[nt] * dist[mt][r]) : -200.f); if (MODE == 2) pv *= invl[nt]; p[mt][r] = pv; ps += pv; }
        if (MODE != 2) l[nt] += ps;
        if (MODE == 2) {
#pragma unroll
            for (int mt = 0; mt < 2; ++mt) { imp_main[mt] += (p[mt][0] + p[mt][1]) + (p[mt][2] + p[mt][3]); imp_spill[mt] += p[mt][3]; }
        }
        if (MODE != 1) {
            const bf16x8 pf = cvt8(p[0], p[1]);
#pragma unroll
            for (int dt = 0; dt < 4; ++dt) O[nt][dt] = MFMA16(f.v[dt], pf, O[nt][dt]);
        }
    }
    if (MODE == 2) {
#pragma unroll
        for (int mt = 0; mt < 2; ++mt) { const int j = key0 / 4 + 2 * fq + mt;
            __hip_atomic_fetch_add(improw + j, imp_main[mt], __ATOMIC_RELAXED, __HIP_MEMORY_SCOPE_WORKGROUP);
            __hip_atomic_fetch_add(improw + j + 1, imp_spill[mt], __ATOMIC_RELAXED, __HIP_MEMORY_SCOPE_WORKGROUP); }
    }
}
template <int NT, int MODE, class KV>
__device__ __forceinline__ void nsa_tile(const KV& kv, int key0, const LAS bf16* qrow, int qnt, f32x4 (&O)[NT][4], float (&m)[NT], float (&l)[NT], const float (&invl)[NT], const float (&slope)[NT],
                                         int t, int pmul, int padd, int wlim, bool selok, LAS float* improw, int fr, int fq) {
    KvFrags f; nsa_load<MODE != 1>(kv, key0, fr, fq, f);
    nsa_core<NT, MODE>(f, key0, qrow, qnt, O, m, l, invl, slope, t, pmul, padd, wlim, selok, improw, fq);
}

template <int NT>
__device__ __forceinline__ void nsa_zero(f32x4 (&O)[NT][4], float (&m)[NT], float (&l)[NT]) {
#pragma unroll
    for (int nt = 0; nt < NT; ++nt) { m[nt] = -1e30f; l[nt] = 0.f;
#pragma unroll
        for (int dt = 0; dt < 4; ++dt) O[nt][dt] = (f32x4){0.f, 0.f, 0.f, 0.f}; }
}

template <bool SAMPLE>
__device__ __forceinline__ void nsa_unit(Frame& F, int id) {
    constexpr int NT = SAMPLE ? 1 : 4;
    int lane_ = F.lane; asm volatile("" : "+v"(lane_));
    const int lane = lane_, fr = lane & 15, fq = lane >> 4;
    LAS unsigned char* L = F.lds; asm volatile("" : "+v"(L));
    LAS float* imp = (LAS float*)(L + NSA_IMP + F.wave * 8448);
    LAS bf16* qw = (LAS bf16*)(L + NSA_Q + F.wave * 8704);
    int bg, g, t, row, trow, tmax, row0;
    if (SAMPLE) { bg = id; g = id & 3; t = PAST + (fr >> 2); row0 = MP + (id >> 2) * 4; row = row0 + (fr >> 2); trow = fr >> 2; tmax = PAST + 3; }
    else { bg = id >> 9; g = bg & 3; const int tt = id & 511; t = 16 * tt + fr; row0 = (bg >> 2) * PT + 16 * tt; row = row0 + fr; trow = fr; tmax = 16 * tt + 15; }
    {
        const int nrow = SAMPLE ? 16 : 64;
        for (int i = lane; i < nrow * 8; i += 64) { const int rr = i >> 3, c8 = i & 7;
            *(LAS v4u*)(qw + rr * NSA_QLD + 8 * c8) = *(const v4u*)(WSP(bf16, WS_QN) + (size_t)(row0 + (rr >> 2)) * 1024 + (g * 4 + (rr & 3)) * 64 + 8 * c8); }
    }
    float slope[NT]; int hd[NT];
#pragma unroll
    for (int nt = 0; nt < NT; ++nt) { hd[nt] = g * 4 + (SAMPLE ? (fr & 3) : nt); slope[nt] = ex2(-0.5f * (float)(hd[nt] + 1)) * LOG2E; }
    const LAS bf16* qrow = qw + (SAMPLE ? fr : fr * 4) * NSA_QLD; const int qnt = SAMPLE ? 0 : NSA_QLD;
    const float* gates = WSP(float, WS_GATES) + (size_t)row * 48;
    float* oacc = WSP(float, WS_OACC) + (size_t)row * 1024;
    for (int i = lane; i < 16 * 132; i += 64) imp[i] = 0.f;
    LDS_WAIT();
    f32x4 O[NT][4]; float m[NT], l[NT], invl[NT];
    {
        KvBf16 kv{WSP(bf16, SAMPLE ? WS_SKCMP : WS_KCMP) + (size_t)bg * 512 * 64, WSP(bf16, SAMPLE ? WS_SVCMPT : WS_VCMPT) + (size_t)bg * 64 * 512, 512};
        const int cmax = (tmax - 31) >> 4;
        const int ntile = (tmax >= 31) ? ((cmax < 510 ? cmax : 510) / 32 + 1) : 0;
#pragma unroll
        for (int nt = 0; nt < NT; ++nt) invl[nt] = 0.f;
        nsa_zero<NT>(O, m, l);
        { KvFrags fa, fb; if (ntile > 0) nsa_load<false>(kv, 0, fr, fq, fa);
#pragma unroll 1
          for (int tl = 0; tl < ntile; ++tl) { if (tl + 1 < ntile) nsa_load<false>(kv, 32 * (tl + 1), fr, fq, fb);
            nsa_core<NT, 1>(fa, 32 * tl, qrow, qnt, O, m, l, invl, slope, t, 16, 31, 1 << 30, true, imp + trow * 132, fq); fa = fb; } }
#pragma unroll
        for (int nt = 0; nt < NT; ++nt) { float lt = l[nt]; lt = x32_sum(x16_sum(lt)); invl[nt] = lt > 0.f ? 1.f / lt : 0.f; }
        { KvFrags fa, fb; if (ntile > 0) nsa_load<true>(kv, 0, fr, fq, fa);
#pragma unroll 1
          for (int tl = 0; tl < ntile; ++tl) { if (tl + 1 < ntile) nsa_load<true>(kv, 32 * (tl + 1), fr, fq, fb);
            nsa_core<NT, 2>(fa, 32 * tl, qrow, qnt, O, m, l, invl, slope, t, 16, 31, 1 << 30, true, imp + trow * 132, fq); fa = fb; } }
#pragma unroll
        for (int nt = 0; nt < NT; ++nt) { const float gc = gates[0 * 16 + hd[nt]];
#pragma unroll
            for (int dt = 0; dt < 4; ++dt) *(f32x4*)(oacc + hd[nt] * 64 + 16 * dt + 4 * fq) = O[nt][dt] * gc; }
    }
    LDS_WAIT();
    unsigned selm[4] = {0u, 0u, 0u, 0u};
    {
        const int cur = t >> 6;
        if (!SAMPLE) {
            unsigned v[32];
#pragma unroll
            for (int i = 0; i < 32; ++i) { const int j = 32 * fq + i; const bool forced = (j == 0) | (j == cur) | (j == cur - 1);
                const unsigned key = ((f2u(imp[trow * 132 + j]) & ~127u) | (unsigned)(127 - j)) + 128u;
                v[i] = (!forced && j <= cur) ? key : 0u;
                if (forced) selm[fq] |= 1u << i; }
            unsigned fw = selm[0] | selm[1] | selm[2] | selm[3];
            const unsigned w16 = __shfl_xor(fw, 16), w32 = __shfl_xor(fw, 32), w48 = __shfl_xor(fw, 48);
#pragma unroll
            for (int wd = 0; wd < 4; ++wd) selm[wd] = (fq == wd) ? fw : ((fq ^ 1) == wd) ? w16 : ((fq ^ 2) == wd) ? w32 : w48;
            const int nforced = cur >= 2 ? 3 : cur + 1;
#pragma unroll 1
            for (int rd = 0; rd < 15; ++rd) {
                unsigned mx = v[0];
#pragma unroll
                for (int i = 1; i < 32; ++i) mx = mx > v[i] ? mx : v[i];
                mx = x32_umax(x16_umax(mx));
#pragma unroll
                for (int i = 0; i < 32; ++i) v[i] = (v[i] == mx) ? 0u : v[i];
                if (mx != 0u && rd < 16 - nforced) { const int js = 127 - (int)(mx & 127u);
#pragma unroll
                    for (int wd = 0; wd < 4; ++wd) selm[wd] |= ((js >> 5) == wd) ? (1u << (js & 31)) : 0u; }
            }
        } else {
            const int li = (fr & 3) * 4 + fq;
            unsigned v[8];
#pragma unroll
            for (int i = 0; i < 8; ++i) { const int j = li * 8 + i; v[i] = (j >= 1 && j <= 126) ? (((f2u(imp[trow * 132 + j]) & ~127u) | (unsigned)(127 - j)) + 128u) : 0u; }
            selm[0] = 1u; selm[3] = 1u << 31;
#pragma unroll 1
            for (int rd = 0; rd < 13; ++rd) {
                unsigned mx = v[0];
#pragma unroll
                for (int i = 1; i < 8; ++i) mx = mx > v[i] ? mx : v[i];
                { unsigned o = dpp_u<DPP_XOR1>(mx); mx = mx > o ? mx : o; o = dpp_u<DPP_XOR2>(mx); mx = mx > o ? mx : o; mx = x32_umax(x16_umax(mx)); }
#pragma unroll
                for (int i = 0; i < 8; ++i) v[i] = (v[i] == mx) ? 0u : v[i];
                if (mx != 0u) { const int js = 127 - (int)(mx & 127u);
#pragma unroll
                    for (int wd = 0; wd < 4; ++wd) selm[wd] |= ((js >> 5) == wd) ? (1u << (js & 31)) : 0u; }
            }
        }
    }
    if (SAMPLE || !NSA_SUBUNITS) {
        nsa_zero<NT>(O, m, l);
        unsigned un[4];
#pragma unroll
        for (int wd = 0; wd < 4; ++wd) { unsigned x = selm[wd]; x |= __shfl_xor(x, 1); x |= __shfl_xor(x, 2); x |= __shfl_xor(x, 4); x |= __shfl_xor(x, 8); un[wd] = (unsigned)__builtin_amdgcn_readfirstlane((int)x); }
        KvSampleSel kvs{FIN(2) + g * 64, (const int*)FIN(6) + (SAMPLE ? (id >> 2) : 0) * NPAGES, WSP(float, WS_SNEW) + (size_t)(SAMPLE ? (id >> 2) : 0) * 2048 + g * 64, g};
        KvBf16 kvp{WSP(bf16, WS_KSEL) + (size_t)bg * PT * 64, WSP(bf16, WS_VSELT) + (size_t)bg * 64 * PT, PT};
        if (SAMPLE) {
#pragma unroll 1
        for (int wd = 0; wd < 4; ++wd) {
            unsigned mm = un[wd];
            const unsigned mine = wd == 0 ? selm[0] : wd == 1 ? selm[1] : wd == 2 ? selm[2] : selm[3];
            while (mm) {
                const int bit = __builtin_ctz(mm); mm &= mm - 1u; const int j = 32 * wd + bit;
                const bool ok = (mine >> bit) & 1u;
#pragma unroll 1
                for (int hh = 0; hh < 2; ++hh) { nsa_tile<NT, 0>(kvs, 64 * j + 32 * hh, qrow, qnt, O, m, l, invl, slope, t, 1, 0, 1 << 30, ok, imp, fr, fq); __builtin_amdgcn_sched_barrier(0); }
            }
        }
        } else {
            int wdc = 0; unsigned mmc = un[0];
            while (wdc < 3 && mmc == 0u) { ++wdc; mmc = wdc == 1 ? un[1] : wdc == 2 ? un[2] : un[3]; }
            KvFrags fa, fb; int jc = -1, hc = 0;
            if (mmc) { jc = 32 * wdc + __builtin_ctz(mmc); mmc &= mmc - 1u; nsa_load<true>(kvp, 64 * jc, fr, fq, fa); }
#pragma unroll 1
            while (jc >= 0) {
                int jn = jc, hn = hc + 1;
                if (hn == 2) { hn = 0;
                    while (wdc < 3 && mmc == 0u) { ++wdc; mmc = wdc == 1 ? un[1] : wdc == 2 ? un[2] : un[3]; }
                    if (mmc) { jn = 32 * wdc + __builtin_ctz(mmc); mmc &= mmc - 1u; } else jn = -1; }
                if (jn >= 0) nsa_load<true>(kvp, 64 * jn + 32 * hn, fr, fq, fb);
                const int wj = jc >> 5, bj = jc & 31;
                const unsigned mine = wj == 0 ? selm[0] : wj == 1 ? selm[1] : wj == 2 ? selm[2] : selm[3];
                nsa_core<NT, 0>(fa, 64 * jc + 32 * hc, qrow, qnt, O, m, l, invl, slope, t, 1, 0, 1 << 30, (mine >> bj) & 1u, imp, fq);
                fa = fb; jc = jn; hc = hn;
            }
        }
        if (SAMPLE) nsa_tile<NT, 0>(kvs, 64 * 128, qrow, qnt, O, m, l, invl, slope, t, 1, 0, 1 << 30, true, imp, fr, fq);
#pragma unroll
        for (int nt = 0; nt < NT; ++nt) { float lt = l[nt]; lt = x32_sum(x16_sum(lt)); const float sc = gates[1 * 16 + hd[nt]] / fmaxf(lt, 1e-30f);
#pragma unroll
            for (int dt = 0; dt < 4; ++dt) { f32x4* o = (f32x4*)(oacc + hd[nt] * 64 + 16 * dt + 4 * fq); *o = *o + O[nt][dt] * sc; } }
    } else {
        unsigned ms[4][4];
#pragma unroll
        for (int s = 0; s < 4; ++s)
#pragma unroll
            for (int wd = 0; wd < 4; ++wd) ms[s][wd] = __shfl(selm[wd], 4 * s + (fr >> 2));
        unsigned su[4][4], un[4];
#pragma unroll
        for (int wd = 0; wd < 4; ++wd) { un[wd] = 0u;
#pragma unroll
            for (int s = 0; s < 4; ++s) { unsigned x = ms[s][wd]; x |= __shfl_xor(x, 4); x |= __shfl_xor(x, 8); su[s][wd] = (unsigned)__builtin_amdgcn_readfirstlane((int)x); un[wd] |= su[s][wd]; } }
        const int hds = g * 4 + (fr & 3); float slp[1]; slp[0] = ex2(-0.5f * (float)(hds + 1)) * LOG2E;
        const int tb = (id & 511) * 16 + (fr >> 2);
        f32x4 Os[4][1][4]; float mS[4][1], lS[4][1]; float inv1[1] = {0.f};
#pragma unroll
        for (int s = 0; s < 4; ++s) nsa_zero<1>(Os[s], mS[s], lS[s]);
        KvBf16 kvp{WSP(bf16, WS_KSEL) + (size_t)bg * PT * 64, WSP(bf16, WS_VSELT) + (size_t)bg * 64 * PT, PT};
        int wdc = 0; unsigned mmc = un[0];
        while (wdc < 3 && mmc == 0u) { ++wdc; mmc = wdc == 1 ? un[1] : wdc == 2 ? un[2] : un[3]; }
        KvFrags fa, fb;
        int jc = -1, hc = 0;
        if (mmc) { jc = 32 * wdc + __builtin_ctz(mmc); mmc &= mmc - 1u; nsa_load<true>(kvp, 64 * jc, fr, fq, fa); }
#pragma unroll 1
        while (jc >= 0) {
            int jn = jc, hn = hc + 1;
            if (hn == 2) { hn = 0;
                while (wdc < 3 && mmc == 0u) { ++wdc; mmc = wdc == 1 ? un[1] : wdc == 2 ? un[2] : un[3]; }
                if (mmc) { jn = 32 * wdc + __builtin_ctz(mmc); mmc &= mmc - 1u; } else jn = -1; }
            if (jn >= 0) nsa_load<true>(kvp, 64 * jn + 32 * hn, fr, fq, fb);
            const int wj = jc >> 5, bj = jc & 31;
#pragma unroll
            for (int s = 0; s < 4; ++s) {
                const unsigned suw = wj == 0 ? su[s][0] : wj == 1 ? su[s][1] : wj == 2 ? su[s][2] : su[s][3];
                if ((suw >> bj) & 1u) {
                    const unsigned mw = wj == 0 ? ms[s][0] : wj == 1 ? ms[s][1] : wj == 2 ? ms[s][2] : ms[s][3];
                    nsa_core<1, 0>(fa, 64 * jc + 32 * hc, qw + (16 * s + fr) * NSA_QLD, 0, Os[s], mS[s], lS[s], inv1, slp, tb + 4 * s, 1, 0, 1 << 30, (mw >> bj) & 1u, imp, fq);
                }
            }
            fa = fb; jc = jn; hc = hn;
        }
#pragma unroll
        for (int s = 0; s < 4; ++s) { float lt = lS[s][0]; lt = x32_sum(x16_sum(lt));
            const size_t rs = (size_t)(row0 + 4 * s + (fr >> 2));
            const float sc = WSP(float, WS_GATES)[rs * 48 + 16 + hds] / fmaxf(lt, 1e-30f);
#pragma unroll
            for (int dt = 0; dt < 4; ++dt) { f32x4* o = (f32x4*)(WSP(float, WS_OACC) + rs * 1024 + hds * 64 + 16 * dt + 4 * fq); *o = *o + Os[s][0][dt] * sc; } }
    }
    {
        nsa_zero<NT>(O, m, l);
        KvBf16 kv = SAMPLE ? KvBf16{WSP(bf16, WS_SKWIN) + (size_t)bg * 544 * 64, WSP(bf16, WS_SVWINT) + (size_t)bg * 64 * 544, 544}
                           : KvBf16{WSP(bf16, WS_KWIN) + (size_t)bg * PT * 64, WSP(bf16, WS_VWINT) + (size_t)bg * 64 * PT, PT};
        int k0, k1, padd;
        if (SAMPLE) { k0 = 0; k1 = 544; padd = PAST - WINDOW; }
        else { const int lo = tmax - 15 - (WINDOW - 1); k0 = (lo > 0 ? lo : 0) & ~31; k1 = tmax + 1; padd = 0; }
        { KvFrags fa, fb; nsa_load<true>(kv, k0, fr, fq, fa);
#pragma unroll 1
          for (int kk = k0; kk < k1; kk += 32) { if (kk + 32 < k1) nsa_load<true>(kv, kk + 32, fr, fq, fb);
            nsa_core<NT, 0>(fa, kk, qrow, qnt, O, m, l, invl, slope, t, 1, padd, WINDOW, true, imp, fq); fa = fb; } }
        bf16* on = WSP(bf16, WS_OG) + (size_t)row * 1024;
#pragma unroll
        for (int nt = 0; nt < NT; ++nt) { float lt = l[nt]; lt = x32_sum(x16_sum(lt)); const float sc = gates[2 * 16 + hd[nt]] / fmaxf(lt, 1e-30f);
#pragma unroll
            for (int dt = 0; dt < 4; ++dt) { const f32x4 o = *(const f32x4*)(oacc + hd[nt] * 64 + 16 * dt + 4 * fq) + O[nt][dt] * sc;
                *(v2u*)(on + hd[nt] * 64 + 16 * dt + 4 * fq) = (v2u){pk2(o[0], o[1]), pk2(o[2], o[3])}; } }
    }
}

constexpr int NW_STG = 67584;
constexpr int NW_STG_BYTES = 18432;
constexpr int NW_UN = NW_STG + 2 * NW_STG_BYTES;
struct NwStage { v4u k, v; };
__device__ __forceinline__ void nw_load(const bf16* K, const bf16* VT, int ld, int key0, int tid, NwStage& s) {
    s.k = *(const v4u*)(K + (size_t)(key0 + (tid >> 3)) * 64 + 8 * (tid & 7));
    s.v = *(const v4u*)(VT + (size_t)(tid >> 3) * ld + key0 + 8 * (tid & 7));
}
__device__ __forceinline__ void nw_store(LAS unsigned char* buf, int tid, const NwStage& s) {
    const int kk = tid >> 3, c8 = tid & 7, k32 = kk & 31;
    const int rho = 32 * (kk >> 5) + 16 * ((k32 >> 2) & 1) + 4 * (k32 >> 3) + (k32 & 3);
    *(LAS v4u*)(buf + rho * 144 + c8 * 16) = s.k;
    *(LAS v4u*)(buf + 9216 + kk * 144 + c8 * 16) = s.v;
}
template <bool WITHV>
__device__ __forceinline__ void nw_frags(const LAS unsigned char* buf, int th, int fr, int fq, KvFrags& f) {
#pragma unroll
    for (int mt = 0; mt < 2; ++mt)
#pragma unroll
        for (int ks = 0; ks < 2; ++ks) f.k[mt][ks] = *(const LAS bf16x8*)(buf + (32 * th + 16 * mt + fr) * 144 + (32 * ks + 8 * fq) * 2);
    if (WITHV) {
#pragma unroll
        for (int dt = 0; dt < 4; ++dt) f.v[dt] = *(const LAS bf16x8*)(buf + 9216 + (16 * dt + fr) * 144 + (32 * th + 8 * fq) * 2);
    }
}
#define NW_PIPE(Kp, VTp, ldv, NB, BLK, BODY) do { const int nb_ = (NB); \
        if (nb_ > 0) { NwStage st_; nw_load(Kp, VTp, ldv, BLK(0), F.tid, st_); nw_store(stg, F.tid, st_); } \
        __syncthreads(); \
        _Pragma("unroll 1") for (int ib_ = 0; ib_ < nb_; ++ib_) { \
            NwStage st_; const bool more_ = ib_ + 1 < nb_; if (more_) nw_load(Kp, VTp, ldv, BLK(ib_ + 1), F.tid, st_); \
            const LAS unsigned char* buf_ = stg + (ib_ & 1) * NW_STG_BYTES; const int key0_ = BLK(ib_); \
            BODY(buf_, key0_) \
            if (more_) nw_store(stg + ((ib_ + 1) & 1) * NW_STG_BYTES, F.tid, st_); \
            __syncthreads(); } } while (0)

__device__ __forceinline__ void nsa_wg(Frame& F, int bg, int qb) {
    int lane_ = F.lane; asm volatile("" : "+v"(lane_));
    const int lane = lane_, fr = lane & 15, fq = lane >> 4, w = F.wave, g = bg & 3;
    LAS unsigned char* L = F.lds; asm volatile("" : "+v"(L));
    LAS float* imp = (LAS float*)(L + NSA_IMP + w * 8448);
    LAS unsigned char* stg = L + NW_STG;
    LAS unsigned* wun = (LAS unsigned*)(L + NW_UN); volatile LAS unsigned char* blist = (volatile LAS unsigned char*)(L + NW_UN + 16);
    const int tt = qb * 8 + w, t = 16 * tt + fr, row0 = (bg >> 2) * PT + 16 * tt, row = row0 + fr, tw0 = 16 * tt, tw1 = tw0 + 15;
    float slope[4]; bf16x8 qreg[8];
#pragma unroll
    for (int nt = 0; nt < 4; ++nt) { slope[nt] = ex2(-0.5f * (float)(g * 4 + nt + 1)) * LOG2E;
        const bf16* qp = WSP(bf16, WS_QN) + (size_t)row * 1024 + (g * 4 + nt) * 64 + 8 * fq; qreg[2 * nt] = ld8(qp); qreg[2 * nt + 1] = ld8(qp + 32); }
    const float* gates = WSP(float, WS_GATES) + (size_t)row * 48;
    float* oacc = WSP(float, WS_OACC) + (size_t)row * 1024;
    for (int i = lane; i < 16 * 132; i += 64) imp[i] = 0.f;
    if (F.tid < 4) wun[F.tid] = 0u;
    f32x4 O[4][4]; float m[4], l[4], invl[4];
    {
        const bf16* Kc = WSP(bf16, WS_KCMP) + (size_t)bg * 512 * 64; const bf16* Vc = WSP(bf16, WS_VCMPT) + (size_t)bg * 64 * 512;
        const int cmax = (128 * qb + 127 - 31) >> 4, ncb = (cmax < 510 ? cmax : 510) / 64 + 1;
#pragma unroll
        for (int nt = 0; nt < 4; ++nt) invl[nt] = 0.f;
        nsa_zero<4>(O, m, l);
#define NW_BLK(i) (64 * (i))
#define NW_CMP1(buf, k0) { _Pragma("unroll 1") for (int th = 0; th < 2; ++th) if (16 * ((k0) + 32 * th) + 31 <= tw1) { KvFrags f; nw_frags<false>(buf, th, fr, fq, f); \
            nsa_core<4, 1, true>(f, (k0) + 32 * th, nullptr, 0, O, m, l, invl, slope, t, 16, 31, 1 << 30, true, imp + fr * 132, fq, qreg); } }
        NW_PIPE(Kc, Vc, 512, ncb, NW_BLK, NW_CMP1);
#pragma unroll
        for (int nt = 0; nt < 4; ++nt) { const float lt = x32_sum(x16_sum(l[nt])); invl[nt] = lt > 0.f ? 1.f / lt : 0.f; }
#define NW_CMP2(buf, k0) { _Pragma("unroll 1") for (int th = 0; th < 2; ++th) if (16 * ((k0) + 32 * th) + 31 <= tw1) { KvFrags f; nw_frags<true>(buf, th, fr, fq, f); \
            nsa_core<4, 2, true>(f, (k0) + 32 * th, nullptr, 0, O, m, l, invl, slope, t, 16, 31, 1 << 30, true, imp + fr * 132, fq, qreg); } }
        NW_PIPE(Kc, Vc, 512, ncb, NW_BLK, NW_CMP2);
#pragma unroll
        for (int nt = 0; nt < 4; ++nt) { const float gc = gates[0 * 16 + g * 4 + nt];
#pragma unroll
            for (int dt = 0; dt < 4; ++dt) *(f32x4*)(oacc + (g * 4 + nt) * 64 + 16 * dt + 4 * fq) = O[nt][dt] * gc; }
    }
    LDS_WAIT();
    unsigned selm[4] = {0u, 0u, 0u, 0u};
    {
        const int cur = t >> 6;
        unsigned v[32];
#pragma unroll
        for (int i = 0; i < 32; ++i) { const int j = 32 * fq + i; const bool forced = (j == 0) | (j == cur) | (j == cur - 1);
            const unsigned key = ((f2u(imp[fr * 132 + j]) & ~127u) | (unsigned)(127 - j)) + 128u;
            v[i] = (!forced && j <= cur) ? key : 0u;
            if (forced) selm[fq] |= 1u << i; }
        unsigned fw = selm[0] | selm[1] | selm[2] | selm[3];
        const unsigned w16 = __shfl_xor(fw, 16), w32 = __shfl_xor(fw, 32), w48 = __shfl_xor(fw, 48);
#pragma unroll
        for (int wd = 0; wd < 4; ++wd) selm[wd] = (fq == wd) ? fw : ((fq ^ 1) == wd) ? w16 : ((fq ^ 2) == wd) ? w32 : w48;
        const int nforced = cur >= 2 ? 3 : cur + 1;
#pragma unroll 1
        for (int rd = 0; rd < 15; ++rd) {
            unsigned mx = v[0];
#pragma unroll
            for (int i = 1; i < 32; ++i) mx = mx > v[i] ? mx : v[i];
            mx = x32_umax(x16_umax(mx));
#pragma unroll
            for (int i = 0; i < 32; ++i) v[i] = (v[i] == mx) ? 0u : v[i];
            if (mx != 0u && rd < 16 - nforced) { const int js = 127 - (int)(mx & 127u);
#pragma unroll
                for (int wd = 0; wd < 4; ++wd) selm[wd] |= ((js >> 5) == wd) ? (1u << (js & 31)) : 0u; }
        }
    }
    unsigned un[4];
#pragma unroll
    for (int wd = 0; wd < 4; ++wd) { unsigned x = selm[wd]; x |= dpp_u<DPP_XOR1>(x); x |= dpp_u<DPP_XOR2>(x); x |= dpp_u<DPP_HMIR>(x); x |= dpp_u<DPP_MIR>(x); un[wd] = (unsigned)__builtin_amdgcn_readfirstlane((int)x); }
    if (lane < 4) __hip_atomic_fetch_or(wun + lane, lane == 0 ? un[0] : lane == 1 ? un[1] : lane == 2 ? un[2] : un[3], __ATOMIC_RELAXED, __HIP_MEMORY_SCOPE_WORKGROUP);
    __syncthreads();
    unsigned wu[4];
#pragma unroll
    for (int wd = 0; wd < 4; ++wd) wu[wd] = (unsigned)__builtin_amdgcn_readfirstlane((int)wun[wd]);
    {
        nsa_zero<4>(O, m, l);
        const bf16* Ks = WSP(bf16, WS_KSEL) + (size_t)bg * PT * 64; const bf16* Vs = WSP(bf16, WS_VSELT) + (size_t)bg * 64 * PT;
        const int nsb = __builtin_popcount(wu[0]) + __builtin_popcount(wu[1]) + __builtin_popcount(wu[2]) + __builtin_popcount(wu[3]);
        if (F.tid < 128) { const int j = F.tid, wj = j >> 5, bj = j & 31; const unsigned ww = wj == 0 ? wu[0] : wj == 1 ? wu[1] : wj == 2 ? wu[2] : wu[3];
            if ((ww >> bj) & 1u) { int pos = __builtin_popcount(ww & ((1u << bj) - 1u)); if (wj > 0) pos += __builtin_popcount(wu[0]); if (wj > 1) pos += __builtin_popcount(wu[1]); if (wj > 2) pos += __builtin_popcount(wu[2]);
                blist[pos] = (unsigned char)j; } }
        __syncthreads();
#define NW_SBLK(i) (64 * (int)blist[(i)])
#define NW_SEL(buf, k0) { const int j_ = (k0) >> 6, wj_ = j_ >> 5, bj_ = j_ & 31; const unsigned uw_ = wj_ == 0 ? un[0] : wj_ == 1 ? un[1] : wj_ == 2 ? un[2] : un[3]; \
            if ((uw_ >> bj_) & 1u) { const unsigned mine_ = wj_ == 0 ? selm[0] : wj_ == 1 ? selm[1] : wj_ == 2 ? selm[2] : selm[3]; const bool ok_ = (mine_ >> bj_) & 1u; \
                _Pragma("unroll 1") for (int th = 0; th < 2; ++th) { KvFrags f; nw_frags<true>(buf, th, fr, fq, f); \
                    nsa_core<4, 0, true>(f, (k0) + 32 * th, nullptr, 0, O, m, l, invl, slope, t, 1, 0, 1 << 30, ok_, imp, fq, qreg); } } }
        NW_PIPE(Ks, Vs, PT, nsb, NW_SBLK, NW_SEL);
#pragma unroll
        for (int nt = 0; nt < 4; ++nt) { const float lt = x32_sum(x16_sum(l[nt])); const float sc = gates[1 * 16 + g * 4 + nt] / fmaxf(lt, 1e-30f);
#pragma unroll
            for (int dt = 0; dt < 4; ++dt) { f32x4* o = (f32x4*)(oacc + (g * 4 + nt) * 64 + 16 * dt + 4 * fq); *o = *o + O[nt][dt] * sc; } }
    }
    {
        nsa_zero<4>(O, m, l);
        const bf16* Kw = WSP(bf16, WS_KWIN) + (size_t)bg * PT * 64; const bf16* Vw = WSP(bf16, WS_VWINT) + (size_t)bg * 64 * PT;
        const int lo = 128 * qb - (WINDOW - 1), kb0 = (lo > 0 ? lo : 0) >> 6, kb1 = (128 * qb + 127) >> 6, nwb = kb1 - kb0 + 1;
#define NW_WBLK(i) (64 * (kb0 + (i)))
#define NW_WIN(buf, k0) { _Pragma("unroll 1") for (int th = 0; th < 2; ++th) { const int kk_ = (k0) + 32 * th; if (kk_ <= tw1 && kk_ + 31 >= tw0 - (WINDOW - 1)) { KvFrags f; nw_frags<true>(buf, th, fr, fq, f); \
                nsa_core<4, 0, true>(f, kk_, nullptr, 0, O, m, l, invl, slope, t, 1, 0, WINDOW, true, imp, fq, qreg); } } }
        NW_PIPE(Kw, Vw, PT, nwb, NW_WBLK, NW_WIN);
        bf16* on = WSP(bf16, WS_OG) + (size_t)row * 1024;
#pragma unroll
        for (int nt = 0; nt < 4; ++nt) { const float lt = x32_sum(x16_sum(l[nt])); const float sc = gates[2 * 16 + g * 4 + nt] / fmaxf(lt, 1e-30f);
#pragma unroll
            for (int dt = 0; dt < 4; ++dt) { const f32x4 o = *(const f32x4*)(oacc + (g * 4 + nt) * 64 + 16 * dt + 4 * fq) + O[nt][dt] * sc;
                *(v2u*)(on + (g * 4 + nt) * 64 + 16 * dt + 4 * fq) = (v2u){pk2(o[0], o[1]), pk2(o[2], o[3])}; } }
    }
    __syncthreads();
}

constexpr int SW_Q = 0;
constexpr int SW_IMPP = 2304;
constexpr int SW_IMPT = SW_IMPP + 8 * 2112;
constexpr int SW_LP = SW_IMPT + 2112;
constexpr int SW_OP = SW_LP + 3 * 8 * 16 * 4;
static_assert(SW_OP + 8 * 3 * 16 * 64 * 4 <= RING_BYTES, "sample NSA LDS map");
__device__ __forceinline__ void nsa_sample_wg(Frame& F, int id) {
    int lane_ = F.lane; asm volatile("" : "+v"(lane_));
    const int lane = lane_, fr = lane & 15, fq = lane >> 4, w = F.wave, g = id & 3, bs = id >> 2;
    LAS unsigned char* L = F.lds; asm volatile("" : "+v"(L));
    LAS bf16* qw = (LAS bf16*)(L + SW_Q);
    LAS float* impP = (LAS float*)(L + SW_IMPP) + w * 528; LAS float* impT = (LAS float*)(L + SW_IMPT);
    LAS float* LP = (LAS float*)(L + SW_LP); LAS float* OP = (LAS float*)(L + SW_OP);
    const int t = PAST + (fr >> 2), row0 = MP + bs * 4, trow = fr >> 2, hd = g * 4 + (fr & 3);
    if (F.tid < 128) { const int rr = F.tid >> 3, c8 = F.tid & 7;
        *(LAS v4u*)(qw + rr * NSA_QLD + 8 * c8) = *(const v4u*)(WSP(bf16, WS_QN) + (size_t)(row0 + (rr >> 2)) * 1024 + (g * 4 + (rr & 3)) * 64 + 8 * c8); }
    for (int i = lane; i < 528; i += 64) impP[i] = 0.f;
    __syncthreads();
    float slope[1] = {ex2(-0.5f * (float)(hd + 1)) * LOG2E};
    const LAS bf16* qrow = qw + fr * NSA_QLD;
    f32x4 O[1][4]; float m[1], l[1], invl[1] = {0.f};
#define SW_PUT_O(br) { _Pragma("unroll") for (int dt = 0; dt < 4; ++dt) *(LAS f32x4*)(OP + ((w * 3 + (br)) * 16 + fr) * 64 + 16 * dt + 4 * fq) = O[0][dt]; }
#define SW_PUT_L(br) { const float lt_ = x32_sum(x16_sum(l[0])); if (fq == 0) LP[((br) * 8 + w) * 16 + fr] = lt_; }
    {
        KvBf16 kv{WSP(bf16, WS_SKCMP) + (size_t)id * 512 * 64, WSP(bf16, WS_SVCMPT) + (size_t)id * 64 * 512, 512};
        nsa_zero<1>(O, m, l);
#pragma unroll 1
        for (int tl = w; tl < 16; tl += 8) nsa_tile<1, 1>(kv, 32 * tl, qrow, 0, O, m, l, invl, slope, t, 16, 31, 1 << 30, true, impP + trow * 132, fr, fq);
        SW_PUT_L(0)
        __syncthreads();
        { float lt = 0.f;
#pragma unroll
          for (int ww = 0; ww < 8; ++ww) lt += LP[(0 * 8 + ww) * 16 + fr];
          invl[0] = lt > 0.f ? 1.f / lt : 0.f; }
#pragma unroll 1
        for (int tl = w; tl < 16; tl += 8) nsa_tile<1, 2>(kv, 32 * tl, qrow, 0, O, m, l, invl, slope, t, 16, 31, 1 << 30, true, impP + trow * 132, fr, fq);
        SW_PUT_O(0)
    }
    __syncthreads();
    for (int i = F.tid; i < 528; i += 512) { float s = 0.f;
#pragma unroll
        for (int ww = 0; ww < 8; ++ww) s += ((LAS float*)(L + SW_IMPP))[ww * 528 + i];
        impT[i] = s; }
    __syncthreads();
    unsigned selm[4] = {1u, 0u, 0u, 1u << 31};
    {
        const int li = (fr & 3) * 4 + fq;
        unsigned v[8];
#pragma unroll
        for (int i = 0; i < 8; ++i) { const int j = li * 8 + i; v[i] = (j >= 1 && j <= 126) ? (((f2u(impT[trow * 132 + j]) & ~127u) | (unsigned)(127 - j)) + 128u) : 0u; }
#pragma unroll 1
        for (int rd = 0; rd < 13; ++rd) {
            unsigned mx = v[0];
#pragma unroll
            for (int i = 1; i < 8; ++i) mx = mx > v[i] ? mx : v[i];
            { unsigned o = dpp_u<DPP_XOR1>(mx); mx = mx > o ? mx : o; o = dpp_u<DPP_XOR2>(mx); mx = mx > o ? mx : o; mx = x32_umax(x16_umax(mx)); }
#pragma unroll
            for (int i = 0; i < 8; ++i) v[i] = (v[i] == mx) ? 0u : v[i];
            if (mx != 0u) { const int js = 127 - (int)(mx & 127u);
#pragma unroll
                for (int wd = 0; wd < 4; ++wd) selm[wd] |= ((js >> 5) == wd) ? (1u << (js & 31)) : 0u; }
        }
    }
    {
        nsa_zero<1>(O, m, l);
        unsigned un[4];
#pragma unroll
        for (int wd = 0; wd < 4; ++wd) { unsigned x = selm[wd]; x |= dpp_u<DPP_XOR1>(x); x |= dpp_u<DPP_XOR2>(x); x |= dpp_u<DPP_HMIR>(x); x |= dpp_u<DPP_MIR>(x); un[wd] = (unsigned)__builtin_amdgcn_readfirstlane((int)x); }
        KvSampleSel kvs{FIN(2) + g * 64, (const int*)FIN(6) + bs * NPAGES, WSP(float, WS_SNEW) + (size_t)bs * 2048 + g * 64, g};
        int q = 0;
#pragma unroll 1
        for (int wd = 0; wd < 4; ++wd) {
            unsigned mm = un[wd];
            const unsigned mine = wd == 0 ? selm[0] : wd == 1 ? selm[1] : wd == 2 ? selm[2] : selm[3];
            while (mm) {
                const int bit = __builtin_ctz(mm); mm &= mm - 1u; const int j = 32 * wd + bit;
                const bool ok = (mine >> bit) & 1u;
#pragma unroll 1
                for (int hh = 0; hh < 2; ++hh, ++q) if ((q & 7) == w) { nsa_tile<1, 0>(kvs, 64 * j + 32 * hh, qrow, 0, O, m, l, invl, slope, t, 1, 0, 1 << 30, ok, impP, fr, fq); __builtin_amdgcn_sched_barrier(0); }
            }
        }
        if ((q & 7) == w) nsa_tile<1, 0>(kvs, 64 * 128, qrow, 0, O, m, l, invl, slope, t, 1, 0, 1 << 30, true, impP, fr, fq);
        SW_PUT_O(1) SW_PUT_L(1)
    }
    {
        nsa_zero<1>(O, m, l);
        KvBf16 kv{WSP(bf16, WS_SKWIN) + (size_t)id * 544 * 64, WSP(bf16, WS_SVWINT) + (size_t)id * 64 * 544, 544};
#pragma unroll 1
        for (int kk = 32 * w; kk < 544; kk += 256) nsa_tile<1, 0>(kv, kk, qrow, 0, O, m, l, invl, slope, t, 1, PAST - WINDOW, WINDOW, true, impP, fr, fq);
        SW_PUT_O(2) SW_PUT_L(2)
    }
    __syncthreads();
    {
        const int r = F.tid >> 5, d0 = (F.tid & 31) * 2, rowg = row0 + (r >> 2), hdr = g * 4 + (r & 3);
        float o0 = 0.f, o1 = 0.f;
#pragma unroll
        for (int br = 0; br < 3; ++br) { float a0 = 0.f, a1 = 0.f, lt = 0.f;
#pragma unroll
            for (int ww = 0; ww < 8; ++ww) { const f32x2 x = *(const LAS f32x2*)(OP + ((ww * 3 + br) * 16 + r) * 64 + d0); a0 += x.x; a1 += x.y; if (br > 0) lt += LP[(br * 8 + ww) * 16 + r]; }
            const float sc = WSP(float, WS_GATES)[(size_t)rowg * 48 + br * 16 + hdr] * (br == 0 ? 1.f : 1.f / fmaxf(lt, 1e-30f));
            o0 += a0 * sc; o1 += a1 * sc; }
        *(unsigned*)(WSP(bf16, WS_OG) + (size_t)rowg * 1024 + hdr * 64 + d0) = pk2(o0, o1);
    }
    __syncthreads();
#undef SW_PUT_O
#undef SW_PUT_L
}


#ifndef MK_SINGLE
#define MK_SINGLE 1
#endif
constexpr int NPHASE = 21;
struct Args { const float* in[29]; float* out; unsigned char* ws; int ph_lo, ph_hi; };
static_assert(sizeof(Args) == 31 * 8 + 8, "Args has no padding");

__global__ void __launch_bounds__(512, 2) mk_fwd(Args args) {
    extern __shared__ __attribute__((aligned(16))) unsigned char lds_raw[];
    Frame F;
    F.lds = (LAS unsigned char*)lds_raw;
    F.tid = threadIdx.x; F.lane = F.tid & 63; F.wave = __builtin_amdgcn_readfirstlane(F.tid >> 6);
    F.G = gridDim.x; F.bid = blockIdx.x;
    F.ka = (const __attribute__((address_space(4))) char*)__builtin_amdgcn_kernarg_segment_ptr();
    F.out = args.out; F.ws = args.ws;
    volatile LAS unsigned* MISC = (volatile LAS unsigned*)(F.lds + MISC_OFF);
    for (int u = F.tid; u < (LDS_BYTES - LDSCTL_OFF) / 4; u += 512) ((LAS unsigned*)(F.lds + LDSCTL_OFF))[u] = 0u;
    __syncthreads();
    unsigned* barw = (unsigned*)(F.ws + WS_CTL) + 4096;
    XcdBarrier bar; bar.bar = barw; bar.x = 0; bar.st = nullptr;
    const int lo = args.ph_lo, hi = args.ph_hi;
    if (hi - lo > 1) bar = xcd_barrier_post(barw, MISC + 8);
#ifndef PH_MASK
#define PH_MASK 0xFFFFFFFFu
#endif
#define IN(k) (((PH_MASK >> (k)) & 1u) && lo <= (k) && (k) < hi)
#define SEAM(k) do { if (IN(k) && IN((k) + 1)) xcd_barrier(bar); } while (0)
    const int gw = F.bid * 8 + F.wave, NGW = F.G * 8;

#ifndef REPX
#define REPX 0
#endif
#ifndef REPY
#define REPY 0
#endif
#ifndef REP_MASK
#define REP_MASK 0u
#endif
#define PHASE(k, ...) if (IN(k)) { _Pragma("unroll 1") for (int rep_ = 0; rep_ < (int)((REP_MASK >> (k)) & 1u) + 1; ++rep_) { if (rep_) xcd_barrier(bar); __VA_ARGS__ } } SEAM(k);
    PHASE(0, p0_prologue(F);)
    PHASE(1, { pg8::Gemm g{WSP(bf16, WS_CKA), WSP(bf16, WS_W1BD), 65536, 256, 2048}; pg8::StaticOrder S; S.init(65536, 256, F.G, F.bid);
               pg8::EpiFn<FnF32> E{FnF32{WSP(float, WS_FS), 256}}; pg8::gemm_phase<pg8::EpiFn<FnF32>, pg8::StaticOrder, true, true>(F.lds, g, S, E); })
    PHASE(2, gemm_all(F, WSP(bf16, WS_XNA), WSP(bf16, WS_WIN_T), 4096, FnBf16{WSP(bf16, WS_PROJ), 4096});)
    PHASE(3, for (int u = F.bid; u < 2048 + 256; u += F.G) { if (u < 2048) p2_chunk(F, u); else p2_sample(F, u - 2048); })
    PHASE(4, if (F.G == 256) { const int x = F.bid & 7, idx = F.bid >> 3; if (idx < 16) p3_scan(F, x * 2 + (idx >> 3), idx & 7);
                 else peer_tables_to_fp8(F, (size_t)(((idx - 16) * 8 + x) * 512 + F.tid), (size_t)128 * 512); }
             else { for (int u = F.bid; u < 128; u += F.G) p3_scan(F, u >> 3, u & 7); })
    PHASE(5, for (int r = gw; r < MTOK; r += NGW) p4_row(F, r);
             for (int id = gw; id < 8192; id += NGW) compress_sample(F, id);)
    PHASE(6, gemm_all(F, WSP(bf16, WS_OG), WSP(bf16, WS_WOA_T), 1024, FnResid{WSP(float, WS_XS), FIN(0), FIN(1)});)
    PHASE(7, for (int r = gw; r < MTOK; r += NGW) rms_row_to_bf16(WSP(float, WS_XS) + (size_t)r * DM, WSP(bf16, WS_XNB) + (size_t)r * DM, F.lane);)
    PHASE(8, gemm_all(F, WSP(bf16, WS_XNB), WSP(bf16, WS_WPQ_T), 2048, FnBf16{WSP(bf16, WS_QPEER), 2048});)
    PHASE(9, p8_phase(F, 0);)
    int pg_slice = F.bid & 7, pg_first = (F.bid >> 3) * 8 + F.wave, pg_stride = ((F.G - (F.bid & 7) + 7) >> 3) * 8;
#define PEER_GROUPS() do { if (MISC[8 + 3] != 0u && (F.G & 7) == 0) { const unsigned c_ = xb_ld(&barw[XB_XCNT(F.lane & 15)]); const bool ok_ = (F.lane & 15) < 8 ? c_ == (unsigned)(F.G >> 3) : c_ == 0u; \
        if (__builtin_amdgcn_ballot_w64(ok_) == ~0ull && bar.x < 8u) { pg_slice = (int)bar.x; pg_first = (int)MISC[8 + 2] * 8 + F.wave; pg_stride = F.G; } } } while (0)
    PHASE(10, PEER_GROUPS(); p9u_wave(F, 0, pg_slice, pg_first, pg_stride);)
    PHASE(11, PEER_GROUPS(); p9v_wave(F, 0, pg_slice, pg_first, pg_stride, 0);)
    PHASE(12, gemm_all(F, WSP(bf16, WS_XNA), WSP(bf16, WS_WKVQ_T), NKVQ, FnKvq{WSP(float, WS_KVQ), WSP(float, WS_SSQ)});)
    PHASE(13, for (int u = F.bid; u < 256; u += F.G) pp_prompt_tile(F, u);
              if (F.G == 256) { if (F.wave == 7 && F.bid < MS) pp_sample_row(F, F.bid); if ((F.wave & 3) == 0) compress_prompt(F, F.bid * 2 + (F.wave >> 2)); }
              else { for (int r = gw; r < MS; r += NGW) pp_sample_row(F, r); for (int id = gw; id < 512; id += NGW) compress_prompt(F, id); })
    PHASE(14, if (F.G == 256) {
                  _Pragma("unroll 1") for (int q_ = 0; q_ < 1 + REPX; ++q_) { if (F.bid < 128) nsa_sample_wg(F, F.bid); }
                  __syncthreads();
                  nsa_wg(F, F.bid & 7, F.bid >> 3); nsa_wg(F, F.bid & 7, 63 - (F.bid >> 3));
              } else { for (int id = gw; id < 128 + 4096; id += NGW) { if (id < 128) nsa_unit<true>(F, id); else nsa_unit<false>(F, id - 128); } })
    PHASE(15, gemm_all(F, WSP(bf16, WS_OG), WSP(bf16, WS_WOB_T), 1024, FnResid{WSP(float, WS_XS), WSP(float, WS_XS), WSP(float, WS_XS) + (size_t)MP * DM});)
    PHASE(16, for (int r = gw; r < MTOK; r += NGW) rms_row_to_bf16(WSP(float, WS_XS) + (size_t)r * DM, WSP(bf16, WS_XNB) + (size_t)r * DM, F.lane);)
    PHASE(17, gemm_all(F, WSP(bf16, WS_XNB), WSP(bf16, WS_WPQ_T) + (size_t)2048 * 1024, 2048, FnBf16{WSP(bf16, WS_QPEER), 2048});)
    PHASE(18, p8_phase(F, 1);)
    PHASE(19, PEER_GROUPS(); p9u_wave(F, 1, pg_slice, pg_first, pg_stride);)
    PHASE(20, PEER_GROUPS(); p9v_wave(F, 1, pg_slice, pg_first, pg_stride, 1);)
#undef IN
#undef SEAM
}

extern "C" void kernel_launch(void* const* d_in, const int* in_sizes, int n_in, void* d_out, int out_size, void* d_ws, size_t ws_size, hipStream_t stream) {
    static int grid = 0;
    if (grid == 0) {
        if (n_in != 29 || (size_t)out_size != O_END || ws_size < WS_END) { fprintf(stderr, "kernel_launch: unexpected shapes n_in %d out %d ws %zu (need %zu)\n", n_in, out_size, ws_size, (size_t)WS_END); grid = -1; return; }
        int dev = 0, cus = 0, per_cu = 0;
        if (hipGetDevice(&dev) != hipSuccess || hipDeviceGetAttribute(&cus, hipDeviceAttributeMultiprocessorCount, dev) != hipSuccess) { grid = -1; return; }
        if (hipFuncSetAttribute((const void*)mk_fwd, hipFuncAttributeMaxDynamicSharedMemorySize, LDS_BYTES) != hipSuccess) { fprintf(stderr, "kernel_launch: hipFuncSetAttribute failed\n"); grid = -1; return; }
        if (hipOccupancyMaxActiveBlocksPerMultiprocessor(&per_cu, (const void*)mk_fwd, 512, LDS_BYTES) != hipSuccess || per_cu < 1) fprintf(stderr, "kernel_launch: occupancy query reports %d\n", per_cu);
        (void)hipGetLastError();
        grid = cus;
    }
    if (grid < 0) return;
    if (hipMemsetAsync((char*)d_ws + WS_CTL, 0, CTL_BYTES, stream) != hipSuccess) return;
    Args a{};
    for (int i = 0; i < 29; ++i) a.in[i] = (const float*)d_in[i];
    a.out = (float*)d_out; a.ws = (unsigned char*)d_ws;
#if MK_SINGLE
    a.ph_lo = 0; a.ph_hi = NPHASE;
    hipLaunchKernelGGL(mk_fwd, dim3(grid), dim3(512), LDS_BYTES, stream, a);
#else
    for (int p = 0; p < NPHASE; ++p) { a.ph_lo = p; a.ph_hi = p + 1; hipLaunchKernelGGL(mk_fwd, dim3(grid), dim3(512), LDS_BYTES, stream, a); }
#endif
    const hipError_t le = hipPeekAtLastError();
    if (le != hipSuccess) fprintf(stderr, "kernel_launch: launch failed: %s\n", hipGetErrorName(le));
}
```

```cpp
#include <hip/hip_runtime.h>
#include <cstdio>
#include <cstdint>

constexpr int DM = 1024, PB = 2, PT = 8192, SB = 32, SL = 4, PAST = 8192, PAGE = 128;
constexpr int MP = PB * PT;
constexpr int MS = SB * SL;
constexpr int MTOK = MP + MS;
constexpr int GH = 8, GDK = 128, GDV = 128, GCONV = 3072, GPROJ = 4112, CHUNK = 64, NCH = PT / CHUNK;
constexpr int NH = 16, NG = 4, HPG = 4, DH = 64, NQG = 1072, NKV = 1536, NKVQ = 2816, NKVQ_REAL = 2608;
constexpr int WINDOW = 512, NSELP = 128, NSELS = 129, NCMP = 511;
constexpr int PEH = 8, PEDQ = 256, PEHALF = 128, NKEYS = 128, NEXP = 16384, PETOP = 16;
constexpr int NPAGES = PAST / PAGE;
constexpr float EPS = 1e-6f;

constexpr size_t O_YP = 0;
constexpr size_t O_YS = O_YP + (size_t)MP * DM;
constexpr size_t O_KVP = O_YS + (size_t)MS * DM;
constexpr size_t O_WINP = O_KVP + (size_t)MP * 1024;
constexpr size_t O_GDNP = O_WINP + (size_t)PB * 512 * 512;
constexpr size_t O_CONVP = O_GDNP + (size_t)PB * GH * 128 * 128;
constexpr size_t O_KVS = O_CONVP + (size_t)PB * 3 * GCONV;
constexpr size_t O_WINS = O_KVS + (size_t)MS * 1024;
constexpr size_t O_GDNS = O_WINS + (size_t)SB * 512 * 512;
constexpr size_t O_CONVS = O_GDNS + (size_t)SB * GH * 128 * 128;
constexpr size_t O_END = O_CONVS + (size_t)SB * 3 * GCONV;

constexpr size_t MiB = 1u << 20;
constexpr size_t al(size_t x) { return (x + 4095) & ~(size_t)4095; }
constexpr size_t WS_CTL = 0, CTL_BYTES = 1 * MiB;
constexpr size_t WS_WIN_T = WS_CTL + CTL_BYTES;
constexpr size_t WS_WOA_T = WS_WIN_T + (size_t)4096 * 1024 * 2;
constexpr size_t WS_WKVQ_T = WS_WOA_T + (size_t)1024 * 1024 * 2;
constexpr size_t WS_WOB_T = WS_WKVQ_T + (size_t)NKVQ * 1024 * 2;
constexpr size_t WS_WPQ_T = WS_WOB_T + (size_t)1024 * 1024 * 2;
constexpr size_t WS_WAB = WS_WPQ_T + (size_t)2 * 2048 * 1024 * 2;
constexpr size_t WS_SUBK = WS_WAB + (size_t)16 * 1024 * 4;
constexpr size_t WS_W1T = WS_SUBK + (size_t)2 * 8 * 2 * 128 * 128 * 2;
constexpr size_t WS_PETERM = WS_W1T + (size_t)2 * 128 * 1024 * 2;
constexpr size_t WS_PU = al(WS_PETERM + 512);
constexpr size_t WS_PV = WS_PU + (size_t)2 * NEXP * DM * 2;
constexpr size_t WS_XNA = WS_PV + (size_t)2 * NEXP * DM * 2;
constexpr size_t WS_XNB = al(WS_XNA + (size_t)MTOK * DM * 2);
constexpr size_t WS_PROJ = al(WS_XNB + (size_t)MTOK * DM * 2);
constexpr size_t WS_GW = al(WS_PROJ + (size_t)MTOK * 4096 * 2);
constexpr size_t WS_GQ = WS_GW + (size_t)2048 * 64 * 128 * 2;
constexpr size_t WS_GKT = WS_GQ + (size_t)2048 * 64 * 128 * 2;
constexpr size_t WS_GQK = WS_GKT + (size_t)2048 * 64 * 128 * 2;
constexpr size_t WS_GU = WS_GQK + (size_t)2048 * 64 * 64 * 2;
constexpr size_t WS_GDEC = WS_GU + (size_t)2048 * 64 * 128 * 4;
constexpr size_t WS_OGDN = al(WS_GDEC + 2048 * 4);
constexpr size_t WS_OG = al(WS_OGDN + (size_t)MTOK * DM * 4);
constexpr size_t WS_XS = al(WS_OG + (size_t)MTOK * DM * 2);
constexpr size_t WS_QPEER = al(WS_XS + (size_t)MTOK * DM * 4);
constexpr size_t WS_PEI = al(WS_QPEER + (size_t)MTOK * 2048 * 2);
constexpr size_t WS_PEG = al(WS_PEI + (size_t)MTOK * 128 * 4);
constexpr size_t WS_KVQ = al(WS_PEG + (size_t)MTOK * 128 * 4);
constexpr size_t WS_KSEL = al(WS_KVQ + (size_t)MTOK * NKVQ * 4);
constexpr size_t WS_VSELT = WS_KSEL + (size_t)PB * NG * PT * 64 * 2;
constexpr size_t WS_KWIN = WS_VSELT + (size_t)PB * NG * PT * 64 * 2;
constexpr size_t WS_VWINT = WS_KWIN + (size_t)PB * NG * PT * 64 * 2;
constexpr size_t WS_KCMP = WS_VWINT + (size_t)PB * NG * PT * 64 * 2;
constexpr size_t WS_VCMPT = WS_KCMP + (size_t)PB * NG * 512 * 64 * 2;
constexpr size_t WS_SKCMP = WS_VCMPT + (size_t)PB * NG * 512 * 64 * 2;
constexpr size_t WS_SVCMPT = WS_SKCMP + (size_t)SB * NG * 512 * 64 * 2;
constexpr size_t WS_SKWIN = WS_SVCMPT + (size_t)SB * NG * 512 * 64 * 2;
constexpr size_t WS_SVWINT = WS_SKWIN + (size_t)SB * NG * 544 * 64 * 2;
constexpr size_t WS_SNEW = WS_SVWINT + (size_t)SB * NG * 544 * 64 * 2;
constexpr size_t WS_QN = al(WS_SNEW + (size_t)SB * 4 * 2 * 4 * 64 * 4);
constexpr size_t WS_GATES = al(WS_QN + (size_t)MTOK * 1024 * 2);
constexpr size_t WS_OACC = al(WS_GATES + (size_t)MTOK * 48 * 4);
constexpr size_t WS_CKA = al(WS_OACC + (size_t)MTOK * DM * 4);
constexpr size_t WS_W1BD = al(WS_CKA + (size_t)65536 * 2048 * 2);
constexpr size_t WS_FS = al(WS_W1BD + (size_t)256 * 2048 * 2);
constexpr size_t WS_PA = al(WS_FS + (size_t)65536 * 256 * 4);
constexpr size_t WS_SSQ = al(WS_PA + (size_t)MTOK * 8 * 64 * 4);
constexpr size_t WS_END = al(WS_SSQ + (size_t)MTOK * 8 * 4);

constexpr int RING_BYTES = 143360;
constexpr int LDSCTL_OFF = RING_BYTES, MISC_OFF = LDSCTL_OFF + 320;
constexpr int LDS_BYTES = 147456;

#define GAS __attribute__((address_space(1)))
#define LAS __attribute__((address_space(3)))
typedef unsigned short bf16;
typedef unsigned v4u __attribute__((ext_vector_type(4)));
typedef unsigned v2u __attribute__((ext_vector_type(2)));
typedef float f32x4 __attribute__((ext_vector_type(4)));
typedef float f32x2 __attribute__((ext_vector_type(2)));
typedef short bf16x8 __attribute__((ext_vector_type(8)));
typedef GAS unsigned gu32;
#define RLX_AGENT __ATOMIC_RELAXED, __HIP_MEMORY_SCOPE_AGENT
#define LDS_WAIT() asm volatile("s_waitcnt lgkmcnt(0)" ::: "memory")
#define VM_WAIT() asm volatile("s_waitcnt vmcnt(0)" ::: "memory")

__device__ __forceinline__ unsigned f2bf(float f) { unsigned u = __builtin_bit_cast(unsigned, f); return (u + 0x7fffu + ((u >> 16) & 1u)) >> 16; }
typedef __bf16 hwbf16x2 __attribute__((ext_vector_type(2)));
__device__ __forceinline__ unsigned pk2(float lo, float hi) { const f32x2 v = {lo, hi}; return __builtin_bit_cast(unsigned, __builtin_convertvector(v, hwbf16x2)); }
__device__ __forceinline__ float bf2f(unsigned b) { return __builtin_bit_cast(float, b << 16); }
__device__ __forceinline__ float bflo(unsigned w) { return __builtin_bit_cast(float, w << 16); }
__device__ __forceinline__ float bfhi(unsigned w) { return __builtin_bit_cast(float, w & 0xffff0000u); }
#ifndef USE_PERMSWAP
#define USE_PERMSWAP 1
#endif
template <int CTRL> __device__ __forceinline__ float dpp_f(float x) { return __builtin_bit_cast(float, __builtin_amdgcn_update_dpp(0, __builtin_bit_cast(int, x), CTRL, 0xF, 0xF, true)); }
template <int CTRL> __device__ __forceinline__ unsigned dpp_u(unsigned x) { return (unsigned)__builtin_amdgcn_update_dpp(0, (int)x, CTRL, 0xF, 0xF, true); }
#define DPP_XOR1 0xB1
#define DPP_XOR2 0x4E
#define DPP_HMIR 0x141
#define DPP_MIR 0x140
#define DPP_ROR4 0x124
#define DPP_ROR8 0x128
#if USE_PERMSWAP
#define PSWAP16(a, b) asm volatile("s_nop 1\n\tv_permlane16_swap_b32 %0, %1" : "+v"(a), "+v"(b))
#define PSWAP32(a, b) asm volatile("s_nop 1\n\tv_permlane32_swap_b32 %0, %1" : "+v"(a), "+v"(b))
__device__ __forceinline__ float x16_sum(float x) { unsigned a = __builtin_bit_cast(unsigned, x), b = a; PSWAP16(a, b); return __builtin_bit_cast(float, a) + __builtin_bit_cast(float, b); }
__device__ __forceinline__ float x32_sum(float x) { unsigned a = __builtin_bit_cast(unsigned, x), b = a; PSWAP32(a, b); return __builtin_bit_cast(float, a) + __builtin_bit_cast(float, b); }
__device__ __forceinline__ float x16_max(float x) { unsigned a = __builtin_bit_cast(unsigned, x), b = a; PSWAP16(a, b); return fmaxf(__builtin_bit_cast(float, a), __builtin_bit_cast(float, b)); }
__device__ __forceinline__ float x32_max(float x) { unsigned a = __builtin_bit_cast(unsigned, x), b = a; PSWAP32(a, b); return fmaxf(__builtin_bit_cast(float, a), __builtin_bit_cast(float, b)); }
__device__ __forceinline__ unsigned x16_umax(unsigned u) { unsigned a = u, b = u; PSWAP16(a, b); return a > b ? a : b; }
__device__ __forceinline__ unsigned x32_umax(unsigned u) { unsigned a = u, b = u; PSWAP32(a, b); return a > b ? a : b; }
#else
__device__ __forceinline__ float x16_sum(float x) { return x + __shfl_xor(x, 16); }
__device__ __forceinline__ float x32_sum(float x) { return x + __shfl_xor(x, 32); }
__device__ __forceinline__ float x16_max(float x) { return fmaxf(x, __shfl_xor(x, 16)); }
__device__ __forceinline__ float x32_max(float x) { return fmaxf(x, __shfl_xor(x, 32)); }
__device__ __forceinline__ unsigned x16_umax(unsigned u) { const unsigned o = __shfl_xor(u, 16); return u > o ? u : o; }
__device__ __forceinline__ unsigned x32_umax(unsigned u) { const unsigned o = __shfl_xor(u, 32); return u > o ? u : o; }
#endif
__device__ __forceinline__ float row_sum16(float x) { x += dpp_f<DPP_XOR1>(x); x += dpp_f<DPP_XOR2>(x); x += dpp_f<DPP_HMIR>(x); x += dpp_f<DPP_MIR>(x); return x; }
__device__ __forceinline__ float wave_sum(float v) { return x32_sum(x16_sum(row_sum16(v))); }
__device__ __forceinline__ float silu_f(float x) { return x / (1.f + __expf(-x)); }
__device__ __forceinline__ float sigmoid_f(float x) { return 1.f / (1.f + __expf(-x)); }
__device__ __forceinline__ float gelu_tanh(float x) {
    const float u = 0.7978845608028654f * (x + 0.044715f * x * x * x);
    const float e = __expf(2.f * u);
    const float th = 1.f - 2.f / (e + 1.f);
    return 0.5f * x * (1.f + th);
}
__device__ __forceinline__ bf16x8 ld8(const bf16* p) { return *(const bf16x8*)p; }
__device__ __forceinline__ bf16x8 ld8l(const LAS bf16* p) { return *(const LAS bf16x8*)p; }
#define MFMA16(a, b, c) __builtin_amdgcn_mfma_f32_16x16x32_bf16((a), (b), (c), 0, 0, 0)
__device__ __forceinline__ bf16x8 cvt8(f32x4 a, f32x4 b) {
    v4u r; r.x = pk2(a.x, a.y); r.y = pk2(a.z, a.w); r.z = pk2(b.x, b.y); r.w = pk2(b.z, b.w); return __builtin_bit_cast(bf16x8, r);
}

struct Frame {
    LAS unsigned char* lds;
    int tid, lane, wave, G, bid;
    const __attribute__((address_space(4))) char* ka;
    float* out;
    unsigned char* ws;
};
#define WSP(T, off) ((T*)(F.ws + (off)))
__device__ __forceinline__ const float* fin_(const __attribute__((address_space(4))) char* ka, int i) {
    const __attribute__((address_space(4))) char* p = ka; asm volatile("" : "+s"(p));
    return *(const float* const __attribute__((address_space(4)))*)(p + 8 * i);
}
#define FIN(i) fin_(F.ka, (i))
namespace pg8 {
#define PG8_LAS __attribute__((address_space(3)))
typedef unsigned short bf16_t;
typedef short bf16x8 __attribute__((ext_vector_type(8)));
typedef float f32x4 __attribute__((ext_vector_type(4)));
typedef unsigned u32x4 __attribute__((ext_vector_type(4)));
constexpr int BM = 256, BK = 64, HALF = 128, HTB = HALF * BK * 2  , STAGE_BYTES = 8 * HTB, NXCD = 8, WGM = 8;

__host__ __device__ __forceinline__ int lds_byte(int r, int c) { const int st = (r >> 4) * 2 + (c >> 5), rr = r & 15, cc = c & 31, ob = rr * 64 + cc * 2; return st * 1024 + (ob ^ (((ob >> 9) & 1) << 5)); }
__host__ __device__ __forceinline__ void stage_rc(int b, int& R, int& C) { const int st = b / 1024, sb = b % 1024, swz = sb ^ (((sb >> 9) & 1) << 5); R = (st >> 1) * 16 + swz / 64; C = (st & 1) * 32 + (swz % 64) / 2; }
__host__ __device__ __forceinline__ int perm32(int rho) { const int n = rho >> 4, i = rho & 15; return 8 * (i >> 2) + 4 * n + (i & 3); }

struct Unit { int pm, pn; };
struct Gemm { const bf16_t* A; const bf16_t* Bt; int M, N, K; };

struct StaticOrder {
    int nM, nN, nwg, G, c;
    __host__ __device__ void init(int M, int N, int G_, int c_) { nM = M / BM; nN = N / BM; nwg = nM * nN; G = G_; c = c_; }
    __host__ __device__ bool next(int i, Unit& u) const {
        const long L = (long)i * G + c; if (L >= nwg) return false;
        int wgid = (int)L; { const int q = nwg / NXCD, r = nwg % NXCD, xcd = wgid % NXCD, off = wgid / NXCD; wgid = (xcd < r ? xcd * (q + 1) : r * (q + 1) + (xcd - r) * q) + off; }
        const int nig = WGM * nN, gid = wgid / nig, fm = gid * WGM, gsz = (nM - fm) < WGM ? (nM - fm) : WGM;
        u.pm = fm + ((wgid % nig) % gsz); u.pn = (wgid % nig) / gsz; return true;
    }
    __device__ __forceinline__ void a_ready(const Unit&) const {}
    __device__ __forceinline__ void done(const Unit&) const {}
};
template <class Epi, class Sched, bool ALIGN_EPI = false, bool SP2 = false>
__device__ __forceinline__ void gemm_phase(PG8_LAS unsigned char* lds, const Gemm g, const Sched& S, const Epi& E) {
    const int tid = threadIdx.x, wid = __builtin_amdgcn_readfirstlane(tid >> 6), lane = tid & 63, wr = wid >> 2, wc = wid & 3, fr = lane & 15, fq = lane >> 4;
    const int K = g.K, nt = K / BK;
    unsigned voffA[2], voffB[2];
#pragma unroll
    for (int i = 0; i < 2; ++i) { int R, C; stage_rc(tid * 16 + i * 8192, R, C); const int Rb = Epi::PERM ? ((R & ~31) + perm32(R & 31)) : R;
        voffA[i] = (unsigned)(R * K + C) * 2u; voffB[i] = (unsigned)(Rb * K + C) * 2u; }
    const size_t kstep = (size_t)(BK * 2);
    const size_t hstep = (size_t)HALF * K * 2;
    const size_t tstep = 2 * hstep;
    const unsigned ldsw = (unsigned)wid * 1024u;
    const int aoff = lds_byte(wr * 64 + fr, fq * 8), boff = lds_byte(wc * 32 + fr, fq * 8);
#define PG8_SA(b, h) (((b) * 2 + (h)) * HTB)
#define PG8_SB(b, h) ((4 + (b) * 2 + (h)) * HTB)
#define PG8_STAGE(bufoff, gbase, voff) do { _Pragma("unroll") for (int _i = 0; _i < 2; ++_i) \
        __builtin_amdgcn_global_load_lds((const unsigned*)((const char*)(gbase) + (voff)[_i]), (PG8_LAS unsigned*)(lds + (bufoff) + ldsw + _i * 8192), 16, 0, 0); } while (0)
#define PG8_LDA(dst, b, h) do { _Pragma("unroll") for (int m = 0; m < 4; ++m) _Pragma("unroll") for (int k = 0; k < 2; ++k) dst[m][k] = *(const PG8_LAS bf16x8*)(lds + PG8_SA(b, h) + aoff + m * 2048 + k * 1024); } while (0)
#define PG8_LDB(dst, b, h) do { _Pragma("unroll") for (int n = 0; n < 2; ++n) _Pragma("unroll") for (int k = 0; k < 2; ++k) dst[n][k] = *(const PG8_LAS bf16x8*)(lds + PG8_SB(b, h) + boff + n * 2048 + k * 1024); } while (0)
#define PG8_MMA(ai, bj, At, Bt) do { __builtin_amdgcn_s_setprio(1); _Pragma("unroll") for (int m = 0; m < 4; ++m) _Pragma("unroll") for (int n = 0; n < 2; ++n) _Pragma("unroll") for (int k = 0; k < 2; ++k) \
        acc[ai][bj][m][n] = __builtin_amdgcn_mfma_f32_16x16x32_bf16(Bt[n][k], At[m][k], acc[ai][bj][m][n], 0, 0, 0); __builtin_amdgcn_s_setprio(0); } while (0)
#define PG8_WAIT_V(n) asm volatile("s_waitcnt vmcnt(" #n ")" ::: "memory")
#define PG8_WAIT_L(n) asm volatile("s_waitcnt lgkmcnt(" #n ")" ::: "memory")
#define PG8_BAR __builtin_amdgcn_s_barrier()
#define PG8_SCHED __builtin_amdgcn_sched_barrier(0)
    Unit cur, nxt; int ui = 0;
    if (!S.next(0, cur)) return;
    f32x4 acc[2][2][4][2];
#pragma unroll
    for (int a = 0; a < 2; ++a)
#pragma unroll
        for (int b = 0; b < 2; ++b)
#pragma unroll
            for (int m = 0; m < 4; ++m)
#pragma unroll
                for (int n = 0; n < 2; ++n) acc[a][b][m][n] = (f32x4){0.f, 0.f, 0.f, 0.f};
    bf16x8 At[4][2], B0[2][2], B1[2][2];
    const char* cA = (const char*)g.A + (size_t)cur.pm * tstep; const char* cB = (const char*)g.Bt + (size_t)cur.pn * tstep;
    S.a_ready(cur);
    if constexpr (SP2) {
        PG8_STAGE(PG8_SB(0, 0), cB, voffB); PG8_STAGE(PG8_SB(0, 1), cB + hstep, voffB); PG8_STAGE(PG8_SA(0, 0), cA, voffA); PG8_STAGE(PG8_SA(0, 1), cA + hstep, voffA);
        if (wr == 1) PG8_BAR;
        PG8_WAIT_V(2); PG8_BAR;
        PG8_STAGE(PG8_SB(1, 0), cB + kstep, voffB); PG8_STAGE(PG8_SA(1, 0), cA + kstep, voffA); PG8_STAGE(PG8_SB(1, 1), cB + hstep + kstep, voffB);
        PG8_WAIT_V(6); PG8_BAR;
    } else {
        PG8_STAGE(PG8_SB(0, 0), cB, voffB); PG8_STAGE(PG8_SA(0, 0), cA, voffA); PG8_STAGE(PG8_SB(0, 1), cB + hstep, voffB); PG8_STAGE(PG8_SA(0, 1), cA + hstep, voffA);
        if (wr == 1) PG8_BAR;
        PG8_WAIT_V(4); PG8_BAR;
        PG8_STAGE(PG8_SB(1, 0), cB + kstep, voffB); PG8_STAGE(PG8_SA(1, 0), cA + kstep, voffA); PG8_STAGE(PG8_SB(1, 1), cB + hstep + kstep, voffB);
        PG8_WAIT_V(6); PG8_BAR;
    }
    for (;;) {
        const bool has_next = S.next(ui + 1, nxt);
        const char* nA = has_next ? (const char*)g.A + (size_t)nxt.pm * tstep : cA; const char* nB = has_next ? (const char*)g.Bt + (size_t)nxt.pn * tstep : cB;
        for (int t = 0; t < nt; t += 2) {
            const bool last = (t == nt - 2);
            const char* a1 = cA + (size_t)(t + 1) * kstep;
            const char* a2 = last ? nA : cA + (size_t)(t + 2) * kstep; const char* b2 = last ? nB : cB + (size_t)(t + 2) * kstep;
            const char* a3 = a2 + kstep; const char* b3 = b2 + kstep;
            if (last && has_next) S.a_ready(nxt);
            if constexpr (SP2) {
            PG8_LDB(B0, 0, 0); PG8_LDB(B1, 0, 1); PG8_SCHED; PG8_LDA(At, 0, 0); PG8_STAGE(PG8_SA(1, 1), a1 + hstep, voffA);
            PG8_WAIT_V(8); PG8_WAIT_L(0); PG8_BAR; PG8_MMA(0, 0, At, B0); PG8_MMA(0, 1, At, B1); PG8_BAR; PG8_SCHED;
            PG8_LDA(At, 0, 1); PG8_STAGE(PG8_SB(0, 0), b2, voffB); PG8_STAGE(PG8_SB(0, 1), b2 + hstep, voffB); PG8_STAGE(PG8_SA(0, 0), a2, voffA);
            PG8_WAIT_V(8); PG8_WAIT_L(0); PG8_BAR; PG8_MMA(1, 0, At, B0); PG8_MMA(1, 1, At, B1); PG8_BAR; PG8_SCHED;
            PG8_LDB(B0, 1, 0); PG8_LDB(B1, 1, 1); PG8_SCHED; PG8_LDA(At, 1, 0); PG8_STAGE(PG8_SA(0, 1), a2 + hstep, voffA);
            PG8_WAIT_V(8); PG8_WAIT_L(0); PG8_BAR; PG8_MMA(0, 0, At, B0); PG8_MMA(0, 1, At, B1); PG8_BAR; PG8_SCHED;
            PG8_LDA(At, 1, 1); PG8_STAGE(PG8_SB(1, 0), b3, voffB); PG8_STAGE(PG8_SB(1, 1), b3 + hstep, voffB); PG8_STAGE(PG8_SA(1, 0), a3, voffA);
            PG8_WAIT_V(8); PG8_WAIT_L(0); PG8_BAR; PG8_MMA(1, 0, At, B0); PG8_MMA(1, 1, At, B1); PG8_BAR; PG8_SCHED;
            } else {
            PG8_LDB(B0, 0, 0); PG8_SCHED; PG8_LDA(At, 0, 0); PG8_STAGE(PG8_SA(1, 1), a1 + hstep, voffA);
            PG8_WAIT_L(8); PG8_BAR; PG8_WAIT_L(0); PG8_MMA(0, 0, At, B0); PG8_BAR; PG8_SCHED;
            PG8_LDB(B1, 0, 1); PG8_STAGE(PG8_SB(0, 0), b2, voffB);
            PG8_BAR; PG8_WAIT_L(0); PG8_MMA(0, 1, At, B1); PG8_BAR;
            PG8_LDA(At, 0, 1); PG8_STAGE(PG8_SA(0, 0), a2, voffA);
            PG8_BAR; PG8_WAIT_L(0); PG8_MMA(1, 0, At, B0); PG8_BAR; PG8_SCHED;
            PG8_STAGE(PG8_SB(0, 1), b2 + hstep, voffB);
            PG8_WAIT_V(6); PG8_BAR; PG8_MMA(1, 1, At, B1); PG8_BAR;
            PG8_LDB(B0, 1, 0); PG8_SCHED; PG8_LDA(At, 1, 0); PG8_STAGE(PG8_SA(0, 1), a2 + hstep, voffA);
            PG8_WAIT_L(8); PG8_BAR; PG8_WAIT_L(0); PG8_MMA(0, 0, At, B0); PG8_BAR; PG8_SCHED;
            PG8_LDB(B1, 1, 1); PG8_STAGE(PG8_SB(1, 0), b3, voffB);
            PG8_BAR; PG8_WAIT_L(0); PG8_MMA(0, 1, At, B1); PG8_BAR;
            PG8_LDA(At, 1, 1); PG8_STAGE(PG8_SA(1, 0), a3, voffA);
            PG8_BAR; PG8_WAIT_L(0); PG8_MMA(1, 0, At, B0); PG8_BAR; PG8_SCHED;
            PG8_STAGE(PG8_SB(1, 1), b3 + hstep, voffB);
            PG8_WAIT_V(6); PG8_BAR; PG8_MMA(1, 1, At, B1); PG8_BAR;
            }
        }
        if constexpr (ALIGN_EPI) { if (wr == 0) PG8_BAR; }
        if constexpr (!Epi::AFTER_DRAIN) { E(acc, cur, wr, wc, fr, fq); S.done(cur); }
        if (!has_next) break;
#pragma unroll
        for (int a = 0; a < 2; ++a)
#pragma unroll
            for (int b = 0; b < 2; ++b)
#pragma unroll
                for (int m = 0; m < 4; ++m)
#pragma unroll
                    for (int n = 0; n < 2; ++n) acc[a][b][m][n] = (f32x4){0.f, 0.f, 0.f, 0.f};
        cur = nxt; cA = nA; cB = nB; ++ui;
        if constexpr (ALIGN_EPI) { if (wr == 1) PG8_BAR; }
    }
    PG8_WAIT_V(0);
    if constexpr (!ALIGN_EPI) { if (wr == 0) PG8_BAR; }
    PG8_BAR;
    if constexpr (Epi::AFTER_DRAIN) { E.fused(acc, cur, wr, wc, fr, fq, lds, wid, lane); S.done(cur); }
#undef PG8_SA
#undef PG8_SB
#undef PG8_STAGE
#undef PG8_LDA
#undef PG8_LDB
#undef PG8_MMA
#undef PG8_WAIT_V
#undef PG8_WAIT_L
#undef PG8_BAR
#undef PG8_SCHED
}
}
#define XB_TMO      128
#define XB_XCNT(j)  (256  + 64 * (j))
#define XB_XSUB(j)  (1280 + 64 * (j))
#define XB_XGEN(j)  (2304 + 64 * (j))
#define XB_TOP      3328
#define XB_TOPGEN   3392
#define XCD_BAR_WORDS 3456
#define XB_SPIN_CAP (1u << 18)

__device__ __forceinline__ unsigned xb_ld(unsigned* p)              { return __hip_atomic_load(p, __ATOMIC_RELAXED, __HIP_MEMORY_SCOPE_AGENT); }
__device__ __forceinline__ unsigned xb_add(unsigned* p, unsigned v) { return __hip_atomic_fetch_add(p, v, __ATOMIC_RELAXED, __HIP_MEMORY_SCOPE_AGENT); }
__device__ __forceinline__ unsigned xb_xcc_id() { return (unsigned)__builtin_amdgcn_s_getreg((3 << 11) | 20) & 0xFu; }
#define XB_SPIN(cond, bar) do { unsigned _sp = 0; while (cond) { __builtin_amdgcn_s_sleep(1); \
    if ((++_sp & 255u) == 0u) { if (xb_ld(&(bar)[XB_TMO])) break; if (_sp > XB_SPIN_CAP) { atomicAdd(&(bar)[XB_TMO], 1u); break; } } } } while (0)

struct XcdBarrier {
    unsigned* bar; unsigned x;
    volatile LAS unsigned* st;
};

__device__ __forceinline__ XcdBarrier xcd_barrier_post(unsigned* bar, volatile LAS unsigned* st) {
    XcdBarrier b; b.bar = bar; b.x = xb_xcc_id(); b.st = st;
    if (threadIdx.x == 0) { st[2] = xb_add(&bar[XB_XCNT(b.x)], 1u); st[3] = 1u; }
    return b;
}
__device__ __forceinline__ void xcd_barrier_complete(unsigned* bar, unsigned x, unsigned& nloc, unsigned& nx) {
    const unsigned G = gridDim.x * gridDim.y * gridDim.z;
    unsigned sum, cnt, mine, sp = 0u;
    for (;;) {
        sum = 0u; cnt = 0u; mine = 0u;
#pragma unroll
        for (unsigned j = 0; j < 16; ++j) { const unsigned c = xb_ld(&bar[XB_XCNT(j)]); sum += c; cnt += (c > 0u) ? 1u : 0u; mine = (j == x) ? c : mine; }
        if (sum == G) break;
        __builtin_amdgcn_s_sleep(1);
        if ((++sp & 255u) == 0u) { if (xb_ld(&bar[XB_TMO])) break; if (sp > XB_SPIN_CAP) { atomicAdd(&bar[XB_TMO], 1u); break; } }
    }
    nloc = mine > 0u ? mine : 1u; nx = cnt > 0u ? cnt : 1u;
}

__device__ __forceinline__ void xcd_barrier(const XcdBarrier& b) {
    asm volatile("s_waitcnt vmcnt(0)" ::: "memory");
    __syncthreads();
    if (threadIdx.x == 0) {
        unsigned* bar = b.bar;
        __builtin_amdgcn_s_waitcnt(0);
        unsigned nloc = b.st[0], nx = b.st[1];
        if (nloc == 0u) { xcd_barrier_complete(bar, b.x, nloc, nx); b.st[0] = nloc; b.st[1] = nx; }
        const unsigned old = xb_add(&bar[XB_XSUB(b.x)], 1u);
        const unsigned gen = old / nloc;
        if (old + 1u == (gen + 1u) * nloc) {
            __builtin_amdgcn_fence(__ATOMIC_RELEASE, "agent");
            asm volatile("s_waitcnt vmcnt(0)" ::: "memory");
            const unsigned og = xb_add(&bar[XB_TOP], 1u);
            const unsigned tg = og / nx;
            if (og + 1u == (tg + 1u) * nx) xb_add(&bar[XB_TOPGEN], 1u);
            else XB_SPIN(xb_ld(&bar[XB_TOPGEN]) == tg, bar);
            __builtin_amdgcn_fence(__ATOMIC_ACQUIRE, "agent");
            xb_add(&bar[XB_XGEN(b.x)], 1u);
            asm volatile("s_waitcnt vmcnt(0)" ::: "memory");
        } else {
            XB_SPIN(xb_ld(&bar[XB_XGEN(b.x)]) == gen, bar);
            __builtin_amdgcn_fence(__ATOMIC_ACQUIRE, "agent");
            asm volatile("s_waitcnt vmcnt(0)" ::: "memory");
        }
    }
    __syncthreads();
}

namespace pg8 {
template <class Fn> struct EpiFn {
    static constexpr bool PERM = true, AFTER_DRAIN = false;
    Fn f;
    __device__ __forceinline__ void operator()(const f32x4 (&acc)[2][2][4][2], const Unit& u, int wr, int wc, int fr, int fq) const {
        const int row0 = u.pm * BM + wr * 64 + fr, col0 = u.pn * BM + wc * 32 + 8 * fq;
#pragma unroll
        for (int ai = 0; ai < 2; ++ai)
#pragma unroll
            for (int m = 0; m < 4; ++m)
#pragma unroll
                for (int bj = 0; bj < 2; ++bj) f.e8(row0 + ai * HALF + m * 16, col0 + bj * HALF, acc[ai][bj][m][0], acc[ai][bj][m][1]);
    }
};
}

struct FnBf16 {
    bf16* O; int ld;
    __device__ __forceinline__ void e8(int row, int col, f32x4 a, f32x4 b) const {
        v4u w; w.x = pk2(a.x, a.y); w.y = pk2(a.z, a.w); w.z = pk2(b.x, b.y); w.w = pk2(b.z, b.w);
        *(v4u*)(O + (size_t)row * ld + col) = w;
    }
    __device__ __forceinline__ void e4(int row, int col, f32x4 a) const {
        v2u w; w.x = pk2(a.x, a.y); w.y = pk2(a.z, a.w);
        *(v2u*)(O + (size_t)row * ld + col) = w;
    }
};
struct FnResid {
    float* XS; const float* baseP; const float* baseS;
    __device__ __forceinline__ const float* brow(int row) const { return row < MP ? baseP + (size_t)row * DM : baseS + (size_t)(row - MP) * DM; }
    __device__ __forceinline__ void e8(int row, int col, f32x4 a, f32x4 b) const {
        const float* br = brow(row) + col; float* o = XS + (size_t)row * DM + col;
        const f32x4 x0 = *(const f32x4*)br, x1 = *(const f32x4*)(br + 4);
        *(f32x4*)o = x0 + a; *(f32x4*)(o + 4) = x1 + b;
    }
    __device__ __forceinline__ void e4(int row, int col, f32x4 a) const {
        const float* br = brow(row) + col; float* o = XS + (size_t)row * DM + col;
        *(f32x4*)o = *(const f32x4*)br + a;
    }
};
struct FnF32 {
    float* O; int ld;
    __device__ __forceinline__ void e8(int row, int col, f32x4 a, f32x4 b) const { float* o = O + (size_t)row * ld + col; *(f32x4*)o = a; *(f32x4*)(o + 4) = b; }
    __device__ __forceinline__ void e4(int row, int col, f32x4 a) const { *(f32x4*)(O + (size_t)row * ld + col) = a; }
};
struct FnKvq {
    float* O; const float* ssq;
    __device__ __forceinline__ float rstd(int row) const { const f32x4 s0 = *(const f32x4*)(ssq + (size_t)row * 8), s1 = *(const f32x4*)(ssq + (size_t)row * 8 + 4);
        return 1.f / sqrtf((((s0.x + s0.y) + (s0.z + s0.w)) + ((s1.x + s1.y) + (s1.z + s1.w))) * (1.f / DM) + EPS); }
    __device__ __forceinline__ void e8(int row, int col, f32x4 a, f32x4 b) const {
        if (col < NKVQ_REAL) { const float rs = rstd(row); float* o = O + (size_t)row * NKVQ + col; *(f32x4*)o = a * rs; *(f32x4*)(o + 4) = b * rs; }
    }
    __device__ __forceinline__ void e4(int row, int col, f32x4 a) const {
        if (col < NKVQ_REAL) *(f32x4*)(O + (size_t)row * NKVQ + col) = a * rstd(row);
    }
};

template <class Fn>
__device__ __forceinline__ void skinny_gemm(Frame& F, const bf16* A, const bf16* Bt, int N, int row_base, const Fn& fn) {
    const int fr = F.lane & 15, fq = F.lane >> 4;
    const int nun = N / 16;
    for (int u = F.bid; u < nun; u += F.G) {
        const bf16* ap = Bt + (size_t)(u * 16 + fr) * DM + fq * 8;
        const bf16* bp = A + (size_t)(F.wave * 16 + fr) * DM + fq * 8;
        f32x4 acc = {0.f, 0.f, 0.f, 0.f};
#pragma unroll 8
        for (int ks = 0; ks < 32; ++ks) acc = MFMA16(ld8(ap + ks * 32), ld8(bp + ks * 32), acc);
        fn.e4(row_base + F.wave * 16 + fr, u * 16 + 4 * fq, acc);
    }
}

template <class Fn>
__device__ __forceinline__ void gemm_all(Frame& F, const bf16* A, const bf16* Bt, int N, const Fn& fn) {
    pg8::Gemm g{A, Bt, MP, N, DM}; pg8::StaticOrder S; S.init(MP, N, F.G, F.bid);
    pg8::EpiFn<Fn> E{fn};
    pg8::gemm_phase<pg8::EpiFn<Fn>, pg8::StaticOrder, true, true>(F.lds, g, S, E);
    skinny_gemm(F, A + (size_t)MP * DM, Bt, N, MP, fn);
}

__device__ __forceinline__ void p0_transpose_item(const float* W, int N, bf16* WT, int row_off, const float* gain, LAS float* scr, int item, int lane) {
    const int nblk = (N + 31) / 32, kb = item / nblk, nb = item % nblk, k0 = 64 * kb, n0 = 32 * nb;
#pragma unroll 8
    for (int i = 0; i < 32; ++i) { const int kk = 2 * i + (lane >> 5); const int n = n0 + (lane & 31);
        float v = 0.f; if (n < N) { v = W[(size_t)(k0 + kk) * N + n]; if (gain) v *= gain[k0 + kk]; }
        scr[kk * 33 + (lane & 31)] = v; }
    LDS_WAIT(); asm volatile("" ::: "memory");
    const int c = lane & 7;
#pragma unroll
    for (int j = 0; j < 4; ++j) { const int n = (lane >> 3) + 8 * j; const LAS float* s = scr + (8 * c) * 33 + n;
        v4u o; o.x = pk2(s[0 * 33], s[1 * 33]); o.y = pk2(s[2 * 33], s[3 * 33]); o.z = pk2(s[4 * 33], s[5 * 33]); o.w = pk2(s[6 * 33], s[7 * 33]);
        if (n0 + n < N) *(v4u*)(WT + (size_t)(row_off + n0 + n) * DM + k0 + 8 * c) = o; }
    LDS_WAIT(); asm volatile("" ::: "memory");
}
__device__ __forceinline__ void rms_row_to_bf16(const float* xrow, bf16* orow, int lane) {
    const f32x4* xr = (const f32x4*)xrow + lane;
    f32x4 v[4]; float s = 0.f;
#pragma unroll
    for (int j = 0; j < 4; ++j) { v[j] = xr[64 * j]; s += (v[j].x * v[j].x + v[j].y * v[j].y) + (v[j].z * v[j].z + v[j].w * v[j].w); }
    const float rstd = 1.f / sqrtf(wave_sum(s) * (1.f / DM) + EPS);
    v2u* o8 = (v2u*)orow + lane;
#pragma unroll
    for (int j = 0; j < 4; ++j) { v2u w; w.x = pk2(v[j].x * rstd, v[j].y * rstd); w.y = pk2(v[j].z * rstd, v[j].w * rstd); o8[64 * j] = w; }
}
__device__ __forceinline__ const float* xin_row(Frame& F, int row) { return row < MP ? FIN(0) + (size_t)row * DM : FIN(1) + (size_t)(row - MP) * DM; }

__device__ __forceinline__ void peer_tables_to_fp8(Frame& F, size_t thr, size_t nthr, size_t lo = 0, size_t hi = (size_t)2 * NEXP * DM / 8) {
    const size_t gt = thr, NGT = nthr;
        for (int t = 0; t < 2; ++t) { const f32x4* src = (const f32x4*)FIN(27 + t); v2u* dst = (v2u*)WSP(unsigned char, t == 0 ? WS_PU : WS_PV); const float* pln = FIN(24);
            for (size_t i0 = lo + gt; i0 < hi; i0 += (size_t)4 * NGT) {
                f32x4 a[4], b[4];
#pragma unroll
                for (int u = 0; u < 4; ++u) { const size_t i = i0 + (size_t)u * NGT; if (i < hi) { a[u] = src[2 * i]; b[u] = src[2 * i + 1]; } }
#pragma unroll
                for (int u = 0; u < 4; ++u) { const size_t i = i0 + (size_t)u * NGT; if (i < hi) {
                    if (t == 0) { const float* gp = pln + ((i >> 21) << 10) + ((i & 127) << 3); a[u] = a[u] * *(const f32x4*)gp * 32.f; b[u] = b[u] * *(const f32x4*)(gp + 4) * 32.f; }
                    else { a[u] = a[u] * 16.f; b[u] = b[u] * 16.f; }
                    int w0 = __builtin_amdgcn_cvt_pk_fp8_f32(a[u].x, a[u].y, 0, false); w0 = __builtin_amdgcn_cvt_pk_fp8_f32(a[u].z, a[u].w, w0, true);
                    int w1 = __builtin_amdgcn_cvt_pk_fp8_f32(b[u].x, b[u].y, 0, false); w1 = __builtin_amdgcn_cvt_pk_fp8_f32(b[u].z, b[u].w, w1, true);
                    dst[((((i >> 21) * 8 + ((i & 127) >> 4)) * (size_t)NEXP + ((i >> 7) & (NEXP - 1))) << 4) + (i & 15)] = (v2u){(unsigned)w0, (unsigned)w1}; } } } }
}

constexpr int FD_BUF = 16384;
__device__ __forceinline__ void fs_direct_task(Frame& F, int task) {
    int lane_ = F.lane; asm volatile("" : "+v"(lane_));
    const int lane = lane_, w = F.wave, fr = lane & 15, fq = lane >> 4, kv = w >> 2, g = w & 3, bs = task >> 4, c0 = (task & 15) * 32;
    LAS unsigned char* L = F.lds; asm volatile("" : "+v"(L));
    const float* cache = FIN(2); const int* pt = (const int*)FIN(6) + bs * NPAGES;
    const float* base[2];
#pragma unroll
    for (int nt = 0; nt < 2; ++nt) { const int t0 = 16 * (c0 + 16 * nt + fr); base[nt] = cache + ((size_t)pt[t0 >> 7] * PAGE + (t0 & 127)) * 1024 + kv * 256 + g * 64 + 8 * fq; }
    const bf16* wsrc[2]; int wdst[2];
#pragma unroll
    for (int q = 0; q < 2; ++q) { const int item = F.tid + 512 * q, kvw = item >> 9, n = (item >> 2) & 127, kq = item & 3;
        wsrc[q] = WSP(bf16, WS_W1BD) + (size_t)(kvw * 128 + n) * 2048 + kvw * 1024 + 8 * kq; wdst[q] = ((kvw * 8 + (n >> 4)) * 64 + kq * 16 + (n & 15)) * 16; }
    f32x4 acc[2][8];
#pragma unroll
    for (int nt = 0; nt < 2; ++nt)
#pragma unroll
        for (int mt = 0; mt < 8; ++mt) acc[nt][mt] = (f32x4){0.f, 0.f, 0.f, 0.f};
    f32x4 S0[2][2], S1[2][2]; v4u wr[2];
#define FD_DATA(S, ks) do { const int ks_ = (ks) < 32 ? (ks) : 31; _Pragma("unroll") for (int nt_ = 0; nt_ < 2; ++nt_) { const float* p_ = base[nt_] + (ks_ >> 1) * 1024 + (ks_ & 1) * 32; S[nt_][0] = *(const f32x4*)p_; S[nt_][1] = *(const f32x4*)(p_ + 4); } } while (0)
#define FD_WLOAD(ks) do { const int ks_ = (ks) < 32 ? (ks) : 31; wr[0] = *(const v4u*)(wsrc[0] + 32 * ks_); wr[1] = *(const v4u*)(wsrc[1] + 32 * ks_); } while (0)
#define FD_WSTORE(buf) do { *(LAS v4u*)(L + (buf) * FD_BUF + wdst[0]) = wr[0]; *(LAS v4u*)(L + (buf) * FD_BUF + wdst[1]) = wr[1]; } while (0)
#define FD_STEP(S, ks, buf) do { bf16x8 b_[2]; _Pragma("unroll") for (int nt_ = 0; nt_ < 2; ++nt_) b_[nt_] = cvt8(S[nt_][0], S[nt_][1]); \
        FD_DATA(S, (ks) + 2); \
        _Pragma("unroll") for (int mt_ = 0; mt_ < 8; ++mt_) { const bf16x8 a_ = *(const LAS bf16x8*)(L + (buf) * FD_BUF + ((kv * 8 + mt_) * 64 + lane) * 16); \
            acc[0][mt_] = MFMA16(a_, b_[0], acc[0][mt_]); acc[1][mt_] = MFMA16(a_, b_[1], acc[1][mt_]); } \
        FD_WSTORE((buf) ^ 1); FD_WLOAD((ks) + 2); \
        __syncthreads(); } while (0)
    FD_WLOAD(0); FD_WSTORE(0); FD_WLOAD(1); FD_DATA(S0, 0); FD_DATA(S1, 1);
    __syncthreads();
#pragma unroll 1
    for (int ks = 0; ks < 32; ks += 2) { FD_STEP(S0, ks, 0); FD_STEP(S1, ks + 1, 1); }
#undef FD_DATA
#undef FD_WLOAD
#undef FD_WSTORE
#undef FD_STEP
    float* fs = WSP(float, WS_FS) + ((size_t)(bs * 4 + g) * 512 + c0 + fr) * 256 + kv * 128 + 4 * fq;
#pragma unroll
    for (int nt = 0; nt < 2; ++nt)
#pragma unroll
        for (int mt = 0; mt < 8; ++mt) *(f32x4*)(fs + (size_t)nt * 16 * 256 + 16 * mt) = acc[nt][mt];
    __syncthreads();
}

__device__ __forceinline__ void p0_prologue(Frame& F) {
    LAS float* scr = (LAS float*)(F.lds + F.wave * 16384);
    const int gw = F.bid * 8 + F.wave, NGW = F.G * 8;
    const int gt = F.bid * 512 + F.tid, NGT = F.G * 512;
    {
        constexpr int I_IN = 128 * 16, I_OA = 32 * 16, I_KV = 48 * 16, I_QG = 34 * 16, I_OB = 32 * 16, I_PQ = 64 * 16;
        constexpr int NITEMS = I_IN + I_OA + I_KV + I_QG + I_OB + 2 * I_PQ;
        for (int it = gw; it < NITEMS; it += NGW) {
            int r = it;
            if (r < I_IN) {
                const int kb = r / 128, nb = r % 128, k0 = 64 * kb, n0 = 32 * nb; const float* W = FIN(8); const float* gain = FIN(7);
#pragma unroll 8
                for (int i = 0; i < 32; ++i) { const int kk = 2 * i + (F.lane >> 5); scr[kk * 33 + (F.lane & 31)] = W[(size_t)(k0 + kk) * GPROJ + n0 + (F.lane & 31)] * gain[k0 + kk]; }
                LDS_WAIT(); asm volatile("" ::: "memory");
                const int c = F.lane & 7;
#pragma unroll
                for (int j = 0; j < 4; ++j) { const int n = (F.lane >> 3) + 8 * j; const LAS float* s = scr + (8 * c) * 33 + n;
                    v4u o; o.x = pk2(s[0 * 33], s[1 * 33]); o.y = pk2(s[2 * 33], s[3 * 33]); o.z = pk2(s[4 * 33], s[5 * 33]); o.w = pk2(s[6 * 33], s[7 * 33]);
                    *(v4u*)(WSP(bf16, WS_WIN_T) + (size_t)(n0 + n) * DM + k0 + 8 * c) = o; }
                LDS_WAIT(); asm volatile("" ::: "memory");
                continue; }
            r -= I_IN;
            if (r < I_OA) { p0_transpose_item(FIN(13), 1024, WSP(bf16, WS_WOA_T), 0, nullptr, scr, r, F.lane); continue; } r -= I_OA;
            if (r < I_KV) { p0_transpose_item(FIN(15), NKV, WSP(bf16, WS_WKVQ_T), 0, FIN(14), scr, r, F.lane); continue; } r -= I_KV;
            if (r < I_QG) { p0_transpose_item(FIN(21), NQG, WSP(bf16, WS_WKVQ_T), NKV, FIN(20), scr, r, F.lane); continue; } r -= I_QG;
            if (r < I_OB) { p0_transpose_item(FIN(23), 1024, WSP(bf16, WS_WOB_T), 0, nullptr, scr, r, F.lane); continue; } r -= I_OB;
            if (r < I_PQ) { p0_transpose_item(FIN(25), 2048, WSP(bf16, WS_WPQ_T), 0, FIN(24), scr, r, F.lane); continue; } r -= I_PQ;
            p0_transpose_item(FIN(25) + (size_t)1024 * 2048, 2048, WSP(bf16, WS_WPQ_T) + (size_t)2048 * 1024, 0, FIN(24) + 1024, scr, r, F.lane);
        }
        for (int i = gt; i < (NKVQ - NKVQ_REAL) * DM / 8; i += NGT) ((v4u*)(WSP(bf16, WS_WKVQ_T) + (size_t)NKVQ_REAL * DM))[i] = (v4u){0u, 0u, 0u, 0u};
        for (int i = gt; i < 16 * 1024; i += NGT) { const int j = i >> 10, k = i & 1023; WSP(float, WS_WAB)[i] = FIN(7)[k] * FIN(8)[(size_t)k * GPROJ + 4096 + j]; }
    }
    for (int m = gw; m < MTOK; m += NGW) rms_row_to_bf16(xin_row(F, m), WSP(bf16, WS_XNA) + (size_t)m * DM, F.lane);
    {
        if (F.G != 256) peer_tables_to_fp8(F, (size_t)gt, (size_t)NGT);
        const f32x4* sk = (const f32x4*)FIN(26); v4u* dk = (v4u*)WSP(bf16, WS_SUBK);
        for (int i = gt; i < 2 * 8 * 2 * 128 * 128 / 8; i += NGT) { const f32x4 a = sk[2 * i], b = sk[2 * i + 1]; v4u w; w.x = pk2(a.x, a.y); w.y = pk2(a.z, a.w); w.z = pk2(b.x, b.y); w.w = pk2(b.z, b.w); dk[i] = w; }
    }
    for (int i = gt; i < 2 * 64 * 2048; i += NGT) { const int kv = i >> 17, hh = (i >> 11) & 63, k = i & 2047;
        WSP(bf16, WS_W1T)[i] = (bf16)f2bf(FIN(17)[((size_t)kv * 2048 + k) * 64 + hh]); }
    for (int it = gw; it < 128; it += NGW) { const int kv = it >> 6, h = it & 63; float s = 0.f;
        for (int k = F.lane; k < 2048; k += 64) s += FIN(18)[(size_t)kv * 2048 + k] * FIN(17)[((size_t)kv * 2048 + k) * 64 + h];
        s = wave_sum(s); if (F.lane == 0) WSP(float, WS_PETERM)[it] = s; }
    {
        bf16* wbd = WSP(bf16, WS_W1BD);
        for (int i = gt; i < 256 * 2048; i += NGT) { const int n = i >> 11, col = i & 2047, kv = n >> 7, sec = (n >> 6) & 1, hh = n & 63;
            float v = 0.f; if ((col >> 10) == kv) { const int k = col & 1023, r = (k >> 6) + 16 * sec, d = k & 63; v = FIN(17)[(((size_t)kv * 32 + r) * 64 + d) * 64 + hh]; }
            wbd[i] = (bf16)f2bf(v); }
    }
    {
        const f32x4* src = (const f32x4*)FIN(3); f32x4* dst = (f32x4*)(F.out + O_WINS);
        const int per_b = 508 * 512 / 4;
        for (int i = gt; i < SB * per_b; i += NGT) { const int b = i / per_b, r = i % per_b; dst[(size_t)b * (512 * 512 / 4) + r] = src[(size_t)b * (512 * 512 / 4) + 4 * 512 / 4 + r]; }
    }
    for (int i = gt; i < SB * NG * 544 * 64; i += NGT) {
        const int d = i & 63, r = (i >> 6) % 544, bg = (i >> 6) / 544, g = bg & 3, b = bg >> 2;
        if (r < 512) { const float* cw = FIN(3) + (((size_t)b * 512 + r) * 2) * 256 + g * 64 + d;
            WSP(bf16, WS_SKWIN)[i] = (bf16)f2bf(cw[0]);
            WSP(bf16, WS_SVWINT)[((size_t)bg * 64 + d) * 544 + r] = (bf16)f2bf(cw[256]); }
        else if (r >= 516) { WSP(bf16, WS_SKWIN)[i] = 0; WSP(bf16, WS_SVWINT)[((size_t)bg * 64 + d) * 544 + r] = 0; }
    }
}

constexpr int P2_QS = 0, P2_KS = 17408, P2_KBGT = 34816, P2_VBT = 53248, P2_AM = 71680, P2_TB = 89088, P2_G = 98304, P2_TF = 99328, P2_XF = 116736;
constexpr int QS_LD = 136, KT_LD = 72, AM_LD = 68, TB_LD = 72;

__device__ __forceinline__ float softplus_f(float x) { return fmaxf(x, 0.f) + log1pf(expf(-fabsf(x))); }

__device__ __forceinline__ void p2_chunk(Frame& F, int unit) {
    const int c = unit & 127, h = (unit >> 7) & 7, b = unit >> 10;
    const int t0 = c * CHUNK, lane = F.lane, w = F.wave, fr = lane & 15, fq = lane >> 4;
    LAS unsigned char* L = F.lds; asm volatile("" : "+v"(L));
    LAS bf16* qs = (LAS bf16*)(L + P2_QS); LAS bf16* ks = (LAS bf16*)(L + P2_KS);
    LAS bf16* kbgT = (LAS bf16*)(L + P2_KBGT); LAS bf16* vbT = (LAS bf16*)(L + P2_VBT);
    LAS float* Am = (LAS float*)(L + P2_AM); LAS bf16* Tb = (LAS bf16*)(L + P2_TB);
    LAS float* Gs = (LAS float*)(L + P2_G);
    const bf16* PROJ = WSP(bf16, WS_PROJ); const bf16* XNA = WSP(bf16, WS_XNA); const float* WAB = WSP(float, WS_WAB);
    const size_t rowb = (size_t)b * PT;
    float beta_r[8];
    {
        f32x4 wa[4], wb[4];
        const float* pa = WAB + (size_t)h * DM + 8 * lane; const float* pb = WAB + (size_t)(8 + h) * DM + 8 * lane;
        wa[0] = *(const f32x4*)pa; wa[1] = *(const f32x4*)(pa + 4); wa[2] = *(const f32x4*)(pa + 512); wa[3] = *(const f32x4*)(pa + 516);
        wb[0] = *(const f32x4*)pb; wb[1] = *(const f32x4*)(pb + 4); wb[2] = *(const f32x4*)(pb + 512); wb[3] = *(const f32x4*)(pb + 516);
        const float Aneg = -expf(FIN(10)[h]), dtb = FIN(11)[h];
#pragma unroll
        for (int tk = 0; tk < 8; ++tk) {
            const int tok = 8 * w + tk; const bf16* xr = XNA + (rowb + t0 + tok) * DM + 8 * lane;
            const v4u x0 = *(const v4u*)xr, x1 = *(const v4u*)(xr + 512);
            float sa = 0.f, sb = 0.f;
#define ACC2(xw, wv0, wv1, i0) { const float lo = bflo(xw), hi = bfhi(xw); sa += lo * wv0[i0] + hi * wv0[i0 + 1]; sb += lo * wv1[i0] + hi * wv1[i0 + 1]; }
            ACC2(x0.x, wa[0], wb[0], 0) ACC2(x0.y, wa[0], wb[0], 2) ACC2(x0.z, wa[1], wb[1], 0) ACC2(x0.w, wa[1], wb[1], 2)
            ACC2(x1.x, wa[2], wb[2], 0) ACC2(x1.y, wa[2], wb[2], 2) ACC2(x1.z, wa[3], wb[3], 0) ACC2(x1.w, wa[3], wb[3], 2)
#undef ACC2
            sa = wave_sum(sa); sb = wave_sum(sb);
            const float g = Aneg * softplus_f(sa + dtb), be = 1.f / (1.f + expf(-sb));
            beta_r[tk] = be;
            if (lane == 0) { Gs[tok] = g; Gs[64 + tok] = be; }
        }
    }
#pragma unroll
    for (int p = 0; p < 3; ++p) {
        const int col0 = p * 1024 + h * 128 + 2 * lane;
        float cw0[4], cw1[4];
#pragma unroll
        for (int i = 0; i < 4; ++i) { const f32x2 cv = *(const f32x2*)(FIN(9) + (size_t)i * GCONV + col0); cw0[i] = cv.x; cw1[i] = cv.y; }
        unsigned xw[11];
#pragma unroll
        for (int rr = 0; rr < 11; ++rr) { const int t = t0 + 8 * w - 3 + rr; xw[rr] = (t >= 0) ? *(const unsigned*)(PROJ + (rowb + t) * 4096 + col0) : 0u; }
        if (c == 127 && w == 7) {
#pragma unroll
            for (int r = 0; r < 3; ++r) { float* o = F.out + O_CONVP + ((size_t)b * 3 + r) * GCONV + col0; o[0] = bflo(xw[8 + r]); o[1] = bfhi(xw[8 + r]); }
        }
#pragma unroll
        for (int tk = 0; tk < 8; ++tk) {
            const int tok = 8 * w + tk;
            float y0 = 0.f, y1 = 0.f;
#pragma unroll
            for (int i = 0; i < 4; ++i) { y0 += cw0[i] * bflo(xw[tk + i]); y1 += cw1[i] * bfhi(xw[tk + i]); }
            y0 = silu_f(y0); y1 = silu_f(y1);
            if (p < 2) {
                const float ss = wave_sum(y0 * y0 + y1 * y1);
                const float rs = (1.f / sqrtf(ss + EPS)) * (p == 0 ? 0.08838834764831845f : 1.f);
                *(LAS unsigned*)((p == 0 ? qs : ks) + tok * QS_LD + 2 * lane) = pk2(y0 * rs, y1 * rs);
            } else {
                vbT[(2 * lane) * KT_LD + tok] = (bf16)f2bf(y0 * beta_r[tk]); vbT[(2 * lane + 1) * KT_LD + tok] = (bf16)f2bf(y1 * beta_r[tk]);
            }
        }
    }
    __syncthreads();
    if (w == 0) { float g = Gs[lane];
#pragma unroll
        for (int o = 1; o < 64; o <<= 1) { const float up = __shfl_up(g, o); if (lane >= o) g += up; }
        Gs[128 + lane] = g; }
    __syncthreads();
    const float glast = Gs[128 + 63];
    const size_t chunk = (size_t)unit;
    if (w < 4) {
        const int mt = w;
        bf16x8 a[4];
#pragma unroll
        for (int kk = 0; kk < 4; ++kk) a[kk] = ld8l(ks + (16 * mt + fr) * QS_LD + 32 * kk + 8 * fq);
#pragma unroll
        for (int nt = 0; nt < 4; ++nt) {
            f32x4 acc = {0.f, 0.f, 0.f, 0.f};
            if (nt <= mt) {
#pragma unroll
                for (int kk = 0; kk < 4; ++kk) acc = MFMA16(a[kk], ld8l(ks + (16 * nt + fr) * QS_LD + 32 * kk + 8 * fq), acc);
            }
            const int j = 16 * nt + fr; const float gj = Gs[128 + j];
#pragma unroll
            for (int r = 0; r < 4; ++r) { const int i = 16 * mt + 4 * fq + r;
                Am[i * AM_LD + j] = (i > j) ? Gs[64 + i] * acc[r] * __expf(Gs[128 + i] - gj) : 0.f; }
        }
    } else {
        const int nt = w - 4;
        bf16x8 bq[4];
#pragma unroll
        for (int kk = 0; kk < 4; ++kk) bq[kk] = ld8l(qs + (16 * nt + fr) * QS_LD + 32 * kk + 8 * fq);
        const int i = 16 * nt + fr; const float gi = Gs[128 + i];
        bf16* gqk = WSP(bf16, WS_GQK) + chunk * 4096;
#pragma unroll
        for (int mt = 0; mt < 4; ++mt) {
            f32x4 acc = {0.f, 0.f, 0.f, 0.f};
            if (mt <= nt) {
#pragma unroll
                for (int kk = 0; kk < 4; ++kk) acc = MFMA16(ld8l(ks + (16 * mt + fr) * QS_LD + 32 * kk + 8 * fq), bq[kk], acc);
            }
            float v[4];
#pragma unroll
            for (int r = 0; r < 4; ++r) { const int j = 16 * mt + 4 * fq + r; v[r] = (i >= j) ? acc[r] * __expf(gi - Gs[128 + j]) : 0.f; }
            v2u o; o.x = pk2(v[0], v[1]); o.y = pk2(v[2], v[3]);
            *(v2u*)(gqk + (((nt * 2 + (mt >> 1)) * 64 + (2 * (mt & 1) + (fq >> 1)) * 16 + fr) * 8 + 4 * (fq & 1))) = o;
        }
    }
    {
        const int tok = F.tid >> 3, d0 = (F.tid & 7) * 16; const float e = __expf(Gs[128 + tok]);
        bf16* gq = WSP(bf16, WS_GQ) + chunk * 8192;
#pragma unroll
        for (int hh = 0; hh < 2; ++hh) { const v4u q = *(const LAS v4u*)(qs + tok * QS_LD + d0 + 8 * hh); v4u o;
            o.x = pk2(bflo(q.x) * e, bfhi(q.x) * e); o.y = pk2(bflo(q.y) * e, bfhi(q.y) * e); o.z = pk2(bflo(q.z) * e, bfhi(q.z) * e); o.w = pk2(bflo(q.w) * e, bfhi(q.w) * e);
            *(v4u*)(gq + ((((tok >> 4) * 4 + ((F.tid & 7) >> 1)) * 64 + (2 * (F.tid & 1) + hh) * 16 + (tok & 15)) * 8)) = o; }
    }
    {
        const int dk = F.tid & 127, tg = F.tid >> 7;
        unsigned o1[8], o2[8];
#pragma unroll
        for (int i = 0; i < 8; ++i) {
            const int ta = 16 * tg + 2 * i, tb2 = ta + 1;
            const float ka = bf2f(ks[ta * QS_LD + dk]), kb = bf2f(ks[tb2 * QS_LD + dk]);
            const float ga = Gs[128 + ta], gb = Gs[128 + tb2];
            o1[i] = pk2(ka * Gs[64 + ta] * __expf(ga), kb * Gs[64 + tb2] * __expf(gb));
            o2[i] = pk2(ka * __expf(glast - ga), kb * __expf(glast - gb));
        }
        LAS v4u* d1 = (LAS v4u*)(kbgT + dk * KT_LD + 16 * tg); d1[0] = (v4u){o1[0], o1[1], o1[2], o1[3]}; d1[1] = (v4u){o1[4], o1[5], o1[6], o1[7]};
        bf16* d2 = WSP(bf16, WS_GKT) + chunk * 8192 + ((((dk >> 4) * 2 + (tg >> 1)) * 64 + (2 * (tg & 1)) * 16 + (dk & 15)) * 8);
        *(v4u*)d2 = (v4u){o2[0], o2[1], o2[2], o2[3]}; *(v4u*)(d2 + 16 * 8) = (v4u){o2[4], o2[5], o2[6], o2[7]};
    }
    if (F.tid == 0) WSP(float, WS_GDEC)[chunk] = __expf(glast);
    __syncthreads();
    LAS float* Tf = (LAS float*)(L + P2_TF); LAS float* Xf = (LAS float*)(L + P2_XF);
    if (w == 0) {
        const int blk = lane >> 5, cc = lane & 31; const LAS float* Ab = Am + (32 * blk) * AM_LD + 32 * blk;
        float t[32];
#pragma unroll
        for (int i = 0; i < 32; ++i) {
            float acc0 = (i == cc) ? 1.f : 0.f, acc1 = 0.f;
#pragma unroll
            for (int j4 = 0; j4 < (i + 3) / 4; ++j4) {
                const f32x4 a = *(const LAS f32x4*)(Ab + i * AM_LD + 4 * j4);
                if (4 * j4 + 0 < i) acc0 = __builtin_fmaf(-a.x, t[4 * j4 + 0], acc0);
                if (4 * j4 + 1 < i) acc1 = __builtin_fmaf(-a.y, t[4 * j4 + 1], acc1);
                if (4 * j4 + 2 < i) acc0 = __builtin_fmaf(-a.z, t[4 * j4 + 2], acc0);
                if (4 * j4 + 3 < i) acc1 = __builtin_fmaf(-a.w, t[4 * j4 + 3], acc1);
            }
            t[i] = acc0 + acc1;
            asm volatile("" : "+v"(t[i]));
            __builtin_amdgcn_sched_barrier(0);
        }
#pragma unroll
        for (int i = 0; i < 32; ++i) { Tf[(32 * blk + i) * AM_LD + 32 * blk + cc] = t[i]; if (blk == 0) Tf[i * AM_LD + 32 + cc] = 0.f; }
    }
    __syncthreads();
    {
        const int i = F.tid >> 4, c0 = (F.tid & 15) * 2; float x0 = 0.f, x1 = 0.f;
#pragma unroll 8
        for (int k = 0; k < 32; ++k) { const float a = Am[(32 + i) * AM_LD + k]; x0 = __builtin_fmaf(a, Tf[k * AM_LD + c0], x0); x1 = __builtin_fmaf(a, Tf[k * AM_LD + c0 + 1], x1); }
        Xf[i * 34 + c0] = x0; Xf[i * 34 + c0 + 1] = x1;
    }
    __syncthreads();
    {
        const int i = F.tid >> 4, c0 = (F.tid & 15) * 2; float x0 = 0.f, x1 = 0.f;
#pragma unroll 8
        for (int k = 0; k < 32; ++k) { const float a = Tf[(32 + i) * AM_LD + 32 + k]; x0 = __builtin_fmaf(a, Xf[k * 34 + c0], x0); x1 = __builtin_fmaf(a, Xf[k * 34 + c0 + 1], x1); }
        Tf[(32 + i) * AM_LD + c0] = -x0; Tf[(32 + i) * AM_LD + c0 + 1] = -x1;
    }
    __syncthreads();
    {
        const int i = F.tid >> 3, c0 = (F.tid & 7) * 8; const f32x4 a = *(const LAS f32x4*)(Tf + i * AM_LD + c0), b2 = *(const LAS f32x4*)(Tf + i * AM_LD + c0 + 4);
        *(LAS v4u*)(Tb + i * TB_LD + c0) = (v4u){pk2(a.x, a.y), pk2(a.z, a.w), pk2(b2.x, b2.y), pk2(b2.z, b2.w)};
    }
    __syncthreads();
    {
        bf16x8 tb[4][2];
#pragma unroll
        for (int x = 0; x < 4; ++x)
#pragma unroll
            for (int s = 0; s < 2; ++s) tb[x][s] = ld8l(Tb + (16 * x + fr) * TB_LD + 32 * s + 8 * fq);
        const bf16x8 bv0 = ld8l(vbT + (16 * w + fr) * KT_LD + 8 * fq), bv1 = ld8l(vbT + (16 * w + fr) * KT_LD + 32 + 8 * fq);
        f32x4* gu = (f32x4*)(WSP(float, WS_GU) + chunk * 8192) + (size_t)w * 256 + lane;
#pragma unroll
        for (int mt = 0; mt < 4; ++mt) { f32x4 acc = {0.f, 0.f, 0.f, 0.f}; acc = MFMA16(tb[mt][0], bv0, acc); acc = MFMA16(tb[mt][1], bv1, acc); gu[mt * 64] = acc; }
        const bf16x8 ak0 = ld8l(kbgT + (16 * w + fr) * KT_LD + 8 * fq), ak1 = ld8l(kbgT + (16 * w + fr) * KT_LD + 32 + 8 * fq);
        bf16* gw = WSP(bf16, WS_GW) + chunk * 8192;
#pragma unroll
        for (int nt = 0; nt < 4; ++nt) { f32x4 acc = {0.f, 0.f, 0.f, 0.f}; acc = MFMA16(ak0, tb[nt][0], acc); acc = MFMA16(ak1, tb[nt][1], acc);
            v2u o; o.x = pk2(acc[0], acc[1]); o.y = pk2(acc[2], acc[3]);
            *(v2u*)(gw + (((nt * 4 + (w >> 1)) * 64 + (2 * (w & 1) + (fq >> 1)) * 16 + fr) * 8 + 4 * (fq & 1))) = o; }
    }
    __syncthreads();
}

constexpr int S2_Y = 0;
constexpr int S2_AB = 6144;
constexpr int S2_DOT = 6400;
constexpr int S2_U = 6656;
constexpr int S2_W = 8704;
constexpr int S2_VN = 10752;
__device__ __forceinline__ void p2_sample(Frame& F, int unit) {
    const int h = unit & 7, bs = unit >> 3, tid = F.tid, lane = F.lane, w = F.wave;
    LAS unsigned char* L = F.lds; asm volatile("" : "+v"(L));
    LAS float* Y = (LAS float*)(L + S2_Y); LAS float* AB = (LAS float*)(L + S2_AB); LAS float* DOT = (LAS float*)(L + S2_DOT);
    LAS float* U = (LAS float*)(L + S2_U); LAS float* W = (LAS float*)(L + S2_W); LAS float* VN = (LAS float*)(L + S2_VN);
    const bf16* PROJ = WSP(bf16, WS_PROJ); const bf16* XNA = WSP(bf16, WS_XNA); const float* WAB = WSP(float, WS_WAB);
    const size_t row0 = (size_t)MP + bs * 4;
    if (tid < 384) {
        const int part = tid >> 7, cc = tid & 127, col = part * 1024 + h * 128 + cc;
        float buf[7];
#pragma unroll
        for (int r = 0; r < 3; ++r) buf[r] = FIN(5)[((size_t)bs * 3 + r) * GCONV + col];
#pragma unroll
        for (int i = 0; i < 4; ++i) buf[3 + i] = bf2f(PROJ[(row0 + i) * 4096 + col]);
#pragma unroll
        for (int r = 0; r < 3; ++r) F.out[O_CONVS + ((size_t)bs * 3 + r) * GCONV + col] = buf[4 + r];
        float cw[4];
#pragma unroll
        for (int i = 0; i < 4; ++i) cw[i] = FIN(9)[(size_t)i * GCONV + col];
#pragma unroll
        for (int i = 0; i < 4; ++i) { float y = 0.f;
#pragma unroll
            for (int k = 0; k < 4; ++k) y += cw[k] * buf[i + k];
            Y[(part * 4 + i) * 128 + cc] = silu_f(y); }
    }
    {
        const int i = w >> 1, which = w & 1; const bf16* xr = XNA + (row0 + i) * DM; const float* wr = WAB + (size_t)(which * 8 + h) * DM; float s = 0.f;
        for (int k = lane; k < DM; k += 64) s += bf2f(xr[k]) * wr[k];
        s = wave_sum(s); if (lane == 0) AB[which * 4 + i] = s;
    }
    __syncthreads();
    {
        const int part = w >> 2, i = w & 3; LAS float* y = Y + (part * 4 + i) * 128; const float a = y[lane], bq = y[64 + lane];
        const float ss = wave_sum(a * a + bq * bq); const float rs = (1.f / sqrtf(ss + EPS)) * (part == 0 ? 0.08838834764831845f : 1.f);
        y[lane] = a * rs; y[64 + lane] = bq * rs;
    }
    if (tid == 0) { const float Aneg = -expf(FIN(10)[h]), dtb = FIN(11)[h]; float gc = 0.f;
        for (int i = 0; i < 4; ++i) { const float g = Aneg * softplus_f(AB[i] + dtb); gc += g; AB[8 + i] = g; AB[12 + i] = 1.f / (1.f + expf(-AB[4 + i])); AB[16 + i] = gc; } }
    __syncthreads();
    {
#pragma unroll
        for (int pp = 0; pp < 4; ++pp) { const int pr = 4 * w + pp, which = pr >> 4, i = (pr >> 2) & 3, j = pr & 3;
            const LAS float* x = Y + ((which == 0 ? 1 : 0) * 4 + i) * 128; const LAS float* y = Y + (1 * 4 + j) * 128;
            float s = x[lane] * y[lane] + x[64 + lane] * y[64 + lane]; s = wave_sum(s); if (lane == 0) DOT[pr] = s; }
    }
    __syncthreads();
    float g_[4], be[4], gc[4];
#pragma unroll
    for (int i = 0; i < 4; ++i) { g_[i] = AB[8 + i]; be[i] = AB[12 + i]; gc[i] = AB[16 + i]; }
    float Tm[4][4];
    {
        float A[4][4];
#pragma unroll
        for (int i = 0; i < 4; ++i)
#pragma unroll
            for (int j = 0; j < 4; ++j) A[i][j] = (i > j) ? be[i] * DOT[i * 4 + j] * expf(gc[i] - gc[j]) : 0.f;
#pragma unroll
        for (int cc = 0; cc < 4; ++cc)
#pragma unroll
            for (int i = 0; i < 4; ++i) { float acc = (i == cc) ? 1.f : 0.f;
#pragma unroll
                for (int j = 0; j < 4; ++j) if (j < i) acc -= A[i][j] * Tm[j][cc];
                Tm[i][cc] = acc; }
    }
    {
        const int i = tid >> 7, x = tid & 127; float su = 0.f, sw = 0.f;
#pragma unroll
        for (int j = 0; j < 4; ++j) { su += Tm[i][j] * Y[(2 * 4 + j) * 128 + x] * be[j]; sw += Tm[i][j] * Y[(1 * 4 + j) * 128 + x] * be[j] * expf(gc[j]); }
        U[i * 128 + x] = su; W[i * 128 + x] = sw;
    }
    __syncthreads();
    const float* S0 = FIN(4) + ((size_t)bs * GH + h) * 128 * 128;
    float qs_acc;
    {
        const int i = tid >> 7, dv = tid & 127; float p = 0.f, qq = 0.f;
        const LAS float* wr = W + i * 128; const LAS float* qr = Y + (0 * 4 + i) * 128;
#pragma unroll 16
        for (int dk = 0; dk < 128; ++dk) { const float s = S0[(size_t)dk * 128 + dv]; p += wr[dk] * s; qq += qr[dk] * s; }
        VN[i * 128 + dv] = U[i * 128 + dv] - p; qs_acc = qq * expf(gc[i]);
    }
    __syncthreads();
    {
        const int i = tid >> 7, dv = tid & 127; float o = qs_acc;
#pragma unroll
        for (int j = 0; j < 4; ++j) if (j <= i) o += DOT[16 + i * 4 + j] * expf(gc[i] - gc[j]) * VN[j * 128 + dv];
        WSP(float, WS_OGDN)[(row0 + i) * DM + h * 128 + dv] = o;
    }
    {
        const int dv = tid & 127, dg = tid >> 7; const float el = expf(gc[3]);
        float kd[4], vn[4];
#pragma unroll
        for (int j = 0; j < 4; ++j) { kd[j] = expf(gc[3] - gc[j]); vn[j] = VN[j * 128 + dv]; }
        float* So = F.out + O_GDNS + ((size_t)bs * GH + h) * 128 * 128;
#pragma unroll 8
        for (int dk = dg * 32; dk < dg * 32 + 32; ++dk) { float s = S0[(size_t)dk * 128 + dv] * el;
#pragma unroll
            for (int j = 0; j < 4; ++j) s += Y[(1 * 4 + j) * 128 + dk] * kd[j] * vn[j];
            So[(size_t)dk * 128 + dv] = s; }
    }
    (void)g_;
    __syncthreads();
}

constexpr int P3_S = 0;
constexpr int P3_VN = 16384;
__device__ __forceinline__ void p3_scan(Frame& F, int bh, int s) {
    const int lane = F.lane, w = F.wave, fr = lane & 15, fq = lane >> 4;
    const int b = bh >> 3, h = bh & 7;
    LAS bf16* Sl = (LAS bf16*)(F.lds + P3_S); LAS bf16* Vl = (LAS bf16*)(F.lds + P3_VN);
    const bf16* GW = WSP(bf16, WS_GW); const bf16* GQ = WSP(bf16, WS_GQ); const bf16* GKT = WSP(bf16, WS_GKT); const bf16* GQK = WSP(bf16, WS_GQK);
    const float* GU = WSP(float, WS_GU); const float* GDEC = WSP(float, WS_GDEC);
    float* OG = WSP(float, WS_OGDN);
    f32x4 Sacc[2];
#pragma unroll
    for (int n = 0; n < 2; ++n) { Sacc[n] = (f32x4){0.f, 0.f, 0.f, 0.f}; v2u z = {0u, 0u}; *(LAS v2u*)(Sl + (n * 16 + fr) * 136 + 16 * w + 4 * fq) = z; }
    __syncthreads();
    const int m = w & 3;
    struct P3Ops { bf16x8 a1[4], ak0, ak1; v4u x0, x1; float dec; };
    P3Ops R0, R1, R2;
#define P3_FETCH(R, cc) do { const size_t ch_ = (size_t)bh * NCH + (cc); \
        const bf16* p1_ = (w < 4 ? GW : GQ) + ch_ * 8192 + (size_t)(m * 4 * 64 + lane) * 8;        \
        _Pragma("unroll") for (int k_ = 0; k_ < 4; ++k_) R.a1[k_] = ld8(p1_ + 512 * k_); \
        const bf16* pk_ = GKT + ch_ * 8192 + (size_t)(w * 2 * 64 + lane) * 8; R.ak0 = ld8(pk_); R.ak1 = ld8(pk_ + 512); \
        const unsigned char* px_ = w < 4 ? (const unsigned char*)(GU + ch_ * 8192 + ((size_t)(2 * s) * 256 + m * 64 + lane) * 4) : (const unsigned char*)(GQK + ch_ * 4096 + (size_t)(m * 2 * 64 + lane) * 8); \
        R.x0 = *(const v4u*)px_; R.x1 = *(const v4u*)(px_ + (w < 4 ? 4096 : 1024));        \
        R.dec = GDEC[ch_]; } while (0)
#define P3_STEP(R, c) do { \
        f32x4 acc[2]; \
        _Pragma("unroll") for (int n = 0; n < 2; ++n) { acc[n] = (f32x4){0.f, 0.f, 0.f, 0.f}; \
            _Pragma("unroll") for (int k = 0; k < 4; ++k) acc[n] = MFMA16(R.a1[k], ld8l(Sl + (n * 16 + fr) * 136 + 32 * k + 8 * fq), acc[n]); } \
        if (w < 4) { _Pragma("unroll") for (int n = 0; n < 2; ++n) { const f32x4 vn = __builtin_bit_cast(f32x4, n == 0 ? R.x0 : R.x1) - acc[n]; v2u o; o.x = pk2(vn[0], vn[1]); o.y = pk2(vn[2], vn[3]); \
            *(LAS v2u*)(Vl + (n * 16 + fr) * 72 + 16 * m + 4 * fq) = o; } } \
        asm volatile("s_waitcnt lgkmcnt(0)\n\ts_barrier" ::: "memory"); \
        bf16x8 v0[2], v1[2]; \
        _Pragma("unroll") for (int n = 0; n < 2; ++n) { v0[n] = ld8l(Vl + (n * 16 + fr) * 72 + 8 * fq); v1[n] = ld8l(Vl + (n * 16 + fr) * 72 + 32 + 8 * fq); } \
        if (w >= 4) { _Pragma("unroll") for (int n = 0; n < 2; ++n) { acc[n] = MFMA16(__builtin_bit_cast(bf16x8, R.x0), v0[n], acc[n]); acc[n] = MFMA16(__builtin_bit_cast(bf16x8, R.x1), v1[n], acc[n]); \
            float* o = OG + ((size_t)b * PT + (c) * CHUNK + 16 * m + 4 * fq) * DM + h * 128 + 32 * s + 16 * n + fr; \
            _Pragma("unroll") for (int r = 0; r < 4; ++r) o[(size_t)r * DM] = acc[n][r]; } } \
        { float d_ = R.dec;        \
          _Pragma("unroll") for (int n = 0; n < 2; ++n) asm volatile("v_mul_f32 %0, %0, %4\n\tv_mul_f32 %1, %1, %4\n\tv_mul_f32 %2, %2, %4\n\tv_mul_f32 %3, %3, %4" : "+v"(Sacc[n][0]), "+v"(Sacc[n][1]), "+v"(Sacc[n][2]), "+v"(Sacc[n][3]) : "v"(d_)); } \
        _Pragma("unroll") for (int n = 0; n < 2; ++n) { Sacc[n] = MFMA16(R.ak0, v0[n], Sacc[n]); Sacc[n] = MFMA16(R.ak1, v1[n], Sacc[n]); \
            v2u o; o.x = pk2(Sacc[n][0], Sacc[n][1]); o.y = pk2(Sacc[n][2], Sacc[n][3]); *(LAS v2u*)(Sl + (n * 16 + fr) * 136 + 16 * w + 4 * fq) = o; } \
        asm volatile("s_waitcnt lgkmcnt(0)\n\ts_barrier" ::: "memory"); } while (0)
    P3_FETCH(R0, 0); __builtin_amdgcn_sched_barrier(0); P3_FETCH(R1, 1); __builtin_amdgcn_sched_barrier(0); P3_FETCH(R2, 2); __builtin_amdgcn_sched_barrier(0);
    static_assert(NCH % 3 == 2, "ring schedule below assumes NCH = 3k + 2");
#pragma unroll 1
    for (int c = 0; c + 3 <= NCH; c += 3) {
        P3_STEP(R0, c);     P3_FETCH(R0, (c + 3 < NCH ? c + 3 : NCH - 1));
        P3_STEP(R1, c + 1); P3_FETCH(R1, (c + 4 < NCH ? c + 4 : NCH - 1));
        P3_STEP(R2, c + 2); P3_FETCH(R2, (c + 5 < NCH ? c + 5 : NCH - 1));
    }
    P3_STEP(R0, NCH - 2); P3_STEP(R1, NCH - 1);
#undef P3_FETCH
#undef P3_STEP
    float* So = F.out + O_GDNP + ((size_t)bh * 128) * 128;
#pragma unroll
    for (int n = 0; n < 2; ++n)
#pragma unroll
        for (int r = 0; r < 4; ++r) So[(size_t)(16 * w + 4 * fq + r) * 128 + 32 * s + 16 * n + fr] = Sacc[n][r];
}

__device__ __forceinline__ void p4_row(Frame& F, int row) {
    const int lane = F.lane;
    const float* o = WSP(float, WS_OGDN) + (size_t)row * DM + 16 * lane;
    const bf16* z = WSP(bf16, WS_PROJ) + (size_t)row * 4096 + 3072 + 16 * lane;
    f32x4 v[4]; float ss = 0.f;
#pragma unroll
    for (int j = 0; j < 4; ++j) { v[j] = *(const f32x4*)(o + 4 * j); ss += (v[j].x * v[j].x + v[j].y * v[j].y) + (v[j].z * v[j].z + v[j].w * v[j].w); }
    ss += dpp_f<DPP_XOR1>(ss); ss += dpp_f<DPP_XOR2>(ss); ss += dpp_f<DPP_HMIR>(ss);
    const float rstd = 1.f / sqrtf(ss * (1.f / 128.f) + EPS);
    const v4u z0 = *(const v4u*)z, z1 = *(const v4u*)(z + 8);
    const float* gn = FIN(12) + (16 * lane & 127);
    float zz[16] = {bflo(z0.x), bfhi(z0.x), bflo(z0.y), bfhi(z0.y), bflo(z0.z), bfhi(z0.z), bflo(z0.w), bfhi(z0.w),
                    bflo(z1.x), bfhi(z1.x), bflo(z1.y), bfhi(z1.y), bflo(z1.z), bfhi(z1.z), bflo(z1.w), bfhi(z1.w)};
    unsigned ow[8];
#pragma unroll
    for (int j = 0; j < 8; ++j) { const float a = v[j >> 1][(2 * j) & 3] * rstd * gn[2 * j] * silu_f(zz[2 * j]), bq = v[j >> 1][(2 * j + 1) & 3] * rstd * gn[2 * j + 1] * silu_f(zz[2 * j + 1]); ow[j] = pk2(a, bq); }
    v4u* dst = (v4u*)(WSP(bf16, WS_OG) + (size_t)row * DM + 16 * lane);
    dst[0] = (v4u){ow[0], ow[1], ow[2], ow[3]}; dst[1] = (v4u){ow[4], ow[5], ow[6], ow[7]};
}

typedef __bf16 bf16x2_t __attribute__((ext_vector_type(2)));
__device__ __forceinline__ float dot2_bf16(unsigned w, unsigned x, float acc) { return __builtin_amdgcn_fdot2_f32_bf16(__builtin_bit_cast(bf16x2_t, w), __builtin_bit_cast(bf16x2_t, x), acc, false); }
__device__ __forceinline__ float u2f(unsigned u) { return __builtin_bit_cast(float, u); }
__device__ __forceinline__ unsigned f2u(float f) { return __builtin_bit_cast(unsigned, f); }

constexpr int P8_MAXU = 4;
constexpr int P8_WAVE = P8_MAXU * 2048 + 1024;
constexpr int P8_TOP = 0;
constexpr int P8_TAB = 8 * P8_WAVE;
__device__ __forceinline__ void p8_init_tab(Frame& F) {
    LAS unsigned char* tab = F.lds + P8_TAB;
    if (F.tid < 64) { const int k = F.tid; int i = 0, j = 0;
        if (k < 16) { i = 0; j = k; } else if (k < 24) { i = 1; j = k - 16; } else if (k < 29) { i = 2; j = k - 24; } else if (k < 33) { i = 3; j = k - 29; }
        else if (k < 36) { i = 4; j = k - 33; } else if (k < 38) { i = 5; j = k - 36; } else if (k < 40) { i = 6; j = k - 38; } else if (k < 42) { i = 7; j = k - 40; } else if (k < 50) { i = k - 34; j = 0; }
        tab[k] = (unsigned char)i; tab[64 + k] = (unsigned char)j; }
    __syncthreads();
}
__device__ __forceinline__ int fkey(float x) { const int b = __builtin_bit_cast(int, x); return b ^ ((b >> 31) & 0x7fffffff); }
__device__ __forceinline__ float fkey_inv(int k) { return __builtin_bit_cast(float, k ^ ((k >> 31) & 0x7fffffff)); }
template <int CTRL> __device__ __forceinline__ int dpp_i(int x) { return __builtin_amdgcn_update_dpp(0, x, CTRL, 0xF, 0xF, true); }
__device__ __forceinline__ int imax(int a, int b) { return a > b ? a : b; }
__device__ __forceinline__ int imin(int a, int b) { return a < b ? a : b; }
__device__ __forceinline__ int row_imax16(int x) {
    x = imax(x, dpp_i<0xB1>(x)); x = imax(x, dpp_i<0x4E>(x)); x = imax(x, dpp_i<0x141>(x)); x = imax(x, dpp_i<0x140>(x)); return x;
}
#define ICSWAP(a, b) { const int hi_ = imax(a, b), lo_ = imin(a, b); a = hi_; b = lo_; }
constexpr int IKEY_MIN = (int)0x80000000;
template <int NR>
__device__ __forceinline__ void p8_run(Frame& F, int layer, int w, int rq, int u0, int ustride, int nu) {
    int lane_ = F.lane; asm volatile("" : "+v"(lane_));
    const int lane = lane_, fr = lane & 15, fq = lane >> 4;
    LAS unsigned char* L = F.lds; asm volatile("" : "+v"(L));
    LAS int* toplw = (LAS int*)(L + P8_TOP + F.wave * P8_WAVE);
    LAS float* wins = (LAS float*)(L + P8_TOP + F.wave * P8_WAVE + P8_MAXU * 2048);
    const LAS unsigned char* tab = L + P8_TAB;
    const bf16* Qb = WSP(bf16, WS_QPEER) + (size_t)fr * 2048 + w * 256 + 8 * fq;
    const bf16* SK = WSP(bf16, WS_SUBK) + (size_t)((layer * 8 + w) * 2) * 16384 + (size_t)fr * 128 + 8 * fq;
#pragma unroll 1
    for (int p = 0; p < 2; ++p) {
        bf16x8 bk[32], aq[4];
#pragma unroll
        for (int i = 0; i < 32; ++i) bk[i] = ld8(SK + (size_t)p * 16384 + (size_t)(i >> 2) * 2048 + 32 * (i & 3));
#pragma unroll
        for (int ks = 0; ks < 4; ++ks) aq[ks] = ld8(Qb + (size_t)u0 * 16 * 2048 + p * 128 + 32 * ks);
#pragma unroll 1
        for (int k = 0; k < nu; ++k) {
            LAS int* topl = toplw + k * 512;
            int s[NR][8];
#pragma unroll
            for (int nt = 0; nt < 8; ++nt) { f32x4 acc = {0.f, 0.f, 0.f, 0.f};
#pragma unroll
                for (int ks = 0; ks < 4; ++ks) acc = MFMA16(aq[ks], bk[nt * 4 + ks], acc);
                if (NR == 4) {
#pragma unroll
                    for (int r = 0; r < NR; ++r) s[r][nt] = fkey(u2f((f2u(acc[r]) & ~127u) | (unsigned)(16 * nt + fr)));
                } else { const float av = rq == 0 ? acc[0] : rq == 1 ? acc[1] : rq == 2 ? acc[2] : acc[3]; s[0][nt] = fkey(u2f((f2u(av) & ~127u) | (unsigned)(16 * nt + fr))); } }
            { const int un = u0 + (k + 1 < nu ? k + 1 : k) * ustride;
#pragma unroll
              for (int ks = 0; ks < 4; ++ks) aq[ks] = ld8(Qb + (size_t)un * 16 * 2048 + p * 128 + 32 * ks); }
#pragma unroll
            for (int r = 0; r < NR; ++r) {
                ICSWAP(s[r][0], s[r][1]) ICSWAP(s[r][2], s[r][3]) ICSWAP(s[r][4], s[r][5]) ICSWAP(s[r][6], s[r][7])
                ICSWAP(s[r][0], s[r][2]) ICSWAP(s[r][1], s[r][3]) ICSWAP(s[r][4], s[r][6]) ICSWAP(s[r][5], s[r][7])
                ICSWAP(s[r][1], s[r][2]) ICSWAP(s[r][5], s[r][6]) ICSWAP(s[r][0], s[r][4]) ICSWAP(s[r][3], s[r][7])
                ICSWAP(s[r][1], s[r][5]) ICSWAP(s[r][2], s[r][6]) ICSWAP(s[r][1], s[r][4]) ICSWAP(s[r][3], s[r][6])
                ICSWAP(s[r][2], s[r][4]) ICSWAP(s[r][3], s[r][5]) ICSWAP(s[r][3], s[r][4]) }
            int mine[NR];
#pragma unroll
            for (int r = 0; r < NR; ++r) mine[r] = IKEY_MIN;
#pragma unroll 1
            for (int rd = 0; rd < 16; ++rd) {
                const bool me = fr == rd;
#pragma unroll
                for (int r = 0; r < NR; ++r) {
                    const int mx = row_imax16(s[r][0]);
                    const bool pop = s[r][0] == mx;
#pragma unroll
                    for (int i = 0; i < 7; ++i) s[r][i] = pop ? s[r][i + 1] : s[r][i];
                    s[r][7] = pop ? IKEY_MIN : s[r][7];
                    mine[r] = me ? mx : mine[r];
                }
            }
#pragma unroll
            for (int r = 0; r < NR; ++r) topl[((4 * fq + (NR == 4 ? r : rq)) * 2 + p) * 16 + fr] = mine[r];
        }
    }
    LDS_WAIT();
#pragma unroll 1
    for (int k = 0; k < nu; ++k) {
    LAS int* topl = toplw + k * 512;
    const int r0 = (u0 + k * ustride) * 16;
    int c[NR][4];
#pragma unroll
    for (int r = 0; r < NR; ++r) { const int tk = 4 * fq + (NR == 4 ? r : rq);
#pragma unroll
        for (int m = 0; m < 4; ++m) { const int kc = fr + 16 * m; int cv = IKEY_MIN;
            if (kc < 50) { const int i = tab[kc], j = tab[64 + kc]; const float s1 = u2f(f2u(fkey_inv(topl[(tk * 2 + 0) * 16 + i])) & ~127u), s2 = u2f(f2u(fkey_inv(topl[(tk * 2 + 1) * 16 + j])) & ~127u);
                cv = fkey(u2f((f2u(s1 + s2) & ~63u) | (unsigned)kc)); }
            c[r][m] = cv; }
        ICSWAP(c[r][0], c[r][1]) ICSWAP(c[r][2], c[r][3]) ICSWAP(c[r][0], c[r][2]) ICSWAP(c[r][1], c[r][3]) ICSWAP(c[r][1], c[r][2]) }
    int minec[NR];
#pragma unroll
    for (int r = 0; r < NR; ++r) minec[r] = IKEY_MIN;
#pragma unroll 1
    for (int rd = 0; rd < 16; ++rd) {
        const bool me = fr == rd;
#pragma unroll
        for (int r = 0; r < NR; ++r) {
            const int mx = row_imax16(c[r][0]);
            const bool pop = c[r][0] == mx;
            c[r][0] = pop ? c[r][1] : c[r][0]; c[r][1] = pop ? c[r][2] : c[r][1]; c[r][2] = pop ? c[r][3] : c[r][2]; c[r][3] = pop ? IKEY_MIN : c[r][3];
            minec[r] = me ? mx : minec[r];
        }
    }
#pragma unroll
    for (int r = 0; r < NR; ++r) wins[(4 * fq + (NR == 4 ? r : rq)) * 16 + fr] = fkey_inv(minec[r]);
    LDS_WAIT();
    if (NR == 4 || (fr >> 2) == rq) {
        const int tk = 4 * fq + (fr >> 2), q4 = fr & 3;
        const float w0 = wins[tk * 16]; float den = 0.f;
#pragma unroll
        for (int rd = 0; rd < 16; ++rd) den += __expf(wins[tk * 16 + rd] - w0);
        const float inv = 1.f / den;
        int e[4]; float g[4];
#pragma unroll
        for (int x = 0; x < 4; ++x) { const float wv = wins[tk * 16 + 4 * q4 + x]; const int kc = (int)(f2u(wv) & 63u); const int i = tab[kc], j = tab[64 + kc];
            e[x] = (int)(f2u(fkey_inv(topl[(tk * 2 + 0) * 16 + i])) & 127u) * 128 + (int)(f2u(fkey_inv(topl[(tk * 2 + 1) * 16 + j])) & 127u); g[x] = __expf(wv - w0) * inv; }
        unsigned short* pei = WSP(unsigned short, WS_PEI) + (size_t)(r0 + tk) * 128 + w * 16 + 4 * q4; float* peg = WSP(float, WS_PEG) + (size_t)(r0 + tk) * 128 + w * 16 + 4 * q4;
        *(v2u*)pei = (v2u){(unsigned)e[0] | ((unsigned)e[1] << 16), (unsigned)e[2] | ((unsigned)e[3] << 16)};
        *(f32x4*)peg = (f32x4){g[0], g[1], g[2], g[3]};
    }
    LDS_WAIT();
    }
}
__device__ __forceinline__ void p8_phase(Frame& F, int layer) {
    p8_init_tab(F);
    for (int ub = F.bid; ub < MP / 16; ub += F.G * P8_MAXU) { const int left = (MP / 16 - ub + F.G - 1) / F.G; p8_run<4>(F, layer, F.wave, 0, ub, F.G, left < P8_MAXU ? left : P8_MAXU); }
    for (int qu = F.bid * 8 + F.wave; qu < (MS / 16) * 8 * 4 * 8; qu += F.G * 8) { if ((qu & 7) == 0) { const int x = qu >> 3; p8_run<1>(F, layer, (x >> 2) & 7, x & 3, MP / 16 + (x >> 5), 0, 1); } }
}

constexpr size_t PE_SLICE_BYTES = (size_t)NEXP * 128;
__device__ __forceinline__ f32x2 p9_cvt(unsigned w, bool hi) { return hi ? __builtin_amdgcn_cvt_pk_f32_fp8((int)w, true) : __builtin_amdgcn_cvt_pk_f32_fp8((int)w, false); }
__device__ __forceinline__ f32x2 fma2(f32x2 a, f32x2 b, f32x2 c) { return __builtin_elementwise_fma(a, b, c); }
__device__ __forceinline__ float p9_dot16(const v4u u, const f32x2 (&h)[8]) {
    f32x2 a = {0.f, 0.f}, b = {0.f, 0.f};
    a = fma2(p9_cvt(u.x, false), h[0], a); b = fma2(p9_cvt(u.x, true), h[1], b); a = fma2(p9_cvt(u.y, false), h[2], a); b = fma2(p9_cvt(u.y, true), h[3], b);
    a = fma2(p9_cvt(u.z, false), h[4], a); b = fma2(p9_cvt(u.z, true), h[5], b); a = fma2(p9_cvt(u.w, false), h[6], a); b = fma2(p9_cvt(u.w, true), h[7], b);
    a = a + b; return a.x + a.y;
}
__device__ __forceinline__ void p9_axpy16(const v4u v, float c, f32x2 (&o)[8]) {
    const f32x2 cc = {c, c};
    o[0] = fma2(p9_cvt(v.x, false), cc, o[0]); o[1] = fma2(p9_cvt(v.x, true), cc, o[1]); o[2] = fma2(p9_cvt(v.y, false), cc, o[2]); o[3] = fma2(p9_cvt(v.y, true), cc, o[3]);
    o[4] = fma2(p9_cvt(v.z, false), cc, o[4]); o[5] = fma2(p9_cvt(v.z, true), cc, o[5]); o[6] = fma2(p9_cvt(v.w, false), cc, o[6]); o[7] = fma2(p9_cvt(v.w, true), cc, o[7]);
}
#define P9_GATHER(S, iw) do { _Pragma("unroll") for (int j_ = 0; j_ < 8; ++j_) { const unsigned w_ = (iw)[j_ >> 1]; const unsigned id_ = (j_ & 1) ? (w_ >> 16) : (w_ & 0xffffu); \
        S[j_] = *(const v4u*)(tab + ((id_ << 7) + sub16)); } } while (0)
__device__ __forceinline__ float swapsum16(float x, float y) { unsigned a = __builtin_bit_cast(unsigned, x), b = __builtin_bit_cast(unsigned, y); PSWAP16(a, b); return __builtin_bit_cast(float, a) + __builtin_bit_cast(float, b); }
__device__ __forceinline__ float swapsum32(float x, float y) { unsigned a = __builtin_bit_cast(unsigned, x), b = __builtin_bit_cast(unsigned, y); PSWAP32(a, b); return __builtin_bit_cast(float, a) + __builtin_bit_cast(float, b); }

__device__ __forceinline__ void p9u_wave(Frame& F, int layer, int slice, int first, int stride) {
    int lane_ = F.lane; asm volatile("" : "+v"(lane_));
    const int lane = lane_, gi = lane >> 3, sub = lane & 7;
    const unsigned char* tab = WSP(unsigned char, WS_PU) + (size_t)(layer * 8 + slice) * PE_SLICE_BYTES;
    const unsigned sub16 = (unsigned)sub * 16u;
    const unsigned char* hbase = (const unsigned char*)(WSP(bf16, WS_XNB) + slice * 128 + sub * 16);
    const unsigned char* ibase = (const unsigned char*)(WSP(unsigned short, WS_PEI) + gi * 16);
    unsigned* pa = WSP(unsigned, WS_PA) + slice * 64 + lane;
    int t = first; if (t >= MTOK) return;
    v4u ia, ib, ha, hb, nia, nib, nha, nhb, A[8], B[8];
#define P9U_META(tt, xa, xb, ya, yb) do { const v4u* ip_ = (const v4u*)(ibase + (size_t)(tt) * 256); xa = ip_[0]; xb = ip_[1]; const v4u* hp_ = (const v4u*)(hbase + (size_t)(tt) * 2048); ya = hp_[0]; yb = hp_[1]; } while (0)
    P9U_META(t, ia, ib, ha, hb);
    P9_GATHER(A, ia);
    const bool b0 = sub & 1, b1 = sub & 2, b2 = sub & 4;
#pragma unroll 1
    for (;;) {
        const int tn = t + stride; const bool more = tn < MTOK; const int tl = more ? tn : t;
        P9U_META(tl, nia, nib, nha, nhb);
        P9_GATHER(B, ib);
        f32x2 h[8];
#pragma unroll
        for (int k = 0; k < 4; ++k) { h[k] = (f32x2){bflo(ha[k]), bfhi(ha[k])}; h[4 + k] = (f32x2){bflo(hb[k]), bfhi(hb[k])}; }
        float p[16];
#pragma unroll
        for (int j = 0; j < 8; ++j) p[j] = p9_dot16(A[j], h);
        P9_GATHER(A, nia);
#pragma unroll
        for (int j = 0; j < 8; ++j) p[8 + j] = p9_dot16(B[j], h);
        float q[8], r[4], sv[2];
#pragma unroll
        for (int i = 0; i < 8; ++i) { const float keep = b2 ? p[8 + i] : p[i], send = b2 ? p[i] : p[8 + i]; q[i] = keep + dpp_f<DPP_HMIR>(send); }
#pragma unroll
        for (int i = 0; i < 4; ++i) { const float keep = b0 ? q[2 * i + 1] : q[2 * i], send = b0 ? q[2 * i] : q[2 * i + 1]; r[i] = keep + dpp_f<DPP_XOR1>(send); }
#pragma unroll
        for (int i = 0; i < 2; ++i) { const float keep = b1 ? r[2 * i + 1] : r[2 * i], send = b1 ? r[2 * i] : r[2 * i + 1]; sv[i] = keep + dpp_f<DPP_XOR2>(send); }
        pa[(size_t)t * 512] = pk2(sv[0], sv[1]);
        if (!more) break;
        t = tn; ia = nia; ib = nib; ha = nha; hb = nhb;
    }
#undef P9U_META
}

__device__ __forceinline__ void p9v_wave(Frame& F, int layer, int slice, int first, int stride, int mode) {
    int lane_ = F.lane; asm volatile("" : "+v"(lane_));
    const int lane = lane_, gi = lane >> 3, sub = lane & 7, j0 = 8 * (sub >> 2) + (sub & 3);
    const unsigned char* tab = WSP(unsigned char, WS_PV) + (size_t)(layer * 8 + slice) * PE_SLICE_BYTES;
    const unsigned sub16 = (unsigned)sub * 16u;
    const unsigned char* ibase = (const unsigned char*)(WSP(unsigned short, WS_PEI) + gi * 16);
    const unsigned* pab = WSP(unsigned, WS_PA) + lane;
    const float* pegb = WSP(float, WS_PEG) + gi * 16 + j0;
    const int eoff = slice * 128 + sub * 16 + gi;
    float* xsb = WSP(float, WS_XS) + eoff;
    int t = first; if (t >= MTOK) return;
    v4u ia, ib, nia, nib, A[8], B[8];
    unsigned pw[8], npw[8]; float g0, g1, ng0, ng1, x0, x1, nx0, nx1;
#define P9V_META(tt, xa, xb, pp, ga, gb, ya, yb) do { const v4u* ip_ = (const v4u*)(ibase + (size_t)(tt) * 256); xa = ip_[0]; xb = ip_[1]; \
        _Pragma("unroll") for (int x_ = 0; x_ < 8; ++x_) pp[x_] = pab[(size_t)(tt) * 512 + x_ * 64]; \
        ga = pegb[(size_t)(tt) * 128]; gb = pegb[(size_t)(tt) * 128 + 4]; ya = xsb[(size_t)(tt) * DM]; yb = xsb[(size_t)(tt) * DM + 8]; } while (0)
    P9V_META(t, ia, ib, pw, g0, g1, x0, x1);
    P9_GATHER(A, ia);
#pragma unroll 1
    for (;;) {
        const int tn = t + stride; const bool more = tn < MTOK; const int tl = more ? tn : t;
        P9V_META(tl, nia, nib, npw, ng0, ng1, nx0, nx1);
        P9_GATHER(B, ib);
        float alo = 0.f, ahi = 0.f;
#pragma unroll
        for (int x = 0; x < 8; ++x) { alo += bflo(pw[x]); ahi += bfhi(pw[x]); }
        const float c0 = gelu_tanh(alo * 0.03125f) * g0 * 0.0625f, c1 = gelu_tanh(ahi * 0.03125f) * g1 * 0.0625f;
        f32x2 o[8];
#pragma unroll
        for (int i = 0; i < 8; ++i) o[i] = (f32x2){0.f, 0.f};
#define P9V_C(j) __builtin_bit_cast(float, __builtin_amdgcn_ds_swizzle(__builtin_bit_cast(int, (((j) >> 2) & 1) ? c1 : c0), ((4 * ((j) >> 3) + ((j) & 3)) << 5) | 0x18))
        { const float cj[8] = {P9V_C(0), P9V_C(1), P9V_C(2), P9V_C(3), P9V_C(4), P9V_C(5), P9V_C(6), P9V_C(7)};
#pragma unroll
          for (int j = 0; j < 8; ++j) p9_axpy16(A[j], cj[j], o); }
        P9_GATHER(A, nia);
        { const float cj[8] = {P9V_C(8), P9V_C(9), P9V_C(10), P9V_C(11), P9V_C(12), P9V_C(13), P9V_C(14), P9V_C(15)};
#pragma unroll
          for (int j = 0; j < 8; ++j) p9_axpy16(B[j], cj[j], o); }
#undef P9V_C
        const bool g0b = lane & 8;
        float q[8], r[4], sv[2];
#pragma unroll
        for (int i = 0; i < 8; ++i) { const float keep = g0b ? o[i].y : o[i].x, send = g0b ? o[i].x : o[i].y; q[i] = keep + dpp_f<DPP_ROR8>(send); }
#pragma unroll
        for (int i = 0; i < 4; ++i) r[i] = swapsum16(q[2 * i], q[2 * i + 1]);
#pragma unroll
        for (int i = 0; i < 2; ++i) sv[i] = swapsum32(r[2 * i], r[2 * i + 1]);
        const float y0 = x0 + sv[0], y1 = x1 + sv[1];
        if (mode == 0) {
            float* xs = xsb + (size_t)t * DM; xs[0] = y0; xs[8] = y1;
            bf16* xn = WSP(bf16, WS_XNA) + (size_t)t * DM + eoff; xn[0] = (bf16)f2bf(y0); xn[8] = (bf16)f2bf(y1);
            const float ss = wave_sum(y0 * y0 + y1 * y1);
            if (lane == 0) WSP(float, WS_SSQ)[(size_t)t * 8 + slice] = ss;
        } else {
            float* y = (t < MP ? F.out + O_YP + (size_t)t * DM : F.out + O_YS + (size_t)(t - MP) * DM) + eoff;
            y[0] = y0; y[8] = y1;
        }
        if (!more) break;
        t = tn; ia = nia; ib = nib; g0 = ng0; g1 = ng1; x0 = nx0; x1 = nx1;
#pragma unroll
        for (int x = 0; x < 8; ++x) pw[x] = npw[x];
    }
#undef P9V_META
}
#undef P9_GATHER

constexpr float QSCALE = 0.125f * 1.4426950408889634f;
constexpr int PP_VT = 0;
__device__ __forceinline__ float rms64(float v) { return 1.f / sqrtf(wave_sum(v * v) * (1.f / 64.f) + EPS); }

__device__ __forceinline__ void pp_q_row(Frame& F, int row, const float* kvq, const float qg) {
    const int lane = F.lane;
    bf16* qn = WSP(bf16, WS_QN) + (size_t)row * 1024;
#pragma unroll 4
    for (int hd = 0; hd < 16; ++hd) { const float v = kvq[NKV + hd * 64 + lane]; qn[hd * 64 + lane] = (bf16)f2bf(v * rms64(v) * qg); }
    if (lane < 48) WSP(float, WS_GATES)[(size_t)row * 48 + lane] = sigmoid_f(kvq[NKV + 1024 + lane]);
}
__device__ __forceinline__ f32x4 rms64x4(f32x4 v) { const float ss = row_sum16((v.x * v.x + v.y * v.y) + (v.z * v.z + v.w * v.w)); return v * (1.f / sqrtf(ss * (1.f / 64.f) + EPS)); }
__device__ __forceinline__ v2u pk4(f32x4 v) { return (v2u){pk2(v.x, v.y), pk2(v.z, v.w)}; }
__device__ __forceinline__ void pp_prompt_tile(Frame& F, int unit) {
    const int lane = F.lane, w = F.wave, b = unit >> 7, t0 = (unit & 127) * 64, g = lane >> 4, d4 = (lane & 15) * 4;
    LAS unsigned char* L = F.lds; asm volatile("" : "+v"(L));
    LAS bf16* vt = (LAS bf16*)(L + PP_VT);
    const f32x4 kg1 = *(const f32x4*)(FIN(16) + 64 + d4), kg2 = *(const f32x4*)(FIN(16) + 128 + d4), qg = *(const f32x4*)(FIN(22) + d4) * QSCALE;
#pragma unroll 1
    for (int rr = 0; rr < 8; ++rr) {
        const int tl = 8 * w + rr, t = t0 + tl, row = b * PT + t;
        const f32x4* kvq = (const f32x4*)(WSP(float, WS_KVQ) + (size_t)row * NKVQ) + lane;
        f32x4 v[6], q[4], gl = {0.f, 0.f, 0.f, 0.f};
#pragma unroll
        for (int sidx = 0; sidx < 6; ++sidx) v[sidx] = kvq[64 * sidx];
#pragma unroll
        for (int i = 0; i < 4; ++i) q[i] = kvq[64 * (6 + i)];
        if (lane < 12) gl = kvq[640];
        const f32x4 ks = rms64x4(v[2]) * kg1, kw = rms64x4(v[4]) * kg2;
        f32x4* okv = (f32x4*)(F.out + O_KVP + (size_t)row * 1024) + lane;
        okv[0] = v[0]; okv[64] = v[1]; okv[128] = ks; okv[192] = v[3];
        if (t >= PT - WINDOW) { f32x4* owin = (f32x4*)(F.out + O_WINP + ((size_t)b * 512 + (t - (PT - WINDOW))) * 512) + lane; owin[0] = kw; owin[64] = v[5]; }
        const size_t kidx = (((size_t)b * NG + g) * PT + t) * 64 + d4;
        *(v2u*)(WSP(bf16, WS_KSEL) + kidx) = pk4(ks); *(v2u*)(WSP(bf16, WS_KWIN) + kidx) = pk4(kw);
#pragma unroll
        for (int j = 0; j < 4; ++j) { vt[((0 * 4 + g) * 64 + d4 + j) * 72 + tl] = (bf16)f2bf(v[3][j]); vt[((1 * 4 + g) * 64 + d4 + j) * 72 + tl] = (bf16)f2bf(v[5][j]); }
        bf16* qn = WSP(bf16, WS_QN) + (size_t)row * 1024 + g * 64 + d4;
#pragma unroll
        for (int i = 0; i < 4; ++i) *(v2u*)(qn + i * 256) = pk4(rms64x4(q[i]) * qg);
        if (lane < 12) *(f32x4*)(WSP(float, WS_GATES) + (size_t)row * 48 + 4 * lane) = (f32x4){sigmoid_f(gl.x), sigmoid_f(gl.y), sigmoid_f(gl.z), sigmoid_f(gl.w)};
    }
    __syncthreads();
    {
        const int which = F.tid >> 8, gd = F.tid & 255;
        bf16* dst = WSP(bf16, which == 0 ? WS_VSELT : WS_VWINT) + (((size_t)b * NG * 64 + gd) * PT + t0);
        const LAS bf16* src = vt + ((which * 256 + gd) * 72);
#pragma unroll
        for (int i = 0; i < 8; ++i) *(v4u*)(dst + 8 * i) = *(const LAS v4u*)(src + 8 * i);
    }
    __syncthreads();
}
__device__ __forceinline__ void pp_sample_row(Frame& F, int sr) {
    const int lane = F.lane, bs = sr >> 2, i = sr & 3, row = MP + sr;
    const float kg1 = FIN(16)[64 + lane], kg2 = FIN(16)[128 + lane], qg = FIN(22)[lane] * QSCALE;
    const float* kvq = WSP(float, WS_KVQ) + (size_t)row * NKVQ;
    float* okv = F.out + O_KVS + (size_t)sr * 1024;
    float* owin = F.out + O_WINS + ((size_t)bs * 512 + 508 + i) * 512;
#pragma unroll
    for (int g = 0; g < 4; ++g) {
        const float v0 = kvq[0 * 256 + g * 64 + lane], v1 = kvq[1 * 256 + g * 64 + lane], v2 = kvq[2 * 256 + g * 64 + lane];
        const float v3 = kvq[3 * 256 + g * 64 + lane], v4 = kvq[4 * 256 + g * 64 + lane], v5 = kvq[5 * 256 + g * 64 + lane];
        const float ks = v2 * rms64(v2) * kg1, kw = v4 * rms64(v4) * kg2;
        okv[0 * 256 + g * 64 + lane] = v0; okv[1 * 256 + g * 64 + lane] = v1; okv[2 * 256 + g * 64 + lane] = ks; okv[3 * 256 + g * 64 + lane] = v3;
        owin[g * 64 + lane] = kw; owin[256 + g * 64 + lane] = v5;
        const size_t bg = (size_t)bs * NG + g;
        WSP(bf16, WS_SKWIN)[(bg * 544 + 512 + i) * 64 + lane] = (bf16)f2bf(kw);
        WSP(bf16, WS_SVWINT)[(bg * 64 + lane) * 544 + 512 + i] = (bf16)f2bf(v5);
        float* sn = WSP(float, WS_SNEW) + (((size_t)bs * 4 + i) * 2) * 256 + g * 64 + lane;
        sn[0] = ks; sn[256] = v3;
    }
    pp_q_row(F, row, kvq, qg);
}

__device__ __forceinline__ void compress_finish(Frame& F, const f32x4 (&acc)[4], int kv, int blk, bf16* KC, bf16* VCT) {
    const int lane = F.lane, fr = lane & 15, fq = lane >> 4;
    const float* pet = WSP(float, WS_PETERM) + kv * 64;
    bf16x8 hb[2];
#pragma unroll
    for (int s = 0; s < 2; ++s) { f32x4 h0, h1;
#pragma unroll
        for (int r = 0; r < 4; ++r) { h0[r] = gelu_tanh(acc[2 * s][r] + pet[16 * (2 * s) + 4 * fq + r]); h1[r] = gelu_tanh(acc[2 * s + 1][r] + pet[16 * (2 * s + 1) + 4 * fq + r]); }
        hb[s] = cvt8(h0, h1); }
    const float* w2 = FIN(19) + (size_t)kv * 64 * 64;
    f32x4 o[4];
#pragma unroll
    for (int dt = 0; dt < 4; ++dt) { o[dt] = (f32x4){0.f, 0.f, 0.f, 0.f};
#pragma unroll
        for (int s = 0; s < 2; ++s) { f32x4 a0, a1;
#pragma unroll
            for (int jj = 0; jj < 4; ++jj) { a0[jj] = w2[(size_t)(16 * (2 * s) + 4 * fq + jj) * 64 + 16 * dt + fr]; a1[jj] = w2[(size_t)(16 * (2 * s + 1) + 4 * fq + jj) * 64 + 16 * dt + fr]; }
            o[dt] = MFMA16(cvt8(a0, a1), hb[s], o[dt]); } }
    if (kv == 0) {
        float ss = 0.f;
#pragma unroll
        for (int dt = 0; dt < 4; ++dt) ss += (o[dt][0] * o[dt][0] + o[dt][1] * o[dt][1]) + (o[dt][2] * o[dt][2] + o[dt][3] * o[dt][3]);
        ss = x32_sum(x16_sum(ss));
        const float rstd = 1.f / sqrtf(ss * (1.f / 64.f) + EPS);
        const float* kg0 = FIN(16);
        if (blk < NCMP) {
#pragma unroll
            for (int dt = 0; dt < 4; ++dt) { const int d = 16 * dt + 4 * fq; v2u ov; ov.x = pk2(o[dt][0] * rstd * kg0[d], o[dt][1] * rstd * kg0[d + 1]); ov.y = pk2(o[dt][2] * rstd * kg0[d + 2], o[dt][3] * rstd * kg0[d + 3]);
                *(v2u*)(KC + (size_t)blk * 64 + d) = ov; }
        } else {
#pragma unroll
            for (int dt = 0; dt < 4; ++dt) *(v2u*)(KC + (size_t)blk * 64 + 16 * dt + 4 * fq) = (v2u){0u, 0u};
        }
    } else {
#pragma unroll
        for (int dt = 0; dt < 4; ++dt)
#pragma unroll
            for (int r = 0; r < 4; ++r) VCT[(size_t)(16 * dt + 4 * fq + r) * 512 + blk] = (blk < NCMP) ? (bf16)f2bf(o[dt][r]) : (bf16)0;
    }
}

template <class RowP>
__device__ __forceinline__ void compress_part(Frame& F, const RowP& rowp, int kv, int j, int r_lo, int r_hi, f32x4 (&acc)[4]) {
    const int lane = F.lane, fr = lane & 15, fq = lane >> 4;
    const bf16* W1 = WSP(bf16, WS_W1T) + (size_t)kv * 64 * 2048 + (size_t)fr * 2048 + 8 * fq;
    const int blk = 16 * j + fr;
#pragma unroll
    for (int mt = 0; mt < 4; ++mt) acc[mt] = (f32x4){0.f, 0.f, 0.f, 0.f};
#pragma unroll 2
    for (int r = r_lo; r < r_hi; ++r) {
        int t = 16 * blk + r; t = t < PAST ? t : PAST - 1;
        const float* rp = rowp(t) + 8 * fq;
#pragma unroll
        for (int hf = 0; hf < 2; ++hf) {
            const f32x4 x0 = *(const f32x4*)(rp + 32 * hf), x1 = *(const f32x4*)(rp + 32 * hf + 4);
            const bf16x8 bfrag = cvt8(x0, x1);
            const int ks = 2 * r + hf;
#pragma unroll
            for (int mt = 0; mt < 4; ++mt) acc[mt] = MFMA16(ld8(W1 + (size_t)mt * 16 * 2048 + 32 * ks), bfrag, acc[mt]);
        }
    }
}
template <class RowP>
__device__ __forceinline__ void compress_tile(Frame& F, const RowP& rowp, int kv, int j, bf16* KC, bf16* VCT) {
    const int lane = F.lane, fr = lane & 15, fq = lane >> 4;
    const bf16* W1 = WSP(bf16, WS_W1T) + (size_t)kv * 64 * 2048 + (size_t)fr * 2048 + 8 * fq;
    const int blk = 16 * j + fr;
    f32x4 acc[4];
#pragma unroll
    for (int mt = 0; mt < 4; ++mt) acc[mt] = (f32x4){0.f, 0.f, 0.f, 0.f};
#pragma unroll 2
    for (int r = 0; r < 32; ++r) {
        int t = 16 * blk + r; t = t < PAST ? t : PAST - 1;
        const float* rp = rowp(t) + 8 * fq;
#pragma unroll
        for (int hf = 0; hf < 2; ++hf) {
            const f32x4 x0 = *(const f32x4*)(rp + 32 * hf), x1 = *(const f32x4*)(rp + 32 * hf + 4);
            const bf16x8 bfrag = cvt8(x0, x1);
            const int ks = 2 * r + hf;
#pragma unroll
            for (int mt = 0; mt < 4; ++mt) acc[mt] = MFMA16(ld8(W1 + (size_t)mt * 16 * 2048 + 32 * ks), bfrag, acc[mt]);
        }
    }
    compress_finish(F, acc, kv, blk, KC, VCT);
}
struct RowPPrompt { const float* base; __device__ __forceinline__ const float* operator()(int t) const { return base + (size_t)t * NKVQ; } };
struct RowPSample { const float* cache; const int* pt; __device__ __forceinline__ const float* operator()(int t) const { return cache + ((size_t)pt[t >> 7] * PAGE + (t & 127)) * 1024; } };

__device__ __forceinline__ void compress_prompt(Frame& F, int id) {
    const int kv = id & 1, j = (id >> 1) & 31, bg = id >> 6, b = bg >> 2, g = bg & 3;
    RowPPrompt rp{WSP(float, WS_KVQ) + (size_t)b * PT * NKVQ + kv * 256 + g * 64};
    compress_tile(F, rp, kv, j, WSP(bf16, WS_KCMP) + (size_t)bg * 512 * 64, WSP(bf16, WS_VCMPT) + (size_t)bg * 64 * 512);
}
constexpr int CP_PART = 81920;
__device__ __forceinline__ void compress_prompt_split(Frame& F, int id) {
    const int kv = id & 1, j = (id >> 1) & 31, bg = id >> 6, b = bg >> 2, g = bg & 3, q = F.wave & 3, lane = F.lane;
    RowPPrompt rp{WSP(float, WS_KVQ) + (size_t)b * PT * NKVQ + kv * 256 + g * 64};
    f32x4 acc[4];
    compress_part(F, rp, kv, j, 8 * q, 8 * q + 8, acc);
    LAS f32x4* part = (LAS f32x4*)(F.lds + CP_PART) + (F.wave >> 2) * 1024;
#pragma unroll
    for (int mt = 0; mt < 4; ++mt) part[(q * 4 + mt) * 64 + lane] = acc[mt];
    __syncthreads();
    if (q == 0) {
#pragma unroll
        for (int mt = 0; mt < 4; ++mt) acc[mt] = (part[(0 * 4 + mt) * 64 + lane] + part[(1 * 4 + mt) * 64 + lane]) + (part[(2 * 4 + mt) * 64 + lane] + part[(3 * 4 + mt) * 64 + lane]);
        compress_finish(F, acc, kv, 16 * j + (lane & 15), WSP(bf16, WS_KCMP) + (size_t)bg * 512 * 64, WSP(bf16, WS_VCMPT) + (size_t)bg * 64 * 512);
    }
    __syncthreads();
}
__device__ __forceinline__ void compress_sample(Frame& F, int id) {
    const int kv = id & 1, j = (id >> 1) & 31, bg = id >> 6, lane = F.lane, fr = lane & 15, fq = lane >> 4;
    const int blk = 16 * j + fr, nb = blk < 511 ? blk + 1 : 511;
    const float* f1 = WSP(float, WS_FS) + ((size_t)bg * 512 + blk) * 256 + kv * 128 + 4 * fq;
    const float* f2 = WSP(float, WS_FS) + ((size_t)bg * 512 + nb) * 256 + kv * 128 + 64 + 4 * fq;
    f32x4 acc[4];
#pragma unroll
    for (int mt = 0; mt < 4; ++mt) acc[mt] = *(const f32x4*)(f1 + 16 * mt) + *(const f32x4*)(f2 + 16 * mt);
    compress_finish(F, acc, kv, blk, WSP(bf16, WS_SKCMP) + (size_t)bg * 512 * 64, WSP(bf16, WS_SVCMPT) + (size_t)bg * 64 * 512);
}

constexpr int NSA_IMP = 0;
constexpr int NSA_Q = 67584;
constexpr int NSA_QLD = 68;
constexpr float LOG2E = 1.4426950408889634f;
#ifndef NSA_SUBUNITS
#define NSA_SUBUNITS 0
#endif
__device__ __forceinline__ float ex2(float x) { return __builtin_amdgcn_exp2f(x); }

struct KvBf16 {
    const bf16* K; const bf16* VT; int ld;
    __device__ __forceinline__ void lane_offsets(int fr, int fq, unsigned& ko, unsigned& vo) const {
        ko = (unsigned)(((8 * (fr >> 2) + (fr & 3)) * 64 + 8 * fq) * 2); vo = (unsigned)((fr * ld + 8 * fq) * 2);
        asm volatile("" : "+v"(ko), "+v"(vo));
    }
    __device__ __forceinline__ bf16x8 kf(int key0, int mt, int ks, unsigned ko) const {
        return *(const bf16x8*)((const char*)K + (size_t)key0 * 128 + (ko + (unsigned)((4 * mt * 64 + 32 * ks) * 2))); }
    __device__ __forceinline__ bf16x8 vf(int key0, int dt, unsigned vo) const {
        return *(const bf16x8*)((const char*)VT + (size_t)key0 * 2 + (vo + (unsigned)(16 * dt * ld * 2))); }
};
struct KvSampleSel {
    const float* cache; const int* pt; const float* snew; int g;
    __device__ __forceinline__ const float* krow(int pos, int slot) const {
        if (pos < PAST) return cache + ((size_t)pt[pos >> 7] * PAGE + (pos & 127)) * 1024 + slot * 256;
        int i = pos - PAST; i = i < 3 ? i : 3; return snew + (size_t)i * 512 + (slot - 2) * 256; }
    __device__ __forceinline__ void lane_offsets(int fr, int fq, unsigned& ko, unsigned& vo) const { ko = (unsigned)(fr | (fq << 8)); vo = ko; asm volatile("" : "+v"(ko), "+v"(vo)); }
    __device__ __forceinline__ bf16x8 kf(int key0, int mt, int ks, unsigned ko) const { const int fr = ko & 255, fq = ko >> 8;
        const float* p = krow(key0 + 8 * (fr >> 2) + 4 * mt + (fr & 3), 2) + 32 * ks + 8 * fq; return cvt8(*(const f32x4*)p, *(const f32x4*)(p + 4)); }
    __device__ __forceinline__ bf16x8 vf(int key0, int dt, unsigned vo) const { const int fr = vo & 255, fq = vo >> 8; f32x4 a, b;
#pragma unroll
        for (int j = 0; j < 4; ++j) { a[j] = krow(key0 + 8 * fq + j, 3)[16 * dt + fr]; b[j] = krow(key0 + 8 * fq + 4 + j, 3)[16 * dt + fr]; }
        return cvt8(a, b); }
};
struct KvFrags { bf16x8 k[2][2]; bf16x8 v[4]; };
template <bool WITHV, class KV>
__device__ __forceinline__ void nsa_load(const KV& kv, int key0, int fr, int fq, KvFrags& f) {
    unsigned ko, vo; kv.lane_offsets(fr, fq, ko, vo);
#pragma unroll
    for (int mt = 0; mt < 2; ++mt)
#pragma unroll
        for (int ks = 0; ks < 2; ++ks) f.k[mt][ks] = kv.kf(key0, mt, ks, ko);
    if (WITHV) {
#pragma unroll
        for (int dt = 0; dt < 4; ++dt) f.v[dt] = kv.vf(key0, dt, vo);
    }
}

template <int NT, int MODE, bool QREG = false>
__device__ __forceinline__ void nsa_core(const KvFrags& f, int key0, const LAS bf16* qrow, int qnt, f32x4 (&O)[NT][4], float (&m)[NT], float (&l)[NT], const float (&invl)[NT], const float (&slope)[NT],
                                         int t, int pmul, int padd, int wlim, bool selok, LAS float* improw, int fq, const bf16x8* qreg = nullptr) {
    float dist[2][4]; bool val[2][4];
#pragma unroll
    for (int mt = 0; mt < 2; ++mt)
#pragma unroll
        for (int r = 0; r < 4; ++r) { const int kk = key0 + 8 * fq + 4 * mt + r; const int dd = t - (pmul * kk + padd); val[mt][r] = selok && dd >= 0 && dd < wlim; dist[mt][r] = val[mt][r] ? (float)dd : 1e6f; }
    float imp_main[2] = {0.f, 0.f}, imp_spill[2] = {0.f, 0.f};
    f32x4 sc[NT][2]; bf16x8 pfr[NT];
#pragma unroll
    for (int nt = 0; nt < NT; ++nt) {
        bf16x8 q0, q1; if (QREG) { q0 = qreg[nt * 2]; q1 = qreg[nt * 2 + 1]; } else { q0 = ld8l(qrow + nt * qnt + 8 * fq); q1 = ld8l(qrow + nt * qnt + 32 + 8 * fq); }
#pragma unroll
        for (int mt = 0; mt < 2; ++mt) { sc[nt][mt] = (f32x4){0.f, 0.f, 0.f, 0.f}; sc[nt][mt] = MFMA16(f.k[mt][0], q0, sc[nt][mt]); sc[nt][mt] = MFMA16(f.k[mt][1], q1, sc[nt][mt]); }
    }
#pragma unroll
    for (int nt = 0; nt < NT; ++nt) {
        f32x4 p[2]; float ps = 0.f;
#pragma unroll
        for (int mt = 0; mt < 2; ++mt)
#pragma unroll
            for (int r = 0; r < 4; ++r) { float pv = ex2(sc[nt][mt][r] - slope[nt] * dist[mt][r]); if (MODE == 2) pv *= invl[nt]; p[mt][r] = pv; ps += pv; }
        if (MODE != 2) l[nt] += ps;
        if (MODE == 2) {
#pragma unroll
            for (int mt = 0; mt < 2; ++mt) { imp_main[mt] += (p[mt][0] + p[mt][1]) + (p[mt][2] + p[mt][3]); imp_spill[mt] += p[mt][3]; }
        }
        if (MODE != 1) pfr[nt] = cvt8(p[0], p[1]);
    }
    if (MODE != 1) {
#pragma unroll
        for (int nt = 0; nt < NT; ++nt)
#pragma unroll
            for (int dt = 0; dt < 4; ++dt) O[nt][dt] = MFMA16(f.v[dt], pfr[nt], O[nt][dt]);
    }
    if (MODE == 2) {
#pragma unroll
        for (int mt = 0; mt < 2; ++mt) { const int j = key0 / 4 + 2 * fq + mt;
            __hip_atomic_fetch_add(improw + j, imp_main[mt], __ATOMIC_RELAXED, __HIP_MEMORY_SCOPE_WORKGROUP);
            __hip_atomic_fetch_add(improw + j + 1, imp_spill[mt], __ATOMIC_RELAXED, __HIP_MEMORY_SCOPE_WORKGROUP); }
    }
}
template <int NT, int MODE, class KV>
__device__ __forceinline__ void nsa_tile(const KV& kv, int key0, const LAS bf16* qrow, int qnt, f32x4 (&O)[NT][4], float (&m)[NT], float (&l)[NT], const float (&invl)[NT], const float (&slope)[NT],
                                         int t, int pmul, int padd, int wlim, bool selok, LAS float* improw, int fr, int fq) {
    KvFrags f; nsa_load<MODE != 1>(kv, key0, fr, fq, f);
    nsa_core<NT, MODE>(f, key0, qrow, qnt, O, m, l, invl, slope, t, pmul, padd, wlim, selok, improw, fq);
}

template <int NT>
__device__ __forceinline__ void nsa_zero(f32x4 (&O)[NT][4], float (&m)[NT], float (&l)[NT]) {
#pragma unroll
    for (int nt = 0; nt < NT; ++nt) { m[nt] = -1e30f; l[nt] = 0.f;
#pragma unroll
        for (int dt = 0; dt < 4; ++dt) O[nt][dt] = (f32x4){0.f, 0.f, 0.f, 0.f}; }
}

template <bool SAMPLE>
__device__ __forceinline__ void nsa_unit(Frame& F, int id) {
    constexpr int NT = SAMPLE ? 1 : 4;
    int lane_ = F.lane; asm volatile("" : "+v"(lane_));
    const int lane = lane_, fr = lane & 15, fq = lane >> 4;
    LAS unsigned char* L = F.lds; asm volatile("" : "+v"(L));
    LAS float* imp = (LAS float*)(L + NSA_IMP + F.wave * 8448);
    LAS bf16* qw = (LAS bf16*)(L + NSA_Q + F.wave * 8704);
    int bg, g, t, row, trow, tmax, row0;
    if (SAMPLE) { bg = id; g = id & 3; t = PAST + (fr >> 2); row0 = MP + (id >> 2) * 4; row = row0 + (fr >> 2); trow = fr >> 2; tmax = PAST + 3; }
    else { bg = id >> 9; g = bg & 3; const int tt = id & 511; t = 16 * tt + fr; row0 = (bg >> 2) * PT + 16 * tt; row = row0 + fr; trow = fr; tmax = 16 * tt + 15; }
    {
        const int nrow = SAMPLE ? 16 : 64;
        for (int i = lane; i < nrow * 8; i += 64) { const int rr = i >> 3, c8 = i & 7;
            *(LAS v4u*)(qw + rr * NSA_QLD + 8 * c8) = *(const v4u*)(WSP(bf16, WS_QN) + (size_t)(row0 + (rr >> 2)) * 1024 + (g * 4 + (rr & 3)) * 64 + 8 * c8); }
    }
    float slope[NT]; int hd[NT];
#pragma unroll
    for (int nt = 0; nt < NT; ++nt) { hd[nt] = g * 4 + (SAMPLE ? (fr & 3) : nt); slope[nt] = ex2(-0.5f * (float)(hd[nt] + 1)) * LOG2E; }
    const LAS bf16* qrow = qw + (SAMPLE ? fr : fr * 4) * NSA_QLD; const int qnt = SAMPLE ? 0 : NSA_QLD;
    const float* gates = WSP(float, WS_GATES) + (size_t)row * 48;
    float* oacc = WSP(float, WS_OACC) + (size_t)row * 1024;
    for (int i = lane; i < 16 * 132; i += 64) imp[i] = 0.f;
    LDS_WAIT();
    f32x4 O[NT][4]; float m[NT], l[NT], invl[NT];
    {
        KvBf16 kv{WSP(bf16, SAMPLE ? WS_SKCMP : WS_KCMP) + (size_t)bg * 512 * 64, WSP(bf16, SAMPLE ? WS_SVCMPT : WS_VCMPT) + (size_t)bg * 64 * 512, 512};
        const int cmax = (tmax - 31) >> 4;
        const int ntile = (tmax >= 31) ? ((cmax < 510 ? cmax : 510) / 32 + 1) : 0;
#pragma unroll
        for (int nt = 0; nt < NT; ++nt) invl[nt] = 0.f;
        nsa_zero<NT>(O, m, l);
        { KvFrags fa, fb; if (ntile > 0) nsa_load<false>(kv, 0, fr, fq, fa);
#pragma unroll 1
          for (int tl = 0; tl < ntile; ++tl) { if (tl + 1 < ntile) nsa_load<false>(kv, 32 * (tl + 1), fr, fq, fb);
            nsa_core<NT, 1>(fa, 32 * tl, qrow, qnt, O, m, l, invl, slope, t, 16, 31, 1 << 30, true, imp + trow * 132, fq); fa = fb; } }
#pragma unroll
        for (int nt = 0; nt < NT; ++nt) { float lt = l[nt]; lt = x32_sum(x16_sum(lt)); invl[nt] = lt > 0.f ? 1.f / lt : 0.f; }
        { KvFrags fa, fb; if (ntile > 0) nsa_load<true>(kv, 0, fr, fq, fa);
#pragma unroll 1
          for (int tl = 0; tl < ntile; ++tl) { if (tl + 1 < ntile) nsa_load<true>(kv, 32 * (tl + 1), fr, fq, fb);
            nsa_core<NT, 2>(fa, 32 * tl, qrow, qnt, O, m, l, invl, slope, t, 16, 31, 1 << 30, true, imp + trow * 132, fq); fa = fb; } }
#pragma unroll
        for (int nt = 0; nt < NT; ++nt) { const float gc = gates[0 * 16 + hd[nt]];
#pragma unroll
            for (int dt = 0; dt < 4; ++dt) *(f32x4*)(oacc + hd[nt] * 64 + 16 * dt + 4 * fq) = O[nt][dt] * gc; }
    }
    LDS_WAIT();
    unsigned selm[4] = {0u, 0u, 0u, 0u};
    {
        const int cur = t >> 6;
        if (!SAMPLE) {
            unsigned v[32];
#pragma unroll
            for (int i = 0; i < 32; ++i) { const int j = 32 * fq + i; const bool forced = (j == 0) | (j == cur) | (j == cur - 1);
                const unsigned key = ((f2u(imp[trow * 132 + j]) & ~127u) | (unsigned)(127 - j)) + 128u;
                v[i] = (!forced && j <= cur) ? key : 0u;
                if (forced) selm[fq] |= 1u << i; }
            unsigned fw = selm[0] | selm[1] | selm[2] | selm[3];
            const unsigned w16 = __shfl_xor(fw, 16), w32 = __shfl_xor(fw, 32), w48 = __shfl_xor(fw, 48);
#pragma unroll
            for (int wd = 0; wd < 4; ++wd) selm[wd] = (fq == wd) ? fw : ((fq ^ 1) == wd) ? w16 : ((fq ^ 2) == wd) ? w32 : w48;
            const int nforced = cur >= 2 ? 3 : cur + 1;
#pragma unroll 1
            for (int rd = 0; rd < 15; ++rd) {
                unsigned mx = v[0];
#pragma unroll
                for (int i = 1; i < 32; ++i) mx = mx > v[i] ? mx : v[i];
                mx = x32_umax(x16_umax(mx));
#pragma unroll
                for (int i = 0; i < 32; ++i) v[i] = (v[i] == mx) ? 0u : v[i];
                if (mx != 0u && rd < 16 - nforced) { const int js = 127 - (int)(mx & 127u);
#pragma unroll
                    for (int wd = 0; wd < 4; ++wd) selm[wd] |= ((js >> 5) == wd) ? (1u << (js & 31)) : 0u; }
            }
        } else {
            const int li = (fr & 3) * 4 + fq;
            unsigned v[8];
#pragma unroll
            for (int i = 0; i < 8; ++i) { const int j = li * 8 + i; v[i] = (j >= 1 && j <= 126) ? (((f2u(imp[trow * 132 + j]) & ~127u) | (unsigned)(127 - j)) + 128u) : 0u; }
            selm[0] = 1u; selm[3] = 1u << 31;
#pragma unroll 1
            for (int rd = 0; rd < 13; ++rd) {
                unsigned mx = v[0];
#pragma unroll
                for (int i = 1; i < 8; ++i) mx = mx > v[i] ? mx : v[i];
                { unsigned o = dpp_u<DPP_XOR1>(mx); mx = mx > o ? mx : o; o = dpp_u<DPP_XOR2>(mx); mx = mx > o ? mx : o; mx = x32_umax(x16_umax(mx)); }
#pragma unroll
                for (int i = 0; i < 8; ++i) v[i] = (v[i] == mx) ? 0u : v[i];
                if (mx != 0u) { const int js = 127 - (int)(mx & 127u);
#pragma unroll
                    for (int wd = 0; wd < 4; ++wd) selm[wd] |= ((js >> 5) == wd) ? (1u << (js & 31)) : 0u; }
            }
        }
    }
    if (SAMPLE || !NSA_SUBUNITS) {
        nsa_zero<NT>(O, m, l);
        unsigned un[4];
#pragma unroll
        for (int wd = 0; wd < 4; ++wd) { unsigned x = selm[wd]; x |= __shfl_xor(x, 1); x |= __shfl_xor(x, 2); x |= __shfl_xor(x, 4); x |= __shfl_xor(x, 8); un[wd] = (unsigned)__builtin_amdgcn_readfirstlane((int)x); }
        KvSampleSel kvs{FIN(2) + g * 64, (const int*)FIN(6) + (SAMPLE ? (id >> 2) : 0) * NPAGES, WSP(float, WS_SNEW) + (size_t)(SAMPLE ? (id >> 2) : 0) * 2048 + g * 64, g};
        KvBf16 kvp{WSP(bf16, WS_KSEL) + (size_t)bg * PT * 64, WSP(bf16, WS_VSELT) + (size_t)bg * 64 * PT, PT};
        if (SAMPLE) {
#pragma unroll 1
        for (int wd = 0; wd < 4; ++wd) {
            unsigned mm = un[wd];
            const unsigned mine = wd == 0 ? selm[0] : wd == 1 ? selm[1] : wd == 2 ? selm[2] : selm[3];
            while (mm) {
                const int bit = __builtin_ctz(mm); mm &= mm - 1u; const int j = 32 * wd + bit;
                const bool ok = (mine >> bit) & 1u;
#pragma unroll 1
                for (int hh = 0; hh < 2; ++hh) { nsa_tile<NT, 0>(kvs, 64 * j + 32 * hh, qrow, qnt, O, m, l, invl, slope, t, 1, 0, 1 << 30, ok, imp, fr, fq); __builtin_amdgcn_sched_barrier(0); }
            }
        }
        } else {
            int wdc = 0; unsigned mmc = un[0];
            while (wdc < 3 && mmc == 0u) { ++wdc; mmc = wdc == 1 ? un[1] : wdc == 2 ? un[2] : un[3]; }
            KvFrags fa, fb; int jc = -1, hc = 0;
            if (mmc) { jc = 32 * wdc + __builtin_ctz(mmc); mmc &= mmc - 1u; nsa_load<true>(kvp, 64 * jc, fr, fq, fa); }
#pragma unroll 1
            while (jc >= 0) {
                int jn = jc, hn = hc + 1;
                if (hn == 2) { hn = 0;
                    while (wdc < 3 && mmc == 0u) { ++wdc; mmc = wdc == 1 ? un[1] : wdc == 2 ? un[2] : un[3]; }
                    if (mmc) { jn = 32 * wdc + __builtin_ctz(mmc); mmc &= mmc - 1u; } else jn = -1; }
                if (jn >= 0) nsa_load<true>(kvp, 64 * jn + 32 * hn, fr, fq, fb);
                const int wj = jc >> 5, bj = jc & 31;
                const unsigned mine = wj == 0 ? selm[0] : wj == 1 ? selm[1] : wj == 2 ? selm[2] : selm[3];
                nsa_core<NT, 0>(fa, 64 * jc + 32 * hc, qrow, qnt, O, m, l, invl, slope, t, 1, 0, 1 << 30, (mine >> bj) & 1u, imp, fq);
                fa = fb; jc = jn; hc = hn;
            }
        }
        if (SAMPLE) nsa_tile<NT, 0>(kvs, 64 * 128, qrow, qnt, O, m, l, invl, slope, t, 1, 0, 1 << 30, true, imp, fr, fq);
#pragma unroll
        for (int nt = 0; nt < NT; ++nt) { float lt = l[nt]; lt = x32_sum(x16_sum(lt)); const float sc = gates[1 * 16 + hd[nt]] / fmaxf(lt, 1e-30f);
#pragma unroll
            for (int dt = 0; dt < 4; ++dt) { f32x4* o = (f32x4*)(oacc + hd[nt] * 64 + 16 * dt + 4 * fq); *o = *o + O[nt][dt] * sc; } }
    } else {
        unsigned ms[4][4];
#pragma unroll
        for (int s = 0; s < 4; ++s)
#pragma unroll
            for (int wd = 0; wd < 4; ++wd) ms[s][wd] = __shfl(selm[wd], 4 * s + (fr >> 2));
        unsigned su[4][4], un[4];
#pragma unroll
        for (int wd = 0; wd < 4; ++wd) { un[wd] = 0u;
#pragma unroll
            for (int s = 0; s < 4; ++s) { unsigned x = ms[s][wd]; x |= __shfl_xor(x, 4); x |= __shfl_xor(x, 8); su[s][wd] = (unsigned)__builtin_amdgcn_readfirstlane((int)x); un[wd] |= su[s][wd]; } }
        const int hds = g * 4 + (fr & 3); float slp[1]; slp[0] = ex2(-0.5f * (float)(hds + 1)) * LOG2E;
        const int tb = (id & 511) * 16 + (fr >> 2);
        f32x4 Os[4][1][4]; float mS[4][1], lS[4][1]; float inv1[1] = {0.f};
#pragma unroll
        for (int s = 0; s < 4; ++s) nsa_zero<1>(Os[s], mS[s], lS[s]);
        KvBf16 kvp{WSP(bf16, WS_KSEL) + (size_t)bg * PT * 64, WSP(bf16, WS_VSELT) + (size_t)bg * 64 * PT, PT};
        int wdc = 0; unsigned mmc = un[0];
        while (wdc < 3 && mmc == 0u) { ++wdc; mmc = wdc == 1 ? un[1] : wdc == 2 ? un[2] : un[3]; }
        KvFrags fa, fb;
        int jc = -1, hc = 0;
        if (mmc) { jc = 32 * wdc + __builtin_ctz(mmc); mmc &= mmc - 1u; nsa_load<true>(kvp, 64 * jc, fr, fq, fa); }
#pragma unroll 1
        while (jc >= 0) {
            int jn = jc, hn = hc + 1;
            if (hn == 2) { hn = 0;
                while (wdc < 3 && mmc == 0u) { ++wdc; mmc = wdc == 1 ? un[1] : wdc == 2 ? un[2] : un[3]; }
                if (mmc) { jn = 32 * wdc + __builtin_ctz(mmc); mmc &= mmc - 1u; } else jn = -1; }
            if (jn >= 0) nsa_load<true>(kvp, 64 * jn + 32 * hn, fr, fq, fb);
            const int wj = jc >> 5, bj = jc & 31;
#pragma unroll
            for (int s = 0; s < 4; ++s) {
                const unsigned suw = wj == 0 ? su[s][0] : wj == 1 ? su[s][1] : wj == 2 ? su[s][2] : su[s][3];
                if ((suw >> bj) & 1u) {
                    const unsigned mw = wj == 0 ? ms[s][0] : wj == 1 ? ms[s][1] : wj == 2 ? ms[s][2] : ms[s][3];
                    nsa_core<1, 0>(fa, 64 * jc + 32 * hc, qw + (16 * s + fr) * NSA_QLD, 0, Os[s], mS[s], lS[s], inv1, slp, tb + 4 * s, 1, 0, 1 << 30, (mw >> bj) & 1u, imp, fq);
                }
            }
            fa = fb; jc = jn; hc = hn;
        }
#pragma unroll
        for (int s = 0; s < 4; ++s) { float lt = lS[s][0]; lt = x32_sum(x16_sum(lt));
            const size_t rs = (size_t)(row0 + 4 * s + (fr >> 2));
            const float sc = WSP(float, WS_GATES)[rs * 48 + 16 + hds] / fmaxf(lt, 1e-30f);
#pragma unroll
            for (int dt = 0; dt < 4; ++dt) { f32x4* o = (f32x4*)(WSP(float, WS_OACC) + rs * 1024 + hds * 64 + 16 * dt + 4 * fq); *o = *o + Os[s][0][dt] * sc; } }
    }
    {
        nsa_zero<NT>(O, m, l);
        KvBf16 kv = SAMPLE ? KvBf16{WSP(bf16, WS_SKWIN) + (size_t)bg * 544 * 64, WSP(bf16, WS_SVWINT) + (size_t)bg * 64 * 544, 544}
                           : KvBf16{WSP(bf16, WS_KWIN) + (size_t)bg * PT * 64, WSP(bf16, WS_VWINT) + (size_t)bg * 64 * PT, PT};
        int k0, k1, padd;
        if (SAMPLE) { k0 = 0; k1 = 544; padd = PAST - WINDOW; }
        else { const int lo = tmax - 15 - (WINDOW - 1); k0 = (lo > 0 ? lo : 0) & ~31; k1 = tmax + 1; padd = 0; }
        { KvFrags fa, fb; nsa_load<true>(kv, k0, fr, fq, fa);
#pragma unroll 1
          for (int kk = k0; kk < k1; kk += 32) { if (kk + 32 < k1) nsa_load<true>(kv, kk + 32, fr, fq, fb);
            nsa_core<NT, 0>(fa, kk, qrow, qnt, O, m, l, invl, slope, t, 1, padd, WINDOW, true, imp, fq); fa = fb; } }
        bf16* on = WSP(bf16, WS_OG) + (size_t)row * 1024;
#pragma unroll
        for (int nt = 0; nt < NT; ++nt) { float lt = l[nt]; lt = x32_sum(x16_sum(lt)); const float sc = gates[2 * 16 + hd[nt]] / fmaxf(lt, 1e-30f);
#pragma unroll
            for (int dt = 0; dt < 4; ++dt) { const f32x4 o = *(const f32x4*)(oacc + hd[nt] * 64 + 16 * dt + 4 * fq) + O[nt][dt] * sc;
                *(v2u*)(on + hd[nt] * 64 + 16 * dt + 4 * fq) = (v2u){pk2(o[0], o[1]), pk2(o[2], o[3])}; } }
    }
}

constexpr int NW_STG = 67584;
constexpr int NW_STG_BYTES = 18432;
constexpr int NW_UN = NW_STG + 2 * NW_STG_BYTES;
struct NwStage { v4u k, v; };
__device__ __forceinline__ void nw_load(const bf16* K, const bf16* VT, int ld, int key0, int tid, NwStage& s) {
    s.k = *(const v4u*)(K + (size_t)(key0 + (tid >> 3)) * 64 + 8 * (tid & 7));
    s.v = *(const v4u*)(VT + (size_t)(tid >> 3) * ld + key0 + 8 * (tid & 7));
}
__device__ __forceinline__ void nw_store(LAS unsigned char* buf, int tid, const NwStage& s) {
    const int kk = tid >> 3, c8 = tid & 7, k32 = kk & 31;
    const int rho = 32 * (kk >> 5) + 16 * ((k32 >> 2) & 1) + 4 * (k32 >> 3) + (k32 & 3);
    *(LAS v4u*)(buf + rho * 144 + c8 * 16) = s.k;
    *(LAS v4u*)(buf + 9216 + kk * 144 + c8 * 16) = s.v;
}
template <bool WITHV>
__device__ __forceinline__ void nw_frags(const LAS unsigned char* buf, int th, int fr, int fq, KvFrags& f) {
#pragma unroll
    for (int mt = 0; mt < 2; ++mt)
#pragma unroll
        for (int ks = 0; ks < 2; ++ks) f.k[mt][ks] = *(const LAS bf16x8*)(buf + (32 * th + 16 * mt + fr) * 144 + (32 * ks + 8 * fq) * 2);
    if (WITHV) {
#pragma unroll
        for (int dt = 0; dt < 4; ++dt) f.v[dt] = *(const LAS bf16x8*)(buf + 9216 + (16 * dt + fr) * 144 + (32 * th + 8 * fq) * 2);
    }
}
#define NW_PIPE(Kp, VTp, ldv, NB, BLK, BODY) do { const int nb_ = (NB); \
        if (nb_ > 0) { NwStage st_; nw_load(Kp, VTp, ldv, BLK(0), F.tid, st_); nw_store(stg, F.tid, st_); } \
        __syncthreads(); \
        _Pragma("unroll 1") for (int ib_ = 0; ib_ < nb_; ++ib_) { \
            NwStage st_; const bool more_ = ib_ + 1 < nb_; if (more_) nw_load(Kp, VTp, ldv, BLK(ib_ + 1), F.tid, st_); \
            const LAS unsigned char* buf_ = stg + (ib_ & 1) * NW_STG_BYTES; const int key0_ = BLK(ib_); \
            BODY(buf_, key0_) \
            if (more_) nw_store(stg + ((ib_ + 1) & 1) * NW_STG_BYTES, F.tid, st_); \
            __syncthreads(); } } while (0)

__device__ __forceinline__ void nsa_wg(Frame& F, int bg, int qb) {
    int lane_ = F.lane; asm volatile("" : "+v"(lane_));
    const int lane = lane_, fr = lane & 15, fq = lane >> 4, w = F.wave, g = bg & 3;
    LAS unsigned char* L = F.lds; asm volatile("" : "+v"(L));
    LAS float* imp = (LAS float*)(L + NSA_IMP + w * 8448);
    LAS unsigned char* stg = L + NW_STG;
    LAS unsigned* wun = (LAS unsigned*)(L + NW_UN); volatile LAS unsigned char* blist = (volatile LAS unsigned char*)(L + NW_UN + 16);
    const int tt = qb * 8 + w, t = 16 * tt + fr, row0 = (bg >> 2) * PT + 16 * tt, row = row0 + fr, tw0 = 16 * tt, tw1 = tw0 + 15;
    float slope[4]; bf16x8 qreg[8];
#pragma unroll
    for (int nt = 0; nt < 4; ++nt) { slope[nt] = ex2(-0.5f * (float)(g * 4 + nt + 1)) * LOG2E;
        const bf16* qp = WSP(bf16, WS_QN) + (size_t)row * 1024 + (g * 4 + nt) * 64 + 8 * fq; qreg[2 * nt] = ld8(qp); qreg[2 * nt + 1] = ld8(qp + 32); }
    const float* gates = WSP(float, WS_GATES) + (size_t)row * 48;
    float* oacc = WSP(float, WS_OACC) + (size_t)row * 1024;
    for (int i = lane; i < 16 * 132; i += 64) imp[i] = 0.f;
    if (F.tid < 4) wun[F.tid] = 0u;
    f32x4 O[4][4]; float m[4], l[4], invl[4];
    {
        const bf16* Kc = WSP(bf16, WS_KCMP) + (size_t)bg * 512 * 64; const bf16* Vc = WSP(bf16, WS_VCMPT) + (size_t)bg * 64 * 512;
        const int cmax = (128 * qb + 127 - 31) >> 4, ncb = (cmax < 510 ? cmax : 510) / 64 + 1;
#pragma unroll
        for (int nt = 0; nt < 4; ++nt) invl[nt] = 0.f;
        nsa_zero<4>(O, m, l);
#define NW_BLK(i) (64 * (i))
#define NW_CMP1(buf, k0) { _Pragma("unroll 1") for (int th = 0; th < 2; ++th) if (16 * ((k0) + 32 * th) + 31 <= tw1) { KvFrags f; nw_frags<false>(buf, th, fr, fq, f); \
            nsa_core<4, 1, true>(f, (k0) + 32 * th, nullptr, 0, O, m, l, invl, slope, t, 16, 31, 1 << 30, true, imp + fr * 132, fq, qreg); } }
        NW_PIPE(Kc, Vc, 512, ncb, NW_BLK, NW_CMP1);
#pragma unroll
        for (int nt = 0; nt < 4; ++nt) { const float lt = x32_sum(x16_sum(l[nt])); invl[nt] = lt > 0.f ? 1.f / lt : 0.f; }
#define NW_CMP2(buf, k0) { _Pragma("unroll 1") for (int th = 0; th < 2; ++th) if (16 * ((k0) + 32 * th) + 31 <= tw1) { KvFrags f; nw_frags<true>(buf, th, fr, fq, f); \
            nsa_core<4, 2, true>(f, (k0) + 32 * th, nullptr, 0, O, m, l, invl, slope, t, 16, 31, 1 << 30, true, imp + fr * 132, fq, qreg); } }
        NW_PIPE(Kc, Vc, 512, ncb, NW_BLK, NW_CMP2);
#pragma unroll
        for (int nt = 0; nt < 4; ++nt) { const float gc = gates[0 * 16 + g * 4 + nt];
#pragma unroll
            for (int dt = 0; dt < 4; ++dt) *(f32x4*)(oacc + (g * 4 + nt) * 64 + 16 * dt + 4 * fq) = O[nt][dt] * gc; }
    }
    LDS_WAIT();
    unsigned selm[4] = {0u, 0u, 0u, 0u};
    {
        const int cur = t >> 6;
        unsigned v[32];
#pragma unroll
        for (int i = 0; i < 32; ++i) { const int j = 32 * fq + i; const bool forced = (j == 0) | (j == cur) | (j == cur - 1);
            const unsigned key = ((f2u(imp[fr * 132 + j]) & ~127u) | (unsigned)(127 - j)) + 128u;
            v[i] = (!forced && j <= cur) ? key : 0u;
            if (forced) selm[fq] |= 1u << i; }
        unsigned fw = selm[0] | selm[1] | selm[2] | selm[3];
        const unsigned w16 = __shfl_xor(fw, 16), w32 = __shfl_xor(fw, 32), w48 = __shfl_xor(fw, 48);
#pragma unroll
        for (int wd = 0; wd < 4; ++wd) selm[wd] = (fq == wd) ? fw : ((fq ^ 1) == wd) ? w16 : ((fq ^ 2) == wd) ? w32 : w48;
        const int nforced = cur >= 2 ? 3 : cur + 1;
#pragma unroll 1
        for (int rd = 0; rd < 15; ++rd) {
            unsigned mx = v[0];
#pragma unroll
            for (int i = 1; i < 32; ++i) mx = mx > v[i] ? mx : v[i];
            mx = x32_umax(x16_umax(mx));
#pragma unroll
            for (int i = 0; i < 32; ++i) v[i] = (v[i] == mx) ? 0u : v[i];
            if (mx != 0u && rd < 16 - nforced) { const int js = 127 - (int)(mx & 127u);
#pragma unroll
                for (int wd = 0; wd < 4; ++wd) selm[wd] |= ((js >> 5) == wd) ? (1u << (js & 31)) : 0u; }
        }
    }
    unsigned un[4];
#pragma unroll
    for (int wd = 0; wd < 4; ++wd) { unsigned x = selm[wd]; x |= dpp_u<DPP_XOR1>(x); x |= dpp_u<DPP_XOR2>(x); x |= dpp_u<DPP_HMIR>(x); x |= dpp_u<DPP_MIR>(x); un[wd] = (unsigned)__builtin_amdgcn_readfirstlane((int)x); }
    if (lane < 4) __hip_atomic_fetch_or(wun + lane, lane == 0 ? un[0] : lane == 1 ? un[1] : lane == 2 ? un[2] : un[3], __ATOMIC_RELAXED, __HIP_MEMORY_SCOPE_WORKGROUP);
    __syncthreads();
    unsigned wu[4];
#pragma unroll
    for (int wd = 0; wd < 4; ++wd) wu[wd] = (unsigned)__builtin_amdgcn_readfirstlane((int)wun[wd]);
    {
        nsa_zero<4>(O, m, l);
        const bf16* Ks = WSP(bf16, WS_KSEL) + (size_t)bg * PT * 64; const bf16* Vs = WSP(bf16, WS_VSELT) + (size_t)bg * 64 * PT;
        const int nsb = __builtin_popcount(wu[0]) + __builtin_popcount(wu[1]) + __builtin_popcount(wu[2]) + __builtin_popcount(wu[3]);
        if (F.tid < 128) { const int j = F.tid, wj = j >> 5, bj = j & 31; const unsigned ww = wj == 0 ? wu[0] : wj == 1 ? wu[1] : wj == 2 ? wu[2] : wu[3];
            if ((ww >> bj) & 1u) { int pos = __builtin_popcount(ww & ((1u << bj) - 1u)); if (wj > 0) pos += __builtin_popcount(wu[0]); if (wj > 1) pos += __builtin_popcount(wu[1]); if (wj > 2) pos += __builtin_popcount(wu[2]);
                blist[pos] = (unsigned char)j; } }
        __syncthreads();
#define NW_SBLK(i) (64 * (int)blist[(i)])
#define NW_SEL(buf, k0) { const int j_ = (k0) >> 6, wj_ = j_ >> 5, bj_ = j_ & 31; const unsigned uw_ = wj_ == 0 ? un[0] : wj_ == 1 ? un[1] : wj_ == 2 ? un[2] : un[3]; \
            if ((uw_ >> bj_) & 1u) { const unsigned mine_ = wj_ == 0 ? selm[0] : wj_ == 1 ? selm[1] : wj_ == 2 ? selm[2] : selm[3]; const bool ok_ = (mine_ >> bj_) & 1u; \
                _Pragma("unroll 1") for (int th = 0; th < 2; ++th) { KvFrags f; nw_frags<true>(buf, th, fr, fq, f); \
                    nsa_core<4, 0, true>(f, (k0) + 32 * th, nullptr, 0, O, m, l, invl, slope, t, 1, 0, 1 << 30, ok_, imp, fq, qreg); } } }
        NW_PIPE(Ks, Vs, PT, nsb, NW_SBLK, NW_SEL);
#pragma unroll
        for (int nt = 0; nt < 4; ++nt) { const float lt = x32_sum(x16_sum(l[nt])); const float sc = gates[1 * 16 + g * 4 + nt] / fmaxf(lt, 1e-30f);
#pragma unroll
            for (int dt = 0; dt < 4; ++dt) { f32x4* o = (f32x4*)(oacc + (g * 4 + nt) * 64 + 16 * dt + 4 * fq); *o = *o + O[nt][dt] * sc; } }
    }
    {
        nsa_zero<4>(O, m, l);
        const bf16* Kw = WSP(bf16, WS_KWIN) + (size_t)bg * PT * 64; const bf16* Vw = WSP(bf16, WS_VWINT) + (size_t)bg * 64 * PT;
        const int lo = 128 * qb - (WINDOW - 1), kb0 = (lo > 0 ? lo : 0) >> 6, kb1 = (128 * qb + 127) >> 6, nwb = kb1 - kb0 + 1;
#define NW_WBLK(i) (64 * (kb0 + (i)))
#define NW_WIN(buf, k0) { _Pragma("unroll 1") for (int th = 0; th < 2; ++th) { const int kk_ = (k0) + 32 * th; if (kk_ <= tw1 && kk_ + 31 >= tw0 - (WINDOW - 1)) { KvFrags f; nw_frags<true>(buf, th, fr, fq, f); \
                nsa_core<4, 0, true>(f, kk_, nullptr, 0, O, m, l, invl, slope, t, 1, 0, WINDOW, true, imp, fq, qreg); } } }
        NW_PIPE(Kw, Vw, PT, nwb, NW_WBLK, NW_WIN);
        bf16* on = WSP(bf16, WS_OG) + (size_t)row * 1024;
#pragma unroll
        for (int nt = 0; nt < 4; ++nt) { const float lt = x32_sum(x16_sum(l[nt])); const float sc = gates[2 * 16 + g * 4 + nt] / fmaxf(lt, 1e-30f);
#pragma unroll
            for (int dt = 0; dt < 4; ++dt) { const f32x4 o = *(const f32x4*)(oacc + (g * 4 + nt) * 64 + 16 * dt + 4 * fq) + O[nt][dt] * sc;
                *(v2u*)(on + (g * 4 + nt) * 64 + 16 * dt + 4 * fq) = (v2u){pk2(o[0], o[1]), pk2(o[2], o[3])}; } }
    }
    __syncthreads();
}

constexpr int SW_Q = 0;
constexpr int SW_IMPP = 2304;
constexpr int SW_IMPT = SW_IMPP + 8 * 2112;
constexpr int SW_LP = SW_IMPT + 2112;
constexpr int SW_OP = SW_LP + 3 * 8 * 16 * 4;
static_assert(SW_OP + 8 * 3 * 16 * 64 * 4 <= RING_BYTES, "sample NSA LDS map");
__device__ __forceinline__ void nsa_sample_wg(Frame& F, int id) {
    int lane_ = F.lane; asm volatile("" : "+v"(lane_));
    const int lane = lane_, fr = lane & 15, fq = lane >> 4, w = F.wave, g = id & 3, bs = id >> 2;
    LAS unsigned char* L = F.lds; asm volatile("" : "+v"(L));
    LAS bf16* qw = (LAS bf16*)(L + SW_Q);
    LAS float* impP = (LAS float*)(L + SW_IMPP) + w * 528; LAS float* impT = (LAS float*)(L + SW_IMPT);
    LAS float* LP = (LAS float*)(L + SW_LP); LAS float* OP = (LAS float*)(L + SW_OP);
    const int t = PAST + (fr >> 2), row0 = MP + bs * 4, trow = fr >> 2, hd = g * 4 + (fr & 3);
    if (F.tid < 128) { const int rr = F.tid >> 3, c8 = F.tid & 7;
        *(LAS v4u*)(qw + rr * NSA_QLD + 8 * c8) = *(const v4u*)(WSP(bf16, WS_QN) + (size_t)(row0 + (rr >> 2)) * 1024 + (g * 4 + (rr & 3)) * 64 + 8 * c8); }
    for (int i = lane; i < 528; i += 64) impP[i] = 0.f;
    __syncthreads();
    float slope[1] = {ex2(-0.5f * (float)(hd + 1)) * LOG2E};
    const LAS bf16* qrow = qw + fr * NSA_QLD;
    f32x4 O[1][4]; float m[1], l[1], invl[1] = {0.f};
#define SW_PUT_O(br) { _Pragma("unroll") for (int dt = 0; dt < 4; ++dt) *(LAS f32x4*)(OP + ((w * 3 + (br)) * 16 + fr) * 64 + 16 * dt + 4 * fq) = O[0][dt]; }
#define SW_PUT_L(br) { const float lt_ = x32_sum(x16_sum(l[0])); if (fq == 0) LP[((br) * 8 + w) * 16 + fr] = lt_; }
    {
        KvBf16 kv{WSP(bf16, WS_SKCMP) + (size_t)id * 512 * 64, WSP(bf16, WS_SVCMPT) + (size_t)id * 64 * 512, 512};
        nsa_zero<1>(O, m, l);
#pragma unroll 1
        for (int tl = w; tl < 16; tl += 8) nsa_tile<1, 1>(kv, 32 * tl, qrow, 0, O, m, l, invl, slope, t, 16, 31, 1 << 30, true, impP + trow * 132, fr, fq);
        SW_PUT_L(0)
        __syncthreads();
        { float lt = 0.f;
#pragma unroll
          for (int ww = 0; ww < 8; ++ww) lt += LP[(0 * 8 + ww) * 16 + fr];
          invl[0] = lt > 0.f ? 1.f / lt : 0.f; }
#pragma unroll 1
        for (int tl = w; tl < 16; tl += 8) nsa_tile<1, 2>(kv, 32 * tl, qrow, 0, O, m, l, invl, slope, t, 16, 31, 1 << 30, true, impP + trow * 132, fr, fq);
        SW_PUT_O(0)
    }
    __syncthreads();
    for (int i = F.tid; i < 528; i += 512) { float s = 0.f;
#pragma unroll
        for (int ww = 0; ww < 8; ++ww) s += ((LAS float*)(L + SW_IMPP))[ww * 528 + i];
        impT[i] = s; }
    __syncthreads();
    unsigned selm[4] = {1u, 0u, 0u, 1u << 31};
    {
        const int li = (fr & 3) * 4 + fq;
        unsigned v[8];
#pragma unroll
        for (int i = 0; i < 8; ++i) { const int j = li * 8 + i; v[i] = (j >= 1 && j <= 126) ? (((f2u(impT[trow * 132 + j]) & ~127u) | (unsigned)(127 - j)) + 128u) : 0u; }
#pragma unroll 1
        for (int rd = 0; rd < 13; ++rd) {
            unsigned mx = v[0];
#pragma unroll
            for (int i = 1; i < 8; ++i) mx = mx > v[i] ? mx : v[i];
            { unsigned o = dpp_u<DPP_XOR1>(mx); mx = mx > o ? mx : o; o = dpp_u<DPP_XOR2>(mx); mx = mx > o ? mx : o; mx = x32_umax(x16_umax(mx)); }
#pragma unroll
            for (int i = 0; i < 8; ++i) v[i] = (v[i] == mx) ? 0u : v[i];
            if (mx != 0u) { const int js = 127 - (int)(mx & 127u);
#pragma unroll
                for (int wd = 0; wd < 4; ++wd) selm[wd] |= ((js >> 5) == wd) ? (1u << (js & 31)) : 0u; }
        }
    }
    {
        nsa_zero<1>(O, m, l);
        unsigned un[4];
#pragma unroll
        for (int wd = 0; wd < 4; ++wd) { unsigned x = selm[wd]; x |= dpp_u<DPP_XOR1>(x); x |= dpp_u<DPP_XOR2>(x); x |= dpp_u<DPP_HMIR>(x); x |= dpp_u<DPP_MIR>(x); un[wd] = (unsigned)__builtin_amdgcn_readfirstlane((int)x); }
        KvSampleSel kvs{FIN(2) + g * 64, (const int*)FIN(6) + bs * NPAGES, WSP(float, WS_SNEW) + (size_t)bs * 2048 + g * 64, g};
        int q = 0;
#pragma unroll 1
        for (int wd = 0; wd < 4; ++wd) {
            unsigned mm = un[wd];
            const unsigned mine = wd == 0 ? selm[0] : wd == 1 ? selm[1] : wd == 2 ? selm[2] : selm[3];
            while (mm) {
                const int bit = __builtin_ctz(mm); mm &= mm - 1u; const int j = 32 * wd + bit;
                const bool ok = (mine >> bit) & 1u;
#pragma unroll 1
                for (int hh = 0; hh < 2; ++hh, ++q) if ((q & 7) == w) { nsa_tile<1, 0>(kvs, 64 * j + 32 * hh, qrow, 0, O, m, l, invl, slope, t, 1, 0, 1 << 30, ok, impP, fr, fq); __builtin_amdgcn_sched_barrier(0); }
            }
        }
        if ((q & 7) == w) nsa_tile<1, 0>(kvs, 64 * 128, qrow, 0, O, m, l, invl, slope, t, 1, 0, 1 << 30, true, impP, fr, fq);
        SW_PUT_O(1) SW_PUT_L(1)
    }
    {
        nsa_zero<1>(O, m, l);
        KvBf16 kv{WSP(bf16, WS_SKWIN) + (size_t)id * 544 * 64, WSP(bf16, WS_SVWINT) + (size_t)id * 64 * 544, 544};
#pragma unroll 1
        for (int kk = 32 * w; kk < 544; kk += 256) nsa_tile<1, 0>(kv, kk, qrow, 0, O, m, l, invl, slope, t, 1, PAST - WINDOW, WINDOW, true, impP, fr, fq);
        SW_PUT_O(2) SW_PUT_L(2)
    }
    __syncthreads();
    {
        const int r = F.tid >> 5, d0 = (F.tid & 31) * 2, rowg = row0 + (r >> 2), hdr = g * 4 + (r & 3);
        float o0 = 0.f, o1 = 0.f;
#pragma unroll
        for (int br = 0; br < 3; ++br) { float a0 = 0.f, a1 = 0.f, lt = 0.f;
#pragma unroll
            for (int ww = 0; ww < 8; ++ww) { const f32x2 x = *(const LAS f32x2*)(OP + ((ww * 3 + br) * 16 + r) * 64 + d0); a0 += x.x; a1 += x.y; if (br > 0) lt += LP[(br * 8 + ww) * 16 + r]; }
            const float sc = WSP(float, WS_GATES)[(size_t)rowg * 48 + br * 16 + hdr] * (br == 0 ? 1.f : 1.f / fmaxf(lt, 1e-30f));
            o0 += a0 * sc; o1 += a1 * sc; }
        *(unsigned*)(WSP(bf16, WS_OG) + (size_t)rowg * 1024 + hdr * 64 + d0) = pk2(o0, o1);
    }
    __syncthreads();
#undef SW_PUT_O
#undef SW_PUT_L
}


#ifndef MK_SINGLE
#define MK_SINGLE 1
#endif
constexpr int NPHASE = 21;
struct Args { const float* in[29]; float* out; unsigned char* ws; int ph_lo, ph_hi; };
static_assert(sizeof(Args) == 31 * 8 + 8, "Args has no padding");

__global__ void __launch_bounds__(512, 2) mk_fwd(Args args) {
    extern __shared__ __attribute__((aligned(16))) unsigned char lds_raw[];
    Frame F;
    F.lds = (LAS unsigned char*)lds_raw;
    F.tid = threadIdx.x; F.lane = F.tid & 63; F.wave = __builtin_amdgcn_readfirstlane(F.tid >> 6);
    F.G = gridDim.x; F.bid = blockIdx.x;
    F.ka = (const __attribute__((address_space(4))) char*)__builtin_amdgcn_kernarg_segment_ptr();
    F.out = args.out; F.ws = args.ws;
    volatile LAS unsigned* MISC = (volatile LAS unsigned*)(F.lds + MISC_OFF);
    for (int u = F.tid; u < (LDS_BYTES - LDSCTL_OFF) / 4; u += 512) ((LAS unsigned*)(F.lds + LDSCTL_OFF))[u] = 0u;
    __syncthreads();
    unsigned* barw = (unsigned*)(F.ws + WS_CTL) + 4096;
    XcdBarrier bar; bar.bar = barw; bar.x = 0; bar.st = nullptr;
    const int lo = args.ph_lo, hi = args.ph_hi;
    if (hi - lo > 1) bar = xcd_barrier_post(barw, MISC + 8);
#ifndef PH_MASK
#define PH_MASK 0xFFFFFFFFu
#endif
#define IN(k) (((PH_MASK >> (k)) & 1u) && lo <= (k) && (k) < hi)
#define SEAM(k) do { if (IN(k) && IN((k) + 1)) xcd_barrier(bar); } while (0)
    const int gw = F.bid * 8 + F.wave, NGW = F.G * 8;

#ifndef REPX
#define REPX 0
#endif
#ifndef REPY
#define REPY 0
#endif
#ifndef REP_MASK
#define REP_MASK 0u
#endif
#define PHASE(k, ...) if (IN(k)) { _Pragma("unroll 1") for (int rep_ = 0; rep_ < (int)((REP_MASK >> (k)) & 1u) + 1; ++rep_) { if (rep_) xcd_barrier(bar); __VA_ARGS__ } } SEAM(k);
    PHASE(0, p0_prologue(F);)
    if (IN(1) && F.G != 256) { for (int task = F.bid; task < 512; task += F.G) fs_direct_task(F, task); }
    if (IN(1) && IN(2) && F.G != 256) xcd_barrier(bar);
    PHASE(2, gemm_all(F, WSP(bf16, WS_XNA), WSP(bf16, WS_WIN_T), 4096, FnBf16{WSP(bf16, WS_PROJ), 4096});)
    PHASE(3, for (int u = F.bid; u < 2048 + 256; u += F.G) { if (u < 2048) p2_chunk(F, u); else p2_sample(F, u - 2048); })
    PHASE(4, if (F.G == 256) { const int x = F.bid & 7, idx = F.bid >> 3;
                 if (idx < 8) p3_scan(F, x * 2 + (idx >> 2), idx & 3);
                 else { const int j = (idx - 8) * 8 + x;
                        const size_t n8 = (size_t)2 * NEXP * DM / 8; const int p0 = j < 128 ? 6 * j : 768 + 13 * (j - 128), p1 = p0 + (j < 128 ? 6 : 13);
                        peer_tables_to_fp8(F, (size_t)F.tid, (size_t)512, n8 * p0 / 1600, n8 * p1 / 1600);
                        __syncthreads();
                        for (int task = j; task < 512; task += 192) fs_direct_task(F, task); } }
             else { for (int u = F.bid; u < 64; u += F.G) p3_scan(F, u >> 2, u & 3); })
    PHASE(5, for (int r = gw; r < MTOK; r += NGW) p4_row(F, r);
             for (int id = gw; id < 8192; id += NGW) compress_sample(F, id);)
    PHASE(6, gemm_all(F, WSP(bf16, WS_OG), WSP(bf16, WS_WOA_T), 1024, FnResid{WSP(float, WS_XS), FIN(0), FIN(1)});)
    PHASE(7, for (int r = gw; r < MTOK; r += NGW) rms_row_to_bf16(WSP(float, WS_XS) + (size_t)r * DM, WSP(bf16, WS_XNB) + (size_t)r * DM, F.lane);)
    PHASE(8, gemm_all(F, WSP(bf16, WS_XNB), WSP(bf16, WS_WPQ_T), 2048, FnBf16{WSP(bf16, WS_QPEER), 2048});)
    PHASE(9, p8_phase(F, 0);)
    int pg_slice = F.bid & 7, pg_first = (F.bid >> 3) * 8 + F.wave, pg_stride = ((F.G - (F.bid & 7) + 7) >> 3) * 8;
#define PEER_GROUPS() do { if (MISC[8 + 3] != 0u && (F.G & 7) == 0) { const unsigned c_ = xb_ld(&barw[XB_XCNT(F.lane & 15)]); const bool ok_ = (F.lane & 15) < 8 ? c_ == (unsigned)(F.G >> 3) : c_ == 0u; \
        if (__builtin_amdgcn_ballot_w64(ok_) == ~0ull && bar.x < 8u) { pg_slice = (int)bar.x; pg_first = (int)MISC[8 + 2] * 8 + F.wave; pg_stride = F.G; } } } while (0)
    PHASE(10, PEER_GROUPS(); p9u_wave(F, 0, pg_slice, pg_first, pg_stride);)
    PHASE(11, PEER_GROUPS(); p9v_wave(F, 0, pg_slice, pg_first, pg_stride, 0);)
    PHASE(12, gemm_all(F, WSP(bf16, WS_XNA), WSP(bf16, WS_WKVQ_T), NKVQ, FnKvq{WSP(float, WS_KVQ), WSP(float, WS_SSQ)});)
    PHASE(13, for (int u = F.bid; u < 256; u += F.G) pp_prompt_tile(F, u);
              if (F.G == 256) { compress_prompt_split(F, F.bid * 2 + (F.wave >> 2)); if (F.wave == 7 && F.bid < MS) pp_sample_row(F, F.bid); }
              else { for (int r = gw; r < MS; r += NGW) pp_sample_row(F, r); for (int id = gw; id < 512; id += NGW) compress_prompt(F, id); })
    PHASE(14, if (F.G == 256) {
                  _Pragma("unroll 1") for (int q_ = 0; q_ < 1 + REPX; ++q_) { if (F.bid < 128) nsa_sample_wg(F, F.bid); }
                  __syncthreads();
                  nsa_wg(F, F.bid & 7, F.bid >> 3); nsa_wg(F, F.bid & 7, 63 - (F.bid >> 3));
              } else { for (int id = gw; id < 128 + 4096; id += NGW) { if (id < 128) nsa_unit<true>(F, id); else nsa_unit<false>(F, id - 128); } })
    PHASE(15, gemm_all(F, WSP(bf16, WS_OG), WSP(bf16, WS_WOB_T), 1024, FnResid{WSP(float, WS_XS), WSP(float, WS_XS), WSP(float, WS_XS) + (size_t)MP * DM});)
    PHASE(16, for (int r = gw; r < MTOK; r += NGW) rms_row_to_bf16(WSP(float, WS_XS) + (size_t)r * DM, WSP(bf16, WS_XNB) + (size_t)r * DM, F.lane);)
    PHASE(17, gemm_all(F, WSP(bf16, WS_XNB), WSP(bf16, WS_WPQ_T) + (size_t)2048 * 1024, 2048, FnBf16{WSP(bf16, WS_QPEER), 2048});)
    PHASE(18, p8_phase(F, 1);)
    PHASE(19, PEER_GROUPS(); p9u_wave(F, 1, pg_slice, pg_first, pg_stride);)
    PHASE(20, PEER_GROUPS(); p9v_wave(F, 1, pg_slice, pg_first, pg_stride, 1);)
#undef IN
#undef SEAM
}

extern "C" void kernel_launch(void* const* d_in, const int* in_sizes, int n_in, void* d_out, int out_size, void* d_ws, size_t ws_size, hipStream_t stream) {
    static int grid = 0;
    if (grid == 0) {
        if (n_in != 29 || (size_t)out_size != O_END || ws_size < WS_END) { fprintf(stderr, "kernel_launch: unexpected shapes n_in %d out %d ws %zu (need %zu)\n", n_in, out_size, ws_size, (size_t)WS_END); grid = -1; return; }
        int dev = 0, cus = 0, per_cu = 0;
        if (hipGetDevice(&dev) != hipSuccess || hipDeviceGetAttribute(&cus, hipDeviceAttributeMultiprocessorCount, dev) != hipSuccess) { grid = -1; return; }
        if (hipFuncSetAttribute((const void*)mk_fwd, hipFuncAttributeMaxDynamicSharedMemorySize, LDS_BYTES) != hipSuccess) { fprintf(stderr, "kernel_launch: hipFuncSetAttribute failed\n"); grid = -1; return; }
        if (hipOccupancyMaxActiveBlocksPerMultiprocessor(&per_cu, (const void*)mk_fwd, 512, LDS_BYTES) != hipSuccess || per_cu < 1) fprintf(stderr, "kernel_launch: occupancy query reports %d\n", per_cu);
        (void)hipGetLastError();
        grid = cus;
    }
    if (grid < 0) return;
    if (hipMemsetAsync((char*)d_ws + WS_CTL, 0, CTL_BYTES, stream) != hipSuccess) return;
    Args a{};
    for (int i = 0; i < 29; ++i) a.in[i] = (const float*)d_in[i];
    a.out = (float*)d_out; a.ws = (unsigned char*)d_ws;
#if MK_SINGLE
    a.ph_lo = 0; a.ph_hi = NPHASE;
    hipLaunchKernelGGL(mk_fwd, dim3(grid), dim3(512), LDS_BYTES, stream, a);
#else
    for (int p = 0; p < NPHASE; ++p) { a.ph_lo = p; a.ph_hi = p + 1; hipLaunchKernelGGL(mk_fwd, dim3(grid), dim3(512), LDS_BYTES, stream, a); }
#endif
    const hipError_t le = hipPeekAtLastError();
    if (le != hipSuccess) fprintf(stderr, "kernel_launch: launch failed: %s\n", hipGetErrorName(le));
}
```

```cpp
#include <hip/hip_runtime.h>
#include <cstdio>
#include <cstdint>

constexpr int DM = 1024, PB = 2, PT = 8192, SB = 32, SL = 4, PAST = 8192, PAGE = 128;
constexpr int MP = PB * PT;
constexpr int MS = SB * SL;
constexpr int MTOK = MP + MS;
constexpr int GH = 8, GDK = 128, GDV = 128, GCONV = 3072, GPROJ = 4112, CHUNK = 64, NCH = PT / CHUNK;
constexpr int NH = 16, NG = 4, HPG = 4, DH = 64, NQG = 1072, NKV = 1536, NKVQ = 2816, NKVQ_REAL = 2608;
constexpr int WINDOW = 512, NSELP = 128, NSELS = 129, NCMP = 511;
constexpr int PEH = 8, PEDQ = 256, PEHALF = 128, NKEYS = 128, NEXP = 16384, PETOP = 16;
constexpr int NPAGES = PAST / PAGE;
constexpr float EPS = 1e-6f;

constexpr size_t O_YP = 0;
constexpr size_t O_YS = O_YP + (size_t)MP * DM;
constexpr size_t O_KVP = O_YS + (size_t)MS * DM;
constexpr size_t O_WINP = O_KVP + (size_t)MP * 1024;
constexpr size_t O_GDNP = O_WINP + (size_t)PB * 512 * 512;
constexpr size_t O_CONVP = O_GDNP + (size_t)PB * GH * 128 * 128;
constexpr size_t O_KVS = O_CONVP + (size_t)PB * 3 * GCONV;
constexpr size_t O_WINS = O_KVS + (size_t)MS * 1024;
constexpr size_t O_GDNS = O_WINS + (size_t)SB * 512 * 512;
constexpr size_t O_CONVS = O_GDNS + (size_t)SB * GH * 128 * 128;
constexpr size_t O_END = O_CONVS + (size_t)SB * 3 * GCONV;

constexpr size_t MiB = 1u << 20;
constexpr size_t al(size_t x) { return (x + 4095) & ~(size_t)4095; }
constexpr size_t WS_CTL = 0, CTL_BYTES = 1 * MiB;
constexpr size_t WS_WIN_T = WS_CTL + CTL_BYTES;
constexpr size_t WS_WOA_T = WS_WIN_T + (size_t)4096 * 1024 * 2;
constexpr size_t WS_WKVQ_T = WS_WOA_T + (size_t)1024 * 1024 * 2;
constexpr size_t WS_WOB_T = WS_WKVQ_T + (size_t)NKVQ * 1024 * 2;
constexpr size_t WS_WPQ_T = WS_WOB_T + (size_t)1024 * 1024 * 2;
constexpr size_t WS_WAB = WS_WPQ_T + (size_t)2 * 2048 * 1024 * 2;
constexpr size_t WS_SUBK = WS_WAB + (size_t)16 * 1024 * 4;
constexpr size_t WS_W1T = WS_SUBK + (size_t)2 * 8 * 2 * 128 * 128 * 2;
constexpr size_t WS_PETERM = WS_W1T + (size_t)2 * 128 * 1024 * 2;
constexpr size_t WS_PU = al(WS_PETERM + 512);
constexpr size_t WS_PV = WS_PU + (size_t)2 * NEXP * DM * 2;
constexpr size_t WS_XNA = WS_PV + (size_t)2 * NEXP * DM * 2;
constexpr size_t WS_XNB = al(WS_XNA + (size_t)MTOK * DM * 2);
constexpr size_t WS_PROJ = al(WS_XNB + (size_t)MTOK * DM * 2);
constexpr size_t WS_GW = al(WS_PROJ + (size_t)MTOK * 4096 * 2);
constexpr size_t WS_GQ = WS_GW + (size_t)2048 * 64 * 128 * 2;
constexpr size_t WS_GKT = WS_GQ + (size_t)2048 * 64 * 128 * 2;
constexpr size_t WS_GQK = WS_GKT + (size_t)2048 * 64 * 128 * 2;
constexpr size_t WS_GU = WS_GQK + (size_t)2048 * 64 * 64 * 2;
constexpr size_t WS_GDEC = WS_GU + (size_t)2048 * 64 * 128 * 4;
constexpr size_t WS_OGDN = al(WS_GDEC + 2048 * 4);
constexpr size_t WS_OG = al(WS_OGDN + (size_t)MTOK * DM * 4);
constexpr size_t WS_XS = al(WS_OG + (size_t)MTOK * DM * 2);
constexpr size_t WS_QPEER = al(WS_XS + (size_t)MTOK * DM * 4);
constexpr size_t WS_PEI = al(WS_QPEER + (size_t)MTOK * 2048 * 2);
constexpr size_t WS_PEG = al(WS_PEI + (size_t)MTOK * 128 * 4);
constexpr size_t WS_KVQ = al(WS_PEG + (size_t)MTOK * 128 * 4);
constexpr size_t WS_KSEL = al(WS_KVQ + (size_t)MTOK * NKVQ * 4);
constexpr size_t WS_VSELT = WS_KSEL + (size_t)PB * NG * PT * 64 * 2;
constexpr size_t WS_KWIN = WS_VSELT + (size_t)PB * NG * PT * 64 * 2;
constexpr size_t WS_VWINT = WS_KWIN + (size_t)PB * NG * PT * 64 * 2;
constexpr size_t WS_KCMP = WS_VWINT + (size_t)PB * NG * PT * 64 * 2;
constexpr size_t WS_VCMPT = WS_KCMP + (size_t)PB * NG * 512 * 64 * 2;
constexpr size_t WS_SKCMP = WS_VCMPT + (size_t)PB * NG * 512 * 64 * 2;
constexpr size_t WS_SVCMPT = WS_SKCMP + (size_t)SB * NG * 512 * 64 * 2;
constexpr size_t WS_SKWIN = WS_SVCMPT + (size_t)SB * NG * 512 * 64 * 2;
constexpr size_t WS_SVWINT = WS_SKWIN + (size_t)SB * NG * 544 * 64 * 2;
constexpr size_t WS_SNEW = WS_SVWINT + (size_t)SB * NG * 544 * 64 * 2;
constexpr size_t WS_QN = al(WS_SNEW + (size_t)SB * 4 * 2 * 4 * 64 * 4);
constexpr size_t WS_GATES = al(WS_QN + (size_t)MTOK * 1024 * 2);
constexpr size_t WS_OACC = al(WS_GATES + (size_t)MTOK * 48 * 4);
constexpr size_t WS_CKA = al(WS_OACC + (size_t)MTOK * DM * 4);
constexpr size_t WS_W1BD = al(WS_CKA + (size_t)65536 * 2048 * 2);
constexpr size_t WS_FS = al(WS_W1BD + (size_t)256 * 2048 * 2);
constexpr size_t WS_PA = al(WS_FS + (size_t)65536 * 256 * 4);
constexpr size_t WS_SSQ = al(WS_PA + (size_t)MTOK * 8 * 64 * 4);
constexpr size_t WS_END = al(WS_SSQ + (size_t)MTOK * 8 * 4);

constexpr int RING_BYTES = 143360;
constexpr int LDSCTL_OFF = RING_BYTES, MISC_OFF = LDSCTL_OFF + 320;
constexpr int LDS_BYTES = 147456;

#define GAS __attribute__((address_space(1)))
#define LAS __attribute__((address_space(3)))
typedef unsigned short bf16;
typedef unsigned v4u __attribute__((ext_vector_type(4)));
typedef unsigned v2u __attribute__((ext_vector_type(2)));
typedef float f32x4 __attribute__((ext_vector_type(4)));
typedef float f32x2 __attribute__((ext_vector_type(2)));
typedef short bf16x8 __attribute__((ext_vector_type(8)));
typedef GAS unsigned gu32;
#define RLX_AGENT __ATOMIC_RELAXED, __HIP_MEMORY_SCOPE_AGENT
#define LDS_WAIT() asm volatile("s_waitcnt lgkmcnt(0)" ::: "memory")
#define VM_WAIT() asm volatile("s_waitcnt vmcnt(0)" ::: "memory")

__device__ __forceinline__ unsigned f2bf(float f) { unsigned u = __builtin_bit_cast(unsigned, f); return (u + 0x7fffu + ((u >> 16) & 1u)) >> 16; }
typedef __bf16 hwbf16x2 __attribute__((ext_vector_type(2)));
__device__ __forceinline__ unsigned pk2(float lo, float hi) { const f32x2 v = {lo, hi}; return __builtin_bit_cast(unsigned, __builtin_convertvector(v, hwbf16x2)); }
__device__ __forceinline__ float bf2f(unsigned b) { return __builtin_bit_cast(float, b << 16); }
__device__ __forceinline__ float bflo(unsigned w) { return __builtin_bit_cast(float, w << 16); }
__device__ __forceinline__ float bfhi(unsigned w) { return __builtin_bit_cast(float, w & 0xffff0000u); }
#ifndef USE_PERMSWAP
#define USE_PERMSWAP 1
#endif
template <int CTRL> __device__ __forceinline__ float dpp_f(float x) { return __builtin_bit_cast(float, __builtin_amdgcn_update_dpp(0, __builtin_bit_cast(int, x), CTRL, 0xF, 0xF, true)); }
template <int CTRL> __device__ __forceinline__ unsigned dpp_u(unsigned x) { return (unsigned)__builtin_amdgcn_update_dpp(0, (int)x, CTRL, 0xF, 0xF, true); }
#define DPP_XOR1 0xB1
#define DPP_XOR2 0x4E
#define DPP_HMIR 0x141
#define DPP_MIR 0x140
#define DPP_ROR4 0x124
#define DPP_ROR8 0x128
#if USE_PERMSWAP
#define PSWAP16(a, b) asm volatile("s_nop 1\n\tv_permlane16_swap_b32 %0, %1" : "+v"(a), "+v"(b))
#define PSWAP32(a, b) asm volatile("s_nop 1\n\tv_permlane32_swap_b32 %0, %1" : "+v"(a), "+v"(b))
__device__ __forceinline__ float x16_sum(float x) { unsigned a = __builtin_bit_cast(unsigned, x), b = a; PSWAP16(a, b); return __builtin_bit_cast(float, a) + __builtin_bit_cast(float, b); }
__device__ __forceinline__ float x32_sum(float x) { unsigned a = __builtin_bit_cast(unsigned, x), b = a; PSWAP32(a, b); return __builtin_bit_cast(float, a) + __builtin_bit_cast(float, b); }
__device__ __forceinline__ float x16_max(float x) { unsigned a = __builtin_bit_cast(unsigned, x), b = a; PSWAP16(a, b); return fmaxf(__builtin_bit_cast(float, a), __builtin_bit_cast(float, b)); }
__device__ __forceinline__ float x32_max(float x) { unsigned a = __builtin_bit_cast(unsigned, x), b = a; PSWAP32(a, b); return fmaxf(__builtin_bit_cast(float, a), __builtin_bit_cast(float, b)); }
__device__ __forceinline__ unsigned x16_umax(unsigned u) { unsigned a = u, b = u; PSWAP16(a, b); return a > b ? a : b; }
__device__ __forceinline__ unsigned x32_umax(unsigned u) { unsigned a = u, b = u; PSWAP32(a, b); return a > b ? a : b; }
#else
__device__ __forceinline__ float x16_sum(float x) { return x + __shfl_xor(x, 16); }
__device__ __forceinline__ float x32_sum(float x) { return x + __shfl_xor(x, 32); }
__device__ __forceinline__ float x16_max(float x) { return fmaxf(x, __shfl_xor(x, 16)); }
__device__ __forceinline__ float x32_max(float x) { return fmaxf(x, __shfl_xor(x, 32)); }
__device__ __forceinline__ unsigned x16_umax(unsigned u) { const unsigned o = __shfl_xor(u, 16); return u > o ? u : o; }
__device__ __forceinline__ unsigned x32_umax(unsigned u) { const unsigned o = __shfl_xor(u, 32); return u > o ? u : o; }
#endif
__device__ __forceinline__ float row_sum16(float x) { x += dpp_f<DPP_XOR1>(x); x += dpp_f<DPP_XOR2>(x); x += dpp_f<DPP_HMIR>(x); x += dpp_f<DPP_MIR>(x); return x; }
__device__ __forceinline__ float wave_sum(float v) { return x32_sum(x16_sum(row_sum16(v))); }
__device__ __forceinline__ float frcp(float x) { return __builtin_amdgcn_rcpf(x); }
__device__ __forceinline__ float frsq(float x) { return __builtin_amdgcn_rsqf(x); }
__device__ __forceinline__ float silu_f(float x) { return x * frcp(1.f + __expf(-x)); }
__device__ __forceinline__ float sigmoid_f(float x) { return frcp(1.f + __expf(-x)); }
__device__ __forceinline__ float gelu_tanh(float x) {
    const float u = 0.7978845608028654f * (x + 0.044715f * x * x * x);
    const float e = __expf(2.f * u);
    const float th = 1.f - 2.f * frcp(e + 1.f);
    return 0.5f * x * (1.f + th);
}
__device__ __forceinline__ bf16x8 ld8(const bf16* p) { return *(const bf16x8*)p; }
__device__ __forceinline__ bf16x8 ld8l(const LAS bf16* p) { return *(const LAS bf16x8*)p; }
#define MFMA16(a, b, c) __builtin_amdgcn_mfma_f32_16x16x32_bf16((a), (b), (c), 0, 0, 0)
__device__ __forceinline__ bf16x8 cvt8(f32x4 a, f32x4 b) {
    v4u r; r.x = pk2(a.x, a.y); r.y = pk2(a.z, a.w); r.z = pk2(b.x, b.y); r.w = pk2(b.z, b.w); return __builtin_bit_cast(bf16x8, r);
}

struct Frame {
    LAS unsigned char* lds;
    int tid, lane, wave, G, bid;
    const __attribute__((address_space(4))) char* ka;
    float* out;
    unsigned char* ws;
};
#define WSP(T, off) ((T*)(F.ws + (off)))
__device__ __forceinline__ const float* fin_(const __attribute__((address_space(4))) char* ka, int i) {
    const __attribute__((address_space(4))) char* p = ka; asm volatile("" : "+s"(p));
    return *(const float* const __attribute__((address_space(4)))*)(p + 8 * i);
}
#define FIN(i) fin_(F.ka, (i))
namespace pg8 {
#define PG8_LAS __attribute__((address_space(3)))
typedef unsigned short bf16_t;
typedef short bf16x8 __attribute__((ext_vector_type(8)));
typedef float f32x4 __attribute__((ext_vector_type(4)));
typedef unsigned u32x4 __attribute__((ext_vector_type(4)));
constexpr int BM = 256, BK = 64, HALF = 128, HTB = HALF * BK * 2  , STAGE_BYTES = 8 * HTB, NXCD = 8, WGM = 8;

__host__ __device__ __forceinline__ int lds_byte(int r, int c) { const int st = (r >> 4) * 2 + (c >> 5), rr = r & 15, cc = c & 31, ob = rr * 64 + cc * 2; return st * 1024 + (ob ^ (((ob >> 9) & 1) << 5)); }
__host__ __device__ __forceinline__ void stage_rc(int b, int& R, int& C) { const int st = b / 1024, sb = b % 1024, swz = sb ^ (((sb >> 9) & 1) << 5); R = (st >> 1) * 16 + swz / 64; C = (st & 1) * 32 + (swz % 64) / 2; }
__host__ __device__ __forceinline__ int perm32(int rho) { const int n = rho >> 4, i = rho & 15; return 8 * (i >> 2) + 4 * n + (i & 3); }

struct Unit { int pm, pn; };
struct Gemm { const bf16_t* A; const bf16_t* Bt; int M, N, K; };

struct StaticOrder {
    int nM, nN, nwg, G, c;
    __host__ __device__ void init(int M, int N, int G_, int c_) { nM = M / BM; nN = N / BM; nwg = nM * nN; G = G_; c = c_; }
    __host__ __device__ bool next(int i, Unit& u) const {
        const long L = (long)i * G + c; if (L >= nwg) return false;
        int wgid = (int)L; { const int q = nwg / NXCD, r = nwg % NXCD, xcd = wgid % NXCD, off = wgid / NXCD; wgid = (xcd < r ? xcd * (q + 1) : r * (q + 1) + (xcd - r) * q) + off; }
        const int nig = WGM * nN, gid = wgid / nig, fm = gid * WGM, gsz = (nM - fm) < WGM ? (nM - fm) : WGM;
        u.pm = fm + ((wgid % nig) % gsz); u.pn = (wgid % nig) / gsz; return true;
    }
    __device__ __forceinline__ void a_ready(const Unit&) const {}
    __device__ __forceinline__ void done(const Unit&) const {}
};
template <class Epi, class Sched, bool ALIGN_EPI = false, bool SP2 = false>
__device__ __forceinline__ void gemm_phase(PG8_LAS unsigned char* lds, const Gemm g, const Sched& S, const Epi& E) {
    const int tid = threadIdx.x, wid = __builtin_amdgcn_readfirstlane(tid >> 6), lane = tid & 63, wr = wid >> 2, wc = wid & 3, fr = lane & 15, fq = lane >> 4;
    const int K = g.K, nt = K / BK;
    unsigned voffA[2], voffB[2];
#pragma unroll
    for (int i = 0; i < 2; ++i) { int R, C; stage_rc(tid * 16 + i * 8192, R, C); const int Rb = Epi::PERM ? ((R & ~31) + perm32(R & 31)) : R;
        voffA[i] = (unsigned)(R * K + C) * 2u; voffB[i] = (unsigned)(Rb * K + C) * 2u; }
    const size_t kstep = (size_t)(BK * 2);
    const size_t hstep = (size_t)HALF * K * 2;
    const size_t tstep = 2 * hstep;
    const unsigned ldsw = (unsigned)wid * 1024u;
    const int aoff = lds_byte(wr * 64 + fr, fq * 8), boff = lds_byte(wc * 32 + fr, fq * 8);
#define PG8_SA(b, h) (((b) * 2 + (h)) * HTB)
#define PG8_SB(b, h) ((4 + (b) * 2 + (h)) * HTB)
#define PG8_STAGE(bufoff, gbase, voff) do { _Pragma("unroll") for (int _i = 0; _i < 2; ++_i) \
        __builtin_amdgcn_global_load_lds((const unsigned*)((const char*)(gbase) + (voff)[_i]), (PG8_LAS unsigned*)(lds + (bufoff) + ldsw + _i * 8192), 16, 0, 0); } while (0)
#define PG8_LDA(dst, b, h) do { _Pragma("unroll") for (int m = 0; m < 4; ++m) _Pragma("unroll") for (int k = 0; k < 2; ++k) dst[m][k] = *(const PG8_LAS bf16x8*)(lds + PG8_SA(b, h) + aoff + m * 2048 + k * 1024); } while (0)
#define PG8_LDB(dst, b, h) do { _Pragma("unroll") for (int n = 0; n < 2; ++n) _Pragma("unroll") for (int k = 0; k < 2; ++k) dst[n][k] = *(const PG8_LAS bf16x8*)(lds + PG8_SB(b, h) + boff + n * 2048 + k * 1024); } while (0)
#define PG8_MMA(ai, bj, At, Bt) do { __builtin_amdgcn_s_setprio(1); _Pragma("unroll") for (int m = 0; m < 4; ++m) _Pragma("unroll") for (int n = 0; n < 2; ++n) _Pragma("unroll") for (int k = 0; k < 2; ++k) \
        acc[ai][bj][m][n] = __builtin_amdgcn_mfma_f32_16x16x32_bf16(Bt[n][k], At[m][k], acc[ai][bj][m][n], 0, 0, 0); __builtin_amdgcn_s_setprio(0); } while (0)
#define PG8_WAIT_V(n) asm volatile("s_waitcnt vmcnt(" #n ")" ::: "memory")
#define PG8_WAIT_L(n) asm volatile("s_waitcnt lgkmcnt(" #n ")" ::: "memory")
#define PG8_BAR __builtin_amdgcn_s_barrier()
#define PG8_SCHED __builtin_amdgcn_sched_barrier(0)
    Unit cur, nxt; int ui = 0;
    if (!S.next(0, cur)) return;
    f32x4 acc[2][2][4][2];
#pragma unroll
    for (int a = 0; a < 2; ++a)
#pragma unroll
        for (int b = 0; b < 2; ++b)
#pragma unroll
            for (int m = 0; m < 4; ++m)
#pragma unroll
                for (int n = 0; n < 2; ++n) acc[a][b][m][n] = (f32x4){0.f, 0.f, 0.f, 0.f};
    bf16x8 At[4][2], B0[2][2], B1[2][2];
    const char* cA = (const char*)g.A + (size_t)cur.pm * tstep; const char* cB = (const char*)g.Bt + (size_t)cur.pn * tstep;
    S.a_ready(cur);
    if constexpr (SP2) {
        PG8_STAGE(PG8_SB(0, 0), cB, voffB); PG8_STAGE(PG8_SB(0, 1), cB + hstep, voffB); PG8_STAGE(PG8_SA(0, 0), cA, voffA); PG8_STAGE(PG8_SA(0, 1), cA + hstep, voffA);
        if (wr == 1) PG8_BAR;
        PG8_WAIT_V(2); PG8_BAR;
        PG8_STAGE(PG8_SB(1, 0), cB + kstep, voffB); PG8_STAGE(PG8_SA(1, 0), cA + kstep, voffA); PG8_STAGE(PG8_SB(1, 1), cB + hstep + kstep, voffB);
        PG8_WAIT_V(6); PG8_BAR;
    } else {
        PG8_STAGE(PG8_SB(0, 0), cB, voffB); PG8_STAGE(PG8_SA(0, 0), cA, voffA); PG8_STAGE(PG8_SB(0, 1), cB + hstep, voffB); PG8_STAGE(PG8_SA(0, 1), cA + hstep, voffA);
        if (wr == 1) PG8_BAR;
        PG8_WAIT_V(4); PG8_BAR;
        PG8_STAGE(PG8_SB(1, 0), cB + kstep, voffB); PG8_STAGE(PG8_SA(1, 0), cA + kstep, voffA); PG8_STAGE(PG8_SB(1, 1), cB + hstep + kstep, voffB);
        PG8_WAIT_V(6); PG8_BAR;
    }
    for (;;) {
        const bool has_next = S.next(ui + 1, nxt);
        const char* nA = has_next ? (const char*)g.A + (size_t)nxt.pm * tstep : cA; const char* nB = has_next ? (const char*)g.Bt + (size_t)nxt.pn * tstep : cB;
        for (int t = 0; t < nt; t += 2) {
            const bool last = (t == nt - 2);
            const char* a1 = cA + (size_t)(t + 1) * kstep;
            const char* a2 = last ? nA : cA + (size_t)(t + 2) * kstep; const char* b2 = last ? nB : cB + (size_t)(t + 2) * kstep;
            const char* a3 = a2 + kstep; const char* b3 = b2 + kstep;
            if (last && has_next) S.a_ready(nxt);
            if constexpr (SP2) {
            PG8_LDB(B0, 0, 0); PG8_LDB(B1, 0, 1); PG8_SCHED; PG8_LDA(At, 0, 0); PG8_STAGE(PG8_SA(1, 1), a1 + hstep, voffA);
            PG8_WAIT_V(8); PG8_WAIT_L(0); PG8_BAR; PG8_MMA(0, 0, At, B0); PG8_MMA(0, 1, At, B1); PG8_BAR; PG8_SCHED;
            PG8_LDA(At, 0, 1); PG8_STAGE(PG8_SB(0, 0), b2, voffB); PG8_STAGE(PG8_SB(0, 1), b2 + hstep, voffB); PG8_STAGE(PG8_SA(0, 0), a2, voffA);
            PG8_WAIT_V(8); PG8_WAIT_L(0); PG8_BAR; PG8_MMA(1, 0, At, B0); PG8_MMA(1, 1, At, B1); PG8_BAR; PG8_SCHED;
            PG8_LDB(B0, 1, 0); PG8_LDB(B1, 1, 1); PG8_SCHED; PG8_LDA(At, 1, 0); PG8_STAGE(PG8_SA(0, 1), a2 + hstep, voffA);
            PG8_WAIT_V(8); PG8_WAIT_L(0); PG8_BAR; PG8_MMA(0, 0, At, B0); PG8_MMA(0, 1, At, B1); PG8_BAR; PG8_SCHED;
            PG8_LDA(At, 1, 1); PG8_STAGE(PG8_SB(1, 0), b3, voffB); PG8_STAGE(PG8_SB(1, 1), b3 + hstep, voffB); PG8_STAGE(PG8_SA(1, 0), a3, voffA);
            PG8_WAIT_V(8); PG8_WAIT_L(0); PG8_BAR; PG8_MMA(1, 0, At, B0); PG8_MMA(1, 1, At, B1); PG8_BAR; PG8_SCHED;
            } else {
            PG8_LDB(B0, 0, 0); PG8_SCHED; PG8_LDA(At, 0, 0); PG8_STAGE(PG8_SA(1, 1), a1 + hstep, voffA);
            PG8_WAIT_L(8); PG8_BAR; PG8_WAIT_L(0); PG8_MMA(0, 0, At, B0); PG8_BAR; PG8_SCHED;
            PG8_LDB(B1, 0, 1); PG8_STAGE(PG8_SB(0, 0), b2, voffB);
            PG8_BAR; PG8_WAIT_L(0); PG8_MMA(0, 1, At, B1); PG8_BAR;
            PG8_LDA(At, 0, 1); PG8_STAGE(PG8_SA(0, 0), a2, voffA);
            PG8_BAR; PG8_WAIT_L(0); PG8_MMA(1, 0, At, B0); PG8_BAR; PG8_SCHED;
            PG8_STAGE(PG8_SB(0, 1), b2 + hstep, voffB);
            PG8_WAIT_V(6); PG8_BAR; PG8_MMA(1, 1, At, B1); PG8_BAR;
            PG8_LDB(B0, 1, 0); PG8_SCHED; PG8_LDA(At, 1, 0); PG8_STAGE(PG8_SA(0, 1), a2 + hstep, voffA);
            PG8_WAIT_L(8); PG8_BAR; PG8_WAIT_L(0); PG8_MMA(0, 0, At, B0); PG8_BAR; PG8_SCHED;
            PG8_LDB(B1, 1, 1); PG8_STAGE(PG8_SB(1, 0), b3, voffB);
            PG8_BAR; PG8_WAIT_L(0); PG8_MMA(0, 1, At, B1); PG8_BAR;
            PG8_LDA(At, 1, 1); PG8_STAGE(PG8_SA(1, 0), a3, voffA);
            PG8_BAR; PG8_WAIT_L(0); PG8_MMA(1, 0, At, B0); PG8_BAR; PG8_SCHED;
            PG8_STAGE(PG8_SB(1, 1), b3 + hstep, voffB);
            PG8_WAIT_V(6); PG8_BAR; PG8_MMA(1, 1, At, B1); PG8_BAR;
            }
        }
        if constexpr (ALIGN_EPI) { if (wr == 0) PG8_BAR; }
        if constexpr (!Epi::AFTER_DRAIN) { E(acc, cur, wr, wc, fr, fq); S.done(cur); }
        if (!has_next) break;
#pragma unroll
        for (int a = 0; a < 2; ++a)
#pragma unroll
            for (int b = 0; b < 2; ++b)
#pragma unroll
                for (int m = 0; m < 4; ++m)
#pragma unroll
                    for (int n = 0; n < 2; ++n) acc[a][b][m][n] = (f32x4){0.f, 0.f, 0.f, 0.f};
        cur = nxt; cA = nA; cB = nB; ++ui;
        if constexpr (ALIGN_EPI) { if (wr == 1) PG8_BAR; }
    }
    PG8_WAIT_V(0);
    if constexpr (!ALIGN_EPI) { if (wr == 0) PG8_BAR; }
    PG8_BAR;
    if constexpr (Epi::AFTER_DRAIN) { E.fused(acc, cur, wr, wc, fr, fq, lds, wid, lane); S.done(cur); }
#undef PG8_SA
#undef PG8_SB
#undef PG8_STAGE
#undef PG8_LDA
#undef PG8_LDB
#undef PG8_MMA
#undef PG8_WAIT_V
#undef PG8_WAIT_L
#undef PG8_BAR
#undef PG8_SCHED
}
}
#define XB_TMO      128
#define XB_XCNT(j)  (256  + 64 * (j))
#define XB_XSUB(j)  (1280 + 64 * (j))
#define XB_XGEN(j)  (2304 + 64 * (j))
#define XB_TOP      3328
#define XB_TOPGEN   3392
#define XCD_BAR_WORDS 3456
#define XB_SPIN_CAP (1u << 18)

__device__ __forceinline__ unsigned xb_ld(unsigned* p)              { return __hip_atomic_load(p, __ATOMIC_RELAXED, __HIP_MEMORY_SCOPE_AGENT); }
__device__ __forceinline__ unsigned xb_add(unsigned* p, unsigned v) { return __hip_atomic_fetch_add(p, v, __ATOMIC_RELAXED, __HIP_MEMORY_SCOPE_AGENT); }
__device__ __forceinline__ unsigned xb_xcc_id() { return (unsigned)__builtin_amdgcn_s_getreg((3 << 11) | 20) & 0xFu; }
#define XB_SPIN(cond, bar) do { unsigned _sp = 0; while (cond) { __builtin_amdgcn_s_sleep(1); \
    if ((++_sp & 255u) == 0u) { if (xb_ld(&(bar)[XB_TMO])) break; if (_sp > XB_SPIN_CAP) { atomicAdd(&(bar)[XB_TMO], 1u); break; } } } } while (0)

struct XcdBarrier {
    unsigned* bar; unsigned x;
    volatile LAS unsigned* st;
};

__device__ __forceinline__ XcdBarrier xcd_barrier_post(unsigned* bar, volatile LAS unsigned* st) {
    XcdBarrier b; b.bar = bar; b.x = xb_xcc_id(); b.st = st;
    if (threadIdx.x == 0) { st[2] = xb_add(&bar[XB_XCNT(b.x)], 1u); st[3] = 1u; }
    return b;
}
__device__ __forceinline__ void xcd_barrier_complete(unsigned* bar, unsigned x, unsigned& nloc, unsigned& nx) {
    const unsigned G = gridDim.x * gridDim.y * gridDim.z;
    unsigned sum, cnt, mine, sp = 0u;
    for (;;) {
        sum = 0u; cnt = 0u; mine = 0u;
#pragma unroll
        for (unsigned j = 0; j < 16; ++j) { const unsigned c = xb_ld(&bar[XB_XCNT(j)]); sum += c; cnt += (c > 0u) ? 1u : 0u; mine = (j == x) ? c : mine; }
        if (sum == G) break;
        __builtin_amdgcn_s_sleep(1);
        if ((++sp & 255u) == 0u) { if (xb_ld(&bar[XB_TMO])) break; if (sp > XB_SPIN_CAP) { atomicAdd(&bar[XB_TMO], 1u); break; } }
    }
    nloc = mine > 0u ? mine : 1u; nx = cnt > 0u ? cnt : 1u;
}

__device__ __forceinline__ void xcd_barrier(const XcdBarrier& b) {
    asm volatile("s_waitcnt vmcnt(0)" ::: "memory");
    __syncthreads();
    if (threadIdx.x == 0) {
        unsigned* bar = b.bar;
        __builtin_amdgcn_s_waitcnt(0);
        unsigned nloc = b.st[0], nx = b.st[1];
        if (nloc == 0u) { xcd_barrier_complete(bar, b.x, nloc, nx); b.st[0] = nloc; b.st[1] = nx; }
        const unsigned old = xb_add(&bar[XB_XSUB(b.x)], 1u);
        const unsigned gen = old / nloc;
        if (old + 1u == (gen + 1u) * nloc) {
            __builtin_amdgcn_fence(__ATOMIC_RELEASE, "agent");
            asm volatile("s_waitcnt vmcnt(0)" ::: "memory");
            const unsigned og = xb_add(&bar[XB_TOP], 1u);
            const unsigned tg = og / nx;
            if (og + 1u == (tg + 1u) * nx) xb_add(&bar[XB_TOPGEN], 1u);
            else XB_SPIN(xb_ld(&bar[XB_TOPGEN]) == tg, bar);
            __builtin_amdgcn_fence(__ATOMIC_ACQUIRE, "agent");
            xb_add(&bar[XB_XGEN(b.x)], 1u);
            asm volatile("s_waitcnt vmcnt(0)" ::: "memory");
        } else {
            XB_SPIN(xb_ld(&bar[XB_XGEN(b.x)]) == gen, bar);
            __builtin_amdgcn_fence(__ATOMIC_ACQUIRE, "agent");
            asm volatile("s_waitcnt vmcnt(0)" ::: "memory");
        }
    }
    __syncthreads();
}

namespace pg8 {
template <class Fn> struct EpiFn {
    static constexpr bool PERM = true, AFTER_DRAIN = false;
    Fn f;
    __device__ __forceinline__ void operator()(const f32x4 (&acc)[2][2][4][2], const Unit& u, int wr, int wc, int fr, int fq) const {
        const int row0 = u.pm * BM + wr * 64 + fr, col0 = u.pn * BM + wc * 32 + 8 * fq;
#pragma unroll
        for (int ai = 0; ai < 2; ++ai)
#pragma unroll
            for (int m = 0; m < 4; ++m)
#pragma unroll
                for (int bj = 0; bj < 2; ++bj) f.e8(row0 + ai * HALF + m * 16, col0 + bj * HALF, acc[ai][bj][m][0], acc[ai][bj][m][1]);
    }
};
}

struct FnBf16 {
    bf16* O; int ld;
    __device__ __forceinline__ void e8(int row, int col, f32x4 a, f32x4 b) const {
        v4u w; w.x = pk2(a.x, a.y); w.y = pk2(a.z, a.w); w.z = pk2(b.x, b.y); w.w = pk2(b.z, b.w);
        *(v4u*)(O + (size_t)row * ld + col) = w;
    }
    __device__ __forceinline__ void e4(int row, int col, f32x4 a) const {
        v2u w; w.x = pk2(a.x, a.y); w.y = pk2(a.z, a.w);
        *(v2u*)(O + (size_t)row * ld + col) = w;
    }
};
struct FnResid {
    float* XS; const float* baseP; const float* baseS;
    __device__ __forceinline__ const float* brow(int row) const { return row < MP ? baseP + (size_t)row * DM : baseS + (size_t)(row - MP) * DM; }
    __device__ __forceinline__ void e8(int row, int col, f32x4 a, f32x4 b) const {
        const float* br = brow(row) + col; float* o = XS + (size_t)row * DM + col;
        const f32x4 x0 = *(const f32x4*)br, x1 = *(const f32x4*)(br + 4);
        *(f32x4*)o = x0 + a; *(f32x4*)(o + 4) = x1 + b;
    }
    __device__ __forceinline__ void e4(int row, int col, f32x4 a) const {
        const float* br = brow(row) + col; float* o = XS + (size_t)row * DM + col;
        *(f32x4*)o = *(const f32x4*)br + a;
    }
};
struct FnF32 {
    float* O; int ld;
    __device__ __forceinline__ void e8(int row, int col, f32x4 a, f32x4 b) const { float* o = O + (size_t)row * ld + col; *(f32x4*)o = a; *(f32x4*)(o + 4) = b; }
    __device__ __forceinline__ void e4(int row, int col, f32x4 a) const { *(f32x4*)(O + (size_t)row * ld + col) = a; }
};
struct FnKvq {
    float* O; const float* ssq;
    __device__ __forceinline__ float rstd(int row) const { const f32x4 s0 = *(const f32x4*)(ssq + (size_t)row * 8), s1 = *(const f32x4*)(ssq + (size_t)row * 8 + 4);
        return frsq((((s0.x + s0.y) + (s0.z + s0.w)) + ((s1.x + s1.y) + (s1.z + s1.w))) * (1.f / DM) + EPS); }
    __device__ __forceinline__ void e8(int row, int col, f32x4 a, f32x4 b) const {
        if (col < NKVQ_REAL) { const float rs = rstd(row); float* o = O + (size_t)row * NKVQ + col; *(f32x4*)o = a * rs; *(f32x4*)(o + 4) = b * rs; }
    }
    __device__ __forceinline__ void e4(int row, int col, f32x4 a) const {
        if (col < NKVQ_REAL) *(f32x4*)(O + (size_t)row * NKVQ + col) = a * rstd(row);
    }
};

template <class Fn>
__device__ __forceinline__ void skinny_gemm(Frame& F, const bf16* A, const bf16* Bt, int N, int row_base, const Fn& fn) {
    const int fr = F.lane & 15, fq = F.lane >> 4;
    const int nun = N / 16;
    for (int u = F.bid; u < nun; u += F.G) {
        const bf16* ap = Bt + (size_t)(u * 16 + fr) * DM + fq * 8;
        const bf16* bp = A + (size_t)(F.wave * 16 + fr) * DM + fq * 8;
        f32x4 acc = {0.f, 0.f, 0.f, 0.f};
#pragma unroll 8
        for (int ks = 0; ks < 32; ++ks) acc = MFMA16(ld8(ap + ks * 32), ld8(bp + ks * 32), acc);
        fn.e4(row_base + F.wave * 16 + fr, u * 16 + 4 * fq, acc);
    }
}

template <class Fn>
__device__ __forceinline__ void gemm_all(Frame& F, const bf16* A, const bf16* Bt, int N, const Fn& fn) {
    pg8::Gemm g{A, Bt, MP, N, DM}; pg8::StaticOrder S; S.init(MP, N, F.G, F.bid);
    pg8::EpiFn<Fn> E{fn};
    pg8::gemm_phase<pg8::EpiFn<Fn>, pg8::StaticOrder, true, true>(F.lds, g, S, E);
    skinny_gemm(F, A + (size_t)MP * DM, Bt, N, MP, fn);
}

__device__ __forceinline__ void p0_transpose_item(const float* W, int N, bf16* WT, int row_off, const float* gain, LAS float* scr, int item, int lane) {
    const int nblk = (N + 31) / 32, kb = item / nblk, nb = item % nblk, k0 = 64 * kb, n0 = 32 * nb;
#pragma unroll 8
    for (int i = 0; i < 32; ++i) { const int kk = 2 * i + (lane >> 5); const int n = n0 + (lane & 31);
        float v = 0.f; if (n < N) { v = W[(size_t)(k0 + kk) * N + n]; if (gain) v *= gain[k0 + kk]; }
        scr[kk * 33 + (lane & 31)] = v; }
    LDS_WAIT(); asm volatile("" ::: "memory");
    const int c = lane & 7;
#pragma unroll
    for (int j = 0; j < 4; ++j) { const int n = (lane >> 3) + 8 * j; const LAS float* s = scr + (8 * c) * 33 + n;
        v4u o; o.x = pk2(s[0 * 33], s[1 * 33]); o.y = pk2(s[2 * 33], s[3 * 33]); o.z = pk2(s[4 * 33], s[5 * 33]); o.w = pk2(s[6 * 33], s[7 * 33]);
        if (n0 + n < N) *(v4u*)(WT + (size_t)(row_off + n0 + n) * DM + k0 + 8 * c) = o; }
    LDS_WAIT(); asm volatile("" ::: "memory");
}
__device__ __forceinline__ void rms_row_to_bf16(const float* xrow, bf16* orow, int lane) {
    const f32x4* xr = (const f32x4*)xrow + lane;
    f32x4 v[4]; float s = 0.f;
#pragma unroll
    for (int j = 0; j < 4; ++j) { v[j] = xr[64 * j]; s += (v[j].x * v[j].x + v[j].y * v[j].y) + (v[j].z * v[j].z + v[j].w * v[j].w); }
    const float rstd = frsq(wave_sum(s) * (1.f / DM) + EPS);
    v2u* o8 = (v2u*)orow + lane;
#pragma unroll
    for (int j = 0; j < 4; ++j) { v2u w; w.x = pk2(v[j].x * rstd, v[j].y * rstd); w.y = pk2(v[j].z * rstd, v[j].w * rstd); o8[64 * j] = w; }
}
__device__ __forceinline__ const float* xin_row(Frame& F, int row) { return row < MP ? FIN(0) + (size_t)row * DM : FIN(1) + (size_t)(row - MP) * DM; }

__device__ __forceinline__ void peer_tables_to_fp8(Frame& F, size_t thr, size_t nthr, size_t lo = 0, size_t hi = (size_t)2 * NEXP * DM / 8) {
    const size_t gt = thr, NGT = nthr;
        for (int t = 0; t < 2; ++t) { const f32x4* src = (const f32x4*)FIN(27 + t); v2u* dst = (v2u*)WSP(unsigned char, t == 0 ? WS_PU : WS_PV); const float* pln = FIN(24);
            for (size_t i0 = lo + gt; i0 < hi; i0 += (size_t)4 * NGT) {
                f32x4 a[4], b[4];
#pragma unroll
                for (int u = 0; u < 4; ++u) { const size_t i = i0 + (size_t)u * NGT; if (i < hi) { a[u] = src[2 * i]; b[u] = src[2 * i + 1]; } }
#pragma unroll
                for (int u = 0; u < 4; ++u) { const size_t i = i0 + (size_t)u * NGT; if (i < hi) {
                    if (t == 0) { const float* gp = pln + ((i >> 21) << 10) + ((i & 127) << 3); a[u] = a[u] * *(const f32x4*)gp * 32.f; b[u] = b[u] * *(const f32x4*)(gp + 4) * 32.f; }
                    else { a[u] = a[u] * 16.f; b[u] = b[u] * 16.f; }
                    int w0 = __builtin_amdgcn_cvt_pk_fp8_f32(a[u].x, a[u].y, 0, false); w0 = __builtin_amdgcn_cvt_pk_fp8_f32(a[u].z, a[u].w, w0, true);
                    int w1 = __builtin_amdgcn_cvt_pk_fp8_f32(b[u].x, b[u].y, 0, false); w1 = __builtin_amdgcn_cvt_pk_fp8_f32(b[u].z, b[u].w, w1, true);
                    dst[((((i >> 21) * 8 + ((i & 127) >> 4)) * (size_t)NEXP + ((i >> 7) & (NEXP - 1))) << 4) + (i & 15)] = (v2u){(unsigned)w0, (unsigned)w1}; } } } }
}

constexpr int FD_BUF = 16384;
__device__ __forceinline__ void fs_direct_task(Frame& F, int task) {
    int lane_ = F.lane; asm volatile("" : "+v"(lane_));
    const int lane = lane_, w = F.wave, fr = lane & 15, fq = lane >> 4, kv = w >> 2, g = w & 3, bs = task >> 4, c0 = (task & 15) * 32;
    LAS unsigned char* L = F.lds; asm volatile("" : "+v"(L));
    const float* cache = FIN(2); const int* pt = (const int*)FIN(6) + bs * NPAGES;
    const float* base[2];
#pragma unroll
    for (int nt = 0; nt < 2; ++nt) { const int t0 = 16 * (c0 + 16 * nt + fr); base[nt] = cache + ((size_t)pt[t0 >> 7] * PAGE + (t0 & 127)) * 1024 + kv * 256 + g * 64 + 8 * fq; }
    const bf16* wsrc[2]; int wdst[2];
#pragma unroll
    for (int q = 0; q < 2; ++q) { const int item = F.tid + 512 * q, kvw = item >> 9, n = (item >> 2) & 127, kq = item & 3;
        wsrc[q] = WSP(bf16, WS_W1BD) + (size_t)(kvw * 128 + n) * 2048 + kvw * 1024 + 8 * kq; wdst[q] = ((kvw * 8 + (n >> 4)) * 64 + kq * 16 + (n & 15)) * 16; }
    f32x4 acc[2][8];
#pragma unroll
    for (int nt = 0; nt < 2; ++nt)
#pragma unroll
        for (int mt = 0; mt < 8; ++mt) acc[nt][mt] = (f32x4){0.f, 0.f, 0.f, 0.f};
    f32x4 S0[2][4], S1[2][4]; v4u wr[2];
#define FD_DATA(S, r) do { const int r_ = (r) < 16 ? (r) : 15; _Pragma("unroll") for (int nt_ = 0; nt_ < 2; ++nt_) { const float* p_ = base[nt_] + r_ * 1024; \
        S[nt_][0] = *(const f32x4*)p_; S[nt_][1] = *(const f32x4*)(p_ + 4); S[nt_][2] = *(const f32x4*)(p_ + 32); S[nt_][3] = *(const f32x4*)(p_ + 36); } } while (0)
#define FD_WLOAD(ks) do { const int ks_ = (ks) < 32 ? (ks) : 31; wr[0] = *(const v4u*)(wsrc[0] + 32 * ks_); wr[1] = *(const v4u*)(wsrc[1] + 32 * ks_); } while (0)
#define FD_WSTORE(buf) do { *(LAS v4u*)(L + (buf) * FD_BUF + wdst[0]) = wr[0]; *(LAS v4u*)(L + (buf) * FD_BUF + wdst[1]) = wr[1]; } while (0)
#define FD_KSTEP(bq, ks, buf) do { \
        _Pragma("unroll") for (int mt_ = 0; mt_ < 8; ++mt_) { const bf16x8 a_ = *(const LAS bf16x8*)(L + (buf) * FD_BUF + ((kv * 8 + mt_) * 64 + lane) * 16); \
            acc[0][mt_] = MFMA16(a_, bq[0], acc[0][mt_]); acc[1][mt_] = MFMA16(a_, bq[1], acc[1][mt_]); } \
        FD_WSTORE((buf) ^ 1); FD_WLOAD((ks) + 2); \
        __syncthreads(); } while (0)
#define FD_ROW(S, r) do { bf16x8 b0_[2], b1_[2]; _Pragma("unroll") for (int nt_ = 0; nt_ < 2; ++nt_) { b0_[nt_] = cvt8(S[nt_][0], S[nt_][1]); b1_[nt_] = cvt8(S[nt_][2], S[nt_][3]); } \
        FD_DATA(S, (r) + 2); \
        FD_KSTEP(b0_, 2 * (r), 0); FD_KSTEP(b1_, 2 * (r) + 1, 1); } while (0)
    FD_WLOAD(0); FD_WSTORE(0); FD_WLOAD(1); FD_DATA(S0, 0); FD_DATA(S1, 1);
    __syncthreads();
#pragma unroll 1
    for (int r = 0; r < 16; r += 2) { FD_ROW(S0, r); FD_ROW(S1, r + 1); }
#undef FD_KSTEP
#undef FD_ROW
#undef FD_DATA
#undef FD_WLOAD
#undef FD_WSTORE
    float* fs = WSP(float, WS_FS) + ((size_t)(bs * 4 + g) * 512 + c0 + fr) * 256 + kv * 128 + 4 * fq;
#pragma unroll
    for (int nt = 0; nt < 2; ++nt)
#pragma unroll
        for (int mt = 0; mt < 8; ++mt) *(f32x4*)(fs + (size_t)nt * 16 * 256 + 16 * mt) = acc[nt][mt];
    __syncthreads();
}

__device__ __forceinline__ void p0_prologue(Frame& F) {
    LAS float* scr = (LAS float*)(F.lds + F.wave * 16384);
    const int gw = F.bid * 8 + F.wave, NGW = F.G * 8;
    const int gt = F.bid * 512 + F.tid, NGT = F.G * 512;
    {
        constexpr int I_IN = 128 * 16, I_OA = 32 * 16, I_KV = 48 * 16, I_QG = 34 * 16, I_OB = 32 * 16, I_PQ = 64 * 16;
        constexpr int NITEMS = I_IN + I_OA + I_KV + I_QG + I_OB + 2 * I_PQ;
        for (int it = gw; it < NITEMS; it += NGW) {
            int r = it;
            if (r < I_IN) {
                const int kb = r / 128, nb = r % 128, k0 = 64 * kb, n0 = 32 * nb; const float* W = FIN(8); const float* gain = FIN(7);
#pragma unroll 8
                for (int i = 0; i < 32; ++i) { const int kk = 2 * i + (F.lane >> 5); scr[kk * 33 + (F.lane & 31)] = W[(size_t)(k0 + kk) * GPROJ + n0 + (F.lane & 31)] * gain[k0 + kk]; }
                LDS_WAIT(); asm volatile("" ::: "memory");
                const int c = F.lane & 7;
#pragma unroll
                for (int j = 0; j < 4; ++j) { const int n = (F.lane >> 3) + 8 * j; const LAS float* s = scr + (8 * c) * 33 + n;
                    v4u o; o.x = pk2(s[0 * 33], s[1 * 33]); o.y = pk2(s[2 * 33], s[3 * 33]); o.z = pk2(s[4 * 33], s[5 * 33]); o.w = pk2(s[6 * 33], s[7 * 33]);
                    *(v4u*)(WSP(bf16, WS_WIN_T) + (size_t)(n0 + n) * DM + k0 + 8 * c) = o; }
                LDS_WAIT(); asm volatile("" ::: "memory");
                continue; }
            r -= I_IN;
            if (r < I_OA) { p0_transpose_item(FIN(13), 1024, WSP(bf16, WS_WOA_T), 0, nullptr, scr, r, F.lane); continue; } r -= I_OA;
            if (r < I_KV) { p0_transpose_item(FIN(15), NKV, WSP(bf16, WS_WKVQ_T), 0, FIN(14), scr, r, F.lane); continue; } r -= I_KV;
            if (r < I_QG) { p0_transpose_item(FIN(21), NQG, WSP(bf16, WS_WKVQ_T), NKV, FIN(20), scr, r, F.lane); continue; } r -= I_QG;
            if (r < I_OB) { p0_transpose_item(FIN(23), 1024, WSP(bf16, WS_WOB_T), 0, nullptr, scr, r, F.lane); continue; } r -= I_OB;
            if (r < I_PQ) { p0_transpose_item(FIN(25), 2048, WSP(bf16, WS_WPQ_T), 0, FIN(24), scr, r, F.lane); continue; } r -= I_PQ;
            p0_transpose_item(FIN(25) + (size_t)1024 * 2048, 2048, WSP(bf16, WS_WPQ_T) + (size_t)2048 * 1024, 0, FIN(24) + 1024, scr, r, F.lane);
        }
        for (int i = gt; i < (NKVQ - NKVQ_REAL) * DM / 8; i += NGT) ((v4u*)(WSP(bf16, WS_WKVQ_T) + (size_t)NKVQ_REAL * DM))[i] = (v4u){0u, 0u, 0u, 0u};
        for (int i = gt; i < 16 * 1024; i += NGT) { const int j = i >> 10, k = i & 1023; WSP(float, WS_WAB)[i] = FIN(7)[k] * FIN(8)[(size_t)k * GPROJ + 4096 + j]; }
    }
    for (int m = gw; m < MTOK; m += NGW) rms_row_to_bf16(xin_row(F, m), WSP(bf16, WS_XNA) + (size_t)m * DM, F.lane);
    {
        if (F.G != 256) peer_tables_to_fp8(F, (size_t)gt, (size_t)NGT);
        const f32x4* sk = (const f32x4*)FIN(26); v4u* dk = (v4u*)WSP(bf16, WS_SUBK);
        for (int i = gt; i < 2 * 8 * 2 * 128 * 128 / 8; i += NGT) { const f32x4 a = sk[2 * i], b = sk[2 * i + 1]; v4u w; w.x = pk2(a.x, a.y); w.y = pk2(a.z, a.w); w.z = pk2(b.x, b.y); w.w = pk2(b.z, b.w); dk[i] = w; }
    }
    for (int i = gt; i < 2 * 64 * 2048; i += NGT) { const int kv = i >> 17, hh = (i >> 11) & 63, k = i & 2047;
        WSP(bf16, WS_W1T)[i] = (bf16)f2bf(FIN(17)[((size_t)kv * 2048 + k) * 64 + hh]); }
    for (int it = gw; it < 128; it += NGW) { const int kv = it >> 6, h = it & 63; float s = 0.f;
        for (int k = F.lane; k < 2048; k += 64) s += FIN(18)[(size_t)kv * 2048 + k] * FIN(17)[((size_t)kv * 2048 + k) * 64 + h];
        s = wave_sum(s); if (F.lane == 0) WSP(float, WS_PETERM)[it] = s; }
    {
        bf16* wbd = WSP(bf16, WS_W1BD);
        for (int i = gt; i < 256 * 2048; i += NGT) { const int n = i >> 11, col = i & 2047, kv = n >> 7, sec = (n >> 6) & 1, hh = n & 63;
            float v = 0.f; if ((col >> 10) == kv) { const int k = col & 1023, r = (k >> 6) + 16 * sec, d = k & 63; v = FIN(17)[(((size_t)kv * 32 + r) * 64 + d) * 64 + hh]; }
            wbd[i] = (bf16)f2bf(v); }
    }
    {
        const f32x4* src = (const f32x4*)FIN(3); f32x4* dst = (f32x4*)(F.out + O_WINS);
        const int per_b = 508 * 512 / 4;
        for (int i = gt; i < SB * per_b; i += NGT) { const int b = i / per_b, r = i % per_b; dst[(size_t)b * (512 * 512 / 4) + r] = src[(size_t)b * (512 * 512 / 4) + 4 * 512 / 4 + r]; }
    }
    for (int i = gt; i < SB * NG * 544 * 64; i += NGT) {
        const int d = i & 63, r = (i >> 6) % 544, bg = (i >> 6) / 544, g = bg & 3, b = bg >> 2;
        if (r < 512) { const float* cw = FIN(3) + (((size_t)b * 512 + r) * 2) * 256 + g * 64 + d;
            WSP(bf16, WS_SKWIN)[i] = (bf16)f2bf(cw[0]);
            WSP(bf16, WS_SVWINT)[((size_t)bg * 64 + d) * 544 + r] = (bf16)f2bf(cw[256]); }
        else if (r >= 516) { WSP(bf16, WS_SKWIN)[i] = 0; WSP(bf16, WS_SVWINT)[((size_t)bg * 64 + d) * 544 + r] = 0; }
    }
}

constexpr int P2_QS = 0, P2_KS = 17408, P2_KBGT = 34816, P2_VBT = 53248, P2_AM = 71680, P2_TB = 89088, P2_G = 98304, P2_TF = 99328, P2_XF = 116736;
constexpr int QS_LD = 136, KT_LD = 72, AM_LD = 68, TB_LD = 72;

__device__ __forceinline__ float softplus_f(float x) { return fmaxf(x, 0.f) + __logf(1.f + __expf(-fabsf(x))); }

__device__ __forceinline__ void p2_chunk(Frame& F, int unit) {
    const int c = unit & 127, h = (unit >> 7) & 7, b = unit >> 10;
    const int t0 = c * CHUNK, lane = F.lane, w = F.wave, fr = lane & 15, fq = lane >> 4;
    LAS unsigned char* L = F.lds; asm volatile("" : "+v"(L));
    LAS bf16* qs = (LAS bf16*)(L + P2_QS); LAS bf16* ks = (LAS bf16*)(L + P2_KS);
    LAS bf16* kbgT = (LAS bf16*)(L + P2_KBGT); LAS bf16* vbT = (LAS bf16*)(L + P2_VBT);
    LAS float* Am = (LAS float*)(L + P2_AM); LAS bf16* Tb = (LAS bf16*)(L + P2_TB);
    LAS float* Gs = (LAS float*)(L + P2_G);
    const bf16* PROJ = WSP(bf16, WS_PROJ); const bf16* XNA = WSP(bf16, WS_XNA); const float* WAB = WSP(float, WS_WAB);
    const size_t rowb = (size_t)b * PT;
    float beta_r[8];
    {
        f32x4 wa[4], wb[4];
        const float* pa = WAB + (size_t)h * DM + 8 * lane; const float* pb = WAB + (size_t)(8 + h) * DM + 8 * lane;
        wa[0] = *(const f32x4*)pa; wa[1] = *(const f32x4*)(pa + 4); wa[2] = *(const f32x4*)(pa + 512); wa[3] = *(const f32x4*)(pa + 516);
        wb[0] = *(const f32x4*)pb; wb[1] = *(const f32x4*)(pb + 4); wb[2] = *(const f32x4*)(pb + 512); wb[3] = *(const f32x4*)(pb + 516);
        const float Aneg = -expf(FIN(10)[h]), dtb = FIN(11)[h];
#pragma unroll
        for (int tk = 0; tk < 8; ++tk) {
            const int tok = 8 * w + tk; const bf16* xr = XNA + (rowb + t0 + tok) * DM + 8 * lane;
            const v4u x0 = *(const v4u*)xr, x1 = *(const v4u*)(xr + 512);
            float sa = 0.f, sb = 0.f;
#define ACC2(xw, wv0, wv1, i0) { const float lo = bflo(xw), hi = bfhi(xw); sa += lo * wv0[i0] + hi * wv0[i0 + 1]; sb += lo * wv1[i0] + hi * wv1[i0 + 1]; }
            ACC2(x0.x, wa[0], wb[0], 0) ACC2(x0.y, wa[0], wb[0], 2) ACC2(x0.z, wa[1], wb[1], 0) ACC2(x0.w, wa[1], wb[1], 2)
            ACC2(x1.x, wa[2], wb[2], 0) ACC2(x1.y, wa[2], wb[2], 2) ACC2(x1.z, wa[3], wb[3], 0) ACC2(x1.w, wa[3], wb[3], 2)
#undef ACC2
            sa = wave_sum(sa); sb = wave_sum(sb);
            const float g = Aneg * softplus_f(sa + dtb), be = sigmoid_f(sb);
            beta_r[tk] = be;
            if (lane == 0) { Gs[tok] = g; Gs[64 + tok] = be; }
        }
    }
#pragma unroll
    for (int p = 0; p < 3; ++p) {
        const int col0 = p * 1024 + h * 128 + 2 * lane;
        float cw0[4], cw1[4];
#pragma unroll
        for (int i = 0; i < 4; ++i) { const f32x2 cv = *(const f32x2*)(FIN(9) + (size_t)i * GCONV + col0); cw0[i] = cv.x; cw1[i] = cv.y; }
        unsigned xw[11];
#pragma unroll
        for (int rr = 0; rr < 11; ++rr) { const int t = t0 + 8 * w - 3 + rr; xw[rr] = (t >= 0) ? *(const unsigned*)(PROJ + (rowb + t) * 4096 + col0) : 0u; }
        if (c == 127 && w == 7) {
#pragma unroll
            for (int r = 0; r < 3; ++r) { float* o = F.out + O_CONVP + ((size_t)b * 3 + r) * GCONV + col0; o[0] = bflo(xw[8 + r]); o[1] = bfhi(xw[8 + r]); }
        }
#pragma unroll
        for (int tk = 0; tk < 8; ++tk) {
            const int tok = 8 * w + tk;
            float y0 = 0.f, y1 = 0.f;
#pragma unroll
            for (int i = 0; i < 4; ++i) { y0 += cw0[i] * bflo(xw[tk + i]); y1 += cw1[i] * bfhi(xw[tk + i]); }
            y0 = silu_f(y0); y1 = silu_f(y1);
            if (p < 2) {
                const float ss = wave_sum(y0 * y0 + y1 * y1);
                const float rs = (frsq(ss + EPS)) * (p == 0 ? 0.08838834764831845f : 1.f);
                *(LAS unsigned*)((p == 0 ? qs : ks) + tok * QS_LD + 2 * lane) = pk2(y0 * rs, y1 * rs);
            } else {
                vbT[(2 * lane) * KT_LD + tok] = (bf16)f2bf(y0 * beta_r[tk]); vbT[(2 * lane + 1) * KT_LD + tok] = (bf16)f2bf(y1 * beta_r[tk]);
            }
        }
    }
    __syncthreads();
    if (w == 0) { float g = Gs[lane];
#pragma unroll
        for (int o = 1; o < 64; o <<= 1) { const float up = __shfl_up(g, o); if (lane >= o) g += up; }
        Gs[128 + lane] = g; }
    __syncthreads();
    const float glast = Gs[128 + 63];
    const size_t chunk = (size_t)unit;
    if (w < 4) {
        const int mt = w;
        bf16x8 a[4];
#pragma unroll
        for (int kk = 0; kk < 4; ++kk) a[kk] = ld8l(ks + (16 * mt + fr) * QS_LD + 32 * kk + 8 * fq);
#pragma unroll
        for (int nt = 0; nt < 4; ++nt) {
            f32x4 acc = {0.f, 0.f, 0.f, 0.f};
            if (nt <= mt) {
#pragma unroll
                for (int kk = 0; kk < 4; ++kk) acc = MFMA16(a[kk], ld8l(ks + (16 * nt + fr) * QS_LD + 32 * kk + 8 * fq), acc);
            }
            const int j = 16 * nt + fr; const float gj = Gs[128 + j];
#pragma unroll
            for (int r = 0; r < 4; ++r) { const int i = 16 * mt + 4 * fq + r;
                Am[i * AM_LD + j] = (i > j) ? Gs[64 + i] * acc[r] * __expf(Gs[128 + i] - gj) : 0.f; }
        }
    } else {
        const int nt = w - 4;
        bf16x8 bq[4];
#pragma unroll
        for (int kk = 0; kk < 4; ++kk) bq[kk] = ld8l(qs + (16 * nt + fr) * QS_LD + 32 * kk + 8 * fq);
        const int i = 16 * nt + fr; const float gi = Gs[128 + i];
        bf16* gqk = WSP(bf16, WS_GQK) + chunk * 4096;
#pragma unroll
        for (int mt = 0; mt < 4; ++mt) {
            f32x4 acc = {0.f, 0.f, 0.f, 0.f};
            if (mt <= nt) {
#pragma unroll
                for (int kk = 0; kk < 4; ++kk) acc = MFMA16(ld8l(ks + (16 * mt + fr) * QS_LD + 32 * kk + 8 * fq), bq[kk], acc);
            }
            float v[4];
#pragma unroll
            for (int r = 0; r < 4; ++r) { const int j = 16 * mt + 4 * fq + r; v[r] = (i >= j) ? acc[r] * __expf(gi - Gs[128 + j]) : 0.f; }
            v2u o; o.x = pk2(v[0], v[1]); o.y = pk2(v[2], v[3]);
            *(v2u*)(gqk + (((nt * 2 + (mt >> 1)) * 64 + (2 * (mt & 1) + (fq >> 1)) * 16 + fr) * 8 + 4 * (fq & 1))) = o;
        }
    }
    {
        const int tok = F.tid >> 3, d0 = (F.tid & 7) * 16; const float e = __expf(Gs[128 + tok]);
        bf16* gq = WSP(bf16, WS_GQ) + chunk * 8192;
#pragma unroll
        for (int hh = 0; hh < 2; ++hh) { const v4u q = *(const LAS v4u*)(qs + tok * QS_LD + d0 + 8 * hh); v4u o;
            o.x = pk2(bflo(q.x) * e, bfhi(q.x) * e); o.y = pk2(bflo(q.y) * e, bfhi(q.y) * e); o.z = pk2(bflo(q.z) * e, bfhi(q.z) * e); o.w = pk2(bflo(q.w) * e, bfhi(q.w) * e);
            *(v4u*)(gq + ((((tok >> 4) * 4 + ((F.tid & 7) >> 1)) * 64 + (2 * (F.tid & 1) + hh) * 16 + (tok & 15)) * 8)) = o; }
    }
    {
        const int dk = F.tid & 127, tg = F.tid >> 7;
        unsigned o1[8], o2[8];
#pragma unroll
        for (int i = 0; i < 8; ++i) {
            const int ta = 16 * tg + 2 * i, tb2 = ta + 1;
            const float ka = bf2f(ks[ta * QS_LD + dk]), kb = bf2f(ks[tb2 * QS_LD + dk]);
            const float ga = Gs[128 + ta], gb = Gs[128 + tb2];
            o1[i] = pk2(ka * Gs[64 + ta] * __expf(ga), kb * Gs[64 + tb2] * __expf(gb));
            o2[i] = pk2(ka * __expf(glast - ga), kb * __expf(glast - gb));
        }
        LAS v4u* d1 = (LAS v4u*)(kbgT + dk * KT_LD + 16 * tg); d1[0] = (v4u){o1[0], o1[1], o1[2], o1[3]}; d1[1] = (v4u){o1[4], o1[5], o1[6], o1[7]};
        bf16* d2 = WSP(bf16, WS_GKT) + chunk * 8192 + ((((dk >> 4) * 2 + (tg >> 1)) * 64 + (2 * (tg & 1)) * 16 + (dk & 15)) * 8);
        *(v4u*)d2 = (v4u){o2[0], o2[1], o2[2], o2[3]}; *(v4u*)(d2 + 16 * 8) = (v4u){o2[4], o2[5], o2[6], o2[7]};
    }
    if (F.tid == 0) WSP(float, WS_GDEC)[chunk] = __expf(glast);
    __syncthreads();
    LAS float* Tf = (LAS float*)(L + P2_TF); LAS float* Xf = (LAS float*)(L + P2_XF);
    if (w == 0) {
        const int blk = lane >> 5, cc = lane & 31; const LAS float* Ab = Am + (32 * blk) * AM_LD + 32 * blk;
        float t[32];
#pragma unroll
        for (int i = 0; i < 32; ++i) {
            float acc0 = (i == cc) ? 1.f : 0.f, acc1 = 0.f;
#pragma unroll
            for (int j4 = 0; j4 < (i + 3) / 4; ++j4) {
                const f32x4 a = *(const LAS f32x4*)(Ab + i * AM_LD + 4 * j4);
                if (4 * j4 + 0 < i) acc0 = __builtin_fmaf(-a.x, t[4 * j4 + 0], acc0);
                if (4 * j4 + 1 < i) acc1 = __builtin_fmaf(-a.y, t[4 * j4 + 1], acc1);
                if (4 * j4 + 2 < i) acc0 = __builtin_fmaf(-a.z, t[4 * j4 + 2], acc0);
                if (4 * j4 + 3 < i) acc1 = __builtin_fmaf(-a.w, t[4 * j4 + 3], acc1);
            }
            t[i] = acc0 + acc1;
            asm volatile("" : "+v"(t[i]));
            __builtin_amdgcn_sched_barrier(0);
        }
#pragma unroll
        for (int i = 0; i < 32; ++i) { Tf[(32 * blk + i) * AM_LD + 32 * blk + cc] = t[i]; if (blk == 0) Tf[i * AM_LD + 32 + cc] = 0.f; }
    }
    __syncthreads();
    {
        const int i = F.tid >> 4, c0 = (F.tid & 15) * 2; float x0 = 0.f, x1 = 0.f;
#pragma unroll 8
        for (int k = 0; k < 32; ++k) { const float a = Am[(32 + i) * AM_LD + k]; x0 = __builtin_fmaf(a, Tf[k * AM_LD + c0], x0); x1 = __builtin_fmaf(a, Tf[k * AM_LD + c0 + 1], x1); }
        Xf[i * 34 + c0] = x0; Xf[i * 34 + c0 + 1] = x1;
    }
    __syncthreads();
    {
        const int i = F.tid >> 4, c0 = (F.tid & 15) * 2; float x0 = 0.f, x1 = 0.f;
#pragma unroll 8
        for (int k = 0; k < 32; ++k) { const float a = Tf[(32 + i) * AM_LD + 32 + k]; x0 = __builtin_fmaf(a, Xf[k * 34 + c0], x0); x1 = __builtin_fmaf(a, Xf[k * 34 + c0 + 1], x1); }
        Tf[(32 + i) * AM_LD + c0] = -x0; Tf[(32 + i) * AM_LD + c0 + 1] = -x1;
    }
    __syncthreads();
    {
        const int i = F.tid >> 3, c0 = (F.tid & 7) * 8; const f32x4 a = *(const LAS f32x4*)(Tf + i * AM_LD + c0), b2 = *(const LAS f32x4*)(Tf + i * AM_LD + c0 + 4);
        *(LAS v4u*)(Tb + i * TB_LD + c0) = (v4u){pk2(a.x, a.y), pk2(a.z, a.w), pk2(b2.x, b2.y), pk2(b2.z, b2.w)};
    }
    __syncthreads();
    {
        bf16x8 tb[4][2];
#pragma unroll
        for (int x = 0; x < 4; ++x)
#pragma unroll
            for (int s = 0; s < 2; ++s) tb[x][s] = ld8l(Tb + (16 * x + fr) * TB_LD + 32 * s + 8 * fq);
        const bf16x8 bv0 = ld8l(vbT + (16 * w + fr) * KT_LD + 8 * fq), bv1 = ld8l(vbT + (16 * w + fr) * KT_LD + 32 + 8 * fq);
        f32x4* gu = (f32x4*)(WSP(float, WS_GU) + chunk * 8192) + (size_t)w * 256 + lane;
#pragma unroll
        for (int mt = 0; mt < 4; ++mt) { f32x4 acc = {0.f, 0.f, 0.f, 0.f}; acc = MFMA16(tb[mt][0], bv0, acc); acc = MFMA16(tb[mt][1], bv1, acc); gu[mt * 64] = acc; }
        const bf16x8 ak0 = ld8l(kbgT + (16 * w + fr) * KT_LD + 8 * fq), ak1 = ld8l(kbgT + (16 * w + fr) * KT_LD + 32 + 8 * fq);
        bf16* gw = WSP(bf16, WS_GW) + chunk * 8192;
#pragma unroll
        for (int nt = 0; nt < 4; ++nt) { f32x4 acc = {0.f, 0.f, 0.f, 0.f}; acc = MFMA16(ak0, tb[nt][0], acc); acc = MFMA16(ak1, tb[nt][1], acc);
            v2u o; o.x = pk2(acc[0], acc[1]); o.y = pk2(acc[2], acc[3]);
            *(v2u*)(gw + (((nt * 4 + (w >> 1)) * 64 + (2 * (w & 1) + (fq >> 1)) * 16 + fr) * 8 + 4 * (fq & 1))) = o; }
    }
    __syncthreads();
}

constexpr int S2_Y = 0;
constexpr int S2_AB = 6144;
constexpr int S2_DOT = 6400;
constexpr int S2_U = 6656;
constexpr int S2_W = 8704;
constexpr int S2_VN = 10752;
__device__ __forceinline__ void p2_sample(Frame& F, int unit) {
    const int h = unit & 7, bs = unit >> 3, tid = F.tid, lane = F.lane, w = F.wave;
    LAS unsigned char* L = F.lds; asm volatile("" : "+v"(L));
    LAS float* Y = (LAS float*)(L + S2_Y); LAS float* AB = (LAS float*)(L + S2_AB); LAS float* DOT = (LAS float*)(L + S2_DOT);
    LAS float* U = (LAS float*)(L + S2_U); LAS float* W = (LAS float*)(L + S2_W); LAS float* VN = (LAS float*)(L + S2_VN);
    const bf16* PROJ = WSP(bf16, WS_PROJ); const bf16* XNA = WSP(bf16, WS_XNA); const float* WAB = WSP(float, WS_WAB);
    const size_t row0 = (size_t)MP + bs * 4;
    if (tid < 384) {
        const int part = tid >> 7, cc = tid & 127, col = part * 1024 + h * 128 + cc;
        float buf[7];
#pragma unroll
        for (int r = 0; r < 3; ++r) buf[r] = FIN(5)[((size_t)bs * 3 + r) * GCONV + col];
#pragma unroll
        for (int i = 0; i < 4; ++i) buf[3 + i] = bf2f(PROJ[(row0 + i) * 4096 + col]);
#pragma unroll
        for (int r = 0; r < 3; ++r) F.out[O_CONVS + ((size_t)bs * 3 + r) * GCONV + col] = buf[4 + r];
        float cw[4];
#pragma unroll
        for (int i = 0; i < 4; ++i) cw[i] = FIN(9)[(size_t)i * GCONV + col];
#pragma unroll
        for (int i = 0; i < 4; ++i) { float y = 0.f;
#pragma unroll
            for (int k = 0; k < 4; ++k) y += cw[k] * buf[i + k];
            Y[(part * 4 + i) * 128 + cc] = silu_f(y); }
    }
    {
        const int i = w >> 1, which = w & 1; const bf16* xr = XNA + (row0 + i) * DM; const float* wr = WAB + (size_t)(which * 8 + h) * DM; float s = 0.f;
        for (int k = lane; k < DM; k += 64) s += bf2f(xr[k]) * wr[k];
        s = wave_sum(s); if (lane == 0) AB[which * 4 + i] = s;
    }
    __syncthreads();
    {
        const int part = w >> 2, i = w & 3; LAS float* y = Y + (part * 4 + i) * 128; const float a = y[lane], bq = y[64 + lane];
        const float ss = wave_sum(a * a + bq * bq); const float rs = (frsq(ss + EPS)) * (part == 0 ? 0.08838834764831845f : 1.f);
        y[lane] = a * rs; y[64 + lane] = bq * rs;
    }
    if (tid == 0) { const float Aneg = -expf(FIN(10)[h]), dtb = FIN(11)[h]; float gc = 0.f;
        for (int i = 0; i < 4; ++i) { const float g = Aneg * softplus_f(AB[i] + dtb); gc += g; AB[8 + i] = g; AB[12 + i] = 1.f / (1.f + expf(-AB[4 + i])); AB[16 + i] = gc; } }
    __syncthreads();
    {
#pragma unroll
        for (int pp = 0; pp < 4; ++pp) { const int pr = 4 * w + pp, which = pr >> 4, i = (pr >> 2) & 3, j = pr & 3;
            const LAS float* x = Y + ((which == 0 ? 1 : 0) * 4 + i) * 128; const LAS float* y = Y + (1 * 4 + j) * 128;
            float s = x[lane] * y[lane] + x[64 + lane] * y[64 + lane]; s = wave_sum(s); if (lane == 0) DOT[pr] = s; }
    }
    __syncthreads();
    float g_[4], be[4], gc[4];
#pragma unroll
    for (int i = 0; i < 4; ++i) { g_[i] = AB[8 + i]; be[i] = AB[12 + i]; gc[i] = AB[16 + i]; }
    float Tm[4][4];
    {
        float A[4][4];
#pragma unroll
        for (int i = 0; i < 4; ++i)
#pragma unroll
            for (int j = 0; j < 4; ++j) A[i][j] = (i > j) ? be[i] * DOT[i * 4 + j] * expf(gc[i] - gc[j]) : 0.f;
#pragma unroll
        for (int cc = 0; cc < 4; ++cc)
#pragma unroll
            for (int i = 0; i < 4; ++i) { float acc = (i == cc) ? 1.f : 0.f;
#pragma unroll
                for (int j = 0; j < 4; ++j) if (j < i) acc -= A[i][j] * Tm[j][cc];
                Tm[i][cc] = acc; }
    }
    {
        const int i = tid >> 7, x = tid & 127; float su = 0.f, sw = 0.f;
#pragma unroll
        for (int j = 0; j < 4; ++j) { su += Tm[i][j] * Y[(2 * 4 + j) * 128 + x] * be[j]; sw += Tm[i][j] * Y[(1 * 4 + j) * 128 + x] * be[j] * expf(gc[j]); }
        U[i * 128 + x] = su; W[i * 128 + x] = sw;
    }
    __syncthreads();
    const float* S0 = FIN(4) + ((size_t)bs * GH + h) * 128 * 128;
    float qs_acc;
    {
        const int i = tid >> 7, dv = tid & 127; float p = 0.f, qq = 0.f;
        const LAS float* wr = W + i * 128; const LAS float* qr = Y + (0 * 4 + i) * 128;
#pragma unroll 16
        for (int dk = 0; dk < 128; ++dk) { const float s = S0[(size_t)dk * 128 + dv]; p += wr[dk] * s; qq += qr[dk] * s; }
        VN[i * 128 + dv] = U[i * 128 + dv] - p; qs_acc = qq * expf(gc[i]);
    }
    __syncthreads();
    {
        const int i = tid >> 7, dv = tid & 127; float o = qs_acc;
#pragma unroll
        for (int j = 0; j < 4; ++j) if (j <= i) o += DOT[16 + i * 4 + j] * expf(gc[i] - gc[j]) * VN[j * 128 + dv];
        WSP(float, WS_OGDN)[(row0 + i) * DM + h * 128 + dv] = o;
    }
    {
        const int dv = tid & 127, dg = tid >> 7; const float el = expf(gc[3]);
        float kd[4], vn[4];
#pragma unroll
        for (int j = 0; j < 4; ++j) { kd[j] = expf(gc[3] - gc[j]); vn[j] = VN[j * 128 + dv]; }
        float* So = F.out + O_GDNS + ((size_t)bs * GH + h) * 128 * 128;
#pragma unroll 8
        for (int dk = dg * 32; dk < dg * 32 + 32; ++dk) { float s = S0[(size_t)dk * 128 + dv] * el;
#pragma unroll
            for (int j = 0; j < 4; ++j) s += Y[(1 * 4 + j) * 128 + dk] * kd[j] * vn[j];
            So[(size_t)dk * 128 + dv] = s; }
    }
    (void)g_;
    __syncthreads();
}

constexpr int P3_S = 0;
constexpr int P3_VN = 16384;
__device__ __forceinline__ void p3_scan(Frame& F, int bh, int s) {
    const int lane = F.lane, w = F.wave, fr = lane & 15, fq = lane >> 4;
    const int b = bh >> 3, h = bh & 7;
    LAS bf16* Sl = (LAS bf16*)(F.lds + P3_S); LAS bf16* Vl = (LAS bf16*)(F.lds + P3_VN);
    const bf16* GW = WSP(bf16, WS_GW); const bf16* GQ = WSP(bf16, WS_GQ); const bf16* GKT = WSP(bf16, WS_GKT); const bf16* GQK = WSP(bf16, WS_GQK);
    const float* GU = WSP(float, WS_GU); const float* GDEC = WSP(float, WS_GDEC);
    float* OG = WSP(float, WS_OGDN);
    f32x4 Sacc[2];
#pragma unroll
    for (int n = 0; n < 2; ++n) { Sacc[n] = (f32x4){0.f, 0.f, 0.f, 0.f}; v2u z = {0u, 0u}; *(LAS v2u*)(Sl + (n * 16 + fr) * 136 + 16 * w + 4 * fq) = z; }
    __syncthreads();
    const int m = w & 3;
    struct P3Ops { bf16x8 a1[4], ak0, ak1; v4u x0, x1; float dec; };
    P3Ops R0, R1, R2;
#define P3_FETCH(R, cc) do { const size_t ch_ = (size_t)bh * NCH + (cc); \
        const bf16* p1_ = (w < 4 ? GW : GQ) + ch_ * 8192 + (size_t)(m * 4 * 64 + lane) * 8;        \
        _Pragma("unroll") for (int k_ = 0; k_ < 4; ++k_) R.a1[k_] = ld8(p1_ + 512 * k_); \
        const bf16* pk_ = GKT + ch_ * 8192 + (size_t)(w * 2 * 64 + lane) * 8; R.ak0 = ld8(pk_); R.ak1 = ld8(pk_ + 512); \
        const unsigned char* px_ = w < 4 ? (const unsigned char*)(GU + ch_ * 8192 + ((size_t)(2 * s) * 256 + m * 64 + lane) * 4) : (const unsigned char*)(GQK + ch_ * 4096 + (size_t)(m * 2 * 64 + lane) * 8); \
        R.x0 = *(const v4u*)px_; R.x1 = *(const v4u*)(px_ + (w < 4 ? 4096 : 1024));        \
        R.dec = GDEC[ch_]; } while (0)
#define P3_STEP(R, c) do { \
        f32x4 acc[2]; \
        _Pragma("unroll") for (int n = 0; n < 2; ++n) { acc[n] = (f32x4){0.f, 0.f, 0.f, 0.f}; \
            _Pragma("unroll") for (int k = 0; k < 4; ++k) acc[n] = MFMA16(R.a1[k], ld8l(Sl + (n * 16 + fr) * 136 + 32 * k + 8 * fq), acc[n]); } \
        if (w < 4) { _Pragma("unroll") for (int n = 0; n < 2; ++n) { const f32x4 vn = __builtin_bit_cast(f32x4, n == 0 ? R.x0 : R.x1) - acc[n]; v2u o; o.x = pk2(vn[0], vn[1]); o.y = pk2(vn[2], vn[3]); \
            *(LAS v2u*)(Vl + (n * 16 + fr) * 72 + 16 * m + 4 * fq) = o; } } \
        asm volatile("s_waitcnt lgkmcnt(0)\n\ts_barrier" ::: "memory"); \
        bf16x8 v0[2], v1[2]; \
        _Pragma("unroll") for (int n = 0; n < 2; ++n) { v0[n] = ld8l(Vl + (n * 16 + fr) * 72 + 8 * fq); v1[n] = ld8l(Vl + (n * 16 + fr) * 72 + 32 + 8 * fq); } \
        if (w >= 4) { _Pragma("unroll") for (int n = 0; n < 2; ++n) { acc[n] = MFMA16(__builtin_bit_cast(bf16x8, R.x0), v0[n], acc[n]); acc[n] = MFMA16(__builtin_bit_cast(bf16x8, R.x1), v1[n], acc[n]); \
            float* o = OG + ((size_t)b * PT + (c) * CHUNK + 16 * m + 4 * fq) * DM + h * 128 + 32 * s + 16 * n + fr; \
            _Pragma("unroll") for (int r = 0; r < 4; ++r) o[(size_t)r * DM] = acc[n][r]; } } \
        { float d_ = R.dec;        \
          _Pragma("unroll") for (int n = 0; n < 2; ++n) asm volatile("v_mul_f32 %0, %0, %4\n\tv_mul_f32 %1, %1, %4\n\tv_mul_f32 %2, %2, %4\n\tv_mul_f32 %3, %3, %4" : "+v"(Sacc[n][0]), "+v"(Sacc[n][1]), "+v"(Sacc[n][2]), "+v"(Sacc[n][3]) : "v"(d_)); } \
        _Pragma("unroll") for (int n = 0; n < 2; ++n) { Sacc[n] = MFMA16(R.ak0, v0[n], Sacc[n]); Sacc[n] = MFMA16(R.ak1, v1[n], Sacc[n]); \
            v2u o; o.x = pk2(Sacc[n][0], Sacc[n][1]); o.y = pk2(Sacc[n][2], Sacc[n][3]); *(LAS v2u*)(Sl + (n * 16 + fr) * 136 + 16 * w + 4 * fq) = o; } \
        asm volatile("s_waitcnt lgkmcnt(0)\n\ts_barrier" ::: "memory"); } while (0)
    P3_FETCH(R0, 0); __builtin_amdgcn_sched_barrier(0); P3_FETCH(R1, 1); __builtin_amdgcn_sched_barrier(0); P3_FETCH(R2, 2); __builtin_amdgcn_sched_barrier(0);
    static_assert(NCH % 3 == 2, "ring schedule below assumes NCH = 3k + 2");
#pragma unroll 1
    for (int c = 0; c + 3 <= NCH; c += 3) {
        P3_STEP(R0, c);     P3_FETCH(R0, (c + 3 < NCH ? c + 3 : NCH - 1));
        P3_STEP(R1, c + 1); P3_FETCH(R1, (c + 4 < NCH ? c + 4 : NCH - 1));
        P3_STEP(R2, c + 2); P3_FETCH(R2, (c + 5 < NCH ? c + 5 : NCH - 1));
    }
    P3_STEP(R0, NCH - 2); P3_STEP(R1, NCH - 1);
#undef P3_FETCH
#undef P3_STEP
    float* So = F.out + O_GDNP + ((size_t)bh * 128) * 128;
#pragma unroll
    for (int n = 0; n < 2; ++n)
#pragma unroll
        for (int r = 0; r < 4; ++r) So[(size_t)(16 * w + 4 * fq + r) * 128 + 32 * s + 16 * n + fr] = Sacc[n][r];
}

__device__ __forceinline__ void p4_row(Frame& F, int row) {
    const int lane = F.lane;
    const float* o = WSP(float, WS_OGDN) + (size_t)row * DM + 16 * lane;
    const bf16* z = WSP(bf16, WS_PROJ) + (size_t)row * 4096 + 3072 + 16 * lane;
    f32x4 v[4]; float ss = 0.f;
#pragma unroll
    for (int j = 0; j < 4; ++j) { v[j] = *(const f32x4*)(o + 4 * j); ss += (v[j].x * v[j].x + v[j].y * v[j].y) + (v[j].z * v[j].z + v[j].w * v[j].w); }
    ss += dpp_f<DPP_XOR1>(ss); ss += dpp_f<DPP_XOR2>(ss); ss += dpp_f<DPP_HMIR>(ss);
    const float rstd = frsq(ss * (1.f / 128.f) + EPS);
    const v4u z0 = *(const v4u*)z, z1 = *(const v4u*)(z + 8);
    const float* gn = FIN(12) + (16 * lane & 127);
    float zz[16] = {bflo(z0.x), bfhi(z0.x), bflo(z0.y), bfhi(z0.y), bflo(z0.z), bfhi(z0.z), bflo(z0.w), bfhi(z0.w),
                    bflo(z1.x), bfhi(z1.x), bflo(z1.y), bfhi(z1.y), bflo(z1.z), bfhi(z1.z), bflo(z1.w), bfhi(z1.w)};
    unsigned ow[8];
#pragma unroll
    for (int j = 0; j < 8; ++j) { const float a = v[j >> 1][(2 * j) & 3] * rstd * gn[2 * j] * silu_f(zz[2 * j]), bq = v[j >> 1][(2 * j + 1) & 3] * rstd * gn[2 * j + 1] * silu_f(zz[2 * j + 1]); ow[j] = pk2(a, bq); }
    v4u* dst = (v4u*)(WSP(bf16, WS_OG) + (size_t)row * DM + 16 * lane);
    dst[0] = (v4u){ow[0], ow[1], ow[2], ow[3]}; dst[1] = (v4u){ow[4], ow[5], ow[6], ow[7]};
}

typedef __bf16 bf16x2_t __attribute__((ext_vector_type(2)));
__device__ __forceinline__ float dot2_bf16(unsigned w, unsigned x, float acc) { return __builtin_amdgcn_fdot2_f32_bf16(__builtin_bit_cast(bf16x2_t, w), __builtin_bit_cast(bf16x2_t, x), acc, false); }
__device__ __forceinline__ float u2f(unsigned u) { return __builtin_bit_cast(float, u); }
__device__ __forceinline__ unsigned f2u(float f) { return __builtin_bit_cast(unsigned, f); }

constexpr int P8_MAXU = 4;
constexpr int P8_WAVE = P8_MAXU * 2048 + 1024;
constexpr int P8_TOP = 0;
constexpr int P8_TAB = 8 * P8_WAVE;
__device__ __forceinline__ void p8_init_tab(Frame& F) {
    LAS unsigned char* tab = F.lds + P8_TAB;
    if (F.tid < 64) { const int k = F.tid; int i = 0, j = 0;
        if (k < 16) { i = 0; j = k; } else if (k < 24) { i = 1; j = k - 16; } else if (k < 29) { i = 2; j = k - 24; } else if (k < 33) { i = 3; j = k - 29; }
        else if (k < 36) { i = 4; j = k - 33; } else if (k < 38) { i = 5; j = k - 36; } else if (k < 40) { i = 6; j = k - 38; } else if (k < 42) { i = 7; j = k - 40; } else if (k < 50) { i = k - 34; j = 0; }
        tab[k] = (unsigned char)i; tab[64 + k] = (unsigned char)j; }
    __syncthreads();
}
__device__ __forceinline__ int fkey(float x) { const int b = __builtin_bit_cast(int, x); return b ^ ((b >> 31) & 0x7fffffff); }
__device__ __forceinline__ float fkey_inv(int k) { return __builtin_bit_cast(float, k ^ ((k >> 31) & 0x7fffffff)); }
template <int CTRL> __device__ __forceinline__ int dpp_i(int x) { return __builtin_amdgcn_update_dpp(0, x, CTRL, 0xF, 0xF, true); }
__device__ __forceinline__ int imax(int a, int b) { return a > b ? a : b; }
__device__ __forceinline__ int imin(int a, int b) { return a < b ? a : b; }
__device__ __forceinline__ int row_imax16(int x) {
    x = imax(x, dpp_i<0xB1>(x)); x = imax(x, dpp_i<0x4E>(x)); x = imax(x, dpp_i<0x141>(x)); x = imax(x, dpp_i<0x140>(x)); return x;
}
#define ICSWAP(a, b) { const int hi_ = imax(a, b), lo_ = imin(a, b); a = hi_; b = lo_; }
constexpr int IKEY_MIN = (int)0x80000000;
template <int NR>
__device__ __forceinline__ void p8_run(Frame& F, int layer, int w, int rq, int u0, int ustride, int nu) {
    int lane_ = F.lane; asm volatile("" : "+v"(lane_));
    const int lane = lane_, fr = lane & 15, fq = lane >> 4;
    LAS unsigned char* L = F.lds; asm volatile("" : "+v"(L));
    LAS int* toplw = (LAS int*)(L + P8_TOP + F.wave * P8_WAVE);
    LAS float* wins = (LAS float*)(L + P8_TOP + F.wave * P8_WAVE + P8_MAXU * 2048);
    const LAS unsigned char* tab = L + P8_TAB;
    const bf16* Qb = WSP(bf16, WS_QPEER) + (size_t)fr * 2048 + w * 256 + 8 * fq;
    const bf16* SK = WSP(bf16, WS_SUBK) + (size_t)((layer * 8 + w) * 2) * 16384 + (size_t)fr * 128 + 8 * fq;
#pragma unroll 1
    for (int p = 0; p < 2; ++p) {
        bf16x8 bk[32], aq[4];
#pragma unroll
        for (int i = 0; i < 32; ++i) bk[i] = ld8(SK + (size_t)p * 16384 + (size_t)(i >> 2) * 2048 + 32 * (i & 3));
#pragma unroll
        for (int ks = 0; ks < 4; ++ks) aq[ks] = ld8(Qb + (size_t)u0 * 16 * 2048 + p * 128 + 32 * ks);
#pragma unroll 1
        for (int k = 0; k < nu; ++k) {
            LAS int* topl = toplw + k * 512;
            int s[NR][8];
#pragma unroll
            for (int nt = 0; nt < 8; ++nt) { f32x4 acc = {0.f, 0.f, 0.f, 0.f};
#pragma unroll
                for (int ks = 0; ks < 4; ++ks) acc = MFMA16(aq[ks], bk[nt * 4 + ks], acc);
                if (NR == 4) {
#pragma unroll
                    for (int r = 0; r < NR; ++r) s[r][nt] = fkey(u2f((f2u(acc[r]) & ~127u) | (unsigned)(16 * nt + fr)));
                } else { const float av = rq == 0 ? acc[0] : rq == 1 ? acc[1] : rq == 2 ? acc[2] : acc[3]; s[0][nt] = fkey(u2f((f2u(av) & ~127u) | (unsigned)(16 * nt + fr))); } }
            { const int un = u0 + (k + 1 < nu ? k + 1 : k) * ustride;
#pragma unroll
              for (int ks = 0; ks < 4; ++ks) aq[ks] = ld8(Qb + (size_t)un * 16 * 2048 + p * 128 + 32 * ks); }
#pragma unroll
            for (int r = 0; r < NR; ++r) {
                ICSWAP(s[r][0], s[r][1]) ICSWAP(s[r][2], s[r][3]) ICSWAP(s[r][4], s[r][5]) ICSWAP(s[r][6], s[r][7])
                ICSWAP(s[r][0], s[r][2]) ICSWAP(s[r][1], s[r][3]) ICSWAP(s[r][4], s[r][6]) ICSWAP(s[r][5], s[r][7])
                ICSWAP(s[r][1], s[r][2]) ICSWAP(s[r][5], s[r][6]) ICSWAP(s[r][0], s[r][4]) ICSWAP(s[r][3], s[r][7])
                ICSWAP(s[r][1], s[r][5]) ICSWAP(s[r][2], s[r][6]) ICSWAP(s[r][1], s[r][4]) ICSWAP(s[r][3], s[r][6])
                ICSWAP(s[r][2], s[r][4]) ICSWAP(s[r][3], s[r][5]) ICSWAP(s[r][3], s[r][4]) }
            int mine[NR];
#pragma unroll
            for (int r = 0; r < NR; ++r) mine[r] = IKEY_MIN;
#pragma unroll 1
            for (int rd = 0; rd < 16; ++rd) {
                const bool me = fr == rd;
#pragma unroll
                for (int r = 0; r < NR; ++r) {
                    const int mx = row_imax16(s[r][0]);
                    const bool pop = s[r][0] == mx;
#pragma unroll
                    for (int i = 0; i < 7; ++i) s[r][i] = pop ? s[r][i + 1] : s[r][i];
                    s[r][7] = pop ? IKEY_MIN : s[r][7];
                    mine[r] = me ? mx : mine[r];
                }
            }
#pragma unroll
            for (int r = 0; r < NR; ++r) topl[((4 * fq + (NR == 4 ? r : rq)) * 2 + p) * 16 + fr] = mine[r];
        }
    }
    LDS_WAIT();
#pragma unroll 1
    for (int k = 0; k < nu; ++k) {
    LAS int* topl = toplw + k * 512;
    const int r0 = (u0 + k * ustride) * 16;
    int c[NR][4];
#pragma unroll
    for (int r = 0; r < NR; ++r) { const int tk = 4 * fq + (NR == 4 ? r : rq);
#pragma unroll
        for (int m = 0; m < 4; ++m) { const int kc = fr + 16 * m; int cv = IKEY_MIN;
            if (kc < 50) { const int i = tab[kc], j = tab[64 + kc]; const float s1 = u2f(f2u(fkey_inv(topl[(tk * 2 + 0) * 16 + i])) & ~127u), s2 = u2f(f2u(fkey_inv(topl[(tk * 2 + 1) * 16 + j])) & ~127u);
                cv = fkey(u2f((f2u(s1 + s2) & ~63u) | (unsigned)kc)); }
            c[r][m] = cv; }
        ICSWAP(c[r][0], c[r][1]) ICSWAP(c[r][2], c[r][3]) ICSWAP(c[r][0], c[r][2]) ICSWAP(c[r][1], c[r][3]) ICSWAP(c[r][1], c[r][2]) }
    int minec[NR];
#pragma unroll
    for (int r = 0; r < NR; ++r) minec[r] = IKEY_MIN;
#pragma unroll 1
    for (int rd = 0; rd < 16; ++rd) {
        const bool me = fr == rd;
#pragma unroll
        for (int r = 0; r < NR; ++r) {
            const int mx = row_imax16(c[r][0]);
            const bool pop = c[r][0] == mx;
            c[r][0] = pop ? c[r][1] : c[r][0]; c[r][1] = pop ? c[r][2] : c[r][1]; c[r][2] = pop ? c[r][3] : c[r][2]; c[r][3] = pop ? IKEY_MIN : c[r][3];
            minec[r] = me ? mx : minec[r];
        }
    }
#pragma unroll
    for (int r = 0; r < NR; ++r) wins[(4 * fq + (NR == 4 ? r : rq)) * 16 + fr] = fkey_inv(minec[r]);
    LDS_WAIT();
    if (NR == 4 || (fr >> 2) == rq) {
        const int tk = 4 * fq + (fr >> 2), q4 = fr & 3;
        const float w0 = wins[tk * 16]; float den = 0.f;
#pragma unroll
        for (int rd = 0; rd < 16; ++rd) den += __expf(wins[tk * 16 + rd] - w0);
        const float inv = 1.f / den;
        int e[4]; float g[4];
#pragma unroll
        for (int x = 0; x < 4; ++x) { const float wv = wins[tk * 16 + 4 * q4 + x]; const int kc = (int)(f2u(wv) & 63u); const int i = tab[kc], j = tab[64 + kc];
            e[x] = (int)(f2u(fkey_inv(topl[(tk * 2 + 0) * 16 + i])) & 127u) * 128 + (int)(f2u(fkey_inv(topl[(tk * 2 + 1) * 16 + j])) & 127u); g[x] = __expf(wv - w0) * inv; }
        unsigned short* pei = WSP(unsigned short, WS_PEI) + (size_t)(r0 + tk) * 128 + w * 16 + 4 * q4; float* peg = WSP(float, WS_PEG) + (size_t)(r0 + tk) * 128 + w * 16 + 4 * q4;
        *(v2u*)pei = (v2u){(unsigned)e[0] | ((unsigned)e[1] << 16), (unsigned)e[2] | ((unsigned)e[3] << 16)};
        *(f32x4*)peg = (f32x4){g[0], g[1], g[2], g[3]};
    }
    LDS_WAIT();
    }
}
__device__ __forceinline__ void p8_phase(Frame& F, int layer) {
    p8_init_tab(F);
    for (int ub = F.bid; ub < MP / 16; ub += F.G * P8_MAXU) { const int left = (MP / 16 - ub + F.G - 1) / F.G; p8_run<4>(F, layer, F.wave, 0, ub, F.G, left < P8_MAXU ? left : P8_MAXU); }
    for (int qu = F.bid * 8 + F.wave; qu < (MS / 16) * 8 * 4 * 8; qu += F.G * 8) { if ((qu & 7) == 0) { const int x = qu >> 3; p8_run<1>(F, layer, (x >> 2) & 7, x & 3, MP / 16 + (x >> 5), 0, 1); } }
}

constexpr size_t PE_SLICE_BYTES = (size_t)NEXP * 128;
__device__ __forceinline__ f32x2 p9_cvt(unsigned w, bool hi) { return hi ? __builtin_amdgcn_cvt_pk_f32_fp8((int)w, true) : __builtin_amdgcn_cvt_pk_f32_fp8((int)w, false); }
__device__ __forceinline__ f32x2 fma2(f32x2 a, f32x2 b, f32x2 c) { return __builtin_elementwise_fma(a, b, c); }
__device__ __forceinline__ float p9_dot16(const v4u u, const f32x2 (&h)[8]) {
    f32x2 a = {0.f, 0.f}, b = {0.f, 0.f};
    a = fma2(p9_cvt(u.x, false), h[0], a); b = fma2(p9_cvt(u.x, true), h[1], b); a = fma2(p9_cvt(u.y, false), h[2], a); b = fma2(p9_cvt(u.y, true), h[3], b);
    a = fma2(p9_cvt(u.z, false), h[4], a); b = fma2(p9_cvt(u.z, true), h[5], b); a = fma2(p9_cvt(u.w, false), h[6], a); b = fma2(p9_cvt(u.w, true), h[7], b);
    a = a + b; return a.x + a.y;
}
__device__ __forceinline__ void p9_axpy16(const v4u v, float c, f32x2 (&o)[8]) {
    const f32x2 cc = {c, c};
    o[0] = fma2(p9_cvt(v.x, false), cc, o[0]); o[1] = fma2(p9_cvt(v.x, true), cc, o[1]); o[2] = fma2(p9_cvt(v.y, false), cc, o[2]); o[3] = fma2(p9_cvt(v.y, true), cc, o[3]);
    o[4] = fma2(p9_cvt(v.z, false), cc, o[4]); o[5] = fma2(p9_cvt(v.z, true), cc, o[5]); o[6] = fma2(p9_cvt(v.w, false), cc, o[6]); o[7] = fma2(p9_cvt(v.w, true), cc, o[7]);
}
#define P9_GATHER(S, iw) do { _Pragma("unroll") for (int j_ = 0; j_ < 8; ++j_) { const unsigned w_ = (iw)[j_ >> 1]; const unsigned id_ = (j_ & 1) ? (w_ >> 16) : (w_ & 0xffffu); \
        S[j_] = *(const v4u*)(tab + ((id_ << 7) + sub16)); } } while (0)
__device__ __forceinline__ float swapsum16(float x, float y) { unsigned a = __builtin_bit_cast(unsigned, x), b = __builtin_bit_cast(unsigned, y); PSWAP16(a, b); return __builtin_bit_cast(float, a) + __builtin_bit_cast(float, b); }
__device__ __forceinline__ float swapsum32(float x, float y) { unsigned a = __builtin_bit_cast(unsigned, x), b = __builtin_bit_cast(unsigned, y); PSWAP32(a, b); return __builtin_bit_cast(float, a) + __builtin_bit_cast(float, b); }

__device__ __forceinline__ void p9u_wave(Frame& F, int layer, int slice, int first, int stride) {
    int lane_ = F.lane; asm volatile("" : "+v"(lane_));
    const int lane = lane_, gi = lane >> 3, sub = lane & 7;
    const unsigned char* tab = WSP(unsigned char, WS_PU) + (size_t)(layer * 8 + slice) * PE_SLICE_BYTES;
    const unsigned sub16 = (unsigned)sub * 16u;
    const unsigned char* hbase = (const unsigned char*)(WSP(bf16, WS_XNB) + slice * 128 + sub * 16);
    const unsigned char* ibase = (const unsigned char*)(WSP(unsigned short, WS_PEI) + gi * 16);
    unsigned* pa = WSP(unsigned, WS_PA) + slice * 64 + lane;
    int t = first; if (t >= MTOK) return;
    v4u ia, ib, ha, hb, nia, nib, nha, nhb, A[8], B[8];
#define P9U_META(tt, xa, xb, ya, yb) do { const v4u* ip_ = (const v4u*)(ibase + (size_t)(tt) * 256); xa = ip_[0]; xb = ip_[1]; const v4u* hp_ = (const v4u*)(hbase + (size_t)(tt) * 2048); ya = hp_[0]; yb = hp_[1]; } while (0)
    P9U_META(t, ia, ib, ha, hb);
    P9_GATHER(A, ia);
    const bool b0 = sub & 1, b1 = sub & 2, b2 = sub & 4;
#pragma unroll 1
    for (;;) {
        const int tn = t + stride; const bool more = tn < MTOK; const int tl = more ? tn : t;
        P9U_META(tl, nia, nib, nha, nhb);
        P9_GATHER(B, ib);
        f32x2 h[8];
#pragma unroll
        for (int k = 0; k < 4; ++k) { h[k] = (f32x2){bflo(ha[k]), bfhi(ha[k])}; h[4 + k] = (f32x2){bflo(hb[k]), bfhi(hb[k])}; }
        float p[16];
#pragma unroll
        for (int j = 0; j < 8; ++j) p[j] = p9_dot16(A[j], h);
        P9_GATHER(A, nia);
#pragma unroll
        for (int j = 0; j < 8; ++j) p[8 + j] = p9_dot16(B[j], h);
        float q[8], r[4], sv[2];
#pragma unroll
        for (int i = 0; i < 8; ++i) { const float keep = b2 ? p[8 + i] : p[i], send = b2 ? p[i] : p[8 + i]; q[i] = keep + dpp_f<DPP_HMIR>(send); }
#pragma unroll
        for (int i = 0; i < 4; ++i) { const float keep = b0 ? q[2 * i + 1] : q[2 * i], send = b0 ? q[2 * i] : q[2 * i + 1]; r[i] = keep + dpp_f<DPP_XOR1>(send); }
#pragma unroll
        for (int i = 0; i < 2; ++i) { const float keep = b1 ? r[2 * i + 1] : r[2 * i], send = b1 ? r[2 * i] : r[2 * i + 1]; sv[i] = keep + dpp_f<DPP_XOR2>(send); }
        pa[(size_t)t * 512] = pk2(sv[0], sv[1]);
        if (!more) break;
        t = tn; ia = nia; ib = nib; ha = nha; hb = nhb;
    }
#undef P9U_META
}

__device__ __forceinline__ void p9v_wave(Frame& F, int layer, int slice, int first, int stride, int mode) {
    int lane_ = F.lane; asm volatile("" : "+v"(lane_));
    const int lane = lane_, gi = lane >> 3, sub = lane & 7, j0 = 8 * (sub >> 2) + (sub & 3);
    const unsigned char* tab = WSP(unsigned char, WS_PV) + (size_t)(layer * 8 + slice) * PE_SLICE_BYTES;
    const unsigned sub16 = (unsigned)sub * 16u;
    const unsigned char* ibase = (const unsigned char*)(WSP(unsigned short, WS_PEI) + gi * 16);
    const unsigned* pab = WSP(unsigned, WS_PA) + lane;
    const float* pegb = WSP(float, WS_PEG) + gi * 16 + j0;
    const int eoff = slice * 128 + sub * 16 + gi;
    float* xsb = WSP(float, WS_XS) + eoff;
    int t = first; if (t >= MTOK) return;
    v4u ia, ib, nia, nib, A[8], B[8];
    unsigned pw[8], npw[8]; float g0, g1, ng0, ng1, x0, x1, nx0, nx1;
#define P9V_META(tt, xa, xb, pp, ga, gb, ya, yb) do { const v4u* ip_ = (const v4u*)(ibase + (size_t)(tt) * 256); xa = ip_[0]; xb = ip_[1]; \
        _Pragma("unroll") for (int x_ = 0; x_ < 8; ++x_) pp[x_] = pab[(size_t)(tt) * 512 + x_ * 64]; \
        ga = pegb[(size_t)(tt) * 128]; gb = pegb[(size_t)(tt) * 128 + 4]; ya = xsb[(size_t)(tt) * DM]; yb = xsb[(size_t)(tt) * DM + 8]; } while (0)
    P9V_META(t, ia, ib, pw, g0, g1, x0, x1);
    P9_GATHER(A, ia);
#pragma unroll 1
    for (;;) {
        const int tn = t + stride; const bool more = tn < MTOK; const int tl = more ? tn : t;
        P9V_META(tl, nia, nib, npw, ng0, ng1, nx0, nx1);
        P9_GATHER(B, ib);
        float alo = 0.f, ahi = 0.f;
#pragma unroll
        for (int x = 0; x < 8; ++x) { alo += bflo(pw[x]); ahi += bfhi(pw[x]); }
        const float c0 = gelu_tanh(alo * 0.03125f) * g0 * 0.0625f, c1 = gelu_tanh(ahi * 0.03125f) * g1 * 0.0625f;
        f32x2 o[8];
#pragma unroll
        for (int i = 0; i < 8; ++i) o[i] = (f32x2){0.f, 0.f};
#define P9V_C(j) __builtin_bit_cast(float, __builtin_amdgcn_ds_swizzle(__builtin_bit_cast(int, (((j) >> 2) & 1) ? c1 : c0), ((4 * ((j) >> 3) + ((j) & 3)) << 5) | 0x18))
        { const float cj[8] = {P9V_C(0), P9V_C(1), P9V_C(2), P9V_C(3), P9V_C(4), P9V_C(5), P9V_C(6), P9V_C(7)};
#pragma unroll
          for (int j = 0; j < 8; ++j) p9_axpy16(A[j], cj[j], o); }
        P9_GATHER(A, nia);
        { const float cj[8] = {P9V_C(8), P9V_C(9), P9V_C(10), P9V_C(11), P9V_C(12), P9V_C(13), P9V_C(14), P9V_C(15)};
#pragma unroll
          for (int j = 0; j < 8; ++j) p9_axpy16(B[j], cj[j], o); }
#undef P9V_C
        const bool g0b = lane & 8;
        float q[8], r[4], sv[2];
#pragma unroll
        for (int i = 0; i < 8; ++i) { const float keep = g0b ? o[i].y : o[i].x, send = g0b ? o[i].x : o[i].y; q[i] = keep + dpp_f<DPP_ROR8>(send); }
#pragma unroll
        for (int i = 0; i < 4; ++i) r[i] = swapsum16(q[2 * i], q[2 * i + 1]);
#pragma unroll
        for (int i = 0; i < 2; ++i) sv[i] = swapsum32(r[2 * i], r[2 * i + 1]);
        const float y0 = x0 + sv[0], y1 = x1 + sv[1];
        if (mode == 0) {
            float* xs = xsb + (size_t)t * DM; xs[0] = y0; xs[8] = y1;
            bf16* xn = WSP(bf16, WS_XNA) + (size_t)t * DM + eoff; xn[0] = (bf16)f2bf(y0); xn[8] = (bf16)f2bf(y1);
            const float ss = wave_sum(y0 * y0 + y1 * y1);
            if (lane == 0) WSP(float, WS_SSQ)[(size_t)t * 8 + slice] = ss;
        } else {
            float* y = (t < MP ? F.out + O_YP + (size_t)t * DM : F.out + O_YS + (size_t)(t - MP) * DM) + eoff;
            y[0] = y0; y[8] = y1;
        }
        if (!more) break;
        t = tn; ia = nia; ib = nib; g0 = ng0; g1 = ng1; x0 = nx0; x1 = nx1;
#pragma unroll
        for (int x = 0; x < 8; ++x) pw[x] = npw[x];
    }
#undef P9V_META
}
#undef P9_GATHER

constexpr float QSCALE = 0.125f * 1.4426950408889634f;
constexpr int PP_VT = 0;
__device__ __forceinline__ float rms64(float v) { return frsq(wave_sum(v * v) * (1.f / 64.f) + EPS); }

__device__ __forceinline__ void pp_q_row(Frame& F, int row, const float* kvq, const float qg) {
    const int lane = F.lane;
    bf16* qn = WSP(bf16, WS_QN) + (size_t)row * 1024;
#pragma unroll 4
    for (int hd = 0; hd < 16; ++hd) { const float v = kvq[NKV + hd * 64 + lane]; qn[hd * 64 + lane] = (bf16)f2bf(v * rms64(v) * qg); }
    if (lane < 48) WSP(float, WS_GATES)[(size_t)row * 48 + lane] = sigmoid_f(kvq[NKV + 1024 + lane]);
}
__device__ __forceinline__ f32x4 rms64x4(f32x4 v) { const float ss = row_sum16((v.x * v.x + v.y * v.y) + (v.z * v.z + v.w * v.w)); return v * (frsq(ss * (1.f / 64.f) + EPS)); }
__device__ __forceinline__ v2u pk4(f32x4 v) { return (v2u){pk2(v.x, v.y), pk2(v.z, v.w)}; }
__device__ __forceinline__ void pp_prompt_tile(Frame& F, int unit) {
    const int lane = F.lane, w = F.wave, b = unit >> 7, t0 = (unit & 127) * 64, g = lane >> 4, d4 = (lane & 15) * 4;
    LAS unsigned char* L = F.lds; asm volatile("" : "+v"(L));
    LAS bf16* vt = (LAS bf16*)(L + PP_VT);
    const f32x4 kg1 = *(const f32x4*)(FIN(16) + 64 + d4), kg2 = *(const f32x4*)(FIN(16) + 128 + d4), qg = *(const f32x4*)(FIN(22) + d4) * QSCALE;
#pragma unroll 1
    for (int rr = 0; rr < 8; ++rr) {
        const int tl = 8 * w + rr, t = t0 + tl, row = b * PT + t;
        const f32x4* kvq = (const f32x4*)(WSP(float, WS_KVQ) + (size_t)row * NKVQ) + lane;
        f32x4 v[6], q[4], gl = {0.f, 0.f, 0.f, 0.f};
#pragma unroll
        for (int sidx = 0; sidx < 6; ++sidx) v[sidx] = kvq[64 * sidx];
#pragma unroll
        for (int i = 0; i < 4; ++i) q[i] = kvq[64 * (6 + i)];
        if (lane < 12) gl = kvq[640];
        const f32x4 ks = rms64x4(v[2]) * kg1, kw = rms64x4(v[4]) * kg2;
        f32x4* okv = (f32x4*)(F.out + O_KVP + (size_t)row * 1024) + lane;
        okv[0] = v[0]; okv[64] = v[1]; okv[128] = ks; okv[192] = v[3];
        if (t >= PT - WINDOW) { f32x4* owin = (f32x4*)(F.out + O_WINP + ((size_t)b * 512 + (t - (PT - WINDOW))) * 512) + lane; owin[0] = kw; owin[64] = v[5]; }
        const size_t kidx = (((size_t)b * NG + g) * PT + t) * 64 + d4;
        *(v2u*)(WSP(bf16, WS_KSEL) + kidx) = pk4(ks); *(v2u*)(WSP(bf16, WS_KWIN) + kidx) = pk4(kw);
#pragma unroll
        for (int j = 0; j < 4; ++j) { vt[((0 * 4 + g) * 64 + d4 + j) * 72 + tl] = (bf16)f2bf(v[3][j]); vt[((1 * 4 + g) * 64 + d4 + j) * 72 + tl] = (bf16)f2bf(v[5][j]); }
        bf16* qn = WSP(bf16, WS_QN) + (size_t)row * 1024 + g * 64 + d4;
#pragma unroll
        for (int i = 0; i < 4; ++i) *(v2u*)(qn + i * 256) = pk4(rms64x4(q[i]) * qg);
        if (lane < 12) *(f32x4*)(WSP(float, WS_GATES) + (size_t)row * 48 + 4 * lane) = (f32x4){sigmoid_f(gl.x), sigmoid_f(gl.y), sigmoid_f(gl.z), sigmoid_f(gl.w)};
    }
    __syncthreads();
    {
        const int which = F.tid >> 8, gd = F.tid & 255;
        bf16* dst = WSP(bf16, which == 0 ? WS_VSELT : WS_VWINT) + (((size_t)b * NG * 64 + gd) * PT + t0);
        const LAS bf16* src = vt + ((which * 256 + gd) * 72);
#pragma unroll
        for (int i = 0; i < 8; ++i) *(v4u*)(dst + 8 * i) = *(const LAS v4u*)(src + 8 * i);
    }
    __syncthreads();
}
__device__ __forceinline__ void pp_sample_row(Frame& F, int sr) {
    const int lane = F.lane, bs = sr >> 2, i = sr & 3, row = MP + sr;
    const float kg1 = FIN(16)[64 + lane], kg2 = FIN(16)[128 + lane], qg = FIN(22)[lane] * QSCALE;
    const float* kvq = WSP(float, WS_KVQ) + (size_t)row * NKVQ;
    float* okv = F.out + O_KVS + (size_t)sr * 1024;
    float* owin = F.out + O_WINS + ((size_t)bs * 512 + 508 + i) * 512;
#pragma unroll
    for (int g = 0; g < 4; ++g) {
        const float v0 = kvq[0 * 256 + g * 64 + lane], v1 = kvq[1 * 256 + g * 64 + lane], v2 = kvq[2 * 256 + g * 64 + lane];
        const float v3 = kvq[3 * 256 + g * 64 + lane], v4 = kvq[4 * 256 + g * 64 + lane], v5 = kvq[5 * 256 + g * 64 + lane];
        const float ks = v2 * rms64(v2) * kg1, kw = v4 * rms64(v4) * kg2;
        okv[0 * 256 + g * 64 + lane] = v0; okv[1 * 256 + g * 64 + lane] = v1; okv[2 * 256 + g * 64 + lane] = ks; okv[3 * 256 + g * 64 + lane] = v3;
        owin[g * 64 + lane] = kw; owin[256 + g * 64 + lane] = v5;
        const size_t bg = (size_t)bs * NG + g;
        WSP(bf16, WS_SKWIN)[(bg * 544 + 512 + i) * 64 + lane] = (bf16)f2bf(kw);
        WSP(bf16, WS_SVWINT)[(bg * 64 + lane) * 544 + 512 + i] = (bf16)f2bf(v5);
        float* sn = WSP(float, WS_SNEW) + (((size_t)bs * 4 + i) * 2) * 256 + g * 64 + lane;
        sn[0] = ks; sn[256] = v3;
    }
    pp_q_row(F, row, kvq, qg);
}

__device__ __forceinline__ void compress_finish(Frame& F, const f32x4 (&acc)[4], int kv, int blk, bf16* KC, bf16* VCT) {
    const int lane = F.lane, fr = lane & 15, fq = lane >> 4;
    const float* pet = WSP(float, WS_PETERM) + kv * 64;
    bf16x8 hb[2];
#pragma unroll
    for (int s = 0; s < 2; ++s) { f32x4 h0, h1;
#pragma unroll
        for (int r = 0; r < 4; ++r) { h0[r] = gelu_tanh(acc[2 * s][r] + pet[16 * (2 * s) + 4 * fq + r]); h1[r] = gelu_tanh(acc[2 * s + 1][r] + pet[16 * (2 * s + 1) + 4 * fq + r]); }
        hb[s] = cvt8(h0, h1); }
    const float* w2 = FIN(19) + (size_t)kv * 64 * 64;
    f32x4 o[4];
#pragma unroll
    for (int dt = 0; dt < 4; ++dt) { o[dt] = (f32x4){0.f, 0.f, 0.f, 0.f};
#pragma unroll
        for (int s = 0; s < 2; ++s) { f32x4 a0, a1;
#pragma unroll
            for (int jj = 0; jj < 4; ++jj) { a0[jj] = w2[(size_t)(16 * (2 * s) + 4 * fq + jj) * 64 + 16 * dt + fr]; a1[jj] = w2[(size_t)(16 * (2 * s + 1) + 4 * fq + jj) * 64 + 16 * dt + fr]; }
            o[dt] = MFMA16(cvt8(a0, a1), hb[s], o[dt]); } }
    if (kv == 0) {
        float ss = 0.f;
#pragma unroll
        for (int dt = 0; dt < 4; ++dt) ss += (o[dt][0] * o[dt][0] + o[dt][1] * o[dt][1]) + (o[dt][2] * o[dt][2] + o[dt][3] * o[dt][3]);
        ss = x32_sum(x16_sum(ss));
        const float rstd = frsq(ss * (1.f / 64.f) + EPS);
        const float* kg0 = FIN(16);
        if (blk < NCMP) {
#pragma unroll
            for (int dt = 0; dt < 4; ++dt) { const int d = 16 * dt + 4 * fq; v2u ov; ov.x = pk2(o[dt][0] * rstd * kg0[d], o[dt][1] * rstd * kg0[d + 1]); ov.y = pk2(o[dt][2] * rstd * kg0[d + 2], o[dt][3] * rstd * kg0[d + 3]);
                *(v2u*)(KC + (size_t)blk * 64 + d) = ov; }
        } else {
#pragma unroll
            for (int dt = 0; dt < 4; ++dt) *(v2u*)(KC + (size_t)blk * 64 + 16 * dt + 4 * fq) = (v2u){0u, 0u};
        }
    } else {
#pragma unroll
        for (int dt = 0; dt < 4; ++dt)
#pragma unroll
            for (int r = 0; r < 4; ++r) VCT[(size_t)(16 * dt + 4 * fq + r) * 512 + blk] = (blk < NCMP) ? (bf16)f2bf(o[dt][r]) : (bf16)0;
    }
}

template <class RowP>
__device__ __forceinline__ void compress_part(Frame& F, const RowP& rowp, int kv, int j, int r_lo, int r_hi, f32x4 (&acc)[4]) {
    const int lane = F.lane, fr = lane & 15, fq = lane >> 4;
    const bf16* W1 = WSP(bf16, WS_W1T) + (size_t)kv * 64 * 2048 + (size_t)fr * 2048 + 8 * fq;
    const int blk = 16 * j + fr;
#pragma unroll
    for (int mt = 0; mt < 4; ++mt) acc[mt] = (f32x4){0.f, 0.f, 0.f, 0.f};
#pragma unroll 2
    for (int r = r_lo; r < r_hi; ++r) {
        int t = 16 * blk + r; t = t < PAST ? t : PAST - 1;
        const float* rp = rowp(t) + 8 * fq;
#pragma unroll
        for (int hf = 0; hf < 2; ++hf) {
            const f32x4 x0 = *(const f32x4*)(rp + 32 * hf), x1 = *(const f32x4*)(rp + 32 * hf + 4);
            const bf16x8 bfrag = cvt8(x0, x1);
            const int ks = 2 * r + hf;
#pragma unroll
            for (int mt = 0; mt < 4; ++mt) acc[mt] = MFMA16(ld8(W1 + (size_t)mt * 16 * 2048 + 32 * ks), bfrag, acc[mt]);
        }
    }
}
template <class RowP>
__device__ __forceinline__ void compress_tile(Frame& F, const RowP& rowp, int kv, int j, bf16* KC, bf16* VCT) {
    const int lane = F.lane, fr = lane & 15, fq = lane >> 4;
    const bf16* W1 = WSP(bf16, WS_W1T) + (size_t)kv * 64 * 2048 + (size_t)fr * 2048 + 8 * fq;
    const int blk = 16 * j + fr;
    f32x4 acc[4];
#pragma unroll
    for (int mt = 0; mt < 4; ++mt) acc[mt] = (f32x4){0.f, 0.f, 0.f, 0.f};
#pragma unroll 2
    for (int r = 0; r < 32; ++r) {
        int t = 16 * blk + r; t = t < PAST ? t : PAST - 1;
        const float* rp = rowp(t) + 8 * fq;
#pragma unroll
        for (int hf = 0; hf < 2; ++hf) {
            const f32x4 x0 = *(const f32x4*)(rp + 32 * hf), x1 = *(const f32x4*)(rp + 32 * hf + 4);
            const bf16x8 bfrag = cvt8(x0, x1);
            const int ks = 2 * r + hf;
#pragma unroll
            for (int mt = 0; mt < 4; ++mt) acc[mt] = MFMA16(ld8(W1 + (size_t)mt * 16 * 2048 + 32 * ks), bfrag, acc[mt]);
        }
    }
    compress_finish(F, acc, kv, blk, KC, VCT);
}
struct RowPPrompt { const float* base; __device__ __forceinline__ const float* operator()(int t) const { return base + (size_t)t * NKVQ; } };
struct RowPSample { const float* cache; const int* pt; __device__ __forceinline__ const float* operator()(int t) const { return cache + ((size_t)pt[t >> 7] * PAGE + (t & 127)) * 1024; } };

__device__ __forceinline__ void compress_prompt(Frame& F, int id) {
    const int kv = id & 1, j = (id >> 1) & 31, bg = id >> 6, b = bg >> 2, g = bg & 3;
    RowPPrompt rp{WSP(float, WS_KVQ) + (size_t)b * PT * NKVQ + kv * 256 + g * 64};
    compress_tile(F, rp, kv, j, WSP(bf16, WS_KCMP) + (size_t)bg * 512 * 64, WSP(bf16, WS_VCMPT) + (size_t)bg * 64 * 512);
}
constexpr int CP_PART = 81920;
__device__ __forceinline__ void compress_prompt_split(Frame& F, int id) {
    const int kv = id & 1, j = (id >> 1) & 31, bg = id >> 6, b = bg >> 2, g = bg & 3, q = F.wave & 3, lane = F.lane;
    RowPPrompt rp{WSP(float, WS_KVQ) + (size_t)b * PT * NKVQ + kv * 256 + g * 64};
    f32x4 acc[4];
    compress_part(F, rp, kv, j, 8 * q, 8 * q + 8, acc);
    LAS f32x4* part = (LAS f32x4*)(F.lds + CP_PART) + (F.wave >> 2) * 1024;
#pragma unroll
    for (int mt = 0; mt < 4; ++mt) part[(q * 4 + mt) * 64 + lane] = acc[mt];
    __syncthreads();
    if (q == 0) {
#pragma unroll
        for (int mt = 0; mt < 4; ++mt) acc[mt] = (part[(0 * 4 + mt) * 64 + lane] + part[(1 * 4 + mt) * 64 + lane]) + (part[(2 * 4 + mt) * 64 + lane] + part[(3 * 4 + mt) * 64 + lane]);
        compress_finish(F, acc, kv, 16 * j + (lane & 15), WSP(bf16, WS_KCMP) + (size_t)bg * 512 * 64, WSP(bf16, WS_VCMPT) + (size_t)bg * 64 * 512);
    }
    __syncthreads();
}
__device__ __forceinline__ void compress_sample(Frame& F, int id) {
    const int kv = id & 1, j = (id >> 1) & 31, bg = id >> 6, lane = F.lane, fr = lane & 15, fq = lane >> 4;
    const int blk = 16 * j + fr, nb = blk < 511 ? blk + 1 : 511;
    const float* f1 = WSP(float, WS_FS) + ((size_t)bg * 512 + blk) * 256 + kv * 128 + 4 * fq;
    const float* f2 = WSP(float, WS_FS) + ((size_t)bg * 512 + nb) * 256 + kv * 128 + 64 + 4 * fq;
    f32x4 acc[4];
#pragma unroll
    for (int mt = 0; mt < 4; ++mt) acc[mt] = *(const f32x4*)(f1 + 16 * mt) + *(const f32x4*)(f2 + 16 * mt);
    compress_finish(F, acc, kv, blk, WSP(bf16, WS_SKCMP) + (size_t)bg * 512 * 64, WSP(bf16, WS_SVCMPT) + (size_t)bg * 64 * 512);
}

constexpr int NSA_IMP = 0;
constexpr int NSA_Q = 67584;
constexpr int NSA_QLD = 68;
constexpr float LOG2E = 1.4426950408889634f;
#ifndef NSA_SUBUNITS
#define NSA_SUBUNITS 0
#endif
__device__ __forceinline__ float ex2(float x) { return __builtin_amdgcn_exp2f(x); }

struct KvBf16 {
    const bf16* K; const bf16* VT; int ld;
    __device__ __forceinline__ void lane_offsets(int fr, int fq, unsigned& ko, unsigned& vo) const {
        ko = (unsigned)(((8 * (fr >> 2) + (fr & 3)) * 64 + 8 * fq) * 2); vo = (unsigned)((fr * ld + 8 * fq) * 2);
        asm volatile("" : "+v"(ko), "+v"(vo));
    }
    __device__ __forceinline__ bf16x8 kf(int key0, int mt, int ks, unsigned ko) const {
        return *(const bf16x8*)((const char*)K + (size_t)key0 * 128 + (ko + (unsigned)((4 * mt * 64 + 32 * ks) * 2))); }
    __device__ __forceinline__ bf16x8 vf(int key0, int dt, unsigned vo) const {
        return *(const bf16x8*)((const char*)VT + (size_t)key0 * 2 + (vo + (unsigned)(16 * dt * ld * 2))); }
};
struct KvSampleSel {
    const float* cache; const int* pt; const float* snew; int g;
    __device__ __forceinline__ const float* krow(int pos, int slot) const {
        if (pos < PAST) return cache + ((size_t)pt[pos >> 7] * PAGE + (pos & 127)) * 1024 + slot * 256;
        int i = pos - PAST; i = i < 3 ? i : 3; return snew + (size_t)i * 512 + (slot - 2) * 256; }
    __device__ __forceinline__ void lane_offsets(int fr, int fq, unsigned& ko, unsigned& vo) const { ko = (unsigned)(fr | (fq << 8)); vo = ko; asm volatile("" : "+v"(ko), "+v"(vo)); }
    __device__ __forceinline__ bf16x8 kf(int key0, int mt, int ks, unsigned ko) const { const int fr = ko & 255, fq = ko >> 8;
        const float* p = krow(key0 + 8 * (fr >> 2) + 4 * mt + (fr & 3), 2) + 32 * ks + 8 * fq; return cvt8(*(const f32x4*)p, *(const f32x4*)(p + 4)); }
    __device__ __forceinline__ bf16x8 vf(int key0, int dt, unsigned vo) const { const int fr = vo & 255, fq = vo >> 8; f32x4 a, b;
#pragma unroll
        for (int j = 0; j < 4; ++j) { a[j] = krow(key0 + 8 * fq + j, 3)[16 * dt + fr]; b[j] = krow(key0 + 8 * fq + 4 + j, 3)[16 * dt + fr]; }
        return cvt8(a, b); }
};
struct KvFrags { bf16x8 k[2][2]; bf16x8 v[4]; };
template <bool WITHV, class KV>
__device__ __forceinline__ void nsa_load(const KV& kv, int key0, int fr, int fq, KvFrags& f) {
    unsigned ko, vo; kv.lane_offsets(fr, fq, ko, vo);
#pragma unroll
    for (int mt = 0; mt < 2; ++mt)
#pragma unroll
        for (int ks = 0; ks < 2; ++ks) f.k[mt][ks] = kv.kf(key0, mt, ks, ko);
    if (WITHV) {
#pragma unroll
        for (int dt = 0; dt < 4; ++dt) f.v[dt] = kv.vf(key0, dt, vo);
    }
}

template <int NT, int MODE, bool QREG = false>
__device__ __forceinline__ void nsa_core(const KvFrags& f, int key0, const LAS bf16* qrow, int qnt, f32x4 (&O)[NT][4], float (&m)[NT], float (&l)[NT], const float (&invl)[NT], const float (&slope)[NT],
                                         int t, int pmul, int padd, int wlim, bool selok, LAS float* improw, int fq, const bf16x8* qreg = nullptr) {
    float dist[2][4]; bool val[2][4];
#pragma unroll
    for (int mt = 0; mt < 2; ++mt)
#pragma unroll
        for (int r = 0; r < 4; ++r) { const int kk = key0 + 8 * fq + 4 * mt + r; const int dd = t - (pmul * kk + padd); val[mt][r] = selok && dd >= 0 && dd < wlim; dist[mt][r] = val[mt][r] ? (float)dd : 1e6f; }
    float imp_main[2] = {0.f, 0.f}, imp_spill[2] = {0.f, 0.f};
    f32x4 sc[NT][2]; bf16x8 pfr[NT];
#pragma unroll
    for (int nt = 0; nt < NT; ++nt) {
        bf16x8 q0, q1; if (QREG) { q0 = qreg[nt * 2]; q1 = qreg[nt * 2 + 1]; } else { q0 = ld8l(qrow + nt * qnt + 8 * fq); q1 = ld8l(qrow + nt * qnt + 32 + 8 * fq); }
#pragma unroll
        for (int mt = 0; mt < 2; ++mt) { sc[nt][mt] = (f32x4){0.f, 0.f, 0.f, 0.f}; sc[nt][mt] = MFMA16(f.k[mt][0], q0, sc[nt][mt]); sc[nt][mt] = MFMA16(f.k[mt][1], q1, sc[nt][mt]); }
    }
#pragma unroll
    for (int nt = 0; nt < NT; ++nt) {
        f32x4 p[2]; float ps = 0.f;
#pragma unroll
        for (int mt = 0; mt < 2; ++mt)
#pragma unroll
            for (int r = 0; r < 4; ++r) { float pv = ex2(sc[nt][mt][r] - slope[nt] * dist[mt][r]); if (MODE == 2) pv *= invl[nt]; p[mt][r] = pv; ps += pv; }
        if (MODE != 2) l[nt] += ps;
        if (MODE == 2) {
#pragma unroll
            for (int mt = 0; mt < 2; ++mt) { imp_main[mt] += (p[mt][0] + p[mt][1]) + (p[mt][2] + p[mt][3]); imp_spill[mt] += p[mt][3]; }
        }
        if (MODE != 1) pfr[nt] = cvt8(p[0], p[1]);
    }
    if (MODE != 1) {
#pragma unroll
        for (int nt = 0; nt < NT; ++nt)
#pragma unroll
            for (int dt = 0; dt < 4; ++dt) O[nt][dt] = MFMA16(f.v[dt], pfr[nt], O[nt][dt]);
    }
    if (MODE == 2) {
#pragma unroll
        for (int mt = 0; mt < 2; ++mt) { const int j = key0 / 4 + 2 * fq + mt;
            __hip_atomic_fetch_add(improw + j, imp_main[mt], __ATOMIC_RELAXED, __HIP_MEMORY_SCOPE_WORKGROUP);
            __hip_atomic_fetch_add(improw + j + 1, imp_spill[mt], __ATOMIC_RELAXED, __HIP_MEMORY_SCOPE_WORKGROUP); }
    }
}
template <int NT, int MODE, class KV>
__device__ __forceinline__ void nsa_tile(const KV& kv, int key0, const LAS bf16* qrow, int qnt, f32x4 (&O)[NT][4], float (&m)[NT], float (&l)[NT], const float (&invl)[NT], const float (&slope)[NT],
                                         int t, int pmul, int padd, int wlim, bool selok, LAS float* improw, int fr, int fq) {
    KvFrags f; nsa_load<MODE != 1>(kv, key0, fr, fq, f);
    nsa_core<NT, MODE>(f, key0, qrow, qnt, O, m, l, invl, slope, t, pmul, padd, wlim, selok, improw, fq);
}

template <int NT>
__device__ __forceinline__ void nsa_zero(f32x4 (&O)[NT][4], float (&m)[NT], float (&l)[NT]) {
#pragma unroll
    for (int nt = 0; nt < NT; ++nt) { m[nt] = -1e30f; l[nt] = 0.f;
#pragma unroll
        for (int dt = 0; dt < 4; ++dt) O[nt][dt] = (f32x4){0.f, 0.f, 0.f, 0.f}; }
}

template <bool SAMPLE>
__device__ __forceinline__ void nsa_unit(Frame& F, int id) {
    constexpr int NT = SAMPLE ? 1 : 4;
    int lane_ = F.lane; asm volatile("" : "+v"(lane_));
    const int lane = lane_, fr = lane & 15, fq = lane >> 4;
    LAS unsigned char* L = F.lds; asm volatile("" : "+v"(L));
    LAS float* imp = (LAS float*)(L + NSA_IMP + F.wave * 8448);
    LAS bf16* qw = (LAS bf16*)(L + NSA_Q + F.wave * 8704);
    int bg, g, t, row, trow, tmax, row0;
    if (SAMPLE) { bg = id; g = id & 3; t = PAST + (fr >> 2); row0 = MP + (id >> 2) * 4; row = row0 + (fr >> 2); trow = fr >> 2; tmax = PAST + 3; }
    else { bg = id >> 9; g = bg & 3; const int tt = id & 511; t = 16 * tt + fr; row0 = (bg >> 2) * PT + 16 * tt; row = row0 + fr; trow = fr; tmax = 16 * tt + 15; }
    {
        const int nrow = SAMPLE ? 16 : 64;
        for (int i = lane; i < nrow * 8; i += 64) { const int rr = i >> 3, c8 = i & 7;
            *(LAS v4u*)(qw + rr * NSA_QLD + 8 * c8) = *(const v4u*)(WSP(bf16, WS_QN) + (size_t)(row0 + (rr >> 2)) * 1024 + (g * 4 + (rr & 3)) * 64 + 8 * c8); }
    }
    float slope[NT]; int hd[NT];
#pragma unroll
    for (int nt = 0; nt < NT; ++nt) { hd[nt] = g * 4 + (SAMPLE ? (fr & 3) : nt); slope[nt] = ex2(-0.5f * (float)(hd[nt] + 1)) * LOG2E; }
    const LAS bf16* qrow = qw + (SAMPLE ? fr : fr * 4) * NSA_QLD; const int qnt = SAMPLE ? 0 : NSA_QLD;
    const float* gates = WSP(float, WS_GATES) + (size_t)row * 48;
    float* oacc = WSP(float, WS_OACC) + (size_t)row * 1024;
    for (int i = lane; i < 16 * 132; i += 64) imp[i] = 0.f;
    LDS_WAIT();
    f32x4 O[NT][4]; float m[NT], l[NT], invl[NT];
    {
        KvBf16 kv{WSP(bf16, SAMPLE ? WS_SKCMP : WS_KCMP) + (size_t)bg * 512 * 64, WSP(bf16, SAMPLE ? WS_SVCMPT : WS_VCMPT) + (size_t)bg * 64 * 512, 512};
        const int cmax = (tmax - 31) >> 4;
        const int ntile = (tmax >= 31) ? ((cmax < 510 ? cmax : 510) / 32 + 1) : 0;
#pragma unroll
        for (int nt = 0; nt < NT; ++nt) invl[nt] = 0.f;
        nsa_zero<NT>(O, m, l);
        { KvFrags fa, fb; if (ntile > 0) nsa_load<false>(kv, 0, fr, fq, fa);
#pragma unroll 1
          for (int tl = 0; tl < ntile; ++tl) { if (tl + 1 < ntile) nsa_load<false>(kv, 32 * (tl + 1), fr, fq, fb);
            nsa_core<NT, 1>(fa, 32 * tl, qrow, qnt, O, m, l, invl, slope, t, 16, 31, 1 << 30, true, imp + trow * 132, fq); fa = fb; } }
#pragma unroll
        for (int nt = 0; nt < NT; ++nt) { float lt = l[nt]; lt = x32_sum(x16_sum(lt)); invl[nt] = lt > 0.f ? 1.f / lt : 0.f; }
        { KvFrags fa, fb; if (ntile > 0) nsa_load<true>(kv, 0, fr, fq, fa);
#pragma unroll 1
          for (int tl = 0; tl < ntile; ++tl) { if (tl + 1 < ntile) nsa_load<true>(kv, 32 * (tl + 1), fr, fq, fb);
            nsa_core<NT, 2>(fa, 32 * tl, qrow, qnt, O, m, l, invl, slope, t, 16, 31, 1 << 30, true, imp + trow * 132, fq); fa = fb; } }
#pragma unroll
        for (int nt = 0; nt < NT; ++nt) { const float gc = gates[0 * 16 + hd[nt]];
#pragma unroll
            for (int dt = 0; dt < 4; ++dt) *(f32x4*)(oacc + hd[nt] * 64 + 16 * dt + 4 * fq) = O[nt][dt] * gc; }
    }
    LDS_WAIT();
    unsigned selm[4] = {0u, 0u, 0u, 0u};
    {
        const int cur = t >> 6;
        if (!SAMPLE) {
            unsigned v[32];
#pragma unroll
            for (int i = 0; i < 32; ++i) { const int j = 32 * fq + i; const bool forced = (j == 0) | (j == cur) | (j == cur - 1);
                const unsigned key = ((f2u(imp[trow * 132 + j]) & ~127u) | (unsigned)(127 - j)) + 128u;
                v[i] = (!forced && j <= cur) ? key : 0u;
                if (forced) selm[fq] |= 1u << i; }
            unsigned fw = selm[0] | selm[1] | selm[2] | selm[3];
            const unsigned w16 = __shfl_xor(fw, 16), w32 = __shfl_xor(fw, 32), w48 = __shfl_xor(fw, 48);
#pragma unroll
            for (int wd = 0; wd < 4; ++wd) selm[wd] = (fq == wd) ? fw : ((fq ^ 1) == wd) ? w16 : ((fq ^ 2) == wd) ? w32 : w48;
            const int nforced = cur >= 2 ? 3 : cur + 1;
#pragma unroll 1
            for (int rd = 0; rd < 15; ++rd) {
                unsigned mx = v[0];
#pragma unroll
                for (int i = 1; i < 32; ++i) mx = mx > v[i] ? mx : v[i];
                mx = x32_umax(x16_umax(mx));
#pragma unroll
                for (int i = 0; i < 32; ++i) v[i] = (v[i] == mx) ? 0u : v[i];
                if (mx != 0u && rd < 16 - nforced) { const int js = 127 - (int)(mx & 127u);
#pragma unroll
                    for (int wd = 0; wd < 4; ++wd) selm[wd] |= ((js >> 5) == wd) ? (1u << (js & 31)) : 0u; }
            }
        } else {
            const int li = (fr & 3) * 4 + fq;
            unsigned v[8];
#pragma unroll
            for (int i = 0; i < 8; ++i) { const int j = li * 8 + i; v[i] = (j >= 1 && j <= 126) ? (((f2u(imp[trow * 132 + j]) & ~127u) | (unsigned)(127 - j)) + 128u) : 0u; }
            selm[0] = 1u; selm[3] = 1u << 31;
#pragma unroll 1
            for (int rd = 0; rd < 13; ++rd) {
                unsigned mx = v[0];
#pragma unroll
                for (int i = 1; i < 8; ++i) mx = mx > v[i] ? mx : v[i];
                { unsigned o = dpp_u<DPP_XOR1>(mx); mx = mx > o ? mx : o; o = dpp_u<DPP_XOR2>(mx); mx = mx > o ? mx : o; mx = x32_umax(x16_umax(mx)); }
#pragma unroll
                for (int i = 0; i < 8; ++i) v[i] = (v[i] == mx) ? 0u : v[i];
                if (mx != 0u) { const int js = 127 - (int)(mx & 127u);
#pragma unroll
                    for (int wd = 0; wd < 4; ++wd) selm[wd] |= ((js >> 5) == wd) ? (1u << (js & 31)) : 0u; }
            }
        }
    }
    if (SAMPLE || !NSA_SUBUNITS) {
        nsa_zero<NT>(O, m, l);
        unsigned un[4];
#pragma unroll
        for (int wd = 0; wd < 4; ++wd) { unsigned x = selm[wd]; x |= __shfl_xor(x, 1); x |= __shfl_xor(x, 2); x |= __shfl_xor(x, 4); x |= __shfl_xor(x, 8); un[wd] = (unsigned)__builtin_amdgcn_readfirstlane((int)x); }
        KvSampleSel kvs{FIN(2) + g * 64, (const int*)FIN(6) + (SAMPLE ? (id >> 2) : 0) * NPAGES, WSP(float, WS_SNEW) + (size_t)(SAMPLE ? (id >> 2) : 0) * 2048 + g * 64, g};
        KvBf16 kvp{WSP(bf16, WS_KSEL) + (size_t)bg * PT * 64, WSP(bf16, WS_VSELT) + (size_t)bg * 64 * PT, PT};
        if (SAMPLE) {
#pragma unroll 1
        for (int wd = 0; wd < 4; ++wd) {
            unsigned mm = un[wd];
            const unsigned mine = wd == 0 ? selm[0] : wd == 1 ? selm[1] : wd == 2 ? selm[2] : selm[3];
            while (mm) {
                const int bit = __builtin_ctz(mm); mm &= mm - 1u; const int j = 32 * wd + bit;
                const bool ok = (mine >> bit) & 1u;
#pragma unroll 1
                for (int hh = 0; hh < 2; ++hh) { nsa_tile<NT, 0>(kvs, 64 * j + 32 * hh, qrow, qnt, O, m, l, invl, slope, t, 1, 0, 1 << 30, ok, imp, fr, fq); __builtin_amdgcn_sched_barrier(0); }
            }
        }
        } else {
            int wdc = 0; unsigned mmc = un[0];
            while (wdc < 3 && mmc == 0u) { ++wdc; mmc = wdc == 1 ? un[1] : wdc == 2 ? un[2] : un[3]; }
            KvFrags fa, fb; int jc = -1, hc = 0;
            if (mmc) { jc = 32 * wdc + __builtin_ctz(mmc); mmc &= mmc - 1u; nsa_load<true>(kvp, 64 * jc, fr, fq, fa); }
#pragma unroll 1
            while (jc >= 0) {
                int jn = jc, hn = hc + 1;
                if (hn == 2) { hn = 0;
                    while (wdc < 3 && mmc == 0u) { ++wdc; mmc = wdc == 1 ? un[1] : wdc == 2 ? un[2] : un[3]; }
                    if (mmc) { jn = 32 * wdc + __builtin_ctz(mmc); mmc &= mmc - 1u; } else jn = -1; }
                if (jn >= 0) nsa_load<true>(kvp, 64 * jn + 32 * hn, fr, fq, fb);
                const int wj = jc >> 5, bj = jc & 31;
                const unsigned mine = wj == 0 ? selm[0] : wj == 1 ? selm[1] : wj == 2 ? selm[2] : selm[3];
                nsa_core<NT, 0>(fa, 64 * jc + 32 * hc, qrow, qnt, O, m, l, invl, slope, t, 1, 0, 1 << 30, (mine >> bj) & 1u, imp, fq);
                fa = fb; jc = jn; hc = hn;
            }
        }
        if (SAMPLE) nsa_tile<NT, 0>(kvs, 64 * 128, qrow, qnt, O, m, l, invl, slope, t, 1, 0, 1 << 30, true, imp, fr, fq);
#pragma unroll
        for (int nt = 0; nt < NT; ++nt) { float lt = l[nt]; lt = x32_sum(x16_sum(lt)); const float sc = gates[1 * 16 + hd[nt]] / fmaxf(lt, 1e-30f);
#pragma unroll
            for (int dt = 0; dt < 4; ++dt) { f32x4* o = (f32x4*)(oacc + hd[nt] * 64 + 16 * dt + 4 * fq); *o = *o + O[nt][dt] * sc; } }
    } else {
        unsigned ms[4][4];
#pragma unroll
        for (int s = 0; s < 4; ++s)
#pragma unroll
            for (int wd = 0; wd < 4; ++wd) ms[s][wd] = __shfl(selm[wd], 4 * s + (fr >> 2));
        unsigned su[4][4], un[4];
#pragma unroll
        for (int wd = 0; wd < 4; ++wd) { un[wd] = 0u;
#pragma unroll
            for (int s = 0; s < 4; ++s) { unsigned x = ms[s][wd]; x |= __shfl_xor(x, 4); x |= __shfl_xor(x, 8); su[s][wd] = (unsigned)__builtin_amdgcn_readfirstlane((int)x); un[wd] |= su[s][wd]; } }
        const int hds = g * 4 + (fr & 3); float slp[1]; slp[0] = ex2(-0.5f * (float)(hds + 1)) * LOG2E;
        const int tb = (id & 511) * 16 + (fr >> 2);
        f32x4 Os[4][1][4]; float mS[4][1], lS[4][1]; float inv1[1] = {0.f};
#pragma unroll
        for (int s = 0; s < 4; ++s) nsa_zero<1>(Os[s], mS[s], lS[s]);
        KvBf16 kvp{WSP(bf16, WS_KSEL) + (size_t)bg * PT * 64, WSP(bf16, WS_VSELT) + (size_t)bg * 64 * PT, PT};
        int wdc = 0; unsigned mmc = un[0];
        while (wdc < 3 && mmc == 0u) { ++wdc; mmc = wdc == 1 ? un[1] : wdc == 2 ? un[2] : un[3]; }
        KvFrags fa, fb;
        int jc = -1, hc = 0;
        if (mmc) { jc = 32 * wdc + __builtin_ctz(mmc); mmc &= mmc - 1u; nsa_load<true>(kvp, 64 * jc, fr, fq, fa); }
#pragma unroll 1
        while (jc >= 0) {
            int jn = jc, hn = hc + 1;
            if (hn == 2) { hn = 0;
                while (wdc < 3 && mmc == 0u) { ++wdc; mmc = wdc == 1 ? un[1] : wdc == 2 ? un[2] : un[3]; }
                if (mmc) { jn = 32 * wdc + __builtin_ctz(mmc); mmc &= mmc - 1u; } else jn = -1; }
            if (jn >= 0) nsa_load<true>(kvp, 64 * jn + 32 * hn, fr, fq, fb);
            const int wj = jc >> 5, bj = jc & 31;
#pragma unroll
            for (int s = 0; s < 4; ++s) {
                const unsigned suw = wj == 0 ? su[s][0] : wj == 1 ? su[s][1] : wj == 2 ? su[s][2] : su[s][3];
                if ((suw >> bj) & 1u) {
                    const unsigned mw = wj == 0 ? ms[s][0] : wj == 1 ? ms[s][1] : wj == 2 ? ms[s][2] : ms[s][3];
                    nsa_core<1, 0>(fa, 64 * jc + 32 * hc, qw + (16 * s + fr) * NSA_QLD, 0, Os[s], mS[s], lS[s], inv1, slp, tb + 4 * s, 1, 0, 1 << 30, (mw >> bj) & 1u, imp, fq);
                }
            }
            fa = fb; jc = jn; hc = hn;
        }
#pragma unroll
        for (int s = 0; s < 4; ++s) { float lt = lS[s][0]; lt = x32_sum(x16_sum(lt));
            const size_t rs = (size_t)(row0 + 4 * s + (fr >> 2));
            const float sc = WSP(float, WS_GATES)[rs * 48 + 16 + hds] / fmaxf(lt, 1e-30f);
#pragma unroll
            for (int dt = 0; dt < 4; ++dt) { f32x4* o = (f32x4*)(WSP(float, WS_OACC) + rs * 1024 + hds * 64 + 16 * dt + 4 * fq); *o = *o + Os[s][0][dt] * sc; } }
    }
    {
        nsa_zero<NT>(O, m, l);
        KvBf16 kv = SAMPLE ? KvBf16{WSP(bf16, WS_SKWIN) + (size_t)bg * 544 * 64, WSP(bf16, WS_SVWINT) + (size_t)bg * 64 * 544, 544}
                           : KvBf16{WSP(bf16, WS_KWIN) + (size_t)bg * PT * 64, WSP(bf16, WS_VWINT) + (size_t)bg * 64 * PT, PT};
        int k0, k1, padd;
        if (SAMPLE) { k0 = 0; k1 = 544; padd = PAST - WINDOW; }
        else { const int lo = tmax - 15 - (WINDOW - 1); k0 = (lo > 0 ? lo : 0) & ~31; k1 = tmax + 1; padd = 0; }
        { KvFrags fa, fb; nsa_load<true>(kv, k0, fr, fq, fa);
#pragma unroll 1
          for (int kk = k0; kk < k1; kk += 32) { if (kk + 32 < k1) nsa_load<true>(kv, kk + 32, fr, fq, fb);
            nsa_core<NT, 0>(fa, kk, qrow, qnt, O, m, l, invl, slope, t, 1, padd, WINDOW, true, imp, fq); fa = fb; } }
        bf16* on = WSP(bf16, WS_OG) + (size_t)row * 1024;
#pragma unroll
        for (int nt = 0; nt < NT; ++nt) { float lt = l[nt]; lt = x32_sum(x16_sum(lt)); const float sc = gates[2 * 16 + hd[nt]] / fmaxf(lt, 1e-30f);
#pragma unroll
            for (int dt = 0; dt < 4; ++dt) { const f32x4 o = *(const f32x4*)(oacc + hd[nt] * 64 + 16 * dt + 4 * fq) + O[nt][dt] * sc;
                *(v2u*)(on + hd[nt] * 64 + 16 * dt + 4 * fq) = (v2u){pk2(o[0], o[1]), pk2(o[2], o[3])}; } }
    }
}

constexpr int NW_STG = 67584;
constexpr int NW_STG_BYTES = 18432;
constexpr int NW_UN = NW_STG + 2 * NW_STG_BYTES;
struct NwStage { v4u k, v; };
__device__ __forceinline__ void nw_load(const bf16* K, const bf16* VT, int ld, int key0, int tid, NwStage& s) {
    s.k = *(const v4u*)(K + (size_t)(key0 + (tid >> 3)) * 64 + 8 * (tid & 7));
    s.v = *(const v4u*)(VT + (size_t)(tid >> 3) * ld + key0 + 8 * (tid & 7));
}
__device__ __forceinline__ void nw_store(LAS unsigned char* buf, int tid, const NwStage& s) {
    const int kk = tid >> 3, c8 = tid & 7, k32 = kk & 31;
    const int rho = 32 * (kk >> 5) + 16 * ((k32 >> 2) & 1) + 4 * (k32 >> 3) + (k32 & 3);
    *(LAS v4u*)(buf + rho * 144 + c8 * 16) = s.k;
    *(LAS v4u*)(buf + 9216 + kk * 144 + c8 * 16) = s.v;
}
template <bool WITHV>
__device__ __forceinline__ void nw_frags(const LAS unsigned char* buf, int th, int fr, int fq, KvFrags& f) {
#pragma unroll
    for (int mt = 0; mt < 2; ++mt)
#pragma unroll
        for (int ks = 0; ks < 2; ++ks) f.k[mt][ks] = *(const LAS bf16x8*)(buf + (32 * th + 16 * mt + fr) * 144 + (32 * ks + 8 * fq) * 2);
    if (WITHV) {
#pragma unroll
        for (int dt = 0; dt < 4; ++dt) f.v[dt] = *(const LAS bf16x8*)(buf + 9216 + (16 * dt + fr) * 144 + (32 * th + 8 * fq) * 2);
    }
}
#define NW_PIPE(Kp, VTp, ldv, NB, BLK, BODY) do { const int nb_ = (NB); \
        if (nb_ > 0) { NwStage st_; nw_load(Kp, VTp, ldv, BLK(0), F.tid, st_); nw_store(stg, F.tid, st_); } \
        __syncthreads(); \
        _Pragma("unroll 1") for (int ib_ = 0; ib_ < nb_; ++ib_) { \
            NwStage st_; const bool more_ = ib_ + 1 < nb_; if (more_) nw_load(Kp, VTp, ldv, BLK(ib_ + 1), F.tid, st_); \
            const LAS unsigned char* buf_ = stg + (ib_ & 1) * NW_STG_BYTES; const int key0_ = BLK(ib_); \
            BODY(buf_, key0_) \
            if (more_) nw_store(stg + ((ib_ + 1) & 1) * NW_STG_BYTES, F.tid, st_); \
            __syncthreads(); } } while (0)

__device__ __forceinline__ void nsa_wg(Frame& F, int bg, int qb) {
    int lane_ = F.lane; asm volatile("" : "+v"(lane_));
    const int lane = lane_, fr = lane & 15, fq = lane >> 4, w = F.wave, g = bg & 3;
    LAS unsigned char* L = F.lds; asm volatile("" : "+v"(L));
    LAS float* imp = (LAS float*)(L + NSA_IMP + w * 8448);
    LAS unsigned char* stg = L + NW_STG;
    LAS unsigned* wun = (LAS unsigned*)(L + NW_UN); volatile LAS unsigned char* blist = (volatile LAS unsigned char*)(L + NW_UN + 16);
    const int tt = qb * 8 + w, t = 16 * tt + fr, row0 = (bg >> 2) * PT + 16 * tt, row = row0 + fr, tw0 = 16 * tt, tw1 = tw0 + 15;
    float slope[4]; bf16x8 qreg[8];
#pragma unroll
    for (int nt = 0; nt < 4; ++nt) { slope[nt] = ex2(-0.5f * (float)(g * 4 + nt + 1)) * LOG2E;
        const bf16* qp = WSP(bf16, WS_QN) + (size_t)row * 1024 + (g * 4 + nt) * 64 + 8 * fq; qreg[2 * nt] = ld8(qp); qreg[2 * nt + 1] = ld8(qp + 32); }
    const float* gates = WSP(float, WS_GATES) + (size_t)row * 48;
    float* oacc = WSP(float, WS_OACC) + (size_t)row * 1024;
    for (int i = lane; i < 16 * 132; i += 64) imp[i] = 0.f;
    if (F.tid < 4) wun[F.tid] = 0u;
    f32x4 O[4][4]; float m[4], l[4], invl[4];
    {
        const bf16* Kc = WSP(bf16, WS_KCMP) + (size_t)bg * 512 * 64; const bf16* Vc = WSP(bf16, WS_VCMPT) + (size_t)bg * 64 * 512;
        const int cmax = (128 * qb + 127 - 31) >> 4, ncb = (cmax < 510 ? cmax : 510) / 64 + 1;
#pragma unroll
        for (int nt = 0; nt < 4; ++nt) invl[nt] = 0.f;
        nsa_zero<4>(O, m, l);
#define NW_BLK(i) (64 * (i))
#define NW_CMP1(buf, k0) { _Pragma("unroll 1") for (int th = 0; th < 2; ++th) if (16 * ((k0) + 32 * th) + 31 <= tw1) { KvFrags f; nw_frags<false>(buf, th, fr, fq, f); \
            nsa_core<4, 1, true>(f, (k0) + 32 * th, nullptr, 0, O, m, l, invl, slope, t, 16, 31, 1 << 30, true, imp + fr * 132, fq, qreg); } }
        NW_PIPE(Kc, Vc, 512, ncb, NW_BLK, NW_CMP1);
#pragma unroll
        for (int nt = 0; nt < 4; ++nt) { const float lt = x32_sum(x16_sum(l[nt])); invl[nt] = lt > 0.f ? 1.f / lt : 0.f; }
#define NW_CMP2(buf, k0) { _Pragma("unroll 1") for (int th = 0; th < 2; ++th) if (16 * ((k0) + 32 * th) + 31 <= tw1) { KvFrags f; nw_frags<true>(buf, th, fr, fq, f); \
            nsa_core<4, 2, true>(f, (k0) + 32 * th, nullptr, 0, O, m, l, invl, slope, t, 16, 31, 1 << 30, true, imp + fr * 132, fq, qreg); } }
        NW_PIPE(Kc, Vc, 512, ncb, NW_BLK, NW_CMP2);
#pragma unroll
        for (int nt = 0; nt < 4; ++nt) { const float gc = gates[0 * 16 + g * 4 + nt];
#pragma unroll
            for (int dt = 0; dt < 4; ++dt) *(f32x4*)(oacc + (g * 4 + nt) * 64 + 16 * dt + 4 * fq) = O[nt][dt] * gc; }
    }
    LDS_WAIT();
    unsigned selm[4] = {0u, 0u, 0u, 0u};
    {
        const int cur = t >> 6;
        unsigned v[32];
#pragma unroll
        for (int i = 0; i < 32; ++i) { const int j = 32 * fq + i; const bool forced = (j == 0) | (j == cur) | (j == cur - 1);
            const unsigned key = ((f2u(imp[fr * 132 + j]) & ~127u) | (unsigned)(127 - j)) + 128u;
            v[i] = (!forced && j <= cur) ? key : 0u;
            if (forced) selm[fq] |= 1u << i; }
        unsigned fw = selm[0] | selm[1] | selm[2] | selm[3];
        const unsigned w16 = __shfl_xor(fw, 16), w32 = __shfl_xor(fw, 32), w48 = __shfl_xor(fw, 48);
#pragma unroll
        for (int wd = 0; wd < 4; ++wd) selm[wd] = (fq == wd) ? fw : ((fq ^ 1) == wd) ? w16 : ((fq ^ 2) == wd) ? w32 : w48;
        const int nforced = cur >= 2 ? 3 : cur + 1;
#pragma unroll 1
        for (int rd = 0; rd < 15; ++rd) {
            unsigned mx = v[0];
#pragma unroll
            for (int i = 1; i < 32; ++i) mx = mx > v[i] ? mx : v[i];
            mx = x32_umax(x16_umax(mx));
#pragma unroll
            for (int i = 0; i < 32; ++i) v[i] = (v[i] == mx) ? 0u : v[i];
            if (mx != 0u && rd < 16 - nforced) { const int js = 127 - (int)(mx & 127u);
#pragma unroll
                for (int wd = 0; wd < 4; ++wd) selm[wd] |= ((js >> 5) == wd) ? (1u << (js & 31)) : 0u; }
        }
    }
    unsigned un[4];
#pragma unroll
    for (int wd = 0; wd < 4; ++wd) { unsigned x = selm[wd]; x |= dpp_u<DPP_XOR1>(x); x |= dpp_u<DPP_XOR2>(x); x |= dpp_u<DPP_HMIR>(x); x |= dpp_u<DPP_MIR>(x); un[wd] = (unsigned)__builtin_amdgcn_readfirstlane((int)x); }
    if (lane < 4) __hip_atomic_fetch_or(wun + lane, lane == 0 ? un[0] : lane == 1 ? un[1] : lane == 2 ? un[2] : un[3], __ATOMIC_RELAXED, __HIP_MEMORY_SCOPE_WORKGROUP);
    __syncthreads();
    unsigned wu[4];
#pragma unroll
    for (int wd = 0; wd < 4; ++wd) wu[wd] = (unsigned)__builtin_amdgcn_readfirstlane((int)wun[wd]);
    {
        nsa_zero<4>(O, m, l);
        const bf16* Ks = WSP(bf16, WS_KSEL) + (size_t)bg * PT * 64; const bf16* Vs = WSP(bf16, WS_VSELT) + (size_t)bg * 64 * PT;
        const int nsb = __builtin_popcount(wu[0]) + __builtin_popcount(wu[1]) + __builtin_popcount(wu[2]) + __builtin_popcount(wu[3]);
        if (F.tid < 128) { const int j = F.tid, wj = j >> 5, bj = j & 31; const unsigned ww = wj == 0 ? wu[0] : wj == 1 ? wu[1] : wj == 2 ? wu[2] : wu[3];
            if ((ww >> bj) & 1u) { int pos = __builtin_popcount(ww & ((1u << bj) - 1u)); if (wj > 0) pos += __builtin_popcount(wu[0]); if (wj > 1) pos += __builtin_popcount(wu[1]); if (wj > 2) pos += __builtin_popcount(wu[2]);
                blist[pos] = (unsigned char)j; } }
        __syncthreads();
#define NW_SBLK(i) (64 * (int)blist[(i)])
#define NW_SEL(buf, k0) { const int j_ = (k0) >> 6, wj_ = j_ >> 5, bj_ = j_ & 31; const unsigned uw_ = wj_ == 0 ? un[0] : wj_ == 1 ? un[1] : wj_ == 2 ? un[2] : un[3]; \
            if ((uw_ >> bj_) & 1u) { const unsigned mine_ = wj_ == 0 ? selm[0] : wj_ == 1 ? selm[1] : wj_ == 2 ? selm[2] : selm[3]; const bool ok_ = (mine_ >> bj_) & 1u; \
                _Pragma("unroll 1") for (int th = 0; th < 2; ++th) { KvFrags f; nw_frags<true>(buf, th, fr, fq, f); \
                    nsa_core<4, 0, true>(f, (k0) + 32 * th, nullptr, 0, O, m, l, invl, slope, t, 1, 0, 1 << 30, ok_, imp, fq, qreg); } } }
        NW_PIPE(Ks, Vs, PT, nsb, NW_SBLK, NW_SEL);
#pragma unroll
        for (int nt = 0; nt < 4; ++nt) { const float lt = x32_sum(x16_sum(l[nt])); const float sc = gates[1 * 16 + g * 4 + nt] / fmaxf(lt, 1e-30f);
#pragma unroll
            for (int dt = 0; dt < 4; ++dt) { f32x4* o = (f32x4*)(oacc + (g * 4 + nt) * 64 + 16 * dt + 4 * fq); *o = *o + O[nt][dt] * sc; } }
    }
    {
        nsa_zero<4>(O, m, l);
        const bf16* Kw = WSP(bf16, WS_KWIN) + (size_t)bg * PT * 64; const bf16* Vw = WSP(bf16, WS_VWINT) + (size_t)bg * 64 * PT;
        const int lo = 128 * qb - (WINDOW - 1), kb0 = (lo > 0 ? lo : 0) >> 6, kb1 = (128 * qb + 127) >> 6, nwb = kb1 - kb0 + 1;
#define NW_WBLK(i) (64 * (kb0 + (i)))
#define NW_WIN(buf, k0) { _Pragma("unroll 1") for (int th = 0; th < 2; ++th) { const int kk_ = (k0) + 32 * th; if (kk_ <= tw1 && kk_ + 31 >= tw0 - (WINDOW - 1)) { KvFrags f; nw_frags<true>(buf, th, fr, fq, f); \
                nsa_core<4, 0, true>(f, kk_, nullptr, 0, O, m, l, invl, slope, t, 1, 0, WINDOW, true, imp, fq, qreg); } } }
        NW_PIPE(Kw, Vw, PT, nwb, NW_WBLK, NW_WIN);
        bf16* on = WSP(bf16, WS_OG) + (size_t)row * 1024;
#pragma unroll
        for (int nt = 0; nt < 4; ++nt) { const float lt = x32_sum(x16_sum(l[nt])); const float sc = gates[2 * 16 + g * 4 + nt] / fmaxf(lt, 1e-30f);
#pragma unroll
            for (int dt = 0; dt < 4; ++dt) { const f32x4 o = *(const f32x4*)(oacc + (g * 4 + nt) * 64 + 16 * dt + 4 * fq) + O[nt][dt] * sc;
                *(v2u*)(on + (g * 4 + nt) * 64 + 16 * dt + 4 * fq) = (v2u){pk2(o[0], o[1]), pk2(o[2], o[3])}; } }
    }
    __syncthreads();
}

constexpr int SW_Q = 0;
constexpr int SW_IMPP = 2304;
constexpr int SW_IMPT = SW_IMPP + 8 * 2112;
constexpr int SW_LP = SW_IMPT + 2112;
constexpr int SW_OP = SW_LP + 3 * 8 * 16 * 4;
static_assert(SW_OP + 8 * 3 * 16 * 64 * 4 <= RING_BYTES, "sample NSA LDS map");
__device__ __forceinline__ void nsa_sample_wg(Frame& F, int id) {
    int lane_ = F.lane; asm volatile("" : "+v"(lane_));
    const int lane = lane_, fr = lane & 15, fq = lane >> 4, w = F.wave, g = id & 3, bs = id >> 2;
    LAS unsigned char* L = F.lds; asm volatile("" : "+v"(L));
    LAS bf16* qw = (LAS bf16*)(L + SW_Q);
    LAS float* impP = (LAS float*)(L + SW_IMPP) + w * 528; LAS float* impT = (LAS float*)(L + SW_IMPT);
    LAS float* LP = (LAS float*)(L + SW_LP); LAS float* OP = (LAS float*)(L + SW_OP);
    const int t = PAST + (fr >> 2), row0 = MP + bs * 4, trow = fr >> 2, hd = g * 4 + (fr & 3);
    if (F.tid < 128) { const int rr = F.tid >> 3, c8 = F.tid & 7;
        *(LAS v4u*)(qw + rr * NSA_QLD + 8 * c8) = *(const v4u*)(WSP(bf16, WS_QN) + (size_t)(row0 + (rr >> 2)) * 1024 + (g * 4 + (rr & 3)) * 64 + 8 * c8); }
    for (int i = lane; i < 528; i += 64) impP[i] = 0.f;
    __syncthreads();
    float slope[1] = {ex2(-0.5f * (float)(hd + 1)) * LOG2E};
    const LAS bf16* qrow = qw + fr * NSA_QLD;
    f32x4 O[1][4]; float m[1], l[1], invl[1] = {0.f};
#define SW_PUT_O(br) { _Pragma("unroll") for (int dt = 0; dt < 4; ++dt) *(LAS f32x4*)(OP + ((w * 3 + (br)) * 16 + fr) * 64 + 16 * dt + 4 * fq) = O[0][dt]; }
#define SW_PUT_L(br) { const float lt_ = x32_sum(x16_sum(l[0])); if (fq == 0) LP[((br) * 8 + w) * 16 + fr] = lt_; }
    {
        KvBf16 kv{WSP(bf16, WS_SKCMP) + (size_t)id * 512 * 64, WSP(bf16, WS_SVCMPT) + (size_t)id * 64 * 512, 512};
        nsa_zero<1>(O, m, l);
#pragma unroll 1
        for (int tl = w; tl < 16; tl += 8) nsa_tile<1, 1>(kv, 32 * tl, qrow, 0, O, m, l, invl, slope, t, 16, 31, 1 << 30, true, impP + trow * 132, fr, fq);
        SW_PUT_L(0)
        __syncthreads();
        { float lt = 0.f;
#pragma unroll
          for (int ww = 0; ww < 8; ++ww) lt += LP[(0 * 8 + ww) * 16 + fr];
          invl[0] = lt > 0.f ? 1.f / lt : 0.f; }
#pragma unroll 1
        for (int tl = w; tl < 16; tl += 8) nsa_tile<1, 2>(kv, 32 * tl, qrow, 0, O, m, l, invl, slope, t, 16, 31, 1 << 30, true, impP + trow * 132, fr, fq);
        SW_PUT_O(0)
    }
    __syncthreads();
    for (int i = F.tid; i < 528; i += 512) { float s = 0.f;
#pragma unroll
        for (int ww = 0; ww < 8; ++ww) s += ((LAS float*)(L + SW_IMPP))[ww * 528 + i];
        impT[i] = s; }
    __syncthreads();
    unsigned selm[4] = {1u, 0u, 0u, 1u << 31};
    {
        const int li = (fr & 3) * 4 + fq;
        unsigned v[8];
#pragma unroll
        for (int i = 0; i < 8; ++i) { const int j = li * 8 + i; v[i] = (j >= 1 && j <= 126) ? (((f2u(impT[trow * 132 + j]) & ~127u) | (unsigned)(127 - j)) + 128u) : 0u; }
#pragma unroll 1
        for (int rd = 0; rd < 13; ++rd) {
            unsigned mx = v[0];
#pragma unroll
            for (int i = 1; i < 8; ++i) mx = mx > v[i] ? mx : v[i];
            { unsigned o = dpp_u<DPP_XOR1>(mx); mx = mx > o ? mx : o; o = dpp_u<DPP_XOR2>(mx); mx = mx > o ? mx : o; mx = x32_umax(x16_umax(mx)); }
#pragma unroll
            for (int i = 0; i < 8; ++i) v[i] = (v[i] == mx) ? 0u : v[i];
            if (mx != 0u) { const int js = 127 - (int)(mx & 127u);
#pragma unroll
                for (int wd = 0; wd < 4; ++wd) selm[wd] |= ((js >> 5) == wd) ? (1u << (js & 31)) : 0u; }
        }
    }
    {
        nsa_zero<1>(O, m, l);
        unsigned un[4];
#pragma unroll
        for (int wd = 0; wd < 4; ++wd) { unsigned x = selm[wd]; x |= dpp_u<DPP_XOR1>(x); x |= dpp_u<DPP_XOR2>(x); x |= dpp_u<DPP_HMIR>(x); x |= dpp_u<DPP_MIR>(x); un[wd] = (unsigned)__builtin_amdgcn_readfirstlane((int)x); }
        KvSampleSel kvs{FIN(2) + g * 64, (const int*)FIN(6) + bs * NPAGES, WSP(float, WS_SNEW) + (size_t)bs * 2048 + g * 64, g};
        int q = 0;
#pragma unroll 1
        for (int wd = 0; wd < 4; ++wd) {
            unsigned mm = un[wd];
            const unsigned mine = wd == 0 ? selm[0] : wd == 1 ? selm[1] : wd == 2 ? selm[2] : selm[3];
            while (mm) {
                const int bit = __builtin_ctz(mm); mm &= mm - 1u; const int j = 32 * wd + bit;
                const bool ok = (mine >> bit) & 1u;
#pragma unroll 1
                for (int hh = 0; hh < 2; ++hh, ++q) if ((q & 7) == w) { nsa_tile<1, 0>(kvs, 64 * j + 32 * hh, qrow, 0, O, m, l, invl, slope, t, 1, 0, 1 << 30, ok, impP, fr, fq); __builtin_amdgcn_sched_barrier(0); }
            }
        }
        if ((q & 7) == w) nsa_tile<1, 0>(kvs, 64 * 128, qrow, 0, O, m, l, invl, slope, t, 1, 0, 1 << 30, true, impP, fr, fq);
        SW_PUT_O(1) SW_PUT_L(1)
    }
    {
        nsa_zero<1>(O, m, l);
        KvBf16 kv{WSP(bf16, WS_SKWIN) + (size_t)id * 544 * 64, WSP(bf16, WS_SVWINT) + (size_t)id * 64 * 544, 544};
#pragma unroll 1
        for (int kk = 32 * w; kk < 544; kk += 256) nsa_tile<1, 0>(kv, kk, qrow, 0, O, m, l, invl, slope, t, 1, PAST - WINDOW, WINDOW, true, impP, fr, fq);
        SW_PUT_O(2) SW_PUT_L(2)
    }
    __syncthreads();
    {
        const int r = F.tid >> 5, d0 = (F.tid & 31) * 2, rowg = row0 + (r >> 2), hdr = g * 4 + (r & 3);
        float o0 = 0.f, o1 = 0.f;
#pragma unroll
        for (int br = 0; br < 3; ++br) { float a0 = 0.f, a1 = 0.f, lt = 0.f;
#pragma unroll
            for (int ww = 0; ww < 8; ++ww) { const f32x2 x = *(const LAS f32x2*)(OP + ((ww * 3 + br) * 16 + r) * 64 + d0); a0 += x.x; a1 += x.y; if (br > 0) lt += LP[(br * 8 + ww) * 16 + r]; }
            const float sc = WSP(float, WS_GATES)[(size_t)rowg * 48 + br * 16 + hdr] * (br == 0 ? 1.f : 1.f / fmaxf(lt, 1e-30f));
            o0 += a0 * sc; o1 += a1 * sc; }
        *(unsigned*)(WSP(bf16, WS_OG) + (size_t)rowg * 1024 + hdr * 64 + d0) = pk2(o0, o1);
    }
    __syncthreads();
#undef SW_PUT_O
#undef SW_PUT_L
}


#ifndef MK_SINGLE
#define MK_SINGLE 1
#endif
constexpr int NPHASE = 21;
struct Args { const float* in[29]; float* out; unsigned char* ws; int ph_lo, ph_hi; };
static_assert(sizeof(Args) == 31 * 8 + 8, "Args has no padding");

__global__ void __launch_bounds__(512, 2) mk_fwd(Args args) {
    extern __shared__ __attribute__((aligned(16))) unsigned char lds_raw[];
    Frame F;
    F.lds = (LAS unsigned char*)lds_raw;
    F.tid = threadIdx.x; F.lane = F.tid & 63; F.wave = __builtin_amdgcn_readfirstlane(F.tid >> 6);
    F.G = gridDim.x; F.bid = blockIdx.x;
    F.ka = (const __attribute__((address_space(4))) char*)__builtin_amdgcn_kernarg_segment_ptr();
    F.out = args.out; F.ws = args.ws;
    volatile LAS unsigned* MISC = (volatile LAS unsigned*)(F.lds + MISC_OFF);
    for (int u = F.tid; u < (LDS_BYTES - LDSCTL_OFF) / 4; u += 512) ((LAS unsigned*)(F.lds + LDSCTL_OFF))[u] = 0u;
    __syncthreads();
    unsigned* barw = (unsigned*)(F.ws + WS_CTL) + 4096;
    XcdBarrier bar; bar.bar = barw; bar.x = 0; bar.st = nullptr;
    const int lo = args.ph_lo, hi = args.ph_hi;
    if (hi - lo > 1) bar = xcd_barrier_post(barw, MISC + 8);
#ifndef PH_MASK
#define PH_MASK 0xFFFFFFFFu
#endif
#define IN(k) (((PH_MASK >> (k)) & 1u) && lo <= (k) && (k) < hi)
#define SEAM(k) do { if (IN(k) && IN((k) + 1)) xcd_barrier(bar); } while (0)
    const int gw = F.bid * 8 + F.wave, NGW = F.G * 8;

#ifndef REPX
#define REPX 0
#endif
#ifndef REPY
#define REPY 0
#endif
#ifndef REP_MASK
#define REP_MASK 0u
#endif
#define PHASE(k, ...) if (IN(k)) { _Pragma("unroll 1") for (int rep_ = 0; rep_ < (int)((REP_MASK >> (k)) & 1u) + 1; ++rep_) { if (rep_) xcd_barrier(bar); __VA_ARGS__ } } SEAM(k);
    PHASE(0, p0_prologue(F);)
    if (IN(1) && F.G != 256) { for (int task = F.bid; task < 512; task += F.G) fs_direct_task(F, task); }
    if (IN(1) && IN(2) && F.G != 256) xcd_barrier(bar);
    PHASE(2, gemm_all(F, WSP(bf16, WS_XNA), WSP(bf16, WS_WIN_T), 4096, FnBf16{WSP(bf16, WS_PROJ), 4096});)
    PHASE(3, for (int u = F.bid; u < 2048 + 256; u += F.G) { if (u < 2048) p2_chunk(F, u); else p2_sample(F, u - 2048); })
    PHASE(4, if (F.G == 256) { const int x = F.bid & 7, idx = F.bid >> 3;
                 if (idx < 8) p3_scan(F, x * 2 + (idx >> 2), idx & 3);
                 else { const int j = (idx - 8) * 8 + x;
                        const size_t n8 = (size_t)2 * NEXP * DM / 8; const int p0 = j < 128 ? 6 * j : 768 + 13 * (j - 128), p1 = p0 + (j < 128 ? 6 : 13);
                        peer_tables_to_fp8(F, (size_t)F.tid, (size_t)512, n8 * p0 / 1600, n8 * p1 / 1600);
                        __syncthreads();
                        for (int task = j; task < 512; task += 192) fs_direct_task(F, task); } }
             else { for (int u = F.bid; u < 64; u += F.G) p3_scan(F, u >> 2, u & 3); })
    PHASE(5, for (int r = gw; r < MTOK; r += NGW) p4_row(F, r);
             for (int id = gw; id < 8192; id += NGW) compress_sample(F, id);)
    PHASE(6, gemm_all(F, WSP(bf16, WS_OG), WSP(bf16, WS_WOA_T), 1024, FnResid{WSP(float, WS_XS), FIN(0), FIN(1)});)
    PHASE(7, for (int r = gw; r < MTOK; r += NGW) rms_row_to_bf16(WSP(float, WS_XS) + (size_t)r * DM, WSP(bf16, WS_XNB) + (size_t)r * DM, F.lane);)
    PHASE(8, gemm_all(F, WSP(bf16, WS_XNB), WSP(bf16, WS_WPQ_T), 2048, FnBf16{WSP(bf16, WS_QPEER), 2048});)
    PHASE(9, p8_phase(F, 0);)
    int pg_slice = F.bid & 7, pg_first = (F.bid >> 3) * 8 + F.wave, pg_stride = ((F.G - (F.bid & 7) + 7) >> 3) * 8;
#define PEER_GROUPS() do { if (MISC[8 + 3] != 0u && (F.G & 7) == 0) { const unsigned c_ = xb_ld(&barw[XB_XCNT(F.lane & 15)]); const bool ok_ = (F.lane & 15) < 8 ? c_ == (unsigned)(F.G >> 3) : c_ == 0u; \
        if (__builtin_amdgcn_ballot_w64(ok_) == ~0ull && bar.x < 8u) { pg_slice = (int)bar.x; pg_first = (int)MISC[8 + 2] * 8 + F.wave; pg_stride = F.G; } } } while (0)
    PHASE(10, PEER_GROUPS(); p9u_wave(F, 0, pg_slice, pg_first, pg_stride);)
    PHASE(11, PEER_GROUPS(); p9v_wave(F, 0, pg_slice, pg_first, pg_stride, 0);)
    PHASE(12, gemm_all(F, WSP(bf16, WS_XNA), WSP(bf16, WS_WKVQ_T), NKVQ, FnKvq{WSP(float, WS_KVQ), WSP(float, WS_SSQ)});)
    PHASE(13, for (int u = F.bid; u < 256; u += F.G) pp_prompt_tile(F, u);
              if (F.G == 256) { compress_prompt_split(F, F.bid * 2 + (F.wave >> 2)); if (F.wave == 7 && F.bid < MS) pp_sample_row(F, F.bid); }
              else { for (int r = gw; r < MS; r += NGW) pp_sample_row(F, r); for (int id = gw; id < 512; id += NGW) compress_prompt(F, id); })
    PHASE(14, if (F.G == 256) {
                  _Pragma("unroll 1") for (int q_ = 0; q_ < 1 + REPX; ++q_) { if (F.bid < 128) nsa_sample_wg(F, F.bid); }
                  __syncthreads();
                  nsa_wg(F, F.bid & 7, F.bid >> 3); nsa_wg(F, F.bid & 7, 63 - (F.bid >> 3));
              } else { for (int id = gw; id < 128 + 4096; id += NGW) { if (id < 128) nsa_unit<true>(F, id); else nsa_unit<false>(F, id - 128); } })
    PHASE(15, gemm_all(F, WSP(bf16, WS_OG), WSP(bf16, WS_WOB_T), 1024, FnResid{WSP(float, WS_XS), WSP(float, WS_XS), WSP(float, WS_XS) + (size_t)MP * DM});)
    PHASE(16, for (int r = gw; r < MTOK; r += NGW) rms_row_to_bf16(WSP(float, WS_XS) + (size_t)r * DM, WSP(bf16, WS_XNB) + (size_t)r * DM, F.lane);)
    PHASE(17, gemm_all(F, WSP(bf16, WS_XNB), WSP(bf16, WS_WPQ_T) + (size_t)2048 * 1024, 2048, FnBf16{WSP(bf16, WS_QPEER), 2048});)
    PHASE(18, p8_phase(F, 1);)
    PHASE(19, PEER_GROUPS(); p9u_wave(F, 1, pg_slice, pg_first, pg_stride);)
    PHASE(20, PEER_GROUPS(); p9v_wave(F, 1, pg_slice, pg_first, pg_stride, 1);)
#undef IN
#undef SEAM
}

extern "C" void kernel_launch(void* const* d_in, const int* in_sizes, int n_in, void* d_out, int out_size, void* d_ws, size_t ws_size, hipStream_t stream) {
    static int grid = 0;
    if (grid == 0) {
        if (n_in != 29 || (size_t)out_size != O_END || ws_size < WS_END) { fprintf(stderr, "kernel_launch: unexpected shapes n_in %d out %d ws %zu (need %zu)\n", n_in, out_size, ws_size, (size_t)WS_END); grid = -1; return; }
        int dev = 0, cus = 0, per_cu = 0;
        if (hipGetDevice(&dev) != hipSuccess || hipDeviceGetAttribute(&cus, hipDeviceAttributeMultiprocessorCount, dev) != hipSuccess) { grid = -1; return; }
        if (hipFuncSetAttribute((const void*)mk_fwd, hipFuncAttributeMaxDynamicSharedMemorySize, LDS_BYTES) != hipSuccess) { fprintf(stderr, "kernel_launch: hipFuncSetAttribute failed\n"); grid = -1; return; }
        if (hipOccupancyMaxActiveBlocksPerMultiprocessor(&per_cu, (const void*)mk_fwd, 512, LDS_BYTES) != hipSuccess || per_cu < 1) fprintf(stderr, "kernel_launch: occupancy query reports %d\n", per_cu);
        (void)hipGetLastError();
        grid = cus;
    }
    if (grid < 0) return;
    if (hipMemsetAsync((char*)d_ws + WS_CTL, 0, CTL_BYTES, stream) != hipSuccess) return;
    Args a{};
    for (int i = 0; i < 29; ++i) a.in[i] = (const float*)d_in[i];
    a.out = (float*)d_out; a.ws = (unsigned char*)d_ws;
#if MK_SINGLE
    a.ph_lo = 0; a.ph_hi = NPHASE;
    hipLaunchKernelGGL(mk_fwd, dim3(grid), dim3(512), LDS_BYTES, stream, a);
#else
    for (int p = 0; p < NPHASE; ++p) { a.ph_lo = p; a.ph_hi = p + 1; hipLaunchKernelGGL(mk_fwd, dim3(grid), dim3(512), LDS_BYTES, stream, a); }
#endif
    const hipError_t le = hipPeekAtLastError();
    if (le != hipSuccess) fprintf(stderr, "kernel_launch: launch failed: %s\n", hipGetErrorName(le));
}
```

```cpp
#include <hip/hip_runtime.h>
#include <cstdio>
#include <cstdint>

constexpr int DM = 1024, PB = 2, PT = 8192, SB = 32, SL = 4, PAST = 8192, PAGE = 128;
constexpr int MP = PB * PT;
constexpr int MS = SB * SL;
constexpr int MTOK = MP + MS;
constexpr int GH = 8, GDK = 128, GDV = 128, GCONV = 3072, GPROJ = 4112, CHUNK = 64, NCH = PT / CHUNK;
constexpr int NH = 16, NG = 4, HPG = 4, DH = 64, NQG = 1072, NKV = 1536, NKVQ = 2816, NKVQ_REAL = 2608;
constexpr int WINDOW = 512, NSELP = 128, NSELS = 129, NCMP = 511;
constexpr int PEH = 8, PEDQ = 256, PEHALF = 128, NKEYS = 128, NEXP = 16384, PETOP = 16;
constexpr int NPAGES = PAST / PAGE;
constexpr float EPS = 1e-6f;

constexpr size_t O_YP = 0;
constexpr size_t O_YS = O_YP + (size_t)MP * DM;
constexpr size_t O_KVP = O_YS + (size_t)MS * DM;
constexpr size_t O_WINP = O_KVP + (size_t)MP * 1024;
constexpr size_t O_GDNP = O_WINP + (size_t)PB * 512 * 512;
constexpr size_t O_CONVP = O_GDNP + (size_t)PB * GH * 128 * 128;
constexpr size_t O_KVS = O_CONVP + (size_t)PB * 3 * GCONV;
constexpr size_t O_WINS = O_KVS + (size_t)MS * 1024;
constexpr size_t O_GDNS = O_WINS + (size_t)SB * 512 * 512;
constexpr size_t O_CONVS = O_GDNS + (size_t)SB * GH * 128 * 128;
constexpr size_t O_END = O_CONVS + (size_t)SB * 3 * GCONV;

constexpr size_t MiB = 1u << 20;
constexpr size_t al(size_t x) { return (x + 4095) & ~(size_t)4095; }
constexpr size_t WS_CTL = 0, CTL_BYTES = 1 * MiB;
constexpr size_t WS_WIN_T = WS_CTL + CTL_BYTES;
constexpr size_t WS_WOA_T = WS_WIN_T + (size_t)4096 * 1024 * 2;
constexpr size_t WS_WKVQ_T = WS_WOA_T + (size_t)1024 * 1024 * 2;
constexpr size_t WS_WOB_T = WS_WKVQ_T + (size_t)NKVQ * 1024 * 2;
constexpr size_t WS_WPQ_T = WS_WOB_T + (size_t)1024 * 1024 * 2;
constexpr size_t WS_WAB = WS_WPQ_T + (size_t)2 * 2048 * 1024 * 2;
constexpr size_t WS_SUBK = WS_WAB + (size_t)16 * 1024 * 4;
constexpr size_t WS_W1T = WS_SUBK + (size_t)2 * 8 * 2 * 128 * 128 * 2;
constexpr size_t WS_PETERM = WS_W1T + (size_t)2 * 128 * 1024 * 2;
constexpr size_t WS_PU = al(WS_PETERM + 512);
constexpr size_t WS_PV = WS_PU + (size_t)2 * NEXP * DM * 2;
constexpr size_t WS_XNA = WS_PV + (size_t)2 * NEXP * DM * 2;
constexpr size_t WS_XNB = al(WS_XNA + (size_t)MTOK * DM * 2);
constexpr size_t WS_PROJ = al(WS_XNB + (size_t)MTOK * DM * 2);
constexpr size_t WS_GW = al(WS_PROJ + (size_t)MTOK * 4096 * 2);
constexpr size_t WS_GQ = WS_GW + (size_t)2048 * 64 * 128 * 2;
constexpr size_t WS_GKT = WS_GQ + (size_t)2048 * 64 * 128 * 2;
constexpr size_t WS_GQK = WS_GKT + (size_t)2048 * 64 * 128 * 2;
constexpr size_t WS_GU = WS_GQK + (size_t)2048 * 64 * 64 * 2;
constexpr size_t WS_GDEC = WS_GU + (size_t)2048 * 64 * 128 * 4;
constexpr size_t WS_OGDN = al(WS_GDEC + 2048 * 4);
constexpr size_t WS_OG = al(WS_OGDN + (size_t)MTOK * DM * 4);
constexpr size_t WS_XS = al(WS_OG + (size_t)MTOK * DM * 2);
constexpr size_t WS_QPEER = al(WS_XS + (size_t)MTOK * DM * 4);
constexpr size_t WS_PEI = al(WS_QPEER + (size_t)MTOK * 2048 * 2);
constexpr size_t WS_PEG = al(WS_PEI + (size_t)MTOK * 128 * 4);
constexpr size_t WS_KVQ = al(WS_PEG + (size_t)MTOK * 128 * 4);
constexpr size_t WS_KSEL = al(WS_KVQ + (size_t)MTOK * NKVQ * 4);
constexpr size_t WS_VSELT = WS_KSEL + (size_t)PB * NG * PT * 64 * 2;
constexpr size_t WS_KWIN = WS_VSELT + (size_t)PB * NG * PT * 64 * 2;
constexpr size_t WS_VWINT = WS_KWIN + (size_t)PB * NG * PT * 64 * 2;
constexpr size_t WS_KCMP = WS_VWINT + (size_t)PB * NG * PT * 64 * 2;
constexpr size_t WS_VCMPT = WS_KCMP + (size_t)PB * NG * 512 * 64 * 2;
constexpr size_t WS_SKCMP = WS_VCMPT + (size_t)PB * NG * 512 * 64 * 2;
constexpr size_t WS_SVCMPT = WS_SKCMP + (size_t)SB * NG * 512 * 64 * 2;
constexpr size_t WS_SKWIN = WS_SVCMPT + (size_t)SB * NG * 512 * 64 * 2;
constexpr size_t WS_SVWINT = WS_SKWIN + (size_t)SB * NG * 544 * 64 * 2;
constexpr size_t WS_SNEW = WS_SVWINT + (size_t)SB * NG * 544 * 64 * 2;
constexpr size_t WS_QN = al(WS_SNEW + (size_t)SB * 4 * 2 * 4 * 64 * 4);
constexpr size_t WS_GATES = al(WS_QN + (size_t)MTOK * 1024 * 2);
constexpr size_t WS_OACC = al(WS_GATES + (size_t)MTOK * 48 * 4);
constexpr size_t WS_CKA = al(WS_OACC + (size_t)MTOK * DM * 4);
constexpr size_t WS_W1BD = al(WS_CKA + (size_t)65536 * 2048 * 2);
constexpr size_t WS_FS = al(WS_W1BD + (size_t)256 * 2048 * 2);
constexpr size_t WS_PA = al(WS_FS + (size_t)65536 * 256 * 4);
constexpr size_t WS_SSQ = al(WS_PA + (size_t)MTOK * 8 * 64 * 4);
constexpr size_t WS_END = al(WS_SSQ + (size_t)MTOK * 8 * 4);

constexpr int RING_BYTES = 143360;
constexpr int LDSCTL_OFF = RING_BYTES, MISC_OFF = LDSCTL_OFF + 320;
constexpr int LDS_BYTES = 147456;

#define GAS __attribute__((address_space(1)))
#define LAS __attribute__((address_space(3)))
typedef unsigned short bf16;
typedef unsigned v4u __attribute__((ext_vector_type(4)));
typedef unsigned v2u __attribute__((ext_vector_type(2)));
typedef float f32x4 __attribute__((ext_vector_type(4)));
typedef float f32x2 __attribute__((ext_vector_type(2)));
typedef short bf16x8 __attribute__((ext_vector_type(8)));
typedef GAS unsigned gu32;
#define RLX_AGENT __ATOMIC_RELAXED, __HIP_MEMORY_SCOPE_AGENT
#define LDS_WAIT() asm volatile("s_waitcnt lgkmcnt(0)" ::: "memory")
#define VM_WAIT() asm volatile("s_waitcnt vmcnt(0)" ::: "memory")

__device__ __forceinline__ unsigned f2bf(float f) { unsigned u = __builtin_bit_cast(unsigned, f); return (u + 0x7fffu + ((u >> 16) & 1u)) >> 16; }
typedef __bf16 hwbf16x2 __attribute__((ext_vector_type(2)));
__device__ __forceinline__ unsigned pk2(float lo, float hi) { const f32x2 v = {lo, hi}; return __builtin_bit_cast(unsigned, __builtin_convertvector(v, hwbf16x2)); }
__device__ __forceinline__ float bf2f(unsigned b) { return __builtin_bit_cast(float, b << 16); }
__device__ __forceinline__ float bflo(unsigned w) { return __builtin_bit_cast(float, w << 16); }
__device__ __forceinline__ float bfhi(unsigned w) { return __builtin_bit_cast(float, w & 0xffff0000u); }
#ifndef USE_PERMSWAP
#define USE_PERMSWAP 1
#endif
template <int CTRL> __device__ __forceinline__ float dpp_f(float x) { return __builtin_bit_cast(float, __builtin_amdgcn_update_dpp(0, __builtin_bit_cast(int, x), CTRL, 0xF, 0xF, true)); }
template <int CTRL> __device__ __forceinline__ unsigned dpp_u(unsigned x) { return (unsigned)__builtin_amdgcn_update_dpp(0, (int)x, CTRL, 0xF, 0xF, true); }
#define DPP_XOR1 0xB1
#define DPP_XOR2 0x4E
#define DPP_HMIR 0x141
#define DPP_MIR 0x140
#define DPP_ROR4 0x124
#define DPP_ROR8 0x128
#if USE_PERMSWAP
#define PSWAP16(a, b) asm volatile("s_nop 1\n\tv_permlane16_swap_b32 %0, %1" : "+v"(a), "+v"(b))
#define PSWAP32(a, b) asm volatile("s_nop 1\n\tv_permlane32_swap_b32 %0, %1" : "+v"(a), "+v"(b))
__device__ __forceinline__ float x16_sum(float x) { unsigned a = __builtin_bit_cast(unsigned, x), b = a; PSWAP16(a, b); return __builtin_bit_cast(float, a) + __builtin_bit_cast(float, b); }
__device__ __forceinline__ float x32_sum(float x) { unsigned a = __builtin_bit_cast(unsigned, x), b = a; PSWAP32(a, b); return __builtin_bit_cast(float, a) + __builtin_bit_cast(float, b); }
__device__ __forceinline__ float x16_max(float x) { unsigned a = __builtin_bit_cast(unsigned, x), b = a; PSWAP16(a, b); return fmaxf(__builtin_bit_cast(float, a), __builtin_bit_cast(float, b)); }
__device__ __forceinline__ float x32_max(float x) { unsigned a = __builtin_bit_cast(unsigned, x), b = a; PSWAP32(a, b); return fmaxf(__builtin_bit_cast(float, a), __builtin_bit_cast(float, b)); }
__device__ __forceinline__ unsigned x16_umax(unsigned u) { unsigned a = u, b = u; PSWAP16(a, b); return a > b ? a : b; }
__device__ __forceinline__ unsigned x32_umax(unsigned u) { unsigned a = u, b = u; PSWAP32(a, b); return a > b ? a : b; }
#else
__device__ __forceinline__ float x16_sum(float x) { return x + __shfl_xor(x, 16); }
__device__ __forceinline__ float x32_sum(float x) { return x + __shfl_xor(x, 32); }
__device__ __forceinline__ float x16_max(float x) { return fmaxf(x, __shfl_xor(x, 16)); }
__device__ __forceinline__ float x32_max(float x) { return fmaxf(x, __shfl_xor(x, 32)); }
__device__ __forceinline__ unsigned x16_umax(unsigned u) { const unsigned o = __shfl_xor(u, 16); return u > o ? u : o; }
__device__ __forceinline__ unsigned x32_umax(unsigned u) { const unsigned o = __shfl_xor(u, 32); return u > o ? u : o; }
#endif
__device__ __forceinline__ float row_sum16(float x) { x += dpp_f<DPP_XOR1>(x); x += dpp_f<DPP_XOR2>(x); x += dpp_f<DPP_HMIR>(x); x += dpp_f<DPP_MIR>(x); return x; }
__device__ __forceinline__ float wave_sum(float v) { return x32_sum(x16_sum(row_sum16(v))); }
__device__ __forceinline__ float frcp(float x) { return __builtin_amdgcn_rcpf(x); }
__device__ __forceinline__ float frsq(float x) { return __builtin_amdgcn_rsqf(x); }
__device__ __forceinline__ float silu_f(float x) { return x * frcp(1.f + __expf(-x)); }
__device__ __forceinline__ float sigmoid_f(float x) { return frcp(1.f + __expf(-x)); }
__device__ __forceinline__ float gelu_tanh(float x) {
    const float u = 0.7978845608028654f * (x + 0.044715f * x * x * x);
    const float e = __expf(2.f * u);
    const float th = 1.f - 2.f * frcp(e + 1.f);
    return 0.5f * x * (1.f + th);
}
__device__ __forceinline__ bf16x8 ld8(const bf16* p) { return *(const bf16x8*)p; }
__device__ __forceinline__ bf16x8 ld8l(const LAS bf16* p) { return *(const LAS bf16x8*)p; }
#define MFMA16(a, b, c) __builtin_amdgcn_mfma_f32_16x16x32_bf16((a), (b), (c), 0, 0, 0)
__device__ __forceinline__ bf16x8 cvt8(f32x4 a, f32x4 b) {
    v4u r; r.x = pk2(a.x, a.y); r.y = pk2(a.z, a.w); r.z = pk2(b.x, b.y); r.w = pk2(b.z, b.w); return __builtin_bit_cast(bf16x8, r);
}

struct Frame {
    LAS unsigned char* lds;
    int tid, lane, wave, G, bid;
    const __attribute__((address_space(4))) char* ka;
    float* out;
    unsigned char* ws;
};
#define WSP(T, off) ((T*)(F.ws + (off)))
__device__ __forceinline__ const float* fin_(const __attribute__((address_space(4))) char* ka, int i) {
    const __attribute__((address_space(4))) char* p = ka; asm volatile("" : "+s"(p));
    return *(const float* const __attribute__((address_space(4)))*)(p + 8 * i);
}
#define FIN(i) fin_(F.ka, (i))
namespace pg8 {
#define PG8_LAS __attribute__((address_space(3)))
typedef unsigned short bf16_t;
typedef short bf16x8 __attribute__((ext_vector_type(8)));
typedef float f32x4 __attribute__((ext_vector_type(4)));
typedef unsigned u32x4 __attribute__((ext_vector_type(4)));
constexpr int BM = 256, BK = 64, HALF = 128, HTB = HALF * BK * 2  , STAGE_BYTES = 8 * HTB, NXCD = 8, WGM = 8;

__host__ __device__ __forceinline__ int lds_byte(int r, int c) { const int st = (r >> 4) * 2 + (c >> 5), rr = r & 15, cc = c & 31, ob = rr * 64 + cc * 2; return st * 1024 + (ob ^ (((ob >> 9) & 1) << 5)); }
__host__ __device__ __forceinline__ void stage_rc(int b, int& R, int& C) { const int st = b / 1024, sb = b % 1024, swz = sb ^ (((sb >> 9) & 1) << 5); R = (st >> 1) * 16 + swz / 64; C = (st & 1) * 32 + (swz % 64) / 2; }
__host__ __device__ __forceinline__ int perm32(int rho) { const int n = rho >> 4, i = rho & 15; return 8 * (i >> 2) + 4 * n + (i & 3); }

struct Unit { int pm, pn; };
struct Gemm { const bf16_t* A; const bf16_t* Bt; int M, N, K; };

struct StaticOrder {
    int nM, nN, nwg, G, c;
    __host__ __device__ void init(int M, int N, int G_, int c_) { nM = M / BM; nN = N / BM; nwg = nM * nN; G = G_; c = c_; }
    __host__ __device__ bool next(int i, Unit& u) const {
        const long L = (long)i * G + c; if (L >= nwg) return false;
        int wgid = (int)L; { const int q = nwg / NXCD, r = nwg % NXCD, xcd = wgid % NXCD, off = wgid / NXCD; wgid = (xcd < r ? xcd * (q + 1) : r * (q + 1) + (xcd - r) * q) + off; }
        const int nig = WGM * nN, gid = wgid / nig, fm = gid * WGM, gsz = (nM - fm) < WGM ? (nM - fm) : WGM;
        u.pm = fm + ((wgid % nig) % gsz); u.pn = (wgid % nig) / gsz; return true;
    }
    __device__ __forceinline__ void a_ready(const Unit&) const {}
    __device__ __forceinline__ void done(const Unit&) const {}
};
template <class Epi, class Sched, bool ALIGN_EPI = false, bool SP2 = false>
__device__ __forceinline__ void gemm_phase(PG8_LAS unsigned char* lds, const Gemm g, const Sched& S, const Epi& E) {
    const int tid = threadIdx.x, wid = __builtin_amdgcn_readfirstlane(tid >> 6), lane = tid & 63, wr = wid >> 2, wc = wid & 3, fr = lane & 15, fq = lane >> 4;
    const int K = g.K, nt = K / BK;
    unsigned voffA[2], voffB[2];
#pragma unroll
    for (int i = 0; i < 2; ++i) { int R, C; stage_rc(tid * 16 + i * 8192, R, C); const int Rb = Epi::PERM ? ((R & ~31) + perm32(R & 31)) : R;
        voffA[i] = (unsigned)(R * K + C) * 2u; voffB[i] = (unsigned)(Rb * K + C) * 2u; }
    const size_t kstep = (size_t)(BK * 2);
    const size_t hstep = (size_t)HALF * K * 2;
    const size_t tstep = 2 * hstep;
    const unsigned ldsw = (unsigned)wid * 1024u;
    const int aoff = lds_byte(wr * 64 + fr, fq * 8), boff = lds_byte(wc * 32 + fr, fq * 8);
#define PG8_SA(b, h) (((b) * 2 + (h)) * HTB)
#define PG8_SB(b, h) ((4 + (b) * 2 + (h)) * HTB)
#define PG8_STAGE(bufoff, gbase, voff) do { _Pragma("unroll") for (int _i = 0; _i < 2; ++_i) \
        __builtin_amdgcn_global_load_lds((const unsigned*)((const char*)(gbase) + (voff)[_i]), (PG8_LAS unsigned*)(lds + (bufoff) + ldsw + _i * 8192), 16, 0, 0); } while (0)
#define PG8_LDA(dst, b, h) do { _Pragma("unroll") for (int m = 0; m < 4; ++m) _Pragma("unroll") for (int k = 0; k < 2; ++k) dst[m][k] = *(const PG8_LAS bf16x8*)(lds + PG8_SA(b, h) + aoff + m * 2048 + k * 1024); } while (0)
#define PG8_LDB(dst, b, h) do { _Pragma("unroll") for (int n = 0; n < 2; ++n) _Pragma("unroll") for (int k = 0; k < 2; ++k) dst[n][k] = *(const PG8_LAS bf16x8*)(lds + PG8_SB(b, h) + boff + n * 2048 + k * 1024); } while (0)
#define PG8_MMA(ai, bj, At, Bt) do { __builtin_amdgcn_s_setprio(1); _Pragma("unroll") for (int m = 0; m < 4; ++m) _Pragma("unroll") for (int n = 0; n < 2; ++n) _Pragma("unroll") for (int k = 0; k < 2; ++k) \
        acc[ai][bj][m][n] = __builtin_amdgcn_mfma_f32_16x16x32_bf16(Bt[n][k], At[m][k], acc[ai][bj][m][n], 0, 0, 0); __builtin_amdgcn_s_setprio(0); } while (0)
#define PG8_WAIT_V(n) asm volatile("s_waitcnt vmcnt(" #n ")" ::: "memory")
#define PG8_WAIT_L(n) asm volatile("s_waitcnt lgkmcnt(" #n ")" ::: "memory")
#define PG8_BAR __builtin_amdgcn_s_barrier()
#define PG8_SCHED __builtin_amdgcn_sched_barrier(0)
    Unit cur, nxt; int ui = 0;
    if (!S.next(0, cur)) return;
    f32x4 acc[2][2][4][2];
#pragma unroll
    for (int a = 0; a < 2; ++a)
#pragma unroll
        for (int b = 0; b < 2; ++b)
#pragma unroll
            for (int m = 0; m < 4; ++m)
#pragma unroll
                for (int n = 0; n < 2; ++n) acc[a][b][m][n] = (f32x4){0.f, 0.f, 0.f, 0.f};
    bf16x8 At[4][2], B0[2][2], B1[2][2];
    const char* cA = (const char*)g.A + (size_t)cur.pm * tstep; const char* cB = (const char*)g.Bt + (size_t)cur.pn * tstep;
    S.a_ready(cur);
    if constexpr (SP2) {
        PG8_STAGE(PG8_SB(0, 0), cB, voffB); PG8_STAGE(PG8_SB(0, 1), cB + hstep, voffB); PG8_STAGE(PG8_SA(0, 0), cA, voffA); PG8_STAGE(PG8_SA(0, 1), cA + hstep, voffA);
        if (wr == 1) PG8_BAR;
        PG8_WAIT_V(2); PG8_BAR;
        PG8_STAGE(PG8_SB(1, 0), cB + kstep, voffB); PG8_STAGE(PG8_SA(1, 0), cA + kstep, voffA); PG8_STAGE(PG8_SB(1, 1), cB + hstep + kstep, voffB);
        PG8_WAIT_V(6); PG8_BAR;
    } else {
        PG8_STAGE(PG8_SB(0, 0), cB, voffB); PG8_STAGE(PG8_SA(0, 0), cA, voffA); PG8_STAGE(PG8_SB(0, 1), cB + hstep, voffB); PG8_STAGE(PG8_SA(0, 1), cA + hstep, voffA);
        if (wr == 1) PG8_BAR;
        PG8_WAIT_V(4); PG8_BAR;
        PG8_STAGE(PG8_SB(1, 0), cB + kstep, voffB); PG8_STAGE(PG8_SA(1, 0), cA + kstep, voffA); PG8_STAGE(PG8_SB(1, 1), cB + hstep + kstep, voffB);
        PG8_WAIT_V(6); PG8_BAR;
    }
    for (;;) {
        const bool has_next = S.next(ui + 1, nxt);
        const char* nA = has_next ? (const char*)g.A + (size_t)nxt.pm * tstep : cA; const char* nB = has_next ? (const char*)g.Bt + (size_t)nxt.pn * tstep : cB;
        for (int t = 0; t < nt; t += 2) {
            const bool last = (t == nt - 2);
            const char* a1 = cA + (size_t)(t + 1) * kstep;
            const char* a2 = last ? nA : cA + (size_t)(t + 2) * kstep; const char* b2 = last ? nB : cB + (size_t)(t + 2) * kstep;
            const char* a3 = a2 + kstep; const char* b3 = b2 + kstep;
            if (last && has_next) S.a_ready(nxt);
            if constexpr (SP2) {
            PG8_LDB(B0, 0, 0); PG8_LDB(B1, 0, 1); PG8_SCHED; PG8_LDA(At, 0, 0); PG8_STAGE(PG8_SA(1, 1), a1 + hstep, voffA);
            PG8_WAIT_V(8); PG8_WAIT_L(0); PG8_BAR; PG8_MMA(0, 0, At, B0); PG8_MMA(0, 1, At, B1); PG8_BAR; PG8_SCHED;
            PG8_LDA(At, 0, 1); PG8_STAGE(PG8_SB(0, 0), b2, voffB); PG8_STAGE(PG8_SB(0, 1), b2 + hstep, voffB); PG8_STAGE(PG8_SA(0, 0), a2, voffA);
            PG8_WAIT_V(8); PG8_WAIT_L(0); PG8_BAR; PG8_MMA(1, 0, At, B0); PG8_MMA(1, 1, At, B1); PG8_BAR; PG8_SCHED;
            PG8_LDB(B0, 1, 0); PG8_LDB(B1, 1, 1); PG8_SCHED; PG8_LDA(At, 1, 0); PG8_STAGE(PG8_SA(0, 1), a2 + hstep, voffA);
            PG8_WAIT_V(8); PG8_WAIT_L(0); PG8_BAR; PG8_MMA(0, 0, At, B0); PG8_MMA(0, 1, At, B1); PG8_BAR; PG8_SCHED;
            PG8_LDA(At, 1, 1); PG8_STAGE(PG8_SB(1, 0), b3, voffB); PG8_STAGE(PG8_SB(1, 1), b3 + hstep, voffB); PG8_STAGE(PG8_SA(1, 0), a3, voffA);
            PG8_WAIT_V(8); PG8_WAIT_L(0); PG8_BAR; PG8_MMA(1, 0, At, B0); PG8_MMA(1, 1, At, B1); PG8_BAR; PG8_SCHED;
            } else {
            PG8_LDB(B0, 0, 0); PG8_SCHED; PG8_LDA(At, 0, 0); PG8_STAGE(PG8_SA(1, 1), a1 + hstep, voffA);
            PG8_WAIT_L(8); PG8_BAR; PG8_WAIT_L(0); PG8_MMA(0, 0, At, B0); PG8_BAR; PG8_SCHED;
            PG8_LDB(B1, 0, 1); PG8_STAGE(PG8_SB(0, 0), b2, voffB);
            PG8_BAR; PG8_WAIT_L(0); PG8_MMA(0, 1, At, B1); PG8_BAR;
            PG8_LDA(At, 0, 1); PG8_STAGE(PG8_SA(0, 0), a2, voffA);
            PG8_BAR; PG8_WAIT_L(0); PG8_MMA(1, 0, At, B0); PG8_BAR; PG8_SCHED;
            PG8_STAGE(PG8_SB(0, 1), b2 + hstep, voffB);
            PG8_WAIT_V(6); PG8_BAR; PG8_MMA(1, 1, At, B1); PG8_BAR;
            PG8_LDB(B0, 1, 0); PG8_SCHED; PG8_LDA(At, 1, 0); PG8_STAGE(PG8_SA(0, 1), a2 + hstep, voffA);
            PG8_WAIT_L(8); PG8_BAR; PG8_WAIT_L(0); PG8_MMA(0, 0, At, B0); PG8_BAR; PG8_SCHED;
            PG8_LDB(B1, 1, 1); PG8_STAGE(PG8_SB(1, 0), b3, voffB);
            PG8_BAR; PG8_WAIT_L(0); PG8_MMA(0, 1, At, B1); PG8_BAR;
            PG8_LDA(At, 1, 1); PG8_STAGE(PG8_SA(1, 0), a3, voffA);
            PG8_BAR; PG8_WAIT_L(0); PG8_MMA(1, 0, At, B0); PG8_BAR; PG8_SCHED;
            PG8_STAGE(PG8_SB(1, 1), b3 + hstep, voffB);
            PG8_WAIT_V(6); PG8_BAR; PG8_MMA(1, 1, At, B1); PG8_BAR;
            }
        }
        if constexpr (ALIGN_EPI) { if (wr == 0) PG8_BAR; }
        if constexpr (!Epi::AFTER_DRAIN) { E(acc, cur, wr, wc, fr, fq); S.done(cur); }
        if (!has_next) break;
#pragma unroll
        for (int a = 0; a < 2; ++a)
#pragma unroll
            for (int b = 0; b < 2; ++b)
#pragma unroll
                for (int m = 0; m < 4; ++m)
#pragma unroll
                    for (int n = 0; n < 2; ++n) acc[a][b][m][n] = (f32x4){0.f, 0.f, 0.f, 0.f};
        cur = nxt; cA = nA; cB = nB; ++ui;
        if constexpr (ALIGN_EPI) { if (wr == 1) PG8_BAR; }
    }
    PG8_WAIT_V(0);
    if constexpr (!ALIGN_EPI) { if (wr == 0) PG8_BAR; }
    PG8_BAR;
    if constexpr (Epi::AFTER_DRAIN) { E.fused(acc, cur, wr, wc, fr, fq, lds, wid, lane); S.done(cur); }
#undef PG8_SA
#undef PG8_SB
#undef PG8_STAGE
#undef PG8_LDA
#undef PG8_LDB
#undef PG8_MMA
#undef PG8_WAIT_V
#undef PG8_WAIT_L
#undef PG8_BAR
#undef PG8_SCHED
}
}
#define XB_TMO      128
#define XB_XCNT(j)  (256  + 64 * (j))
#define XB_XSUB(j)  (1280 + 64 * (j))
#define XB_XGEN(j)  (2304 + 64 * (j))
#define XB_TOP      3328
#define XB_TOPGEN   3392
#define XCD_BAR_WORDS 3456
#define XB_SPIN_CAP (1u << 18)

__device__ __forceinline__ unsigned xb_ld(unsigned* p)              { return __hip_atomic_load(p, __ATOMIC_RELAXED, __HIP_MEMORY_SCOPE_AGENT); }
__device__ __forceinline__ unsigned xb_add(unsigned* p, unsigned v) { return __hip_atomic_fetch_add(p, v, __ATOMIC_RELAXED, __HIP_MEMORY_SCOPE_AGENT); }
__device__ __forceinline__ unsigned xb_xcc_id() { return (unsigned)__builtin_amdgcn_s_getreg((3 << 11) | 20) & 0xFu; }
#define XB_SPIN(cond, bar) do { unsigned _sp = 0; while (cond) { __builtin_amdgcn_s_sleep(1); \
    if ((++_sp & 255u) == 0u) { if (xb_ld(&(bar)[XB_TMO])) break; if (_sp > XB_SPIN_CAP) { atomicAdd(&(bar)[XB_TMO], 1u); break; } } } } while (0)

struct XcdBarrier {
    unsigned* bar; unsigned x;
    volatile LAS unsigned* st;
};

__device__ __forceinline__ XcdBarrier xcd_barrier_post(unsigned* bar, volatile LAS unsigned* st) {
    XcdBarrier b; b.bar = bar; b.x = xb_xcc_id(); b.st = st;
    if (threadIdx.x == 0) { st[2] = xb_add(&bar[XB_XCNT(b.x)], 1u); st[3] = 1u; }
    return b;
}
__device__ __forceinline__ void xcd_barrier_complete(unsigned* bar, unsigned x, unsigned& nloc, unsigned& nx) {
    const unsigned G = gridDim.x * gridDim.y * gridDim.z;
    unsigned sum, cnt, mine, sp = 0u;
    for (;;) {
        sum = 0u; cnt = 0u; mine = 0u;
#pragma unroll
        for (unsigned j = 0; j < 16; ++j) { const unsigned c = xb_ld(&bar[XB_XCNT(j)]); sum += c; cnt += (c > 0u) ? 1u : 0u; mine = (j == x) ? c : mine; }
        if (sum == G) break;
        __builtin_amdgcn_s_sleep(1);
        if ((++sp & 255u) == 0u) { if (xb_ld(&bar[XB_TMO])) break; if (sp > XB_SPIN_CAP) { atomicAdd(&bar[XB_TMO], 1u); break; } }
    }
    nloc = mine > 0u ? mine : 1u; nx = cnt > 0u ? cnt : 1u;
}

__device__ __forceinline__ void xcd_barrier(const XcdBarrier& b) {
    asm volatile("s_waitcnt vmcnt(0)" ::: "memory");
    __syncthreads();
    if (threadIdx.x == 0) {
        unsigned* bar = b.bar;
        __builtin_amdgcn_s_waitcnt(0);
        unsigned nloc = b.st[0], nx = b.st[1];
        if (nloc == 0u) { xcd_barrier_complete(bar, b.x, nloc, nx); b.st[0] = nloc; b.st[1] = nx; }
        const unsigned old = xb_add(&bar[XB_XSUB(b.x)], 1u);
        const unsigned gen = old / nloc;
        if (old + 1u == (gen + 1u) * nloc) {
            __builtin_amdgcn_fence(__ATOMIC_RELEASE, "agent");
            asm volatile("s_waitcnt vmcnt(0)" ::: "memory");
            const unsigned og = xb_add(&bar[XB_TOP], 1u);
            const unsigned tg = og / nx;
            if (og + 1u == (tg + 1u) * nx) xb_add(&bar[XB_TOPGEN], 1u);
            else XB_SPIN(xb_ld(&bar[XB_TOPGEN]) == tg, bar);
            __builtin_amdgcn_fence(__ATOMIC_ACQUIRE, "agent");
            xb_add(&bar[XB_XGEN(b.x)], 1u);
            asm volatile("s_waitcnt vmcnt(0)" ::: "memory");
        } else {
            XB_SPIN(xb_ld(&bar[XB_XGEN(b.x)]) == gen, bar);
            __builtin_amdgcn_fence(__ATOMIC_ACQUIRE, "agent");
            asm volatile("s_waitcnt vmcnt(0)" ::: "memory");
        }
    }
    __syncthreads();
}

namespace pg8 {
template <class Fn> struct EpiFn {
    static constexpr bool PERM = true, AFTER_DRAIN = false;
    Fn f;
    __device__ __forceinline__ void operator()(const f32x4 (&acc)[2][2][4][2], const Unit& u, int wr, int wc, int fr, int fq) const {
        const int row0 = u.pm * BM + wr * 64 + fr, col0 = u.pn * BM + wc * 32 + 8 * fq;
#pragma unroll
        for (int ai = 0; ai < 2; ++ai)
#pragma unroll
            for (int m = 0; m < 4; ++m)
#pragma unroll
                for (int bj = 0; bj < 2; ++bj) f.e8(row0 + ai * HALF + m * 16, col0 + bj * HALF, acc[ai][bj][m][0], acc[ai][bj][m][1]);
    }
};
}

struct FnBf16 {
    bf16* O; int ld;
    __device__ __forceinline__ void e8(int row, int col, f32x4 a, f32x4 b) const {
        v4u w; w.x = pk2(a.x, a.y); w.y = pk2(a.z, a.w); w.z = pk2(b.x, b.y); w.w = pk2(b.z, b.w);
        *(v4u*)(O + (size_t)row * ld + col) = w;
    }
    __device__ __forceinline__ void e4(int row, int col, f32x4 a) const {
        v2u w; w.x = pk2(a.x, a.y); w.y = pk2(a.z, a.w);
        *(v2u*)(O + (size_t)row * ld + col) = w;
    }
};
struct FnResid {
    float* XS; const float* baseP; const float* baseS;
    __device__ __forceinline__ const float* brow(int row) const { return row < MP ? baseP + (size_t)row * DM : baseS + (size_t)(row - MP) * DM; }
    __device__ __forceinline__ void e8(int row, int col, f32x4 a, f32x4 b) const {
        const float* br = brow(row) + col; float* o = XS + (size_t)row * DM + col;
        const f32x4 x0 = *(const f32x4*)br, x1 = *(const f32x4*)(br + 4);
        *(f32x4*)o = x0 + a; *(f32x4*)(o + 4) = x1 + b;
    }
    __device__ __forceinline__ void e4(int row, int col, f32x4 a) const {
        const float* br = brow(row) + col; float* o = XS + (size_t)row * DM + col;
        *(f32x4*)o = *(const f32x4*)br + a;
    }
};
struct FnF32 {
    float* O; int ld;
    __device__ __forceinline__ void e8(int row, int col, f32x4 a, f32x4 b) const { float* o = O + (size_t)row * ld + col; *(f32x4*)o = a; *(f32x4*)(o + 4) = b; }
    __device__ __forceinline__ void e4(int row, int col, f32x4 a) const { *(f32x4*)(O + (size_t)row * ld + col) = a; }
};
struct FnKvq {
    bf16* O; const float* ssq;
    __device__ __forceinline__ float rstd(int row) const { const f32x4 s0 = *(const f32x4*)(ssq + (size_t)row * 8), s1 = *(const f32x4*)(ssq + (size_t)row * 8 + 4);
        return frsq((((s0.x + s0.y) + (s0.z + s0.w)) + ((s1.x + s1.y) + (s1.z + s1.w))) * (1.f / DM) + EPS); }
    __device__ __forceinline__ void e8(int row, int col, f32x4 a, f32x4 b) const {
        if (col < NKVQ_REAL) { const float rs = rstd(row); a = a * rs; b = b * rs; *(v4u*)(O + (size_t)row * NKVQ + col) = (v4u){pk2(a.x, a.y), pk2(a.z, a.w), pk2(b.x, b.y), pk2(b.z, b.w)}; }
    }
    __device__ __forceinline__ void e4(int row, int col, f32x4 a) const {
        if (col < NKVQ_REAL) { a = a * rstd(row); *(v2u*)(O + (size_t)row * NKVQ + col) = (v2u){pk2(a.x, a.y), pk2(a.z, a.w)}; }
    }
};

template <class Fn>
__device__ __forceinline__ void skinny_gemm(Frame& F, const bf16* A, const bf16* Bt, int N, int row_base, const Fn& fn) {
    const int fr = F.lane & 15, fq = F.lane >> 4;
    const int nun = N / 16;
    for (int u = F.bid; u < nun; u += F.G) {
        const bf16* ap = Bt + (size_t)(u * 16 + fr) * DM + fq * 8;
        const bf16* bp = A + (size_t)(F.wave * 16 + fr) * DM + fq * 8;
        f32x4 acc = {0.f, 0.f, 0.f, 0.f};
#pragma unroll 8
        for (int ks = 0; ks < 32; ++ks) acc = MFMA16(ld8(ap + ks * 32), ld8(bp + ks * 32), acc);
        fn.e4(row_base + F.wave * 16 + fr, u * 16 + 4 * fq, acc);
    }
}

template <class Fn>
__device__ __forceinline__ void gemm_all(Frame& F, const bf16* A, const bf16* Bt, int N, const Fn& fn) {
    pg8::Gemm g{A, Bt, MP, N, DM}; pg8::StaticOrder S; S.init(MP, N, F.G, F.bid);
    pg8::EpiFn<Fn> E{fn};
    pg8::gemm_phase<pg8::EpiFn<Fn>, pg8::StaticOrder, true, true>(F.lds, g, S, E);
    skinny_gemm(F, A + (size_t)MP * DM, Bt, N, MP, fn);
}

__device__ __forceinline__ void p0_transpose_item(const float* W, int N, bf16* WT, int row_off, const float* gain, LAS float* scr, int item, int lane) {
    const int nblk = (N + 31) / 32, kb = item / nblk, nb = item % nblk, k0 = 64 * kb, n0 = 32 * nb;
#pragma unroll 8
    for (int i = 0; i < 32; ++i) { const int kk = 2 * i + (lane >> 5); const int n = n0 + (lane & 31);
        float v = 0.f; if (n < N) { v = W[(size_t)(k0 + kk) * N + n]; if (gain) v *= gain[k0 + kk]; }
        scr[kk * 33 + (lane & 31)] = v; }
    LDS_WAIT(); asm volatile("" ::: "memory");
    const int c = lane & 7;
#pragma unroll
    for (int j = 0; j < 4; ++j) { const int n = (lane >> 3) + 8 * j; const LAS float* s = scr + (8 * c) * 33 + n;
        v4u o; o.x = pk2(s[0 * 33], s[1 * 33]); o.y = pk2(s[2 * 33], s[3 * 33]); o.z = pk2(s[4 * 33], s[5 * 33]); o.w = pk2(s[6 * 33], s[7 * 33]);
        if (n0 + n < N) *(v4u*)(WT + (size_t)(row_off + n0 + n) * DM + k0 + 8 * c) = o; }
    LDS_WAIT(); asm volatile("" ::: "memory");
}
__device__ __forceinline__ void rms_row_to_bf16(const float* xrow, bf16* orow, int lane) {
    const f32x4* xr = (const f32x4*)xrow + lane;
    f32x4 v[4]; float s = 0.f;
#pragma unroll
    for (int j = 0; j < 4; ++j) { v[j] = xr[64 * j]; s += (v[j].x * v[j].x + v[j].y * v[j].y) + (v[j].z * v[j].z + v[j].w * v[j].w); }
    const float rstd = frsq(wave_sum(s) * (1.f / DM) + EPS);
    v2u* o8 = (v2u*)orow + lane;
#pragma unroll
    for (int j = 0; j < 4; ++j) { v2u w; w.x = pk2(v[j].x * rstd, v[j].y * rstd); w.y = pk2(v[j].z * rstd, v[j].w * rstd); o8[64 * j] = w; }
}
__device__ __forceinline__ const float* xin_row(Frame& F, int row) { return row < MP ? FIN(0) + (size_t)row * DM : FIN(1) + (size_t)(row - MP) * DM; }

__device__ __forceinline__ void peer_tables_to_fp8(Frame& F, size_t thr, size_t nthr, size_t lo = 0, size_t hi = (size_t)2 * NEXP * DM / 8) {
    const size_t gt = thr, NGT = nthr;
        for (int t = 0; t < 2; ++t) { const f32x4* src = (const f32x4*)FIN(27 + t); v2u* dst = (v2u*)WSP(unsigned char, t == 0 ? WS_PU : WS_PV); const float* pln = FIN(24);
            for (size_t i0 = lo + gt; i0 < hi; i0 += (size_t)4 * NGT) {
                f32x4 a[4], b[4];
#pragma unroll
                for (int u = 0; u < 4; ++u) { const size_t i = i0 + (size_t)u * NGT; if (i < hi) { a[u] = src[2 * i]; b[u] = src[2 * i + 1]; } }
#pragma unroll
                for (int u = 0; u < 4; ++u) { const size_t i = i0 + (size_t)u * NGT; if (i < hi) {
                    if (t == 0) { const float* gp = pln + ((i >> 21) << 10) + ((i & 127) << 3); a[u] = a[u] * *(const f32x4*)gp * 32.f; b[u] = b[u] * *(const f32x4*)(gp + 4) * 32.f; }
                    else { a[u] = a[u] * 16.f; b[u] = b[u] * 16.f; }
                    int w0 = __builtin_amdgcn_cvt_pk_fp8_f32(a[u].x, a[u].y, 0, false); w0 = __builtin_amdgcn_cvt_pk_fp8_f32(a[u].z, a[u].w, w0, true);
                    int w1 = __builtin_amdgcn_cvt_pk_fp8_f32(b[u].x, b[u].y, 0, false); w1 = __builtin_amdgcn_cvt_pk_fp8_f32(b[u].z, b[u].w, w1, true);
                    dst[((((i >> 21) * 8 + ((i & 127) >> 4)) * (size_t)NEXP + ((i >> 7) & (NEXP - 1))) << 4) + (i & 15)] = (v2u){(unsigned)w0, (unsigned)w1}; } } } }
}

constexpr int FD_BUF = 16384;
__device__ __forceinline__ void fs_direct_task(Frame& F, int task) {
    int lane_ = F.lane; asm volatile("" : "+v"(lane_));
    const int lane = lane_, w = F.wave, fr = lane & 15, fq = lane >> 4, kv = w >> 2, g = w & 3, bs = task >> 4, c0 = (task & 15) * 32;
    LAS unsigned char* L = F.lds; asm volatile("" : "+v"(L));
    const float* cache = FIN(2); const int* pt = (const int*)FIN(6) + bs * NPAGES;
    const float* base[2];
#pragma unroll
    for (int nt = 0; nt < 2; ++nt) { const int t0 = 16 * (c0 + 16 * nt + fr); base[nt] = cache + ((size_t)pt[t0 >> 7] * PAGE + (t0 & 127)) * 1024 + kv * 256 + g * 64 + 8 * fq; }
    const bf16* wsrc[2]; int wdst[2];
#pragma unroll
    for (int q = 0; q < 2; ++q) { const int item = F.tid + 512 * q, kvw = item >> 9, n = (item >> 2) & 127, kq = item & 3;
        wsrc[q] = WSP(bf16, WS_W1BD) + (size_t)(kvw * 128 + n) * 2048 + kvw * 1024 + 8 * kq; wdst[q] = ((kvw * 8 + (n >> 4)) * 64 + kq * 16 + (n & 15)) * 16; }
    f32x4 acc[2][8];
#pragma unroll
    for (int nt = 0; nt < 2; ++nt)
#pragma unroll
        for (int mt = 0; mt < 8; ++mt) acc[nt][mt] = (f32x4){0.f, 0.f, 0.f, 0.f};
    f32x4 S0[2][4], S1[2][4]; v4u wr[2];
#define FD_DATA(S, r) do { const int r_ = (r) < 16 ? (r) : 15; _Pragma("unroll") for (int nt_ = 0; nt_ < 2; ++nt_) { const float* p_ = base[nt_] + r_ * 1024; \
        S[nt_][0] = *(const f32x4*)p_; S[nt_][1] = *(const f32x4*)(p_ + 4); S[nt_][2] = *(const f32x4*)(p_ + 32); S[nt_][3] = *(const f32x4*)(p_ + 36); } } while (0)
#define FD_WLOAD(ks) do { const int ks_ = (ks) < 32 ? (ks) : 31; wr[0] = *(const v4u*)(wsrc[0] + 32 * ks_); wr[1] = *(const v4u*)(wsrc[1] + 32 * ks_); } while (0)
#define FD_WSTORE(buf) do { *(LAS v4u*)(L + (buf) * FD_BUF + wdst[0]) = wr[0]; *(LAS v4u*)(L + (buf) * FD_BUF + wdst[1]) = wr[1]; } while (0)
#define FD_KSTEP(bq, ks, buf) do { \
        _Pragma("unroll") for (int mt_ = 0; mt_ < 8; ++mt_) { const bf16x8 a_ = *(const LAS bf16x8*)(L + (buf) * FD_BUF + ((kv * 8 + mt_) * 64 + lane) * 16); \
            acc[0][mt_] = MFMA16(a_, bq[0], acc[0][mt_]); acc[1][mt_] = MFMA16(a_, bq[1], acc[1][mt_]); } \
        FD_WSTORE((buf) ^ 1); FD_WLOAD((ks) + 2); \
        __syncthreads(); } while (0)
#define FD_ROW(S, r) do { bf16x8 b0_[2], b1_[2]; _Pragma("unroll") for (int nt_ = 0; nt_ < 2; ++nt_) { b0_[nt_] = cvt8(S[nt_][0], S[nt_][1]); b1_[nt_] = cvt8(S[nt_][2], S[nt_][3]); } \
        FD_DATA(S, (r) + 2); \
        FD_KSTEP(b0_, 2 * (r), 0); FD_KSTEP(b1_, 2 * (r) + 1, 1); } while (0)
    FD_WLOAD(0); FD_WSTORE(0); FD_WLOAD(1); FD_DATA(S0, 0); FD_DATA(S1, 1);
    __syncthreads();
#pragma unroll 1
    for (int r = 0; r < 16; r += 2) { FD_ROW(S0, r); FD_ROW(S1, r + 1); }
#undef FD_KSTEP
#undef FD_ROW
#undef FD_DATA
#undef FD_WLOAD
#undef FD_WSTORE
    bf16* fs = WSP(bf16, WS_FS) + ((size_t)(bs * 4 + g) * 512 + c0 + fr) * 256 + kv * 128 + 4 * fq;
#pragma unroll
    for (int nt = 0; nt < 2; ++nt)
#pragma unroll
        for (int mt = 0; mt < 8; ++mt) *(v2u*)(fs + (size_t)nt * 16 * 256 + 16 * mt) = (v2u){pk2(acc[nt][mt][0], acc[nt][mt][1]), pk2(acc[nt][mt][2], acc[nt][mt][3])};
    __syncthreads();
}

__device__ __forceinline__ void p0_prologue(Frame& F) {
    LAS float* scr = (LAS float*)(F.lds + F.wave * 16384);
    const int gw = F.bid * 8 + F.wave, NGW = F.G * 8;
    const int gt = F.bid * 512 + F.tid, NGT = F.G * 512;
    {
        constexpr int I_IN = 128 * 16, I_OA = 32 * 16, I_KV = 48 * 16, I_QG = 34 * 16, I_OB = 32 * 16, I_PQ = 64 * 16;
        constexpr int NITEMS = I_IN + I_OA + I_KV + I_QG + I_OB + 2 * I_PQ;
        for (int it = gw; it < NITEMS; it += NGW) {
            int r = it;
            if (r < I_IN) {
                const int kb = r / 128, nb = r % 128, k0 = 64 * kb, n0 = 32 * nb; const float* W = FIN(8); const float* gain = FIN(7);
#pragma unroll 8
                for (int i = 0; i < 32; ++i) { const int kk = 2 * i + (F.lane >> 5); scr[kk * 33 + (F.lane & 31)] = W[(size_t)(k0 + kk) * GPROJ + n0 + (F.lane & 31)] * gain[k0 + kk]; }
                LDS_WAIT(); asm volatile("" ::: "memory");
                const int c = F.lane & 7;
#pragma unroll
                for (int j = 0; j < 4; ++j) { const int n = (F.lane >> 3) + 8 * j; const LAS float* s = scr + (8 * c) * 33 + n;
                    v4u o; o.x = pk2(s[0 * 33], s[1 * 33]); o.y = pk2(s[2 * 33], s[3 * 33]); o.z = pk2(s[4 * 33], s[5 * 33]); o.w = pk2(s[6 * 33], s[7 * 33]);
                    *(v4u*)(WSP(bf16, WS_WIN_T) + (size_t)(n0 + n) * DM + k0 + 8 * c) = o; }
                LDS_WAIT(); asm volatile("" ::: "memory");
                continue; }
            r -= I_IN;
            if (r < I_OA) { p0_transpose_item(FIN(13), 1024, WSP(bf16, WS_WOA_T), 0, nullptr, scr, r, F.lane); continue; } r -= I_OA;
            if (r < I_KV) { p0_transpose_item(FIN(15), NKV, WSP(bf16, WS_WKVQ_T), 0, FIN(14), scr, r, F.lane); continue; } r -= I_KV;
            if (r < I_QG) { p0_transpose_item(FIN(21), NQG, WSP(bf16, WS_WKVQ_T), NKV, FIN(20), scr, r, F.lane); continue; } r -= I_QG;
            if (r < I_OB) { p0_transpose_item(FIN(23), 1024, WSP(bf16, WS_WOB_T), 0, nullptr, scr, r, F.lane); continue; } r -= I_OB;
            if (r < I_PQ) { p0_transpose_item(FIN(25), 2048, WSP(bf16, WS_WPQ_T), 0, FIN(24), scr, r, F.lane); continue; } r -= I_PQ;
            p0_transpose_item(FIN(25) + (size_t)1024 * 2048, 2048, WSP(bf16, WS_WPQ_T) + (size_t)2048 * 1024, 0, FIN(24) + 1024, scr, r, F.lane);
        }
        for (int i = gt; i < (NKVQ - NKVQ_REAL) * DM / 8; i += NGT) ((v4u*)(WSP(bf16, WS_WKVQ_T) + (size_t)NKVQ_REAL * DM))[i] = (v4u){0u, 0u, 0u, 0u};
        for (int i = gt; i < 16 * 1024; i += NGT) { const int j = i >> 10, k = i & 1023; WSP(float, WS_WAB)[i] = FIN(7)[k] * FIN(8)[(size_t)k * GPROJ + 4096 + j]; }
    }
    for (int m = gw; m < MTOK; m += NGW) rms_row_to_bf16(xin_row(F, m), WSP(bf16, WS_XNA) + (size_t)m * DM, F.lane);
    {
        if (F.G != 256) peer_tables_to_fp8(F, (size_t)gt, (size_t)NGT);
        const f32x4* sk = (const f32x4*)FIN(26); v4u* dk = (v4u*)WSP(bf16, WS_SUBK);
        for (int i = gt; i < 2 * 8 * 2 * 128 * 128 / 8; i += NGT) { const f32x4 a = sk[2 * i], b = sk[2 * i + 1]; v4u w; w.x = pk2(a.x, a.y); w.y = pk2(a.z, a.w); w.z = pk2(b.x, b.y); w.w = pk2(b.z, b.w); dk[i] = w; }
    }
    for (int i = gt; i < 2 * 64 * 2048; i += NGT) { const int kv = i >> 17, hh = (i >> 11) & 63, k = i & 2047;
        WSP(bf16, WS_W1T)[i] = (bf16)f2bf(FIN(17)[((size_t)kv * 2048 + k) * 64 + hh]); }
    for (int it = gw; it < 128; it += NGW) { const int kv = it >> 6, h = it & 63; float s = 0.f;
        for (int k = F.lane; k < 2048; k += 64) s += FIN(18)[(size_t)kv * 2048 + k] * FIN(17)[((size_t)kv * 2048 + k) * 64 + h];
        s = wave_sum(s); if (F.lane == 0) WSP(float, WS_PETERM)[it] = s; }
    {
        bf16* wbd = WSP(bf16, WS_W1BD);
        for (int i = gt; i < 256 * 2048; i += NGT) { const int n = i >> 11, col = i & 2047, kv = n >> 7, sec = (n >> 6) & 1, hh = n & 63;
            float v = 0.f; if ((col >> 10) == kv) { const int k = col & 1023, r = (k >> 6) + 16 * sec, d = k & 63; v = FIN(17)[(((size_t)kv * 32 + r) * 64 + d) * 64 + hh]; }
            wbd[i] = (bf16)f2bf(v); }
    }
    {
        const f32x4* src = (const f32x4*)FIN(3); f32x4* dst = (f32x4*)(F.out + O_WINS);
        const int per_b = 508 * 512 / 4;
        for (int i = gt; i < SB * per_b; i += NGT) { const int b = i / per_b, r = i % per_b; dst[(size_t)b * (512 * 512 / 4) + r] = src[(size_t)b * (512 * 512 / 4) + 4 * 512 / 4 + r]; }
    }
    for (int i = gt; i < SB * NG * 544 * 64; i += NGT) {
        const int d = i & 63, r = (i >> 6) % 544, bg = (i >> 6) / 544, g = bg & 3, b = bg >> 2;
        if (r < 512) { const float* cw = FIN(3) + (((size_t)b * 512 + r) * 2) * 256 + g * 64 + d;
            WSP(bf16, WS_SKWIN)[i] = (bf16)f2bf(cw[0]);
            WSP(bf16, WS_SVWINT)[((size_t)bg * 64 + d) * 544 + r] = (bf16)f2bf(cw[256]); }
        else if (r >= 516) { WSP(bf16, WS_SKWIN)[i] = 0; WSP(bf16, WS_SVWINT)[((size_t)bg * 64 + d) * 544 + r] = 0; }
    }
}

constexpr int P2_QS = 0, P2_KS = 17408, P2_KBGT = 34816, P2_VBT = 53248, P2_AM = 71680, P2_TB = 89088, P2_G = 98304, P2_TF = 99328, P2_XF = 116736;
constexpr int QS_LD = 136, KT_LD = 72, AM_LD = 68, TB_LD = 72;

__device__ __forceinline__ float softplus_f(float x) { return fmaxf(x, 0.f) + __logf(1.f + __expf(-fabsf(x))); }

__device__ __forceinline__ void p2_chunk(Frame& F, int unit) {
    const int c = unit & 127, h = (unit >> 7) & 7, b = unit >> 10;
    const int t0 = c * CHUNK, lane = F.lane, w = F.wave, fr = lane & 15, fq = lane >> 4;
    LAS unsigned char* L = F.lds; asm volatile("" : "+v"(L));
    LAS bf16* qs = (LAS bf16*)(L + P2_QS); LAS bf16* ks = (LAS bf16*)(L + P2_KS);
    LAS bf16* kbgT = (LAS bf16*)(L + P2_KBGT); LAS bf16* vbT = (LAS bf16*)(L + P2_VBT);
    LAS float* Am = (LAS float*)(L + P2_AM); LAS bf16* Tb = (LAS bf16*)(L + P2_TB);
    LAS float* Gs = (LAS float*)(L + P2_G);
    const bf16* PROJ = WSP(bf16, WS_PROJ); const bf16* XNA = WSP(bf16, WS_XNA); const float* WAB = WSP(float, WS_WAB);
    const size_t rowb = (size_t)b * PT;
    float beta_r[8];
    {
        f32x4 wa[4], wb[4];
        const float* pa = WAB + (size_t)h * DM + 8 * lane; const float* pb = WAB + (size_t)(8 + h) * DM + 8 * lane;
        wa[0] = *(const f32x4*)pa; wa[1] = *(const f32x4*)(pa + 4); wa[2] = *(const f32x4*)(pa + 512); wa[3] = *(const f32x4*)(pa + 516);
        wb[0] = *(const f32x4*)pb; wb[1] = *(const f32x4*)(pb + 4); wb[2] = *(const f32x4*)(pb + 512); wb[3] = *(const f32x4*)(pb + 516);
        const float Aneg = -expf(FIN(10)[h]), dtb = FIN(11)[h];
#pragma unroll
        for (int tk = 0; tk < 8; ++tk) {
            const int tok = 8 * w + tk; const bf16* xr = XNA + (rowb + t0 + tok) * DM + 8 * lane;
            const v4u x0 = *(const v4u*)xr, x1 = *(const v4u*)(xr + 512);
            float sa = 0.f, sb = 0.f;
#define ACC2(xw, wv0, wv1, i0) { const float lo = bflo(xw), hi = bfhi(xw); sa += lo * wv0[i0] + hi * wv0[i0 + 1]; sb += lo * wv1[i0] + hi * wv1[i0 + 1]; }
            ACC2(x0.x, wa[0], wb[0], 0) ACC2(x0.y, wa[0], wb[0], 2) ACC2(x0.z, wa[1], wb[1], 0) ACC2(x0.w, wa[1], wb[1], 2)
            ACC2(x1.x, wa[2], wb[2], 0) ACC2(x1.y, wa[2], wb[2], 2) ACC2(x1.z, wa[3], wb[3], 0) ACC2(x1.w, wa[3], wb[3], 2)
#undef ACC2
            sa = wave_sum(sa); sb = wave_sum(sb);
            const float g = Aneg * softplus_f(sa + dtb), be = sigmoid_f(sb);
            beta_r[tk] = be;
            if (lane == 0) { Gs[tok] = g; Gs[64 + tok] = be; }
        }
    }
#pragma unroll
    for (int p = 0; p < 3; ++p) {
        const int col0 = p * 1024 + h * 128 + 2 * lane;
        float cw0[4], cw1[4];
#pragma unroll
        for (int i = 0; i < 4; ++i) { const f32x2 cv = *(const f32x2*)(FIN(9) + (size_t)i * GCONV + col0); cw0[i] = cv.x; cw1[i] = cv.y; }
        unsigned xw[11];
#pragma unroll
        for (int rr = 0; rr < 11; ++rr) { const int t = t0 + 8 * w - 3 + rr; xw[rr] = (t >= 0) ? *(const unsigned*)(PROJ + (rowb + t) * 4096 + col0) : 0u; }
        if (c == 127 && w == 7) {
#pragma unroll
            for (int r = 0; r < 3; ++r) { float* o = F.out + O_CONVP + ((size_t)b * 3 + r) * GCONV + col0; o[0] = bflo(xw[8 + r]); o[1] = bfhi(xw[8 + r]); }
        }
#pragma unroll
        for (int tk = 0; tk < 8; ++tk) {
            const int tok = 8 * w + tk;
            float y0 = 0.f, y1 = 0.f;
#pragma unroll
            for (int i = 0; i < 4; ++i) { y0 += cw0[i] * bflo(xw[tk + i]); y1 += cw1[i] * bfhi(xw[tk + i]); }
            y0 = silu_f(y0); y1 = silu_f(y1);
            if (p < 2) {
                const float ss = wave_sum(y0 * y0 + y1 * y1);
                const float rs = (frsq(ss + EPS)) * (p == 0 ? 0.08838834764831845f : 1.f);
                *(LAS unsigned*)((p == 0 ? qs : ks) + tok * QS_LD + 2 * lane) = pk2(y0 * rs, y1 * rs);
            } else {
                vbT[(2 * lane) * KT_LD + tok] = (bf16)f2bf(y0 * beta_r[tk]); vbT[(2 * lane + 1) * KT_LD + tok] = (bf16)f2bf(y1 * beta_r[tk]);
            }
        }
    }
    __syncthreads();
    if (w == 0) { float g = Gs[lane];
#pragma unroll
        for (int o = 1; o < 64; o <<= 1) { const float up = __shfl_up(g, o); if (lane >= o) g += up; }
        Gs[128 + lane] = g; }
    __syncthreads();
    const float glast = Gs[128 + 63];
    const size_t chunk = (size_t)unit;
    if (w < 4) {
        const int mt = w;
        bf16x8 a[4];
#pragma unroll
        for (int kk = 0; kk < 4; ++kk) a[kk] = ld8l(ks + (16 * mt + fr) * QS_LD + 32 * kk + 8 * fq);
#pragma unroll
        for (int nt = 0; nt < 4; ++nt) {
            f32x4 acc = {0.f, 0.f, 0.f, 0.f};
            if (nt <= mt) {
#pragma unroll
                for (int kk = 0; kk < 4; ++kk) acc = MFMA16(a[kk], ld8l(ks + (16 * nt + fr) * QS_LD + 32 * kk + 8 * fq), acc);
            }
            const int j = 16 * nt + fr; const float gj = Gs[128 + j];
#pragma unroll
            for (int r = 0; r < 4; ++r) { const int i = 16 * mt + 4 * fq + r;
                Am[i * AM_LD + j] = (i > j) ? Gs[64 + i] * acc[r] * __expf(Gs[128 + i] - gj) : 0.f; }
        }
    } else {
        const int nt = w - 4;
        bf16x8 bq[4];
#pragma unroll
        for (int kk = 0; kk < 4; ++kk) bq[kk] = ld8l(qs + (16 * nt + fr) * QS_LD + 32 * kk + 8 * fq);
        const int i = 16 * nt + fr; const float gi = Gs[128 + i];
        bf16* gqk = WSP(bf16, WS_GQK) + chunk * 4096;
#pragma unroll
        for (int mt = 0; mt < 4; ++mt) {
            f32x4 acc = {0.f, 0.f, 0.f, 0.f};
            if (mt <= nt) {
#pragma unroll
                for (int kk = 0; kk < 4; ++kk) acc = MFMA16(ld8l(ks + (16 * mt + fr) * QS_LD + 32 * kk + 8 * fq), bq[kk], acc);
            }
            float v[4];
#pragma unroll
            for (int r = 0; r < 4; ++r) { const int j = 16 * mt + 4 * fq + r; v[r] = (i >= j) ? acc[r] * __expf(gi - Gs[128 + j]) : 0.f; }
            v2u o; o.x = pk2(v[0], v[1]); o.y = pk2(v[2], v[3]);
            *(v2u*)(gqk + (((nt * 2 + (mt >> 1)) * 64 + (2 * (mt & 1) + (fq >> 1)) * 16 + fr) * 8 + 4 * (fq & 1))) = o;
        }
    }
    {
        const int tok = F.tid >> 3, d0 = (F.tid & 7) * 16; const float e = __expf(Gs[128 + tok]);
        bf16* gq = WSP(bf16, WS_GQ) + chunk * 8192;
#pragma unroll
        for (int hh = 0; hh < 2; ++hh) { const v4u q = *(const LAS v4u*)(qs + tok * QS_LD + d0 + 8 * hh); v4u o;
            o.x = pk2(bflo(q.x) * e, bfhi(q.x) * e); o.y = pk2(bflo(q.y) * e, bfhi(q.y) * e); o.z = pk2(bflo(q.z) * e, bfhi(q.z) * e); o.w = pk2(bflo(q.w) * e, bfhi(q.w) * e);
            *(v4u*)(gq + ((((tok >> 4) * 4 + ((F.tid & 7) >> 1)) * 64 + (2 * (F.tid & 1) + hh) * 16 + (tok & 15)) * 8)) = o; }
    }
    {
        const int dk = F.tid & 127, tg = F.tid >> 7;
        unsigned o1[8], o2[8];
#pragma unroll
        for (int i = 0; i < 8; ++i) {
            const int ta = 16 * tg + 2 * i, tb2 = ta + 1;
            const float ka = bf2f(ks[ta * QS_LD + dk]), kb = bf2f(ks[tb2 * QS_LD + dk]);
            const float ga = Gs[128 + ta], gb = Gs[128 + tb2];
            o1[i] = pk2(ka * Gs[64 + ta] * __expf(ga), kb * Gs[64 + tb2] * __expf(gb));
            o2[i] = pk2(ka * __expf(glast - ga), kb * __expf(glast - gb));
        }
        LAS v4u* d1 = (LAS v4u*)(kbgT + dk * KT_LD + 16 * tg); d1[0] = (v4u){o1[0], o1[1], o1[2], o1[3]}; d1[1] = (v4u){o1[4], o1[5], o1[6], o1[7]};
        bf16* d2 = WSP(bf16, WS_GKT) + chunk * 8192 + ((((dk >> 4) * 2 + (tg >> 1)) * 64 + (2 * (tg & 1)) * 16 + (dk & 15)) * 8);
        *(v4u*)d2 = (v4u){o2[0], o2[1], o2[2], o2[3]}; *(v4u*)(d2 + 16 * 8) = (v4u){o2[4], o2[5], o2[6], o2[7]};
    }
    if (F.tid == 0) WSP(float, WS_GDEC)[chunk] = __expf(glast);
    __syncthreads();
    LAS float* Tf = (LAS float*)(L + P2_TF); LAS float* Xf = (LAS float*)(L + P2_XF);
    if (w == 0) {
        const int blk = lane >> 5, cc = lane & 31; const LAS float* Ab = Am + (32 * blk) * AM_LD + 32 * blk;
        float t[32];
#pragma unroll
        for (int i = 0; i < 32; ++i) {
            float acc0 = (i == cc) ? 1.f : 0.f, acc1 = 0.f, acc2 = 0.f, acc3 = 0.f;
#pragma unroll
            for (int j4 = 0; j4 < (i + 3) / 4; ++j4) {
                const f32x4 a = *(const LAS f32x4*)(Ab + i * AM_LD + 4 * j4);
                if (4 * j4 + 0 < i) acc0 = __builtin_fmaf(-a.x, t[4 * j4 + 0], acc0);
                if (4 * j4 + 1 < i) acc1 = __builtin_fmaf(-a.y, t[4 * j4 + 1], acc1);
                if (4 * j4 + 2 < i) acc2 = __builtin_fmaf(-a.z, t[4 * j4 + 2], acc2);
                if (4 * j4 + 3 < i) acc3 = __builtin_fmaf(-a.w, t[4 * j4 + 3], acc3);
            }
            t[i] = (acc0 + acc1) + (acc2 + acc3);
            asm volatile("" : "+v"(t[i]));
            __builtin_amdgcn_sched_barrier(0);
        }
#pragma unroll
        for (int i = 0; i < 32; ++i) { Tf[(32 * blk + i) * AM_LD + 32 * blk + cc] = t[i]; if (blk == 0) Tf[i * AM_LD + 32 + cc] = 0.f; }
    }
    __syncthreads();
    {
        const int i = F.tid >> 4, c0 = (F.tid & 15) * 2; float x0 = 0.f, x1 = 0.f;
#pragma unroll 8
        for (int k = 0; k < 32; ++k) { const float a = Am[(32 + i) * AM_LD + k]; x0 = __builtin_fmaf(a, Tf[k * AM_LD + c0], x0); x1 = __builtin_fmaf(a, Tf[k * AM_LD + c0 + 1], x1); }
        Xf[i * 34 + c0] = x0; Xf[i * 34 + c0 + 1] = x1;
    }
    __syncthreads();
    {
        const int i = F.tid >> 4, c0 = (F.tid & 15) * 2; float x0 = 0.f, x1 = 0.f;
#pragma unroll 8
        for (int k = 0; k < 32; ++k) { const float a = Tf[(32 + i) * AM_LD + 32 + k]; x0 = __builtin_fmaf(a, Xf[k * 34 + c0], x0); x1 = __builtin_fmaf(a, Xf[k * 34 + c0 + 1], x1); }
        Tf[(32 + i) * AM_LD + c0] = -x0; Tf[(32 + i) * AM_LD + c0 + 1] = -x1;
    }
    __syncthreads();
    {
        const int i = F.tid >> 3, c0 = (F.tid & 7) * 8; const f32x4 a = *(const LAS f32x4*)(Tf + i * AM_LD + c0), b2 = *(const LAS f32x4*)(Tf + i * AM_LD + c0 + 4);
        *(LAS v4u*)(Tb + i * TB_LD + c0) = (v4u){pk2(a.x, a.y), pk2(a.z, a.w), pk2(b2.x, b2.y), pk2(b2.z, b2.w)};
    }
    __syncthreads();
    {
        bf16x8 tb[4][2];
#pragma unroll
        for (int x = 0; x < 4; ++x)
#pragma unroll
            for (int s = 0; s < 2; ++s) tb[x][s] = ld8l(Tb + (16 * x + fr) * TB_LD + 32 * s + 8 * fq);
        const bf16x8 bv0 = ld8l(vbT + (16 * w + fr) * KT_LD + 8 * fq), bv1 = ld8l(vbT + (16 * w + fr) * KT_LD + 32 + 8 * fq);
        bf16* gu = WSP(bf16, WS_GU) + chunk * 8192 + ((size_t)((w >> 1) * 4 * 64 + lane) * 2 + (w & 1)) * 4;
#pragma unroll
        for (int mt = 0; mt < 4; ++mt) { f32x4 acc = {0.f, 0.f, 0.f, 0.f}; acc = MFMA16(tb[mt][0], bv0, acc); acc = MFMA16(tb[mt][1], bv1, acc); *(v2u*)(gu + mt * 64 * 8) = (v2u){pk2(acc[0], acc[1]), pk2(acc[2], acc[3])}; }
        const bf16x8 ak0 = ld8l(kbgT + (16 * w + fr) * KT_LD + 8 * fq), ak1 = ld8l(kbgT + (16 * w + fr) * KT_LD + 32 + 8 * fq);
        bf16* gw = WSP(bf16, WS_GW) + chunk * 8192;
#pragma unroll
        for (int nt = 0; nt < 4; ++nt) { f32x4 acc = {0.f, 0.f, 0.f, 0.f}; acc = MFMA16(ak0, tb[nt][0], acc); acc = MFMA16(ak1, tb[nt][1], acc);
            v2u o; o.x = pk2(acc[0], acc[1]); o.y = pk2(acc[2], acc[3]);
            *(v2u*)(gw + (((nt * 4 + (w >> 1)) * 64 + (2 * (w & 1) + (fq >> 1)) * 16 + fr) * 8 + 4 * (fq & 1))) = o; }
    }
    __syncthreads();
}

constexpr int S2_Y = 0;
constexpr int S2_AB = 6144;
constexpr int S2_DOT = 6400;
constexpr int S2_U = 6656;
constexpr int S2_W = 8704;
constexpr int S2_VN = 10752;
__device__ __forceinline__ void p2_sample(Frame& F, int unit) {
    const int h = unit & 7, bs = unit >> 3, tid = F.tid, lane = F.lane, w = F.wave;
    LAS unsigned char* L = F.lds; asm volatile("" : "+v"(L));
    LAS float* Y = (LAS float*)(L + S2_Y); LAS float* AB = (LAS float*)(L + S2_AB); LAS float* DOT = (LAS float*)(L + S2_DOT);
    LAS float* U = (LAS float*)(L + S2_U); LAS float* W = (LAS float*)(L + S2_W); LAS float* VN = (LAS float*)(L + S2_VN);
    const bf16* PROJ = WSP(bf16, WS_PROJ); const bf16* XNA = WSP(bf16, WS_XNA); const float* WAB = WSP(float, WS_WAB);
    const size_t row0 = (size_t)MP + bs * 4;
    if (tid < 384) {
        const int part = tid >> 7, cc = tid & 127, col = part * 1024 + h * 128 + cc;
        float buf[7];
#pragma unroll
        for (int r = 0; r < 3; ++r) buf[r] = FIN(5)[((size_t)bs * 3 + r) * GCONV + col];
#pragma unroll
        for (int i = 0; i < 4; ++i) buf[3 + i] = bf2f(PROJ[(row0 + i) * 4096 + col]);
#pragma unroll
        for (int r = 0; r < 3; ++r) F.out[O_CONVS + ((size_t)bs * 3 + r) * GCONV + col] = buf[4 + r];
        float cw[4];
#pragma unroll
        for (int i = 0; i < 4; ++i) cw[i] = FIN(9)[(size_t)i * GCONV + col];
#pragma unroll
        for (int i = 0; i < 4; ++i) { float y = 0.f;
#pragma unroll
            for (int k = 0; k < 4; ++k) y += cw[k] * buf[i + k];
            Y[(part * 4 + i) * 128 + cc] = silu_f(y); }
    }
    {
        const int i = w >> 1, which = w & 1; const bf16* xr = XNA + (row0 + i) * DM; const float* wr = WAB + (size_t)(which * 8 + h) * DM; float s = 0.f;
        for (int k = lane; k < DM; k += 64) s += bf2f(xr[k]) * wr[k];
        s = wave_sum(s); if (lane == 0) AB[which * 4 + i] = s;
    }
    __syncthreads();
    {
        const int part = w >> 2, i = w & 3; LAS float* y = Y + (part * 4 + i) * 128; const float a = y[lane], bq = y[64 + lane];
        const float ss = wave_sum(a * a + bq * bq); const float rs = (frsq(ss + EPS)) * (part == 0 ? 0.08838834764831845f : 1.f);
        y[lane] = a * rs; y[64 + lane] = bq * rs;
    }
    if (tid == 0) { const float Aneg = -expf(FIN(10)[h]), dtb = FIN(11)[h]; float gc = 0.f;
        for (int i = 0; i < 4; ++i) { const float g = Aneg * softplus_f(AB[i] + dtb); gc += g; AB[8 + i] = g; AB[12 + i] = 1.f / (1.f + expf(-AB[4 + i])); AB[16 + i] = gc; } }
    __syncthreads();
    {
#pragma unroll
        for (int pp = 0; pp < 4; ++pp) { const int pr = 4 * w + pp, which = pr >> 4, i = (pr >> 2) & 3, j = pr & 3;
            const LAS float* x = Y + ((which == 0 ? 1 : 0) * 4 + i) * 128; const LAS float* y = Y + (1 * 4 + j) * 128;
            float s = x[lane] * y[lane] + x[64 + lane] * y[64 + lane]; s = wave_sum(s); if (lane == 0) DOT[pr] = s; }
    }
    __syncthreads();
    float g_[4], be[4], gc[4];
#pragma unroll
    for (int i = 0; i < 4; ++i) { g_[i] = AB[8 + i]; be[i] = AB[12 + i]; gc[i] = AB[16 + i]; }
    float Tm[4][4];
    {
        float A[4][4];
#pragma unroll
        for (int i = 0; i < 4; ++i)
#pragma unroll
            for (int j = 0; j < 4; ++j) A[i][j] = (i > j) ? be[i] * DOT[i * 4 + j] * expf(gc[i] - gc[j]) : 0.f;
#pragma unroll
        for (int cc = 0; cc < 4; ++cc)
#pragma unroll
            for (int i = 0; i < 4; ++i) { float acc = (i == cc) ? 1.f : 0.f;
#pragma unroll
                for (int j = 0; j < 4; ++j) if (j < i) acc -= A[i][j] * Tm[j][cc];
                Tm[i][cc] = acc; }
    }
    {
        const int i = tid >> 7, x = tid & 127; float su = 0.f, sw = 0.f;
#pragma unroll
        for (int j = 0; j < 4; ++j) { su += Tm[i][j] * Y[(2 * 4 + j) * 128 + x] * be[j]; sw += Tm[i][j] * Y[(1 * 4 + j) * 128 + x] * be[j] * expf(gc[j]); }
        U[i * 128 + x] = su; W[i * 128 + x] = sw;
    }
    __syncthreads();
    const float* S0 = FIN(4) + ((size_t)bs * GH + h) * 128 * 128;
    float qs_acc;
    {
        const int i = tid >> 7, dv = tid & 127; float p = 0.f, qq = 0.f;
        const LAS float* wr = W + i * 128; const LAS float* qr = Y + (0 * 4 + i) * 128;
#pragma unroll 16
        for (int dk = 0; dk < 128; ++dk) { const float s = S0[(size_t)dk * 128 + dv]; p += wr[dk] * s; qq += qr[dk] * s; }
        VN[i * 128 + dv] = U[i * 128 + dv] - p; qs_acc = qq * expf(gc[i]);
    }
    __syncthreads();
    {
        const int i = tid >> 7, dv = tid & 127; float o = qs_acc;
#pragma unroll
        for (int j = 0; j < 4; ++j) if (j <= i) o += DOT[16 + i * 4 + j] * expf(gc[i] - gc[j]) * VN[j * 128 + dv];
        WSP(bf16, WS_OGDN)[(row0 + i) * DM + h * 128 + dv] = (bf16)f2bf(o);
    }
    {
        const int dv = tid & 127, dg = tid >> 7; const float el = expf(gc[3]);
        float kd[4], vn[4];
#pragma unroll
        for (int j = 0; j < 4; ++j) { kd[j] = expf(gc[3] - gc[j]); vn[j] = VN[j * 128 + dv]; }
        float* So = F.out + O_GDNS + ((size_t)bs * GH + h) * 128 * 128;
#pragma unroll 8
        for (int dk = dg * 32; dk < dg * 32 + 32; ++dk) { float s = S0[(size_t)dk * 128 + dv] * el;
#pragma unroll
            for (int j = 0; j < 4; ++j) s += Y[(1 * 4 + j) * 128 + dk] * kd[j] * vn[j];
            So[(size_t)dk * 128 + dv] = s; }
    }
    (void)g_;
    __syncthreads();
}

constexpr int P3_S = 0;
constexpr int P3_VN = 16384;
__device__ __forceinline__ void p3_scan(Frame& F, int bh, int s) {
    const int lane = F.lane, w = F.wave, fr = lane & 15, fq = lane >> 4;
    const int b = bh >> 3, h = bh & 7;
    LAS bf16* Sl = (LAS bf16*)(F.lds + P3_S); LAS bf16* Vl = (LAS bf16*)(F.lds + P3_VN);
    const bf16* GW = WSP(bf16, WS_GW); const bf16* GQ = WSP(bf16, WS_GQ); const bf16* GKT = WSP(bf16, WS_GKT); const bf16* GQK = WSP(bf16, WS_GQK);
    const bf16* GU = WSP(bf16, WS_GU); const float* GDEC = WSP(float, WS_GDEC);
    bf16* OG = WSP(bf16, WS_OGDN);
    f32x4 Sacc[2];
#pragma unroll
    for (int n = 0; n < 2; ++n) { Sacc[n] = (f32x4){0.f, 0.f, 0.f, 0.f}; v2u z = {0u, 0u}; *(LAS v2u*)(Sl + (n * 16 + fr) * 136 + 16 * w + 4 * fq) = z; }
    __syncthreads();
    const int m = w & 3;
    struct P3Ops { bf16x8 a1[4], ak0, ak1; v4u x0, x1; float dec; };
    P3Ops R0, R1, R2;
#define P3_FETCH(R, cc) do { const size_t ch_ = (size_t)bh * NCH + (cc); \
        const bf16* p1_ = (w < 4 ? GW : GQ) + ch_ * 8192 + (size_t)(m * 4 * 64 + lane) * 8;        \
        _Pragma("unroll") for (int k_ = 0; k_ < 4; ++k_) R.a1[k_] = ld8(p1_ + 512 * k_); \
        const bf16* pk_ = GKT + ch_ * 8192 + (size_t)(w * 2 * 64 + lane) * 8; R.ak0 = ld8(pk_); R.ak1 = ld8(pk_ + 512); \
        const unsigned char* px_ = w < 4 ? (const unsigned char*)(GU + ch_ * 8192 + ((size_t)(s * 4 + m) * 64 + lane) * 8) : (const unsigned char*)(GQK + ch_ * 4096 + (size_t)(m * 2 * 64 + lane) * 8); \
        R.x0 = *(const v4u*)px_; R.x1 = *(const v4u*)(px_ + (w < 4 ? 0 : 1024));        \
        R.dec = GDEC[ch_]; } while (0)
#define P3_STEP(R, c) do { \
        f32x4 acc[2]; \
        _Pragma("unroll") for (int n = 0; n < 2; ++n) { acc[n] = (f32x4){0.f, 0.f, 0.f, 0.f}; \
            _Pragma("unroll") for (int k = 0; k < 4; ++k) acc[n] = MFMA16(R.a1[k], ld8l(Sl + (n * 16 + fr) * 136 + 32 * k + 8 * fq), acc[n]); } \
        if (w < 4) { _Pragma("unroll") for (int n = 0; n < 2; ++n) { const unsigned ua_ = n == 0 ? R.x0.x : R.x0.z, ub_ = n == 0 ? R.x0.y : R.x0.w; const f32x4 vn = (f32x4){bflo(ua_), bfhi(ua_), bflo(ub_), bfhi(ub_)} - acc[n]; v2u o; o.x = pk2(vn[0], vn[1]); o.y = pk2(vn[2], vn[3]); \
            *(LAS v2u*)(Vl + (n * 16 + fr) * 72 + 16 * m + 4 * fq) = o; } } \
        asm volatile("s_waitcnt lgkmcnt(0)\n\ts_barrier" ::: "memory"); \
        bf16x8 v0[2], v1[2]; \
        _Pragma("unroll") for (int n = 0; n < 2; ++n) { v0[n] = ld8l(Vl + (n * 16 + fr) * 72 + 8 * fq); v1[n] = ld8l(Vl + (n * 16 + fr) * 72 + 32 + 8 * fq); } \
        if (w >= 4) { _Pragma("unroll") for (int n = 0; n < 2; ++n) { acc[n] = MFMA16(__builtin_bit_cast(bf16x8, R.x0), v0[n], acc[n]); acc[n] = MFMA16(__builtin_bit_cast(bf16x8, R.x1), v1[n], acc[n]); \
            bf16* o = OG + ((size_t)b * PT + (c) * CHUNK + 16 * m + 4 * fq) * DM + h * 128 + 32 * s + 16 * n + fr; \
            _Pragma("unroll") for (int r = 0; r < 4; ++r) o[(size_t)r * DM] = (bf16)f2bf(acc[n][r]); } } \
        { float d_ = R.dec;        \
          _Pragma("unroll") for (int n = 0; n < 2; ++n) asm volatile("v_mul_f32 %0, %0, %4\n\tv_mul_f32 %1, %1, %4\n\tv_mul_f32 %2, %2, %4\n\tv_mul_f32 %3, %3, %4" : "+v"(Sacc[n][0]), "+v"(Sacc[n][1]), "+v"(Sacc[n][2]), "+v"(Sacc[n][3]) : "v"(d_)); } \
        _Pragma("unroll") for (int n = 0; n < 2; ++n) { Sacc[n] = MFMA16(R.ak0, v0[n], Sacc[n]); Sacc[n] = MFMA16(R.ak1, v1[n], Sacc[n]); \
            v2u o; o.x = pk2(Sacc[n][0], Sacc[n][1]); o.y = pk2(Sacc[n][2], Sacc[n][3]); *(LAS v2u*)(Sl + (n * 16 + fr) * 136 + 16 * w + 4 * fq) = o; } \
        asm volatile("s_waitcnt lgkmcnt(0)\n\ts_barrier" ::: "memory"); } while (0)
    P3_FETCH(R0, 0); __builtin_amdgcn_sched_barrier(0); P3_FETCH(R1, 1); __builtin_amdgcn_sched_barrier(0); P3_FETCH(R2, 2); __builtin_amdgcn_sched_barrier(0);
    static_assert(NCH % 3 == 2, "ring schedule below assumes NCH = 3k + 2");
#pragma unroll 1
    for (int c = 0; c + 3 <= NCH; c += 3) {
        P3_STEP(R0, c);     P3_FETCH(R0, (c + 3 < NCH ? c + 3 : NCH - 1));
        P3_STEP(R1, c + 1); P3_FETCH(R1, (c + 4 < NCH ? c + 4 : NCH - 1));
        P3_STEP(R2, c + 2); P3_FETCH(R2, (c + 5 < NCH ? c + 5 : NCH - 1));
    }
    P3_STEP(R0, NCH - 2); P3_STEP(R1, NCH - 1);
#undef P3_FETCH
#undef P3_STEP
    float* So = F.out + O_GDNP + ((size_t)bh * 128) * 128;
#pragma unroll
    for (int n = 0; n < 2; ++n)
#pragma unroll
        for (int r = 0; r < 4; ++r) So[(size_t)(16 * w + 4 * fq + r) * 128 + 32 * s + 16 * n + fr] = Sacc[n][r];
}

__device__ __forceinline__ void p4_rows(Frame& F, int first, int stride) {
    const int lane = F.lane;
    if (first >= MTOK) return;
    float gn[16];
    { const f32x4* gp = (const f32x4*)(FIN(12) + (16 * lane & 127));
#pragma unroll
      for (int j = 0; j < 4; ++j) { const f32x4 g4 = gp[j]; gn[4 * j] = g4.x; gn[4 * j + 1] = g4.y; gn[4 * j + 2] = g4.z; gn[4 * j + 3] = g4.w; } }
    v4u no0, no1, nz0, nz1;
#define P4_FETCH(rw) do { const bf16* o_ = WSP(bf16, WS_OGDN) + (size_t)(rw) * DM + 16 * lane; const bf16* z_ = WSP(bf16, WS_PROJ) + (size_t)(rw) * 4096 + 3072 + 16 * lane; \
        no0 = *(const v4u*)o_; no1 = *(const v4u*)(o_ + 8); nz0 = *(const v4u*)z_; nz1 = *(const v4u*)(z_ + 8); } while (0)
    P4_FETCH(first);
#pragma unroll 1
    for (int row = first; row < MTOK; row += stride) {
        f32x4 v[4]; const v4u z0 = nz0, z1 = nz1; float ss = 0.f;
#pragma unroll
        for (int j = 0; j < 4; ++j) { const unsigned wa = j < 2 ? (j == 0 ? no0.x : no0.z) : (j == 2 ? no1.x : no1.z), wb = j < 2 ? (j == 0 ? no0.y : no0.w) : (j == 2 ? no1.y : no1.w);
            v[j] = (f32x4){bflo(wa), bfhi(wa), bflo(wb), bfhi(wb)}; ss += (v[j].x * v[j].x + v[j].y * v[j].y) + (v[j].z * v[j].z + v[j].w * v[j].w); }
        { const int nr = row + stride < MTOK ? row + stride : row; P4_FETCH(nr); }
        ss += dpp_f<DPP_XOR1>(ss); ss += dpp_f<DPP_XOR2>(ss); ss += dpp_f<DPP_HMIR>(ss);
        const float rstd = frsq(ss * (1.f / 128.f) + EPS);
        float zz[16] = {bflo(z0.x), bfhi(z0.x), bflo(z0.y), bfhi(z0.y), bflo(z0.z), bfhi(z0.z), bflo(z0.w), bfhi(z0.w),
                        bflo(z1.x), bfhi(z1.x), bflo(z1.y), bfhi(z1.y), bflo(z1.z), bfhi(z1.z), bflo(z1.w), bfhi(z1.w)};
        unsigned ow[8];
#pragma unroll
        for (int j = 0; j < 8; ++j) { const float a = v[j >> 1][(2 * j) & 3] * rstd * gn[2 * j] * silu_f(zz[2 * j]), bq = v[j >> 1][(2 * j + 1) & 3] * rstd * gn[2 * j + 1] * silu_f(zz[2 * j + 1]); ow[j] = pk2(a, bq); }
        v4u* dst = (v4u*)(WSP(bf16, WS_OG) + (size_t)row * DM + 16 * lane);
        dst[0] = (v4u){ow[0], ow[1], ow[2], ow[3]}; dst[1] = (v4u){ow[4], ow[5], ow[6], ow[7]};
    }
#undef P4_FETCH
}

typedef __bf16 bf16x2_t __attribute__((ext_vector_type(2)));
__device__ __forceinline__ float dot2_bf16(unsigned w, unsigned x, float acc) { return __builtin_amdgcn_fdot2_f32_bf16(__builtin_bit_cast(bf16x2_t, w), __builtin_bit_cast(bf16x2_t, x), acc, false); }
__device__ __forceinline__ float u2f(unsigned u) { return __builtin_bit_cast(float, u); }
__device__ __forceinline__ unsigned f2u(float f) { return __builtin_bit_cast(unsigned, f); }

constexpr int P8_MAXU = 4;
constexpr int P8_WAVE = P8_MAXU * 2048 + 1024;
constexpr int P8_TOP = 0;
constexpr int P8_TAB = 8 * P8_WAVE;
__device__ __forceinline__ void p8_init_tab(Frame& F) {
    LAS unsigned char* tab = F.lds + P8_TAB;
    if (F.tid < 64) { const int k = F.tid; int i = 0, j = 0;
        if (k < 16) { i = 0; j = k; } else if (k < 24) { i = 1; j = k - 16; } else if (k < 29) { i = 2; j = k - 24; } else if (k < 33) { i = 3; j = k - 29; }
        else if (k < 36) { i = 4; j = k - 33; } else if (k < 38) { i = 5; j = k - 36; } else if (k < 40) { i = 6; j = k - 38; } else if (k < 42) { i = 7; j = k - 40; } else if (k < 50) { i = k - 34; j = 0; }
        tab[k] = (unsigned char)i; tab[64 + k] = (unsigned char)j; }
    __syncthreads();
}
__device__ __forceinline__ int fkey(float x) { const int b = __builtin_bit_cast(int, x); return b ^ ((b >> 31) & 0x7fffffff); }
__device__ __forceinline__ float fkey_inv(int k) { return __builtin_bit_cast(float, k ^ ((k >> 31) & 0x7fffffff)); }
template <int CTRL> __device__ __forceinline__ int dpp_i(int x) { return __builtin_amdgcn_update_dpp(0, x, CTRL, 0xF, 0xF, true); }
__device__ __forceinline__ int imax(int a, int b) { return a > b ? a : b; }
__device__ __forceinline__ int imin(int a, int b) { return a < b ? a : b; }
__device__ __forceinline__ int row_imax16(int x) {
    x = imax(x, dpp_i<0xB1>(x)); x = imax(x, dpp_i<0x4E>(x)); x = imax(x, dpp_i<0x141>(x)); x = imax(x, dpp_i<0x140>(x)); return x;
}
#define ICSWAP(a, b) { const int hi_ = imax(a, b), lo_ = imin(a, b); a = hi_; b = lo_; }
constexpr int IKEY_MIN = (int)0x80000000;
template <int NR>
__device__ __forceinline__ void p8_run(Frame& F, int layer, int w, int rq, int u0, int ustride, int nu) {
    int lane_ = F.lane; asm volatile("" : "+v"(lane_));
    const int lane = lane_, fr = lane & 15, fq = lane >> 4;
    LAS unsigned char* L = F.lds; asm volatile("" : "+v"(L));
    LAS int* toplw = (LAS int*)(L + P8_TOP + F.wave * P8_WAVE);
    LAS float* wins = (LAS float*)(L + P8_TOP + F.wave * P8_WAVE + P8_MAXU * 2048);
    const LAS unsigned char* tab = L + P8_TAB;
    const bf16* Qb = WSP(bf16, WS_QPEER) + (size_t)fr * 2048 + w * 256 + 8 * fq;
    const bf16* SK = WSP(bf16, WS_SUBK) + (size_t)((layer * 8 + w) * 2) * 16384 + (size_t)fr * 128 + 8 * fq;
#pragma unroll 1
    for (int p = 0; p < 2; ++p) {
        bf16x8 bk[32], aq[4];
#pragma unroll
        for (int i = 0; i < 32; ++i) bk[i] = ld8(SK + (size_t)p * 16384 + (size_t)(i >> 2) * 2048 + 32 * (i & 3));
#pragma unroll
        for (int ks = 0; ks < 4; ++ks) aq[ks] = ld8(Qb + (size_t)u0 * 16 * 2048 + p * 128 + 32 * ks);
#pragma unroll 1
        for (int k = 0; k < nu; ++k) {
            LAS int* topl = toplw + k * 512;
            int s[NR][8];
#pragma unroll
            for (int nt = 0; nt < 8; ++nt) { f32x4 acc = {0.f, 0.f, 0.f, 0.f};
#pragma unroll
                for (int ks = 0; ks < 4; ++ks) acc = MFMA16(aq[ks], bk[nt * 4 + ks], acc);
                if (NR == 4) {
#pragma unroll
                    for (int r = 0; r < NR; ++r) s[r][nt] = fkey(u2f((f2u(acc[r]) & ~127u) | (unsigned)(16 * nt + fr)));
                } else { const float av = rq == 0 ? acc[0] : rq == 1 ? acc[1] : rq == 2 ? acc[2] : acc[3]; s[0][nt] = fkey(u2f((f2u(av) & ~127u) | (unsigned)(16 * nt + fr))); } }
            { const int un = u0 + (k + 1 < nu ? k + 1 : k) * ustride;
#pragma unroll
              for (int ks = 0; ks < 4; ++ks) aq[ks] = ld8(Qb + (size_t)un * 16 * 2048 + p * 128 + 32 * ks); }
#pragma unroll
            for (int r = 0; r < NR; ++r) {
                ICSWAP(s[r][0], s[r][1]) ICSWAP(s[r][2], s[r][3]) ICSWAP(s[r][4], s[r][5]) ICSWAP(s[r][6], s[r][7])
                ICSWAP(s[r][0], s[r][2]) ICSWAP(s[r][1], s[r][3]) ICSWAP(s[r][4], s[r][6]) ICSWAP(s[r][5], s[r][7])
                ICSWAP(s[r][1], s[r][2]) ICSWAP(s[r][5], s[r][6]) ICSWAP(s[r][0], s[r][4]) ICSWAP(s[r][3], s[r][7])
                ICSWAP(s[r][1], s[r][5]) ICSWAP(s[r][2], s[r][6]) ICSWAP(s[r][1], s[r][4]) ICSWAP(s[r][3], s[r][6])
                ICSWAP(s[r][2], s[r][4]) ICSWAP(s[r][3], s[r][5]) ICSWAP(s[r][3], s[r][4]) }
            int mine[NR];
#pragma unroll
            for (int r = 0; r < NR; ++r) mine[r] = IKEY_MIN;
#pragma unroll 1
            for (int rd = 0; rd < 16; ++rd) {
                const bool me = fr == rd;
#pragma unroll
                for (int r = 0; r < NR; ++r) {
                    const int mx = row_imax16(s[r][0]);
                    const bool pop = s[r][0] == mx;
#pragma unroll
                    for (int i = 0; i < 7; ++i) s[r][i] = pop ? s[r][i + 1] : s[r][i];
                    s[r][7] = pop ? IKEY_MIN : s[r][7];
                    mine[r] = me ? mx : mine[r];
                }
            }
#pragma unroll
            for (int r = 0; r < NR; ++r) topl[((4 * fq + (NR == 4 ? r : rq)) * 2 + p) * 16 + fr] = mine[r];
        }
    }
    LDS_WAIT();
#pragma unroll 1
    for (int k = 0; k < nu; ++k) {
    LAS int* topl = toplw + k * 512;
    const int r0 = (u0 + k * ustride) * 16;
    int c[NR][4];
#pragma unroll
    for (int r = 0; r < NR; ++r) { const int tk = 4 * fq + (NR == 4 ? r : rq);
#pragma unroll
        for (int m = 0; m < 4; ++m) { const int kc = fr + 16 * m; int cv = IKEY_MIN;
            if (kc < 50) { const int i = tab[kc], j = tab[64 + kc]; const float s1 = u2f(f2u(fkey_inv(topl[(tk * 2 + 0) * 16 + i])) & ~127u), s2 = u2f(f2u(fkey_inv(topl[(tk * 2 + 1) * 16 + j])) & ~127u);
                cv = fkey(u2f((f2u(s1 + s2) & ~63u) | (unsigned)kc)); }
            c[r][m] = cv; }
        ICSWAP(c[r][0], c[r][1]) ICSWAP(c[r][2], c[r][3]) ICSWAP(c[r][0], c[r][2]) ICSWAP(c[r][1], c[r][3]) ICSWAP(c[r][1], c[r][2]) }
    int minec[NR];
#pragma unroll
    for (int r = 0; r < NR; ++r) minec[r] = IKEY_MIN;
#pragma unroll 1
    for (int rd = 0; rd < 16; ++rd) {
        const bool me = fr == rd;
#pragma unroll
        for (int r = 0; r < NR; ++r) {
            const int mx = row_imax16(c[r][0]);
            const bool pop = c[r][0] == mx;
            c[r][0] = pop ? c[r][1] : c[r][0]; c[r][1] = pop ? c[r][2] : c[r][1]; c[r][2] = pop ? c[r][3] : c[r][2]; c[r][3] = pop ? IKEY_MIN : c[r][3];
            minec[r] = me ? mx : minec[r];
        }
    }
#pragma unroll
    for (int r = 0; r < NR; ++r) wins[(4 * fq + (NR == 4 ? r : rq)) * 16 + fr] = fkey_inv(minec[r]);
    LDS_WAIT();
    if (NR == 4 || (fr >> 2) == rq) {
        const int tk = 4 * fq + (fr >> 2), q4 = fr & 3;
        const float w0 = wins[tk * 16]; float den = 0.f;
#pragma unroll
        for (int rd = 0; rd < 16; ++rd) den += __expf(wins[tk * 16 + rd] - w0);
        const float inv = 1.f / den;
        int e[4]; float g[4];
#pragma unroll
        for (int x = 0; x < 4; ++x) { const float wv = wins[tk * 16 + 4 * q4 + x]; const int kc = (int)(f2u(wv) & 63u); const int i = tab[kc], j = tab[64 + kc];
            e[x] = (int)(f2u(fkey_inv(topl[(tk * 2 + 0) * 16 + i])) & 127u) * 128 + (int)(f2u(fkey_inv(topl[(tk * 2 + 1) * 16 + j])) & 127u); g[x] = __expf(wv - w0) * inv; }
        unsigned short* pei = WSP(unsigned short, WS_PEI) + (size_t)(r0 + tk) * 128 + w * 16 + 4 * q4; float* peg = WSP(float, WS_PEG) + (size_t)(r0 + tk) * 128 + w * 16 + 4 * q4;
        *(v2u*)pei = (v2u){(unsigned)e[0] | ((unsigned)e[1] << 16), (unsigned)e[2] | ((unsigned)e[3] << 16)};
        *(f32x4*)peg = (f32x4){g[0], g[1], g[2], g[3]};
    }
    LDS_WAIT();
    }
}
__device__ __forceinline__ void p8_phase(Frame& F, int layer) {
    p8_init_tab(F);
    for (int ub = F.bid; ub < MP / 16; ub += F.G * P8_MAXU) { const int left = (MP / 16 - ub + F.G - 1) / F.G; p8_run<4>(F, layer, F.wave, 0, ub, F.G, left < P8_MAXU ? left : P8_MAXU); }
    for (int qu = F.bid * 8 + F.wave; qu < (MS / 16) * 8 * 4 * 8; qu += F.G * 8) { if ((qu & 7) == 0) { const int x = qu >> 3; p8_run<1>(F, layer, (x >> 2) & 7, x & 3, MP / 16 + (x >> 5), 0, 1); } }
}

constexpr size_t PE_SLICE_BYTES = (size_t)NEXP * 128;
__device__ __forceinline__ f32x2 p9_cvt(unsigned w, bool hi) { return hi ? __builtin_amdgcn_cvt_pk_f32_fp8((int)w, true) : __builtin_amdgcn_cvt_pk_f32_fp8((int)w, false); }
__device__ __forceinline__ f32x2 fma2(f32x2 a, f32x2 b, f32x2 c) { return __builtin_elementwise_fma(a, b, c); }
__device__ __forceinline__ float p9_dot16(const v4u u, const f32x2 (&h)[8]) {
    f32x2 a = {0.f, 0.f}, b = {0.f, 0.f};
    a = fma2(p9_cvt(u.x, false), h[0], a); b = fma2(p9_cvt(u.x, true), h[1], b); a = fma2(p9_cvt(u.y, false), h[2], a); b = fma2(p9_cvt(u.y, true), h[3], b);
    a = fma2(p9_cvt(u.z, false), h[4], a); b = fma2(p9_cvt(u.z, true), h[5], b); a = fma2(p9_cvt(u.w, false), h[6], a); b = fma2(p9_cvt(u.w, true), h[7], b);
    a = a + b; return a.x + a.y;
}
__device__ __forceinline__ void p9_axpy16(const v4u v, float c, f32x2 (&o)[8]) {
    const f32x2 cc = {c, c};
    o[0] = fma2(p9_cvt(v.x, false), cc, o[0]); o[1] = fma2(p9_cvt(v.x, true), cc, o[1]); o[2] = fma2(p9_cvt(v.y, false), cc, o[2]); o[3] = fma2(p9_cvt(v.y, true), cc, o[3]);
    o[4] = fma2(p9_cvt(v.z, false), cc, o[4]); o[5] = fma2(p9_cvt(v.z, true), cc, o[5]); o[6] = fma2(p9_cvt(v.w, false), cc, o[6]); o[7] = fma2(p9_cvt(v.w, true), cc, o[7]);
}
#define P9_GATHER(S, iw) do { _Pragma("unroll") for (int j_ = 0; j_ < 8; ++j_) { const unsigned w_ = (iw)[j_ >> 1]; const unsigned id_ = (j_ & 1) ? (w_ >> 16) : (w_ & 0xffffu); \
        S[j_] = *(const v4u*)(tab + ((id_ << 7) + sub16)); } } while (0)
__device__ __forceinline__ float swapsum16(float x, float y) { unsigned a = __builtin_bit_cast(unsigned, x), b = __builtin_bit_cast(unsigned, y); PSWAP16(a, b); return __builtin_bit_cast(float, a) + __builtin_bit_cast(float, b); }
__device__ __forceinline__ float swapsum32(float x, float y) { unsigned a = __builtin_bit_cast(unsigned, x), b = __builtin_bit_cast(unsigned, y); PSWAP32(a, b); return __builtin_bit_cast(float, a) + __builtin_bit_cast(float, b); }

__device__ __forceinline__ void p9u_wave(Frame& F, int layer, int slice, int first, int stride) {
    int lane_ = F.lane; asm volatile("" : "+v"(lane_));
    const int lane = lane_, gi = lane >> 3, sub = lane & 7;
    const unsigned char* tab = WSP(unsigned char, WS_PU) + (size_t)(layer * 8 + slice) * PE_SLICE_BYTES;
    const unsigned sub16 = (unsigned)sub * 16u;
    const unsigned char* hbase = (const unsigned char*)(WSP(bf16, WS_XNB) + slice * 128 + sub * 16);
    const unsigned char* ibase = (const unsigned char*)(WSP(unsigned short, WS_PEI) + gi * 16);
    unsigned* pa = WSP(unsigned, WS_PA) + slice * 64 + lane;
    int t = first; if (t >= MTOK) return;
    v4u ia, ib, ha, hb, nia, nib, nha, nhb, A[8], B[8];
#define P9U_META(tt, xa, xb, ya, yb) do { const v4u* ip_ = (const v4u*)(ibase + (size_t)(tt) * 256); xa = ip_[0]; xb = ip_[1]; const v4u* hp_ = (const v4u*)(hbase + (size_t)(tt) * 2048); ya = hp_[0]; yb = hp_[1]; } while (0)
    P9U_META(t, ia, ib, ha, hb);
    P9_GATHER(A, ia);
    const bool b0 = sub & 1, b1 = sub & 2, b2 = sub & 4;
#pragma unroll 1
    for (;;) {
        const int tn = t + stride; const bool more = tn < MTOK; const int tl = more ? tn : t;
        P9U_META(tl, nia, nib, nha, nhb);
        P9_GATHER(B, ib);
        f32x2 h[8];
#pragma unroll
        for (int k = 0; k < 4; ++k) { h[k] = (f32x2){bflo(ha[k]), bfhi(ha[k])}; h[4 + k] = (f32x2){bflo(hb[k]), bfhi(hb[k])}; }
        float p[16];
#pragma unroll
        for (int j = 0; j < 8; ++j) p[j] = p9_dot16(A[j], h);
        P9_GATHER(A, nia);
#pragma unroll
        for (int j = 0; j < 8; ++j) p[8 + j] = p9_dot16(B[j], h);
        float q[8], r[4], sv[2];
#pragma unroll
        for (int i = 0; i < 8; ++i) { const float keep = b2 ? p[8 + i] : p[i], send = b2 ? p[i] : p[8 + i]; q[i] = keep + dpp_f<DPP_HMIR>(send); }
#pragma unroll
        for (int i = 0; i < 4; ++i) { const float keep = b0 ? q[2 * i + 1] : q[2 * i], send = b0 ? q[2 * i] : q[2 * i + 1]; r[i] = keep + dpp_f<DPP_XOR1>(send); }
#pragma unroll
        for (int i = 0; i < 2; ++i) { const float keep = b1 ? r[2 * i + 1] : r[2 * i], send = b1 ? r[2 * i] : r[2 * i + 1]; sv[i] = keep + dpp_f<DPP_XOR2>(send); }
        pa[(size_t)t * 512] = pk2(sv[0], sv[1]);
        if (!more) break;
        t = tn; ia = nia; ib = nib; ha = nha; hb = nhb;
    }
#undef P9U_META
}

__device__ __forceinline__ void p9v_wave(Frame& F, int layer, int slice, int first, int stride, int mode) {
    int lane_ = F.lane; asm volatile("" : "+v"(lane_));
    const int lane = lane_, gi = lane >> 3, sub = lane & 7, j0 = 8 * (sub >> 2) + (sub & 3);
    const unsigned char* tab = WSP(unsigned char, WS_PV) + (size_t)(layer * 8 + slice) * PE_SLICE_BYTES;
    const unsigned sub16 = (unsigned)sub * 16u;
    const unsigned char* ibase = (const unsigned char*)(WSP(unsigned short, WS_PEI) + gi * 16);
    const unsigned* pab = WSP(unsigned, WS_PA) + lane;
    const float* pegb = WSP(float, WS_PEG) + gi * 16 + j0;
    const int eoff = slice * 128 + sub * 16 + gi;
    float* xsb = WSP(float, WS_XS) + eoff;
    int t = first; if (t >= MTOK) return;
    v4u ia, ib, nia, nib, A[8], B[8];
    unsigned pw[8], npw[8]; float g0, g1, ng0, ng1, x0, x1, nx0, nx1;
#define P9V_META(tt, xa, xb, pp, ga, gb, ya, yb) do { const v4u* ip_ = (const v4u*)(ibase + (size_t)(tt) * 256); xa = ip_[0]; xb = ip_[1]; \
        _Pragma("unroll") for (int x_ = 0; x_ < 8; ++x_) pp[x_] = pab[(size_t)(tt) * 512 + x_ * 64]; \
        ga = pegb[(size_t)(tt) * 128]; gb = pegb[(size_t)(tt) * 128 + 4]; ya = xsb[(size_t)(tt) * DM]; yb = xsb[(size_t)(tt) * DM + 8]; } while (0)
    P9V_META(t, ia, ib, pw, g0, g1, x0, x1);
    P9_GATHER(A, ia);
#pragma unroll 1
    for (;;) {
        const int tn = t + stride; const bool more = tn < MTOK; const int tl = more ? tn : t;
        P9V_META(tl, nia, nib, npw, ng0, ng1, nx0, nx1);
        P9_GATHER(B, ib);
        float alo = 0.f, ahi = 0.f;
#pragma unroll
        for (int x = 0; x < 8; ++x) { alo += bflo(pw[x]); ahi += bfhi(pw[x]); }
        const float c0 = gelu_tanh(alo * 0.03125f) * g0 * 0.0625f, c1 = gelu_tanh(ahi * 0.03125f) * g1 * 0.0625f;
        f32x2 o[8];
#pragma unroll
        for (int i = 0; i < 8; ++i) o[i] = (f32x2){0.f, 0.f};
#define P9V_C(j) __builtin_bit_cast(float, __builtin_amdgcn_ds_swizzle(__builtin_bit_cast(int, (((j) >> 2) & 1) ? c1 : c0), ((4 * ((j) >> 3) + ((j) & 3)) << 5) | 0x18))
        { const float cj[8] = {P9V_C(0), P9V_C(1), P9V_C(2), P9V_C(3), P9V_C(4), P9V_C(5), P9V_C(6), P9V_C(7)};
#pragma unroll
          for (int j = 0; j < 8; ++j) p9_axpy16(A[j], cj[j], o); }
        P9_GATHER(A, nia);
        { const float cj[8] = {P9V_C(8), P9V_C(9), P9V_C(10), P9V_C(11), P9V_C(12), P9V_C(13), P9V_C(14), P9V_C(15)};
#pragma unroll
          for (int j = 0; j < 8; ++j) p9_axpy16(B[j], cj[j], o); }
#undef P9V_C
        const bool g0b = lane & 8;
        float q[8], r[4], sv[2];
#pragma unroll
        for (int i = 0; i < 8; ++i) { const float keep = g0b ? o[i].y : o[i].x, send = g0b ? o[i].x : o[i].y; q[i] = keep + dpp_f<DPP_ROR8>(send); }
#pragma unroll
        for (int i = 0; i < 4; ++i) r[i] = swapsum16(q[2 * i], q[2 * i + 1]);
#pragma unroll
        for (int i = 0; i < 2; ++i) sv[i] = swapsum32(r[2 * i], r[2 * i + 1]);
        const float y0 = x0 + sv[0], y1 = x1 + sv[1];
        if (mode == 0) {
            float* xs = xsb + (size_t)t * DM; xs[0] = y0; xs[8] = y1;
            bf16* xn = WSP(bf16, WS_XNA) + (size_t)t * DM + eoff; xn[0] = (bf16)f2bf(y0); xn[8] = (bf16)f2bf(y1);
            const float ss = wave_sum(y0 * y0 + y1 * y1);
            if (lane == 0) WSP(float, WS_SSQ)[(size_t)t * 8 + slice] = ss;
        } else {
            float* y = (t < MP ? F.out + O_YP + (size_t)t * DM : F.out + O_YS + (size_t)(t - MP) * DM) + eoff;
            y[0] = y0; y[8] = y1;
        }
        if (!more) break;
        t = tn; ia = nia; ib = nib; g0 = ng0; g1 = ng1; x0 = nx0; x1 = nx1;
#pragma unroll
        for (int x = 0; x < 8; ++x) pw[x] = npw[x];
    }
#undef P9V_META
}
#undef P9_GATHER

constexpr float QSCALE = 0.125f * 1.4426950408889634f;
constexpr int PP_VT = 0;
__device__ __forceinline__ float rms64(float v) { return frsq(wave_sum(v * v) * (1.f / 64.f) + EPS); }

__device__ __forceinline__ void pp_q_row(Frame& F, int row, const bf16* kvq, const float qg) {
    const int lane = F.lane;
    bf16* qn = WSP(bf16, WS_QN) + (size_t)row * 1024;
#pragma unroll 4
    for (int hd = 0; hd < 16; ++hd) { const float v = bf2f(kvq[NKV + hd * 64 + lane]); qn[hd * 64 + lane] = (bf16)f2bf(v * rms64(v) * qg); }
    if (lane < 48) WSP(float, WS_GATES)[(size_t)row * 48 + lane] = sigmoid_f(bf2f(kvq[NKV + 1024 + lane]));
}
__device__ __forceinline__ f32x4 rms64x4(f32x4 v) { const float ss = row_sum16((v.x * v.x + v.y * v.y) + (v.z * v.z + v.w * v.w)); return v * (frsq(ss * (1.f / 64.f) + EPS)); }
__device__ __forceinline__ v2u pk4(f32x4 v) { return (v2u){pk2(v.x, v.y), pk2(v.z, v.w)}; }
__device__ __forceinline__ void pp_prompt_tile(Frame& F, int unit) {
    const int lane = F.lane, w = F.wave, b = unit >> 7, t0 = (unit & 127) * 64, g = lane >> 4, d4 = (lane & 15) * 4;
    LAS unsigned char* L = F.lds; asm volatile("" : "+v"(L));
    LAS bf16* vt = (LAS bf16*)(L + PP_VT);
    const f32x4 kg1 = *(const f32x4*)(FIN(16) + 64 + d4), kg2 = *(const f32x4*)(FIN(16) + 128 + d4), qg = *(const f32x4*)(FIN(22) + d4) * QSCALE;
    v2u nv[6], nq[4], ngl;
#define PP_FETCH(rr_) do { const int row_ = b * PT + t0 + 8 * w + ((rr_) < 8 ? (rr_) : 7); const v2u* kvq_ = (const v2u*)(WSP(bf16, WS_KVQ) + (size_t)row_ * NKVQ) + lane;        \
        _Pragma("unroll") for (int sidx_ = 0; sidx_ < 6; ++sidx_) nv[sidx_] = kvq_[64 * sidx_]; \
        _Pragma("unroll") for (int i_ = 0; i_ < 4; ++i_) nq[i_] = kvq_[64 * (6 + i_)]; \
        ngl = ((const v2u*)(WSP(bf16, WS_KVQ) + (size_t)row_ * NKVQ))[640 + (lane & 15)]; } while (0)
    PP_FETCH(0);
#pragma unroll 1
    for (int rr = 0; rr < 8; ++rr) {
        const int tl = 8 * w + rr, t = t0 + tl, row = b * PT + t;
        f32x4 v[6], q[4]; const f32x4 gl = {bflo(ngl.x), bfhi(ngl.x), bflo(ngl.y), bfhi(ngl.y)};
#pragma unroll
        for (int sidx = 0; sidx < 6; ++sidx) v[sidx] = (f32x4){bflo(nv[sidx].x), bfhi(nv[sidx].x), bflo(nv[sidx].y), bfhi(nv[sidx].y)};
#pragma unroll
        for (int i = 0; i < 4; ++i) q[i] = (f32x4){bflo(nq[i].x), bfhi(nq[i].x), bflo(nq[i].y), bfhi(nq[i].y)};
        PP_FETCH(rr + 1);
        const f32x4 ks = rms64x4(v[2]) * kg1, kw = rms64x4(v[4]) * kg2;
        f32x4* okv = (f32x4*)(F.out + O_KVP + (size_t)row * 1024) + lane;
        okv[0] = v[0]; okv[64] = v[1]; okv[128] = ks; okv[192] = v[3];
        if (t >= PT - WINDOW) { f32x4* owin = (f32x4*)(F.out + O_WINP + ((size_t)b * 512 + (t - (PT - WINDOW))) * 512) + lane; owin[0] = kw; owin[64] = v[5]; }
        const size_t kidx = (((size_t)b * NG + g) * PT + t) * 64 + d4;
        *(v2u*)(WSP(bf16, WS_KSEL) + kidx) = pk4(ks); *(v2u*)(WSP(bf16, WS_KWIN) + kidx) = pk4(kw);
#pragma unroll
        for (int j = 0; j < 4; ++j) { vt[((0 * 4 + g) * 64 + d4 + j) * 72 + tl] = (bf16)f2bf(v[3][j]); vt[((1 * 4 + g) * 64 + d4 + j) * 72 + tl] = (bf16)f2bf(v[5][j]); }
        bf16* qn = WSP(bf16, WS_QN) + (size_t)row * 1024 + g * 64 + d4;
#pragma unroll
        for (int i = 0; i < 4; ++i) *(v2u*)(qn + i * 256) = pk4(rms64x4(q[i]) * qg);
        if (lane < 12) *(f32x4*)(WSP(float, WS_GATES) + (size_t)row * 48 + 4 * lane) = (f32x4){sigmoid_f(gl.x), sigmoid_f(gl.y), sigmoid_f(gl.z), sigmoid_f(gl.w)};
    }
#undef PP_FETCH
    __syncthreads();
    {
        const int which = F.tid >> 8, gd = F.tid & 255;
        bf16* dst = WSP(bf16, which == 0 ? WS_VSELT : WS_VWINT) + (((size_t)b * NG * 64 + gd) * PT + t0);
        const LAS bf16* src = vt + ((which * 256 + gd) * 72);
#pragma unroll
        for (int i = 0; i < 8; ++i) *(v4u*)(dst + 8 * i) = *(const LAS v4u*)(src + 8 * i);
    }
    __syncthreads();
}
__device__ __forceinline__ void pp_sample_row(Frame& F, int sr) {
    const int lane = F.lane, bs = sr >> 2, i = sr & 3, row = MP + sr;
    const float kg1 = FIN(16)[64 + lane], kg2 = FIN(16)[128 + lane], qg = FIN(22)[lane] * QSCALE;
    const bf16* kvq = WSP(bf16, WS_KVQ) + (size_t)row * NKVQ;
    float* okv = F.out + O_KVS + (size_t)sr * 1024;
    float* owin = F.out + O_WINS + ((size_t)bs * 512 + 508 + i) * 512;
#pragma unroll
    for (int g = 0; g < 4; ++g) {
        const float v0 = bf2f(kvq[0 * 256 + g * 64 + lane]), v1 = bf2f(kvq[1 * 256 + g * 64 + lane]), v2 = bf2f(kvq[2 * 256 + g * 64 + lane]);
        const float v3 = bf2f(kvq[3 * 256 + g * 64 + lane]), v4 = bf2f(kvq[4 * 256 + g * 64 + lane]), v5 = bf2f(kvq[5 * 256 + g * 64 + lane]);
        const float ks = v2 * rms64(v2) * kg1, kw = v4 * rms64(v4) * kg2;
        okv[0 * 256 + g * 64 + lane] = v0; okv[1 * 256 + g * 64 + lane] = v1; okv[2 * 256 + g * 64 + lane] = ks; okv[3 * 256 + g * 64 + lane] = v3;
        owin[g * 64 + lane] = kw; owin[256 + g * 64 + lane] = v5;
        const size_t bg = (size_t)bs * NG + g;
        WSP(bf16, WS_SKWIN)[(bg * 544 + 512 + i) * 64 + lane] = (bf16)f2bf(kw);
        WSP(bf16, WS_SVWINT)[(bg * 64 + lane) * 544 + 512 + i] = (bf16)f2bf(v5);
        float* sn = WSP(float, WS_SNEW) + (((size_t)bs * 4 + i) * 2) * 256 + g * 64 + lane;
        sn[0] = ks; sn[256] = v3;
    }
    pp_q_row(F, row, kvq, qg);
}

struct RowPPrompt { static constexpr bool BF = true; const bf16* base; __device__ __forceinline__ const bf16* operator()(int t) const { return base + (size_t)t * NKVQ; } };
struct RowPSample { static constexpr bool BF = false; const float* cache; const int* pt; __device__ __forceinline__ const float* operator()(int t) const { return cache + ((size_t)pt[t >> 7] * PAGE + (t & 127)) * 1024; } };
template <class RowP> __device__ __forceinline__ bf16x8 rowp_frag(const RowP& rowp, int t, int off) {
    if constexpr (RowP::BF) return ld8(rowp(t) + off);
    else { const float* rp = rowp(t) + off; return cvt8(*(const f32x4*)rp, *(const f32x4*)(rp + 4)); }
}
__device__ __forceinline__ void compress_finish(Frame& F, const f32x4 (&acc)[4], int kv, int blk, bf16* KC, bf16* VCT) {
    const int lane = F.lane, fr = lane & 15, fq = lane >> 4;
    const float* pet = WSP(float, WS_PETERM) + kv * 64;
    bf16x8 hb[2];
#pragma unroll
    for (int s = 0; s < 2; ++s) { f32x4 h0, h1;
#pragma unroll
        for (int r = 0; r < 4; ++r) { h0[r] = gelu_tanh(acc[2 * s][r] + pet[16 * (2 * s) + 4 * fq + r]); h1[r] = gelu_tanh(acc[2 * s + 1][r] + pet[16 * (2 * s + 1) + 4 * fq + r]); }
        hb[s] = cvt8(h0, h1); }
    const float* w2 = FIN(19) + (size_t)kv * 64 * 64;
    f32x4 o[4];
#pragma unroll
    for (int dt = 0; dt < 4; ++dt) { o[dt] = (f32x4){0.f, 0.f, 0.f, 0.f};
#pragma unroll
        for (int s = 0; s < 2; ++s) { f32x4 a0, a1;
#pragma unroll
            for (int jj = 0; jj < 4; ++jj) { a0[jj] = w2[(size_t)(16 * (2 * s) + 4 * fq + jj) * 64 + 16 * dt + fr]; a1[jj] = w2[(size_t)(16 * (2 * s + 1) + 4 * fq + jj) * 64 + 16 * dt + fr]; }
            o[dt] = MFMA16(cvt8(a0, a1), hb[s], o[dt]); } }
    if (kv == 0) {
        float ss = 0.f;
#pragma unroll
        for (int dt = 0; dt < 4; ++dt) ss += (o[dt][0] * o[dt][0] + o[dt][1] * o[dt][1]) + (o[dt][2] * o[dt][2] + o[dt][3] * o[dt][3]);
        ss = x32_sum(x16_sum(ss));
        const float rstd = frsq(ss * (1.f / 64.f) + EPS);
        const float* kg0 = FIN(16);
        if (blk < NCMP) {
#pragma unroll
            for (int dt = 0; dt < 4; ++dt) { const int d = 16 * dt + 4 * fq; v2u ov; ov.x = pk2(o[dt][0] * rstd * kg0[d], o[dt][1] * rstd * kg0[d + 1]); ov.y = pk2(o[dt][2] * rstd * kg0[d + 2], o[dt][3] * rstd * kg0[d + 3]);
                *(v2u*)(KC + (size_t)blk * 64 + d) = ov; }
        } else {
#pragma unroll
            for (int dt = 0; dt < 4; ++dt) *(v2u*)(KC + (size_t)blk * 64 + 16 * dt + 4 * fq) = (v2u){0u, 0u};
        }
    } else {
#pragma unroll
        for (int dt = 0; dt < 4; ++dt)
#pragma unroll
            for (int r = 0; r < 4; ++r) VCT[(size_t)(16 * dt + 4 * fq + r) * 512 + blk] = (blk < NCMP) ? (bf16)f2bf(o[dt][r]) : (bf16)0;
    }
}

template <class RowP>
__device__ __forceinline__ void compress_part(Frame& F, const RowP& rowp, int kv, int j, int r_lo, int r_hi, f32x4 (&acc)[4]) {
    const int lane = F.lane, fr = lane & 15, fq = lane >> 4;
    const bf16* W1 = WSP(bf16, WS_W1T) + (size_t)kv * 64 * 2048 + (size_t)fr * 2048 + 8 * fq;
    const int blk = 16 * j + fr;
#pragma unroll
    for (int mt = 0; mt < 4; ++mt) acc[mt] = (f32x4){0.f, 0.f, 0.f, 0.f};
#pragma unroll 2
    for (int r = r_lo; r < r_hi; ++r) {
        int t = 16 * blk + r; t = t < PAST ? t : PAST - 1;
#pragma unroll
        for (int hf = 0; hf < 2; ++hf) {
            const bf16x8 bfrag = rowp_frag(rowp, t, 8 * fq + 32 * hf);
            const int ks = 2 * r + hf;
#pragma unroll
            for (int mt = 0; mt < 4; ++mt) acc[mt] = MFMA16(ld8(W1 + (size_t)mt * 16 * 2048 + 32 * ks), bfrag, acc[mt]);
        }
    }
}
template <class RowP>
__device__ __forceinline__ void compress_tile(Frame& F, const RowP& rowp, int kv, int j, bf16* KC, bf16* VCT) {
    const int lane = F.lane, fr = lane & 15, fq = lane >> 4;
    const bf16* W1 = WSP(bf16, WS_W1T) + (size_t)kv * 64 * 2048 + (size_t)fr * 2048 + 8 * fq;
    const int blk = 16 * j + fr;
    f32x4 acc[4];
#pragma unroll
    for (int mt = 0; mt < 4; ++mt) acc[mt] = (f32x4){0.f, 0.f, 0.f, 0.f};
#pragma unroll 2
    for (int r = 0; r < 32; ++r) {
        int t = 16 * blk + r; t = t < PAST ? t : PAST - 1;
#pragma unroll
        for (int hf = 0; hf < 2; ++hf) {
            const bf16x8 bfrag = rowp_frag(rowp, t, 8 * fq + 32 * hf);
            const int ks = 2 * r + hf;
#pragma unroll
            for (int mt = 0; mt < 4; ++mt) acc[mt] = MFMA16(ld8(W1 + (size_t)mt * 16 * 2048 + 32 * ks), bfrag, acc[mt]);
        }
    }
    compress_finish(F, acc, kv, blk, KC, VCT);
}


__device__ __forceinline__ void compress_prompt(Frame& F, int id) {
    const int kv = id & 1, j = (id >> 1) & 31, bg = id >> 6, b = bg >> 2, g = bg & 3;
    RowPPrompt rp{WSP(bf16, WS_KVQ) + (size_t)b * PT * NKVQ + kv * 256 + g * 64};
    compress_tile(F, rp, kv, j, WSP(bf16, WS_KCMP) + (size_t)bg * 512 * 64, WSP(bf16, WS_VCMPT) + (size_t)bg * 64 * 512);
}
constexpr int CP_PART = 81920;
__device__ __forceinline__ void compress_prompt_split(Frame& F, int id) {
    const int kv = id & 1, j = (id >> 1) & 31, bg = id >> 6, b = bg >> 2, g = bg & 3, q = F.wave & 3, lane = F.lane;
    RowPPrompt rp{WSP(bf16, WS_KVQ) + (size_t)b * PT * NKVQ + kv * 256 + g * 64};
    f32x4 acc[4];
    compress_part(F, rp, kv, j, 8 * q, 8 * q + 8, acc);
    LAS f32x4* part = (LAS f32x4*)(F.lds + CP_PART) + (F.wave >> 2) * 1024;
#pragma unroll
    for (int mt = 0; mt < 4; ++mt) part[(q * 4 + mt) * 64 + lane] = acc[mt];
    __syncthreads();
    if (q == 0) {
#pragma unroll
        for (int mt = 0; mt < 4; ++mt) acc[mt] = (part[(0 * 4 + mt) * 64 + lane] + part[(1 * 4 + mt) * 64 + lane]) + (part[(2 * 4 + mt) * 64 + lane] + part[(3 * 4 + mt) * 64 + lane]);
        compress_finish(F, acc, kv, 16 * j + (lane & 15), WSP(bf16, WS_KCMP) + (size_t)bg * 512 * 64, WSP(bf16, WS_VCMPT) + (size_t)bg * 64 * 512);
    }
    __syncthreads();
}
__device__ __forceinline__ void compress_sample(Frame& F, int id) {
    const int kv = id & 1, j = (id >> 1) & 31, bg = id >> 6, lane = F.lane, fr = lane & 15, fq = lane >> 4;
    const int blk = 16 * j + fr, nb = blk < 511 ? blk + 1 : 511;
    const bf16* f1 = WSP(bf16, WS_FS) + ((size_t)bg * 512 + blk) * 256 + kv * 128 + 4 * fq;
    const bf16* f2 = WSP(bf16, WS_FS) + ((size_t)bg * 512 + nb) * 256 + kv * 128 + 64 + 4 * fq;
    f32x4 acc[4];
#pragma unroll
    for (int mt = 0; mt < 4; ++mt) { const v2u a = *(const v2u*)(f1 + 16 * mt), b = *(const v2u*)(f2 + 16 * mt);
        acc[mt] = (f32x4){bflo(a.x) + bflo(b.x), bfhi(a.x) + bfhi(b.x), bflo(a.y) + bflo(b.y), bfhi(a.y) + bfhi(b.y)}; }
    compress_finish(F, acc, kv, blk, WSP(bf16, WS_SKCMP) + (size_t)bg * 512 * 64, WSP(bf16, WS_SVCMPT) + (size_t)bg * 64 * 512);
}

constexpr int NSA_IMP = 0;
constexpr int NSA_Q = 67584;
constexpr int NSA_QLD = 68;
constexpr float LOG2E = 1.4426950408889634f;
#ifndef NSA_SUBUNITS
#define NSA_SUBUNITS 0
#endif
__device__ __forceinline__ float ex2(float x) { return __builtin_amdgcn_exp2f(x); }

struct KvBf16 {
    const bf16* K; const bf16* VT; int ld;
    __device__ __forceinline__ void lane_offsets(int fr, int fq, unsigned& ko, unsigned& vo) const {
        ko = (unsigned)(((8 * (fr >> 2) + (fr & 3)) * 64 + 8 * fq) * 2); vo = (unsigned)((fr * ld + 8 * fq) * 2);
        asm volatile("" : "+v"(ko), "+v"(vo));
    }
    __device__ __forceinline__ bf16x8 kf(int key0, int mt, int ks, unsigned ko) const {
        return *(const bf16x8*)((const char*)K + (size_t)key0 * 128 + (ko + (unsigned)((4 * mt * 64 + 32 * ks) * 2))); }
    __device__ __forceinline__ bf16x8 vf(int key0, int dt, unsigned vo) const {
        return *(const bf16x8*)((const char*)VT + (size_t)key0 * 2 + (vo + (unsigned)(16 * dt * ld * 2))); }
};
struct KvSampleSel {
    const float* cache; const int* pt; const float* snew; int g;
    __device__ __forceinline__ const float* krow(int pos, int slot) const {
        if (pos < PAST) return cache + ((size_t)pt[pos >> 7] * PAGE + (pos & 127)) * 1024 + slot * 256;
        int i = pos - PAST; i = i < 3 ? i : 3; return snew + (size_t)i * 512 + (slot - 2) * 256; }
    __device__ __forceinline__ void lane_offsets(int fr, int fq, unsigned& ko, unsigned& vo) const { ko = (unsigned)(fr | (fq << 8)); vo = ko; asm volatile("" : "+v"(ko), "+v"(vo)); }
    __device__ __forceinline__ bf16x8 kf(int key0, int mt, int ks, unsigned ko) const { const int fr = ko & 255, fq = ko >> 8;
        const float* p = krow(key0 + 8 * (fr >> 2) + 4 * mt + (fr & 3), 2) + 32 * ks + 8 * fq; return cvt8(*(const f32x4*)p, *(const f32x4*)(p + 4)); }
    __device__ __forceinline__ bf16x8 vf(int key0, int dt, unsigned vo) const { const int fr = vo & 255, fq = vo >> 8; f32x4 a, b;
#pragma unroll
        for (int j = 0; j < 4; ++j) { a[j] = krow(key0 + 8 * fq + j, 3)[16 * dt + fr]; b[j] = krow(key0 + 8 * fq + 4 + j, 3)[16 * dt + fr]; }
        return cvt8(a, b); }
};
struct KvFrags { bf16x8 k[2][2]; bf16x8 v[4]; };
template <bool WITHV, class KV>
__device__ __forceinline__ void nsa_load(const KV& kv, int key0, int fr, int fq, KvFrags& f) {
    unsigned ko, vo; kv.lane_offsets(fr, fq, ko, vo);
#pragma unroll
    for (int mt = 0; mt < 2; ++mt)
#pragma unroll
        for (int ks = 0; ks < 2; ++ks) f.k[mt][ks] = kv.kf(key0, mt, ks, ko);
    if (WITHV) {
#pragma unroll
        for (int dt = 0; dt < 4; ++dt) f.v[dt] = kv.vf(key0, dt, vo);
    }
}

template <int NT, int MODE, bool QREG = false>
__device__ __forceinline__ void nsa_core(const KvFrags& f, int key0, const LAS bf16* qrow, int qnt, f32x4 (&O)[NT][4], float (&m)[NT], float (&l)[NT], const float (&invl)[NT], const float (&slope)[NT],
                                         int t, int pmul, int padd, int wlim, bool selok, LAS float* improw, int fq, const bf16x8* qreg = nullptr) {
    float dist[2][4]; bool val[2][4];
#pragma unroll
    for (int mt = 0; mt < 2; ++mt)
#pragma unroll
        for (int r = 0; r < 4; ++r) { const int kk = key0 + 8 * fq + 4 * mt + r; const int dd = t - (pmul * kk + padd); val[mt][r] = selok && dd >= 0 && dd < wlim; dist[mt][r] = val[mt][r] ? (float)dd : 1e6f; }
    float imp_main[2] = {0.f, 0.f}, imp_spill[2] = {0.f, 0.f};
    f32x4 sc[NT][2]; bf16x8 pfr[NT];
#pragma unroll
    for (int nt = 0; nt < NT; ++nt) {
        bf16x8 q0, q1; if (QREG) { q0 = qreg[nt * 2]; q1 = qreg[nt * 2 + 1]; } else { q0 = ld8l(qrow + nt * qnt + 8 * fq); q1 = ld8l(qrow + nt * qnt + 32 + 8 * fq); }
#pragma unroll
        for (int mt = 0; mt < 2; ++mt) { sc[nt][mt] = (f32x4){0.f, 0.f, 0.f, 0.f}; sc[nt][mt] = MFMA16(f.k[mt][0], q0, sc[nt][mt]); sc[nt][mt] = MFMA16(f.k[mt][1], q1, sc[nt][mt]); }
    }
#pragma unroll
    for (int nt = 0; nt < NT; ++nt) {
        f32x4 p[2]; float ps = 0.f;
#pragma unroll
        for (int mt = 0; mt < 2; ++mt)
#pragma unroll
            for (int r = 0; r < 4; ++r) { float pv = ex2(sc[nt][mt][r] - slope[nt] * dist[mt][r]); if (MODE == 2) pv *= invl[nt]; p[mt][r] = pv; ps += pv; }
        if (MODE != 2) l[nt] += ps;
        if (MODE == 2) {
#pragma unroll
            for (int mt = 0; mt < 2; ++mt) { imp_main[mt] += (p[mt][0] + p[mt][1]) + (p[mt][2] + p[mt][3]); imp_spill[mt] += p[mt][3]; }
        }
        if (MODE != 1) pfr[nt] = cvt8(p[0], p[1]);
    }
    if (MODE != 1) {
#pragma unroll
        for (int nt = 0; nt < NT; ++nt)
#pragma unroll
            for (int dt = 0; dt < 4; ++dt) O[nt][dt] = MFMA16(f.v[dt], pfr[nt], O[nt][dt]);
    }
    if (MODE == 2) {
#pragma unroll
        for (int mt = 0; mt < 2; ++mt) { const int j = key0 / 4 + 2 * fq + mt;
            __hip_atomic_fetch_add(improw + j, imp_main[mt], __ATOMIC_RELAXED, __HIP_MEMORY_SCOPE_WORKGROUP);
            __hip_atomic_fetch_add(improw + j + 1, imp_spill[mt], __ATOMIC_RELAXED, __HIP_MEMORY_SCOPE_WORKGROUP); }
    }
}
template <int NT, int MODE, class KV>
__device__ __forceinline__ void nsa_tile(const KV& kv, int key0, const LAS bf16* qrow, int qnt, f32x4 (&O)[NT][4], float (&m)[NT], float (&l)[NT], const float (&invl)[NT], const float (&slope)[NT],
                                         int t, int pmul, int padd, int wlim, bool selok, LAS float* improw, int fr, int fq) {
    KvFrags f; nsa_load<MODE != 1>(kv, key0, fr, fq, f);
    nsa_core<NT, MODE>(f, key0, qrow, qnt, O, m, l, invl, slope, t, pmul, padd, wlim, selok, improw, fq);
}

template <int NT>
__device__ __forceinline__ void nsa_zero(f32x4 (&O)[NT][4], float (&m)[NT], float (&l)[NT]) {
#pragma unroll
    for (int nt = 0; nt < NT; ++nt) { m[nt] = -1e30f; l[nt] = 0.f;
#pragma unroll
        for (int dt = 0; dt < 4; ++dt) O[nt][dt] = (f32x4){0.f, 0.f, 0.f, 0.f}; }
}

template <bool SAMPLE>
__device__ __forceinline__ void nsa_unit(Frame& F, int id) {
    constexpr int NT = SAMPLE ? 1 : 4;
    int lane_ = F.lane; asm volatile("" : "+v"(lane_));
    const int lane = lane_, fr = lane & 15, fq = lane >> 4;
    LAS unsigned char* L = F.lds; asm volatile("" : "+v"(L));
    LAS float* imp = (LAS float*)(L + NSA_IMP + F.wave * 8448);
    LAS bf16* qw = (LAS bf16*)(L + NSA_Q + F.wave * 8704);
    int bg, g, t, row, trow, tmax, row0;
    if (SAMPLE) { bg = id; g = id & 3; t = PAST + (fr >> 2); row0 = MP + (id >> 2) * 4; row = row0 + (fr >> 2); trow = fr >> 2; tmax = PAST + 3; }
    else { bg = id >> 9; g = bg & 3; const int tt = id & 511; t = 16 * tt + fr; row0 = (bg >> 2) * PT + 16 * tt; row = row0 + fr; trow = fr; tmax = 16 * tt + 15; }
    {
        const int nrow = SAMPLE ? 16 : 64;
        for (int i = lane; i < nrow * 8; i += 64) { const int rr = i >> 3, c8 = i & 7;
            *(LAS v4u*)(qw + rr * NSA_QLD + 8 * c8) = *(const v4u*)(WSP(bf16, WS_QN) + (size_t)(row0 + (rr >> 2)) * 1024 + (g * 4 + (rr & 3)) * 64 + 8 * c8); }
    }
    float slope[NT]; int hd[NT];
#pragma unroll
    for (int nt = 0; nt < NT; ++nt) { hd[nt] = g * 4 + (SAMPLE ? (fr & 3) : nt); slope[nt] = ex2(-0.5f * (float)(hd[nt] + 1)) * LOG2E; }
    const LAS bf16* qrow = qw + (SAMPLE ? fr : fr * 4) * NSA_QLD; const int qnt = SAMPLE ? 0 : NSA_QLD;
    const float* gates = WSP(float, WS_GATES) + (size_t)row * 48;
    float* oacc = WSP(float, WS_OACC) + (size_t)row * 1024;
    for (int i = lane; i < 16 * 132; i += 64) imp[i] = 0.f;
    LDS_WAIT();
    f32x4 O[NT][4]; float m[NT], l[NT], invl[NT];
    {
        KvBf16 kv{WSP(bf16, SAMPLE ? WS_SKCMP : WS_KCMP) + (size_t)bg * 512 * 64, WSP(bf16, SAMPLE ? WS_SVCMPT : WS_VCMPT) + (size_t)bg * 64 * 512, 512};
        const int cmax = (tmax - 31) >> 4;
        const int ntile = (tmax >= 31) ? ((cmax < 510 ? cmax : 510) / 32 + 1) : 0;
#pragma unroll
        for (int nt = 0; nt < NT; ++nt) invl[nt] = 0.f;
        nsa_zero<NT>(O, m, l);
        { KvFrags fa, fb; if (ntile > 0) nsa_load<false>(kv, 0, fr, fq, fa);
#pragma unroll 1
          for (int tl = 0; tl < ntile; ++tl) { if (tl + 1 < ntile) nsa_load<false>(kv, 32 * (tl + 1), fr, fq, fb);
            nsa_core<NT, 1>(fa, 32 * tl, qrow, qnt, O, m, l, invl, slope, t, 16, 31, 1 << 30, true, imp + trow * 132, fq); fa = fb; } }
#pragma unroll
        for (int nt = 0; nt < NT; ++nt) { float lt = l[nt]; lt = x32_sum(x16_sum(lt)); invl[nt] = lt > 0.f ? 1.f / lt : 0.f; }
        { KvFrags fa, fb; if (ntile > 0) nsa_load<true>(kv, 0, fr, fq, fa);
#pragma unroll 1
          for (int tl = 0; tl < ntile; ++tl) { if (tl + 1 < ntile) nsa_load<true>(kv, 32 * (tl + 1), fr, fq, fb);
            nsa_core<NT, 2>(fa, 32 * tl, qrow, qnt, O, m, l, invl, slope, t, 16, 31, 1 << 30, true, imp + trow * 132, fq); fa = fb; } }
#pragma unroll
        for (int nt = 0; nt < NT; ++nt) { const float gc = gates[0 * 16 + hd[nt]];
#pragma unroll
            for (int dt = 0; dt < 4; ++dt) *(f32x4*)(oacc + hd[nt] * 64 + 16 * dt + 4 * fq) = O[nt][dt] * gc; }
    }
    LDS_WAIT();
    unsigned selm[4] = {0u, 0u, 0u, 0u};
    {
        const int cur = t >> 6;
        if (!SAMPLE) {
            unsigned v[32];
#pragma unroll
            for (int i = 0; i < 32; ++i) { const int j = 32 * fq + i; const bool forced = (j == 0) | (j == cur) | (j == cur - 1);
                const unsigned key = ((f2u(imp[trow * 132 + j]) & ~127u) | (unsigned)(127 - j)) + 128u;
                v[i] = (!forced && j <= cur) ? key : 0u;
                if (forced) selm[fq] |= 1u << i; }
            unsigned fw = selm[0] | selm[1] | selm[2] | selm[3];
            const unsigned w16 = __shfl_xor(fw, 16), w32 = __shfl_xor(fw, 32), w48 = __shfl_xor(fw, 48);
#pragma unroll
            for (int wd = 0; wd < 4; ++wd) selm[wd] = (fq == wd) ? fw : ((fq ^ 1) == wd) ? w16 : ((fq ^ 2) == wd) ? w32 : w48;
            const int nforced = cur >= 2 ? 3 : cur + 1;
#pragma unroll 1
            for (int rd = 0; rd < 15; ++rd) {
                unsigned mx = v[0];
#pragma unroll
                for (int i = 1; i < 32; ++i) mx = mx > v[i] ? mx : v[i];
                mx = x32_umax(x16_umax(mx));
#pragma unroll
                for (int i = 0; i < 32; ++i) v[i] = (v[i] == mx) ? 0u : v[i];
                if (mx != 0u && rd < 16 - nforced) { const int js = 127 - (int)(mx & 127u);
#pragma unroll
                    for (int wd = 0; wd < 4; ++wd) selm[wd] |= ((js >> 5) == wd) ? (1u << (js & 31)) : 0u; }
            }
        } else {
            const int li = (fr & 3) * 4 + fq;
            unsigned v[8];
#pragma unroll
            for (int i = 0; i < 8; ++i) { const int j = li * 8 + i; v[i] = (j >= 1 && j <= 126) ? (((f2u(imp[trow * 132 + j]) & ~127u) | (unsigned)(127 - j)) + 128u) : 0u; }
            selm[0] = 1u; selm[3] = 1u << 31;
#pragma unroll 1
            for (int rd = 0; rd < 13; ++rd) {
                unsigned mx = v[0];
#pragma unroll
                for (int i = 1; i < 8; ++i) mx = mx > v[i] ? mx : v[i];
                { unsigned o = dpp_u<DPP_XOR1>(mx); mx = mx > o ? mx : o; o = dpp_u<DPP_XOR2>(mx); mx = mx > o ? mx : o; mx = x32_umax(x16_umax(mx)); }
#pragma unroll
                for (int i = 0; i < 8; ++i) v[i] = (v[i] == mx) ? 0u : v[i];
                if (mx != 0u) { const int js = 127 - (int)(mx & 127u);
#pragma unroll
                    for (int wd = 0; wd < 4; ++wd) selm[wd] |= ((js >> 5) == wd) ? (1u << (js & 31)) : 0u; }
            }
        }
    }
    if (SAMPLE || !NSA_SUBUNITS) {
        nsa_zero<NT>(O, m, l);
        unsigned un[4];
#pragma unroll
        for (int wd = 0; wd < 4; ++wd) { unsigned x = selm[wd]; x |= __shfl_xor(x, 1); x |= __shfl_xor(x, 2); x |= __shfl_xor(x, 4); x |= __shfl_xor(x, 8); un[wd] = (unsigned)__builtin_amdgcn_readfirstlane((int)x); }
        KvSampleSel kvs{FIN(2) + g * 64, (const int*)FIN(6) + (SAMPLE ? (id >> 2) : 0) * NPAGES, WSP(float, WS_SNEW) + (size_t)(SAMPLE ? (id >> 2) : 0) * 2048 + g * 64, g};
        KvBf16 kvp{WSP(bf16, WS_KSEL) + (size_t)bg * PT * 64, WSP(bf16, WS_VSELT) + (size_t)bg * 64 * PT, PT};
        if (SAMPLE) {
#pragma unroll 1
        for (int wd = 0; wd < 4; ++wd) {
            unsigned mm = un[wd];
            const unsigned mine = wd == 0 ? selm[0] : wd == 1 ? selm[1] : wd == 2 ? selm[2] : selm[3];
            while (mm) {
                const int bit = __builtin_ctz(mm); mm &= mm - 1u; const int j = 32 * wd + bit;
                const bool ok = (mine >> bit) & 1u;
#pragma unroll 1
                for (int hh = 0; hh < 2; ++hh) { nsa_tile<NT, 0>(kvs, 64 * j + 32 * hh, qrow, qnt, O, m, l, invl, slope, t, 1, 0, 1 << 30, ok, imp, fr, fq); __builtin_amdgcn_sched_barrier(0); }
            }
        }
        } else {
            int wdc = 0; unsigned mmc = un[0];
            while (wdc < 3 && mmc == 0u) { ++wdc; mmc = wdc == 1 ? un[1] : wdc == 2 ? un[2] : un[3]; }
            KvFrags fa, fb; int jc = -1, hc = 0;
            if (mmc) { jc = 32 * wdc + __builtin_ctz(mmc); mmc &= mmc - 1u; nsa_load<true>(kvp, 64 * jc, fr, fq, fa); }
#pragma unroll 1
            while (jc >= 0) {
                int jn = jc, hn = hc + 1;
                if (hn == 2) { hn = 0;
                    while (wdc < 3 && mmc == 0u) { ++wdc; mmc = wdc == 1 ? un[1] : wdc == 2 ? un[2] : un[3]; }
                    if (mmc) { jn = 32 * wdc + __builtin_ctz(mmc); mmc &= mmc - 1u; } else jn = -1; }
                if (jn >= 0) nsa_load<true>(kvp, 64 * jn + 32 * hn, fr, fq, fb);
                const int wj = jc >> 5, bj = jc & 31;
                const unsigned mine = wj == 0 ? selm[0] : wj == 1 ? selm[1] : wj == 2 ? selm[2] : selm[3];
                nsa_core<NT, 0>(fa, 64 * jc + 32 * hc, qrow, qnt, O, m, l, invl, slope, t, 1, 0, 1 << 30, (mine >> bj) & 1u, imp, fq);
                fa = fb; jc = jn; hc = hn;
            }
        }
        if (SAMPLE) nsa_tile<NT, 0>(kvs, 64 * 128, qrow, qnt, O, m, l, invl, slope, t, 1, 0, 1 << 30, true, imp, fr, fq);
#pragma unroll
        for (int nt = 0; nt < NT; ++nt) { float lt = l[nt]; lt = x32_sum(x16_sum(lt)); const float sc = gates[1 * 16 + hd[nt]] / fmaxf(lt, 1e-30f);
#pragma unroll
            for (int dt = 0; dt < 4; ++dt) { f32x4* o = (f32x4*)(oacc + hd[nt] * 64 + 16 * dt + 4 * fq); *o = *o + O[nt][dt] * sc; } }
    } else {
        unsigned ms[4][4];
#pragma unroll
        for (int s = 0; s < 4; ++s)
#pragma unroll
            for (int wd = 0; wd < 4; ++wd) ms[s][wd] = __shfl(selm[wd], 4 * s + (fr >> 2));
        unsigned su[4][4], un[4];
#pragma unroll
        for (int wd = 0; wd < 4; ++wd) { un[wd] = 0u;
#pragma unroll
            for (int s = 0; s < 4; ++s) { unsigned x = ms[s][wd]; x |= __shfl_xor(x, 4); x |= __shfl_xor(x, 8); su[s][wd] = (unsigned)__builtin_amdgcn_readfirstlane((int)x); un[wd] |= su[s][wd]; } }
        const int hds = g * 4 + (fr & 3); float slp[1]; slp[0] = ex2(-0.5f * (float)(hds + 1)) * LOG2E;
        const int tb = (id & 511) * 16 + (fr >> 2);
        f32x4 Os[4][1][4]; float mS[4][1], lS[4][1]; float inv1[1] = {0.f};
#pragma unroll
        for (int s = 0; s < 4; ++s) nsa_zero<1>(Os[s], mS[s], lS[s]);
        KvBf16 kvp{WSP(bf16, WS_KSEL) + (size_t)bg * PT * 64, WSP(bf16, WS_VSELT) + (size_t)bg * 64 * PT, PT};
        int wdc = 0; unsigned mmc = un[0];
        while (wdc < 3 && mmc == 0u) { ++wdc; mmc = wdc == 1 ? un[1] : wdc == 2 ? un[2] : un[3]; }
        KvFrags fa, fb;
        int jc = -1, hc = 0;
        if (mmc) { jc = 32 * wdc + __builtin_ctz(mmc); mmc &= mmc - 1u; nsa_load<true>(kvp, 64 * jc, fr, fq, fa); }
#pragma unroll 1
        while (jc >= 0) {
            int jn = jc, hn = hc + 1;
            if (hn == 2) { hn = 0;
                while (wdc < 3 && mmc == 0u) { ++wdc; mmc = wdc == 1 ? un[1] : wdc == 2 ? un[2] : un[3]; }
                if (mmc) { jn = 32 * wdc + __builtin_ctz(mmc); mmc &= mmc - 1u; } else jn = -1; }
            if (jn >= 0) nsa_load<true>(kvp, 64 * jn + 32 * hn, fr, fq, fb);
            const int wj = jc >> 5, bj = jc & 31;
#pragma unroll
            for (int s = 0; s < 4; ++s) {
                const unsigned suw = wj == 0 ? su[s][0] : wj == 1 ? su[s][1] : wj == 2 ? su[s][2] : su[s][3];
                if ((suw >> bj) & 1u) {
                    const unsigned mw = wj == 0 ? ms[s][0] : wj == 1 ? ms[s][1] : wj == 2 ? ms[s][2] : ms[s][3];
                    nsa_core<1, 0>(fa, 64 * jc + 32 * hc, qw + (16 * s + fr) * NSA_QLD, 0, Os[s], mS[s], lS[s], inv1, slp, tb + 4 * s, 1, 0, 1 << 30, (mw >> bj) & 1u, imp, fq);
                }
            }
            fa = fb; jc = jn; hc = hn;
        }
#pragma unroll
        for (int s = 0; s < 4; ++s) { float lt = lS[s][0]; lt = x32_sum(x16_sum(lt));
            const size_t rs = (size_t)(row0 + 4 * s + (fr >> 2));
            const float sc = WSP(float, WS_GATES)[rs * 48 + 16 + hds] / fmaxf(lt, 1e-30f);
#pragma unroll
            for (int dt = 0; dt < 4; ++dt) { f32x4* o = (f32x4*)(WSP(float, WS_OACC) + rs * 1024 + hds * 64 + 16 * dt + 4 * fq); *o = *o + Os[s][0][dt] * sc; } }
    }
    {
        nsa_zero<NT>(O, m, l);
        KvBf16 kv = SAMPLE ? KvBf16{WSP(bf16, WS_SKWIN) + (size_t)bg * 544 * 64, WSP(bf16, WS_SVWINT) + (size_t)bg * 64 * 544, 544}
                           : KvBf16{WSP(bf16, WS_KWIN) + (size_t)bg * PT * 64, WSP(bf16, WS_VWINT) + (size_t)bg * 64 * PT, PT};
        int k0, k1, padd;
        if (SAMPLE) { k0 = 0; k1 = 544; padd = PAST - WINDOW; }
        else { const int lo = tmax - 15 - (WINDOW - 1); k0 = (lo > 0 ? lo : 0) & ~31; k1 = tmax + 1; padd = 0; }
        { KvFrags fa, fb; nsa_load<true>(kv, k0, fr, fq, fa);
#pragma unroll 1
          for (int kk = k0; kk < k1; kk += 32) { if (kk + 32 < k1) nsa_load<true>(kv, kk + 32, fr, fq, fb);
            nsa_core<NT, 0>(fa, kk, qrow, qnt, O, m, l, invl, slope, t, 1, padd, WINDOW, true, imp, fq); fa = fb; } }
        bf16* on = WSP(bf16, WS_OG) + (size_t)row * 1024;
#pragma unroll
        for (int nt = 0; nt < NT; ++nt) { float lt = l[nt]; lt = x32_sum(x16_sum(lt)); const float sc = gates[2 * 16 + hd[nt]] / fmaxf(lt, 1e-30f);
#pragma unroll
            for (int dt = 0; dt < 4; ++dt) { const f32x4 o = *(const f32x4*)(oacc + hd[nt] * 64 + 16 * dt + 4 * fq) + O[nt][dt] * sc;
                *(v2u*)(on + hd[nt] * 64 + 16 * dt + 4 * fq) = (v2u){pk2(o[0], o[1]), pk2(o[2], o[3])}; } }
    }
}

constexpr int NW_STG = 67584;
constexpr int NW_STG_BYTES = 18432;
constexpr int NW_UN = NW_STG + 2 * NW_STG_BYTES;
struct NwStage { v4u k, v; };
__device__ __forceinline__ void nw_load(const bf16* K, const bf16* VT, int ld, int key0, int tid, NwStage& s) {
    s.k = *(const v4u*)(K + (size_t)(key0 + (tid >> 3)) * 64 + 8 * (tid & 7));
    s.v = *(const v4u*)(VT + (size_t)(tid >> 3) * ld + key0 + 8 * (tid & 7));
}
__device__ __forceinline__ void nw_store(LAS unsigned char* buf, int tid, const NwStage& s) {
    const int kk = tid >> 3, c8 = tid & 7, k32 = kk & 31;
    const int rho = 32 * (kk >> 5) + 16 * ((k32 >> 2) & 1) + 4 * (k32 >> 3) + (k32 & 3);
    *(LAS v4u*)(buf + rho * 144 + c8 * 16) = s.k;
    *(LAS v4u*)(buf + 9216 + kk * 144 + c8 * 16) = s.v;
}
template <bool WITHV>
__device__ __forceinline__ void nw_frags(const LAS unsigned char* buf, int th, int fr, int fq, KvFrags& f) {
#pragma unroll
    for (int mt = 0; mt < 2; ++mt)
#pragma unroll
        for (int ks = 0; ks < 2; ++ks) f.k[mt][ks] = *(const LAS bf16x8*)(buf + (32 * th + 16 * mt + fr) * 144 + (32 * ks + 8 * fq) * 2);
    if (WITHV) {
#pragma unroll
        for (int dt = 0; dt < 4; ++dt) f.v[dt] = *(const LAS bf16x8*)(buf + 9216 + (16 * dt + fr) * 144 + (32 * th + 8 * fq) * 2);
    }
}
#define NW_PIPE(Kp, VTp, ldv, NB, BLK, BODY) do { const int nb_ = (NB); \
        if (nb_ > 0) { NwStage st_; nw_load(Kp, VTp, ldv, BLK(0), F.tid, st_); nw_store(stg, F.tid, st_); } \
        __syncthreads(); \
        _Pragma("unroll 1") for (int ib_ = 0; ib_ < nb_; ++ib_) { \
            NwStage st_; const bool more_ = ib_ + 1 < nb_; if (more_) nw_load(Kp, VTp, ldv, BLK(ib_ + 1), F.tid, st_); \
            const LAS unsigned char* buf_ = stg + (ib_ & 1) * NW_STG_BYTES; const int key0_ = BLK(ib_); \
            BODY(buf_, key0_) \
            if (more_) nw_store(stg + ((ib_ + 1) & 1) * NW_STG_BYTES, F.tid, st_); \
            __syncthreads(); } } while (0)

__device__ __forceinline__ void nsa_wg(Frame& F, int bg, int qb) {
    int lane_ = F.lane; asm volatile("" : "+v"(lane_));
    const int lane = lane_, fr = lane & 15, fq = lane >> 4, w = F.wave, g = bg & 3;
    LAS unsigned char* L = F.lds; asm volatile("" : "+v"(L));
    LAS float* imp = (LAS float*)(L + NSA_IMP + w * 8448);
    LAS unsigned char* stg = L + NW_STG;
    LAS unsigned* wun = (LAS unsigned*)(L + NW_UN); volatile LAS unsigned char* blist = (volatile LAS unsigned char*)(L + NW_UN + 16);
    const int tt = qb * 8 + w, t = 16 * tt + fr, row0 = (bg >> 2) * PT + 16 * tt, row = row0 + fr, tw0 = 16 * tt, tw1 = tw0 + 15;
    float slope[4]; bf16x8 qreg[8];
#pragma unroll
    for (int nt = 0; nt < 4; ++nt) { slope[nt] = ex2(-0.5f * (float)(g * 4 + nt + 1)) * LOG2E;
        const bf16* qp = WSP(bf16, WS_QN) + (size_t)row * 1024 + (g * 4 + nt) * 64 + 8 * fq; qreg[2 * nt] = ld8(qp); qreg[2 * nt + 1] = ld8(qp + 32); }
    const float* gates = WSP(float, WS_GATES) + (size_t)row * 48;
    float* oacc = WSP(float, WS_OACC) + (size_t)row * 1024;
    for (int i = lane; i < 16 * 132; i += 64) imp[i] = 0.f;
    if (F.tid < 4) wun[F.tid] = 0u;
    f32x4 O[4][4]; float m[4], l[4], invl[4];
    {
        const bf16* Kc = WSP(bf16, WS_KCMP) + (size_t)bg * 512 * 64; const bf16* Vc = WSP(bf16, WS_VCMPT) + (size_t)bg * 64 * 512;
        const int cmax = (128 * qb + 127 - 31) >> 4, ncb = (cmax < 510 ? cmax : 510) / 64 + 1;
#pragma unroll
        for (int nt = 0; nt < 4; ++nt) invl[nt] = 0.f;
        nsa_zero<4>(O, m, l);
#define NW_BLK(i) (64 * (i))
#define NW_CMP1(buf, k0) { _Pragma("unroll 1") for (int th = 0; th < 2; ++th) if (16 * ((k0) + 32 * th) + 31 <= tw1) { KvFrags f; nw_frags<false>(buf, th, fr, fq, f); \
            nsa_core<4, 1, true>(f, (k0) + 32 * th, nullptr, 0, O, m, l, invl, slope, t, 16, 31, 1 << 30, true, imp + fr * 132, fq, qreg); } }
        NW_PIPE(Kc, Vc, 512, ncb, NW_BLK, NW_CMP1);
#pragma unroll
        for (int nt = 0; nt < 4; ++nt) { const float lt = x32_sum(x16_sum(l[nt])); invl[nt] = lt > 0.f ? 1.f / lt : 0.f; }
#define NW_CMP2(buf, k0) { _Pragma("unroll 1") for (int th = 0; th < 2; ++th) if (16 * ((k0) + 32 * th) + 31 <= tw1) { KvFrags f; nw_frags<true>(buf, th, fr, fq, f); \
            nsa_core<4, 2, true>(f, (k0) + 32 * th, nullptr, 0, O, m, l, invl, slope, t, 16, 31, 1 << 30, true, imp + fr * 132, fq, qreg); } }
        NW_PIPE(Kc, Vc, 512, ncb, NW_BLK, NW_CMP2);
#pragma unroll
        for (int nt = 0; nt < 4; ++nt) { const float gc = gates[0 * 16 + g * 4 + nt];
#pragma unroll
            for (int dt = 0; dt < 4; ++dt) *(f32x4*)(oacc + (g * 4 + nt) * 64 + 16 * dt + 4 * fq) = O[nt][dt] * gc; }
    }
    LDS_WAIT();
    unsigned selm[4] = {0u, 0u, 0u, 0u};
    {
        const int cur = t >> 6;
        unsigned v[32];
#pragma unroll
        for (int i = 0; i < 32; ++i) { const int j = 32 * fq + i; const bool forced = (j == 0) | (j == cur) | (j == cur - 1);
            const unsigned key = ((f2u(imp[fr * 132 + j]) & ~127u) | (unsigned)(127 - j)) + 128u;
            v[i] = (!forced && j <= cur) ? key : 0u;
            if (forced) selm[fq] |= 1u << i; }
        unsigned fw = selm[0] | selm[1] | selm[2] | selm[3];
        const unsigned w16 = __shfl_xor(fw, 16), w32 = __shfl_xor(fw, 32), w48 = __shfl_xor(fw, 48);
#pragma unroll
        for (int wd = 0; wd < 4; ++wd) selm[wd] = (fq == wd) ? fw : ((fq ^ 1) == wd) ? w16 : ((fq ^ 2) == wd) ? w32 : w48;
        const int nforced = cur >= 2 ? 3 : cur + 1;
#pragma unroll 1
        for (int rd = 0; rd < 15; ++rd) {
            unsigned mx = v[0];
#pragma unroll
            for (int i = 1; i < 32; ++i) mx = mx > v[i] ? mx : v[i];
            mx = x32_umax(x16_umax(mx));
#pragma unroll
            for (int i = 0; i < 32; ++i) v[i] = (v[i] == mx) ? 0u : v[i];
            if (mx != 0u && rd < 16 - nforced) { const int js = 127 - (int)(mx & 127u);
#pragma unroll
                for (int wd = 0; wd < 4; ++wd) selm[wd] |= ((js >> 5) == wd) ? (1u << (js & 31)) : 0u; }
        }
    }
    unsigned un[4];
#pragma unroll
    for (int wd = 0; wd < 4; ++wd) { unsigned x = selm[wd]; x |= dpp_u<DPP_XOR1>(x); x |= dpp_u<DPP_XOR2>(x); x |= dpp_u<DPP_HMIR>(x); x |= dpp_u<DPP_MIR>(x); un[wd] = (unsigned)__builtin_amdgcn_readfirstlane((int)x); }
    if (lane < 4) __hip_atomic_fetch_or(wun + lane, lane == 0 ? un[0] : lane == 1 ? un[1] : lane == 2 ? un[2] : un[3], __ATOMIC_RELAXED, __HIP_MEMORY_SCOPE_WORKGROUP);
    __syncthreads();
    unsigned wu[4];
#pragma unroll
    for (int wd = 0; wd < 4; ++wd) wu[wd] = (unsigned)__builtin_amdgcn_readfirstlane((int)wun[wd]);
    {
        nsa_zero<4>(O, m, l);
        const bf16* Ks = WSP(bf16, WS_KSEL) + (size_t)bg * PT * 64; const bf16* Vs = WSP(bf16, WS_VSELT) + (size_t)bg * 64 * PT;
        const int nsb = __builtin_popcount(wu[0]) + __builtin_popcount(wu[1]) + __builtin_popcount(wu[2]) + __builtin_popcount(wu[3]);
        if (F.tid < 128) { const int j = F.tid, wj = j >> 5, bj = j & 31; const unsigned ww = wj == 0 ? wu[0] : wj == 1 ? wu[1] : wj == 2 ? wu[2] : wu[3];
            if ((ww >> bj) & 1u) { int pos = __builtin_popcount(ww & ((1u << bj) - 1u)); if (wj > 0) pos += __builtin_popcount(wu[0]); if (wj > 1) pos += __builtin_popcount(wu[1]); if (wj > 2) pos += __builtin_popcount(wu[2]);
                blist[pos] = (unsigned char)j; } }
        __syncthreads();
#define NW_SBLK(i) (64 * (int)blist[(i)])
#define NW_SEL(buf, k0) { const int j_ = (k0) >> 6, wj_ = j_ >> 5, bj_ = j_ & 31; const unsigned uw_ = wj_ == 0 ? un[0] : wj_ == 1 ? un[1] : wj_ == 2 ? un[2] : un[3]; \
            if ((uw_ >> bj_) & 1u) { const unsigned mine_ = wj_ == 0 ? selm[0] : wj_ == 1 ? selm[1] : wj_ == 2 ? selm[2] : selm[3]; const bool ok_ = (mine_ >> bj_) & 1u; \
                _Pragma("unroll 1") for (int th = 0; th < 2; ++th) { KvFrags f; nw_frags<true>(buf, th, fr, fq, f); \
                    nsa_core<4, 0, true>(f, (k0) + 32 * th, nullptr, 0, O, m, l, invl, slope, t, 1, 0, 1 << 30, ok_, imp, fq, qreg); } } }
        NW_PIPE(Ks, Vs, PT, nsb, NW_SBLK, NW_SEL);
#pragma unroll
        for (int nt = 0; nt < 4; ++nt) { const float lt = x32_sum(x16_sum(l[nt])); const float sc = gates[1 * 16 + g * 4 + nt] / fmaxf(lt, 1e-30f);
#pragma unroll
            for (int dt = 0; dt < 4; ++dt) { f32x4* o = (f32x4*)(oacc + (g * 4 + nt) * 64 + 16 * dt + 4 * fq); *o = *o + O[nt][dt] * sc; } }
    }
    {
        nsa_zero<4>(O, m, l);
        const bf16* Kw = WSP(bf16, WS_KWIN) + (size_t)bg * PT * 64; const bf16* Vw = WSP(bf16, WS_VWINT) + (size_t)bg * 64 * PT;
        const int lo = 128 * qb - (WINDOW - 1), kb0 = (lo > 0 ? lo : 0) >> 6, kb1 = (128 * qb + 127) >> 6, nwb = kb1 - kb0 + 1;
#define NW_WBLK(i) (64 * (kb0 + (i)))
#define NW_WIN(buf, k0) { _Pragma("unroll 1") for (int th = 0; th < 2; ++th) { const int kk_ = (k0) + 32 * th; if (kk_ <= tw1 && kk_ + 31 >= tw0 - (WINDOW - 1)) { KvFrags f; nw_frags<true>(buf, th, fr, fq, f); \
                nsa_core<4, 0, true>(f, kk_, nullptr, 0, O, m, l, invl, slope, t, 1, 0, WINDOW, true, imp, fq, qreg); } } }
        NW_PIPE(Kw, Vw, PT, nwb, NW_WBLK, NW_WIN);
        bf16* on = WSP(bf16, WS_OG) + (size_t)row * 1024;
#pragma unroll
        for (int nt = 0; nt < 4; ++nt) { const float lt = x32_sum(x16_sum(l[nt])); const float sc = gates[2 * 16 + g * 4 + nt] / fmaxf(lt, 1e-30f);
#pragma unroll
            for (int dt = 0; dt < 4; ++dt) { const f32x4 o = *(const f32x4*)(oacc + (g * 4 + nt) * 64 + 16 * dt + 4 * fq) + O[nt][dt] * sc;
                *(v2u*)(on + (g * 4 + nt) * 64 + 16 * dt + 4 * fq) = (v2u){pk2(o[0], o[1]), pk2(o[2], o[3])}; } }
    }
    __syncthreads();
}

constexpr int SW_Q = 0;
constexpr int SW_IMPP = 2304;
constexpr int SW_IMPT = SW_IMPP + 8 * 2112;
constexpr int SW_LP = SW_IMPT + 2112;
constexpr int SW_OP = SW_LP + 3 * 8 * 16 * 4;
static_assert(SW_OP + 8 * 3 * 16 * 64 * 4 <= RING_BYTES, "sample NSA LDS map");
__device__ __forceinline__ void nsa_sample_wg(Frame& F, int id) {
    int lane_ = F.lane; asm volatile("" : "+v"(lane_));
    const int lane = lane_, fr = lane & 15, fq = lane >> 4, w = F.wave, g = id & 3, bs = id >> 2;
    LAS unsigned char* L = F.lds; asm volatile("" : "+v"(L));
    LAS bf16* qw = (LAS bf16*)(L + SW_Q);
    LAS float* impP = (LAS float*)(L + SW_IMPP) + w * 528; LAS float* impT = (LAS float*)(L + SW_IMPT);
    LAS float* LP = (LAS float*)(L + SW_LP); LAS float* OP = (LAS float*)(L + SW_OP);
    const int t = PAST + (fr >> 2), row0 = MP + bs * 4, trow = fr >> 2, hd = g * 4 + (fr & 3);
    if (F.tid < 128) { const int rr = F.tid >> 3, c8 = F.tid & 7;
        *(LAS v4u*)(qw + rr * NSA_QLD + 8 * c8) = *(const v4u*)(WSP(bf16, WS_QN) + (size_t)(row0 + (rr >> 2)) * 1024 + (g * 4 + (rr & 3)) * 64 + 8 * c8); }
    for (int i = lane; i < 528; i += 64) impP[i] = 0.f;
    __syncthreads();
    float slope[1] = {ex2(-0.5f * (float)(hd + 1)) * LOG2E};
    const LAS bf16* qrow = qw + fr * NSA_QLD;
    f32x4 O[1][4]; float m[1], l[1], invl[1] = {0.f};
#define SW_PUT_O(br) { _Pragma("unroll") for (int dt = 0; dt < 4; ++dt) *(LAS f32x4*)(OP + ((w * 3 + (br)) * 16 + fr) * 64 + 16 * dt + 4 * fq) = O[0][dt]; }
#define SW_PUT_L(br) { const float lt_ = x32_sum(x16_sum(l[0])); if (fq == 0) LP[((br) * 8 + w) * 16 + fr] = lt_; }
    {
        KvBf16 kv{WSP(bf16, WS_SKCMP) + (size_t)id * 512 * 64, WSP(bf16, WS_SVCMPT) + (size_t)id * 64 * 512, 512};
        nsa_zero<1>(O, m, l);
#pragma unroll 1
        for (int tl = w; tl < 16; tl += 8) nsa_tile<1, 1>(kv, 32 * tl, qrow, 0, O, m, l, invl, slope, t, 16, 31, 1 << 30, true, impP + trow * 132, fr, fq);
        SW_PUT_L(0)
        __syncthreads();
        { float lt = 0.f;
#pragma unroll
          for (int ww = 0; ww < 8; ++ww) lt += LP[(0 * 8 + ww) * 16 + fr];
          invl[0] = lt > 0.f ? 1.f / lt : 0.f; }
#pragma unroll 1
        for (int tl = w; tl < 16; tl += 8) nsa_tile<1, 2>(kv, 32 * tl, qrow, 0, O, m, l, invl, slope, t, 16, 31, 1 << 30, true, impP + trow * 132, fr, fq);
        SW_PUT_O(0)
    }
    __syncthreads();
    for (int i = F.tid; i < 528; i += 512) { float s = 0.f;
#pragma unroll
        for (int ww = 0; ww < 8; ++ww) s += ((LAS float*)(L + SW_IMPP))[ww * 528 + i];
        impT[i] = s; }
    __syncthreads();
    unsigned selm[4] = {1u, 0u, 0u, 1u << 31};
    {
        const int li = (fr & 3) * 4 + fq;
        unsigned v[8];
#pragma unroll
        for (int i = 0; i < 8; ++i) { const int j = li * 8 + i; v[i] = (j >= 1 && j <= 126) ? (((f2u(impT[trow * 132 + j]) & ~127u) | (unsigned)(127 - j)) + 128u) : 0u; }
#pragma unroll 1
        for (int rd = 0; rd < 13; ++rd) {
            unsigned mx = v[0];
#pragma unroll
            for (int i = 1; i < 8; ++i) mx = mx > v[i] ? mx : v[i];
            { unsigned o = dpp_u<DPP_XOR1>(mx); mx = mx > o ? mx : o; o = dpp_u<DPP_XOR2>(mx); mx = mx > o ? mx : o; mx = x32_umax(x16_umax(mx)); }
#pragma unroll
            for (int i = 0; i < 8; ++i) v[i] = (v[i] == mx) ? 0u : v[i];
            if (mx != 0u) { const int js = 127 - (int)(mx & 127u);
#pragma unroll
                for (int wd = 0; wd < 4; ++wd) selm[wd] |= ((js >> 5) == wd) ? (1u << (js & 31)) : 0u; }
        }
    }
    {
        nsa_zero<1>(O, m, l);
        unsigned un[4];
#pragma unroll
        for (int wd = 0; wd < 4; ++wd) { unsigned x = selm[wd]; x |= dpp_u<DPP_XOR1>(x); x |= dpp_u<DPP_XOR2>(x); x |= dpp_u<DPP_HMIR>(x); x |= dpp_u<DPP_MIR>(x); un[wd] = (unsigned)__builtin_amdgcn_readfirstlane((int)x); }
        KvSampleSel kvs{FIN(2) + g * 64, (const int*)FIN(6) + bs * NPAGES, WSP(float, WS_SNEW) + (size_t)bs * 2048 + g * 64, g};
        int q = 0;
#pragma unroll 1
        for (int wd = 0; wd < 4; ++wd) {
            unsigned mm = un[wd];
            const unsigned mine = wd == 0 ? selm[0] : wd == 1 ? selm[1] : wd == 2 ? selm[2] : selm[3];
            while (mm) {
                const int bit = __builtin_ctz(mm); mm &= mm - 1u; const int j = 32 * wd + bit;
                const bool ok = (mine >> bit) & 1u;
#pragma unroll 1
                for (int hh = 0; hh < 2; ++hh, ++q) if ((q & 7) == w) { nsa_tile<1, 0>(kvs, 64 * j + 32 * hh, qrow, 0, O, m, l, invl, slope, t, 1, 0, 1 << 30, ok, impP, fr, fq); __builtin_amdgcn_sched_barrier(0); }
            }
        }
        if ((q & 7) == w) nsa_tile<1, 0>(kvs, 64 * 128, qrow, 0, O, m, l, invl, slope, t, 1, 0, 1 << 30, true, impP, fr, fq);
        SW_PUT_O(1) SW_PUT_L(1)
    }
    {
        nsa_zero<1>(O, m, l);
        KvBf16 kv{WSP(bf16, WS_SKWIN) + (size_t)id * 544 * 64, WSP(bf16, WS_SVWINT) + (size_t)id * 64 * 544, 544};
#pragma unroll 1
        for (int kk = 32 * w; kk < 544; kk += 256) nsa_tile<1, 0>(kv, kk, qrow, 0, O, m, l, invl, slope, t, 1, PAST - WINDOW, WINDOW, true, impP, fr, fq);
        SW_PUT_O(2) SW_PUT_L(2)
    }
    __syncthreads();
    {
        const int r = F.tid >> 5, d0 = (F.tid & 31) * 2, rowg = row0 + (r >> 2), hdr = g * 4 + (r & 3);
        float o0 = 0.f, o1 = 0.f;
#pragma unroll
        for (int br = 0; br < 3; ++br) { float a0 = 0.f, a1 = 0.f, lt = 0.f;
#pragma unroll
            for (int ww = 0; ww < 8; ++ww) { const f32x2 x = *(const LAS f32x2*)(OP + ((ww * 3 + br) * 16 + r) * 64 + d0); a0 += x.x; a1 += x.y; if (br > 0) lt += LP[(br * 8 + ww) * 16 + r]; }
            const float sc = WSP(float, WS_GATES)[(size_t)rowg * 48 + br * 16 + hdr] * (br == 0 ? 1.f : 1.f / fmaxf(lt, 1e-30f));
            o0 += a0 * sc; o1 += a1 * sc; }
        *(unsigned*)(WSP(bf16, WS_OG) + (size_t)rowg * 1024 + hdr * 64 + d0) = pk2(o0, o1);
    }
    __syncthreads();
#undef SW_PUT_O
#undef SW_PUT_L
}


#ifndef MK_SINGLE
#define MK_SINGLE 1
#endif
constexpr int NPHASE = 21;
struct Args { const float* in[29]; float* out; unsigned char* ws; int ph_lo, ph_hi; };
static_assert(sizeof(Args) == 31 * 8 + 8, "Args has no padding");

__global__ void __launch_bounds__(512, 2) mk_fwd(Args args) {
    extern __shared__ __attribute__((aligned(16))) unsigned char lds_raw[];
    Frame F;
    F.lds = (LAS unsigned char*)lds_raw;
    F.tid = threadIdx.x; F.lane = F.tid & 63; F.wave = __builtin_amdgcn_readfirstlane(F.tid >> 6);
    F.G = gridDim.x; F.bid = blockIdx.x;
    F.ka = (const __attribute__((address_space(4))) char*)__builtin_amdgcn_kernarg_segment_ptr();
    F.out = args.out; F.ws = args.ws;
    volatile LAS unsigned* MISC = (volatile LAS unsigned*)(F.lds + MISC_OFF);
    for (int u = F.tid; u < (LDS_BYTES - LDSCTL_OFF) / 4; u += 512) ((LAS unsigned*)(F.lds + LDSCTL_OFF))[u] = 0u;
    __syncthreads();
    unsigned* barw = (unsigned*)(F.ws + WS_CTL) + 4096;
    XcdBarrier bar; bar.bar = barw; bar.x = 0; bar.st = nullptr;
    const int lo = args.ph_lo, hi = args.ph_hi;
    if (hi - lo > 1) bar = xcd_barrier_post(barw, MISC + 8);
#ifndef PH_MASK
#define PH_MASK 0xFFFFFFFFu
#endif
#define IN(k) (((PH_MASK >> (k)) & 1u) && lo <= (k) && (k) < hi)
#define SEAM(k) do { if (IN(k) && IN((k) + 1)) xcd_barrier(bar); } while (0)
    const int gw = F.bid * 8 + F.wave, NGW = F.G * 8;

#ifndef REPX
#define REPX 0
#endif
#ifndef REPY
#define REPY 0
#endif
#ifndef REP_MASK
#define REP_MASK 0u
#endif
#define PHASE(k, ...) if (IN(k)) { _Pragma("unroll 1") for (int rep_ = 0; rep_ < (int)((REP_MASK >> (k)) & 1u) + 1; ++rep_) { if (rep_) xcd_barrier(bar); __VA_ARGS__ } } SEAM(k);
    PHASE(0, p0_prologue(F);)
    if (IN(1) && F.G != 256) { for (int task = F.bid; task < 512; task += F.G) fs_direct_task(F, task); }
    if (IN(1) && IN(2) && F.G != 256) xcd_barrier(bar);
    PHASE(2, gemm_all(F, WSP(bf16, WS_XNA), WSP(bf16, WS_WIN_T), 4096, FnBf16{WSP(bf16, WS_PROJ), 4096});)
    PHASE(3, for (int u = F.bid; u < 2048 + 256; u += F.G) { if (u < 2048) p2_chunk(F, u); else p2_sample(F, u - 2048); })
    PHASE(4, if (F.G == 256) { const int x = F.bid & 7, idx = F.bid >> 3;
                 if (idx < 8) p3_scan(F, x * 2 + (idx >> 2), idx & 3);
                 else { const int j = (idx - 8) * 8 + x;
                        const size_t n8 = (size_t)2 * NEXP * DM / 8; const int p0 = j < 128 ? 6 * j : 768 + 13 * (j - 128), p1 = p0 + (j < 128 ? 6 : 13);
                        peer_tables_to_fp8(F, (size_t)F.tid, (size_t)512, n8 * p0 / 1600, n8 * p1 / 1600);
                        __syncthreads();
                        for (int task = j; task < 512; task += 192) fs_direct_task(F, task); } }
             else { for (int u = F.bid; u < 64; u += F.G) p3_scan(F, u >> 2, u & 3); })
    PHASE(5, p4_rows(F, gw, NGW);
             for (int id = gw; id < 8192; id += NGW) compress_sample(F, id);)
    PHASE(6, gemm_all(F, WSP(bf16, WS_OG), WSP(bf16, WS_WOA_T), 1024, FnResid{WSP(float, WS_XS), FIN(0), FIN(1)});)
    PHASE(7, for (int r = gw; r < MTOK; r += NGW) rms_row_to_bf16(WSP(float, WS_XS) + (size_t)r * DM, WSP(bf16, WS_XNB) + (size_t)r * DM, F.lane);)
    PHASE(8, gemm_all(F, WSP(bf16, WS_XNB), WSP(bf16, WS_WPQ_T), 2048, FnBf16{WSP(bf16, WS_QPEER), 2048});)
    PHASE(9, p8_phase(F, 0);)
    int pg_slice = F.bid & 7, pg_first = (F.bid >> 3) * 8 + F.wave, pg_stride = ((F.G - (F.bid & 7) + 7) >> 3) * 8;
#define PEER_GROUPS() do { if (MISC[8 + 3] != 0u && (F.G & 7) == 0) { const unsigned c_ = xb_ld(&barw[XB_XCNT(F.lane & 15)]); const bool ok_ = (F.lane & 15) < 8 ? c_ == (unsigned)(F.G >> 3) : c_ == 0u; \
        if (__builtin_amdgcn_ballot_w64(ok_) == ~0ull && bar.x < 8u) { pg_slice = (int)bar.x; pg_first = (int)MISC[8 + 2] * 8 + F.wave; pg_stride = F.G; } } } while (0)
    PHASE(10, PEER_GROUPS(); p9u_wave(F, 0, pg_slice, pg_first, pg_stride);)
    PHASE(11, PEER_GROUPS(); p9v_wave(F, 0, pg_slice, pg_first, pg_stride, 0);)
    PHASE(12, gemm_all(F, WSP(bf16, WS_XNA), WSP(bf16, WS_WKVQ_T), NKVQ, FnKvq{WSP(bf16, WS_KVQ), WSP(float, WS_SSQ)});)
    PHASE(13, for (int u = F.bid; u < 256; u += F.G) pp_prompt_tile(F, u);
              if (F.G == 256) { compress_prompt_split(F, F.bid * 2 + (F.wave >> 2)); if (F.wave == 7 && F.bid < MS) pp_sample_row(F, F.bid); }
              else { for (int r = gw; r < MS; r += NGW) pp_sample_row(F, r); for (int id = gw; id < 512; id += NGW) compress_prompt(F, id); })
    PHASE(14, if (F.G == 256) {
                  _Pragma("unroll 1") for (int q_ = 0; q_ < 1 + REPX; ++q_) { if (F.bid < 128) nsa_sample_wg(F, F.bid); }
                  __syncthreads();
                  { const int i_ = F.bid >> 3;
                    if (i_ < 16) { nsa_wg(F, F.bid & 7, i_); nsa_wg(F, F.bid & 7, 31 - i_); } else { nsa_wg(F, F.bid & 7, 16 + i_); nsa_wg(F, F.bid & 7, 79 - i_); } }
              } else { for (int id = gw; id < 128 + 4096; id += NGW) { if (id < 128) nsa_unit<true>(F, id); else nsa_unit<false>(F, id - 128); } })
    PHASE(15, gemm_all(F, WSP(bf16, WS_OG), WSP(bf16, WS_WOB_T), 1024, FnResid{WSP(float, WS_XS), WSP(float, WS_XS), WSP(float, WS_XS) + (size_t)MP * DM});)
    PHASE(16, for (int r = gw; r < MTOK; r += NGW) rms_row_to_bf16(WSP(float, WS_XS) + (size_t)r * DM, WSP(bf16, WS_XNB) + (size_t)r * DM, F.lane);)
    PHASE(17, gemm_all(F, WSP(bf16, WS_XNB), WSP(bf16, WS_WPQ_T) + (size_t)2048 * 1024, 2048, FnBf16{WSP(bf16, WS_QPEER), 2048});)
    PHASE(18, p8_phase(F, 1);)
    PHASE(19, PEER_GROUPS(); p9u_wave(F, 1, pg_slice, pg_first, pg_stride);)
    PHASE(20, PEER_GROUPS(); p9v_wave(F, 1, pg_slice, pg_first, pg_stride, 1);)
#undef IN
#undef SEAM
}

extern "C" void kernel_launch(void* const* d_in, const int* in_sizes, int n_in, void* d_out, int out_size, void* d_ws, size_t ws_size, hipStream_t stream) {
    static int grid = 0;
    if (grid == 0) {
        if (n_in != 29 || (size_t)out_size != O_END || ws_size < WS_END) { fprintf(stderr, "kernel_launch: unexpected shapes n_in %d out %d ws %zu (need %zu)\n", n_in, out_size, ws_size, (size_t)WS_END); grid = -1; return; }
        int dev = 0, cus = 0, per_cu = 0;
        if (hipGetDevice(&dev) != hipSuccess || hipDeviceGetAttribute(&cus, hipDeviceAttributeMultiprocessorCount, dev) != hipSuccess) { grid = -1; return; }
        if (hipFuncSetAttribute((const void*)mk_fwd, hipFuncAttributeMaxDynamicSharedMemorySize, LDS_BYTES) != hipSuccess) { fprintf(stderr, "kernel_launch: hipFuncSetAttribute failed\n"); grid = -1; return; }
        if (hipOccupancyMaxActiveBlocksPerMultiprocessor(&per_cu, (const void*)mk_fwd, 512, LDS_BYTES) != hipSuccess || per_cu < 1) fprintf(stderr, "kernel_launch: occupancy query reports %d\n", per_cu);
        (void)hipGetLastError();
        grid = cus;
    }
    if (grid < 0) return;
    if (hipMemsetAsync((char*)d_ws + WS_CTL, 0, CTL_BYTES, stream) != hipSuccess) return;
    Args a{};
    for (int i = 0; i < 29; ++i) a.in[i] = (const float*)d_in[i];
    a.out = (float*)d_out; a.ws = (unsigned char*)d_ws;
#if MK_SINGLE
    a.ph_lo = 0; a.ph_hi = NPHASE;
    hipLaunchKernelGGL(mk_fwd, dim3(grid), dim3(512), LDS_BYTES, stream, a);
#else
    for (int p = 0; p < NPHASE; ++p) { a.ph_lo = p; a.ph_hi = p + 1; hipLaunchKernelGGL(mk_fwd, dim3(grid), dim3(512), LDS_BYTES, stream, a); }
#endif
    const hipError_t le = hipPeekAtLastError();
    if (le != hipSuccess) fprintf(stderr, "kernel_launch: launch failed: %s\n", hipGetErrorName(le));
}
```

```cpp
#include <hip/hip_runtime.h>
#include <cstdio>
#include <cstdint>

constexpr int DM = 1024, PB = 2, PT = 8192, SB = 32, SL = 4, PAST = 8192, PAGE = 128;
constexpr int MP = PB * PT;
constexpr int MS = SB * SL;
constexpr int MTOK = MP + MS;
constexpr int GH = 8, GDK = 128, GDV = 128, GCONV = 3072, GPROJ = 4112, CHUNK = 64, NCH = PT / CHUNK;
constexpr int NH = 16, NG = 4, HPG = 4, DH = 64, NQG = 1072, NKV = 1536, NKVQ = 2816, NKVQ_REAL = 2608;
constexpr int WINDOW = 512, NSELP = 128, NSELS = 129, NCMP = 511;
constexpr int PEH = 8, PEDQ = 256, PEHALF = 128, NKEYS = 128, NEXP = 16384, PETOP = 16;
constexpr int NPAGES = PAST / PAGE;
constexpr float EPS = 1e-6f;

constexpr size_t O_YP = 0;
constexpr size_t O_YS = O_YP + (size_t)MP * DM;
constexpr size_t O_KVP = O_YS + (size_t)MS * DM;
constexpr size_t O_WINP = O_KVP + (size_t)MP * 1024;
constexpr size_t O_GDNP = O_WINP + (size_t)PB * 512 * 512;
constexpr size_t O_CONVP = O_GDNP + (size_t)PB * GH * 128 * 128;
constexpr size_t O_KVS = O_CONVP + (size_t)PB * 3 * GCONV;
constexpr size_t O_WINS = O_KVS + (size_t)MS * 1024;
constexpr size_t O_GDNS = O_WINS + (size_t)SB * 512 * 512;
constexpr size_t O_CONVS = O_GDNS + (size_t)SB * GH * 128 * 128;
constexpr size_t O_END = O_CONVS + (size_t)SB * 3 * GCONV;

constexpr size_t MiB = 1u << 20;
constexpr size_t al(size_t x) { return (x + 4095) & ~(size_t)4095; }
constexpr size_t WS_CTL = 0, CTL_BYTES = 1 * MiB;
constexpr size_t WS_WIN_T = WS_CTL + CTL_BYTES;
constexpr size_t WS_WOA_T = WS_WIN_T + (size_t)4096 * 1024 * 2;
constexpr size_t WS_WKVQ_T = WS_WOA_T + (size_t)1024 * 1024 * 2;
constexpr size_t WS_WOB_T = WS_WKVQ_T + (size_t)NKVQ * 1024 * 2;
constexpr size_t WS_WPQ_T = WS_WOB_T + (size_t)1024 * 1024 * 2;
constexpr size_t WS_WAB = WS_WPQ_T + (size_t)2 * 2048 * 1024 * 2;
constexpr size_t WS_SUBK = WS_WAB + (size_t)16 * 1024 * 4;
constexpr size_t WS_W1T = WS_SUBK + (size_t)2 * 8 * 2 * 128 * 128 * 2;
constexpr size_t WS_PETERM = WS_W1T + (size_t)2 * 128 * 1024 * 2;
constexpr size_t WS_PU = al(WS_PETERM + 512);
constexpr size_t WS_PV = WS_PU + (size_t)2 * NEXP * DM * 2;
constexpr size_t WS_XNA = WS_PV + (size_t)2 * NEXP * DM * 2;
constexpr size_t WS_XNB = al(WS_XNA + (size_t)MTOK * DM * 2);
constexpr size_t WS_PROJ = al(WS_XNB + (size_t)MTOK * DM * 2);
constexpr size_t WS_GW = al(WS_PROJ + (size_t)MTOK * 4096 * 2);
constexpr size_t WS_GQ = WS_GW + (size_t)2048 * 64 * 128 * 2;
constexpr size_t WS_GKT = WS_GQ + (size_t)2048 * 64 * 128 * 2;
constexpr size_t WS_GQK = WS_GKT + (size_t)2048 * 64 * 128 * 2;
constexpr size_t WS_GU = WS_GQK + (size_t)2048 * 64 * 64 * 2;
constexpr size_t WS_GDEC = WS_GU + (size_t)2048 * 64 * 128 * 4;
constexpr size_t WS_OGDN = al(WS_GDEC + 2048 * 4);
constexpr size_t WS_OG = al(WS_OGDN + (size_t)MTOK * DM * 4);
constexpr size_t WS_XS = al(WS_OG + (size_t)MTOK * DM * 2);
constexpr size_t WS_QPEER = al(WS_XS + (size_t)MTOK * DM * 4);
constexpr size_t WS_PEI = al(WS_QPEER + (size_t)MTOK * 2048 * 2);
constexpr size_t WS_PEG = al(WS_PEI + (size_t)MTOK * 128 * 4);
constexpr size_t WS_KVQ = al(WS_PEG + (size_t)MTOK * 128 * 4);
constexpr size_t WS_KSEL = al(WS_KVQ + (size_t)MTOK * NKVQ * 4);
constexpr size_t WS_VSELT = WS_KSEL + (size_t)PB * NG * PT * 64 * 2;
constexpr size_t WS_KWIN = WS_VSELT + (size_t)PB * NG * PT * 64 * 2;
constexpr size_t WS_VWINT = WS_KWIN + (size_t)PB * NG * PT * 64 * 2;
constexpr size_t WS_KCMP = WS_VWINT + (size_t)PB * NG * PT * 64 * 2;
constexpr size_t WS_VCMPT = WS_KCMP + (size_t)PB * NG * 512 * 64 * 2;
constexpr size_t WS_SKCMP = WS_VCMPT + (size_t)PB * NG * 512 * 64 * 2;
constexpr size_t WS_SVCMPT = WS_SKCMP + (size_t)SB * NG * 512 * 64 * 2;
constexpr size_t WS_SKWIN = WS_SVCMPT + (size_t)SB * NG * 512 * 64 * 2;
constexpr size_t WS_SVWINT = WS_SKWIN + (size_t)SB * NG * 544 * 64 * 2;
constexpr size_t WS_SNEW = WS_SVWINT + (size_t)SB * NG * 544 * 64 * 2;
constexpr size_t WS_QN = al(WS_SNEW + (size_t)SB * 4 * 2 * 4 * 64 * 4);
constexpr size_t WS_GATES = al(WS_QN + (size_t)MTOK * 1024 * 2);
constexpr size_t WS_OACC = al(WS_GATES + (size_t)MTOK * 48 * 4);
constexpr size_t WS_CKA = al(WS_OACC + (size_t)MTOK * DM * 4);
constexpr size_t WS_W1BD = al(WS_CKA + (size_t)65536 * 2048 * 2);
constexpr size_t WS_FS = al(WS_W1BD + (size_t)256 * 2048 * 2);
constexpr size_t WS_PA = al(WS_FS + (size_t)65536 * 256 * 4);
constexpr size_t WS_SSQ = al(WS_PA + (size_t)MTOK * 8 * 64 * 4);
constexpr size_t WS_W2F = al(WS_SSQ + (size_t)MTOK * 8 * 4);
constexpr size_t WS_END = al(WS_W2F + 2 * 4 * 2 * 64 * 8 * 2);

constexpr int RING_BYTES = 143360;
constexpr int LDSCTL_OFF = RING_BYTES, MISC_OFF = LDSCTL_OFF + 320;
constexpr int LDS_BYTES = 147456;

#define GAS __attribute__((address_space(1)))
#define LAS __attribute__((address_space(3)))
typedef unsigned short bf16;
typedef unsigned v4u __attribute__((ext_vector_type(4)));
typedef unsigned v2u __attribute__((ext_vector_type(2)));
typedef float f32x4 __attribute__((ext_vector_type(4)));
typedef float f32x2 __attribute__((ext_vector_type(2)));
typedef short bf16x8 __attribute__((ext_vector_type(8)));
typedef GAS unsigned gu32;
#define RLX_AGENT __ATOMIC_RELAXED, __HIP_MEMORY_SCOPE_AGENT
#define LDS_WAIT() asm volatile("s_waitcnt lgkmcnt(0)" ::: "memory")
#define VM_WAIT() asm volatile("s_waitcnt vmcnt(0)" ::: "memory")

__device__ __forceinline__ unsigned f2bf(float f) { unsigned u = __builtin_bit_cast(unsigned, f); return (u + 0x7fffu + ((u >> 16) & 1u)) >> 16; }
typedef __bf16 hwbf16x2 __attribute__((ext_vector_type(2)));
__device__ __forceinline__ unsigned pk2(float lo, float hi) { const f32x2 v = {lo, hi}; return __builtin_bit_cast(unsigned, __builtin_convertvector(v, hwbf16x2)); }
__device__ __forceinline__ float bf2f(unsigned b) { return __builtin_bit_cast(float, b << 16); }
__device__ __forceinline__ float bflo(unsigned w) { return __builtin_bit_cast(float, w << 16); }
__device__ __forceinline__ float bfhi(unsigned w) { return __builtin_bit_cast(float, w & 0xffff0000u); }
#ifndef USE_PERMSWAP
#define USE_PERMSWAP 1
#endif
template <int CTRL> __device__ __forceinline__ float dpp_f(float x) { return __builtin_bit_cast(float, __builtin_amdgcn_update_dpp(0, __builtin_bit_cast(int, x), CTRL, 0xF, 0xF, true)); }
template <int CTRL> __device__ __forceinline__ unsigned dpp_u(unsigned x) { return (unsigned)__builtin_amdgcn_update_dpp(0, (int)x, CTRL, 0xF, 0xF, true); }
#define DPP_XOR1 0xB1
#define DPP_XOR2 0x4E
#define DPP_HMIR 0x141
#define DPP_MIR 0x140
#define DPP_ROR4 0x124
#define DPP_ROR8 0x128
#if USE_PERMSWAP
#define PSWAP16(a, b) asm volatile("s_nop 1\n\tv_permlane16_swap_b32 %0, %1" : "+v"(a), "+v"(b))
#define PSWAP32(a, b) asm volatile("s_nop 1\n\tv_permlane32_swap_b32 %0, %1" : "+v"(a), "+v"(b))
__device__ __forceinline__ float x16_sum(float x) { unsigned a = __builtin_bit_cast(unsigned, x), b = a; PSWAP16(a, b); return __builtin_bit_cast(float, a) + __builtin_bit_cast(float, b); }
__device__ __forceinline__ float x32_sum(float x) { unsigned a = __builtin_bit_cast(unsigned, x), b = a; PSWAP32(a, b); return __builtin_bit_cast(float, a) + __builtin_bit_cast(float, b); }
__device__ __forceinline__ float x16_max(float x) { unsigned a = __builtin_bit_cast(unsigned, x), b = a; PSWAP16(a, b); return fmaxf(__builtin_bit_cast(float, a), __builtin_bit_cast(float, b)); }
__device__ __forceinline__ float x32_max(float x) { unsigned a = __builtin_bit_cast(unsigned, x), b = a; PSWAP32(a, b); return fmaxf(__builtin_bit_cast(float, a), __builtin_bit_cast(float, b)); }
__device__ __forceinline__ unsigned x16_umax(unsigned u) { unsigned a = u, b = u; PSWAP16(a, b); return a > b ? a : b; }
__device__ __forceinline__ unsigned x32_umax(unsigned u) { unsigned a = u, b = u; PSWAP32(a, b); return a > b ? a : b; }
#else
__device__ __forceinline__ float x16_sum(float x) { return x + __shfl_xor(x, 16); }
__device__ __forceinline__ float x32_sum(float x) { return x + __shfl_xor(x, 32); }
__device__ __forceinline__ float x16_max(float x) { return fmaxf(x, __shfl_xor(x, 16)); }
__device__ __forceinline__ float x32_max(float x) { return fmaxf(x, __shfl_xor(x, 32)); }
__device__ __forceinline__ unsigned x16_umax(unsigned u) { const unsigned o = __shfl_xor(u, 16); return u > o ? u : o; }
__device__ __forceinline__ unsigned x32_umax(unsigned u) { const unsigned o = __shfl_xor(u, 32); return u > o ? u : o; }
#endif
__device__ __forceinline__ float row_sum16(float x) { x += dpp_f<DPP_XOR1>(x); x += dpp_f<DPP_XOR2>(x); x += dpp_f<DPP_HMIR>(x); x += dpp_f<DPP_MIR>(x); return x; }
__device__ __forceinline__ float wave_sum(float v) { return x32_sum(x16_sum(row_sum16(v))); }
__device__ __forceinline__ float frcp(float x) { return __builtin_amdgcn_rcpf(x); }
__device__ __forceinline__ float frsq(float x) { return __builtin_amdgcn_rsqf(x); }
__device__ __forceinline__ float silu_f(float x) { return x * frcp(1.f + __expf(-x)); }
__device__ __forceinline__ float sigmoid_f(float x) { return frcp(1.f + __expf(-x)); }
__device__ __forceinline__ float gelu_tanh(float x) {
    const float u = 0.7978845608028654f * (x + 0.044715f * x * x * x);
    const float e = __expf(2.f * u);
    const float th = 1.f - 2.f * frcp(e + 1.f);
    return 0.5f * x * (1.f + th);
}
__device__ __forceinline__ bf16x8 ld8(const bf16* p) { return *(const bf16x8*)p; }
__device__ __forceinline__ bf16x8 ld8l(const LAS bf16* p) { return *(const LAS bf16x8*)p; }
#define MFMA16(a, b, c) __builtin_amdgcn_mfma_f32_16x16x32_bf16((a), (b), (c), 0, 0, 0)
__device__ __forceinline__ bf16x8 cvt8(f32x4 a, f32x4 b) {
    v4u r; r.x = pk2(a.x, a.y); r.y = pk2(a.z, a.w); r.z = pk2(b.x, b.y); r.w = pk2(b.z, b.w); return __builtin_bit_cast(bf16x8, r);
}

struct Frame {
    LAS unsigned char* lds;
    int tid, lane, wave, G, bid;
    const __attribute__((address_space(4))) char* ka;
    float* out;
    unsigned char* ws;
};
#define WSP(T, off) ((T*)(F.ws + (off)))
__device__ __forceinline__ const float* fin_(const __attribute__((address_space(4))) char* ka, int i) {
    const __attribute__((address_space(4))) char* p = ka; asm volatile("" : "+s"(p));
    return *(const float* const __attribute__((address_space(4)))*)(p + 8 * i);
}
#define FIN(i) fin_(F.ka, (i))
namespace pg8 {
#define PG8_LAS __attribute__((address_space(3)))
typedef unsigned short bf16_t;
typedef short bf16x8 __attribute__((ext_vector_type(8)));
typedef float f32x4 __attribute__((ext_vector_type(4)));
typedef unsigned u32x4 __attribute__((ext_vector_type(4)));
constexpr int BM = 256, BK = 64, HALF = 128, HTB = HALF * BK * 2  , STAGE_BYTES = 8 * HTB, NXCD = 8, WGM = 8;

__host__ __device__ __forceinline__ int lds_byte(int r, int c) { const int st = (r >> 4) * 2 + (c >> 5), rr = r & 15, cc = c & 31, ob = rr * 64 + cc * 2; return st * 1024 + (ob ^ (((ob >> 9) & 1) << 5)); }
__host__ __device__ __forceinline__ void stage_rc(int b, int& R, int& C) { const int st = b / 1024, sb = b % 1024, swz = sb ^ (((sb >> 9) & 1) << 5); R = (st >> 1) * 16 + swz / 64; C = (st & 1) * 32 + (swz % 64) / 2; }
__host__ __device__ __forceinline__ int perm32(int rho) { const int n = rho >> 4, i = rho & 15; return 8 * (i >> 2) + 4 * n + (i & 3); }

struct Unit { int pm, pn; };
struct Gemm { const bf16_t* A; const bf16_t* Bt; int M, N, K; };

struct StaticOrder {
    int nM, nN, nwg, G, c;
    __host__ __device__ void init(int M, int N, int G_, int c_) { nM = M / BM; nN = N / BM; nwg = nM * nN; G = G_; c = c_; }
    __host__ __device__ bool next(int i, Unit& u) const {
        const long L = (long)i * G + c; if (L >= nwg) return false;
        int wgid = (int)L; { const int q = nwg / NXCD, r = nwg % NXCD, xcd = wgid % NXCD, off = wgid / NXCD; wgid = (xcd < r ? xcd * (q + 1) : r * (q + 1) + (xcd - r) * q) + off; }
        const int nig = WGM * nN, gid = wgid / nig, fm = gid * WGM, gsz = (nM - fm) < WGM ? (nM - fm) : WGM;
        u.pm = fm + ((wgid % nig) % gsz); u.pn = (wgid % nig) / gsz; return true;
    }
    __device__ __forceinline__ void a_ready(const Unit&) const {}
    __device__ __forceinline__ void done(const Unit&) const {}
};
template <class Epi, class Sched, bool ALIGN_EPI = false, bool SP2 = false>
__device__ __forceinline__ void gemm_phase(PG8_LAS unsigned char* lds, const Gemm g, const Sched& S, const Epi& E) {
    const int tid = threadIdx.x, wid = __builtin_amdgcn_readfirstlane(tid >> 6), lane = tid & 63, wr = wid >> 2, wc = wid & 3, fr = lane & 15, fq = lane >> 4;
    const int K = g.K, nt = K / BK;
    unsigned voffA[2], voffB[2];
#pragma unroll
    for (int i = 0; i < 2; ++i) { int R, C; stage_rc(tid * 16 + i * 8192, R, C); const int Rb = Epi::PERM ? ((R & ~31) + perm32(R & 31)) : R;
        voffA[i] = (unsigned)(R * K + C) * 2u; voffB[i] = (unsigned)(Rb * K + C) * 2u; }
    const size_t kstep = (size_t)(BK * 2);
    const size_t hstep = (size_t)HALF * K * 2;
    const size_t tstep = 2 * hstep;
    const unsigned ldsw = (unsigned)wid * 1024u;
    const int aoff = lds_byte(wr * 64 + fr, fq * 8), boff = lds_byte(wc * 32 + fr, fq * 8);
#define PG8_SA(b, h) (((b) * 2 + (h)) * HTB)
#define PG8_SB(b, h) ((4 + (b) * 2 + (h)) * HTB)
#define PG8_STAGE(bufoff, gbase, voff) do { _Pragma("unroll") for (int _i = 0; _i < 2; ++_i) \
        __builtin_amdgcn_global_load_lds((const unsigned*)((const char*)(gbase) + (voff)[_i]), (PG8_LAS unsigned*)(lds + (bufoff) + ldsw + _i * 8192), 16, 0, 0); } while (0)
#define PG8_LDA(dst, b, h) do { _Pragma("unroll") for (int m = 0; m < 4; ++m) _Pragma("unroll") for (int k = 0; k < 2; ++k) dst[m][k] = *(const PG8_LAS bf16x8*)(lds + PG8_SA(b, h) + aoff + m * 2048 + k * 1024); } while (0)
#define PG8_LDB(dst, b, h) do { _Pragma("unroll") for (int n = 0; n < 2; ++n) _Pragma("unroll") for (int k = 0; k < 2; ++k) dst[n][k] = *(const PG8_LAS bf16x8*)(lds + PG8_SB(b, h) + boff + n * 2048 + k * 1024); } while (0)
#define PG8_MMA(ai, bj, At, Bt) do { __builtin_amdgcn_s_setprio(1); _Pragma("unroll") for (int m = 0; m < 4; ++m) _Pragma("unroll") for (int n = 0; n < 2; ++n) _Pragma("unroll") for (int k = 0; k < 2; ++k) \
        acc[ai][bj][m][n] = __builtin_amdgcn_mfma_f32_16x16x32_bf16(Bt[n][k], At[m][k], acc[ai][bj][m][n], 0, 0, 0); __builtin_amdgcn_s_setprio(0); } while (0)
#define PG8_WAIT_V(n) asm volatile("s_waitcnt vmcnt(" #n ")" ::: "memory")
#define PG8_WAIT_L(n) asm volatile("s_waitcnt lgkmcnt(" #n ")" ::: "memory")
#define PG8_BAR __builtin_amdgcn_s_barrier()
#define PG8_SCHED __builtin_amdgcn_sched_barrier(0)
    Unit cur, nxt; int ui = 0;
    if (!S.next(0, cur)) return;
    f32x4 acc[2][2][4][2];
#pragma unroll
    for (int a = 0; a < 2; ++a)
#pragma unroll
        for (int b = 0; b < 2; ++b)
#pragma unroll
            for (int m = 0; m < 4; ++m)
#pragma unroll
                for (int n = 0; n < 2; ++n) acc[a][b][m][n] = (f32x4){0.f, 0.f, 0.f, 0.f};
    bf16x8 At[4][2], B0[2][2], B1[2][2];
    const char* cA = (const char*)g.A + (size_t)cur.pm * tstep; const char* cB = (const char*)g.Bt + (size_t)cur.pn * tstep;
    S.a_ready(cur);
    if constexpr (SP2) {
        PG8_STAGE(PG8_SB(0, 0), cB, voffB); PG8_STAGE(PG8_SB(0, 1), cB + hstep, voffB); PG8_STAGE(PG8_SA(0, 0), cA, voffA); PG8_STAGE(PG8_SA(0, 1), cA + hstep, voffA);
        if (wr == 1) PG8_BAR;
        PG8_WAIT_V(2); PG8_BAR;
        PG8_STAGE(PG8_SB(1, 0), cB + kstep, voffB); PG8_STAGE(PG8_SA(1, 0), cA + kstep, voffA); PG8_STAGE(PG8_SB(1, 1), cB + hstep + kstep, voffB);
        PG8_WAIT_V(6); PG8_BAR;
    } else {
        PG8_STAGE(PG8_SB(0, 0), cB, voffB); PG8_STAGE(PG8_SA(0, 0), cA, voffA); PG8_STAGE(PG8_SB(0, 1), cB + hstep, voffB); PG8_STAGE(PG8_SA(0, 1), cA + hstep, voffA);
        if (wr == 1) PG8_BAR;
        PG8_WAIT_V(4); PG8_BAR;
        PG8_STAGE(PG8_SB(1, 0), cB + kstep, voffB); PG8_STAGE(PG8_SA(1, 0), cA + kstep, voffA); PG8_STAGE(PG8_SB(1, 1), cB + hstep + kstep, voffB);
        PG8_WAIT_V(6); PG8_BAR;
    }
    for (;;) {
        const bool has_next = S.next(ui + 1, nxt);
        const char* nA = has_next ? (const char*)g.A + (size_t)nxt.pm * tstep : cA; const char* nB = has_next ? (const char*)g.Bt + (size_t)nxt.pn * tstep : cB;
        for (int t = 0; t < nt; t += 2) {
            const bool last = (t == nt - 2);
            const char* a1 = cA + (size_t)(t + 1) * kstep;
            const char* a2 = last ? nA : cA + (size_t)(t + 2) * kstep; const char* b2 = last ? nB : cB + (size_t)(t + 2) * kstep;
            const char* a3 = a2 + kstep; const char* b3 = b2 + kstep;
            if (last && has_next) S.a_ready(nxt);
            if constexpr (SP2) {
            PG8_LDB(B0, 0, 0); PG8_LDB(B1, 0, 1); PG8_SCHED; PG8_LDA(At, 0, 0); PG8_STAGE(PG8_SA(1, 1), a1 + hstep, voffA);
            PG8_WAIT_V(8); PG8_WAIT_L(0); PG8_BAR; PG8_MMA(0, 0, At, B0); PG8_MMA(0, 1, At, B1); PG8_BAR; PG8_SCHED;
            PG8_LDA(At, 0, 1); PG8_STAGE(PG8_SB(0, 0), b2, voffB); PG8_STAGE(PG8_SB(0, 1), b2 + hstep, voffB); PG8_STAGE(PG8_SA(0, 0), a2, voffA);
            PG8_WAIT_V(8); PG8_WAIT_L(0); PG8_BAR; PG8_MMA(1, 0, At, B0); PG8_MMA(1, 1, At, B1); PG8_BAR; PG8_SCHED;
            PG8_LDB(B0, 1, 0); PG8_LDB(B1, 1, 1); PG8_SCHED; PG8_LDA(At, 1, 0); PG8_STAGE(PG8_SA(0, 1), a2 + hstep, voffA);
            PG8_WAIT_V(8); PG8_WAIT_L(0); PG8_BAR; PG8_MMA(0, 0, At, B0); PG8_MMA(0, 1, At, B1); PG8_BAR; PG8_SCHED;
            PG8_LDA(At, 1, 1); PG8_STAGE(PG8_SB(1, 0), b3, voffB); PG8_STAGE(PG8_SB(1, 1), b3 + hstep, voffB); PG8_STAGE(PG8_SA(1, 0), a3, voffA);
            PG8_WAIT_V(8); PG8_WAIT_L(0); PG8_BAR; PG8_MMA(1, 0, At, B0); PG8_MMA(1, 1, At, B1); PG8_BAR; PG8_SCHED;
            } else {
            PG8_LDB(B0, 0, 0); PG8_SCHED; PG8_LDA(At, 0, 0); PG8_STAGE(PG8_SA(1, 1), a1 + hstep, voffA);
            PG8_WAIT_L(8); PG8_BAR; PG8_WAIT_L(0); PG8_MMA(0, 0, At, B0); PG8_BAR; PG8_SCHED;
            PG8_LDB(B1, 0, 1); PG8_STAGE(PG8_SB(0, 0), b2, voffB);
            PG8_BAR; PG8_WAIT_L(0); PG8_MMA(0, 1, At, B1); PG8_BAR;
            PG8_LDA(At, 0, 1); PG8_STAGE(PG8_SA(0, 0), a2, voffA);
            PG8_BAR; PG8_WAIT_L(0); PG8_MMA(1, 0, At, B0); PG8_BAR; PG8_SCHED;
            PG8_STAGE(PG8_SB(0, 1), b2 + hstep, voffB);
            PG8_WAIT_V(6); PG8_BAR; PG8_MMA(1, 1, At, B1); PG8_BAR;
            PG8_LDB(B0, 1, 0); PG8_SCHED; PG8_LDA(At, 1, 0); PG8_STAGE(PG8_SA(0, 1), a2 + hstep, voffA);
            PG8_WAIT_L(8); PG8_BAR; PG8_WAIT_L(0); PG8_MMA(0, 0, At, B0); PG8_BAR; PG8_SCHED;
            PG8_LDB(B1, 1, 1); PG8_STAGE(PG8_SB(1, 0), b3, voffB);
            PG8_BAR; PG8_WAIT_L(0); PG8_MMA(0, 1, At, B1); PG8_BAR;
            PG8_LDA(At, 1, 1); PG8_STAGE(PG8_SA(1, 0), a3, voffA);
            PG8_BAR; PG8_WAIT_L(0); PG8_MMA(1, 0, At, B0); PG8_BAR; PG8_SCHED;
            PG8_STAGE(PG8_SB(1, 1), b3 + hstep, voffB);
            PG8_WAIT_V(6); PG8_BAR; PG8_MMA(1, 1, At, B1); PG8_BAR;
            }
        }
        if constexpr (ALIGN_EPI) { if (wr == 0) PG8_BAR; }
        if constexpr (!Epi::AFTER_DRAIN) { E(acc, cur, wr, wc, fr, fq); S.done(cur); }
        if (!has_next) break;
#pragma unroll
        for (int a = 0; a < 2; ++a)
#pragma unroll
            for (int b = 0; b < 2; ++b)
#pragma unroll
                for (int m = 0; m < 4; ++m)
#pragma unroll
                    for (int n = 0; n < 2; ++n) acc[a][b][m][n] = (f32x4){0.f, 0.f, 0.f, 0.f};
        cur = nxt; cA = nA; cB = nB; ++ui;
        if constexpr (ALIGN_EPI) { if (wr == 1) PG8_BAR; }
    }
    PG8_WAIT_V(0);
    if constexpr (!ALIGN_EPI) { if (wr == 0) PG8_BAR; }
    PG8_BAR;
    if constexpr (Epi::AFTER_DRAIN) { E.fused(acc, cur, wr, wc, fr, fq, lds, wid, lane); S.done(cur); }
#undef PG8_SA
#undef PG8_SB
#undef PG8_STAGE
#undef PG8_LDA
#undef PG8_LDB
#undef PG8_MMA
#undef PG8_WAIT_V
#undef PG8_WAIT_L
#undef PG8_BAR
#undef PG8_SCHED
}
}
#define XB_TMO      128
#define XB_XCNT(j)  (256  + 64 * (j))
#define XB_XSUB(j)  (1280 + 64 * (j))
#define XB_XGEN(j)  (2304 + 64 * (j))
#define XB_TOP      3328
#define XB_TOPGEN   3392
#define XCD_BAR_WORDS 3456
#define XB_SPIN_CAP (1u << 18)

__device__ __forceinline__ unsigned xb_ld(unsigned* p)              { return __hip_atomic_load(p, __ATOMIC_RELAXED, __HIP_MEMORY_SCOPE_AGENT); }
__device__ __forceinline__ unsigned xb_add(unsigned* p, unsigned v) { return __hip_atomic_fetch_add(p, v, __ATOMIC_RELAXED, __HIP_MEMORY_SCOPE_AGENT); }
__device__ __forceinline__ unsigned xb_xcc_id() { return (unsigned)__builtin_amdgcn_s_getreg((3 << 11) | 20) & 0xFu; }
#define XB_SPIN(cond, bar) do { unsigned _sp = 0; while (cond) { __builtin_amdgcn_s_sleep(1); \
    if ((++_sp & 255u) == 0u) { if (xb_ld(&(bar)[XB_TMO])) break; if (_sp > XB_SPIN_CAP) { atomicAdd(&(bar)[XB_TMO], 1u); break; } } } } while (0)

struct XcdBarrier {
    unsigned* bar; unsigned x;
    volatile LAS unsigned* st;
};

__device__ __forceinline__ XcdBarrier xcd_barrier_post(unsigned* bar, volatile LAS unsigned* st) {
    XcdBarrier b; b.bar = bar; b.x = xb_xcc_id(); b.st = st;
    if (threadIdx.x == 0) { st[2] = xb_add(&bar[XB_XCNT(b.x)], 1u); st[3] = 1u; }
    return b;
}
__device__ __forceinline__ void xcd_barrier_complete(unsigned* bar, unsigned x, unsigned& nloc, unsigned& nx) {
    const unsigned G = gridDim.x * gridDim.y * gridDim.z;
    unsigned sum, cnt, mine, sp = 0u;
    for (;;) {
        sum = 0u; cnt = 0u; mine = 0u;
#pragma unroll
        for (unsigned j = 0; j < 16; ++j) { const unsigned c = xb_ld(&bar[XB_XCNT(j)]); sum += c; cnt += (c > 0u) ? 1u : 0u; mine = (j == x) ? c : mine; }
        if (sum == G) break;
        __builtin_amdgcn_s_sleep(1);
        if ((++sp & 255u) == 0u) { if (xb_ld(&bar[XB_TMO])) break; if (sp > XB_SPIN_CAP) { atomicAdd(&bar[XB_TMO], 1u); break; } }
    }
    nloc = mine > 0u ? mine : 1u; nx = cnt > 0u ? cnt : 1u;
}

__device__ __forceinline__ void xcd_barrier(const XcdBarrier& b) {
    asm volatile("s_waitcnt vmcnt(0)" ::: "memory");
    __syncthreads();
    if (threadIdx.x == 0) {
        unsigned* bar = b.bar;
        __builtin_amdgcn_s_waitcnt(0);
        unsigned nloc = b.st[0], nx = b.st[1];
        if (nloc == 0u) { xcd_barrier_complete(bar, b.x, nloc, nx); b.st[0] = nloc; b.st[1] = nx; }
        const unsigned old = xb_add(&bar[XB_XSUB(b.x)], 1u);
        const unsigned gen = old / nloc;
        if (old + 1u == (gen + 1u) * nloc) {
            __builtin_amdgcn_fence(__ATOMIC_RELEASE, "agent");
            asm volatile("s_waitcnt vmcnt(0)" ::: "memory");
            const unsigned og = xb_add(&bar[XB_TOP], 1u);
            const unsigned tg = og / nx;
            if (og + 1u == (tg + 1u) * nx) xb_add(&bar[XB_TOPGEN], 1u);
            else XB_SPIN(xb_ld(&bar[XB_TOPGEN]) == tg, bar);
            __builtin_amdgcn_fence(__ATOMIC_ACQUIRE, "agent");
            xb_add(&bar[XB_XGEN(b.x)], 1u);
            asm volatile("s_waitcnt vmcnt(0)" ::: "memory");
        } else {
            XB_SPIN(xb_ld(&bar[XB_XGEN(b.x)]) == gen, bar);
            __builtin_amdgcn_fence(__ATOMIC_ACQUIRE, "agent");
            asm volatile("s_waitcnt vmcnt(0)" ::: "memory");
        }
    }
    __syncthreads();
}

namespace pg8 {
template <class Fn> struct EpiFn {
    static constexpr bool PERM = true, AFTER_DRAIN = false;
    Fn f;
    __device__ __forceinline__ void operator()(const f32x4 (&acc)[2][2][4][2], const Unit& u, int wr, int wc, int fr, int fq) const {
        const int row0 = u.pm * BM + wr * 64 + fr, col0 = u.pn * BM + wc * 32 + 8 * fq;
#pragma unroll
        for (int ai = 0; ai < 2; ++ai)
#pragma unroll
            for (int m = 0; m < 4; ++m)
#pragma unroll
                for (int bj = 0; bj < 2; ++bj) f.e8(row0 + ai * HALF + m * 16, col0 + bj * HALF, acc[ai][bj][m][0], acc[ai][bj][m][1]);
    }
};
}

struct FnBf16 {
    bf16* O; int ld;
    __device__ __forceinline__ void e8(int row, int col, f32x4 a, f32x4 b) const {
        v4u w; w.x = pk2(a.x, a.y); w.y = pk2(a.z, a.w); w.z = pk2(b.x, b.y); w.w = pk2(b.z, b.w);
        *(v4u*)(O + (size_t)row * ld + col) = w;
    }
    __device__ __forceinline__ void e4(int row, int col, f32x4 a) const {
        v2u w; w.x = pk2(a.x, a.y); w.y = pk2(a.z, a.w);
        *(v2u*)(O + (size_t)row * ld + col) = w;
    }
};
struct FnResid {
    float* XS; const float* baseP; const float* baseS;
    __device__ __forceinline__ const float* brow(int row) const { return row < MP ? baseP + (size_t)row * DM : baseS + (size_t)(row - MP) * DM; }
    __device__ __forceinline__ void e8(int row, int col, f32x4 a, f32x4 b) const {
        const float* br = brow(row) + col; float* o = XS + (size_t)row * DM + col;
        const f32x4 x0 = *(const f32x4*)br, x1 = *(const f32x4*)(br + 4);
        *(f32x4*)o = x0 + a; *(f32x4*)(o + 4) = x1 + b;
    }
    __device__ __forceinline__ void e4(int row, int col, f32x4 a) const {
        const float* br = brow(row) + col; float* o = XS + (size_t)row * DM + col;
        *(f32x4*)o = *(const f32x4*)br + a;
    }
};
struct FnF32 {
    float* O; int ld;
    __device__ __forceinline__ void e8(int row, int col, f32x4 a, f32x4 b) const { float* o = O + (size_t)row * ld + col; *(f32x4*)o = a; *(f32x4*)(o + 4) = b; }
    __device__ __forceinline__ void e4(int row, int col, f32x4 a) const { *(f32x4*)(O + (size_t)row * ld + col) = a; }
};
struct FnKvq {
    bf16* O; const float* ssq;
    __device__ __forceinline__ float rstd(int row) const { const f32x4 s0 = *(const f32x4*)(ssq + (size_t)row * 8), s1 = *(const f32x4*)(ssq + (size_t)row * 8 + 4);
        return frsq((((s0.x + s0.y) + (s0.z + s0.w)) + ((s1.x + s1.y) + (s1.z + s1.w))) * (1.f / DM) + EPS); }
    __device__ __forceinline__ void e8(int row, int col, f32x4 a, f32x4 b) const {
        if (col < NKVQ_REAL) { const float rs = rstd(row); a = a * rs; b = b * rs; *(v4u*)(O + (size_t)row * NKVQ + col) = (v4u){pk2(a.x, a.y), pk2(a.z, a.w), pk2(b.x, b.y), pk2(b.z, b.w)}; }
    }
    __device__ __forceinline__ void e4(int row, int col, f32x4 a) const {
        if (col < NKVQ_REAL) { a = a * rstd(row); *(v2u*)(O + (size_t)row * NKVQ + col) = (v2u){pk2(a.x, a.y), pk2(a.z, a.w)}; }
    }
};

template <class Fn>
__device__ __forceinline__ void skinny_gemm(Frame& F, const bf16* A, const bf16* Bt, int N, int row_base, const Fn& fn) {
    const int fr = F.lane & 15, fq = F.lane >> 4;
    const int nun = N / 16;
    for (int u = F.bid; u < nun; u += F.G) {
        const bf16* ap = Bt + (size_t)(u * 16 + fr) * DM + fq * 8;
        const bf16* bp = A + (size_t)(F.wave * 16 + fr) * DM + fq * 8;
        f32x4 acc = {0.f, 0.f, 0.f, 0.f};
#pragma unroll 8
        for (int ks = 0; ks < 32; ++ks) acc = MFMA16(ld8(ap + ks * 32), ld8(bp + ks * 32), acc);
        fn.e4(row_base + F.wave * 16 + fr, u * 16 + 4 * fq, acc);
    }
}

template <class Fn>
__device__ __forceinline__ void gemm_all(Frame& F, const bf16* A, const bf16* Bt, int N, const Fn& fn) {
    pg8::Gemm g{A, Bt, MP, N, DM}; pg8::StaticOrder S; S.init(MP, N, F.G, F.bid);
    pg8::EpiFn<Fn> E{fn};
    pg8::gemm_phase<pg8::EpiFn<Fn>, pg8::StaticOrder, true, true>(F.lds, g, S, E);
    skinny_gemm(F, A + (size_t)MP * DM, Bt, N, MP, fn);
}

__device__ __forceinline__ void p0_transpose_item(const float* W, int N, bf16* WT, int row_off, const float* gain, LAS float* scr, int item, int lane) {
    const int nblk = (N + 31) / 32, kb = item / nblk, nb = item % nblk, k0 = 64 * kb, n0 = 32 * nb;
#pragma unroll 8
    for (int i = 0; i < 32; ++i) { const int kk = 2 * i + (lane >> 5); const int n = n0 + (lane & 31);
        float v = 0.f; if (n < N) { v = W[(size_t)(k0 + kk) * N + n]; if (gain) v *= gain[k0 + kk]; }
        scr[kk * 33 + (lane & 31)] = v; }
    LDS_WAIT(); asm volatile("" ::: "memory");
    const int c = lane & 7;
#pragma unroll
    for (int j = 0; j < 4; ++j) { const int n = (lane >> 3) + 8 * j; const LAS float* s = scr + (8 * c) * 33 + n;
        v4u o; o.x = pk2(s[0 * 33], s[1 * 33]); o.y = pk2(s[2 * 33], s[3 * 33]); o.z = pk2(s[4 * 33], s[5 * 33]); o.w = pk2(s[6 * 33], s[7 * 33]);
        if (n0 + n < N) *(v4u*)(WT + (size_t)(row_off + n0 + n) * DM + k0 + 8 * c) = o; }
    LDS_WAIT(); asm volatile("" ::: "memory");
}
__device__ __forceinline__ void rms_row_to_bf16(const float* xrow, bf16* orow, int lane) {
    const f32x4* xr = (const f32x4*)xrow + lane;
    f32x4 v[4]; float s = 0.f;
#pragma unroll
    for (int j = 0; j < 4; ++j) { v[j] = xr[64 * j]; s += (v[j].x * v[j].x + v[j].y * v[j].y) + (v[j].z * v[j].z + v[j].w * v[j].w); }
    const float rstd = frsq(wave_sum(s) * (1.f / DM) + EPS);
    v2u* o8 = (v2u*)orow + lane;
#pragma unroll
    for (int j = 0; j < 4; ++j) { v2u w; w.x = pk2(v[j].x * rstd, v[j].y * rstd); w.y = pk2(v[j].z * rstd, v[j].w * rstd); o8[64 * j] = w; }
}
__device__ __forceinline__ const float* xin_row(Frame& F, int row) { return row < MP ? FIN(0) + (size_t)row * DM : FIN(1) + (size_t)(row - MP) * DM; }

__device__ __forceinline__ void peer_tables_to_fp8(Frame& F, size_t thr, size_t nthr, size_t lo = 0, size_t hi = (size_t)2 * NEXP * DM / 8) {
    const size_t gt = thr, NGT = nthr;
        for (int t = 0; t < 2; ++t) { const f32x4* src = (const f32x4*)FIN(27 + t); v2u* dst = (v2u*)WSP(unsigned char, t == 0 ? WS_PU : WS_PV); const float* pln = FIN(24);
            for (size_t i0 = lo + gt; i0 < hi; i0 += (size_t)4 * NGT) {
                f32x4 a[4], b[4];
#pragma unroll
                for (int u = 0; u < 4; ++u) { const size_t i = i0 + (size_t)u * NGT; if (i < hi) { a[u] = src[2 * i]; b[u] = src[2 * i + 1]; } }
#pragma unroll
                for (int u = 0; u < 4; ++u) { const size_t i = i0 + (size_t)u * NGT; if (i < hi) {
                    if (t == 0) { const float* gp = pln + ((i >> 21) << 10) + ((i & 127) << 3); a[u] = a[u] * *(const f32x4*)gp * 32.f; b[u] = b[u] * *(const f32x4*)(gp + 4) * 32.f; }
                    else { a[u] = a[u] * 16.f; b[u] = b[u] * 16.f; }
                    int w0 = __builtin_amdgcn_cvt_pk_fp8_f32(a[u].x, a[u].y, 0, false); w0 = __builtin_amdgcn_cvt_pk_fp8_f32(a[u].z, a[u].w, w0, true);
                    int w1 = __builtin_amdgcn_cvt_pk_fp8_f32(b[u].x, b[u].y, 0, false); w1 = __builtin_amdgcn_cvt_pk_fp8_f32(b[u].z, b[u].w, w1, true);
                    dst[((((i >> 21) * 8 + ((i & 127) >> 4)) * (size_t)NEXP + ((i >> 7) & (NEXP - 1))) << 4) + (i & 15)] = (v2u){(unsigned)w0, (unsigned)w1}; } } } }
}

constexpr int FD_BUF = 16384;
__device__ __forceinline__ void fs_direct_task(Frame& F, int task) {
    int lane_ = F.lane; asm volatile("" : "+v"(lane_));
    const int lane = lane_, w = F.wave, fr = lane & 15, fq = lane >> 4, kv = w >> 2, g = w & 3, bs = task >> 4, c0 = (task & 15) * 32;
    LAS unsigned char* L = F.lds; asm volatile("" : "+v"(L));
    const float* cache = FIN(2); const int* pt = (const int*)FIN(6) + bs * NPAGES;
    const float* base[2];
#pragma unroll
    for (int nt = 0; nt < 2; ++nt) { const int t0 = 16 * (c0 + 16 * nt + fr); base[nt] = cache + ((size_t)pt[t0 >> 7] * PAGE + (t0 & 127)) * 1024 + kv * 256 + g * 64 + 8 * fq; }
    const bf16* wsrc[2]; int wdst[2];
#pragma unroll
    for (int q = 0; q < 2; ++q) { const int item = F.tid + 512 * q, kvw = item >> 9, n = (item >> 2) & 127, kq = item & 3;
        wsrc[q] = WSP(bf16, WS_W1BD) + (size_t)(kvw * 128 + n) * 2048 + kvw * 1024 + 8 * kq; wdst[q] = ((kvw * 8 + (n >> 4)) * 64 + kq * 16 + (n & 15)) * 16; }
    f32x4 acc[2][8];
#pragma unroll
    for (int nt = 0; nt < 2; ++nt)
#pragma unroll
        for (int mt = 0; mt < 8; ++mt) acc[nt][mt] = (f32x4){0.f, 0.f, 0.f, 0.f};
    f32x4 S0[2][4], S1[2][4]; v4u wr[2];
#define FD_DATA(S, r) do { const int r_ = (r) < 16 ? (r) : 15; _Pragma("unroll") for (int nt_ = 0; nt_ < 2; ++nt_) { const float* p_ = base[nt_] + r_ * 1024; \
        S[nt_][0] = *(const f32x4*)p_; S[nt_][1] = *(const f32x4*)(p_ + 4); S[nt_][2] = *(const f32x4*)(p_ + 32); S[nt_][3] = *(const f32x4*)(p_ + 36); } } while (0)
#define FD_WLOAD(ks) do { const int ks_ = (ks) < 32 ? (ks) : 31; wr[0] = *(const v4u*)(wsrc[0] + 32 * ks_); wr[1] = *(const v4u*)(wsrc[1] + 32 * ks_); } while (0)
#define FD_WSTORE(buf) do { *(LAS v4u*)(L + (buf) * FD_BUF + wdst[0]) = wr[0]; *(LAS v4u*)(L + (buf) * FD_BUF + wdst[1]) = wr[1]; } while (0)
#define FD_KSTEP(bq, ks, buf) do { \
        _Pragma("unroll") for (int mt_ = 0; mt_ < 8; ++mt_) { const bf16x8 a_ = *(const LAS bf16x8*)(L + (buf) * FD_BUF + ((kv * 8 + mt_) * 64 + lane) * 16); \
            acc[0][mt_] = MFMA16(a_, bq[0], acc[0][mt_]); acc[1][mt_] = MFMA16(a_, bq[1], acc[1][mt_]); } \
        FD_WSTORE((buf) ^ 1); FD_WLOAD((ks) + 2); \
        __syncthreads(); } while (0)
#define FD_ROW(S, r) do { bf16x8 b0_[2], b1_[2]; _Pragma("unroll") for (int nt_ = 0; nt_ < 2; ++nt_) { b0_[nt_] = cvt8(S[nt_][0], S[nt_][1]); b1_[nt_] = cvt8(S[nt_][2], S[nt_][3]); } \
        FD_DATA(S, (r) + 2); \
        FD_KSTEP(b0_, 2 * (r), 0); FD_KSTEP(b1_, 2 * (r) + 1, 1); } while (0)
    FD_WLOAD(0); FD_WSTORE(0); FD_WLOAD(1); FD_DATA(S0, 0); FD_DATA(S1, 1);
    __syncthreads();
#pragma unroll 1
    for (int r = 0; r < 16; r += 2) { FD_ROW(S0, r); FD_ROW(S1, r + 1); }
#undef FD_KSTEP
#undef FD_ROW
#undef FD_DATA
#undef FD_WLOAD
#undef FD_WSTORE
    bf16* fs = WSP(bf16, WS_FS) + ((size_t)(bs * 4 + g) * 512 + c0 + fr) * 256 + kv * 128 + 4 * fq;
#pragma unroll
    for (int nt = 0; nt < 2; ++nt)
#pragma unroll
        for (int mt = 0; mt < 8; ++mt) *(v2u*)(fs + (size_t)nt * 16 * 256 + 16 * mt) = (v2u){pk2(acc[nt][mt][0], acc[nt][mt][1]), pk2(acc[nt][mt][2], acc[nt][mt][3])};
    __syncthreads();
}

__device__ __forceinline__ void p0_prologue(Frame& F) {
    LAS float* scr = (LAS float*)(F.lds + F.wave * 16384);
    const int gw = F.bid * 8 + F.wave, NGW = F.G * 8;
    const int gt = F.bid * 512 + F.tid, NGT = F.G * 512;
    {
        constexpr int I_IN = 128 * 16, I_OA = 32 * 16, I_KV = 48 * 16, I_QG = 34 * 16, I_OB = 32 * 16, I_PQ = 64 * 16;
        constexpr int NITEMS = I_IN + I_OA + I_KV + I_QG + I_OB + 2 * I_PQ;
        for (int it = gw; it < NITEMS; it += NGW) {
            int r = it;
            if (r < I_IN) {
                const int kb = r / 128, nb = r % 128, k0 = 64 * kb, n0 = 32 * nb; const float* W = FIN(8); const float* gain = FIN(7);
#pragma unroll 8
                for (int i = 0; i < 32; ++i) { const int kk = 2 * i + (F.lane >> 5); scr[kk * 33 + (F.lane & 31)] = W[(size_t)(k0 + kk) * GPROJ + n0 + (F.lane & 31)] * gain[k0 + kk]; }
                LDS_WAIT(); asm volatile("" ::: "memory");
                const int c = F.lane & 7;
#pragma unroll
                for (int j = 0; j < 4; ++j) { const int n = (F.lane >> 3) + 8 * j; const LAS float* s = scr + (8 * c) * 33 + n;
                    v4u o; o.x = pk2(s[0 * 33], s[1 * 33]); o.y = pk2(s[2 * 33], s[3 * 33]); o.z = pk2(s[4 * 33], s[5 * 33]); o.w = pk2(s[6 * 33], s[7 * 33]);
                    *(v4u*)(WSP(bf16, WS_WIN_T) + (size_t)(n0 + n) * DM + k0 + 8 * c) = o; }
                LDS_WAIT(); asm volatile("" ::: "memory");
                continue; }
            r -= I_IN;
            if (r < I_OA) { p0_transpose_item(FIN(13), 1024, WSP(bf16, WS_WOA_T), 0, nullptr, scr, r, F.lane); continue; } r -= I_OA;
            if (r < I_KV) { p0_transpose_item(FIN(15), NKV, WSP(bf16, WS_WKVQ_T), 0, FIN(14), scr, r, F.lane); continue; } r -= I_KV;
            if (r < I_QG) { p0_transpose_item(FIN(21), NQG, WSP(bf16, WS_WKVQ_T), NKV, FIN(20), scr, r, F.lane); continue; } r -= I_QG;
            if (r < I_OB) { p0_transpose_item(FIN(23), 1024, WSP(bf16, WS_WOB_T), 0, nullptr, scr, r, F.lane); continue; } r -= I_OB;
            if (r < I_PQ) { p0_transpose_item(FIN(25), 2048, WSP(bf16, WS_WPQ_T), 0, FIN(24), scr, r, F.lane); continue; } r -= I_PQ;
            p0_transpose_item(FIN(25) + (size_t)1024 * 2048, 2048, WSP(bf16, WS_WPQ_T) + (size_t)2048 * 1024, 0, FIN(24) + 1024, scr, r, F.lane);
        }
        for (int i = gt; i < (NKVQ - NKVQ_REAL) * DM / 8; i += NGT) ((v4u*)(WSP(bf16, WS_WKVQ_T) + (size_t)NKVQ_REAL * DM))[i] = (v4u){0u, 0u, 0u, 0u};
        for (int i = gt; i < 16 * 1024; i += NGT) { const int j = i >> 10, k = i & 1023; WSP(float, WS_WAB)[i] = FIN(7)[k] * FIN(8)[(size_t)k * GPROJ + 4096 + j]; }
    }
    for (int m = gw; m < MTOK; m += NGW) rms_row_to_bf16(xin_row(F, m), WSP(bf16, WS_XNA) + (size_t)m * DM, F.lane);
    {
        if (F.G != 256) peer_tables_to_fp8(F, (size_t)gt, (size_t)NGT);
        const f32x4* sk = (const f32x4*)FIN(26); v4u* dk = (v4u*)WSP(bf16, WS_SUBK);
        for (int i = gt; i < 2 * 8 * 2 * 128 * 128 / 8; i += NGT) { const f32x4 a = sk[2 * i], b = sk[2 * i + 1]; v4u w; w.x = pk2(a.x, a.y); w.y = pk2(a.z, a.w); w.z = pk2(b.x, b.y); w.w = pk2(b.z, b.w); dk[i] = w; }
    }
    for (int i = gt; i < 2 * 64 * 2048; i += NGT) { const int kv = i >> 17, hh = (i >> 11) & 63, k = i & 2047;
        WSP(bf16, WS_W1T)[i] = (bf16)f2bf(FIN(17)[((size_t)kv * 2048 + k) * 64 + hh]); }
    for (int i = gt; i < 2 * 4 * 2 * 64 * 8; i += NGT) { const int e = i & 7, ln = (i >> 3) & 63, sx = (i >> 9) & 1, dt = (i >> 10) & 3, kv = i >> 12, fr_ = ln & 15, fq_ = ln >> 4;
        WSP(bf16, WS_W2F)[i] = (bf16)f2bf(FIN(19)[((size_t)kv * 64 + 16 * (2 * sx + (e >> 2)) + 4 * fq_ + (e & 3)) * 64 + 16 * dt + fr_]); }
    for (int it = gw; it < 128; it += NGW) { const int kv = it >> 6, h = it & 63; float s = 0.f;
        for (int k = F.lane; k < 2048; k += 64) s += FIN(18)[(size_t)kv * 2048 + k] * FIN(17)[((size_t)kv * 2048 + k) * 64 + h];
        s = wave_sum(s); if (F.lane == 0) WSP(float, WS_PETERM)[it] = s; }
    {
        bf16* wbd = WSP(bf16, WS_W1BD);
        for (int i = gt; i < 256 * 2048; i += NGT) { const int n = i >> 11, col = i & 2047, kv = n >> 7, sec = (n >> 6) & 1, hh = n & 63;
            float v = 0.f; if ((col >> 10) == kv) { const int k = col & 1023, r = (k >> 6) + 16 * sec, d = k & 63; v = FIN(17)[(((size_t)kv * 32 + r) * 64 + d) * 64 + hh]; }
            wbd[i] = (bf16)f2bf(v); }
    }
    {
        const f32x4* src = (const f32x4*)FIN(3); f32x4* dst = (f32x4*)(F.out + O_WINS);
        const int per_b = 508 * 512 / 4;
        for (int i = gt; i < SB * per_b; i += NGT) { const int b = i / per_b, r = i % per_b; dst[(size_t)b * (512 * 512 / 4) + r] = src[(size_t)b * (512 * 512 / 4) + 4 * 512 / 4 + r]; }
    }
    for (int i = gt; i < SB * NG * 544 * 64; i += NGT) {
        const int d = i & 63, r = (i >> 6) % 544, bg = (i >> 6) / 544, g = bg & 3, b = bg >> 2;
        if (r < 512) { const float* cw = FIN(3) + (((size_t)b * 512 + r) * 2) * 256 + g * 64 + d;
            WSP(bf16, WS_SKWIN)[i] = (bf16)f2bf(cw[0]);
            WSP(bf16, WS_SVWINT)[((size_t)bg * 64 + d) * 544 + r] = (bf16)f2bf(cw[256]); }
        else if (r >= 516) { WSP(bf16, WS_SKWIN)[i] = 0; WSP(bf16, WS_SVWINT)[((size_t)bg * 64 + d) * 544 + r] = 0; }
    }
}

constexpr int P2_QS = 0, P2_KS = 17408, P2_KBGT = 34816, P2_VBT = 53248, P2_AM = 71680, P2_TB = 89088, P2_G = 98304, P2_TF = 99328, P2_XF = 116736;
constexpr int QS_LD = 136, KT_LD = 72, AM_LD = 68, TB_LD = 72;

__device__ __forceinline__ float softplus_f(float x) { return fmaxf(x, 0.f) + __logf(1.f + __expf(-fabsf(x))); }

__device__ __forceinline__ void p2_chunk(Frame& F, int unit) {
    const int c = unit & 127, h = (unit >> 7) & 7, b = unit >> 10;
    const int t0 = c * CHUNK, lane = F.lane, w = F.wave, fr = lane & 15, fq = lane >> 4;
    LAS unsigned char* L = F.lds; asm volatile("" : "+v"(L));
    LAS bf16* qs = (LAS bf16*)(L + P2_QS); LAS bf16* ks = (LAS bf16*)(L + P2_KS);
    LAS bf16* kbgT = (LAS bf16*)(L + P2_KBGT); LAS bf16* vbT = (LAS bf16*)(L + P2_VBT);
    LAS float* Am = (LAS float*)(L + P2_AM); LAS bf16* Tb = (LAS bf16*)(L + P2_TB);
    LAS float* Gs = (LAS float*)(L + P2_G);
    const bf16* PROJ = WSP(bf16, WS_PROJ); const bf16* XNA = WSP(bf16, WS_XNA); const float* WAB = WSP(float, WS_WAB);
    const size_t rowb = (size_t)b * PT;
    float beta_r[8];
    {
        f32x4 wa[4], wb[4];
        const float* pa = WAB + (size_t)h * DM + 8 * lane; const float* pb = WAB + (size_t)(8 + h) * DM + 8 * lane;
        wa[0] = *(const f32x4*)pa; wa[1] = *(const f32x4*)(pa + 4); wa[2] = *(const f32x4*)(pa + 512); wa[3] = *(const f32x4*)(pa + 516);
        wb[0] = *(const f32x4*)pb; wb[1] = *(const f32x4*)(pb + 4); wb[2] = *(const f32x4*)(pb + 512); wb[3] = *(const f32x4*)(pb + 516);
        const float Aneg = -expf(FIN(10)[h]), dtb = FIN(11)[h];
#pragma unroll
        for (int tk = 0; tk < 8; ++tk) {
            const int tok = 8 * w + tk; const bf16* xr = XNA + (rowb + t0 + tok) * DM + 8 * lane;
            const v4u x0 = *(const v4u*)xr, x1 = *(const v4u*)(xr + 512);
            float sa = 0.f, sb = 0.f;
#define ACC2(xw, wv0, wv1, i0) { const float lo = bflo(xw), hi = bfhi(xw); sa += lo * wv0[i0] + hi * wv0[i0 + 1]; sb += lo * wv1[i0] + hi * wv1[i0 + 1]; }
            ACC2(x0.x, wa[0], wb[0], 0) ACC2(x0.y, wa[0], wb[0], 2) ACC2(x0.z, wa[1], wb[1], 0) ACC2(x0.w, wa[1], wb[1], 2)
            ACC2(x1.x, wa[2], wb[2], 0) ACC2(x1.y, wa[2], wb[2], 2) ACC2(x1.z, wa[3], wb[3], 0) ACC2(x1.w, wa[3], wb[3], 2)
#undef ACC2
            sa = wave_sum(sa); sb = wave_sum(sb);
            const float g = Aneg * softplus_f(sa + dtb), be = sigmoid_f(sb);
            beta_r[tk] = be;
            if (lane == 0) { Gs[tok] = g; Gs[64 + tok] = be; }
        }
    }
#pragma unroll
    for (int p = 0; p < 3; ++p) {
        const int col0 = p * 1024 + h * 128 + 2 * lane;
        float cw0[4], cw1[4];
#pragma unroll
        for (int i = 0; i < 4; ++i) { const f32x2 cv = *(const f32x2*)(FIN(9) + (size_t)i * GCONV + col0); cw0[i] = cv.x; cw1[i] = cv.y; }
        unsigned xw[11];
#pragma unroll
        for (int rr = 0; rr < 11; ++rr) { const int t = t0 + 8 * w - 3 + rr; xw[rr] = (t >= 0) ? *(const unsigned*)(PROJ + (rowb + t) * 4096 + col0) : 0u; }
        if (c == 127 && w == 7) {
#pragma unroll
            for (int r = 0; r < 3; ++r) { float* o = F.out + O_CONVP + ((size_t)b * 3 + r) * GCONV + col0; o[0] = bflo(xw[8 + r]); o[1] = bfhi(xw[8 + r]); }
        }
#pragma unroll
        for (int tk = 0; tk < 8; ++tk) {
            const int tok = 8 * w + tk;
            float y0 = 0.f, y1 = 0.f;
#pragma unroll
            for (int i = 0; i < 4; ++i) { y0 += cw0[i] * bflo(xw[tk + i]); y1 += cw1[i] * bfhi(xw[tk + i]); }
            y0 = silu_f(y0); y1 = silu_f(y1);
            if (p < 2) {
                const float ss = wave_sum(y0 * y0 + y1 * y1);
                const float rs = (frsq(ss + EPS)) * (p == 0 ? 0.08838834764831845f : 1.f);
                *(LAS unsigned*)((p == 0 ? qs : ks) + tok * QS_LD + 2 * lane) = pk2(y0 * rs, y1 * rs);
            } else {
                vbT[(2 * lane) * KT_LD + tok] = (bf16)f2bf(y0 * beta_r[tk]); vbT[(2 * lane + 1) * KT_LD + tok] = (bf16)f2bf(y1 * beta_r[tk]);
            }
        }
    }
    __syncthreads();
    if (w == 0) { float g = Gs[lane];
#pragma unroll
        for (int o = 1; o < 64; o <<= 1) { const float up = __shfl_up(g, o); if (lane >= o) g += up; }
        Gs[128 + lane] = g; }
    __syncthreads();
    const float glast = Gs[128 + 63];
    const size_t chunk = (size_t)unit;
    if (w < 4) {
        const int mt = w;
        bf16x8 a[4];
#pragma unroll
        for (int kk = 0; kk < 4; ++kk) a[kk] = ld8l(ks + (16 * mt + fr) * QS_LD + 32 * kk + 8 * fq);
#pragma unroll
        for (int nt = 0; nt < 4; ++nt) {
            f32x4 acc = {0.f, 0.f, 0.f, 0.f};
            if (nt <= mt) {
#pragma unroll
                for (int kk = 0; kk < 4; ++kk) acc = MFMA16(a[kk], ld8l(ks + (16 * nt + fr) * QS_LD + 32 * kk + 8 * fq), acc);
            }
            const int j = 16 * nt + fr; const float gj = Gs[128 + j];
#pragma unroll
            for (int r = 0; r < 4; ++r) { const int i = 16 * mt + 4 * fq + r;
                Am[i * AM_LD + j] = (i > j) ? Gs[64 + i] * acc[r] * __expf(Gs[128 + i] - gj) : 0.f; }
        }
    } else {
        const int nt = w - 4;
        bf16x8 bq[4];
#pragma unroll
        for (int kk = 0; kk < 4; ++kk) bq[kk] = ld8l(qs + (16 * nt + fr) * QS_LD + 32 * kk + 8 * fq);
        const int i = 16 * nt + fr; const float gi = Gs[128 + i];
        bf16* gqk = WSP(bf16, WS_GQK) + chunk * 4096;
#pragma unroll
        for (int mt = 0; mt < 4; ++mt) {
            f32x4 acc = {0.f, 0.f, 0.f, 0.f};
            if (mt <= nt) {
#pragma unroll
                for (int kk = 0; kk < 4; ++kk) acc = MFMA16(ld8l(ks + (16 * mt + fr) * QS_LD + 32 * kk + 8 * fq), bq[kk], acc);
            }
            float v[4];
#pragma unroll
            for (int r = 0; r < 4; ++r) { const int j = 16 * mt + 4 * fq + r; v[r] = (i >= j) ? acc[r] * __expf(gi - Gs[128 + j]) : 0.f; }
            v2u o; o.x = pk2(v[0], v[1]); o.y = pk2(v[2], v[3]);
            *(v2u*)(gqk + (((nt * 2 + (mt >> 1)) * 64 + (2 * (mt & 1) + (fq >> 1)) * 16 + fr) * 8 + 4 * (fq & 1))) = o;
        }
    }
    {
        const int tok = F.tid >> 3, d0 = (F.tid & 7) * 16; const float e = __expf(Gs[128 + tok]);
        bf16* gq = WSP(bf16, WS_GQ) + chunk * 8192;
#pragma unroll
        for (int hh = 0; hh < 2; ++hh) { const v4u q = *(const LAS v4u*)(qs + tok * QS_LD + d0 + 8 * hh); v4u o;
            o.x = pk2(bflo(q.x) * e, bfhi(q.x) * e); o.y = pk2(bflo(q.y) * e, bfhi(q.y) * e); o.z = pk2(bflo(q.z) * e, bfhi(q.z) * e); o.w = pk2(bflo(q.w) * e, bfhi(q.w) * e);
            *(v4u*)(gq + ((((tok >> 4) * 4 + ((F.tid & 7) >> 1)) * 64 + (2 * (F.tid & 1) + hh) * 16 + (tok & 15)) * 8)) = o; }
    }
    {
        const int dk = F.tid & 127, tg = F.tid >> 7;
        unsigned o1[8], o2[8];
#pragma unroll
        for (int i = 0; i < 8; ++i) {
            const int ta = 16 * tg + 2 * i, tb2 = ta + 1;
            const float ka = bf2f(ks[ta * QS_LD + dk]), kb = bf2f(ks[tb2 * QS_LD + dk]);
            const float ga = Gs[128 + ta], gb = Gs[128 + tb2];
            o1[i] = pk2(ka * Gs[64 + ta] * __expf(ga), kb * Gs[64 + tb2] * __expf(gb));
            o2[i] = pk2(ka * __expf(glast - ga), kb * __expf(glast - gb));
        }
        LAS v4u* d1 = (LAS v4u*)(kbgT + dk * KT_LD + 16 * tg); d1[0] = (v4u){o1[0], o1[1], o1[2], o1[3]}; d1[1] = (v4u){o1[4], o1[5], o1[6], o1[7]};
        bf16* d2 = WSP(bf16, WS_GKT) + chunk * 8192 + ((((dk >> 4) * 2 + (tg >> 1)) * 64 + (2 * (tg & 1)) * 16 + (dk & 15)) * 8);
        *(v4u*)d2 = (v4u){o2[0], o2[1], o2[2], o2[3]}; *(v4u*)(d2 + 16 * 8) = (v4u){o2[4], o2[5], o2[6], o2[7]};
    }
    if (F.tid == 0) WSP(float, WS_GDEC)[chunk] = __expf(glast);
    __syncthreads();
    LAS float* Tf = (LAS float*)(L + P2_TF); LAS float* Xf = (LAS float*)(L + P2_XF);
    if (w == 0) {
        const int blk = lane >> 5, cc = lane & 31; const LAS float* Ab = Am + (32 * blk) * AM_LD + 32 * blk;
        float t[32];
#pragma unroll
        for (int i = 0; i < 32; ++i) {
            float acc0 = (i == cc) ? 1.f : 0.f, acc1 = 0.f, acc2 = 0.f, acc3 = 0.f;
#pragma unroll
            for (int j4 = 0; j4 < (i + 3) / 4; ++j4) {
                const f32x4 a = *(const LAS f32x4*)(Ab + i * AM_LD + 4 * j4);
                if (4 * j4 + 0 < i) acc0 = __builtin_fmaf(-a.x, t[4 * j4 + 0], acc0);
                if (4 * j4 + 1 < i) acc1 = __builtin_fmaf(-a.y, t[4 * j4 + 1], acc1);
                if (4 * j4 + 2 < i) acc2 = __builtin_fmaf(-a.z, t[4 * j4 + 2], acc2);
                if (4 * j4 + 3 < i) acc3 = __builtin_fmaf(-a.w, t[4 * j4 + 3], acc3);
            }
            t[i] = (acc0 + acc1) + (acc2 + acc3);
            asm volatile("" : "+v"(t[i]));
            __builtin_amdgcn_sched_barrier(0);
        }
#pragma unroll
        for (int i = 0; i < 32; ++i) { Tf[(32 * blk + i) * AM_LD + 32 * blk + cc] = t[i]; if (blk == 0) Tf[i * AM_LD + 32 + cc] = 0.f; }
    }
    __syncthreads();
    {
        const int i = F.tid >> 4, c0 = (F.tid & 15) * 2; float x0 = 0.f, x1 = 0.f;
#pragma unroll 8
        for (int k = 0; k < 32; ++k) { const float a = Am[(32 + i) * AM_LD + k]; x0 = __builtin_fmaf(a, Tf[k * AM_LD + c0], x0); x1 = __builtin_fmaf(a, Tf[k * AM_LD + c0 + 1], x1); }
        Xf[i * 34 + c0] = x0; Xf[i * 34 + c0 + 1] = x1;
    }
    __syncthreads();
    {
        const int i = F.tid >> 4, c0 = (F.tid & 15) * 2; float x0 = 0.f, x1 = 0.f;
#pragma unroll 8
        for (int k = 0; k < 32; ++k) { const float a = Tf[(32 + i) * AM_LD + 32 + k]; x0 = __builtin_fmaf(a, Xf[k * 34 + c0], x0); x1 = __builtin_fmaf(a, Xf[k * 34 + c0 + 1], x1); }
        Tf[(32 + i) * AM_LD + c0] = -x0; Tf[(32 + i) * AM_LD + c0 + 1] = -x1;
    }
    __syncthreads();
    {
        const int i = F.tid >> 3, c0 = (F.tid & 7) * 8; const f32x4 a = *(const LAS f32x4*)(Tf + i * AM_LD + c0), b2 = *(const LAS f32x4*)(Tf + i * AM_LD + c0 + 4);
        *(LAS v4u*)(Tb + i * TB_LD + c0) = (v4u){pk2(a.x, a.y), pk2(a.z, a.w), pk2(b2.x, b2.y), pk2(b2.z, b2.w)};
    }
    __syncthreads();
    {
        bf16x8 tb[4][2];
#pragma unroll
        for (int x = 0; x < 4; ++x)
#pragma unroll
            for (int s = 0; s < 2; ++s) tb[x][s] = ld8l(Tb + (16 * x + fr) * TB_LD + 32 * s + 8 * fq);
        const bf16x8 bv0 = ld8l(vbT + (16 * w + fr) * KT_LD + 8 * fq), bv1 = ld8l(vbT + (16 * w + fr) * KT_LD + 32 + 8 * fq);
        bf16* gu = WSP(bf16, WS_GU) + chunk * 8192 + ((size_t)((w >> 1) * 4 * 64 + lane) * 2 + (w & 1)) * 4;
#pragma unroll
        for (int mt = 0; mt < 4; ++mt) { f32x4 acc = {0.f, 0.f, 0.f, 0.f}; acc = MFMA16(tb[mt][0], bv0, acc); acc = MFMA16(tb[mt][1], bv1, acc); *(v2u*)(gu + mt * 64 * 8) = (v2u){pk2(acc[0], acc[1]), pk2(acc[2], acc[3])}; }
        const bf16x8 ak0 = ld8l(kbgT + (16 * w + fr) * KT_LD + 8 * fq), ak1 = ld8l(kbgT + (16 * w + fr) * KT_LD + 32 + 8 * fq);
        bf16* gw = WSP(bf16, WS_GW) + chunk * 8192;
#pragma unroll
        for (int nt = 0; nt < 4; ++nt) { f32x4 acc = {0.f, 0.f, 0.f, 0.f}; acc = MFMA16(ak0, tb[nt][0], acc); acc = MFMA16(ak1, tb[nt][1], acc);
            v2u o; o.x = pk2(acc[0], acc[1]); o.y = pk2(acc[2], acc[3]);
            *(v2u*)(gw + (((nt * 4 + (w >> 1)) * 64 + (2 * (w & 1) + (fq >> 1)) * 16 + fr) * 8 + 4 * (fq & 1))) = o; }
    }
    __syncthreads();
}

constexpr int S2_Y = 0;
constexpr int S2_AB = 6144;
constexpr int S2_DOT = 6400;
constexpr int S2_U = 6656;
constexpr int S2_W = 8704;
constexpr int S2_VN = 10752;
__device__ __forceinline__ void p2_sample(Frame& F, int unit) {
    const int h = unit & 7, bs = unit >> 3, tid = F.tid, lane = F.lane, w = F.wave;
    LAS unsigned char* L = F.lds; asm volatile("" : "+v"(L));
    LAS float* Y = (LAS float*)(L + S2_Y); LAS float* AB = (LAS float*)(L + S2_AB); LAS float* DOT = (LAS float*)(L + S2_DOT);
    LAS float* U = (LAS float*)(L + S2_U); LAS float* W = (LAS float*)(L + S2_W); LAS float* VN = (LAS float*)(L + S2_VN);
    const bf16* PROJ = WSP(bf16, WS_PROJ); const bf16* XNA = WSP(bf16, WS_XNA); const float* WAB = WSP(float, WS_WAB);
    const size_t row0 = (size_t)MP + bs * 4;
    if (tid < 384) {
        const int part = tid >> 7, cc = tid & 127, col = part * 1024 + h * 128 + cc;
        float buf[7];
#pragma unroll
        for (int r = 0; r < 3; ++r) buf[r] = FIN(5)[((size_t)bs * 3 + r) * GCONV + col];
#pragma unroll
        for (int i = 0; i < 4; ++i) buf[3 + i] = bf2f(PROJ[(row0 + i) * 4096 + col]);
#pragma unroll
        for (int r = 0; r < 3; ++r) F.out[O_CONVS + ((size_t)bs * 3 + r) * GCONV + col] = buf[4 + r];
        float cw[4];
#pragma unroll
        for (int i = 0; i < 4; ++i) cw[i] = FIN(9)[(size_t)i * GCONV + col];
#pragma unroll
        for (int i = 0; i < 4; ++i) { float y = 0.f;
#pragma unroll
            for (int k = 0; k < 4; ++k) y += cw[k] * buf[i + k];
            Y[(part * 4 + i) * 128 + cc] = silu_f(y); }
    }
    {
        const int i = w >> 1, which = w & 1; const bf16* xr = XNA + (row0 + i) * DM; const float* wr = WAB + (size_t)(which * 8 + h) * DM; float s = 0.f;
        for (int k = lane; k < DM; k += 64) s += bf2f(xr[k]) * wr[k];
        s = wave_sum(s); if (lane == 0) AB[which * 4 + i] = s;
    }
    __syncthreads();
    {
        const int part = w >> 2, i = w & 3; LAS float* y = Y + (part * 4 + i) * 128; const float a = y[lane], bq = y[64 + lane];
        const float ss = wave_sum(a * a + bq * bq); const float rs = (frsq(ss + EPS)) * (part == 0 ? 0.08838834764831845f : 1.f);
        y[lane] = a * rs; y[64 + lane] = bq * rs;
    }
    if (tid == 0) { const float Aneg = -expf(FIN(10)[h]), dtb = FIN(11)[h]; float gc = 0.f;
        for (int i = 0; i < 4; ++i) { const float g = Aneg * softplus_f(AB[i] + dtb); gc += g; AB[8 + i] = g; AB[12 + i] = 1.f / (1.f + expf(-AB[4 + i])); AB[16 + i] = gc; } }
    __syncthreads();
    {
#pragma unroll
        for (int pp = 0; pp < 4; ++pp) { const int pr = 4 * w + pp, which = pr >> 4, i = (pr >> 2) & 3, j = pr & 3;
            const LAS float* x = Y + ((which == 0 ? 1 : 0) * 4 + i) * 128; const LAS float* y = Y + (1 * 4 + j) * 128;
            float s = x[lane] * y[lane] + x[64 + lane] * y[64 + lane]; s = wave_sum(s); if (lane == 0) DOT[pr] = s; }
    }
    __syncthreads();
    float g_[4], be[4], gc[4];
#pragma unroll
    for (int i = 0; i < 4; ++i) { g_[i] = AB[8 + i]; be[i] = AB[12 + i]; gc[i] = AB[16 + i]; }
    float Tm[4][4];
    {
        float A[4][4];
#pragma unroll
        for (int i = 0; i < 4; ++i)
#pragma unroll
            for (int j = 0; j < 4; ++j) A[i][j] = (i > j) ? be[i] * DOT[i * 4 + j] * expf(gc[i] - gc[j]) : 0.f;
#pragma unroll
        for (int cc = 0; cc < 4; ++cc)
#pragma unroll
            for (int i = 0; i < 4; ++i) { float acc = (i == cc) ? 1.f : 0.f;
#pragma unroll
                for (int j = 0; j < 4; ++j) if (j < i) acc -= A[i][j] * Tm[j][cc];
                Tm[i][cc] = acc; }
    }
    {
        const int i = tid >> 7, x = tid & 127; float su = 0.f, sw = 0.f;
#pragma unroll
        for (int j = 0; j < 4; ++j) { su += Tm[i][j] * Y[(2 * 4 + j) * 128 + x] * be[j]; sw += Tm[i][j] * Y[(1 * 4 + j) * 128 + x] * be[j] * expf(gc[j]); }
        U[i * 128 + x] = su; W[i * 128 + x] = sw;
    }
    __syncthreads();
    const float* S0 = FIN(4) + ((size_t)bs * GH + h) * 128 * 128;
    const int dv = tid & 127, dg = tid >> 7;
    LAS float* SL = (LAS float*)(L + 32768);
#pragma unroll 16
    for (int r = 0; r < 32; ++r) SL[(32 * dg + r) * 128 + dv] = S0[(size_t)(32 * dg + r) * 128 + dv];
    LAS float* PP = (LAS float*)(L + 16384); LAS float* PQ = (LAS float*)(L + 16384 + 8192);
    {
        float pp[4] = {0.f, 0.f, 0.f, 0.f}, qp[4] = {0.f, 0.f, 0.f, 0.f};
#pragma unroll
        for (int r = 0; r < 32; ++r) { const int dk = 32 * dg + r; const float sv = SL[dk * 128 + dv];
#pragma unroll
            for (int i = 0; i < 4; ++i) { pp[i] += W[i * 128 + dk] * sv; qp[i] += Y[(0 * 4 + i) * 128 + dk] * sv; } }
#pragma unroll
        for (int i = 0; i < 4; ++i) { PP[(dg * 4 + i) * 128 + dv] = pp[i]; PQ[(dg * 4 + i) * 128 + dv] = qp[i]; }
    }
    __syncthreads();
    float qs_acc;
    {
        const int i = tid >> 7;
        const float p = (PP[(0 * 4 + i) * 128 + dv] + PP[(1 * 4 + i) * 128 + dv]) + (PP[(2 * 4 + i) * 128 + dv] + PP[(3 * 4 + i) * 128 + dv]);
        const float qq = (PQ[(0 * 4 + i) * 128 + dv] + PQ[(1 * 4 + i) * 128 + dv]) + (PQ[(2 * 4 + i) * 128 + dv] + PQ[(3 * 4 + i) * 128 + dv]);
        VN[i * 128 + dv] = U[i * 128 + dv] - p; qs_acc = qq * expf(gc[i]);
    }
    __syncthreads();
    {
        const int i = tid >> 7; float o = qs_acc;
#pragma unroll
        for (int j = 0; j < 4; ++j) if (j <= i) o += DOT[16 + i * 4 + j] * expf(gc[i] - gc[j]) * VN[j * 128 + dv];
        WSP(bf16, WS_OGDN)[(row0 + i) * DM + h * 128 + dv] = (bf16)f2bf(o);
    }
    {
        const float el = expf(gc[3]);
        float kd[4], vn[4];
#pragma unroll
        for (int j = 0; j < 4; ++j) { kd[j] = expf(gc[3] - gc[j]); vn[j] = VN[j * 128 + dv]; }
        float* So = F.out + O_GDNS + ((size_t)bs * GH + h) * 128 * 128;
#pragma unroll
        for (int r = 0; r < 32; ++r) { const int dk = 32 * dg + r; float sv = SL[dk * 128 + dv] * el;
#pragma unroll
            for (int j = 0; j < 4; ++j) sv += Y[(1 * 4 + j) * 128 + dk] * kd[j] * vn[j];
            So[(size_t)dk * 128 + dv] = sv; }
    }
    (void)g_;
    __syncthreads();
}

constexpr int P3_S = 0;
constexpr int P3_VN = 16384;
__device__ __forceinline__ void p3_scan(Frame& F, int bh, int s) {
    const int lane = F.lane, w = F.wave, fr = lane & 15, fq = lane >> 4;
    const int b = bh >> 3, h = bh & 7;
    LAS bf16* Sl = (LAS bf16*)(F.lds + P3_S); LAS bf16* Vl = (LAS bf16*)(F.lds + P3_VN);
    const bf16* GW = WSP(bf16, WS_GW); const bf16* GQ = WSP(bf16, WS_GQ); const bf16* GKT = WSP(bf16, WS_GKT); const bf16* GQK = WSP(bf16, WS_GQK);
    const bf16* GU = WSP(bf16, WS_GU); const float* GDEC = WSP(float, WS_GDEC);
    bf16* OG = WSP(bf16, WS_OGDN);
    f32x4 Sacc[2];
#pragma unroll
    for (int n = 0; n < 2; ++n) { Sacc[n] = (f32x4){0.f, 0.f, 0.f, 0.f}; v2u z = {0u, 0u}; *(LAS v2u*)(Sl + (n * 16 + fr) * 136 + 16 * w + 4 * fq) = z; }
    __syncthreads();
    const int m = w & 3;
    struct P3Ops { bf16x8 a1[4], ak0, ak1; v4u x0, x1; float dec; };
    P3Ops R0, R1, R2;
#define P3_FETCH(R, cc) do { const size_t ch_ = (size_t)bh * NCH + (cc); \
        const bf16* p1_ = (w < 4 ? GW : GQ) + ch_ * 8192 + (size_t)(m * 4 * 64 + lane) * 8;        \
        _Pragma("unroll") for (int k_ = 0; k_ < 4; ++k_) R.a1[k_] = ld8(p1_ + 512 * k_); \
        const bf16* pk_ = GKT + ch_ * 8192 + (size_t)(w * 2 * 64 + lane) * 8; R.ak0 = ld8(pk_); R.ak1 = ld8(pk_ + 512); \
        const unsigned char* px_ = w < 4 ? (const unsigned char*)(GU + ch_ * 8192 + ((size_t)(s * 4 + m) * 64 + lane) * 8) : (const unsigned char*)(GQK + ch_ * 4096 + (size_t)(m * 2 * 64 + lane) * 8); \
        R.x0 = *(const v4u*)px_; R.x1 = *(const v4u*)(px_ + (w < 4 ? 0 : 1024));        \
        R.dec = GDEC[ch_]; } while (0)
#define P3_STEP(R, c) do { \
        f32x4 acc[2]; \
        _Pragma("unroll") for (int n = 0; n < 2; ++n) { acc[n] = (f32x4){0.f, 0.f, 0.f, 0.f}; \
            _Pragma("unroll") for (int k = 0; k < 4; ++k) acc[n] = MFMA16(R.a1[k], ld8l(Sl + (n * 16 + fr) * 136 + 32 * k + 8 * fq), acc[n]); } \
        if (w < 4) { _Pragma("unroll") for (int n = 0; n < 2; ++n) { const unsigned ua_ = n == 0 ? R.x0.x : R.x0.z, ub_ = n == 0 ? R.x0.y : R.x0.w; const f32x4 vn = (f32x4){bflo(ua_), bfhi(ua_), bflo(ub_), bfhi(ub_)} - acc[n]; v2u o; o.x = pk2(vn[0], vn[1]); o.y = pk2(vn[2], vn[3]); \
            *(LAS v2u*)(Vl + (n * 16 + fr) * 72 + 16 * m + 4 * fq) = o; } } \
        asm volatile("s_waitcnt lgkmcnt(0)\n\ts_barrier" ::: "memory"); \
        bf16x8 v0[2], v1[2]; \
        _Pragma("unroll") for (int n = 0; n < 2; ++n) { v0[n] = ld8l(Vl + (n * 16 + fr) * 72 + 8 * fq); v1[n] = ld8l(Vl + (n * 16 + fr) * 72 + 32 + 8 * fq); } \
        if (w >= 4) { _Pragma("unroll") for (int n = 0; n < 2; ++n) { acc[n] = MFMA16(__builtin_bit_cast(bf16x8, R.x0), v0[n], acc[n]); acc[n] = MFMA16(__builtin_bit_cast(bf16x8, R.x1), v1[n], acc[n]); \
            bf16* o = OG + ((size_t)b * PT + (c) * CHUNK + 16 * m + 4 * fq) * DM + h * 128 + 32 * s + 16 * n + fr; \
            _Pragma("unroll") for (int r = 0; r < 4; ++r) o[(size_t)r * DM] = (bf16)f2bf(acc[n][r]); } } \
        { float d_ = R.dec;        \
          _Pragma("unroll") for (int n = 0; n < 2; ++n) asm volatile("v_mul_f32 %0, %0, %4\n\tv_mul_f32 %1, %1, %4\n\tv_mul_f32 %2, %2, %4\n\tv_mul_f32 %3, %3, %4" : "+v"(Sacc[n][0]), "+v"(Sacc[n][1]), "+v"(Sacc[n][2]), "+v"(Sacc[n][3]) : "v"(d_)); } \
        _Pragma("unroll") for (int n = 0; n < 2; ++n) { Sacc[n] = MFMA16(R.ak0, v0[n], Sacc[n]); Sacc[n] = MFMA16(R.ak1, v1[n], Sacc[n]); \
            v2u o; o.x = pk2(Sacc[n][0], Sacc[n][1]); o.y = pk2(Sacc[n][2], Sacc[n][3]); *(LAS v2u*)(Sl + (n * 16 + fr) * 136 + 16 * w + 4 * fq) = o; } \
        asm volatile("s_waitcnt lgkmcnt(0)\n\ts_barrier" ::: "memory"); } while (0)
    P3_FETCH(R0, 0); __builtin_amdgcn_sched_barrier(0); P3_FETCH(R1, 1); __builtin_amdgcn_sched_barrier(0); P3_FETCH(R2, 2); __builtin_amdgcn_sched_barrier(0);
    static_assert(NCH % 3 == 2, "ring schedule below assumes NCH = 3k + 2");
#pragma unroll 1
    for (int c = 0; c + 3 <= NCH; c += 3) {
        P3_STEP(R0, c);     P3_FETCH(R0, (c + 3 < NCH ? c + 3 : NCH - 1));
        P3_STEP(R1, c + 1); P3_FETCH(R1, (c + 4 < NCH ? c + 4 : NCH - 1));
        P3_STEP(R2, c + 2); P3_FETCH(R2, (c + 5 < NCH ? c + 5 : NCH - 1));
    }
    P3_STEP(R0, NCH - 2); P3_STEP(R1, NCH - 1);
#undef P3_FETCH
#undef P3_STEP
    float* So = F.out + O_GDNP + ((size_t)bh * 128) * 128;
#pragma unroll
    for (int n = 0; n < 2; ++n)
#pragma unroll
        for (int r = 0; r < 4; ++r) So[(size_t)(16 * w + 4 * fq + r) * 128 + 32 * s + 16 * n + fr] = Sacc[n][r];
}

__device__ __forceinline__ void p4_rows(Frame& F, int first, int stride) {
    const int lane = F.lane;
    if (first >= MTOK) return;
    float gn[16];
    { const f32x4* gp = (const f32x4*)(FIN(12) + (16 * lane & 127));
#pragma unroll
      for (int j = 0; j < 4; ++j) { const f32x4 g4 = gp[j]; gn[4 * j] = g4.x; gn[4 * j + 1] = g4.y; gn[4 * j + 2] = g4.z; gn[4 * j + 3] = g4.w; } }
    v4u no0, no1, nz0, nz1;
#define P4_FETCH(rw) do { const bf16* o_ = WSP(bf16, WS_OGDN) + (size_t)(rw) * DM + 16 * lane; const bf16* z_ = WSP(bf16, WS_PROJ) + (size_t)(rw) * 4096 + 3072 + 16 * lane; \
        no0 = *(const v4u*)o_; no1 = *(const v4u*)(o_ + 8); nz0 = *(const v4u*)z_; nz1 = *(const v4u*)(z_ + 8); } while (0)
    P4_FETCH(first);
#pragma unroll 1
    for (int row = first; row < MTOK; row += stride) {
        f32x4 v[4]; const v4u z0 = nz0, z1 = nz1; float ss = 0.f;
#pragma unroll
        for (int j = 0; j < 4; ++j) { const unsigned wa = j < 2 ? (j == 0 ? no0.x : no0.z) : (j == 2 ? no1.x : no1.z), wb = j < 2 ? (j == 0 ? no0.y : no0.w) : (j == 2 ? no1.y : no1.w);
            v[j] = (f32x4){bflo(wa), bfhi(wa), bflo(wb), bfhi(wb)}; ss += (v[j].x * v[j].x + v[j].y * v[j].y) + (v[j].z * v[j].z + v[j].w * v[j].w); }
        { const int nr = row + stride < MTOK ? row + stride : row; P4_FETCH(nr); }
        ss += dpp_f<DPP_XOR1>(ss); ss += dpp_f<DPP_XOR2>(ss); ss += dpp_f<DPP_HMIR>(ss);
        const float rstd = frsq(ss * (1.f / 128.f) + EPS);
        float zz[16] = {bflo(z0.x), bfhi(z0.x), bflo(z0.y), bfhi(z0.y), bflo(z0.z), bfhi(z0.z), bflo(z0.w), bfhi(z0.w),
                        bflo(z1.x), bfhi(z1.x), bflo(z1.y), bfhi(z1.y), bflo(z1.z), bfhi(z1.z), bflo(z1.w), bfhi(z1.w)};
        unsigned ow[8];
#pragma unroll
        for (int j = 0; j < 8; ++j) { const float a = v[j >> 1][(2 * j) & 3] * rstd * gn[2 * j] * silu_f(zz[2 * j]), bq = v[j >> 1][(2 * j + 1) & 3] * rstd * gn[2 * j + 1] * silu_f(zz[2 * j + 1]); ow[j] = pk2(a, bq); }
        v4u* dst = (v4u*)(WSP(bf16, WS_OG) + (size_t)row * DM + 16 * lane);
        dst[0] = (v4u){ow[0], ow[1], ow[2], ow[3]}; dst[1] = (v4u){ow[4], ow[5], ow[6], ow[7]};
    }
#undef P4_FETCH
}

typedef __bf16 bf16x2_t __attribute__((ext_vector_type(2)));
__device__ __forceinline__ float dot2_bf16(unsigned w, unsigned x, float acc) { return __builtin_amdgcn_fdot2_f32_bf16(__builtin_bit_cast(bf16x2_t, w), __builtin_bit_cast(bf16x2_t, x), acc, false); }
__device__ __forceinline__ float u2f(unsigned u) { return __builtin_bit_cast(float, u); }
__device__ __forceinline__ unsigned f2u(float f) { return __builtin_bit_cast(unsigned, f); }

constexpr int P8_MAXU = 4;
constexpr int P8_WAVE = P8_MAXU * 2048 + 1024;
constexpr int P8_TOP = 0;
constexpr int P8_TAB = 8 * P8_WAVE;
__device__ __forceinline__ void p8_init_tab(Frame& F) {
    LAS unsigned char* tab = F.lds + P8_TAB;
    if (F.tid < 64) { const int k = F.tid; int i = 0, j = 0;
        if (k < 16) { i = 0; j = k; } else if (k < 24) { i = 1; j = k - 16; } else if (k < 29) { i = 2; j = k - 24; } else if (k < 33) { i = 3; j = k - 29; }
        else if (k < 36) { i = 4; j = k - 33; } else if (k < 38) { i = 5; j = k - 36; } else if (k < 40) { i = 6; j = k - 38; } else if (k < 42) { i = 7; j = k - 40; } else if (k < 50) { i = k - 34; j = 0; }
        tab[k] = (unsigned char)i; tab[64 + k] = (unsigned char)j; }
    __syncthreads();
}
__device__ __forceinline__ int fkey(float x) { const int b = __builtin_bit_cast(int, x); return b ^ ((b >> 31) & 0x7fffffff); }
__device__ __forceinline__ float fkey_inv(int k) { return __builtin_bit_cast(float, k ^ ((k >> 31) & 0x7fffffff)); }
template <int CTRL> __device__ __forceinline__ int dpp_i(int x) { return __builtin_amdgcn_update_dpp(0, x, CTRL, 0xF, 0xF, true); }
__device__ __forceinline__ int imax(int a, int b) { return a > b ? a : b; }
__device__ __forceinline__ int imin(int a, int b) { return a < b ? a : b; }
__device__ __forceinline__ int row_imax16(int x) {
    x = imax(x, dpp_i<0xB1>(x)); x = imax(x, dpp_i<0x4E>(x)); x = imax(x, dpp_i<0x141>(x)); x = imax(x, dpp_i<0x140>(x)); return x;
}
#define ICSWAP(a, b) { const int hi_ = imax(a, b), lo_ = imin(a, b); a = hi_; b = lo_; }
constexpr int IKEY_MIN = (int)0x80000000;
template <int NR>
__device__ __forceinline__ void p8_run(Frame& F, int layer, int w, int rq, int u0, int ustride, int nu) {
    int lane_ = F.lane; asm volatile("" : "+v"(lane_));
    const int lane = lane_, fr = lane & 15, fq = lane >> 4;
    LAS unsigned char* L = F.lds; asm volatile("" : "+v"(L));
    LAS int* toplw = (LAS int*)(L + P8_TOP + F.wave * P8_WAVE);
    LAS float* wins = (LAS float*)(L + P8_TOP + F.wave * P8_WAVE + P8_MAXU * 2048);
    const LAS unsigned char* tab = L + P8_TAB;
    const bf16* Qb = WSP(bf16, WS_QPEER) + (size_t)fr * 2048 + w * 256 + 8 * fq;
    const bf16* SK = WSP(bf16, WS_SUBK) + (size_t)((layer * 8 + w) * 2) * 16384 + (size_t)fr * 128 + 8 * fq;
#pragma unroll 1
    for (int p = 0; p < 2; ++p) {
        bf16x8 bk[32], aq[4];
#pragma unroll
        for (int i = 0; i < 32; ++i) bk[i] = ld8(SK + (size_t)p * 16384 + (size_t)(i >> 2) * 2048 + 32 * (i & 3));
#pragma unroll
        for (int ks = 0; ks < 4; ++ks) aq[ks] = ld8(Qb + (size_t)u0 * 16 * 2048 + p * 128 + 32 * ks);
#pragma unroll 1
        for (int k = 0; k < nu; ++k) {
            LAS int* topl = toplw + k * 512;
            int s[NR][8];
#pragma unroll
            for (int nt = 0; nt < 8; ++nt) { f32x4 acc = {0.f, 0.f, 0.f, 0.f};
#pragma unroll
                for (int ks = 0; ks < 4; ++ks) acc = MFMA16(aq[ks], bk[nt * 4 + ks], acc);
                if (NR == 4) {
#pragma unroll
                    for (int r = 0; r < NR; ++r) s[r][nt] = fkey(u2f((f2u(acc[r]) & ~127u) | (unsigned)(16 * nt + fr)));
                } else { const float av = rq == 0 ? acc[0] : rq == 1 ? acc[1] : rq == 2 ? acc[2] : acc[3]; s[0][nt] = fkey(u2f((f2u(av) & ~127u) | (unsigned)(16 * nt + fr))); } }
            { const int un = u0 + (k + 1 < nu ? k + 1 : k) * ustride;
#pragma unroll
              for (int ks = 0; ks < 4; ++ks) aq[ks] = ld8(Qb + (size_t)un * 16 * 2048 + p * 128 + 32 * ks); }
#pragma unroll
            for (int r = 0; r < NR; ++r) {
                ICSWAP(s[r][0], s[r][1]) ICSWAP(s[r][2], s[r][3]) ICSWAP(s[r][4], s[r][5]) ICSWAP(s[r][6], s[r][7])
                ICSWAP(s[r][0], s[r][2]) ICSWAP(s[r][1], s[r][3]) ICSWAP(s[r][4], s[r][6]) ICSWAP(s[r][5], s[r][7])
                ICSWAP(s[r][1], s[r][2]) ICSWAP(s[r][5], s[r][6]) ICSWAP(s[r][0], s[r][4]) ICSWAP(s[r][3], s[r][7])
                ICSWAP(s[r][1], s[r][5]) ICSWAP(s[r][2], s[r][6]) ICSWAP(s[r][1], s[r][4]) ICSWAP(s[r][3], s[r][6])
                ICSWAP(s[r][2], s[r][4]) ICSWAP(s[r][3], s[r][5]) ICSWAP(s[r][3], s[r][4]) }
            int mine[NR];
#pragma unroll
            for (int r = 0; r < NR; ++r) mine[r] = IKEY_MIN;
#pragma unroll 1
            for (int rd = 0; rd < 16; ++rd) {
                const bool me = fr == rd;
#pragma unroll
                for (int r = 0; r < NR; ++r) {
                    const int mx = row_imax16(s[r][0]);
                    const bool pop = s[r][0] == mx;
#pragma unroll
                    for (int i = 0; i < 7; ++i) s[r][i] = pop ? s[r][i + 1] : s[r][i];
                    s[r][7] = pop ? IKEY_MIN : s[r][7];
                    mine[r] = me ? mx : mine[r];
                }
            }
#pragma unroll
            for (int r = 0; r < NR; ++r) topl[((4 * fq + (NR == 4 ? r : rq)) * 2 + p) * 16 + fr] = mine[r];
        }
    }
    LDS_WAIT();
#pragma unroll 1
    for (int k = 0; k < nu; ++k) {
    LAS int* topl = toplw + k * 512;
    const int r0 = (u0 + k * ustride) * 16;
    int c[NR][4];
#pragma unroll
    for (int r = 0; r < NR; ++r) { const int tk = 4 * fq + (NR == 4 ? r : rq);
#pragma unroll
        for (int m = 0; m < 4; ++m) { const int kc = fr + 16 * m; int cv = IKEY_MIN;
            if (kc < 50) { const int i = tab[kc], j = tab[64 + kc]; const float s1 = u2f(f2u(fkey_inv(topl[(tk * 2 + 0) * 16 + i])) & ~127u), s2 = u2f(f2u(fkey_inv(topl[(tk * 2 + 1) * 16 + j])) & ~127u);
                cv = fkey(u2f((f2u(s1 + s2) & ~63u) | (unsigned)kc)); }
            c[r][m] = cv; }
        ICSWAP(c[r][0], c[r][1]) ICSWAP(c[r][2], c[r][3]) ICSWAP(c[r][0], c[r][2]) ICSWAP(c[r][1], c[r][3]) ICSWAP(c[r][1], c[r][2]) }
    int minec[NR];
#pragma unroll
    for (int r = 0; r < NR; ++r) minec[r] = IKEY_MIN;
#pragma unroll 1
    for (int rd = 0; rd < 16; ++rd) {
        const bool me = fr == rd;
#pragma unroll
        for (int r = 0; r < NR; ++r) {
            const int mx = row_imax16(c[r][0]);
            const bool pop = c[r][0] == mx;
            c[r][0] = pop ? c[r][1] : c[r][0]; c[r][1] = pop ? c[r][2] : c[r][1]; c[r][2] = pop ? c[r][3] : c[r][2]; c[r][3] = pop ? IKEY_MIN : c[r][3];
            minec[r] = me ? mx : minec[r];
        }
    }
#pragma unroll
    for (int r = 0; r < NR; ++r) wins[(4 * fq + (NR == 4 ? r : rq)) * 16 + fr] = fkey_inv(minec[r]);
    LDS_WAIT();
    if (NR == 4 || (fr >> 2) == rq) {
        const int tk = 4 * fq + (fr >> 2), q4 = fr & 3;
        const float w0 = wins[tk * 16]; float den = 0.f;
#pragma unroll
        for (int rd = 0; rd < 16; ++rd) den += __expf(wins[tk * 16 + rd] - w0);
        const float inv = 1.f / den;
        int e[4]; float g[4];
#pragma unroll
        for (int x = 0; x < 4; ++x) { const float wv = wins[tk * 16 + 4 * q4 + x]; const int kc = (int)(f2u(wv) & 63u); const int i = tab[kc], j = tab[64 + kc];
            e[x] = (int)(f2u(fkey_inv(topl[(tk * 2 + 0) * 16 + i])) & 127u) * 128 + (int)(f2u(fkey_inv(topl[(tk * 2 + 1) * 16 + j])) & 127u); g[x] = __expf(wv - w0) * inv; }
        unsigned short* pei = WSP(unsigned short, WS_PEI) + (size_t)(r0 + tk) * 128 + w * 16 + 4 * q4; float* peg = WSP(float, WS_PEG) + (size_t)(r0 + tk) * 128 + w * 16 + 4 * q4;
        *(v2u*)pei = (v2u){(unsigned)e[0] | ((unsigned)e[1] << 16), (unsigned)e[2] | ((unsigned)e[3] << 16)};
        *(f32x4*)peg = (f32x4){g[0], g[1], g[2], g[3]};
    }
    LDS_WAIT();
    }
}
__device__ __forceinline__ void p8_phase(Frame& F, int layer) {
    p8_init_tab(F);
    for (int ub = F.bid; ub < MP / 16; ub += F.G * P8_MAXU) { const int left = (MP / 16 - ub + F.G - 1) / F.G; p8_run<4>(F, layer, F.wave, 0, ub, F.G, left < P8_MAXU ? left : P8_MAXU); }
    for (int qu = F.bid * 8 + F.wave; qu < (MS / 16) * 8 * 4 * 8; qu += F.G * 8) { if ((qu & 7) == 0) { const int x = qu >> 3; p8_run<1>(F, layer, (x >> 2) & 7, x & 3, MP / 16 + (x >> 5), 0, 1); } }
}

constexpr size_t PE_SLICE_BYTES = (size_t)NEXP * 128;
__device__ __forceinline__ f32x2 p9_cvt(unsigned w, bool hi) { return hi ? __builtin_amdgcn_cvt_pk_f32_fp8((int)w, true) : __builtin_amdgcn_cvt_pk_f32_fp8((int)w, false); }
__device__ __forceinline__ f32x2 fma2(f32x2 a, f32x2 b, f32x2 c) { return __builtin_elementwise_fma(a, b, c); }
__device__ __forceinline__ float p9_dot16(const v4u u, const f32x2 (&h)[8]) {
    f32x2 a = {0.f, 0.f}, b = {0.f, 0.f};
    a = fma2(p9_cvt(u.x, false), h[0], a); b = fma2(p9_cvt(u.x, true), h[1], b); a = fma2(p9_cvt(u.y, false), h[2], a); b = fma2(p9_cvt(u.y, true), h[3], b);
    a = fma2(p9_cvt(u.z, false), h[4], a); b = fma2(p9_cvt(u.z, true), h[5], b); a = fma2(p9_cvt(u.w, false), h[6], a); b = fma2(p9_cvt(u.w, true), h[7], b);
    a = a + b; return a.x + a.y;
}
__device__ __forceinline__ void p9_axpy16(const v4u v, float c, f32x2 (&o)[8]) {
    const f32x2 cc = {c, c};
    o[0] = fma2(p9_cvt(v.x, false), cc, o[0]); o[1] = fma2(p9_cvt(v.x, true), cc, o[1]); o[2] = fma2(p9_cvt(v.y, false), cc, o[2]); o[3] = fma2(p9_cvt(v.y, true), cc, o[3]);
    o[4] = fma2(p9_cvt(v.z, false), cc, o[4]); o[5] = fma2(p9_cvt(v.z, true), cc, o[5]); o[6] = fma2(p9_cvt(v.w, false), cc, o[6]); o[7] = fma2(p9_cvt(v.w, true), cc, o[7]);
}
#define P9_GATHER(S, iw) do { _Pragma("unroll") for (int j_ = 0; j_ < 8; ++j_) { const unsigned w_ = (iw)[j_ >> 1]; const unsigned id_ = (j_ & 1) ? (w_ >> 16) : (w_ & 0xffffu); \
        S[j_] = *(const v4u*)(tab + ((id_ << 7) + sub16)); } } while (0)
__device__ __forceinline__ float swapsum16(float x, float y) { unsigned a = __builtin_bit_cast(unsigned, x), b = __builtin_bit_cast(unsigned, y); PSWAP16(a, b); return __builtin_bit_cast(float, a) + __builtin_bit_cast(float, b); }
__device__ __forceinline__ float swapsum32(float x, float y) { unsigned a = __builtin_bit_cast(unsigned, x), b = __builtin_bit_cast(unsigned, y); PSWAP32(a, b); return __builtin_bit_cast(float, a) + __builtin_bit_cast(float, b); }

__device__ __forceinline__ void p9u_wave(Frame& F, int layer, int slice, int first, int stride) {
    int lane_ = F.lane; asm volatile("" : "+v"(lane_));
    const int lane = lane_, gi = lane >> 3, sub = lane & 7;
    const unsigned char* tab = WSP(unsigned char, WS_PU) + (size_t)(layer * 8 + slice) * PE_SLICE_BYTES;
    const unsigned sub16 = (unsigned)sub * 16u;
    const unsigned char* hbase = (const unsigned char*)(WSP(bf16, WS_XNB) + slice * 128 + sub * 16);
    const unsigned char* ibase = (const unsigned char*)(WSP(unsigned short, WS_PEI) + gi * 16);
    unsigned* pa = WSP(unsigned, WS_PA) + slice * 64 + lane;
    int t = first; if (t >= MTOK) return;
    v4u ia, ib, ha, hb, nia, nib, nha, nhb, A[8], B[8];
#define P9U_META(tt, xa, xb, ya, yb) do { const v4u* ip_ = (const v4u*)(ibase + (size_t)(tt) * 256); xa = ip_[0]; xb = ip_[1]; const v4u* hp_ = (const v4u*)(hbase + (size_t)(tt) * 2048); ya = hp_[0]; yb = hp_[1]; } while (0)
    P9U_META(t, ia, ib, ha, hb);
    P9_GATHER(A, ia);
    const bool b0 = sub & 1, b1 = sub & 2, b2 = sub & 4;
#pragma unroll 1
    for (;;) {
        const int tn = t + stride; const bool more = tn < MTOK; const int tl = more ? tn : t;
        P9U_META(tl, nia, nib, nha, nhb);
        P9_GATHER(B, ib);
        f32x2 h[8];
#pragma unroll
        for (int k = 0; k < 4; ++k) { h[k] = (f32x2){bflo(ha[k]), bfhi(ha[k])}; h[4 + k] = (f32x2){bflo(hb[k]), bfhi(hb[k])}; }
        float p[16];
#pragma unroll
        for (int j = 0; j < 8; ++j) p[j] = p9_dot16(A[j], h);
        P9_GATHER(A, nia);
#pragma unroll
        for (int j = 0; j < 8; ++j) p[8 + j] = p9_dot16(B[j], h);
        float q[8], r[4], sv[2];
#pragma unroll
        for (int i = 0; i < 8; ++i) { const float keep = b2 ? p[8 + i] : p[i], send = b2 ? p[i] : p[8 + i]; q[i] = keep + dpp_f<DPP_HMIR>(send); }
#pragma unroll
        for (int i = 0; i < 4; ++i) { const float keep = b0 ? q[2 * i + 1] : q[2 * i], send = b0 ? q[2 * i] : q[2 * i + 1]; r[i] = keep + dpp_f<DPP_XOR1>(send); }
#pragma unroll
        for (int i = 0; i < 2; ++i) { const float keep = b1 ? r[2 * i + 1] : r[2 * i], send = b1 ? r[2 * i] : r[2 * i + 1]; sv[i] = keep + dpp_f<DPP_XOR2>(send); }
        pa[(size_t)t * 512] = pk2(sv[0], sv[1]);
        if (!more) break;
        t = tn; ia = nia; ib = nib; ha = nha; hb = nhb;
    }
#undef P9U_META
}

__device__ __forceinline__ void p9v_wave(Frame& F, int layer, int slice, int first, int stride, int mode) {
    int lane_ = F.lane; asm volatile("" : "+v"(lane_));
    const int lane = lane_, gi = lane >> 3, sub = lane & 7, j0 = 8 * (sub >> 2) + (sub & 3);
    const unsigned char* tab = WSP(unsigned char, WS_PV) + (size_t)(layer * 8 + slice) * PE_SLICE_BYTES;
    const unsigned sub16 = (unsigned)sub * 16u;
    const unsigned char* ibase = (const unsigned char*)(WSP(unsigned short, WS_PEI) + gi * 16);
    const unsigned* pab = WSP(unsigned, WS_PA) + lane;
    const float* pegb = WSP(float, WS_PEG) + gi * 16 + j0;
    const int eoff = slice * 128 + sub * 16 + gi;
    float* xsb = WSP(float, WS_XS) + eoff;
    int t = first; if (t >= MTOK) return;
    v4u ia, ib, nia, nib, A[8], B[8];
    unsigned pw[8], npw[8]; float g0, g1, ng0, ng1, x0, x1, nx0, nx1;
#define P9V_META(tt, xa, xb, pp, ga, gb, ya, yb) do { const v4u* ip_ = (const v4u*)(ibase + (size_t)(tt) * 256); xa = ip_[0]; xb = ip_[1]; \
        _Pragma("unroll") for (int x_ = 0; x_ < 8; ++x_) pp[x_] = pab[(size_t)(tt) * 512 + x_ * 64]; \
        ga = pegb[(size_t)(tt) * 128]; gb = pegb[(size_t)(tt) * 128 + 4]; ya = xsb[(size_t)(tt) * DM]; yb = xsb[(size_t)(tt) * DM + 8]; } while (0)
    P9V_META(t, ia, ib, pw, g0, g1, x0, x1);
    P9_GATHER(A, ia);
#pragma unroll 1
    for (;;) {
        const int tn = t + stride; const bool more = tn < MTOK; const int tl = more ? tn : t;
        P9V_META(tl, nia, nib, npw, ng0, ng1, nx0, nx1);
        P9_GATHER(B, ib);
        float alo = 0.f, ahi = 0.f;
#pragma unroll
        for (int x = 0; x < 8; ++x) { alo += bflo(pw[x]); ahi += bfhi(pw[x]); }
        const float c0 = gelu_tanh(alo * 0.03125f) * g0 * 0.0625f, c1 = gelu_tanh(ahi * 0.03125f) * g1 * 0.0625f;
        f32x2 o[8];
#pragma unroll
        for (int i = 0; i < 8; ++i) o[i] = (f32x2){0.f, 0.f};
#define P9V_C(j) __builtin_bit_cast(float, __builtin_amdgcn_ds_swizzle(__builtin_bit_cast(int, (((j) >> 2) & 1) ? c1 : c0), ((4 * ((j) >> 3) + ((j) & 3)) << 5) | 0x18))
        { const float cj[8] = {P9V_C(0), P9V_C(1), P9V_C(2), P9V_C(3), P9V_C(4), P9V_C(5), P9V_C(6), P9V_C(7)};
#pragma unroll
          for (int j = 0; j < 8; ++j) p9_axpy16(A[j], cj[j], o); }
        P9_GATHER(A, nia);
        { const float cj[8] = {P9V_C(8), P9V_C(9), P9V_C(10), P9V_C(11), P9V_C(12), P9V_C(13), P9V_C(14), P9V_C(15)};
#pragma unroll
          for (int j = 0; j < 8; ++j) p9_axpy16(B[j], cj[j], o); }
#undef P9V_C
        const bool g0b = lane & 8;
        float q[8], r[4], sv[2];
#pragma unroll
        for (int i = 0; i < 8; ++i) { const float keep = g0b ? o[i].y : o[i].x, send = g0b ? o[i].x : o[i].y; q[i] = keep + dpp_f<DPP_ROR8>(send); }
#pragma unroll
        for (int i = 0; i < 4; ++i) r[i] = swapsum16(q[2 * i], q[2 * i + 1]);
#pragma unroll
        for (int i = 0; i < 2; ++i) sv[i] = swapsum32(r[2 * i], r[2 * i + 1]);
        const float y0 = x0 + sv[0], y1 = x1 + sv[1];
        if (mode == 0) {
            float* xs = xsb + (size_t)t * DM; xs[0] = y0; xs[8] = y1;
            bf16* xn = WSP(bf16, WS_XNA) + (size_t)t * DM + eoff; xn[0] = (bf16)f2bf(y0); xn[8] = (bf16)f2bf(y1);
            const float ss = wave_sum(y0 * y0 + y1 * y1);
            if (lane == 0) WSP(float, WS_SSQ)[(size_t)t * 8 + slice] = ss;
        } else {
            float* y = (t < MP ? F.out + O_YP + (size_t)t * DM : F.out + O_YS + (size_t)(t - MP) * DM) + eoff;
            y[0] = y0; y[8] = y1;
        }
        if (!more) break;
        t = tn; ia = nia; ib = nib; g0 = ng0; g1 = ng1; x0 = nx0; x1 = nx1;
#pragma unroll
        for (int x = 0; x < 8; ++x) pw[x] = npw[x];
    }
#undef P9V_META
}
#undef P9_GATHER

constexpr float QSCALE = 0.125f * 1.4426950408889634f;
constexpr int PP_VT = 0;
__device__ __forceinline__ float rms64(float v) { return frsq(wave_sum(v * v) * (1.f / 64.f) + EPS); }

__device__ __forceinline__ void pp_q_row(Frame& F, int row, const bf16* kvq, const float qg) {
    const int lane = F.lane;
    bf16* qn = WSP(bf16, WS_QN) + (size_t)row * 1024;
#pragma unroll 4
    for (int hd = 0; hd < 16; ++hd) { const float v = bf2f(kvq[NKV + hd * 64 + lane]); qn[hd * 64 + lane] = (bf16)f2bf(v * rms64(v) * qg); }
    if (lane < 48) WSP(float, WS_GATES)[(size_t)row * 48 + lane] = sigmoid_f(bf2f(kvq[NKV + 1024 + lane]));
}
__device__ __forceinline__ f32x4 rms64x4(f32x4 v) { const float ss = row_sum16((v.x * v.x + v.y * v.y) + (v.z * v.z + v.w * v.w)); return v * (frsq(ss * (1.f / 64.f) + EPS)); }
__device__ __forceinline__ v2u pk4(f32x4 v) { return (v2u){pk2(v.x, v.y), pk2(v.z, v.w)}; }
__device__ __forceinline__ void pp_prompt_tile(Frame& F, int unit) {
    const int lane = F.lane, w = F.wave, b = unit >> 7, t0 = (unit & 127) * 64, g = lane >> 4, d4 = (lane & 15) * 4;
    LAS unsigned char* L = F.lds; asm volatile("" : "+v"(L));
    LAS bf16* vt = (LAS bf16*)(L + PP_VT);
    const f32x4 kg1 = *(const f32x4*)(FIN(16) + 64 + d4), kg2 = *(const f32x4*)(FIN(16) + 128 + d4), qg = *(const f32x4*)(FIN(22) + d4) * QSCALE;
    v2u nv[6], nq[4], ngl;
#define PP_FETCH(rr_) do { const int row_ = b * PT + t0 + 8 * w + ((rr_) < 8 ? (rr_) : 7); const v2u* kvq_ = (const v2u*)(WSP(bf16, WS_KVQ) + (size_t)row_ * NKVQ) + lane;        \
        _Pragma("unroll") for (int sidx_ = 0; sidx_ < 6; ++sidx_) nv[sidx_] = kvq_[64 * sidx_]; \
        _Pragma("unroll") for (int i_ = 0; i_ < 4; ++i_) nq[i_] = kvq_[64 * (6 + i_)]; \
        ngl = ((const v2u*)(WSP(bf16, WS_KVQ) + (size_t)row_ * NKVQ))[640 + (lane & 15)]; } while (0)
    PP_FETCH(0);
#pragma unroll 1
    for (int rr = 0; rr < 8; ++rr) {
        const int tl = 8 * w + rr, t = t0 + tl, row = b * PT + t;
        f32x4 v[6], q[4]; const f32x4 gl = {bflo(ngl.x), bfhi(ngl.x), bflo(ngl.y), bfhi(ngl.y)};
#pragma unroll
        for (int sidx = 0; sidx < 6; ++sidx) v[sidx] = (f32x4){bflo(nv[sidx].x), bfhi(nv[sidx].x), bflo(nv[sidx].y), bfhi(nv[sidx].y)};
#pragma unroll
        for (int i = 0; i < 4; ++i) q[i] = (f32x4){bflo(nq[i].x), bfhi(nq[i].x), bflo(nq[i].y), bfhi(nq[i].y)};
        PP_FETCH(rr + 1);
        const f32x4 ks = rms64x4(v[2]) * kg1, kw = rms64x4(v[4]) * kg2;
        f32x4* okv = (f32x4*)(F.out + O_KVP + (size_t)row * 1024) + lane;
        okv[0] = v[0]; okv[64] = v[1]; okv[128] = ks; okv[192] = v[3];
        if (t >= PT - WINDOW) { f32x4* owin = (f32x4*)(F.out + O_WINP + ((size_t)b * 512 + (t - (PT - WINDOW))) * 512) + lane; owin[0] = kw; owin[64] = v[5]; }
        const size_t kidx = (((size_t)b * NG + g) * PT + t) * 64 + d4;
        *(v2u*)(WSP(bf16, WS_KSEL) + kidx) = pk4(ks); *(v2u*)(WSP(bf16, WS_KWIN) + kidx) = pk4(kw);
#pragma unroll
        for (int j = 0; j < 4; ++j) { vt[((0 * 4 + g) * 64 + d4 + j) * 72 + tl] = (bf16)f2bf(v[3][j]); vt[((1 * 4 + g) * 64 + d4 + j) * 72 + tl] = (bf16)f2bf(v[5][j]); }
        bf16* qn = WSP(bf16, WS_QN) + (size_t)row * 1024 + g * 64 + d4;
#pragma unroll
        for (int i = 0; i < 4; ++i) *(v2u*)(qn + i * 256) = pk4(rms64x4(q[i]) * qg);
        if (lane < 12) *(f32x4*)(WSP(float, WS_GATES) + (size_t)row * 48 + 4 * lane) = (f32x4){sigmoid_f(gl.x), sigmoid_f(gl.y), sigmoid_f(gl.z), sigmoid_f(gl.w)};
    }
#undef PP_FETCH
    __syncthreads();
    {
        const int which = F.tid >> 8, gd = F.tid & 255;
        bf16* dst = WSP(bf16, which == 0 ? WS_VSELT : WS_VWINT) + (((size_t)b * NG * 64 + gd) * PT + t0);
        const LAS bf16* src = vt + ((which * 256 + gd) * 72);
#pragma unroll
        for (int i = 0; i < 8; ++i) *(v4u*)(dst + 8 * i) = *(const LAS v4u*)(src + 8 * i);
    }
    __syncthreads();
}
__device__ __forceinline__ void pp_sample_row(Frame& F, int sr, int part = -1) {
    const int lane = F.lane, bs = sr >> 2, i = sr & 3, row = MP + sr;
    const float kg1 = FIN(16)[64 + lane], kg2 = FIN(16)[128 + lane], qg = FIN(22)[lane] * QSCALE;
    const bf16* kvq = WSP(bf16, WS_KVQ) + (size_t)row * NKVQ;
    float* okv = F.out + O_KVS + (size_t)sr * 1024;
    float* owin = F.out + O_WINS + ((size_t)bs * 512 + 508 + i) * 512;
#pragma unroll
    for (int g = 0; g < 4; ++g) { if (part >= 0 && part != g) continue;
        const float v0 = bf2f(kvq[0 * 256 + g * 64 + lane]), v1 = bf2f(kvq[1 * 256 + g * 64 + lane]), v2 = bf2f(kvq[2 * 256 + g * 64 + lane]);
        const float v3 = bf2f(kvq[3 * 256 + g * 64 + lane]), v4 = bf2f(kvq[4 * 256 + g * 64 + lane]), v5 = bf2f(kvq[5 * 256 + g * 64 + lane]);
        const float ks = v2 * rms64(v2) * kg1, kw = v4 * rms64(v4) * kg2;
        okv[0 * 256 + g * 64 + lane] = v0; okv[1 * 256 + g * 64 + lane] = v1; okv[2 * 256 + g * 64 + lane] = ks; okv[3 * 256 + g * 64 + lane] = v3;
        owin[g * 64 + lane] = kw; owin[256 + g * 64 + lane] = v5;
        const size_t bg = (size_t)bs * NG + g;
        WSP(bf16, WS_SKWIN)[(bg * 544 + 512 + i) * 64 + lane] = (bf16)f2bf(kw);
        WSP(bf16, WS_SVWINT)[(bg * 64 + lane) * 544 + 512 + i] = (bf16)f2bf(v5);
        float* sn = WSP(float, WS_SNEW) + (((size_t)bs * 4 + i) * 2) * 256 + g * 64 + lane;
        sn[0] = ks; sn[256] = v3;
    }
    bf16* qn = WSP(bf16, WS_QN) + (size_t)row * 1024;
#pragma unroll 4
    for (int hd = 0; hd < 16; ++hd) { if (part >= 0 && (hd >> 2) != part - 4) continue; const float v = bf2f(kvq[NKV + hd * 64 + lane]); qn[hd * 64 + lane] = (bf16)f2bf(v * rms64(v) * qg); }
    if ((part < 0 || part == 7) && lane < 48) WSP(float, WS_GATES)[(size_t)row * 48 + lane] = sigmoid_f(bf2f(kvq[NKV + 1024 + lane]));
}

struct RowPPrompt { static constexpr bool BF = true; const bf16* base; __device__ __forceinline__ const bf16* operator()(int t) const { return base + (size_t)t * NKVQ; } };
struct RowPSample { static constexpr bool BF = false; const float* cache; const int* pt; __device__ __forceinline__ const float* operator()(int t) const { return cache + ((size_t)pt[t >> 7] * PAGE + (t & 127)) * 1024; } };
template <class RowP> __device__ __forceinline__ bf16x8 rowp_frag(const RowP& rowp, int t, int off) {
    if constexpr (RowP::BF) return ld8(rowp(t) + off);
    else { const float* rp = rowp(t) + off; return cvt8(*(const f32x4*)rp, *(const f32x4*)(rp + 4)); }
}
__device__ __forceinline__ void compress_finish(Frame& F, const f32x4 (&acc)[4], int kv, int blk, bf16* KC, bf16* VCT) {
    const int lane = F.lane, fr = lane & 15, fq = lane >> 4;
    const float* pet = WSP(float, WS_PETERM) + kv * 64;
    bf16x8 hb[2];
#pragma unroll
    for (int s = 0; s < 2; ++s) { f32x4 h0, h1;
#pragma unroll
        for (int r = 0; r < 4; ++r) { h0[r] = gelu_tanh(acc[2 * s][r] + pet[16 * (2 * s) + 4 * fq + r]); h1[r] = gelu_tanh(acc[2 * s + 1][r] + pet[16 * (2 * s + 1) + 4 * fq + r]); }
        hb[s] = cvt8(h0, h1); }
    const bf16* w2f = WSP(bf16, WS_W2F) + (size_t)kv * 4096 + lane * 8;
    f32x4 o[4];
#pragma unroll
    for (int dt = 0; dt < 4; ++dt) { o[dt] = (f32x4){0.f, 0.f, 0.f, 0.f};
#pragma unroll
        for (int s = 0; s < 2; ++s) o[dt] = MFMA16(ld8(w2f + (dt * 2 + s) * 512), hb[s], o[dt]); }
    if (kv == 0) {
        float ss = 0.f;
#pragma unroll
        for (int dt = 0; dt < 4; ++dt) ss += (o[dt][0] * o[dt][0] + o[dt][1] * o[dt][1]) + (o[dt][2] * o[dt][2] + o[dt][3] * o[dt][3]);
        ss = x32_sum(x16_sum(ss));
        const float rstd = frsq(ss * (1.f / 64.f) + EPS);
        const float* kg0 = FIN(16);
        if (blk < NCMP) {
#pragma unroll
            for (int dt = 0; dt < 4; ++dt) { const int d = 16 * dt + 4 * fq; v2u ov; ov.x = pk2(o[dt][0] * rstd * kg0[d], o[dt][1] * rstd * kg0[d + 1]); ov.y = pk2(o[dt][2] * rstd * kg0[d + 2], o[dt][3] * rstd * kg0[d + 3]);
                *(v2u*)(KC + (size_t)blk * 64 + d) = ov; }
        } else {
#pragma unroll
            for (int dt = 0; dt < 4; ++dt) *(v2u*)(KC + (size_t)blk * 64 + 16 * dt + 4 * fq) = (v2u){0u, 0u};
        }
    } else {
#pragma unroll
        for (int dt = 0; dt < 4; ++dt)
#pragma unroll
            for (int r = 0; r < 4; ++r) VCT[(size_t)(16 * dt + 4 * fq + r) * 512 + blk] = (blk < NCMP) ? (bf16)f2bf(o[dt][r]) : (bf16)0;
    }
}

template <class RowP>
__device__ __forceinline__ void compress_part(Frame& F, const RowP& rowp, int kv, int j, int r_lo, int r_hi, f32x4 (&acc)[4]) {
    const int lane = F.lane, fr = lane & 15, fq = lane >> 4;
    const bf16* W1 = WSP(bf16, WS_W1T) + (size_t)kv * 64 * 2048 + (size_t)fr * 2048 + 8 * fq;
    const int blk = 16 * j + fr;
#pragma unroll
    for (int mt = 0; mt < 4; ++mt) acc[mt] = (f32x4){0.f, 0.f, 0.f, 0.f};
#pragma unroll 2
    for (int r = r_lo; r < r_hi; ++r) {
        int t = 16 * blk + r; t = t < PAST ? t : PAST - 1;
#pragma unroll
        for (int hf = 0; hf < 2; ++hf) {
            const bf16x8 bfrag = rowp_frag(rowp, t, 8 * fq + 32 * hf);
            const int ks = 2 * r + hf;
#pragma unroll
            for (int mt = 0; mt < 4; ++mt) acc[mt] = MFMA16(ld8(W1 + (size_t)mt * 16 * 2048 + 32 * ks), bfrag, acc[mt]);
        }
    }
}
template <class RowP>
__device__ __forceinline__ void compress_tile(Frame& F, const RowP& rowp, int kv, int j, bf16* KC, bf16* VCT) {
    const int lane = F.lane, fr = lane & 15, fq = lane >> 4;
    const bf16* W1 = WSP(bf16, WS_W1T) + (size_t)kv * 64 * 2048 + (size_t)fr * 2048 + 8 * fq;
    const int blk = 16 * j + fr;
    f32x4 acc[4];
#pragma unroll
    for (int mt = 0; mt < 4; ++mt) acc[mt] = (f32x4){0.f, 0.f, 0.f, 0.f};
#pragma unroll 2
    for (int r = 0; r < 32; ++r) {
        int t = 16 * blk + r; t = t < PAST ? t : PAST - 1;
#pragma unroll
        for (int hf = 0; hf < 2; ++hf) {
            const bf16x8 bfrag = rowp_frag(rowp, t, 8 * fq + 32 * hf);
            const int ks = 2 * r + hf;
#pragma unroll
            for (int mt = 0; mt < 4; ++mt) acc[mt] = MFMA16(ld8(W1 + (size_t)mt * 16 * 2048 + 32 * ks), bfrag, acc[mt]);
        }
    }
    compress_finish(F, acc, kv, blk, KC, VCT);
}


__device__ __forceinline__ void compress_prompt(Frame& F, int id) {
    const int kv = id & 1, j = (id >> 1) & 31, bg = id >> 6, b = bg >> 2, g = bg & 3;
    RowPPrompt rp{WSP(bf16, WS_KVQ) + (size_t)b * PT * NKVQ + kv * 256 + g * 64};
    compress_tile(F, rp, kv, j, WSP(bf16, WS_KCMP) + (size_t)bg * 512 * 64, WSP(bf16, WS_VCMPT) + (size_t)bg * 64 * 512);
}
constexpr int CP_PART = 81920;
__device__ __forceinline__ void compress_prompt_split(Frame& F, int id) {
    const int kv = id & 1, j = (id >> 1) & 31, bg = id >> 6, b = bg >> 2, g = bg & 3, q = F.wave & 3, lane = F.lane;
    RowPPrompt rp{WSP(bf16, WS_KVQ) + (size_t)b * PT * NKVQ + kv * 256 + g * 64};
    f32x4 acc[4];
    compress_part(F, rp, kv, j, 8 * q, 8 * q + 8, acc);
    LAS f32x4* part = (LAS f32x4*)(F.lds + CP_PART) + (F.wave >> 2) * 1024;
#pragma unroll
    for (int mt = 0; mt < 4; ++mt) part[(q * 4 + mt) * 64 + lane] = acc[mt];
    __syncthreads();
    if (q == 0) {
#pragma unroll
        for (int mt = 0; mt < 4; ++mt) acc[mt] = (part[(0 * 4 + mt) * 64 + lane] + part[(1 * 4 + mt) * 64 + lane]) + (part[(2 * 4 + mt) * 64 + lane] + part[(3 * 4 + mt) * 64 + lane]);
        compress_finish(F, acc, kv, 16 * j + (lane & 15), WSP(bf16, WS_KCMP) + (size_t)bg * 512 * 64, WSP(bf16, WS_VCMPT) + (size_t)bg * 64 * 512);
    }
    __syncthreads();
}
__device__ __forceinline__ void compress_sample(Frame& F, int id) {
    const int kv = id & 1, j = (id >> 1) & 31, bg = id >> 6, lane = F.lane, fr = lane & 15, fq = lane >> 4;
    const int blk = 16 * j + fr, nb = blk < 511 ? blk + 1 : 511;
    const bf16* f1 = WSP(bf16, WS_FS) + ((size_t)bg * 512 + blk) * 256 + kv * 128 + 4 * fq;
    const bf16* f2 = WSP(bf16, WS_FS) + ((size_t)bg * 512 + nb) * 256 + kv * 128 + 64 + 4 * fq;
    f32x4 acc[4];
#pragma unroll
    for (int mt = 0; mt < 4; ++mt) { const v2u a = *(const v2u*)(f1 + 16 * mt), b = *(const v2u*)(f2 + 16 * mt);
        acc[mt] = (f32x4){bflo(a.x) + bflo(b.x), bfhi(a.x) + bfhi(b.x), bflo(a.y) + bflo(b.y), bfhi(a.y) + bfhi(b.y)}; }
    compress_finish(F, acc, kv, blk, WSP(bf16, WS_SKCMP) + (size_t)bg * 512 * 64, WSP(bf16, WS_SVCMPT) + (size_t)bg * 64 * 512);
}

constexpr int NSA_IMP = 0;
constexpr int NSA_Q = 67584;
constexpr int NSA_QLD = 68;
constexpr float LOG2E = 1.4426950408889634f;
#ifndef NSA_SUBUNITS
#define NSA_SUBUNITS 0
#endif
__device__ __forceinline__ float ex2(float x) { return __builtin_amdgcn_exp2f(x); }

struct KvBf16 {
    const bf16* K; const bf16* VT; int ld;
    __device__ __forceinline__ void lane_offsets(int fr, int fq, unsigned& ko, unsigned& vo) const {
        ko = (unsigned)(((8 * (fr >> 2) + (fr & 3)) * 64 + 8 * fq) * 2); vo = (unsigned)((fr * ld + 8 * fq) * 2);
        asm volatile("" : "+v"(ko), "+v"(vo));
    }
    __device__ __forceinline__ bf16x8 kf(int key0, int mt, int ks, unsigned ko) const {
        return *(const bf16x8*)((const char*)K + (size_t)key0 * 128 + (ko + (unsigned)((4 * mt * 64 + 32 * ks) * 2))); }
    __device__ __forceinline__ bf16x8 vf(int key0, int dt, unsigned vo) const {
        return *(const bf16x8*)((const char*)VT + (size_t)key0 * 2 + (vo + (unsigned)(16 * dt * ld * 2))); }
};
struct KvSampleSel {
    const float* cache; const int* pt; const float* snew; int g;
    __device__ __forceinline__ const float* krow(int pos, int slot) const {
        if (pos < PAST) return cache + ((size_t)pt[pos >> 7] * PAGE + (pos & 127)) * 1024 + slot * 256;
        int i = pos - PAST; i = i < 3 ? i : 3; return snew + (size_t)i * 512 + (slot - 2) * 256; }
    __device__ __forceinline__ void lane_offsets(int fr, int fq, unsigned& ko, unsigned& vo) const { ko = (unsigned)(fr | (fq << 8)); vo = ko; asm volatile("" : "+v"(ko), "+v"(vo)); }
    __device__ __forceinline__ bf16x8 kf(int key0, int mt, int ks, unsigned ko) const { const int fr = ko & 255, fq = ko >> 8;
        const float* p = krow(key0 + 8 * (fr >> 2) + 4 * mt + (fr & 3), 2) + 32 * ks + 8 * fq; return cvt8(*(const f32x4*)p, *(const f32x4*)(p + 4)); }
    __device__ __forceinline__ bf16x8 vf(int key0, int dt, unsigned vo) const { const int fr = vo & 255, fq = vo >> 8; f32x4 a, b;
#pragma unroll
        for (int j = 0; j < 4; ++j) { a[j] = krow(key0 + 8 * fq + j, 3)[16 * dt + fr]; b[j] = krow(key0 + 8 * fq + 4 + j, 3)[16 * dt + fr]; }
        return cvt8(a, b); }
};
struct KvFrags { bf16x8 k[2][2]; bf16x8 v[4]; };
template <bool WITHV, class KV>
__device__ __forceinline__ void nsa_load(const KV& kv, int key0, int fr, int fq, KvFrags& f) {
    unsigned ko, vo; kv.lane_offsets(fr, fq, ko, vo);
#pragma unroll
    for (int mt = 0; mt < 2; ++mt)
#pragma unroll
        for (int ks = 0; ks < 2; ++ks) f.k[mt][ks] = kv.kf(key0, mt, ks, ko);
    if (WITHV) {
#pragma unroll
        for (int dt = 0; dt < 4; ++dt) f.v[dt] = kv.vf(key0, dt, vo);
    }
}

template <int NT, int MODE, bool QREG = false>
__device__ __forceinline__ void nsa_core(const KvFrags& f, int key0, const LAS bf16* qrow, int qnt, f32x4 (&O)[NT][4], float (&m)[NT], float (&l)[NT], const float (&invl)[NT], const float (&slope)[NT],
                                         int t, int pmul, int padd, int wlim, bool selok, LAS float* improw, int fq, const bf16x8* qreg = nullptr) {
    float dist[2][4]; bool val[2][4];
#pragma unroll
    for (int mt = 0; mt < 2; ++mt)
#pragma unroll
        for (int r = 0; r < 4; ++r) { const int kk = key0 + 8 * fq + 4 * mt + r; const int dd = t - (pmul * kk + padd); val[mt][r] = selok && dd >= 0 && dd < wlim; dist[mt][r] = val[mt][r] ? (float)dd : 1e6f; }
    float imp_main[2] = {0.f, 0.f}, imp_spill[2] = {0.f, 0.f};
    f32x4 sc[NT][2]; bf16x8 pfr[NT];
#pragma unroll
    for (int nt = 0; nt < NT; ++nt) {
        bf16x8 q0, q1; if (QREG) { q0 = qreg[nt * 2]; q1 = qreg[nt * 2 + 1]; } else { q0 = ld8l(qrow + nt * qnt + 8 * fq); q1 = ld8l(qrow + nt * qnt + 32 + 8 * fq); }
#pragma unroll
        for (int mt = 0; mt < 2; ++mt) { sc[nt][mt] = (f32x4){0.f, 0.f, 0.f, 0.f}; sc[nt][mt] = MFMA16(f.k[mt][0], q0, sc[nt][mt]); sc[nt][mt] = MFMA16(f.k[mt][1], q1, sc[nt][mt]); }
    }
#pragma unroll
    for (int nt = 0; nt < NT; ++nt) {
        f32x4 p[2]; float ps = 0.f;
#pragma unroll
        for (int mt = 0; mt < 2; ++mt)
#pragma unroll
            for (int r = 0; r < 4; ++r) { float pv = ex2(sc[nt][mt][r] - slope[nt] * dist[mt][r]); if (MODE == 2) pv *= invl[nt]; p[mt][r] = pv; ps += pv; }
        if (MODE != 2) l[nt] += ps;
        if (MODE == 2) {
#pragma unroll
            for (int mt = 0; mt < 2; ++mt) { imp_main[mt] += (p[mt][0] + p[mt][1]) + (p[mt][2] + p[mt][3]); imp_spill[mt] += p[mt][3]; }
        }
        if (MODE != 1) pfr[nt] = cvt8(p[0], p[1]);
    }
    if (MODE != 1) {
#pragma unroll
        for (int nt = 0; nt < NT; ++nt)
#pragma unroll
            for (int dt = 0; dt < 4; ++dt) O[nt][dt] = MFMA16(f.v[dt], pfr[nt], O[nt][dt]);
    }
    if (MODE == 2) {
#pragma unroll
        for (int mt = 0; mt < 2; ++mt) { const int j = key0 / 4 + 2 * fq + mt;
            __hip_atomic_fetch_add(improw + j, imp_main[mt], __ATOMIC_RELAXED, __HIP_MEMORY_SCOPE_WORKGROUP);
            __hip_atomic_fetch_add(improw + j + 1, imp_spill[mt], __ATOMIC_RELAXED, __HIP_MEMORY_SCOPE_WORKGROUP); }
    }
}
template <int NT, int MODE, class KV>
__device__ __forceinline__ void nsa_tile(const KV& kv, int key0, const LAS bf16* qrow, int qnt, f32x4 (&O)[NT][4], float (&m)[NT], float (&l)[NT], const float (&invl)[NT], const float (&slope)[NT],
                                         int t, int pmul, int padd, int wlim, bool selok, LAS float* improw, int fr, int fq) {
    KvFrags f; nsa_load<MODE != 1>(kv, key0, fr, fq, f);
    nsa_core<NT, MODE>(f, key0, qrow, qnt, O, m, l, invl, slope, t, pmul, padd, wlim, selok, improw, fq);
}

template <int NT>
__device__ __forceinline__ void nsa_zero(f32x4 (&O)[NT][4], float (&m)[NT], float (&l)[NT]) {
#pragma unroll
    for (int nt = 0; nt < NT; ++nt) { m[nt] = -1e30f; l[nt] = 0.f;
#pragma unroll
        for (int dt = 0; dt < 4; ++dt) O[nt][dt] = (f32x4){0.f, 0.f, 0.f, 0.f}; }
}

template <bool SAMPLE>
__device__ __forceinline__ void nsa_unit(Frame& F, int id) {
    constexpr int NT = SAMPLE ? 1 : 4;
    int lane_ = F.lane; asm volatile("" : "+v"(lane_));
    const int lane = lane_, fr = lane & 15, fq = lane >> 4;
    LAS unsigned char* L = F.lds; asm volatile("" : "+v"(L));
    LAS float* imp = (LAS float*)(L + NSA_IMP + F.wave * 8448);
    LAS bf16* qw = (LAS bf16*)(L + NSA_Q + F.wave * 8704);
    int bg, g, t, row, trow, tmax, row0;
    if (SAMPLE) { bg = id; g = id & 3; t = PAST + (fr >> 2); row0 = MP + (id >> 2) * 4; row = row0 + (fr >> 2); trow = fr >> 2; tmax = PAST + 3; }
    else { bg = id >> 9; g = bg & 3; const int tt = id & 511; t = 16 * tt + fr; row0 = (bg >> 2) * PT + 16 * tt; row = row0 + fr; trow = fr; tmax = 16 * tt + 15; }
    {
        const int nrow = SAMPLE ? 16 : 64;
        for (int i = lane; i < nrow * 8; i += 64) { const int rr = i >> 3, c8 = i & 7;
            *(LAS v4u*)(qw + rr * NSA_QLD + 8 * c8) = *(const v4u*)(WSP(bf16, WS_QN) + (size_t)(row0 + (rr >> 2)) * 1024 + (g * 4 + (rr & 3)) * 64 + 8 * c8); }
    }
    float slope[NT]; int hd[NT];
#pragma unroll
    for (int nt = 0; nt < NT; ++nt) { hd[nt] = g * 4 + (SAMPLE ? (fr & 3) : nt); slope[nt] = ex2(-0.5f * (float)(hd[nt] + 1)) * LOG2E; }
    const LAS bf16* qrow = qw + (SAMPLE ? fr : fr * 4) * NSA_QLD; const int qnt = SAMPLE ? 0 : NSA_QLD;
    const float* gates = WSP(float, WS_GATES) + (size_t)row * 48;
    float* oacc = WSP(float, WS_OACC) + (size_t)row * 1024;
    for (int i = lane; i < 16 * 132; i += 64) imp[i] = 0.f;
    LDS_WAIT();
    f32x4 O[NT][4]; float m[NT], l[NT], invl[NT];
    {
        KvBf16 kv{WSP(bf16, SAMPLE ? WS_SKCMP : WS_KCMP) + (size_t)bg * 512 * 64, WSP(bf16, SAMPLE ? WS_SVCMPT : WS_VCMPT) + (size_t)bg * 64 * 512, 512};
        const int cmax = (tmax - 31) >> 4;
        const int ntile = (tmax >= 31) ? ((cmax < 510 ? cmax : 510) / 32 + 1) : 0;
#pragma unroll
        for (int nt = 0; nt < NT; ++nt) invl[nt] = 0.f;
        nsa_zero<NT>(O, m, l);
        { KvFrags fa, fb; if (ntile > 0) nsa_load<false>(kv, 0, fr, fq, fa);
#pragma unroll 1
          for (int tl = 0; tl < ntile; ++tl) { if (tl + 1 < ntile) nsa_load<false>(kv, 32 * (tl + 1), fr, fq, fb);
            nsa_core<NT, 1>(fa, 32 * tl, qrow, qnt, O, m, l, invl, slope, t, 16, 31, 1 << 30, true, imp + trow * 132, fq); fa = fb; } }
#pragma unroll
        for (int nt = 0; nt < NT; ++nt) { float lt = l[nt]; lt = x32_sum(x16_sum(lt)); invl[nt] = lt > 0.f ? 1.f / lt : 0.f; }
        { KvFrags fa, fb; if (ntile > 0) nsa_load<true>(kv, 0, fr, fq, fa);
#pragma unroll 1
          for (int tl = 0; tl < ntile; ++tl) { if (tl + 1 < ntile) nsa_load<true>(kv, 32 * (tl + 1), fr, fq, fb);
            nsa_core<NT, 2>(fa, 32 * tl, qrow, qnt, O, m, l, invl, slope, t, 16, 31, 1 << 30, true, imp + trow * 132, fq); fa = fb; } }
#pragma unroll
        for (int nt = 0; nt < NT; ++nt) { const float gc = gates[0 * 16 + hd[nt]];
#pragma unroll
            for (int dt = 0; dt < 4; ++dt) *(f32x4*)(oacc + hd[nt] * 64 + 16 * dt + 4 * fq) = O[nt][dt] * gc; }
    }
    LDS_WAIT();
    unsigned selm[4] = {0u, 0u, 0u, 0u};
    {
        const int cur = t >> 6;
        if (!SAMPLE) {
            unsigned v[32];
#pragma unroll
            for (int i = 0; i < 32; ++i) { const int j = 32 * fq + i; const bool forced = (j == 0) | (j == cur) | (j == cur - 1);
                const unsigned key = ((f2u(imp[trow * 132 + j]) & ~127u) | (unsigned)(127 - j)) + 128u;
                v[i] = (!forced && j <= cur) ? key : 0u;
                if (forced) selm[fq] |= 1u << i; }
            unsigned fw = selm[0] | selm[1] | selm[2] | selm[3];
            const unsigned w16 = __shfl_xor(fw, 16), w32 = __shfl_xor(fw, 32), w48 = __shfl_xor(fw, 48);
#pragma unroll
            for (int wd = 0; wd < 4; ++wd) selm[wd] = (fq == wd) ? fw : ((fq ^ 1) == wd) ? w16 : ((fq ^ 2) == wd) ? w32 : w48;
            const int nforced = cur >= 2 ? 3 : cur + 1;
#pragma unroll 1
            for (int rd = 0; rd < 15; ++rd) {
                unsigned mx = v[0];
#pragma unroll
                for (int i = 1; i < 32; ++i) mx = mx > v[i] ? mx : v[i];
                mx = x32_umax(x16_umax(mx));
#pragma unroll
                for (int i = 0; i < 32; ++i) v[i] = (v[i] == mx) ? 0u : v[i];
                if (mx != 0u && rd < 16 - nforced) { const int js = 127 - (int)(mx & 127u);
#pragma unroll
                    for (int wd = 0; wd < 4; ++wd) selm[wd] |= ((js >> 5) == wd) ? (1u << (js & 31)) : 0u; }
            }
        } else {
            const int li = (fr & 3) * 4 + fq;
            unsigned v[8];
#pragma unroll
            for (int i = 0; i < 8; ++i) { const int j = li * 8 + i; v[i] = (j >= 1 && j <= 126) ? (((f2u(imp[trow * 132 + j]) & ~127u) | (unsigned)(127 - j)) + 128u) : 0u; }
            selm[0] = 1u; selm[3] = 1u << 31;
#pragma unroll 1
            for (int rd = 0; rd < 13; ++rd) {
                unsigned mx = v[0];
#pragma unroll
                for (int i = 1; i < 8; ++i) mx = mx > v[i] ? mx : v[i];
                { unsigned o = dpp_u<DPP_XOR1>(mx); mx = mx > o ? mx : o; o = dpp_u<DPP_XOR2>(mx); mx = mx > o ? mx : o; mx = x32_umax(x16_umax(mx)); }
#pragma unroll
                for (int i = 0; i < 8; ++i) v[i] = (v[i] == mx) ? 0u : v[i];
                if (mx != 0u) { const int js = 127 - (int)(mx & 127u);
#pragma unroll
                    for (int wd = 0; wd < 4; ++wd) selm[wd] |= ((js >> 5) == wd) ? (1u << (js & 31)) : 0u; }
            }
        }
    }
    if (SAMPLE || !NSA_SUBUNITS) {
        nsa_zero<NT>(O, m, l);
        unsigned un[4];
#pragma unroll
        for (int wd = 0; wd < 4; ++wd) { unsigned x = selm[wd]; x |= __shfl_xor(x, 1); x |= __shfl_xor(x, 2); x |= __shfl_xor(x, 4); x |= __shfl_xor(x, 8); un[wd] = (unsigned)__builtin_amdgcn_readfirstlane((int)x); }
        KvSampleSel kvs{FIN(2) + g * 64, (const int*)FIN(6) + (SAMPLE ? (id >> 2) : 0) * NPAGES, WSP(float, WS_SNEW) + (size_t)(SAMPLE ? (id >> 2) : 0) * 2048 + g * 64, g};
        KvBf16 kvp{WSP(bf16, WS_KSEL) + (size_t)bg * PT * 64, WSP(bf16, WS_VSELT) + (size_t)bg * 64 * PT, PT};
        if (SAMPLE) {
#pragma unroll 1
        for (int wd = 0; wd < 4; ++wd) {
            unsigned mm = un[wd];
            const unsigned mine = wd == 0 ? selm[0] : wd == 1 ? selm[1] : wd == 2 ? selm[2] : selm[3];
            while (mm) {
                const int bit = __builtin_ctz(mm); mm &= mm - 1u; const int j = 32 * wd + bit;
                const bool ok = (mine >> bit) & 1u;
#pragma unroll 1
                for (int hh = 0; hh < 2; ++hh) { nsa_tile<NT, 0>(kvs, 64 * j + 32 * hh, qrow, qnt, O, m, l, invl, slope, t, 1, 0, 1 << 30, ok, imp, fr, fq); __builtin_amdgcn_sched_barrier(0); }
            }
        }
        } else {
            int wdc = 0; unsigned mmc = un[0];
            while (wdc < 3 && mmc == 0u) { ++wdc; mmc = wdc == 1 ? un[1] : wdc == 2 ? un[2] : un[3]; }
            KvFrags fa, fb; int jc = -1, hc = 0;
            if (mmc) { jc = 32 * wdc + __builtin_ctz(mmc); mmc &= mmc - 1u; nsa_load<true>(kvp, 64 * jc, fr, fq, fa); }
#pragma unroll 1
            while (jc >= 0) {
                int jn = jc, hn = hc + 1;
                if (hn == 2) { hn = 0;
                    while (wdc < 3 && mmc == 0u) { ++wdc; mmc = wdc == 1 ? un[1] : wdc == 2 ? un[2] : un[3]; }
                    if (mmc) { jn = 32 * wdc + __builtin_ctz(mmc); mmc &= mmc - 1u; } else jn = -1; }
                if (jn >= 0) nsa_load<true>(kvp, 64 * jn + 32 * hn, fr, fq, fb);
                const int wj = jc >> 5, bj = jc & 31;
                const unsigned mine = wj == 0 ? selm[0] : wj == 1 ? selm[1] : wj == 2 ? selm[2] : selm[3];
                nsa_core<NT, 0>(fa, 64 * jc + 32 * hc, qrow, qnt, O, m, l, invl, slope, t, 1, 0, 1 << 30, (mine >> bj) & 1u, imp, fq);
                fa = fb; jc = jn; hc = hn;
            }
        }
        if (SAMPLE) nsa_tile<NT, 0>(kvs, 64 * 128, qrow, qnt, O, m, l, invl, slope, t, 1, 0, 1 << 30, true, imp, fr, fq);
#pragma unroll
        for (int nt = 0; nt < NT; ++nt) { float lt = l[nt]; lt = x32_sum(x16_sum(lt)); const float sc = gates[1 * 16 + hd[nt]] / fmaxf(lt, 1e-30f);
#pragma unroll
            for (int dt = 0; dt < 4; ++dt) { f32x4* o = (f32x4*)(oacc + hd[nt] * 64 + 16 * dt + 4 * fq); *o = *o + O[nt][dt] * sc; } }
    } else {
        unsigned ms[4][4];
#pragma unroll
        for (int s = 0; s < 4; ++s)
#pragma unroll
            for (int wd = 0; wd < 4; ++wd) ms[s][wd] = __shfl(selm[wd], 4 * s + (fr >> 2));
        unsigned su[4][4], un[4];
#pragma unroll
        for (int wd = 0; wd < 4; ++wd) { un[wd] = 0u;
#pragma unroll
            for (int s = 0; s < 4; ++s) { unsigned x = ms[s][wd]; x |= __shfl_xor(x, 4); x |= __shfl_xor(x, 8); su[s][wd] = (unsigned)__builtin_amdgcn_readfirstlane((int)x); un[wd] |= su[s][wd]; } }
        const int hds = g * 4 + (fr & 3); float slp[1]; slp[0] = ex2(-0.5f * (float)(hds + 1)) * LOG2E;
        const int tb = (id & 511) * 16 + (fr >> 2);
        f32x4 Os[4][1][4]; float mS[4][1], lS[4][1]; float inv1[1] = {0.f};
#pragma unroll
        for (int s = 0; s < 4; ++s) nsa_zero<1>(Os[s], mS[s], lS[s]);
        KvBf16 kvp{WSP(bf16, WS_KSEL) + (size_t)bg * PT * 64, WSP(bf16, WS_VSELT) + (size_t)bg * 64 * PT, PT};
        int wdc = 0; unsigned mmc = un[0];
        while (wdc < 3 && mmc == 0u) { ++wdc; mmc = wdc == 1 ? un[1] : wdc == 2 ? un[2] : un[3]; }
        KvFrags fa, fb;
        int jc = -1, hc = 0;
        if (mmc) { jc = 32 * wdc + __builtin_ctz(mmc); mmc &= mmc - 1u; nsa_load<true>(kvp, 64 * jc, fr, fq, fa); }
#pragma unroll 1
        while (jc >= 0) {
            int jn = jc, hn = hc + 1;
            if (hn == 2) { hn = 0;
                while (wdc < 3 && mmc == 0u) { ++wdc; mmc = wdc == 1 ? un[1] : wdc == 2 ? un[2] : un[3]; }
                if (mmc) { jn = 32 * wdc + __builtin_ctz(mmc); mmc &= mmc - 1u; } else jn = -1; }
            if (jn >= 0) nsa_load<true>(kvp, 64 * jn + 32 * hn, fr, fq, fb);
            const int wj = jc >> 5, bj = jc & 31;
#pragma unroll
            for (int s = 0; s < 4; ++s) {
                const unsigned suw = wj == 0 ? su[s][0] : wj == 1 ? su[s][1] : wj == 2 ? su[s][2] : su[s][3];
                if ((suw >> bj) & 1u) {
                    const unsigned mw = wj == 0 ? ms[s][0] : wj == 1 ? ms[s][1] : wj == 2 ? ms[s][2] : ms[s][3];
                    nsa_core<1, 0>(fa, 64 * jc + 32 * hc, qw + (16 * s + fr) * NSA_QLD, 0, Os[s], mS[s], lS[s], inv1, slp, tb + 4 * s, 1, 0, 1 << 30, (mw >> bj) & 1u, imp, fq);
                }
            }
            fa = fb; jc = jn; hc = hn;
        }
#pragma unroll
        for (int s = 0; s < 4; ++s) { float lt = lS[s][0]; lt = x32_sum(x16_sum(lt));
            const size_t rs = (size_t)(row0 + 4 * s + (fr >> 2));
            const float sc = WSP(float, WS_GATES)[rs * 48 + 16 + hds] / fmaxf(lt, 1e-30f);
#pragma unroll
            for (int dt = 0; dt < 4; ++dt) { f32x4* o = (f32x4*)(WSP(float, WS_OACC) + rs * 1024 + hds * 64 + 16 * dt + 4 * fq); *o = *o + Os[s][0][dt] * sc; } }
    }
    {
        nsa_zero<NT>(O, m, l);
        KvBf16 kv = SAMPLE ? KvBf16{WSP(bf16, WS_SKWIN) + (size_t)bg * 544 * 64, WSP(bf16, WS_SVWINT) + (size_t)bg * 64 * 544, 544}
                           : KvBf16{WSP(bf16, WS_KWIN) + (size_t)bg * PT * 64, WSP(bf16, WS_VWINT) + (size_t)bg * 64 * PT, PT};
        int k0, k1, padd;
        if (SAMPLE) { k0 = 0; k1 = 544; padd = PAST - WINDOW; }
        else { const int lo = tmax - 15 - (WINDOW - 1); k0 = (lo > 0 ? lo : 0) & ~31; k1 = tmax + 1; padd = 0; }
        { KvFrags fa, fb; nsa_load<true>(kv, k0, fr, fq, fa);
#pragma unroll 1
          for (int kk = k0; kk < k1; kk += 32) { if (kk + 32 < k1) nsa_load<true>(kv, kk + 32, fr, fq, fb);
            nsa_core<NT, 0>(fa, kk, qrow, qnt, O, m, l, invl, slope, t, 1, padd, WINDOW, true, imp, fq); fa = fb; } }
        bf16* on = WSP(bf16, WS_OG) + (size_t)row * 1024;
#pragma unroll
        for (int nt = 0; nt < NT; ++nt) { float lt = l[nt]; lt = x32_sum(x16_sum(lt)); const float sc = gates[2 * 16 + hd[nt]] / fmaxf(lt, 1e-30f);
#pragma unroll
            for (int dt = 0; dt < 4; ++dt) { const f32x4 o = *(const f32x4*)(oacc + hd[nt] * 64 + 16 * dt + 4 * fq) + O[nt][dt] * sc;
                *(v2u*)(on + hd[nt] * 64 + 16 * dt + 4 * fq) = (v2u){pk2(o[0], o[1]), pk2(o[2], o[3])}; } }
    }
}

constexpr int NW_STG = 67584;
constexpr int NW_STG_BYTES = 18432;
constexpr int NW_UN = NW_STG + 2 * NW_STG_BYTES;
struct NwStage { v4u k, v; };
__device__ __forceinline__ void nw_load(const bf16* K, const bf16* VT, int ld, int key0, int tid, NwStage& s) {
    s.k = *(const v4u*)(K + (size_t)(key0 + (tid >> 3)) * 64 + 8 * (tid & 7));
    s.v = *(const v4u*)(VT + (size_t)(tid >> 3) * ld + key0 + 8 * (tid & 7));
}
__device__ __forceinline__ void nw_store(LAS unsigned char* buf, int tid, const NwStage& s) {
    const int kk = tid >> 3, c8 = tid & 7, k32 = kk & 31;
    const int rho = 32 * (kk >> 5) + 16 * ((k32 >> 2) & 1) + 4 * (k32 >> 3) + (k32 & 3);
    *(LAS v4u*)(buf + rho * 144 + c8 * 16) = s.k;
    *(LAS v4u*)(buf + 9216 + kk * 144 + c8 * 16) = s.v;
}
template <bool WITHV>
__device__ __forceinline__ void nw_frags(const LAS unsigned char* buf, int th, int fr, int fq, KvFrags& f) {
#pragma unroll
    for (int mt = 0; mt < 2; ++mt)
#pragma unroll
        for (int ks = 0; ks < 2; ++ks) f.k[mt][ks] = *(const LAS bf16x8*)(buf + (32 * th + 16 * mt + fr) * 144 + (32 * ks + 8 * fq) * 2);
    if (WITHV) {
#pragma unroll
        for (int dt = 0; dt < 4; ++dt) f.v[dt] = *(const LAS bf16x8*)(buf + 9216 + (16 * dt + fr) * 144 + (32 * th + 8 * fq) * 2);
    }
}
#define NW_PIPE(Kp, VTp, ldv, NB, BLK, BODY) do { const int nb_ = (NB); \
        if (nb_ > 0) { NwStage st_; nw_load(Kp, VTp, ldv, BLK(0), F.tid, st_); nw_store(stg, F.tid, st_); } \
        __syncthreads(); \
        _Pragma("unroll 1") for (int ib_ = 0; ib_ < nb_; ++ib_) { \
            NwStage st_; const bool more_ = ib_ + 1 < nb_; if (more_) nw_load(Kp, VTp, ldv, BLK(ib_ + 1), F.tid, st_); \
            const LAS unsigned char* buf_ = stg + (ib_ & 1) * NW_STG_BYTES; const int key0_ = BLK(ib_); \
            BODY(buf_, key0_) \
            if (more_) nw_store(stg + ((ib_ + 1) & 1) * NW_STG_BYTES, F.tid, st_); \
            __syncthreads(); } } while (0)

__device__ __forceinline__ void nsa_wg(Frame& F, int bg, int qb) {
    int lane_ = F.lane; asm volatile("" : "+v"(lane_));
    const int lane = lane_, fr = lane & 15, fq = lane >> 4, w = F.wave, g = bg & 3;
    LAS unsigned char* L = F.lds; asm volatile("" : "+v"(L));
    LAS float* imp = (LAS float*)(L + NSA_IMP + w * 8448);
    LAS unsigned char* stg = L + NW_STG;
    LAS unsigned* wun = (LAS unsigned*)(L + NW_UN); volatile LAS unsigned char* blist = (volatile LAS unsigned char*)(L + NW_UN + 16);
    const int tt = qb * 8 + w, t = 16 * tt + fr, row0 = (bg >> 2) * PT + 16 * tt, row = row0 + fr, tw0 = 16 * tt, tw1 = tw0 + 15;
    float slope[4]; bf16x8 qreg[8];
#pragma unroll
    for (int nt = 0; nt < 4; ++nt) { slope[nt] = ex2(-0.5f * (float)(g * 4 + nt + 1)) * LOG2E;
        const bf16* qp = WSP(bf16, WS_QN) + (size_t)row * 1024 + (g * 4 + nt) * 64 + 8 * fq; qreg[2 * nt] = ld8(qp); qreg[2 * nt + 1] = ld8(qp + 32); }
    const float* gates = WSP(float, WS_GATES) + (size_t)row * 48;
    float* oacc = WSP(float, WS_OACC) + (size_t)row * 1024;
    for (int i = lane; i < 16 * 132; i += 64) imp[i] = 0.f;
    if (F.tid < 4) wun[F.tid] = 0u;
    f32x4 O[4][4]; float m[4], l[4], invl[4];
    {
        const bf16* Kc = WSP(bf16, WS_KCMP) + (size_t)bg * 512 * 64; const bf16* Vc = WSP(bf16, WS_VCMPT) + (size_t)bg * 64 * 512;
        const int cmax = (128 * qb + 127 - 31) >> 4, ncb = (cmax < 510 ? cmax : 510) / 64 + 1;
#pragma unroll
        for (int nt = 0; nt < 4; ++nt) invl[nt] = 0.f;
        nsa_zero<4>(O, m, l);
#define NW_BLK(i) (64 * (i))
#define NW_CMP1(buf, k0) { _Pragma("unroll 1") for (int th = 0; th < 2; ++th) if (16 * ((k0) + 32 * th) + 31 <= tw1) { KvFrags f; nw_frags<false>(buf, th, fr, fq, f); \
            nsa_core<4, 1, true>(f, (k0) + 32 * th, nullptr, 0, O, m, l, invl, slope, t, 16, 31, 1 << 30, true, imp + fr * 132, fq, qreg); } }
        NW_PIPE(Kc, Vc, 512, ncb, NW_BLK, NW_CMP1);
#pragma unroll
        for (int nt = 0; nt < 4; ++nt) { const float lt = x32_sum(x16_sum(l[nt])); invl[nt] = lt > 0.f ? 1.f / lt : 0.f; }
#define NW_CMP2(buf, k0) { _Pragma("unroll 1") for (int th = 0; th < 2; ++th) if (16 * ((k0) + 32 * th) + 31 <= tw1) { KvFrags f; nw_frags<true>(buf, th, fr, fq, f); \
            nsa_core<4, 2, true>(f, (k0) + 32 * th, nullptr, 0, O, m, l, invl, slope, t, 16, 31, 1 << 30, true, imp + fr * 132, fq, qreg); } }
        NW_PIPE(Kc, Vc, 512, ncb, NW_BLK, NW_CMP2);
#pragma unroll
        for (int nt = 0; nt < 4; ++nt) { const float gc = gates[0 * 16 + g * 4 + nt];
#pragma unroll
            for (int dt = 0; dt < 4; ++dt) *(f32x4*)(oacc + (g * 4 + nt) * 64 + 16 * dt + 4 * fq) = O[nt][dt] * gc; }
    }
    LDS_WAIT();
    unsigned selm[4] = {0u, 0u, 0u, 0u};
    {
        const int cur = t >> 6;
        unsigned v[32];
#pragma unroll
        for (int i = 0; i < 32; ++i) { const int j = 32 * fq + i; const bool forced = (j == 0) | (j == cur) | (j == cur - 1);
            const unsigned key = ((f2u(imp[fr * 132 + j]) & ~127u) | (unsigned)(127 - j)) + 128u;
            v[i] = (!forced && j <= cur) ? key : 0u;
            if (forced) selm[fq] |= 1u << i; }
        unsigned fw = selm[0] | selm[1] | selm[2] | selm[3];
        const unsigned w16 = __shfl_xor(fw, 16), w32 = __shfl_xor(fw, 32), w48 = __shfl_xor(fw, 48);
#pragma unroll
        for (int wd = 0; wd < 4; ++wd) selm[wd] = (fq == wd) ? fw : ((fq ^ 1) == wd) ? w16 : ((fq ^ 2) == wd) ? w32 : w48;
        const int nforced = cur >= 2 ? 3 : cur + 1;
#pragma unroll 1
        for (int rd = 0; rd < 15; ++rd) {
            unsigned mx = v[0];
#pragma unroll
            for (int i = 1; i < 32; ++i) mx = mx > v[i] ? mx : v[i];
            mx = x32_umax(x16_umax(mx));
#pragma unroll
            for (int i = 0; i < 32; ++i) v[i] = (v[i] == mx) ? 0u : v[i];
            if (mx != 0u && rd < 16 - nforced) { const int js = 127 - (int)(mx & 127u);
#pragma unroll
                for (int wd = 0; wd < 4; ++wd) selm[wd] |= ((js >> 5) == wd) ? (1u << (js & 31)) : 0u; }
        }
    }
    unsigned un[4];
#pragma unroll
    for (int wd = 0; wd < 4; ++wd) { unsigned x = selm[wd]; x |= dpp_u<DPP_XOR1>(x); x |= dpp_u<DPP_XOR2>(x); x |= dpp_u<DPP_HMIR>(x); x |= dpp_u<DPP_MIR>(x); un[wd] = (unsigned)__builtin_amdgcn_readfirstlane((int)x); }
    if (lane < 4) __hip_atomic_fetch_or(wun + lane, lane == 0 ? un[0] : lane == 1 ? un[1] : lane == 2 ? un[2] : un[3], __ATOMIC_RELAXED, __HIP_MEMORY_SCOPE_WORKGROUP);
    __syncthreads();
    unsigned wu[4];
#pragma unroll
    for (int wd = 0; wd < 4; ++wd) wu[wd] = (unsigned)__builtin_amdgcn_readfirstlane((int)wun[wd]);
    {
        nsa_zero<4>(O, m, l);
        const bf16* Ks = WSP(bf16, WS_KSEL) + (size_t)bg * PT * 64; const bf16* Vs = WSP(bf16, WS_VSELT) + (size_t)bg * 64 * PT;
        const int nsb = __builtin_popcount(wu[0]) + __builtin_popcount(wu[1]) + __builtin_popcount(wu[2]) + __builtin_popcount(wu[3]);
        if (F.tid < 128) { const int j = F.tid, wj = j >> 5, bj = j & 31; const unsigned ww = wj == 0 ? wu[0] : wj == 1 ? wu[1] : wj == 2 ? wu[2] : wu[3];
            if ((ww >> bj) & 1u) { int pos = __builtin_popcount(ww & ((1u << bj) - 1u)); if (wj > 0) pos += __builtin_popcount(wu[0]); if (wj > 1) pos += __builtin_popcount(wu[1]); if (wj > 2) pos += __builtin_popcount(wu[2]);
                blist[pos] = (unsigned char)j; } }
        __syncthreads();
#define NW_SBLK(i) (64 * (int)blist[(i)])
#define NW_SEL(buf, k0) { const int j_ = (k0) >> 6, wj_ = j_ >> 5, bj_ = j_ & 31; const unsigned uw_ = wj_ == 0 ? un[0] : wj_ == 1 ? un[1] : wj_ == 2 ? un[2] : un[3]; \
            if ((uw_ >> bj_) & 1u) { const unsigned mine_ = wj_ == 0 ? selm[0] : wj_ == 1 ? selm[1] : wj_ == 2 ? selm[2] : selm[3]; const bool ok_ = (mine_ >> bj_) & 1u; \
                _Pragma("unroll 1") for (int th = 0; th < 2; ++th) { KvFrags f; nw_frags<true>(buf, th, fr, fq, f); \
                    nsa_core<4, 0, true>(f, (k0) + 32 * th, nullptr, 0, O, m, l, invl, slope, t, 1, 0, 1 << 30, ok_, imp, fq, qreg); } } }
        NW_PIPE(Ks, Vs, PT, nsb, NW_SBLK, NW_SEL);
#pragma unroll
        for (int nt = 0; nt < 4; ++nt) { const float lt = x32_sum(x16_sum(l[nt])); const float sc = gates[1 * 16 + g * 4 + nt] / fmaxf(lt, 1e-30f);
#pragma unroll
            for (int dt = 0; dt < 4; ++dt) { f32x4* o = (f32x4*)(oacc + (g * 4 + nt) * 64 + 16 * dt + 4 * fq); *o = *o + O[nt][dt] * sc; } }
    }
    {
        nsa_zero<4>(O, m, l);
        const bf16* Kw = WSP(bf16, WS_KWIN) + (size_t)bg * PT * 64; const bf16* Vw = WSP(bf16, WS_VWINT) + (size_t)bg * 64 * PT;
        const int lo = 128 * qb - (WINDOW - 1), kb0 = (lo > 0 ? lo : 0) >> 6, kb1 = (128 * qb + 127) >> 6, nwb = kb1 - kb0 + 1;
#define NW_WBLK(i) (64 * (kb0 + (i)))
#define NW_WIN(buf, k0) { _Pragma("unroll 1") for (int th = 0; th < 2; ++th) { const int kk_ = (k0) + 32 * th; if (kk_ <= tw1 && kk_ + 31 >= tw0 - (WINDOW - 1)) { KvFrags f; nw_frags<true>(buf, th, fr, fq, f); \
                nsa_core<4, 0, true>(f, kk_, nullptr, 0, O, m, l, invl, slope, t, 1, 0, WINDOW, true, imp, fq, qreg); } } }
        NW_PIPE(Kw, Vw, PT, nwb, NW_WBLK, NW_WIN);
        bf16* on = WSP(bf16, WS_OG) + (size_t)row * 1024;
#pragma unroll
        for (int nt = 0; nt < 4; ++nt) { const float lt = x32_sum(x16_sum(l[nt])); const float sc = gates[2 * 16 + g * 4 + nt] / fmaxf(lt, 1e-30f);
#pragma unroll
            for (int dt = 0; dt < 4; ++dt) { const f32x4 o = *(const f32x4*)(oacc + (g * 4 + nt) * 64 + 16 * dt + 4 * fq) + O[nt][dt] * sc;
                *(v2u*)(on + (g * 4 + nt) * 64 + 16 * dt + 4 * fq) = (v2u){pk2(o[0], o[1]), pk2(o[2], o[3])}; } }
    }
    __syncthreads();
}

constexpr int SW_Q = 0;
constexpr int SW_IMPP = 2304;
constexpr int SW_IMPT = SW_IMPP + 8 * 2112;
constexpr int SW_LP = SW_IMPT + 2112;
constexpr int SW_OP = SW_LP + 3 * 8 * 16 * 4;
static_assert(SW_OP + 8 * 3 * 16 * 64 * 4 <= RING_BYTES, "sample NSA LDS map");
__device__ __forceinline__ void nsa_sample_wg(Frame& F, int id) {
    int lane_ = F.lane; asm volatile("" : "+v"(lane_));
    const int lane = lane_, fr = lane & 15, fq = lane >> 4, w = F.wave, g = id & 3, bs = id >> 2;
    LAS unsigned char* L = F.lds; asm volatile("" : "+v"(L));
    LAS bf16* qw = (LAS bf16*)(L + SW_Q);
    LAS float* impP = (LAS float*)(L + SW_IMPP) + w * 528; LAS float* impT = (LAS float*)(L + SW_IMPT);
    LAS float* LP = (LAS float*)(L + SW_LP); LAS float* OP = (LAS float*)(L + SW_OP);
    const int t = PAST + (fr >> 2), row0 = MP + bs * 4, trow = fr >> 2, hd = g * 4 + (fr & 3);
    if (F.tid < 128) { const int rr = F.tid >> 3, c8 = F.tid & 7;
        *(LAS v4u*)(qw + rr * NSA_QLD + 8 * c8) = *(const v4u*)(WSP(bf16, WS_QN) + (size_t)(row0 + (rr >> 2)) * 1024 + (g * 4 + (rr & 3)) * 64 + 8 * c8); }
    for (int i = lane; i < 528; i += 64) impP[i] = 0.f;
    __syncthreads();
    float slope[1] = {ex2(-0.5f * (float)(hd + 1)) * LOG2E};
    const LAS bf16* qrow = qw + fr * NSA_QLD;
    f32x4 O[1][4]; float m[1], l[1], invl[1] = {0.f};
#define SW_PUT_O(br) { _Pragma("unroll") for (int dt = 0; dt < 4; ++dt) *(LAS f32x4*)(OP + ((w * 3 + (br)) * 16 + fr) * 64 + 16 * dt + 4 * fq) = O[0][dt]; }
#define SW_PUT_L(br) { const float lt_ = x32_sum(x16_sum(l[0])); if (fq == 0) LP[((br) * 8 + w) * 16 + fr] = lt_; }
    {
        KvBf16 kv{WSP(bf16, WS_SKCMP) + (size_t)id * 512 * 64, WSP(bf16, WS_SVCMPT) + (size_t)id * 64 * 512, 512};
        nsa_zero<1>(O, m, l);
#pragma unroll 1
        for (int tl = w; tl < 16; tl += 8) nsa_tile<1, 1>(kv, 32 * tl, qrow, 0, O, m, l, invl, slope, t, 16, 31, 1 << 30, true, impP + trow * 132, fr, fq);
        SW_PUT_L(0)
        __syncthreads();
        { float lt = 0.f;
#pragma unroll
          for (int ww = 0; ww < 8; ++ww) lt += LP[(0 * 8 + ww) * 16 + fr];
          invl[0] = lt > 0.f ? 1.f / lt : 0.f; }
#pragma unroll 1
        for (int tl = w; tl < 16; tl += 8) nsa_tile<1, 2>(kv, 32 * tl, qrow, 0, O, m, l, invl, slope, t, 16, 31, 1 << 30, true, impP + trow * 132, fr, fq);
        SW_PUT_O(0)
    }
    __syncthreads();
    for (int i = F.tid; i < 528; i += 512) { float s = 0.f;
#pragma unroll
        for (int ww = 0; ww < 8; ++ww) s += ((LAS float*)(L + SW_IMPP))[ww * 528 + i];
        impT[i] = s; }
    __syncthreads();
    unsigned selm[4] = {1u, 0u, 0u, 1u << 31};
    {
        const int li = (fr & 3) * 4 + fq;
        unsigned v[8];
#pragma unroll
        for (int i = 0; i < 8; ++i) { const int j = li * 8 + i; v[i] = (j >= 1 && j <= 126) ? (((f2u(impT[trow * 132 + j]) & ~127u) | (unsigned)(127 - j)) + 128u) : 0u; }
#pragma unroll 1
        for (int rd = 0; rd < 13; ++rd) {
            unsigned mx = v[0];
#pragma unroll
            for (int i = 1; i < 8; ++i) mx = mx > v[i] ? mx : v[i];
            { unsigned o = dpp_u<DPP_XOR1>(mx); mx = mx > o ? mx : o; o = dpp_u<DPP_XOR2>(mx); mx = mx > o ? mx : o; mx = x32_umax(x16_umax(mx)); }
#pragma unroll
            for (int i = 0; i < 8; ++i) v[i] = (v[i] == mx) ? 0u : v[i];
            if (mx != 0u) { const int js = 127 - (int)(mx & 127u);
#pragma unroll
                for (int wd = 0; wd < 4; ++wd) selm[wd] |= ((js >> 5) == wd) ? (1u << (js & 31)) : 0u; }
        }
    }
    {
        nsa_zero<1>(O, m, l);
        unsigned un[4];
#pragma unroll
        for (int wd = 0; wd < 4; ++wd) { unsigned x = selm[wd]; x |= dpp_u<DPP_XOR1>(x); x |= dpp_u<DPP_XOR2>(x); x |= dpp_u<DPP_HMIR>(x); x |= dpp_u<DPP_MIR>(x); un[wd] = (unsigned)__builtin_amdgcn_readfirstlane((int)x); }
        KvSampleSel kvs{FIN(2) + g * 64, (const int*)FIN(6) + bs * NPAGES, WSP(float, WS_SNEW) + (size_t)bs * 2048 + g * 64, g};
        int q = 0;
#pragma unroll 1
        for (int wd = 0; wd < 4; ++wd) {
            unsigned mm = un[wd];
            const unsigned mine = wd == 0 ? selm[0] : wd == 1 ? selm[1] : wd == 2 ? selm[2] : selm[3];
            while (mm) {
                const int bit = __builtin_ctz(mm); mm &= mm - 1u; const int j = 32 * wd + bit;
                const bool ok = (mine >> bit) & 1u;
#pragma unroll 1
                for (int hh = 0; hh < 2; ++hh, ++q) if ((q & 7) == w) { nsa_tile<1, 0>(kvs, 64 * j + 32 * hh, qrow, 0, O, m, l, invl, slope, t, 1, 0, 1 << 30, ok, impP, fr, fq); __builtin_amdgcn_sched_barrier(0); }
            }
        }
        if ((q & 7) == w) nsa_tile<1, 0>(kvs, 64 * 128, qrow, 0, O, m, l, invl, slope, t, 1, 0, 1 << 30, true, impP, fr, fq);
        SW_PUT_O(1) SW_PUT_L(1)
    }
    {
        nsa_zero<1>(O, m, l);
        KvBf16 kv{WSP(bf16, WS_SKWIN) + (size_t)id * 544 * 64, WSP(bf16, WS_SVWINT) + (size_t)id * 64 * 544, 544};
#pragma unroll 1
        for (int kk = 32 * w; kk < 544; kk += 256) nsa_tile<1, 0>(kv, kk, qrow, 0, O, m, l, invl, slope, t, 1, PAST - WINDOW, WINDOW, true, impP, fr, fq);
        SW_PUT_O(2) SW_PUT_L(2)
    }
    __syncthreads();
    {
        const int r = F.tid >> 5, d0 = (F.tid & 31) * 2, rowg = row0 + (r >> 2), hdr = g * 4 + (r & 3);
        float o0 = 0.f, o1 = 0.f;
#pragma unroll
        for (int br = 0; br < 3; ++br) { float a0 = 0.f, a1 = 0.f, lt = 0.f;
#pragma unroll
            for (int ww = 0; ww < 8; ++ww) { const f32x2 x = *(const LAS f32x2*)(OP + ((ww * 3 + br) * 16 + r) * 64 + d0); a0 += x.x; a1 += x.y; if (br > 0) lt += LP[(br * 8 + ww) * 16 + r]; }
            const float sc = WSP(float, WS_GATES)[(size_t)rowg * 48 + br * 16 + hdr] * (br == 0 ? 1.f : 1.f / fmaxf(lt, 1e-30f));
            o0 += a0 * sc; o1 += a1 * sc; }
        *(unsigned*)(WSP(bf16, WS_OG) + (size_t)rowg * 1024 + hdr * 64 + d0) = pk2(o0, o1);
    }
    __syncthreads();
#undef SW_PUT_O
#undef SW_PUT_L
}


#ifndef MK_SINGLE
#define MK_SINGLE 1
#endif
constexpr int NPHASE = 21;
struct Args { const float* in[29]; float* out; unsigned char* ws; int ph_lo, ph_hi; };
static_assert(sizeof(Args) == 31 * 8 + 8, "Args has no padding");

__global__ void __launch_bounds__(512, 2) mk_fwd(Args args) {
    extern __shared__ __attribute__((aligned(16))) unsigned char lds_raw[];
    Frame F;
    F.lds = (LAS unsigned char*)lds_raw;
    F.tid = threadIdx.x; F.lane = F.tid & 63; F.wave = __builtin_amdgcn_readfirstlane(F.tid >> 6);
    F.G = gridDim.x; F.bid = blockIdx.x;
    F.ka = (const __attribute__((address_space(4))) char*)__builtin_amdgcn_kernarg_segment_ptr();
    F.out = args.out; F.ws = args.ws;
    volatile LAS unsigned* MISC = (volatile LAS unsigned*)(F.lds + MISC_OFF);
    for (int u = F.tid; u < (LDS_BYTES - LDSCTL_OFF) / 4; u += 512) ((LAS unsigned*)(F.lds + LDSCTL_OFF))[u] = 0u;
    __syncthreads();
    unsigned* barw = (unsigned*)(F.ws + WS_CTL) + 4096;
    XcdBarrier bar; bar.bar = barw; bar.x = 0; bar.st = nullptr;
    const int lo = args.ph_lo, hi = args.ph_hi;
    if (hi - lo > 1) bar = xcd_barrier_post(barw, MISC + 8);
#ifndef PH_MASK
#define PH_MASK 0xFFFFFFFFu
#endif
#define IN(k) (((PH_MASK >> (k)) & 1u) && lo <= (k) && (k) < hi)
#define SEAM(k) do { if (IN(k) && IN((k) + 1)) xcd_barrier(bar); } while (0)
    const int gw = F.bid * 8 + F.wave, NGW = F.G * 8;

#ifndef REPX
#define REPX 0
#endif
#ifndef REPY
#define REPY 0
#endif
#ifndef REP_MASK
#define REP_MASK 0u
#endif
#define PHASE(k, ...) if (IN(k)) { _Pragma("unroll 1") for (int rep_ = 0; rep_ < (int)((REP_MASK >> (k)) & 1u) + 1; ++rep_) { if (rep_) xcd_barrier(bar); __VA_ARGS__ } } SEAM(k);
    PHASE(0, p0_prologue(F);)
    if (IN(1) && F.G != 256) { for (int task = F.bid; task < 512; task += F.G) fs_direct_task(F, task); }
    if (IN(1) && IN(2) && F.G != 256) xcd_barrier(bar);
    PHASE(2, gemm_all(F, WSP(bf16, WS_XNA), WSP(bf16, WS_WIN_T), 4096, FnBf16{WSP(bf16, WS_PROJ), 4096});)
    PHASE(3, for (int u = F.bid; u < 2048 + 256; u += F.G) { if (u < 2048) p2_chunk(F, u); else p2_sample(F, u - 2048); })
    PHASE(4, if (F.G == 256) { const int x = F.bid & 7, idx = F.bid >> 3;
                 if (idx < 8) p3_scan(F, x * 2 + (idx >> 2), idx & 3);
                 else { const int j = (idx - 8) * 8 + x;
                        const size_t n8 = (size_t)2 * NEXP * DM / 8; const int p0 = j < 128 ? 6 * j : 768 + 13 * (j - 128), p1 = p0 + (j < 128 ? 6 : 13);
                        peer_tables_to_fp8(F, (size_t)F.tid, (size_t)512, n8 * p0 / 1600, n8 * p1 / 1600);
                        __syncthreads();
                        for (int task = j; task < 512; task += 192) fs_direct_task(F, task); } }
             else { for (int u = F.bid; u < 64; u += F.G) p3_scan(F, u >> 2, u & 3); })
    PHASE(5, p4_rows(F, gw, NGW);
             for (int id = gw; id < 8192; id += NGW) compress_sample(F, id);)
    PHASE(6, gemm_all(F, WSP(bf16, WS_OG), WSP(bf16, WS_WOA_T), 1024, FnResid{WSP(float, WS_XS), FIN(0), FIN(1)});)
    PHASE(7, for (int r = gw; r < MTOK; r += NGW) rms_row_to_bf16(WSP(float, WS_XS) + (size_t)r * DM, WSP(bf16, WS_XNB) + (size_t)r * DM, F.lane);)
    PHASE(8, gemm_all(F, WSP(bf16, WS_XNB), WSP(bf16, WS_WPQ_T), 2048, FnBf16{WSP(bf16, WS_QPEER), 2048});)
    PHASE(9, p8_phase(F, 0);)
    int pg_slice = F.bid & 7, pg_first = (F.bid >> 3) * 8 + F.wave, pg_stride = ((F.G - (F.bid & 7) + 7) >> 3) * 8;
#define PEER_GROUPS() do { if (MISC[8 + 3] != 0u && (F.G & 7) == 0) { const unsigned c_ = xb_ld(&barw[XB_XCNT(F.lane & 15)]); const bool ok_ = (F.lane & 15) < 8 ? c_ == (unsigned)(F.G >> 3) : c_ == 0u; \
        if (__builtin_amdgcn_ballot_w64(ok_) == ~0ull && bar.x < 8u) { pg_slice = (int)bar.x; pg_first = (int)MISC[8 + 2] * 8 + F.wave; pg_stride = F.G; } } } while (0)
    PHASE(10, PEER_GROUPS(); p9u_wave(F, 0, pg_slice, pg_first, pg_stride);)
    PHASE(11, PEER_GROUPS(); p9v_wave(F, 0, pg_slice, pg_first, pg_stride, 0);)
    PHASE(12, gemm_all(F, WSP(bf16, WS_XNA), WSP(bf16, WS_WKVQ_T), NKVQ, FnKvq{WSP(bf16, WS_KVQ), WSP(float, WS_SSQ)});)
    PHASE(13, for (int u = F.bid; u < 256; u += F.G) pp_prompt_tile(F, u);
              if (F.G == 256) { compress_prompt_split(F, F.bid * 2 + (F.wave >> 2)); if (F.bid < MS) pp_sample_row(F, F.bid, F.wave); }
              else { for (int r = gw; r < MS; r += NGW) pp_sample_row(F, r); for (int id = gw; id < 512; id += NGW) compress_prompt(F, id); })
    PHASE(14, if (F.G == 256) {
                  _Pragma("unroll 1") for (int q_ = 0; q_ < 1 + REPX; ++q_) { if (F.bid < 128) nsa_sample_wg(F, F.bid); }
                  __syncthreads();
                  { const int i_ = F.bid >> 3;
                    if (i_ < 16) { nsa_wg(F, F.bid & 7, i_); nsa_wg(F, F.bid & 7, 31 - i_); } else { nsa_wg(F, F.bid & 7, 16 + i_); nsa_wg(F, F.bid & 7, 79 - i_); } }
              } else { for (int id = gw; id < 128 + 4096; id += NGW) { if (id < 128) nsa_unit<true>(F, id); else nsa_unit<false>(F, id - 128); } })
    PHASE(15, gemm_all(F, WSP(bf16, WS_OG), WSP(bf16, WS_WOB_T), 1024, FnResid{WSP(float, WS_XS), WSP(float, WS_XS), WSP(float, WS_XS) + (size_t)MP * DM});)
    PHASE(16, for (int r = gw; r < MTOK; r += NGW) rms_row_to_bf16(WSP(float, WS_XS) + (size_t)r * DM, WSP(bf16, WS_XNB) + (size_t)r * DM, F.lane);)
    PHASE(17, gemm_all(F, WSP(bf16, WS_XNB), WSP(bf16, WS_WPQ_T) + (size_t)2048 * 1024, 2048, FnBf16{WSP(bf16, WS_QPEER), 2048});)
    PHASE(18, p8_phase(F, 1);)
    PHASE(19, PEER_GROUPS(); p9u_wave(F, 1, pg_slice, pg_first, pg_stride);)
    PHASE(20, PEER_GROUPS(); p9v_wave(F, 1, pg_slice, pg_first, pg_stride, 1);)
#undef IN
#undef SEAM
}

extern "C" void kernel_launch(void* const* d_in, const int* in_sizes, int n_in, void* d_out, int out_size, void* d_ws, size_t ws_size, hipStream_t stream) {
    static int grid = 0;
    if (grid == 0) {
        if (n_in != 29 || (size_t)out_size != O_END || ws_size < WS_END) { fprintf(stderr, "kernel_launch: unexpected shapes n_in %d out %d ws %zu (need %zu)\n", n_in, out_size, ws_size, (size_t)WS_END); grid = -1; return; }
        int dev = 0, cus = 0, per_cu = 0;
        if (hipGetDevice(&dev) != hipSuccess || hipDeviceGetAttribute(&cus, hipDeviceAttributeMultiprocessorCount, dev) != hipSuccess) { grid = -1; return; }
        if (hipFuncSetAttribute((const void*)mk_fwd, hipFuncAttributeMaxDynamicSharedMemorySize, LDS_BYTES) != hipSuccess) { fprintf(stderr, "kernel_launch: hipFuncSetAttribute failed\n"); grid = -1; return; }
        if (hipOccupancyMaxActiveBlocksPerMultiprocessor(&per_cu, (const void*)mk_fwd, 512, LDS_BYTES) != hipSuccess || per_cu < 1) fprintf(stderr, "kernel_launch: occupancy query reports %d\n", per_cu);
        (void)hipGetLastError();
        grid = cus;
    }
    if (grid < 0) return;
    if (hipMemsetAsync((char*)d_ws + WS_CTL, 0, CTL_BYTES, stream) != hipSuccess) return;
    Args a{};
    for (int i = 0; i < 29; ++i) a.in[i] = (const float*)d_in[i];
    a.out = (float*)d_out; a.ws = (unsigned char*)d_ws;
#if MK_SINGLE
    a.ph_lo = 0; a.ph_hi = NPHASE;
    hipLaunchKernelGGL(mk_fwd, dim3(grid), dim3(512), LDS_BYTES, stream, a);
#else
    for (int p = 0; p < NPHASE; ++p) { a.ph_lo = p; a.ph_hi = p + 1; hipLaunchKernelGGL(mk_fwd, dim3(grid), dim3(512), LDS_BYTES, stream, a); }
#endif
    const hipError_t le = hipPeekAtLastError();
    if (le != hipSuccess) fprintf(stderr, "kernel_launch: launch failed: %s\n", hipGetErrorName(le));
}
```

```cpp
#include <hip/hip_runtime.h>
#include <cstdio>
#include <cstdint>

constexpr int DM = 1024, PB = 2, PT = 8192, SB = 32, SL = 4, PAST = 8192, PAGE = 128;
constexpr int MP = PB * PT;
constexpr int MS = SB * SL;
constexpr int MTOK = MP + MS;
constexpr int GH = 8, GDK = 128, GDV = 128, GCONV = 3072, GPROJ = 4112, CHUNK = 64, NCH = PT / CHUNK;
constexpr int NH = 16, NG = 4, HPG = 4, DH = 64, NQG = 1072, NKV = 1536, NKVQ = 2816, NKVQ_REAL = 2608;
constexpr int WINDOW = 512, NSELP = 128, NSELS = 129, NCMP = 511;
constexpr int PEH = 8, PEDQ = 256, PEHALF = 128, NKEYS = 128, NEXP = 16384, PETOP = 16;
constexpr int NPAGES = PAST / PAGE;
constexpr float EPS = 1e-6f;

constexpr size_t O_YP = 0;
constexpr size_t O_YS = O_YP + (size_t)MP * DM;
constexpr size_t O_KVP = O_YS + (size_t)MS * DM;
constexpr size_t O_WINP = O_KVP + (size_t)MP * 1024;
constexpr size_t O_GDNP = O_WINP + (size_t)PB * 512 * 512;
constexpr size_t O_CONVP = O_GDNP + (size_t)PB * GH * 128 * 128;
constexpr size_t O_KVS = O_CONVP + (size_t)PB * 3 * GCONV;
constexpr size_t O_WINS = O_KVS + (size_t)MS * 1024;
constexpr size_t O_GDNS = O_WINS + (size_t)SB * 512 * 512;
constexpr size_t O_CONVS = O_GDNS + (size_t)SB * GH * 128 * 128;
constexpr size_t O_END = O_CONVS + (size_t)SB * 3 * GCONV;

constexpr size_t MiB = 1u << 20;
constexpr size_t al(size_t x) { return (x + 4095) & ~(size_t)4095; }
constexpr size_t WS_CTL = 0, CTL_BYTES = 1 * MiB;
constexpr size_t WS_WIN_T = WS_CTL + CTL_BYTES;
constexpr size_t WS_WOA_T = WS_WIN_T + (size_t)4096 * 1024 * 2;
constexpr size_t WS_WKVQ_T = WS_WOA_T + (size_t)1024 * 1024 * 2;
constexpr size_t WS_WOB_T = WS_WKVQ_T + (size_t)NKVQ * 1024 * 2;
constexpr size_t WS_WPQ_T = WS_WOB_T + (size_t)1024 * 1024 * 2;
constexpr size_t WS_WAB = WS_WPQ_T + (size_t)2 * 2048 * 1024 * 2;
constexpr size_t WS_SUBK = WS_WAB + (size_t)16 * 1024 * 4;
constexpr size_t WS_W1T = WS_SUBK + (size_t)2 * 8 * 2 * 128 * 128 * 2;
constexpr size_t WS_PETERM = WS_W1T + (size_t)2 * 128 * 1024 * 2;
constexpr size_t WS_PU = al(WS_PETERM + 512);
constexpr size_t WS_PV = WS_PU + (size_t)2 * NEXP * DM * 2;
constexpr size_t WS_XNA = WS_PV + (size_t)2 * NEXP * DM * 2;
constexpr size_t WS_XNB = al(WS_XNA + (size_t)MTOK * DM * 2);
constexpr size_t WS_PROJ = al(WS_XNB + (size_t)MTOK * DM * 2);
constexpr size_t WS_GW = al(WS_PROJ + (size_t)MTOK * 4096 * 2);
constexpr size_t WS_GQ = WS_GW + (size_t)2048 * 64 * 128 * 2;
constexpr size_t WS_GKT = WS_GQ + (size_t)2048 * 64 * 128 * 2;
constexpr size_t WS_GQK = WS_GKT + (size_t)2048 * 64 * 128 * 2;
constexpr size_t WS_GU = WS_GQK + (size_t)2048 * 64 * 64 * 2;
constexpr size_t WS_GDEC = WS_GU + (size_t)2048 * 64 * 128 * 4;
constexpr size_t WS_OGDN = al(WS_GDEC + 2048 * 4);
constexpr size_t WS_OG = al(WS_OGDN + (size_t)MTOK * DM * 4);
constexpr size_t WS_XS = al(WS_OG + (size_t)MTOK * DM * 2);
constexpr size_t WS_QPEER = al(WS_XS + (size_t)MTOK * DM * 4);
constexpr size_t WS_PEI = al(WS_QPEER + (size_t)MTOK * 2048 * 2);
constexpr size_t WS_PEG = al(WS_PEI + (size_t)MTOK * 128 * 4);
constexpr size_t WS_KVQ = al(WS_PEG + (size_t)MTOK * 128 * 4);
constexpr size_t WS_KSEL = al(WS_KVQ + (size_t)MTOK * NKVQ * 4);
constexpr size_t WS_VSELT = WS_KSEL + (size_t)PB * NG * PT * 64 * 2;
constexpr size_t WS_KWIN = WS_VSELT + (size_t)PB * NG * PT * 64 * 2;
constexpr size_t WS_VWINT = WS_KWIN + (size_t)PB * NG * PT * 64 * 2;
constexpr size_t WS_KCMP = WS_VWINT + (size_t)PB * NG * PT * 64 * 2;
constexpr size_t WS_VCMPT = WS_KCMP + (size_t)PB * NG * 512 * 64 * 2;
constexpr size_t WS_SKCMP = WS_VCMPT + (size_t)PB * NG * 512 * 64 * 2;
constexpr size_t WS_SVCMPT = WS_SKCMP + (size_t)SB * NG * 512 * 64 * 2;
constexpr size_t WS_SKWIN = WS_SVCMPT + (size_t)SB * NG * 512 * 64 * 2;
constexpr size_t WS_SVWINT = WS_SKWIN + (size_t)SB * NG * 544 * 64 * 2;
constexpr size_t WS_SNEW = WS_SVWINT + (size_t)SB * NG * 544 * 64 * 2;
constexpr size_t WS_QN = al(WS_SNEW + (size_t)SB * 4 * 2 * 4 * 64 * 4);
constexpr size_t WS_GATES = al(WS_QN + (size_t)MTOK * 1024 * 2);
constexpr size_t WS_OACC = al(WS_GATES + (size_t)MTOK * 48 * 4);
constexpr size_t WS_CKA = al(WS_OACC + (size_t)MTOK * DM * 4);
constexpr size_t WS_W1BD = al(WS_CKA + (size_t)65536 * 2048 * 2);
constexpr size_t WS_FS = al(WS_W1BD + (size_t)256 * 2048 * 2);
constexpr size_t WS_PA = al(WS_FS + (size_t)65536 * 256 * 4);
constexpr size_t WS_SSQ = al(WS_PA + (size_t)MTOK * 8 * 64 * 4);
constexpr size_t WS_W2F = al(WS_SSQ + (size_t)MTOK * 8 * 4);
constexpr size_t WS_END = al(WS_W2F + 2 * 4 * 2 * 64 * 8 * 2);

constexpr int RING_BYTES = 143360;
constexpr int LDSCTL_OFF = RING_BYTES, MISC_OFF = LDSCTL_OFF + 320;
constexpr int LDS_BYTES = 147456;

#define GAS __attribute__((address_space(1)))
#define LAS __attribute__((address_space(3)))
typedef unsigned short bf16;
typedef unsigned v4u __attribute__((ext_vector_type(4)));
typedef unsigned v2u __attribute__((ext_vector_type(2)));
typedef float f32x4 __attribute__((ext_vector_type(4)));
typedef float f32x2 __attribute__((ext_vector_type(2)));
typedef short bf16x8 __attribute__((ext_vector_type(8)));
typedef GAS unsigned gu32;
#define RLX_AGENT __ATOMIC_RELAXED, __HIP_MEMORY_SCOPE_AGENT
#define LDS_WAIT() asm volatile("s_waitcnt lgkmcnt(0)" ::: "memory")
#define VM_WAIT() asm volatile("s_waitcnt vmcnt(0)" ::: "memory")

__device__ __forceinline__ unsigned f2bf(float f) { unsigned u = __builtin_bit_cast(unsigned, f); return (u + 0x7fffu + ((u >> 16) & 1u)) >> 16; }
typedef __bf16 hwbf16x2 __attribute__((ext_vector_type(2)));
__device__ __forceinline__ unsigned pk2(float lo, float hi) { const f32x2 v = {lo, hi}; return __builtin_bit_cast(unsigned, __builtin_convertvector(v, hwbf16x2)); }
__device__ __forceinline__ float bf2f(unsigned b) { return __builtin_bit_cast(float, b << 16); }
__device__ __forceinline__ float bflo(unsigned w) { return __builtin_bit_cast(float, w << 16); }
__device__ __forceinline__ float bfhi(unsigned w) { return __builtin_bit_cast(float, w & 0xffff0000u); }
#ifndef USE_PERMSWAP
#define USE_PERMSWAP 1
#endif
template <int CTRL> __device__ __forceinline__ float dpp_f(float x) { return __builtin_bit_cast(float, __builtin_amdgcn_update_dpp(0, __builtin_bit_cast(int, x), CTRL, 0xF, 0xF, true)); }
template <int CTRL> __device__ __forceinline__ unsigned dpp_u(unsigned x) { return (unsigned)__builtin_amdgcn_update_dpp(0, (int)x, CTRL, 0xF, 0xF, true); }
#define DPP_XOR1 0xB1
#define DPP_XOR2 0x4E
#define DPP_HMIR 0x141
#define DPP_MIR 0x140
#define DPP_ROR4 0x124
#define DPP_ROR8 0x128
#if USE_PERMSWAP
#define PSWAP16(a, b) asm volatile("s_nop 1\n\tv_permlane16_swap_b32 %0, %1" : "+v"(a), "+v"(b))
#define PSWAP32(a, b) asm volatile("s_nop 1\n\tv_permlane32_swap_b32 %0, %1" : "+v"(a), "+v"(b))
__device__ __forceinline__ float x16_sum(float x) { unsigned a = __builtin_bit_cast(unsigned, x), b = a; PSWAP16(a, b); return __builtin_bit_cast(float, a) + __builtin_bit_cast(float, b); }
__device__ __forceinline__ float x32_sum(float x) { unsigned a = __builtin_bit_cast(unsigned, x), b = a; PSWAP32(a, b); return __builtin_bit_cast(float, a) + __builtin_bit_cast(float, b); }
__device__ __forceinline__ float x16_max(float x) { unsigned a = __builtin_bit_cast(unsigned, x), b = a; PSWAP16(a, b); return fmaxf(__builtin_bit_cast(float, a), __builtin_bit_cast(float, b)); }
__device__ __forceinline__ float x32_max(float x) { unsigned a = __builtin_bit_cast(unsigned, x), b = a; PSWAP32(a, b); return fmaxf(__builtin_bit_cast(float, a), __builtin_bit_cast(float, b)); }
__device__ __forceinline__ unsigned x16_umax(unsigned u) { unsigned a = u, b = u; PSWAP16(a, b); return a > b ? a : b; }
__device__ __forceinline__ unsigned x32_umax(unsigned u) { unsigned a = u, b = u; PSWAP32(a, b); return a > b ? a : b; }
#else
__device__ __forceinline__ float x16_sum(float x) { return x + __shfl_xor(x, 16); }
__device__ __forceinline__ float x32_sum(float x) { return x + __shfl_xor(x, 32); }
__device__ __forceinline__ float x16_max(float x) { return fmaxf(x, __shfl_xor(x, 16)); }
__device__ __forceinline__ float x32_max(float x) { return fmaxf(x, __shfl_xor(x, 32)); }
__device__ __forceinline__ unsigned x16_umax(unsigned u) { const unsigned o = __shfl_xor(u, 16); return u > o ? u : o; }
__device__ __forceinline__ unsigned x32_umax(unsigned u) { const unsigned o = __shfl_xor(u, 32); return u > o ? u : o; }
#endif
__device__ __forceinline__ float row_sum16(float x) { x += dpp_f<DPP_XOR1>(x); x += dpp_f<DPP_XOR2>(x); x += dpp_f<DPP_HMIR>(x); x += dpp_f<DPP_MIR>(x); return x; }
__device__ __forceinline__ float wave_sum(float v) { return x32_sum(x16_sum(row_sum16(v))); }
__device__ __forceinline__ float frcp(float x) { return __builtin_amdgcn_rcpf(x); }
__device__ __forceinline__ float frsq(float x) { return __builtin_amdgcn_rsqf(x); }
__device__ __forceinline__ float silu_f(float x) { return x * frcp(1.f + __expf(-x)); }
__device__ __forceinline__ float sigmoid_f(float x) { return frcp(1.f + __expf(-x)); }
__device__ __forceinline__ float gelu_tanh(float x) {
    const float u = 0.7978845608028654f * (x + 0.044715f * x * x * x);
    const float e = __expf(2.f * u);
    const float th = 1.f - 2.f * frcp(e + 1.f);
    return 0.5f * x * (1.f + th);
}
__device__ __forceinline__ bf16x8 ld8(const bf16* p) { return *(const bf16x8*)p; }
__device__ __forceinline__ bf16x8 ld8l(const LAS bf16* p) { return *(const LAS bf16x8*)p; }
#define MFMA16(a, b, c) __builtin_amdgcn_mfma_f32_16x16x32_bf16((a), (b), (c), 0, 0, 0)
__device__ __forceinline__ bf16x8 cvt8(f32x4 a, f32x4 b) {
    v4u r; r.x = pk2(a.x, a.y); r.y = pk2(a.z, a.w); r.z = pk2(b.x, b.y); r.w = pk2(b.z, b.w); return __builtin_bit_cast(bf16x8, r);
}

struct Frame {
    LAS unsigned char* lds;
    int tid, lane, wave, G, bid;
    const __attribute__((address_space(4))) char* ka;
    float* out;
    unsigned char* ws;
};
#define WSP(T, off) ((T*)(F.ws + (off)))
__device__ __forceinline__ const float* fin_(const __attribute__((address_space(4))) char* ka, int i) {
    const __attribute__((address_space(4))) char* p = ka; asm volatile("" : "+s"(p));
    return *(const float* const __attribute__((address_space(4)))*)(p + 8 * i);
}
#define FIN(i) fin_(F.ka, (i))
namespace pg8 {
#define PG8_LAS __attribute__((address_space(3)))
typedef unsigned short bf16_t;
typedef short bf16x8 __attribute__((ext_vector_type(8)));
typedef float f32x4 __attribute__((ext_vector_type(4)));
typedef unsigned u32x4 __attribute__((ext_vector_type(4)));
constexpr int BM = 256, BK = 64, HALF = 128, HTB = HALF * BK * 2  , STAGE_BYTES = 8 * HTB, NXCD = 8, WGM = 8;

__host__ __device__ __forceinline__ int lds_byte(int r, int c) { const int st = (r >> 4) * 2 + (c >> 5), rr = r & 15, cc = c & 31, ob = rr * 64 + cc * 2; return st * 1024 + (ob ^ (((ob >> 9) & 1) << 5)); }
__host__ __device__ __forceinline__ void stage_rc(int b, int& R, int& C) { const int st = b / 1024, sb = b % 1024, swz = sb ^ (((sb >> 9) & 1) << 5); R = (st >> 1) * 16 + swz / 64; C = (st & 1) * 32 + (swz % 64) / 2; }
__host__ __device__ __forceinline__ int perm32(int rho) { const int n = rho >> 4, i = rho & 15; return 8 * (i >> 2) + 4 * n + (i & 3); }

struct Unit { int pm, pn; };
struct Gemm { const bf16_t* A; const bf16_t* Bt; int M, N, K; };

struct StaticOrder {
    int nM, nN, nwg, G, c;
    __host__ __device__ void init(int M, int N, int G_, int c_) { nM = M / BM; nN = N / BM; nwg = nM * nN; G = G_; c = c_; }
    __host__ __device__ bool next(int i, Unit& u) const {
        const long L = (long)i * G + c; if (L >= nwg) return false;
        int wgid = (int)L; { const int q = nwg / NXCD, r = nwg % NXCD, xcd = wgid % NXCD, off = wgid / NXCD; wgid = (xcd < r ? xcd * (q + 1) : r * (q + 1) + (xcd - r) * q) + off; }
        const int nig = WGM * nN, gid = wgid / nig, fm = gid * WGM, gsz = (nM - fm) < WGM ? (nM - fm) : WGM;
        u.pm = fm + ((wgid % nig) % gsz); u.pn = (wgid % nig) / gsz; return true;
    }
    __device__ __forceinline__ void a_ready(const Unit&) const {}
    __device__ __forceinline__ void done(const Unit&) const {}
};
template <class Epi, class Sched, bool ALIGN_EPI = false, bool SP2 = false>
__device__ __forceinline__ void gemm_phase(PG8_LAS unsigned char* lds, const Gemm g, const Sched& S, const Epi& E) {
    const int tid = threadIdx.x, wid = __builtin_amdgcn_readfirstlane(tid >> 6), lane = tid & 63, wr = wid >> 2, wc = wid & 3, fr = lane & 15, fq = lane >> 4;
    const int K = g.K, nt = K / BK;
    unsigned voffA[2], voffB[2];
#pragma unroll
    for (int i = 0; i < 2; ++i) { int R, C; stage_rc(tid * 16 + i * 8192, R, C); const int Rb = Epi::PERM ? ((R & ~31) + perm32(R & 31)) : R;
        voffA[i] = (unsigned)(R * K + C) * 2u; voffB[i] = (unsigned)(Rb * K + C) * 2u; }
    const size_t kstep = (size_t)(BK * 2);
    const size_t hstep = (size_t)HALF * K * 2;
    const size_t tstep = 2 * hstep;
    const unsigned ldsw = (unsigned)wid * 1024u;
    const int aoff = lds_byte(wr * 64 + fr, fq * 8), boff = lds_byte(wc * 32 + fr, fq * 8);
#define PG8_SA(b, h) (((b) * 2 + (h)) * HTB)
#define PG8_SB(b, h) ((4 + (b) * 2 + (h)) * HTB)
#define PG8_STAGE(bufoff, gbase, voff) do { _Pragma("unroll") for (int _i = 0; _i < 2; ++_i) \
        __builtin_amdgcn_global_load_lds((const unsigned*)((const char*)(gbase) + (voff)[_i]), (PG8_LAS unsigned*)(lds + (bufoff) + ldsw + _i * 8192), 16, 0, 0); } while (0)
#define PG8_LDA(dst, b, h) do { _Pragma("unroll") for (int m = 0; m < 4; ++m) _Pragma("unroll") for (int k = 0; k < 2; ++k) dst[m][k] = *(const PG8_LAS bf16x8*)(lds + PG8_SA(b, h) + aoff + m * 2048 + k * 1024); } while (0)
#define PG8_LDB(dst, b, h) do { _Pragma("unroll") for (int n = 0; n < 2; ++n) _Pragma("unroll") for (int k = 0; k < 2; ++k) dst[n][k] = *(const PG8_LAS bf16x8*)(lds + PG8_SB(b, h) + boff + n * 2048 + k * 1024); } while (0)
#define PG8_MMA(ai, bj, At, Bt) do { __builtin_amdgcn_s_setprio(1); _Pragma("unroll") for (int m = 0; m < 4; ++m) _Pragma("unroll") for (int n = 0; n < 2; ++n) _Pragma("unroll") for (int k = 0; k < 2; ++k) \
        acc[ai][bj][m][n] = __builtin_amdgcn_mfma_f32_16x16x32_bf16(Bt[n][k], At[m][k], acc[ai][bj][m][n], 0, 0, 0); __builtin_amdgcn_s_setprio(0); } while (0)
#define PG8_WAIT_V(n) asm volatile("s_waitcnt vmcnt(" #n ")" ::: "memory")
#define PG8_WAIT_L(n) asm volatile("s_waitcnt lgkmcnt(" #n ")" ::: "memory")
#define PG8_BAR __builtin_amdgcn_s_barrier()
#define PG8_SCHED __builtin_amdgcn_sched_barrier(0)
    Unit cur, nxt; int ui = 0;
    if (!S.next(0, cur)) return;
    f32x4 acc[2][2][4][2];
#pragma unroll
    for (int a = 0; a < 2; ++a)
#pragma unroll
        for (int b = 0; b < 2; ++b)
#pragma unroll
            for (int m = 0; m < 4; ++m)
#pragma unroll
                for (int n = 0; n < 2; ++n) acc[a][b][m][n] = (f32x4){0.f, 0.f, 0.f, 0.f};
    bf16x8 At[4][2], B0[2][2], B1[2][2];
    const char* cA = (const char*)g.A + (size_t)cur.pm * tstep; const char* cB = (const char*)g.Bt + (size_t)cur.pn * tstep;
    S.a_ready(cur);
    if constexpr (SP2) {
        PG8_STAGE(PG8_SB(0, 0), cB, voffB); PG8_STAGE(PG8_SB(0, 1), cB + hstep, voffB); PG8_STAGE(PG8_SA(0, 0), cA, voffA); PG8_STAGE(PG8_SA(0, 1), cA + hstep, voffA);
        if (wr == 1) PG8_BAR;
        PG8_WAIT_V(2); PG8_BAR;
        PG8_STAGE(PG8_SB(1, 0), cB + kstep, voffB); PG8_STAGE(PG8_SA(1, 0), cA + kstep, voffA); PG8_STAGE(PG8_SB(1, 1), cB + hstep + kstep, voffB);
        PG8_WAIT_V(6); PG8_BAR;
    } else {
        PG8_STAGE(PG8_SB(0, 0), cB, voffB); PG8_STAGE(PG8_SA(0, 0), cA, voffA); PG8_STAGE(PG8_SB(0, 1), cB + hstep, voffB); PG8_STAGE(PG8_SA(0, 1), cA + hstep, voffA);
        if (wr == 1) PG8_BAR;
        PG8_WAIT_V(4); PG8_BAR;
        PG8_STAGE(PG8_SB(1, 0), cB + kstep, voffB); PG8_STAGE(PG8_SA(1, 0), cA + kstep, voffA); PG8_STAGE(PG8_SB(1, 1), cB + hstep + kstep, voffB);
        PG8_WAIT_V(6); PG8_BAR;
    }
    for (;;) {
        const bool has_next = S.next(ui + 1, nxt);
        const char* nA = has_next ? (const char*)g.A + (size_t)nxt.pm * tstep : cA; const char* nB = has_next ? (const char*)g.Bt + (size_t)nxt.pn * tstep : cB;
        for (int t = 0; t < nt; t += 2) {
            const bool last = (t == nt - 2);
            const char* a1 = cA + (size_t)(t + 1) * kstep;
            const char* a2 = last ? nA : cA + (size_t)(t + 2) * kstep; const char* b2 = last ? nB : cB + (size_t)(t + 2) * kstep;
            const char* a3 = a2 + kstep; const char* b3 = b2 + kstep;
            if (last && has_next) S.a_ready(nxt);
            if constexpr (SP2) {
            PG8_LDB(B0, 0, 0); PG8_LDB(B1, 0, 1); PG8_SCHED; PG8_LDA(At, 0, 0); PG8_STAGE(PG8_SA(1, 1), a1 + hstep, voffA);
            PG8_WAIT_V(8); PG8_WAIT_L(0); PG8_BAR; PG8_MMA(0, 0, At, B0); PG8_MMA(0, 1, At, B1); PG8_BAR; PG8_SCHED;
            PG8_LDA(At, 0, 1); PG8_STAGE(PG8_SB(0, 0), b2, voffB); PG8_STAGE(PG8_SB(0, 1), b2 + hstep, voffB); PG8_STAGE(PG8_SA(0, 0), a2, voffA);
            PG8_WAIT_V(8); PG8_WAIT_L(0); PG8_BAR; PG8_MMA(1, 0, At, B0); PG8_MMA(1, 1, At, B1); PG8_BAR; PG8_SCHED;
            PG8_LDB(B0, 1, 0); PG8_LDB(B1, 1, 1); PG8_SCHED; PG8_LDA(At, 1, 0); PG8_STAGE(PG8_SA(0, 1), a2 + hstep, voffA);
            PG8_WAIT_V(8); PG8_WAIT_L(0); PG8_BAR; PG8_MMA(0, 0, At, B0); PG8_MMA(0, 1, At, B1); PG8_BAR; PG8_SCHED;
            PG8_LDA(At, 1, 1); PG8_STAGE(PG8_SB(1, 0), b3, voffB); PG8_STAGE(PG8_SB(1, 1), b3 + hstep, voffB); PG8_STAGE(PG8_SA(1, 0), a3, voffA);
            PG8_WAIT_V(8); PG8_WAIT_L(0); PG8_BAR; PG8_MMA(1, 0, At, B0); PG8_MMA(1, 1, At, B1); PG8_BAR; PG8_SCHED;
            } else {
            PG8_LDB(B0, 0, 0); PG8_SCHED; PG8_LDA(At, 0, 0); PG8_STAGE(PG8_SA(1, 1), a1 + hstep, voffA);
            PG8_WAIT_L(8); PG8_BAR; PG8_WAIT_L(0); PG8_MMA(0, 0, At, B0); PG8_BAR; PG8_SCHED;
            PG8_LDB(B1, 0, 1); PG8_STAGE(PG8_SB(0, 0), b2, voffB);
            PG8_BAR; PG8_WAIT_L(0); PG8_MMA(0, 1, At, B1); PG8_BAR;
            PG8_LDA(At, 0, 1); PG8_STAGE(PG8_SA(0, 0), a2, voffA);
            PG8_BAR; PG8_WAIT_L(0); PG8_MMA(1, 0, At, B0); PG8_BAR; PG8_SCHED;
            PG8_STAGE(PG8_SB(0, 1), b2 + hstep, voffB);
            PG8_WAIT_V(6); PG8_BAR; PG8_MMA(1, 1, At, B1); PG8_BAR;
            PG8_LDB(B0, 1, 0); PG8_SCHED; PG8_LDA(At, 1, 0); PG8_STAGE(PG8_SA(0, 1), a2 + hstep, voffA);
            PG8_WAIT_L(8); PG8_BAR; PG8_WAIT_L(0); PG8_MMA(0, 0, At, B0); PG8_BAR; PG8_SCHED;
            PG8_LDB(B1, 1, 1); PG8_STAGE(PG8_SB(1, 0), b3, voffB);
            PG8_BAR; PG8_WAIT_L(0); PG8_MMA(0, 1, At, B1); PG8_BAR;
            PG8_LDA(At, 1, 1); PG8_STAGE(PG8_SA(1, 0), a3, voffA);
            PG8_BAR; PG8_WAIT_L(0); PG8_MMA(1, 0, At, B0); PG8_BAR; PG8_SCHED;
            PG8_STAGE(PG8_SB(1, 1), b3 + hstep, voffB);
            PG8_WAIT_V(6); PG8_BAR; PG8_MMA(1, 1, At, B1); PG8_BAR;
            }
        }
        if constexpr (ALIGN_EPI) { if (wr == 0) PG8_BAR; }
        if constexpr (!Epi::AFTER_DRAIN) { E(acc, cur, wr, wc, fr, fq); S.done(cur); }
        if (!has_next) break;
#pragma unroll
        for (int a = 0; a < 2; ++a)
#pragma unroll
            for (int b = 0; b < 2; ++b)
#pragma unroll
                for (int m = 0; m < 4; ++m)
#pragma unroll
                    for (int n = 0; n < 2; ++n) acc[a][b][m][n] = (f32x4){0.f, 0.f, 0.f, 0.f};
        cur = nxt; cA = nA; cB = nB; ++ui;
        if constexpr (ALIGN_EPI) { if (wr == 1) PG8_BAR; }
    }
    PG8_WAIT_V(0);
    if constexpr (!ALIGN_EPI) { if (wr == 0) PG8_BAR; }
    PG8_BAR;
    if constexpr (Epi::AFTER_DRAIN) { E.fused(acc, cur, wr, wc, fr, fq, lds, wid, lane); S.done(cur); }
#undef PG8_SA
#undef PG8_SB
#undef PG8_STAGE
#undef PG8_LDA
#undef PG8_LDB
#undef PG8_MMA
#undef PG8_WAIT_V
#undef PG8_WAIT_L
#undef PG8_BAR
#undef PG8_SCHED
}
}
#define XB_TMO      128
#define XB_XCNT(j)  (256  + 64 * (j))
#define XB_XSUB(j)  (1280 + 64 * (j))
#define XB_XGEN(j)  (2304 + 64 * (j))
#define XB_TOP      3328
#define XB_TOPGEN   3392
#define XCD_BAR_WORDS 3456
#define XB_SPIN_CAP (1u << 18)

__device__ __forceinline__ unsigned xb_ld(unsigned* p)              { return __hip_atomic_load(p, __ATOMIC_RELAXED, __HIP_MEMORY_SCOPE_AGENT); }
__device__ __forceinline__ unsigned xb_add(unsigned* p, unsigned v) { return __hip_atomic_fetch_add(p, v, __ATOMIC_RELAXED, __HIP_MEMORY_SCOPE_AGENT); }
__device__ __forceinline__ unsigned xb_xcc_id() { return (unsigned)__builtin_amdgcn_s_getreg((3 << 11) | 20) & 0xFu; }
#define XB_SPIN(cond, bar) do { unsigned _sp = 0; while (cond) { __builtin_amdgcn_s_sleep(1); \
    if ((++_sp & 255u) == 0u) { if (xb_ld(&(bar)[XB_TMO])) break; if (_sp > XB_SPIN_CAP) { atomicAdd(&(bar)[XB_TMO], 1u); break; } } } } while (0)

struct XcdBarrier {
    unsigned* bar; unsigned x;
    volatile LAS unsigned* st;
};

__device__ __forceinline__ XcdBarrier xcd_barrier_post(unsigned* bar, volatile LAS unsigned* st) {
    XcdBarrier b; b.bar = bar; b.x = xb_xcc_id(); b.st = st;
    if (threadIdx.x == 0) { st[2] = xb_add(&bar[XB_XCNT(b.x)], 1u); st[3] = 1u; }
    return b;
}
__device__ __forceinline__ void xcd_barrier_complete(unsigned* bar, unsigned x, unsigned& nloc, unsigned& nx) {
    const unsigned G = gridDim.x * gridDim.y * gridDim.z;
    unsigned sum, cnt, mine, sp = 0u;
    for (;;) {
        sum = 0u; cnt = 0u; mine = 0u;
#pragma unroll
        for (unsigned j = 0; j < 16; ++j) { const unsigned c = xb_ld(&bar[XB_XCNT(j)]); sum += c; cnt += (c > 0u) ? 1u : 0u; mine = (j == x) ? c : mine; }
        if (sum == G) break;
        __builtin_amdgcn_s_sleep(1);
        if ((++sp & 255u) == 0u) { if (xb_ld(&bar[XB_TMO])) break; if (sp > XB_SPIN_CAP) { atomicAdd(&bar[XB_TMO], 1u); break; } }
    }
    nloc = mine > 0u ? mine : 1u; nx = cnt > 0u ? cnt : 1u;
}

__device__ __forceinline__ void xcd_barrier(const XcdBarrier& b) {
    asm volatile("s_waitcnt vmcnt(0)" ::: "memory");
    __syncthreads();
    if (threadIdx.x == 0) {
        unsigned* bar = b.bar;
        __builtin_amdgcn_s_waitcnt(0);
        unsigned nloc = b.st[0], nx = b.st[1];
        if (nloc == 0u) { xcd_barrier_complete(bar, b.x, nloc, nx); b.st[0] = nloc; b.st[1] = nx; }
        const unsigned old = xb_add(&bar[XB_XSUB(b.x)], 1u);
        const unsigned gen = old / nloc;
        if (old + 1u == (gen + 1u) * nloc) {
            __builtin_amdgcn_fence(__ATOMIC_RELEASE, "agent");
            asm volatile("s_waitcnt vmcnt(0)" ::: "memory");
            const unsigned og = xb_add(&bar[XB_TOP], 1u);
            const unsigned tg = og / nx;
            if (og + 1u == (tg + 1u) * nx) xb_add(&bar[XB_TOPGEN], 1u);
            else XB_SPIN(xb_ld(&bar[XB_TOPGEN]) == tg, bar);
            __builtin_amdgcn_fence(__ATOMIC_ACQUIRE, "agent");
            xb_add(&bar[XB_XGEN(b.x)], 1u);
            asm volatile("s_waitcnt vmcnt(0)" ::: "memory");
        } else {
            XB_SPIN(xb_ld(&bar[XB_XGEN(b.x)]) == gen, bar);
            __builtin_amdgcn_fence(__ATOMIC_ACQUIRE, "agent");
            asm volatile("s_waitcnt vmcnt(0)" ::: "memory");
        }
    }
    __syncthreads();
}

namespace pg8 {
template <class Fn> struct EpiFn {
    static constexpr bool PERM = true, AFTER_DRAIN = false;
    Fn f;
    __device__ __forceinline__ void operator()(const f32x4 (&acc)[2][2][4][2], const Unit& u, int wr, int wc, int fr, int fq) const {
        const int row0 = u.pm * BM + wr * 64 + fr, col0 = u.pn * BM + wc * 32 + 8 * fq;
#pragma unroll
        for (int ai = 0; ai < 2; ++ai)
#pragma unroll
            for (int m = 0; m < 4; ++m)
#pragma unroll
                for (int bj = 0; bj < 2; ++bj) f.e8(row0 + ai * HALF + m * 16, col0 + bj * HALF, acc[ai][bj][m][0], acc[ai][bj][m][1]);
    }
};
}

struct FnBf16 {
    bf16* O; int ld;
    __device__ __forceinline__ void e8(int row, int col, f32x4 a, f32x4 b) const {
        v4u w; w.x = pk2(a.x, a.y); w.y = pk2(a.z, a.w); w.z = pk2(b.x, b.y); w.w = pk2(b.z, b.w);
        *(v4u*)(O + (size_t)row * ld + col) = w;
    }
    __device__ __forceinline__ void e4(int row, int col, f32x4 a) const {
        v2u w; w.x = pk2(a.x, a.y); w.y = pk2(a.z, a.w);
        *(v2u*)(O + (size_t)row * ld + col) = w;
    }
};
struct FnResid {
    float* XS; const float* baseP; const float* baseS;
    __device__ __forceinline__ const float* brow(int row) const { return row < MP ? baseP + (size_t)row * DM : baseS + (size_t)(row - MP) * DM; }
    __device__ __forceinline__ void e8(int row, int col, f32x4 a, f32x4 b) const {
        const float* br = brow(row) + col; float* o = XS + (size_t)row * DM + col;
        const f32x4 x0 = *(const f32x4*)br, x1 = *(const f32x4*)(br + 4);
        *(f32x4*)o = x0 + a; *(f32x4*)(o + 4) = x1 + b;
    }
    __device__ __forceinline__ void e4(int row, int col, f32x4 a) const {
        const float* br = brow(row) + col; float* o = XS + (size_t)row * DM + col;
        *(f32x4*)o = *(const f32x4*)br + a;
    }
};
struct FnF32 {
    float* O; int ld;
    __device__ __forceinline__ void e8(int row, int col, f32x4 a, f32x4 b) const { float* o = O + (size_t)row * ld + col; *(f32x4*)o = a; *(f32x4*)(o + 4) = b; }
    __device__ __forceinline__ void e4(int row, int col, f32x4 a) const { *(f32x4*)(O + (size_t)row * ld + col) = a; }
};
struct FnKvq {
    bf16* O; const float* ssq;
    __device__ __forceinline__ float rstd(int row) const { const f32x4 s0 = *(const f32x4*)(ssq + (size_t)row * 8), s1 = *(const f32x4*)(ssq + (size_t)row * 8 + 4);
        return frsq((((s0.x + s0.y) + (s0.z + s0.w)) + ((s1.x + s1.y) + (s1.z + s1.w))) * (1.f / DM) + EPS); }
    __device__ __forceinline__ void e8(int row, int col, f32x4 a, f32x4 b) const {
        if (col < NKVQ_REAL) { const float rs = rstd(row); a = a * rs; b = b * rs; *(v4u*)(O + (size_t)row * NKVQ + col) = (v4u){pk2(a.x, a.y), pk2(a.z, a.w), pk2(b.x, b.y), pk2(b.z, b.w)}; }
    }
    __device__ __forceinline__ void e4(int row, int col, f32x4 a) const {
        if (col < NKVQ_REAL) { a = a * rstd(row); *(v2u*)(O + (size_t)row * NKVQ + col) = (v2u){pk2(a.x, a.y), pk2(a.z, a.w)}; }
    }
};

template <class Fn>
__device__ __forceinline__ void skinny_gemm(Frame& F, const bf16* A, const bf16* Bt, int N, int row_base, const Fn& fn) {
    const int fr = F.lane & 15, fq = F.lane >> 4;
    const int nun = N / 16;
    for (int u = F.bid; u < nun; u += F.G) {
        const bf16* ap = Bt + (size_t)(u * 16 + fr) * DM + fq * 8;
        const bf16* bp = A + (size_t)(F.wave * 16 + fr) * DM + fq * 8;
        f32x4 acc = {0.f, 0.f, 0.f, 0.f};
#pragma unroll 8
        for (int ks = 0; ks < 32; ++ks) acc = MFMA16(ld8(ap + ks * 32), ld8(bp + ks * 32), acc);
        fn.e4(row_base + F.wave * 16 + fr, u * 16 + 4 * fq, acc);
    }
}

template <class Fn>
__device__ __forceinline__ void gemm_all(Frame& F, const bf16* A, const bf16* Bt, int N, const Fn& fn) {
    pg8::Gemm g{A, Bt, MP, N, DM}; pg8::StaticOrder S; S.init(MP, N, F.G, F.bid);
    pg8::EpiFn<Fn> E{fn};
    pg8::gemm_phase<pg8::EpiFn<Fn>, pg8::StaticOrder, true, true>(F.lds, g, S, E);
    skinny_gemm(F, A + (size_t)MP * DM, Bt, N, MP, fn);
}

__device__ __forceinline__ void p0_transpose_item(const float* W, int N, bf16* WT, int row_off, const float* gain, LAS float* scr, int item, int lane) {
    const int nblk = (N + 31) / 32, kb = item / nblk, nb = item % nblk, k0 = 64 * kb, n0 = 32 * nb;
#pragma unroll 8
    for (int i = 0; i < 32; ++i) { const int kk = 2 * i + (lane >> 5); const int n = n0 + (lane & 31);
        float v = 0.f; if (n < N) { v = W[(size_t)(k0 + kk) * N + n]; if (gain) v *= gain[k0 + kk]; }
        scr[kk * 33 + (lane & 31)] = v; }
    LDS_WAIT(); asm volatile("" ::: "memory");
    const int c = lane & 7;
#pragma unroll
    for (int j = 0; j < 4; ++j) { const int n = (lane >> 3) + 8 * j; const LAS float* s = scr + (8 * c) * 33 + n;
        v4u o; o.x = pk2(s[0 * 33], s[1 * 33]); o.y = pk2(s[2 * 33], s[3 * 33]); o.z = pk2(s[4 * 33], s[5 * 33]); o.w = pk2(s[6 * 33], s[7 * 33]);
        if (n0 + n < N) *(v4u*)(WT + (size_t)(row_off + n0 + n) * DM + k0 + 8 * c) = o; }
    LDS_WAIT(); asm volatile("" ::: "memory");
}
__device__ __forceinline__ void rms_row_to_bf16(const float* xrow, bf16* orow, int lane) {
    const f32x4* xr = (const f32x4*)xrow + lane;
    f32x4 v[4]; float s = 0.f;
#pragma unroll
    for (int j = 0; j < 4; ++j) { v[j] = xr[64 * j]; s += (v[j].x * v[j].x + v[j].y * v[j].y) + (v[j].z * v[j].z + v[j].w * v[j].w); }
    const float rstd = frsq(wave_sum(s) * (1.f / DM) + EPS);
    v2u* o8 = (v2u*)orow + lane;
#pragma unroll
    for (int j = 0; j < 4; ++j) { v2u w; w.x = pk2(v[j].x * rstd, v[j].y * rstd); w.y = pk2(v[j].z * rstd, v[j].w * rstd); o8[64 * j] = w; }
}
__device__ __forceinline__ const float* xin_row(Frame& F, int row) { return row < MP ? FIN(0) + (size_t)row * DM : FIN(1) + (size_t)(row - MP) * DM; }

__device__ __forceinline__ void peer_tables_to_fp8(Frame& F, size_t thr, size_t nthr, size_t lo = 0, size_t hi = (size_t)2 * NEXP * DM / 8) {
    const size_t gt = thr, NGT = nthr;
        for (int t = 0; t < 2; ++t) { const f32x4* src = (const f32x4*)FIN(27 + t); v2u* dst = (v2u*)WSP(unsigned char, t == 0 ? WS_PU : WS_PV); const float* pln = FIN(24);
            for (size_t i0 = lo + gt; i0 < hi; i0 += (size_t)4 * NGT) {
                f32x4 a[4], b[4];
#pragma unroll
                for (int u = 0; u < 4; ++u) { const size_t i = i0 + (size_t)u * NGT; if (i < hi) { a[u] = src[2 * i]; b[u] = src[2 * i + 1]; } }
#pragma unroll
                for (int u = 0; u < 4; ++u) { const size_t i = i0 + (size_t)u * NGT; if (i < hi) {
                    if (t == 0) { const float* gp = pln + ((i >> 21) << 10) + ((i & 127) << 3); a[u] = a[u] * *(const f32x4*)gp * 32.f; b[u] = b[u] * *(const f32x4*)(gp + 4) * 32.f; }
                    else { a[u] = a[u] * 16.f; b[u] = b[u] * 16.f; }
                    int w0 = __builtin_amdgcn_cvt_pk_fp8_f32(a[u].x, a[u].y, 0, false); w0 = __builtin_amdgcn_cvt_pk_fp8_f32(a[u].z, a[u].w, w0, true);
                    int w1 = __builtin_amdgcn_cvt_pk_fp8_f32(b[u].x, b[u].y, 0, false); w1 = __builtin_amdgcn_cvt_pk_fp8_f32(b[u].z, b[u].w, w1, true);
                    dst[((((i >> 21) * 8 + ((i & 127) >> 4)) * (size_t)NEXP + ((i >> 7) & (NEXP - 1))) << 4) + (i & 15)] = (v2u){(unsigned)w0, (unsigned)w1}; } } } }
}

constexpr int FD_BUF = 16384;
__device__ __forceinline__ void fs_direct_task(Frame& F, int task) {
    int lane_ = F.lane; asm volatile("" : "+v"(lane_));
    const int lane = lane_, w = F.wave, fr = lane & 15, fq = lane >> 4, kv = w >> 2, g = w & 3, bs = task >> 4, c0 = (task & 15) * 32;
    LAS unsigned char* L = F.lds; asm volatile("" : "+v"(L));
    const float* cache = FIN(2); const int* pt = (const int*)FIN(6) + bs * NPAGES;
    const float* base[2];
#pragma unroll
    for (int nt = 0; nt < 2; ++nt) { const int t0 = 16 * (c0 + 16 * nt + fr); base[nt] = cache + ((size_t)pt[t0 >> 7] * PAGE + (t0 & 127)) * 1024 + kv * 256 + g * 64 + 8 * fq; }
    const bf16* wsrc[2]; int wdst[2];
#pragma unroll
    for (int q = 0; q < 2; ++q) { const int item = F.tid + 512 * q, kvw = item >> 9, n = (item >> 2) & 127, kq = item & 3;
        wsrc[q] = WSP(bf16, WS_W1BD) + (size_t)(kvw * 128 + n) * 2048 + kvw * 1024 + 8 * kq; wdst[q] = ((kvw * 8 + (n >> 4)) * 64 + kq * 16 + (n & 15)) * 16; }
    f32x4 acc[2][8];
#pragma unroll
    for (int nt = 0; nt < 2; ++nt)
#pragma unroll
        for (int mt = 0; mt < 8; ++mt) acc[nt][mt] = (f32x4){0.f, 0.f, 0.f, 0.f};
    f32x4 S0[2][4], S1[2][4]; v4u wr[2];
#define FD_DATA(S, r) do { const int r_ = (r) < 16 ? (r) : 15; _Pragma("unroll") for (int nt_ = 0; nt_ < 2; ++nt_) { const float* p_ = base[nt_] + r_ * 1024; \
        S[nt_][0] = *(const f32x4*)p_; S[nt_][1] = *(const f32x4*)(p_ + 4); S[nt_][2] = *(const f32x4*)(p_ + 32); S[nt_][3] = *(const f32x4*)(p_ + 36); } } while (0)
#define FD_WLOAD(ks) do { const int ks_ = (ks) < 32 ? (ks) : 31; wr[0] = *(const v4u*)(wsrc[0] + 32 * ks_); wr[1] = *(const v4u*)(wsrc[1] + 32 * ks_); } while (0)
#define FD_WSTORE(buf) do { *(LAS v4u*)(L + (buf) * FD_BUF + wdst[0]) = wr[0]; *(LAS v4u*)(L + (buf) * FD_BUF + wdst[1]) = wr[1]; } while (0)
#define FD_KSTEP(bq, ks, buf) do { \
        _Pragma("unroll") for (int mt_ = 0; mt_ < 8; ++mt_) { const bf16x8 a_ = *(const LAS bf16x8*)(L + (buf) * FD_BUF + ((kv * 8 + mt_) * 64 + lane) * 16); \
            acc[0][mt_] = MFMA16(a_, bq[0], acc[0][mt_]); acc[1][mt_] = MFMA16(a_, bq[1], acc[1][mt_]); } \
        FD_WSTORE((buf) ^ 1); FD_WLOAD((ks) + 2); \
        __syncthreads(); } while (0)
#define FD_ROW(S, r) do { bf16x8 b0_[2], b1_[2]; _Pragma("unroll") for (int nt_ = 0; nt_ < 2; ++nt_) { b0_[nt_] = cvt8(S[nt_][0], S[nt_][1]); b1_[nt_] = cvt8(S[nt_][2], S[nt_][3]); } \
        FD_DATA(S, (r) + 2); \
        FD_KSTEP(b0_, 2 * (r), 0); FD_KSTEP(b1_, 2 * (r) + 1, 1); } while (0)
    FD_WLOAD(0); FD_WSTORE(0); FD_WLOAD(1); FD_DATA(S0, 0); FD_DATA(S1, 1);
    __syncthreads();
#pragma unroll 1
    for (int r = 0; r < 16; r += 2) { FD_ROW(S0, r); FD_ROW(S1, r + 1); }
#undef FD_KSTEP
#undef FD_ROW
#undef FD_DATA
#undef FD_WLOAD
#undef FD_WSTORE
    bf16* fs = WSP(bf16, WS_FS) + ((size_t)(bs * 4 + g) * 512 + c0 + fr) * 256 + kv * 128 + 4 * fq;
#pragma unroll
    for (int nt = 0; nt < 2; ++nt)
#pragma unroll
        for (int mt = 0; mt < 8; ++mt) *(v2u*)(fs + (size_t)nt * 16 * 256 + 16 * mt) = (v2u){pk2(acc[nt][mt][0], acc[nt][mt][1]), pk2(acc[nt][mt][2], acc[nt][mt][3])};
    __syncthreads();
}

__device__ __forceinline__ void p0_prologue(Frame& F) {
    LAS float* scr = (LAS float*)(F.lds + F.wave * 16384);
    const int gw = F.bid * 8 + F.wave, NGW = F.G * 8;
    const int gt = F.bid * 512 + F.tid, NGT = F.G * 512;
    {
        constexpr int I_IN = 128 * 16, I_OA = 32 * 16, I_KV = 48 * 16, I_QG = 34 * 16, I_OB = 32 * 16, I_PQ = 64 * 16;
        constexpr int NITEMS = I_IN + I_OA + I_KV + I_QG + I_OB + 2 * I_PQ;
        for (int it = gw; it < NITEMS; it += NGW) {
            int r = it;
            if (r < I_IN) {
                const int kb = r / 128, nb = r % 128, k0 = 64 * kb, n0 = 32 * nb; const float* W = FIN(8); const float* gain = FIN(7);
#pragma unroll 8
                for (int i = 0; i < 32; ++i) { const int kk = 2 * i + (F.lane >> 5); scr[kk * 33 + (F.lane & 31)] = W[(size_t)(k0 + kk) * GPROJ + n0 + (F.lane & 31)] * gain[k0 + kk]; }
                LDS_WAIT(); asm volatile("" ::: "memory");
                const int c = F.lane & 7;
#pragma unroll
                for (int j = 0; j < 4; ++j) { const int n = (F.lane >> 3) + 8 * j; const LAS float* s = scr + (8 * c) * 33 + n;
                    v4u o; o.x = pk2(s[0 * 33], s[1 * 33]); o.y = pk2(s[2 * 33], s[3 * 33]); o.z = pk2(s[4 * 33], s[5 * 33]); o.w = pk2(s[6 * 33], s[7 * 33]);
                    *(v4u*)(WSP(bf16, WS_WIN_T) + (size_t)(n0 + n) * DM + k0 + 8 * c) = o; }
                LDS_WAIT(); asm volatile("" ::: "memory");
                continue; }
            r -= I_IN;
            if (r < I_OA) { p0_transpose_item(FIN(13), 1024, WSP(bf16, WS_WOA_T), 0, nullptr, scr, r, F.lane); continue; } r -= I_OA;
            if (r < I_KV) { p0_transpose_item(FIN(15), NKV, WSP(bf16, WS_WKVQ_T), 0, FIN(14), scr, r, F.lane); continue; } r -= I_KV;
            if (r < I_QG) { p0_transpose_item(FIN(21), NQG, WSP(bf16, WS_WKVQ_T), NKV, FIN(20), scr, r, F.lane); continue; } r -= I_QG;
            if (r < I_OB) { p0_transpose_item(FIN(23), 1024, WSP(bf16, WS_WOB_T), 0, nullptr, scr, r, F.lane); continue; } r -= I_OB;
            if (r < I_PQ) { p0_transpose_item(FIN(25), 2048, WSP(bf16, WS_WPQ_T), 0, FIN(24), scr, r, F.lane); continue; } r -= I_PQ;
            p0_transpose_item(FIN(25) + (size_t)1024 * 2048, 2048, WSP(bf16, WS_WPQ_T) + (size_t)2048 * 1024, 0, FIN(24) + 1024, scr, r, F.lane);
        }
        for (int i = gt; i < (NKVQ - NKVQ_REAL) * DM / 8; i += NGT) ((v4u*)(WSP(bf16, WS_WKVQ_T) + (size_t)NKVQ_REAL * DM))[i] = (v4u){0u, 0u, 0u, 0u};
        for (int i = gt; i < 16 * 1024; i += NGT) { const int j = i >> 10, k = i & 1023; WSP(float, WS_WAB)[i] = FIN(7)[k] * FIN(8)[(size_t)k * GPROJ + 4096 + j]; }
    }
    for (int m = gw; m < MTOK; m += NGW) rms_row_to_bf16(xin_row(F, m), WSP(bf16, WS_XNA) + (size_t)m * DM, F.lane);
    {
        if (F.G != 256) peer_tables_to_fp8(F, (size_t)gt, (size_t)NGT);
        const f32x4* sk = (const f32x4*)FIN(26); v4u* dk = (v4u*)WSP(bf16, WS_SUBK);
        for (int i = gt; i < 2 * 8 * 2 * 128 * 128 / 8; i += NGT) { const f32x4 a = sk[2 * i], b = sk[2 * i + 1]; v4u w; w.x = pk2(a.x, a.y); w.y = pk2(a.z, a.w); w.z = pk2(b.x, b.y); w.w = pk2(b.z, b.w); dk[i] = w; }
    }
    for (int i = gt; i < 2 * 64 * 2048; i += NGT) { const int kv = i >> 17, hh = (i >> 11) & 63, k = i & 2047;
        WSP(bf16, WS_W1T)[i] = (bf16)f2bf(FIN(17)[((size_t)kv * 2048 + k) * 64 + hh]); }
    for (int i = gt; i < 2 * 4 * 2 * 64 * 8; i += NGT) { const int e = i & 7, ln = (i >> 3) & 63, sx = (i >> 9) & 1, dt = (i >> 10) & 3, kv = i >> 12, fr_ = ln & 15, fq_ = ln >> 4;
        WSP(bf16, WS_W2F)[i] = (bf16)f2bf(FIN(19)[((size_t)kv * 64 + 16 * (2 * sx + (e >> 2)) + 4 * fq_ + (e & 3)) * 64 + 16 * dt + fr_]); }
    for (int it = gw; it < 128; it += NGW) { const int kv = it >> 6, h = it & 63; float s = 0.f;
        for (int k = F.lane; k < 2048; k += 64) s += FIN(18)[(size_t)kv * 2048 + k] * FIN(17)[((size_t)kv * 2048 + k) * 64 + h];
        s = wave_sum(s); if (F.lane == 0) WSP(float, WS_PETERM)[it] = s; }
    {
        bf16* wbd = WSP(bf16, WS_W1BD);
        for (int i = gt; i < 256 * 2048; i += NGT) { const int n = i >> 11, col = i & 2047, kv = n >> 7, sec = (n >> 6) & 1, hh = n & 63;
            float v = 0.f; if ((col >> 10) == kv) { const int k = col & 1023, r = (k >> 6) + 16 * sec, d = k & 63; v = FIN(17)[(((size_t)kv * 32 + r) * 64 + d) * 64 + hh]; }
            wbd[i] = (bf16)f2bf(v); }
    }
    {
        const f32x4* src = (const f32x4*)FIN(3); f32x4* dst = (f32x4*)(F.out + O_WINS);
        const int per_b = 508 * 512 / 4;
        for (int i = gt; i < SB * per_b; i += NGT) { const int b = i / per_b, r = i % per_b; dst[(size_t)b * (512 * 512 / 4) + r] = src[(size_t)b * (512 * 512 / 4) + 4 * 512 / 4 + r]; }
    }
    for (int i = gt; i < SB * NG * 544 * 64; i += NGT) {
        const int d = i & 63, r = (i >> 6) % 544, bg = (i >> 6) / 544, g = bg & 3, b = bg >> 2;
        if (r < 512) { const float* cw = FIN(3) + (((size_t)b * 512 + r) * 2) * 256 + g * 64 + d;
            WSP(bf16, WS_SKWIN)[i] = (bf16)f2bf(cw[0]);
            WSP(bf16, WS_SVWINT)[((size_t)bg * 64 + d) * 544 + r] = (bf16)f2bf(cw[256]); }
        else if (r >= 516) { WSP(bf16, WS_SKWIN)[i] = 0; WSP(bf16, WS_SVWINT)[((size_t)bg * 64 + d) * 544 + r] = 0; }
    }
}

constexpr int P2_QS = 0, P2_KS = 17408, P2_KBGT = 34816, P2_VBT = 53248, P2_AM = 71680, P2_TB = 89088, P2_G = 98304, P2_TF = 99328, P2_XF = 116736;
constexpr int QS_LD = 136, KT_LD = 72, AM_LD = 68, TB_LD = 72;

__device__ __forceinline__ float softplus_f(float x) { return fmaxf(x, 0.f) + __logf(1.f + __expf(-fabsf(x))); }

__device__ __forceinline__ void p2_chunk(Frame& F, int unit) {
    const int c = unit & 127, h = (unit >> 7) & 7, b = unit >> 10;
    const int t0 = c * CHUNK, lane = F.lane, w = F.wave, fr = lane & 15, fq = lane >> 4;
    LAS unsigned char* L = F.lds; asm volatile("" : "+v"(L));
    LAS bf16* qs = (LAS bf16*)(L + P2_QS); LAS bf16* ks = (LAS bf16*)(L + P2_KS);
    LAS bf16* kbgT = (LAS bf16*)(L + P2_KBGT); LAS bf16* vbT = (LAS bf16*)(L + P2_VBT);
    LAS float* Am = (LAS float*)(L + P2_AM); LAS bf16* Tb = (LAS bf16*)(L + P2_TB);
    LAS float* Gs = (LAS float*)(L + P2_G);
    const bf16* PROJ = WSP(bf16, WS_PROJ); const bf16* XNA = WSP(bf16, WS_XNA); const float* WAB = WSP(float, WS_WAB);
    const size_t rowb = (size_t)b * PT;
    float beta_r[8];
    {
        f32x4 wa[4], wb[4];
        const float* pa = WAB + (size_t)h * DM + 8 * lane; const float* pb = WAB + (size_t)(8 + h) * DM + 8 * lane;
        wa[0] = *(const f32x4*)pa; wa[1] = *(const f32x4*)(pa + 4); wa[2] = *(const f32x4*)(pa + 512); wa[3] = *(const f32x4*)(pa + 516);
        wb[0] = *(const f32x4*)pb; wb[1] = *(const f32x4*)(pb + 4); wb[2] = *(const f32x4*)(pb + 512); wb[3] = *(const f32x4*)(pb + 516);
        const float Aneg = -expf(FIN(10)[h]), dtb = FIN(11)[h];
#pragma unroll
        for (int tk = 0; tk < 8; ++tk) {
            const int tok = 8 * w + tk; const bf16* xr = XNA + (rowb + t0 + tok) * DM + 8 * lane;
            const v4u x0 = *(const v4u*)xr, x1 = *(const v4u*)(xr + 512);
            float sa = 0.f, sb = 0.f;
#define ACC2(xw, wv0, wv1, i0) { const float lo = bflo(xw), hi = bfhi(xw); sa += lo * wv0[i0] + hi * wv0[i0 + 1]; sb += lo * wv1[i0] + hi * wv1[i0 + 1]; }
            ACC2(x0.x, wa[0], wb[0], 0) ACC2(x0.y, wa[0], wb[0], 2) ACC2(x0.z, wa[1], wb[1], 0) ACC2(x0.w, wa[1], wb[1], 2)
            ACC2(x1.x, wa[2], wb[2], 0) ACC2(x1.y, wa[2], wb[2], 2) ACC2(x1.z, wa[3], wb[3], 0) ACC2(x1.w, wa[3], wb[3], 2)
#undef ACC2
            sa = wave_sum(sa); sb = wave_sum(sb);
            const float g = Aneg * softplus_f(sa + dtb), be = sigmoid_f(sb);
            beta_r[tk] = be;
            if (lane == 0) { Gs[tok] = g; Gs[64 + tok] = be; }
        }
    }
#pragma unroll
    for (int p = 0; p < 3; ++p) {
        const int col0 = p * 1024 + h * 128 + 2 * lane;
        float cw0[4], cw1[4];
#pragma unroll
        for (int i = 0; i < 4; ++i) { const f32x2 cv = *(const f32x2*)(FIN(9) + (size_t)i * GCONV + col0); cw0[i] = cv.x; cw1[i] = cv.y; }
        unsigned xw[11];
#pragma unroll
        for (int rr = 0; rr < 11; ++rr) { const int t = t0 + 8 * w - 3 + rr; xw[rr] = (t >= 0) ? *(const unsigned*)(PROJ + (rowb + t) * 4096 + col0) : 0u; }
        if (c == 127 && w == 7) {
#pragma unroll
            for (int r = 0; r < 3; ++r) { float* o = F.out + O_CONVP + ((size_t)b * 3 + r) * GCONV + col0; o[0] = bflo(xw[8 + r]); o[1] = bfhi(xw[8 + r]); }
        }
#pragma unroll
        for (int tk = 0; tk < 8; ++tk) {
            const int tok = 8 * w + tk;
            float y0 = 0.f, y1 = 0.f;
#pragma unroll
            for (int i = 0; i < 4; ++i) { y0 += cw0[i] * bflo(xw[tk + i]); y1 += cw1[i] * bfhi(xw[tk + i]); }
            y0 = silu_f(y0); y1 = silu_f(y1);
            if (p < 2) {
                const float ss = wave_sum(y0 * y0 + y1 * y1);
                const float rs = (frsq(ss + EPS)) * (p == 0 ? 0.08838834764831845f : 1.f);
                *(LAS unsigned*)((p == 0 ? qs : ks) + tok * QS_LD + 2 * lane) = pk2(y0 * rs, y1 * rs);
            } else {
                vbT[(2 * lane) * KT_LD + tok] = (bf16)f2bf(y0 * beta_r[tk]); vbT[(2 * lane + 1) * KT_LD + tok] = (bf16)f2bf(y1 * beta_r[tk]);
            }
        }
    }
    __syncthreads();
    if (w == 0) { float g = Gs[lane];
#pragma unroll
        for (int o = 1; o < 64; o <<= 1) { const float up = __shfl_up(g, o); if (lane >= o) g += up; }
        Gs[128 + lane] = g; }
    __syncthreads();
    const float glast = Gs[128 + 63];
    const size_t chunk = (size_t)unit;
    if (w < 4) {
        const int mt = w;
        bf16x8 a[4];
#pragma unroll
        for (int kk = 0; kk < 4; ++kk) a[kk] = ld8l(ks + (16 * mt + fr) * QS_LD + 32 * kk + 8 * fq);
#pragma unroll
        for (int nt = 0; nt < 4; ++nt) {
            f32x4 acc = {0.f, 0.f, 0.f, 0.f};
            if (nt <= mt) {
#pragma unroll
                for (int kk = 0; kk < 4; ++kk) acc = MFMA16(a[kk], ld8l(ks + (16 * nt + fr) * QS_LD + 32 * kk + 8 * fq), acc);
            }
            const int j = 16 * nt + fr; const float gj = Gs[128 + j];
#pragma unroll
            for (int r = 0; r < 4; ++r) { const int i = 16 * mt + 4 * fq + r;
                Am[i * AM_LD + j] = (i > j) ? Gs[64 + i] * acc[r] * __expf(Gs[128 + i] - gj) : 0.f; }
        }
    } else {
        const int nt = w - 4;
        bf16x8 bq[4];
#pragma unroll
        for (int kk = 0; kk < 4; ++kk) bq[kk] = ld8l(qs + (16 * nt + fr) * QS_LD + 32 * kk + 8 * fq);
        const int i = 16 * nt + fr; const float gi = Gs[128 + i];
        bf16* gqk = WSP(bf16, WS_GQK) + chunk * 4096;
#pragma unroll
        for (int mt = 0; mt < 4; ++mt) {
            f32x4 acc = {0.f, 0.f, 0.f, 0.f};
            if (mt <= nt) {
#pragma unroll
                for (int kk = 0; kk < 4; ++kk) acc = MFMA16(ld8l(ks + (16 * mt + fr) * QS_LD + 32 * kk + 8 * fq), bq[kk], acc);
            }
            float v[4];
#pragma unroll
            for (int r = 0; r < 4; ++r) { const int j = 16 * mt + 4 * fq + r; v[r] = (i >= j) ? acc[r] * __expf(gi - Gs[128 + j]) : 0.f; }
            v2u o; o.x = pk2(v[0], v[1]); o.y = pk2(v[2], v[3]);
            *(v2u*)(gqk + (((nt * 2 + (mt >> 1)) * 64 + (2 * (mt & 1) + (fq >> 1)) * 16 + fr) * 8 + 4 * (fq & 1))) = o;
        }
    }
    {
        const int tok = F.tid >> 3, d0 = (F.tid & 7) * 16; const float e = __expf(Gs[128 + tok]);
        bf16* gq = WSP(bf16, WS_GQ) + chunk * 8192;
#pragma unroll
        for (int hh = 0; hh < 2; ++hh) { const v4u q = *(const LAS v4u*)(qs + tok * QS_LD + d0 + 8 * hh); v4u o;
            o.x = pk2(bflo(q.x) * e, bfhi(q.x) * e); o.y = pk2(bflo(q.y) * e, bfhi(q.y) * e); o.z = pk2(bflo(q.z) * e, bfhi(q.z) * e); o.w = pk2(bflo(q.w) * e, bfhi(q.w) * e);
            *(v4u*)(gq + ((((tok >> 4) * 4 + ((F.tid & 7) >> 1)) * 64 + (2 * (F.tid & 1) + hh) * 16 + (tok & 15)) * 8)) = o; }
    }
    {
        const int dk = F.tid & 127, tg = F.tid >> 7;
        unsigned o1[8], o2[8];
#pragma unroll
        for (int i = 0; i < 8; ++i) {
            const int ta = 16 * tg + 2 * i, tb2 = ta + 1;
            const float ka = bf2f(ks[ta * QS_LD + dk]), kb = bf2f(ks[tb2 * QS_LD + dk]);
            const float ga = Gs[128 + ta], gb = Gs[128 + tb2];
            o1[i] = pk2(ka * Gs[64 + ta] * __expf(ga), kb * Gs[64 + tb2] * __expf(gb));
            o2[i] = pk2(ka * __expf(glast - ga), kb * __expf(glast - gb));
        }
        LAS v4u* d1 = (LAS v4u*)(kbgT + dk * KT_LD + 16 * tg); d1[0] = (v4u){o1[0], o1[1], o1[2], o1[3]}; d1[1] = (v4u){o1[4], o1[5], o1[6], o1[7]};
        bf16* d2 = WSP(bf16, WS_GKT) + chunk * 8192 + ((((dk >> 4) * 2 + (tg >> 1)) * 64 + (2 * (tg & 1)) * 16 + (dk & 15)) * 8);
        *(v4u*)d2 = (v4u){o2[0], o2[1], o2[2], o2[3]}; *(v4u*)(d2 + 16 * 8) = (v4u){o2[4], o2[5], o2[6], o2[7]};
    }
    if (F.tid == 0) WSP(float, WS_GDEC)[chunk] = __expf(glast);
    __syncthreads();
    LAS float* Tf = (LAS float*)(L + P2_TF); LAS float* Xf = (LAS float*)(L + P2_XF);
    if (w == 0) {
        const int blk = lane >> 5, cc = lane & 31; const LAS float* Ab = Am + (32 * blk) * AM_LD + 32 * blk;
        float t[32];
#pragma unroll
        for (int i = 0; i < 32; ++i) {
            float acc0 = (i == cc) ? 1.f : 0.f, acc1 = 0.f, acc2 = 0.f, acc3 = 0.f;
#pragma unroll
            for (int j4 = 0; j4 < (i + 3) / 4; ++j4) {
                const f32x4 a = *(const LAS f32x4*)(Ab + i * AM_LD + 4 * j4);
                if (4 * j4 + 0 < i) acc0 = __builtin_fmaf(-a.x, t[4 * j4 + 0], acc0);
                if (4 * j4 + 1 < i) acc1 = __builtin_fmaf(-a.y, t[4 * j4 + 1], acc1);
                if (4 * j4 + 2 < i) acc2 = __builtin_fmaf(-a.z, t[4 * j4 + 2], acc2);
                if (4 * j4 + 3 < i) acc3 = __builtin_fmaf(-a.w, t[4 * j4 + 3], acc3);
            }
            t[i] = (acc0 + acc1) + (acc2 + acc3);
            asm volatile("" : "+v"(t[i]));
            __builtin_amdgcn_sched_barrier(0);
        }
#pragma unroll
        for (int i = 0; i < 32; ++i) { Tf[(32 * blk + i) * AM_LD + 32 * blk + cc] = t[i]; if (blk == 0) Tf[i * AM_LD + 32 + cc] = 0.f; }
    }
    __syncthreads();
    {
        const int i = F.tid >> 4, c0 = (F.tid & 15) * 2; float x0 = 0.f, x1 = 0.f;
#pragma unroll 8
        for (int k = 0; k < 32; ++k) { const float a = Am[(32 + i) * AM_LD + k]; x0 = __builtin_fmaf(a, Tf[k * AM_LD + c0], x0); x1 = __builtin_fmaf(a, Tf[k * AM_LD + c0 + 1], x1); }
        Xf[i * 34 + c0] = x0; Xf[i * 34 + c0 + 1] = x1;
    }
    __syncthreads();
    {
        const int i = F.tid >> 4, c0 = (F.tid & 15) * 2; float x0 = 0.f, x1 = 0.f;
#pragma unroll 8
        for (int k = 0; k < 32; ++k) { const float a = Tf[(32 + i) * AM_LD + 32 + k]; x0 = __builtin_fmaf(a, Xf[k * 34 + c0], x0); x1 = __builtin_fmaf(a, Xf[k * 34 + c0 + 1], x1); }
        Tf[(32 + i) * AM_LD + c0] = -x0; Tf[(32 + i) * AM_LD + c0 + 1] = -x1;
    }
    __syncthreads();
    {
        const int i = F.tid >> 3, c0 = (F.tid & 7) * 8; const f32x4 a = *(const LAS f32x4*)(Tf + i * AM_LD + c0), b2 = *(const LAS f32x4*)(Tf + i * AM_LD + c0 + 4);
        *(LAS v4u*)(Tb + i * TB_LD + c0) = (v4u){pk2(a.x, a.y), pk2(a.z, a.w), pk2(b2.x, b2.y), pk2(b2.z, b2.w)};
    }
    __syncthreads();
    {
        bf16x8 tb[4][2];
#pragma unroll
        for (int x = 0; x < 4; ++x)
#pragma unroll
            for (int s = 0; s < 2; ++s) tb[x][s] = ld8l(Tb + (16 * x + fr) * TB_LD + 32 * s + 8 * fq);
        const bf16x8 bv0 = ld8l(vbT + (16 * w + fr) * KT_LD + 8 * fq), bv1 = ld8l(vbT + (16 * w + fr) * KT_LD + 32 + 8 * fq);
        bf16* gu = WSP(bf16, WS_GU) + chunk * 8192 + ((size_t)((w >> 1) * 4 * 64 + lane) * 2 + (w & 1)) * 4;
#pragma unroll
        for (int mt = 0; mt < 4; ++mt) { f32x4 acc = {0.f, 0.f, 0.f, 0.f}; acc = MFMA16(tb[mt][0], bv0, acc); acc = MFMA16(tb[mt][1], bv1, acc); *(v2u*)(gu + mt * 64 * 8) = (v2u){pk2(acc[0], acc[1]), pk2(acc[2], acc[3])}; }
        const bf16x8 ak0 = ld8l(kbgT + (16 * w + fr) * KT_LD + 8 * fq), ak1 = ld8l(kbgT + (16 * w + fr) * KT_LD + 32 + 8 * fq);
        bf16* gw = WSP(bf16, WS_GW) + chunk * 8192;
#pragma unroll
        for (int nt = 0; nt < 4; ++nt) { f32x4 acc = {0.f, 0.f, 0.f, 0.f}; acc = MFMA16(ak0, tb[nt][0], acc); acc = MFMA16(ak1, tb[nt][1], acc);
            v2u o; o.x = pk2(acc[0], acc[1]); o.y = pk2(acc[2], acc[3]);
            *(v2u*)(gw + (((nt * 4 + (w >> 1)) * 64 + (2 * (w & 1) + (fq >> 1)) * 16 + fr) * 8 + 4 * (fq & 1))) = o; }
    }
    __syncthreads();
}

constexpr int S2_Y = 0;
constexpr int S2_AB = 6144;
constexpr int S2_DOT = 6400;
constexpr int S2_U = 6656;
constexpr int S2_W = 8704;
constexpr int S2_VN = 10752;
__device__ __forceinline__ void p2_sample(Frame& F, int unit) {
    const int h = unit & 7, bs = unit >> 3, tid = F.tid, lane = F.lane, w = F.wave;
    LAS unsigned char* L = F.lds; asm volatile("" : "+v"(L));
    LAS float* Y = (LAS float*)(L + S2_Y); LAS float* AB = (LAS float*)(L + S2_AB); LAS float* DOT = (LAS float*)(L + S2_DOT);
    LAS float* U = (LAS float*)(L + S2_U); LAS float* W = (LAS float*)(L + S2_W); LAS float* VN = (LAS float*)(L + S2_VN);
    const bf16* PROJ = WSP(bf16, WS_PROJ); const bf16* XNA = WSP(bf16, WS_XNA); const float* WAB = WSP(float, WS_WAB);
    const size_t row0 = (size_t)MP + bs * 4;
    if (tid < 384) {
        const int part = tid >> 7, cc = tid & 127, col = part * 1024 + h * 128 + cc;
        float buf[7];
#pragma unroll
        for (int r = 0; r < 3; ++r) buf[r] = FIN(5)[((size_t)bs * 3 + r) * GCONV + col];
#pragma unroll
        for (int i = 0; i < 4; ++i) buf[3 + i] = bf2f(PROJ[(row0 + i) * 4096 + col]);
#pragma unroll
        for (int r = 0; r < 3; ++r) F.out[O_CONVS + ((size_t)bs * 3 + r) * GCONV + col] = buf[4 + r];
        float cw[4];
#pragma unroll
        for (int i = 0; i < 4; ++i) cw[i] = FIN(9)[(size_t)i * GCONV + col];
#pragma unroll
        for (int i = 0; i < 4; ++i) { float y = 0.f;
#pragma unroll
            for (int k = 0; k < 4; ++k) y += cw[k] * buf[i + k];
            Y[(part * 4 + i) * 128 + cc] = silu_f(y); }
    }
    {
        const int i = w >> 1, which = w & 1; const bf16* xr = XNA + (row0 + i) * DM; const float* wr = WAB + (size_t)(which * 8 + h) * DM; float s = 0.f;
        for (int k = lane; k < DM; k += 64) s += bf2f(xr[k]) * wr[k];
        s = wave_sum(s); if (lane == 0) AB[which * 4 + i] = s;
    }
    __syncthreads();
    {
        const int part = w >> 2, i = w & 3; LAS float* y = Y + (part * 4 + i) * 128; const float a = y[lane], bq = y[64 + lane];
        const float ss = wave_sum(a * a + bq * bq); const float rs = (frsq(ss + EPS)) * (part == 0 ? 0.08838834764831845f : 1.f);
        y[lane] = a * rs; y[64 + lane] = bq * rs;
    }
    if (tid == 0) { const float Aneg = -expf(FIN(10)[h]), dtb = FIN(11)[h]; float gc = 0.f;
        for (int i = 0; i < 4; ++i) { const float g = Aneg * softplus_f(AB[i] + dtb); gc += g; AB[8 + i] = g; AB[12 + i] = 1.f / (1.f + expf(-AB[4 + i])); AB[16 + i] = gc; } }
    __syncthreads();
    {
#pragma unroll
        for (int pp = 0; pp < 4; ++pp) { const int pr = 4 * w + pp, which = pr >> 4, i = (pr >> 2) & 3, j = pr & 3;
            const LAS float* x = Y + ((which == 0 ? 1 : 0) * 4 + i) * 128; const LAS float* y = Y + (1 * 4 + j) * 128;
            float s = x[lane] * y[lane] + x[64 + lane] * y[64 + lane]; s = wave_sum(s); if (lane == 0) DOT[pr] = s; }
    }
    __syncthreads();
    float g_[4], be[4], gc[4];
#pragma unroll
    for (int i = 0; i < 4; ++i) { g_[i] = AB[8 + i]; be[i] = AB[12 + i]; gc[i] = AB[16 + i]; }
    float Tm[4][4];
    {
        float A[4][4];
#pragma unroll
        for (int i = 0; i < 4; ++i)
#pragma unroll
            for (int j = 0; j < 4; ++j) A[i][j] = (i > j) ? be[i] * DOT[i * 4 + j] * expf(gc[i] - gc[j]) : 0.f;
#pragma unroll
        for (int cc = 0; cc < 4; ++cc)
#pragma unroll
            for (int i = 0; i < 4; ++i) { float acc = (i == cc) ? 1.f : 0.f;
#pragma unroll
                for (int j = 0; j < 4; ++j) if (j < i) acc -= A[i][j] * Tm[j][cc];
                Tm[i][cc] = acc; }
    }
    {
        const int i = tid >> 7, x = tid & 127; float su = 0.f, sw = 0.f;
#pragma unroll
        for (int j = 0; j < 4; ++j) { su += Tm[i][j] * Y[(2 * 4 + j) * 128 + x] * be[j]; sw += Tm[i][j] * Y[(1 * 4 + j) * 128 + x] * be[j] * expf(gc[j]); }
        U[i * 128 + x] = su; W[i * 128 + x] = sw;
    }
    __syncthreads();
    const float* S0 = FIN(4) + ((size_t)bs * GH + h) * 128 * 128;
    const int dv = tid & 127, dg = tid >> 7;
    LAS float* SL = (LAS float*)(L + 32768);
#pragma unroll 16
    for (int r = 0; r < 32; ++r) SL[(32 * dg + r) * 128 + dv] = S0[(size_t)(32 * dg + r) * 128 + dv];
    LAS float* PP = (LAS float*)(L + 16384); LAS float* PQ = (LAS float*)(L + 16384 + 8192);
    {
        float pp[4] = {0.f, 0.f, 0.f, 0.f}, qp[4] = {0.f, 0.f, 0.f, 0.f};
#pragma unroll
        for (int r = 0; r < 32; ++r) { const int dk = 32 * dg + r; const float sv = SL[dk * 128 + dv];
#pragma unroll
            for (int i = 0; i < 4; ++i) { pp[i] += W[i * 128 + dk] * sv; qp[i] += Y[(0 * 4 + i) * 128 + dk] * sv; } }
#pragma unroll
        for (int i = 0; i < 4; ++i) { PP[(dg * 4 + i) * 128 + dv] = pp[i]; PQ[(dg * 4 + i) * 128 + dv] = qp[i]; }
    }
    __syncthreads();
    float qs_acc;
    {
        const int i = tid >> 7;
        const float p = (PP[(0 * 4 + i) * 128 + dv] + PP[(1 * 4 + i) * 128 + dv]) + (PP[(2 * 4 + i) * 128 + dv] + PP[(3 * 4 + i) * 128 + dv]);
        const float qq = (PQ[(0 * 4 + i) * 128 + dv] + PQ[(1 * 4 + i) * 128 + dv]) + (PQ[(2 * 4 + i) * 128 + dv] + PQ[(3 * 4 + i) * 128 + dv]);
        VN[i * 128 + dv] = U[i * 128 + dv] - p; qs_acc = qq * expf(gc[i]);
    }
    __syncthreads();
    {
        const int i = tid >> 7; float o = qs_acc;
#pragma unroll
        for (int j = 0; j < 4; ++j) if (j <= i) o += DOT[16 + i * 4 + j] * expf(gc[i] - gc[j]) * VN[j * 128 + dv];
        WSP(bf16, WS_OGDN)[(row0 + i) * DM + h * 128 + dv] = (bf16)f2bf(o);
    }
    {
        const float el = expf(gc[3]);
        float kd[4], vn[4];
#pragma unroll
        for (int j = 0; j < 4; ++j) { kd[j] = expf(gc[3] - gc[j]); vn[j] = VN[j * 128 + dv]; }
        float* So = F.out + O_GDNS + ((size_t)bs * GH + h) * 128 * 128;
#pragma unroll
        for (int r = 0; r < 32; ++r) { const int dk = 32 * dg + r; float sv = SL[dk * 128 + dv] * el;
#pragma unroll
            for (int j = 0; j < 4; ++j) sv += Y[(1 * 4 + j) * 128 + dk] * kd[j] * vn[j];
            So[(size_t)dk * 128 + dv] = sv; }
    }
    (void)g_;
    __syncthreads();
}

constexpr int P3_S = 0;
constexpr int P3_VN = 16384;
__device__ __forceinline__ void p3_scan(Frame& F, int bh, int s) {
    const int lane = F.lane, w = F.wave, fr = lane & 15, fq = lane >> 4;
    const int b = bh >> 3, h = bh & 7;
    LAS bf16* Sl = (LAS bf16*)(F.lds + P3_S); LAS bf16* Vl = (LAS bf16*)(F.lds + P3_VN);
    const bf16* GW = WSP(bf16, WS_GW); const bf16* GQ = WSP(bf16, WS_GQ); const bf16* GKT = WSP(bf16, WS_GKT); const bf16* GQK = WSP(bf16, WS_GQK);
    const bf16* GU = WSP(bf16, WS_GU); const float* GDEC = WSP(float, WS_GDEC);
    bf16* OG = WSP(bf16, WS_OGDN);
    f32x4 Sacc[2];
#pragma unroll
    for (int n = 0; n < 2; ++n) { Sacc[n] = (f32x4){0.f, 0.f, 0.f, 0.f}; v2u z = {0u, 0u}; *(LAS v2u*)(Sl + (n * 16 + fr) * 136 + 16 * w + 4 * fq) = z; }
    __syncthreads();
    const int m = w & 3;
    struct P3Ops { bf16x8 a1[4], ak0, ak1; v4u x0, x1; float dec; };
    P3Ops R0, R1, R2;
#define P3_FETCH(R, cc) do { const size_t ch_ = (size_t)bh * NCH + (cc); \
        const bf16* p1_ = (w < 4 ? GW : GQ) + ch_ * 8192 + (size_t)(m * 4 * 64 + lane) * 8;        \
        _Pragma("unroll") for (int k_ = 0; k_ < 4; ++k_) R.a1[k_] = ld8(p1_ + 512 * k_); \
        const bf16* pk_ = GKT + ch_ * 8192 + (size_t)(w * 2 * 64 + lane) * 8; R.ak0 = ld8(pk_); R.ak1 = ld8(pk_ + 512); \
        const unsigned char* px_ = w < 4 ? (const unsigned char*)(GU + ch_ * 8192 + ((size_t)(s * 4 + m) * 64 + lane) * 8) : (const unsigned char*)(GQK + ch_ * 4096 + (size_t)(m * 2 * 64 + lane) * 8); \
        R.x0 = *(const v4u*)px_; R.x1 = *(const v4u*)(px_ + (w < 4 ? 0 : 1024));        \
        R.dec = GDEC[ch_]; } while (0)
#define P3_STEP(R, c) do { \
        f32x4 acc[2]; \
        _Pragma("unroll") for (int n = 0; n < 2; ++n) { acc[n] = (f32x4){0.f, 0.f, 0.f, 0.f}; \
            _Pragma("unroll") for (int k = 0; k < 4; ++k) acc[n] = MFMA16(R.a1[k], ld8l(Sl + (n * 16 + fr) * 136 + 32 * k + 8 * fq), acc[n]); } \
        if (w < 4) { _Pragma("unroll") for (int n = 0; n < 2; ++n) { const unsigned ua_ = n == 0 ? R.x0.x : R.x0.z, ub_ = n == 0 ? R.x0.y : R.x0.w; const f32x4 vn = (f32x4){bflo(ua_), bfhi(ua_), bflo(ub_), bfhi(ub_)} - acc[n]; v2u o; o.x = pk2(vn[0], vn[1]); o.y = pk2(vn[2], vn[3]); \
            *(LAS v2u*)(Vl + (n * 16 + fr) * 72 + 16 * m + 4 * fq) = o; } } \
        asm volatile("s_waitcnt lgkmcnt(0)\n\ts_barrier" ::: "memory"); \
        bf16x8 v0[2], v1[2]; \
        _Pragma("unroll") for (int n = 0; n < 2; ++n) { v0[n] = ld8l(Vl + (n * 16 + fr) * 72 + 8 * fq); v1[n] = ld8l(Vl + (n * 16 + fr) * 72 + 32 + 8 * fq); } \
        if (w >= 4) { _Pragma("unroll") for (int n = 0; n < 2; ++n) { acc[n] = MFMA16(__builtin_bit_cast(bf16x8, R.x0), v0[n], acc[n]); acc[n] = MFMA16(__builtin_bit_cast(bf16x8, R.x1), v1[n], acc[n]); \
            bf16* o = OG + ((size_t)b * PT + (c) * CHUNK + 16 * m + 4 * fq) * DM + h * 128 + 32 * s + 16 * n + fr; \
            _Pragma("unroll") for (int r = 0; r < 4; ++r) o[(size_t)r * DM] = (bf16)f2bf(acc[n][r]); } } \
        { float d_ = R.dec;        \
          _Pragma("unroll") for (int n = 0; n < 2; ++n) asm volatile("v_mul_f32 %0, %0, %4\n\tv_mul_f32 %1, %1, %4\n\tv_mul_f32 %2, %2, %4\n\tv_mul_f32 %3, %3, %4" : "+v"(Sacc[n][0]), "+v"(Sacc[n][1]), "+v"(Sacc[n][2]), "+v"(Sacc[n][3]) : "v"(d_)); } \
        _Pragma("unroll") for (int n = 0; n < 2; ++n) { Sacc[n] = MFMA16(R.ak0, v0[n], Sacc[n]); Sacc[n] = MFMA16(R.ak1, v1[n], Sacc[n]); \
            v2u o; o.x = pk2(Sacc[n][0], Sacc[n][1]); o.y = pk2(Sacc[n][2], Sacc[n][3]); *(LAS v2u*)(Sl + (n * 16 + fr) * 136 + 16 * w + 4 * fq) = o; } \
        asm volatile("s_waitcnt lgkmcnt(0)\n\ts_barrier" ::: "memory"); } while (0)
    P3_FETCH(R0, 0); __builtin_amdgcn_sched_barrier(0); P3_FETCH(R1, 1); __builtin_amdgcn_sched_barrier(0); P3_FETCH(R2, 2); __builtin_amdgcn_sched_barrier(0);
    static_assert(NCH % 3 == 2, "ring schedule below assumes NCH = 3k + 2");
#pragma unroll 1
    for (int c = 0; c + 3 <= NCH; c += 3) {
        P3_STEP(R0, c);     P3_FETCH(R0, (c + 3 < NCH ? c + 3 : NCH - 1));
        P3_STEP(R1, c + 1); P3_FETCH(R1, (c + 4 < NCH ? c + 4 : NCH - 1));
        P3_STEP(R2, c + 2); P3_FETCH(R2, (c + 5 < NCH ? c + 5 : NCH - 1));
    }
    P3_STEP(R0, NCH - 2); P3_STEP(R1, NCH - 1);
#undef P3_FETCH
#undef P3_STEP
    float* So = F.out + O_GDNP + ((size_t)bh * 128) * 128;
#pragma unroll
    for (int n = 0; n < 2; ++n)
#pragma unroll
        for (int r = 0; r < 4; ++r) So[(size_t)(16 * w + 4 * fq + r) * 128 + 32 * s + 16 * n + fr] = Sacc[n][r];
}

__device__ __forceinline__ void p4_rows(Frame& F, int first, int stride) {
    const int lane = F.lane;
    if (first >= MTOK) return;
    float gn[16];
    { const f32x4* gp = (const f32x4*)(FIN(12) + (16 * lane & 127));
#pragma unroll
      for (int j = 0; j < 4; ++j) { const f32x4 g4 = gp[j]; gn[4 * j] = g4.x; gn[4 * j + 1] = g4.y; gn[4 * j + 2] = g4.z; gn[4 * j + 3] = g4.w; } }
    v4u no0, no1, nz0, nz1;
#define P4_FETCH(rw) do { const bf16* o_ = WSP(bf16, WS_OGDN) + (size_t)(rw) * DM + 16 * lane; const bf16* z_ = WSP(bf16, WS_PROJ) + (size_t)(rw) * 4096 + 3072 + 16 * lane; \
        no0 = *(const v4u*)o_; no1 = *(const v4u*)(o_ + 8); nz0 = *(const v4u*)z_; nz1 = *(const v4u*)(z_ + 8); } while (0)
    P4_FETCH(first);
#pragma unroll 1
    for (int row = first; row < MTOK; row += stride) {
        f32x4 v[4]; const v4u z0 = nz0, z1 = nz1; float ss = 0.f;
#pragma unroll
        for (int j = 0; j < 4; ++j) { const unsigned wa = j < 2 ? (j == 0 ? no0.x : no0.z) : (j == 2 ? no1.x : no1.z), wb = j < 2 ? (j == 0 ? no0.y : no0.w) : (j == 2 ? no1.y : no1.w);
            v[j] = (f32x4){bflo(wa), bfhi(wa), bflo(wb), bfhi(wb)}; ss += (v[j].x * v[j].x + v[j].y * v[j].y) + (v[j].z * v[j].z + v[j].w * v[j].w); }
        { const int nr = row + stride < MTOK ? row + stride : row; P4_FETCH(nr); }
        ss += dpp_f<DPP_XOR1>(ss); ss += dpp_f<DPP_XOR2>(ss); ss += dpp_f<DPP_HMIR>(ss);
        const float rstd = frsq(ss * (1.f / 128.f) + EPS);
        float zz[16] = {bflo(z0.x), bfhi(z0.x), bflo(z0.y), bfhi(z0.y), bflo(z0.z), bfhi(z0.z), bflo(z0.w), bfhi(z0.w),
                        bflo(z1.x), bfhi(z1.x), bflo(z1.y), bfhi(z1.y), bflo(z1.z), bfhi(z1.z), bflo(z1.w), bfhi(z1.w)};
        unsigned ow[8];
#pragma unroll
        for (int j = 0; j < 8; ++j) { const float a = v[j >> 1][(2 * j) & 3] * rstd * gn[2 * j] * silu_f(zz[2 * j]), bq = v[j >> 1][(2 * j + 1) & 3] * rstd * gn[2 * j + 1] * silu_f(zz[2 * j + 1]); ow[j] = pk2(a, bq); }
        v4u* dst = (v4u*)(WSP(bf16, WS_OG) + (size_t)row * DM + 16 * lane);
        dst[0] = (v4u){ow[0], ow[1], ow[2], ow[3]}; dst[1] = (v4u){ow[4], ow[5], ow[6], ow[7]};
    }
#undef P4_FETCH
}

typedef __bf16 bf16x2_t __attribute__((ext_vector_type(2)));
__device__ __forceinline__ float dot2_bf16(unsigned w, unsigned x, float acc) { return __builtin_amdgcn_fdot2_f32_bf16(__builtin_bit_cast(bf16x2_t, w), __builtin_bit_cast(bf16x2_t, x), acc, false); }
__device__ __forceinline__ float u2f(unsigned u) { return __builtin_bit_cast(float, u); }
__device__ __forceinline__ unsigned f2u(float f) { return __builtin_bit_cast(unsigned, f); }

constexpr int P8_MAXU = 4;
constexpr int P8_WAVE = P8_MAXU * 2048 + 1024;
constexpr int P8_TOP = 0;
constexpr int P8_TAB = 8 * P8_WAVE;
__device__ __forceinline__ void p8_init_tab(Frame& F) {
    LAS unsigned char* tab = F.lds + P8_TAB;
    if (F.tid < 64) { const int k = F.tid; int i = 0, j = 0;
        if (k < 16) { i = 0; j = k; } else if (k < 24) { i = 1; j = k - 16; } else if (k < 29) { i = 2; j = k - 24; } else if (k < 33) { i = 3; j = k - 29; }
        else if (k < 36) { i = 4; j = k - 33; } else if (k < 38) { i = 5; j = k - 36; } else if (k < 40) { i = 6; j = k - 38; } else if (k < 42) { i = 7; j = k - 40; } else if (k < 50) { i = k - 34; j = 0; }
        tab[k] = (unsigned char)i; tab[64 + k] = (unsigned char)j; }
    __syncthreads();
}
__device__ __forceinline__ int fkey(float x) { const int b = __builtin_bit_cast(int, x); return b ^ ((b >> 31) & 0x7fffffff); }
__device__ __forceinline__ float fkey_inv(int k) { return __builtin_bit_cast(float, k ^ ((k >> 31) & 0x7fffffff)); }
template <int CTRL> __device__ __forceinline__ int dpp_i(int x) { return __builtin_amdgcn_update_dpp(0, x, CTRL, 0xF, 0xF, true); }
__device__ __forceinline__ int imax(int a, int b) { return a > b ? a : b; }
__device__ __forceinline__ int imin(int a, int b) { return a < b ? a : b; }
__device__ __forceinline__ int row_imax16(int x) {
    x = imax(x, dpp_i<0xB1>(x)); x = imax(x, dpp_i<0x4E>(x)); x = imax(x, dpp_i<0x141>(x)); x = imax(x, dpp_i<0x140>(x)); return x;
}
#define ICSWAP(a, b) { const int hi_ = imax(a, b), lo_ = imin(a, b); a = hi_; b = lo_; }
constexpr int IKEY_MIN = (int)0x80000000;
template <int NR>
__device__ __forceinline__ void p8_run(Frame& F, int layer, int w, int rq, int u0, int ustride, int nu) {
    int lane_ = F.lane; asm volatile("" : "+v"(lane_));
    const int lane = lane_, fr = lane & 15, fq = lane >> 4;
    LAS unsigned char* L = F.lds; asm volatile("" : "+v"(L));
    LAS int* toplw = (LAS int*)(L + P8_TOP + F.wave * P8_WAVE);
    LAS float* wins = (LAS float*)(L + P8_TOP + F.wave * P8_WAVE + P8_MAXU * 2048);
    const LAS unsigned char* tab = L + P8_TAB;
    const bf16* Qb = WSP(bf16, WS_QPEER) + (size_t)fr * 2048 + w * 256 + 8 * fq;
    const bf16* SK = WSP(bf16, WS_SUBK) + (size_t)((layer * 8 + w) * 2) * 16384 + (size_t)fr * 128 + 8 * fq;
#pragma unroll 1
    for (int p = 0; p < 2; ++p) {
        bf16x8 bk[32], aq[4];
#pragma unroll
        for (int i = 0; i < 32; ++i) bk[i] = ld8(SK + (size_t)p * 16384 + (size_t)(i >> 2) * 2048 + 32 * (i & 3));
#pragma unroll
        for (int ks = 0; ks < 4; ++ks) aq[ks] = ld8(Qb + (size_t)u0 * 16 * 2048 + p * 128 + 32 * ks);
#pragma unroll 1
        for (int k = 0; k < nu; ++k) {
            LAS int* topl = toplw + k * 512;
            int s[NR][8];
#pragma unroll
            for (int nt = 0; nt < 8; ++nt) { f32x4 acc = {0.f, 0.f, 0.f, 0.f};
#pragma unroll
                for (int ks = 0; ks < 4; ++ks) acc = MFMA16(aq[ks], bk[nt * 4 + ks], acc);
                if (NR == 4) {
#pragma unroll
                    for (int r = 0; r < NR; ++r) s[r][nt] = fkey(u2f((f2u(acc[r]) & ~127u) | (unsigned)(16 * nt + fr)));
                } else { const float av = rq == 0 ? acc[0] : rq == 1 ? acc[1] : rq == 2 ? acc[2] : acc[3]; s[0][nt] = fkey(u2f((f2u(av) & ~127u) | (unsigned)(16 * nt + fr))); } }
            { const int un = u0 + (k + 1 < nu ? k + 1 : k) * ustride;
#pragma unroll
              for (int ks = 0; ks < 4; ++ks) aq[ks] = ld8(Qb + (size_t)un * 16 * 2048 + p * 128 + 32 * ks); }
#pragma unroll
            for (int r = 0; r < NR; ++r) {
                ICSWAP(s[r][0], s[r][1]) ICSWAP(s[r][2], s[r][3]) ICSWAP(s[r][4], s[r][5]) ICSWAP(s[r][6], s[r][7])
                ICSWAP(s[r][0], s[r][2]) ICSWAP(s[r][1], s[r][3]) ICSWAP(s[r][4], s[r][6]) ICSWAP(s[r][5], s[r][7])
                ICSWAP(s[r][1], s[r][2]) ICSWAP(s[r][5], s[r][6]) ICSWAP(s[r][0], s[r][4]) ICSWAP(s[r][3], s[r][7])
                ICSWAP(s[r][1], s[r][5]) ICSWAP(s[r][2], s[r][6]) ICSWAP(s[r][1], s[r][4]) ICSWAP(s[r][3], s[r][6])
                ICSWAP(s[r][2], s[r][4]) ICSWAP(s[r][3], s[r][5]) ICSWAP(s[r][3], s[r][4]) }
            int mine[NR];
#pragma unroll
            for (int r = 0; r < NR; ++r) mine[r] = IKEY_MIN;
#pragma unroll 1
            for (int rd = 0; rd < 16; ++rd) {
                const bool me = fr == rd;
#pragma unroll
                for (int r = 0; r < NR; ++r) {
                    const int mx = row_imax16(s[r][0]);
                    const bool pop = s[r][0] == mx;
#pragma unroll
                    for (int i = 0; i < 7; ++i) s[r][i] = pop ? s[r][i + 1] : s[r][i];
                    s[r][7] = pop ? IKEY_MIN : s[r][7];
                    mine[r] = me ? mx : mine[r];
                }
            }
#pragma unroll
            for (int r = 0; r < NR; ++r) topl[((4 * fq + (NR == 4 ? r : rq)) * 2 + p) * 16 + fr] = mine[r];
        }
    }
    LDS_WAIT();
#pragma unroll 1
    for (int k = 0; k < nu; ++k) {
    LAS int* topl = toplw + k * 512;
    const int r0 = (u0 + k * ustride) * 16;
    int c[NR][4];
#pragma unroll
    for (int r = 0; r < NR; ++r) { const int tk = 4 * fq + (NR == 4 ? r : rq);
#pragma unroll
        for (int m = 0; m < 4; ++m) { const int kc = fr + 16 * m; int cv = IKEY_MIN;
            if (kc < 50) { const int i = tab[kc], j = tab[64 + kc]; const float s1 = u2f(f2u(fkey_inv(topl[(tk * 2 + 0) * 16 + i])) & ~127u), s2 = u2f(f2u(fkey_inv(topl[(tk * 2 + 1) * 16 + j])) & ~127u);
                cv = fkey(u2f((f2u(s1 + s2) & ~63u) | (unsigned)kc)); }
            c[r][m] = cv; }
        ICSWAP(c[r][0], c[r][1]) ICSWAP(c[r][2], c[r][3]) ICSWAP(c[r][0], c[r][2]) ICSWAP(c[r][1], c[r][3]) ICSWAP(c[r][1], c[r][2]) }
    int minec[NR];
#pragma unroll
    for (int r = 0; r < NR; ++r) minec[r] = IKEY_MIN;
#pragma unroll 1
    for (int rd = 0; rd < 16; ++rd) {
        const bool me = fr == rd;
#pragma unroll
        for (int r = 0; r < NR; ++r) {
            const int mx = row_imax16(c[r][0]);
            const bool pop = c[r][0] == mx;
            c[r][0] = pop ? c[r][1] : c[r][0]; c[r][1] = pop ? c[r][2] : c[r][1]; c[r][2] = pop ? c[r][3] : c[r][2]; c[r][3] = pop ? IKEY_MIN : c[r][3];
            minec[r] = me ? mx : minec[r];
        }
    }
#pragma unroll
    for (int r = 0; r < NR; ++r) wins[(4 * fq + (NR == 4 ? r : rq)) * 16 + fr] = fkey_inv(minec[r]);
    LDS_WAIT();
    if (NR == 4 || (fr >> 2) == rq) {
        const int tk = 4 * fq + (fr >> 2), q4 = fr & 3;
        const float w0 = wins[tk * 16]; float den = 0.f;
#pragma unroll
        for (int rd = 0; rd < 16; ++rd) den += __expf(wins[tk * 16 + rd] - w0);
        const float inv = 1.f / den;
        int e[4]; float g[4];
#pragma unroll
        for (int x = 0; x < 4; ++x) { const float wv = wins[tk * 16 + 4 * q4 + x]; const int kc = (int)(f2u(wv) & 63u); const int i = tab[kc], j = tab[64 + kc];
            e[x] = (int)(f2u(fkey_inv(topl[(tk * 2 + 0) * 16 + i])) & 127u) * 128 + (int)(f2u(fkey_inv(topl[(tk * 2 + 1) * 16 + j])) & 127u); g[x] = __expf(wv - w0) * inv; }
        unsigned short* pei = WSP(unsigned short, WS_PEI) + (size_t)(r0 + tk) * 128 + w * 16 + 4 * q4; float* peg = WSP(float, WS_PEG) + (size_t)(r0 + tk) * 128 + w * 16 + 4 * q4;
        *(v2u*)pei = (v2u){(unsigned)e[0] | ((unsigned)e[1] << 16), (unsigned)e[2] | ((unsigned)e[3] << 16)};
        *(f32x4*)peg = (f32x4){g[0], g[1], g[2], g[3]};
    }
    LDS_WAIT();
    }
}
__device__ __forceinline__ void p8_phase(Frame& F, int layer) {
    p8_init_tab(F);
    for (int ub = F.bid; ub < MP / 16; ub += F.G * P8_MAXU) { const int left = (MP / 16 - ub + F.G - 1) / F.G; p8_run<4>(F, layer, F.wave, 0, ub, F.G, left < P8_MAXU ? left : P8_MAXU); }
    for (int qu = F.bid * 8 + F.wave; qu < (MS / 16) * 8 * 4 * 8; qu += F.G * 8) { if ((qu & 7) == 0) { const int x = qu >> 3; p8_run<1>(F, layer, (x >> 2) & 7, x & 3, MP / 16 + (x >> 5), 0, 1); } }
}

constexpr size_t PE_SLICE_BYTES = (size_t)NEXP * 128;
__device__ __forceinline__ f32x2 p9_cvt(unsigned w, bool hi) { return hi ? __builtin_amdgcn_cvt_pk_f32_fp8((int)w, true) : __builtin_amdgcn_cvt_pk_f32_fp8((int)w, false); }
__device__ __forceinline__ f32x2 fma2(f32x2 a, f32x2 b, f32x2 c) { return __builtin_elementwise_fma(a, b, c); }
__device__ __forceinline__ float p9_dot16(const v4u u, const f32x2 (&h)[8]) {
    f32x2 a = {0.f, 0.f}, b = {0.f, 0.f};
    a = fma2(p9_cvt(u.x, false), h[0], a); b = fma2(p9_cvt(u.x, true), h[1], b); a = fma2(p9_cvt(u.y, false), h[2], a); b = fma2(p9_cvt(u.y, true), h[3], b);
    a = fma2(p9_cvt(u.z, false), h[4], a); b = fma2(p9_cvt(u.z, true), h[5], b); a = fma2(p9_cvt(u.w, false), h[6], a); b = fma2(p9_cvt(u.w, true), h[7], b);
    a = a + b; return a.x + a.y;
}
__device__ __forceinline__ void p9_axpy16(const v4u v, float c, f32x2 (&o)[8]) {
    const f32x2 cc = {c, c};
    o[0] = fma2(p9_cvt(v.x, false), cc, o[0]); o[1] = fma2(p9_cvt(v.x, true), cc, o[1]); o[2] = fma2(p9_cvt(v.y, false), cc, o[2]); o[3] = fma2(p9_cvt(v.y, true), cc, o[3]);
    o[4] = fma2(p9_cvt(v.z, false), cc, o[4]); o[5] = fma2(p9_cvt(v.z, true), cc, o[5]); o[6] = fma2(p9_cvt(v.w, false), cc, o[6]); o[7] = fma2(p9_cvt(v.w, true), cc, o[7]);
}
#define P9_GATHER(S, iw) do { _Pragma("unroll") for (int j_ = 0; j_ < 8; ++j_) { const unsigned w_ = (iw)[j_ >> 1]; const unsigned id_ = (j_ & 1) ? (w_ >> 16) : (w_ & 0xffffu); \
        S[j_] = *(const v4u*)(tab + ((id_ << 7) + sub16)); } } while (0)
__device__ __forceinline__ float swapsum16(float x, float y) { unsigned a = __builtin_bit_cast(unsigned, x), b = __builtin_bit_cast(unsigned, y); PSWAP16(a, b); return __builtin_bit_cast(float, a) + __builtin_bit_cast(float, b); }
__device__ __forceinline__ float swapsum32(float x, float y) { unsigned a = __builtin_bit_cast(unsigned, x), b = __builtin_bit_cast(unsigned, y); PSWAP32(a, b); return __builtin_bit_cast(float, a) + __builtin_bit_cast(float, b); }

__device__ __forceinline__ void p9u_wave(Frame& F, int layer, int slice, int first, int stride) {
    int lane_ = F.lane; asm volatile("" : "+v"(lane_));
    const int lane = lane_, gi = lane >> 3, sub = lane & 7;
    const unsigned char* tab = WSP(unsigned char, WS_PU) + (size_t)(layer * 8 + slice) * PE_SLICE_BYTES;
    const unsigned sub16 = (unsigned)sub * 16u;
    const unsigned char* hbase = (const unsigned char*)(WSP(bf16, WS_XNB) + slice * 128 + sub * 16);
    const unsigned char* ibase = (const unsigned char*)(WSP(unsigned short, WS_PEI) + gi * 16);
    unsigned* pa = WSP(unsigned, WS_PA) + slice * 64 + lane;
    int t = first; if (t >= MTOK) return;
    v4u ia, ib, ha, hb, nia, nib, nha, nhb, A[8], B[8];
#define P9U_META(tt, xa, xb, ya, yb) do { const v4u* ip_ = (const v4u*)(ibase + (size_t)(tt) * 256); xa = ip_[0]; xb = ip_[1]; const v4u* hp_ = (const v4u*)(hbase + (size_t)(tt) * 2048); ya = hp_[0]; yb = hp_[1]; } while (0)
    P9U_META(t, ia, ib, ha, hb);
    P9_GATHER(A, ia);
    const bool b0 = sub & 1, b1 = sub & 2, b2 = sub & 4;
#pragma unroll 1
    for (;;) {
        const int tn = t + stride; const bool more = tn < MTOK; const int tl = more ? tn : t;
        P9U_META(tl, nia, nib, nha, nhb);
        P9_GATHER(B, ib);
        f32x2 h[8];
#pragma unroll
        for (int k = 0; k < 4; ++k) { h[k] = (f32x2){bflo(ha[k]), bfhi(ha[k])}; h[4 + k] = (f32x2){bflo(hb[k]), bfhi(hb[k])}; }
        float p[16];
#pragma unroll
        for (int j = 0; j < 8; ++j) p[j] = p9_dot16(A[j], h);
        P9_GATHER(A, nia);
#pragma unroll
        for (int j = 0; j < 8; ++j) p[8 + j] = p9_dot16(B[j], h);
        float q[8], r[4], sv[2];
#pragma unroll
        for (int i = 0; i < 8; ++i) { const float keep = b2 ? p[8 + i] : p[i], send = b2 ? p[i] : p[8 + i]; q[i] = keep + dpp_f<DPP_HMIR>(send); }
#pragma unroll
        for (int i = 0; i < 4; ++i) { const float keep = b0 ? q[2 * i + 1] : q[2 * i], send = b0 ? q[2 * i] : q[2 * i + 1]; r[i] = keep + dpp_f<DPP_XOR1>(send); }
#pragma unroll
        for (int i = 0; i < 2; ++i) { const float keep = b1 ? r[2 * i + 1] : r[2 * i], send = b1 ? r[2 * i] : r[2 * i + 1]; sv[i] = keep + dpp_f<DPP_XOR2>(send); }
        pa[(size_t)t * 512] = pk2(sv[0], sv[1]);
        if (!more) break;
        t = tn; ia = nia; ib = nib; ha = nha; hb = nhb;
    }
#undef P9U_META
}

__device__ __forceinline__ void p9v_wave(Frame& F, int layer, int slice, int first, int stride, int mode) {
    int lane_ = F.lane; asm volatile("" : "+v"(lane_));
    const int lane = lane_, gi = lane >> 3, sub = lane & 7, j0 = 8 * (sub >> 2) + (sub & 3);
    const unsigned char* tab = WSP(unsigned char, WS_PV) + (size_t)(layer * 8 + slice) * PE_SLICE_BYTES;
    const unsigned sub16 = (unsigned)sub * 16u;
    const unsigned char* ibase = (const unsigned char*)(WSP(unsigned short, WS_PEI) + gi * 16);
    const unsigned* pab = WSP(unsigned, WS_PA) + lane;
    const float* pegb = WSP(float, WS_PEG) + gi * 16 + j0;
    const int eoff = slice * 128 + sub * 16 + gi;
    float* xsb = WSP(float, WS_XS) + eoff;
    int t = first; if (t >= MTOK) return;
    v4u ia, ib, nia, nib, A[8], B[8];
    unsigned pw[8], npw[8]; float g0, g1, ng0, ng1, x0, x1, nx0, nx1;
#define P9V_META(tt, xa, xb, pp, ga, gb, ya, yb) do { const v4u* ip_ = (const v4u*)(ibase + (size_t)(tt) * 256); xa = ip_[0]; xb = ip_[1]; \
        _Pragma("unroll") for (int x_ = 0; x_ < 8; ++x_) pp[x_] = pab[(size_t)(tt) * 512 + x_ * 64]; \
        ga = pegb[(size_t)(tt) * 128]; gb = pegb[(size_t)(tt) * 128 + 4]; ya = xsb[(size_t)(tt) * DM]; yb = xsb[(size_t)(tt) * DM + 8]; } while (0)
    P9V_META(t, ia, ib, pw, g0, g1, x0, x1);
    P9_GATHER(A, ia);
#pragma unroll 1
    for (;;) {
        const int tn = t + stride; const bool more = tn < MTOK; const int tl = more ? tn : t;
        P9V_META(tl, nia, nib, npw, ng0, ng1, nx0, nx1);
        P9_GATHER(B, ib);
        float alo = 0.f, ahi = 0.f;
#pragma unroll
        for (int x = 0; x < 8; ++x) { alo += bflo(pw[x]); ahi += bfhi(pw[x]); }
        const float c0 = gelu_tanh(alo * 0.03125f) * g0 * 0.0625f, c1 = gelu_tanh(ahi * 0.03125f) * g1 * 0.0625f;
        f32x2 o[8];
#pragma unroll
        for (int i = 0; i < 8; ++i) o[i] = (f32x2){0.f, 0.f};
#define P9V_C(j) __builtin_bit_cast(float, __builtin_amdgcn_ds_swizzle(__builtin_bit_cast(int, (((j) >> 2) & 1) ? c1 : c0), ((4 * ((j) >> 3) + ((j) & 3)) << 5) | 0x18))
        { const float cj[8] = {P9V_C(0), P9V_C(1), P9V_C(2), P9V_C(3), P9V_C(4), P9V_C(5), P9V_C(6), P9V_C(7)};
#pragma unroll
          for (int j = 0; j < 8; ++j) p9_axpy16(A[j], cj[j], o); }
        P9_GATHER(A, nia);
        { const float cj[8] = {P9V_C(8), P9V_C(9), P9V_C(10), P9V_C(11), P9V_C(12), P9V_C(13), P9V_C(14), P9V_C(15)};
#pragma unroll
          for (int j = 0; j < 8; ++j) p9_axpy16(B[j], cj[j], o); }
#undef P9V_C
        const bool g0b = lane & 8;
        float q[8], r[4], sv[2];
#pragma unroll
        for (int i = 0; i < 8; ++i) { const float keep = g0b ? o[i].y : o[i].x, send = g0b ? o[i].x : o[i].y; q[i] = keep + dpp_f<DPP_ROR8>(send); }
#pragma unroll
        for (int i = 0; i < 4; ++i) r[i] = swapsum16(q[2 * i], q[2 * i + 1]);
#pragma unroll
        for (int i = 0; i < 2; ++i) sv[i] = swapsum32(r[2 * i], r[2 * i + 1]);
        const float y0 = x0 + sv[0], y1 = x1 + sv[1];
        if (mode == 0) {
            float* xs = xsb + (size_t)t * DM; xs[0] = y0; xs[8] = y1;
            bf16* xn = WSP(bf16, WS_XNA) + (size_t)t * DM + eoff; xn[0] = (bf16)f2bf(y0); xn[8] = (bf16)f2bf(y1);
            const float ss = wave_sum(y0 * y0 + y1 * y1);
            if (lane == 0) WSP(float, WS_SSQ)[(size_t)t * 8 + slice] = ss;
        } else {
            float* y = (t < MP ? F.out + O_YP + (size_t)t * DM : F.out + O_YS + (size_t)(t - MP) * DM) + eoff;
            y[0] = y0; y[8] = y1;
        }
        if (!more) break;
        t = tn; ia = nia; ib = nib; g0 = ng0; g1 = ng1; x0 = nx0; x1 = nx1;
#pragma unroll
        for (int x = 0; x < 8; ++x) pw[x] = npw[x];
    }
#undef P9V_META
}
#undef P9_GATHER

constexpr float QSCALE = 0.125f * 1.4426950408889634f;
constexpr int PP_VT = 0;
__device__ __forceinline__ float rms64(float v) { return frsq(wave_sum(v * v) * (1.f / 64.f) + EPS); }

__device__ __forceinline__ void pp_q_row(Frame& F, int row, const bf16* kvq, const float qg) {
    const int lane = F.lane;
    bf16* qn = WSP(bf16, WS_QN) + (size_t)row * 1024;
#pragma unroll 4
    for (int hd = 0; hd < 16; ++hd) { const float v = bf2f(kvq[NKV + hd * 64 + lane]); qn[hd * 64 + lane] = (bf16)f2bf(v * rms64(v) * qg); }
    if (lane < 48) WSP(float, WS_GATES)[(size_t)row * 48 + lane] = sigmoid_f(bf2f(kvq[NKV + 1024 + lane]));
}
__device__ __forceinline__ f32x4 rms64x4(f32x4 v) { const float ss = row_sum16((v.x * v.x + v.y * v.y) + (v.z * v.z + v.w * v.w)); return v * (frsq(ss * (1.f / 64.f) + EPS)); }
__device__ __forceinline__ v2u pk4(f32x4 v) { return (v2u){pk2(v.x, v.y), pk2(v.z, v.w)}; }
__device__ __forceinline__ void pp_prompt_tile(Frame& F, int unit) {
    const int lane = F.lane, w = F.wave, b = unit >> 7, t0 = (unit & 127) * 64, g = lane >> 4, d4 = (lane & 15) * 4;
    LAS unsigned char* L = F.lds; asm volatile("" : "+v"(L));
    LAS bf16* vt = (LAS bf16*)(L + PP_VT);
    const f32x4 kg1 = *(const f32x4*)(FIN(16) + 64 + d4), kg2 = *(const f32x4*)(FIN(16) + 128 + d4), qg = *(const f32x4*)(FIN(22) + d4) * QSCALE;
    v2u nv[6], nq[4], ngl;
#define PP_FETCH(rr_) do { const int row_ = b * PT + t0 + 8 * w + ((rr_) < 8 ? (rr_) : 7); const v2u* kvq_ = (const v2u*)(WSP(bf16, WS_KVQ) + (size_t)row_ * NKVQ) + lane;        \
        _Pragma("unroll") for (int sidx_ = 0; sidx_ < 6; ++sidx_) nv[sidx_] = kvq_[64 * sidx_]; \
        _Pragma("unroll") for (int i_ = 0; i_ < 4; ++i_) nq[i_] = kvq_[64 * (6 + i_)]; \
        ngl = ((const v2u*)(WSP(bf16, WS_KVQ) + (size_t)row_ * NKVQ))[640 + (lane & 15)]; } while (0)
    PP_FETCH(0);
#pragma unroll 1
    for (int rr = 0; rr < 8; ++rr) {
        const int tl = 8 * w + rr, t = t0 + tl, row = b * PT + t;
        f32x4 v[6], q[4]; const f32x4 gl = {bflo(ngl.x), bfhi(ngl.x), bflo(ngl.y), bfhi(ngl.y)};
#pragma unroll
        for (int sidx = 0; sidx < 6; ++sidx) v[sidx] = (f32x4){bflo(nv[sidx].x), bfhi(nv[sidx].x), bflo(nv[sidx].y), bfhi(nv[sidx].y)};
#pragma unroll
        for (int i = 0; i < 4; ++i) q[i] = (f32x4){bflo(nq[i].x), bfhi(nq[i].x), bflo(nq[i].y), bfhi(nq[i].y)};
        PP_FETCH(rr + 1);
        const f32x4 ks = rms64x4(v[2]) * kg1, kw = rms64x4(v[4]) * kg2;
        f32x4* okv = (f32x4*)(F.out + O_KVP + (size_t)row * 1024) + lane;
        okv[0] = v[0]; okv[64] = v[1]; okv[128] = ks; okv[192] = v[3];
        if (t >= PT - WINDOW) { f32x4* owin = (f32x4*)(F.out + O_WINP + ((size_t)b * 512 + (t - (PT - WINDOW))) * 512) + lane; owin[0] = kw; owin[64] = v[5]; }
        const size_t kidx = (((size_t)b * NG + g) * PT + t) * 64 + d4;
        *(v2u*)(WSP(bf16, WS_KSEL) + kidx) = pk4(ks); *(v2u*)(WSP(bf16, WS_KWIN) + kidx) = pk4(kw);
#pragma unroll
        for (int j = 0; j < 4; ++j) { vt[((0 * 4 + g) * 64 + d4 + j) * 72 + tl] = (bf16)f2bf(v[3][j]); vt[((1 * 4 + g) * 64 + d4 + j) * 72 + tl] = (bf16)f2bf(v[5][j]); }
        bf16* qn = WSP(bf16, WS_QN) + (size_t)row * 1024 + g * 64 + d4;
#pragma unroll
        for (int i = 0; i < 4; ++i) *(v2u*)(qn + i * 256) = pk4(rms64x4(q[i]) * qg);
        if (lane < 12) *(f32x4*)(WSP(float, WS_GATES) + (size_t)row * 48 + 4 * lane) = (f32x4){sigmoid_f(gl.x), sigmoid_f(gl.y), sigmoid_f(gl.z), sigmoid_f(gl.w)};
    }
#undef PP_FETCH
    __syncthreads();
    {
        const int which = F.tid >> 8, gd = F.tid & 255;
        bf16* dst = WSP(bf16, which == 0 ? WS_VSELT : WS_VWINT) + (((size_t)b * NG * 64 + gd) * PT + t0);
        const LAS bf16* src = vt + ((which * 256 + gd) * 72);
#pragma unroll
        for (int i = 0; i < 8; ++i) *(v4u*)(dst + 8 * i) = *(const LAS v4u*)(src + 8 * i);
    }
    __syncthreads();
}
__device__ __forceinline__ void pp_sample_row(Frame& F, int sr, int part = -1) {
    const int lane = F.lane, bs = sr >> 2, i = sr & 3, row = MP + sr;
    const float kg1 = FIN(16)[64 + lane], kg2 = FIN(16)[128 + lane], qg = FIN(22)[lane] * QSCALE;
    const bf16* kvq = WSP(bf16, WS_KVQ) + (size_t)row * NKVQ;
    float* okv = F.out + O_KVS + (size_t)sr * 1024;
    float* owin = F.out + O_WINS + ((size_t)bs * 512 + 508 + i) * 512;
#pragma unroll
    for (int g = 0; g < 4; ++g) { if (part >= 0 && part != g) continue;
        const float v0 = bf2f(kvq[0 * 256 + g * 64 + lane]), v1 = bf2f(kvq[1 * 256 + g * 64 + lane]), v2 = bf2f(kvq[2 * 256 + g * 64 + lane]);
        const float v3 = bf2f(kvq[3 * 256 + g * 64 + lane]), v4 = bf2f(kvq[4 * 256 + g * 64 + lane]), v5 = bf2f(kvq[5 * 256 + g * 64 + lane]);
        const float ks = v2 * rms64(v2) * kg1, kw = v4 * rms64(v4) * kg2;
        okv[0 * 256 + g * 64 + lane] = v0; okv[1 * 256 + g * 64 + lane] = v1; okv[2 * 256 + g * 64 + lane] = ks; okv[3 * 256 + g * 64 + lane] = v3;
        owin[g * 64 + lane] = kw; owin[256 + g * 64 + lane] = v5;
        const size_t bg = (size_t)bs * NG + g;
        WSP(bf16, WS_SKWIN)[(bg * 544 + 512 + i) * 64 + lane] = (bf16)f2bf(kw);
        WSP(bf16, WS_SVWINT)[(bg * 64 + lane) * 544 + 512 + i] = (bf16)f2bf(v5);
        float* sn = WSP(float, WS_SNEW) + (((size_t)bs * 4 + i) * 2) * 256 + g * 64 + lane;
        sn[0] = ks; sn[256] = v3;
    }
    bf16* qn = WSP(bf16, WS_QN) + (size_t)row * 1024;
#pragma unroll 4
    for (int hd = 0; hd < 16; ++hd) { if (part >= 0 && (hd >> 2) != part - 4) continue; const float v = bf2f(kvq[NKV + hd * 64 + lane]); qn[hd * 64 + lane] = (bf16)f2bf(v * rms64(v) * qg); }
    if ((part < 0 || part == 7) && lane < 48) WSP(float, WS_GATES)[(size_t)row * 48 + lane] = sigmoid_f(bf2f(kvq[NKV + 1024 + lane]));
}

struct RowPPrompt { static constexpr bool BF = true; const bf16* base; __device__ __forceinline__ const bf16* operator()(int t) const { return base + (size_t)t * NKVQ; } };
struct RowPSample { static constexpr bool BF = false; const float* cache; const int* pt; __device__ __forceinline__ const float* operator()(int t) const { return cache + ((size_t)pt[t >> 7] * PAGE + (t & 127)) * 1024; } };
template <class RowP> __device__ __forceinline__ bf16x8 rowp_frag(const RowP& rowp, int t, int off) {
    if constexpr (RowP::BF) return ld8(rowp(t) + off);
    else { const float* rp = rowp(t) + off; return cvt8(*(const f32x4*)rp, *(const f32x4*)(rp + 4)); }
}
__device__ __forceinline__ void compress_finish(Frame& F, const f32x4 (&acc)[4], int kv, int blk, bf16* KC, bf16* VCT) {
    const int lane = F.lane, fr = lane & 15, fq = lane >> 4;
    const float* pet = WSP(float, WS_PETERM) + kv * 64;
    bf16x8 hb[2];
#pragma unroll
    for (int s = 0; s < 2; ++s) { f32x4 h0, h1;
#pragma unroll
        for (int r = 0; r < 4; ++r) { h0[r] = gelu_tanh(acc[2 * s][r] + pet[16 * (2 * s) + 4 * fq + r]); h1[r] = gelu_tanh(acc[2 * s + 1][r] + pet[16 * (2 * s + 1) + 4 * fq + r]); }
        hb[s] = cvt8(h0, h1); }
    const bf16* w2f = WSP(bf16, WS_W2F) + (size_t)kv * 4096 + lane * 8;
    f32x4 o[4];
#pragma unroll
    for (int dt = 0; dt < 4; ++dt) { o[dt] = (f32x4){0.f, 0.f, 0.f, 0.f};
#pragma unroll
        for (int s = 0; s < 2; ++s) o[dt] = MFMA16(ld8(w2f + (dt * 2 + s) * 512), hb[s], o[dt]); }
    if (kv == 0) {
        float ss = 0.f;
#pragma unroll
        for (int dt = 0; dt < 4; ++dt) ss += (o[dt][0] * o[dt][0] + o[dt][1] * o[dt][1]) + (o[dt][2] * o[dt][2] + o[dt][3] * o[dt][3]);
        ss = x32_sum(x16_sum(ss));
        const float rstd = frsq(ss * (1.f / 64.f) + EPS);
        const float* kg0 = FIN(16);
        if (blk < NCMP) {
#pragma unroll
            for (int dt = 0; dt < 4; ++dt) { const int d = 16 * dt + 4 * fq; v2u ov; ov.x = pk2(o[dt][0] * rstd * kg0[d], o[dt][1] * rstd * kg0[d + 1]); ov.y = pk2(o[dt][2] * rstd * kg0[d + 2], o[dt][3] * rstd * kg0[d + 3]);
                *(v2u*)(KC + (size_t)blk * 64 + d) = ov; }
        } else {
#pragma unroll
            for (int dt = 0; dt < 4; ++dt) *(v2u*)(KC + (size_t)blk * 64 + 16 * dt + 4 * fq) = (v2u){0u, 0u};
        }
    } else {
#pragma unroll
        for (int dt = 0; dt < 4; ++dt)
#pragma unroll
            for (int r = 0; r < 4; ++r) VCT[(size_t)(16 * dt + 4 * fq + r) * 512 + blk] = (blk < NCMP) ? (bf16)f2bf(o[dt][r]) : (bf16)0;
    }
}

template <class RowP>
__device__ __forceinline__ void compress_part(Frame& F, const RowP& rowp, int kv, int j, int r_lo, int r_hi, f32x4 (&acc)[4]) {
    const int lane = F.lane, fr = lane & 15, fq = lane >> 4;
    const bf16* W1 = WSP(bf16, WS_W1T) + (size_t)kv * 64 * 2048 + (size_t)fr * 2048 + 8 * fq;
    const int blk = 16 * j + fr;
#pragma unroll
    for (int mt = 0; mt < 4; ++mt) acc[mt] = (f32x4){0.f, 0.f, 0.f, 0.f};
#pragma unroll 2
    for (int r = r_lo; r < r_hi; ++r) {
        int t = 16 * blk + r; t = t < PAST ? t : PAST - 1;
#pragma unroll
        for (int hf = 0; hf < 2; ++hf) {
            const bf16x8 bfrag = rowp_frag(rowp, t, 8 * fq + 32 * hf);
            const int ks = 2 * r + hf;
#pragma unroll
            for (int mt = 0; mt < 4; ++mt) acc[mt] = MFMA16(ld8(W1 + (size_t)mt * 16 * 2048 + 32 * ks), bfrag, acc[mt]);
        }
    }
}
template <class RowP>
__device__ __forceinline__ void compress_tile(Frame& F, const RowP& rowp, int kv, int j, bf16* KC, bf16* VCT) {
    const int lane = F.lane, fr = lane & 15, fq = lane >> 4;
    const bf16* W1 = WSP(bf16, WS_W1T) + (size_t)kv * 64 * 2048 + (size_t)fr * 2048 + 8 * fq;
    const int blk = 16 * j + fr;
    f32x4 acc[4];
#pragma unroll
    for (int mt = 0; mt < 4; ++mt) acc[mt] = (f32x4){0.f, 0.f, 0.f, 0.f};
#pragma unroll 2
    for (int r = 0; r < 32; ++r) {
        int t = 16 * blk + r; t = t < PAST ? t : PAST - 1;
#pragma unroll
        for (int hf = 0; hf < 2; ++hf) {
            const bf16x8 bfrag = rowp_frag(rowp, t, 8 * fq + 32 * hf);
            const int ks = 2 * r + hf;
#pragma unroll
            for (int mt = 0; mt < 4; ++mt) acc[mt] = MFMA16(ld8(W1 + (size_t)mt * 16 * 2048 + 32 * ks), bfrag, acc[mt]);
        }
    }
    compress_finish(F, acc, kv, blk, KC, VCT);
}


__device__ __forceinline__ void compress_prompt(Frame& F, int id) {
    const int kv = id & 1, j = (id >> 1) & 31, bg = id >> 6, b = bg >> 2, g = bg & 3;
    RowPPrompt rp{WSP(bf16, WS_KVQ) + (size_t)b * PT * NKVQ + kv * 256 + g * 64};
    compress_tile(F, rp, kv, j, WSP(bf16, WS_KCMP) + (size_t)bg * 512 * 64, WSP(bf16, WS_VCMPT) + (size_t)bg * 64 * 512);
}
constexpr int CP_PART = 81920;
__device__ __forceinline__ void compress_prompt_split(Frame& F, int id) {
    const int kv = id & 1, j = (id >> 1) & 31, bg = id >> 6, b = bg >> 2, g = bg & 3, q = F.wave & 3, lane = F.lane;
    RowPPrompt rp{WSP(bf16, WS_KVQ) + (size_t)b * PT * NKVQ + kv * 256 + g * 64};
    f32x4 acc[4];
    compress_part(F, rp, kv, j, 8 * q, 8 * q + 8, acc);
    LAS f32x4* part = (LAS f32x4*)(F.lds + CP_PART) + (F.wave >> 2) * 1024;
#pragma unroll
    for (int mt = 0; mt < 4; ++mt) part[(q * 4 + mt) * 64 + lane] = acc[mt];
    __syncthreads();
    if (q == 0) {
#pragma unroll
        for (int mt = 0; mt < 4; ++mt) acc[mt] = (part[(0 * 4 + mt) * 64 + lane] + part[(1 * 4 + mt) * 64 + lane]) + (part[(2 * 4 + mt) * 64 + lane] + part[(3 * 4 + mt) * 64 + lane]);
        compress_finish(F, acc, kv, 16 * j + (lane & 15), WSP(bf16, WS_KCMP) + (size_t)bg * 512 * 64, WSP(bf16, WS_VCMPT) + (size_t)bg * 64 * 512);
    }
    __syncthreads();
}
__device__ __forceinline__ void compress_sample(Frame& F, int id) {
    const int kv = id & 1, j = (id >> 1) & 31, bg = id >> 6, lane = F.lane, fr = lane & 15, fq = lane >> 4;
    const int blk = 16 * j + fr, nb = blk < 511 ? blk + 1 : 511;
    const bf16* f1 = WSP(bf16, WS_FS) + ((size_t)bg * 512 + blk) * 256 + kv * 128 + 4 * fq;
    const bf16* f2 = WSP(bf16, WS_FS) + ((size_t)bg * 512 + nb) * 256 + kv * 128 + 64 + 4 * fq;
    f32x4 acc[4];
#pragma unroll
    for (int mt = 0; mt < 4; ++mt) { const v2u a = *(const v2u*)(f1 + 16 * mt), b = *(const v2u*)(f2 + 16 * mt);
        acc[mt] = (f32x4){bflo(a.x) + bflo(b.x), bfhi(a.x) + bfhi(b.x), bflo(a.y) + bflo(b.y), bfhi(a.y) + bfhi(b.y)}; }
    compress_finish(F, acc, kv, blk, WSP(bf16, WS_SKCMP) + (size_t)bg * 512 * 64, WSP(bf16, WS_SVCMPT) + (size_t)bg * 64 * 512);
}

constexpr int NSA_IMP = 0;
constexpr int NSA_Q = 67584;
constexpr int NSA_QLD = 68;
constexpr float LOG2E = 1.4426950408889634f;
#ifndef NSA_SUBUNITS
#define NSA_SUBUNITS 0
#endif
__device__ __forceinline__ float ex2(float x) { return __builtin_amdgcn_exp2f(x); }

struct KvBf16 {
    const bf16* K; const bf16* VT; int ld;
    __device__ __forceinline__ void lane_offsets(int fr, int fq, unsigned& ko, unsigned& vo) const {
        ko = (unsigned)(((8 * (fr >> 2) + (fr & 3)) * 64 + 8 * fq) * 2); vo = (unsigned)((fr * ld + 8 * fq) * 2);
        asm volatile("" : "+v"(ko), "+v"(vo));
    }
    __device__ __forceinline__ bf16x8 kf(int key0, int mt, int ks, unsigned ko) const {
        return *(const bf16x8*)((const char*)K + (size_t)key0 * 128 + (ko + (unsigned)((4 * mt * 64 + 32 * ks) * 2))); }
    __device__ __forceinline__ bf16x8 vf(int key0, int dt, unsigned vo) const {
        return *(const bf16x8*)((const char*)VT + (size_t)key0 * 2 + (vo + (unsigned)(16 * dt * ld * 2))); }
};
struct KvSampleSel {
    const float* cache; const int* pt; const float* snew; int g;
    __device__ __forceinline__ const float* krow(int pos, int slot) const {
        if (pos < PAST) return cache + ((size_t)pt[pos >> 7] * PAGE + (pos & 127)) * 1024 + slot * 256;
        int i = pos - PAST; i = i < 3 ? i : 3; return snew + (size_t)i * 512 + (slot - 2) * 256; }
    __device__ __forceinline__ void lane_offsets(int fr, int fq, unsigned& ko, unsigned& vo) const { ko = (unsigned)(fr | (fq << 8)); vo = ko; asm volatile("" : "+v"(ko), "+v"(vo)); }
    __device__ __forceinline__ bf16x8 kf(int key0, int mt, int ks, unsigned ko) const { const int fr = ko & 255, fq = ko >> 8;
        const float* p = krow(key0 + 8 * (fr >> 2) + 4 * mt + (fr & 3), 2) + 32 * ks + 8 * fq; return cvt8(*(const f32x4*)p, *(const f32x4*)(p + 4)); }
    __device__ __forceinline__ bf16x8 vf(int key0, int dt, unsigned vo) const { const int fr = vo & 255, fq = vo >> 8; f32x4 a, b;
#pragma unroll
        for (int j = 0; j < 4; ++j) { a[j] = krow(key0 + 8 * fq + j, 3)[16 * dt + fr]; b[j] = krow(key0 + 8 * fq + 4 + j, 3)[16 * dt + fr]; }
        return cvt8(a, b); }
};
struct KvFrags { bf16x8 k[2][2]; bf16x8 v[4]; };
template <bool WITHV, class KV>
__device__ __forceinline__ void nsa_load(const KV& kv, int key0, int fr, int fq, KvFrags& f) {
    unsigned ko, vo; kv.lane_offsets(fr, fq, ko, vo);
#pragma unroll
    for (int mt = 0; mt < 2; ++mt)
#pragma unroll
        for (int ks = 0; ks < 2; ++ks) f.k[mt][ks] = kv.kf(key0, mt, ks, ko);
    if (WITHV) {
#pragma unroll
        for (int dt = 0; dt < 4; ++dt) f.v[dt] = kv.vf(key0, dt, vo);
    }
}

template <int NT, int MODE, bool QREG = false>
__device__ __forceinline__ void nsa_core(const KvFrags& f, int key0, const LAS bf16* qrow, int qnt, f32x4 (&O)[NT][4], float (&m)[NT], float (&l)[NT], const float (&invl)[NT], const float (&slope)[NT],
                                         int t, int pmul, int padd, int wlim, bool selok, LAS float* improw, int fq, const bf16x8* qreg = nullptr) {
    float dist[2][4]; bool val[2][4];
#pragma unroll
    for (int mt = 0; mt < 2; ++mt)
#pragma unroll
        for (int r = 0; r < 4; ++r) { const int kk = key0 + 8 * fq + 4 * mt + r; const int dd = t - (pmul * kk + padd); val[mt][r] = selok && dd >= 0 && dd < wlim; dist[mt][r] = val[mt][r] ? (float)dd : 1e6f; }
    float imp_main[2] = {0.f, 0.f}, imp_spill[2] = {0.f, 0.f};
    f32x4 sc[NT][2]; bf16x8 pfr[NT];
    __builtin_amdgcn_s_setprio(1);
#pragma unroll
    for (int nt = 0; nt < NT; ++nt) {
        bf16x8 q0, q1; if (QREG) { q0 = qreg[nt * 2]; q1 = qreg[nt * 2 + 1]; } else { q0 = ld8l(qrow + nt * qnt + 8 * fq); q1 = ld8l(qrow + nt * qnt + 32 + 8 * fq); }
#pragma unroll
        for (int mt = 0; mt < 2; ++mt) { sc[nt][mt] = (f32x4){0.f, 0.f, 0.f, 0.f}; sc[nt][mt] = MFMA16(f.k[mt][0], q0, sc[nt][mt]); sc[nt][mt] = MFMA16(f.k[mt][1], q1, sc[nt][mt]); }
    }
    __builtin_amdgcn_s_setprio(0);
#pragma unroll
    for (int nt = 0; nt < NT; ++nt) {
        f32x4 p[2]; float ps = 0.f;
#pragma unroll
        for (int mt = 0; mt < 2; ++mt)
#pragma unroll
            for (int r = 0; r < 4; ++r) { float pv = ex2(sc[nt][mt][r] - slope[nt] * dist[mt][r]); if (MODE == 2) pv *= invl[nt]; p[mt][r] = pv; ps += pv; }
        if (MODE != 2) l[nt] += ps;
        if (MODE == 2) {
#pragma unroll
            for (int mt = 0; mt < 2; ++mt) { imp_main[mt] += (p[mt][0] + p[mt][1]) + (p[mt][2] + p[mt][3]); imp_spill[mt] += p[mt][3]; }
        }
        if (MODE != 1) pfr[nt] = cvt8(p[0], p[1]);
    }
    if (MODE != 1) {
        __builtin_amdgcn_s_setprio(1);
#pragma unroll
        for (int nt = 0; nt < NT; ++nt)
#pragma unroll
            for (int dt = 0; dt < 4; ++dt) O[nt][dt] = MFMA16(f.v[dt], pfr[nt], O[nt][dt]);
        __builtin_amdgcn_s_setprio(0);
    }
    if (MODE == 2) {
#pragma unroll
        for (int mt = 0; mt < 2; ++mt) { const int j = key0 / 4 + 2 * fq + mt;
            __hip_atomic_fetch_add(improw + j, imp_main[mt], __ATOMIC_RELAXED, __HIP_MEMORY_SCOPE_WORKGROUP);
            __hip_atomic_fetch_add(improw + j + 1, imp_spill[mt], __ATOMIC_RELAXED, __HIP_MEMORY_SCOPE_WORKGROUP); }
    }
}
template <int NT, int MODE, class KV>
__device__ __forceinline__ void nsa_tile(const KV& kv, int key0, const LAS bf16* qrow, int qnt, f32x4 (&O)[NT][4], float (&m)[NT], float (&l)[NT], const float (&invl)[NT], const float (&slope)[NT],
                                         int t, int pmul, int padd, int wlim, bool selok, LAS float* improw, int fr, int fq) {
    KvFrags f; nsa_load<MODE != 1>(kv, key0, fr, fq, f);
    nsa_core<NT, MODE>(f, key0, qrow, qnt, O, m, l, invl, slope, t, pmul, padd, wlim, selok, improw, fq);
}

template <int NT>
__device__ __forceinline__ void nsa_zero(f32x4 (&O)[NT][4], float (&m)[NT], float (&l)[NT]) {
#pragma unroll
    for (int nt = 0; nt < NT; ++nt) { m[nt] = -1e30f; l[nt] = 0.f;
#pragma unroll
        for (int dt = 0; dt < 4; ++dt) O[nt][dt] = (f32x4){0.f, 0.f, 0.f, 0.f}; }
}

template <bool SAMPLE>
__device__ __forceinline__ void nsa_unit(Frame& F, int id) {
    constexpr int NT = SAMPLE ? 1 : 4;
    int lane_ = F.lane; asm volatile("" : "+v"(lane_));
    const int lane = lane_, fr = lane & 15, fq = lane >> 4;
    LAS unsigned char* L = F.lds; asm volatile("" : "+v"(L));
    LAS float* imp = (LAS float*)(L + NSA_IMP + F.wave * 8448);
    LAS bf16* qw = (LAS bf16*)(L + NSA_Q + F.wave * 8704);
    int bg, g, t, row, trow, tmax, row0;
    if (SAMPLE) { bg = id; g = id & 3; t = PAST + (fr >> 2); row0 = MP + (id >> 2) * 4; row = row0 + (fr >> 2); trow = fr >> 2; tmax = PAST + 3; }
    else { bg = id >> 9; g = bg & 3; const int tt = id & 511; t = 16 * tt + fr; row0 = (bg >> 2) * PT + 16 * tt; row = row0 + fr; trow = fr; tmax = 16 * tt + 15; }
    {
        const int nrow = SAMPLE ? 16 : 64;
        for (int i = lane; i < nrow * 8; i += 64) { const int rr = i >> 3, c8 = i & 7;
            *(LAS v4u*)(qw + rr * NSA_QLD + 8 * c8) = *(const v4u*)(WSP(bf16, WS_QN) + (size_t)(row0 + (rr >> 2)) * 1024 + (g * 4 + (rr & 3)) * 64 + 8 * c8); }
    }
    float slope[NT]; int hd[NT];
#pragma unroll
    for (int nt = 0; nt < NT; ++nt) { hd[nt] = g * 4 + (SAMPLE ? (fr & 3) : nt); slope[nt] = ex2(-0.5f * (float)(hd[nt] + 1)) * LOG2E; }
    const LAS bf16* qrow = qw + (SAMPLE ? fr : fr * 4) * NSA_QLD; const int qnt = SAMPLE ? 0 : NSA_QLD;
    const float* gates = WSP(float, WS_GATES) + (size_t)row * 48;
    float* oacc = WSP(float, WS_OACC) + (size_t)row * 1024;
    for (int i = lane; i < 16 * 132; i += 64) imp[i] = 0.f;
    LDS_WAIT();
    f32x4 O[NT][4]; float m[NT], l[NT], invl[NT];
    {
        KvBf16 kv{WSP(bf16, SAMPLE ? WS_SKCMP : WS_KCMP) + (size_t)bg * 512 * 64, WSP(bf16, SAMPLE ? WS_SVCMPT : WS_VCMPT) + (size_t)bg * 64 * 512, 512};
        const int cmax = (tmax - 31) >> 4;
        const int ntile = (tmax >= 31) ? ((cmax < 510 ? cmax : 510) / 32 + 1) : 0;
#pragma unroll
        for (int nt = 0; nt < NT; ++nt) invl[nt] = 0.f;
        nsa_zero<NT>(O, m, l);
        { KvFrags fa, fb; if (ntile > 0) nsa_load<false>(kv, 0, fr, fq, fa);
#pragma unroll 1
          for (int tl = 0; tl < ntile; ++tl) { if (tl + 1 < ntile) nsa_load<false>(kv, 32 * (tl + 1), fr, fq, fb);
            nsa_core<NT, 1>(fa, 32 * tl, qrow, qnt, O, m, l, invl, slope, t, 16, 31, 1 << 30, true, imp + trow * 132, fq); fa = fb; } }
#pragma unroll
        for (int nt = 0; nt < NT; ++nt) { float lt = l[nt]; lt = x32_sum(x16_sum(lt)); invl[nt] = lt > 0.f ? 1.f / lt : 0.f; }
        { KvFrags fa, fb; if (ntile > 0) nsa_load<true>(kv, 0, fr, fq, fa);
#pragma unroll 1
          for (int tl = 0; tl < ntile; ++tl) { if (tl + 1 < ntile) nsa_load<true>(kv, 32 * (tl + 1), fr, fq, fb);
            nsa_core<NT, 2>(fa, 32 * tl, qrow, qnt, O, m, l, invl, slope, t, 16, 31, 1 << 30, true, imp + trow * 132, fq); fa = fb; } }
#pragma unroll
        for (int nt = 0; nt < NT; ++nt) { const float gc = gates[0 * 16 + hd[nt]];
#pragma unroll
            for (int dt = 0; dt < 4; ++dt) *(f32x4*)(oacc + hd[nt] * 64 + 16 * dt + 4 * fq) = O[nt][dt] * gc; }
    }
    LDS_WAIT();
    unsigned selm[4] = {0u, 0u, 0u, 0u};
    {
        const int cur = t >> 6;
        if (!SAMPLE) {
            unsigned v[32];
#pragma unroll
            for (int i = 0; i < 32; ++i) { const int j = 32 * fq + i; const bool forced = (j == 0) | (j == cur) | (j == cur - 1);
                const unsigned key = ((f2u(imp[trow * 132 + j]) & ~127u) | (unsigned)(127 - j)) + 128u;
                v[i] = (!forced && j <= cur) ? key : 0u;
                if (forced) selm[fq] |= 1u << i; }
            unsigned fw = selm[0] | selm[1] | selm[2] | selm[3];
            const unsigned w16 = __shfl_xor(fw, 16), w32 = __shfl_xor(fw, 32), w48 = __shfl_xor(fw, 48);
#pragma unroll
            for (int wd = 0; wd < 4; ++wd) selm[wd] = (fq == wd) ? fw : ((fq ^ 1) == wd) ? w16 : ((fq ^ 2) == wd) ? w32 : w48;
            const int nforced = cur >= 2 ? 3 : cur + 1;
#pragma unroll 1
            for (int rd = 0; rd < 15; ++rd) {
                unsigned mx = v[0];
#pragma unroll
                for (int i = 1; i < 32; ++i) mx = mx > v[i] ? mx : v[i];
                mx = x32_umax(x16_umax(mx));
#pragma unroll
                for (int i = 0; i < 32; ++i) v[i] = (v[i] == mx) ? 0u : v[i];
                if (mx != 0u && rd < 16 - nforced) { const int js = 127 - (int)(mx & 127u);
#pragma unroll
                    for (int wd = 0; wd < 4; ++wd) selm[wd] |= ((js >> 5) == wd) ? (1u << (js & 31)) : 0u; }
            }
        } else {
            const int li = (fr & 3) * 4 + fq;
            unsigned v[8];
#pragma unroll
            for (int i = 0; i < 8; ++i) { const int j = li * 8 + i; v[i] = (j >= 1 && j <= 126) ? (((f2u(imp[trow * 132 + j]) & ~127u) | (unsigned)(127 - j)) + 128u) : 0u; }
            selm[0] = 1u; selm[3] = 1u << 31;
#pragma unroll 1
            for (int rd = 0; rd < 13; ++rd) {
                unsigned mx = v[0];
#pragma unroll
                for (int i = 1; i < 8; ++i) mx = mx > v[i] ? mx : v[i];
                { unsigned o = dpp_u<DPP_XOR1>(mx); mx = mx > o ? mx : o; o = dpp_u<DPP_XOR2>(mx); mx = mx > o ? mx : o; mx = x32_umax(x16_umax(mx)); }
#pragma unroll
                for (int i = 0; i < 8; ++i) v[i] = (v[i] == mx) ? 0u : v[i];
                if (mx != 0u) { const int js = 127 - (int)(mx & 127u);
#pragma unroll
                    for (int wd = 0; wd < 4; ++wd) selm[wd] |= ((js >> 5) == wd) ? (1u << (js & 31)) : 0u; }
            }
        }
    }
    if (SAMPLE || !NSA_SUBUNITS) {
        nsa_zero<NT>(O, m, l);
        unsigned un[4];
#pragma unroll
        for (int wd = 0; wd < 4; ++wd) { unsigned x = selm[wd]; x |= __shfl_xor(x, 1); x |= __shfl_xor(x, 2); x |= __shfl_xor(x, 4); x |= __shfl_xor(x, 8); un[wd] = (unsigned)__builtin_amdgcn_readfirstlane((int)x); }
        KvSampleSel kvs{FIN(2) + g * 64, (const int*)FIN(6) + (SAMPLE ? (id >> 2) : 0) * NPAGES, WSP(float, WS_SNEW) + (size_t)(SAMPLE ? (id >> 2) : 0) * 2048 + g * 64, g};
        KvBf16 kvp{WSP(bf16, WS_KSEL) + (size_t)bg * PT * 64, WSP(bf16, WS_VSELT) + (size_t)bg * 64 * PT, PT};
        if (SAMPLE) {
#pragma unroll 1
        for (int wd = 0; wd < 4; ++wd) {
            unsigned mm = un[wd];
            const unsigned mine = wd == 0 ? selm[0] : wd == 1 ? selm[1] : wd == 2 ? selm[2] : selm[3];
            while (mm) {
                const int bit = __builtin_ctz(mm); mm &= mm - 1u; const int j = 32 * wd + bit;
                const bool ok = (mine >> bit) & 1u;
#pragma unroll 1
                for (int hh = 0; hh < 2; ++hh) { nsa_tile<NT, 0>(kvs, 64 * j + 32 * hh, qrow, qnt, O, m, l, invl, slope, t, 1, 0, 1 << 30, ok, imp, fr, fq); __builtin_amdgcn_sched_barrier(0); }
            }
        }
        } else {
            int wdc = 0; unsigned mmc = un[0];
            while (wdc < 3 && mmc == 0u) { ++wdc; mmc = wdc == 1 ? un[1] : wdc == 2 ? un[2] : un[3]; }
            KvFrags fa, fb; int jc = -1, hc = 0;
            if (mmc) { jc = 32 * wdc + __builtin_ctz(mmc); mmc &= mmc - 1u; nsa_load<true>(kvp, 64 * jc, fr, fq, fa); }
#pragma unroll 1
            while (jc >= 0) {
                int jn = jc, hn = hc + 1;
                if (hn == 2) { hn = 0;
                    while (wdc < 3 && mmc == 0u) { ++wdc; mmc = wdc == 1 ? un[1] : wdc == 2 ? un[2] : un[3]; }
                    if (mmc) { jn = 32 * wdc + __builtin_ctz(mmc); mmc &= mmc - 1u; } else jn = -1; }
                if (jn >= 0) nsa_load<true>(kvp, 64 * jn + 32 * hn, fr, fq, fb);
                const int wj = jc >> 5, bj = jc & 31;
                const unsigned mine = wj == 0 ? selm[0] : wj == 1 ? selm[1] : wj == 2 ? selm[2] : selm[3];
                nsa_core<NT, 0>(fa, 64 * jc + 32 * hc, qrow, qnt, O, m, l, invl, slope, t, 1, 0, 1 << 30, (mine >> bj) & 1u, imp, fq);
                fa = fb; jc = jn; hc = hn;
            }
        }
        if (SAMPLE) nsa_tile<NT, 0>(kvs, 64 * 128, qrow, qnt, O, m, l, invl, slope, t, 1, 0, 1 << 30, true, imp, fr, fq);
#pragma unroll
        for (int nt = 0; nt < NT; ++nt) { float lt = l[nt]; lt = x32_sum(x16_sum(lt)); const float sc = gates[1 * 16 + hd[nt]] / fmaxf(lt, 1e-30f);
#pragma unroll
            for (int dt = 0; dt < 4; ++dt) { f32x4* o = (f32x4*)(oacc + hd[nt] * 64 + 16 * dt + 4 * fq); *o = *o + O[nt][dt] * sc; } }
    } else {
        unsigned ms[4][4];
#pragma unroll
        for (int s = 0; s < 4; ++s)
#pragma unroll
            for (int wd = 0; wd < 4; ++wd) ms[s][wd] = __shfl(selm[wd], 4 * s + (fr >> 2));
        unsigned su[4][4], un[4];
#pragma unroll
        for (int wd = 0; wd < 4; ++wd) { un[wd] = 0u;
#pragma unroll
            for (int s = 0; s < 4; ++s) { unsigned x = ms[s][wd]; x |= __shfl_xor(x, 4); x |= __shfl_xor(x, 8); su[s][wd] = (unsigned)__builtin_amdgcn_readfirstlane((int)x); un[wd] |= su[s][wd]; } }
        const int hds = g * 4 + (fr & 3); float slp[1]; slp[0] = ex2(-0.5f * (float)(hds + 1)) * LOG2E;
        const int tb = (id & 511) * 16 + (fr >> 2);
        f32x4 Os[4][1][4]; float mS[4][1], lS[4][1]; float inv1[1] = {0.f};
#pragma unroll
        for (int s = 0; s < 4; ++s) nsa_zero<1>(Os[s], mS[s], lS[s]);
        KvBf16 kvp{WSP(bf16, WS_KSEL) + (size_t)bg * PT * 64, WSP(bf16, WS_VSELT) + (size_t)bg * 64 * PT, PT};
        int wdc = 0; unsigned mmc = un[0];
        while (wdc < 3 && mmc == 0u) { ++wdc; mmc = wdc == 1 ? un[1] : wdc == 2 ? un[2] : un[3]; }
        KvFrags fa, fb;
        int jc = -1, hc = 0;
        if (mmc) { jc = 32 * wdc + __builtin_ctz(mmc); mmc &= mmc - 1u; nsa_load<true>(kvp, 64 * jc, fr, fq, fa); }
#pragma unroll 1
        while (jc >= 0) {
            int jn = jc, hn = hc + 1;
            if (hn == 2) { hn = 0;
                while (wdc < 3 && mmc == 0u) { ++wdc; mmc = wdc == 1 ? un[1] : wdc == 2 ? un[2] : un[3]; }
                if (mmc) { jn = 32 * wdc + __builtin_ctz(mmc); mmc &= mmc - 1u; } else jn = -1; }
            if (jn >= 0) nsa_load<true>(kvp, 64 * jn + 32 * hn, fr, fq, fb);
            const int wj = jc >> 5, bj = jc & 31;
#pragma unroll
            for (int s = 0; s < 4; ++s) {
                const unsigned suw = wj == 0 ? su[s][0] : wj == 1 ? su[s][1] : wj == 2 ? su[s][2] : su[s][3];
                if ((suw >> bj) & 1u) {
                    const unsigned mw = wj == 0 ? ms[s][0] : wj == 1 ? ms[s][1] : wj == 2 ? ms[s][2] : ms[s][3];
                    nsa_core<1, 0>(fa, 64 * jc + 32 * hc, qw + (16 * s + fr) * NSA_QLD, 0, Os[s], mS[s], lS[s], inv1, slp, tb + 4 * s, 1, 0, 1 << 30, (mw >> bj) & 1u, imp, fq);
                }
            }
            fa = fb; jc = jn; hc = hn;
        }
#pragma unroll
        for (int s = 0; s < 4; ++s) { float lt = lS[s][0]; lt = x32_sum(x16_sum(lt));
            const size_t rs = (size_t)(row0 + 4 * s + (fr >> 2));
            const float sc = WSP(float, WS_GATES)[rs * 48 + 16 + hds] / fmaxf(lt, 1e-30f);
#pragma unroll
            for (int dt = 0; dt < 4; ++dt) { f32x4* o = (f32x4*)(WSP(float, WS_OACC) + rs * 1024 + hds * 64 + 16 * dt + 4 * fq); *o = *o + Os[s][0][dt] * sc; } }
    }
    {
        nsa_zero<NT>(O, m, l);
        KvBf16 kv = SAMPLE ? KvBf16{WSP(bf16, WS_SKWIN) + (size_t)bg * 544 * 64, WSP(bf16, WS_SVWINT) + (size_t)bg * 64 * 544, 544}
                           : KvBf16{WSP(bf16, WS_KWIN) + (size_t)bg * PT * 64, WSP(bf16, WS_VWINT) + (size_t)bg * 64 * PT, PT};
        int k0, k1, padd;
        if (SAMPLE) { k0 = 0; k1 = 544; padd = PAST - WINDOW; }
        else { const int lo = tmax - 15 - (WINDOW - 1); k0 = (lo > 0 ? lo : 0) & ~31; k1 = tmax + 1; padd = 0; }
        { KvFrags fa, fb; nsa_load<true>(kv, k0, fr, fq, fa);
#pragma unroll 1
          for (int kk = k0; kk < k1; kk += 32) { if (kk + 32 < k1) nsa_load<true>(kv, kk + 32, fr, fq, fb);
            nsa_core<NT, 0>(fa, kk, qrow, qnt, O, m, l, invl, slope, t, 1, padd, WINDOW, true, imp, fq); fa = fb; } }
        bf16* on = WSP(bf16, WS_OG) + (size_t)row * 1024;
#pragma unroll
        for (int nt = 0; nt < NT; ++nt) { float lt = l[nt]; lt = x32_sum(x16_sum(lt)); const float sc = gates[2 * 16 + hd[nt]] / fmaxf(lt, 1e-30f);
#pragma unroll
            for (int dt = 0; dt < 4; ++dt) { const f32x4 o = *(const f32x4*)(oacc + hd[nt] * 64 + 16 * dt + 4 * fq) + O[nt][dt] * sc;
                *(v2u*)(on + hd[nt] * 64 + 16 * dt + 4 * fq) = (v2u){pk2(o[0], o[1]), pk2(o[2], o[3])}; } }
    }
}

constexpr int NW_STG = 67584;
constexpr int NW_STG_BYTES = 18432;
constexpr int NW_UN = NW_STG + 2 * NW_STG_BYTES;
struct NwStage { v4u k, v; };
__device__ __forceinline__ void nw_load(const bf16* K, const bf16* VT, int ld, int key0, int tid, NwStage& s) {
    s.k = *(const v4u*)(K + (size_t)(key0 + (tid >> 3)) * 64 + 8 * (tid & 7));
    s.v = *(const v4u*)(VT + (size_t)(tid >> 3) * ld + key0 + 8 * (tid & 7));
}
__device__ __forceinline__ void nw_store(LAS unsigned char* buf, int tid, const NwStage& s) {
    const int kk = tid >> 3, c8 = tid & 7, k32 = kk & 31;
    const int rho = 32 * (kk >> 5) + 16 * ((k32 >> 2) & 1) + 4 * (k32 >> 3) + (k32 & 3);
    *(LAS v4u*)(buf + rho * 144 + c8 * 16) = s.k;
    *(LAS v4u*)(buf + 9216 + kk * 144 + c8 * 16) = s.v;
}
template <bool WITHV>
__device__ __forceinline__ void nw_frags(const LAS unsigned char* buf, int th, int fr, int fq, KvFrags& f) {
#pragma unroll
    for (int mt = 0; mt < 2; ++mt)
#pragma unroll
        for (int ks = 0; ks < 2; ++ks) f.k[mt][ks] = *(const LAS bf16x8*)(buf + (32 * th + 16 * mt + fr) * 144 + (32 * ks + 8 * fq) * 2);
    if (WITHV) {
#pragma unroll
        for (int dt = 0; dt < 4; ++dt) f.v[dt] = *(const LAS bf16x8*)(buf + 9216 + (16 * dt + fr) * 144 + (32 * th + 8 * fq) * 2);
    }
}
#define NW_PIPE(Kp, VTp, ldv, NB, BLK, BODY) do { const int nb_ = (NB); \
        if (nb_ > 0) { NwStage st_; nw_load(Kp, VTp, ldv, BLK(0), F.tid, st_); nw_store(stg, F.tid, st_); } \
        __syncthreads(); \
        _Pragma("unroll 1") for (int ib_ = 0; ib_ < nb_; ++ib_) { \
            NwStage st_; const bool more_ = ib_ + 1 < nb_; if (more_) nw_load(Kp, VTp, ldv, BLK(ib_ + 1), F.tid, st_); \
            const LAS unsigned char* buf_ = stg + (ib_ & 1) * NW_STG_BYTES; const int key0_ = BLK(ib_); \
            BODY(buf_, key0_) \
            if (more_) nw_store(stg + ((ib_ + 1) & 1) * NW_STG_BYTES, F.tid, st_); \
            __syncthreads(); } } while (0)

__device__ __forceinline__ void nsa_wg(Frame& F, int bg, int qb) {
    int lane_ = F.lane; asm volatile("" : "+v"(lane_));
    const int lane = lane_, fr = lane & 15, fq = lane >> 4, w = F.wave, g = bg & 3;
    LAS unsigned char* L = F.lds; asm volatile("" : "+v"(L));
    LAS float* imp = (LAS float*)(L + NSA_IMP + w * 8448);
    LAS unsigned char* stg = L + NW_STG;
    LAS unsigned* wun = (LAS unsigned*)(L + NW_UN); volatile LAS unsigned char* blist = (volatile LAS unsigned char*)(L + NW_UN + 16);
    const int tt = qb * 8 + w, t = 16 * tt + fr, row0 = (bg >> 2) * PT + 16 * tt, row = row0 + fr, tw0 = 16 * tt, tw1 = tw0 + 15;
    float slope[4]; bf16x8 qreg[8];
#pragma unroll
    for (int nt = 0; nt < 4; ++nt) { slope[nt] = ex2(-0.5f * (float)(g * 4 + nt + 1)) * LOG2E;
        const bf16* qp = WSP(bf16, WS_QN) + (size_t)row * 1024 + (g * 4 + nt) * 64 + 8 * fq; qreg[2 * nt] = ld8(qp); qreg[2 * nt + 1] = ld8(qp + 32); }
    const float* gates = WSP(float, WS_GATES) + (size_t)row * 48;
    float* oacc = WSP(float, WS_OACC) + (size_t)row * 1024;
    for (int i = lane; i < 16 * 132; i += 64) imp[i] = 0.f;
    if (F.tid < 4) wun[F.tid] = 0u;
    f32x4 O[4][4]; float m[4], l[4], invl[4];
    {
        const bf16* Kc = WSP(bf16, WS_KCMP) + (size_t)bg * 512 * 64; const bf16* Vc = WSP(bf16, WS_VCMPT) + (size_t)bg * 64 * 512;
        const int cmax = (128 * qb + 127 - 31) >> 4, ncb = (cmax < 510 ? cmax : 510) / 64 + 1;
#pragma unroll
        for (int nt = 0; nt < 4; ++nt) invl[nt] = 0.f;
        nsa_zero<4>(O, m, l);
#define NW_BLK(i) (64 * (i))
#define NW_CMP1(buf, k0) { _Pragma("unroll 1") for (int th = 0; th < 2; ++th) if (16 * ((k0) + 32 * th) + 31 <= tw1) { KvFrags f; nw_frags<false>(buf, th, fr, fq, f); \
            nsa_core<4, 1, true>(f, (k0) + 32 * th, nullptr, 0, O, m, l, invl, slope, t, 16, 31, 1 << 30, true, imp + fr * 132, fq, qreg); } }
        NW_PIPE(Kc, Vc, 512, ncb, NW_BLK, NW_CMP1);
#pragma unroll
        for (int nt = 0; nt < 4; ++nt) { const float lt = x32_sum(x16_sum(l[nt])); invl[nt] = lt > 0.f ? 1.f / lt : 0.f; }
#define NW_CMP2(buf, k0) { _Pragma("unroll 1") for (int th = 0; th < 2; ++th) if (16 * ((k0) + 32 * th) + 31 <= tw1) { KvFrags f; nw_frags<true>(buf, th, fr, fq, f); \
            nsa_core<4, 2, true>(f, (k0) + 32 * th, nullptr, 0, O, m, l, invl, slope, t, 16, 31, 1 << 30, true, imp + fr * 132, fq, qreg); } }
        NW_PIPE(Kc, Vc, 512, ncb, NW_BLK, NW_CMP2);
#pragma unroll
        for (int nt = 0; nt < 4; ++nt) { const float gc = gates[0 * 16 + g * 4 + nt];
#pragma unroll
            for (int dt = 0; dt < 4; ++dt) *(f32x4*)(oacc + (g * 4 + nt) * 64 + 16 * dt + 4 * fq) = O[nt][dt] * gc; }
    }
    LDS_WAIT();
    unsigned selm[4] = {0u, 0u, 0u, 0u};
    {
        const int cur = t >> 6;
        unsigned v[32];
#pragma unroll
        for (int i = 0; i < 32; ++i) { const int j = 32 * fq + i; const bool forced = (j == 0) | (j == cur) | (j == cur - 1);
            const unsigned key = ((f2u(imp[fr * 132 + j]) & ~127u) | (unsigned)(127 - j)) + 128u;
            v[i] = (!forced && j <= cur) ? key : 0u;
            if (forced) selm[fq] |= 1u << i; }
        unsigned fw = selm[0] | selm[1] | selm[2] | selm[3];
        const unsigned w16 = __shfl_xor(fw, 16), w32 = __shfl_xor(fw, 32), w48 = __shfl_xor(fw, 48);
#pragma unroll
        for (int wd = 0; wd < 4; ++wd) selm[wd] = (fq == wd) ? fw : ((fq ^ 1) == wd) ? w16 : ((fq ^ 2) == wd) ? w32 : w48;
        const int nforced = cur >= 2 ? 3 : cur + 1;
#pragma unroll 1
        for (int rd = 0; rd < 15; ++rd) {
            unsigned mx = v[0];
#pragma unroll
            for (int i = 1; i < 32; ++i) mx = mx > v[i] ? mx : v[i];
            mx = x32_umax(x16_umax(mx));
#pragma unroll
            for (int i = 0; i < 32; ++i) v[i] = (v[i] == mx) ? 0u : v[i];
            if (mx != 0u && rd < 16 - nforced) { const int js = 127 - (int)(mx & 127u);
#pragma unroll
                for (int wd = 0; wd < 4; ++wd) selm[wd] |= ((js >> 5) == wd) ? (1u << (js & 31)) : 0u; }
        }
    }
    unsigned un[4];
#pragma unroll
    for (int wd = 0; wd < 4; ++wd) { unsigned x = selm[wd]; x |= dpp_u<DPP_XOR1>(x); x |= dpp_u<DPP_XOR2>(x); x |= dpp_u<DPP_HMIR>(x); x |= dpp_u<DPP_MIR>(x); un[wd] = (unsigned)__builtin_amdgcn_readfirstlane((int)x); }
    if (lane < 4) __hip_atomic_fetch_or(wun + lane, lane == 0 ? un[0] : lane == 1 ? un[1] : lane == 2 ? un[2] : un[3], __ATOMIC_RELAXED, __HIP_MEMORY_SCOPE_WORKGROUP);
    __syncthreads();
    unsigned wu[4];
#pragma unroll
    for (int wd = 0; wd < 4; ++wd) wu[wd] = (unsigned)__builtin_amdgcn_readfirstlane((int)wun[wd]);
    {
        nsa_zero<4>(O, m, l);
        const bf16* Ks = WSP(bf16, WS_KSEL) + (size_t)bg * PT * 64; const bf16* Vs = WSP(bf16, WS_VSELT) + (size_t)bg * 64 * PT;
        const int nsb = __builtin_popcount(wu[0]) + __builtin_popcount(wu[1]) + __builtin_popcount(wu[2]) + __builtin_popcount(wu[3]);
        if (F.tid < 128) { const int j = F.tid, wj = j >> 5, bj = j & 31; const unsigned ww = wj == 0 ? wu[0] : wj == 1 ? wu[1] : wj == 2 ? wu[2] : wu[3];
            if ((ww >> bj) & 1u) { int pos = __builtin_popcount(ww & ((1u << bj) - 1u)); if (wj > 0) pos += __builtin_popcount(wu[0]); if (wj > 1) pos += __builtin_popcount(wu[1]); if (wj > 2) pos += __builtin_popcount(wu[2]);
                blist[pos] = (unsigned char)j; } }
        __syncthreads();
#define NW_SBLK(i) (64 * (int)blist[(i)])
#define NW_SEL(buf, k0) { const int j_ = (k0) >> 6, wj_ = j_ >> 5, bj_ = j_ & 31; const unsigned uw_ = wj_ == 0 ? un[0] : wj_ == 1 ? un[1] : wj_ == 2 ? un[2] : un[3]; \
            if ((uw_ >> bj_) & 1u) { const unsigned mine_ = wj_ == 0 ? selm[0] : wj_ == 1 ? selm[1] : wj_ == 2 ? selm[2] : selm[3]; const bool ok_ = (mine_ >> bj_) & 1u; \
                _Pragma("unroll 1") for (int th = 0; th < 2; ++th) { KvFrags f; nw_frags<true>(buf, th, fr, fq, f); \
                    nsa_core<4, 0, true>(f, (k0) + 32 * th, nullptr, 0, O, m, l, invl, slope, t, 1, 0, 1 << 30, ok_, imp, fq, qreg); } } }
        NW_PIPE(Ks, Vs, PT, nsb, NW_SBLK, NW_SEL);
#pragma unroll
        for (int nt = 0; nt < 4; ++nt) { const float lt = x32_sum(x16_sum(l[nt])); const float sc = gates[1 * 16 + g * 4 + nt] / fmaxf(lt, 1e-30f);
#pragma unroll
            for (int dt = 0; dt < 4; ++dt) { f32x4* o = (f32x4*)(oacc + (g * 4 + nt) * 64 + 16 * dt + 4 * fq); *o = *o + O[nt][dt] * sc; } }
    }
    {
        nsa_zero<4>(O, m, l);
        const bf16* Kw = WSP(bf16, WS_KWIN) + (size_t)bg * PT * 64; const bf16* Vw = WSP(bf16, WS_VWINT) + (size_t)bg * 64 * PT;
        const int lo = 128 * qb - (WINDOW - 1), kb0 = (lo > 0 ? lo : 0) >> 6, kb1 = (128 * qb + 127) >> 6, nwb = kb1 - kb0 + 1;
#define NW_WBLK(i) (64 * (kb0 + (i)))
#define NW_WIN(buf, k0) { _Pragma("unroll 1") for (int th = 0; th < 2; ++th) { const int kk_ = (k0) + 32 * th; if (kk_ <= tw1 && kk_ + 31 >= tw0 - (WINDOW - 1)) { KvFrags f; nw_frags<true>(buf, th, fr, fq, f); \
                nsa_core<4, 0, true>(f, kk_, nullptr, 0, O, m, l, invl, slope, t, 1, 0, WINDOW, true, imp, fq, qreg); } } }
        NW_PIPE(Kw, Vw, PT, nwb, NW_WBLK, NW_WIN);
        bf16* on = WSP(bf16, WS_OG) + (size_t)row * 1024;
#pragma unroll
        for (int nt = 0; nt < 4; ++nt) { const float lt = x32_sum(x16_sum(l[nt])); const float sc = gates[2 * 16 + g * 4 + nt] / fmaxf(lt, 1e-30f);
#pragma unroll
            for (int dt = 0; dt < 4; ++dt) { const f32x4 o = *(const f32x4*)(oacc + (g * 4 + nt) * 64 + 16 * dt + 4 * fq) + O[nt][dt] * sc;
                *(v2u*)(on + (g * 4 + nt) * 64 + 16 * dt + 4 * fq) = (v2u){pk2(o[0], o[1]), pk2(o[2], o[3])}; } }
    }
    __syncthreads();
}

constexpr int SW_Q = 0;
constexpr int SW_IMPP = 2304;
constexpr int SW_IMPT = SW_IMPP + 8 * 2112;
constexpr int SW_LP = SW_IMPT + 2112;
constexpr int SW_OP = SW_LP + 3 * 8 * 16 * 4;
static_assert(SW_OP + 8 * 3 * 16 * 64 * 4 <= RING_BYTES, "sample NSA LDS map");
__device__ __forceinline__ void nsa_sample_wg(Frame& F, int id) {
    int lane_ = F.lane; asm volatile("" : "+v"(lane_));
    const int lane = lane_, fr = lane & 15, fq = lane >> 4, w = F.wave, g = id & 3, bs = id >> 2;
    LAS unsigned char* L = F.lds; asm volatile("" : "+v"(L));
    LAS bf16* qw = (LAS bf16*)(L + SW_Q);
    LAS float* impP = (LAS float*)(L + SW_IMPP) + w * 528; LAS float* impT = (LAS float*)(L + SW_IMPT);
    LAS float* LP = (LAS float*)(L + SW_LP); LAS float* OP = (LAS float*)(L + SW_OP);
    const int t = PAST + (fr >> 2), row0 = MP + bs * 4, trow = fr >> 2, hd = g * 4 + (fr & 3);
    if (F.tid < 128) { const int rr = F.tid >> 3, c8 = F.tid & 7;
        *(LAS v4u*)(qw + rr * NSA_QLD + 8 * c8) = *(const v4u*)(WSP(bf16, WS_QN) + (size_t)(row0 + (rr >> 2)) * 1024 + (g * 4 + (rr & 3)) * 64 + 8 * c8); }
    for (int i = lane; i < 528; i += 64) impP[i] = 0.f;
    __syncthreads();
    float slope[1] = {ex2(-0.5f * (float)(hd + 1)) * LOG2E};
    const LAS bf16* qrow = qw + fr * NSA_QLD;
    f32x4 O[1][4]; float m[1], l[1], invl[1] = {0.f};
#define SW_PUT_O(br) { _Pragma("unroll") for (int dt = 0; dt < 4; ++dt) *(LAS f32x4*)(OP + ((w * 3 + (br)) * 16 + fr) * 64 + 16 * dt + 4 * fq) = O[0][dt]; }
#define SW_PUT_L(br) { const float lt_ = x32_sum(x16_sum(l[0])); if (fq == 0) LP[((br) * 8 + w) * 16 + fr] = lt_; }
    {
        KvBf16 kv{WSP(bf16, WS_SKCMP) + (size_t)id * 512 * 64, WSP(bf16, WS_SVCMPT) + (size_t)id * 64 * 512, 512};
        nsa_zero<1>(O, m, l);
#pragma unroll 1
        for (int tl = w; tl < 16; tl += 8) nsa_tile<1, 1>(kv, 32 * tl, qrow, 0, O, m, l, invl, slope, t, 16, 31, 1 << 30, true, impP + trow * 132, fr, fq);
        SW_PUT_L(0)
        __syncthreads();
        { float lt = 0.f;
#pragma unroll
          for (int ww = 0; ww < 8; ++ww) lt += LP[(0 * 8 + ww) * 16 + fr];
          invl[0] = lt > 0.f ? 1.f / lt : 0.f; }
#pragma unroll 1
        for (int tl = w; tl < 16; tl += 8) nsa_tile<1, 2>(kv, 32 * tl, qrow, 0, O, m, l, invl, slope, t, 16, 31, 1 << 30, true, impP + trow * 132, fr, fq);
        SW_PUT_O(0)
    }
    __syncthreads();
    for (int i = F.tid; i < 528; i += 512) { float s = 0.f;
#pragma unroll
        for (int ww = 0; ww < 8; ++ww) s += ((LAS float*)(L + SW_IMPP))[ww * 528 + i];
        impT[i] = s; }
    __syncthreads();
    unsigned selm[4] = {1u, 0u, 0u, 1u << 31};
    {
        const int li = (fr & 3) * 4 + fq;
        unsigned v[8];
#pragma unroll
        for (int i = 0; i < 8; ++i) { const int j = li * 8 + i; v[i] = (j >= 1 && j <= 126) ? (((f2u(impT[trow * 132 + j]) & ~127u) | (unsigned)(127 - j)) + 128u) : 0u; }
#pragma unroll 1
        for (int rd = 0; rd < 13; ++rd) {
            unsigned mx = v[0];
#pragma unroll
            for (int i = 1; i < 8; ++i) mx = mx > v[i] ? mx : v[i];
            { unsigned o = dpp_u<DPP_XOR1>(mx); mx = mx > o ? mx : o; o = dpp_u<DPP_XOR2>(mx); mx = mx > o ? mx : o; mx = x32_umax(x16_umax(mx)); }
#pragma unroll
            for (int i = 0; i < 8; ++i) v[i] = (v[i] == mx) ? 0u : v[i];
            if (mx != 0u) { const int js = 127 - (int)(mx & 127u);
#pragma unroll
                for (int wd = 0; wd < 4; ++wd) selm[wd] |= ((js >> 5) == wd) ? (1u << (js & 31)) : 0u; }
        }
    }
    {
        nsa_zero<1>(O, m, l);
        unsigned un[4];
#pragma unroll
        for (int wd = 0; wd < 4; ++wd) { unsigned x = selm[wd]; x |= dpp_u<DPP_XOR1>(x); x |= dpp_u<DPP_XOR2>(x); x |= dpp_u<DPP_HMIR>(x); x |= dpp_u<DPP_MIR>(x); un[wd] = (unsigned)__builtin_amdgcn_readfirstlane((int)x); }
        KvSampleSel kvs{FIN(2) + g * 64, (const int*)FIN(6) + bs * NPAGES, WSP(float, WS_SNEW) + (size_t)bs * 2048 + g * 64, g};
        int q = 0;
#pragma unroll 1
        for (int wd = 0; wd < 4; ++wd) {
            unsigned mm = un[wd];
            const unsigned mine = wd == 0 ? selm[0] : wd == 1 ? selm[1] : wd == 2 ? selm[2] : selm[3];
            while (mm) {
                const int bit = __builtin_ctz(mm); mm &= mm - 1u; const int j = 32 * wd + bit;
                const bool ok = (mine >> bit) & 1u;
#pragma unroll 1
                for (int hh = 0; hh < 2; ++hh, ++q) if ((q & 7) == w) { nsa_tile<1, 0>(kvs, 64 * j + 32 * hh, qrow, 0, O, m, l, invl, slope, t, 1, 0, 1 << 30, ok, impP, fr, fq); __builtin_amdgcn_sched_barrier(0); }
            }
        }
        if ((q & 7) == w) nsa_tile<1, 0>(kvs, 64 * 128, qrow, 0, O, m, l, invl, slope, t, 1, 0, 1 << 30, true, impP, fr, fq);
        SW_PUT_O(1) SW_PUT_L(1)
    }
    {
        nsa_zero<1>(O, m, l);
        KvBf16 kv{WSP(bf16, WS_SKWIN) + (size_t)id * 544 * 64, WSP(bf16, WS_SVWINT) + (size_t)id * 64 * 544, 544};
#pragma unroll 1
        for (int kk = 32 * w; kk < 544; kk += 256) nsa_tile<1, 0>(kv, kk, qrow, 0, O, m, l, invl, slope, t, 1, PAST - WINDOW, WINDOW, true, impP, fr, fq);
        SW_PUT_O(2) SW_PUT_L(2)
    }
    __syncthreads();
    {
        const int r = F.tid >> 5, d0 = (F.tid & 31) * 2, rowg = row0 + (r >> 2), hdr = g * 4 + (r & 3);
        float o0 = 0.f, o1 = 0.f;
#pragma unroll
        for (int br = 0; br < 3; ++br) { float a0 = 0.f, a1 = 0.f, lt = 0.f;
#pragma unroll
            for (int ww = 0; ww < 8; ++ww) { const f32x2 x = *(const LAS f32x2*)(OP + ((ww * 3 + br) * 16 + r) * 64 + d0); a0 += x.x; a1 += x.y; if (br > 0) lt += LP[(br * 8 + ww) * 16 + r]; }
            const float sc = WSP(float, WS_GATES)[(size_t)rowg * 48 + br * 16 + hdr] * (br == 0 ? 1.f : 1.f / fmaxf(lt, 1e-30f));
            o0 += a0 * sc; o1 += a1 * sc; }
        *(unsigned*)(WSP(bf16, WS_OG) + (size_t)rowg * 1024 + hdr * 64 + d0) = pk2(o0, o1);
    }
    __syncthreads();
#undef SW_PUT_O
#undef SW_PUT_L
}


#ifndef MK_SINGLE
#define MK_SINGLE 1
#endif
constexpr int NPHASE = 21;
struct Args { const float* in[29]; float* out; unsigned char* ws; int ph_lo, ph_hi; };
static_assert(sizeof(Args) == 31 * 8 + 8, "Args has no padding");

__global__ void __launch_bounds__(512, 2) mk_fwd(Args args) {
    extern __shared__ __attribute__((aligned(16))) unsigned char lds_raw[];
    Frame F;
    F.lds = (LAS unsigned char*)lds_raw;
    F.tid = threadIdx.x; F.lane = F.tid & 63; F.wave = __builtin_amdgcn_readfirstlane(F.tid >> 6);
    F.G = gridDim.x; F.bid = blockIdx.x;
    F.ka = (const __attribute__((address_space(4))) char*)__builtin_amdgcn_kernarg_segment_ptr();
    F.out = args.out; F.ws = args.ws;
    volatile LAS unsigned* MISC = (volatile LAS unsigned*)(F.lds + MISC_OFF);
    for (int u = F.tid; u < (LDS_BYTES - LDSCTL_OFF) / 4; u += 512) ((LAS unsigned*)(F.lds + LDSCTL_OFF))[u] = 0u;
    __syncthreads();
    unsigned* barw = (unsigned*)(F.ws + WS_CTL) + 4096;
    XcdBarrier bar; bar.bar = barw; bar.x = 0; bar.st = nullptr;
    const int lo = args.ph_lo, hi = args.ph_hi;
    if (hi - lo > 1) bar = xcd_barrier_post(barw, MISC + 8);
#ifndef PH_MASK
#define PH_MASK 0xFFFFFFFFu
#endif
#define IN(k) (((PH_MASK >> (k)) & 1u) && lo <= (k) && (k) < hi)
#define SEAM(k) do { if (IN(k) && IN((k) + 1)) xcd_barrier(bar); } while (0)
    const int gw = F.bid * 8 + F.wave, NGW = F.G * 8;

#ifndef REPX
#define REPX 0
#endif
#ifndef REPY
#define REPY 0
#endif
#ifndef REP_MASK
#define REP_MASK 0u
#endif
#define PHASE(k, ...) if (IN(k)) { _Pragma("unroll 1") for (int rep_ = 0; rep_ < (int)((REP_MASK >> (k)) & 1u) + 1; ++rep_) { if (rep_) xcd_barrier(bar); __VA_ARGS__ } } SEAM(k);
    PHASE(0, p0_prologue(F);)
    if (IN(1) && F.G != 256) { for (int task = F.bid; task < 512; task += F.G) fs_direct_task(F, task); }
    if (IN(1) && IN(2) && F.G != 256) xcd_barrier(bar);
    PHASE(2, gemm_all(F, WSP(bf16, WS_XNA), WSP(bf16, WS_WIN_T), 4096, FnBf16{WSP(bf16, WS_PROJ), 4096});)
    PHASE(3, for (int u = F.bid; u < 2048 + 256; u += F.G) { if (u < 2048) p2_chunk(F, u); else p2_sample(F, u - 2048); })
    PHASE(4, if (F.G == 256) { const int x = F.bid & 7, idx = F.bid >> 3;
                 if (idx < 8) p3_scan(F, x * 2 + (idx >> 2), idx & 3);
                 else { const int j = (idx - 8) * 8 + x;
                        const size_t n8 = (size_t)2 * NEXP * DM / 8; const int p0 = j < 128 ? 6 * j : 768 + 13 * (j - 128), p1 = p0 + (j < 128 ? 6 : 13);
                        peer_tables_to_fp8(F, (size_t)F.tid, (size_t)512, n8 * p0 / 1600, n8 * p1 / 1600);
                        __syncthreads();
                        for (int task = j; task < 512; task += 192) fs_direct_task(F, task); } }
             else { for (int u = F.bid; u < 64; u += F.G) p3_scan(F, u >> 2, u & 3); })
    PHASE(5, p4_rows(F, gw, NGW);
             for (int id = gw; id < 8192; id += NGW) compress_sample(F, id);)
    PHASE(6, gemm_all(F, WSP(bf16, WS_OG), WSP(bf16, WS_WOA_T), 1024, FnResid{WSP(float, WS_XS), FIN(0), FIN(1)});)
    PHASE(7, for (int r = gw; r < MTOK; r += NGW) rms_row_to_bf16(WSP(float, WS_XS) + (size_t)r * DM, WSP(bf16, WS_XNB) + (size_t)r * DM, F.lane);)
    PHASE(8, gemm_all(F, WSP(bf16, WS_XNB), WSP(bf16, WS_WPQ_T), 2048, FnBf16{WSP(bf16, WS_QPEER), 2048});)
    PHASE(9, p8_phase(F, 0);)
    int pg_slice = F.bid & 7, pg_first = (F.bid >> 3) * 8 + F.wave, pg_stride = ((F.G - (F.bid & 7) + 7) >> 3) * 8;
#define PEER_GROUPS() do { if (MISC[8 + 3] != 0u && (F.G & 7) == 0) { const unsigned c_ = xb_ld(&barw[XB_XCNT(F.lane & 15)]); const bool ok_ = (F.lane & 15) < 8 ? c_ == (unsigned)(F.G >> 3) : c_ == 0u; \
        if (__builtin_amdgcn_ballot_w64(ok_) == ~0ull && bar.x < 8u) { pg_slice = (int)bar.x; pg_first = (int)MISC[8 + 2] * 8 + F.wave; pg_stride = F.G; } } } while (0)
    PHASE(10, PEER_GROUPS(); p9u_wave(F, 0, pg_slice, pg_first, pg_stride);)
    PHASE(11, PEER_GROUPS(); p9v_wave(F, 0, pg_slice, pg_first, pg_stride, 0);)
    PHASE(12, gemm_all(F, WSP(bf16, WS_XNA), WSP(bf16, WS_WKVQ_T), NKVQ, FnKvq{WSP(bf16, WS_KVQ), WSP(float, WS_SSQ)});)
    PHASE(13, for (int u = F.bid; u < 256; u += F.G) pp_prompt_tile(F, u);
              if (F.G == 256) { compress_prompt_split(F, F.bid * 2 + (F.wave >> 2)); if (F.bid < MS) pp_sample_row(F, F.bid, F.wave); }
              else { for (int r = gw; r < MS; r += NGW) pp_sample_row(F, r); for (int id = gw; id < 512; id += NGW) compress_prompt(F, id); })
    PHASE(14, if (F.G == 256) {
                  _Pragma("unroll 1") for (int q_ = 0; q_ < 1 + REPX; ++q_) { if (F.bid < 128) nsa_sample_wg(F, F.bid); }
                  __syncthreads();
                  { const int i_ = F.bid >> 3;
                    if (i_ < 16) { nsa_wg(F, F.bid & 7, i_); nsa_wg(F, F.bid & 7, 31 - i_); } else { nsa_wg(F, F.bid & 7, 16 + i_); nsa_wg(F, F.bid & 7, 79 - i_); } }
              } else { for (int id = gw; id < 128 + 4096; id += NGW) { if (id < 128) nsa_unit<true>(F, id); else nsa_unit<false>(F, id - 128); } })
    PHASE(15, gemm_all(F, WSP(bf16, WS_OG), WSP(bf16, WS_WOB_T), 1024, FnResid{WSP(float, WS_XS), WSP(float, WS_XS), WSP(float, WS_XS) + (size_t)MP * DM});)
    PHASE(16, for (int r = gw; r < MTOK; r += NGW) rms_row_to_bf16(WSP(float, WS_XS) + (size_t)r * DM, WSP(bf16, WS_XNB) + (size_t)r * DM, F.lane);)
    PHASE(17, gemm_all(F, WSP(bf16, WS_XNB), WSP(bf16, WS_WPQ_T) + (size_t)2048 * 1024, 2048, FnBf16{WSP(bf16, WS_QPEER), 2048});)
    PHASE(18, p8_phase(F, 1);)
    PHASE(19, PEER_GROUPS(); p9u_wave(F, 1, pg_slice, pg_first, pg_stride);)
    PHASE(20, PEER_GROUPS(); p9v_wave(F, 1, pg_slice, pg_first, pg_stride, 1);)
#undef IN
#undef SEAM
}

extern "C" void kernel_launch(void* const* d_in, const int* in_sizes, int n_in, void* d_out, int out_size, void* d_ws, size_t ws_size, hipStream_t stream) {
    static int grid = 0;
    if (grid == 0) {
        if (n_in != 29 || (size_t)out_size != O_END || ws_size < WS_END) { fprintf(stderr, "kernel_launch: unexpected shapes n_in %d out %d ws %zu (need %zu)\n", n_in, out_size, ws_size, (size_t)WS_END); grid = -1; return; }
        int dev = 0, cus = 0, per_cu = 0;
        if (hipGetDevice(&dev) != hipSuccess || hipDeviceGetAttribute(&cus, hipDeviceAttributeMultiprocessorCount, dev) != hipSuccess) { grid = -1; return; }
        if (hipFuncSetAttribute((const void*)mk_fwd, hipFuncAttributeMaxDynamicSharedMemorySize, LDS_BYTES) != hipSuccess) { fprintf(stderr, "kernel_launch: hipFuncSetAttribute failed\n"); grid = -1; return; }
        if (hipOccupancyMaxActiveBlocksPerMultiprocessor(&per_cu, (const void*)mk_fwd, 512, LDS_BYTES) != hipSuccess || per_cu < 1) fprintf(stderr, "kernel_launch: occupancy query reports %d\n", per_cu);
        (void)hipGetLastError();
        grid = cus;
    }
    if (grid < 0) return;
    if (hipMemsetAsync((char*)d_ws + WS_CTL, 0, CTL_BYTES, stream) != hipSuccess) return;
    Args a{};
    for (int i = 0; i < 29; ++i) a.in[i] = (const float*)d_in[i];
    a.out = (float*)d_out; a.ws = (unsigned char*)d_ws;
#if MK_SINGLE
    a.ph_lo = 0; a.ph_hi = NPHASE;
    hipLaunchKernelGGL(mk_fwd, dim3(grid), dim3(512), LDS_BYTES, stream, a);
#else
    for (int p = 0; p < NPHASE; ++p) { a.ph_lo = p; a.ph_hi = p + 1; hipLaunchKernelGGL(mk_fwd, dim3(grid), dim3(512), LDS_BYTES, stream, a); }
#endif
    const hipError_t le = hipPeekAtLastError();
    if (le != hipSuccess) fprintf(stderr, "kernel_launch: launch failed: %s\n", hipGetErrorName(le));
}
```

```cpp
#include <hip/hip_runtime.h>
#include <cstdio>
#include <cstdint>

constexpr int DM = 1024, PB = 2, PT = 8192, SB = 32, SL = 4, PAST = 8192, PAGE = 128;
constexpr int MP = PB * PT;
constexpr int MS = SB * SL;
constexpr int MTOK = MP + MS;
constexpr int GH = 8, GDK = 128, GDV = 128, GCONV = 3072, GPROJ = 4112, CHUNK = 64, NCH = PT / CHUNK;
constexpr int NH = 16, NG = 4, HPG = 4, DH = 64, NQG = 1072, NKV = 1536, NKVQ = 2816, NKVQ_REAL = 2608;
constexpr int WINDOW = 512, NSELP = 128, NSELS = 129, NCMP = 511;
constexpr int PEH = 8, PEDQ = 256, PEHALF = 128, NKEYS = 128, NEXP = 16384, PETOP = 16;
constexpr int NPAGES = PAST / PAGE;
constexpr float EPS = 1e-6f;

constexpr size_t O_YP = 0;
constexpr size_t O_YS = O_YP + (size_t)MP * DM;
constexpr size_t O_KVP = O_YS + (size_t)MS * DM;
constexpr size_t O_WINP = O_KVP + (size_t)MP * 1024;
constexpr size_t O_GDNP = O_WINP + (size_t)PB * 512 * 512;
constexpr size_t O_CONVP = O_GDNP + (size_t)PB * GH * 128 * 128;
constexpr size_t O_KVS = O_CONVP + (size_t)PB * 3 * GCONV;
constexpr size_t O_WINS = O_KVS + (size_t)MS * 1024;
constexpr size_t O_GDNS = O_WINS + (size_t)SB * 512 * 512;
constexpr size_t O_CONVS = O_GDNS + (size_t)SB * GH * 128 * 128;
constexpr size_t O_END = O_CONVS + (size_t)SB * 3 * GCONV;

constexpr size_t MiB = 1u << 20;
constexpr size_t al(size_t x) { return (x + 4095) & ~(size_t)4095; }
constexpr size_t WS_CTL = 0, CTL_BYTES = 1 * MiB;
constexpr size_t WS_WIN_T = WS_CTL + CTL_BYTES;
constexpr size_t WS_WOA_T = WS_WIN_T + (size_t)4096 * 1024 * 2;
constexpr size_t WS_WKVQ_T = WS_WOA_T + (size_t)1024 * 1024 * 2;
constexpr size_t WS_WOB_T = WS_WKVQ_T + (size_t)NKVQ * 1024 * 2;
constexpr size_t WS_WPQ_T = WS_WOB_T + (size_t)1024 * 1024 * 2;
constexpr size_t WS_WAB = WS_WPQ_T + (size_t)2 * 2048 * 1024 * 2;
constexpr size_t WS_SUBK = WS_WAB + (size_t)16 * 1024 * 4;
constexpr size_t WS_W1T = WS_SUBK + (size_t)2 * 8 * 2 * 128 * 128 * 2;
constexpr size_t WS_PETERM = WS_W1T + (size_t)2 * 128 * 1024 * 2;
constexpr size_t WS_PU = al(WS_PETERM + 512);
constexpr size_t WS_PV = WS_PU + (size_t)2 * NEXP * DM * 2;
constexpr size_t WS_XNA = WS_PV + (size_t)2 * NEXP * DM * 2;
constexpr size_t WS_XNB = al(WS_XNA + (size_t)MTOK * DM * 2);
constexpr size_t WS_PROJ = al(WS_XNB + (size_t)MTOK * DM * 2);
constexpr size_t WS_GW = al(WS_PROJ + (size_t)MTOK * 4096 * 2);
constexpr size_t WS_GQ = WS_GW + (size_t)2048 * 64 * 128 * 2;
constexpr size_t WS_GKT = WS_GQ + (size_t)2048 * 64 * 128 * 2;
constexpr size_t WS_GQK = WS_GKT + (size_t)2048 * 64 * 128 * 2;
constexpr size_t WS_GU = WS_GQK + (size_t)2048 * 64 * 64 * 2;
constexpr size_t WS_GDEC = WS_GU + (size_t)2048 * 64 * 128 * 4;
constexpr size_t WS_OGDN = al(WS_GDEC + 2048 * 4);
constexpr size_t WS_OG = al(WS_OGDN + (size_t)MTOK * DM * 4);
constexpr size_t WS_XS = al(WS_OG + (size_t)MTOK * DM * 2);
constexpr size_t WS_QPEER = al(WS_XS + (size_t)MTOK * DM * 4);
constexpr size_t WS_PEI = al(WS_QPEER + (size_t)MTOK * 2048 * 2);
constexpr size_t WS_PEG = al(WS_PEI + (size_t)MTOK * 128 * 4);
constexpr size_t WS_KVQ = al(WS_PEG + (size_t)MTOK * 128 * 4);
constexpr size_t WS_KSEL = al(WS_KVQ + (size_t)MTOK * NKVQ * 4);
constexpr size_t WS_VSELT = WS_KSEL + (size_t)PB * NG * PT * 64 * 2;
constexpr size_t WS_KWIN = WS_VSELT + (size_t)PB * NG * PT * 64 * 2;
constexpr size_t WS_VWINT = WS_KWIN + (size_t)PB * NG * PT * 64 * 2;
constexpr size_t WS_KCMP = WS_VWINT + (size_t)PB * NG * PT * 64 * 2;
constexpr size_t WS_VCMPT = WS_KCMP + (size_t)PB * NG * 512 * 64 * 2;
constexpr size_t WS_SKCMP = WS_VCMPT + (size_t)PB * NG * 512 * 64 * 2;
constexpr size_t WS_SVCMPT = WS_SKCMP + (size_t)SB * NG * 512 * 64 * 2;
constexpr size_t WS_SKWIN = WS_SVCMPT + (size_t)SB * NG * 512 * 64 * 2;
constexpr size_t WS_SVWINT = WS_SKWIN + (size_t)SB * NG * 544 * 64 * 2;
constexpr size_t WS_SNEW = WS_SVWINT + (size_t)SB * NG * 544 * 64 * 2;
constexpr size_t WS_QN = al(WS_SNEW + (size_t)SB * 4 * 2 * 4 * 64 * 4);
constexpr size_t WS_GATES = al(WS_QN + (size_t)MTOK * 1024 * 2);
constexpr size_t WS_OACC = al(WS_GATES + (size_t)MTOK * 48 * 4);
constexpr size_t WS_CKA = al(WS_OACC + (size_t)MTOK * DM * 4);
constexpr size_t WS_W1BD = al(WS_CKA + (size_t)65536 * 2048 * 2);
constexpr size_t WS_FS = al(WS_W1BD + (size_t)256 * 2048 * 2);
constexpr size_t WS_PA = al(WS_FS + (size_t)65536 * 256 * 4);
constexpr size_t WS_SSQ = al(WS_PA + (size_t)MTOK * 8 * 64 * 4);
constexpr size_t WS_W2F = al(WS_SSQ + (size_t)MTOK * 8 * 4);
constexpr size_t WS_XN8 = al(WS_W2F + 2 * 4 * 2 * 64 * 8 * 2);
constexpr size_t WS_HS = al(WS_XN8 + (size_t)MTOK * DM);
constexpr size_t WS_END = al(WS_HS + (size_t)MTOK * 4);

constexpr int RING_BYTES = 143360;
constexpr int LDSCTL_OFF = RING_BYTES, MISC_OFF = LDSCTL_OFF + 320;
constexpr int LDS_BYTES = 147456;

#define GAS __attribute__((address_space(1)))
#define LAS __attribute__((address_space(3)))
typedef unsigned short bf16;
typedef unsigned v4u __attribute__((ext_vector_type(4)));
typedef unsigned v2u __attribute__((ext_vector_type(2)));
typedef float f32x4 __attribute__((ext_vector_type(4)));
typedef float f32x2 __attribute__((ext_vector_type(2)));
typedef short bf16x8 __attribute__((ext_vector_type(8)));
typedef GAS unsigned gu32;
#define RLX_AGENT __ATOMIC_RELAXED, __HIP_MEMORY_SCOPE_AGENT
#define LDS_WAIT() asm volatile("s_waitcnt lgkmcnt(0)" ::: "memory")
#define VM_WAIT() asm volatile("s_waitcnt vmcnt(0)" ::: "memory")

__device__ __forceinline__ unsigned f2bf(float f) { unsigned u = __builtin_bit_cast(unsigned, f); return (u + 0x7fffu + ((u >> 16) & 1u)) >> 16; }
typedef __bf16 hwbf16x2 __attribute__((ext_vector_type(2)));
__device__ __forceinline__ unsigned pk2(float lo, float hi) { const f32x2 v = {lo, hi}; return __builtin_bit_cast(unsigned, __builtin_convertvector(v, hwbf16x2)); }
__device__ __forceinline__ float bf2f(unsigned b) { return __builtin_bit_cast(float, b << 16); }
__device__ __forceinline__ float bflo(unsigned w) { return __builtin_bit_cast(float, w << 16); }
__device__ __forceinline__ float bfhi(unsigned w) { return __builtin_bit_cast(float, w & 0xffff0000u); }
#ifndef USE_PERMSWAP
#define USE_PERMSWAP 1
#endif
template <int CTRL> __device__ __forceinline__ float dpp_f(float x) { return __builtin_bit_cast(float, __builtin_amdgcn_update_dpp(0, __builtin_bit_cast(int, x), CTRL, 0xF, 0xF, true)); }
template <int CTRL> __device__ __forceinline__ unsigned dpp_u(unsigned x) { return (unsigned)__builtin_amdgcn_update_dpp(0, (int)x, CTRL, 0xF, 0xF, true); }
#define DPP_XOR1 0xB1
#define DPP_XOR2 0x4E
#define DPP_HMIR 0x141
#define DPP_MIR 0x140
#define DPP_ROR4 0x124
#define DPP_ROR8 0x128
#if USE_PERMSWAP
#define PSWAP16(a, b) asm volatile("s_nop 1\n\tv_permlane16_swap_b32 %0, %1" : "+v"(a), "+v"(b))
#define PSWAP32(a, b) asm volatile("s_nop 1\n\tv_permlane32_swap_b32 %0, %1" : "+v"(a), "+v"(b))
__device__ __forceinline__ float x16_sum(float x) { unsigned a = __builtin_bit_cast(unsigned, x), b = a; PSWAP16(a, b); return __builtin_bit_cast(float, a) + __builtin_bit_cast(float, b); }
__device__ __forceinline__ float x32_sum(float x) { unsigned a = __builtin_bit_cast(unsigned, x), b = a; PSWAP32(a, b); return __builtin_bit_cast(float, a) + __builtin_bit_cast(float, b); }
__device__ __forceinline__ float x16_max(float x) { unsigned a = __builtin_bit_cast(unsigned, x), b = a; PSWAP16(a, b); return fmaxf(__builtin_bit_cast(float, a), __builtin_bit_cast(float, b)); }
__device__ __forceinline__ float x32_max(float x) { unsigned a = __builtin_bit_cast(unsigned, x), b = a; PSWAP32(a, b); return fmaxf(__builtin_bit_cast(float, a), __builtin_bit_cast(float, b)); }
__device__ __forceinline__ unsigned x16_umax(unsigned u) { unsigned a = u, b = u; PSWAP16(a, b); return a > b ? a : b; }
__device__ __forceinline__ unsigned x32_umax(unsigned u) { unsigned a = u, b = u; PSWAP32(a, b); return a > b ? a : b; }
#else
__device__ __forceinline__ float x16_sum(float x) { return x + __shfl_xor(x, 16); }
__device__ __forceinline__ float x32_sum(float x) { return x + __shfl_xor(x, 32); }
__device__ __forceinline__ float x16_max(float x) { return fmaxf(x, __shfl_xor(x, 16)); }
__device__ __forceinline__ float x32_max(float x) { return fmaxf(x, __shfl_xor(x, 32)); }
__device__ __forceinline__ unsigned x16_umax(unsigned u) { const unsigned o = __shfl_xor(u, 16); return u > o ? u : o; }
__device__ __forceinline__ unsigned x32_umax(unsigned u) { const unsigned o = __shfl_xor(u, 32); return u > o ? u : o; }
#endif
__device__ __forceinline__ float row_sum16(float x) { x += dpp_f<DPP_XOR1>(x); x += dpp_f<DPP_XOR2>(x); x += dpp_f<DPP_HMIR>(x); x += dpp_f<DPP_MIR>(x); return x; }
__device__ __forceinline__ float wave_sum(float v) { return x32_sum(x16_sum(row_sum16(v))); }
__device__ __forceinline__ float frcp(float x) { return __builtin_amdgcn_rcpf(x); }
__device__ __forceinline__ float frsq(float x) { return __builtin_amdgcn_rsqf(x); }
__device__ __forceinline__ unsigned pk_i8(f32x4 v) {
    const int q0 = (int)__builtin_rintf(fminf(fmaxf(v.x, -127.f), 127.f)), q1 = (int)__builtin_rintf(fminf(fmaxf(v.y, -127.f), 127.f));
    const int q2 = (int)__builtin_rintf(fminf(fmaxf(v.z, -127.f), 127.f)), q3 = (int)__builtin_rintf(fminf(fmaxf(v.w, -127.f), 127.f));
    return (unsigned)(q0 & 255) | ((unsigned)(q1 & 255) << 8) | ((unsigned)(q2 & 255) << 16) | ((unsigned)q3 << 24);
}
__device__ __forceinline__ float silu_f(float x) { return x * frcp(1.f + __expf(-x)); }
__device__ __forceinline__ float sigmoid_f(float x) { return frcp(1.f + __expf(-x)); }
__device__ __forceinline__ float gelu_tanh(float x) {
    const float u = 0.7978845608028654f * (x + 0.044715f * x * x * x);
    const float e = __expf(2.f * u);
    const float th = 1.f - 2.f * frcp(e + 1.f);
    return 0.5f * x * (1.f + th);
}
__device__ __forceinline__ bf16x8 ld8(const bf16* p) { return *(const bf16x8*)p; }
__device__ __forceinline__ bf16x8 ld8l(const LAS bf16* p) { return *(const LAS bf16x8*)p; }
#define MFMA16(a, b, c) __builtin_amdgcn_mfma_f32_16x16x32_bf16((a), (b), (c), 0, 0, 0)
__device__ __forceinline__ bf16x8 cvt8(f32x4 a, f32x4 b) {
    v4u r; r.x = pk2(a.x, a.y); r.y = pk2(a.z, a.w); r.z = pk2(b.x, b.y); r.w = pk2(b.z, b.w); return __builtin_bit_cast(bf16x8, r);
}

struct Frame {
    LAS unsigned char* lds;
    int tid, lane, wave, G, bid;
    const __attribute__((address_space(4))) char* ka;
    float* out;
    unsigned char* ws;
};
#define WSP(T, off) ((T*)(F.ws + (off)))
__device__ __forceinline__ const float* fin_(const __attribute__((address_space(4))) char* ka, int i) {
    const __attribute__((address_space(4))) char* p = ka; asm volatile("" : "+s"(p));
    return *(const float* const __attribute__((address_space(4)))*)(p + 8 * i);
}
#define FIN(i) fin_(F.ka, (i))
namespace pg8 {
#define PG8_LAS __attribute__((address_space(3)))
typedef unsigned short bf16_t;
typedef short bf16x8 __attribute__((ext_vector_type(8)));
typedef float f32x4 __attribute__((ext_vector_type(4)));
typedef unsigned u32x4 __attribute__((ext_vector_type(4)));
constexpr int BM = 256, BK = 64, HALF = 128, HTB = HALF * BK * 2  , STAGE_BYTES = 8 * HTB, NXCD = 8, WGM = 8;

__host__ __device__ __forceinline__ int lds_byte(int r, int c) { const int st = (r >> 4) * 2 + (c >> 5), rr = r & 15, cc = c & 31, ob = rr * 64 + cc * 2; return st * 1024 + (ob ^ (((ob >> 9) & 1) << 5)); }
__host__ __device__ __forceinline__ void stage_rc(int b, int& R, int& C) { const int st = b / 1024, sb = b % 1024, swz = sb ^ (((sb >> 9) & 1) << 5); R = (st >> 1) * 16 + swz / 64; C = (st & 1) * 32 + (swz % 64) / 2; }
__host__ __device__ __forceinline__ int perm32(int rho) { const int n = rho >> 4, i = rho & 15; return 8 * (i >> 2) + 4 * n + (i & 3); }

struct Unit { int pm, pn; };
struct Gemm { const bf16_t* A; const bf16_t* Bt; int M, N, K; };

struct StaticOrder {
    int nM, nN, nwg, G, c;
    __host__ __device__ void init(int M, int N, int G_, int c_) { nM = M / BM; nN = N / BM; nwg = nM * nN; G = G_; c = c_; }
    __host__ __device__ bool next(int i, Unit& u) const {
        const long L = (long)i * G + c; if (L >= nwg) return false;
        int wgid = (int)L; { const int q = nwg / NXCD, r = nwg % NXCD, xcd = wgid % NXCD, off = wgid / NXCD; wgid = (xcd < r ? xcd * (q + 1) : r * (q + 1) + (xcd - r) * q) + off; }
        const int nig = WGM * nN, gid = wgid / nig, fm = gid * WGM, gsz = (nM - fm) < WGM ? (nM - fm) : WGM;
        u.pm = fm + ((wgid % nig) % gsz); u.pn = (wgid % nig) / gsz; return true;
    }
    __device__ __forceinline__ void a_ready(const Unit&) const {}
    __device__ __forceinline__ void done(const Unit&) const {}
};
template <class Epi, class Sched, bool ALIGN_EPI = false, bool SP2 = false>
__device__ __forceinline__ void gemm_phase(PG8_LAS unsigned char* lds, const Gemm g, const Sched& S, const Epi& E) {
    const int tid = threadIdx.x, wid = __builtin_amdgcn_readfirstlane(tid >> 6), lane = tid & 63, wr = wid >> 2, wc = wid & 3, fr = lane & 15, fq = lane >> 4;
    const int K = g.K, nt = K / BK;
    unsigned voffA[2], voffB[2];
#pragma unroll
    for (int i = 0; i < 2; ++i) { int R, C; stage_rc(tid * 16 + i * 8192, R, C); const int Rb = Epi::PERM ? ((R & ~31) + perm32(R & 31)) : R;
        voffA[i] = (unsigned)(R * K + C) * 2u; voffB[i] = (unsigned)(Rb * K + C) * 2u; }
    const size_t kstep = (size_t)(BK * 2);
    const size_t hstep = (size_t)HALF * K * 2;
    const size_t tstep = 2 * hstep;
    const unsigned ldsw = (unsigned)wid * 1024u;
    const int aoff = lds_byte(wr * 64 + fr, fq * 8), boff = lds_byte(wc * 32 + fr, fq * 8);
#define PG8_SA(b, h) (((b) * 2 + (h)) * HTB)
#define PG8_SB(b, h) ((4 + (b) * 2 + (h)) * HTB)
#define PG8_STAGE(bufoff, gbase, voff) do { _Pragma("unroll") for (int _i = 0; _i < 2; ++_i) \
        __builtin_amdgcn_global_load_lds((const unsigned*)((const char*)(gbase) + (voff)[_i]), (PG8_LAS unsigned*)(lds + (bufoff) + ldsw + _i * 8192), 16, 0, 0); } while (0)
#define PG8_LDA(dst, b, h) do { _Pragma("unroll") for (int m = 0; m < 4; ++m) _Pragma("unroll") for (int k = 0; k < 2; ++k) dst[m][k] = *(const PG8_LAS bf16x8*)(lds + PG8_SA(b, h) + aoff + m * 2048 + k * 1024); } while (0)
#define PG8_LDB(dst, b, h) do { _Pragma("unroll") for (int n = 0; n < 2; ++n) _Pragma("unroll") for (int k = 0; k < 2; ++k) dst[n][k] = *(const PG8_LAS bf16x8*)(lds + PG8_SB(b, h) + boff + n * 2048 + k * 1024); } while (0)
#define PG8_MMA(ai, bj, At, Bt) do { __builtin_amdgcn_s_setprio(1); _Pragma("unroll") for (int m = 0; m < 4; ++m) _Pragma("unroll") for (int n = 0; n < 2; ++n) _Pragma("unroll") for (int k = 0; k < 2; ++k) \
        acc[ai][bj][m][n] = __builtin_amdgcn_mfma_f32_16x16x32_bf16(Bt[n][k], At[m][k], acc[ai][bj][m][n], 0, 0, 0); __builtin_amdgcn_s_setprio(0); } while (0)
#define PG8_WAIT_V(n) asm volatile("s_waitcnt vmcnt(" #n ")" ::: "memory")
#define PG8_WAIT_L(n) asm volatile("s_waitcnt lgkmcnt(" #n ")" ::: "memory")
#define PG8_BAR __builtin_amdgcn_s_barrier()
#define PG8_SCHED __builtin_amdgcn_sched_barrier(0)
    Unit cur, nxt; int ui = 0;
    if (!S.next(0, cur)) return;
    f32x4 acc[2][2][4][2];
#pragma unroll
    for (int a = 0; a < 2; ++a)
#pragma unroll
        for (int b = 0; b < 2; ++b)
#pragma unroll
            for (int m = 0; m < 4; ++m)
#pragma unroll
                for (int n = 0; n < 2; ++n) acc[a][b][m][n] = (f32x4){0.f, 0.f, 0.f, 0.f};
    bf16x8 At[4][2], B0[2][2], B1[2][2];
    const char* cA = (const char*)g.A + (size_t)cur.pm * tstep; const char* cB = (const char*)g.Bt + (size_t)cur.pn * tstep;
    S.a_ready(cur);
    if constexpr (SP2) {
        PG8_STAGE(PG8_SB(0, 0), cB, voffB); PG8_STAGE(PG8_SB(0, 1), cB + hstep, voffB); PG8_STAGE(PG8_SA(0, 0), cA, voffA); PG8_STAGE(PG8_SA(0, 1), cA + hstep, voffA);
        if (wr == 1) PG8_BAR;
        PG8_WAIT_V(2); PG8_BAR;
        PG8_STAGE(PG8_SB(1, 0), cB + kstep, voffB); PG8_STAGE(PG8_SA(1, 0), cA + kstep, voffA); PG8_STAGE(PG8_SB(1, 1), cB + hstep + kstep, voffB);
        PG8_WAIT_V(6); PG8_BAR;
    } else {
        PG8_STAGE(PG8_SB(0, 0), cB, voffB); PG8_STAGE(PG8_SA(0, 0), cA, voffA); PG8_STAGE(PG8_SB(0, 1), cB + hstep, voffB); PG8_STAGE(PG8_SA(0, 1), cA + hstep, voffA);
        if (wr == 1) PG8_BAR;
        PG8_WAIT_V(4); PG8_BAR;
        PG8_STAGE(PG8_SB(1, 0), cB + kstep, voffB); PG8_STAGE(PG8_SA(1, 0), cA + kstep, voffA); PG8_STAGE(PG8_SB(1, 1), cB + hstep + kstep, voffB);
        PG8_WAIT_V(6); PG8_BAR;
    }
    for (;;) {
        const bool has_next = S.next(ui + 1, nxt);
        const char* nA = has_next ? (const char*)g.A + (size_t)nxt.pm * tstep : cA; const char* nB = has_next ? (const char*)g.Bt + (size_t)nxt.pn * tstep : cB;
        for (int t = 0; t < nt; t += 2) {
            const bool last = (t == nt - 2);
            const char* a1 = cA + (size_t)(t + 1) * kstep;
            const char* a2 = last ? nA : cA + (size_t)(t + 2) * kstep; const char* b2 = last ? nB : cB + (size_t)(t + 2) * kstep;
            const char* a3 = a2 + kstep; const char* b3 = b2 + kstep;
            if (last && has_next) S.a_ready(nxt);
            if constexpr (SP2) {
            PG8_LDB(B0, 0, 0); PG8_LDB(B1, 0, 1); PG8_SCHED; PG8_LDA(At, 0, 0); PG8_STAGE(PG8_SA(1, 1), a1 + hstep, voffA);
            PG8_WAIT_V(8); PG8_WAIT_L(0); PG8_BAR; PG8_MMA(0, 0, At, B0); PG8_MMA(0, 1, At, B1); PG8_BAR; PG8_SCHED;
            PG8_LDA(At, 0, 1); PG8_STAGE(PG8_SB(0, 0), b2, voffB); PG8_STAGE(PG8_SB(0, 1), b2 + hstep, voffB); PG8_STAGE(PG8_SA(0, 0), a2, voffA);
            PG8_WAIT_V(8); PG8_WAIT_L(0); PG8_BAR; PG8_MMA(1, 0, At, B0); PG8_MMA(1, 1, At, B1); PG8_BAR; PG8_SCHED;
            PG8_LDB(B0, 1, 0); PG8_LDB(B1, 1, 1); PG8_SCHED; PG8_LDA(At, 1, 0); PG8_STAGE(PG8_SA(0, 1), a2 + hstep, voffA);
            PG8_WAIT_V(8); PG8_WAIT_L(0); PG8_BAR; PG8_MMA(0, 0, At, B0); PG8_MMA(0, 1, At, B1); PG8_BAR; PG8_SCHED;
            PG8_LDA(At, 1, 1); PG8_STAGE(PG8_SB(1, 0), b3, voffB); PG8_STAGE(PG8_SB(1, 1), b3 + hstep, voffB); PG8_STAGE(PG8_SA(1, 0), a3, voffA);
            PG8_WAIT_V(8); PG8_WAIT_L(0); PG8_BAR; PG8_MMA(1, 0, At, B0); PG8_MMA(1, 1, At, B1); PG8_BAR; PG8_SCHED;
            } else {
            PG8_LDB(B0, 0, 0); PG8_SCHED; PG8_LDA(At, 0, 0); PG8_STAGE(PG8_SA(1, 1), a1 + hstep, voffA);
            PG8_WAIT_L(8); PG8_BAR; PG8_WAIT_L(0); PG8_MMA(0, 0, At, B0); PG8_BAR; PG8_SCHED;
            PG8_LDB(B1, 0, 1); PG8_STAGE(PG8_SB(0, 0), b2, voffB);
            PG8_BAR; PG8_WAIT_L(0); PG8_MMA(0, 1, At, B1); PG8_BAR;
            PG8_LDA(At, 0, 1); PG8_STAGE(PG8_SA(0, 0), a2, voffA);
            PG8_BAR; PG8_WAIT_L(0); PG8_MMA(1, 0, At, B0); PG8_BAR; PG8_SCHED;
            PG8_STAGE(PG8_SB(0, 1), b2 + hstep, voffB);
            PG8_WAIT_V(6); PG8_BAR; PG8_MMA(1, 1, At, B1); PG8_BAR;
            PG8_LDB(B0, 1, 0); PG8_SCHED; PG8_LDA(At, 1, 0); PG8_STAGE(PG8_SA(0, 1), a2 + hstep, voffA);
            PG8_WAIT_L(8); PG8_BAR; PG8_WAIT_L(0); PG8_MMA(0, 0, At, B0); PG8_BAR; PG8_SCHED;
            PG8_LDB(B1, 1, 1); PG8_STAGE(PG8_SB(1, 0), b3, voffB);
            PG8_BAR; PG8_WAIT_L(0); PG8_MMA(0, 1, At, B1); PG8_BAR;
            PG8_LDA(At, 1, 1); PG8_STAGE(PG8_SA(1, 0), a3, voffA);
            PG8_BAR; PG8_WAIT_L(0); PG8_MMA(1, 0, At, B0); PG8_BAR; PG8_SCHED;
            PG8_STAGE(PG8_SB(1, 1), b3 + hstep, voffB);
            PG8_WAIT_V(6); PG8_BAR; PG8_MMA(1, 1, At, B1); PG8_BAR;
            }
        }
        if constexpr (ALIGN_EPI) { if (wr == 0) PG8_BAR; }
        if constexpr (!Epi::AFTER_DRAIN) { E(acc, cur, wr, wc, fr, fq); S.done(cur); }
        if (!has_next) break;
#pragma unroll
        for (int a = 0; a < 2; ++a)
#pragma unroll
            for (int b = 0; b < 2; ++b)
#pragma unroll
                for (int m = 0; m < 4; ++m)
#pragma unroll
                    for (int n = 0; n < 2; ++n) acc[a][b][m][n] = (f32x4){0.f, 0.f, 0.f, 0.f};
        cur = nxt; cA = nA; cB = nB; ++ui;
        if constexpr (ALIGN_EPI) { if (wr == 1) PG8_BAR; }
    }
    PG8_WAIT_V(0);
    if constexpr (!ALIGN_EPI) { if (wr == 0) PG8_BAR; }
    PG8_BAR;
    if constexpr (Epi::AFTER_DRAIN) { E.fused(acc, cur, wr, wc, fr, fq, lds, wid, lane); S.done(cur); }
#undef PG8_SA
#undef PG8_SB
#undef PG8_STAGE
#undef PG8_LDA
#undef PG8_LDB
#undef PG8_MMA
#undef PG8_WAIT_V
#undef PG8_WAIT_L
#undef PG8_BAR
#undef PG8_SCHED
}
}
#define XB_TMO      128
#define XB_XCNT(j)  (256  + 64 * (j))
#define XB_XSUB(j)  (1280 + 64 * (j))
#define XB_XGEN(j)  (2304 + 64 * (j))
#define XB_TOP      3328
#define XB_TOPGEN   3392
#define XCD_BAR_WORDS 3456
#define XB_SPIN_CAP (1u << 18)

__device__ __forceinline__ unsigned xb_ld(unsigned* p)              { return __hip_atomic_load(p, __ATOMIC_RELAXED, __HIP_MEMORY_SCOPE_AGENT); }
__device__ __forceinline__ unsigned xb_add(unsigned* p, unsigned v) { return __hip_atomic_fetch_add(p, v, __ATOMIC_RELAXED, __HIP_MEMORY_SCOPE_AGENT); }
__device__ __forceinline__ unsigned xb_xcc_id() { return (unsigned)__builtin_amdgcn_s_getreg((3 << 11) | 20) & 0xFu; }
#define XB_SPIN(cond, bar) do { unsigned _sp = 0; while (cond) { __builtin_amdgcn_s_sleep(1); \
    if ((++_sp & 255u) == 0u) { if (xb_ld(&(bar)[XB_TMO])) break; if (_sp > XB_SPIN_CAP) { atomicAdd(&(bar)[XB_TMO], 1u); break; } } } } while (0)

struct XcdBarrier {
    unsigned* bar; unsigned x;
    volatile LAS unsigned* st;
};

__device__ __forceinline__ XcdBarrier xcd_barrier_post(unsigned* bar, volatile LAS unsigned* st) {
    XcdBarrier b; b.bar = bar; b.x = xb_xcc_id(); b.st = st;
    if (threadIdx.x == 0) { st[2] = xb_add(&bar[XB_XCNT(b.x)], 1u); st[3] = 1u; }
    return b;
}
__device__ __forceinline__ void xcd_barrier_complete(unsigned* bar, unsigned x, unsigned& nloc, unsigned& nx) {
    const unsigned G = gridDim.x * gridDim.y * gridDim.z;
    unsigned sum, cnt, mine, sp = 0u;
    for (;;) {
        sum = 0u; cnt = 0u; mine = 0u;
#pragma unroll
        for (unsigned j = 0; j < 16; ++j) { const unsigned c = xb_ld(&bar[XB_XCNT(j)]); sum += c; cnt += (c > 0u) ? 1u : 0u; mine = (j == x) ? c : mine; }
        if (sum == G) break;
        __builtin_amdgcn_s_sleep(1);
        if ((++sp & 255u) == 0u) { if (xb_ld(&bar[XB_TMO])) break; if (sp > XB_SPIN_CAP) { atomicAdd(&bar[XB_TMO], 1u); break; } }
    }
    nloc = mine > 0u ? mine : 1u; nx = cnt > 0u ? cnt : 1u;
}

__device__ __forceinline__ void xcd_barrier(const XcdBarrier& b) {
    asm volatile("s_waitcnt vmcnt(0)" ::: "memory");
    __syncthreads();
    if (threadIdx.x == 0) {
        unsigned* bar = b.bar;
        __builtin_amdgcn_s_waitcnt(0);
        unsigned nloc = b.st[0], nx = b.st[1];
        if (nloc == 0u) { xcd_barrier_complete(bar, b.x, nloc, nx); b.st[0] = nloc; b.st[1] = nx; }
        const unsigned old = xb_add(&bar[XB_XSUB(b.x)], 1u);
        const unsigned gen = old / nloc;
        if (old + 1u == (gen + 1u) * nloc) {
            __builtin_amdgcn_fence(__ATOMIC_RELEASE, "agent");
            asm volatile("s_waitcnt vmcnt(0)" ::: "memory");
            const unsigned og = xb_add(&bar[XB_TOP], 1u);
            const unsigned tg = og / nx;
            if (og + 1u == (tg + 1u) * nx) xb_add(&bar[XB_TOPGEN], 1u);
            else XB_SPIN(xb_ld(&bar[XB_TOPGEN]) == tg, bar);
            __builtin_amdgcn_fence(__ATOMIC_ACQUIRE, "agent");
            xb_add(&bar[XB_XGEN(b.x)], 1u);
            asm volatile("s_waitcnt vmcnt(0)" ::: "memory");
        } else {
            XB_SPIN(xb_ld(&bar[XB_XGEN(b.x)]) == gen, bar);
            __builtin_amdgcn_fence(__ATOMIC_ACQUIRE, "agent");
            asm volatile("s_waitcnt vmcnt(0)" ::: "memory");
        }
    }
    __syncthreads();
}

namespace pg8 {
template <class Fn> struct EpiFn {
    static constexpr bool PERM = true, AFTER_DRAIN = false;
    Fn f;
    __device__ __forceinline__ void operator()(const f32x4 (&acc)[2][2][4][2], const Unit& u, int wr, int wc, int fr, int fq) const {
        const int row0 = u.pm * BM + wr * 64 + fr, col0 = u.pn * BM + wc * 32 + 8 * fq;
#pragma unroll
        for (int ai = 0; ai < 2; ++ai)
#pragma unroll
            for (int m = 0; m < 4; ++m)
#pragma unroll
                for (int bj = 0; bj < 2; ++bj) f.e8(row0 + ai * HALF + m * 16, col0 + bj * HALF, acc[ai][bj][m][0], acc[ai][bj][m][1]);
    }
};
}

struct FnBf16 {
    bf16* O; int ld;
    __device__ __forceinline__ void e8(int row, int col, f32x4 a, f32x4 b) const {
        v4u w; w.x = pk2(a.x, a.y); w.y = pk2(a.z, a.w); w.z = pk2(b.x, b.y); w.w = pk2(b.z, b.w);
        *(v4u*)(O + (size_t)row * ld + col) = w;
    }
    __device__ __forceinline__ void e4(int row, int col, f32x4 a) const {
        v2u w; w.x = pk2(a.x, a.y); w.y = pk2(a.z, a.w);
        *(v2u*)(O + (size_t)row * ld + col) = w;
    }
};
struct FnResid {
    float* XS; const float* baseP; const float* baseS;
    __device__ __forceinline__ const float* brow(int row) const { return row < MP ? baseP + (size_t)row * DM : baseS + (size_t)(row - MP) * DM; }
    __device__ __forceinline__ void e8(int row, int col, f32x4 a, f32x4 b) const {
        const float* br = brow(row) + col; float* o = XS + (size_t)row * DM + col;
        const f32x4 x0 = *(const f32x4*)br, x1 = *(const f32x4*)(br + 4);
        *(f32x4*)o = x0 + a; *(f32x4*)(o + 4) = x1 + b;
    }
    __device__ __forceinline__ void e4(int row, int col, f32x4 a) const {
        const float* br = brow(row) + col; float* o = XS + (size_t)row * DM + col;
        *(f32x4*)o = *(const f32x4*)br + a;
    }
};
struct FnF32 {
    float* O; int ld;
    __device__ __forceinline__ void e8(int row, int col, f32x4 a, f32x4 b) const { float* o = O + (size_t)row * ld + col; *(f32x4*)o = a; *(f32x4*)(o + 4) = b; }
    __device__ __forceinline__ void e4(int row, int col, f32x4 a) const { *(f32x4*)(O + (size_t)row * ld + col) = a; }
};
struct FnKvq {
    bf16* O; const float* ssq;
    __device__ __forceinline__ float rstd(int row) const { const f32x4 s0 = *(const f32x4*)(ssq + (size_t)row * 8), s1 = *(const f32x4*)(ssq + (size_t)row * 8 + 4);
        return frsq((((s0.x + s0.y) + (s0.z + s0.w)) + ((s1.x + s1.y) + (s1.z + s1.w))) * (1.f / DM) + EPS); }
    __device__ __forceinline__ void e8(int row, int col, f32x4 a, f32x4 b) const {
        if (col < NKVQ_REAL) { const float rs = rstd(row); a = a * rs; b = b * rs; *(v4u*)(O + (size_t)row * NKVQ + col) = (v4u){pk2(a.x, a.y), pk2(a.z, a.w), pk2(b.x, b.y), pk2(b.z, b.w)}; }
    }
    __device__ __forceinline__ void e4(int row, int col, f32x4 a) const {
        if (col < NKVQ_REAL) { a = a * rstd(row); *(v2u*)(O + (size_t)row * NKVQ + col) = (v2u){pk2(a.x, a.y), pk2(a.z, a.w)}; }
    }
};

template <class Fn>
__device__ __forceinline__ void skinny_gemm(Frame& F, const bf16* A, const bf16* Bt, int N, int row_base, const Fn& fn) {
    const int fr = F.lane & 15, fq = F.lane >> 4;
    const int nun = N / 16;
    for (int u = F.bid; u < nun; u += F.G) {
        const bf16* ap = Bt + (size_t)(u * 16 + fr) * DM + fq * 8;
        const bf16* bp = A + (size_t)(F.wave * 16 + fr) * DM + fq * 8;
        f32x4 acc = {0.f, 0.f, 0.f, 0.f};
#pragma unroll 8
        for (int ks = 0; ks < 32; ++ks) acc = MFMA16(ld8(ap + ks * 32), ld8(bp + ks * 32), acc);
        fn.e4(row_base + F.wave * 16 + fr, u * 16 + 4 * fq, acc);
    }
}

template <class Fn>
__device__ __forceinline__ void gemm_all(Frame& F, const bf16* A, const bf16* Bt, int N, const Fn& fn) {
    pg8::Gemm g{A, Bt, MP, N, DM}; pg8::StaticOrder S; S.init(MP, N, F.G, F.bid);
    pg8::EpiFn<Fn> E{fn};
    pg8::gemm_phase<pg8::EpiFn<Fn>, pg8::StaticOrder, true, true>(F.lds, g, S, E);
    skinny_gemm(F, A + (size_t)MP * DM, Bt, N, MP, fn);
}

__device__ __forceinline__ void p0_transpose_item(const float* W, int N, bf16* WT, int row_off, const float* gain, LAS float* scr, int item, int lane) {
    const int nblk = (N + 31) / 32, kb = item / nblk, nb = item % nblk, k0 = 64 * kb, n0 = 32 * nb;
#pragma unroll 8
    for (int i = 0; i < 32; ++i) { const int kk = 2 * i + (lane >> 5); const int n = n0 + (lane & 31);
        float v = 0.f; if (n < N) { v = W[(size_t)(k0 + kk) * N + n]; if (gain) v *= gain[k0 + kk]; }
        scr[kk * 33 + (lane & 31)] = v; }
    LDS_WAIT(); asm volatile("" ::: "memory");
    const int c = lane & 7;
#pragma unroll
    for (int j = 0; j < 4; ++j) { const int n = (lane >> 3) + 8 * j; const LAS float* s = scr + (8 * c) * 33 + n;
        v4u o; o.x = pk2(s[0 * 33], s[1 * 33]); o.y = pk2(s[2 * 33], s[3 * 33]); o.z = pk2(s[4 * 33], s[5 * 33]); o.w = pk2(s[6 * 33], s[7 * 33]);
        if (n0 + n < N) *(v4u*)(WT + (size_t)(row_off + n0 + n) * DM + k0 + 8 * c) = o; }
    LDS_WAIT(); asm volatile("" ::: "memory");
}
__device__ __forceinline__ void rms_row_to_bf16(const float* xrow, bf16* orow, int lane) {
    const f32x4* xr = (const f32x4*)xrow + lane;
    f32x4 v[4]; float s = 0.f;
#pragma unroll
    for (int j = 0; j < 4; ++j) { v[j] = xr[64 * j]; s += (v[j].x * v[j].x + v[j].y * v[j].y) + (v[j].z * v[j].z + v[j].w * v[j].w); }
    const float rstd = frsq(wave_sum(s) * (1.f / DM) + EPS);
    v2u* o8 = (v2u*)orow + lane;
#pragma unroll
    for (int j = 0; j < 4; ++j) { v2u w; w.x = pk2(v[j].x * rstd, v[j].y * rstd); w.y = pk2(v[j].z * rstd, v[j].w * rstd); o8[64 * j] = w; }
}
__device__ __forceinline__ void rms_row_to_bf16_i8(const float* xrow, bf16* orow, unsigned* o8row, float* hs, int lane) {
    const f32x4* xr = (const f32x4*)xrow + lane;
    f32x4 v[4]; float s = 0.f, mx = 0.f;
#pragma unroll
    for (int j = 0; j < 4; ++j) { v[j] = xr[64 * j]; s += (v[j].x * v[j].x + v[j].y * v[j].y) + (v[j].z * v[j].z + v[j].w * v[j].w);
        mx = fmaxf(mx, fmaxf(fmaxf(fabsf(v[j].x), fabsf(v[j].y)), fmaxf(fabsf(v[j].z), fabsf(v[j].w)))); }
    const float rstd = frsq(wave_sum(s) * (1.f / DM) + EPS);
    mx = fmaxf(mx, dpp_f<DPP_XOR1>(mx)); mx = fmaxf(mx, dpp_f<DPP_XOR2>(mx)); mx = fmaxf(mx, dpp_f<DPP_HMIR>(mx)); mx = fmaxf(mx, dpp_f<DPP_MIR>(mx)); mx = x32_max(x16_max(mx));
    const float hmax = fmaxf(mx * rstd, 1e-20f), qs = 127.f * frcp(hmax);
    if (lane == 0) *hs = hmax * (1.f / 127.f);
    v2u* o16 = (v2u*)orow + lane;
#pragma unroll
    for (int j = 0; j < 4; ++j) { const f32x4 y = v[j] * rstd; v2u w; w.x = pk2(y.x, y.y); w.y = pk2(y.z, y.w); o16[64 * j] = w; o8row[lane + 64 * j] = pk_i8(y * qs); }
}
__device__ __forceinline__ const float* xin_row(Frame& F, int row) { return row < MP ? FIN(0) + (size_t)row * DM : FIN(1) + (size_t)(row - MP) * DM; }

__device__ __forceinline__ void peer_tables_to_fp8(Frame& F, size_t thr, size_t nthr, size_t lo = 0, size_t hi = (size_t)2 * NEXP * DM / 8) {
    const size_t gt = thr, NGT = nthr;
        for (int t = 0; t < 2; ++t) { const f32x4* src = (const f32x4*)FIN(27 + t); v2u* dst = (v2u*)WSP(unsigned char, t == 0 ? WS_PU : WS_PV); const float* pln = FIN(24);
            for (size_t i0 = lo + gt; i0 < hi; i0 += (size_t)4 * NGT) {
                f32x4 a[4], b[4];
#pragma unroll
                for (int u = 0; u < 4; ++u) { const size_t i = i0 + (size_t)u * NGT; if (i < hi) { a[u] = src[2 * i]; b[u] = src[2 * i + 1]; } }
#pragma unroll
                for (int u = 0; u < 4; ++u) { const size_t i = i0 + (size_t)u * NGT; if (i < hi) {
                    if (t == 0) { const float* gp = pln + ((i >> 21) << 10) + ((i & 127) << 3); a[u] = a[u] * *(const f32x4*)gp * 32.f; b[u] = b[u] * *(const f32x4*)(gp + 4) * 32.f; }
                    else { a[u] = a[u] * 16.f; b[u] = b[u] * 16.f; }
                    int w0, w1;
                    if (t == 0) { w0 = (int)pk_i8(a[u] * 19.f); w1 = (int)pk_i8(b[u] * 19.f); }
                    else { w0 = __builtin_amdgcn_cvt_pk_fp8_f32(a[u].x, a[u].y, 0, false); w0 = __builtin_amdgcn_cvt_pk_fp8_f32(a[u].z, a[u].w, w0, true);
                           w1 = __builtin_amdgcn_cvt_pk_fp8_f32(b[u].x, b[u].y, 0, false); w1 = __builtin_amdgcn_cvt_pk_fp8_f32(b[u].z, b[u].w, w1, true); }
                    dst[((((i >> 21) * 8 + ((i & 127) >> 4)) * (size_t)NEXP + ((i >> 7) & (NEXP - 1))) << 4) + (i & 15)] = (v2u){(unsigned)w0, (unsigned)w1}; } } } }
}

constexpr int FD_BUF = 16384;
__device__ __forceinline__ void fs_direct_task(Frame& F, int task) {
    int lane_ = F.lane; asm volatile("" : "+v"(lane_));
    const int lane = lane_, w = F.wave, fr = lane & 15, fq = lane >> 4, kv = w >> 2, g = w & 3, bs = task >> 4, c0 = (task & 15) * 32;
    LAS unsigned char* L = F.lds; asm volatile("" : "+v"(L));
    const float* cache = FIN(2); const int* pt = (const int*)FIN(6) + bs * NPAGES;
    const float* base[2];
#pragma unroll
    for (int nt = 0; nt < 2; ++nt) { const int t0 = 16 * (c0 + 16 * nt + fr); base[nt] = cache + ((size_t)pt[t0 >> 7] * PAGE + (t0 & 127)) * 1024 + kv * 256 + g * 64 + 8 * fq; }
    const bf16* wsrc[2]; int wdst[2];
#pragma unroll
    for (int q = 0; q < 2; ++q) { const int item = F.tid + 512 * q, kvw = item >> 9, n = (item >> 2) & 127, kq = item & 3;
        wsrc[q] = WSP(bf16, WS_W1BD) + (size_t)(kvw * 128 + n) * 2048 + kvw * 1024 + 8 * kq; wdst[q] = ((kvw * 8 + (n >> 4)) * 64 + kq * 16 + (n & 15)) * 16; }
    f32x4 acc[2][8];
#pragma unroll
    for (int nt = 0; nt < 2; ++nt)
#pragma unroll
        for (int mt = 0; mt < 8; ++mt) acc[nt][mt] = (f32x4){0.f, 0.f, 0.f, 0.f};
    f32x4 S0[2][4], S1[2][4]; v4u wr[2];
#define FD_DATA(S, r) do { const int r_ = (r) < 16 ? (r) : 15; _Pragma("unroll") for (int nt_ = 0; nt_ < 2; ++nt_) { const float* p_ = base[nt_] + r_ * 1024; \
        S[nt_][0] = *(const f32x4*)p_; S[nt_][1] = *(const f32x4*)(p_ + 4); S[nt_][2] = *(const f32x4*)(p_ + 32); S[nt_][3] = *(const f32x4*)(p_ + 36); } } while (0)
#define FD_WLOAD(ks) do { const int ks_ = (ks) < 32 ? (ks) : 31; wr[0] = *(const v4u*)(wsrc[0] + 32 * ks_); wr[1] = *(const v4u*)(wsrc[1] + 32 * ks_); } while (0)
#define FD_WSTORE(buf) do { *(LAS v4u*)(L + (buf) * FD_BUF + wdst[0]) = wr[0]; *(LAS v4u*)(L + (buf) * FD_BUF + wdst[1]) = wr[1]; } while (0)
#define FD_KSTEP(bq, ks, buf) do { \
        _Pragma("unroll") for (int mt_ = 0; mt_ < 8; ++mt_) { const bf16x8 a_ = *(const LAS bf16x8*)(L + (buf) * FD_BUF + ((kv * 8 + mt_) * 64 + lane) * 16); \
            acc[0][mt_] = MFMA16(a_, bq[0], acc[0][mt_]); acc[1][mt_] = MFMA16(a_, bq[1], acc[1][mt_]); } \
        FD_WSTORE((buf) ^ 1); FD_WLOAD((ks) + 2); \
        __syncthreads(); } while (0)
#define FD_ROW(S, r) do { bf16x8 b0_[2], b1_[2]; _Pragma("unroll") for (int nt_ = 0; nt_ < 2; ++nt_) { b0_[nt_] = cvt8(S[nt_][0], S[nt_][1]); b1_[nt_] = cvt8(S[nt_][2], S[nt_][3]); } \
        FD_DATA(S, (r) + 2); \
        FD_KSTEP(b0_, 2 * (r), 0); FD_KSTEP(b1_, 2 * (r) + 1, 1); } while (0)
    FD_WLOAD(0); FD_WSTORE(0); FD_WLOAD(1); FD_DATA(S0, 0); FD_DATA(S1, 1);
    __syncthreads();
#pragma unroll 1
    for (int r = 0; r < 16; r += 2) { FD_ROW(S0, r); FD_ROW(S1, r + 1); }
#undef FD_KSTEP
#undef FD_ROW
#undef FD_DATA
#undef FD_WLOAD
#undef FD_WSTORE
    bf16* fs = WSP(bf16, WS_FS) + ((size_t)(bs * 4 + g) * 512 + c0 + fr) * 256 + kv * 128 + 4 * fq;
#pragma unroll
    for (int nt = 0; nt < 2; ++nt)
#pragma unroll
        for (int mt = 0; mt < 8; ++mt) *(v2u*)(fs + (size_t)nt * 16 * 256 + 16 * mt) = (v2u){pk2(acc[nt][mt][0], acc[nt][mt][1]), pk2(acc[nt][mt][2], acc[nt][mt][3])};
    __syncthreads();
}

__device__ __forceinline__ void p0_prologue(Frame& F) {
    LAS float* scr = (LAS float*)(F.lds + F.wave * 16384);
    const int gw = F.bid * 8 + F.wave, NGW = F.G * 8;
    const int gt = F.bid * 512 + F.tid, NGT = F.G * 512;
    {
        constexpr int I_IN = 128 * 16, I_OA = 32 * 16, I_KV = 48 * 16, I_QG = 34 * 16, I_OB = 32 * 16, I_PQ = 64 * 16;
        constexpr int NITEMS = I_IN + I_OA + I_KV + I_QG + I_OB + 2 * I_PQ;
        for (int it = gw; it < NITEMS; it += NGW) {
            int r = it;
            if (r < I_IN) {
                const int kb = r / 128, nb = r % 128, k0 = 64 * kb, n0 = 32 * nb; const float* W = FIN(8); const float* gain = FIN(7);
#pragma unroll 8
                for (int i = 0; i < 32; ++i) { const int kk = 2 * i + (F.lane >> 5); scr[kk * 33 + (F.lane & 31)] = W[(size_t)(k0 + kk) * GPROJ + n0 + (F.lane & 31)] * gain[k0 + kk]; }
                LDS_WAIT(); asm volatile("" ::: "memory");
                const int c = F.lane & 7;
#pragma unroll
                for (int j = 0; j < 4; ++j) { const int n = (F.lane >> 3) + 8 * j; const LAS float* s = scr + (8 * c) * 33 + n;
                    v4u o; o.x = pk2(s[0 * 33], s[1 * 33]); o.y = pk2(s[2 * 33], s[3 * 33]); o.z = pk2(s[4 * 33], s[5 * 33]); o.w = pk2(s[6 * 33], s[7 * 33]);
                    *(v4u*)(WSP(bf16, WS_WIN_T) + (size_t)(n0 + n) * DM + k0 + 8 * c) = o; }
                LDS_WAIT(); asm volatile("" ::: "memory");
                continue; }
            r -= I_IN;
            if (r < I_OA) { p0_transpose_item(FIN(13), 1024, WSP(bf16, WS_WOA_T), 0, nullptr, scr, r, F.lane); continue; } r -= I_OA;
            if (r < I_KV) { p0_transpose_item(FIN(15), NKV, WSP(bf16, WS_WKVQ_T), 0, FIN(14), scr, r, F.lane); continue; } r -= I_KV;
            if (r < I_QG) { p0_transpose_item(FIN(21), NQG, WSP(bf16, WS_WKVQ_T), NKV, FIN(20), scr, r, F.lane); continue; } r -= I_QG;
            if (r < I_OB) { p0_transpose_item(FIN(23), 1024, WSP(bf16, WS_WOB_T), 0, nullptr, scr, r, F.lane); continue; } r -= I_OB;
            if (r < I_PQ) { p0_transpose_item(FIN(25), 2048, WSP(bf16, WS_WPQ_T), 0, FIN(24), scr, r, F.lane); continue; } r -= I_PQ;
            p0_transpose_item(FIN(25) + (size_t)1024 * 2048, 2048, WSP(bf16, WS_WPQ_T) + (size_t)2048 * 1024, 0, FIN(24) + 1024, scr, r, F.lane);
        }
        for (int i = gt; i < (NKVQ - NKVQ_REAL) * DM / 8; i += NGT) ((v4u*)(WSP(bf16, WS_WKVQ_T) + (size_t)NKVQ_REAL * DM))[i] = (v4u){0u, 0u, 0u, 0u};
        for (int i = gt; i < 16 * 1024; i += NGT) { const int j = i >> 10, k = i & 1023; WSP(float, WS_WAB)[i] = FIN(7)[k] * FIN(8)[(size_t)k * GPROJ + 4096 + j]; }
    }
    for (int m = gw; m < MTOK; m += NGW) rms_row_to_bf16(xin_row(F, m), WSP(bf16, WS_XNA) + (size_t)m * DM, F.lane);
    {
        if (F.G != 256) peer_tables_to_fp8(F, (size_t)gt, (size_t)NGT);
        const f32x4* sk = (const f32x4*)FIN(26); v4u* dk = (v4u*)WSP(bf16, WS_SUBK);
        for (int i = gt; i < 2 * 8 * 2 * 128 * 128 / 8; i += NGT) { const f32x4 a = sk[2 * i], b = sk[2 * i + 1]; v4u w; w.x = pk2(a.x, a.y); w.y = pk2(a.z, a.w); w.z = pk2(b.x, b.y); w.w = pk2(b.z, b.w); dk[i] = w; }
    }
    for (int i = gt; i < 2 * 64 * 2048; i += NGT) { const int kv = i >> 17, hh = (i >> 11) & 63, k = i & 2047;
        WSP(bf16, WS_W1T)[i] = (bf16)f2bf(FIN(17)[((size_t)kv * 2048 + k) * 64 + hh]); }
    for (int i = gt; i < 2 * 4 * 2 * 64 * 8; i += NGT) { const int e = i & 7, ln = (i >> 3) & 63, sx = (i >> 9) & 1, dt = (i >> 10) & 3, kv = i >> 12, fr_ = ln & 15, fq_ = ln >> 4;
        WSP(bf16, WS_W2F)[i] = (bf16)f2bf(FIN(19)[((size_t)kv * 64 + 16 * (2 * sx + (e >> 2)) + 4 * fq_ + (e & 3)) * 64 + 16 * dt + fr_]); }
    for (int it = gw; it < 128; it += NGW) { const int kv = it >> 6, h = it & 63; float s = 0.f;
        for (int k = F.lane; k < 2048; k += 64) s += FIN(18)[(size_t)kv * 2048 + k] * FIN(17)[((size_t)kv * 2048 + k) * 64 + h];
        s = wave_sum(s); if (F.lane == 0) WSP(float, WS_PETERM)[it] = s; }
    {
        bf16* wbd = WSP(bf16, WS_W1BD);
        for (int i = gt; i < 256 * 2048; i += NGT) { const int n = i >> 11, col = i & 2047, kv = n >> 7, sec = (n >> 6) & 1, hh = n & 63;
            float v = 0.f; if ((col >> 10) == kv) { const int k = col & 1023, r = (k >> 6) + 16 * sec, d = k & 63; v = FIN(17)[(((size_t)kv * 32 + r) * 64 + d) * 64 + hh]; }
            wbd[i] = (bf16)f2bf(v); }
    }
    {
        const f32x4* src = (const f32x4*)FIN(3); f32x4* dst = (f32x4*)(F.out + O_WINS);
        const int per_b = 508 * 512 / 4;
        for (int i = gt; i < SB * per_b; i += NGT) { const int b = i / per_b, r = i % per_b; dst[(size_t)b * (512 * 512 / 4) + r] = src[(size_t)b * (512 * 512 / 4) + 4 * 512 / 4 + r]; }
    }
    for (int i = gt; i < SB * NG * 544 * 64; i += NGT) {
        const int d = i & 63, r = (i >> 6) % 544, bg = (i >> 6) / 544, g = bg & 3, b = bg >> 2;
        if (r < 512) { const float* cw = FIN(3) + (((size_t)b * 512 + r) * 2) * 256 + g * 64 + d;
            WSP(bf16, WS_SKWIN)[i] = (bf16)f2bf(cw[0]);
            WSP(bf16, WS_SVWINT)[((size_t)bg * 64 + d) * 544 + r] = (bf16)f2bf(cw[256]); }
        else if (r >= 516) { WSP(bf16, WS_SKWIN)[i] = 0; WSP(bf16, WS_SVWINT)[((size_t)bg * 64 + d) * 544 + r] = 0; }
    }
}

constexpr int P2_QS = 0, P2_KS = 17408, P2_KBGT = 34816, P2_VBT = 53248, P2_AM = 71680, P2_TB = 89088, P2_G = 98304, P2_TF = 99328, P2_XF = 116736;
constexpr int QS_LD = 136, KT_LD = 72, AM_LD = 68, TB_LD = 72;

__device__ __forceinline__ float softplus_f(float x) { return fmaxf(x, 0.f) + __logf(1.f + __expf(-fabsf(x))); }

__device__ __forceinline__ void p2_chunk(Frame& F, int unit) {
    const int c = unit & 127, h = (unit >> 7) & 7, b = unit >> 10;
    const int t0 = c * CHUNK, lane = F.lane, w = F.wave, fr = lane & 15, fq = lane >> 4;
    LAS unsigned char* L = F.lds; asm volatile("" : "+v"(L));
    LAS bf16* qs = (LAS bf16*)(L + P2_QS); LAS bf16* ks = (LAS bf16*)(L + P2_KS);
    LAS bf16* kbgT = (LAS bf16*)(L + P2_KBGT); LAS bf16* vbT = (LAS bf16*)(L + P2_VBT);
    LAS float* Am = (LAS float*)(L + P2_AM); LAS bf16* Tb = (LAS bf16*)(L + P2_TB);
    LAS float* Gs = (LAS float*)(L + P2_G);
    const bf16* PROJ = WSP(bf16, WS_PROJ); const bf16* XNA = WSP(bf16, WS_XNA); const float* WAB = WSP(float, WS_WAB);
    const size_t rowb = (size_t)b * PT;
    float beta_r[8];
    {
        f32x4 wa[4], wb[4];
        const float* pa = WAB + (size_t)h * DM + 8 * lane; const float* pb = WAB + (size_t)(8 + h) * DM + 8 * lane;
        wa[0] = *(const f32x4*)pa; wa[1] = *(const f32x4*)(pa + 4); wa[2] = *(const f32x4*)(pa + 512); wa[3] = *(const f32x4*)(pa + 516);
        wb[0] = *(const f32x4*)pb; wb[1] = *(const f32x4*)(pb + 4); wb[2] = *(const f32x4*)(pb + 512); wb[3] = *(const f32x4*)(pb + 516);
        const float Aneg = -expf(FIN(10)[h]), dtb = FIN(11)[h];
#pragma unroll
        for (int tk = 0; tk < 8; ++tk) {
            const int tok = 8 * w + tk; const bf16* xr = XNA + (rowb + t0 + tok) * DM + 8 * lane;
            const v4u x0 = *(const v4u*)xr, x1 = *(const v4u*)(xr + 512);
            float sa = 0.f, sb = 0.f;
#define ACC2(xw, wv0, wv1, i0) { const float lo = bflo(xw), hi = bfhi(xw); sa += lo * wv0[i0] + hi * wv0[i0 + 1]; sb += lo * wv1[i0] + hi * wv1[i0 + 1]; }
            ACC2(x0.x, wa[0], wb[0], 0) ACC2(x0.y, wa[0], wb[0], 2) ACC2(x0.z, wa[1], wb[1], 0) ACC2(x0.w, wa[1], wb[1], 2)
            ACC2(x1.x, wa[2], wb[2], 0) ACC2(x1.y, wa[2], wb[2], 2) ACC2(x1.z, wa[3], wb[3], 0) ACC2(x1.w, wa[3], wb[3], 2)
#undef ACC2
            sa = wave_sum(sa); sb = wave_sum(sb);
            const float g = Aneg * softplus_f(sa + dtb), be = sigmoid_f(sb);
            beta_r[tk] = be;
            if (lane == 0) { Gs[tok] = g; Gs[64 + tok] = be; }
        }
    }
#pragma unroll
    for (int p = 0; p < 3; ++p) {
        const int col0 = p * 1024 + h * 128 + 2 * lane;
        float cw0[4], cw1[4];
#pragma unroll
        for (int i = 0; i < 4; ++i) { const f32x2 cv = *(const f32x2*)(FIN(9) + (size_t)i * GCONV + col0); cw0[i] = cv.x; cw1[i] = cv.y; }
        unsigned xw[11];
#pragma unroll
        for (int rr = 0; rr < 11; ++rr) { const int t = t0 + 8 * w - 3 + rr; xw[rr] = (t >= 0) ? *(const unsigned*)(PROJ + (rowb + t) * 4096 + col0) : 0u; }
        if (c == 127 && w == 7) {
#pragma unroll
            for (int r = 0; r < 3; ++r) { float* o = F.out + O_CONVP + ((size_t)b * 3 + r) * GCONV + col0; o[0] = bflo(xw[8 + r]); o[1] = bfhi(xw[8 + r]); }
        }
#pragma unroll
        for (int tk = 0; tk < 8; ++tk) {
            const int tok = 8 * w + tk;
            float y0 = 0.f, y1 = 0.f;
#pragma unroll
            for (int i = 0; i < 4; ++i) { y0 += cw0[i] * bflo(xw[tk + i]); y1 += cw1[i] * bfhi(xw[tk + i]); }
            y0 = silu_f(y0); y1 = silu_f(y1);
            if (p < 2) {
                const float ss = wave_sum(y0 * y0 + y1 * y1);
                const float rs = (frsq(ss + EPS)) * (p == 0 ? 0.08838834764831845f : 1.f);
                *(LAS unsigned*)((p == 0 ? qs : ks) + tok * QS_LD + 2 * lane) = pk2(y0 * rs, y1 * rs);
            } else {
                vbT[(2 * lane) * KT_LD + tok] = (bf16)f2bf(y0 * beta_r[tk]); vbT[(2 * lane + 1) * KT_LD + tok] = (bf16)f2bf(y1 * beta_r[tk]);
            }
        }
    }
    __syncthreads();
    if (w == 0) { float g = Gs[lane];
#pragma unroll
        for (int o = 1; o < 64; o <<= 1) { const float up = __shfl_up(g, o); if (lane >= o) g += up; }
        Gs[128 + lane] = g; }
    __syncthreads();
    const float glast = Gs[128 + 63];
    const size_t chunk = (size_t)unit;
    if (w < 4) {
        const int mt = w;
        bf16x8 a[4];
#pragma unroll
        for (int kk = 0; kk < 4; ++kk) a[kk] = ld8l(ks + (16 * mt + fr) * QS_LD + 32 * kk + 8 * fq);
#pragma unroll
        for (int nt = 0; nt < 4; ++nt) {
            f32x4 acc = {0.f, 0.f, 0.f, 0.f};
            if (nt <= mt) {
#pragma unroll
                for (int kk = 0; kk < 4; ++kk) acc = MFMA16(a[kk], ld8l(ks + (16 * nt + fr) * QS_LD + 32 * kk + 8 * fq), acc);
            }
            const int j = 16 * nt + fr; const float gj = Gs[128 + j];
#pragma unroll
            for (int r = 0; r < 4; ++r) { const int i = 16 * mt + 4 * fq + r;
                Am[i * AM_LD + j] = (i > j) ? Gs[64 + i] * acc[r] * __expf(Gs[128 + i] - gj) : 0.f; }
        }
    } else {
        const int nt = w - 4;
        bf16x8 bq[4];
#pragma unroll
        for (int kk = 0; kk < 4; ++kk) bq[kk] = ld8l(qs + (16 * nt + fr) * QS_LD + 32 * kk + 8 * fq);
        const int i = 16 * nt + fr; const float gi = Gs[128 + i];
        bf16* gqk = WSP(bf16, WS_GQK) + chunk * 4096;
#pragma unroll
        for (int mt = 0; mt < 4; ++mt) {
            f32x4 acc = {0.f, 0.f, 0.f, 0.f};
            if (mt <= nt) {
#pragma unroll
                for (int kk = 0; kk < 4; ++kk) acc = MFMA16(ld8l(ks + (16 * mt + fr) * QS_LD + 32 * kk + 8 * fq), bq[kk], acc);
            }
            float v[4];
#pragma unroll
            for (int r = 0; r < 4; ++r) { const int j = 16 * mt + 4 * fq + r; v[r] = (i >= j) ? acc[r] * __expf(gi - Gs[128 + j]) : 0.f; }
            v2u o; o.x = pk2(v[0], v[1]); o.y = pk2(v[2], v[3]);
            *(v2u*)(gqk + (((nt * 2 + (mt >> 1)) * 64 + (2 * (mt & 1) + (fq >> 1)) * 16 + fr) * 8 + 4 * (fq & 1))) = o;
        }
    }
    {
        const int tok = F.tid >> 3, d0 = (F.tid & 7) * 16; const float e = __expf(Gs[128 + tok]);
        bf16* gq = WSP(bf16, WS_GQ) + chunk * 8192;
#pragma unroll
        for (int hh = 0; hh < 2; ++hh) { const v4u q = *(const LAS v4u*)(qs + tok * QS_LD + d0 + 8 * hh); v4u o;
            o.x = pk2(bflo(q.x) * e, bfhi(q.x) * e); o.y = pk2(bflo(q.y) * e, bfhi(q.y) * e); o.z = pk2(bflo(q.z) * e, bfhi(q.z) * e); o.w = pk2(bflo(q.w) * e, bfhi(q.w) * e);
            *(v4u*)(gq + ((((tok >> 4) * 4 + ((F.tid & 7) >> 1)) * 64 + (2 * (F.tid & 1) + hh) * 16 + (tok & 15)) * 8)) = o; }
    }
    {
        const int dk = F.tid & 127, tg = F.tid >> 7;
        unsigned o1[8], o2[8];
#pragma unroll
        for (int i = 0; i < 8; ++i) {
            const int ta = 16 * tg + 2 * i, tb2 = ta + 1;
            const float ka = bf2f(ks[ta * QS_LD + dk]), kb = bf2f(ks[tb2 * QS_LD + dk]);
            const float ga = Gs[128 + ta], gb = Gs[128 + tb2];
            o1[i] = pk2(ka * Gs[64 + ta] * __expf(ga), kb * Gs[64 + tb2] * __expf(gb));
            o2[i] = pk2(ka * __expf(glast - ga), kb * __expf(glast - gb));
        }
        LAS v4u* d1 = (LAS v4u*)(kbgT + dk * KT_LD + 16 * tg); d1[0] = (v4u){o1[0], o1[1], o1[2], o1[3]}; d1[1] = (v4u){o1[4], o1[5], o1[6], o1[7]};
        bf16* d2 = WSP(bf16, WS_GKT) + chunk * 8192 + ((((dk >> 4) * 2 + (tg >> 1)) * 64 + (2 * (tg & 1)) * 16 + (dk & 15)) * 8);
        *(v4u*)d2 = (v4u){o2[0], o2[1], o2[2], o2[3]}; *(v4u*)(d2 + 16 * 8) = (v4u){o2[4], o2[5], o2[6], o2[7]};
    }
    if (F.tid == 0) WSP(float, WS_GDEC)[chunk] = __expf(glast);
    __syncthreads();
    LAS float* Tf = (LAS float*)(L + P2_TF); LAS float* Xf = (LAS float*)(L + P2_XF);
    if (w == 0) {
        const int blk = lane >> 5, cc = lane & 31; const LAS float* Ab = Am + (32 * blk) * AM_LD + 32 * blk;
        float t[32];
#pragma unroll
        for (int i = 0; i < 32; ++i) {
            float acc0 = (i == cc) ? 1.f : 0.f, acc1 = 0.f, acc2 = 0.f, acc3 = 0.f;
#pragma unroll
            for (int j4 = 0; j4 < (i + 3) / 4; ++j4) {
                const f32x4 a = *(const LAS f32x4*)(Ab + i * AM_LD + 4 * j4);
                if (4 * j4 + 0 < i) acc0 = __builtin_fmaf(-a.x, t[4 * j4 + 0], acc0);
                if (4 * j4 + 1 < i) acc1 = __builtin_fmaf(-a.y, t[4 * j4 + 1], acc1);
                if (4 * j4 + 2 < i) acc2 = __builtin_fmaf(-a.z, t[4 * j4 + 2], acc2);
                if (4 * j4 + 3 < i) acc3 = __builtin_fmaf(-a.w, t[4 * j4 + 3], acc3);
            }
            t[i] = (acc0 + acc1) + (acc2 + acc3);
            asm volatile("" : "+v"(t[i]));
            __builtin_amdgcn_sched_barrier(0);
        }
#pragma unroll
        for (int i = 0; i < 32; ++i) { Tf[(32 * blk + i) * AM_LD + 32 * blk + cc] = t[i]; if (blk == 0) Tf[i * AM_LD + 32 + cc] = 0.f; }
    }
    __syncthreads();
    {
        const int i = F.tid >> 4, c0 = (F.tid & 15) * 2; float x0 = 0.f, x1 = 0.f;
#pragma unroll 8
        for (int k = 0; k < 32; ++k) { const float a = Am[(32 + i) * AM_LD + k]; x0 = __builtin_fmaf(a, Tf[k * AM_LD + c0], x0); x1 = __builtin_fmaf(a, Tf[k * AM_LD + c0 + 1], x1); }
        Xf[i * 34 + c0] = x0; Xf[i * 34 + c0 + 1] = x1;
    }
    __syncthreads();
    {
        const int i = F.tid >> 4, c0 = (F.tid & 15) * 2; float x0 = 0.f, x1 = 0.f;
#pragma unroll 8
        for (int k = 0; k < 32; ++k) { const float a = Tf[(32 + i) * AM_LD + 32 + k]; x0 = __builtin_fmaf(a, Xf[k * 34 + c0], x0); x1 = __builtin_fmaf(a, Xf[k * 34 + c0 + 1], x1); }
        Tf[(32 + i) * AM_LD + c0] = -x0; Tf[(32 + i) * AM_LD + c0 + 1] = -x1;
    }
    __syncthreads();
    {
        const int i = F.tid >> 3, c0 = (F.tid & 7) * 8; const f32x4 a = *(const LAS f32x4*)(Tf + i * AM_LD + c0), b2 = *(const LAS f32x4*)(Tf + i * AM_LD + c0 + 4);
        *(LAS v4u*)(Tb + i * TB_LD + c0) = (v4u){pk2(a.x, a.y), pk2(a.z, a.w), pk2(b2.x, b2.y), pk2(b2.z, b2.w)};
    }
    __syncthreads();
    {
        bf16x8 tb[4][2];
#pragma unroll
        for (int x = 0; x < 4; ++x)
#pragma unroll
            for (int s = 0; s < 2; ++s) tb[x][s] = ld8l(Tb + (16 * x + fr) * TB_LD + 32 * s + 8 * fq);
        const bf16x8 bv0 = ld8l(vbT + (16 * w + fr) * KT_LD + 8 * fq), bv1 = ld8l(vbT + (16 * w + fr) * KT_LD + 32 + 8 * fq);
        bf16* gu = WSP(bf16, WS_GU) + chunk * 8192 + ((size_t)((w >> 1) * 4 * 64 + lane) * 2 + (w & 1)) * 4;
#pragma unroll
        for (int mt = 0; mt < 4; ++mt) { f32x4 acc = {0.f, 0.f, 0.f, 0.f}; acc = MFMA16(tb[mt][0], bv0, acc); acc = MFMA16(tb[mt][1], bv1, acc); *(v2u*)(gu + mt * 64 * 8) = (v2u){pk2(acc[0], acc[1]), pk2(acc[2], acc[3])}; }
        const bf16x8 ak0 = ld8l(kbgT + (16 * w + fr) * KT_LD + 8 * fq), ak1 = ld8l(kbgT + (16 * w + fr) * KT_LD + 32 + 8 * fq);
        bf16* gw = WSP(bf16, WS_GW) + chunk * 8192;
#pragma unroll
        for (int nt = 0; nt < 4; ++nt) { f32x4 acc = {0.f, 0.f, 0.f, 0.f}; acc = MFMA16(ak0, tb[nt][0], acc); acc = MFMA16(ak1, tb[nt][1], acc);
            v2u o; o.x = pk2(acc[0], acc[1]); o.y = pk2(acc[2], acc[3]);
            *(v2u*)(gw + (((nt * 4 + (w >> 1)) * 64 + (2 * (w & 1) + (fq >> 1)) * 16 + fr) * 8 + 4 * (fq & 1))) = o; }
    }
    __syncthreads();
}

constexpr int S2_Y = 0;
constexpr int S2_AB = 6144;
constexpr int S2_DOT = 6400;
constexpr int S2_U = 6656;
constexpr int S2_W = 8704;
constexpr int S2_VN = 10752;
__device__ __forceinline__ void p2_sample(Frame& F, int unit) {
    const int h = unit & 7, bs = unit >> 3, tid = F.tid, lane = F.lane, w = F.wave;
    LAS unsigned char* L = F.lds; asm volatile("" : "+v"(L));
    LAS float* Y = (LAS float*)(L + S2_Y); LAS float* AB = (LAS float*)(L + S2_AB); LAS float* DOT = (LAS float*)(L + S2_DOT);
    LAS float* U = (LAS float*)(L + S2_U); LAS float* W = (LAS float*)(L + S2_W); LAS float* VN = (LAS float*)(L + S2_VN);
    const bf16* PROJ = WSP(bf16, WS_PROJ); const bf16* XNA = WSP(bf16, WS_XNA); const float* WAB = WSP(float, WS_WAB);
    const size_t row0 = (size_t)MP + bs * 4;
    if (tid < 384) {
        const int part = tid >> 7, cc = tid & 127, col = part * 1024 + h * 128 + cc;
        float buf[7];
#pragma unroll
        for (int r = 0; r < 3; ++r) buf[r] = FIN(5)[((size_t)bs * 3 + r) * GCONV + col];
#pragma unroll
        for (int i = 0; i < 4; ++i) buf[3 + i] = bf2f(PROJ[(row0 + i) * 4096 + col]);
#pragma unroll
        for (int r = 0; r < 3; ++r) F.out[O_CONVS + ((size_t)bs * 3 + r) * GCONV + col] = buf[4 + r];
        float cw[4];
#pragma unroll
        for (int i = 0; i < 4; ++i) cw[i] = FIN(9)[(size_t)i * GCONV + col];
#pragma unroll
        for (int i = 0; i < 4; ++i) { float y = 0.f;
#pragma unroll
            for (int k = 0; k < 4; ++k) y += cw[k] * buf[i + k];
            Y[(part * 4 + i) * 128 + cc] = silu_f(y); }
    }
    {
        const int i = w >> 1, which = w & 1; const bf16* xr = XNA + (row0 + i) * DM; const float* wr = WAB + (size_t)(which * 8 + h) * DM; float s = 0.f;
        for (int k = lane; k < DM; k += 64) s += bf2f(xr[k]) * wr[k];
        s = wave_sum(s); if (lane == 0) AB[which * 4 + i] = s;
    }
    __syncthreads();
    {
        const int part = w >> 2, i = w & 3; LAS float* y = Y + (part * 4 + i) * 128; const float a = y[lane], bq = y[64 + lane];
        const float ss = wave_sum(a * a + bq * bq); const float rs = (frsq(ss + EPS)) * (part == 0 ? 0.08838834764831845f : 1.f);
        y[lane] = a * rs; y[64 + lane] = bq * rs;
    }
    if (tid == 0) { const float Aneg = -expf(FIN(10)[h]), dtb = FIN(11)[h]; float gc = 0.f;
        for (int i = 0; i < 4; ++i) { const float g = Aneg * softplus_f(AB[i] + dtb); gc += g; AB[8 + i] = g; AB[12 + i] = 1.f / (1.f + expf(-AB[4 + i])); AB[16 + i] = gc; } }
    __syncthreads();
    {
#pragma unroll
        for (int pp = 0; pp < 4; ++pp) { const int pr = 4 * w + pp, which = pr >> 4, i = (pr >> 2) & 3, j = pr & 3;
            const LAS float* x = Y + ((which == 0 ? 1 : 0) * 4 + i) * 128; const LAS float* y = Y + (1 * 4 + j) * 128;
            float s = x[lane] * y[lane] + x[64 + lane] * y[64 + lane]; s = wave_sum(s); if (lane == 0) DOT[pr] = s; }
    }
    __syncthreads();
    float g_[4], be[4], gc[4];
#pragma unroll
    for (int i = 0; i < 4; ++i) { g_[i] = AB[8 + i]; be[i] = AB[12 + i]; gc[i] = AB[16 + i]; }
    float Tm[4][4];
    {
        float A[4][4];
#pragma unroll
        for (int i = 0; i < 4; ++i)
#pragma unroll
            for (int j = 0; j < 4; ++j) A[i][j] = (i > j) ? be[i] * DOT[i * 4 + j] * expf(gc[i] - gc[j]) : 0.f;
#pragma unroll
        for (int cc = 0; cc < 4; ++cc)
#pragma unroll
            for (int i = 0; i < 4; ++i) { float acc = (i == cc) ? 1.f : 0.f;
#pragma unroll
                for (int j = 0; j < 4; ++j) if (j < i) acc -= A[i][j] * Tm[j][cc];
                Tm[i][cc] = acc; }
    }
    {
        const int i = tid >> 7, x = tid & 127; float su = 0.f, sw = 0.f;
#pragma unroll
        for (int j = 0; j < 4; ++j) { su += Tm[i][j] * Y[(2 * 4 + j) * 128 + x] * be[j]; sw += Tm[i][j] * Y[(1 * 4 + j) * 128 + x] * be[j] * expf(gc[j]); }
        U[i * 128 + x] = su; W[i * 128 + x] = sw;
    }
    __syncthreads();
    const float* S0 = FIN(4) + ((size_t)bs * GH + h) * 128 * 128;
    const int dv = tid & 127, dg = tid >> 7;
    LAS float* SL = (LAS float*)(L + 32768);
#pragma unroll 16
    for (int r = 0; r < 32; ++r) SL[(32 * dg + r) * 128 + dv] = S0[(size_t)(32 * dg + r) * 128 + dv];
    LAS float* PP = (LAS float*)(L + 16384); LAS float* PQ = (LAS float*)(L + 16384 + 8192);
    {
        float pp[4] = {0.f, 0.f, 0.f, 0.f}, qp[4] = {0.f, 0.f, 0.f, 0.f};
#pragma unroll
        for (int r = 0; r < 32; ++r) { const int dk = 32 * dg + r; const float sv = SL[dk * 128 + dv];
#pragma unroll
            for (int i = 0; i < 4; ++i) { pp[i] += W[i * 128 + dk] * sv; qp[i] += Y[(0 * 4 + i) * 128 + dk] * sv; } }
#pragma unroll
        for (int i = 0; i < 4; ++i) { PP[(dg * 4 + i) * 128 + dv] = pp[i]; PQ[(dg * 4 + i) * 128 + dv] = qp[i]; }
    }
    __syncthreads();
    float qs_acc;
    {
        const int i = tid >> 7;
        const float p = (PP[(0 * 4 + i) * 128 + dv] + PP[(1 * 4 + i) * 128 + dv]) + (PP[(2 * 4 + i) * 128 + dv] + PP[(3 * 4 + i) * 128 + dv]);
        const float qq = (PQ[(0 * 4 + i) * 128 + dv] + PQ[(1 * 4 + i) * 128 + dv]) + (PQ[(2 * 4 + i) * 128 + dv] + PQ[(3 * 4 + i) * 128 + dv]);
        VN[i * 128 + dv] = U[i * 128 + dv] - p; qs_acc = qq * expf(gc[i]);
    }
    __syncthreads();
    {
        const int i = tid >> 7; float o = qs_acc;
#pragma unroll
        for (int j = 0; j < 4; ++j) if (j <= i) o += DOT[16 + i * 4 + j] * expf(gc[i] - gc[j]) * VN[j * 128 + dv];
        WSP(bf16, WS_OGDN)[(row0 + i) * DM + h * 128 + dv] = (bf16)f2bf(o);
    }
    {
        const float el = expf(gc[3]);
        float kd[4], vn[4];
#pragma unroll
        for (int j = 0; j < 4; ++j) { kd[j] = expf(gc[3] - gc[j]); vn[j] = VN[j * 128 + dv]; }
        float* So = F.out + O_GDNS + ((size_t)bs * GH + h) * 128 * 128;
#pragma unroll
        for (int r = 0; r < 32; ++r) { const int dk = 32 * dg + r; float sv = SL[dk * 128 + dv] * el;
#pragma unroll
            for (int j = 0; j < 4; ++j) sv += Y[(1 * 4 + j) * 128 + dk] * kd[j] * vn[j];
            So[(size_t)dk * 128 + dv] = sv; }
    }
    (void)g_;
    __syncthreads();
}

constexpr int P3_S = 0;
constexpr int P3_VN = 16384;
__device__ __forceinline__ void p3_scan(Frame& F, int bh, int s) {
    const int lane = F.lane, w = F.wave, fr = lane & 15, fq = lane >> 4;
    const int b = bh >> 3, h = bh & 7;
    LAS bf16* Sl = (LAS bf16*)(F.lds + P3_S); LAS bf16* Vl = (LAS bf16*)(F.lds + P3_VN);
    const bf16* GW = WSP(bf16, WS_GW); const bf16* GQ = WSP(bf16, WS_GQ); const bf16* GKT = WSP(bf16, WS_GKT); const bf16* GQK = WSP(bf16, WS_GQK);
    const bf16* GU = WSP(bf16, WS_GU); const float* GDEC = WSP(float, WS_GDEC);
    bf16* OG = WSP(bf16, WS_OGDN);
    f32x4 Sacc[2];
#pragma unroll
    for (int n = 0; n < 2; ++n) { Sacc[n] = (f32x4){0.f, 0.f, 0.f, 0.f}; v2u z = {0u, 0u}; *(LAS v2u*)(Sl + (n * 16 + fr) * 136 + 16 * w + 4 * fq) = z; }
    __syncthreads();
    const int m = w & 3;
    struct P3Ops { bf16x8 a1[4], ak0, ak1; v4u x0, x1; float dec; };
    P3Ops R0, R1, R2;
#define P3_FETCH(R, cc) do { const size_t ch_ = (size_t)bh * NCH + (cc); \
        const bf16* p1_ = (w < 4 ? GW : GQ) + ch_ * 8192 + (size_t)(m * 4 * 64 + lane) * 8;        \
        _Pragma("unroll") for (int k_ = 0; k_ < 4; ++k_) R.a1[k_] = ld8(p1_ + 512 * k_); \
        const bf16* pk_ = GKT + ch_ * 8192 + (size_t)(w * 2 * 64 + lane) * 8; R.ak0 = ld8(pk_); R.ak1 = ld8(pk_ + 512); \
        const unsigned char* px_ = w < 4 ? (const unsigned char*)(GU + ch_ * 8192 + ((size_t)(s * 4 + m) * 64 + lane) * 8) : (const unsigned char*)(GQK + ch_ * 4096 + (size_t)(m * 2 * 64 + lane) * 8); \
        R.x0 = *(const v4u*)px_; R.x1 = *(const v4u*)(px_ + (w < 4 ? 0 : 1024));        \
        R.dec = GDEC[ch_]; } while (0)
#define P3_STEP(R, c) do { \
        f32x4 acc[2]; \
        _Pragma("unroll") for (int n = 0; n < 2; ++n) { acc[n] = (f32x4){0.f, 0.f, 0.f, 0.f}; \
            _Pragma("unroll") for (int k = 0; k < 4; ++k) acc[n] = MFMA16(R.a1[k], ld8l(Sl + (n * 16 + fr) * 136 + 32 * k + 8 * fq), acc[n]); } \
        if (w < 4) { _Pragma("unroll") for (int n = 0; n < 2; ++n) { const unsigned ua_ = n == 0 ? R.x0.x : R.x0.z, ub_ = n == 0 ? R.x0.y : R.x0.w; const f32x4 vn = (f32x4){bflo(ua_), bfhi(ua_), bflo(ub_), bfhi(ub_)} - acc[n]; v2u o; o.x = pk2(vn[0], vn[1]); o.y = pk2(vn[2], vn[3]); \
            *(LAS v2u*)(Vl + (n * 16 + fr) * 72 + 16 * m + 4 * fq) = o; } } \
        asm volatile("s_waitcnt lgkmcnt(0)\n\ts_barrier" ::: "memory"); \
        bf16x8 v0[2], v1[2]; \
        _Pragma("unroll") for (int n = 0; n < 2; ++n) { v0[n] = ld8l(Vl + (n * 16 + fr) * 72 + 8 * fq); v1[n] = ld8l(Vl + (n * 16 + fr) * 72 + 32 + 8 * fq); } \
        if (w >= 4) { _Pragma("unroll") for (int n = 0; n < 2; ++n) { acc[n] = MFMA16(__builtin_bit_cast(bf16x8, R.x0), v0[n], acc[n]); acc[n] = MFMA16(__builtin_bit_cast(bf16x8, R.x1), v1[n], acc[n]); \
            bf16* o = OG + ((size_t)b * PT + (c) * CHUNK + 16 * m + 4 * fq) * DM + h * 128 + 32 * s + 16 * n + fr; \
            _Pragma("unroll") for (int r = 0; r < 4; ++r) o[(size_t)r * DM] = (bf16)f2bf(acc[n][r]); } } \
        { float d_ = R.dec;        \
          _Pragma("unroll") for (int n = 0; n < 2; ++n) asm volatile("v_mul_f32 %0, %0, %4\n\tv_mul_f32 %1, %1, %4\n\tv_mul_f32 %2, %2, %4\n\tv_mul_f32 %3, %3, %4" : "+v"(Sacc[n][0]), "+v"(Sacc[n][1]), "+v"(Sacc[n][2]), "+v"(Sacc[n][3]) : "v"(d_)); } \
        _Pragma("unroll") for (int n = 0; n < 2; ++n) { Sacc[n] = MFMA16(R.ak0, v0[n], Sacc[n]); Sacc[n] = MFMA16(R.ak1, v1[n], Sacc[n]); \
            v2u o; o.x = pk2(Sacc[n][0], Sacc[n][1]); o.y = pk2(Sacc[n][2], Sacc[n][3]); *(LAS v2u*)(Sl + (n * 16 + fr) * 136 + 16 * w + 4 * fq) = o; } \
        asm volatile("s_waitcnt lgkmcnt(0)\n\ts_barrier" ::: "memory"); } while (0)
    P3_FETCH(R0, 0); __builtin_amdgcn_sched_barrier(0); P3_FETCH(R1, 1); __builtin_amdgcn_sched_barrier(0); P3_FETCH(R2, 2); __builtin_amdgcn_sched_barrier(0);
    static_assert(NCH % 3 == 2, "ring schedule below assumes NCH = 3k + 2");
#pragma unroll 1
    for (int c = 0; c + 3 <= NCH; c += 3) {
        P3_STEP(R0, c);     P3_FETCH(R0, (c + 3 < NCH ? c + 3 : NCH - 1));
        P3_STEP(R1, c + 1); P3_FETCH(R1, (c + 4 < NCH ? c + 4 : NCH - 1));
        P3_STEP(R2, c + 2); P3_FETCH(R2, (c + 5 < NCH ? c + 5 : NCH - 1));
    }
    P3_STEP(R0, NCH - 2); P3_STEP(R1, NCH - 1);
#undef P3_FETCH
#undef P3_STEP
    float* So = F.out + O_GDNP + ((size_t)bh * 128) * 128;
#pragma unroll
    for (int n = 0; n < 2; ++n)
#pragma unroll
        for (int r = 0; r < 4; ++r) So[(size_t)(16 * w + 4 * fq + r) * 128 + 32 * s + 16 * n + fr] = Sacc[n][r];
}

__device__ __forceinline__ void p4_rows(Frame& F, int first, int stride) {
    const int lane = F.lane;
    if (first >= MTOK) return;
    float gn[16];
    { const f32x4* gp = (const f32x4*)(FIN(12) + (16 * lane & 127));
#pragma unroll
      for (int j = 0; j < 4; ++j) { const f32x4 g4 = gp[j]; gn[4 * j] = g4.x; gn[4 * j + 1] = g4.y; gn[4 * j + 2] = g4.z; gn[4 * j + 3] = g4.w; } }
    v4u no0, no1, nz0, nz1;
#define P4_FETCH(rw) do { const bf16* o_ = WSP(bf16, WS_OGDN) + (size_t)(rw) * DM + 16 * lane; const bf16* z_ = WSP(bf16, WS_PROJ) + (size_t)(rw) * 4096 + 3072 + 16 * lane; \
        no0 = *(const v4u*)o_; no1 = *(const v4u*)(o_ + 8); nz0 = *(const v4u*)z_; nz1 = *(const v4u*)(z_ + 8); } while (0)
    P4_FETCH(first);
#pragma unroll 1
    for (int row = first; row < MTOK; row += stride) {
        f32x4 v[4]; const v4u z0 = nz0, z1 = nz1; float ss = 0.f;
#pragma unroll
        for (int j = 0; j < 4; ++j) { const unsigned wa = j < 2 ? (j == 0 ? no0.x : no0.z) : (j == 2 ? no1.x : no1.z), wb = j < 2 ? (j == 0 ? no0.y : no0.w) : (j == 2 ? no1.y : no1.w);
            v[j] = (f32x4){bflo(wa), bfhi(wa), bflo(wb), bfhi(wb)}; ss += (v[j].x * v[j].x + v[j].y * v[j].y) + (v[j].z * v[j].z + v[j].w * v[j].w); }
        { const int nr = row + stride < MTOK ? row + stride : row; P4_FETCH(nr); }
        ss += dpp_f<DPP_XOR1>(ss); ss += dpp_f<DPP_XOR2>(ss); ss += dpp_f<DPP_HMIR>(ss);
        const float rstd = frsq(ss * (1.f / 128.f) + EPS);
        float zz[16] = {bflo(z0.x), bfhi(z0.x), bflo(z0.y), bfhi(z0.y), bflo(z0.z), bfhi(z0.z), bflo(z0.w), bfhi(z0.w),
                        bflo(z1.x), bfhi(z1.x), bflo(z1.y), bfhi(z1.y), bflo(z1.z), bfhi(z1.z), bflo(z1.w), bfhi(z1.w)};
        unsigned ow[8];
#pragma unroll
        for (int j = 0; j < 8; ++j) { const float a = v[j >> 1][(2 * j) & 3] * rstd * gn[2 * j] * silu_f(zz[2 * j]), bq = v[j >> 1][(2 * j + 1) & 3] * rstd * gn[2 * j + 1] * silu_f(zz[2 * j + 1]); ow[j] = pk2(a, bq); }
        v4u* dst = (v4u*)(WSP(bf16, WS_OG) + (size_t)row * DM + 16 * lane);
        dst[0] = (v4u){ow[0], ow[1], ow[2], ow[3]}; dst[1] = (v4u){ow[4], ow[5], ow[6], ow[7]};
    }
#undef P4_FETCH
}

typedef __bf16 bf16x2_t __attribute__((ext_vector_type(2)));
__device__ __forceinline__ float dot2_bf16(unsigned w, unsigned x, float acc) { return __builtin_amdgcn_fdot2_f32_bf16(__builtin_bit_cast(bf16x2_t, w), __builtin_bit_cast(bf16x2_t, x), acc, false); }
__device__ __forceinline__ float u2f(unsigned u) { return __builtin_bit_cast(float, u); }
__device__ __forceinline__ unsigned f2u(float f) { return __builtin_bit_cast(unsigned, f); }

constexpr int P8_MAXU = 4;
constexpr int P8_WAVE = P8_MAXU * 2048 + 1024;
constexpr int P8_TOP = 0;
constexpr int P8_TAB = 8 * P8_WAVE;
__device__ __forceinline__ void p8_init_tab(Frame& F) {
    LAS unsigned char* tab = F.lds + P8_TAB;
    if (F.tid < 64) { const int k = F.tid; int i = 0, j = 0;
        if (k < 16) { i = 0; j = k; } else if (k < 24) { i = 1; j = k - 16; } else if (k < 29) { i = 2; j = k - 24; } else if (k < 33) { i = 3; j = k - 29; }
        else if (k < 36) { i = 4; j = k - 33; } else if (k < 38) { i = 5; j = k - 36; } else if (k < 40) { i = 6; j = k - 38; } else if (k < 42) { i = 7; j = k - 40; } else if (k < 50) { i = k - 34; j = 0; }
        tab[k] = (unsigned char)i; tab[64 + k] = (unsigned char)j; }
    __syncthreads();
}
__device__ __forceinline__ int fkey(float x) { const int b = __builtin_bit_cast(int, x); return b ^ ((b >> 31) & 0x7fffffff); }
__device__ __forceinline__ float fkey_inv(int k) { return __builtin_bit_cast(float, k ^ ((k >> 31) & 0x7fffffff)); }
template <int CTRL> __device__ __forceinline__ int dpp_i(int x) { return __builtin_amdgcn_update_dpp(0, x, CTRL, 0xF, 0xF, true); }
__device__ __forceinline__ int imax(int a, int b) { return a > b ? a : b; }
__device__ __forceinline__ int imin(int a, int b) { return a < b ? a : b; }
__device__ __forceinline__ int row_imax16(int x) {
    x = imax(x, dpp_i<0xB1>(x)); x = imax(x, dpp_i<0x4E>(x)); x = imax(x, dpp_i<0x141>(x)); x = imax(x, dpp_i<0x140>(x)); return x;
}
#define ICSWAP(a, b) { const int hi_ = imax(a, b), lo_ = imin(a, b); a = hi_; b = lo_; }
constexpr int IKEY_MIN = (int)0x80000000;
template <int NR>
__device__ __forceinline__ void p8_run(Frame& F, int layer, int w, int rq, int u0, int ustride, int nu) {
    int lane_ = F.lane; asm volatile("" : "+v"(lane_));
    const int lane = lane_, fr = lane & 15, fq = lane >> 4;
    LAS unsigned char* L = F.lds; asm volatile("" : "+v"(L));
    LAS int* toplw = (LAS int*)(L + P8_TOP + F.wave * P8_WAVE);
    LAS float* wins = (LAS float*)(L + P8_TOP + F.wave * P8_WAVE + P8_MAXU * 2048);
    const LAS unsigned char* tab = L + P8_TAB;
    const bf16* Qb = WSP(bf16, WS_QPEER) + (size_t)fr * 2048 + w * 256 + 8 * fq;
    const bf16* SK = WSP(bf16, WS_SUBK) + (size_t)((layer * 8 + w) * 2) * 16384 + (size_t)fr * 128 + 8 * fq;
#pragma unroll 1
    for (int p = 0; p < 2; ++p) {
        bf16x8 bk[32], aq[4];
#pragma unroll
        for (int i = 0; i < 32; ++i) bk[i] = ld8(SK + (size_t)p * 16384 + (size_t)(i >> 2) * 2048 + 32 * (i & 3));
#pragma unroll
        for (int ks = 0; ks < 4; ++ks) aq[ks] = ld8(Qb + (size_t)u0 * 16 * 2048 + p * 128 + 32 * ks);
#pragma unroll 1
        for (int k = 0; k < nu; ++k) {
            LAS int* topl = toplw + k * 512;
            int s[NR][8];
#pragma unroll
            for (int nt = 0; nt < 8; ++nt) { f32x4 acc = {0.f, 0.f, 0.f, 0.f};
#pragma unroll
                for (int ks = 0; ks < 4; ++ks) acc = MFMA16(aq[ks], bk[nt * 4 + ks], acc);
                if (NR == 4) {
#pragma unroll
                    for (int r = 0; r < NR; ++r) s[r][nt] = fkey(u2f((f2u(acc[r]) & ~127u) | (unsigned)(16 * nt + fr)));
                } else { const float av = rq == 0 ? acc[0] : rq == 1 ? acc[1] : rq == 2 ? acc[2] : acc[3]; s[0][nt] = fkey(u2f((f2u(av) & ~127u) | (unsigned)(16 * nt + fr))); } }
            { const int un = u0 + (k + 1 < nu ? k + 1 : k) * ustride;
#pragma unroll
              for (int ks = 0; ks < 4; ++ks) aq[ks] = ld8(Qb + (size_t)un * 16 * 2048 + p * 128 + 32 * ks); }
#pragma unroll
            for (int r = 0; r < NR; ++r) {
                ICSWAP(s[r][0], s[r][1]) ICSWAP(s[r][2], s[r][3]) ICSWAP(s[r][4], s[r][5]) ICSWAP(s[r][6], s[r][7])
                ICSWAP(s[r][0], s[r][2]) ICSWAP(s[r][1], s[r][3]) ICSWAP(s[r][4], s[r][6]) ICSWAP(s[r][5], s[r][7])
                ICSWAP(s[r][1], s[r][2]) ICSWAP(s[r][5], s[r][6]) ICSWAP(s[r][0], s[r][4]) ICSWAP(s[r][3], s[r][7])
                ICSWAP(s[r][1], s[r][5]) ICSWAP(s[r][2], s[r][6]) ICSWAP(s[r][1], s[r][4]) ICSWAP(s[r][3], s[r][6])
                ICSWAP(s[r][2], s[r][4]) ICSWAP(s[r][3], s[r][5]) ICSWAP(s[r][3], s[r][4]) }
            int mine[NR];
#pragma unroll
            for (int r = 0; r < NR; ++r) mine[r] = IKEY_MIN;
#pragma unroll 1
            for (int rd = 0; rd < 16; ++rd) {
                const bool me = fr == rd;
#pragma unroll
                for (int r = 0; r < NR; ++r) {
                    const int mx = row_imax16(s[r][0]);
                    const bool pop = s[r][0] == mx;
#pragma unroll
                    for (int i = 0; i < 7; ++i) s[r][i] = pop ? s[r][i + 1] : s[r][i];
                    s[r][7] = pop ? IKEY_MIN : s[r][7];
                    mine[r] = me ? mx : mine[r];
                }
            }
#pragma unroll
            for (int r = 0; r < NR; ++r) topl[((4 * fq + (NR == 4 ? r : rq)) * 2 + p) * 16 + fr] = mine[r];
        }
    }
    LDS_WAIT();
#pragma unroll 1
    for (int k = 0; k < nu; ++k) {
    LAS int* topl = toplw + k * 512;
    const int r0 = (u0 + k * ustride) * 16;
    int c[NR][4];
#pragma unroll
    for (int r = 0; r < NR; ++r) { const int tk = 4 * fq + (NR == 4 ? r : rq);
#pragma unroll
        for (int m = 0; m < 4; ++m) { const int kc = fr + 16 * m; int cv = IKEY_MIN;
            if (kc < 50) { const int i = tab[kc], j = tab[64 + kc]; const float s1 = u2f(f2u(fkey_inv(topl[(tk * 2 + 0) * 16 + i])) & ~127u), s2 = u2f(f2u(fkey_inv(topl[(tk * 2 + 1) * 16 + j])) & ~127u);
                cv = fkey(u2f((f2u(s1 + s2) & ~63u) | (unsigned)kc)); }
            c[r][m] = cv; }
        ICSWAP(c[r][0], c[r][1]) ICSWAP(c[r][2], c[r][3]) ICSWAP(c[r][0], c[r][2]) ICSWAP(c[r][1], c[r][3]) ICSWAP(c[r][1], c[r][2]) }
    int minec[NR];
#pragma unroll
    for (int r = 0; r < NR; ++r) minec[r] = IKEY_MIN;
#pragma unroll 1
    for (int rd = 0; rd < 16; ++rd) {
        const bool me = fr == rd;
#pragma unroll
        for (int r = 0; r < NR; ++r) {
            const int mx = row_imax16(c[r][0]);
            const bool pop = c[r][0] == mx;
            c[r][0] = pop ? c[r][1] : c[r][0]; c[r][1] = pop ? c[r][2] : c[r][1]; c[r][2] = pop ? c[r][3] : c[r][2]; c[r][3] = pop ? IKEY_MIN : c[r][3];
            minec[r] = me ? mx : minec[r];
        }
    }
#pragma unroll
    for (int r = 0; r < NR; ++r) wins[(4 * fq + (NR == 4 ? r : rq)) * 16 + fr] = fkey_inv(minec[r]);
    LDS_WAIT();
    if (NR == 4 || (fr >> 2) == rq) {
        const int tk = 4 * fq + (fr >> 2), q4 = fr & 3;
        const float w0 = wins[tk * 16]; float den = 0.f;
#pragma unroll
        for (int rd = 0; rd < 16; ++rd) den += __expf(wins[tk * 16 + rd] - w0);
        const float inv = 1.f / den;
        int e[4]; float g[4];
#pragma unroll
        for (int x = 0; x < 4; ++x) { const float wv = wins[tk * 16 + 4 * q4 + x]; const int kc = (int)(f2u(wv) & 63u); const int i = tab[kc], j = tab[64 + kc];
            e[x] = (int)(f2u(fkey_inv(topl[(tk * 2 + 0) * 16 + i])) & 127u) * 128 + (int)(f2u(fkey_inv(topl[(tk * 2 + 1) * 16 + j])) & 127u); g[x] = __expf(wv - w0) * inv; }
        unsigned short* pei = WSP(unsigned short, WS_PEI) + (size_t)(r0 + tk) * 128 + w * 16 + 4 * q4; float* peg = WSP(float, WS_PEG) + (size_t)(r0 + tk) * 128 + w * 16 + 4 * q4;
        *(v2u*)pei = (v2u){(unsigned)e[0] | ((unsigned)e[1] << 16), (unsigned)e[2] | ((unsigned)e[3] << 16)};
        *(f32x4*)peg = (f32x4){g[0], g[1], g[2], g[3]};
    }
    LDS_WAIT();
    }
}
__device__ __forceinline__ void p8_phase(Frame& F, int layer) {
    p8_init_tab(F);
    for (int ub = F.bid; ub < MP / 16; ub += F.G * P8_MAXU) { const int left = (MP / 16 - ub + F.G - 1) / F.G; p8_run<4>(F, layer, F.wave, 0, ub, F.G, left < P8_MAXU ? left : P8_MAXU); }
    for (int qu = F.bid * 8 + F.wave; qu < (MS / 16) * 8 * 4 * 8; qu += F.G * 8) { if ((qu & 7) == 0) { const int x = qu >> 3; p8_run<1>(F, layer, (x >> 2) & 7, x & 3, MP / 16 + (x >> 5), 0, 1); } }
}

constexpr size_t PE_SLICE_BYTES = (size_t)NEXP * 128;
__device__ __forceinline__ f32x2 p9_cvt(unsigned w, bool hi) { return hi ? __builtin_amdgcn_cvt_pk_f32_fp8((int)w, true) : __builtin_amdgcn_cvt_pk_f32_fp8((int)w, false); }
__device__ __forceinline__ f32x2 fma2(f32x2 a, f32x2 b, f32x2 c) { return __builtin_elementwise_fma(a, b, c); }
__device__ __forceinline__ float p9_dot16(const v4u u, const f32x2 (&h)[8]) {
    f32x2 a = {0.f, 0.f}, b = {0.f, 0.f};
    a = fma2(p9_cvt(u.x, false), h[0], a); b = fma2(p9_cvt(u.x, true), h[1], b); a = fma2(p9_cvt(u.y, false), h[2], a); b = fma2(p9_cvt(u.y, true), h[3], b);
    a = fma2(p9_cvt(u.z, false), h[4], a); b = fma2(p9_cvt(u.z, true), h[5], b); a = fma2(p9_cvt(u.w, false), h[6], a); b = fma2(p9_cvt(u.w, true), h[7], b);
    a = a + b; return a.x + a.y;
}
__device__ __forceinline__ void p9_axpy16(const v4u v, float c, f32x2 (&o)[8]) {
    const f32x2 cc = {c, c};
    o[0] = fma2(p9_cvt(v.x, false), cc, o[0]); o[1] = fma2(p9_cvt(v.x, true), cc, o[1]); o[2] = fma2(p9_cvt(v.y, false), cc, o[2]); o[3] = fma2(p9_cvt(v.y, true), cc, o[3]);
    o[4] = fma2(p9_cvt(v.z, false), cc, o[4]); o[5] = fma2(p9_cvt(v.z, true), cc, o[5]); o[6] = fma2(p9_cvt(v.w, false), cc, o[6]); o[7] = fma2(p9_cvt(v.w, true), cc, o[7]);
}
#define P9_GATHER(S, iw) do { _Pragma("unroll") for (int j_ = 0; j_ < 8; ++j_) { const unsigned w_ = (iw)[j_ >> 1]; const unsigned id_ = (j_ & 1) ? (w_ >> 16) : (w_ & 0xffffu); \
        S[j_] = *(const v4u*)(tab + ((id_ << 7) + sub16)); } } while (0)
__device__ __forceinline__ float swapsum16(float x, float y) { unsigned a = __builtin_bit_cast(unsigned, x), b = __builtin_bit_cast(unsigned, y); PSWAP16(a, b); return __builtin_bit_cast(float, a) + __builtin_bit_cast(float, b); }
__device__ __forceinline__ float swapsum32(float x, float y) { unsigned a = __builtin_bit_cast(unsigned, x), b = __builtin_bit_cast(unsigned, y); PSWAP32(a, b); return __builtin_bit_cast(float, a) + __builtin_bit_cast(float, b); }

__device__ __forceinline__ int p9_idot16(const v4u u, const v4u h) {
    int a = __builtin_amdgcn_sdot4((int)u.x, (int)h.x, 0, false); a = __builtin_amdgcn_sdot4((int)u.y, (int)h.y, a, false);
    a = __builtin_amdgcn_sdot4((int)u.z, (int)h.z, a, false); return __builtin_amdgcn_sdot4((int)u.w, (int)h.w, a, false);
}
__device__ __forceinline__ void p9u_wave(Frame& F, int layer, int slice, int first, int stride) {
    int lane_ = F.lane; asm volatile("" : "+v"(lane_));
    const int lane = lane_, gi = lane >> 3, sub = lane & 7;
    const unsigned char* tab = WSP(unsigned char, WS_PU) + (size_t)(layer * 8 + slice) * PE_SLICE_BYTES;
    const unsigned sub16 = (unsigned)sub * 16u;
    const unsigned char* hbase = WSP(unsigned char, WS_XN8) + slice * 128 + sub * 16;
    const unsigned char* ibase = (const unsigned char*)(WSP(unsigned short, WS_PEI) + gi * 16);
    const float* hsb = WSP(float, WS_HS);
    unsigned* pa = WSP(unsigned, WS_PA) + slice * 64 + lane;
    int t = first; if (t >= MTOK) return;
    v4u ia, ib, hq, nia, nib, nhq, A[8], B[8]; float hs, nhs;
#define P9U_META(tt, xa, xb, yq, ys) do { const v4u* ip_ = (const v4u*)(ibase + (size_t)(tt) * 256); xa = ip_[0]; xb = ip_[1]; yq = *(const v4u*)(hbase + (size_t)(tt) * 1024); ys = hsb[(tt)]; } while (0)
    P9U_META(t, ia, ib, hq, hs);
    P9_GATHER(A, ia);
    const bool b0 = sub & 1, b1 = sub & 2, b2 = sub & 4;
#pragma unroll 1
    for (;;) {
        const int tn = t + stride; const bool more = tn < MTOK; const int tl = more ? tn : t;
        P9U_META(tl, nia, nib, nhq, nhs);
        P9_GATHER(B, ib);
        int p[16];
#pragma unroll
        for (int j = 0; j < 8; ++j) p[j] = p9_idot16(A[j], hq);
        P9_GATHER(A, nia);
#pragma unroll
        for (int j = 0; j < 8; ++j) p[8 + j] = p9_idot16(B[j], hq);
        int q[8], r[4], sv[2];
#pragma unroll
        for (int i = 0; i < 8; ++i) { const int keep = b2 ? p[8 + i] : p[i], send = b2 ? p[i] : p[8 + i]; q[i] = keep + dpp_i<DPP_HMIR>(send); }
#pragma unroll
        for (int i = 0; i < 4; ++i) { const int keep = b0 ? q[2 * i + 1] : q[2 * i], send = b0 ? q[2 * i] : q[2 * i + 1]; r[i] = keep + dpp_i<DPP_XOR1>(send); }
#pragma unroll
        for (int i = 0; i < 2; ++i) { const int keep = b1 ? r[2 * i + 1] : r[2 * i], send = b1 ? r[2 * i] : r[2 * i + 1]; sv[i] = keep + dpp_i<DPP_XOR2>(send); }
        const float sc = hs * (1.f / 19.f);
        pa[(size_t)t * 512] = pk2((float)sv[0] * sc, (float)sv[1] * sc);
        if (!more) break;
        t = tn; ia = nia; ib = nib; hq = nhq; hs = nhs;
    }
#undef P9U_META
}

__device__ __forceinline__ void p9v_wave(Frame& F, int layer, int slice, int first, int stride, int mode) {
    int lane_ = F.lane; asm volatile("" : "+v"(lane_));
    const int lane = lane_, gi = lane >> 3, sub = lane & 7, j0 = 8 * (sub >> 2) + (sub & 3);
    const unsigned char* tab = WSP(unsigned char, WS_PV) + (size_t)(layer * 8 + slice) * PE_SLICE_BYTES;
    const unsigned sub16 = (unsigned)sub * 16u;
    const unsigned char* ibase = (const unsigned char*)(WSP(unsigned short, WS_PEI) + gi * 16);
    const unsigned* pab = WSP(unsigned, WS_PA) + lane;
    const float* pegb = WSP(float, WS_PEG) + gi * 16 + j0;
    const int eoff = slice * 128 + sub * 16 + gi;
    float* xsb = WSP(float, WS_XS) + eoff;
    int t = first; if (t >= MTOK) return;
    v4u ia, ib, nia, nib, A[8], B[8];
    unsigned pw[8], npw[8]; float g0, g1, ng0, ng1, x0, x1, nx0, nx1;
#define P9V_META(tt, xa, xb, pp, ga, gb, ya, yb) do { const v4u* ip_ = (const v4u*)(ibase + (size_t)(tt) * 256); xa = ip_[0]; xb = ip_[1]; \
        _Pragma("unroll") for (int x_ = 0; x_ < 8; ++x_) pp[x_] = pab[(size_t)(tt) * 512 + x_ * 64]; \
        ga = pegb[(size_t)(tt) * 128]; gb = pegb[(size_t)(tt) * 128 + 4]; ya = xsb[(size_t)(tt) * DM]; yb = xsb[(size_t)(tt) * DM + 8]; } while (0)
    P9V_META(t, ia, ib, pw, g0, g1, x0, x1);
    P9_GATHER(A, ia);
#pragma unroll 1
    for (;;) {
        const int tn = t + stride; const bool more = tn < MTOK; const int tl = more ? tn : t;
        P9V_META(tl, nia, nib, npw, ng0, ng1, nx0, nx1);
        P9_GATHER(B, ib);
        float alo = 0.f, ahi = 0.f;
#pragma unroll
        for (int x = 0; x < 8; ++x) { alo += bflo(pw[x]); ahi += bfhi(pw[x]); }
        const float c0 = gelu_tanh(alo * 0.03125f) * g0 * 0.0625f, c1 = gelu_tanh(ahi * 0.03125f) * g1 * 0.0625f;
        f32x2 o[8];
#pragma unroll
        for (int i = 0; i < 8; ++i) o[i] = (f32x2){0.f, 0.f};
#define P9V_C(j) __builtin_bit_cast(float, __builtin_amdgcn_ds_swizzle(__builtin_bit_cast(int, (((j) >> 2) & 1) ? c1 : c0), ((4 * ((j) >> 3) + ((j) & 3)) << 5) | 0x18))
        { const float cj[8] = {P9V_C(0), P9V_C(1), P9V_C(2), P9V_C(3), P9V_C(4), P9V_C(5), P9V_C(6), P9V_C(7)};
#pragma unroll
          for (int j = 0; j < 8; ++j) p9_axpy16(A[j], cj[j], o); }
        P9_GATHER(A, nia);
        { const float cj[8] = {P9V_C(8), P9V_C(9), P9V_C(10), P9V_C(11), P9V_C(12), P9V_C(13), P9V_C(14), P9V_C(15)};
#pragma unroll
          for (int j = 0; j < 8; ++j) p9_axpy16(B[j], cj[j], o); }
#undef P9V_C
        const bool g0b = lane & 8;
        float q[8], r[4], sv[2];
#pragma unroll
        for (int i = 0; i < 8; ++i) { const float keep = g0b ? o[i].y : o[i].x, send = g0b ? o[i].x : o[i].y; q[i] = keep + dpp_f<DPP_ROR8>(send); }
#pragma unroll
        for (int i = 0; i < 4; ++i) r[i] = swapsum16(q[2 * i], q[2 * i + 1]);
#pragma unroll
        for (int i = 0; i < 2; ++i) sv[i] = swapsum32(r[2 * i], r[2 * i + 1]);
        const float y0 = x0 + sv[0], y1 = x1 + sv[1];
        if (mode == 0) {
            float* xs = xsb + (size_t)t * DM; xs[0] = y0; xs[8] = y1;
            bf16* xn = WSP(bf16, WS_XNA) + (size_t)t * DM + eoff; xn[0] = (bf16)f2bf(y0); xn[8] = (bf16)f2bf(y1);
            const float ss = wave_sum(y0 * y0 + y1 * y1);
            if (lane == 0) WSP(float, WS_SSQ)[(size_t)t * 8 + slice] = ss;
        } else {
            float* y = (t < MP ? F.out + O_YP + (size_t)t * DM : F.out + O_YS + (size_t)(t - MP) * DM) + eoff;
            y[0] = y0; y[8] = y1;
        }
        if (!more) break;
        t = tn; ia = nia; ib = nib; g0 = ng0; g1 = ng1; x0 = nx0; x1 = nx1;
#pragma unroll
        for (int x = 0; x < 8; ++x) pw[x] = npw[x];
    }
#undef P9V_META
}
#undef P9_GATHER

constexpr float QSCALE = 0.125f * 1.4426950408889634f;
constexpr int PP_VT = 0;
__device__ __forceinline__ float rms64(float v) { return frsq(wave_sum(v * v) * (1.f / 64.f) + EPS); }

__device__ __forceinline__ void pp_q_row(Frame& F, int row, const bf16* kvq, const float qg) {
    const int lane = F.lane;
    bf16* qn = WSP(bf16, WS_QN) + (size_t)row * 1024;
#pragma unroll 4
    for (int hd = 0; hd < 16; ++hd) { const float v = bf2f(kvq[NKV + hd * 64 + lane]); qn[hd * 64 + lane] = (bf16)f2bf(v * rms64(v) * qg); }
    if (lane < 48) WSP(float, WS_GATES)[(size_t)row * 48 + lane] = sigmoid_f(bf2f(kvq[NKV + 1024 + lane]));
}
__device__ __forceinline__ f32x4 rms64x4(f32x4 v) { const float ss = row_sum16((v.x * v.x + v.y * v.y) + (v.z * v.z + v.w * v.w)); return v * (frsq(ss * (1.f / 64.f) + EPS)); }
__device__ __forceinline__ v2u pk4(f32x4 v) { return (v2u){pk2(v.x, v.y), pk2(v.z, v.w)}; }
__device__ __forceinline__ void pp_prompt_tile(Frame& F, int unit) {
    const int lane = F.lane, w = F.wave, b = unit >> 7, t0 = (unit & 127) * 64, g = lane >> 4, d4 = (lane & 15) * 4;
    LAS unsigned char* L = F.lds; asm volatile("" : "+v"(L));
    LAS bf16* vt = (LAS bf16*)(L + PP_VT);
    const f32x4 kg1 = *(const f32x4*)(FIN(16) + 64 + d4), kg2 = *(const f32x4*)(FIN(16) + 128 + d4), qg = *(const f32x4*)(FIN(22) + d4) * QSCALE;
    v2u nv[6], nq[4], ngl;
#define PP_FETCH(rr_) do { const int row_ = b * PT + t0 + 8 * w + ((rr_) < 8 ? (rr_) : 7); const v2u* kvq_ = (const v2u*)(WSP(bf16, WS_KVQ) + (size_t)row_ * NKVQ) + lane;        \
        _Pragma("unroll") for (int sidx_ = 0; sidx_ < 6; ++sidx_) nv[sidx_] = kvq_[64 * sidx_]; \
        _Pragma("unroll") for (int i_ = 0; i_ < 4; ++i_) nq[i_] = kvq_[64 * (6 + i_)]; \
        ngl = ((const v2u*)(WSP(bf16, WS_KVQ) + (size_t)row_ * NKVQ))[640 + (lane & 15)]; } while (0)
    PP_FETCH(0);
#pragma unroll 1
    for (int rr = 0; rr < 8; ++rr) {
        const int tl = 8 * w + rr, t = t0 + tl, row = b * PT + t;
        f32x4 v[6], q[4]; const f32x4 gl = {bflo(ngl.x), bfhi(ngl.x), bflo(ngl.y), bfhi(ngl.y)};
#pragma unroll
        for (int sidx = 0; sidx < 6; ++sidx) v[sidx] = (f32x4){bflo(nv[sidx].x), bfhi(nv[sidx].x), bflo(nv[sidx].y), bfhi(nv[sidx].y)};
#pragma unroll
        for (int i = 0; i < 4; ++i) q[i] = (f32x4){bflo(nq[i].x), bfhi(nq[i].x), bflo(nq[i].y), bfhi(nq[i].y)};
        PP_FETCH(rr + 1);
        const f32x4 ks = rms64x4(v[2]) * kg1, kw = rms64x4(v[4]) * kg2;
        f32x4* okv = (f32x4*)(F.out + O_KVP + (size_t)row * 1024) + lane;
        okv[0] = v[0]; okv[64] = v[1]; okv[128] = ks; okv[192] = v[3];
        if (t >= PT - WINDOW) { f32x4* owin = (f32x4*)(F.out + O_WINP + ((size_t)b * 512 + (t - (PT - WINDOW))) * 512) + lane; owin[0] = kw; owin[64] = v[5]; }
        const size_t kidx = (((size_t)b * NG + g) * PT + t) * 64 + d4;
        *(v2u*)(WSP(bf16, WS_KSEL) + kidx) = pk4(ks); *(v2u*)(WSP(bf16, WS_KWIN) + kidx) = pk4(kw);
#pragma unroll
        for (int j = 0; j < 4; ++j) { vt[((0 * 4 + g) * 64 + d4 + j) * 72 + tl] = (bf16)f2bf(v[3][j]); vt[((1 * 4 + g) * 64 + d4 + j) * 72 + tl] = (bf16)f2bf(v[5][j]); }
        bf16* qn = WSP(bf16, WS_QN) + (size_t)row * 1024 + g * 64 + d4;
#pragma unroll
        for (int i = 0; i < 4; ++i) *(v2u*)(qn + i * 256) = pk4(rms64x4(q[i]) * qg);
        if (lane < 12) *(f32x4*)(WSP(float, WS_GATES) + (size_t)row * 48 + 4 * lane) = (f32x4){sigmoid_f(gl.x), sigmoid_f(gl.y), sigmoid_f(gl.z), sigmoid_f(gl.w)};
    }
#undef PP_FETCH
    __syncthreads();
    {
        const int which = F.tid >> 8, gd = F.tid & 255;
        bf16* dst = WSP(bf16, which == 0 ? WS_VSELT : WS_VWINT) + (((size_t)b * NG * 64 + gd) * PT + t0);
        const LAS bf16* src = vt + ((which * 256 + gd) * 72);
#pragma unroll
        for (int i = 0; i < 8; ++i) *(v4u*)(dst + 8 * i) = *(const LAS v4u*)(src + 8 * i);
    }
    __syncthreads();
}
__device__ __forceinline__ void pp_sample_row(Frame& F, int sr, int part = -1) {
    const int lane = F.lane, bs = sr >> 2, i = sr & 3, row = MP + sr;
    const float kg1 = FIN(16)[64 + lane], kg2 = FIN(16)[128 + lane], qg = FIN(22)[lane] * QSCALE;
    const bf16* kvq = WSP(bf16, WS_KVQ) + (size_t)row * NKVQ;
    float* okv = F.out + O_KVS + (size_t)sr * 1024;
    float* owin = F.out + O_WINS + ((size_t)bs * 512 + 508 + i) * 512;
#pragma unroll
    for (int g = 0; g < 4; ++g) { if (part >= 0 && part != g) continue;
        const float v0 = bf2f(kvq[0 * 256 + g * 64 + lane]), v1 = bf2f(kvq[1 * 256 + g * 64 + lane]), v2 = bf2f(kvq[2 * 256 + g * 64 + lane]);
        const float v3 = bf2f(kvq[3 * 256 + g * 64 + lane]), v4 = bf2f(kvq[4 * 256 + g * 64 + lane]), v5 = bf2f(kvq[5 * 256 + g * 64 + lane]);
        const float ks = v2 * rms64(v2) * kg1, kw = v4 * rms64(v4) * kg2;
        okv[0 * 256 + g * 64 + lane] = v0; okv[1 * 256 + g * 64 + lane] = v1; okv[2 * 256 + g * 64 + lane] = ks; okv[3 * 256 + g * 64 + lane] = v3;
        owin[g * 64 + lane] = kw; owin[256 + g * 64 + lane] = v5;
        const size_t bg = (size_t)bs * NG + g;
        WSP(bf16, WS_SKWIN)[(bg * 544 + 512 + i) * 64 + lane] = (bf16)f2bf(kw);
        WSP(bf16, WS_SVWINT)[(bg * 64 + lane) * 544 + 512 + i] = (bf16)f2bf(v5);
        float* sn = WSP(float, WS_SNEW) + (((size_t)bs * 4 + i) * 2) * 256 + g * 64 + lane;
        sn[0] = ks; sn[256] = v3;
    }
    bf16* qn = WSP(bf16, WS_QN) + (size_t)row * 1024;
#pragma unroll 4
    for (int hd = 0; hd < 16; ++hd) { if (part >= 0 && (hd >> 2) != part - 4) continue; const float v = bf2f(kvq[NKV + hd * 64 + lane]); qn[hd * 64 + lane] = (bf16)f2bf(v * rms64(v) * qg); }
    if ((part < 0 || part == 7) && lane < 48) WSP(float, WS_GATES)[(size_t)row * 48 + lane] = sigmoid_f(bf2f(kvq[NKV + 1024 + lane]));
}

struct RowPPrompt { static constexpr bool BF = true; const bf16* base; __device__ __forceinline__ const bf16* operator()(int t) const { return base + (size_t)t * NKVQ; } };
struct RowPSample { static constexpr bool BF = false; const float* cache; const int* pt; __device__ __forceinline__ const float* operator()(int t) const { return cache + ((size_t)pt[t >> 7] * PAGE + (t & 127)) * 1024; } };
template <class RowP> __device__ __forceinline__ bf16x8 rowp_frag(const RowP& rowp, int t, int off) {
    if constexpr (RowP::BF) return ld8(rowp(t) + off);
    else { const float* rp = rowp(t) + off; return cvt8(*(const f32x4*)rp, *(const f32x4*)(rp + 4)); }
}
__device__ __forceinline__ void compress_finish(Frame& F, const f32x4 (&acc)[4], int kv, int blk, bf16* KC, bf16* VCT) {
    const int lane = F.lane, fr = lane & 15, fq = lane >> 4;
    const float* pet = WSP(float, WS_PETERM) + kv * 64;
    bf16x8 hb[2];
#pragma unroll
    for (int s = 0; s < 2; ++s) { f32x4 h0, h1;
#pragma unroll
        for (int r = 0; r < 4; ++r) { h0[r] = gelu_tanh(acc[2 * s][r] + pet[16 * (2 * s) + 4 * fq + r]); h1[r] = gelu_tanh(acc[2 * s + 1][r] + pet[16 * (2 * s + 1) + 4 * fq + r]); }
        hb[s] = cvt8(h0, h1); }
    const bf16* w2f = WSP(bf16, WS_W2F) + (size_t)kv * 4096 + lane * 8;
    f32x4 o[4];
#pragma unroll
    for (int dt = 0; dt < 4; ++dt) { o[dt] = (f32x4){0.f, 0.f, 0.f, 0.f};
#pragma unroll
        for (int s = 0; s < 2; ++s) o[dt] = MFMA16(ld8(w2f + (dt * 2 + s) * 512), hb[s], o[dt]); }
    if (kv == 0) {
        float ss = 0.f;
#pragma unroll
        for (int dt = 0; dt < 4; ++dt) ss += (o[dt][0] * o[dt][0] + o[dt][1] * o[dt][1]) + (o[dt][2] * o[dt][2] + o[dt][3] * o[dt][3]);
        ss = x32_sum(x16_sum(ss));
        const float rstd = frsq(ss * (1.f / 64.f) + EPS);
        const float* kg0 = FIN(16);
        if (blk < NCMP) {
#pragma unroll
            for (int dt = 0; dt < 4; ++dt) { const int d = 16 * dt + 4 * fq; v2u ov; ov.x = pk2(o[dt][0] * rstd * kg0[d], o[dt][1] * rstd * kg0[d + 1]); ov.y = pk2(o[dt][2] * rstd * kg0[d + 2], o[dt][3] * rstd * kg0[d + 3]);
                *(v2u*)(KC + (size_t)blk * 64 + d) = ov; }
        } else {
#pragma unroll
            for (int dt = 0; dt < 4; ++dt) *(v2u*)(KC + (size_t)blk * 64 + 16 * dt + 4 * fq) = (v2u){0u, 0u};
        }
    } else {
#pragma unroll
        for (int dt = 0; dt < 4; ++dt)
#pragma unroll
            for (int r = 0; r < 4; ++r) VCT[(size_t)(16 * dt + 4 * fq + r) * 512 + blk] = (blk < NCMP) ? (bf16)f2bf(o[dt][r]) : (bf16)0;
    }
}

template <class RowP>
__device__ __forceinline__ void compress_part(Frame& F, const RowP& rowp, int kv, int j, int r_lo, int r_hi, f32x4 (&acc)[4]) {
    const int lane = F.lane, fr = lane & 15, fq = lane >> 4;
    const bf16* W1 = WSP(bf16, WS_W1T) + (size_t)kv * 64 * 2048 + (size_t)fr * 2048 + 8 * fq;
    const int blk = 16 * j + fr;
#pragma unroll
    for (int mt = 0; mt < 4; ++mt) acc[mt] = (f32x4){0.f, 0.f, 0.f, 0.f};
#pragma unroll 2
    for (int r = r_lo; r < r_hi; ++r) {
        int t = 16 * blk + r; t = t < PAST ? t : PAST - 1;
#pragma unroll
        for (int hf = 0; hf < 2; ++hf) {
            const bf16x8 bfrag = rowp_frag(rowp, t, 8 * fq + 32 * hf);
            const int ks = 2 * r + hf;
#pragma unroll
            for (int mt = 0; mt < 4; ++mt) acc[mt] = MFMA16(ld8(W1 + (size_t)mt * 16 * 2048 + 32 * ks), bfrag, acc[mt]);
        }
    }
}
template <class RowP>
__device__ __forceinline__ void compress_tile(Frame& F, const RowP& rowp, int kv, int j, bf16* KC, bf16* VCT) {
    const int lane = F.lane, fr = lane & 15, fq = lane >> 4;
    const bf16* W1 = WSP(bf16, WS_W1T) + (size_t)kv * 64 * 2048 + (size_t)fr * 2048 + 8 * fq;
    const int blk = 16 * j + fr;
    f32x4 acc[4];
#pragma unroll
    for (int mt = 0; mt < 4; ++mt) acc[mt] = (f32x4){0.f, 0.f, 0.f, 0.f};
#pragma unroll 2
    for (int r = 0; r < 32; ++r) {
        int t = 16 * blk + r; t = t < PAST ? t : PAST - 1;
#pragma unroll
        for (int hf = 0; hf < 2; ++hf) {
            const bf16x8 bfrag = rowp_frag(rowp, t, 8 * fq + 32 * hf);
            const int ks = 2 * r + hf;
#pragma unroll
            for (int mt = 0; mt < 4; ++mt) acc[mt] = MFMA16(ld8(W1 + (size_t)mt * 16 * 2048 + 32 * ks), bfrag, acc[mt]);
        }
    }
    compress_finish(F, acc, kv, blk, KC, VCT);
}


__device__ __forceinline__ void compress_prompt(Frame& F, int id) {
    const int kv = id & 1, j = (id >> 1) & 31, bg = id >> 6, b = bg >> 2, g = bg & 3;
    RowPPrompt rp{WSP(bf16, WS_KVQ) + (size_t)b * PT * NKVQ + kv * 256 + g * 64};
    compress_tile(F, rp, kv, j, WSP(bf16, WS_KCMP) + (size_t)bg * 512 * 64, WSP(bf16, WS_VCMPT) + (size_t)bg * 64 * 512);
}
constexpr int CP_PART = 81920;
__device__ __forceinline__ void compress_prompt_split(Frame& F, int id) {
    const int kv = id & 1, j = (id >> 1) & 31, bg = id >> 6, b = bg >> 2, g = bg & 3, q = F.wave & 3, lane = F.lane;
    RowPPrompt rp{WSP(bf16, WS_KVQ) + (size_t)b * PT * NKVQ + kv * 256 + g * 64};
    f32x4 acc[4];
    compress_part(F, rp, kv, j, 8 * q, 8 * q + 8, acc);
    LAS f32x4* part = (LAS f32x4*)(F.lds + CP_PART) + (F.wave >> 2) * 1024;
#pragma unroll
    for (int mt = 0; mt < 4; ++mt) part[(q * 4 + mt) * 64 + lane] = acc[mt];
    __syncthreads();
    if (q == 0) {
#pragma unroll
        for (int mt = 0; mt < 4; ++mt) acc[mt] = (part[(0 * 4 + mt) * 64 + lane] + part[(1 * 4 + mt) * 64 + lane]) + (part[(2 * 4 + mt) * 64 + lane] + part[(3 * 4 + mt) * 64 + lane]);
        compress_finish(F, acc, kv, 16 * j + (lane & 15), WSP(bf16, WS_KCMP) + (size_t)bg * 512 * 64, WSP(bf16, WS_VCMPT) + (size_t)bg * 64 * 512);
    }
    __syncthreads();
}
__device__ __forceinline__ void compress_sample(Frame& F, int id) {
    const int kv = id & 1, j = (id >> 1) & 31, bg = id >> 6, lane = F.lane, fr = lane & 15, fq = lane >> 4;
    const int blk = 16 * j + fr, nb = blk < 511 ? blk + 1 : 511;
    const bf16* f1 = WSP(bf16, WS_FS) + ((size_t)bg * 512 + blk) * 256 + kv * 128 + 4 * fq;
    const bf16* f2 = WSP(bf16, WS_FS) + ((size_t)bg * 512 + nb) * 256 + kv * 128 + 64 + 4 * fq;
    f32x4 acc[4];
#pragma unroll
    for (int mt = 0; mt < 4; ++mt) { const v2u a = *(const v2u*)(f1 + 16 * mt), b = *(const v2u*)(f2 + 16 * mt);
        acc[mt] = (f32x4){bflo(a.x) + bflo(b.x), bfhi(a.x) + bfhi(b.x), bflo(a.y) + bflo(b.y), bfhi(a.y) + bfhi(b.y)}; }
    compress_finish(F, acc, kv, blk, WSP(bf16, WS_SKCMP) + (size_t)bg * 512 * 64, WSP(bf16, WS_SVCMPT) + (size_t)bg * 64 * 512);
}

constexpr int NSA_IMP = 0;
constexpr int NSA_Q = 67584;
constexpr int NSA_QLD = 68;
constexpr float LOG2E = 1.4426950408889634f;
#ifndef NSA_SUBUNITS
#define NSA_SUBUNITS 0
#endif
__device__ __forceinline__ float ex2(float x) { return __builtin_amdgcn_exp2f(x); }

struct KvBf16 {
    const bf16* K; const bf16* VT; int ld;
    __device__ __forceinline__ void lane_offsets(int fr, int fq, unsigned& ko, unsigned& vo) const {
        ko = (unsigned)(((8 * (fr >> 2) + (fr & 3)) * 64 + 8 * fq) * 2); vo = (unsigned)((fr * ld + 8 * fq) * 2);
        asm volatile("" : "+v"(ko), "+v"(vo));
    }
    __device__ __forceinline__ bf16x8 kf(int key0, int mt, int ks, unsigned ko) const {
        return *(const bf16x8*)((const char*)K + (size_t)key0 * 128 + (ko + (unsigned)((4 * mt * 64 + 32 * ks) * 2))); }
    __device__ __forceinline__ bf16x8 vf(int key0, int dt, unsigned vo) const {
        return *(const bf16x8*)((const char*)VT + (size_t)key0 * 2 + (vo + (unsigned)(16 * dt * ld * 2))); }
};
struct KvSampleSel {
    const float* cache; const int* pt; const float* snew; int g;
    __device__ __forceinline__ const float* krow(int pos, int slot) const {
        if (pos < PAST) return cache + ((size_t)pt[pos >> 7] * PAGE + (pos & 127)) * 1024 + slot * 256;
        int i = pos - PAST; i = i < 3 ? i : 3; return snew + (size_t)i * 512 + (slot - 2) * 256; }
    __device__ __forceinline__ void lane_offsets(int fr, int fq, unsigned& ko, unsigned& vo) const { ko = (unsigned)(fr | (fq << 8)); vo = ko; asm volatile("" : "+v"(ko), "+v"(vo)); }
    __device__ __forceinline__ bf16x8 kf(int key0, int mt, int ks, unsigned ko) const { const int fr = ko & 255, fq = ko >> 8;
        const float* p = krow(key0 + 8 * (fr >> 2) + 4 * mt + (fr & 3), 2) + 32 * ks + 8 * fq; return cvt8(*(const f32x4*)p, *(const f32x4*)(p + 4)); }
    __device__ __forceinline__ bf16x8 vf(int key0, int dt, unsigned vo) const { const int fr = vo & 255, fq = vo >> 8; f32x4 a, b;
#pragma unroll
        for (int j = 0; j < 4; ++j) { a[j] = krow(key0 + 8 * fq + j, 3)[16 * dt + fr]; b[j] = krow(key0 + 8 * fq + 4 + j, 3)[16 * dt + fr]; }
        return cvt8(a, b); }
};
struct KvFrags { bf16x8 k[2][2]; bf16x8 v[4]; };
template <bool WITHV, class KV>
__device__ __forceinline__ void nsa_load(const KV& kv, int key0, int fr, int fq, KvFrags& f) {
    unsigned ko, vo; kv.lane_offsets(fr, fq, ko, vo);
#pragma unroll
    for (int mt = 0; mt < 2; ++mt)
#pragma unroll
        for (int ks = 0; ks < 2; ++ks) f.k[mt][ks] = kv.kf(key0, mt, ks, ko);
    if (WITHV) {
#pragma unroll
        for (int dt = 0; dt < 4; ++dt) f.v[dt] = kv.vf(key0, dt, vo);
    }
}

template <int NT, int MODE, bool QREG = false>
__device__ __forceinline__ void nsa_core(const KvFrags& f, int key0, const LAS bf16* qrow, int qnt, f32x4 (&O)[NT][4], float (&m)[NT], float (&l)[NT], const float (&invl)[NT], const float (&slope)[NT],
                                         int t, int pmul, int padd, int wlim, bool selok, LAS float* improw, int fq, const bf16x8* qreg = nullptr) {
    float dist[2][4]; bool val[2][4];
#pragma unroll
    for (int mt = 0; mt < 2; ++mt)
#pragma unroll
        for (int r = 0; r < 4; ++r) { const int kk = key0 + 8 * fq + 4 * mt + r; const int dd = t - (pmul * kk + padd); val[mt][r] = selok && dd >= 0 && dd < wlim; dist[mt][r] = val[mt][r] ? (float)dd : 1e6f; }
    float imp_main[2] = {0.f, 0.f}, imp_spill[2] = {0.f, 0.f};
    f32x4 sc[NT][2]; bf16x8 pfr[NT];
    __builtin_amdgcn_s_setprio(1);
#pragma unroll
    for (int nt = 0; nt < NT; ++nt) {
        bf16x8 q0, q1; if (QREG) { q0 = qreg[nt * 2]; q1 = qreg[nt * 2 + 1]; } else { q0 = ld8l(qrow + nt * qnt + 8 * fq); q1 = ld8l(qrow + nt * qnt + 32 + 8 * fq); }
#pragma unroll
        for (int mt = 0; mt < 2; ++mt) { sc[nt][mt] = (f32x4){0.f, 0.f, 0.f, 0.f}; sc[nt][mt] = MFMA16(f.k[mt][0], q0, sc[nt][mt]); sc[nt][mt] = MFMA16(f.k[mt][1], q1, sc[nt][mt]); }
    }
    __builtin_amdgcn_s_setprio(0);
#pragma unroll
    for (int nt = 0; nt < NT; ++nt) {
        f32x4 p[2]; float ps = 0.f;
#pragma unroll
        for (int mt = 0; mt < 2; ++mt)
#pragma unroll
            for (int r = 0; r < 4; ++r) { float pv = ex2(sc[nt][mt][r] - slope[nt] * dist[mt][r]); if (MODE == 2) pv *= invl[nt]; p[mt][r] = pv; ps += pv; }
        if (MODE != 2) l[nt] += ps;
        if (MODE == 2) {
#pragma unroll
            for (int mt = 0; mt < 2; ++mt) { imp_main[mt] += (p[mt][0] + p[mt][1]) + (p[mt][2] + p[mt][3]); imp_spill[mt] += p[mt][3]; }
        }
        if (MODE != 1) pfr[nt] = cvt8(p[0], p[1]);
    }
    if (MODE != 1) {
        __builtin_amdgcn_s_setprio(1);
#pragma unroll
        for (int nt = 0; nt < NT; ++nt)
#pragma unroll
            for (int dt = 0; dt < 4; ++dt) O[nt][dt] = MFMA16(f.v[dt], pfr[nt], O[nt][dt]);
        __builtin_amdgcn_s_setprio(0);
    }
    if (MODE == 2) {
#pragma unroll
        for (int mt = 0; mt < 2; ++mt) { const int j = key0 / 4 + 2 * fq + mt;
            __hip_atomic_fetch_add(improw + j, imp_main[mt], __ATOMIC_RELAXED, __HIP_MEMORY_SCOPE_WORKGROUP);
            __hip_atomic_fetch_add(improw + j + 1, imp_spill[mt], __ATOMIC_RELAXED, __HIP_MEMORY_SCOPE_WORKGROUP); }
    }
}
template <int NT, int MODE, class KV>
__device__ __forceinline__ void nsa_tile(const KV& kv, int key0, const LAS bf16* qrow, int qnt, f32x4 (&O)[NT][4], float (&m)[NT], float (&l)[NT], const float (&invl)[NT], const float (&slope)[NT],
                                         int t, int pmul, int padd, int wlim, bool selok, LAS float* improw, int fr, int fq) {
    KvFrags f; nsa_load<MODE != 1>(kv, key0, fr, fq, f);
    nsa_core<NT, MODE>(f, key0, qrow, qnt, O, m, l, invl, slope, t, pmul, padd, wlim, selok, improw, fq);
}

template <int NT>
__device__ __forceinline__ void nsa_zero(f32x4 (&O)[NT][4], float (&m)[NT], float (&l)[NT]) {
#pragma unroll
    for (int nt = 0; nt < NT; ++nt) { m[nt] = -1e30f; l[nt] = 0.f;
#pragma unroll
        for (int dt = 0; dt < 4; ++dt) O[nt][dt] = (f32x4){0.f, 0.f, 0.f, 0.f}; }
}

template <bool SAMPLE>
__device__ __forceinline__ void nsa_unit(Frame& F, int id) {
    constexpr int NT = SAMPLE ? 1 : 4;
    int lane_ = F.lane; asm volatile("" : "+v"(lane_));
    const int lane = lane_, fr = lane & 15, fq = lane >> 4;
    LAS unsigned char* L = F.lds; asm volatile("" : "+v"(L));
    LAS float* imp = (LAS float*)(L + NSA_IMP + F.wave * 8448);
    LAS bf16* qw = (LAS bf16*)(L + NSA_Q + F.wave * 8704);
    int bg, g, t, row, trow, tmax, row0;
    if (SAMPLE) { bg = id; g = id & 3; t = PAST + (fr >> 2); row0 = MP + (id >> 2) * 4; row = row0 + (fr >> 2); trow = fr >> 2; tmax = PAST + 3; }
    else { bg = id >> 9; g = bg & 3; const int tt = id & 511; t = 16 * tt + fr; row0 = (bg >> 2) * PT + 16 * tt; row = row0 + fr; trow = fr; tmax = 16 * tt + 15; }
    {
        const int nrow = SAMPLE ? 16 : 64;
        for (int i = lane; i < nrow * 8; i += 64) { const int rr = i >> 3, c8 = i & 7;
            *(LAS v4u*)(qw + rr * NSA_QLD + 8 * c8) = *(const v4u*)(WSP(bf16, WS_QN) + (size_t)(row0 + (rr >> 2)) * 1024 + (g * 4 + (rr & 3)) * 64 + 8 * c8); }
    }
    float slope[NT]; int hd[NT];
#pragma unroll
    for (int nt = 0; nt < NT; ++nt) { hd[nt] = g * 4 + (SAMPLE ? (fr & 3) : nt); slope[nt] = ex2(-0.5f * (float)(hd[nt] + 1)) * LOG2E; }
    const LAS bf16* qrow = qw + (SAMPLE ? fr : fr * 4) * NSA_QLD; const int qnt = SAMPLE ? 0 : NSA_QLD;
    const float* gates = WSP(float, WS_GATES) + (size_t)row * 48;
    float* oacc = WSP(float, WS_OACC) + (size_t)row * 1024;
    for (int i = lane; i < 16 * 132; i += 64) imp[i] = 0.f;
    LDS_WAIT();
    f32x4 O[NT][4]; float m[NT], l[NT], invl[NT];
    {
        KvBf16 kv{WSP(bf16, SAMPLE ? WS_SKCMP : WS_KCMP) + (size_t)bg * 512 * 64, WSP(bf16, SAMPLE ? WS_SVCMPT : WS_VCMPT) + (size_t)bg * 64 * 512, 512};
        const int cmax = (tmax - 31) >> 4;
        const int ntile = (tmax >= 31) ? ((cmax < 510 ? cmax : 510) / 32 + 1) : 0;
#pragma unroll
        for (int nt = 0; nt < NT; ++nt) invl[nt] = 0.f;
        nsa_zero<NT>(O, m, l);
        { KvFrags fa, fb; if (ntile > 0) nsa_load<false>(kv, 0, fr, fq, fa);
#pragma unroll 1
          for (int tl = 0; tl < ntile; ++tl) { if (tl + 1 < ntile) nsa_load<false>(kv, 32 * (tl + 1), fr, fq, fb);
            nsa_core<NT, 1>(fa, 32 * tl, qrow, qnt, O, m, l, invl, slope, t, 16, 31, 1 << 30, true, imp + trow * 132, fq); fa = fb; } }
#pragma unroll
        for (int nt = 0; nt < NT; ++nt) { float lt = l[nt]; lt = x32_sum(x16_sum(lt)); invl[nt] = lt > 0.f ? 1.f / lt : 0.f; }
        { KvFrags fa, fb; if (ntile > 0) nsa_load<true>(kv, 0, fr, fq, fa);
#pragma unroll 1
          for (int tl = 0; tl < ntile; ++tl) { if (tl + 1 < ntile) nsa_load<true>(kv, 32 * (tl + 1), fr, fq, fb);
            nsa_core<NT, 2>(fa, 32 * tl, qrow, qnt, O, m, l, invl, slope, t, 16, 31, 1 << 30, true, imp + trow * 132, fq); fa = fb; } }
#pragma unroll
        for (int nt = 0; nt < NT; ++nt) { const float gc = gates[0 * 16 + hd[nt]];
#pragma unroll
            for (int dt = 0; dt < 4; ++dt) *(f32x4*)(oacc + hd[nt] * 64 + 16 * dt + 4 * fq) = O[nt][dt] * gc; }
    }
    LDS_WAIT();
    unsigned selm[4] = {0u, 0u, 0u, 0u};
    {
        const int cur = t >> 6;
        if (!SAMPLE) {
            unsigned v[32];
#pragma unroll
            for (int i = 0; i < 32; ++i) { const int j = 32 * fq + i; const bool forced = (j == 0) | (j == cur) | (j == cur - 1);
                const unsigned key = ((f2u(imp[trow * 132 + j]) & ~127u) | (unsigned)(127 - j)) + 128u;
                v[i] = (!forced && j <= cur) ? key : 0u;
                if (forced) selm[fq] |= 1u << i; }
            unsigned fw = selm[0] | selm[1] | selm[2] | selm[3];
            const unsigned w16 = __shfl_xor(fw, 16), w32 = __shfl_xor(fw, 32), w48 = __shfl_xor(fw, 48);
#pragma unroll
            for (int wd = 0; wd < 4; ++wd) selm[wd] = (fq == wd) ? fw : ((fq ^ 1) == wd) ? w16 : ((fq ^ 2) == wd) ? w32 : w48;
            const int nforced = cur >= 2 ? 3 : cur + 1;
#pragma unroll 1
            for (int rd = 0; rd < 15; ++rd) {
                unsigned mx = v[0];
#pragma unroll
                for (int i = 1; i < 32; ++i) mx = mx > v[i] ? mx : v[i];
                mx = x32_umax(x16_umax(mx));
#pragma unroll
                for (int i = 0; i < 32; ++i) v[i] = (v[i] == mx) ? 0u : v[i];
                if (mx != 0u && rd < 16 - nforced) { const int js = 127 - (int)(mx & 127u);
#pragma unroll
                    for (int wd = 0; wd < 4; ++wd) selm[wd] |= ((js >> 5) == wd) ? (1u << (js & 31)) : 0u; }
            }
        } else {
            const int li = (fr & 3) * 4 + fq;
            unsigned v[8];
#pragma unroll
            for (int i = 0; i < 8; ++i) { const int j = li * 8 + i; v[i] = (j >= 1 && j <= 126) ? (((f2u(imp[trow * 132 + j]) & ~127u) | (unsigned)(127 - j)) + 128u) : 0u; }
            selm[0] = 1u; selm[3] = 1u << 31;
#pragma unroll 1
            for (int rd = 0; rd < 13; ++rd) {
                unsigned mx = v[0];
#pragma unroll
                for (int i = 1; i < 8; ++i) mx = mx > v[i] ? mx : v[i];
                { unsigned o = dpp_u<DPP_XOR1>(mx); mx = mx > o ? mx : o; o = dpp_u<DPP_XOR2>(mx); mx = mx > o ? mx : o; mx = x32_umax(x16_umax(mx)); }
#pragma unroll
                for (int i = 0; i < 8; ++i) v[i] = (v[i] == mx) ? 0u : v[i];
                if (mx != 0u) { const int js = 127 - (int)(mx & 127u);
#pragma unroll
                    for (int wd = 0; wd < 4; ++wd) selm[wd] |= ((js >> 5) == wd) ? (1u << (js & 31)) : 0u; }
            }
        }
    }
    if (SAMPLE || !NSA_SUBUNITS) {
        nsa_zero<NT>(O, m, l);
        unsigned un[4];
#pragma unroll
        for (int wd = 0; wd < 4; ++wd) { unsigned x = selm[wd]; x |= __shfl_xor(x, 1); x |= __shfl_xor(x, 2); x |= __shfl_xor(x, 4); x |= __shfl_xor(x, 8); un[wd] = (unsigned)__builtin_amdgcn_readfirstlane((int)x); }
        KvSampleSel kvs{FIN(2) + g * 64, (const int*)FIN(6) + (SAMPLE ? (id >> 2) : 0) * NPAGES, WSP(float, WS_SNEW) + (size_t)(SAMPLE ? (id >> 2) : 0) * 2048 + g * 64, g};
        KvBf16 kvp{WSP(bf16, WS_KSEL) + (size_t)bg * PT * 64, WSP(bf16, WS_VSELT) + (size_t)bg * 64 * PT, PT};
        if (SAMPLE) {
#pragma unroll 1
        for (int wd = 0; wd < 4; ++wd) {
            unsigned mm = un[wd];
            const unsigned mine = wd == 0 ? selm[0] : wd == 1 ? selm[1] : wd == 2 ? selm[2] : selm[3];
            while (mm) {
                const int bit = __builtin_ctz(mm); mm &= mm - 1u; const int j = 32 * wd + bit;
                const bool ok = (mine >> bit) & 1u;
#pragma unroll 1
                for (int hh = 0; hh < 2; ++hh) { nsa_tile<NT, 0>(kvs, 64 * j + 32 * hh, qrow, qnt, O, m, l, invl, slope, t, 1, 0, 1 << 30, ok, imp, fr, fq); __builtin_amdgcn_sched_barrier(0); }
            }
        }
        } else {
            int wdc = 0; unsigned mmc = un[0];
            while (wdc < 3 && mmc == 0u) { ++wdc; mmc = wdc == 1 ? un[1] : wdc == 2 ? un[2] : un[3]; }
            KvFrags fa, fb; int jc = -1, hc = 0;
            if (mmc) { jc = 32 * wdc + __builtin_ctz(mmc); mmc &= mmc - 1u; nsa_load<true>(kvp, 64 * jc, fr, fq, fa); }
#pragma unroll 1
            while (jc >= 0) {
                int jn = jc, hn = hc + 1;
                if (hn == 2) { hn = 0;
                    while (wdc < 3 && mmc == 0u) { ++wdc; mmc = wdc == 1 ? un[1] : wdc == 2 ? un[2] : un[3]; }
                    if (mmc) { jn = 32 * wdc + __builtin_ctz(mmc); mmc &= mmc - 1u; } else jn = -1; }
                if (jn >= 0) nsa_load<true>(kvp, 64 * jn + 32 * hn, fr, fq, fb);
                const int wj = jc >> 5, bj = jc & 31;
                const unsigned mine = wj == 0 ? selm[0] : wj == 1 ? selm[1] : wj == 2 ? selm[2] : selm[3];
                nsa_core<NT, 0>(fa, 64 * jc + 32 * hc, qrow, qnt, O, m, l, invl, slope, t, 1, 0, 1 << 30, (mine >> bj) & 1u, imp, fq);
                fa = fb; jc = jn; hc = hn;
            }
        }
        if (SAMPLE) nsa_tile<NT, 0>(kvs, 64 * 128, qrow, qnt, O, m, l, invl, slope, t, 1, 0, 1 << 30, true, imp, fr, fq);
#pragma unroll
        for (int nt = 0; nt < NT; ++nt) { float lt = l[nt]; lt = x32_sum(x16_sum(lt)); const float sc = gates[1 * 16 + hd[nt]] / fmaxf(lt, 1e-30f);
#pragma unroll
            for (int dt = 0; dt < 4; ++dt) { f32x4* o = (f32x4*)(oacc + hd[nt] * 64 + 16 * dt + 4 * fq); *o = *o + O[nt][dt] * sc; } }
    } else {
        unsigned ms[4][4];
#pragma unroll
        for (int s = 0; s < 4; ++s)
#pragma unroll
            for (int wd = 0; wd < 4; ++wd) ms[s][wd] = __shfl(selm[wd], 4 * s + (fr >> 2));
        unsigned su[4][4], un[4];
#pragma unroll
        for (int wd = 0; wd < 4; ++wd) { un[wd] = 0u;
#pragma unroll
            for (int s = 0; s < 4; ++s) { unsigned x = ms[s][wd]; x |= __shfl_xor(x, 4); x |= __shfl_xor(x, 8); su[s][wd] = (unsigned)__builtin_amdgcn_readfirstlane((int)x); un[wd] |= su[s][wd]; } }
        const int hds = g * 4 + (fr & 3); float slp[1]; slp[0] = ex2(-0.5f * (float)(hds + 1)) * LOG2E;
        const int tb = (id & 511) * 16 + (fr >> 2);
        f32x4 Os[4][1][4]; float mS[4][1], lS[4][1]; float inv1[1] = {0.f};
#pragma unroll
        for (int s = 0; s < 4; ++s) nsa_zero<1>(Os[s], mS[s], lS[s]);
        KvBf16 kvp{WSP(bf16, WS_KSEL) + (size_t)bg * PT * 64, WSP(bf16, WS_VSELT) + (size_t)bg * 64 * PT, PT};
        int wdc = 0; unsigned mmc = un[0];
        while (wdc < 3 && mmc == 0u) { ++wdc; mmc = wdc == 1 ? un[1] : wdc == 2 ? un[2] : un[3]; }
        KvFrags fa, fb;
        int jc = -1, hc = 0;
        if (mmc) { jc = 32 * wdc + __builtin_ctz(mmc); mmc &= mmc - 1u; nsa_load<true>(kvp, 64 * jc, fr, fq, fa); }
#pragma unroll 1
        while (jc >= 0) {
            int jn = jc, hn = hc + 1;
            if (hn == 2) { hn = 0;
                while (wdc < 3 && mmc == 0u) { ++wdc; mmc = wdc == 1 ? un[1] : wdc == 2 ? un[2] : un[3]; }
                if (mmc) { jn = 32 * wdc + __builtin_ctz(mmc); mmc &= mmc - 1u; } else jn = -1; }
            if (jn >= 0) nsa_load<true>(kvp, 64 * jn + 32 * hn, fr, fq, fb);
            const int wj = jc >> 5, bj = jc & 31;
#pragma unroll
            for (int s = 0; s < 4; ++s) {
                const unsigned suw = wj == 0 ? su[s][0] : wj == 1 ? su[s][1] : wj == 2 ? su[s][2] : su[s][3];
                if ((suw >> bj) & 1u) {
                    const unsigned mw = wj == 0 ? ms[s][0] : wj == 1 ? ms[s][1] : wj == 2 ? ms[s][2] : ms[s][3];
                    nsa_core<1, 0>(fa, 64 * jc + 32 * hc, qw + (16 * s + fr) * NSA_QLD, 0, Os[s], mS[s], lS[s], inv1, slp, tb + 4 * s, 1, 0, 1 << 30, (mw >> bj) & 1u, imp, fq);
                }
            }
            fa = fb; jc = jn; hc = hn;
        }
#pragma unroll
        for (int s = 0; s < 4; ++s) { float lt = lS[s][0]; lt = x32_sum(x16_sum(lt));
            const size_t rs = (size_t)(row0 + 4 * s + (fr >> 2));
            const float sc = WSP(float, WS_GATES)[rs * 48 + 16 + hds] / fmaxf(lt, 1e-30f);
#pragma unroll
            for (int dt = 0; dt < 4; ++dt) { f32x4* o = (f32x4*)(WSP(float, WS_OACC) + rs * 1024 + hds * 64 + 16 * dt + 4 * fq); *o = *o + Os[s][0][dt] * sc; } }
    }
    {
        nsa_zero<NT>(O, m, l);
        KvBf16 kv = SAMPLE ? KvBf16{WSP(bf16, WS_SKWIN) + (size_t)bg * 544 * 64, WSP(bf16, WS_SVWINT) + (size_t)bg * 64 * 544, 544}
                           : KvBf16{WSP(bf16, WS_KWIN) + (size_t)bg * PT * 64, WSP(bf16, WS_VWINT) + (size_t)bg * 64 * PT, PT};
        int k0, k1, padd;
        if (SAMPLE) { k0 = 0; k1 = 544; padd = PAST - WINDOW; }
        else { const int lo = tmax - 15 - (WINDOW - 1); k0 = (lo > 0 ? lo : 0) & ~31; k1 = tmax + 1; padd = 0; }
        { KvFrags fa, fb; nsa_load<true>(kv, k0, fr, fq, fa);
#pragma unroll 1
          for (int kk = k0; kk < k1; kk += 32) { if (kk + 32 < k1) nsa_load<true>(kv, kk + 32, fr, fq, fb);
            nsa_core<NT, 0>(fa, kk, qrow, qnt, O, m, l, invl, slope, t, 1, padd, WINDOW, true, imp, fq); fa = fb; } }
        bf16* on = WSP(bf16, WS_OG) + (size_t)row * 1024;
#pragma unroll
        for (int nt = 0; nt < NT; ++nt) { float lt = l[nt]; lt = x32_sum(x16_sum(lt)); const float sc = gates[2 * 16 + hd[nt]] / fmaxf(lt, 1e-30f);
#pragma unroll
            for (int dt = 0; dt < 4; ++dt) { const f32x4 o = *(const f32x4*)(oacc + hd[nt] * 64 + 16 * dt + 4 * fq) + O[nt][dt] * sc;
                *(v2u*)(on + hd[nt] * 64 + 16 * dt + 4 * fq) = (v2u){pk2(o[0], o[1]), pk2(o[2], o[3])}; } }
    }
}

constexpr int NW_STG = 67584;
constexpr int NW_STG_BYTES = 18432;
constexpr int NW_UN = NW_STG + 2 * NW_STG_BYTES;
struct NwStage { v4u k, v; };
__device__ __forceinline__ void nw_load(const bf16* K, const bf16* VT, int ld, int key0, int tid, NwStage& s) {
    s.k = *(const v4u*)(K + (size_t)(key0 + (tid >> 3)) * 64 + 8 * (tid & 7));
    s.v = *(const v4u*)(VT + (size_t)(tid >> 3) * ld + key0 + 8 * (tid & 7));
}
__device__ __forceinline__ void nw_store(LAS unsigned char* buf, int tid, const NwStage& s) {
    const int kk = tid >> 3, c8 = tid & 7, k32 = kk & 31;
    const int rho = 32 * (kk >> 5) + 16 * ((k32 >> 2) & 1) + 4 * (k32 >> 3) + (k32 & 3);
    *(LAS v4u*)(buf + rho * 144 + c8 * 16) = s.k;
    *(LAS v4u*)(buf + 9216 + kk * 144 + c8 * 16) = s.v;
}
template <bool WITHV>
__device__ __forceinline__ void nw_frags(const LAS unsigned char* buf, int th, int fr, int fq, KvFrags& f) {
#pragma unroll
    for (int mt = 0; mt < 2; ++mt)
#pragma unroll
        for (int ks = 0; ks < 2; ++ks) f.k[mt][ks] = *(const LAS bf16x8*)(buf + (32 * th + 16 * mt + fr) * 144 + (32 * ks + 8 * fq) * 2);
    if (WITHV) {
#pragma unroll
        for (int dt = 0; dt < 4; ++dt) f.v[dt] = *(const LAS bf16x8*)(buf + 9216 + (16 * dt + fr) * 144 + (32 * th + 8 * fq) * 2);
    }
}
#define NW_PIPE(Kp, VTp, ldv, NB, BLK, BODY) do { const int nb_ = (NB); \
        if (nb_ > 0) { NwStage st_; nw_load(Kp, VTp, ldv, BLK(0), F.tid, st_); nw_store(stg, F.tid, st_); } \
        __syncthreads(); \
        _Pragma("unroll 1") for (int ib_ = 0; ib_ < nb_; ++ib_) { \
            NwStage st_; const bool more_ = ib_ + 1 < nb_; if (more_) nw_load(Kp, VTp, ldv, BLK(ib_ + 1), F.tid, st_); \
            const LAS unsigned char* buf_ = stg + (ib_ & 1) * NW_STG_BYTES; const int key0_ = BLK(ib_); \
            BODY(buf_, key0_) \
            if (more_) nw_store(stg + ((ib_ + 1) & 1) * NW_STG_BYTES, F.tid, st_); \
            __syncthreads(); } } while (0)

__device__ __forceinline__ void nsa_wg(Frame& F, int bg, int qb) {
    int lane_ = F.lane; asm volatile("" : "+v"(lane_));
    const int lane = lane_, fr = lane & 15, fq = lane >> 4, w = F.wave, g = bg & 3;
    LAS unsigned char* L = F.lds; asm volatile("" : "+v"(L));
    LAS float* imp = (LAS float*)(L + NSA_IMP + w * 8448);
    LAS unsigned char* stg = L + NW_STG;
    LAS unsigned* wun = (LAS unsigned*)(L + NW_UN); volatile LAS unsigned char* blist = (volatile LAS unsigned char*)(L + NW_UN + 16);
    const int tt = qb * 8 + w, t = 16 * tt + fr, row0 = (bg >> 2) * PT + 16 * tt, row = row0 + fr, tw0 = 16 * tt, tw1 = tw0 + 15;
    float slope[4]; bf16x8 qreg[8];
#pragma unroll
    for (int nt = 0; nt < 4; ++nt) { slope[nt] = ex2(-0.5f * (float)(g * 4 + nt + 1)) * LOG2E;
        const bf16* qp = WSP(bf16, WS_QN) + (size_t)row * 1024 + (g * 4 + nt) * 64 + 8 * fq; qreg[2 * nt] = ld8(qp); qreg[2 * nt + 1] = ld8(qp + 32); }
    const float* gates = WSP(float, WS_GATES) + (size_t)row * 48;
    float* oacc = WSP(float, WS_OACC) + (size_t)row * 1024;
    for (int i = lane; i < 16 * 132; i += 64) imp[i] = 0.f;
    if (F.tid < 4) wun[F.tid] = 0u;
    f32x4 O[4][4]; float m[4], l[4], invl[4];
    {
        const bf16* Kc = WSP(bf16, WS_KCMP) + (size_t)bg * 512 * 64; const bf16* Vc = WSP(bf16, WS_VCMPT) + (size_t)bg * 64 * 512;
        const int cmax = (128 * qb + 127 - 31) >> 4, ncb = (cmax < 510 ? cmax : 510) / 64 + 1;
#pragma unroll
        for (int nt = 0; nt < 4; ++nt) invl[nt] = 0.f;
        nsa_zero<4>(O, m, l);
#define NW_BLK(i) (64 * (i))
#define NW_CMP1(buf, k0) { _Pragma("unroll 1") for (int th = 0; th < 2; ++th) if (16 * ((k0) + 32 * th) + 31 <= tw1) { KvFrags f; nw_frags<false>(buf, th, fr, fq, f); \
            nsa_core<4, 1, true>(f, (k0) + 32 * th, nullptr, 0, O, m, l, invl, slope, t, 16, 31, 1 << 30, true, imp + fr * 132, fq, qreg); } }
        NW_PIPE(Kc, Vc, 512, ncb, NW_BLK, NW_CMP1);
#pragma unroll
        for (int nt = 0; nt < 4; ++nt) { const float lt = x32_sum(x16_sum(l[nt])); invl[nt] = lt > 0.f ? 1.f / lt : 0.f; }
#define NW_CMP2(buf, k0) { _Pragma("unroll 1") for (int th = 0; th < 2; ++th) if (16 * ((k0) + 32 * th) + 31 <= tw1) { KvFrags f; nw_frags<true>(buf, th, fr, fq, f); \
            nsa_core<4, 2, true>(f, (k0) + 32 * th, nullptr, 0, O, m, l, invl, slope, t, 16, 31, 1 << 30, true, imp + fr * 132, fq, qreg); } }
        NW_PIPE(Kc, Vc, 512, ncb, NW_BLK, NW_CMP2);
#pragma unroll
        for (int nt = 0; nt < 4; ++nt) { const float gc = gates[0 * 16 + g * 4 + nt];
#pragma unroll
            for (int dt = 0; dt < 4; ++dt) *(f32x4*)(oacc + (g * 4 + nt) * 64 + 16 * dt + 4 * fq) = O[nt][dt] * gc; }
    }
    LDS_WAIT();
    unsigned selm[4] = {0u, 0u, 0u, 0u};
    {
        const int cur = t >> 6;
        unsigned v[32];
#pragma unroll
        for (int i = 0; i < 32; ++i) { const int j = 32 * fq + i; const bool forced = (j == 0) | (j == cur) | (j == cur - 1);
            const unsigned key = ((f2u(imp[fr * 132 + j]) & ~127u) | (unsigned)(127 - j)) + 128u;
            v[i] = (!forced && j <= cur) ? key : 0u;
            if (forced) selm[fq] |= 1u << i; }
        unsigned fw = selm[0] | selm[1] | selm[2] | selm[3];
        const unsigned w16 = __shfl_xor(fw, 16), w32 = __shfl_xor(fw, 32), w48 = __shfl_xor(fw, 48);
#pragma unroll
        for (int wd = 0; wd < 4; ++wd) selm[wd] = (fq == wd) ? fw : ((fq ^ 1) == wd) ? w16 : ((fq ^ 2) == wd) ? w32 : w48;
        const int nforced = cur >= 2 ? 3 : cur + 1;
#pragma unroll 1
        for (int rd = 0; rd < 15; ++rd) {
            unsigned mx = v[0];
#pragma unroll
            for (int i = 1; i < 32; ++i) mx = mx > v[i] ? mx : v[i];
            mx = x32_umax(x16_umax(mx));
#pragma unroll
            for (int i = 0; i < 32; ++i) v[i] = (v[i] == mx) ? 0u : v[i];
            if (mx != 0u && rd < 16 - nforced) { const int js = 127 - (int)(mx & 127u);
#pragma unroll
                for (int wd = 0; wd < 4; ++wd) selm[wd] |= ((js >> 5) == wd) ? (1u << (js & 31)) : 0u; }
        }
    }
    unsigned un[4];
#pragma unroll
    for (int wd = 0; wd < 4; ++wd) { unsigned x = selm[wd]; x |= dpp_u<DPP_XOR1>(x); x |= dpp_u<DPP_XOR2>(x); x |= dpp_u<DPP_HMIR>(x); x |= dpp_u<DPP_MIR>(x); un[wd] = (unsigned)__builtin_amdgcn_readfirstlane((int)x); }
    if (lane < 4) __hip_atomic_fetch_or(wun + lane, lane == 0 ? un[0] : lane == 1 ? un[1] : lane == 2 ? un[2] : un[3], __ATOMIC_RELAXED, __HIP_MEMORY_SCOPE_WORKGROUP);
    __syncthreads();
    unsigned wu[4];
#pragma unroll
    for (int wd = 0; wd < 4; ++wd) wu[wd] = (unsigned)__builtin_amdgcn_readfirstlane((int)wun[wd]);
    {
        nsa_zero<4>(O, m, l);
        const bf16* Ks = WSP(bf16, WS_KSEL) + (size_t)bg * PT * 64; const bf16* Vs = WSP(bf16, WS_VSELT) + (size_t)bg * 64 * PT;
        const int nsb = __builtin_popcount(wu[0]) + __builtin_popcount(wu[1]) + __builtin_popcount(wu[2]) + __builtin_popcount(wu[3]);
        if (F.tid < 128) { const int j = F.tid, wj = j >> 5, bj = j & 31; const unsigned ww = wj == 0 ? wu[0] : wj == 1 ? wu[1] : wj == 2 ? wu[2] : wu[3];
            if ((ww >> bj) & 1u) { int pos = __builtin_popcount(ww & ((1u << bj) - 1u)); if (wj > 0) pos += __builtin_popcount(wu[0]); if (wj > 1) pos += __builtin_popcount(wu[1]); if (wj > 2) pos += __builtin_popcount(wu[2]);
                blist[pos] = (unsigned char)j; } }
        __syncthreads();
#define NW_SBLK(i) (64 * (int)blist[(i)])
#define NW_SEL(buf, k0) { const int j_ = (k0) >> 6, wj_ = j_ >> 5, bj_ = j_ & 31; const unsigned uw_ = wj_ == 0 ? un[0] : wj_ == 1 ? un[1] : wj_ == 2 ? un[2] : un[3]; \
            if ((uw_ >> bj_) & 1u) { const unsigned mine_ = wj_ == 0 ? selm[0] : wj_ == 1 ? selm[1] : wj_ == 2 ? selm[2] : selm[3]; const bool ok_ = (mine_ >> bj_) & 1u; \
                _Pragma("unroll 1") for (int th = 0; th < 2; ++th) { KvFrags f; nw_frags<true>(buf, th, fr, fq, f); \
                    nsa_core<4, 0, true>(f, (k0) + 32 * th, nullptr, 0, O, m, l, invl, slope, t, 1, 0, 1 << 30, ok_, imp, fq, qreg); } } }
        NW_PIPE(Ks, Vs, PT, nsb, NW_SBLK, NW_SEL);
#pragma unroll
        for (int nt = 0; nt < 4; ++nt) { const float lt = x32_sum(x16_sum(l[nt])); const float sc = gates[1 * 16 + g * 4 + nt] / fmaxf(lt, 1e-30f);
#pragma unroll
            for (int dt = 0; dt < 4; ++dt) { f32x4* o = (f32x4*)(oacc + (g * 4 + nt) * 64 + 16 * dt + 4 * fq); *o = *o + O[nt][dt] * sc; } }
    }
    {
        nsa_zero<4>(O, m, l);
        const bf16* Kw = WSP(bf16, WS_KWIN) + (size_t)bg * PT * 64; const bf16* Vw = WSP(bf16, WS_VWINT) + (size_t)bg * 64 * PT;
        const int lo = 128 * qb - (WINDOW - 1), kb0 = (lo > 0 ? lo : 0) >> 6, kb1 = (128 * qb + 127) >> 6, nwb = kb1 - kb0 + 1;
#define NW_WBLK(i) (64 * (kb0 + (i)))
#define NW_WIN(buf, k0) { _Pragma("unroll 1") for (int th = 0; th < 2; ++th) { const int kk_ = (k0) + 32 * th; if (kk_ <= tw1 && kk_ + 31 >= tw0 - (WINDOW - 1)) { KvFrags f; nw_frags<true>(buf, th, fr, fq, f); \
                nsa_core<4, 0, true>(f, kk_, nullptr, 0, O, m, l, invl, slope, t, 1, 0, WINDOW, true, imp, fq, qreg); } } }
        NW_PIPE(Kw, Vw, PT, nwb, NW_WBLK, NW_WIN);
        bf16* on = WSP(bf16, WS_OG) + (size_t)row * 1024;
#pragma unroll
        for (int nt = 0; nt < 4; ++nt) { const float lt = x32_sum(x16_sum(l[nt])); const float sc = gates[2 * 16 + g * 4 + nt] / fmaxf(lt, 1e-30f);
#pragma unroll
            for (int dt = 0; dt < 4; ++dt) { const f32x4 o = *(const f32x4*)(oacc + (g * 4 + nt) * 64 + 16 * dt + 4 * fq) + O[nt][dt] * sc;
                *(v2u*)(on + (g * 4 + nt) * 64 + 16 * dt + 4 * fq) = (v2u){pk2(o[0], o[1]), pk2(o[2], o[3])}; } }
    }
    __syncthreads();
}

constexpr int SW_Q = 0;
constexpr int SW_IMPP = 2304;
constexpr int SW_IMPT = SW_IMPP + 8 * 2112;
constexpr int SW_LP = SW_IMPT + 2112;
constexpr int SW_OP = SW_LP + 3 * 8 * 16 * 4;
static_assert(SW_OP + 8 * 3 * 16 * 64 * 4 <= RING_BYTES, "sample NSA LDS map");
__device__ __forceinline__ void nsa_sample_wg(Frame& F, int id) {
    int lane_ = F.lane; asm volatile("" : "+v"(lane_));
    const int lane = lane_, fr = lane & 15, fq = lane >> 4, w = F.wave, g = id & 3, bs = id >> 2;
    LAS unsigned char* L = F.lds; asm volatile("" : "+v"(L));
    LAS bf16* qw = (LAS bf16*)(L + SW_Q);
    LAS float* impP = (LAS float*)(L + SW_IMPP) + w * 528; LAS float* impT = (LAS float*)(L + SW_IMPT);
    LAS float* LP = (LAS float*)(L + SW_LP); LAS float* OP = (LAS float*)(L + SW_OP);
    const int t = PAST + (fr >> 2), row0 = MP + bs * 4, trow = fr >> 2, hd = g * 4 + (fr & 3);
    if (F.tid < 128) { const int rr = F.tid >> 3, c8 = F.tid & 7;
        *(LAS v4u*)(qw + rr * NSA_QLD + 8 * c8) = *(const v4u*)(WSP(bf16, WS_QN) + (size_t)(row0 + (rr >> 2)) * 1024 + (g * 4 + (rr & 3)) * 64 + 8 * c8); }
    for (int i = lane; i < 528; i += 64) impP[i] = 0.f;
    __syncthreads();
    float slope[1] = {ex2(-0.5f * (float)(hd + 1)) * LOG2E};
    const LAS bf16* qrow = qw + fr * NSA_QLD;
    f32x4 O[1][4]; float m[1], l[1], invl[1] = {0.f};
#define SW_PUT_O(br) { _Pragma("unroll") for (int dt = 0; dt < 4; ++dt) *(LAS f32x4*)(OP + ((w * 3 + (br)) * 16 + fr) * 64 + 16 * dt + 4 * fq) = O[0][dt]; }
#define SW_PUT_L(br) { const float lt_ = x32_sum(x16_sum(l[0])); if (fq == 0) LP[((br) * 8 + w) * 16 + fr] = lt_; }
    {
        KvBf16 kv{WSP(bf16, WS_SKCMP) + (size_t)id * 512 * 64, WSP(bf16, WS_SVCMPT) + (size_t)id * 64 * 512, 512};
        nsa_zero<1>(O, m, l);
#pragma unroll 1
        for (int tl = w; tl < 16; tl += 8) nsa_tile<1, 1>(kv, 32 * tl, qrow, 0, O, m, l, invl, slope, t, 16, 31, 1 << 30, true, impP + trow * 132, fr, fq);
        SW_PUT_L(0)
        __syncthreads();
        { float lt = 0.f;
#pragma unroll
          for (int ww = 0; ww < 8; ++ww) lt += LP[(0 * 8 + ww) * 16 + fr];
          invl[0] = lt > 0.f ? 1.f / lt : 0.f; }
#pragma unroll 1
        for (int tl = w; tl < 16; tl += 8) nsa_tile<1, 2>(kv, 32 * tl, qrow, 0, O, m, l, invl, slope, t, 16, 31, 1 << 30, true, impP + trow * 132, fr, fq);
        SW_PUT_O(0)
    }
    __syncthreads();
    for (int i = F.tid; i < 528; i += 512) { float s = 0.f;
#pragma unroll
        for (int ww = 0; ww < 8; ++ww) s += ((LAS float*)(L + SW_IMPP))[ww * 528 + i];
        impT[i] = s; }
    __syncthreads();
    unsigned selm[4] = {1u, 0u, 0u, 1u << 31};
    {
        const int li = (fr & 3) * 4 + fq;
        unsigned v[8];
#pragma unroll
        for (int i = 0; i < 8; ++i) { const int j = li * 8 + i; v[i] = (j >= 1 && j <= 126) ? (((f2u(impT[trow * 132 + j]) & ~127u) | (unsigned)(127 - j)) + 128u) : 0u; }
#pragma unroll 1
        for (int rd = 0; rd < 13; ++rd) {
            unsigned mx = v[0];
#pragma unroll
            for (int i = 1; i < 8; ++i) mx = mx > v[i] ? mx : v[i];
            { unsigned o = dpp_u<DPP_XOR1>(mx); mx = mx > o ? mx : o; o = dpp_u<DPP_XOR2>(mx); mx = mx > o ? mx : o; mx = x32_umax(x16_umax(mx)); }
#pragma unroll
            for (int i = 0; i < 8; ++i) v[i] = (v[i] == mx) ? 0u : v[i];
            if (mx != 0u) { const int js = 127 - (int)(mx & 127u);
#pragma unroll
                for (int wd = 0; wd < 4; ++wd) selm[wd] |= ((js >> 5) == wd) ? (1u << (js & 31)) : 0u; }
        }
    }
    {
        nsa_zero<1>(O, m, l);
        unsigned un[4];
#pragma unroll
        for (int wd = 0; wd < 4; ++wd) { unsigned x = selm[wd]; x |= dpp_u<DPP_XOR1>(x); x |= dpp_u<DPP_XOR2>(x); x |= dpp_u<DPP_HMIR>(x); x |= dpp_u<DPP_MIR>(x); un[wd] = (unsigned)__builtin_amdgcn_readfirstlane((int)x); }
        KvSampleSel kvs{FIN(2) + g * 64, (const int*)FIN(6) + bs * NPAGES, WSP(float, WS_SNEW) + (size_t)bs * 2048 + g * 64, g};
        int q = 0;
#pragma unroll 1
        for (int wd = 0; wd < 4; ++wd) {
            unsigned mm = un[wd];
            const unsigned mine = wd == 0 ? selm[0] : wd == 1 ? selm[1] : wd == 2 ? selm[2] : selm[3];
            while (mm) {
                const int bit = __builtin_ctz(mm); mm &= mm - 1u; const int j = 32 * wd + bit;
                const bool ok = (mine >> bit) & 1u;
#pragma unroll 1
                for (int hh = 0; hh < 2; ++hh, ++q) if ((q & 7) == w) { nsa_tile<1, 0>(kvs, 64 * j + 32 * hh, qrow, 0, O, m, l, invl, slope, t, 1, 0, 1 << 30, ok, impP, fr, fq); __builtin_amdgcn_sched_barrier(0); }
            }
        }
        if ((q & 7) == w) nsa_tile<1, 0>(kvs, 64 * 128, qrow, 0, O, m, l, invl, slope, t, 1, 0, 1 << 30, true, impP, fr, fq);
        SW_PUT_O(1) SW_PUT_L(1)
    }
    {
        nsa_zero<1>(O, m, l);
        KvBf16 kv{WSP(bf16, WS_SKWIN) + (size_t)id * 544 * 64, WSP(bf16, WS_SVWINT) + (size_t)id * 64 * 544, 544};
#pragma unroll 1
        for (int kk = 32 * w; kk < 544; kk += 256) nsa_tile<1, 0>(kv, kk, qrow, 0, O, m, l, invl, slope, t, 1, PAST - WINDOW, WINDOW, true, impP, fr, fq);
        SW_PUT_O(2) SW_PUT_L(2)
    }
    __syncthreads();
    {
        const int r = F.tid >> 5, d0 = (F.tid & 31) * 2, rowg = row0 + (r >> 2), hdr = g * 4 + (r & 3);
        float o0 = 0.f, o1 = 0.f;
#pragma unroll
        for (int br = 0; br < 3; ++br) { float a0 = 0.f, a1 = 0.f, lt = 0.f;
#pragma unroll
            for (int ww = 0; ww < 8; ++ww) { const f32x2 x = *(const LAS f32x2*)(OP + ((ww * 3 + br) * 16 + r) * 64 + d0); a0 += x.x; a1 += x.y; if (br > 0) lt += LP[(br * 8 + ww) * 16 + r]; }
            const float sc = WSP(float, WS_GATES)[(size_t)rowg * 48 + br * 16 + hdr] * (br == 0 ? 1.f : 1.f / fmaxf(lt, 1e-30f));
            o0 += a0 * sc; o1 += a1 * sc; }
        *(unsigned*)(WSP(bf16, WS_OG) + (size_t)rowg * 1024 + hdr * 64 + d0) = pk2(o0, o1);
    }
    __syncthreads();
#undef SW_PUT_O
#undef SW_PUT_L
}


#ifndef MK_SINGLE
#define MK_SINGLE 1
#endif
constexpr int NPHASE = 21;
struct Args { const float* in[29]; float* out; unsigned char* ws; int ph_lo, ph_hi; };
static_assert(sizeof(Args) == 31 * 8 + 8, "Args has no padding");

__global__ void __launch_bounds__(512, 2) mk_fwd(Args args) {
    extern __shared__ __attribute__((aligned(16))) unsigned char lds_raw[];
    Frame F;
    F.lds = (LAS unsigned char*)lds_raw;
    F.tid = threadIdx.x; F.lane = F.tid & 63; F.wave = __builtin_amdgcn_readfirstlane(F.tid >> 6);
    F.G = gridDim.x; F.bid = blockIdx.x;
    F.ka = (const __attribute__((address_space(4))) char*)__builtin_amdgcn_kernarg_segment_ptr();
    F.out = args.out; F.ws = args.ws;
    volatile LAS unsigned* MISC = (volatile LAS unsigned*)(F.lds + MISC_OFF);
    for (int u = F.tid; u < (LDS_BYTES - LDSCTL_OFF) / 4; u += 512) ((LAS unsigned*)(F.lds + LDSCTL_OFF))[u] = 0u;
    __syncthreads();
    unsigned* barw = (unsigned*)(F.ws + WS_CTL) + 4096;
    XcdBarrier bar; bar.bar = barw; bar.x = 0; bar.st = nullptr;
    const int lo = args.ph_lo, hi = args.ph_hi;
    if (hi - lo > 1) bar = xcd_barrier_post(barw, MISC + 8);
#ifndef PH_MASK
#define PH_MASK 0xFFFFFFFFu
#endif
#define IN(k) (((PH_MASK >> (k)) & 1u) && lo <= (k) && (k) < hi)
#define SEAM(k) do { if (IN(k) && IN((k) + 1)) xcd_barrier(bar); } while (0)
    const int gw = F.bid * 8 + F.wave, NGW = F.G * 8;

#ifndef REPX
#define REPX 0
#endif
#ifndef REPY
#define REPY 0
#endif
#ifndef REP_MASK
#define REP_MASK 0u
#endif
#define PHASE(k, ...) if (IN(k)) { _Pragma("unroll 1") for (int rep_ = 0; rep_ < (int)((REP_MASK >> (k)) & 1u) + 1; ++rep_) { if (rep_) xcd_barrier(bar); __VA_ARGS__ } } SEAM(k);
    PHASE(0, p0_prologue(F);)
    if (IN(1) && F.G != 256) { for (int task = F.bid; task < 512; task += F.G) fs_direct_task(F, task); }
    if (IN(1) && IN(2) && F.G != 256) xcd_barrier(bar);
    PHASE(2, gemm_all(F, WSP(bf16, WS_XNA), WSP(bf16, WS_WIN_T), 4096, FnBf16{WSP(bf16, WS_PROJ), 4096});)
    PHASE(3, for (int u = F.bid; u < 2048 + 256; u += F.G) { if (u < 2048) p2_chunk(F, u); else p2_sample(F, u - 2048); })
    PHASE(4, if (F.G == 256) { const int x = F.bid & 7, idx = F.bid >> 3;
                 if (idx < 8) p3_scan(F, x * 2 + (idx >> 2), idx & 3);
                 else { const int j = (idx - 8) * 8 + x;
                        const size_t n8 = (size_t)2 * NEXP * DM / 8; const int p0 = j < 128 ? 6 * j : 768 + 13 * (j - 128), p1 = p0 + (j < 128 ? 6 : 13);
                        peer_tables_to_fp8(F, (size_t)F.tid, (size_t)512, n8 * p0 / 1600, n8 * p1 / 1600);
                        __syncthreads();
                        for (int task = j; task < 512; task += 192) fs_direct_task(F, task); } }
             else { for (int u = F.bid; u < 64; u += F.G) p3_scan(F, u >> 2, u & 3); })
    PHASE(5, p4_rows(F, gw, NGW);
             for (int id = gw; id < 8192; id += NGW) compress_sample(F, id);)
    PHASE(6, gemm_all(F, WSP(bf16, WS_OG), WSP(bf16, WS_WOA_T), 1024, FnResid{WSP(float, WS_XS), FIN(0), FIN(1)});)
    PHASE(7, for (int r = gw; r < MTOK; r += NGW) rms_row_to_bf16_i8(WSP(float, WS_XS) + (size_t)r * DM, WSP(bf16, WS_XNB) + (size_t)r * DM, WSP(unsigned, WS_XN8) + (size_t)r * (DM / 4), WSP(float, WS_HS) + r, F.lane);)
    PHASE(8, gemm_all(F, WSP(bf16, WS_XNB), WSP(bf16, WS_WPQ_T), 2048, FnBf16{WSP(bf16, WS_QPEER), 2048});)
    PHASE(9, p8_phase(F, 0);)
    int pg_slice = F.bid & 7, pg_first = (F.bid >> 3) * 8 + F.wave, pg_stride = ((F.G - (F.bid & 7) + 7) >> 3) * 8;
#define PEER_GROUPS() do { if (MISC[8 + 3] != 0u && (F.G & 7) == 0) { const unsigned c_ = xb_ld(&barw[XB_XCNT(F.lane & 15)]); const bool ok_ = (F.lane & 15) < 8 ? c_ == (unsigned)(F.G >> 3) : c_ == 0u; \
        if (__builtin_amdgcn_ballot_w64(ok_) == ~0ull && bar.x < 8u) { pg_slice = (int)bar.x; pg_first = (int)MISC[8 + 2] * 8 + F.wave; pg_stride = F.G; } } } while (0)
    PHASE(10, PEER_GROUPS(); p9u_wave(F, 0, pg_slice, pg_first, pg_stride);)
    PHASE(11, PEER_GROUPS(); p9v_wave(F, 0, pg_slice, pg_first, pg_stride, 0);)
    PHASE(12, gemm_all(F, WSP(bf16, WS_XNA), WSP(bf16, WS_WKVQ_T), NKVQ, FnKvq{WSP(bf16, WS_KVQ), WSP(float, WS_SSQ)});)
    PHASE(13, for (int u = F.bid; u < 256; u += F.G) pp_prompt_tile(F, u);
              if (F.G == 256) { compress_prompt_split(F, F.bid * 2 + (F.wave >> 2)); if (F.bid < MS) pp_sample_row(F, F.bid, F.wave); }
              else { for (int r = gw; r < MS; r += NGW) pp_sample_row(F, r); for (int id = gw; id < 512; id += NGW) compress_prompt(F, id); })
    PHASE(14, if (F.G == 256) {
                  _Pragma("unroll 1") for (int q_ = 0; q_ < 1 + REPX; ++q_) { if (F.bid < 128) nsa_sample_wg(F, F.bid); }
                  __syncthreads();
                  { const int i_ = F.bid >> 3;
                    if (i_ < 16) { nsa_wg(F, F.bid & 7, i_); nsa_wg(F, F.bid & 7, 31 - i_); } else { nsa_wg(F, F.bid & 7, 16 + i_); nsa_wg(F, F.bid & 7, 79 - i_); } }
              } else { for (int id = gw; id < 128 + 4096; id += NGW) { if (id < 128) nsa_unit<true>(F, id); else nsa_unit<false>(F, id - 128); } })
    PHASE(15, gemm_all(F, WSP(bf16, WS_OG), WSP(bf16, WS_WOB_T), 1024, FnResid{WSP(float, WS_XS), WSP(float, WS_XS), WSP(float, WS_XS) + (size_t)MP * DM});)
    PHASE(16, for (int r = gw; r < MTOK; r += NGW) rms_row_to_bf16_i8(WSP(float, WS_XS) + (size_t)r * DM, WSP(bf16, WS_XNB) + (size_t)r * DM, WSP(unsigned, WS_XN8) + (size_t)r * (DM / 4), WSP(float, WS_HS) + r, F.lane);)
    PHASE(17, gemm_all(F, WSP(bf16, WS_XNB), WSP(bf16, WS_WPQ_T) + (size_t)2048 * 1024, 2048, FnBf16{WSP(bf16, WS_QPEER), 2048});)
    PHASE(18, p8_phase(F, 1);)
    PHASE(19, PEER_GROUPS(); p9u_wave(F, 1, pg_slice, pg_first, pg_stride);)
    PHASE(20, PEER_GROUPS(); p9v_wave(F, 1, pg_slice, pg_first, pg_stride, 1);)
#undef IN
#undef SEAM
}

extern "C" void kernel_launch(void* const* d_in, const int* in_sizes, int n_in, void* d_out, int out_size, void* d_ws, size_t ws_size, hipStream_t stream) {
    static int grid = 0;
    if (grid == 0) {
        if (n_in != 29 || (size_t)out_size != O_END || ws_size < WS_END) { fprintf(stderr, "kernel_launch: unexpected shapes n_in %d out %d ws %zu (need %zu)\n", n_in, out_size, ws_size, (size_t)WS_END); grid = -1; return; }
        int dev = 0, cus = 0, per_cu = 0;
        if (hipGetDevice(&dev) != hipSuccess || hipDeviceGetAttribute(&cus, hipDeviceAttributeMultiprocessorCount, dev) != hipSuccess) { grid = -1; return; }
        if (hipFuncSetAttribute((const void*)mk_fwd, hipFuncAttributeMaxDynamicSharedMemorySize, LDS_BYTES) != hipSuccess) { fprintf(stderr, "kernel_launch: hipFuncSetAttribute failed\n"); grid = -1; return; }
        if (hipOccupancyMaxActiveBlocksPerMultiprocessor(&per_cu, (const void*)mk_fwd, 512, LDS_BYTES) != hipSuccess || per_cu < 1) fprintf(stderr, "kernel_launch: occupancy query reports %d\n", per_cu);
        (void)hipGetLastError();
        grid = cus;
    }
    if (grid < 0) return;
    if (hipMemsetAsync((char*)d_ws + WS_CTL, 0, CTL_BYTES, stream) != hipSuccess) return;
    Args a{};
    for (int i = 0; i < 29; ++i) a.in[i] = (const float*)d_in[i];
    a.out = (float*)d_out; a.ws = (unsigned char*)d_ws;
#if MK_SINGLE
    a.ph_lo = 0; a.ph_hi = NPHASE;
    hipLaunchKernelGGL(mk_fwd, dim3(grid), dim3(512), LDS_BYTES, stream, a);
#else
    for (int p = 0; p < NPHASE; ++p) { a.ph_lo = p; a.ph_hi = p + 1; hipLaunchKernelGGL(mk_fwd, dim3(grid), dim3(512), LDS_BYTES, stream, a); }
#endif
    const hipError_t le = hipPeekAtLastError();
    if (le != hipSuccess) fprintf(stderr, "kernel_launch: launch failed: %s\n", hipGetErrorName(le));
}
```

```cpp
#include <hip/hip_runtime.h>
#include <cstdio>
#include <cstdint>

constexpr int DM = 1024, PB = 2, PT = 8192, SB = 32, SL = 4, PAST = 8192, PAGE = 128;
constexpr int MP = PB * PT;
constexpr int MS = SB * SL;
constexpr int MTOK = MP + MS;
constexpr int GH = 8, GDK = 128, GDV = 128, GCONV = 3072, GPROJ = 4112, CHUNK = 64, NCH = PT / CHUNK;
constexpr int NH = 16, NG = 4, HPG = 4, DH = 64, NQG = 1072, NKV = 1536, NKVQ = 2816, NKVQ_REAL = 2608;
constexpr int WINDOW = 512, NSELP = 128, NSELS = 129, NCMP = 511;
constexpr int PEH = 8, PEDQ = 256, PEHALF = 128, NKEYS = 128, NEXP = 16384, PETOP = 16;
constexpr int NPAGES = PAST / PAGE;
constexpr float EPS = 1e-6f;

constexpr size_t O_YP = 0;
constexpr size_t O_YS = O_YP + (size_t)MP * DM;
constexpr size_t O_KVP = O_YS + (size_t)MS * DM;
constexpr size_t O_WINP = O_KVP + (size_t)MP * 1024;
constexpr size_t O_GDNP = O_WINP + (size_t)PB * 512 * 512;
constexpr size_t O_CONVP = O_GDNP + (size_t)PB * GH * 128 * 128;
constexpr size_t O_KVS = O_CONVP + (size_t)PB * 3 * GCONV;
constexpr size_t O_WINS = O_KVS + (size_t)MS * 1024;
constexpr size_t O_GDNS = O_WINS + (size_t)SB * 512 * 512;
constexpr size_t O_CONVS = O_GDNS + (size_t)SB * GH * 128 * 128;
constexpr size_t O_END = O_CONVS + (size_t)SB * 3 * GCONV;

constexpr size_t MiB = 1u << 20;
constexpr size_t al(size_t x) { return (x + 4095) & ~(size_t)4095; }
constexpr size_t WS_CTL = 0, CTL_BYTES = 1 * MiB;
constexpr size_t WS_WIN_T = WS_CTL + CTL_BYTES;
constexpr size_t WS_WOA_T = WS_WIN_T + (size_t)4096 * 1024 * 2;
constexpr size_t WS_WKVQ_T = WS_WOA_T + (size_t)1024 * 1024 * 2;
constexpr size_t WS_WOB_T = WS_WKVQ_T + (size_t)NKVQ * 1024 * 2;
constexpr size_t WS_WPQ_T = WS_WOB_T + (size_t)1024 * 1024 * 2;
constexpr size_t WS_WAB = WS_WPQ_T + (size_t)2 * 2048 * 1024 * 2;
constexpr size_t WS_SUBK = WS_WAB + (size_t)16 * 1024 * 4;
constexpr size_t WS_W1T = WS_SUBK + (size_t)2 * 8 * 2 * 128 * 128 * 2;
constexpr size_t WS_PETERM = WS_W1T + (size_t)2 * 128 * 1024 * 2;
constexpr size_t WS_PU = al(WS_PETERM + 512);
constexpr size_t WS_PV = WS_PU + (size_t)2 * NEXP * DM * 2;
constexpr size_t WS_XNA = WS_PV + (size_t)2 * NEXP * DM * 2;
constexpr size_t WS_XNB = al(WS_XNA + (size_t)MTOK * DM * 2);
constexpr size_t WS_PROJ = al(WS_XNB + (size_t)MTOK * DM * 2);
constexpr size_t WS_GW = al(WS_PROJ + (size_t)MTOK * 4096 * 2);
constexpr size_t WS_GQ = WS_GW + (size_t)2048 * 64 * 128 * 2;
constexpr size_t WS_GKT = WS_GQ + (size_t)2048 * 64 * 128 * 2;
constexpr size_t WS_GQK = WS_GKT + (size_t)2048 * 64 * 128 * 2;
constexpr size_t WS_GU = WS_GQK + (size_t)2048 * 64 * 64 * 2;
constexpr size_t WS_GDEC = WS_GU + (size_t)2048 * 64 * 128 * 4;
constexpr size_t WS_OGDN = al(WS_GDEC + 2048 * 4);
constexpr size_t WS_OG = al(WS_OGDN + (size_t)MTOK * DM * 4);
constexpr size_t WS_XS = al(WS_OG + (size_t)MTOK * DM * 2);
constexpr size_t WS_QPEER = al(WS_XS + (size_t)MTOK * DM * 4);
constexpr size_t WS_PEI = al(WS_QPEER + (size_t)MTOK * 2048 * 2);
constexpr size_t WS_PEG = al(WS_PEI + (size_t)MTOK * 128 * 4);
constexpr size_t WS_KVQ = al(WS_PEG + (size_t)MTOK * 128 * 4);
constexpr size_t WS_KSEL = al(WS_KVQ + (size_t)MTOK * NKVQ * 4);
constexpr size_t WS_VSELT = WS_KSEL + (size_t)PB * NG * PT * 64 * 2;
constexpr size_t WS_KWIN = WS_VSELT + (size_t)PB * NG * PT * 64 * 2;
constexpr size_t WS_VWINT = WS_KWIN + (size_t)PB * NG * PT * 64 * 2;
constexpr size_t WS_KCMP = WS_VWINT + (size_t)PB * NG * PT * 64 * 2;
constexpr size_t WS_VCMPT = WS_KCMP + (size_t)PB * NG * 512 * 64 * 2;
constexpr size_t WS_SKCMP = WS_VCMPT + (size_t)PB * NG * 512 * 64 * 2;
constexpr size_t WS_SVCMPT = WS_SKCMP + (size_t)SB * NG * 512 * 64 * 2;
constexpr size_t WS_SKWIN = WS_SVCMPT + (size_t)SB * NG * 512 * 64 * 2;
constexpr size_t WS_SVWINT = WS_SKWIN + (size_t)SB * NG * 544 * 64 * 2;
constexpr size_t WS_SNEW = WS_SVWINT + (size_t)SB * NG * 544 * 64 * 2;
constexpr size_t WS_QN = al(WS_SNEW + (size_t)SB * 4 * 2 * 4 * 64 * 4);
constexpr size_t WS_GATES = al(WS_QN + (size_t)MTOK * 1024 * 2);
constexpr size_t WS_OACC = al(WS_GATES + (size_t)MTOK * 48 * 4);
constexpr size_t WS_CKA = al(WS_OACC + (size_t)MTOK * DM * 4);
constexpr size_t WS_W1BD = al(WS_CKA + (size_t)65536 * 2048 * 2);
constexpr size_t WS_FS = al(WS_W1BD + (size_t)256 * 2048 * 2);
constexpr size_t WS_PA = al(WS_FS + (size_t)65536 * 256 * 4);
constexpr size_t WS_SSQ = al(WS_PA + (size_t)MTOK * 8 * 64 * 4);
constexpr size_t WS_W2F = al(WS_SSQ + (size_t)MTOK * 8 * 4);
constexpr size_t WS_XN8 = al(WS_W2F + 2 * 4 * 2 * 64 * 8 * 2);
constexpr size_t WS_HS = al(WS_XN8 + (size_t)MTOK * DM);
constexpr size_t WS_END = al(WS_HS + (size_t)MTOK * 4);

constexpr int RING_BYTES = 143360;
constexpr int LDSCTL_OFF = RING_BYTES, MISC_OFF = LDSCTL_OFF + 320;
constexpr int LDS_BYTES = 147456;

#define GAS __attribute__((address_space(1)))
#define LAS __attribute__((address_space(3)))
typedef unsigned short bf16;
typedef unsigned v4u __attribute__((ext_vector_type(4)));
typedef unsigned v2u __attribute__((ext_vector_type(2)));
typedef float f32x4 __attribute__((ext_vector_type(4)));
typedef float f32x2 __attribute__((ext_vector_type(2)));
typedef short bf16x8 __attribute__((ext_vector_type(8)));
typedef GAS unsigned gu32;
#define RLX_AGENT __ATOMIC_RELAXED, __HIP_MEMORY_SCOPE_AGENT
#define LDS_WAIT() asm volatile("s_waitcnt lgkmcnt(0)" ::: "memory")
#define VM_WAIT() asm volatile("s_waitcnt vmcnt(0)" ::: "memory")

__device__ __forceinline__ unsigned f2bf(float f) { unsigned u = __builtin_bit_cast(unsigned, f); return (u + 0x7fffu + ((u >> 16) & 1u)) >> 16; }
typedef __bf16 hwbf16x2 __attribute__((ext_vector_type(2)));
__device__ __forceinline__ unsigned pk2(float lo, float hi) { const f32x2 v = {lo, hi}; return __builtin_bit_cast(unsigned, __builtin_convertvector(v, hwbf16x2)); }
__device__ __forceinline__ float bf2f(unsigned b) { return __builtin_bit_cast(float, b << 16); }
__device__ __forceinline__ float bflo(unsigned w) { return __builtin_bit_cast(float, w << 16); }
__device__ __forceinline__ float bfhi(unsigned w) { return __builtin_bit_cast(float, w & 0xffff0000u); }
#ifndef USE_PERMSWAP
#define USE_PERMSWAP 1
#endif
template <int CTRL> __device__ __forceinline__ float dpp_f(float x) { return __builtin_bit_cast(float, __builtin_amdgcn_update_dpp(0, __builtin_bit_cast(int, x), CTRL, 0xF, 0xF, true)); }
template <int CTRL> __device__ __forceinline__ unsigned dpp_u(unsigned x) { return (unsigned)__builtin_amdgcn_update_dpp(0, (int)x, CTRL, 0xF, 0xF, true); }
#define DPP_XOR1 0xB1
#define DPP_XOR2 0x4E
#define DPP_HMIR 0x141
#define DPP_MIR 0x140
#define DPP_ROR4 0x124
#define DPP_ROR8 0x128
#if USE_PERMSWAP
#define PSWAP16(a, b) asm volatile("s_nop 1\n\tv_permlane16_swap_b32 %0, %1" : "+v"(a), "+v"(b))
#define PSWAP32(a, b) asm volatile("s_nop 1\n\tv_permlane32_swap_b32 %0, %1" : "+v"(a), "+v"(b))
__device__ __forceinline__ float x16_sum(float x) { unsigned a = __builtin_bit_cast(unsigned, x), b = a; PSWAP16(a, b); return __builtin_bit_cast(float, a) + __builtin_bit_cast(float, b); }
__device__ __forceinline__ float x32_sum(float x) { unsigned a = __builtin_bit_cast(unsigned, x), b = a; PSWAP32(a, b); return __builtin_bit_cast(float, a) + __builtin_bit_cast(float, b); }
__device__ __forceinline__ float x16_max(float x) { unsigned a = __builtin_bit_cast(unsigned, x), b = a; PSWAP16(a, b); return fmaxf(__builtin_bit_cast(float, a), __builtin_bit_cast(float, b)); }
__device__ __forceinline__ float x32_max(float x) { unsigned a = __builtin_bit_cast(unsigned, x), b = a; PSWAP32(a, b); return fmaxf(__builtin_bit_cast(float, a), __builtin_bit_cast(float, b)); }
__device__ __forceinline__ unsigned x16_umax(unsigned u) { unsigned a = u, b = u; PSWAP16(a, b); return a > b ? a : b; }
__device__ __forceinline__ unsigned x32_umax(unsigned u) { unsigned a = u, b = u; PSWAP32(a, b); return a > b ? a : b; }
#else
__device__ __forceinline__ float x16_sum(float x) { return x + __shfl_xor(x, 16); }
__device__ __forceinline__ float x32_sum(float x) { return x + __shfl_xor(x, 32); }
__device__ __forceinline__ float x16_max(float x) { return fmaxf(x, __shfl_xor(x, 16)); }
__device__ __forceinline__ float x32_max(float x) { return fmaxf(x, __shfl_xor(x, 32)); }
__device__ __forceinline__ unsigned x16_umax(unsigned u) { const unsigned o = __shfl_xor(u, 16); return u > o ? u : o; }
__device__ __forceinline__ unsigned x32_umax(unsigned u) { const unsigned o = __shfl_xor(u, 32); return u > o ? u : o; }
#endif
__device__ __forceinline__ float row_sum16(float x) { x += dpp_f<DPP_XOR1>(x); x += dpp_f<DPP_XOR2>(x); x += dpp_f<DPP_HMIR>(x); x += dpp_f<DPP_MIR>(x); return x; }
__device__ __forceinline__ float wave_sum(float v) { return x32_sum(x16_sum(row_sum16(v))); }
__device__ __forceinline__ float frcp(float x) { return __builtin_amdgcn_rcpf(x); }
__device__ __forceinline__ float frsq(float x) { return __builtin_amdgcn_rsqf(x); }
__device__ __forceinline__ unsigned pk_i8(f32x4 v) {
    const int q0 = (int)__builtin_rintf(fminf(fmaxf(v.x, -127.f), 127.f)), q1 = (int)__builtin_rintf(fminf(fmaxf(v.y, -127.f), 127.f));
    const int q2 = (int)__builtin_rintf(fminf(fmaxf(v.z, -127.f), 127.f)), q3 = (int)__builtin_rintf(fminf(fmaxf(v.w, -127.f), 127.f));
    return (unsigned)(q0 & 255) | ((unsigned)(q1 & 255) << 8) | ((unsigned)(q2 & 255) << 16) | ((unsigned)q3 << 24);
}
__device__ __forceinline__ float silu_f(float x) { return x * frcp(1.f + __expf(-x)); }
__device__ __forceinline__ float sigmoid_f(float x) { return frcp(1.f + __expf(-x)); }
__device__ __forceinline__ float gelu_tanh(float x) {
    const float u = 0.7978845608028654f * (x + 0.044715f * x * x * x);
    const float e = __expf(2.f * u);
    const float th = 1.f - 2.f * frcp(e + 1.f);
    return 0.5f * x * (1.f + th);
}
__device__ __forceinline__ bf16x8 ld8(const bf16* p) { return *(const bf16x8*)p; }
__device__ __forceinline__ bf16x8 ld8l(const LAS bf16* p) { return *(const LAS bf16x8*)p; }
#define MFMA16(a, b, c) __builtin_amdgcn_mfma_f32_16x16x32_bf16((a), (b), (c), 0, 0, 0)
__device__ __forceinline__ bf16x8 cvt8(f32x4 a, f32x4 b) {
    v4u r; r.x = pk2(a.x, a.y); r.y = pk2(a.z, a.w); r.z = pk2(b.x, b.y); r.w = pk2(b.z, b.w); return __builtin_bit_cast(bf16x8, r);
}

struct Frame {
    LAS unsigned char* lds;
    int tid, lane, wave, G, bid;
    const __attribute__((address_space(4))) char* ka;
    float* out;
    unsigned char* ws;
};
#define WSP(T, off) ((T*)(F.ws + (off)))
__device__ __forceinline__ const float* fin_(const __attribute__((address_space(4))) char* ka, int i) {
    const __attribute__((address_space(4))) char* p = ka; asm volatile("" : "+s"(p));
    return *(const float* const __attribute__((address_space(4)))*)(p + 8 * i);
}
#define FIN(i) fin_(F.ka, (i))
namespace pg8 {
#define PG8_LAS __attribute__((address_space(3)))
typedef unsigned short bf16_t;
typedef short bf16x8 __attribute__((ext_vector_type(8)));
typedef float f32x4 __attribute__((ext_vector_type(4)));
typedef unsigned u32x4 __attribute__((ext_vector_type(4)));
constexpr int BM = 256, BK = 64, HALF = 128, HTB = HALF * BK * 2  , STAGE_BYTES = 8 * HTB, NXCD = 8, WGM = 8;

__host__ __device__ __forceinline__ int lds_byte(int r, int c) { const int st = (r >> 4) * 2 + (c >> 5), rr = r & 15, cc = c & 31, ob = rr * 64 + cc * 2; return st * 1024 + (ob ^ (((ob >> 9) & 1) << 5)); }
__host__ __device__ __forceinline__ void stage_rc(int b, int& R, int& C) { const int st = b / 1024, sb = b % 1024, swz = sb ^ (((sb >> 9) & 1) << 5); R = (st >> 1) * 16 + swz / 64; C = (st & 1) * 32 + (swz % 64) / 2; }
__host__ __device__ __forceinline__ int perm32(int rho) { const int n = rho >> 4, i = rho & 15; return 8 * (i >> 2) + 4 * n + (i & 3); }

struct Unit { int pm, pn; };
struct Gemm { const bf16_t* A; const bf16_t* Bt; int M, N, K; };

struct StaticOrder {
    int nM, nN, nwg, G, c;
    __host__ __device__ void init(int M, int N, int G_, int c_) { nM = M / BM; nN = N / BM; nwg = nM * nN; G = G_; c = c_; }
    __host__ __device__ bool next(int i, Unit& u) const {
        const long L = (long)i * G + c; if (L >= nwg) return false;
        int wgid = (int)L; { const int q = nwg / NXCD, r = nwg % NXCD, xcd = wgid % NXCD, off = wgid / NXCD; wgid = (xcd < r ? xcd * (q + 1) : r * (q + 1) + (xcd - r) * q) + off; }
        const int nig = WGM * nN, gid = wgid / nig, fm = gid * WGM, gsz = (nM - fm) < WGM ? (nM - fm) : WGM;
        u.pm = fm + ((wgid % nig) % gsz); u.pn = (wgid % nig) / gsz; return true;
    }
    __device__ __forceinline__ void a_ready(const Unit&) const {}
    __device__ __forceinline__ void done(const Unit&) const {}
};
template <class Epi, class Sched, bool ALIGN_EPI = false, bool SP2 = false>
__device__ __forceinline__ void gemm_phase(PG8_LAS unsigned char* lds, const Gemm g, const Sched& S, const Epi& E) {
    const int tid = threadIdx.x, wid = __builtin_amdgcn_readfirstlane(tid >> 6), lane = tid & 63, wr = wid >> 2, wc = wid & 3, fr = lane & 15, fq = lane >> 4;
    const int K = g.K, nt = K / BK;
    unsigned voffA[2], voffB[2];
#pragma unroll
    for (int i = 0; i < 2; ++i) { int R, C; stage_rc(tid * 16 + i * 8192, R, C); const int Rb = Epi::PERM ? ((R & ~31) + perm32(R & 31)) : R;
        voffA[i] = (unsigned)(R * K + C) * 2u; voffB[i] = (unsigned)(Rb * K + C) * 2u; }
    const size_t kstep = (size_t)(BK * 2);
    const size_t hstep = (size_t)HALF * K * 2;
    const size_t tstep = 2 * hstep;
    const unsigned ldsw = (unsigned)wid * 1024u;
    const int aoff = lds_byte(wr * 64 + fr, fq * 8), boff = lds_byte(wc * 32 + fr, fq * 8);
#define PG8_SA(b, h) (((b) * 2 + (h)) * HTB)
#define PG8_SB(b, h) ((4 + (b) * 2 + (h)) * HTB)
#define PG8_STAGE(bufoff, gbase, voff) do { _Pragma("unroll") for (int _i = 0; _i < 2; ++_i) \
        __builtin_amdgcn_global_load_lds((const unsigned*)((const char*)(gbase) + (voff)[_i]), (PG8_LAS unsigned*)(lds + (bufoff) + ldsw + _i * 8192), 16, 0, 0); } while (0)
#define PG8_LDA(dst, b, h) do { _Pragma("unroll") for (int m = 0; m < 4; ++m) _Pragma("unroll") for (int k = 0; k < 2; ++k) dst[m][k] = *(const PG8_LAS bf16x8*)(lds + PG8_SA(b, h) + aoff + m * 2048 + k * 1024); } while (0)
#define PG8_LDB(dst, b, h) do { _Pragma("unroll") for (int n = 0; n < 2; ++n) _Pragma("unroll") for (int k = 0; k < 2; ++k) dst[n][k] = *(const PG8_LAS bf16x8*)(lds + PG8_SB(b, h) + boff + n * 2048 + k * 1024); } while (0)
#define PG8_MMA(ai, bj, At, Bt) do { __builtin_amdgcn_s_setprio(1); _Pragma("unroll") for (int m = 0; m < 4; ++m) _Pragma("unroll") for (int n = 0; n < 2; ++n) _Pragma("unroll") for (int k = 0; k < 2; ++k) \
        acc[ai][bj][m][n] = __builtin_amdgcn_mfma_f32_16x16x32_bf16(Bt[n][k], At[m][k], acc[ai][bj][m][n], 0, 0, 0); __builtin_amdgcn_s_setprio(0); } while (0)
#define PG8_WAIT_V(n) asm volatile("s_waitcnt vmcnt(" #n ")" ::: "memory")
#define PG8_WAIT_L(n) asm volatile("s_waitcnt lgkmcnt(" #n ")" ::: "memory")
#define PG8_BAR __builtin_amdgcn_s_barrier()
#define PG8_SCHED __builtin_amdgcn_sched_barrier(0)
    Unit cur, nxt; int ui = 0;
    if (!S.next(0, cur)) return;
    f32x4 acc[2][2][4][2];
#pragma unroll
    for (int a = 0; a < 2; ++a)
#pragma unroll
        for (int b = 0; b < 2; ++b)
#pragma unroll
            for (int m = 0; m < 4; ++m)
#pragma unroll
                for (int n = 0; n < 2; ++n) acc[a][b][m][n] = (f32x4){0.f, 0.f, 0.f, 0.f};
    bf16x8 At[4][2], B0[2][2], B1[2][2];
    const char* cA = (const char*)g.A + (size_t)cur.pm * tstep; const char* cB = (const char*)g.Bt + (size_t)cur.pn * tstep;
    S.a_ready(cur);
    if constexpr (SP2) {
        PG8_STAGE(PG8_SB(0, 0), cB, voffB); PG8_STAGE(PG8_SB(0, 1), cB + hstep, voffB); PG8_STAGE(PG8_SA(0, 0), cA, voffA); PG8_STAGE(PG8_SA(0, 1), cA + hstep, voffA);
        if (wr == 1) PG8_BAR;
        PG8_WAIT_V(2); PG8_BAR;
        PG8_STAGE(PG8_SB(1, 0), cB + kstep, voffB); PG8_STAGE(PG8_SA(1, 0), cA + kstep, voffA); PG8_STAGE(PG8_SB(1, 1), cB + hstep + kstep, voffB);
        PG8_WAIT_V(6); PG8_BAR;
    } else {
        PG8_STAGE(PG8_SB(0, 0), cB, voffB); PG8_STAGE(PG8_SA(0, 0), cA, voffA); PG8_STAGE(PG8_SB(0, 1), cB + hstep, voffB); PG8_STAGE(PG8_SA(0, 1), cA + hstep, voffA);
        if (wr == 1) PG8_BAR;
        PG8_WAIT_V(4); PG8_BAR;
        PG8_STAGE(PG8_SB(1, 0), cB + kstep, voffB); PG8_STAGE(PG8_SA(1, 0), cA + kstep, voffA); PG8_STAGE(PG8_SB(1, 1), cB + hstep + kstep, voffB);
        PG8_WAIT_V(6); PG8_BAR;
    }
    for (;;) {
        const bool has_next = S.next(ui + 1, nxt);
        const char* nA = has_next ? (const char*)g.A + (size_t)nxt.pm * tstep : cA; const char* nB = has_next ? (const char*)g.Bt + (size_t)nxt.pn * tstep : cB;
        for (int t = 0; t < nt; t += 2) {
            const bool last = (t == nt - 2);
            const char* a1 = cA + (size_t)(t + 1) * kstep;
            const char* a2 = last ? nA : cA + (size_t)(t + 2) * kstep; const char* b2 = last ? nB : cB + (size_t)(t + 2) * kstep;
            const char* a3 = a2 + kstep; const char* b3 = b2 + kstep;
            if (last && has_next) S.a_ready(nxt);
            if constexpr (SP2) {
            PG8_LDB(B0, 0, 0); PG8_LDB(B1, 0, 1); PG8_SCHED; PG8_LDA(At, 0, 0); PG8_STAGE(PG8_SA(1, 1), a1 + hstep, voffA);
            PG8_WAIT_V(8); PG8_WAIT_L(0); PG8_BAR; PG8_MMA(0, 0, At, B0); PG8_MMA(0, 1, At, B1); PG8_BAR; PG8_SCHED;
            PG8_LDA(At, 0, 1); PG8_STAGE(PG8_SB(0, 0), b2, voffB); PG8_STAGE(PG8_SB(0, 1), b2 + hstep, voffB); PG8_STAGE(PG8_SA(0, 0), a2, voffA);
            PG8_WAIT_V(8); PG8_WAIT_L(0); PG8_BAR; PG8_MMA(1, 0, At, B0); PG8_MMA(1, 1, At, B1); PG8_BAR; PG8_SCHED;
            PG8_LDB(B0, 1, 0); PG8_LDB(B1, 1, 1); PG8_SCHED; PG8_LDA(At, 1, 0); PG8_STAGE(PG8_SA(0, 1), a2 + hstep, voffA);
            PG8_WAIT_V(8); PG8_WAIT_L(0); PG8_BAR; PG8_MMA(0, 0, At, B0); PG8_MMA(0, 1, At, B1); PG8_BAR; PG8_SCHED;
            PG8_LDA(At, 1, 1); PG8_STAGE(PG8_SB(1, 0), b3, voffB); PG8_STAGE(PG8_SB(1, 1), b3 + hstep, voffB); PG8_STAGE(PG8_SA(1, 0), a3, voffA);
            PG8_WAIT_V(8); PG8_WAIT_L(0); PG8_BAR; PG8_MMA(1, 0, At, B0); PG8_MMA(1, 1, At, B1); PG8_BAR; PG8_SCHED;
            } else {
            PG8_LDB(B0, 0, 0); PG8_SCHED; PG8_LDA(At, 0, 0); PG8_STAGE(PG8_SA(1, 1), a1 + hstep, voffA);
            PG8_WAIT_L(8); PG8_BAR; PG8_WAIT_L(0); PG8_MMA(0, 0, At, B0); PG8_BAR; PG8_SCHED;
            PG8_LDB(B1, 0, 1); PG8_STAGE(PG8_SB(0, 0), b2, voffB);
            PG8_BAR; PG8_WAIT_L(0); PG8_MMA(0, 1, At, B1); PG8_BAR;
            PG8_LDA(At, 0, 1); PG8_STAGE(PG8_SA(0, 0), a2, voffA);
            PG8_BAR; PG8_WAIT_L(0); PG8_MMA(1, 0, At, B0); PG8_BAR; PG8_SCHED;
            PG8_STAGE(PG8_SB(0, 1), b2 + hstep, voffB);
            PG8_WAIT_V(6); PG8_BAR; PG8_MMA(1, 1, At, B1); PG8_BAR;
            PG8_LDB(B0, 1, 0); PG8_SCHED; PG8_LDA(At, 1, 0); PG8_STAGE(PG8_SA(0, 1), a2 + hstep, voffA);
            PG8_WAIT_L(8); PG8_BAR; PG8_WAIT_L(0); PG8_MMA(0, 0, At, B0); PG8_BAR; PG8_SCHED;
            PG8_LDB(B1, 1, 1); PG8_STAGE(PG8_SB(1, 0), b3, voffB);
            PG8_BAR; PG8_WAIT_L(0); PG8_MMA(0, 1, At, B1); PG8_BAR;
            PG8_LDA(At, 1, 1); PG8_STAGE(PG8_SA(1, 0), a3, voffA);
            PG8_BAR; PG8_WAIT_L(0); PG8_MMA(1, 0, At, B0); PG8_BAR; PG8_SCHED;
            PG8_STAGE(PG8_SB(1, 1), b3 + hstep, voffB);
            PG8_WAIT_V(6); PG8_BAR; PG8_MMA(1, 1, At, B1); PG8_BAR;
            }
        }
        if constexpr (ALIGN_EPI) { if (wr == 0) PG8_BAR; }
        if constexpr (!Epi::AFTER_DRAIN) { E(acc, cur, wr, wc, fr, fq); S.done(cur); }
        if (!has_next) break;
#pragma unroll
        for (int a = 0; a < 2; ++a)
#pragma unroll
            for (int b = 0; b < 2; ++b)
#pragma unroll
                for (int m = 0; m < 4; ++m)
#pragma unroll
                    for (int n = 0; n < 2; ++n) acc[a][b][m][n] = (f32x4){0.f, 0.f, 0.f, 0.f};
        cur = nxt; cA = nA; cB = nB; ++ui;
        if constexpr (ALIGN_EPI) { if (wr == 1) PG8_BAR; }
    }
    PG8_WAIT_V(0);
    if constexpr (!ALIGN_EPI) { if (wr == 0) PG8_BAR; }
    PG8_BAR;
    if constexpr (Epi::AFTER_DRAIN) { E.fused(acc, cur, wr, wc, fr, fq, lds, wid, lane); S.done(cur); }
#undef PG8_SA
#undef PG8_SB
#undef PG8_STAGE
#undef PG8_LDA
#undef PG8_LDB
#undef PG8_MMA
#undef PG8_WAIT_V
#undef PG8_WAIT_L
#undef PG8_BAR
#undef PG8_SCHED
}
}
#define XB_TMO      128
#define XB_XCNT(j)  (256  + 64 * (j))
#define XB_XSUB(j)  (1280 + 64 * (j))
#define XB_XGEN(j)  (2304 + 64 * (j))
#define XB_TOP      3328
#define XB_TOPGEN   3392
#define XCD_BAR_WORDS 3456
#define XB_SPIN_CAP (1u << 18)

__device__ __forceinline__ unsigned xb_ld(unsigned* p)              { return __hip_atomic_load(p, __ATOMIC_RELAXED, __HIP_MEMORY_SCOPE_AGENT); }
__device__ __forceinline__ unsigned xb_add(unsigned* p, unsigned v) { return __hip_atomic_fetch_add(p, v, __ATOMIC_RELAXED, __HIP_MEMORY_SCOPE_AGENT); }
__device__ __forceinline__ unsigned xb_xcc_id() { return (unsigned)__builtin_amdgcn_s_getreg((3 << 11) | 20) & 0xFu; }
#define XB_SPIN(cond, bar) do { unsigned _sp = 0; while (cond) { __builtin_amdgcn_s_sleep(1); \
    if ((++_sp & 255u) == 0u) { if (xb_ld(&(bar)[XB_TMO])) break; if (_sp > XB_SPIN_CAP) { atomicAdd(&(bar)[XB_TMO], 1u); break; } } } } while (0)

struct XcdBarrier {
    unsigned* bar; unsigned x;
    volatile LAS unsigned* st;
};

__device__ __forceinline__ XcdBarrier xcd_barrier_post(unsigned* bar, volatile LAS unsigned* st) {
    XcdBarrier b; b.bar = bar; b.x = xb_xcc_id(); b.st = st;
    if (threadIdx.x == 0) { st[2] = xb_add(&bar[XB_XCNT(b.x)], 1u); st[3] = 1u; }
    return b;
}
__device__ __forceinline__ void xcd_barrier_complete(unsigned* bar, unsigned x, unsigned& nloc, unsigned& nx) {
    const unsigned G = gridDim.x * gridDim.y * gridDim.z;
    unsigned sum, cnt, mine, sp = 0u;
    for (;;) {
        sum = 0u; cnt = 0u; mine = 0u;
#pragma unroll
        for (unsigned j = 0; j < 16; ++j) { const unsigned c = xb_ld(&bar[XB_XCNT(j)]); sum += c; cnt += (c > 0u) ? 1u : 0u; mine = (j == x) ? c : mine; }
        if (sum == G) break;
        __builtin_amdgcn_s_sleep(1);
        if ((++sp & 255u) == 0u) { if (xb_ld(&bar[XB_TMO])) break; if (sp > XB_SPIN_CAP) { atomicAdd(&bar[XB_TMO], 1u); break; } }
    }
    nloc = mine > 0u ? mine : 1u; nx = cnt > 0u ? cnt : 1u;
}

__device__ __forceinline__ void xcd_barrier(const XcdBarrier& b) {
    asm volatile("s_waitcnt vmcnt(0)" ::: "memory");
    __syncthreads();
    if (threadIdx.x == 0) {
        unsigned* bar = b.bar;
        __builtin_amdgcn_s_waitcnt(0);
        unsigned nloc = b.st[0], nx = b.st[1];
        if (nloc == 0u) { xcd_barrier_complete(bar, b.x, nloc, nx); b.st[0] = nloc; b.st[1] = nx; }
        const unsigned old = xb_add(&bar[XB_XSUB(b.x)], 1u);
        const unsigned gen = old / nloc;
        if (old + 1u == (gen + 1u) * nloc) {
            __builtin_amdgcn_fence(__ATOMIC_RELEASE, "agent");
            asm volatile("s_waitcnt vmcnt(0)" ::: "memory");
            const unsigned og = xb_add(&bar[XB_TOP], 1u);
            const unsigned tg = og / nx;
            if (og + 1u == (tg + 1u) * nx) xb_add(&bar[XB_TOPGEN], 1u);
            else XB_SPIN(xb_ld(&bar[XB_TOPGEN]) == tg, bar);
            __builtin_amdgcn_fence(__ATOMIC_ACQUIRE, "agent");
            xb_add(&bar[XB_XGEN(b.x)], 1u);
            asm volatile("s_waitcnt vmcnt(0)" ::: "memory");
        } else {
            XB_SPIN(xb_ld(&bar[XB_XGEN(b.x)]) == gen, bar);
            __builtin_amdgcn_fence(__ATOMIC_ACQUIRE, "agent");
            asm volatile("s_waitcnt vmcnt(0)" ::: "memory");
        }
    }
    __syncthreads();
}

namespace pg8 {
template <class Fn> struct EpiFn {
    static constexpr bool PERM = true, AFTER_DRAIN = false;
    Fn f;
    __device__ __forceinline__ void operator()(const f32x4 (&acc)[2][2][4][2], const Unit& u, int wr, int wc, int fr, int fq) const {
        const int row0 = u.pm * BM + wr * 64 + fr, col0 = u.pn * BM + wc * 32 + 8 * fq;
#pragma unroll
        for (int ai = 0; ai < 2; ++ai)
#pragma unroll
            for (int m = 0; m < 4; ++m)
#pragma unroll
                for (int bj = 0; bj < 2; ++bj) f.e8(row0 + ai * HALF + m * 16, col0 + bj * HALF, acc[ai][bj][m][0], acc[ai][bj][m][1]);
    }
};
}

struct FnBf16 {
    bf16* O; int ld;
    __device__ __forceinline__ void e8(int row, int col, f32x4 a, f32x4 b) const {
        v4u w; w.x = pk2(a.x, a.y); w.y = pk2(a.z, a.w); w.z = pk2(b.x, b.y); w.w = pk2(b.z, b.w);
        *(v4u*)(O + (size_t)row * ld + col) = w;
    }
    __device__ __forceinline__ void e4(int row, int col, f32x4 a) const {
        v2u w; w.x = pk2(a.x, a.y); w.y = pk2(a.z, a.w);
        *(v2u*)(O + (size_t)row * ld + col) = w;
    }
};
struct FnResid {
    float* XS; const float* baseP; const float* baseS;
    __device__ __forceinline__ const float* brow(int row) const { return row < MP ? baseP + (size_t)row * DM : baseS + (size_t)(row - MP) * DM; }
    __device__ __forceinline__ void e8(int row, int col, f32x4 a, f32x4 b) const {
        const float* br = brow(row) + col; float* o = XS + (size_t)row * DM + col;
        const f32x4 x0 = *(const f32x4*)br, x1 = *(const f32x4*)(br + 4);
        *(f32x4*)o = x0 + a; *(f32x4*)(o + 4) = x1 + b;
    }
    __device__ __forceinline__ void e4(int row, int col, f32x4 a) const {
        const float* br = brow(row) + col; float* o = XS + (size_t)row * DM + col;
        *(f32x4*)o = *(const f32x4*)br + a;
    }
};
struct FnF32 {
    float* O; int ld;
    __device__ __forceinline__ void e8(int row, int col, f32x4 a, f32x4 b) const { float* o = O + (size_t)row * ld + col; *(f32x4*)o = a; *(f32x4*)(o + 4) = b; }
    __device__ __forceinline__ void e4(int row, int col, f32x4 a) const { *(f32x4*)(O + (size_t)row * ld + col) = a; }
};
struct FnKvq {
    bf16* O; const float* ssq;
    __device__ __forceinline__ float rstd(int row) const { const f32x4 s0 = *(const f32x4*)(ssq + (size_t)row * 8), s1 = *(const f32x4*)(ssq + (size_t)row * 8 + 4);
        return frsq((((s0.x + s0.y) + (s0.z + s0.w)) + ((s1.x + s1.y) + (s1.z + s1.w))) * (1.f / DM) + EPS); }
    __device__ __forceinline__ void e8(int row, int col, f32x4 a, f32x4 b) const {
        if (col < NKVQ_REAL) { const float rs = rstd(row); a = a * rs; b = b * rs; *(v4u*)(O + (size_t)row * NKVQ + col) = (v4u){pk2(a.x, a.y), pk2(a.z, a.w), pk2(b.x, b.y), pk2(b.z, b.w)}; }
    }
    __device__ __forceinline__ void e4(int row, int col, f32x4 a) const {
        if (col < NKVQ_REAL) { a = a * rstd(row); *(v2u*)(O + (size_t)row * NKVQ + col) = (v2u){pk2(a.x, a.y), pk2(a.z, a.w)}; }
    }
};

template <class Fn>
__device__ __forceinline__ void skinny_gemm(Frame& F, const bf16* A, const bf16* Bt, int N, int row_base, const Fn& fn) {
    const int fr = F.lane & 15, fq = F.lane >> 4;
    const int nun = N / 16;
    for (int u = F.bid; u < nun; u += F.G) {
        const bf16* ap = Bt + (size_t)(u * 16 + fr) * DM + fq * 8;
        const bf16* bp = A + (size_t)(F.wave * 16 + fr) * DM + fq * 8;
        f32x4 acc = {0.f, 0.f, 0.f, 0.f};
#pragma unroll 8
        for (int ks = 0; ks < 32; ++ks) acc = MFMA16(ld8(ap + ks * 32), ld8(bp + ks * 32), acc);
        fn.e4(row_base + F.wave * 16 + fr, u * 16 + 4 * fq, acc);
    }
}

template <class Fn>
__device__ __forceinline__ void gemm_all(Frame& F, const bf16* A, const bf16* Bt, int N, const Fn& fn) {
    pg8::Gemm g{A, Bt, MP, N, DM}; pg8::StaticOrder S; S.init(MP, N, F.G, F.bid);
    pg8::EpiFn<Fn> E{fn};
    pg8::gemm_phase<pg8::EpiFn<Fn>, pg8::StaticOrder, true, true>(F.lds, g, S, E);
    skinny_gemm(F, A + (size_t)MP * DM, Bt, N, MP, fn);
}

__device__ __forceinline__ void p0_transpose_item(const float* W, int N, bf16* WT, int row_off, const float* gain, LAS float* scr, int item, int lane) {
    const int nblk = (N + 31) / 32, kb = item / nblk, nb = item % nblk, k0 = 64 * kb, n0 = 32 * nb;
    { const int n = n0 + (lane & 31); const bool inb = n < N; const float* wp = W + (size_t)(k0 + (lane >> 5)) * N + (inb ? n : N - 1);
      float v[32];
#pragma unroll
      for (int i = 0; i < 32; ++i) v[i] = wp[(size_t)(2 * i) * N];
      if (gain) { const float* gp = gain + k0 + (lane >> 5);
#pragma unroll
          for (int i = 0; i < 32; ++i) v[i] *= gp[2 * i]; }
#pragma unroll
      for (int i = 0; i < 32; ++i) scr[(2 * i + (lane >> 5)) * 33 + (lane & 31)] = inb ? v[i] : 0.f; }
    LDS_WAIT(); asm volatile("" ::: "memory");
    const int c = lane & 7;
#pragma unroll
    for (int j = 0; j < 4; ++j) { const int n = (lane >> 3) + 8 * j; const LAS float* s = scr + (8 * c) * 33 + n;
        v4u o; o.x = pk2(s[0 * 33], s[1 * 33]); o.y = pk2(s[2 * 33], s[3 * 33]); o.z = pk2(s[4 * 33], s[5 * 33]); o.w = pk2(s[6 * 33], s[7 * 33]);
        if (n0 + n < N) *(v4u*)(WT + (size_t)(row_off + n0 + n) * DM + k0 + 8 * c) = o; }
    LDS_WAIT(); asm volatile("" ::: "memory");
}
__device__ __forceinline__ void rms_row_to_bf16(const float* xrow, bf16* orow, int lane) {
    const f32x4* xr = (const f32x4*)xrow + lane;
    f32x4 v[4]; float s = 0.f;
#pragma unroll
    for (int j = 0; j < 4; ++j) { v[j] = xr[64 * j]; s += (v[j].x * v[j].x + v[j].y * v[j].y) + (v[j].z * v[j].z + v[j].w * v[j].w); }
    const float rstd = frsq(wave_sum(s) * (1.f / DM) + EPS);
    v2u* o8 = (v2u*)orow + lane;
#pragma unroll
    for (int j = 0; j < 4; ++j) { v2u w; w.x = pk2(v[j].x * rstd, v[j].y * rstd); w.y = pk2(v[j].z * rstd, v[j].w * rstd); o8[64 * j] = w; }
}
__device__ __forceinline__ void rms_fin_bf16(const f32x4 v0, const f32x4 v1, const f32x4 v2, const f32x4 v3, bf16* orow, int lane) {
    const f32x4 v[4] = {v0, v1, v2, v3}; float s = 0.f;
#pragma unroll
    for (int j = 0; j < 4; ++j) s += (v[j].x * v[j].x + v[j].y * v[j].y) + (v[j].z * v[j].z + v[j].w * v[j].w);
    const float rstd = frsq(wave_sum(s) * (1.f / DM) + EPS);
    v2u* o8 = (v2u*)orow + lane;
#pragma unroll
    for (int j = 0; j < 4; ++j) { v2u w; w.x = pk2(v[j].x * rstd, v[j].y * rstd); w.y = pk2(v[j].z * rstd, v[j].w * rstd); o8[64 * j] = w; }
}
__device__ __forceinline__ void rms_row_to_bf16_i8(const float* xrow, bf16* orow, unsigned* o8row, float* hs, int lane) {
    const f32x4* xr = (const f32x4*)xrow + lane;
    f32x4 v[4]; float s = 0.f, mx = 0.f;
#pragma unroll
    for (int j = 0; j < 4; ++j) { v[j] = xr[64 * j]; s += (v[j].x * v[j].x + v[j].y * v[j].y) + (v[j].z * v[j].z + v[j].w * v[j].w);
        mx = fmaxf(mx, fmaxf(fmaxf(fabsf(v[j].x), fabsf(v[j].y)), fmaxf(fabsf(v[j].z), fabsf(v[j].w)))); }
    const float rstd = frsq(wave_sum(s) * (1.f / DM) + EPS);
    mx = fmaxf(mx, dpp_f<DPP_XOR1>(mx)); mx = fmaxf(mx, dpp_f<DPP_XOR2>(mx)); mx = fmaxf(mx, dpp_f<DPP_HMIR>(mx)); mx = fmaxf(mx, dpp_f<DPP_MIR>(mx)); mx = x32_max(x16_max(mx));
    const float hmax = fmaxf(mx * rstd, 1e-20f), qs = 127.f * frcp(hmax);
    if (lane == 0) *hs = hmax * (1.f / 127.f);
    v2u* o16 = (v2u*)orow + lane;
#pragma unroll
    for (int j = 0; j < 4; ++j) { const f32x4 y = v[j] * rstd; v2u w; w.x = pk2(y.x, y.y); w.y = pk2(y.z, y.w); o16[64 * j] = w; o8row[lane + 64 * j] = pk_i8(y * qs); }
}
__device__ __forceinline__ void rms_fin_bf16_i8(const f32x4 v0, const f32x4 v1, const f32x4 v2, const f32x4 v3, bf16* orow, unsigned* o8row, float* hs, int lane) {
    const f32x4 v[4] = {v0, v1, v2, v3}; float s = 0.f, mx = 0.f;
#pragma unroll
    for (int j = 0; j < 4; ++j) { s += (v[j].x * v[j].x + v[j].y * v[j].y) + (v[j].z * v[j].z + v[j].w * v[j].w);
        mx = fmaxf(mx, fmaxf(fmaxf(fabsf(v[j].x), fabsf(v[j].y)), fmaxf(fabsf(v[j].z), fabsf(v[j].w)))); }
    const float rstd = frsq(wave_sum(s) * (1.f / DM) + EPS);
    mx = fmaxf(mx, dpp_f<DPP_XOR1>(mx)); mx = fmaxf(mx, dpp_f<DPP_XOR2>(mx)); mx = fmaxf(mx, dpp_f<DPP_HMIR>(mx)); mx = fmaxf(mx, dpp_f<DPP_MIR>(mx)); mx = x32_max(x16_max(mx));
    const float hmax = fmaxf(mx * rstd, 1e-20f), qs = 127.f * frcp(hmax);
    if (lane == 0) *hs = hmax * (1.f / 127.f);
    v2u* o16 = (v2u*)orow + lane;
#pragma unroll
    for (int j = 0; j < 4; ++j) { const f32x4 y = v[j] * rstd; v2u w; w.x = pk2(y.x, y.y); w.y = pk2(y.z, y.w); o16[64 * j] = w; o8row[lane + 64 * j] = pk_i8(y * qs); }
}
__device__ __forceinline__ void rms_rows_phase(Frame& F, int gw, int ngw) {
    int r = gw;
    for (; r + 3 * ngw < MTOK; r += 4 * ngw) {
        const f32x4* xa = (const f32x4*)(WSP(float, WS_XS) + (size_t)r * DM) + F.lane; const f32x4* xb = xa + (size_t)ngw * (DM / 4); const f32x4* xc = xb + (size_t)ngw * (DM / 4); const f32x4* xd = xc + (size_t)ngw * (DM / 4);
        const f32x4 a0 = xa[0], a1 = xa[64], a2 = xa[128], a3 = xa[192], b0 = xb[0], b1 = xb[64], b2 = xb[128], b3 = xb[192];
        const f32x4 c0 = xc[0], c1 = xc[64], c2 = xc[128], c3 = xc[192], d0 = xd[0], d1 = xd[64], d2 = xd[128], d3 = xd[192];
        rms_fin_bf16_i8(a0, a1, a2, a3, WSP(bf16, WS_XNB) + (size_t)r * DM, WSP(unsigned, WS_XN8) + (size_t)r * (DM / 4), WSP(float, WS_HS) + r, F.lane);
        rms_fin_bf16_i8(b0, b1, b2, b3, WSP(bf16, WS_XNB) + (size_t)(r + ngw) * DM, WSP(unsigned, WS_XN8) + (size_t)(r + ngw) * (DM / 4), WSP(float, WS_HS) + r + ngw, F.lane);
        rms_fin_bf16_i8(c0, c1, c2, c3, WSP(bf16, WS_XNB) + (size_t)(r + 2 * ngw) * DM, WSP(unsigned, WS_XN8) + (size_t)(r + 2 * ngw) * (DM / 4), WSP(float, WS_HS) + r + 2 * ngw, F.lane);
        rms_fin_bf16_i8(d0, d1, d2, d3, WSP(bf16, WS_XNB) + (size_t)(r + 3 * ngw) * DM, WSP(unsigned, WS_XN8) + (size_t)(r + 3 * ngw) * (DM / 4), WSP(float, WS_HS) + r + 3 * ngw, F.lane);
    }
    for (; r + ngw < MTOK; r += 2 * ngw) {
        const f32x4* xa = (const f32x4*)(WSP(float, WS_XS) + (size_t)r * DM) + F.lane; const f32x4* xb = (const f32x4*)(WSP(float, WS_XS) + (size_t)(r + ngw) * DM) + F.lane;
        const f32x4 a0 = xa[0], a1 = xa[64], a2 = xa[128], a3 = xa[192], b0 = xb[0], b1 = xb[64], b2 = xb[128], b3 = xb[192];
        rms_fin_bf16_i8(a0, a1, a2, a3, WSP(bf16, WS_XNB) + (size_t)r * DM, WSP(unsigned, WS_XN8) + (size_t)r * (DM / 4), WSP(float, WS_HS) + r, F.lane);
        rms_fin_bf16_i8(b0, b1, b2, b3, WSP(bf16, WS_XNB) + (size_t)(r + ngw) * DM, WSP(unsigned, WS_XN8) + (size_t)(r + ngw) * (DM / 4), WSP(float, WS_HS) + r + ngw, F.lane);
    }
    if (r < MTOK) rms_row_to_bf16_i8(WSP(float, WS_XS) + (size_t)r * DM, WSP(bf16, WS_XNB) + (size_t)r * DM, WSP(unsigned, WS_XN8) + (size_t)r * (DM / 4), WSP(float, WS_HS) + r, F.lane);
}
__device__ __forceinline__ const float* xin_row(Frame& F, int row) { return row < MP ? FIN(0) + (size_t)row * DM : FIN(1) + (size_t)(row - MP) * DM; }

__device__ __forceinline__ void peer_tables_to_fp8(Frame& F, size_t thr, size_t nthr, size_t lo = 0, size_t hi = (size_t)2 * NEXP * DM / 8) {
    const size_t gt = thr, NGT = nthr;
        for (int t = 0; t < 2; ++t) { const f32x4* src = (const f32x4*)FIN(27 + t); v2u* dst = (v2u*)WSP(unsigned char, t == 0 ? WS_PU : WS_PV); const float* pln = FIN(24);
            for (size_t i0 = lo + gt; i0 < hi; i0 += (size_t)4 * NGT) {
                f32x4 a[4], b[4];
#pragma unroll
                for (int u = 0; u < 4; ++u) { const size_t i = i0 + (size_t)u * NGT; if (i < hi) { a[u] = src[2 * i]; b[u] = src[2 * i + 1]; } }
#pragma unroll
                for (int u = 0; u < 4; ++u) { const size_t i = i0 + (size_t)u * NGT; if (i < hi) {
                    if (t == 0) { const float* gp = pln + ((i >> 21) << 10) + ((i & 127) << 3); a[u] = a[u] * *(const f32x4*)gp * 32.f; b[u] = b[u] * *(const f32x4*)(gp + 4) * 32.f; }
                    else { a[u] = a[u] * 16.f; b[u] = b[u] * 16.f; }
                    int w0, w1;
                    if (t == 0) { w0 = (int)pk_i8(a[u] * 19.f); w1 = (int)pk_i8(b[u] * 19.f); }
                    else { w0 = __builtin_amdgcn_cvt_pk_fp8_f32(a[u].x, a[u].y, 0, false); w0 = __builtin_amdgcn_cvt_pk_fp8_f32(a[u].z, a[u].w, w0, true);
                           w1 = __builtin_amdgcn_cvt_pk_fp8_f32(b[u].x, b[u].y, 0, false); w1 = __builtin_amdgcn_cvt_pk_fp8_f32(b[u].z, b[u].w, w1, true); }
                    dst[((((i >> 21) * 8 + ((i & 127) >> 4)) * (size_t)NEXP + ((i >> 7) & (NEXP - 1))) << 4) + (i & 15)] = (v2u){(unsigned)w0, (unsigned)w1}; } } } }
}

constexpr int FD_BUF = 16384;
__device__ __forceinline__ void fs_direct_task(Frame& F, int task) {
    int lane_ = F.lane; asm volatile("" : "+v"(lane_));
    const int lane = lane_, w = F.wave, fr = lane & 15, fq = lane >> 4, kv = w >> 2, g = w & 3, bs = task >> 4, c0 = (task & 15) * 32;
    LAS unsigned char* L = F.lds; asm volatile("" : "+v"(L));
    const float* cache = FIN(2); const int* pt = (const int*)FIN(6) + bs * NPAGES;
    const float* base[2];
#pragma unroll
    for (int nt = 0; nt < 2; ++nt) { const int t0 = 16 * (c0 + 16 * nt + fr); base[nt] = cache + ((size_t)pt[t0 >> 7] * PAGE + (t0 & 127)) * 1024 + kv * 256 + g * 64 + 8 * fq; }
    const bf16* wsrc[2]; int wdst[2];
#pragma unroll
    for (int q = 0; q < 2; ++q) { const int item = F.tid + 512 * q, kvw = item >> 9, n = (item >> 2) & 127, kq = item & 3;
        wsrc[q] = WSP(bf16, WS_W1BD) + (size_t)(kvw * 128 + n) * 2048 + kvw * 1024 + 8 * kq; wdst[q] = ((kvw * 8 + (n >> 4)) * 64 + kq * 16 + (n & 15)) * 16; }
    f32x4 acc[2][8];
#pragma unroll
    for (int nt = 0; nt < 2; ++nt)
#pragma unroll
        for (int mt = 0; mt < 8; ++mt) acc[nt][mt] = (f32x4){0.f, 0.f, 0.f, 0.f};
    f32x4 S0[2][4], S1[2][4]; v4u wr[2];
#define FD_DATA(S, r) do { const int r_ = (r) < 16 ? (r) : 15; _Pragma("unroll") for (int nt_ = 0; nt_ < 2; ++nt_) { const float* p_ = base[nt_] + r_ * 1024; \
        S[nt_][0] = *(const f32x4*)p_; S[nt_][1] = *(const f32x4*)(p_ + 4); S[nt_][2] = *(const f32x4*)(p_ + 32); S[nt_][3] = *(const f32x4*)(p_ + 36); } } while (0)
#define FD_WLOAD(ks) do { const int ks_ = (ks) < 32 ? (ks) : 31; wr[0] = *(const v4u*)(wsrc[0] + 32 * ks_); wr[1] = *(const v4u*)(wsrc[1] + 32 * ks_); } while (0)
#define FD_WSTORE(buf) do { *(LAS v4u*)(L + (buf) * FD_BUF + wdst[0]) = wr[0]; *(LAS v4u*)(L + (buf) * FD_BUF + wdst[1]) = wr[1]; } while (0)
#define FD_KSTEP(bq, ks, buf) do { \
        _Pragma("unroll") for (int mt_ = 0; mt_ < 8; ++mt_) { const bf16x8 a_ = *(const LAS bf16x8*)(L + (buf) * FD_BUF + ((kv * 8 + mt_) * 64 + lane) * 16); \
            acc[0][mt_] = MFMA16(a_, bq[0], acc[0][mt_]); acc[1][mt_] = MFMA16(a_, bq[1], acc[1][mt_]); } \
        FD_WSTORE((buf) ^ 1); FD_WLOAD((ks) + 2); \
        __syncthreads(); } while (0)
#define FD_ROW(S, r) do { bf16x8 b0_[2], b1_[2]; _Pragma("unroll") for (int nt_ = 0; nt_ < 2; ++nt_) { b0_[nt_] = cvt8(S[nt_][0], S[nt_][1]); b1_[nt_] = cvt8(S[nt_][2], S[nt_][3]); } \
        FD_DATA(S, (r) + 2); \
        FD_KSTEP(b0_, 2 * (r), 0); FD_KSTEP(b1_, 2 * (r) + 1, 1); } while (0)
    FD_WLOAD(0); FD_WSTORE(0); FD_WLOAD(1); FD_DATA(S0, 0); FD_DATA(S1, 1);
    __syncthreads();
#pragma unroll 1
    for (int r = 0; r < 16; r += 2) { FD_ROW(S0, r); FD_ROW(S1, r + 1); }
#undef FD_KSTEP
#undef FD_ROW
#undef FD_DATA
#undef FD_WLOAD
#undef FD_WSTORE
    bf16* fs = WSP(bf16, WS_FS) + ((size_t)(bs * 4 + g) * 512 + c0 + fr) * 256 + kv * 128 + 4 * fq;
#pragma unroll
    for (int nt = 0; nt < 2; ++nt)
#pragma unroll
        for (int mt = 0; mt < 8; ++mt) *(v2u*)(fs + (size_t)nt * 16 * 256 + 16 * mt) = (v2u){pk2(acc[nt][mt][0], acc[nt][mt][1]), pk2(acc[nt][mt][2], acc[nt][mt][3])};
    __syncthreads();
}

__device__ __forceinline__ void p0_prologue(Frame& F) {
    LAS float* scr = (LAS float*)(F.lds + F.wave * 16384);
    const int gw = F.bid * 8 + F.wave, NGW = F.G * 8;
    const int gt = F.bid * 512 + F.tid, NGT = F.G * 512;
    {
        constexpr int I_IN = 128 * 16, I_OA = 32 * 16, I_KV = 48 * 16, I_QG = 34 * 16, I_OB = 32 * 16, I_PQ = 64 * 16;
        constexpr int NITEMS = I_IN + I_OA + I_KV + I_QG + I_OB + 2 * I_PQ;
        for (int it = gw; it < NITEMS; it += NGW) {
            int r = it;
            if (r < I_IN) {
                const int kb = r / 128, nb = r % 128, k0 = 64 * kb, n0 = 32 * nb; const float* W = FIN(8); const float* gain = FIN(7);
                { const float* wp = W + (size_t)(k0 + (F.lane >> 5)) * GPROJ + n0 + (F.lane & 31); const float* gp = gain + k0 + (F.lane >> 5); float v[32];
#pragma unroll
                  for (int i = 0; i < 32; ++i) v[i] = wp[(size_t)(2 * i) * GPROJ];
#pragma unroll
                  for (int i = 0; i < 32; ++i) v[i] *= gp[2 * i];
#pragma unroll
                  for (int i = 0; i < 32; ++i) scr[(2 * i + (F.lane >> 5)) * 33 + (F.lane & 31)] = v[i]; }
                LDS_WAIT(); asm volatile("" ::: "memory");
                const int c = F.lane & 7;
#pragma unroll
                for (int j = 0; j < 4; ++j) { const int n = (F.lane >> 3) + 8 * j; const LAS float* s = scr + (8 * c) * 33 + n;
                    v4u o; o.x = pk2(s[0 * 33], s[1 * 33]); o.y = pk2(s[2 * 33], s[3 * 33]); o.z = pk2(s[4 * 33], s[5 * 33]); o.w = pk2(s[6 * 33], s[7 * 33]);
                    *(v4u*)(WSP(bf16, WS_WIN_T) + (size_t)(n0 + n) * DM + k0 + 8 * c) = o; }
                LDS_WAIT(); asm volatile("" ::: "memory");
                continue; }
            r -= I_IN;
            if (r < I_OA) { p0_transpose_item(FIN(13), 1024, WSP(bf16, WS_WOA_T), 0, nullptr, scr, r, F.lane); continue; } r -= I_OA;
            if (r < I_KV) { p0_transpose_item(FIN(15), NKV, WSP(bf16, WS_WKVQ_T), 0, FIN(14), scr, r, F.lane); continue; } r -= I_KV;
            if (r < I_QG) { p0_transpose_item(FIN(21), NQG, WSP(bf16, WS_WKVQ_T), NKV, FIN(20), scr, r, F.lane); continue; } r -= I_QG;
            if (r < I_OB) { p0_transpose_item(FIN(23), 1024, WSP(bf16, WS_WOB_T), 0, nullptr, scr, r, F.lane); continue; } r -= I_OB;
            if (r < I_PQ) { p0_transpose_item(FIN(25), 2048, WSP(bf16, WS_WPQ_T), 0, FIN(24), scr, r, F.lane); continue; } r -= I_PQ;
            p0_transpose_item(FIN(25) + (size_t)1024 * 2048, 2048, WSP(bf16, WS_WPQ_T) + (size_t)2048 * 1024, 0, FIN(24) + 1024, scr, r, F.lane);
        }
        for (int i = gt; i < (NKVQ - NKVQ_REAL) * DM / 8; i += NGT) ((v4u*)(WSP(bf16, WS_WKVQ_T) + (size_t)NKVQ_REAL * DM))[i] = (v4u){0u, 0u, 0u, 0u};
        for (int i = gt; i < 16 * 1024; i += NGT) { const int j = i >> 10, k = i & 1023; WSP(float, WS_WAB)[i] = FIN(7)[k] * FIN(8)[(size_t)k * GPROJ + 4096 + j]; }
    }
    { int m = gw;
      for (; m + 3 * NGW < MTOK; m += 4 * NGW) {
          const f32x4* xa = (const f32x4*)xin_row(F, m) + F.lane; const f32x4* xb = (const f32x4*)xin_row(F, m + NGW) + F.lane; const f32x4* xc = (const f32x4*)xin_row(F, m + 2 * NGW) + F.lane; const f32x4* xd = (const f32x4*)xin_row(F, m + 3 * NGW) + F.lane;
          const f32x4 a0 = xa[0], a1 = xa[64], a2 = xa[128], a3 = xa[192], b0 = xb[0], b1 = xb[64], b2 = xb[128], b3 = xb[192];
          const f32x4 c0 = xc[0], c1 = xc[64], c2 = xc[128], c3 = xc[192], d0 = xd[0], d1 = xd[64], d2 = xd[128], d3 = xd[192];
          rms_fin_bf16(a0, a1, a2, a3, WSP(bf16, WS_XNA) + (size_t)m * DM, F.lane); rms_fin_bf16(b0, b1, b2, b3, WSP(bf16, WS_XNA) + (size_t)(m + NGW) * DM, F.lane);
          rms_fin_bf16(c0, c1, c2, c3, WSP(bf16, WS_XNA) + (size_t)(m + 2 * NGW) * DM, F.lane); rms_fin_bf16(d0, d1, d2, d3, WSP(bf16, WS_XNA) + (size_t)(m + 3 * NGW) * DM, F.lane); }
      for (; m < MTOK; m += NGW) rms_row_to_bf16(xin_row(F, m), WSP(bf16, WS_XNA) + (size_t)m * DM, F.lane); }
    {
        if (F.G != 256) peer_tables_to_fp8(F, (size_t)gt, (size_t)NGT);
        const f32x4* sk = (const f32x4*)FIN(26); v4u* dk = (v4u*)WSP(bf16, WS_SUBK);
        for (int i = gt; i < 2 * 8 * 2 * 128 * 128 / 8; i += NGT) { const f32x4 a = sk[2 * i], b = sk[2 * i + 1]; v4u w; w.x = pk2(a.x, a.y); w.y = pk2(a.z, a.w); w.z = pk2(b.x, b.y); w.w = pk2(b.z, b.w); dk[i] = w; }
    }
    for (int i = gt; i < 2 * 64 * 2048; i += NGT) { const int kv = i >> 17, hh = (i >> 11) & 63, k = i & 2047;
        WSP(bf16, WS_W1T)[i] = (bf16)f2bf(FIN(17)[((size_t)kv * 2048 + k) * 64 + hh]); }
    for (int i = gt; i < 2 * 4 * 2 * 64 * 8; i += NGT) { const int e = i & 7, ln = (i >> 3) & 63, sx = (i >> 9) & 1, dt = (i >> 10) & 3, kv = i >> 12, fr_ = ln & 15, fq_ = ln >> 4;
        WSP(bf16, WS_W2F)[i] = (bf16)f2bf(FIN(19)[((size_t)kv * 64 + 16 * (2 * sx + (e >> 2)) + 4 * fq_ + (e & 3)) * 64 + 16 * dt + fr_]); }
    for (int it = gw; it < 128; it += NGW) { const int kv = it >> 6, h = it & 63; float s = 0.f;
        for (int k = F.lane; k < 2048; k += 64) s += FIN(18)[(size_t)kv * 2048 + k] * FIN(17)[((size_t)kv * 2048 + k) * 64 + h];
        s = wave_sum(s); if (F.lane == 0) WSP(float, WS_PETERM)[it] = s; }
    {
        bf16* wbd = WSP(bf16, WS_W1BD);
        for (int i = gt; i < 256 * 2048; i += NGT) { const int n = i >> 11, col = i & 2047, kv = n >> 7, sec = (n >> 6) & 1, hh = n & 63;
            float v = 0.f; if ((col >> 10) == kv) { const int k = col & 1023, r = (k >> 6) + 16 * sec, d = k & 63; v = FIN(17)[(((size_t)kv * 32 + r) * 64 + d) * 64 + hh]; }
            wbd[i] = (bf16)f2bf(v); }
    }
    {
        const f32x4* src = (const f32x4*)FIN(3); f32x4* dst = (f32x4*)(F.out + O_WINS);
        const int per_b = 508 * 512 / 4;
        for (int i = gt; i < SB * per_b; i += NGT) { const int b = i / per_b, r = i % per_b; dst[(size_t)b * (512 * 512 / 4) + r] = src[(size_t)b * (512 * 512 / 4) + 4 * 512 / 4 + r]; }
    }
    for (int i = gt; i < SB * NG * 544 * 64; i += NGT) {
        const int d = i & 63, r = (i >> 6) % 544, bg = (i >> 6) / 544, g = bg & 3, b = bg >> 2;
        if (r < 512) { const float* cw = FIN(3) + (((size_t)b * 512 + r) * 2) * 256 + g * 64 + d;
            WSP(bf16, WS_SKWIN)[i] = (bf16)f2bf(cw[0]);
            WSP(bf16, WS_SVWINT)[((size_t)bg * 64 + d) * 544 + r] = (bf16)f2bf(cw[256]); }
        else if (r >= 516) { WSP(bf16, WS_SKWIN)[i] = 0; WSP(bf16, WS_SVWINT)[((size_t)bg * 64 + d) * 544 + r] = 0; }
    }
}

constexpr int P2_QS = 0, P2_KS = 17408, P2_KBGT = 34816, P2_VBT = 53248, P2_AM = 71680, P2_TB = 89088, P2_G = 98304, P2_TF = 99328, P2_XF = 116736;
constexpr int QS_LD = 136, KT_LD = 72, AM_LD = 68, TB_LD = 72;

__device__ __forceinline__ float softplus_f(float x) { return fmaxf(x, 0.f) + __logf(1.f + __expf(-fabsf(x))); }

__device__ __forceinline__ void p2_chunk(Frame& F, int unit) {
    const int c = unit & 127, h = (unit >> 7) & 7, b = unit >> 10;
    const int t0 = c * CHUNK, lane = F.lane, w = F.wave, fr = lane & 15, fq = lane >> 4;
    LAS unsigned char* L = F.lds; asm volatile("" : "+v"(L));
    LAS bf16* qs = (LAS bf16*)(L + P2_QS); LAS bf16* ks = (LAS bf16*)(L + P2_KS);
    LAS bf16* kbgT = (LAS bf16*)(L + P2_KBGT); LAS bf16* vbT = (LAS bf16*)(L + P2_VBT);
    LAS float* Am = (LAS float*)(L + P2_AM); LAS bf16* Tb = (LAS bf16*)(L + P2_TB);
    LAS float* Gs = (LAS float*)(L + P2_G);
    const bf16* PROJ = WSP(bf16, WS_PROJ); const bf16* XNA = WSP(bf16, WS_XNA); const float* WAB = WSP(float, WS_WAB);
    const size_t rowb = (size_t)b * PT;
    float beta_r[8];
    {
        f32x4 wa[4], wb[4];
        const float* pa = WAB + (size_t)h * DM + 8 * lane; const float* pb = WAB + (size_t)(8 + h) * DM + 8 * lane;
        wa[0] = *(const f32x4*)pa; wa[1] = *(const f32x4*)(pa + 4); wa[2] = *(const f32x4*)(pa + 512); wa[3] = *(const f32x4*)(pa + 516);
        wb[0] = *(const f32x4*)pb; wb[1] = *(const f32x4*)(pb + 4); wb[2] = *(const f32x4*)(pb + 512); wb[3] = *(const f32x4*)(pb + 516);
        const float Aneg = -expf(FIN(10)[h]), dtb = FIN(11)[h];
#pragma unroll
        for (int tk = 0; tk < 8; ++tk) {
            const int tok = 8 * w + tk; const bf16* xr = XNA + (rowb + t0 + tok) * DM + 8 * lane;
            const v4u x0 = *(const v4u*)xr, x1 = *(const v4u*)(xr + 512);
            float sa = 0.f, sb = 0.f;
#define ACC2(xw, wv0, wv1, i0) { const float lo = bflo(xw), hi = bfhi(xw); sa += lo * wv0[i0] + hi * wv0[i0 + 1]; sb += lo * wv1[i0] + hi * wv1[i0 + 1]; }
            ACC2(x0.x, wa[0], wb[0], 0) ACC2(x0.y, wa[0], wb[0], 2) ACC2(x0.z, wa[1], wb[1], 0) ACC2(x0.w, wa[1], wb[1], 2)
            ACC2(x1.x, wa[2], wb[2], 0) ACC2(x1.y, wa[2], wb[2], 2) ACC2(x1.z, wa[3], wb[3], 0) ACC2(x1.w, wa[3], wb[3], 2)
#undef ACC2
            sa = wave_sum(sa); sb = wave_sum(sb);
            const float g = Aneg * softplus_f(sa + dtb), be = sigmoid_f(sb);
            beta_r[tk] = be;
            if (lane == 0) { Gs[tok] = g; Gs[64 + tok] = be; }
        }
    }
#pragma unroll
    for (int p = 0; p < 3; ++p) {
        const int col0 = p * 1024 + h * 128 + 2 * lane;
        float cw0[4], cw1[4];
#pragma unroll
        for (int i = 0; i < 4; ++i) { const f32x2 cv = *(const f32x2*)(FIN(9) + (size_t)i * GCONV + col0); cw0[i] = cv.x; cw1[i] = cv.y; }
        unsigned xw[11];
#pragma unroll
        for (int rr = 0; rr < 11; ++rr) { const int t = t0 + 8 * w - 3 + rr; xw[rr] = (t >= 0) ? *(const unsigned*)(PROJ + (rowb + t) * 4096 + col0) : 0u; }
        if (c == 127 && w == 7) {
#pragma unroll
            for (int r = 0; r < 3; ++r) { float* o = F.out + O_CONVP + ((size_t)b * 3 + r) * GCONV + col0; o[0] = bflo(xw[8 + r]); o[1] = bfhi(xw[8 + r]); }
        }
#pragma unroll
        for (int tk = 0; tk < 8; ++tk) {
            const int tok = 8 * w + tk;
            float y0 = 0.f, y1 = 0.f;
#pragma unroll
            for (int i = 0; i < 4; ++i) { y0 += cw0[i] * bflo(xw[tk + i]); y1 += cw1[i] * bfhi(xw[tk + i]); }
            y0 = silu_f(y0); y1 = silu_f(y1);
            if (p < 2) {
                const float ss = wave_sum(y0 * y0 + y1 * y1);
                const float rs = (frsq(ss + EPS)) * (p == 0 ? 0.08838834764831845f : 1.f);
                *(LAS unsigned*)((p == 0 ? qs : ks) + tok * QS_LD + 2 * lane) = pk2(y0 * rs, y1 * rs);
            } else {
                vbT[(2 * lane) * KT_LD + tok] = (bf16)f2bf(y0 * beta_r[tk]); vbT[(2 * lane + 1) * KT_LD + tok] = (bf16)f2bf(y1 * beta_r[tk]);
            }
        }
    }
    __syncthreads();
    if (w == 0) { float g = Gs[lane];
#pragma unroll
        for (int o = 1; o < 64; o <<= 1) { const float up = __shfl_up(g, o); if (lane >= o) g += up; }
        Gs[128 + lane] = g; }
    __syncthreads();
    const float glast = Gs[128 + 63];
    const size_t chunk = (size_t)unit;
    if (w < 4) {
        const int mt = w;
        bf16x8 a[4];
#pragma unroll
        for (int kk = 0; kk < 4; ++kk) a[kk] = ld8l(ks + (16 * mt + fr) * QS_LD + 32 * kk + 8 * fq);
#pragma unroll
        for (int nt = 0; nt < 4; ++nt) {
            f32x4 acc = {0.f, 0.f, 0.f, 0.f};
            if (nt <= mt) {
#pragma unroll
                for (int kk = 0; kk < 4; ++kk) acc = MFMA16(a[kk], ld8l(ks + (16 * nt + fr) * QS_LD + 32 * kk + 8 * fq), acc);
            }
            const int j = 16 * nt + fr; const float gj = Gs[128 + j];
#pragma unroll
            for (int r = 0; r < 4; ++r) { const int i = 16 * mt + 4 * fq + r;
                Am[i * AM_LD + j] = (i > j) ? Gs[64 + i] * acc[r] * __expf(Gs[128 + i] - gj) : 0.f; }
        }
    } else {
        const int nt = w - 4;
        bf16x8 bq[4];
#pragma unroll
        for (int kk = 0; kk < 4; ++kk) bq[kk] = ld8l(qs + (16 * nt + fr) * QS_LD + 32 * kk + 8 * fq);
        const int i = 16 * nt + fr; const float gi = Gs[128 + i];
        bf16* gqk = WSP(bf16, WS_GQK) + chunk * 4096;
#pragma unroll
        for (int mt = 0; mt < 4; ++mt) {
            f32x4 acc = {0.f, 0.f, 0.f, 0.f};
            if (mt <= nt) {
#pragma unroll
                for (int kk = 0; kk < 4; ++kk) acc = MFMA16(ld8l(ks + (16 * mt + fr) * QS_LD + 32 * kk + 8 * fq), bq[kk], acc);
            }
            float v[4];
#pragma unroll
            for (int r = 0; r < 4; ++r) { const int j = 16 * mt + 4 * fq + r; v[r] = (i >= j) ? acc[r] * __expf(gi - Gs[128 + j]) : 0.f; }
            v2u o; o.x = pk2(v[0], v[1]); o.y = pk2(v[2], v[3]);
            *(v2u*)(gqk + (((nt * 2 + (mt >> 1)) * 64 + (2 * (mt & 1) + (fq >> 1)) * 16 + fr) * 8 + 4 * (fq & 1))) = o;
        }
    }
    {
        const int tok = F.tid >> 3, d0 = (F.tid & 7) * 16; const float e = __expf(Gs[128 + tok]);
        bf16* gq = WSP(bf16, WS_GQ) + chunk * 8192;
#pragma unroll
        for (int hh = 0; hh < 2; ++hh) { const v4u q = *(const LAS v4u*)(qs + tok * QS_LD + d0 + 8 * hh); v4u o;
            o.x = pk2(bflo(q.x) * e, bfhi(q.x) * e); o.y = pk2(bflo(q.y) * e, bfhi(q.y) * e); o.z = pk2(bflo(q.z) * e, bfhi(q.z) * e); o.w = pk2(bflo(q.w) * e, bfhi(q.w) * e);
            *(v4u*)(gq + ((((tok >> 4) * 4 + ((F.tid & 7) >> 1)) * 64 + (2 * (F.tid & 1) + hh) * 16 + (tok & 15)) * 8)) = o; }
    }
    {
        const int dk = F.tid & 127, tg = F.tid >> 7;
        unsigned o1[8], o2[8];
#pragma unroll
        for (int i = 0; i < 8; ++i) {
            const int ta = 16 * tg + 2 * i, tb2 = ta + 1;
            const float ka = bf2f(ks[ta * QS_LD + dk]), kb = bf2f(ks[tb2 * QS_LD + dk]);
            const float ga = Gs[128 + ta], gb = Gs[128 + tb2];
            o1[i] = pk2(ka * Gs[64 + ta] * __expf(ga), kb * Gs[64 + tb2] * __expf(gb));
            o2[i] = pk2(ka * __expf(glast - ga), kb * __expf(glast - gb));
        }
        LAS v4u* d1 = (LAS v4u*)(kbgT + dk * KT_LD + 16 * tg); d1[0] = (v4u){o1[0], o1[1], o1[2], o1[3]}; d1[1] = (v4u){o1[4], o1[5], o1[6], o1[7]};
        bf16* d2 = WSP(bf16, WS_GKT) + chunk * 8192 + ((((dk >> 4) * 2 + (tg >> 1)) * 64 + (2 * (tg & 1)) * 16 + (dk & 15)) * 8);
        *(v4u*)d2 = (v4u){o2[0], o2[1], o2[2], o2[3]}; *(v4u*)(d2 + 16 * 8) = (v4u){o2[4], o2[5], o2[6], o2[7]};
    }
    if (F.tid == 0) WSP(float, WS_GDEC)[chunk] = __expf(glast);
    __syncthreads();
    LAS float* Tf = (LAS float*)(L + P2_TF); LAS float* Xf = (LAS float*)(L + P2_XF);
    if (w == 0) {
        const int blk = lane >> 5, cc = lane & 31; const LAS float* Ab = Am + (32 * blk) * AM_LD + 32 * blk;
        float t[32];
#pragma unroll
        for (int i = 0; i < 32; ++i) {
            float acc0 = (i == cc) ? 1.f : 0.f, acc1 = 0.f, acc2 = 0.f, acc3 = 0.f;
#pragma unroll
            for (int j4 = 0; j4 < (i + 3) / 4; ++j4) {
                const f32x4 a = *(const LAS f32x4*)(Ab + i * AM_LD + 4 * j4);
                if (4 * j4 + 0 < i) acc0 = __builtin_fmaf(-a.x, t[4 * j4 + 0], acc0);
                if (4 * j4 + 1 < i) acc1 = __builtin_fmaf(-a.y, t[4 * j4 + 1], acc1);
                if (4 * j4 + 2 < i) acc2 = __builtin_fmaf(-a.z, t[4 * j4 + 2], acc2);
                if (4 * j4 + 3 < i) acc3 = __builtin_fmaf(-a.w, t[4 * j4 + 3], acc3);
            }
            t[i] = (acc0 + acc1) + (acc2 + acc3);
            asm volatile("" : "+v"(t[i]));
            __builtin_amdgcn_sched_barrier(0);
        }
#pragma unroll
        for (int i = 0; i < 32; ++i) { Tf[(32 * blk + i) * AM_LD + 32 * blk + cc] = t[i]; if (blk == 0) Tf[i * AM_LD + 32 + cc] = 0.f; }
    }
    __syncthreads();
    {
        const int i = F.tid >> 4, c0 = (F.tid & 15) * 2; float x0 = 0.f, x1 = 0.f;
#pragma unroll 8
        for (int k = 0; k < 32; ++k) { const float a = Am[(32 + i) * AM_LD + k]; x0 = __builtin_fmaf(a, Tf[k * AM_LD + c0], x0); x1 = __builtin_fmaf(a, Tf[k * AM_LD + c0 + 1], x1); }
        Xf[i * 34 + c0] = x0; Xf[i * 34 + c0 + 1] = x1;
    }
    __syncthreads();
    {
        const int i = F.tid >> 4, c0 = (F.tid & 15) * 2; float x0 = 0.f, x1 = 0.f;
#pragma unroll 8
        for (int k = 0; k < 32; ++k) { const float a = Tf[(32 + i) * AM_LD + 32 + k]; x0 = __builtin_fmaf(a, Xf[k * 34 + c0], x0); x1 = __builtin_fmaf(a, Xf[k * 34 + c0 + 1], x1); }
        Tf[(32 + i) * AM_LD + c0] = -x0; Tf[(32 + i) * AM_LD + c0 + 1] = -x1;
    }
    __syncthreads();
    {
        const int i = F.tid >> 3, c0 = (F.tid & 7) * 8; const f32x4 a = *(const LAS f32x4*)(Tf + i * AM_LD + c0), b2 = *(const LAS f32x4*)(Tf + i * AM_LD + c0 + 4);
        *(LAS v4u*)(Tb + i * TB_LD + c0) = (v4u){pk2(a.x, a.y), pk2(a.z, a.w), pk2(b2.x, b2.y), pk2(b2.z, b2.w)};
    }
    __syncthreads();
    {
        bf16x8 tb[4][2];
#pragma unroll
        for (int x = 0; x < 4; ++x)
#pragma unroll
            for (int s = 0; s < 2; ++s) tb[x][s] = ld8l(Tb + (16 * x + fr) * TB_LD + 32 * s + 8 * fq);
        const bf16x8 bv0 = ld8l(vbT + (16 * w + fr) * KT_LD + 8 * fq), bv1 = ld8l(vbT + (16 * w + fr) * KT_LD + 32 + 8 * fq);
        bf16* gu = WSP(bf16, WS_GU) + chunk * 8192 + ((size_t)((w >> 1) * 4 * 64 + lane) * 2 + (w & 1)) * 4;
#pragma unroll
        for (int mt = 0; mt < 4; ++mt) { f32x4 acc = {0.f, 0.f, 0.f, 0.f}; acc = MFMA16(tb[mt][0], bv0, acc); acc = MFMA16(tb[mt][1], bv1, acc); *(v2u*)(gu + mt * 64 * 8) = (v2u){pk2(acc[0], acc[1]), pk2(acc[2], acc[3])}; }
        const bf16x8 ak0 = ld8l(kbgT + (16 * w + fr) * KT_LD + 8 * fq), ak1 = ld8l(kbgT + (16 * w + fr) * KT_LD + 32 + 8 * fq);
        bf16* gw = WSP(bf16, WS_GW) + chunk * 8192;
#pragma unroll
        for (int nt = 0; nt < 4; ++nt) { f32x4 acc = {0.f, 0.f, 0.f, 0.f}; acc = MFMA16(ak0, tb[nt][0], acc); acc = MFMA16(ak1, tb[nt][1], acc);
            v2u o; o.x = pk2(acc[0], acc[1]); o.y = pk2(acc[2], acc[3]);
            *(v2u*)(gw + (((nt * 4 + (w >> 1)) * 64 + (2 * (w & 1) + (fq >> 1)) * 16 + fr) * 8 + 4 * (fq & 1))) = o; }
    }
    __syncthreads();
}

constexpr int S2_Y = 0;
constexpr int S2_AB = 6144;
constexpr int S2_DOT = 6400;
constexpr int S2_U = 6656;
constexpr int S2_W = 8704;
constexpr int S2_VN = 10752;
__device__ __forceinline__ void p2_sample(Frame& F, int unit) {
    const int h = unit & 7, bs = unit >> 3, tid = F.tid, lane = F.lane, w = F.wave;
    LAS unsigned char* L = F.lds; asm volatile("" : "+v"(L));
    LAS float* Y = (LAS float*)(L + S2_Y); LAS float* AB = (LAS float*)(L + S2_AB); LAS float* DOT = (LAS float*)(L + S2_DOT);
    LAS float* U = (LAS float*)(L + S2_U); LAS float* W = (LAS float*)(L + S2_W); LAS float* VN = (LAS float*)(L + S2_VN);
    const bf16* PROJ = WSP(bf16, WS_PROJ); const bf16* XNA = WSP(bf16, WS_XNA); const float* WAB = WSP(float, WS_WAB);
    const size_t row0 = (size_t)MP + bs * 4;
    if (tid < 384) {
        const int part = tid >> 7, cc = tid & 127, col = part * 1024 + h * 128 + cc;
        float buf[7];
#pragma unroll
        for (int r = 0; r < 3; ++r) buf[r] = FIN(5)[((size_t)bs * 3 + r) * GCONV + col];
#pragma unroll
        for (int i = 0; i < 4; ++i) buf[3 + i] = bf2f(PROJ[(row0 + i) * 4096 + col]);
#pragma unroll
        for (int r = 0; r < 3; ++r) F.out[O_CONVS + ((size_t)bs * 3 + r) * GCONV + col] = buf[4 + r];
        float cw[4];
#pragma unroll
        for (int i = 0; i < 4; ++i) cw[i] = FIN(9)[(size_t)i * GCONV + col];
#pragma unroll
        for (int i = 0; i < 4; ++i) { float y = 0.f;
#pragma unroll
            for (int k = 0; k < 4; ++k) y += cw[k] * buf[i + k];
            Y[(part * 4 + i) * 128 + cc] = silu_f(y); }
    }
    {
        const int i = w >> 1, which = w & 1; const bf16* xr = XNA + (row0 + i) * DM; const float* wr = WAB + (size_t)(which * 8 + h) * DM; float s = 0.f;
        for (int k = lane; k < DM; k += 64) s += bf2f(xr[k]) * wr[k];
        s = wave_sum(s); if (lane == 0) AB[which * 4 + i] = s;
    }
    __syncthreads();
    {
        const int part = w >> 2, i = w & 3; LAS float* y = Y + (part * 4 + i) * 128; const float a = y[lane], bq = y[64 + lane];
        const float ss = wave_sum(a * a + bq * bq); const float rs = (frsq(ss + EPS)) * (part == 0 ? 0.08838834764831845f : 1.f);
        y[lane] = a * rs; y[64 + lane] = bq * rs;
    }
    if (tid == 0) { const float Aneg = -expf(FIN(10)[h]), dtb = FIN(11)[h]; float gc = 0.f;
        for (int i = 0; i < 4; ++i) { const float g = Aneg * softplus_f(AB[i] + dtb); gc += g; AB[8 + i] = g; AB[12 + i] = 1.f / (1.f + expf(-AB[4 + i])); AB[16 + i] = gc; } }
    __syncthreads();
    {
#pragma unroll
        for (int pp = 0; pp < 4; ++pp) { const int pr = 4 * w + pp, which = pr >> 4, i = (pr >> 2) & 3, j = pr & 3;
            const LAS float* x = Y + ((which == 0 ? 1 : 0) * 4 + i) * 128; const LAS float* y = Y + (1 * 4 + j) * 128;
            float s = x[lane] * y[lane] + x[64 + lane] * y[64 + lane]; s = wave_sum(s); if (lane == 0) DOT[pr] = s; }
    }
    __syncthreads();
    float g_[4], be[4], gc[4];
#pragma unroll
    for (int i = 0; i < 4; ++i) { g_[i] = AB[8 + i]; be[i] = AB[12 + i]; gc[i] = AB[16 + i]; }
    float Tm[4][4];
    {
        float A[4][4];
#pragma unroll
        for (int i = 0; i < 4; ++i)
#pragma unroll
            for (int j = 0; j < 4; ++j) A[i][j] = (i > j) ? be[i] * DOT[i * 4 + j] * expf(gc[i] - gc[j]) : 0.f;
#pragma unroll
        for (int cc = 0; cc < 4; ++cc)
#pragma unroll
            for (int i = 0; i < 4; ++i) { float acc = (i == cc) ? 1.f : 0.f;
#pragma unroll
                for (int j = 0; j < 4; ++j) if (j < i) acc -= A[i][j] * Tm[j][cc];
                Tm[i][cc] = acc; }
    }
    {
        const int i = tid >> 7, x = tid & 127; float su = 0.f, sw = 0.f;
#pragma unroll
        for (int j = 0; j < 4; ++j) { su += Tm[i][j] * Y[(2 * 4 + j) * 128 + x] * be[j]; sw += Tm[i][j] * Y[(1 * 4 + j) * 128 + x] * be[j] * expf(gc[j]); }
        U[i * 128 + x] = su; W[i * 128 + x] = sw;
    }
    __syncthreads();
    const float* S0 = FIN(4) + ((size_t)bs * GH + h) * 128 * 128;
    const int dv = tid & 127, dg = tid >> 7;
    LAS float* SL = (LAS float*)(L + 32768);
#pragma unroll 16
    for (int r = 0; r < 32; ++r) SL[(32 * dg + r) * 128 + dv] = S0[(size_t)(32 * dg + r) * 128 + dv];
    LAS float* PP = (LAS float*)(L + 16384); LAS float* PQ = (LAS float*)(L + 16384 + 8192);
    {
        float pp[4] = {0.f, 0.f, 0.f, 0.f}, qp[4] = {0.f, 0.f, 0.f, 0.f};
#pragma unroll
        for (int r = 0; r < 32; ++r) { const int dk = 32 * dg + r; const float sv = SL[dk * 128 + dv];
#pragma unroll
            for (int i = 0; i < 4; ++i) { pp[i] += W[i * 128 + dk] * sv; qp[i] += Y[(0 * 4 + i) * 128 + dk] * sv; } }
#pragma unroll
        for (int i = 0; i < 4; ++i) { PP[(dg * 4 + i) * 128 + dv] = pp[i]; PQ[(dg * 4 + i) * 128 + dv] = qp[i]; }
    }
    __syncthreads();
    float qs_acc;
    {
        const int i = tid >> 7;
        const float p = (PP[(0 * 4 + i) * 128 + dv] + PP[(1 * 4 + i) * 128 + dv]) + (PP[(2 * 4 + i) * 128 + dv] + PP[(3 * 4 + i) * 128 + dv]);
        const float qq = (PQ[(0 * 4 + i) * 128 + dv] + PQ[(1 * 4 + i) * 128 + dv]) + (PQ[(2 * 4 + i) * 128 + dv] + PQ[(3 * 4 + i) * 128 + dv]);
        VN[i * 128 + dv] = U[i * 128 + dv] - p; qs_acc = qq * expf(gc[i]);
    }
    __syncthreads();
    {
        const int i = tid >> 7; float o = qs_acc;
#pragma unroll
        for (int j = 0; j < 4; ++j) if (j <= i) o += DOT[16 + i * 4 + j] * expf(gc[i] - gc[j]) * VN[j * 128 + dv];
        WSP(bf16, WS_OGDN)[(row0 + i) * DM + h * 128 + dv] = (bf16)f2bf(o);
    }
    {
        const float el = expf(gc[3]);
        float kd[4], vn[4];
#pragma unroll
        for (int j = 0; j < 4; ++j) { kd[j] = expf(gc[3] - gc[j]); vn[j] = VN[j * 128 + dv]; }
        float* So = F.out + O_GDNS + ((size_t)bs * GH + h) * 128 * 128;
#pragma unroll
        for (int r = 0; r < 32; ++r) { const int dk = 32 * dg + r; float sv = SL[dk * 128 + dv] * el;
#pragma unroll
            for (int j = 0; j < 4; ++j) sv += Y[(1 * 4 + j) * 128 + dk] * kd[j] * vn[j];
            So[(size_t)dk * 128 + dv] = sv; }
    }
    (void)g_;
    __syncthreads();
}

constexpr int P3_S = 0;
constexpr int P3_VN = 16384;
__device__ __forceinline__ void p3_scan(Frame& F, int bh, int s) {
    const int lane = F.lane, w = F.wave, fr = lane & 15, fq = lane >> 4;
    const int b = bh >> 3, h = bh & 7;
    LAS bf16* Sl = (LAS bf16*)(F.lds + P3_S); LAS bf16* Vl = (LAS bf16*)(F.lds + P3_VN);
    const bf16* GW = WSP(bf16, WS_GW); const bf16* GQ = WSP(bf16, WS_GQ); const bf16* GKT = WSP(bf16, WS_GKT); const bf16* GQK = WSP(bf16, WS_GQK);
    const bf16* GU = WSP(bf16, WS_GU); const float* GDEC = WSP(float, WS_GDEC);
    bf16* OG = WSP(bf16, WS_OGDN);
    f32x4 Sacc[2];
#pragma unroll
    for (int n = 0; n < 2; ++n) { Sacc[n] = (f32x4){0.f, 0.f, 0.f, 0.f}; v2u z = {0u, 0u}; *(LAS v2u*)(Sl + (n * 16 + fr) * 136 + 16 * w + 4 * fq) = z; }
    __syncthreads();
    const int m = w & 3;
    struct P3Ops { bf16x8 a1[4], ak0, ak1; v4u x0, x1; float dec; };
    P3Ops R0, R1, R2;
#define P3_FETCH(R, cc) do { const size_t ch_ = (size_t)bh * NCH + (cc); \
        const bf16* p1_ = (w < 4 ? GW : GQ) + ch_ * 8192 + (size_t)(m * 4 * 64 + lane) * 8;        \
        _Pragma("unroll") for (int k_ = 0; k_ < 4; ++k_) R.a1[k_] = ld8(p1_ + 512 * k_); \
        const bf16* pk_ = GKT + ch_ * 8192 + (size_t)(w * 2 * 64 + lane) * 8; R.ak0 = ld8(pk_); R.ak1 = ld8(pk_ + 512); \
        const unsigned char* px_ = w < 4 ? (const unsigned char*)(GU + ch_ * 8192 + ((size_t)(s * 4 + m) * 64 + lane) * 8) : (const unsigned char*)(GQK + ch_ * 4096 + (size_t)(m * 2 * 64 + lane) * 8); \
        R.x0 = *(const v4u*)px_; R.x1 = *(const v4u*)(px_ + (w < 4 ? 0 : 1024));        \
        R.dec = GDEC[ch_]; } while (0)
#define P3_STEP(R, c) do { \
        f32x4 acc[2]; \
        _Pragma("unroll") for (int n = 0; n < 2; ++n) { acc[n] = (f32x4){0.f, 0.f, 0.f, 0.f}; \
            _Pragma("unroll") for (int k = 0; k < 4; ++k) acc[n] = MFMA16(R.a1[k], ld8l(Sl + (n * 16 + fr) * 136 + 32 * k + 8 * fq), acc[n]); } \
        if (w < 4) { _Pragma("unroll") for (int n = 0; n < 2; ++n) { const unsigned ua_ = n == 0 ? R.x0.x : R.x0.z, ub_ = n == 0 ? R.x0.y : R.x0.w; const f32x4 vn = (f32x4){bflo(ua_), bfhi(ua_), bflo(ub_), bfhi(ub_)} - acc[n]; v2u o; o.x = pk2(vn[0], vn[1]); o.y = pk2(vn[2], vn[3]); \
            *(LAS v2u*)(Vl + (n * 16 + fr) * 72 + 16 * m + 4 * fq) = o; } } \
        asm volatile("s_waitcnt lgkmcnt(0)\n\ts_barrier" ::: "memory"); \
        bf16x8 v0[2], v1[2]; \
        _Pragma("unroll") for (int n = 0; n < 2; ++n) { v0[n] = ld8l(Vl + (n * 16 + fr) * 72 + 8 * fq); v1[n] = ld8l(Vl + (n * 16 + fr) * 72 + 32 + 8 * fq); } \
        if (w >= 4) { _Pragma("unroll") for (int n = 0; n < 2; ++n) { acc[n] = MFMA16(__builtin_bit_cast(bf16x8, R.x0), v0[n], acc[n]); acc[n] = MFMA16(__builtin_bit_cast(bf16x8, R.x1), v1[n], acc[n]); \
            bf16* o = OG + ((size_t)b * PT + (c) * CHUNK + 16 * m + 4 * fq) * DM + h * 128 + 32 * s + 16 * n + fr; \
            _Pragma("unroll") for (int r = 0; r < 4; ++r) o[(size_t)r * DM] = (bf16)f2bf(acc[n][r]); } } \
        { float d_ = R.dec;        \
          _Pragma("unroll") for (int n = 0; n < 2; ++n) asm volatile("v_mul_f32 %0, %0, %4\n\tv_mul_f32 %1, %1, %4\n\tv_mul_f32 %2, %2, %4\n\tv_mul_f32 %3, %3, %4" : "+v"(Sacc[n][0]), "+v"(Sacc[n][1]), "+v"(Sacc[n][2]), "+v"(Sacc[n][3]) : "v"(d_)); } \
        _Pragma("unroll") for (int n = 0; n < 2; ++n) { Sacc[n] = MFMA16(R.ak0, v0[n], Sacc[n]); Sacc[n] = MFMA16(R.ak1, v1[n], Sacc[n]); \
            v2u o; o.x = pk2(Sacc[n][0], Sacc[n][1]); o.y = pk2(Sacc[n][2], Sacc[n][3]); *(LAS v2u*)(Sl + (n * 16 + fr) * 136 + 16 * w + 4 * fq) = o; } \
        asm volatile("s_waitcnt lgkmcnt(0)\n\ts_barrier" ::: "memory"); } while (0)
    P3_FETCH(R0, 0); __builtin_amdgcn_sched_barrier(0); P3_FETCH(R1, 1); __builtin_amdgcn_sched_barrier(0); P3_FETCH(R2, 2); __builtin_amdgcn_sched_barrier(0);
    static_assert(NCH % 3 == 2, "ring schedule below assumes NCH = 3k + 2");
#pragma unroll 1
    for (int c = 0; c + 3 <= NCH; c += 3) {
        P3_STEP(R0, c);     P3_FETCH(R0, (c + 3 < NCH ? c + 3 : NCH - 1));
        P3_STEP(R1, c + 1); P3_FETCH(R1, (c + 4 < NCH ? c + 4 : NCH - 1));
        P3_STEP(R2, c + 2); P3_FETCH(R2, (c + 5 < NCH ? c + 5 : NCH - 1));
    }
    P3_STEP(R0, NCH - 2); P3_STEP(R1, NCH - 1);
#undef P3_FETCH
#undef P3_STEP
    float* So = F.out + O_GDNP + ((size_t)bh * 128) * 128;
#pragma unroll
    for (int n = 0; n < 2; ++n)
#pragma unroll
        for (int r = 0; r < 4; ++r) So[(size_t)(16 * w + 4 * fq + r) * 128 + 32 * s + 16 * n + fr] = Sacc[n][r];
}

__device__ __forceinline__ void p4_rows(Frame& F, int first, int stride) {
    const int lane = F.lane;
    if (first >= MTOK) return;
    float gn[16];
    { const f32x4* gp = (const f32x4*)(FIN(12) + (16 * lane & 127));
#pragma unroll
      for (int j = 0; j < 4; ++j) { const f32x4 g4 = gp[j]; gn[4 * j] = g4.x; gn[4 * j + 1] = g4.y; gn[4 * j + 2] = g4.z; gn[4 * j + 3] = g4.w; } }
    v4u no0, no1, nz0, nz1;
#define P4_FETCH(rw) do { const bf16* o_ = WSP(bf16, WS_OGDN) + (size_t)(rw) * DM + 16 * lane; const bf16* z_ = WSP(bf16, WS_PROJ) + (size_t)(rw) * 4096 + 3072 + 16 * lane; \
        no0 = *(const v4u*)o_; no1 = *(const v4u*)(o_ + 8); nz0 = *(const v4u*)z_; nz1 = *(const v4u*)(z_ + 8); } while (0)
    P4_FETCH(first);
#pragma unroll 1
    for (int row = first; row < MTOK; row += stride) {
        f32x4 v[4]; const v4u z0 = nz0, z1 = nz1; float ss = 0.f;
#pragma unroll
        for (int j = 0; j < 4; ++j) { const unsigned wa = j < 2 ? (j == 0 ? no0.x : no0.z) : (j == 2 ? no1.x : no1.z), wb = j < 2 ? (j == 0 ? no0.y : no0.w) : (j == 2 ? no1.y : no1.w);
            v[j] = (f32x4){bflo(wa), bfhi(wa), bflo(wb), bfhi(wb)}; ss += (v[j].x * v[j].x + v[j].y * v[j].y) + (v[j].z * v[j].z + v[j].w * v[j].w); }
        { const int nr = row + stride < MTOK ? row + stride : row; P4_FETCH(nr); }
        ss += dpp_f<DPP_XOR1>(ss); ss += dpp_f<DPP_XOR2>(ss); ss += dpp_f<DPP_HMIR>(ss);
        const float rstd = frsq(ss * (1.f / 128.f) + EPS);
        float zz[16] = {bflo(z0.x), bfhi(z0.x), bflo(z0.y), bfhi(z0.y), bflo(z0.z), bfhi(z0.z), bflo(z0.w), bfhi(z0.w),
                        bflo(z1.x), bfhi(z1.x), bflo(z1.y), bfhi(z1.y), bflo(z1.z), bfhi(z1.z), bflo(z1.w), bfhi(z1.w)};
        unsigned ow[8];
#pragma unroll
        for (int j = 0; j < 8; ++j) { const float a = v[j >> 1][(2 * j) & 3] * rstd * gn[2 * j] * silu_f(zz[2 * j]), bq = v[j >> 1][(2 * j + 1) & 3] * rstd * gn[2 * j + 1] * silu_f(zz[2 * j + 1]); ow[j] = pk2(a, bq); }
        v4u* dst = (v4u*)(WSP(bf16, WS_OG) + (size_t)row * DM + 16 * lane);
        dst[0] = (v4u){ow[0], ow[1], ow[2], ow[3]}; dst[1] = (v4u){ow[4], ow[5], ow[6], ow[7]};
    }
#undef P4_FETCH
}

typedef __bf16 bf16x2_t __attribute__((ext_vector_type(2)));
__device__ __forceinline__ float dot2_bf16(unsigned w, unsigned x, float acc) { return __builtin_amdgcn_fdot2_f32_bf16(__builtin_bit_cast(bf16x2_t, w), __builtin_bit_cast(bf16x2_t, x), acc, false); }
__device__ __forceinline__ float u2f(unsigned u) { return __builtin_bit_cast(float, u); }
__device__ __forceinline__ unsigned f2u(float f) { return __builtin_bit_cast(unsigned, f); }

constexpr int P8_MAXU = 4;
constexpr int P8_WAVE = P8_MAXU * 2048 + 1024;
constexpr int P8_TOP = 0;
constexpr int P8_TAB = 8 * P8_WAVE;
__device__ __forceinline__ void p8_init_tab(Frame& F) {
    LAS unsigned char* tab = F.lds + P8_TAB;
    if (F.tid < 64) { const int k = F.tid; int i = 0, j = 0;
        if (k < 16) { i = 0; j = k; } else if (k < 24) { i = 1; j = k - 16; } else if (k < 29) { i = 2; j = k - 24; } else if (k < 33) { i = 3; j = k - 29; }
        else if (k < 36) { i = 4; j = k - 33; } else if (k < 38) { i = 5; j = k - 36; } else if (k < 40) { i = 6; j = k - 38; } else if (k < 42) { i = 7; j = k - 40; } else if (k < 50) { i = k - 34; j = 0; }
        tab[k] = (unsigned char)i; tab[64 + k] = (unsigned char)j; }
    __syncthreads();
}
__device__ __forceinline__ int fkey(float x) { const int b = __builtin_bit_cast(int, x); return b ^ ((b >> 31) & 0x7fffffff); }
__device__ __forceinline__ float fkey_inv(int k) { return __builtin_bit_cast(float, k ^ ((k >> 31) & 0x7fffffff)); }
template <int CTRL> __device__ __forceinline__ int dpp_i(int x) { return __builtin_amdgcn_update_dpp(0, x, CTRL, 0xF, 0xF, true); }
__device__ __forceinline__ int imax(int a, int b) { return a > b ? a : b; }
__device__ __forceinline__ int imin(int a, int b) { return a < b ? a : b; }
__device__ __forceinline__ int row_imax16(int x) {
    x = imax(x, dpp_i<0xB1>(x)); x = imax(x, dpp_i<0x4E>(x)); x = imax(x, dpp_i<0x141>(x)); x = imax(x, dpp_i<0x140>(x)); return x;
}
#define ICSWAP(a, b) { const int hi_ = imax(a, b), lo_ = imin(a, b); a = hi_; b = lo_; }
constexpr int IKEY_MIN = (int)0x80000000;
template <int NR>
__device__ __forceinline__ void p8_run(Frame& F, int layer, int w, int rq, int u0, int ustride, int nu) {
    int lane_ = F.lane; asm volatile("" : "+v"(lane_));
    const int lane = lane_, fr = lane & 15, fq = lane >> 4;
    LAS unsigned char* L = F.lds; asm volatile("" : "+v"(L));
    LAS int* toplw = (LAS int*)(L + P8_TOP + F.wave * P8_WAVE);
    LAS float* wins = (LAS float*)(L + P8_TOP + F.wave * P8_WAVE + P8_MAXU * 2048);
    const LAS unsigned char* tab = L + P8_TAB;
    const bf16* Qb = WSP(bf16, WS_QPEER) + (size_t)fr * 2048 + w * 256 + 8 * fq;
    const bf16* SK = WSP(bf16, WS_SUBK) + (size_t)((layer * 8 + w) * 2) * 16384 + (size_t)fr * 128 + 8 * fq;
#pragma unroll 1
    for (int p = 0; p < 2; ++p) {
        bf16x8 bk[32], aq[4];
#pragma unroll
        for (int i = 0; i < 32; ++i) bk[i] = ld8(SK + (size_t)p * 16384 + (size_t)(i >> 2) * 2048 + 32 * (i & 3));
#pragma unroll
        for (int ks = 0; ks < 4; ++ks) aq[ks] = ld8(Qb + (size_t)u0 * 16 * 2048 + p * 128 + 32 * ks);
#pragma unroll 1
        for (int k = 0; k < nu; ++k) {
            LAS int* topl = toplw + k * 512;
            int s[NR][8];
#pragma unroll
            for (int nt = 0; nt < 8; ++nt) { f32x4 acc = {0.f, 0.f, 0.f, 0.f};
#pragma unroll
                for (int ks = 0; ks < 4; ++ks) acc = MFMA16(aq[ks], bk[nt * 4 + ks], acc);
                if (NR == 4) {
#pragma unroll
                    for (int r = 0; r < NR; ++r) s[r][nt] = fkey(u2f((f2u(acc[r]) & ~127u) | (unsigned)(16 * nt + fr)));
                } else { const float av = rq == 0 ? acc[0] : rq == 1 ? acc[1] : rq == 2 ? acc[2] : acc[3]; s[0][nt] = fkey(u2f((f2u(av) & ~127u) | (unsigned)(16 * nt + fr))); } }
            { const int un = u0 + (k + 1 < nu ? k + 1 : k) * ustride;
#pragma unroll
              for (int ks = 0; ks < 4; ++ks) aq[ks] = ld8(Qb + (size_t)un * 16 * 2048 + p * 128 + 32 * ks); }
#pragma unroll
            for (int r = 0; r < NR; ++r) {
                ICSWAP(s[r][0], s[r][1]) ICSWAP(s[r][2], s[r][3]) ICSWAP(s[r][4], s[r][5]) ICSWAP(s[r][6], s[r][7])
                ICSWAP(s[r][0], s[r][2]) ICSWAP(s[r][1], s[r][3]) ICSWAP(s[r][4], s[r][6]) ICSWAP(s[r][5], s[r][7])
                ICSWAP(s[r][1], s[r][2]) ICSWAP(s[r][5], s[r][6]) ICSWAP(s[r][0], s[r][4]) ICSWAP(s[r][3], s[r][7])
                ICSWAP(s[r][1], s[r][5]) ICSWAP(s[r][2], s[r][6]) ICSWAP(s[r][1], s[r][4]) ICSWAP(s[r][3], s[r][6])
                ICSWAP(s[r][2], s[r][4]) ICSWAP(s[r][3], s[r][5]) ICSWAP(s[r][3], s[r][4]) }
            int mine[NR];
#pragma unroll
            for (int r = 0; r < NR; ++r) mine[r] = IKEY_MIN;
#pragma unroll 1
            for (int rd = 0; rd < 16; ++rd) {
                const bool me = fr == rd;
#pragma unroll
                for (int r = 0; r < NR; ++r) {
                    const int mx = row_imax16(s[r][0]);
                    const bool pop = s[r][0] == mx;
#pragma unroll
                    for (int i = 0; i < 7; ++i) s[r][i] = pop ? s[r][i + 1] : s[r][i];
                    s[r][7] = pop ? IKEY_MIN : s[r][7];
                    mine[r] = me ? mx : mine[r];
                }
            }
#pragma unroll
            for (int r = 0; r < NR; ++r) topl[((4 * fq + (NR == 4 ? r : rq)) * 2 + p) * 16 + fr] = mine[r];
        }
    }
    LDS_WAIT();
#pragma unroll 1
    for (int k = 0; k < nu; ++k) {
    LAS int* topl = toplw + k * 512;
    const int r0 = (u0 + k * ustride) * 16;
    int c[NR][4];
#pragma unroll
    for (int r = 0; r < NR; ++r) { const int tk = 4 * fq + (NR == 4 ? r : rq);
#pragma unroll
        for (int m = 0; m < 4; ++m) { const int kc = fr + 16 * m; int cv = IKEY_MIN;
            if (kc < 50) { const int i = tab[kc], j = tab[64 + kc]; const float s1 = u2f(f2u(fkey_inv(topl[(tk * 2 + 0) * 16 + i])) & ~127u), s2 = u2f(f2u(fkey_inv(topl[(tk * 2 + 1) * 16 + j])) & ~127u);
                cv = fkey(u2f((f2u(s1 + s2) & ~63u) | (unsigned)kc)); }
            c[r][m] = cv; }
        ICSWAP(c[r][0], c[r][1]) ICSWAP(c[r][2], c[r][3]) ICSWAP(c[r][0], c[r][2]) ICSWAP(c[r][1], c[r][3]) ICSWAP(c[r][1], c[r][2]) }
    int minec[NR];
#pragma unroll
    for (int r = 0; r < NR; ++r) minec[r] = IKEY_MIN;
#pragma unroll 1
    for (int rd = 0; rd < 16; ++rd) {
        const bool me = fr == rd;
#pragma unroll
        for (int r = 0; r < NR; ++r) {
            const int mx = row_imax16(c[r][0]);
            const bool pop = c[r][0] == mx;
            c[r][0] = pop ? c[r][1] : c[r][0]; c[r][1] = pop ? c[r][2] : c[r][1]; c[r][2] = pop ? c[r][3] : c[r][2]; c[r][3] = pop ? IKEY_MIN : c[r][3];
            minec[r] = me ? mx : minec[r];
        }
    }
#pragma unroll
    for (int r = 0; r < NR; ++r) wins[(4 * fq + (NR == 4 ? r : rq)) * 16 + fr] = fkey_inv(minec[r]);
    LDS_WAIT();
    if (NR == 4 || (fr >> 2) == rq) {
        const int tk = 4 * fq + (fr >> 2), q4 = fr & 3;
        const float w0 = wins[tk * 16]; float den = 0.f;
#pragma unroll
        for (int rd = 0; rd < 16; ++rd) den += __expf(wins[tk * 16 + rd] - w0);
        const float inv = 1.f / den;
        int e[4]; float g[4];
#pragma unroll
        for (int x = 0; x < 4; ++x) { const float wv = wins[tk * 16 + 4 * q4 + x]; const int kc = (int)(f2u(wv) & 63u); const int i = tab[kc], j = tab[64 + kc];
            e[x] = (int)(f2u(fkey_inv(topl[(tk * 2 + 0) * 16 + i])) & 127u) * 128 + (int)(f2u(fkey_inv(topl[(tk * 2 + 1) * 16 + j])) & 127u); g[x] = __expf(wv - w0) * inv; }
        unsigned short* pei = WSP(unsigned short, WS_PEI) + (size_t)(r0 + tk) * 128 + w * 16 + 4 * q4; float* peg = WSP(float, WS_PEG) + (size_t)(r0 + tk) * 128 + w * 16 + 4 * q4;
        *(v2u*)pei = (v2u){(unsigned)e[0] | ((unsigned)e[1] << 16), (unsigned)e[2] | ((unsigned)e[3] << 16)};
        *(f32x4*)peg = (f32x4){g[0], g[1], g[2], g[3]};
    }
    LDS_WAIT();
    }
}
__device__ __forceinline__ void p8_phase(Frame& F, int layer) {
    p8_init_tab(F);
    for (int ub = F.bid; ub < MP / 16; ub += F.G * P8_MAXU) { const int left = (MP / 16 - ub + F.G - 1) / F.G; p8_run<4>(F, layer, F.wave, 0, ub, F.G, left < P8_MAXU ? left : P8_MAXU); }
    for (int qu = F.bid * 8 + F.wave; qu < (MS / 16) * 8 * 4 * 8; qu += F.G * 8) { if ((qu & 7) == 0) { const int x = qu >> 3; p8_run<1>(F, layer, (x >> 2) & 7, x & 3, MP / 16 + (x >> 5), 0, 1); } }
}

constexpr size_t PE_SLICE_BYTES = (size_t)NEXP * 128;
__device__ __forceinline__ f32x2 p9_cvt(unsigned w, bool hi) { return hi ? __builtin_amdgcn_cvt_pk_f32_fp8((int)w, true) : __builtin_amdgcn_cvt_pk_f32_fp8((int)w, false); }
__device__ __forceinline__ f32x2 fma2(f32x2 a, f32x2 b, f32x2 c) { return __builtin_elementwise_fma(a, b, c); }
__device__ __forceinline__ float p9_dot16(const v4u u, const f32x2 (&h)[8]) {
    f32x2 a = {0.f, 0.f}, b = {0.f, 0.f};
    a = fma2(p9_cvt(u.x, false), h[0], a); b = fma2(p9_cvt(u.x, true), h[1], b); a = fma2(p9_cvt(u.y, false), h[2], a); b = fma2(p9_cvt(u.y, true), h[3], b);
    a = fma2(p9_cvt(u.z, false), h[4], a); b = fma2(p9_cvt(u.z, true), h[5], b); a = fma2(p9_cvt(u.w, false), h[6], a); b = fma2(p9_cvt(u.w, true), h[7], b);
    a = a + b; return a.x + a.y;
}
__device__ __forceinline__ void p9_axpy16(const v4u v, float c, f32x2 (&o)[8]) {
    const f32x2 cc = {c, c};
    o[0] = fma2(p9_cvt(v.x, false), cc, o[0]); o[1] = fma2(p9_cvt(v.x, true), cc, o[1]); o[2] = fma2(p9_cvt(v.y, false), cc, o[2]); o[3] = fma2(p9_cvt(v.y, true), cc, o[3]);
    o[4] = fma2(p9_cvt(v.z, false), cc, o[4]); o[5] = fma2(p9_cvt(v.z, true), cc, o[5]); o[6] = fma2(p9_cvt(v.w, false), cc, o[6]); o[7] = fma2(p9_cvt(v.w, true), cc, o[7]);
}
#define P9_GATHER(S, iw) do { _Pragma("unroll") for (int j_ = 0; j_ < 8; ++j_) { const unsigned w_ = (iw)[j_ >> 1]; const unsigned id_ = (j_ & 1) ? (w_ >> 16) : (w_ & 0xffffu); \
        S[j_] = *(const v4u*)(tab + ((id_ << 7) + sub16)); } } while (0)
__device__ __forceinline__ float swapsum16(float x, float y) { unsigned a = __builtin_bit_cast(unsigned, x), b = __builtin_bit_cast(unsigned, y); PSWAP16(a, b); return __builtin_bit_cast(float, a) + __builtin_bit_cast(float, b); }
__device__ __forceinline__ float swapsum32(float x, float y) { unsigned a = __builtin_bit_cast(unsigned, x), b = __builtin_bit_cast(unsigned, y); PSWAP32(a, b); return __builtin_bit_cast(float, a) + __builtin_bit_cast(float, b); }

__device__ __forceinline__ int p9_idot16(const v4u u, const v4u h) {
    int a = __builtin_amdgcn_sdot4((int)u.x, (int)h.x, 0, false); a = __builtin_amdgcn_sdot4((int)u.y, (int)h.y, a, false);
    a = __builtin_amdgcn_sdot4((int)u.z, (int)h.z, a, false); return __builtin_amdgcn_sdot4((int)u.w, (int)h.w, a, false);
}
__device__ __forceinline__ void p9u_wave(Frame& F, int layer, int slice, int first, int stride) {
    int lane_ = F.lane; asm volatile("" : "+v"(lane_));
    const int lane = lane_, gi = lane >> 3, sub = lane & 7;
    const unsigned char* tab = WSP(unsigned char, WS_PU) + (size_t)(layer * 8 + slice) * PE_SLICE_BYTES;
    const unsigned sub16 = (unsigned)sub * 16u;
    const unsigned char* hbase = WSP(unsigned char, WS_XN8) + slice * 128 + sub * 16;
    const unsigned char* ibase = (const unsigned char*)(WSP(unsigned short, WS_PEI) + gi * 16);
    const float* hsb = WSP(float, WS_HS);
    unsigned* pa = WSP(unsigned, WS_PA) + slice * 64 + lane;
    int t = first; if (t >= MTOK) return;
    v4u ia, ib, hq, nia, nib, nhq, A[8], B[8]; float hs, nhs;
#define P9U_META(tt, xa, xb, yq, ys) do { const v4u* ip_ = (const v4u*)(ibase + (size_t)(tt) * 256); xa = ip_[0]; xb = ip_[1]; yq = *(const v4u*)(hbase + (size_t)(tt) * 1024); ys = hsb[(tt)]; } while (0)
    P9U_META(t, ia, ib, hq, hs);
    P9_GATHER(A, ia);
    const bool b0 = sub & 1, b1 = sub & 2, b2 = sub & 4;
#pragma unroll 1
    for (;;) {
        const int tn = t + stride; const bool more = tn < MTOK; const int tl = more ? tn : t;
        P9U_META(tl, nia, nib, nhq, nhs);
        P9_GATHER(B, ib);
        int p[16];
#pragma unroll
        for (int j = 0; j < 8; ++j) p[j] = p9_idot16(A[j], hq);
        P9_GATHER(A, nia);
#pragma unroll
        for (int j = 0; j < 8; ++j) p[8 + j] = p9_idot16(B[j], hq);
        int q[8], r[4], sv[2];
#pragma unroll
        for (int i = 0; i < 8; ++i) { const int keep = b2 ? p[8 + i] : p[i], send = b2 ? p[i] : p[8 + i]; q[i] = keep + dpp_i<DPP_HMIR>(send); }
#pragma unroll
        for (int i = 0; i < 4; ++i) { const int keep = b0 ? q[2 * i + 1] : q[2 * i], send = b0 ? q[2 * i] : q[2 * i + 1]; r[i] = keep + dpp_i<DPP_XOR1>(send); }
#pragma unroll
        for (int i = 0; i < 2; ++i) { const int keep = b1 ? r[2 * i + 1] : r[2 * i], send = b1 ? r[2 * i] : r[2 * i + 1]; sv[i] = keep + dpp_i<DPP_XOR2>(send); }
        const float sc = hs * (1.f / 19.f);
        pa[(size_t)t * 512] = pk2((float)sv[0] * sc, (float)sv[1] * sc);
        if (!more) break;
        t = tn; ia = nia; ib = nib; hq = nhq; hs = nhs;
    }
#undef P9U_META
}

__device__ __forceinline__ void p9v_wave(Frame& F, int layer, int slice, int first, int stride, int mode) {
    int lane_ = F.lane; asm volatile("" : "+v"(lane_));
    const int lane = lane_, gi = lane >> 3, sub = lane & 7, j0 = 8 * (sub >> 2) + (sub & 3);
    const unsigned char* tab = WSP(unsigned char, WS_PV) + (size_t)(layer * 8 + slice) * PE_SLICE_BYTES;
    const unsigned sub16 = (unsigned)sub * 16u;
    const unsigned char* ibase = (const unsigned char*)(WSP(unsigned short, WS_PEI) + gi * 16);
    const unsigned* pab = WSP(unsigned, WS_PA) + lane;
    const float* pegb = WSP(float, WS_PEG) + gi * 16 + j0;
    const int eoff = slice * 128 + sub * 16 + gi;
    float* xsb = WSP(float, WS_XS) + eoff;
    int t = first; if (t >= MTOK) return;
    v4u ia, ib, nia, nib, A[8], B[8];
    unsigned pw[8], npw[8]; float g0, g1, ng0, ng1, x0, x1, nx0, nx1;
#define P9V_META(tt, xa, xb, pp, ga, gb, ya, yb) do { const v4u* ip_ = (const v4u*)(ibase + (size_t)(tt) * 256); xa = ip_[0]; xb = ip_[1]; \
        _Pragma("unroll") for (int x_ = 0; x_ < 8; ++x_) pp[x_] = pab[(size_t)(tt) * 512 + x_ * 64]; \
        ga = pegb[(size_t)(tt) * 128]; gb = pegb[(size_t)(tt) * 128 + 4]; ya = xsb[(size_t)(tt) * DM]; yb = xsb[(size_t)(tt) * DM + 8]; } while (0)
    P9V_META(t, ia, ib, pw, g0, g1, x0, x1);
    P9_GATHER(A, ia);
#pragma unroll 1
    for (;;) {
        const int tn = t + stride; const bool more = tn < MTOK; const int tl = more ? tn : t;
        P9V_META(tl, nia, nib, npw, ng0, ng1, nx0, nx1);
        P9_GATHER(B, ib);
        float alo = 0.f, ahi = 0.f;
#pragma unroll
        for (int x = 0; x < 8; ++x) { alo += bflo(pw[x]); ahi += bfhi(pw[x]); }
        const float c0 = gelu_tanh(alo * 0.03125f) * g0 * 0.0625f, c1 = gelu_tanh(ahi * 0.03125f) * g1 * 0.0625f;
        f32x2 o[8];
#pragma unroll
        for (int i = 0; i < 8; ++i) o[i] = (f32x2){0.f, 0.f};
#define P9V_C(j) __builtin_bit_cast(float, __builtin_amdgcn_ds_swizzle(__builtin_bit_cast(int, (((j) >> 2) & 1) ? c1 : c0), ((4 * ((j) >> 3) + ((j) & 3)) << 5) | 0x18))
        { const float cj[8] = {P9V_C(0), P9V_C(1), P9V_C(2), P9V_C(3), P9V_C(4), P9V_C(5), P9V_C(6), P9V_C(7)};
#pragma unroll
          for (int j = 0; j < 8; ++j) p9_axpy16(A[j], cj[j], o); }
        P9_GATHER(A, nia);
        { const float cj[8] = {P9V_C(8), P9V_C(9), P9V_C(10), P9V_C(11), P9V_C(12), P9V_C(13), P9V_C(14), P9V_C(15)};
#pragma unroll
          for (int j = 0; j < 8; ++j) p9_axpy16(B[j], cj[j], o); }
#undef P9V_C
        const bool g0b = lane & 8;
        float q[8], r[4], sv[2];
#pragma unroll
        for (int i = 0; i < 8; ++i) { const float keep = g0b ? o[i].y : o[i].x, send = g0b ? o[i].x : o[i].y; q[i] = keep + dpp_f<DPP_ROR8>(send); }
#pragma unroll
        for (int i = 0; i < 4; ++i) r[i] = swapsum16(q[2 * i], q[2 * i + 1]);
#pragma unroll
        for (int i = 0; i < 2; ++i) sv[i] = swapsum32(r[2 * i], r[2 * i + 1]);
        const float y0 = x0 + sv[0], y1 = x1 + sv[1];
        if (mode == 0) {
            float* xs = xsb + (size_t)t * DM; xs[0] = y0; xs[8] = y1;
            bf16* xn = WSP(bf16, WS_XNA) + (size_t)t * DM + eoff; xn[0] = (bf16)f2bf(y0); xn[8] = (bf16)f2bf(y1);
            const float ss = wave_sum(y0 * y0 + y1 * y1);
            if (lane == 0) WSP(float, WS_SSQ)[(size_t)t * 8 + slice] = ss;
        } else {
            float* y = (t < MP ? F.out + O_YP + (size_t)t * DM : F.out + O_YS + (size_t)(t - MP) * DM) + eoff;
            y[0] = y0; y[8] = y1;
        }
        if (!more) break;
        t = tn; ia = nia; ib = nib; g0 = ng0; g1 = ng1; x0 = nx0; x1 = nx1;
#pragma unroll
        for (int x = 0; x < 8; ++x) pw[x] = npw[x];
    }
#undef P9V_META
}
#undef P9_GATHER

__device__ __forceinline__ void glds16_asm(const void* g, unsigned lds_base) {
    unsigned sv; asm volatile("s_mov_b32 %0, m0\n\ts_mov_b32 m0, %2\n\ts_nop 0\n\tglobal_load_lds_dwordx4 %1, off\n\ts_mov_b32 m0, %0" : "=&s"(sv) : "v"(g), "s"(lds_base) : "memory"); }
constexpr int PV_TILE = 16384, PV_CB = 8 * PV_TILE;
typedef short s16x4 __attribute__((ext_vector_type(4)));
struct P9M { v4u ia, ib; unsigned pw[8]; float g0, g1; f32x2 x; };
#define P9V2_ALD(dst, ptr, off) asm volatile("global_load_dword %0, %1, off offset:" #off : "=v"(dst) : "v"(ptr) : "memory")
#define P9V2_LAUNDER(M) "+v"(M.ia), "+v"(M.ib), "+v"(M.pw[0]), "+v"(M.pw[1]), "+v"(M.pw[2]), "+v"(M.pw[3]), "+v"(M.pw[4]), "+v"(M.pw[5]), "+v"(M.pw[6]), "+v"(M.pw[7]), "+v"(M.g0), "+v"(M.g1), "+v"(M.x)
__device__ __forceinline__ void p9v2_wave(Frame& F, int layer, int slice, int first, int stride, int mode) {
    int lane_ = F.lane; asm volatile("" : "+v"(lane_));
    const int lane = lane_, gi = lane >> 3, sub = lane & 7, j0 = 8 * (sub >> 2) + (sub & 3), fr = lane & 15, fq = lane >> 4;
    const unsigned char* tab = WSP(unsigned char, WS_PV) + (size_t)(layer * 8 + slice) * PE_SLICE_BYTES;
    const unsigned sub16 = (unsigned)sub * 16u;
    LAS unsigned char* Tu = F.lds + F.wave * PV_TILE;
    LAS unsigned char* Tl = Tu + (4 * fq + (fr >> 2)) * 128 + 8 * (fr & 3);
    LAS unsigned char* Cb = F.lds + PV_CB + F.wave * 128;
    const unsigned char* ibase = (const unsigned char*)(WSP(unsigned short, WS_PEI) + gi * 16);
    const unsigned* pab = WSP(unsigned, WS_PA) + lane;
    const float* pegb = WSP(float, WS_PEG) + gi * 16 + j0;
    const int eoff = slice * 128 + 32 * fq + 2 * fr;
    float* xsb = WSP(float, WS_XS) + eoff;
    int t = first; if (t >= MTOK) return;
    P9M C, N1, N2;
#define P9V2_META(M, tt) do { const unsigned char* ip_ = ibase + (size_t)(tt) * 256; const unsigned* pp_ = pab + (size_t)(tt) * 512; const float* gp_ = pegb + (size_t)(tt) * 128; const float* xp_ = xsb + (size_t)(tt) * DM; \
        asm volatile("global_load_dwordx4 %0, %1, off" : "=v"(M.ia) : "v"(ip_) : "memory"); asm volatile("global_load_dwordx4 %0, %1, off offset:16" : "=v"(M.ib) : "v"(ip_) : "memory"); \
        P9V2_ALD(M.pw[0], pp_, 0); P9V2_ALD(M.pw[1], pp_, 256); P9V2_ALD(M.pw[2], pp_, 512); P9V2_ALD(M.pw[3], pp_, 768); P9V2_ALD(M.pw[4], pp_, 1024); P9V2_ALD(M.pw[5], pp_, 1280); P9V2_ALD(M.pw[6], pp_, 1536); P9V2_ALD(M.pw[7], pp_, 1792); \
        P9V2_ALD(M.g0, gp_, 0); P9V2_ALD(M.g1, gp_, 16); asm volatile("global_load_dwordx2 %0, %1, off" : "=v"(M.x) : "v"(xp_) : "memory"); } while (0)
#define P9V2_DMA2(ks, M) do { const unsigned w_ = (ks) < 4 ? M.ia[(ks) & 3] : M.ib[(ks) & 3]; \
        glds16_asm(tab + (((w_ & 0xffffu) << 7) + sub16), tu + (unsigned)((2 * (ks)) * 1024)); glds16_asm(tab + (((w_ >> 16) << 7) + sub16), tu + (unsigned)((2 * (ks) + 1) * 1024)); } while (0)
#define P9V2_MM(ks) do { const unsigned cw_ = *(const LAS unsigned*)(Cb + 16 * (ks) + 4 * fq); \
        const long ae_ = __builtin_bit_cast(long, (v2u){__builtin_amdgcn_perm(0u, cw_, 0x0c010c00u), __builtin_amdgcn_perm(0u, cw_, 0x0c030c02u)}); \
        const long ao_ = __builtin_bit_cast(long, (v2u){__builtin_amdgcn_perm(0u, cw_, 0x010c000cu), __builtin_amdgcn_perm(0u, cw_, 0x030c020cu)}); \
        _Pragma("unroll") for (int nt_ = 0; nt_ < 4; ++nt_) { const long b_ = __builtin_bit_cast(long, __builtin_amdgcn_ds_read_tr16_b64_v4i16((LAS s16x4*)(Tl + (ks) * 2048 + nt_ * 32))); \
            acc_e[nt_] = __builtin_amdgcn_mfma_f32_16x16x32_fp8_fp8(ae_, b_, acc_e[nt_], 0, 0, 0); acc_o[nt_] = __builtin_amdgcn_mfma_f32_16x16x32_fp8_fp8(ao_, b_, acc_o[nt_], 0, 0, 0); } } while (0)
#define P9V2_STEP(ks, NXT) do { asm volatile("s_waitcnt vmcnt(27)" ::: "memory"); P9V2_MM(ks); asm volatile("s_waitcnt lgkmcnt(0)" ::: "memory"); P9V2_DMA2(ks, NXT); } while (0)
    const unsigned tu = __builtin_amdgcn_readfirstlane((unsigned)(size_t)Tu);
    bool more = false; int tn = 0;
#define P9V2_UNIT(CUR, NXT, NN) do { \
        tn = t + stride; more = tn < MTOK; const int t2_ = tn + stride < MTOK ? tn + stride : (more ? tn : t);        \
        P9V2_META(NN, t2_);                   \
        float alo_ = 0.f, ahi_ = 0.f; \
        _Pragma("unroll") for (int x_ = 0; x_ < 8; ++x_) { alo_ += bflo(CUR.pw[x_]); ahi_ += bfhi(CUR.pw[x_]); } \
        const float c0_ = gelu_tanh(alo_ * 0.03125f) * CUR.g0 * 0.0625f, c1_ = gelu_tanh(ahi_ * 0.03125f) * CUR.g1 * 0.0625f;        \
        { const int pk_ = __builtin_amdgcn_cvt_pk_fp8_f32(c0_ * 256.f, c1_ * 256.f, 0, false); Cb[8 * j0 + gi] = (unsigned char)(pk_ & 255); Cb[8 * (j0 + 4) + gi] = (unsigned char)((pk_ >> 8) & 255); } \
        f32x4 acc_e[4], acc_o[4]; \
        _Pragma("unroll") for (int i_ = 0; i_ < 4; ++i_) { acc_e[i_] = (f32x4){0.f, 0.f, 0.f, 0.f}; acc_o[i_] = (f32x4){0.f, 0.f, 0.f, 0.f}; } \
        asm volatile("s_waitcnt vmcnt(27)" : P9V2_LAUNDER(NXT) :: "memory");        \
        P9V2_MM(0); asm volatile("s_waitcnt lgkmcnt(0)" ::: "memory"); P9V2_DMA2(0, NXT); \
        P9V2_STEP(1, NXT); P9V2_STEP(2, NXT); P9V2_STEP(3, NXT); P9V2_STEP(4, NXT); P9V2_STEP(5, NXT); P9V2_STEP(6, NXT); P9V2_STEP(7, NXT); \
        const f32x4 se_ = fq == 0 ? acc_e[0] : fq == 1 ? acc_e[1] : fq == 2 ? acc_e[2] : acc_e[3], so_ = fq == 0 ? acc_o[0] : fq == 1 ? acc_o[1] : fq == 2 ? acc_o[2] : acc_o[3]; \
        const float y0_ = CUR.x.x + se_[0] * (1.f / 256.f), y1_ = CUR.x.y + so_[0] * (1.f / 256.f); \
        if (mode == 0) { \
            *(f32x2*)(xsb + (size_t)t * DM) = (f32x2){y0_, y1_}; \
            *(unsigned*)(WSP(bf16, WS_XNA) + (size_t)t * DM + eoff) = pk2(y0_, y1_); \
            const float ss_ = wave_sum(y0_ * y0_ + y1_ * y1_); \
            if (lane == 0) WSP(float, WS_SSQ)[(size_t)t * 8 + slice] = ss_; \
        } else { \
            float* y_ = (t < MP ? F.out + O_YP + (size_t)t * DM : F.out + O_YS + (size_t)(t - MP) * DM) + eoff; \
            *(f32x2*)y_ = (f32x2){y0_, y1_}; \
        } \
    } while (0)
    P9V2_META(C, t);
    { const int t1 = t + stride < MTOK ? t + stride : t; P9V2_META(N1, t1); }
    asm volatile("s_waitcnt vmcnt(13)" : P9V2_LAUNDER(C) :: "memory");
    P9V2_DMA2(0, C); P9V2_DMA2(1, C); P9V2_DMA2(2, C); P9V2_DMA2(3, C); P9V2_DMA2(4, C); P9V2_DMA2(5, C); P9V2_DMA2(6, C); P9V2_DMA2(7, C);
#pragma unroll 1
    for (;;) {
        P9V2_UNIT(C, N1, N2); if (!more) break; t = tn;
        P9V2_UNIT(N1, N2, C); if (!more) break; t = tn;
        P9V2_UNIT(N2, C, N1); if (!more) break; t = tn;
    }
    asm volatile("s_waitcnt vmcnt(0)" ::: "memory");
#undef P9V2_UNIT
#undef P9V2_STEP
#undef P9V2_MM
#undef P9V2_DMA2
#undef P9V2_META
}

constexpr float QSCALE = 0.125f * 1.4426950408889634f;
constexpr int PP_VT = 0;
__device__ __forceinline__ float rms64(float v) { return frsq(wave_sum(v * v) * (1.f / 64.f) + EPS); }

__device__ __forceinline__ void pp_q_row(Frame& F, int row, const bf16* kvq, const float qg) {
    const int lane = F.lane;
    bf16* qn = WSP(bf16, WS_QN) + (size_t)row * 1024;
#pragma unroll 4
    for (int hd = 0; hd < 16; ++hd) { const float v = bf2f(kvq[NKV + hd * 64 + lane]); qn[hd * 64 + lane] = (bf16)f2bf(v * rms64(v) * qg); }
    if (lane < 48) WSP(float, WS_GATES)[(size_t)row * 48 + lane] = sigmoid_f(bf2f(kvq[NKV + 1024 + lane]));
}
__device__ __forceinline__ f32x4 rms64x4(f32x4 v) { const float ss = row_sum16((v.x * v.x + v.y * v.y) + (v.z * v.z + v.w * v.w)); return v * (frsq(ss * (1.f / 64.f) + EPS)); }
__device__ __forceinline__ v2u pk4(f32x4 v) { return (v2u){pk2(v.x, v.y), pk2(v.z, v.w)}; }
__device__ __forceinline__ void pp_prompt_tile(Frame& F, int unit) {
    const int lane = F.lane, w = F.wave, b = unit >> 7, t0 = (unit & 127) * 64, g = lane >> 4, d4 = (lane & 15) * 4;
    LAS unsigned char* L = F.lds; asm volatile("" : "+v"(L));
    LAS bf16* vt = (LAS bf16*)(L + PP_VT);
    const f32x4 kg1 = *(const f32x4*)(FIN(16) + 64 + d4), kg2 = *(const f32x4*)(FIN(16) + 128 + d4), qg = *(const f32x4*)(FIN(22) + d4) * QSCALE;
    v2u nv[6], nq[4], ngl;
#define PP_FETCH(rr_) do { const int row_ = b * PT + t0 + 8 * w + ((rr_) < 8 ? (rr_) : 7); const v2u* kvq_ = (const v2u*)(WSP(bf16, WS_KVQ) + (size_t)row_ * NKVQ) + lane;        \
        _Pragma("unroll") for (int sidx_ = 0; sidx_ < 6; ++sidx_) nv[sidx_] = kvq_[64 * sidx_]; \
        _Pragma("unroll") for (int i_ = 0; i_ < 4; ++i_) nq[i_] = kvq_[64 * (6 + i_)]; \
        ngl = ((const v2u*)(WSP(bf16, WS_KVQ) + (size_t)row_ * NKVQ))[640 + (lane & 15)]; } while (0)
    PP_FETCH(0);
#pragma unroll 1
    for (int rr = 0; rr < 8; ++rr) {
        const int tl = 8 * w + rr, t = t0 + tl, row = b * PT + t;
        f32x4 v[6], q[4]; const f32x4 gl = {bflo(ngl.x), bfhi(ngl.x), bflo(ngl.y), bfhi(ngl.y)};
#pragma unroll
        for (int sidx = 0; sidx < 6; ++sidx) v[sidx] = (f32x4){bflo(nv[sidx].x), bfhi(nv[sidx].x), bflo(nv[sidx].y), bfhi(nv[sidx].y)};
#pragma unroll
        for (int i = 0; i < 4; ++i) q[i] = (f32x4){bflo(nq[i].x), bfhi(nq[i].x), bflo(nq[i].y), bfhi(nq[i].y)};
        PP_FETCH(rr + 1);
        const f32x4 ks = rms64x4(v[2]) * kg1, kw = rms64x4(v[4]) * kg2;
        f32x4* okv = (f32x4*)(F.out + O_KVP + (size_t)row * 1024) + lane;
        okv[0] = v[0]; okv[64] = v[1]; okv[128] = ks; okv[192] = v[3];
        if (t >= PT - WINDOW) { f32x4* owin = (f32x4*)(F.out + O_WINP + ((size_t)b * 512 + (t - (PT - WINDOW))) * 512) + lane; owin[0] = kw; owin[64] = v[5]; }
        const size_t kidx = (((size_t)b * NG + g) * PT + t) * 64 + d4;
        *(v2u*)(WSP(bf16, WS_KSEL) + kidx) = pk4(ks); *(v2u*)(WSP(bf16, WS_KWIN) + kidx) = pk4(kw);
#pragma unroll
        for (int j = 0; j < 4; ++j) { vt[((0 * 4 + g) * 64 + d4 + j) * 72 + tl] = (bf16)f2bf(v[3][j]); vt[((1 * 4 + g) * 64 + d4 + j) * 72 + tl] = (bf16)f2bf(v[5][j]); }
        bf16* qn = WSP(bf16, WS_QN) + (size_t)row * 1024 + g * 64 + d4;
#pragma unroll
        for (int i = 0; i < 4; ++i) *(v2u*)(qn + i * 256) = pk4(rms64x4(q[i]) * qg);
        if (lane < 12) *(f32x4*)(WSP(float, WS_GATES) + (size_t)row * 48 + 4 * lane) = (f32x4){sigmoid_f(gl.x), sigmoid_f(gl.y), sigmoid_f(gl.z), sigmoid_f(gl.w)};
    }
#undef PP_FETCH
    __syncthreads();
    {
        const int which = F.tid >> 8, gd = F.tid & 255;
        bf16* dst = WSP(bf16, which == 0 ? WS_VSELT : WS_VWINT) + (((size_t)b * NG * 64 + gd) * PT + t0);
        const LAS bf16* src = vt + ((which * 256 + gd) * 72);
#pragma unroll
        for (int i = 0; i < 8; ++i) *(v4u*)(dst + 8 * i) = *(const LAS v4u*)(src + 8 * i);
    }
    __syncthreads();
}
__device__ __forceinline__ void pp_sample_row(Frame& F, int sr, int part = -1) {
    const int lane = F.lane, bs = sr >> 2, i = sr & 3, row = MP + sr;
    const float kg1 = FIN(16)[64 + lane], kg2 = FIN(16)[128 + lane], qg = FIN(22)[lane] * QSCALE;
    const bf16* kvq = WSP(bf16, WS_KVQ) + (size_t)row * NKVQ;
    float* okv = F.out + O_KVS + (size_t)sr * 1024;
    float* owin = F.out + O_WINS + ((size_t)bs * 512 + 508 + i) * 512;
#pragma unroll
    for (int g = 0; g < 4; ++g) { if (part >= 0 && part != g) continue;
        const float v0 = bf2f(kvq[0 * 256 + g * 64 + lane]), v1 = bf2f(kvq[1 * 256 + g * 64 + lane]), v2 = bf2f(kvq[2 * 256 + g * 64 + lane]);
        const float v3 = bf2f(kvq[3 * 256 + g * 64 + lane]), v4 = bf2f(kvq[4 * 256 + g * 64 + lane]), v5 = bf2f(kvq[5 * 256 + g * 64 + lane]);
        const float ks = v2 * rms64(v2) * kg1, kw = v4 * rms64(v4) * kg2;
        okv[0 * 256 + g * 64 + lane] = v0; okv[1 * 256 + g * 64 + lane] = v1; okv[2 * 256 + g * 64 + lane] = ks; okv[3 * 256 + g * 64 + lane] = v3;
        owin[g * 64 + lane] = kw; owin[256 + g * 64 + lane] = v5;
        const size_t bg = (size_t)bs * NG + g;
        WSP(bf16, WS_SKWIN)[(bg * 544 + 512 + i) * 64 + lane] = (bf16)f2bf(kw);
        WSP(bf16, WS_SVWINT)[(bg * 64 + lane) * 544 + 512 + i] = (bf16)f2bf(v5);
        float* sn = WSP(float, WS_SNEW) + (((size_t)bs * 4 + i) * 2) * 256 + g * 64 + lane;
        sn[0] = ks; sn[256] = v3;
    }
    bf16* qn = WSP(bf16, WS_QN) + (size_t)row * 1024;
#pragma unroll 4
    for (int hd = 0; hd < 16; ++hd) { if (part >= 0 && (hd >> 2) != part - 4) continue; const float v = bf2f(kvq[NKV + hd * 64 + lane]); qn[hd * 64 + lane] = (bf16)f2bf(v * rms64(v) * qg); }
    if ((part < 0 || part == 7) && lane < 48) WSP(float, WS_GATES)[(size_t)row * 48 + lane] = sigmoid_f(bf2f(kvq[NKV + 1024 + lane]));
}

struct RowPPrompt { static constexpr bool BF = true; const bf16* base; __device__ __forceinline__ const bf16* operator()(int t) const { return base + (size_t)t * NKVQ; } };
struct RowPSample { static constexpr bool BF = false; const float* cache; const int* pt; __device__ __forceinline__ const float* operator()(int t) const { return cache + ((size_t)pt[t >> 7] * PAGE + (t & 127)) * 1024; } };
template <class RowP> __device__ __forceinline__ bf16x8 rowp_frag(const RowP& rowp, int t, int off) {
    if constexpr (RowP::BF) return ld8(rowp(t) + off);
    else { const float* rp = rowp(t) + off; return cvt8(*(const f32x4*)rp, *(const f32x4*)(rp + 4)); }
}
__device__ __forceinline__ void compress_finish(Frame& F, const f32x4 (&acc)[4], int kv, int blk, bf16* KC, bf16* VCT) {
    const int lane = F.lane, fr = lane & 15, fq = lane >> 4;
    const float* pet = WSP(float, WS_PETERM) + kv * 64;
    bf16x8 hb[2];
#pragma unroll
    for (int s = 0; s < 2; ++s) { f32x4 h0, h1;
#pragma unroll
        for (int r = 0; r < 4; ++r) { h0[r] = gelu_tanh(acc[2 * s][r] + pet[16 * (2 * s) + 4 * fq + r]); h1[r] = gelu_tanh(acc[2 * s + 1][r] + pet[16 * (2 * s + 1) + 4 * fq + r]); }
        hb[s] = cvt8(h0, h1); }
    const bf16* w2f = WSP(bf16, WS_W2F) + (size_t)kv * 4096 + lane * 8;
    f32x4 o[4];
#pragma unroll
    for (int dt = 0; dt < 4; ++dt) { o[dt] = (f32x4){0.f, 0.f, 0.f, 0.f};
#pragma unroll
        for (int s = 0; s < 2; ++s) o[dt] = MFMA16(ld8(w2f + (dt * 2 + s) * 512), hb[s], o[dt]); }
    if (kv == 0) {
        float ss = 0.f;
#pragma unroll
        for (int dt = 0; dt < 4; ++dt) ss += (o[dt][0] * o[dt][0] + o[dt][1] * o[dt][1]) + (o[dt][2] * o[dt][2] + o[dt][3] * o[dt][3]);
        ss = x32_sum(x16_sum(ss));
        const float rstd = frsq(ss * (1.f / 64.f) + EPS);
        const float* kg0 = FIN(16);
        if (blk < NCMP) {
#pragma unroll
            for (int dt = 0; dt < 4; ++dt) { const int d = 16 * dt + 4 * fq; v2u ov; ov.x = pk2(o[dt][0] * rstd * kg0[d], o[dt][1] * rstd * kg0[d + 1]); ov.y = pk2(o[dt][2] * rstd * kg0[d + 2], o[dt][3] * rstd * kg0[d + 3]);
                *(v2u*)(KC + (size_t)blk * 64 + d) = ov; }
        } else {
#pragma unroll
            for (int dt = 0; dt < 4; ++dt) *(v2u*)(KC + (size_t)blk * 64 + 16 * dt + 4 * fq) = (v2u){0u, 0u};
        }
    } else {
#pragma unroll
        for (int dt = 0; dt < 4; ++dt)
#pragma unroll
            for (int r = 0; r < 4; ++r) VCT[(size_t)(16 * dt + 4 * fq + r) * 512 + blk] = (blk < NCMP) ? (bf16)f2bf(o[dt][r]) : (bf16)0;
    }
}

template <class RowP>
__device__ __forceinline__ void compress_part(Frame& F, const RowP& rowp, int kv, int j, int r_lo, int r_hi, f32x4 (&acc)[4]) {
    const int lane = F.lane, fr = lane & 15, fq = lane >> 4;
    const bf16* W1 = WSP(bf16, WS_W1T) + (size_t)kv * 64 * 2048 + (size_t)fr * 2048 + 8 * fq;
    const int blk = 16 * j + fr;
#pragma unroll
    for (int mt = 0; mt < 4; ++mt) acc[mt] = (f32x4){0.f, 0.f, 0.f, 0.f};
#pragma unroll 2
    for (int r = r_lo; r < r_hi; ++r) {
        int t = 16 * blk + r; t = t < PAST ? t : PAST - 1;
#pragma unroll
        for (int hf = 0; hf < 2; ++hf) {
            const bf16x8 bfrag = rowp_frag(rowp, t, 8 * fq + 32 * hf);
            const int ks = 2 * r + hf;
#pragma unroll
            for (int mt = 0; mt < 4; ++mt) acc[mt] = MFMA16(ld8(W1 + (size_t)mt * 16 * 2048 + 32 * ks), bfrag, acc[mt]);
        }
    }
}
template <class RowP>
__device__ __forceinline__ void compress_tile(Frame& F, const RowP& rowp, int kv, int j, bf16* KC, bf16* VCT) {
    const int lane = F.lane, fr = lane & 15, fq = lane >> 4;
    const bf16* W1 = WSP(bf16, WS_W1T) + (size_t)kv * 64 * 2048 + (size_t)fr * 2048 + 8 * fq;
    const int blk = 16 * j + fr;
    f32x4 acc[4];
#pragma unroll
    for (int mt = 0; mt < 4; ++mt) acc[mt] = (f32x4){0.f, 0.f, 0.f, 0.f};
#pragma unroll 2
    for (int r = 0; r < 32; ++r) {
        int t = 16 * blk + r; t = t < PAST ? t : PAST - 1;
#pragma unroll
        for (int hf = 0; hf < 2; ++hf) {
            const bf16x8 bfrag = rowp_frag(rowp, t, 8 * fq + 32 * hf);
            const int ks = 2 * r + hf;
#pragma unroll
            for (int mt = 0; mt < 4; ++mt) acc[mt] = MFMA16(ld8(W1 + (size_t)mt * 16 * 2048 + 32 * ks), bfrag, acc[mt]);
        }
    }
    compress_finish(F, acc, kv, blk, KC, VCT);
}


__device__ __forceinline__ void compress_prompt(Frame& F, int id) {
    const int kv = id & 1, j = (id >> 1) & 31, bg = id >> 6, b = bg >> 2, g = bg & 3;
    RowPPrompt rp{WSP(bf16, WS_KVQ) + (size_t)b * PT * NKVQ + kv * 256 + g * 64};
    compress_tile(F, rp, kv, j, WSP(bf16, WS_KCMP) + (size_t)bg * 512 * 64, WSP(bf16, WS_VCMPT) + (size_t)bg * 64 * 512);
}
constexpr int CP_PART = 81920;
__device__ __forceinline__ void compress_prompt_split(Frame& F, int id) {
    const int kv = id & 1, j = (id >> 1) & 31, bg = id >> 6, b = bg >> 2, g = bg & 3, q = F.wave & 3, lane = F.lane;
    RowPPrompt rp{WSP(bf16, WS_KVQ) + (size_t)b * PT * NKVQ + kv * 256 + g * 64};
    f32x4 acc[4];
    compress_part(F, rp, kv, j, 8 * q, 8 * q + 8, acc);
    LAS f32x4* part = (LAS f32x4*)(F.lds + CP_PART) + (F.wave >> 2) * 1024;
#pragma unroll
    for (int mt = 0; mt < 4; ++mt) part[(q * 4 + mt) * 64 + lane] = acc[mt];
    __syncthreads();
    if (q == 0) {
#pragma unroll
        for (int mt = 0; mt < 4; ++mt) acc[mt] = (part[(0 * 4 + mt) * 64 + lane] + part[(1 * 4 + mt) * 64 + lane]) + (part[(2 * 4 + mt) * 64 + lane] + part[(3 * 4 + mt) * 64 + lane]);
        compress_finish(F, acc, kv, 16 * j + (lane & 15), WSP(bf16, WS_KCMP) + (size_t)bg * 512 * 64, WSP(bf16, WS_VCMPT) + (size_t)bg * 64 * 512);
    }
    __syncthreads();
}
__device__ __forceinline__ void compress_sample(Frame& F, int id) {
    const int kv = id & 1, j = (id >> 1) & 31, bg = id >> 6, lane = F.lane, fr = lane & 15, fq = lane >> 4;
    const int blk = 16 * j + fr, nb = blk < 511 ? blk + 1 : 511;
    const bf16* f1 = WSP(bf16, WS_FS) + ((size_t)bg * 512 + blk) * 256 + kv * 128 + 4 * fq;
    const bf16* f2 = WSP(bf16, WS_FS) + ((size_t)bg * 512 + nb) * 256 + kv * 128 + 64 + 4 * fq;
    f32x4 acc[4];
#pragma unroll
    for (int mt = 0; mt < 4; ++mt) { const v2u a = *(const v2u*)(f1 + 16 * mt), b = *(const v2u*)(f2 + 16 * mt);
        acc[mt] = (f32x4){bflo(a.x) + bflo(b.x), bfhi(a.x) + bfhi(b.x), bflo(a.y) + bflo(b.y), bfhi(a.y) + bfhi(b.y)}; }
    compress_finish(F, acc, kv, blk, WSP(bf16, WS_SKCMP) + (size_t)bg * 512 * 64, WSP(bf16, WS_SVCMPT) + (size_t)bg * 64 * 512);
}

constexpr int NSA_IMP = 0;
constexpr int NSA_Q = 67584;
constexpr int NSA_QLD = 68;
constexpr float LOG2E = 1.4426950408889634f;
#ifndef NSA_SUBUNITS
#define NSA_SUBUNITS 0
#endif
__device__ __forceinline__ float ex2(float x) { return __builtin_amdgcn_exp2f(x); }

struct KvBf16 {
    const bf16* K; const bf16* VT; int ld;
    __device__ __forceinline__ void lane_offsets(int fr, int fq, unsigned& ko, unsigned& vo) const {
        ko = (unsigned)(((8 * (fr >> 2) + (fr & 3)) * 64 + 8 * fq) * 2); vo = (unsigned)((fr * ld + 8 * fq) * 2);
        asm volatile("" : "+v"(ko), "+v"(vo));
    }
    __device__ __forceinline__ bf16x8 kf(int key0, int mt, int ks, unsigned ko) const {
        return *(const bf16x8*)((const char*)K + (size_t)key0 * 128 + (ko + (unsigned)((4 * mt * 64 + 32 * ks) * 2))); }
    __device__ __forceinline__ bf16x8 vf(int key0, int dt, unsigned vo) const {
        return *(const bf16x8*)((const char*)VT + (size_t)key0 * 2 + (vo + (unsigned)(16 * dt * ld * 2))); }
};
struct KvSampleSel {
    const float* cache; const int* pt; const float* snew; int g;
    __device__ __forceinline__ const float* krow(int pos, int slot) const {
        if (pos < PAST) return cache + ((size_t)pt[pos >> 7] * PAGE + (pos & 127)) * 1024 + slot * 256;
        int i = pos - PAST; i = i < 3 ? i : 3; return snew + (size_t)i * 512 + (slot - 2) * 256; }
    __device__ __forceinline__ void lane_offsets(int fr, int fq, unsigned& ko, unsigned& vo) const { ko = (unsigned)(fr | (fq << 8)); vo = ko; asm volatile("" : "+v"(ko), "+v"(vo)); }
    __device__ __forceinline__ bf16x8 kf(int key0, int mt, int ks, unsigned ko) const { const int fr = ko & 255, fq = ko >> 8;
        const float* p = krow(key0 + 8 * (fr >> 2) + 4 * mt + (fr & 3), 2) + 32 * ks + 8 * fq; return cvt8(*(const f32x4*)p, *(const f32x4*)(p + 4)); }
    __device__ __forceinline__ bf16x8 vf(int key0, int dt, unsigned vo) const { const int fr = vo & 255, fq = vo >> 8; f32x4 a, b;
#pragma unroll
        for (int j = 0; j < 4; ++j) { a[j] = krow(key0 + 8 * fq + j, 3)[16 * dt + fr]; b[j] = krow(key0 + 8 * fq + 4 + j, 3)[16 * dt + fr]; }
        return cvt8(a, b); }
};
struct KvFrags { bf16x8 k[2][2]; bf16x8 v[4]; };
template <bool WITHV, class KV>
__device__ __forceinline__ void nsa_load(const KV& kv, int key0, int fr, int fq, KvFrags& f) {
    unsigned ko, vo; kv.lane_offsets(fr, fq, ko, vo);
#pragma unroll
    for (int mt = 0; mt < 2; ++mt)
#pragma unroll
        for (int ks = 0; ks < 2; ++ks) f.k[mt][ks] = kv.kf(key0, mt, ks, ko);
    if (WITHV) {
#pragma unroll
        for (int dt = 0; dt < 4; ++dt) f.v[dt] = kv.vf(key0, dt, vo);
    }
}

template <int NT, int MODE, bool QREG = false>
__device__ __forceinline__ void nsa_core(const KvFrags& f, int key0, const LAS bf16* qrow, int qnt, f32x4 (&O)[NT][4], float (&m)[NT], float (&l)[NT], const float (&invl)[NT], const float (&slope)[NT],
                                         int t, int pmul, int padd, int wlim, bool selok, LAS float* improw, int fq, const bf16x8* qreg = nullptr) {
    float dist[2][4]; bool val[2][4];
#pragma unroll
    for (int mt = 0; mt < 2; ++mt)
#pragma unroll
        for (int r = 0; r < 4; ++r) { const int kk = key0 + 8 * fq + 4 * mt + r; const int dd = t - (pmul * kk + padd); val[mt][r] = selok && dd >= 0 && dd < wlim; dist[mt][r] = val[mt][r] ? (float)dd : 1e6f; }
    float imp_main[2] = {0.f, 0.f}, imp_spill[2] = {0.f, 0.f};
    f32x4 sc[NT][2]; bf16x8 pfr[NT];
    __builtin_amdgcn_s_setprio(1);
#pragma unroll
    for (int nt = 0; nt < NT; ++nt) {
        bf16x8 q0, q1; if (QREG) { q0 = qreg[nt * 2]; q1 = qreg[nt * 2 + 1]; } else { q0 = ld8l(qrow + nt * qnt + 8 * fq); q1 = ld8l(qrow + nt * qnt + 32 + 8 * fq); }
#pragma unroll
        for (int mt = 0; mt < 2; ++mt) { sc[nt][mt] = (f32x4){0.f, 0.f, 0.f, 0.f}; sc[nt][mt] = MFMA16(f.k[mt][0], q0, sc[nt][mt]); sc[nt][mt] = MFMA16(f.k[mt][1], q1, sc[nt][mt]); }
    }
    __builtin_amdgcn_s_setprio(0);
#pragma unroll
    for (int nt = 0; nt < NT; ++nt) {
        f32x4 p[2]; float ps = 0.f;
#pragma unroll
        for (int mt = 0; mt < 2; ++mt)
#pragma unroll
            for (int r = 0; r < 4; ++r) { float pv = ex2(sc[nt][mt][r] - slope[nt] * dist[mt][r]); if (MODE == 2) pv *= invl[nt]; p[mt][r] = pv; ps += pv; }
        if (MODE != 2) l[nt] += ps;
        if (MODE == 2) {
#pragma unroll
            for (int mt = 0; mt < 2; ++mt) { imp_main[mt] += (p[mt][0] + p[mt][1]) + (p[mt][2] + p[mt][3]); imp_spill[mt] += p[mt][3]; }
        }
        if (MODE != 1) pfr[nt] = cvt8(p[0], p[1]);
    }
    if (MODE != 1) {
        __builtin_amdgcn_s_setprio(1);
#pragma unroll
        for (int nt = 0; nt < NT; ++nt)
#pragma unroll
            for (int dt = 0; dt < 4; ++dt) O[nt][dt] = MFMA16(f.v[dt], pfr[nt], O[nt][dt]);
        __builtin_amdgcn_s_setprio(0);
    }
    if (MODE == 2) {
#pragma unroll
        for (int mt = 0; mt < 2; ++mt) { const int j = key0 / 4 + 2 * fq + mt;
            __hip_atomic_fetch_add(improw + j, imp_main[mt], __ATOMIC_RELAXED, __HIP_MEMORY_SCOPE_WORKGROUP);
            __hip_atomic_fetch_add(improw + j + 1, imp_spill[mt], __ATOMIC_RELAXED, __HIP_MEMORY_SCOPE_WORKGROUP); }
    }
}
template <int NT, int MODE, class KV>
__device__ __forceinline__ void nsa_tile(const KV& kv, int key0, const LAS bf16* qrow, int qnt, f32x4 (&O)[NT][4], float (&m)[NT], float (&l)[NT], const float (&invl)[NT], const float (&slope)[NT],
                                         int t, int pmul, int padd, int wlim, bool selok, LAS float* improw, int fr, int fq) {
    KvFrags f; nsa_load<MODE != 1>(kv, key0, fr, fq, f);
    nsa_core<NT, MODE>(f, key0, qrow, qnt, O, m, l, invl, slope, t, pmul, padd, wlim, selok, improw, fq);
}

template <int NT>
__device__ __forceinline__ void nsa_zero(f32x4 (&O)[NT][4], float (&m)[NT], float (&l)[NT]) {
#pragma unroll
    for (int nt = 0; nt < NT; ++nt) { m[nt] = -1e30f; l[nt] = 0.f;
#pragma unroll
        for (int dt = 0; dt < 4; ++dt) O[nt][dt] = (f32x4){0.f, 0.f, 0.f, 0.f}; }
}

template <bool SAMPLE>
__device__ __forceinline__ void nsa_unit(Frame& F, int id) {
    constexpr int NT = SAMPLE ? 1 : 4;
    int lane_ = F.lane; asm volatile("" : "+v"(lane_));
    const int lane = lane_, fr = lane & 15, fq = lane >> 4;
    LAS unsigned char* L = F.lds; asm volatile("" : "+v"(L));
    LAS float* imp = (LAS float*)(L + NSA_IMP + F.wave * 8448);
    LAS bf16* qw = (LAS bf16*)(L + NSA_Q + F.wave * 8704);
    int bg, g, t, row, trow, tmax, row0;
    if (SAMPLE) { bg = id; g = id & 3; t = PAST + (fr >> 2); row0 = MP + (id >> 2) * 4; row = row0 + (fr >> 2); trow = fr >> 2; tmax = PAST + 3; }
    else { bg = id >> 9; g = bg & 3; const int tt = id & 511; t = 16 * tt + fr; row0 = (bg >> 2) * PT + 16 * tt; row = row0 + fr; trow = fr; tmax = 16 * tt + 15; }
    {
        const int nrow = SAMPLE ? 16 : 64;
        for (int i = lane; i < nrow * 8; i += 64) { const int rr = i >> 3, c8 = i & 7;
            *(LAS v4u*)(qw + rr * NSA_QLD + 8 * c8) = *(const v4u*)(WSP(bf16, WS_QN) + (size_t)(row0 + (rr >> 2)) * 1024 + (g * 4 + (rr & 3)) * 64 + 8 * c8); }
    }
    float slope[NT]; int hd[NT];
#pragma unroll
    for (int nt = 0; nt < NT; ++nt) { hd[nt] = g * 4 + (SAMPLE ? (fr & 3) : nt); slope[nt] = ex2(-0.5f * (float)(hd[nt] + 1)) * LOG2E; }
    const LAS bf16* qrow = qw + (SAMPLE ? fr : fr * 4) * NSA_QLD; const int qnt = SAMPLE ? 0 : NSA_QLD;
    const float* gates = WSP(float, WS_GATES) + (size_t)row * 48;
    float* oacc = WSP(float, WS_OACC) + (size_t)row * 1024;
    for (int i = lane; i < 16 * 132; i += 64) imp[i] = 0.f;
    LDS_WAIT();
    f32x4 O[NT][4]; float m[NT], l[NT], invl[NT];
    {
        KvBf16 kv{WSP(bf16, SAMPLE ? WS_SKCMP : WS_KCMP) + (size_t)bg * 512 * 64, WSP(bf16, SAMPLE ? WS_SVCMPT : WS_VCMPT) + (size_t)bg * 64 * 512, 512};
        const int cmax = (tmax - 31) >> 4;
        const int ntile = (tmax >= 31) ? ((cmax < 510 ? cmax : 510) / 32 + 1) : 0;
#pragma unroll
        for (int nt = 0; nt < NT; ++nt) invl[nt] = 0.f;
        nsa_zero<NT>(O, m, l);
        { KvFrags fa, fb; if (ntile > 0) nsa_load<false>(kv, 0, fr, fq, fa);
#pragma unroll 1
          for (int tl = 0; tl < ntile; ++tl) { if (tl + 1 < ntile) nsa_load<false>(kv, 32 * (tl + 1), fr, fq, fb);
            nsa_core<NT, 1>(fa, 32 * tl, qrow, qnt, O, m, l, invl, slope, t, 16, 31, 1 << 30, true, imp + trow * 132, fq); fa = fb; } }
#pragma unroll
        for (int nt = 0; nt < NT; ++nt) { float lt = l[nt]; lt = x32_sum(x16_sum(lt)); invl[nt] = lt > 0.f ? 1.f / lt : 0.f; }
        { KvFrags fa, fb; if (ntile > 0) nsa_load<true>(kv, 0, fr, fq, fa);
#pragma unroll 1
          for (int tl = 0; tl < ntile; ++tl) { if (tl + 1 < ntile) nsa_load<true>(kv, 32 * (tl + 1), fr, fq, fb);
            nsa_core<NT, 2>(fa, 32 * tl, qrow, qnt, O, m, l, invl, slope, t, 16, 31, 1 << 30, true, imp + trow * 132, fq); fa = fb; } }
#pragma unroll
        for (int nt = 0; nt < NT; ++nt) { const float gc = gates[0 * 16 + hd[nt]];
#pragma unroll
            for (int dt = 0; dt < 4; ++dt) *(f32x4*)(oacc + hd[nt] * 64 + 16 * dt + 4 * fq) = O[nt][dt] * gc; }
    }
    LDS_WAIT();
    unsigned selm[4] = {0u, 0u, 0u, 0u};
    {
        const int cur = t >> 6;
        if (!SAMPLE) {
            unsigned v[32];
#pragma unroll
            for (int i = 0; i < 32; ++i) { const int j = 32 * fq + i; const bool forced = (j == 0) | (j == cur) | (j == cur - 1);
                const unsigned key = ((f2u(imp[trow * 132 + j]) & ~127u) | (unsigned)(127 - j)) + 128u;
                v[i] = (!forced && j <= cur) ? key : 0u;
                if (forced) selm[fq] |= 1u << i; }
            unsigned fw = selm[0] | selm[1] | selm[2] | selm[3];
            const unsigned w16 = __shfl_xor(fw, 16), w32 = __shfl_xor(fw, 32), w48 = __shfl_xor(fw, 48);
#pragma unroll
            for (int wd = 0; wd < 4; ++wd) selm[wd] = (fq == wd) ? fw : ((fq ^ 1) == wd) ? w16 : ((fq ^ 2) == wd) ? w32 : w48;
            const int nforced = cur >= 2 ? 3 : cur + 1;
#pragma unroll 1
            for (int rd = 0; rd < 15; ++rd) {
                unsigned mx = v[0];
#pragma unroll
                for (int i = 1; i < 32; ++i) mx = mx > v[i] ? mx : v[i];
                mx = x32_umax(x16_umax(mx));
#pragma unroll
                for (int i = 0; i < 32; ++i) v[i] = (v[i] == mx) ? 0u : v[i];
                if (mx != 0u && rd < 16 - nforced) { const int js = 127 - (int)(mx & 127u);
#pragma unroll
                    for (int wd = 0; wd < 4; ++wd) selm[wd] |= ((js >> 5) == wd) ? (1u << (js & 31)) : 0u; }
            }
        } else {
            const int li = (fr & 3) * 4 + fq;
            unsigned v[8];
#pragma unroll
            for (int i = 0; i < 8; ++i) { const int j = li * 8 + i; v[i] = (j >= 1 && j <= 126) ? (((f2u(imp[trow * 132 + j]) & ~127u) | (unsigned)(127 - j)) + 128u) : 0u; }
            selm[0] = 1u; selm[3] = 1u << 31;
#pragma unroll 1
            for (int rd = 0; rd < 13; ++rd) {
                unsigned mx = v[0];
#pragma unroll
                for (int i = 1; i < 8; ++i) mx = mx > v[i] ? mx : v[i];
                { unsigned o = dpp_u<DPP_XOR1>(mx); mx = mx > o ? mx : o; o = dpp_u<DPP_XOR2>(mx); mx = mx > o ? mx : o; mx = x32_umax(x16_umax(mx)); }
#pragma unroll
                for (int i = 0; i < 8; ++i) v[i] = (v[i] == mx) ? 0u : v[i];
                if (mx != 0u) { const int js = 127 - (int)(mx & 127u);
#pragma unroll
                    for (int wd = 0; wd < 4; ++wd) selm[wd] |= ((js >> 5) == wd) ? (1u << (js & 31)) : 0u; }
            }
        }
    }
    if (SAMPLE || !NSA_SUBUNITS) {
        nsa_zero<NT>(O, m, l);
        unsigned un[4];
#pragma unroll
        for (int wd = 0; wd < 4; ++wd) { unsigned x = selm[wd]; x |= __shfl_xor(x, 1); x |= __shfl_xor(x, 2); x |= __shfl_xor(x, 4); x |= __shfl_xor(x, 8); un[wd] = (unsigned)__builtin_amdgcn_readfirstlane((int)x); }
        KvSampleSel kvs{FIN(2) + g * 64, (const int*)FIN(6) + (SAMPLE ? (id >> 2) : 0) * NPAGES, WSP(float, WS_SNEW) + (size_t)(SAMPLE ? (id >> 2) : 0) * 2048 + g * 64, g};
        KvBf16 kvp{WSP(bf16, WS_KSEL) + (size_t)bg * PT * 64, WSP(bf16, WS_VSELT) + (size_t)bg * 64 * PT, PT};
        if (SAMPLE) {
#pragma unroll 1
        for (int wd = 0; wd < 4; ++wd) {
            unsigned mm = un[wd];
            const unsigned mine = wd == 0 ? selm[0] : wd == 1 ? selm[1] : wd == 2 ? selm[2] : selm[3];
            while (mm) {
                const int bit = __builtin_ctz(mm); mm &= mm - 1u; const int j = 32 * wd + bit;
                const bool ok = (mine >> bit) & 1u;
#pragma unroll 1
                for (int hh = 0; hh < 2; ++hh) { nsa_tile<NT, 0>(kvs, 64 * j + 32 * hh, qrow, qnt, O, m, l, invl, slope, t, 1, 0, 1 << 30, ok, imp, fr, fq); __builtin_amdgcn_sched_barrier(0); }
            }
        }
        } else {
            int wdc = 0; unsigned mmc = un[0];
            while (wdc < 3 && mmc == 0u) { ++wdc; mmc = wdc == 1 ? un[1] : wdc == 2 ? un[2] : un[3]; }
            KvFrags fa, fb; int jc = -1, hc = 0;
            if (mmc) { jc = 32 * wdc + __builtin_ctz(mmc); mmc &= mmc - 1u; nsa_load<true>(kvp, 64 * jc, fr, fq, fa); }
#pragma unroll 1
            while (jc >= 0) {
                int jn = jc, hn = hc + 1;
                if (hn == 2) { hn = 0;
                    while (wdc < 3 && mmc == 0u) { ++wdc; mmc = wdc == 1 ? un[1] : wdc == 2 ? un[2] : un[3]; }
                    if (mmc) { jn = 32 * wdc + __builtin_ctz(mmc); mmc &= mmc - 1u; } else jn = -1; }
                if (jn >= 0) nsa_load<true>(kvp, 64 * jn + 32 * hn, fr, fq, fb);
                const int wj = jc >> 5, bj = jc & 31;
                const unsigned mine = wj == 0 ? selm[0] : wj == 1 ? selm[1] : wj == 2 ? selm[2] : selm[3];
                nsa_core<NT, 0>(fa, 64 * jc + 32 * hc, qrow, qnt, O, m, l, invl, slope, t, 1, 0, 1 << 30, (mine >> bj) & 1u, imp, fq);
                fa = fb; jc = jn; hc = hn;
            }
        }
        if (SAMPLE) nsa_tile<NT, 0>(kvs, 64 * 128, qrow, qnt, O, m, l, invl, slope, t, 1, 0, 1 << 30, true, imp, fr, fq);
#pragma unroll
        for (int nt = 0; nt < NT; ++nt) { float lt = l[nt]; lt = x32_sum(x16_sum(lt)); const float sc = gates[1 * 16 + hd[nt]] / fmaxf(lt, 1e-30f);
#pragma unroll
            for (int dt = 0; dt < 4; ++dt) { f32x4* o = (f32x4*)(oacc + hd[nt] * 64 + 16 * dt + 4 * fq); *o = *o + O[nt][dt] * sc; } }
    } else {
        unsigned ms[4][4];
#pragma unroll
        for (int s = 0; s < 4; ++s)
#pragma unroll
            for (int wd = 0; wd < 4; ++wd) ms[s][wd] = __shfl(selm[wd], 4 * s + (fr >> 2));
        unsigned su[4][4], un[4];
#pragma unroll
        for (int wd = 0; wd < 4; ++wd) { un[wd] = 0u;
#pragma unroll
            for (int s = 0; s < 4; ++s) { unsigned x = ms[s][wd]; x |= __shfl_xor(x, 4); x |= __shfl_xor(x, 8); su[s][wd] = (unsigned)__builtin_amdgcn_readfirstlane((int)x); un[wd] |= su[s][wd]; } }
        const int hds = g * 4 + (fr & 3); float slp[1]; slp[0] = ex2(-0.5f * (float)(hds + 1)) * LOG2E;
        const int tb = (id & 511) * 16 + (fr >> 2);
        f32x4 Os[4][1][4]; float mS[4][1], lS[4][1]; float inv1[1] = {0.f};
#pragma unroll
        for (int s = 0; s < 4; ++s) nsa_zero<1>(Os[s], mS[s], lS[s]);
        KvBf16 kvp{WSP(bf16, WS_KSEL) + (size_t)bg * PT * 64, WSP(bf16, WS_VSELT) + (size_t)bg * 64 * PT, PT};
        int wdc = 0; unsigned mmc = un[0];
        while (wdc < 3 && mmc == 0u) { ++wdc; mmc = wdc == 1 ? un[1] : wdc == 2 ? un[2] : un[3]; }
        KvFrags fa, fb;
        int jc = -1, hc = 0;
        if (mmc) { jc = 32 * wdc + __builtin_ctz(mmc); mmc &= mmc - 1u; nsa_load<true>(kvp, 64 * jc, fr, fq, fa); }
#pragma unroll 1
        while (jc >= 0) {
            int jn = jc, hn = hc + 1;
            if (hn == 2) { hn = 0;
                while (wdc < 3 && mmc == 0u) { ++wdc; mmc = wdc == 1 ? un[1] : wdc == 2 ? un[2] : un[3]; }
                if (mmc) { jn = 32 * wdc + __builtin_ctz(mmc); mmc &= mmc - 1u; } else jn = -1; }
            if (jn >= 0) nsa_load<true>(kvp, 64 * jn + 32 * hn, fr, fq, fb);
            const int wj = jc >> 5, bj = jc & 31;
#pragma unroll
            for (int s = 0; s < 4; ++s) {
                const unsigned suw = wj == 0 ? su[s][0] : wj == 1 ? su[s][1] : wj == 2 ? su[s][2] : su[s][3];
                if ((suw >> bj) & 1u) {
                    const unsigned mw = wj == 0 ? ms[s][0] : wj == 1 ? ms[s][1] : wj == 2 ? ms[s][2] : ms[s][3];
                    nsa_core<1, 0>(fa, 64 * jc + 32 * hc, qw + (16 * s + fr) * NSA_QLD, 0, Os[s], mS[s], lS[s], inv1, slp, tb + 4 * s, 1, 0, 1 << 30, (mw >> bj) & 1u, imp, fq);
                }
            }
            fa = fb; jc = jn; hc = hn;
        }
#pragma unroll
        for (int s = 0; s < 4; ++s) { float lt = lS[s][0]; lt = x32_sum(x16_sum(lt));
            const size_t rs = (size_t)(row0 + 4 * s + (fr >> 2));
            const float sc = WSP(float, WS_GATES)[rs * 48 + 16 + hds] / fmaxf(lt, 1e-30f);
#pragma unroll
            for (int dt = 0; dt < 4; ++dt) { f32x4* o = (f32x4*)(WSP(float, WS_OACC) + rs * 1024 + hds * 64 + 16 * dt + 4 * fq); *o = *o + Os[s][0][dt] * sc; } }
    }
    {
        nsa_zero<NT>(O, m, l);
        KvBf16 kv = SAMPLE ? KvBf16{WSP(bf16, WS_SKWIN) + (size_t)bg * 544 * 64, WSP(bf16, WS_SVWINT) + (size_t)bg * 64 * 544, 544}
                           : KvBf16{WSP(bf16, WS_KWIN) + (size_t)bg * PT * 64, WSP(bf16, WS_VWINT) + (size_t)bg * 64 * PT, PT};
        int k0, k1, padd;
        if (SAMPLE) { k0 = 0; k1 = 544; padd = PAST - WINDOW; }
        else { const int lo = tmax - 15 - (WINDOW - 1); k0 = (lo > 0 ? lo : 0) & ~31; k1 = tmax + 1; padd = 0; }
        { KvFrags fa, fb; nsa_load<true>(kv, k0, fr, fq, fa);
#pragma unroll 1
          for (int kk = k0; kk < k1; kk += 32) { if (kk + 32 < k1) nsa_load<true>(kv, kk + 32, fr, fq, fb);
            nsa_core<NT, 0>(fa, kk, qrow, qnt, O, m, l, invl, slope, t, 1, padd, WINDOW, true, imp, fq); fa = fb; } }
        bf16* on = WSP(bf16, WS_OG) + (size_t)row * 1024;
#pragma unroll
        for (int nt = 0; nt < NT; ++nt) { float lt = l[nt]; lt = x32_sum(x16_sum(lt)); const float sc = gates[2 * 16 + hd[nt]] / fmaxf(lt, 1e-30f);
#pragma unroll
            for (int dt = 0; dt < 4; ++dt) { const f32x4 o = *(const f32x4*)(oacc + hd[nt] * 64 + 16 * dt + 4 * fq) + O[nt][dt] * sc;
                *(v2u*)(on + hd[nt] * 64 + 16 * dt + 4 * fq) = (v2u){pk2(o[0], o[1]), pk2(o[2], o[3])}; } }
    }
}

constexpr int NW_STG = 67584;
constexpr int NW_STG_BYTES = 18432;
constexpr int NW_UN = NW_STG + 2 * NW_STG_BYTES;
struct NwStage { v4u k, v; };
__device__ __forceinline__ void nw_load(const bf16* K, const bf16* VT, int ld, int key0, int tid, NwStage& s) {
    s.k = *(const v4u*)(K + (size_t)(key0 + (tid >> 3)) * 64 + 8 * (tid & 7));
    s.v = *(const v4u*)(VT + (size_t)(tid >> 3) * ld + key0 + 8 * (tid & 7));
}
__device__ __forceinline__ void nw_store(LAS unsigned char* buf, int tid, const NwStage& s) {
    const int kk = tid >> 3, c8 = tid & 7, k32 = kk & 31;
    const int rho = 32 * (kk >> 5) + 16 * ((k32 >> 2) & 1) + 4 * (k32 >> 3) + (k32 & 3);
    *(LAS v4u*)(buf + rho * 144 + c8 * 16) = s.k;
    *(LAS v4u*)(buf + 9216 + kk * 144 + c8 * 16) = s.v;
}
template <bool WITHV>
__device__ __forceinline__ void nw_frags(const LAS unsigned char* buf, int th, int fr, int fq, KvFrags& f) {
#pragma unroll
    for (int mt = 0; mt < 2; ++mt)
#pragma unroll
        for (int ks = 0; ks < 2; ++ks) f.k[mt][ks] = *(const LAS bf16x8*)(buf + (32 * th + 16 * mt + fr) * 144 + (32 * ks + 8 * fq) * 2);
    if (WITHV) {
#pragma unroll
        for (int dt = 0; dt < 4; ++dt) f.v[dt] = *(const LAS bf16x8*)(buf + 9216 + (16 * dt + fr) * 144 + (32 * th + 8 * fq) * 2);
    }
}
#define NW_PIPE(Kp, VTp, ldv, NB, BLK, BODY) do { const int nb_ = (NB); \
        if (nb_ > 0) { NwStage st_; nw_load(Kp, VTp, ldv, BLK(0), F.tid, st_); nw_store(stg, F.tid, st_); } \
        __syncthreads(); \
        _Pragma("unroll 1") for (int ib_ = 0; ib_ < nb_; ++ib_) { \
            NwStage st_; const bool more_ = ib_ + 1 < nb_; if (more_) nw_load(Kp, VTp, ldv, BLK(ib_ + 1), F.tid, st_); \
            const LAS unsigned char* buf_ = stg + (ib_ & 1) * NW_STG_BYTES; const int key0_ = BLK(ib_); \
            BODY(buf_, key0_) \
            if (more_) nw_store(stg + ((ib_ + 1) & 1) * NW_STG_BYTES, F.tid, st_); \
            __syncthreads(); } } while (0)

__device__ __forceinline__ void nsa_wg(Frame& F, int bg, int qb) {
    int lane_ = F.lane; asm volatile("" : "+v"(lane_));
    const int lane = lane_, fr = lane & 15, fq = lane >> 4, w = F.wave, g = bg & 3;
    LAS unsigned char* L = F.lds; asm volatile("" : "+v"(L));
    LAS float* imp = (LAS float*)(L + NSA_IMP + w * 8448);
    LAS unsigned char* stg = L + NW_STG;
    LAS unsigned* wun = (LAS unsigned*)(L + NW_UN); volatile LAS unsigned char* blist = (volatile LAS unsigned char*)(L + NW_UN + 16);
    const int tt = qb * 8 + w, t = 16 * tt + fr, row0 = (bg >> 2) * PT + 16 * tt, row = row0 + fr, tw0 = 16 * tt, tw1 = tw0 + 15;
    float slope[4]; bf16x8 qreg[8];
#pragma unroll
    for (int nt = 0; nt < 4; ++nt) { slope[nt] = ex2(-0.5f * (float)(g * 4 + nt + 1)) * LOG2E;
        const bf16* qp = WSP(bf16, WS_QN) + (size_t)row * 1024 + (g * 4 + nt) * 64 + 8 * fq; qreg[2 * nt] = ld8(qp); qreg[2 * nt + 1] = ld8(qp + 32); }
    const float* gates = WSP(float, WS_GATES) + (size_t)row * 48;
    float* oacc = WSP(float, WS_OACC) + (size_t)row * 1024;
    for (int i = lane; i < 16 * 132; i += 64) imp[i] = 0.f;
    if (F.tid < 4) wun[F.tid] = 0u;
    f32x4 O[4][4]; float m[4], l[4], invl[4];
    {
        const bf16* Kc = WSP(bf16, WS_KCMP) + (size_t)bg * 512 * 64; const bf16* Vc = WSP(bf16, WS_VCMPT) + (size_t)bg * 64 * 512;
        const int cmax = (128 * qb + 127 - 31) >> 4, ncb = (cmax < 510 ? cmax : 510) / 64 + 1;
#pragma unroll
        for (int nt = 0; nt < 4; ++nt) invl[nt] = 0.f;
        nsa_zero<4>(O, m, l);
#define NW_BLK(i) (64 * (i))
#define NW_CMP1(buf, k0) { _Pragma("unroll 1") for (int th = 0; th < 2; ++th) if (16 * ((k0) + 32 * th) + 31 <= tw1) { KvFrags f; nw_frags<false>(buf, th, fr, fq, f); \
            nsa_core<4, 1, true>(f, (k0) + 32 * th, nullptr, 0, O, m, l, invl, slope, t, 16, 31, 1 << 30, true, imp + fr * 132, fq, qreg); } }
        NW_PIPE(Kc, Vc, 512, ncb, NW_BLK, NW_CMP1);
#pragma unroll
        for (int nt = 0; nt < 4; ++nt) { const float lt = x32_sum(x16_sum(l[nt])); invl[nt] = lt > 0.f ? 1.f / lt : 0.f; }
#define NW_CMP2(buf, k0) { _Pragma("unroll 1") for (int th = 0; th < 2; ++th) if (16 * ((k0) + 32 * th) + 31 <= tw1) { KvFrags f; nw_frags<true>(buf, th, fr, fq, f); \
            nsa_core<4, 2, true>(f, (k0) + 32 * th, nullptr, 0, O, m, l, invl, slope, t, 16, 31, 1 << 30, true, imp + fr * 132, fq, qreg); } }
        NW_PIPE(Kc, Vc, 512, ncb, NW_BLK, NW_CMP2);
#pragma unroll
        for (int nt = 0; nt < 4; ++nt) { const float gc = gates[0 * 16 + g * 4 + nt];
#pragma unroll
            for (int dt = 0; dt < 4; ++dt) *(f32x4*)(oacc + (g * 4 + nt) * 64 + 16 * dt + 4 * fq) = O[nt][dt] * gc; }
    }
    LDS_WAIT();
    unsigned selm[4] = {0u, 0u, 0u, 0u};
    {
        const int cur = t >> 6;
        unsigned v[32];
#pragma unroll
        for (int i = 0; i < 32; ++i) { const int j = 32 * fq + i; const bool forced = (j == 0) | (j == cur) | (j == cur - 1);
            const unsigned key = ((f2u(imp[fr * 132 + j]) & ~127u) | (unsigned)(127 - j)) + 128u;
            v[i] = (!forced && j <= cur) ? key : 0u;
            if (forced) selm[fq] |= 1u << i; }
        unsigned fw = selm[0] | selm[1] | selm[2] | selm[3];
        const unsigned w16 = __shfl_xor(fw, 16), w32 = __shfl_xor(fw, 32), w48 = __shfl_xor(fw, 48);
#pragma unroll
        for (int wd = 0; wd < 4; ++wd) selm[wd] = (fq == wd) ? fw : ((fq ^ 1) == wd) ? w16 : ((fq ^ 2) == wd) ? w32 : w48;
        const int nforced = cur >= 2 ? 3 : cur + 1;
#pragma unroll 1
        for (int rd = 0; rd < 15; ++rd) {
            unsigned mx = v[0];
#pragma unroll
            for (int i = 1; i < 32; ++i) mx = mx > v[i] ? mx : v[i];
            mx = x32_umax(x16_umax(mx));
#pragma unroll
            for (int i = 0; i < 32; ++i) v[i] = (v[i] == mx) ? 0u : v[i];
            if (mx != 0u && rd < 16 - nforced) { const int js = 127 - (int)(mx & 127u);
#pragma unroll
                for (int wd = 0; wd < 4; ++wd) selm[wd] |= ((js >> 5) == wd) ? (1u << (js & 31)) : 0u; }
        }
    }
    unsigned un[4];
#pragma unroll
    for (int wd = 0; wd < 4; ++wd) { unsigned x = selm[wd]; x |= dpp_u<DPP_XOR1>(x); x |= dpp_u<DPP_XOR2>(x); x |= dpp_u<DPP_HMIR>(x); x |= dpp_u<DPP_MIR>(x); un[wd] = (unsigned)__builtin_amdgcn_readfirstlane((int)x); }
    if (lane < 4) __hip_atomic_fetch_or(wun + lane, lane == 0 ? un[0] : lane == 1 ? un[1] : lane == 2 ? un[2] : un[3], __ATOMIC_RELAXED, __HIP_MEMORY_SCOPE_WORKGROUP);
    __syncthreads();
    unsigned wu[4];
#pragma unroll
    for (int wd = 0; wd < 4; ++wd) wu[wd] = (unsigned)__builtin_amdgcn_readfirstlane((int)wun[wd]);
    {
        nsa_zero<4>(O, m, l);
        const bf16* Ks = WSP(bf16, WS_KSEL) + (size_t)bg * PT * 64; const bf16* Vs = WSP(bf16, WS_VSELT) + (size_t)bg * 64 * PT;
        const int nsb = __builtin_popcount(wu[0]) + __builtin_popcount(wu[1]) + __builtin_popcount(wu[2]) + __builtin_popcount(wu[3]);
        if (F.tid < 128) { const int j = F.tid, wj = j >> 5, bj = j & 31; const unsigned ww = wj == 0 ? wu[0] : wj == 1 ? wu[1] : wj == 2 ? wu[2] : wu[3];
            if ((ww >> bj) & 1u) { int pos = __builtin_popcount(ww & ((1u << bj) - 1u)); if (wj > 0) pos += __builtin_popcount(wu[0]); if (wj > 1) pos += __builtin_popcount(wu[1]); if (wj > 2) pos += __builtin_popcount(wu[2]);
                blist[pos] = (unsigned char)j; } }
        __syncthreads();
#define NW_SBLK(i) (64 * (int)blist[(i)])
#define NW_SEL(buf, k0) { const int j_ = (k0) >> 6, wj_ = j_ >> 5, bj_ = j_ & 31; const unsigned uw_ = wj_ == 0 ? un[0] : wj_ == 1 ? un[1] : wj_ == 2 ? un[2] : un[3]; \
            if ((uw_ >> bj_) & 1u) { const unsigned mine_ = wj_ == 0 ? selm[0] : wj_ == 1 ? selm[1] : wj_ == 2 ? selm[2] : selm[3]; const bool ok_ = (mine_ >> bj_) & 1u; \
                _Pragma("unroll 1") for (int th = 0; th < 2; ++th) { KvFrags f; nw_frags<true>(buf, th, fr, fq, f); \
                    nsa_core<4, 0, true>(f, (k0) + 32 * th, nullptr, 0, O, m, l, invl, slope, t, 1, 0, 1 << 30, ok_, imp, fq, qreg); } } }
        NW_PIPE(Ks, Vs, PT, nsb, NW_SBLK, NW_SEL);
#pragma unroll
        for (int nt = 0; nt < 4; ++nt) { const float lt = x32_sum(x16_sum(l[nt])); const float sc = gates[1 * 16 + g * 4 + nt] / fmaxf(lt, 1e-30f);
#pragma unroll
            for (int dt = 0; dt < 4; ++dt) { f32x4* o = (f32x4*)(oacc + (g * 4 + nt) * 64 + 16 * dt + 4 * fq); *o = *o + O[nt][dt] * sc; } }
    }
    {
        nsa_zero<4>(O, m, l);
        const bf16* Kw = WSP(bf16, WS_KWIN) + (size_t)bg * PT * 64; const bf16* Vw = WSP(bf16, WS_VWINT) + (size_t)bg * 64 * PT;
        const int lo = 128 * qb - (WINDOW - 1), kb0 = (lo > 0 ? lo : 0) >> 6, kb1 = (128 * qb + 127) >> 6, nwb = kb1 - kb0 + 1;
#define NW_WBLK(i) (64 * (kb0 + (i)))
#define NW_WIN(buf, k0) { _Pragma("unroll 1") for (int th = 0; th < 2; ++th) { const int kk_ = (k0) + 32 * th; if (kk_ <= tw1 && kk_ + 31 >= tw0 - (WINDOW - 1)) { KvFrags f; nw_frags<true>(buf, th, fr, fq, f); \
                nsa_core<4, 0, true>(f, kk_, nullptr, 0, O, m, l, invl, slope, t, 1, 0, WINDOW, true, imp, fq, qreg); } } }
        NW_PIPE(Kw, Vw, PT, nwb, NW_WBLK, NW_WIN);
        bf16* on = WSP(bf16, WS_OG) + (size_t)row * 1024;
#pragma unroll
        for (int nt = 0; nt < 4; ++nt) { const float lt = x32_sum(x16_sum(l[nt])); const float sc = gates[2 * 16 + g * 4 + nt] / fmaxf(lt, 1e-30f);
#pragma unroll
            for (int dt = 0; dt < 4; ++dt) { const f32x4 o = *(const f32x4*)(oacc + (g * 4 + nt) * 64 + 16 * dt + 4 * fq) + O[nt][dt] * sc;
                *(v2u*)(on + (g * 4 + nt) * 64 + 16 * dt + 4 * fq) = (v2u){pk2(o[0], o[1]), pk2(o[2], o[3])}; } }
    }
    __syncthreads();
}

constexpr int SW_Q = 0;
constexpr int SW_IMPP = 2304;
constexpr int SW_IMPT = SW_IMPP + 8 * 2112;
constexpr int SW_LP = SW_IMPT + 2112;
constexpr int SW_OP = SW_LP + 3 * 8 * 16 * 4;
static_assert(SW_OP + 8 * 3 * 16 * 64 * 4 <= RING_BYTES, "sample NSA LDS map");
__device__ __forceinline__ void nsa_sample_wg(Frame& F, int id) {
    int lane_ = F.lane; asm volatile("" : "+v"(lane_));
    const int lane = lane_, fr = lane & 15, fq = lane >> 4, w = F.wave, g = id & 3, bs = id >> 2;
    LAS unsigned char* L = F.lds; asm volatile("" : "+v"(L));
    LAS bf16* qw = (LAS bf16*)(L + SW_Q);
    LAS float* impP = (LAS float*)(L + SW_IMPP) + w * 528; LAS float* impT = (LAS float*)(L + SW_IMPT);
    LAS float* LP = (LAS float*)(L + SW_LP); LAS float* OP = (LAS float*)(L + SW_OP);
    const int t = PAST + (fr >> 2), row0 = MP + bs * 4, trow = fr >> 2, hd = g * 4 + (fr & 3);
    if (F.tid < 128) { const int rr = F.tid >> 3, c8 = F.tid & 7;
        *(LAS v4u*)(qw + rr * NSA_QLD + 8 * c8) = *(const v4u*)(WSP(bf16, WS_QN) + (size_t)(row0 + (rr >> 2)) * 1024 + (g * 4 + (rr & 3)) * 64 + 8 * c8); }
    for (int i = lane; i < 528; i += 64) impP[i] = 0.f;
    __syncthreads();
    float slope[1] = {ex2(-0.5f * (float)(hd + 1)) * LOG2E};
    const LAS bf16* qrow = qw + fr * NSA_QLD;
    f32x4 O[1][4]; float m[1], l[1], invl[1] = {0.f};
#define SW_PUT_O(br) { _Pragma("unroll") for (int dt = 0; dt < 4; ++dt) *(LAS f32x4*)(OP + ((w * 3 + (br)) * 16 + fr) * 64 + 16 * dt + 4 * fq) = O[0][dt]; }
#define SW_PUT_L(br) { const float lt_ = x32_sum(x16_sum(l[0])); if (fq == 0) LP[((br) * 8 + w) * 16 + fr] = lt_; }
    {
        KvBf16 kv{WSP(bf16, WS_SKCMP) + (size_t)id * 512 * 64, WSP(bf16, WS_SVCMPT) + (size_t)id * 64 * 512, 512};
        nsa_zero<1>(O, m, l);
#pragma unroll 1
        for (int tl = w; tl < 16; tl += 8) nsa_tile<1, 1>(kv, 32 * tl, qrow, 0, O, m, l, invl, slope, t, 16, 31, 1 << 30, true, impP + trow * 132, fr, fq);
        SW_PUT_L(0)
        __syncthreads();
        { float lt = 0.f;
#pragma unroll
          for (int ww = 0; ww < 8; ++ww) lt += LP[(0 * 8 + ww) * 16 + fr];
          invl[0] = lt > 0.f ? 1.f / lt : 0.f; }
#pragma unroll 1
        for (int tl = w; tl < 16; tl += 8) nsa_tile<1, 2>(kv, 32 * tl, qrow, 0, O, m, l, invl, slope, t, 16, 31, 1 << 30, true, impP + trow * 132, fr, fq);
        SW_PUT_O(0)
    }
    __syncthreads();
    for (int i = F.tid; i < 528; i += 512) { float s = 0.f;
#pragma unroll
        for (int ww = 0; ww < 8; ++ww) s += ((LAS float*)(L + SW_IMPP))[ww * 528 + i];
        impT[i] = s; }
    __syncthreads();
    unsigned selm[4] = {1u, 0u, 0u, 1u << 31};
    {
        const int li = (fr & 3) * 4 + fq;
        unsigned v[8];
#pragma unroll
        for (int i = 0; i < 8; ++i) { const int j = li * 8 + i; v[i] = (j >= 1 && j <= 126) ? (((f2u(impT[trow * 132 + j]) & ~127u) | (unsigned)(127 - j)) + 128u) : 0u; }
#pragma unroll 1
        for (int rd = 0; rd < 13; ++rd) {
            unsigned mx = v[0];
#pragma unroll
            for (int i = 1; i < 8; ++i) mx = mx > v[i] ? mx : v[i];
            { unsigned o = dpp_u<DPP_XOR1>(mx); mx = mx > o ? mx : o; o = dpp_u<DPP_XOR2>(mx); mx = mx > o ? mx : o; mx = x32_umax(x16_umax(mx)); }
#pragma unroll
            for (int i = 0; i < 8; ++i) v[i] = (v[i] == mx) ? 0u : v[i];
            if (mx != 0u) { const int js = 127 - (int)(mx & 127u);
#pragma unroll
                for (int wd = 0; wd < 4; ++wd) selm[wd] |= ((js >> 5) == wd) ? (1u << (js & 31)) : 0u; }
        }
    }
    {
        nsa_zero<1>(O, m, l);
        unsigned un[4];
#pragma unroll
        for (int wd = 0; wd < 4; ++wd) { unsigned x = selm[wd]; x |= dpp_u<DPP_XOR1>(x); x |= dpp_u<DPP_XOR2>(x); x |= dpp_u<DPP_HMIR>(x); x |= dpp_u<DPP_MIR>(x); un[wd] = (unsigned)__builtin_amdgcn_readfirstlane((int)x); }
        KvSampleSel kvs{FIN(2) + g * 64, (const int*)FIN(6) + bs * NPAGES, WSP(float, WS_SNEW) + (size_t)bs * 2048 + g * 64, g};
        int q = 0;
#pragma unroll 1
        for (int wd = 0; wd < 4; ++wd) {
            unsigned mm = un[wd];
            const unsigned mine = wd == 0 ? selm[0] : wd == 1 ? selm[1] : wd == 2 ? selm[2] : selm[3];
            while (mm) {
                const int bit = __builtin_ctz(mm); mm &= mm - 1u; const int j = 32 * wd + bit;
                const bool ok = (mine >> bit) & 1u;
#pragma unroll 1
                for (int hh = 0; hh < 2; ++hh, ++q) if ((q & 7) == w) { nsa_tile<1, 0>(kvs, 64 * j + 32 * hh, qrow, 0, O, m, l, invl, slope, t, 1, 0, 1 << 30, ok, impP, fr, fq); __builtin_amdgcn_sched_barrier(0); }
            }
        }
        if ((q & 7) == w) nsa_tile<1, 0>(kvs, 64 * 128, qrow, 0, O, m, l, invl, slope, t, 1, 0, 1 << 30, true, impP, fr, fq);
        SW_PUT_O(1) SW_PUT_L(1)
    }
    {
        nsa_zero<1>(O, m, l);
        KvBf16 kv{WSP(bf16, WS_SKWIN) + (size_t)id * 544 * 64, WSP(bf16, WS_SVWINT) + (size_t)id * 64 * 544, 544};
#pragma unroll 1
        for (int kk = 32 * w; kk < 544; kk += 256) nsa_tile<1, 0>(kv, kk, qrow, 0, O, m, l, invl, slope, t, 1, PAST - WINDOW, WINDOW, true, impP, fr, fq);
        SW_PUT_O(2) SW_PUT_L(2)
    }
    __syncthreads();
    {
        const int r = F.tid >> 5, d0 = (F.tid & 31) * 2, rowg = row0 + (r >> 2), hdr = g * 4 + (r & 3);
        float o0 = 0.f, o1 = 0.f;
#pragma unroll
        for (int br = 0; br < 3; ++br) { float a0 = 0.f, a1 = 0.f, lt = 0.f;
#pragma unroll
            for (int ww = 0; ww < 8; ++ww) { const f32x2 x = *(const LAS f32x2*)(OP + ((ww * 3 + br) * 16 + r) * 64 + d0); a0 += x.x; a1 += x.y; if (br > 0) lt += LP[(br * 8 + ww) * 16 + r]; }
            const float sc = WSP(float, WS_GATES)[(size_t)rowg * 48 + br * 16 + hdr] * (br == 0 ? 1.f : 1.f / fmaxf(lt, 1e-30f));
            o0 += a0 * sc; o1 += a1 * sc; }
        *(unsigned*)(WSP(bf16, WS_OG) + (size_t)rowg * 1024 + hdr * 64 + d0) = pk2(o0, o1);
    }
    __syncthreads();
#undef SW_PUT_O
#undef SW_PUT_L
}


#ifndef MK_SINGLE
#define MK_SINGLE 1
#endif
constexpr int NPHASE = 21;
struct Args { const float* in[29]; float* out; unsigned char* ws; int ph_lo, ph_hi; };
static_assert(sizeof(Args) == 31 * 8 + 8, "Args has no padding");

__global__ void __launch_bounds__(512, 2) mk_fwd(Args args) {
    extern __shared__ __attribute__((aligned(16))) unsigned char lds_raw[];
    Frame F;
    F.lds = (LAS unsigned char*)lds_raw;
    F.tid = threadIdx.x; F.lane = F.tid & 63; F.wave = __builtin_amdgcn_readfirstlane(F.tid >> 6);
    F.G = gridDim.x; F.bid = blockIdx.x;
    F.ka = (const __attribute__((address_space(4))) char*)__builtin_amdgcn_kernarg_segment_ptr();
    F.out = args.out; F.ws = args.ws;
    volatile LAS unsigned* MISC = (volatile LAS unsigned*)(F.lds + MISC_OFF);
    for (int u = F.tid; u < (LDS_BYTES - LDSCTL_OFF) / 4; u += 512) ((LAS unsigned*)(F.lds + LDSCTL_OFF))[u] = 0u;
    __syncthreads();
    unsigned* barw = (unsigned*)(F.ws + WS_CTL) + 4096;
    XcdBarrier bar; bar.bar = barw; bar.x = 0; bar.st = nullptr;
    const int lo = args.ph_lo, hi = args.ph_hi;
    if (hi - lo > 1) bar = xcd_barrier_post(barw, MISC + 8);
#ifndef PH_MASK
#define PH_MASK 0xFFFFFFFFu
#endif
#define IN(k) (((PH_MASK >> (k)) & 1u) && lo <= (k) && (k) < hi)
#define SEAM(k) do { if (IN(k) && IN((k) + 1)) xcd_barrier(bar); } while (0)
    const int gw = F.bid * 8 + F.wave, NGW = F.G * 8;

#ifndef REPX
#define REPX 0
#endif
#ifndef REPY
#define REPY 0
#endif
#ifndef REP_MASK
#define REP_MASK 0u
#endif
#define PHASE(k, ...) if (IN(k)) { _Pragma("unroll 1") for (int rep_ = 0; rep_ < (int)((REP_MASK >> (k)) & 1u) + 1; ++rep_) { if (rep_) xcd_barrier(bar); __VA_ARGS__ } } SEAM(k);
    PHASE(0, p0_prologue(F);)
    if (IN(1) && F.G != 256) { for (int task = F.bid; task < 512; task += F.G) fs_direct_task(F, task); }
    if (IN(1) && IN(2) && F.G != 256) xcd_barrier(bar);
    PHASE(2, gemm_all(F, WSP(bf16, WS_XNA), WSP(bf16, WS_WIN_T), 4096, FnBf16{WSP(bf16, WS_PROJ), 4096});)
    PHASE(3, for (int u = F.bid; u < 2048 + 256; u += F.G) { if (u < 2048) p2_chunk(F, u); else p2_sample(F, u - 2048); })
    PHASE(4, if (F.G == 256) { const int x = F.bid & 7, idx = F.bid >> 3;
                 if (idx < 8) p3_scan(F, x * 2 + (idx >> 2), idx & 3);
                 else { const int j = (idx - 8) * 8 + x;
                        const size_t n8 = (size_t)2 * NEXP * DM / 8; const int p0 = j < 128 ? 6 * j : 768 + 13 * (j - 128), p1 = p0 + (j < 128 ? 6 : 13);
                        peer_tables_to_fp8(F, (size_t)F.tid, (size_t)512, n8 * p0 / 1600, n8 * p1 / 1600);
                        __syncthreads();
                        for (int task = j; task < 512; task += 192) fs_direct_task(F, task); } }
             else { for (int u = F.bid; u < 64; u += F.G) p3_scan(F, u >> 2, u & 3); })
    PHASE(5, p4_rows(F, gw, NGW);
             for (int id = gw; id < 8192; id += NGW) compress_sample(F, id);)
    PHASE(6, gemm_all(F, WSP(bf16, WS_OG), WSP(bf16, WS_WOA_T), 1024, FnResid{WSP(float, WS_XS), FIN(0), FIN(1)});)
    PHASE(7, rms_rows_phase(F, gw, NGW);)
    PHASE(8, gemm_all(F, WSP(bf16, WS_XNB), WSP(bf16, WS_WPQ_T), 2048, FnBf16{WSP(bf16, WS_QPEER), 2048});)
    PHASE(9, p8_phase(F, 0);)
    int pg_slice = F.bid & 7, pg_first = (F.bid >> 3) * 8 + F.wave, pg_stride = ((F.G - (F.bid & 7) + 7) >> 3) * 8;
#define PEER_GROUPS() do { if (MISC[8 + 3] != 0u && (F.G & 7) == 0) { const unsigned c_ = xb_ld(&barw[XB_XCNT(F.lane & 15)]); const bool ok_ = (F.lane & 15) < 8 ? c_ == (unsigned)(F.G >> 3) : c_ == 0u; \
        if (__builtin_amdgcn_ballot_w64(ok_) == ~0ull && bar.x < 8u) { pg_slice = (int)bar.x; pg_first = (int)MISC[8 + 2] * 8 + F.wave; pg_stride = F.G; } } } while (0)
    PHASE(10, PEER_GROUPS(); p9u_wave(F, 0, pg_slice, pg_first, pg_stride);)
    PHASE(11, PEER_GROUPS(); p9v2_wave(F, 0, pg_slice, pg_first, pg_stride, 0);)
    PHASE(12, gemm_all(F, WSP(bf16, WS_XNA), WSP(bf16, WS_WKVQ_T), NKVQ, FnKvq{WSP(bf16, WS_KVQ), WSP(float, WS_SSQ)});)
    PHASE(13, for (int u = F.bid; u < 256; u += F.G) pp_prompt_tile(F, u);
              if (F.G == 256) { compress_prompt_split(F, F.bid * 2 + (F.wave >> 2)); if (F.bid < MS) pp_sample_row(F, F.bid, F.wave); }
              else { for (int r = gw; r < MS; r += NGW) pp_sample_row(F, r); for (int id = gw; id < 512; id += NGW) compress_prompt(F, id); })
    PHASE(14, if (F.G == 256) {
                  _Pragma("unroll 1") for (int q_ = 0; q_ < 1 + REPX; ++q_) { if (F.bid < 128) nsa_sample_wg(F, F.bid); }
                  __syncthreads();
                  { const int i_ = F.bid >> 3;
                    if (i_ < 16) { nsa_wg(F, F.bid & 7, i_); nsa_wg(F, F.bid & 7, 31 - i_); } else { nsa_wg(F, F.bid & 7, 16 + i_); nsa_wg(F, F.bid & 7, 79 - i_); } }
              } else { for (int id = gw; id < 128 + 4096; id += NGW) { if (id < 128) nsa_unit<true>(F, id); else nsa_unit<false>(F, id - 128); } })
    PHASE(15, gemm_all(F, WSP(bf16, WS_OG), WSP(bf16, WS_WOB_T), 1024, FnResid{WSP(float, WS_XS), WSP(float, WS_XS), WSP(float, WS_XS) + (size_t)MP * DM});)
    PHASE(16, rms_rows_phase(F, gw, NGW);)
    PHASE(17, gemm_all(F, WSP(bf16, WS_XNB), WSP(bf16, WS_WPQ_T) + (size_t)2048 * 1024, 2048, FnBf16{WSP(bf16, WS_QPEER), 2048});)
    PHASE(18, p8_phase(F, 1);)
    PHASE(19, PEER_GROUPS(); p9u_wave(F, 1, pg_slice, pg_first, pg_stride);)
    PHASE(20, PEER_GROUPS(); p9v2_wave(F, 1, pg_slice, pg_first, pg_stride, 1);)
#undef IN
#undef SEAM
}

extern "C" void kernel_launch(void* const* d_in, const int* in_sizes, int n_in, void* d_out, int out_size, void* d_ws, size_t ws_size, hipStream_t stream) {
    static int grid = 0;
    if (grid == 0) {
        if (n_in != 29 || (size_t)out_size != O_END || ws_size < WS_END) { fprintf(stderr, "kernel_launch: unexpected shapes n_in %d out %d ws %zu (need %zu)\n", n_in, out_size, ws_size, (size_t)WS_END); grid = -1; return; }
        int dev = 0, cus = 0, per_cu = 0;
        if (hipGetDevice(&dev) != hipSuccess || hipDeviceGetAttribute(&cus, hipDeviceAttributeMultiprocessorCount, dev) != hipSuccess) { grid = -1; return; }
        if (hipFuncSetAttribute((const void*)mk_fwd, hipFuncAttributeMaxDynamicSharedMemorySize, LDS_BYTES) != hipSuccess) { fprintf(stderr, "kernel_launch: hipFuncSetAttribute failed\n"); grid = -1; return; }
        if (hipOccupancyMaxActiveBlocksPerMultiprocessor(&per_cu, (const void*)mk_fwd, 512, LDS_BYTES) != hipSuccess || per_cu < 1) fprintf(stderr, "kernel_launch: occupancy query reports %d\n", per_cu);
        (void)hipGetLastError();
        grid = cus;
    }
    if (grid < 0) return;
    if (hipMemsetAsync((char*)d_ws + WS_CTL, 0, CTL_BYTES, stream) != hipSuccess) return;
    Args a{};
    for (int i = 0; i < 29; ++i) a.in[i] = (const float*)d_in[i];
    a.out = (float*)d_out; a.ws = (unsigned char*)d_ws;
#if MK_SINGLE
    a.ph_lo = 0; a.ph_hi = NPHASE;
    hipLaunchKernelGGL(mk_fwd, dim3(grid), dim3(512), LDS_BYTES, stream, a);
#else
    for (int p = 0; p < NPHASE; ++p) { a.ph_lo = p; a.ph_hi = p + 1; hipLaunchKernelGGL(mk_fwd, dim3(grid), dim3(512), LDS_BYTES, stream, a); }
#endif
    const hipError_t le = hipPeekAtLastError();
    if (le != hipSuccess) fprintf(stderr, "kernel_launch: launch failed: %s\n", hipGetErrorName(le));
}
```

```cpp
#include <hip/hip_runtime.h>
#include <cstdio>
#include <cstdint>

constexpr int DM = 1024, PB = 2, PT = 8192, SB = 32, SL = 4, PAST = 8192, PAGE = 128;
constexpr int MP = PB * PT;
constexpr int MS = SB * SL;
constexpr int MTOK = MP + MS;
constexpr int GH = 8, GDK = 128, GDV = 128, GCONV = 3072, GPROJ = 4112, CHUNK = 64, NCH = PT / CHUNK;
constexpr int NH = 16, NG = 4, HPG = 4, DH = 64, NQG = 1072, NKV = 1536, NKVQ = 2816, NKVQ_REAL = 2608;
constexpr int WINDOW = 512, NSELP = 128, NSELS = 129, NCMP = 511;
constexpr int PEH = 8, PEDQ = 256, PEHALF = 128, NKEYS = 128, NEXP = 16384, PETOP = 16;
constexpr int NPAGES = PAST / PAGE;
constexpr float EPS = 1e-6f;

constexpr size_t O_YP = 0;
constexpr size_t O_YS = O_YP + (size_t)MP * DM;
constexpr size_t O_KVP = O_YS + (size_t)MS * DM;
constexpr size_t O_WINP = O_KVP + (size_t)MP * 1024;
constexpr size_t O_GDNP = O_WINP + (size_t)PB * 512 * 512;
constexpr size_t O_CONVP = O_GDNP + (size_t)PB * GH * 128 * 128;
constexpr size_t O_KVS = O_CONVP + (size_t)PB * 3 * GCONV;
constexpr size_t O_WINS = O_KVS + (size_t)MS * 1024;
constexpr size_t O_GDNS = O_WINS + (size_t)SB * 512 * 512;
constexpr size_t O_CONVS = O_GDNS + (size_t)SB * GH * 128 * 128;
constexpr size_t O_END = O_CONVS + (size_t)SB * 3 * GCONV;

constexpr size_t MiB = 1u << 20;
constexpr size_t al(size_t x) { return (x + 4095) & ~(size_t)4095; }
constexpr size_t WS_CTL = 0, CTL_BYTES = 1 * MiB;
constexpr size_t WS_WIN_T = WS_CTL + CTL_BYTES;
constexpr size_t WS_WOA_T = WS_WIN_T + (size_t)4096 * 1024 * 2;
constexpr size_t WS_WKVQ_T = WS_WOA_T + (size_t)1024 * 1024 * 2;
constexpr size_t WS_WOB_T = WS_WKVQ_T + (size_t)NKVQ * 1024 * 2;
constexpr size_t WS_WPQ_T = WS_WOB_T + (size_t)1024 * 1024 * 2;
constexpr size_t WS_WAB = WS_WPQ_T + (size_t)2 * 2048 * 1024 * 2;
constexpr size_t WS_SUBK = WS_WAB + (size_t)16 * 1024 * 4;
constexpr size_t WS_W1T = WS_SUBK + (size_t)2 * 8 * 2 * 128 * 128 * 2;
constexpr size_t WS_PETERM = WS_W1T + (size_t)2 * 128 * 1024 * 2;
constexpr size_t WS_PU = al(WS_PETERM + 512);
constexpr size_t WS_PV = WS_PU + (size_t)2 * NEXP * DM * 2;
constexpr size_t WS_XNA = WS_PV + (size_t)2 * NEXP * DM * 2;
constexpr size_t WS_XNB = al(WS_XNA + (size_t)MTOK * DM * 2);
constexpr size_t WS_PROJ = al(WS_XNB + (size_t)MTOK * DM * 2);
constexpr size_t WS_GW = al(WS_PROJ + (size_t)MTOK * 4096 * 2);
constexpr size_t WS_GQ = WS_GW + (size_t)2048 * 64 * 128 * 2;
constexpr size_t WS_GKT = WS_GQ + (size_t)2048 * 64 * 128 * 2;
constexpr size_t WS_GQK = WS_GKT + (size_t)2048 * 64 * 128 * 2;
constexpr size_t WS_GU = WS_GQK + (size_t)2048 * 64 * 64 * 2;
constexpr size_t WS_GDEC = WS_GU + (size_t)2048 * 64 * 128 * 4;
constexpr size_t WS_OGDN = al(WS_GDEC + 2048 * 4);
constexpr size_t WS_OG = al(WS_OGDN + (size_t)MTOK * DM * 4);
constexpr size_t WS_XS = al(WS_OG + (size_t)MTOK * DM * 2);
constexpr size_t WS_QPEER = al(WS_XS + (size_t)MTOK * DM * 4);
constexpr size_t WS_PEI = al(WS_QPEER + (size_t)MTOK * 2048 * 2);
constexpr size_t WS_PEG = al(WS_PEI + (size_t)MTOK * 128 * 4);
constexpr size_t WS_KVQ = al(WS_PEG + (size_t)MTOK * 128 * 4);
constexpr size_t WS_KSEL = al(WS_KVQ + (size_t)MTOK * NKVQ * 4);
constexpr size_t WS_VSELT = WS_KSEL + (size_t)PB * NG * PT * 64 * 2;
constexpr size_t WS_KWIN = WS_VSELT + (size_t)PB * NG * PT * 64 * 2;
constexpr size_t WS_VWINT = WS_KWIN + (size_t)PB * NG * PT * 64 * 2;
constexpr size_t WS_KCMP = WS_VWINT + (size_t)PB * NG * PT * 64 * 2;
constexpr size_t WS_VCMPT = WS_KCMP + (size_t)PB * NG * 512 * 64 * 2;
constexpr size_t WS_SKCMP = WS_VCMPT + (size_t)PB * NG * 512 * 64 * 2;
constexpr size_t WS_SVCMPT = WS_SKCMP + (size_t)SB * NG * 512 * 64 * 2;
constexpr size_t WS_SKWIN = WS_SVCMPT + (size_t)SB * NG * 512 * 64 * 2;
constexpr size_t WS_SVWINT = WS_SKWIN + (size_t)SB * NG * 544 * 64 * 2;
constexpr size_t WS_SNEW = WS_SVWINT + (size_t)SB * NG * 544 * 64 * 2;
constexpr size_t WS_QN = al(WS_SNEW + (size_t)SB * 4 * 2 * 4 * 64 * 4);
constexpr size_t WS_GATES = al(WS_QN + (size_t)MTOK * 1024 * 2);
constexpr size_t WS_OACC = al(WS_GATES + (size_t)MTOK * 48 * 4);
constexpr size_t WS_CKA = al(WS_OACC + (size_t)MTOK * DM * 4);
constexpr size_t WS_W1BD = al(WS_CKA + (size_t)65536 * 2048 * 2);
constexpr size_t WS_FS = al(WS_W1BD + (size_t)256 * 2048 * 2);
constexpr size_t WS_PA = al(WS_FS + (size_t)65536 * 256 * 4);
constexpr size_t WS_SSQ = al(WS_PA + (size_t)MTOK * 8 * 64 * 4);
constexpr size_t WS_W2F = al(WS_SSQ + (size_t)MTOK * 8 * 4);
constexpr size_t WS_XN8 = al(WS_W2F + 2 * 4 * 2 * 64 * 8 * 2);
constexpr size_t WS_HS = al(WS_XN8 + (size_t)MTOK * DM);
constexpr size_t WS_END = al(WS_HS + (size_t)MTOK * 4);

constexpr int RING_BYTES = 143360;
constexpr int LDSCTL_OFF = RING_BYTES, MISC_OFF = LDSCTL_OFF + 320;
constexpr int LDS_BYTES = 147456;

#define GAS __attribute__((address_space(1)))
#define LAS __attribute__((address_space(3)))
typedef unsigned short bf16;
typedef unsigned v4u __attribute__((ext_vector_type(4)));
typedef unsigned v2u __attribute__((ext_vector_type(2)));
typedef float f32x4 __attribute__((ext_vector_type(4)));
typedef float f32x2 __attribute__((ext_vector_type(2)));
typedef short bf16x8 __attribute__((ext_vector_type(8)));
typedef GAS unsigned gu32;
#define RLX_AGENT __ATOMIC_RELAXED, __HIP_MEMORY_SCOPE_AGENT
#define LDS_WAIT() asm volatile("s_waitcnt lgkmcnt(0)" ::: "memory")
#define VM_WAIT() asm volatile("s_waitcnt vmcnt(0)" ::: "memory")

__device__ __forceinline__ unsigned f2bf(float f) { unsigned u = __builtin_bit_cast(unsigned, f); return (u + 0x7fffu + ((u >> 16) & 1u)) >> 16; }
typedef __bf16 hwbf16x2 __attribute__((ext_vector_type(2)));
__device__ __forceinline__ unsigned pk2(float lo, float hi) { const f32x2 v = {lo, hi}; return __builtin_bit_cast(unsigned, __builtin_convertvector(v, hwbf16x2)); }
__device__ __forceinline__ float bf2f(unsigned b) { return __builtin_bit_cast(float, b << 16); }
__device__ __forceinline__ float bflo(unsigned w) { return __builtin_bit_cast(float, w << 16); }
__device__ __forceinline__ float bfhi(unsigned w) { return __builtin_bit_cast(float, w & 0xffff0000u); }
#ifndef USE_PERMSWAP
#define USE_PERMSWAP 1
#endif
template <int CTRL> __device__ __forceinline__ float dpp_f(float x) { return __builtin_bit_cast(float, __builtin_amdgcn_update_dpp(0, __builtin_bit_cast(int, x), CTRL, 0xF, 0xF, true)); }
template <int CTRL> __device__ __forceinline__ unsigned dpp_u(unsigned x) { return (unsigned)__builtin_amdgcn_update_dpp(0, (int)x, CTRL, 0xF, 0xF, true); }
#define DPP_XOR1 0xB1
#define DPP_XOR2 0x4E
#define DPP_HMIR 0x141
#define DPP_MIR 0x140
#define DPP_ROR4 0x124
#define DPP_ROR8 0x128
#if USE_PERMSWAP
#define PSWAP16(a, b) asm volatile("s_nop 1\n\tv_permlane16_swap_b32 %0, %1" : "+v"(a), "+v"(b))
#define PSWAP32(a, b) asm volatile("s_nop 1\n\tv_permlane32_swap_b32 %0, %1" : "+v"(a), "+v"(b))
__device__ __forceinline__ float x16_sum(float x) { unsigned a = __builtin_bit_cast(unsigned, x), b = a; PSWAP16(a, b); return __builtin_bit_cast(float, a) + __builtin_bit_cast(float, b); }
__device__ __forceinline__ float x32_sum(float x) { unsigned a = __builtin_bit_cast(unsigned, x), b = a; PSWAP32(a, b); return __builtin_bit_cast(float, a) + __builtin_bit_cast(float, b); }
__device__ __forceinline__ float x16_max(float x) { unsigned a = __builtin_bit_cast(unsigned, x), b = a; PSWAP16(a, b); return fmaxf(__builtin_bit_cast(float, a), __builtin_bit_cast(float, b)); }
__device__ __forceinline__ float x32_max(float x) { unsigned a = __builtin_bit_cast(unsigned, x), b = a; PSWAP32(a, b); return fmaxf(__builtin_bit_cast(float, a), __builtin_bit_cast(float, b)); }
__device__ __forceinline__ unsigned x16_umax(unsigned u) { unsigned a = u, b = u; PSWAP16(a, b); return a > b ? a : b; }
__device__ __forceinline__ unsigned x32_umax(unsigned u) { unsigned a = u, b = u; PSWAP32(a, b); return a > b ? a : b; }
#else
__device__ __forceinline__ float x16_sum(float x) { return x + __shfl_xor(x, 16); }
__device__ __forceinline__ float x32_sum(float x) { return x + __shfl_xor(x, 32); }
__device__ __forceinline__ float x16_max(float x) { return fmaxf(x, __shfl_xor(x, 16)); }
__device__ __forceinline__ float x32_max(float x) { return fmaxf(x, __shfl_xor(x, 32)); }
__device__ __forceinline__ unsigned x16_umax(unsigned u) { const unsigned o = __shfl_xor(u, 16); return u > o ? u : o; }
__device__ __forceinline__ unsigned x32_umax(unsigned u) { const unsigned o = __shfl_xor(u, 32); return u > o ? u : o; }
#endif
__device__ __forceinline__ float row_sum16(float x) { x += dpp_f<DPP_XOR1>(x); x += dpp_f<DPP_XOR2>(x); x += dpp_f<DPP_HMIR>(x); x += dpp_f<DPP_MIR>(x); return x; }
__device__ __forceinline__ float wave_sum(float v) { return x32_sum(x16_sum(row_sum16(v))); }
__device__ __forceinline__ float frcp(float x) { return __builtin_amdgcn_rcpf(x); }
__device__ __forceinline__ float frsq(float x) { return __builtin_amdgcn_rsqf(x); }
__device__ __forceinline__ unsigned pk_i8(f32x4 v) {
    const int q0 = (int)__builtin_rintf(fminf(fmaxf(v.x, -127.f), 127.f)), q1 = (int)__builtin_rintf(fminf(fmaxf(v.y, -127.f), 127.f));
    const int q2 = (int)__builtin_rintf(fminf(fmaxf(v.z, -127.f), 127.f)), q3 = (int)__builtin_rintf(fminf(fmaxf(v.w, -127.f), 127.f));
    return (unsigned)(q0 & 255) | ((unsigned)(q1 & 255) << 8) | ((unsigned)(q2 & 255) << 16) | ((unsigned)q3 << 24);
}
__device__ __forceinline__ float silu_f(float x) { return x * frcp(1.f + __expf(-x)); }
__device__ __forceinline__ float sigmoid_f(float x) { return frcp(1.f + __expf(-x)); }
__device__ __forceinline__ float gelu_tanh(float x) {
    const float u = 0.7978845608028654f * (x + 0.044715f * x * x * x);
    const float e = __expf(2.f * u);
    const float th = 1.f - 2.f * frcp(e + 1.f);
    return 0.5f * x * (1.f + th);
}
__device__ __forceinline__ bf16x8 ld8(const bf16* p) { return *(const bf16x8*)p; }
__device__ __forceinline__ bf16x8 ld8l(const LAS bf16* p) { return *(const LAS bf16x8*)p; }
#define MFMA16(a, b, c) __builtin_amdgcn_mfma_f32_16x16x32_bf16((a), (b), (c), 0, 0, 0)
__device__ __forceinline__ bf16x8 cvt8(f32x4 a, f32x4 b) {
    v4u r; r.x = pk2(a.x, a.y); r.y = pk2(a.z, a.w); r.z = pk2(b.x, b.y); r.w = pk2(b.z, b.w); return __builtin_bit_cast(bf16x8, r);
}

struct Frame {
    LAS unsigned char* lds;
    int tid, lane, wave, G, bid;
    const __attribute__((address_space(4))) char* ka;
    float* out;
    unsigned char* ws;
};
#define WSP(T, off) ((T*)(F.ws + (off)))
__device__ __forceinline__ const float* fin_(const __attribute__((address_space(4))) char* ka, int i) {
    const __attribute__((address_space(4))) char* p = ka; asm volatile("" : "+s"(p));
    return *(const float* const __attribute__((address_space(4)))*)(p + 8 * i);
}
#define FIN(i) fin_(F.ka, (i))
namespace pg8 {
#define PG8_LAS __attribute__((address_space(3)))
typedef unsigned short bf16_t;
typedef short bf16x8 __attribute__((ext_vector_type(8)));
typedef float f32x4 __attribute__((ext_vector_type(4)));
typedef unsigned u32x4 __attribute__((ext_vector_type(4)));
constexpr int BM = 256, BK = 64, HALF = 128, HTB = HALF * BK * 2  , STAGE_BYTES = 8 * HTB, NXCD = 8, WGM = 8;

__host__ __device__ __forceinline__ int lds_byte(int r, int c) { const int st = (r >> 4) * 2 + (c >> 5), rr = r & 15, cc = c & 31, ob = rr * 64 + cc * 2; return st * 1024 + (ob ^ (((ob >> 9) & 1) << 5)); }
__host__ __device__ __forceinline__ void stage_rc(int b, int& R, int& C) { const int st = b / 1024, sb = b % 1024, swz = sb ^ (((sb >> 9) & 1) << 5); R = (st >> 1) * 16 + swz / 64; C = (st & 1) * 32 + (swz % 64) / 2; }
__host__ __device__ __forceinline__ int perm32(int rho) { const int n = rho >> 4, i = rho & 15; return 8 * (i >> 2) + 4 * n + (i & 3); }

struct Unit { int pm, pn; };
struct Gemm { const bf16_t* A; const bf16_t* Bt; int M, N, K; };

struct StaticOrder {
    int nM, nN, nwg, G, c;
    __host__ __device__ void init(int M, int N, int G_, int c_) { nM = M / BM; nN = N / BM; nwg = nM * nN; G = G_; c = c_; }
    __host__ __device__ bool next(int i, Unit& u) const {
        const long L = (long)i * G + c; if (L >= nwg) return false;
        int wgid = (int)L; { const int q = nwg / NXCD, r = nwg % NXCD, xcd = wgid % NXCD, off = wgid / NXCD; wgid = (xcd < r ? xcd * (q + 1) : r * (q + 1) + (xcd - r) * q) + off; }
        const int nig = WGM * nN, gid = wgid / nig, fm = gid * WGM, gsz = (nM - fm) < WGM ? (nM - fm) : WGM;
        u.pm = fm + ((wgid % nig) % gsz); u.pn = (wgid % nig) / gsz; return true;
    }
    __device__ __forceinline__ void a_ready(const Unit&) const {}
    __device__ __forceinline__ void done(const Unit&) const {}
};
template <class Epi, class Sched, bool ALIGN_EPI = false, bool SP2 = false>
__device__ __forceinline__ void gemm_phase(PG8_LAS unsigned char* lds, const Gemm g, const Sched& S, const Epi& E) {
    const int tid = threadIdx.x, wid = __builtin_amdgcn_readfirstlane(tid >> 6), lane = tid & 63, wr = wid >> 2, wc = wid & 3, fr = lane & 15, fq = lane >> 4;
    const int K = g.K, nt = K / BK;
    unsigned voffA[2], voffB[2];
#pragma unroll
    for (int i = 0; i < 2; ++i) { int R, C; stage_rc(tid * 16 + i * 8192, R, C); const int Rb = Epi::PERM ? ((R & ~31) + perm32(R & 31)) : R;
        voffA[i] = (unsigned)(R * K + C) * 2u; voffB[i] = (unsigned)(Rb * K + C) * 2u; }
    const size_t kstep = (size_t)(BK * 2);
    const size_t hstep = (size_t)HALF * K * 2;
    const size_t tstep = 2 * hstep;
    const unsigned ldsw = (unsigned)wid * 1024u;
    const int aoff = lds_byte(wr * 64 + fr, fq * 8), boff = lds_byte(wc * 32 + fr, fq * 8);
#define PG8_SA(b, h) (((b) * 2 + (h)) * HTB)
#define PG8_SB(b, h) ((4 + (b) * 2 + (h)) * HTB)
#define PG8_STAGE(bufoff, gbase, voff) do { _Pragma("unroll") for (int _i = 0; _i < 2; ++_i) \
        __builtin_amdgcn_global_load_lds((const unsigned*)((const char*)(gbase) + (voff)[_i]), (PG8_LAS unsigned*)(lds + (bufoff) + ldsw + _i * 8192), 16, 0, 0); } while (0)
#define PG8_LDA(dst, b, h) do { _Pragma("unroll") for (int m = 0; m < 4; ++m) _Pragma("unroll") for (int k = 0; k < 2; ++k) dst[m][k] = *(const PG8_LAS bf16x8*)(lds + PG8_SA(b, h) + aoff + m * 2048 + k * 1024); } while (0)
#define PG8_LDB(dst, b, h) do { _Pragma("unroll") for (int n = 0; n < 2; ++n) _Pragma("unroll") for (int k = 0; k < 2; ++k) dst[n][k] = *(const PG8_LAS bf16x8*)(lds + PG8_SB(b, h) + boff + n * 2048 + k * 1024); } while (0)
#define PG8_MMA(ai, bj, At, Bt) do { __builtin_amdgcn_s_setprio(1); _Pragma("unroll") for (int m = 0; m < 4; ++m) _Pragma("unroll") for (int n = 0; n < 2; ++n) _Pragma("unroll") for (int k = 0; k < 2; ++k) \
        acc[ai][bj][m][n] = __builtin_amdgcn_mfma_f32_16x16x32_bf16(Bt[n][k], At[m][k], acc[ai][bj][m][n], 0, 0, 0); __builtin_amdgcn_s_setprio(0); } while (0)
#define PG8_WAIT_V(n) asm volatile("s_waitcnt vmcnt(" #n ")" ::: "memory")
#define PG8_WAIT_L(n) asm volatile("s_waitcnt lgkmcnt(" #n ")" ::: "memory")
#define PG8_BAR __builtin_amdgcn_s_barrier()
#define PG8_SCHED __builtin_amdgcn_sched_barrier(0)
    Unit cur, nxt; int ui = 0;
    if (!S.next(0, cur)) return;
    f32x4 acc[2][2][4][2];
#pragma unroll
    for (int a = 0; a < 2; ++a)
#pragma unroll
        for (int b = 0; b < 2; ++b)
#pragma unroll
            for (int m = 0; m < 4; ++m)
#pragma unroll
                for (int n = 0; n < 2; ++n) acc[a][b][m][n] = (f32x4){0.f, 0.f, 0.f, 0.f};
    bf16x8 At[4][2], B0[2][2], B1[2][2];
    const char* cA = (const char*)g.A + (size_t)cur.pm * tstep; const char* cB = (const char*)g.Bt + (size_t)cur.pn * tstep;
    S.a_ready(cur);
    if constexpr (SP2) {
        PG8_STAGE(PG8_SB(0, 0), cB, voffB); PG8_STAGE(PG8_SB(0, 1), cB + hstep, voffB); PG8_STAGE(PG8_SA(0, 0), cA, voffA); PG8_STAGE(PG8_SA(0, 1), cA + hstep, voffA);
        if (wr == 1) PG8_BAR;
        PG8_WAIT_V(2); PG8_BAR;
        PG8_STAGE(PG8_SB(1, 0), cB + kstep, voffB); PG8_STAGE(PG8_SA(1, 0), cA + kstep, voffA); PG8_STAGE(PG8_SB(1, 1), cB + hstep + kstep, voffB);
        PG8_WAIT_V(6); PG8_BAR;
    } else {
        PG8_STAGE(PG8_SB(0, 0), cB, voffB); PG8_STAGE(PG8_SA(0, 0), cA, voffA); PG8_STAGE(PG8_SB(0, 1), cB + hstep, voffB); PG8_STAGE(PG8_SA(0, 1), cA + hstep, voffA);
        if (wr == 1) PG8_BAR;
        PG8_WAIT_V(4); PG8_BAR;
        PG8_STAGE(PG8_SB(1, 0), cB + kstep, voffB); PG8_STAGE(PG8_SA(1, 0), cA + kstep, voffA); PG8_STAGE(PG8_SB(1, 1), cB + hstep + kstep, voffB);
        PG8_WAIT_V(6); PG8_BAR;
    }
    for (;;) {
        const bool has_next = S.next(ui + 1, nxt);
        const char* nA = has_next ? (const char*)g.A + (size_t)nxt.pm * tstep : cA; const char* nB = has_next ? (const char*)g.Bt + (size_t)nxt.pn * tstep : cB;
        for (int t = 0; t < nt; t += 2) {
            const bool last = (t == nt - 2);
            const char* a1 = cA + (size_t)(t + 1) * kstep;
            const char* a2 = last ? nA : cA + (size_t)(t + 2) * kstep; const char* b2 = last ? nB : cB + (size_t)(t + 2) * kstep;
            const char* a3 = a2 + kstep; const char* b3 = b2 + kstep;
            if (last && has_next) S.a_ready(nxt);
            if constexpr (SP2) {
            PG8_LDB(B0, 0, 0); PG8_LDB(B1, 0, 1); PG8_SCHED; PG8_LDA(At, 0, 0); PG8_STAGE(PG8_SA(1, 1), a1 + hstep, voffA);
            PG8_WAIT_V(8); PG8_WAIT_L(0); PG8_BAR; PG8_MMA(0, 0, At, B0); PG8_MMA(0, 1, At, B1); PG8_BAR; PG8_SCHED;
            PG8_LDA(At, 0, 1); PG8_STAGE(PG8_SB(0, 0), b2, voffB); PG8_STAGE(PG8_SB(0, 1), b2 + hstep, voffB); PG8_STAGE(PG8_SA(0, 0), a2, voffA);
            PG8_WAIT_V(8); PG8_WAIT_L(0); PG8_BAR; PG8_MMA(1, 0, At, B0); PG8_MMA(1, 1, At, B1); PG8_BAR; PG8_SCHED;
            PG8_LDB(B0, 1, 0); PG8_LDB(B1, 1, 1); PG8_SCHED; PG8_LDA(At, 1, 0); PG8_STAGE(PG8_SA(0, 1), a2 + hstep, voffA);
            PG8_WAIT_V(8); PG8_WAIT_L(0); PG8_BAR; PG8_MMA(0, 0, At, B0); PG8_MMA(0, 1, At, B1); PG8_BAR; PG8_SCHED;
            PG8_LDA(At, 1, 1); PG8_STAGE(PG8_SB(1, 0), b3, voffB); PG8_STAGE(PG8_SB(1, 1), b3 + hstep, voffB); PG8_STAGE(PG8_SA(1, 0), a3, voffA);
            PG8_WAIT_V(8); PG8_WAIT_L(0); PG8_BAR; PG8_MMA(1, 0, At, B0); PG8_MMA(1, 1, At, B1); PG8_BAR; PG8_SCHED;
            } else {
            PG8_LDB(B0, 0, 0); PG8_SCHED; PG8_LDA(At, 0, 0); PG8_STAGE(PG8_SA(1, 1), a1 + hstep, voffA);
            PG8_WAIT_L(8); PG8_BAR; PG8_WAIT_L(0); PG8_MMA(0, 0, At, B0); PG8_BAR; PG8_SCHED;
            PG8_LDB(B1, 0, 1); PG8_STAGE(PG8_SB(0, 0), b2, voffB);
            PG8_BAR; PG8_WAIT_L(0); PG8_MMA(0, 1, At, B1); PG8_BAR;
            PG8_LDA(At, 0, 1); PG8_STAGE(PG8_SA(0, 0), a2, voffA);
            PG8_BAR; PG8_WAIT_L(0); PG8_MMA(1, 0, At, B0); PG8_BAR; PG8_SCHED;
            PG8_STAGE(PG8_SB(0, 1), b2 + hstep, voffB);
            PG8_WAIT_V(6); PG8_BAR; PG8_MMA(1, 1, At, B1); PG8_BAR;
            PG8_LDB(B0, 1, 0); PG8_SCHED; PG8_LDA(At, 1, 0); PG8_STAGE(PG8_SA(0, 1), a2 + hstep, voffA);
            PG8_WAIT_L(8); PG8_BAR; PG8_WAIT_L(0); PG8_MMA(0, 0, At, B0); PG8_BAR; PG8_SCHED;
            PG8_LDB(B1, 1, 1); PG8_STAGE(PG8_SB(1, 0), b3, voffB);
            PG8_BAR; PG8_WAIT_L(0); PG8_MMA(0, 1, At, B1); PG8_BAR;
            PG8_LDA(At, 1, 1); PG8_STAGE(PG8_SA(1, 0), a3, voffA);
            PG8_BAR; PG8_WAIT_L(0); PG8_MMA(1, 0, At, B0); PG8_BAR; PG8_SCHED;
            PG8_STAGE(PG8_SB(1, 1), b3 + hstep, voffB);
            PG8_WAIT_V(6); PG8_BAR; PG8_MMA(1, 1, At, B1); PG8_BAR;
            }
        }
        if constexpr (ALIGN_EPI) { if (wr == 0) PG8_BAR; }
        if constexpr (!Epi::AFTER_DRAIN) { E(acc, cur, wr, wc, fr, fq); S.done(cur); }
        if (!has_next) break;
#pragma unroll
        for (int a = 0; a < 2; ++a)
#pragma unroll
            for (int b = 0; b < 2; ++b)
#pragma unroll
                for (int m = 0; m < 4; ++m)
#pragma unroll
                    for (int n = 0; n < 2; ++n) acc[a][b][m][n] = (f32x4){0.f, 0.f, 0.f, 0.f};
        cur = nxt; cA = nA; cB = nB; ++ui;
        if constexpr (ALIGN_EPI) { if (wr == 1) PG8_BAR; }
    }
    PG8_WAIT_V(0);
    if constexpr (!ALIGN_EPI) { if (wr == 0) PG8_BAR; }
    PG8_BAR;
    if constexpr (Epi::AFTER_DRAIN) { E.fused(acc, cur, wr, wc, fr, fq, lds, wid, lane); S.done(cur); }
#undef PG8_SA
#undef PG8_SB
#undef PG8_STAGE
#undef PG8_LDA
#undef PG8_LDB
#undef PG8_MMA
#undef PG8_WAIT_V
#undef PG8_WAIT_L
#undef PG8_BAR
#undef PG8_SCHED
}
}
#define XB_TMO      128
#define XB_XCNT(j)  (256  + 64 * (j))
#define XB_XSUB(j)  (1280 + 64 * (j))
#define XB_XGEN(j)  (2304 + 64 * (j))
#define XB_TOP      3328
#define XB_TOPGEN   3392
#define XCD_BAR_WORDS 3456
#define XB_SPIN_CAP (1u << 18)

__device__ __forceinline__ unsigned xb_ld(unsigned* p)              { return __hip_atomic_load(p, __ATOMIC_RELAXED, __HIP_MEMORY_SCOPE_AGENT); }
__device__ __forceinline__ unsigned xb_add(unsigned* p, unsigned v) { return __hip_atomic_fetch_add(p, v, __ATOMIC_RELAXED, __HIP_MEMORY_SCOPE_AGENT); }
__device__ __forceinline__ unsigned xb_xcc_id() { return (unsigned)__builtin_amdgcn_s_getreg((3 << 11) | 20) & 0xFu; }
#define XB_SPIN(cond, bar) do { unsigned _sp = 0; while (cond) { __builtin_amdgcn_s_sleep(1); \
    if ((++_sp & 255u) == 0u) { if (xb_ld(&(bar)[XB_TMO])) break; if (_sp > XB_SPIN_CAP) { atomicAdd(&(bar)[XB_TMO], 1u); break; } } } } while (0)

struct XcdBarrier {
    unsigned* bar; unsigned x;
    volatile LAS unsigned* st;
};

__device__ __forceinline__ XcdBarrier xcd_barrier_post(unsigned* bar, volatile LAS unsigned* st) {
    XcdBarrier b; b.bar = bar; b.x = xb_xcc_id(); b.st = st;
    if (threadIdx.x == 0) { st[2] = xb_add(&bar[XB_XCNT(b.x)], 1u); st[3] = 1u; }
    return b;
}
__device__ __forceinline__ void xcd_barrier_complete(unsigned* bar, unsigned x, unsigned& nloc, unsigned& nx) {
    const unsigned G = gridDim.x * gridDim.y * gridDim.z;
    unsigned sum, cnt, mine, sp = 0u;
    for (;;) {
        sum = 0u; cnt = 0u; mine = 0u;
#pragma unroll
        for (unsigned j = 0; j < 16; ++j) { const unsigned c = xb_ld(&bar[XB_XCNT(j)]); sum += c; cnt += (c > 0u) ? 1u : 0u; mine = (j == x) ? c : mine; }
        if (sum == G) break;
        __builtin_amdgcn_s_sleep(1);
        if ((++sp & 255u) == 0u) { if (xb_ld(&bar[XB_TMO])) break; if (sp > XB_SPIN_CAP) { atomicAdd(&bar[XB_TMO], 1u); break; } }
    }
    nloc = mine > 0u ? mine : 1u; nx = cnt > 0u ? cnt : 1u;
}

__device__ __forceinline__ void xcd_barrier(const XcdBarrier& b) {
    asm volatile("s_waitcnt vmcnt(0)" ::: "memory");
    __syncthreads();
    if (threadIdx.x == 0) {
        unsigned* bar = b.bar;
        __builtin_amdgcn_s_waitcnt(0);
        unsigned nloc = b.st[0], nx = b.st[1];
        if (nloc == 0u) { xcd_barrier_complete(bar, b.x, nloc, nx); b.st[0] = nloc; b.st[1] = nx; }
        const unsigned old = xb_add(&bar[XB_XSUB(b.x)], 1u);
        const unsigned gen = old / nloc;
        if (old + 1u == (gen + 1u) * nloc) {
            __builtin_amdgcn_fence(__ATOMIC_RELEASE, "agent");
            asm volatile("s_waitcnt vmcnt(0)" ::: "memory");
            const unsigned og = xb_add(&bar[XB_TOP], 1u);
            const unsigned tg = og / nx;
            if (og + 1u == (tg + 1u) * nx) xb_add(&bar[XB_TOPGEN], 1u);
            else XB_SPIN(xb_ld(&bar[XB_TOPGEN]) == tg, bar);
            __builtin_amdgcn_fence(__ATOMIC_ACQUIRE, "agent");
            xb_add(&bar[XB_XGEN(b.x)], 1u);
            asm volatile("s_waitcnt vmcnt(0)" ::: "memory");
        } else {
            XB_SPIN(xb_ld(&bar[XB_XGEN(b.x)]) == gen, bar);
            __builtin_amdgcn_fence(__ATOMIC_ACQUIRE, "agent");
            asm volatile("s_waitcnt vmcnt(0)" ::: "memory");
        }
    }
    __syncthreads();
}

namespace pg8 {
template <class Fn> struct EpiFn {
    static constexpr bool PERM = true, AFTER_DRAIN = false;
    Fn f;
    __device__ __forceinline__ void operator()(const f32x4 (&acc)[2][2][4][2], const Unit& u, int wr, int wc, int fr, int fq) const {
        const int row0 = u.pm * BM + wr * 64 + fr, col0 = u.pn * BM + wc * 32 + 8 * fq;
#pragma unroll
        for (int ai = 0; ai < 2; ++ai)
#pragma unroll
            for (int m = 0; m < 4; ++m)
#pragma unroll
                for (int bj = 0; bj < 2; ++bj) f.e8(row0 + ai * HALF + m * 16, col0 + bj * HALF, acc[ai][bj][m][0], acc[ai][bj][m][1]);
    }
};
}

struct FnBf16 {
    bf16* O; int ld;
    __device__ __forceinline__ void e8(int row, int col, f32x4 a, f32x4 b) const {
        v4u w; w.x = pk2(a.x, a.y); w.y = pk2(a.z, a.w); w.z = pk2(b.x, b.y); w.w = pk2(b.z, b.w);
        *(v4u*)(O + (size_t)row * ld + col) = w;
    }
    __device__ __forceinline__ void e4(int row, int col, f32x4 a) const {
        v2u w; w.x = pk2(a.x, a.y); w.y = pk2(a.z, a.w);
        *(v2u*)(O + (size_t)row * ld + col) = w;
    }
};
struct FnResid {
    float* XS; const float* baseP; const float* baseS;
    __device__ __forceinline__ const float* brow(int row) const { return row < MP ? baseP + (size_t)row * DM : baseS + (size_t)(row - MP) * DM; }
    __device__ __forceinline__ void e8(int row, int col, f32x4 a, f32x4 b) const {
        const float* br = brow(row) + col; float* o = XS + (size_t)row * DM + col;
        const f32x4 x0 = *(const f32x4*)br, x1 = *(const f32x4*)(br + 4);
        *(f32x4*)o = x0 + a; *(f32x4*)(o + 4) = x1 + b;
    }
    __device__ __forceinline__ void e4(int row, int col, f32x4 a) const {
        const float* br = brow(row) + col; float* o = XS + (size_t)row * DM + col;
        *(f32x4*)o = *(const f32x4*)br + a;
    }
};
struct FnF32 {
    float* O; int ld;
    __device__ __forceinline__ void e8(int row, int col, f32x4 a, f32x4 b) const { float* o = O + (size_t)row * ld + col; *(f32x4*)o = a; *(f32x4*)(o + 4) = b; }
    __device__ __forceinline__ void e4(int row, int col, f32x4 a) const { *(f32x4*)(O + (size_t)row * ld + col) = a; }
};
struct FnKvq {
    bf16* O; const float* ssq;
    __device__ __forceinline__ float rstd(int row) const { const f32x4 s0 = *(const f32x4*)(ssq + (size_t)row * 8), s1 = *(const f32x4*)(ssq + (size_t)row * 8 + 4);
        return frsq((((s0.x + s0.y) + (s0.z + s0.w)) + ((s1.x + s1.y) + (s1.z + s1.w))) * (1.f / DM) + EPS); }
    __device__ __forceinline__ void e8(int row, int col, f32x4 a, f32x4 b) const {
        if (col < NKVQ_REAL) { const float rs = rstd(row); a = a * rs; b = b * rs; *(v4u*)(O + (size_t)row * NKVQ + col) = (v4u){pk2(a.x, a.y), pk2(a.z, a.w), pk2(b.x, b.y), pk2(b.z, b.w)}; }
    }
    __device__ __forceinline__ void e4(int row, int col, f32x4 a) const {
        if (col < NKVQ_REAL) { a = a * rstd(row); *(v2u*)(O + (size_t)row * NKVQ + col) = (v2u){pk2(a.x, a.y), pk2(a.z, a.w)}; }
    }
};

template <class Fn>
__device__ __forceinline__ void skinny_gemm(Frame& F, const bf16* A, const bf16* Bt, int N, int row_base, const Fn& fn) {
    const int fr = F.lane & 15, fq = F.lane >> 4;
    const int nun = N / 16;
    for (int u = F.bid; u < nun; u += F.G) {
        const bf16* ap = Bt + (size_t)(u * 16 + fr) * DM + fq * 8;
        const bf16* bp = A + (size_t)(F.wave * 16 + fr) * DM + fq * 8;
        f32x4 acc = {0.f, 0.f, 0.f, 0.f};
#pragma unroll 8
        for (int ks = 0; ks < 32; ++ks) acc = MFMA16(ld8(ap + ks * 32), ld8(bp + ks * 32), acc);
        fn.e4(row_base + F.wave * 16 + fr, u * 16 + 4 * fq, acc);
    }
}

template <class Fn>
__device__ __forceinline__ void gemm_all(Frame& F, const bf16* A, const bf16* Bt, int N, const Fn& fn) {
    pg8::Gemm g{A, Bt, MP, N, DM}; pg8::StaticOrder S; S.init(MP, N, F.G, F.bid);
    pg8::EpiFn<Fn> E{fn};
    pg8::gemm_phase<pg8::EpiFn<Fn>, pg8::StaticOrder, true, true>(F.lds, g, S, E);
    skinny_gemm(F, A + (size_t)MP * DM, Bt, N, MP, fn);
}

__device__ __forceinline__ void p0_transpose_item(const float* W, int N, bf16* WT, int row_off, const float* gain, LAS float* scr, int item, int lane) {
    const int nblk = (N + 31) / 32, kb = item / nblk, nb = item % nblk, k0 = 64 * kb, n0 = 32 * nb;
    const int n_ = n0 + (lane & 31); const bool inb = n_ < N; const float* wp = W + (size_t)(k0 + (lane >> 5)) * N + (inb ? n_ : N - 1); const float* gp = gain ? gain + k0 + (lane >> 5) : W;
#pragma unroll 8
    for (int i = 0; i < 32; ++i) { float v = wp[(size_t)(2 * i) * N]; if (gain) v *= gp[2 * i];
        scr[(2 * i + (lane >> 5)) * 33 + (lane & 31)] = inb ? v : 0.f; }
    LDS_WAIT(); asm volatile("" ::: "memory");
    const int c = lane & 7;
#pragma unroll
    for (int j = 0; j < 4; ++j) { const int n = (lane >> 3) + 8 * j; const LAS float* s = scr + (8 * c) * 33 + n;
        v4u o; o.x = pk2(s[0 * 33], s[1 * 33]); o.y = pk2(s[2 * 33], s[3 * 33]); o.z = pk2(s[4 * 33], s[5 * 33]); o.w = pk2(s[6 * 33], s[7 * 33]);
        if (n0 + n < N) *(v4u*)(WT + (size_t)(row_off + n0 + n) * DM + k0 + 8 * c) = o; }
    LDS_WAIT(); asm volatile("" ::: "memory");
}
__device__ __forceinline__ void rms_row_to_bf16(const float* xrow, bf16* orow, int lane) {
    const f32x4* xr = (const f32x4*)xrow + lane;
    f32x4 v[4]; float s = 0.f;
#pragma unroll
    for (int j = 0; j < 4; ++j) { v[j] = xr[64 * j]; s += (v[j].x * v[j].x + v[j].y * v[j].y) + (v[j].z * v[j].z + v[j].w * v[j].w); }
    const float rstd = frsq(wave_sum(s) * (1.f / DM) + EPS);
    v2u* o8 = (v2u*)orow + lane;
#pragma unroll
    for (int j = 0; j < 4; ++j) { v2u w; w.x = pk2(v[j].x * rstd, v[j].y * rstd); w.y = pk2(v[j].z * rstd, v[j].w * rstd); o8[64 * j] = w; }
}
__device__ __forceinline__ void rms_fin_bf16(const f32x4 v0, const f32x4 v1, const f32x4 v2, const f32x4 v3, bf16* orow, int lane) {
    const f32x4 v[4] = {v0, v1, v2, v3}; float s = 0.f;
#pragma unroll
    for (int j = 0; j < 4; ++j) s += (v[j].x * v[j].x + v[j].y * v[j].y) + (v[j].z * v[j].z + v[j].w * v[j].w);
    const float rstd = frsq(wave_sum(s) * (1.f / DM) + EPS);
    v2u* o8 = (v2u*)orow + lane;
#pragma unroll
    for (int j = 0; j < 4; ++j) { v2u w; w.x = pk2(v[j].x * rstd, v[j].y * rstd); w.y = pk2(v[j].z * rstd, v[j].w * rstd); o8[64 * j] = w; }
}
__device__ __forceinline__ void rms_row_to_bf16_i8(const float* xrow, bf16* orow, unsigned* o8row, float* hs, int lane) {
    const f32x4* xr = (const f32x4*)xrow + lane;
    f32x4 v[4]; float s = 0.f, mx = 0.f;
#pragma unroll
    for (int j = 0; j < 4; ++j) { v[j] = xr[64 * j]; s += (v[j].x * v[j].x + v[j].y * v[j].y) + (v[j].z * v[j].z + v[j].w * v[j].w);
        mx = fmaxf(mx, fmaxf(fmaxf(fabsf(v[j].x), fabsf(v[j].y)), fmaxf(fabsf(v[j].z), fabsf(v[j].w)))); }
    const float rstd = frsq(wave_sum(s) * (1.f / DM) + EPS);
    mx = fmaxf(mx, dpp_f<DPP_XOR1>(mx)); mx = fmaxf(mx, dpp_f<DPP_XOR2>(mx)); mx = fmaxf(mx, dpp_f<DPP_HMIR>(mx)); mx = fmaxf(mx, dpp_f<DPP_MIR>(mx)); mx = x32_max(x16_max(mx));
    const float hmax = fmaxf(mx * rstd, 1e-20f), qs = 127.f * frcp(hmax);
    if (lane == 0) *hs = hmax * (1.f / 127.f);
    v2u* o16 = (v2u*)orow + lane;
#pragma unroll
    for (int j = 0; j < 4; ++j) { const f32x4 y = v[j] * rstd; v2u w; w.x = pk2(y.x, y.y); w.y = pk2(y.z, y.w); o16[64 * j] = w; o8row[lane + 64 * j] = pk_i8(y * qs); }
}
__device__ __forceinline__ void rms_fin_bf16_i8(const f32x4 v0, const f32x4 v1, const f32x4 v2, const f32x4 v3, bf16* orow, unsigned* o8row, float* hs, int lane) {
    const f32x4 v[4] = {v0, v1, v2, v3}; float s = 0.f, mx = 0.f;
#pragma unroll
    for (int j = 0; j < 4; ++j) { s += (v[j].x * v[j].x + v[j].y * v[j].y) + (v[j].z * v[j].z + v[j].w * v[j].w);
        mx = fmaxf(mx, fmaxf(fmaxf(fabsf(v[j].x), fabsf(v[j].y)), fmaxf(fabsf(v[j].z), fabsf(v[j].w)))); }
    const float rstd = frsq(wave_sum(s) * (1.f / DM) + EPS);
    mx = fmaxf(mx, dpp_f<DPP_XOR1>(mx)); mx = fmaxf(mx, dpp_f<DPP_XOR2>(mx)); mx = fmaxf(mx, dpp_f<DPP_HMIR>(mx)); mx = fmaxf(mx, dpp_f<DPP_MIR>(mx)); mx = x32_max(x16_max(mx));
    const float hmax = fmaxf(mx * rstd, 1e-20f), qs = 127.f * frcp(hmax);
    if (lane == 0) *hs = hmax * (1.f / 127.f);
    v2u* o16 = (v2u*)orow + lane;
#pragma unroll
    for (int j = 0; j < 4; ++j) { const f32x4 y = v[j] * rstd; v2u w; w.x = pk2(y.x, y.y); w.y = pk2(y.z, y.w); o16[64 * j] = w; o8row[lane + 64 * j] = pk_i8(y * qs); }
}
__device__ __forceinline__ void rms_rows_phase(Frame& F, int gw, int ngw) {
    int r = gw;
    for (; r + 3 * ngw < MTOK; r += 4 * ngw) {
        const f32x4* xa = (const f32x4*)(WSP(float, WS_XS) + (size_t)r * DM) + F.lane; const f32x4* xb = xa + (size_t)ngw * (DM / 4); const f32x4* xc = xb + (size_t)ngw * (DM / 4); const f32x4* xd = xc + (size_t)ngw * (DM / 4);
        const f32x4 a0 = xa[0], a1 = xa[64], a2 = xa[128], a3 = xa[192], b0 = xb[0], b1 = xb[64], b2 = xb[128], b3 = xb[192];
        const f32x4 c0 = xc[0], c1 = xc[64], c2 = xc[128], c3 = xc[192], d0 = xd[0], d1 = xd[64], d2 = xd[128], d3 = xd[192];
        rms_fin_bf16_i8(a0, a1, a2, a3, WSP(bf16, WS_XNB) + (size_t)r * DM, WSP(unsigned, WS_XN8) + (size_t)r * (DM / 4), WSP(float, WS_HS) + r, F.lane);
        rms_fin_bf16_i8(b0, b1, b2, b3, WSP(bf16, WS_XNB) + (size_t)(r + ngw) * DM, WSP(unsigned, WS_XN8) + (size_t)(r + ngw) * (DM / 4), WSP(float, WS_HS) + r + ngw, F.lane);
        rms_fin_bf16_i8(c0, c1, c2, c3, WSP(bf16, WS_XNB) + (size_t)(r + 2 * ngw) * DM, WSP(unsigned, WS_XN8) + (size_t)(r + 2 * ngw) * (DM / 4), WSP(float, WS_HS) + r + 2 * ngw, F.lane);
        rms_fin_bf16_i8(d0, d1, d2, d3, WSP(bf16, WS_XNB) + (size_t)(r + 3 * ngw) * DM, WSP(unsigned, WS_XN8) + (size_t)(r + 3 * ngw) * (DM / 4), WSP(float, WS_HS) + r + 3 * ngw, F.lane);
    }
    for (; r + ngw < MTOK; r += 2 * ngw) {
        const f32x4* xa = (const f32x4*)(WSP(float, WS_XS) + (size_t)r * DM) + F.lane; const f32x4* xb = (const f32x4*)(WSP(float, WS_XS) + (size_t)(r + ngw) * DM) + F.lane;
        const f32x4 a0 = xa[0], a1 = xa[64], a2 = xa[128], a3 = xa[192], b0 = xb[0], b1 = xb[64], b2 = xb[128], b3 = xb[192];
        rms_fin_bf16_i8(a0, a1, a2, a3, WSP(bf16, WS_XNB) + (size_t)r * DM, WSP(unsigned, WS_XN8) + (size_t)r * (DM / 4), WSP(float, WS_HS) + r, F.lane);
        rms_fin_bf16_i8(b0, b1, b2, b3, WSP(bf16, WS_XNB) + (size_t)(r + ngw) * DM, WSP(unsigned, WS_XN8) + (size_t)(r + ngw) * (DM / 4), WSP(float, WS_HS) + r + ngw, F.lane);
    }
    if (r < MTOK) rms_row_to_bf16_i8(WSP(float, WS_XS) + (size_t)r * DM, WSP(bf16, WS_XNB) + (size_t)r * DM, WSP(unsigned, WS_XN8) + (size_t)r * (DM / 4), WSP(float, WS_HS) + r, F.lane);
}
__device__ __forceinline__ const float* xin_row(Frame& F, int row) { return row < MP ? FIN(0) + (size_t)row * DM : FIN(1) + (size_t)(row - MP) * DM; }

__device__ __forceinline__ void peer_tables_to_fp8(Frame& F, size_t thr, size_t nthr, size_t lo = 0, size_t hi = (size_t)2 * NEXP * DM / 8) {
    const size_t gt = thr, NGT = nthr;
        for (int t = 0; t < 2; ++t) { const f32x4* src = (const f32x4*)FIN(27 + t); v2u* dst = (v2u*)WSP(unsigned char, t == 0 ? WS_PU : WS_PV); const float* pln = FIN(24);
            for (size_t i0 = lo + gt; i0 < hi; i0 += (size_t)4 * NGT) {
                f32x4 a[4], b[4];
#pragma unroll
                for (int u = 0; u < 4; ++u) { const size_t i = i0 + (size_t)u * NGT; if (i < hi) { a[u] = src[2 * i]; b[u] = src[2 * i + 1]; } }
#pragma unroll
                for (int u = 0; u < 4; ++u) { const size_t i = i0 + (size_t)u * NGT; if (i < hi) {
                    if (t == 0) { const float* gp = pln + ((i >> 21) << 10) + ((i & 127) << 3); a[u] = a[u] * *(const f32x4*)gp * 32.f; b[u] = b[u] * *(const f32x4*)(gp + 4) * 32.f; }
                    else { a[u] = a[u] * 16.f; b[u] = b[u] * 16.f; }
                    int w0, w1;
                    if (t == 0) { w0 = (int)pk_i8(a[u] * 19.f); w1 = (int)pk_i8(b[u] * 19.f); }
                    else { w0 = __builtin_amdgcn_cvt_pk_fp8_f32(a[u].x, a[u].y, 0, false); w0 = __builtin_amdgcn_cvt_pk_fp8_f32(a[u].z, a[u].w, w0, true);
                           w1 = __builtin_amdgcn_cvt_pk_fp8_f32(b[u].x, b[u].y, 0, false); w1 = __builtin_amdgcn_cvt_pk_fp8_f32(b[u].z, b[u].w, w1, true); }
                    dst[((((i >> 21) * 8 + ((i & 127) >> 4)) * (size_t)NEXP + ((i >> 7) & (NEXP - 1))) << 4) + (i & 15)] = (v2u){(unsigned)w0, (unsigned)w1}; } } } }
}

constexpr int FD_BUF = 16384;
__device__ __forceinline__ void fs_direct_task(Frame& F, int task) {
    int lane_ = F.lane; asm volatile("" : "+v"(lane_));
    const int lane = lane_, w = F.wave, fr = lane & 15, fq = lane >> 4, kv = w >> 2, g = w & 3, bs = task >> 4, c0 = (task & 15) * 32;
    LAS unsigned char* L = F.lds; asm volatile("" : "+v"(L));
    const float* cache = FIN(2); const int* pt = (const int*)FIN(6) + bs * NPAGES;
    const float* base[2];
#pragma unroll
    for (int nt = 0; nt < 2; ++nt) { const int t0 = 16 * (c0 + 16 * nt + fr); base[nt] = cache + ((size_t)pt[t0 >> 7] * PAGE + (t0 & 127)) * 1024 + kv * 256 + g * 64 + 8 * fq; }
    const bf16* wsrc[2]; int wdst[2];
#pragma unroll
    for (int q = 0; q < 2; ++q) { const int item = F.tid + 512 * q, kvw = item >> 9, n = (item >> 2) & 127, kq = item & 3;
        wsrc[q] = WSP(bf16, WS_W1BD) + (size_t)(kvw * 128 + n) * 2048 + kvw * 1024 + 8 * kq; wdst[q] = ((kvw * 8 + (n >> 4)) * 64 + kq * 16 + (n & 15)) * 16; }
    f32x4 acc[2][8];
#pragma unroll
    for (int nt = 0; nt < 2; ++nt)
#pragma unroll
        for (int mt = 0; mt < 8; ++mt) acc[nt][mt] = (f32x4){0.f, 0.f, 0.f, 0.f};
    f32x4 S0[2][4], S1[2][4]; v4u wr[2];
#define FD_DATA(S, r) do { const int r_ = (r) < 16 ? (r) : 15; _Pragma("unroll") for (int nt_ = 0; nt_ < 2; ++nt_) { const float* p_ = base[nt_] + r_ * 1024; \
        S[nt_][0] = *(const f32x4*)p_; S[nt_][1] = *(const f32x4*)(p_ + 4); S[nt_][2] = *(const f32x4*)(p_ + 32); S[nt_][3] = *(const f32x4*)(p_ + 36); } } while (0)
#define FD_WLOAD(ks) do { const int ks_ = (ks) < 32 ? (ks) : 31; wr[0] = *(const v4u*)(wsrc[0] + 32 * ks_); wr[1] = *(const v4u*)(wsrc[1] + 32 * ks_); } while (0)
#define FD_WSTORE(buf) do { *(LAS v4u*)(L + (buf) * FD_BUF + wdst[0]) = wr[0]; *(LAS v4u*)(L + (buf) * FD_BUF + wdst[1]) = wr[1]; } while (0)
#define FD_KSTEP(bq, ks, buf) do { \
        _Pragma("unroll") for (int mt_ = 0; mt_ < 8; ++mt_) { const bf16x8 a_ = *(const LAS bf16x8*)(L + (buf) * FD_BUF + ((kv * 8 + mt_) * 64 + lane) * 16); \
            acc[0][mt_] = MFMA16(a_, bq[0], acc[0][mt_]); acc[1][mt_] = MFMA16(a_, bq[1], acc[1][mt_]); } \
        FD_WSTORE((buf) ^ 1); FD_WLOAD((ks) + 2); \
        __syncthreads(); } while (0)
#define FD_ROW(S, r) do { bf16x8 b0_[2], b1_[2]; _Pragma("unroll") for (int nt_ = 0; nt_ < 2; ++nt_) { b0_[nt_] = cvt8(S[nt_][0], S[nt_][1]); b1_[nt_] = cvt8(S[nt_][2], S[nt_][3]); } \
        FD_DATA(S, (r) + 2); \
        FD_KSTEP(b0_, 2 * (r), 0); FD_KSTEP(b1_, 2 * (r) + 1, 1); } while (0)
    FD_WLOAD(0); FD_WSTORE(0); FD_WLOAD(1); FD_DATA(S0, 0); FD_DATA(S1, 1);
    __syncthreads();
#pragma unroll 1
    for (int r = 0; r < 16; r += 2) { FD_ROW(S0, r); FD_ROW(S1, r + 1); }
#undef FD_KSTEP
#undef FD_ROW
#undef FD_DATA
#undef FD_WLOAD
#undef FD_WSTORE
    bf16* fs = WSP(bf16, WS_FS) + ((size_t)(bs * 4 + g) * 512 + c0 + fr) * 256 + kv * 128 + 4 * fq;
#pragma unroll
    for (int nt = 0; nt < 2; ++nt)
#pragma unroll
        for (int mt = 0; mt < 8; ++mt) *(v2u*)(fs + (size_t)nt * 16 * 256 + 16 * mt) = (v2u){pk2(acc[nt][mt][0], acc[nt][mt][1]), pk2(acc[nt][mt][2], acc[nt][mt][3])};
    __syncthreads();
}

__device__ __forceinline__ void p0_prologue(Frame& F) {
    LAS float* scr = (LAS float*)(F.lds + F.wave * 16384);
    const int gw = F.bid * 8 + F.wave, NGW = F.G * 8;
    const int gt = F.bid * 512 + F.tid, NGT = F.G * 512;
    {
        constexpr int I_IN = 128 * 16, I_OA = 32 * 16, I_KV = 48 * 16, I_QG = 34 * 16, I_OB = 32 * 16, I_PQ = 64 * 16;
        constexpr int NITEMS = I_IN + I_OA + I_KV + I_QG + I_OB + 2 * I_PQ;
        for (int it = gw; it < NITEMS; it += NGW) {
            int r = it;
            if (r < I_IN) {
                const int kb = r / 128, nb = r % 128, k0 = 64 * kb, n0 = 32 * nb; const float* W = FIN(8); const float* gain = FIN(7);
#pragma unroll 8
                for (int i = 0; i < 32; ++i) { const int kk = 2 * i + (F.lane >> 5); scr[kk * 33 + (F.lane & 31)] = W[(size_t)(k0 + kk) * GPROJ + n0 + (F.lane & 31)] * gain[k0 + kk]; }
                LDS_WAIT(); asm volatile("" ::: "memory");
                const int c = F.lane & 7;
#pragma unroll
                for (int j = 0; j < 4; ++j) { const int n = (F.lane >> 3) + 8 * j; const LAS float* s = scr + (8 * c) * 33 + n;
                    v4u o; o.x = pk2(s[0 * 33], s[1 * 33]); o.y = pk2(s[2 * 33], s[3 * 33]); o.z = pk2(s[4 * 33], s[5 * 33]); o.w = pk2(s[6 * 33], s[7 * 33]);
                    *(v4u*)(WSP(bf16, WS_WIN_T) + (size_t)(n0 + n) * DM + k0 + 8 * c) = o; }
                LDS_WAIT(); asm volatile("" ::: "memory");
                continue; }
            r -= I_IN;
            if (r < I_OA) { p0_transpose_item(FIN(13), 1024, WSP(bf16, WS_WOA_T), 0, nullptr, scr, r, F.lane); continue; } r -= I_OA;
            if (r < I_KV) { p0_transpose_item(FIN(15), NKV, WSP(bf16, WS_WKVQ_T), 0, FIN(14), scr, r, F.lane); continue; } r -= I_KV;
            if (r < I_QG) { p0_transpose_item(FIN(21), NQG, WSP(bf16, WS_WKVQ_T), NKV, FIN(20), scr, r, F.lane); continue; } r -= I_QG;
            if (r < I_OB) { p0_transpose_item(FIN(23), 1024, WSP(bf16, WS_WOB_T), 0, nullptr, scr, r, F.lane); continue; } r -= I_OB;
            if (r < I_PQ) { p0_transpose_item(FIN(25), 2048, WSP(bf16, WS_WPQ_T), 0, FIN(24), scr, r, F.lane); continue; } r -= I_PQ;
            p0_transpose_item(FIN(25) + (size_t)1024 * 2048, 2048, WSP(bf16, WS_WPQ_T) + (size_t)2048 * 1024, 0, FIN(24) + 1024, scr, r, F.lane);
        }
        for (int i = gt; i < (NKVQ - NKVQ_REAL) * DM / 8; i += NGT) ((v4u*)(WSP(bf16, WS_WKVQ_T) + (size_t)NKVQ_REAL * DM))[i] = (v4u){0u, 0u, 0u, 0u};
        for (int i = gt; i < 16 * 1024; i += NGT) { const int j = i >> 10, k = i & 1023; WSP(float, WS_WAB)[i] = FIN(7)[k] * FIN(8)[(size_t)k * GPROJ + 4096 + j]; }
    }
    { int m = gw;
      for (; m + 3 * NGW < MTOK; m += 4 * NGW) {
          const f32x4* xa = (const f32x4*)xin_row(F, m) + F.lane; const f32x4* xb = (const f32x4*)xin_row(F, m + NGW) + F.lane; const f32x4* xc = (const f32x4*)xin_row(F, m + 2 * NGW) + F.lane; const f32x4* xd = (const f32x4*)xin_row(F, m + 3 * NGW) + F.lane;
          const f32x4 a0 = xa[0], a1 = xa[64], a2 = xa[128], a3 = xa[192], b0 = xb[0], b1 = xb[64], b2 = xb[128], b3 = xb[192];
          const f32x4 c0 = xc[0], c1 = xc[64], c2 = xc[128], c3 = xc[192], d0 = xd[0], d1 = xd[64], d2 = xd[128], d3 = xd[192];
          rms_fin_bf16(a0, a1, a2, a3, WSP(bf16, WS_XNA) + (size_t)m * DM, F.lane); rms_fin_bf16(b0, b1, b2, b3, WSP(bf16, WS_XNA) + (size_t)(m + NGW) * DM, F.lane);
          rms_fin_bf16(c0, c1, c2, c3, WSP(bf16, WS_XNA) + (size_t)(m + 2 * NGW) * DM, F.lane); rms_fin_bf16(d0, d1, d2, d3, WSP(bf16, WS_XNA) + (size_t)(m + 3 * NGW) * DM, F.lane); }
      for (; m < MTOK; m += NGW) rms_row_to_bf16(xin_row(F, m), WSP(bf16, WS_XNA) + (size_t)m * DM, F.lane); }
    {
        if (F.G != 256) peer_tables_to_fp8(F, (size_t)gt, (size_t)NGT);
        const f32x4* sk = (const f32x4*)FIN(26); v4u* dk = (v4u*)WSP(bf16, WS_SUBK);
        for (int i = gt; i < 2 * 8 * 2 * 128 * 128 / 8; i += NGT) { const f32x4 a = sk[2 * i], b = sk[2 * i + 1]; v4u w; w.x = pk2(a.x, a.y); w.y = pk2(a.z, a.w); w.z = pk2(b.x, b.y); w.w = pk2(b.z, b.w); dk[i] = w; }
    }
    for (int i = gt; i < 2 * 64 * 2048; i += NGT) { const int kv = i >> 17, hh = (i >> 11) & 63, k = i & 2047;
        WSP(bf16, WS_W1T)[i] = (bf16)f2bf(FIN(17)[((size_t)kv * 2048 + k) * 64 + hh]); }
    for (int i = gt; i < 2 * 4 * 2 * 64 * 8; i += NGT) { const int e = i & 7, ln = (i >> 3) & 63, sx = (i >> 9) & 1, dt = (i >> 10) & 3, kv = i >> 12, fr_ = ln & 15, fq_ = ln >> 4;
        WSP(bf16, WS_W2F)[i] = (bf16)f2bf(FIN(19)[((size_t)kv * 64 + 16 * (2 * sx + (e >> 2)) + 4 * fq_ + (e & 3)) * 64 + 16 * dt + fr_]); }
    for (int it = gw; it < 128; it += NGW) { const int kv = it >> 6, h = it & 63; float s = 0.f;
        for (int k = F.lane; k < 2048; k += 64) s += FIN(18)[(size_t)kv * 2048 + k] * FIN(17)[((size_t)kv * 2048 + k) * 64 + h];
        s = wave_sum(s); if (F.lane == 0) WSP(float, WS_PETERM)[it] = s; }
    {
        bf16* wbd = WSP(bf16, WS_W1BD);
        for (int i = gt; i < 256 * 2048; i += NGT) { const int n = i >> 11, col = i & 2047, kv = n >> 7, sec = (n >> 6) & 1, hh = n & 63;
            float v = 0.f; if ((col >> 10) == kv) { const int k = col & 1023, r = (k >> 6) + 16 * sec, d = k & 63; v = FIN(17)[(((size_t)kv * 32 + r) * 64 + d) * 64 + hh]; }
            wbd[i] = (bf16)f2bf(v); }
    }
    {
        const f32x4* src = (const f32x4*)FIN(3); f32x4* dst = (f32x4*)(F.out + O_WINS);
        const int per_b = 508 * 512 / 4;
        for (int i = gt; i < SB * per_b; i += NGT) { const int b = i / per_b, r = i % per_b; dst[(size_t)b * (512 * 512 / 4) + r] = src[(size_t)b * (512 * 512 / 4) + 4 * 512 / 4 + r]; }
    }
    for (int i = gt; i < SB * NG * 544 * 64; i += NGT) {
        const int d = i & 63, r = (i >> 6) % 544, bg = (i >> 6) / 544, g = bg & 3, b = bg >> 2;
        if (r < 512) { const float* cw = FIN(3) + (((size_t)b * 512 + r) * 2) * 256 + g * 64 + d;
            WSP(bf16, WS_SKWIN)[i] = (bf16)f2bf(cw[0]);
            WSP(bf16, WS_SVWINT)[((size_t)bg * 64 + d) * 544 + r] = (bf16)f2bf(cw[256]); }
        else if (r >= 516) { WSP(bf16, WS_SKWIN)[i] = 0; WSP(bf16, WS_SVWINT)[((size_t)bg * 64 + d) * 544 + r] = 0; }
    }
}

constexpr int P2_QS = 0, P2_KS = 17408, P2_KBGT = 34816, P2_VBT = 53248, P2_AM = 71680, P2_TB = 89088, P2_G = 98304, P2_TF = 99328, P2_XF = 116736;
constexpr int QS_LD = 136, KT_LD = 72, AM_LD = 68, TB_LD = 72;

__device__ __forceinline__ float softplus_f(float x) { return fmaxf(x, 0.f) + __logf(1.f + __expf(-fabsf(x))); }

__device__ __forceinline__ void p2_chunk(Frame& F, int unit) {
    const int c = unit & 127, h = (unit >> 7) & 7, b = unit >> 10;
    const int t0 = c * CHUNK, lane = F.lane, w = F.wave, fr = lane & 15, fq = lane >> 4;
    LAS unsigned char* L = F.lds; asm volatile("" : "+v"(L));
    LAS bf16* qs = (LAS bf16*)(L + P2_QS); LAS bf16* ks = (LAS bf16*)(L + P2_KS);
    LAS bf16* kbgT = (LAS bf16*)(L + P2_KBGT); LAS bf16* vbT = (LAS bf16*)(L + P2_VBT);
    LAS float* Am = (LAS float*)(L + P2_AM); LAS bf16* Tb = (LAS bf16*)(L + P2_TB);
    LAS float* Gs = (LAS float*)(L + P2_G);
    const bf16* PROJ = WSP(bf16, WS_PROJ); const bf16* XNA = WSP(bf16, WS_XNA); const float* WAB = WSP(float, WS_WAB);
    const size_t rowb = (size_t)b * PT;
    float beta_r[8];
    {
        f32x4 wa[4], wb[4];
        const float* pa = WAB + (size_t)h * DM + 8 * lane; const float* pb = WAB + (size_t)(8 + h) * DM + 8 * lane;
        wa[0] = *(const f32x4*)pa; wa[1] = *(const f32x4*)(pa + 4); wa[2] = *(const f32x4*)(pa + 512); wa[3] = *(const f32x4*)(pa + 516);
        wb[0] = *(const f32x4*)pb; wb[1] = *(const f32x4*)(pb + 4); wb[2] = *(const f32x4*)(pb + 512); wb[3] = *(const f32x4*)(pb + 516);
        const float Aneg = -expf(FIN(10)[h]), dtb = FIN(11)[h];
#pragma unroll
        for (int tk = 0; tk < 8; ++tk) {
            const int tok = 8 * w + tk; const bf16* xr = XNA + (rowb + t0 + tok) * DM + 8 * lane;
            const v4u x0 = *(const v4u*)xr, x1 = *(const v4u*)(xr + 512);
            float sa = 0.f, sb = 0.f;
#define ACC2(xw, wv0, wv1, i0) { const float lo = bflo(xw), hi = bfhi(xw); sa += lo * wv0[i0] + hi * wv0[i0 + 1]; sb += lo * wv1[i0] + hi * wv1[i0 + 1]; }
            ACC2(x0.x, wa[0], wb[0], 0) ACC2(x0.y, wa[0], wb[0], 2) ACC2(x0.z, wa[1], wb[1], 0) ACC2(x0.w, wa[1], wb[1], 2)
            ACC2(x1.x, wa[2], wb[2], 0) ACC2(x1.y, wa[2], wb[2], 2) ACC2(x1.z, wa[3], wb[3], 0) ACC2(x1.w, wa[3], wb[3], 2)
#undef ACC2
            sa = wave_sum(sa); sb = wave_sum(sb);
            const float g = Aneg * softplus_f(sa + dtb), be = sigmoid_f(sb);
            beta_r[tk] = be;
            if (lane == 0) { Gs[tok] = g; Gs[64 + tok] = be; }
        }
    }
#pragma unroll
    for (int p = 0; p < 3; ++p) {
        const int col0 = p * 1024 + h * 128 + 2 * lane;
        float cw0[4], cw1[4];
#pragma unroll
        for (int i = 0; i < 4; ++i) { const f32x2 cv = *(const f32x2*)(FIN(9) + (size_t)i * GCONV + col0); cw0[i] = cv.x; cw1[i] = cv.y; }
        unsigned xw[11];
#pragma unroll
        for (int rr = 0; rr < 11; ++rr) { const int t = t0 + 8 * w - 3 + rr; xw[rr] = (t >= 0) ? *(const unsigned*)(PROJ + (rowb + t) * 4096 + col0) : 0u; }
        if (c == 127 && w == 7) {
#pragma unroll
            for (int r = 0; r < 3; ++r) { float* o = F.out + O_CONVP + ((size_t)b * 3 + r) * GCONV + col0; o[0] = bflo(xw[8 + r]); o[1] = bfhi(xw[8 + r]); }
        }
#pragma unroll
        for (int tk = 0; tk < 8; ++tk) {
            const int tok = 8 * w + tk;
            float y0 = 0.f, y1 = 0.f;
#pragma unroll
            for (int i = 0; i < 4; ++i) { y0 += cw0[i] * bflo(xw[tk + i]); y1 += cw1[i] * bfhi(xw[tk + i]); }
            y0 = silu_f(y0); y1 = silu_f(y1);
            if (p < 2) {
                const float ss = wave_sum(y0 * y0 + y1 * y1);
                const float rs = (frsq(ss + EPS)) * (p == 0 ? 0.08838834764831845f : 1.f);
                *(LAS unsigned*)((p == 0 ? qs : ks) + tok * QS_LD + 2 * lane) = pk2(y0 * rs, y1 * rs);
            } else {
                vbT[(2 * lane) * KT_LD + tok] = (bf16)f2bf(y0 * beta_r[tk]); vbT[(2 * lane + 1) * KT_LD + tok] = (bf16)f2bf(y1 * beta_r[tk]);
            }
        }
    }
    __syncthreads();
    if (w == 0) { float g = Gs[lane];
#pragma unroll
        for (int o = 1; o < 64; o <<= 1) { const float up = __shfl_up(g, o); if (lane >= o) g += up; }
        Gs[128 + lane] = g; }
    __syncthreads();
    const float glast = Gs[128 + 63];
    const size_t chunk = (size_t)unit;
    if (w < 4) {
        const int mt = w;
        bf16x8 a[4];
#pragma unroll
        for (int kk = 0; kk < 4; ++kk) a[kk] = ld8l(ks + (16 * mt + fr) * QS_LD + 32 * kk + 8 * fq);
#pragma unroll
        for (int nt = 0; nt < 4; ++nt) {
            f32x4 acc = {0.f, 0.f, 0.f, 0.f};
            if (nt <= mt) {
#pragma unroll
                for (int kk = 0; kk < 4; ++kk) acc = MFMA16(a[kk], ld8l(ks + (16 * nt + fr) * QS_LD + 32 * kk + 8 * fq), acc);
            }
            const int j = 16 * nt + fr; const float gj = Gs[128 + j];
#pragma unroll
            for (int r = 0; r < 4; ++r) { const int i = 16 * mt + 4 * fq + r;
                Am[i * AM_LD + j] = (i > j) ? Gs[64 + i] * acc[r] * __expf(Gs[128 + i] - gj) : 0.f; }
        }
    } else {
        const int nt = w - 4;
        bf16x8 bq[4];
#pragma unroll
        for (int kk = 0; kk < 4; ++kk) bq[kk] = ld8l(qs + (16 * nt + fr) * QS_LD + 32 * kk + 8 * fq);
        const int i = 16 * nt + fr; const float gi = Gs[128 + i];
        bf16* gqk = WSP(bf16, WS_GQK) + chunk * 4096;
#pragma unroll
        for (int mt = 0; mt < 4; ++mt) {
            f32x4 acc = {0.f, 0.f, 0.f, 0.f};
            if (mt <= nt) {
#pragma unroll
                for (int kk = 0; kk < 4; ++kk) acc = MFMA16(ld8l(ks + (16 * mt + fr) * QS_LD + 32 * kk + 8 * fq), bq[kk], acc);
            }
            float v[4];
#pragma unroll
            for (int r = 0; r < 4; ++r) { const int j = 16 * mt + 4 * fq + r; v[r] = (i >= j) ? acc[r] * __expf(gi - Gs[128 + j]) : 0.f; }
            v2u o; o.x = pk2(v[0], v[1]); o.y = pk2(v[2], v[3]);
            *(v2u*)(gqk + (((nt * 2 + (mt >> 1)) * 64 + (2 * (mt & 1) + (fq >> 1)) * 16 + fr) * 8 + 4 * (fq & 1))) = o;
        }
    }
    {
        const int tok = F.tid >> 3, d0 = (F.tid & 7) * 16; const float e = __expf(Gs[128 + tok]);
        bf16* gq = WSP(bf16, WS_GQ) + chunk * 8192;
#pragma unroll
        for (int hh = 0; hh < 2; ++hh) { const v4u q = *(const LAS v4u*)(qs + tok * QS_LD + d0 + 8 * hh); v4u o;
            o.x = pk2(bflo(q.x) * e, bfhi(q.x) * e); o.y = pk2(bflo(q.y) * e, bfhi(q.y) * e); o.z = pk2(bflo(q.z) * e, bfhi(q.z) * e); o.w = pk2(bflo(q.w) * e, bfhi(q.w) * e);
            *(v4u*)(gq + ((((tok >> 4) * 4 + ((F.tid & 7) >> 1)) * 64 + (2 * (F.tid & 1) + hh) * 16 + (tok & 15)) * 8)) = o; }
    }
    {
        const int dk = F.tid & 127, tg = F.tid >> 7;
        unsigned o1[8], o2[8];
#pragma unroll
        for (int i = 0; i < 8; ++i) {
            const int ta = 16 * tg + 2 * i, tb2 = ta + 1;
            const float ka = bf2f(ks[ta * QS_LD + dk]), kb = bf2f(ks[tb2 * QS_LD + dk]);
            const float ga = Gs[128 + ta], gb = Gs[128 + tb2];
            o1[i] = pk2(ka * Gs[64 + ta] * __expf(ga), kb * Gs[64 + tb2] * __expf(gb));
            o2[i] = pk2(ka * __expf(glast - ga), kb * __expf(glast - gb));
        }
        LAS v4u* d1 = (LAS v4u*)(kbgT + dk * KT_LD + 16 * tg); d1[0] = (v4u){o1[0], o1[1], o1[2], o1[3]}; d1[1] = (v4u){o1[4], o1[5], o1[6], o1[7]};
        bf16* d2 = WSP(bf16, WS_GKT) + chunk * 8192 + ((((dk >> 4) * 2 + (tg >> 1)) * 64 + (2 * (tg & 1)) * 16 + (dk & 15)) * 8);
        *(v4u*)d2 = (v4u){o2[0], o2[1], o2[2], o2[3]}; *(v4u*)(d2 + 16 * 8) = (v4u){o2[4], o2[5], o2[6], o2[7]};
    }
    if (F.tid == 0) WSP(float, WS_GDEC)[chunk] = __expf(glast);
    __syncthreads();
    LAS float* Tf = (LAS float*)(L + P2_TF); LAS float* Xf = (LAS float*)(L + P2_XF);
    if (w == 0) {
        const int blk = lane >> 5, cc = lane & 31; const LAS float* Ab = Am + (32 * blk) * AM_LD + 32 * blk;
        float t[32];
#pragma unroll
        for (int i = 0; i < 32; ++i) {
            float acc0 = (i == cc) ? 1.f : 0.f, acc1 = 0.f, acc2 = 0.f, acc3 = 0.f;
#pragma unroll
            for (int j4 = 0; j4 < (i + 3) / 4; ++j4) {
                const f32x4 a = *(const LAS f32x4*)(Ab + i * AM_LD + 4 * j4);
                if (4 * j4 + 0 < i) acc0 = __builtin_fmaf(-a.x, t[4 * j4 + 0], acc0);
                if (4 * j4 + 1 < i) acc1 = __builtin_fmaf(-a.y, t[4 * j4 + 1], acc1);
                if (4 * j4 + 2 < i) acc2 = __builtin_fmaf(-a.z, t[4 * j4 + 2], acc2);
                if (4 * j4 + 3 < i) acc3 = __builtin_fmaf(-a.w, t[4 * j4 + 3], acc3);
            }
            t[i] = (acc0 + acc1) + (acc2 + acc3);
            asm volatile("" : "+v"(t[i]));
            __builtin_amdgcn_sched_barrier(0);
        }
#pragma unroll
        for (int i = 0; i < 32; ++i) { Tf[(32 * blk + i) * AM_LD + 32 * blk + cc] = t[i]; if (blk == 0) Tf[i * AM_LD + 32 + cc] = 0.f; }
    }
    __syncthreads();
    {
        const int i = F.tid >> 4, c0 = (F.tid & 15) * 2; float x0 = 0.f, x1 = 0.f;
#pragma unroll 8
        for (int k = 0; k < 32; ++k) { const float a = Am[(32 + i) * AM_LD + k]; x0 = __builtin_fmaf(a, Tf[k * AM_LD + c0], x0); x1 = __builtin_fmaf(a, Tf[k * AM_LD + c0 + 1], x1); }
        Xf[i * 34 + c0] = x0; Xf[i * 34 + c0 + 1] = x1;
    }
    __syncthreads();
    {
        const int i = F.tid >> 4, c0 = (F.tid & 15) * 2; float x0 = 0.f, x1 = 0.f;
#pragma unroll 8
        for (int k = 0; k < 32; ++k) { const float a = Tf[(32 + i) * AM_LD + 32 + k]; x0 = __builtin_fmaf(a, Xf[k * 34 + c0], x0); x1 = __builtin_fmaf(a, Xf[k * 34 + c0 + 1], x1); }
        Tf[(32 + i) * AM_LD + c0] = -x0; Tf[(32 + i) * AM_LD + c0 + 1] = -x1;
    }
    __syncthreads();
    {
        const int i = F.tid >> 3, c0 = (F.tid & 7) * 8; const f32x4 a = *(const LAS f32x4*)(Tf + i * AM_LD + c0), b2 = *(const LAS f32x4*)(Tf + i * AM_LD + c0 + 4);
        *(LAS v4u*)(Tb + i * TB_LD + c0) = (v4u){pk2(a.x, a.y), pk2(a.z, a.w), pk2(b2.x, b2.y), pk2(b2.z, b2.w)};
    }
    __syncthreads();
    {
        bf16x8 tb[4][2];
#pragma unroll
        for (int x = 0; x < 4; ++x)
#pragma unroll
            for (int s = 0; s < 2; ++s) tb[x][s] = ld8l(Tb + (16 * x + fr) * TB_LD + 32 * s + 8 * fq);
        const bf16x8 bv0 = ld8l(vbT + (16 * w + fr) * KT_LD + 8 * fq), bv1 = ld8l(vbT + (16 * w + fr) * KT_LD + 32 + 8 * fq);
        bf16* gu = WSP(bf16, WS_GU) + chunk * 8192 + ((size_t)((w >> 1) * 4 * 64 + lane) * 2 + (w & 1)) * 4;
#pragma unroll
        for (int mt = 0; mt < 4; ++mt) { f32x4 acc = {0.f, 0.f, 0.f, 0.f}; acc = MFMA16(tb[mt][0], bv0, acc); acc = MFMA16(tb[mt][1], bv1, acc); *(v2u*)(gu + mt * 64 * 8) = (v2u){pk2(acc[0], acc[1]), pk2(acc[2], acc[3])}; }
        const bf16x8 ak0 = ld8l(kbgT + (16 * w + fr) * KT_LD + 8 * fq), ak1 = ld8l(kbgT + (16 * w + fr) * KT_LD + 32 + 8 * fq);
        bf16* gw = WSP(bf16, WS_GW) + chunk * 8192;
#pragma unroll
        for (int nt = 0; nt < 4; ++nt) { f32x4 acc = {0.f, 0.f, 0.f, 0.f}; acc = MFMA16(ak0, tb[nt][0], acc); acc = MFMA16(ak1, tb[nt][1], acc);
            v2u o; o.x = pk2(acc[0], acc[1]); o.y = pk2(acc[2], acc[3]);
            *(v2u*)(gw + (((nt * 4 + (w >> 1)) * 64 + (2 * (w & 1) + (fq >> 1)) * 16 + fr) * 8 + 4 * (fq & 1))) = o; }
    }
    __syncthreads();
}

constexpr int S2_Y = 0;
constexpr int S2_AB = 6144;
constexpr int S2_DOT = 6400;
constexpr int S2_U = 6656;
constexpr int S2_W = 8704;
constexpr int S2_VN = 10752;
__device__ __forceinline__ void p2_sample(Frame& F, int unit) {
    const int h = unit & 7, bs = unit >> 3, tid = F.tid, lane = F.lane, w = F.wave;
    LAS unsigned char* L = F.lds; asm volatile("" : "+v"(L));
    LAS float* Y = (LAS float*)(L + S2_Y); LAS float* AB = (LAS float*)(L + S2_AB); LAS float* DOT = (LAS float*)(L + S2_DOT);
    LAS float* U = (LAS float*)(L + S2_U); LAS float* W = (LAS float*)(L + S2_W); LAS float* VN = (LAS float*)(L + S2_VN);
    const bf16* PROJ = WSP(bf16, WS_PROJ); const bf16* XNA = WSP(bf16, WS_XNA); const float* WAB = WSP(float, WS_WAB);
    const size_t row0 = (size_t)MP + bs * 4;
    if (tid < 384) {
        const int part = tid >> 7, cc = tid & 127, col = part * 1024 + h * 128 + cc;
        float buf[7];
#pragma unroll
        for (int r = 0; r < 3; ++r) buf[r] = FIN(5)[((size_t)bs * 3 + r) * GCONV + col];
#pragma unroll
        for (int i = 0; i < 4; ++i) buf[3 + i] = bf2f(PROJ[(row0 + i) * 4096 + col]);
#pragma unroll
        for (int r = 0; r < 3; ++r) F.out[O_CONVS + ((size_t)bs * 3 + r) * GCONV + col] = buf[4 + r];
        float cw[4];
#pragma unroll
        for (int i = 0; i < 4; ++i) cw[i] = FIN(9)[(size_t)i * GCONV + col];
#pragma unroll
        for (int i = 0; i < 4; ++i) { float y = 0.f;
#pragma unroll
            for (int k = 0; k < 4; ++k) y += cw[k] * buf[i + k];
            Y[(part * 4 + i) * 128 + cc] = silu_f(y); }
    }
    {
        const int i = w >> 1, which = w & 1; const bf16* xr = XNA + (row0 + i) * DM; const float* wr = WAB + (size_t)(which * 8 + h) * DM; float s = 0.f;
        for (int k = lane; k < DM; k += 64) s += bf2f(xr[k]) * wr[k];
        s = wave_sum(s); if (lane == 0) AB[which * 4 + i] = s;
    }
    __syncthreads();
    {
        const int part = w >> 2, i = w & 3; LAS float* y = Y + (part * 4 + i) * 128; const float a = y[lane], bq = y[64 + lane];
        const float ss = wave_sum(a * a + bq * bq); const float rs = (frsq(ss + EPS)) * (part == 0 ? 0.08838834764831845f : 1.f);
        y[lane] = a * rs; y[64 + lane] = bq * rs;
    }
    if (tid == 0) { const float Aneg = -expf(FIN(10)[h]), dtb = FIN(11)[h]; float gc = 0.f;
        for (int i = 0; i < 4; ++i) { const float g = Aneg * softplus_f(AB[i] + dtb); gc += g; AB[8 + i] = g; AB[12 + i] = 1.f / (1.f + expf(-AB[4 + i])); AB[16 + i] = gc; } }
    __syncthreads();
    {
#pragma unroll
        for (int pp = 0; pp < 4; ++pp) { const int pr = 4 * w + pp, which = pr >> 4, i = (pr >> 2) & 3, j = pr & 3;
            const LAS float* x = Y + ((which == 0 ? 1 : 0) * 4 + i) * 128; const LAS float* y = Y + (1 * 4 + j) * 128;
            float s = x[lane] * y[lane] + x[64 + lane] * y[64 + lane]; s = wave_sum(s); if (lane == 0) DOT[pr] = s; }
    }
    __syncthreads();
    float g_[4], be[4], gc[4];
#pragma unroll
    for (int i = 0; i < 4; ++i) { g_[i] = AB[8 + i]; be[i] = AB[12 + i]; gc[i] = AB[16 + i]; }
    float Tm[4][4];
    {
        float A[4][4];
#pragma unroll
        for (int i = 0; i < 4; ++i)
#pragma unroll
            for (int j = 0; j < 4; ++j) A[i][j] = (i > j) ? be[i] * DOT[i * 4 + j] * expf(gc[i] - gc[j]) : 0.f;
#pragma unroll
        for (int cc = 0; cc < 4; ++cc)
#pragma unroll
            for (int i = 0; i < 4; ++i) { float acc = (i == cc) ? 1.f : 0.f;
#pragma unroll
                for (int j = 0; j < 4; ++j) if (j < i) acc -= A[i][j] * Tm[j][cc];
                Tm[i][cc] = acc; }
    }
    {
        const int i = tid >> 7, x = tid & 127; float su = 0.f, sw = 0.f;
#pragma unroll
        for (int j = 0; j < 4; ++j) { su += Tm[i][j] * Y[(2 * 4 + j) * 128 + x] * be[j]; sw += Tm[i][j] * Y[(1 * 4 + j) * 128 + x] * be[j] * expf(gc[j]); }
        U[i * 128 + x] = su; W[i * 128 + x] = sw;
    }
    __syncthreads();
    const float* S0 = FIN(4) + ((size_t)bs * GH + h) * 128 * 128;
    const int dv = tid & 127, dg = tid >> 7;
    LAS float* SL = (LAS float*)(L + 32768);
#pragma unroll 16
    for (int r = 0; r < 32; ++r) SL[(32 * dg + r) * 128 + dv] = S0[(size_t)(32 * dg + r) * 128 + dv];
    LAS float* PP = (LAS float*)(L + 16384); LAS float* PQ = (LAS float*)(L + 16384 + 8192);
    {
        float pp[4] = {0.f, 0.f, 0.f, 0.f}, qp[4] = {0.f, 0.f, 0.f, 0.f};
#pragma unroll
        for (int r = 0; r < 32; ++r) { const int dk = 32 * dg + r; const float sv = SL[dk * 128 + dv];
#pragma unroll
            for (int i = 0; i < 4; ++i) { pp[i] += W[i * 128 + dk] * sv; qp[i] += Y[(0 * 4 + i) * 128 + dk] * sv; } }
#pragma unroll
        for (int i = 0; i < 4; ++i) { PP[(dg * 4 + i) * 128 + dv] = pp[i]; PQ[(dg * 4 + i) * 128 + dv] = qp[i]; }
    }
    __syncthreads();
    float qs_acc;
    {
        const int i = tid >> 7;
        const float p = (PP[(0 * 4 + i) * 128 + dv] + PP[(1 * 4 + i) * 128 + dv]) + (PP[(2 * 4 + i) * 128 + dv] + PP[(3 * 4 + i) * 128 + dv]);
        const float qq = (PQ[(0 * 4 + i) * 128 + dv] + PQ[(1 * 4 + i) * 128 + dv]) + (PQ[(2 * 4 + i) * 128 + dv] + PQ[(3 * 4 + i) * 128 + dv]);
        VN[i * 128 + dv] = U[i * 128 + dv] - p; qs_acc = qq * expf(gc[i]);
    }
    __syncthreads();
    {
        const int i = tid >> 7; float o = qs_acc;
#pragma unroll
        for (int j = 0; j < 4; ++j) if (j <= i) o += DOT[16 + i * 4 + j] * expf(gc[i] - gc[j]) * VN[j * 128 + dv];
        WSP(bf16, WS_OGDN)[(row0 + i) * DM + h * 128 + dv] = (bf16)f2bf(o);
    }
    {
        const float el = expf(gc[3]);
        float kd[4], vn[4];
#pragma unroll
        for (int j = 0; j < 4; ++j) { kd[j] = expf(gc[3] - gc[j]); vn[j] = VN[j * 128 + dv]; }
        float* So = F.out + O_GDNS + ((size_t)bs * GH + h) * 128 * 128;
#pragma unroll
        for (int r = 0; r < 32; ++r) { const int dk = 32 * dg + r; float sv = SL[dk * 128 + dv] * el;
#pragma unroll
            for (int j = 0; j < 4; ++j) sv += Y[(1 * 4 + j) * 128 + dk] * kd[j] * vn[j];
            So[(size_t)dk * 128 + dv] = sv; }
    }
    (void)g_;
    __syncthreads();
}

constexpr int P3_S = 0;
constexpr int P3_VN = 16384;
__device__ __forceinline__ void p3_scan(Frame& F, int bh, int s) {
    const int lane = F.lane, w = F.wave, fr = lane & 15, fq = lane >> 4;
    const int b = bh >> 3, h = bh & 7;
    LAS bf16* Sl = (LAS bf16*)(F.lds + P3_S); LAS bf16* Vl = (LAS bf16*)(F.lds + P3_VN);
    const bf16* GW = WSP(bf16, WS_GW); const bf16* GQ = WSP(bf16, WS_GQ); const bf16* GKT = WSP(bf16, WS_GKT); const bf16* GQK = WSP(bf16, WS_GQK);
    const bf16* GU = WSP(bf16, WS_GU); const float* GDEC = WSP(float, WS_GDEC);
    bf16* OG = WSP(bf16, WS_OGDN);
    f32x4 Sacc[2];
#pragma unroll
    for (int n = 0; n < 2; ++n) { Sacc[n] = (f32x4){0.f, 0.f, 0.f, 0.f}; v2u z = {0u, 0u}; *(LAS v2u*)(Sl + (n * 16 + fr) * 136 + 16 * w + 4 * fq) = z; }
    __syncthreads();
    const int m = w & 3;
    struct P3Ops { bf16x8 a1[4], ak0, ak1; v4u x0, x1; float dec; };
    P3Ops R0, R1, R2;
#define P3_FETCH(R, cc) do { const size_t ch_ = (size_t)bh * NCH + (cc); \
        const bf16* p1_ = (w < 4 ? GW : GQ) + ch_ * 8192 + (size_t)(m * 4 * 64 + lane) * 8;        \
        _Pragma("unroll") for (int k_ = 0; k_ < 4; ++k_) R.a1[k_] = ld8(p1_ + 512 * k_); \
        const bf16* pk_ = GKT + ch_ * 8192 + (size_t)(w * 2 * 64 + lane) * 8; R.ak0 = ld8(pk_); R.ak1 = ld8(pk_ + 512); \
        const unsigned char* px_ = w < 4 ? (const unsigned char*)(GU + ch_ * 8192 + ((size_t)(s * 4 + m) * 64 + lane) * 8) : (const unsigned char*)(GQK + ch_ * 4096 + (size_t)(m * 2 * 64 + lane) * 8); \
        R.x0 = *(const v4u*)px_; R.x1 = *(const v4u*)(px_ + (w < 4 ? 0 : 1024));        \
        R.dec = GDEC[ch_]; } while (0)
#define P3_STEP(R, c) do { \
        f32x4 acc[2]; \
        _Pragma("unroll") for (int n = 0; n < 2; ++n) { acc[n] = (f32x4){0.f, 0.f, 0.f, 0.f}; \
            _Pragma("unroll") for (int k = 0; k < 4; ++k) acc[n] = MFMA16(R.a1[k], ld8l(Sl + (n * 16 + fr) * 136 + 32 * k + 8 * fq), acc[n]); } \
        if (w < 4) { _Pragma("unroll") for (int n = 0; n < 2; ++n) { const unsigned ua_ = n == 0 ? R.x0.x : R.x0.z, ub_ = n == 0 ? R.x0.y : R.x0.w; const f32x4 vn = (f32x4){bflo(ua_), bfhi(ua_), bflo(ub_), bfhi(ub_)} - acc[n]; v2u o; o.x = pk2(vn[0], vn[1]); o.y = pk2(vn[2], vn[3]); \
            *(LAS v2u*)(Vl + (n * 16 + fr) * 72 + 16 * m + 4 * fq) = o; } } \
        asm volatile("s_waitcnt lgkmcnt(0)\n\ts_barrier" ::: "memory"); \
        bf16x8 v0[2], v1[2]; \
        _Pragma("unroll") for (int n = 0; n < 2; ++n) { v0[n] = ld8l(Vl + (n * 16 + fr) * 72 + 8 * fq); v1[n] = ld8l(Vl + (n * 16 + fr) * 72 + 32 + 8 * fq); } \
        if (w >= 4) { _Pragma("unroll") for (int n = 0; n < 2; ++n) { acc[n] = MFMA16(__builtin_bit_cast(bf16x8, R.x0), v0[n], acc[n]); acc[n] = MFMA16(__builtin_bit_cast(bf16x8, R.x1), v1[n], acc[n]); \
            bf16* o = OG + ((size_t)b * PT + (c) * CHUNK + 16 * m + 4 * fq) * DM + h * 128 + 32 * s + 16 * n + fr; \
            _Pragma("unroll") for (int r = 0; r < 4; ++r) o[(size_t)r * DM] = (bf16)f2bf(acc[n][r]); } } \
        { float d_ = R.dec;        \
          _Pragma("unroll") for (int n = 0; n < 2; ++n) asm volatile("v_mul_f32 %0, %0, %4\n\tv_mul_f32 %1, %1, %4\n\tv_mul_f32 %2, %2, %4\n\tv_mul_f32 %3, %3, %4" : "+v"(Sacc[n][0]), "+v"(Sacc[n][1]), "+v"(Sacc[n][2]), "+v"(Sacc[n][3]) : "v"(d_)); } \
        _Pragma("unroll") for (int n = 0; n < 2; ++n) { Sacc[n] = MFMA16(R.ak0, v0[n], Sacc[n]); Sacc[n] = MFMA16(R.ak1, v1[n], Sacc[n]); \
            v2u o; o.x = pk2(Sacc[n][0], Sacc[n][1]); o.y = pk2(Sacc[n][2], Sacc[n][3]); *(LAS v2u*)(Sl + (n * 16 + fr) * 136 + 16 * w + 4 * fq) = o; } \
        asm volatile("s_waitcnt lgkmcnt(0)\n\ts_barrier" ::: "memory"); } while (0)
    P3_FETCH(R0, 0); __builtin_amdgcn_sched_barrier(0); P3_FETCH(R1, 1); __builtin_amdgcn_sched_barrier(0); P3_FETCH(R2, 2); __builtin_amdgcn_sched_barrier(0);
    static_assert(NCH % 3 == 2, "ring schedule below assumes NCH = 3k + 2");
#pragma unroll 1
    for (int c = 0; c + 3 <= NCH; c += 3) {
        P3_STEP(R0, c);     P3_FETCH(R0, (c + 3 < NCH ? c + 3 : NCH - 1));
        P3_STEP(R1, c + 1); P3_FETCH(R1, (c + 4 < NCH ? c + 4 : NCH - 1));
        P3_STEP(R2, c + 2); P3_FETCH(R2, (c + 5 < NCH ? c + 5 : NCH - 1));
    }
    P3_STEP(R0, NCH - 2); P3_STEP(R1, NCH - 1);
#undef P3_FETCH
#undef P3_STEP
    float* So = F.out + O_GDNP + ((size_t)bh * 128) * 128;
#pragma unroll
    for (int n = 0; n < 2; ++n)
#pragma unroll
        for (int r = 0; r < 4; ++r) So[(size_t)(16 * w + 4 * fq + r) * 128 + 32 * s + 16 * n + fr] = Sacc[n][r];
}

__device__ __forceinline__ void p4_rows(Frame& F, int first, int stride) {
    const int lane = F.lane;
    if (first >= MTOK) return;
    float gn[16];
    { const f32x4* gp = (const f32x4*)(FIN(12) + (16 * lane & 127));
#pragma unroll
      for (int j = 0; j < 4; ++j) { const f32x4 g4 = gp[j]; gn[4 * j] = g4.x; gn[4 * j + 1] = g4.y; gn[4 * j + 2] = g4.z; gn[4 * j + 3] = g4.w; } }
    v4u no0, no1, nz0, nz1;
#define P4_FETCH(rw) do { const bf16* o_ = WSP(bf16, WS_OGDN) + (size_t)(rw) * DM + 16 * lane; const bf16* z_ = WSP(bf16, WS_PROJ) + (size_t)(rw) * 4096 + 3072 + 16 * lane; \
        no0 = *(const v4u*)o_; no1 = *(const v4u*)(o_ + 8); nz0 = *(const v4u*)z_; nz1 = *(const v4u*)(z_ + 8); } while (0)
    P4_FETCH(first);
#pragma unroll 1
    for (int row = first; row < MTOK; row += stride) {
        f32x4 v[4]; const v4u z0 = nz0, z1 = nz1; float ss = 0.f;
#pragma unroll
        for (int j = 0; j < 4; ++j) { const unsigned wa = j < 2 ? (j == 0 ? no0.x : no0.z) : (j == 2 ? no1.x : no1.z), wb = j < 2 ? (j == 0 ? no0.y : no0.w) : (j == 2 ? no1.y : no1.w);
            v[j] = (f32x4){bflo(wa), bfhi(wa), bflo(wb), bfhi(wb)}; ss += (v[j].x * v[j].x + v[j].y * v[j].y) + (v[j].z * v[j].z + v[j].w * v[j].w); }
        { const int nr = row + stride < MTOK ? row + stride : row; P4_FETCH(nr); }
        ss += dpp_f<DPP_XOR1>(ss); ss += dpp_f<DPP_XOR2>(ss); ss += dpp_f<DPP_HMIR>(ss);
        const float rstd = frsq(ss * (1.f / 128.f) + EPS);
        float zz[16] = {bflo(z0.x), bfhi(z0.x), bflo(z0.y), bfhi(z0.y), bflo(z0.z), bfhi(z0.z), bflo(z0.w), bfhi(z0.w),
                        bflo(z1.x), bfhi(z1.x), bflo(z1.y), bfhi(z1.y), bflo(z1.z), bfhi(z1.z), bflo(z1.w), bfhi(z1.w)};
        unsigned ow[8];
#pragma unroll
        for (int j = 0; j < 8; ++j) { const float a = v[j >> 1][(2 * j) & 3] * rstd * gn[2 * j] * silu_f(zz[2 * j]), bq = v[j >> 1][(2 * j + 1) & 3] * rstd * gn[2 * j + 1] * silu_f(zz[2 * j + 1]); ow[j] = pk2(a, bq); }
        v4u* dst = (v4u*)(WSP(bf16, WS_OG) + (size_t)row * DM + 16 * lane);
        dst[0] = (v4u){ow[0], ow[1], ow[2], ow[3]}; dst[1] = (v4u){ow[4], ow[5], ow[6], ow[7]};
    }
#undef P4_FETCH
}

typedef __bf16 bf16x2_t __attribute__((ext_vector_type(2)));
__device__ __forceinline__ float dot2_bf16(unsigned w, unsigned x, float acc) { return __builtin_amdgcn_fdot2_f32_bf16(__builtin_bit_cast(bf16x2_t, w), __builtin_bit_cast(bf16x2_t, x), acc, false); }
__device__ __forceinline__ float u2f(unsigned u) { return __builtin_bit_cast(float, u); }
__device__ __forceinline__ unsigned f2u(float f) { return __builtin_bit_cast(unsigned, f); }

constexpr int P8_MAXU = 4;
constexpr int P8_WAVE = P8_MAXU * 2048 + 1024;
constexpr int P8_TOP = 0;
constexpr int P8_TAB = 8 * P8_WAVE;
__device__ __forceinline__ void p8_init_tab(Frame& F) {
    LAS unsigned char* tab = F.lds + P8_TAB;
    if (F.tid < 64) { const int k = F.tid; int i = 0, j = 0;
        if (k < 16) { i = 0; j = k; } else if (k < 24) { i = 1; j = k - 16; } else if (k < 29) { i = 2; j = k - 24; } else if (k < 33) { i = 3; j = k - 29; }
        else if (k < 36) { i = 4; j = k - 33; } else if (k < 38) { i = 5; j = k - 36; } else if (k < 40) { i = 6; j = k - 38; } else if (k < 42) { i = 7; j = k - 40; } else if (k < 50) { i = k - 34; j = 0; }
        tab[k] = (unsigned char)i; tab[64 + k] = (unsigned char)j; }
    __syncthreads();
}
__device__ __forceinline__ int fkey(float x) { const int b = __builtin_bit_cast(int, x); return b ^ ((b >> 31) & 0x7fffffff); }
__device__ __forceinline__ float fkey_inv(int k) { return __builtin_bit_cast(float, k ^ ((k >> 31) & 0x7fffffff)); }
template <int CTRL> __device__ __forceinline__ int dpp_i(int x) { return __builtin_amdgcn_update_dpp(0, x, CTRL, 0xF, 0xF, true); }
__device__ __forceinline__ int imax(int a, int b) { return a > b ? a : b; }
__device__ __forceinline__ int imin(int a, int b) { return a < b ? a : b; }
__device__ __forceinline__ int row_imax16(int x) {
    x = imax(x, dpp_i<0xB1>(x)); x = imax(x, dpp_i<0x4E>(x)); x = imax(x, dpp_i<0x141>(x)); x = imax(x, dpp_i<0x140>(x)); return x;
}
#define ICSWAP(a, b) { const int hi_ = imax(a, b), lo_ = imin(a, b); a = hi_; b = lo_; }
constexpr int IKEY_MIN = (int)0x80000000;
template <int NR>
__device__ __forceinline__ void p8_run(Frame& F, int layer, int w, int rq, int u0, int ustride, int nu) {
    int lane_ = F.lane; asm volatile("" : "+v"(lane_));
    const int lane = lane_, fr = lane & 15, fq = lane >> 4;
    LAS unsigned char* L = F.lds; asm volatile("" : "+v"(L));
    LAS int* toplw = (LAS int*)(L + P8_TOP + F.wave * P8_WAVE);
    LAS float* wins = (LAS float*)(L + P8_TOP + F.wave * P8_WAVE + P8_MAXU * 2048);
    const LAS unsigned char* tab = L + P8_TAB;
    const bf16* Qb = WSP(bf16, WS_QPEER) + (size_t)fr * 2048 + w * 256 + 8 * fq;
    const bf16* SK = WSP(bf16, WS_SUBK) + (size_t)((layer * 8 + w) * 2) * 16384 + (size_t)fr * 128 + 8 * fq;
#pragma unroll 1
    for (int p = 0; p < 2; ++p) {
        bf16x8 bk[32], aq[4];
#pragma unroll
        for (int i = 0; i < 32; ++i) bk[i] = ld8(SK + (size_t)p * 16384 + (size_t)(i >> 2) * 2048 + 32 * (i & 3));
#pragma unroll
        for (int ks = 0; ks < 4; ++ks) aq[ks] = ld8(Qb + (size_t)u0 * 16 * 2048 + p * 128 + 32 * ks);
#pragma unroll 1
        for (int k = 0; k < nu; ++k) {
            LAS int* topl = toplw + k * 512;
            int s[NR][8];
#pragma unroll
            for (int nt = 0; nt < 8; ++nt) { f32x4 acc = {0.f, 0.f, 0.f, 0.f};
#pragma unroll
                for (int ks = 0; ks < 4; ++ks) acc = MFMA16(aq[ks], bk[nt * 4 + ks], acc);
                if (NR == 4) {
#pragma unroll
                    for (int r = 0; r < NR; ++r) s[r][nt] = fkey(u2f((f2u(acc[r]) & ~127u) | (unsigned)(16 * nt + fr)));
                } else { const float av = rq == 0 ? acc[0] : rq == 1 ? acc[1] : rq == 2 ? acc[2] : acc[3]; s[0][nt] = fkey(u2f((f2u(av) & ~127u) | (unsigned)(16 * nt + fr))); } }
            { const int un = u0 + (k + 1 < nu ? k + 1 : k) * ustride;
#pragma unroll
              for (int ks = 0; ks < 4; ++ks) aq[ks] = ld8(Qb + (size_t)un * 16 * 2048 + p * 128 + 32 * ks); }
#pragma unroll
            for (int r = 0; r < NR; ++r) {
                ICSWAP(s[r][0], s[r][1]) ICSWAP(s[r][2], s[r][3]) ICSWAP(s[r][4], s[r][5]) ICSWAP(s[r][6], s[r][7])
                ICSWAP(s[r][0], s[r][2]) ICSWAP(s[r][1], s[r][3]) ICSWAP(s[r][4], s[r][6]) ICSWAP(s[r][5], s[r][7])
                ICSWAP(s[r][1], s[r][2]) ICSWAP(s[r][5], s[r][6]) ICSWAP(s[r][0], s[r][4]) ICSWAP(s[r][3], s[r][7])
                ICSWAP(s[r][1], s[r][5]) ICSWAP(s[r][2], s[r][6]) ICSWAP(s[r][1], s[r][4]) ICSWAP(s[r][3], s[r][6])
                ICSWAP(s[r][2], s[r][4]) ICSWAP(s[r][3], s[r][5]) ICSWAP(s[r][3], s[r][4]) }
            int mine[NR];
#pragma unroll
            for (int r = 0; r < NR; ++r) mine[r] = IKEY_MIN;
#pragma unroll 1
            for (int rd = 0; rd < 16; ++rd) {
                const bool me = fr == rd;
#pragma unroll
                for (int r = 0; r < NR; ++r) {
                    const int mx = row_imax16(s[r][0]);
                    const bool pop = s[r][0] == mx;
#pragma unroll
                    for (int i = 0; i < 7; ++i) s[r][i] = pop ? s[r][i + 1] : s[r][i];
                    s[r][7] = pop ? IKEY_MIN : s[r][7];
                    mine[r] = me ? mx : mine[r];
                }
            }
#pragma unroll
            for (int r = 0; r < NR; ++r) topl[((4 * fq + (NR == 4 ? r : rq)) * 2 + p) * 16 + fr] = mine[r];
        }
    }
    LDS_WAIT();
#pragma unroll 1
    for (int k = 0; k < nu; ++k) {
    LAS int* topl = toplw + k * 512;
    const int r0 = (u0 + k * ustride) * 16;
    int c[NR][4];
#pragma unroll
    for (int r = 0; r < NR; ++r) { const int tk = 4 * fq + (NR == 4 ? r : rq);
#pragma unroll
        for (int m = 0; m < 4; ++m) { const int kc = fr + 16 * m; int cv = IKEY_MIN;
            if (kc < 50) { const int i = tab[kc], j = tab[64 + kc]; const float s1 = u2f(f2u(fkey_inv(topl[(tk * 2 + 0) * 16 + i])) & ~127u), s2 = u2f(f2u(fkey_inv(topl[(tk * 2 + 1) * 16 + j])) & ~127u);
                cv = fkey(u2f((f2u(s1 + s2) & ~63u) | (unsigned)kc)); }
            c[r][m] = cv; }
        ICSWAP(c[r][0], c[r][1]) ICSWAP(c[r][2], c[r][3]) ICSWAP(c[r][0], c[r][2]) ICSWAP(c[r][1], c[r][3]) ICSWAP(c[r][1], c[r][2]) }
    int minec[NR];
#pragma unroll
    for (int r = 0; r < NR; ++r) minec[r] = IKEY_MIN;
#pragma unroll 1
    for (int rd = 0; rd < 16; ++rd) {
        const bool me = fr == rd;
#pragma unroll
        for (int r = 0; r < NR; ++r) {
            const int mx = row_imax16(c[r][0]);
            const bool pop = c[r][0] == mx;
            c[r][0] = pop ? c[r][1] : c[r][0]; c[r][1] = pop ? c[r][2] : c[r][1]; c[r][2] = pop ? c[r][3] : c[r][2]; c[r][3] = pop ? IKEY_MIN : c[r][3];
            minec[r] = me ? mx : minec[r];
        }
    }
#pragma unroll
    for (int r = 0; r < NR; ++r) wins[(4 * fq + (NR == 4 ? r : rq)) * 16 + fr] = fkey_inv(minec[r]);
    LDS_WAIT();
    if (NR == 4 || (fr >> 2) == rq) {
        const int tk = 4 * fq + (fr >> 2), q4 = fr & 3;
        const float w0 = wins[tk * 16]; float den = 0.f;
#pragma unroll
        for (int rd = 0; rd < 16; ++rd) den += __expf(wins[tk * 16 + rd] - w0);
        const float inv = 1.f / den;
        int e[4]; float g[4];
#pragma unroll
        for (int x = 0; x < 4; ++x) { const float wv = wins[tk * 16 + 4 * q4 + x]; const int kc = (int)(f2u(wv) & 63u); const int i = tab[kc], j = tab[64 + kc];
            e[x] = (int)(f2u(fkey_inv(topl[(tk * 2 + 0) * 16 + i])) & 127u) * 128 + (int)(f2u(fkey_inv(topl[(tk * 2 + 1) * 16 + j])) & 127u); g[x] = __expf(wv - w0) * inv; }
        unsigned short* pei = WSP(unsigned short, WS_PEI) + (size_t)(r0 + tk) * 128 + w * 16 + 4 * q4; float* peg = WSP(float, WS_PEG) + (size_t)(r0 + tk) * 128 + w * 16 + 4 * q4;
        *(v2u*)pei = (v2u){(unsigned)e[0] | ((unsigned)e[1] << 16), (unsigned)e[2] | ((unsigned)e[3] << 16)};
        *(f32x4*)peg = (f32x4){g[0], g[1], g[2], g[3]};
    }
    LDS_WAIT();
    }
}
__device__ __forceinline__ void p8_phase(Frame& F, int layer) {
    p8_init_tab(F);
    for (int ub = F.bid; ub < MP / 16; ub += F.G * P8_MAXU) { const int left = (MP / 16 - ub + F.G - 1) / F.G; p8_run<4>(F, layer, F.wave, 0, ub, F.G, left < P8_MAXU ? left : P8_MAXU); }
    for (int qu = F.bid * 8 + F.wave; qu < (MS / 16) * 8 * 4 * 8; qu += F.G * 8) { if ((qu & 7) == 0) { const int x = qu >> 3; p8_run<1>(F, layer, (x >> 2) & 7, x & 3, MP / 16 + (x >> 5), 0, 1); } }
}

constexpr size_t PE_SLICE_BYTES = (size_t)NEXP * 128;
__device__ __forceinline__ f32x2 p9_cvt(unsigned w, bool hi) { return hi ? __builtin_amdgcn_cvt_pk_f32_fp8((int)w, true) : __builtin_amdgcn_cvt_pk_f32_fp8((int)w, false); }
__device__ __forceinline__ f32x2 fma2(f32x2 a, f32x2 b, f32x2 c) { return __builtin_elementwise_fma(a, b, c); }
__device__ __forceinline__ float p9_dot16(const v4u u, const f32x2 (&h)[8]) {
    f32x2 a = {0.f, 0.f}, b = {0.f, 0.f};
    a = fma2(p9_cvt(u.x, false), h[0], a); b = fma2(p9_cvt(u.x, true), h[1], b); a = fma2(p9_cvt(u.y, false), h[2], a); b = fma2(p9_cvt(u.y, true), h[3], b);
    a = fma2(p9_cvt(u.z, false), h[4], a); b = fma2(p9_cvt(u.z, true), h[5], b); a = fma2(p9_cvt(u.w, false), h[6], a); b = fma2(p9_cvt(u.w, true), h[7], b);
    a = a + b; return a.x + a.y;
}
__device__ __forceinline__ void p9_axpy16(const v4u v, float c, f32x2 (&o)[8]) {
    const f32x2 cc = {c, c};
    o[0] = fma2(p9_cvt(v.x, false), cc, o[0]); o[1] = fma2(p9_cvt(v.x, true), cc, o[1]); o[2] = fma2(p9_cvt(v.y, false), cc, o[2]); o[3] = fma2(p9_cvt(v.y, true), cc, o[3]);
    o[4] = fma2(p9_cvt(v.z, false), cc, o[4]); o[5] = fma2(p9_cvt(v.z, true), cc, o[5]); o[6] = fma2(p9_cvt(v.w, false), cc, o[6]); o[7] = fma2(p9_cvt(v.w, true), cc, o[7]);
}
#define P9_GATHER(S, iw) do { _Pragma("unroll") for (int j_ = 0; j_ < 8; ++j_) { const unsigned w_ = (iw)[j_ >> 1]; const unsigned id_ = (j_ & 1) ? (w_ >> 16) : (w_ & 0xffffu); \
        S[j_] = *(const v4u*)(tab + ((id_ << 7) + sub16)); } } while (0)
__device__ __forceinline__ float swapsum16(float x, float y) { unsigned a = __builtin_bit_cast(unsigned, x), b = __builtin_bit_cast(unsigned, y); PSWAP16(a, b); return __builtin_bit_cast(float, a) + __builtin_bit_cast(float, b); }
__device__ __forceinline__ float swapsum32(float x, float y) { unsigned a = __builtin_bit_cast(unsigned, x), b = __builtin_bit_cast(unsigned, y); PSWAP32(a, b); return __builtin_bit_cast(float, a) + __builtin_bit_cast(float, b); }

__device__ __forceinline__ int p9_idot16(const v4u u, const v4u h) {
    int a = __builtin_amdgcn_sdot4((int)u.x, (int)h.x, 0, false); a = __builtin_amdgcn_sdot4((int)u.y, (int)h.y, a, false);
    a = __builtin_amdgcn_sdot4((int)u.z, (int)h.z, a, false); return __builtin_amdgcn_sdot4((int)u.w, (int)h.w, a, false);
}
__device__ __forceinline__ void p9u_wave(Frame& F, int layer, int slice, int first, int stride) {
    int lane_ = F.lane; asm volatile("" : "+v"(lane_));
    const int lane = lane_, gi = lane >> 3, sub = lane & 7;
    const unsigned char* tab = WSP(unsigned char, WS_PU) + (size_t)(layer * 8 + slice) * PE_SLICE_BYTES;
    const unsigned sub16 = (unsigned)sub * 16u;
    const unsigned char* hbase = WSP(unsigned char, WS_XN8) + slice * 128 + sub * 16;
    const unsigned char* ibase = (const unsigned char*)(WSP(unsigned short, WS_PEI) + gi * 16);
    const float* hsb = WSP(float, WS_HS);
    unsigned* pa = WSP(unsigned, WS_PA) + slice * 64 + lane;
    int t = first; if (t >= MTOK) return;
    v4u ia, ib, hq, nia, nib, nhq, A[8], B[8]; float hs, nhs;
#define P9U_META(tt, xa, xb, yq, ys) do { const v4u* ip_ = (const v4u*)(ibase + (size_t)(tt) * 256); xa = ip_[0]; xb = ip_[1]; yq = *(const v4u*)(hbase + (size_t)(tt) * 1024); ys = hsb[(tt)]; } while (0)
    P9U_META(t, ia, ib, hq, hs);
    P9_GATHER(A, ia);
    const bool b0 = sub & 1, b1 = sub & 2, b2 = sub & 4;
#pragma unroll 1
    for (;;) {
        const int tn = t + stride; const bool more = tn < MTOK; const int tl = more ? tn : t;
        P9U_META(tl, nia, nib, nhq, nhs);
        P9_GATHER(B, ib);
        int p[16];
#pragma unroll
        for (int j = 0; j < 8; ++j) p[j] = p9_idot16(A[j], hq);
        P9_GATHER(A, nia);
#pragma unroll
        for (int j = 0; j < 8; ++j) p[8 + j] = p9_idot16(B[j], hq);
        int q[8], r[4], sv[2];
#pragma unroll
        for (int i = 0; i < 8; ++i) { const int keep = b2 ? p[8 + i] : p[i], send = b2 ? p[i] : p[8 + i]; q[i] = keep + dpp_i<DPP_HMIR>(send); }
#pragma unroll
        for (int i = 0; i < 4; ++i) { const int keep = b0 ? q[2 * i + 1] : q[2 * i], send = b0 ? q[2 * i] : q[2 * i + 1]; r[i] = keep + dpp_i<DPP_XOR1>(send); }
#pragma unroll
        for (int i = 0; i < 2; ++i) { const int keep = b1 ? r[2 * i + 1] : r[2 * i], send = b1 ? r[2 * i] : r[2 * i + 1]; sv[i] = keep + dpp_i<DPP_XOR2>(send); }
        const float sc = hs * (1.f / 19.f);
        pa[(size_t)t * 512] = pk2((float)sv[0] * sc, (float)sv[1] * sc);
        if (!more) break;
        t = tn; ia = nia; ib = nib; hq = nhq; hs = nhs;
    }
#undef P9U_META
}

__device__ __forceinline__ void p9v_wave(Frame& F, int layer, int slice, int first, int stride, int mode) {
    int lane_ = F.lane; asm volatile("" : "+v"(lane_));
    const int lane = lane_, gi = lane >> 3, sub = lane & 7, j0 = 8 * (sub >> 2) + (sub & 3);
    const unsigned char* tab = WSP(unsigned char, WS_PV) + (size_t)(layer * 8 + slice) * PE_SLICE_BYTES;
    const unsigned sub16 = (unsigned)sub * 16u;
    const unsigned char* ibase = (const unsigned char*)(WSP(unsigned short, WS_PEI) + gi * 16);
    const unsigned* pab = WSP(unsigned, WS_PA) + lane;
    const float* pegb = WSP(float, WS_PEG) + gi * 16 + j0;
    const int eoff = slice * 128 + sub * 16 + gi;
    float* xsb = WSP(float, WS_XS) + eoff;
    int t = first; if (t >= MTOK) return;
    v4u ia, ib, nia, nib, A[8], B[8];
    unsigned pw[8], npw[8]; float g0, g1, ng0, ng1, x0, x1, nx0, nx1;
#define P9V_META(tt, xa, xb, pp, ga, gb, ya, yb) do { const v4u* ip_ = (const v4u*)(ibase + (size_t)(tt) * 256); xa = ip_[0]; xb = ip_[1]; \
        _Pragma("unroll") for (int x_ = 0; x_ < 8; ++x_) pp[x_] = pab[(size_t)(tt) * 512 + x_ * 64]; \
        ga = pegb[(size_t)(tt) * 128]; gb = pegb[(size_t)(tt) * 128 + 4]; ya = xsb[(size_t)(tt) * DM]; yb = xsb[(size_t)(tt) * DM + 8]; } while (0)
    P9V_META(t, ia, ib, pw, g0, g1, x0, x1);
    P9_GATHER(A, ia);
#pragma unroll 1
    for (;;) {
        const int tn = t + stride; const bool more = tn < MTOK; const int tl = more ? tn : t;
        P9V_META(tl, nia, nib, npw, ng0, ng1, nx0, nx1);
        P9_GATHER(B, ib);
        float alo = 0.f, ahi = 0.f;
#pragma unroll
        for (int x = 0; x < 8; ++x) { alo += bflo(pw[x]); ahi += bfhi(pw[x]); }
        const float c0 = gelu_tanh(alo * 0.03125f) * g0 * 0.0625f, c1 = gelu_tanh(ahi * 0.03125f) * g1 * 0.0625f;
        f32x2 o[8];
#pragma unroll
        for (int i = 0; i < 8; ++i) o[i] = (f32x2){0.f, 0.f};
#define P9V_C(j) __builtin_bit_cast(float, __builtin_amdgcn_ds_swizzle(__builtin_bit_cast(int, (((j) >> 2) & 1) ? c1 : c0), ((4 * ((j) >> 3) + ((j) & 3)) << 5) | 0x18))
        { const float cj[8] = {P9V_C(0), P9V_C(1), P9V_C(2), P9V_C(3), P9V_C(4), P9V_C(5), P9V_C(6), P9V_C(7)};
#pragma unroll
          for (int j = 0; j < 8; ++j) p9_axpy16(A[j], cj[j], o); }
        P9_GATHER(A, nia);
        { const float cj[8] = {P9V_C(8), P9V_C(9), P9V_C(10), P9V_C(11), P9V_C(12), P9V_C(13), P9V_C(14), P9V_C(15)};
#pragma unroll
          for (int j = 0; j < 8; ++j) p9_axpy16(B[j], cj[j], o); }
#undef P9V_C
        const bool g0b = lane & 8;
        float q[8], r[4], sv[2];
#pragma unroll
        for (int i = 0; i < 8; ++i) { const float keep = g0b ? o[i].y : o[i].x, send = g0b ? o[i].x : o[i].y; q[i] = keep + dpp_f<DPP_ROR8>(send); }
#pragma unroll
        for (int i = 0; i < 4; ++i) r[i] = swapsum16(q[2 * i], q[2 * i + 1]);
#pragma unroll
        for (int i = 0; i < 2; ++i) sv[i] = swapsum32(r[2 * i], r[2 * i + 1]);
        const float y0 = x0 + sv[0], y1 = x1 + sv[1];
        if (mode == 0) {
            float* xs = xsb + (size_t)t * DM; xs[0] = y0; xs[8] = y1;
            bf16* xn = WSP(bf16, WS_XNA) + (size_t)t * DM + eoff; xn[0] = (bf16)f2bf(y0); xn[8] = (bf16)f2bf(y1);
            const float ss = wave_sum(y0 * y0 + y1 * y1);
            if (lane == 0) WSP(float, WS_SSQ)[(size_t)t * 8 + slice] = ss;
        } else {
            float* y = (t < MP ? F.out + O_YP + (size_t)t * DM : F.out + O_YS + (size_t)(t - MP) * DM) + eoff;
            y[0] = y0; y[8] = y1;
        }
        if (!more) break;
        t = tn; ia = nia; ib = nib; g0 = ng0; g1 = ng1; x0 = nx0; x1 = nx1;
#pragma unroll
        for (int x = 0; x < 8; ++x) pw[x] = npw[x];
    }
#undef P9V_META
}
#undef P9_GATHER

__device__ __forceinline__ void glds16_asm(const void* g, unsigned lds_base) {
    unsigned sv; asm volatile("s_mov_b32 %0, m0\n\ts_mov_b32 m0, %2\n\ts_nop 0\n\tglobal_load_lds_dwordx4 %1, off\n\ts_mov_b32 m0, %0" : "=&s"(sv) : "v"(g), "s"(lds_base) : "memory"); }
constexpr int PV_TILE = 16384, PV_CB = 8 * PV_TILE;
typedef short s16x4 __attribute__((ext_vector_type(4)));
struct P9M { v4u ia, ib; unsigned pw[8]; float g0, g1; f32x2 x; };
#define P9V2_ALD(dst, ptr, off) asm volatile("global_load_dword %0, %1, off offset:" #off : "=v"(dst) : "v"(ptr) : "memory")
#define P9V2_LAUNDER(M) "+v"(M.ia), "+v"(M.ib), "+v"(M.pw[0]), "+v"(M.pw[1]), "+v"(M.pw[2]), "+v"(M.pw[3]), "+v"(M.pw[4]), "+v"(M.pw[5]), "+v"(M.pw[6]), "+v"(M.pw[7]), "+v"(M.g0), "+v"(M.g1), "+v"(M.x)
__device__ __forceinline__ void p9v2_wave(Frame& F, int layer, int slice, int first, int stride, int mode) {
    int lane_ = F.lane; asm volatile("" : "+v"(lane_));
    const int lane = lane_, gi = lane >> 3, sub = lane & 7, j0 = 8 * (sub >> 2) + (sub & 3), fr = lane & 15, fq = lane >> 4;
    const unsigned char* tab = WSP(unsigned char, WS_PV) + (size_t)(layer * 8 + slice) * PE_SLICE_BYTES;
    const unsigned sub16 = (unsigned)sub * 16u;
    LAS unsigned char* Tu = F.lds + F.wave * PV_TILE;
    LAS unsigned char* Tl = Tu + (4 * fq + (fr >> 2)) * 128 + 8 * (fr & 3);
    LAS unsigned char* Cb = F.lds + PV_CB + F.wave * 128;
    const unsigned char* ibase = (const unsigned char*)(WSP(unsigned short, WS_PEI) + gi * 16);
    const unsigned* pab = WSP(unsigned, WS_PA) + lane;
    const float* pegb = WSP(float, WS_PEG) + gi * 16 + j0;
    const int eoff = slice * 128 + 32 * fq + 2 * fr;
    float* xsb = WSP(float, WS_XS) + eoff;
    int t = first; if (t >= MTOK) return;
    P9M C, N1, N2;
#define P9V2_META(M, tt) do { const unsigned char* ip_ = ibase + (size_t)(tt) * 256; const unsigned* pp_ = pab + (size_t)(tt) * 512; const float* gp_ = pegb + (size_t)(tt) * 128; const float* xp_ = xsb + (size_t)(tt) * DM; \
        asm volatile("global_load_dwordx4 %0, %1, off" : "=v"(M.ia) : "v"(ip_) : "memory"); asm volatile("global_load_dwordx4 %0, %1, off offset:16" : "=v"(M.ib) : "v"(ip_) : "memory"); \
        P9V2_ALD(M.pw[0], pp_, 0); P9V2_ALD(M.pw[1], pp_, 256); P9V2_ALD(M.pw[2], pp_, 512); P9V2_ALD(M.pw[3], pp_, 768); P9V2_ALD(M.pw[4], pp_, 1024); P9V2_ALD(M.pw[5], pp_, 1280); P9V2_ALD(M.pw[6], pp_, 1536); P9V2_ALD(M.pw[7], pp_, 1792); \
        P9V2_ALD(M.g0, gp_, 0); P9V2_ALD(M.g1, gp_, 16); asm volatile("global_load_dwordx2 %0, %1, off" : "=v"(M.x) : "v"(xp_) : "memory"); } while (0)
#define P9V2_DMA2(ks, M) do { const unsigned w_ = (ks) < 4 ? M.ia[(ks) & 3] : M.ib[(ks) & 3]; \
        glds16_asm(tab + (((w_ & 0xffffu) << 7) + sub16), tu + (unsigned)((2 * (ks)) * 1024)); glds16_asm(tab + (((w_ >> 16) << 7) + sub16), tu + (unsigned)((2 * (ks) + 1) * 1024)); } while (0)
#define P9V2_MM(ks) do { const unsigned cw_ = *(const LAS unsigned*)(Cb + 16 * (ks) + 4 * fq); \
        const long ae_ = __builtin_bit_cast(long, (v2u){__builtin_amdgcn_perm(0u, cw_, 0x0c010c00u), __builtin_amdgcn_perm(0u, cw_, 0x0c030c02u)}); \
        const long ao_ = __builtin_bit_cast(long, (v2u){__builtin_amdgcn_perm(0u, cw_, 0x010c000cu), __builtin_amdgcn_perm(0u, cw_, 0x030c020cu)}); \
        _Pragma("unroll") for (int nt_ = 0; nt_ < 4; ++nt_) { const long b_ = __builtin_bit_cast(long, __builtin_amdgcn_ds_read_tr16_b64_v4i16((LAS s16x4*)(Tl + (ks) * 2048 + nt_ * 32))); \
            acc_e[nt_] = __builtin_amdgcn_mfma_f32_16x16x32_fp8_fp8(ae_, b_, acc_e[nt_], 0, 0, 0); acc_o[nt_] = __builtin_amdgcn_mfma_f32_16x16x32_fp8_fp8(ao_, b_, acc_o[nt_], 0, 0, 0); } } while (0)
#define P9V2_STEP(ks, NXT) do { asm volatile("s_waitcnt vmcnt(27)" ::: "memory"); P9V2_MM(ks); asm volatile("s_waitcnt lgkmcnt(0)" ::: "memory"); P9V2_DMA2(ks, NXT); } while (0)
    const unsigned tu = __builtin_amdgcn_readfirstlane((unsigned)(size_t)Tu);
    bool more = false; int tn = 0;
#define P9V2_UNIT(CUR, NXT, NN) do { \
        tn = t + stride; more = tn < MTOK; const int t2_ = tn + stride < MTOK ? tn + stride : (more ? tn : t);        \
        P9V2_META(NN, t2_);                   \
        float alo_ = 0.f, ahi_ = 0.f; \
        _Pragma("unroll") for (int x_ = 0; x_ < 8; ++x_) { alo_ += bflo(CUR.pw[x_]); ahi_ += bfhi(CUR.pw[x_]); } \
        const float c0_ = gelu_tanh(alo_ * 0.03125f) * CUR.g0 * 0.0625f, c1_ = gelu_tanh(ahi_ * 0.03125f) * CUR.g1 * 0.0625f;        \
        { const int pk_ = __builtin_amdgcn_cvt_pk_fp8_f32(c0_ * 256.f, c1_ * 256.f, 0, false); Cb[8 * j0 + gi] = (unsigned char)(pk_ & 255); Cb[8 * (j0 + 4) + gi] = (unsigned char)((pk_ >> 8) & 255); } \
        f32x4 acc_e[4], acc_o[4]; \
        _Pragma("unroll") for (int i_ = 0; i_ < 4; ++i_) { acc_e[i_] = (f32x4){0.f, 0.f, 0.f, 0.f}; acc_o[i_] = (f32x4){0.f, 0.f, 0.f, 0.f}; } \
        asm volatile("s_waitcnt vmcnt(27)" : P9V2_LAUNDER(NXT) :: "memory");        \
        P9V2_MM(0); asm volatile("s_waitcnt lgkmcnt(0)" ::: "memory"); P9V2_DMA2(0, NXT); \
        P9V2_STEP(1, NXT); P9V2_STEP(2, NXT); P9V2_STEP(3, NXT); P9V2_STEP(4, NXT); P9V2_STEP(5, NXT); P9V2_STEP(6, NXT); P9V2_STEP(7, NXT); \
        const f32x4 se_ = fq == 0 ? acc_e[0] : fq == 1 ? acc_e[1] : fq == 2 ? acc_e[2] : acc_e[3], so_ = fq == 0 ? acc_o[0] : fq == 1 ? acc_o[1] : fq == 2 ? acc_o[2] : acc_o[3]; \
        const float y0_ = CUR.x.x + se_[0] * (1.f / 256.f), y1_ = CUR.x.y + so_[0] * (1.f / 256.f); \
        if (mode == 0) { \
            *(f32x2*)(xsb + (size_t)t * DM) = (f32x2){y0_, y1_}; \
            *(unsigned*)(WSP(bf16, WS_XNA) + (size_t)t * DM + eoff) = pk2(y0_, y1_); \
            const float ss_ = wave_sum(y0_ * y0_ + y1_ * y1_); \
            if (lane == 0) WSP(float, WS_SSQ)[(size_t)t * 8 + slice] = ss_; \
        } else { \
            float* y_ = (t < MP ? F.out + O_YP + (size_t)t * DM : F.out + O_YS + (size_t)(t - MP) * DM) + eoff; \
            *(f32x2*)y_ = (f32x2){y0_, y1_}; \
        } \
    } while (0)
    P9V2_META(C, t);
    { const int t1 = t + stride < MTOK ? t + stride : t; P9V2_META(N1, t1); }
    asm volatile("s_waitcnt vmcnt(13)" : P9V2_LAUNDER(C) :: "memory");
    P9V2_DMA2(0, C); P9V2_DMA2(1, C); P9V2_DMA2(2, C); P9V2_DMA2(3, C); P9V2_DMA2(4, C); P9V2_DMA2(5, C); P9V2_DMA2(6, C); P9V2_DMA2(7, C);
#pragma unroll 1
    for (;;) {
        P9V2_UNIT(C, N1, N2); if (!more) break; t = tn;
        P9V2_UNIT(N1, N2, C); if (!more) break; t = tn;
        P9V2_UNIT(N2, C, N1); if (!more) break; t = tn;
    }
    asm volatile("s_waitcnt vmcnt(0)" ::: "memory");
#undef P9V2_UNIT
#undef P9V2_STEP
#undef P9V2_MM
#undef P9V2_DMA2
#undef P9V2_META
}

constexpr float QSCALE = 0.125f * 1.4426950408889634f;
constexpr int PP_VT = 0;
__device__ __forceinline__ float rms64(float v) { return frsq(wave_sum(v * v) * (1.f / 64.f) + EPS); }

__device__ __forceinline__ void pp_q_row(Frame& F, int row, const bf16* kvq, const float qg) {
    const int lane = F.lane;
    bf16* qn = WSP(bf16, WS_QN) + (size_t)row * 1024;
#pragma unroll 4
    for (int hd = 0; hd < 16; ++hd) { const float v = bf2f(kvq[NKV + hd * 64 + lane]); qn[hd * 64 + lane] = (bf16)f2bf(v * rms64(v) * qg); }
    if (lane < 48) WSP(float, WS_GATES)[(size_t)row * 48 + lane] = sigmoid_f(bf2f(kvq[NKV + 1024 + lane]));
}
__device__ __forceinline__ f32x4 rms64x4(f32x4 v) { const float ss = row_sum16((v.x * v.x + v.y * v.y) + (v.z * v.z + v.w * v.w)); return v * (frsq(ss * (1.f / 64.f) + EPS)); }
__device__ __forceinline__ v2u pk4(f32x4 v) { return (v2u){pk2(v.x, v.y), pk2(v.z, v.w)}; }
__device__ __forceinline__ void pp_prompt_tile(Frame& F, int unit) {
    const int lane = F.lane, w = F.wave, b = unit >> 7, t0 = (unit & 127) * 64, g = lane >> 4, d4 = (lane & 15) * 4;
    LAS unsigned char* L = F.lds; asm volatile("" : "+v"(L));
    LAS bf16* vt = (LAS bf16*)(L + PP_VT);
    const f32x4 kg1 = *(const f32x4*)(FIN(16) + 64 + d4), kg2 = *(const f32x4*)(FIN(16) + 128 + d4), qg = *(const f32x4*)(FIN(22) + d4) * QSCALE;
    v2u nv[6], nq[4], ngl;
#define PP_FETCH(rr_) do { const int row_ = b * PT + t0 + 8 * w + ((rr_) < 8 ? (rr_) : 7); const v2u* kvq_ = (const v2u*)(WSP(bf16, WS_KVQ) + (size_t)row_ * NKVQ) + lane;        \
        _Pragma("unroll") for (int sidx_ = 0; sidx_ < 6; ++sidx_) nv[sidx_] = kvq_[64 * sidx_]; \
        _Pragma("unroll") for (int i_ = 0; i_ < 4; ++i_) nq[i_] = kvq_[64 * (6 + i_)]; \
        ngl = ((const v2u*)(WSP(bf16, WS_KVQ) + (size_t)row_ * NKVQ))[640 + (lane & 15)]; } while (0)
    PP_FETCH(0);
#pragma unroll 1
    for (int rr = 0; rr < 8; ++rr) {
        const int tl = 8 * w + rr, t = t0 + tl, row = b * PT + t;
        f32x4 v[6], q[4]; const f32x4 gl = {bflo(ngl.x), bfhi(ngl.x), bflo(ngl.y), bfhi(ngl.y)};
#pragma unroll
        for (int sidx = 0; sidx < 6; ++sidx) v[sidx] = (f32x4){bflo(nv[sidx].x), bfhi(nv[sidx].x), bflo(nv[sidx].y), bfhi(nv[sidx].y)};
#pragma unroll
        for (int i = 0; i < 4; ++i) q[i] = (f32x4){bflo(nq[i].x), bfhi(nq[i].x), bflo(nq[i].y), bfhi(nq[i].y)};
        PP_FETCH(rr + 1);
        const f32x4 ks = rms64x4(v[2]) * kg1, kw = rms64x4(v[4]) * kg2;
        f32x4* okv = (f32x4*)(F.out + O_KVP + (size_t)row * 1024) + lane;
        okv[0] = v[0]; okv[64] = v[1]; okv[128] = ks; okv[192] = v[3];
        if (t >= PT - WINDOW) { f32x4* owin = (f32x4*)(F.out + O_WINP + ((size_t)b * 512 + (t - (PT - WINDOW))) * 512) + lane; owin[0] = kw; owin[64] = v[5]; }
        const size_t kidx = (((size_t)b * NG + g) * PT + t) * 64 + d4;
        *(v2u*)(WSP(bf16, WS_KSEL) + kidx) = pk4(ks); *(v2u*)(WSP(bf16, WS_KWIN) + kidx) = pk4(kw);
#pragma unroll
        for (int j = 0; j < 4; ++j) { vt[((0 * 4 + g) * 64 + d4 + j) * 72 + tl] = (bf16)f2bf(v[3][j]); vt[((1 * 4 + g) * 64 + d4 + j) * 72 + tl] = (bf16)f2bf(v[5][j]); }
        bf16* qn = WSP(bf16, WS_QN) + (size_t)row * 1024 + g * 64 + d4;
#pragma unroll
        for (int i = 0; i < 4; ++i) *(v2u*)(qn + i * 256) = pk4(rms64x4(q[i]) * qg);
        if (lane < 12) *(f32x4*)(WSP(float, WS_GATES) + (size_t)row * 48 + 4 * lane) = (f32x4){sigmoid_f(gl.x), sigmoid_f(gl.y), sigmoid_f(gl.z), sigmoid_f(gl.w)};
    }
#undef PP_FETCH
    __syncthreads();
    {
        const int which = F.tid >> 8, gd = F.tid & 255;
        bf16* dst = WSP(bf16, which == 0 ? WS_VSELT : WS_VWINT) + (((size_t)b * NG * 64 + gd) * PT + t0);
        const LAS bf16* src = vt + ((which * 256 + gd) * 72);
#pragma unroll
        for (int i = 0; i < 8; ++i) *(v4u*)(dst + 8 * i) = *(const LAS v4u*)(src + 8 * i);
    }
    __syncthreads();
}
__device__ __forceinline__ void pp_sample_row(Frame& F, int sr, int part = -1) {
    const int lane = F.lane, bs = sr >> 2, i = sr & 3, row = MP + sr;
    const float kg1 = FIN(16)[64 + lane], kg2 = FIN(16)[128 + lane], qg = FIN(22)[lane] * QSCALE;
    const bf16* kvq = WSP(bf16, WS_KVQ) + (size_t)row * NKVQ;
    float* okv = F.out + O_KVS + (size_t)sr * 1024;
    float* owin = F.out + O_WINS + ((size_t)bs * 512 + 508 + i) * 512;
#pragma unroll
    for (int g = 0; g < 4; ++g) { if (part >= 0 && part != g) continue;
        const float v0 = bf2f(kvq[0 * 256 + g * 64 + lane]), v1 = bf2f(kvq[1 * 256 + g * 64 + lane]), v2 = bf2f(kvq[2 * 256 + g * 64 + lane]);
        const float v3 = bf2f(kvq[3 * 256 + g * 64 + lane]), v4 = bf2f(kvq[4 * 256 + g * 64 + lane]), v5 = bf2f(kvq[5 * 256 + g * 64 + lane]);
        const float ks = v2 * rms64(v2) * kg1, kw = v4 * rms64(v4) * kg2;
        okv[0 * 256 + g * 64 + lane] = v0; okv[1 * 256 + g * 64 + lane] = v1; okv[2 * 256 + g * 64 + lane] = ks; okv[3 * 256 + g * 64 + lane] = v3;
        owin[g * 64 + lane] = kw; owin[256 + g * 64 + lane] = v5;
        const size_t bg = (size_t)bs * NG + g;
        WSP(bf16, WS_SKWIN)[(bg * 544 + 512 + i) * 64 + lane] = (bf16)f2bf(kw);
        WSP(bf16, WS_SVWINT)[(bg * 64 + lane) * 544 + 512 + i] = (bf16)f2bf(v5);
        float* sn = WSP(float, WS_SNEW) + (((size_t)bs * 4 + i) * 2) * 256 + g * 64 + lane;
        sn[0] = ks; sn[256] = v3;
    }
    bf16* qn = WSP(bf16, WS_QN) + (size_t)row * 1024;
#pragma unroll 4
    for (int hd = 0; hd < 16; ++hd) { if (part >= 0 && (hd >> 2) != part - 4) continue; const float v = bf2f(kvq[NKV + hd * 64 + lane]); qn[hd * 64 + lane] = (bf16)f2bf(v * rms64(v) * qg); }
    if ((part < 0 || part == 7) && lane < 48) WSP(float, WS_GATES)[(size_t)row * 48 + lane] = sigmoid_f(bf2f(kvq[NKV + 1024 + lane]));
}

struct RowPPrompt { static constexpr bool BF = true; const bf16* base; __device__ __forceinline__ const bf16* operator()(int t) const { return base + (size_t)t * NKVQ; } };
struct RowPSample { static constexpr bool BF = false; const float* cache; const int* pt; __device__ __forceinline__ const float* operator()(int t) const { return cache + ((size_t)pt[t >> 7] * PAGE + (t & 127)) * 1024; } };
template <class RowP> __device__ __forceinline__ bf16x8 rowp_frag(const RowP& rowp, int t, int off) {
    if constexpr (RowP::BF) return ld8(rowp(t) + off);
    else { const float* rp = rowp(t) + off; return cvt8(*(const f32x4*)rp, *(const f32x4*)(rp + 4)); }
}
__device__ __forceinline__ void compress_finish(Frame& F, const f32x4 (&acc)[4], int kv, int blk, bf16* KC, bf16* VCT) {
    const int lane = F.lane, fr = lane & 15, fq = lane >> 4;
    const float* pet = WSP(float, WS_PETERM) + kv * 64;
    bf16x8 hb[2];
#pragma unroll
    for (int s = 0; s < 2; ++s) { f32x4 h0, h1;
#pragma unroll
        for (int r = 0; r < 4; ++r) { h0[r] = gelu_tanh(acc[2 * s][r] + pet[16 * (2 * s) + 4 * fq + r]); h1[r] = gelu_tanh(acc[2 * s + 1][r] + pet[16 * (2 * s + 1) + 4 * fq + r]); }
        hb[s] = cvt8(h0, h1); }
    const bf16* w2f = WSP(bf16, WS_W2F) + (size_t)kv * 4096 + lane * 8;
    f32x4 o[4];
#pragma unroll
    for (int dt = 0; dt < 4; ++dt) { o[dt] = (f32x4){0.f, 0.f, 0.f, 0.f};
#pragma unroll
        for (int s = 0; s < 2; ++s) o[dt] = MFMA16(ld8(w2f + (dt * 2 + s) * 512), hb[s], o[dt]); }
    if (kv == 0) {
        float ss = 0.f;
#pragma unroll
        for (int dt = 0; dt < 4; ++dt) ss += (o[dt][0] * o[dt][0] + o[dt][1] * o[dt][1]) + (o[dt][2] * o[dt][2] + o[dt][3] * o[dt][3]);
        ss = x32_sum(x16_sum(ss));
        const float rstd = frsq(ss * (1.f / 64.f) + EPS);
        const float* kg0 = FIN(16);
        if (blk < NCMP) {
#pragma unroll
            for (int dt = 0; dt < 4; ++dt) { const int d = 16 * dt + 4 * fq; v2u ov; ov.x = pk2(o[dt][0] * rstd * kg0[d], o[dt][1] * rstd * kg0[d + 1]); ov.y = pk2(o[dt][2] * rstd * kg0[d + 2], o[dt][3] * rstd * kg0[d + 3]);
                *(v2u*)(KC + (size_t)blk * 64 + d) = ov; }
        } else {
#pragma unroll
            for (int dt = 0; dt < 4; ++dt) *(v2u*)(KC + (size_t)blk * 64 + 16 * dt + 4 * fq) = (v2u){0u, 0u};
        }
    } else {
#pragma unroll
        for (int dt = 0; dt < 4; ++dt)
#pragma unroll
            for (int r = 0; r < 4; ++r) VCT[(size_t)(16 * dt + 4 * fq + r) * 512 + blk] = (blk < NCMP) ? (bf16)f2bf(o[dt][r]) : (bf16)0;
    }
}

template <class RowP>
__device__ __forceinline__ void compress_part(Frame& F, const RowP& rowp, int kv, int j, int r_lo, int r_hi, f32x4 (&acc)[4]) {
    const int lane = F.lane, fr = lane & 15, fq = lane >> 4;
    const bf16* W1 = WSP(bf16, WS_W1T) + (size_t)kv * 64 * 2048 + (size_t)fr * 2048 + 8 * fq;
    const int blk = 16 * j + fr;
#pragma unroll
    for (int mt = 0; mt < 4; ++mt) acc[mt] = (f32x4){0.f, 0.f, 0.f, 0.f};
#pragma unroll 2
    for (int r = r_lo; r < r_hi; ++r) {
        int t = 16 * blk + r; t = t < PAST ? t : PAST - 1;
#pragma unroll
        for (int hf = 0; hf < 2; ++hf) {
            const bf16x8 bfrag = rowp_frag(rowp, t, 8 * fq + 32 * hf);
            const int ks = 2 * r + hf;
#pragma unroll
            for (int mt = 0; mt < 4; ++mt) acc[mt] = MFMA16(ld8(W1 + (size_t)mt * 16 * 2048 + 32 * ks), bfrag, acc[mt]);
        }
    }
}
template <class RowP>
__device__ __forceinline__ void compress_tile(Frame& F, const RowP& rowp, int kv, int j, bf16* KC, bf16* VCT) {
    const int lane = F.lane, fr = lane & 15, fq = lane >> 4;
    const bf16* W1 = WSP(bf16, WS_W1T) + (size_t)kv * 64 * 2048 + (size_t)fr * 2048 + 8 * fq;
    const int blk = 16 * j + fr;
    f32x4 acc[4];
#pragma unroll
    for (int mt = 0; mt < 4; ++mt) acc[mt] = (f32x4){0.f, 0.f, 0.f, 0.f};
#pragma unroll 2
    for (int r = 0; r < 32; ++r) {
        int t = 16 * blk + r; t = t < PAST ? t : PAST - 1;
#pragma unroll
        for (int hf = 0; hf < 2; ++hf) {
            const bf16x8 bfrag = rowp_frag(rowp, t, 8 * fq + 32 * hf);
            const int ks = 2 * r + hf;
#pragma unroll
            for (int mt = 0; mt < 4; ++mt) acc[mt] = MFMA16(ld8(W1 + (size_t)mt * 16 * 2048 + 32 * ks), bfrag, acc[mt]);
        }
    }
    compress_finish(F, acc, kv, blk, KC, VCT);
}


__device__ __forceinline__ void compress_prompt(Frame& F, int id) {
    const int kv = id & 1, j = (id >> 1) & 31, bg = id >> 6, b = bg >> 2, g = bg & 3;
    RowPPrompt rp{WSP(bf16, WS_KVQ) + (size_t)b * PT * NKVQ + kv * 256 + g * 64};
    compress_tile(F, rp, kv, j, WSP(bf16, WS_KCMP) + (size_t)bg * 512 * 64, WSP(bf16, WS_VCMPT) + (size_t)bg * 64 * 512);
}
constexpr int CP_PART = 81920;
__device__ __forceinline__ void compress_prompt_split(Frame& F, int id) {
    const int kv = id & 1, j = (id >> 1) & 31, bg = id >> 6, b = bg >> 2, g = bg & 3, q = F.wave & 3, lane = F.lane;
    RowPPrompt rp{WSP(bf16, WS_KVQ) + (size_t)b * PT * NKVQ + kv * 256 + g * 64};
    f32x4 acc[4];
    compress_part(F, rp, kv, j, 8 * q, 8 * q + 8, acc);
    LAS f32x4* part = (LAS f32x4*)(F.lds + CP_PART) + (F.wave >> 2) * 1024;
#pragma unroll
    for (int mt = 0; mt < 4; ++mt) part[(q * 4 + mt) * 64 + lane] = acc[mt];
    __syncthreads();
    if (q == 0) {
#pragma unroll
        for (int mt = 0; mt < 4; ++mt) acc[mt] = (part[(0 * 4 + mt) * 64 + lane] + part[(1 * 4 + mt) * 64 + lane]) + (part[(2 * 4 + mt) * 64 + lane] + part[(3 * 4 + mt) * 64 + lane]);
        compress_finish(F, acc, kv, 16 * j + (lane & 15), WSP(bf16, WS_KCMP) + (size_t)bg * 512 * 64, WSP(bf16, WS_VCMPT) + (size_t)bg * 64 * 512);
    }
    __syncthreads();
}
__device__ __forceinline__ void compress_sample(Frame& F, int id) {
    const int kv = id & 1, j = (id >> 1) & 31, bg = id >> 6, lane = F.lane, fr = lane & 15, fq = lane >> 4;
    const int blk = 16 * j + fr, nb = blk < 511 ? blk + 1 : 511;
    const bf16* f1 = WSP(bf16, WS_FS) + ((size_t)bg * 512 + blk) * 256 + kv * 128 + 4 * fq;
    const bf16* f2 = WSP(bf16, WS_FS) + ((size_t)bg * 512 + nb) * 256 + kv * 128 + 64 + 4 * fq;
    f32x4 acc[4];
#pragma unroll
    for (int mt = 0; mt < 4; ++mt) { const v2u a = *(const v2u*)(f1 + 16 * mt), b = *(const v2u*)(f2 + 16 * mt);
        acc[mt] = (f32x4){bflo(a.x) + bflo(b.x), bfhi(a.x) + bfhi(b.x), bflo(a.y) + bflo(b.y), bfhi(a.y) + bfhi(b.y)}; }
    compress_finish(F, acc, kv, blk, WSP(bf16, WS_SKCMP) + (size_t)bg * 512 * 64, WSP(bf16, WS_SVCMPT) + (size_t)bg * 64 * 512);
}

constexpr int NSA_IMP = 0;
constexpr int NSA_Q = 67584;
constexpr int NSA_QLD = 68;
constexpr float LOG2E = 1.4426950408889634f;
#ifndef NSA_SUBUNITS
#define NSA_SUBUNITS 0
#endif
__device__ __forceinline__ float ex2(float x) { return __builtin_amdgcn_exp2f(x); }

struct KvBf16 {
    const bf16* K; const bf16* VT; int ld;
    __device__ __forceinline__ void lane_offsets(int fr, int fq, unsigned& ko, unsigned& vo) const {
        ko = (unsigned)(((8 * (fr >> 2) + (fr & 3)) * 64 + 8 * fq) * 2); vo = (unsigned)((fr * ld + 8 * fq) * 2);
        asm volatile("" : "+v"(ko), "+v"(vo));
    }
    __device__ __forceinline__ bf16x8 kf(int key0, int mt, int ks, unsigned ko) const {
        return *(const bf16x8*)((const char*)K + (size_t)key0 * 128 + (ko + (unsigned)((4 * mt * 64 + 32 * ks) * 2))); }
    __device__ __forceinline__ bf16x8 vf(int key0, int dt, unsigned vo) const {
        return *(const bf16x8*)((const char*)VT + (size_t)key0 * 2 + (vo + (unsigned)(16 * dt * ld * 2))); }
};
struct KvSampleSel {
    const float* cache; const int* pt; const float* snew; int g;
    __device__ __forceinline__ const float* krow(int pos, int slot) const {
        if (pos < PAST) return cache + ((size_t)pt[pos >> 7] * PAGE + (pos & 127)) * 1024 + slot * 256;
        int i = pos - PAST; i = i < 3 ? i : 3; return snew + (size_t)i * 512 + (slot - 2) * 256; }
    __device__ __forceinline__ void lane_offsets(int fr, int fq, unsigned& ko, unsigned& vo) const { ko = (unsigned)(fr | (fq << 8)); vo = ko; asm volatile("" : "+v"(ko), "+v"(vo)); }
    __device__ __forceinline__ bf16x8 kf(int key0, int mt, int ks, unsigned ko) const { const int fr = ko & 255, fq = ko >> 8;
        const float* p = krow(key0 + 8 * (fr >> 2) + 4 * mt + (fr & 3), 2) + 32 * ks + 8 * fq; return cvt8(*(const f32x4*)p, *(const f32x4*)(p + 4)); }
    __device__ __forceinline__ bf16x8 vf(int key0, int dt, unsigned vo) const { const int fr = vo & 255, fq = vo >> 8; f32x4 a, b;
#pragma unroll
        for (int j = 0; j < 4; ++j) { a[j] = krow(key0 + 8 * fq + j, 3)[16 * dt + fr]; b[j] = krow(key0 + 8 * fq + 4 + j, 3)[16 * dt + fr]; }
        return cvt8(a, b); }
};
struct KvFrags { bf16x8 k[2][2]; bf16x8 v[4]; };
template <bool WITHV, class KV>
__device__ __forceinline__ void nsa_load(const KV& kv, int key0, int fr, int fq, KvFrags& f) {
    unsigned ko, vo; kv.lane_offsets(fr, fq, ko, vo);
#pragma unroll
    for (int mt = 0; mt < 2; ++mt)
#pragma unroll
        for (int ks = 0; ks < 2; ++ks) f.k[mt][ks] = kv.kf(key0, mt, ks, ko);
    if (WITHV) {
#pragma unroll
        for (int dt = 0; dt < 4; ++dt) f.v[dt] = kv.vf(key0, dt, vo);
    }
}

template <int NT, int MODE, bool QREG = false>
__device__ __forceinline__ void nsa_core(const KvFrags& f, int key0, const LAS bf16* qrow, int qnt, f32x4 (&O)[NT][4], float (&m)[NT], float (&l)[NT], const float (&invl)[NT], const float (&slope)[NT],
                                         int t, int pmul, int padd, int wlim, bool selok, LAS float* improw, int fq, const bf16x8* qreg = nullptr) {
    float dist[2][4]; bool val[2][4];
#pragma unroll
    for (int mt = 0; mt < 2; ++mt)
#pragma unroll
        for (int r = 0; r < 4; ++r) { const int kk = key0 + 8 * fq + 4 * mt + r; const int dd = t - (pmul * kk + padd); val[mt][r] = selok && dd >= 0 && dd < wlim; dist[mt][r] = val[mt][r] ? (float)dd : 1e6f; }
    float imp_main[2] = {0.f, 0.f}, imp_spill[2] = {0.f, 0.f};
    f32x4 sc[NT][2]; bf16x8 pfr[NT];
    __builtin_amdgcn_s_setprio(1);
#pragma unroll
    for (int nt = 0; nt < NT; ++nt) {
        bf16x8 q0, q1; if (QREG) { q0 = qreg[nt * 2]; q1 = qreg[nt * 2 + 1]; } else { q0 = ld8l(qrow + nt * qnt + 8 * fq); q1 = ld8l(qrow + nt * qnt + 32 + 8 * fq); }
#pragma unroll
        for (int mt = 0; mt < 2; ++mt) { sc[nt][mt] = (f32x4){0.f, 0.f, 0.f, 0.f}; sc[nt][mt] = MFMA16(f.k[mt][0], q0, sc[nt][mt]); sc[nt][mt] = MFMA16(f.k[mt][1], q1, sc[nt][mt]); }
    }
    __builtin_amdgcn_s_setprio(0);
#pragma unroll
    for (int nt = 0; nt < NT; ++nt) {
        f32x4 p[2]; float ps = 0.f;
#pragma unroll
        for (int mt = 0; mt < 2; ++mt)
#pragma unroll
            for (int r = 0; r < 4; ++r) { float pv = ex2(sc[nt][mt][r] - slope[nt] * dist[mt][r]); if (MODE == 2) pv *= invl[nt]; p[mt][r] = pv; ps += pv; }
        if (MODE != 2) l[nt] += ps;
        if (MODE == 2) {
#pragma unroll
            for (int mt = 0; mt < 2; ++mt) { imp_main[mt] += (p[mt][0] + p[mt][1]) + (p[mt][2] + p[mt][3]); imp_spill[mt] += p[mt][3]; }
        }
        if (MODE != 1) pfr[nt] = cvt8(p[0], p[1]);
    }
    if (MODE != 1) {
        __builtin_amdgcn_s_setprio(1);
#pragma unroll
        for (int nt = 0; nt < NT; ++nt)
#pragma unroll
            for (int dt = 0; dt < 4; ++dt) O[nt][dt] = MFMA16(f.v[dt], pfr[nt], O[nt][dt]);
        __builtin_amdgcn_s_setprio(0);
    }
    if (MODE == 2) {
#pragma unroll
        for (int mt = 0; mt < 2; ++mt) { const int j = key0 / 4 + 2 * fq + mt;
            __hip_atomic_fetch_add(improw + j, imp_main[mt], __ATOMIC_RELAXED, __HIP_MEMORY_SCOPE_WORKGROUP);
            __hip_atomic_fetch_add(improw + j + 1, imp_spill[mt], __ATOMIC_RELAXED, __HIP_MEMORY_SCOPE_WORKGROUP); }
    }
}
template <int NT, int MODE, class KV>
__device__ __forceinline__ void nsa_tile(const KV& kv, int key0, const LAS bf16* qrow, int qnt, f32x4 (&O)[NT][4], float (&m)[NT], float (&l)[NT], const float (&invl)[NT], const float (&slope)[NT],
                                         int t, int pmul, int padd, int wlim, bool selok, LAS float* improw, int fr, int fq) {
    KvFrags f; nsa_load<MODE != 1>(kv, key0, fr, fq, f);
    nsa_core<NT, MODE>(f, key0, qrow, qnt, O, m, l, invl, slope, t, pmul, padd, wlim, selok, improw, fq);
}

template <int NT>
__device__ __forceinline__ void nsa_zero(f32x4 (&O)[NT][4], float (&m)[NT], float (&l)[NT]) {
#pragma unroll
    for (int nt = 0; nt < NT; ++nt) { m[nt] = -1e30f; l[nt] = 0.f;
#pragma unroll
        for (int dt = 0; dt < 4; ++dt) O[nt][dt] = (f32x4){0.f, 0.f, 0.f, 0.f}; }
}

template <bool SAMPLE>
__device__ __forceinline__ void nsa_unit(Frame& F, int id) {
    constexpr int NT = SAMPLE ? 1 : 4;
    int lane_ = F.lane; asm volatile("" : "+v"(lane_));
    const int lane = lane_, fr = lane & 15, fq = lane >> 4;
    LAS unsigned char* L = F.lds; asm volatile("" : "+v"(L));
    LAS float* imp = (LAS float*)(L + NSA_IMP + F.wave * 8448);
    LAS bf16* qw = (LAS bf16*)(L + NSA_Q + F.wave * 8704);
    int bg, g, t, row, trow, tmax, row0;
    if (SAMPLE) { bg = id; g = id & 3; t = PAST + (fr >> 2); row0 = MP + (id >> 2) * 4; row = row0 + (fr >> 2); trow = fr >> 2; tmax = PAST + 3; }
    else { bg = id >> 9; g = bg & 3; const int tt = id & 511; t = 16 * tt + fr; row0 = (bg >> 2) * PT + 16 * tt; row = row0 + fr; trow = fr; tmax = 16 * tt + 15; }
    {
        const int nrow = SAMPLE ? 16 : 64;
        for (int i = lane; i < nrow * 8; i += 64) { const int rr = i >> 3, c8 = i & 7;
            *(LAS v4u*)(qw + rr * NSA_QLD + 8 * c8) = *(const v4u*)(WSP(bf16, WS_QN) + (size_t)(row0 + (rr >> 2)) * 1024 + (g * 4 + (rr & 3)) * 64 + 8 * c8); }
    }
    float slope[NT]; int hd[NT];
#pragma unroll
    for (int nt = 0; nt < NT; ++nt) { hd[nt] = g * 4 + (SAMPLE ? (fr & 3) : nt); slope[nt] = ex2(-0.5f * (float)(hd[nt] + 1)) * LOG2E; }
    const LAS bf16* qrow = qw + (SAMPLE ? fr : fr * 4) * NSA_QLD; const int qnt = SAMPLE ? 0 : NSA_QLD;
    const float* gates = WSP(float, WS_GATES) + (size_t)row * 48;
    float* oacc = WSP(float, WS_OACC) + (size_t)row * 1024;
    for (int i = lane; i < 16 * 132; i += 64) imp[i] = 0.f;
    LDS_WAIT();
    f32x4 O[NT][4]; float m[NT], l[NT], invl[NT];
    {
        KvBf16 kv{WSP(bf16, SAMPLE ? WS_SKCMP : WS_KCMP) + (size_t)bg * 512 * 64, WSP(bf16, SAMPLE ? WS_SVCMPT : WS_VCMPT) + (size_t)bg * 64 * 512, 512};
        const int cmax = (tmax - 31) >> 4;
        const int ntile = (tmax >= 31) ? ((cmax < 510 ? cmax : 510) / 32 + 1) : 0;
#pragma unroll
        for (int nt = 0; nt < NT; ++nt) invl[nt] = 0.f;
        nsa_zero<NT>(O, m, l);
        { KvFrags fa, fb; if (ntile > 0) nsa_load<false>(kv, 0, fr, fq, fa);
#pragma unroll 1
          for (int tl = 0; tl < ntile; ++tl) { if (tl + 1 < ntile) nsa_load<false>(kv, 32 * (tl + 1), fr, fq, fb);
            nsa_core<NT, 1>(fa, 32 * tl, qrow, qnt, O, m, l, invl, slope, t, 16, 31, 1 << 30, true, imp + trow * 132, fq); fa = fb; } }
#pragma unroll
        for (int nt = 0; nt < NT; ++nt) { float lt = l[nt]; lt = x32_sum(x16_sum(lt)); invl[nt] = lt > 0.f ? 1.f / lt : 0.f; }
        { KvFrags fa, fb; if (ntile > 0) nsa_load<true>(kv, 0, fr, fq, fa);
#pragma unroll 1
          for (int tl = 0; tl < ntile; ++tl) { if (tl + 1 < ntile) nsa_load<true>(kv, 32 * (tl + 1), fr, fq, fb);
            nsa_core<NT, 2>(fa, 32 * tl, qrow, qnt, O, m, l, invl, slope, t, 16, 31, 1 << 30, true, imp + trow * 132, fq); fa = fb; } }
#pragma unroll
        for (int nt = 0; nt < NT; ++nt) { const float gc = gates[0 * 16 + hd[nt]];
#pragma unroll
            for (int dt = 0; dt < 4; ++dt) *(f32x4*)(oacc + hd[nt] * 64 + 16 * dt + 4 * fq) = O[nt][dt] * gc; }
    }
    LDS_WAIT();
    unsigned selm[4] = {0u, 0u, 0u, 0u};
    {
        const int cur = t >> 6;
        if (!SAMPLE) {
            unsigned v[32];
#pragma unroll
            for (int i = 0; i < 32; ++i) { const int j = 32 * fq + i; const bool forced = (j == 0) | (j == cur) | (j == cur - 1);
                const unsigned key = ((f2u(imp[trow * 132 + j]) & ~127u) | (unsigned)(127 - j)) + 128u;
                v[i] = (!forced && j <= cur) ? key : 0u;
                if (forced) selm[fq] |= 1u << i; }
            unsigned fw = selm[0] | selm[1] | selm[2] | selm[3];
            const unsigned w16 = __shfl_xor(fw, 16), w32 = __shfl_xor(fw, 32), w48 = __shfl_xor(fw, 48);
#pragma unroll
            for (int wd = 0; wd < 4; ++wd) selm[wd] = (fq == wd) ? fw : ((fq ^ 1) == wd) ? w16 : ((fq ^ 2) == wd) ? w32 : w48;
            const int nforced = cur >= 2 ? 3 : cur + 1;
#pragma unroll 1
            for (int rd = 0; rd < 15; ++rd) {
                unsigned mx = v[0];
#pragma unroll
                for (int i = 1; i < 32; ++i) mx = mx > v[i] ? mx : v[i];
                mx = x32_umax(x16_umax(mx));
#pragma unroll
                for (int i = 0; i < 32; ++i) v[i] = (v[i] == mx) ? 0u : v[i];
                if (mx != 0u && rd < 16 - nforced) { const int js = 127 - (int)(mx & 127u);
#pragma unroll
                    for (int wd = 0; wd < 4; ++wd) selm[wd] |= ((js >> 5) == wd) ? (1u << (js & 31)) : 0u; }
            }
        } else {
            const int li = (fr & 3) * 4 + fq;
            unsigned v[8];
#pragma unroll
            for (int i = 0; i < 8; ++i) { const int j = li * 8 + i; v[i] = (j >= 1 && j <= 126) ? (((f2u(imp[trow * 132 + j]) & ~127u) | (unsigned)(127 - j)) + 128u) : 0u; }
            selm[0] = 1u; selm[3] = 1u << 31;
#pragma unroll 1
            for (int rd = 0; rd < 13; ++rd) {
                unsigned mx = v[0];
#pragma unroll
                for (int i = 1; i < 8; ++i) mx = mx > v[i] ? mx : v[i];
                { unsigned o = dpp_u<DPP_XOR1>(mx); mx = mx > o ? mx : o; o = dpp_u<DPP_XOR2>(mx); mx = mx > o ? mx : o; mx = x32_umax(x16_umax(mx)); }
#pragma unroll
                for (int i = 0; i < 8; ++i) v[i] = (v[i] == mx) ? 0u : v[i];
                if (mx != 0u) { const int js = 127 - (int)(mx & 127u);
#pragma unroll
                    for (int wd = 0; wd < 4; ++wd) selm[wd] |= ((js >> 5) == wd) ? (1u << (js & 31)) : 0u; }
            }
        }
    }
    if (SAMPLE || !NSA_SUBUNITS) {
        nsa_zero<NT>(O, m, l);
        unsigned un[4];
#pragma unroll
        for (int wd = 0; wd < 4; ++wd) { unsigned x = selm[wd]; x |= __shfl_xor(x, 1); x |= __shfl_xor(x, 2); x |= __shfl_xor(x, 4); x |= __shfl_xor(x, 8); un[wd] = (unsigned)__builtin_amdgcn_readfirstlane((int)x); }
        KvSampleSel kvs{FIN(2) + g * 64, (const int*)FIN(6) + (SAMPLE ? (id >> 2) : 0) * NPAGES, WSP(float, WS_SNEW) + (size_t)(SAMPLE ? (id >> 2) : 0) * 2048 + g * 64, g};
        KvBf16 kvp{WSP(bf16, WS_KSEL) + (size_t)bg * PT * 64, WSP(bf16, WS_VSELT) + (size_t)bg * 64 * PT, PT};
        if (SAMPLE) {
#pragma unroll 1
        for (int wd = 0; wd < 4; ++wd) {
            unsigned mm = un[wd];
            const unsigned mine = wd == 0 ? selm[0] : wd == 1 ? selm[1] : wd == 2 ? selm[2] : selm[3];
            while (mm) {
                const int bit = __builtin_ctz(mm); mm &= mm - 1u; const int j = 32 * wd + bit;
                const bool ok = (mine >> bit) & 1u;
#pragma unroll 1
                for (int hh = 0; hh < 2; ++hh) { nsa_tile<NT, 0>(kvs, 64 * j + 32 * hh, qrow, qnt, O, m, l, invl, slope, t, 1, 0, 1 << 30, ok, imp, fr, fq); __builtin_amdgcn_sched_barrier(0); }
            }
        }
        } else {
            int wdc = 0; unsigned mmc = un[0];
            while (wdc < 3 && mmc == 0u) { ++wdc; mmc = wdc == 1 ? un[1] : wdc == 2 ? un[2] : un[3]; }
            KvFrags fa, fb; int jc = -1, hc = 0;
            if (mmc) { jc = 32 * wdc + __builtin_ctz(mmc); mmc &= mmc - 1u; nsa_load<true>(kvp, 64 * jc, fr, fq, fa); }
#pragma unroll 1
            while (jc >= 0) {
                int jn = jc, hn = hc + 1;
                if (hn == 2) { hn = 0;
                    while (wdc < 3 && mmc == 0u) { ++wdc; mmc = wdc == 1 ? un[1] : wdc == 2 ? un[2] : un[3]; }
                    if (mmc) { jn = 32 * wdc + __builtin_ctz(mmc); mmc &= mmc - 1u; } else jn = -1; }
                if (jn >= 0) nsa_load<true>(kvp, 64 * jn + 32 * hn, fr, fq, fb);
                const int wj = jc >> 5, bj = jc & 31;
                const unsigned mine = wj == 0 ? selm[0] : wj == 1 ? selm[1] : wj == 2 ? selm[2] : selm[3];
                nsa_core<NT, 0>(fa, 64 * jc + 32 * hc, qrow, qnt, O, m, l, invl, slope, t, 1, 0, 1 << 30, (mine >> bj) & 1u, imp, fq);
                fa = fb; jc = jn; hc = hn;
            }
        }
        if (SAMPLE) nsa_tile<NT, 0>(kvs, 64 * 128, qrow, qnt, O, m, l, invl, slope, t, 1, 0, 1 << 30, true, imp, fr, fq);
#pragma unroll
        for (int nt = 0; nt < NT; ++nt) { float lt = l[nt]; lt = x32_sum(x16_sum(lt)); const float sc = gates[1 * 16 + hd[nt]] / fmaxf(lt, 1e-30f);
#pragma unroll
            for (int dt = 0; dt < 4; ++dt) { f32x4* o = (f32x4*)(oacc + hd[nt] * 64 + 16 * dt + 4 * fq); *o = *o + O[nt][dt] * sc; } }
    } else {
        unsigned ms[4][4];
#pragma unroll
        for (int s = 0; s < 4; ++s)
#pragma unroll
            for (int wd = 0; wd < 4; ++wd) ms[s][wd] = __shfl(selm[wd], 4 * s + (fr >> 2));
        unsigned su[4][4], un[4];
#pragma unroll
        for (int wd = 0; wd < 4; ++wd) { un[wd] = 0u;
#pragma unroll
            for (int s = 0; s < 4; ++s) { unsigned x = ms[s][wd]; x |= __shfl_xor(x, 4); x |= __shfl_xor(x, 8); su[s][wd] = (unsigned)__builtin_amdgcn_readfirstlane((int)x); un[wd] |= su[s][wd]; } }
        const int hds = g * 4 + (fr & 3); float slp[1]; slp[0] = ex2(-0.5f * (float)(hds + 1)) * LOG2E;
        const int tb = (id & 511) * 16 + (fr >> 2);
        f32x4 Os[4][1][4]; float mS[4][1], lS[4][1]; float inv1[1] = {0.f};
#pragma unroll
        for (int s = 0; s < 4; ++s) nsa_zero<1>(Os[s], mS[s], lS[s]);
        KvBf16 kvp{WSP(bf16, WS_KSEL) + (size_t)bg * PT * 64, WSP(bf16, WS_VSELT) + (size_t)bg * 64 * PT, PT};
        int wdc = 0; unsigned mmc = un[0];
        while (wdc < 3 && mmc == 0u) { ++wdc; mmc = wdc == 1 ? un[1] : wdc == 2 ? un[2] : un[3]; }
        KvFrags fa, fb;
        int jc = -1, hc = 0;
        if (mmc) { jc = 32 * wdc + __builtin_ctz(mmc); mmc &= mmc - 1u; nsa_load<true>(kvp, 64 * jc, fr, fq, fa); }
#pragma unroll 1
        while (jc >= 0) {
            int jn = jc, hn = hc + 1;
            if (hn == 2) { hn = 0;
                while (wdc < 3 && mmc == 0u) { ++wdc; mmc = wdc == 1 ? un[1] : wdc == 2 ? un[2] : un[3]; }
                if (mmc) { jn = 32 * wdc + __builtin_ctz(mmc); mmc &= mmc - 1u; } else jn = -1; }
            if (jn >= 0) nsa_load<true>(kvp, 64 * jn + 32 * hn, fr, fq, fb);
            const int wj = jc >> 5, bj = jc & 31;
#pragma unroll
            for (int s = 0; s < 4; ++s) {
                const unsigned suw = wj == 0 ? su[s][0] : wj == 1 ? su[s][1] : wj == 2 ? su[s][2] : su[s][3];
                if ((suw >> bj) & 1u) {
                    const unsigned mw = wj == 0 ? ms[s][0] : wj == 1 ? ms[s][1] : wj == 2 ? ms[s][2] : ms[s][3];
                    nsa_core<1, 0>(fa, 64 * jc + 32 * hc, qw + (16 * s + fr) * NSA_QLD, 0, Os[s], mS[s], lS[s], inv1, slp, tb + 4 * s, 1, 0, 1 << 30, (mw >> bj) & 1u, imp, fq);
                }
            }
            fa = fb; jc = jn; hc = hn;
        }
#pragma unroll
        for (int s = 0; s < 4; ++s) { float lt = lS[s][0]; lt = x32_sum(x16_sum(lt));
            const size_t rs = (size_t)(row0 + 4 * s + (fr >> 2));
            const float sc = WSP(float, WS_GATES)[rs * 48 + 16 + hds] / fmaxf(lt, 1e-30f);
#pragma unroll
            for (int dt = 0; dt < 4; ++dt) { f32x4* o = (f32x4*)(WSP(float, WS_OACC) + rs * 1024 + hds * 64 + 16 * dt + 4 * fq); *o = *o + Os[s][0][dt] * sc; } }
    }
    {
        nsa_zero<NT>(O, m, l);
        KvBf16 kv = SAMPLE ? KvBf16{WSP(bf16, WS_SKWIN) + (size_t)bg * 544 * 64, WSP(bf16, WS_SVWINT) + (size_t)bg * 64 * 544, 544}
                           : KvBf16{WSP(bf16, WS_KWIN) + (size_t)bg * PT * 64, WSP(bf16, WS_VWINT) + (size_t)bg * 64 * PT, PT};
        int k0, k1, padd;
        if (SAMPLE) { k0 = 0; k1 = 544; padd = PAST - WINDOW; }
        else { const int lo = tmax - 15 - (WINDOW - 1); k0 = (lo > 0 ? lo : 0) & ~31; k1 = tmax + 1; padd = 0; }
        { KvFrags fa, fb; nsa_load<true>(kv, k0, fr, fq, fa);
#pragma unroll 1
          for (int kk = k0; kk < k1; kk += 32) { if (kk + 32 < k1) nsa_load<true>(kv, kk + 32, fr, fq, fb);
            nsa_core<NT, 0>(fa, kk, qrow, qnt, O, m, l, invl, slope, t, 1, padd, WINDOW, true, imp, fq); fa = fb; } }
        bf16* on = WSP(bf16, WS_OG) + (size_t)row * 1024;
#pragma unroll
        for (int nt = 0; nt < NT; ++nt) { float lt = l[nt]; lt = x32_sum(x16_sum(lt)); const float sc = gates[2 * 16 + hd[nt]] / fmaxf(lt, 1e-30f);
#pragma unroll
            for (int dt = 0; dt < 4; ++dt) { const f32x4 o = *(const f32x4*)(oacc + hd[nt] * 64 + 16 * dt + 4 * fq) + O[nt][dt] * sc;
                *(v2u*)(on + hd[nt] * 64 + 16 * dt + 4 * fq) = (v2u){pk2(o[0], o[1]), pk2(o[2], o[3])}; } }
    }
}

constexpr int NW_STG = 67584;
constexpr int NW_STG_BYTES = 18432;
constexpr int NW_UN = NW_STG + 2 * NW_STG_BYTES;
struct NwStage { v4u k, v; };
__device__ __forceinline__ void nw_load(const bf16* K, const bf16* VT, int ld, int key0, int tid, NwStage& s) {
    s.k = *(const v4u*)(K + (size_t)(key0 + (tid >> 3)) * 64 + 8 * (tid & 7));
    s.v = *(const v4u*)(VT + (size_t)(tid >> 3) * ld + key0 + 8 * (tid & 7));
}
__device__ __forceinline__ void nw_store(LAS unsigned char* buf, int tid, const NwStage& s) {
    const int kk = tid >> 3, c8 = tid & 7, k32 = kk & 31;
    const int rho = 32 * (kk >> 5) + 16 * ((k32 >> 2) & 1) + 4 * (k32 >> 3) + (k32 & 3);
    *(LAS v4u*)(buf + rho * 144 + c8 * 16) = s.k;
    *(LAS v4u*)(buf + 9216 + kk * 144 + c8 * 16) = s.v;
}
template <bool WITHV>
__device__ __forceinline__ void nw_frags(const LAS unsigned char* buf, int th, int fr, int fq, KvFrags& f) {
#pragma unroll
    for (int mt = 0; mt < 2; ++mt)
#pragma unroll
        for (int ks = 0; ks < 2; ++ks) f.k[mt][ks] = *(const LAS bf16x8*)(buf + (32 * th + 16 * mt + fr) * 144 + (32 * ks + 8 * fq) * 2);
    if (WITHV) {
#pragma unroll
        for (int dt = 0; dt < 4; ++dt) f.v[dt] = *(const LAS bf16x8*)(buf + 9216 + (16 * dt + fr) * 144 + (32 * th + 8 * fq) * 2);
    }
}
#define NW_PIPE(Kp, VTp, ldv, NB, BLK, BODY) do { const int nb_ = (NB); \
        if (nb_ > 0) { NwStage st_; nw_load(Kp, VTp, ldv, BLK(0), F.tid, st_); nw_store(stg, F.tid, st_); } \
        __syncthreads(); \
        _Pragma("unroll 1") for (int ib_ = 0; ib_ < nb_; ++ib_) { \
            NwStage st_; const bool more_ = ib_ + 1 < nb_; if (more_) nw_load(Kp, VTp, ldv, BLK(ib_ + 1), F.tid, st_); \
            const LAS unsigned char* buf_ = stg + (ib_ & 1) * NW_STG_BYTES; const int key0_ = BLK(ib_); \
            BODY(buf_, key0_) \
            if (more_) nw_store(stg + ((ib_ + 1) & 1) * NW_STG_BYTES, F.tid, st_); \
            __syncthreads(); } } while (0)

__device__ __forceinline__ void nsa_wg(Frame& F, int bg, int qb) {
    int lane_ = F.lane; asm volatile("" : "+v"(lane_));
    const int lane = lane_, fr = lane & 15, fq = lane >> 4, w = F.wave, g = bg & 3;
    LAS unsigned char* L = F.lds; asm volatile("" : "+v"(L));
    LAS float* imp = (LAS float*)(L + NSA_IMP + w * 8448);
    LAS unsigned char* stg = L + NW_STG;
    LAS unsigned* wun = (LAS unsigned*)(L + NW_UN); volatile LAS unsigned char* blist = (volatile LAS unsigned char*)(L + NW_UN + 16);
    const int tt = qb * 8 + w, t = 16 * tt + fr, row0 = (bg >> 2) * PT + 16 * tt, row = row0 + fr, tw0 = 16 * tt, tw1 = tw0 + 15;
    float slope[4]; bf16x8 qreg[8];
#pragma unroll
    for (int nt = 0; nt < 4; ++nt) { slope[nt] = ex2(-0.5f * (float)(g * 4 + nt + 1)) * LOG2E;
        const bf16* qp = WSP(bf16, WS_QN) + (size_t)row * 1024 + (g * 4 + nt) * 64 + 8 * fq; qreg[2 * nt] = ld8(qp); qreg[2 * nt + 1] = ld8(qp + 32); }
    const float* gates = WSP(float, WS_GATES) + (size_t)row * 48;
    float* oacc = WSP(float, WS_OACC) + (size_t)row * 1024;
    for (int i = lane; i < 16 * 132; i += 64) imp[i] = 0.f;
    if (F.tid < 4) wun[F.tid] = 0u;
    f32x4 O[4][4]; float m[4], l[4], invl[4];
    {
        const bf16* Kc = WSP(bf16, WS_KCMP) + (size_t)bg * 512 * 64; const bf16* Vc = WSP(bf16, WS_VCMPT) + (size_t)bg * 64 * 512;
        const int cmax = (128 * qb + 127 - 31) >> 4, ncb = (cmax < 510 ? cmax : 510) / 64 + 1;
#pragma unroll
        for (int nt = 0; nt < 4; ++nt) invl[nt] = 0.f;
        nsa_zero<4>(O, m, l);
#define NW_BLK(i) (64 * (i))
#define NW_CMP1(buf, k0) { _Pragma("unroll 1") for (int th = 0; th < 2; ++th) if (16 * ((k0) + 32 * th) + 31 <= tw1) { KvFrags f; nw_frags<false>(buf, th, fr, fq, f); \
            nsa_core<4, 1, true>(f, (k0) + 32 * th, nullptr, 0, O, m, l, invl, slope, t, 16, 31, 1 << 30, true, imp + fr * 132, fq, qreg); } }
        NW_PIPE(Kc, Vc, 512, ncb, NW_BLK, NW_CMP1);
#pragma unroll
        for (int nt = 0; nt < 4; ++nt) { const float lt = x32_sum(x16_sum(l[nt])); invl[nt] = lt > 0.f ? 1.f / lt : 0.f; }
#define NW_CMP2(buf, k0) { _Pragma("unroll 1") for (int th = 0; th < 2; ++th) if (16 * ((k0) + 32 * th) + 31 <= tw1) { KvFrags f; nw_frags<true>(buf, th, fr, fq, f); \
            nsa_core<4, 2, true>(f, (k0) + 32 * th, nullptr, 0, O, m, l, invl, slope, t, 16, 31, 1 << 30, true, imp + fr * 132, fq, qreg); } }
        NW_PIPE(Kc, Vc, 512, ncb, NW_BLK, NW_CMP2);
#pragma unroll
        for (int nt = 0; nt < 4; ++nt) { const float gc = gates[0 * 16 + g * 4 + nt];
#pragma unroll
            for (int dt = 0; dt < 4; ++dt) *(f32x4*)(oacc + (g * 4 + nt) * 64 + 16 * dt + 4 * fq) = O[nt][dt] * gc; }
    }
    LDS_WAIT();
    unsigned selm[4] = {0u, 0u, 0u, 0u};
    {
        const int cur = t >> 6;
        unsigned v[32];
#pragma unroll
        for (int i = 0; i < 32; ++i) { const int j = 32 * fq + i; const bool forced = (j == 0) | (j == cur) | (j == cur - 1);
            const unsigned key = ((f2u(imp[fr * 132 + j]) & ~127u) | (unsigned)(127 - j)) + 128u;
            v[i] = (!forced && j <= cur) ? key : 0u;
            if (forced) selm[fq] |= 1u << i; }
        unsigned fw = selm[0] | selm[1] | selm[2] | selm[3];
        const unsigned w16 = __shfl_xor(fw, 16), w32 = __shfl_xor(fw, 32), w48 = __shfl_xor(fw, 48);
#pragma unroll
        for (int wd = 0; wd < 4; ++wd) selm[wd] = (fq == wd) ? fw : ((fq ^ 1) == wd) ? w16 : ((fq ^ 2) == wd) ? w32 : w48;
        const int nforced = cur >= 2 ? 3 : cur + 1;
#pragma unroll 1
        for (int rd = 0; rd < 15; ++rd) {
            unsigned mx = v[0];
#pragma unroll
            for (int i = 1; i < 32; ++i) mx = mx > v[i] ? mx : v[i];
            mx = x32_umax(x16_umax(mx));
#pragma unroll
            for (int i = 0; i < 32; ++i) v[i] = (v[i] == mx) ? 0u : v[i];
            if (mx != 0u && rd < 16 - nforced) { const int js = 127 - (int)(mx & 127u);
#pragma unroll
                for (int wd = 0; wd < 4; ++wd) selm[wd] |= ((js >> 5) == wd) ? (1u << (js & 31)) : 0u; }
        }
    }
    unsigned un[4];
#pragma unroll
    for (int wd = 0; wd < 4; ++wd) { unsigned x = selm[wd]; x |= dpp_u<DPP_XOR1>(x); x |= dpp_u<DPP_XOR2>(x); x |= dpp_u<DPP_HMIR>(x); x |= dpp_u<DPP_MIR>(x); un[wd] = (unsigned)__builtin_amdgcn_readfirstlane((int)x); }
    if (lane < 4) __hip_atomic_fetch_or(wun + lane, lane == 0 ? un[0] : lane == 1 ? un[1] : lane == 2 ? un[2] : un[3], __ATOMIC_RELAXED, __HIP_MEMORY_SCOPE_WORKGROUP);
    __syncthreads();
    unsigned wu[4];
#pragma unroll
    for (int wd = 0; wd < 4; ++wd) wu[wd] = (unsigned)__builtin_amdgcn_readfirstlane((int)wun[wd]);
    {
        nsa_zero<4>(O, m, l);
        const bf16* Ks = WSP(bf16, WS_KSEL) + (size_t)bg * PT * 64; const bf16* Vs = WSP(bf16, WS_VSELT) + (size_t)bg * 64 * PT;
        const int nsb = __builtin_popcount(wu[0]) + __builtin_popcount(wu[1]) + __builtin_popcount(wu[2]) + __builtin_popcount(wu[3]);
        if (F.tid < 128) { const int j = F.tid, wj = j >> 5, bj = j & 31; const unsigned ww = wj == 0 ? wu[0] : wj == 1 ? wu[1] : wj == 2 ? wu[2] : wu[3];
            if ((ww >> bj) & 1u) { int pos = __builtin_popcount(ww & ((1u << bj) - 1u)); if (wj > 0) pos += __builtin_popcount(wu[0]); if (wj > 1) pos += __builtin_popcount(wu[1]); if (wj > 2) pos += __builtin_popcount(wu[2]);
                blist[pos] = (unsigned char)j; } }
        __syncthreads();
#define NW_SBLK(i) (64 * (int)blist[(i)])
#define NW_SEL(buf, k0) { const int j_ = (k0) >> 6, wj_ = j_ >> 5, bj_ = j_ & 31; const unsigned uw_ = wj_ == 0 ? un[0] : wj_ == 1 ? un[1] : wj_ == 2 ? un[2] : un[3]; \
            if ((uw_ >> bj_) & 1u) { const unsigned mine_ = wj_ == 0 ? selm[0] : wj_ == 1 ? selm[1] : wj_ == 2 ? selm[2] : selm[3]; const bool ok_ = (mine_ >> bj_) & 1u; \
                _Pragma("unroll 1") for (int th = 0; th < 2; ++th) { KvFrags f; nw_frags<true>(buf, th, fr, fq, f); \
                    nsa_core<4, 0, true>(f, (k0) + 32 * th, nullptr, 0, O, m, l, invl, slope, t, 1, 0, 1 << 30, ok_, imp, fq, qreg); } } }
        NW_PIPE(Ks, Vs, PT, nsb, NW_SBLK, NW_SEL);
#pragma unroll
        for (int nt = 0; nt < 4; ++nt) { const float lt = x32_sum(x16_sum(l[nt])); const float sc = gates[1 * 16 + g * 4 + nt] / fmaxf(lt, 1e-30f);
#pragma unroll
            for (int dt = 0; dt < 4; ++dt) { f32x4* o = (f32x4*)(oacc + (g * 4 + nt) * 64 + 16 * dt + 4 * fq); *o = *o + O[nt][dt] * sc; } }
    }
    {
        nsa_zero<4>(O, m, l);
        const bf16* Kw = WSP(bf16, WS_KWIN) + (size_t)bg * PT * 64; const bf16* Vw = WSP(bf16, WS_VWINT) + (size_t)bg * 64 * PT;
        const int lo = 128 * qb - (WINDOW - 1), kb0 = (lo > 0 ? lo : 0) >> 6, kb1 = (128 * qb + 127) >> 6, nwb = kb1 - kb0 + 1;
#define NW_WBLK(i) (64 * (kb0 + (i)))
#define NW_WIN(buf, k0) { _Pragma("unroll 1") for (int th = 0; th < 2; ++th) { const int kk_ = (k0) + 32 * th; if (kk_ <= tw1 && kk_ + 31 >= tw0 - (WINDOW - 1)) { KvFrags f; nw_frags<true>(buf, th, fr, fq, f); \
                nsa_core<4, 0, true>(f, kk_, nullptr, 0, O, m, l, invl, slope, t, 1, 0, WINDOW, true, imp, fq, qreg); } } }
        NW_PIPE(Kw, Vw, PT, nwb, NW_WBLK, NW_WIN);
        bf16* on = WSP(bf16, WS_OG) + (size_t)row * 1024;
#pragma unroll
        for (int nt = 0; nt < 4; ++nt) { const float lt = x32_sum(x16_sum(l[nt])); const float sc = gates[2 * 16 + g * 4 + nt] / fmaxf(lt, 1e-30f);
#pragma unroll
            for (int dt = 0; dt < 4; ++dt) { const f32x4 o = *(const f32x4*)(oacc + (g * 4 + nt) * 64 + 16 * dt + 4 * fq) + O[nt][dt] * sc;
                *(v2u*)(on + (g * 4 + nt) * 64 + 16 * dt + 4 * fq) = (v2u){pk2(o[0], o[1]), pk2(o[2], o[3])}; } }
    }
    __syncthreads();
}

constexpr int SW_Q = 0;
constexpr int SW_IMPP = 2304;
constexpr int SW_IMPT = SW_IMPP + 8 * 2112;
constexpr int SW_LP = SW_IMPT + 2112;
constexpr int SW_OP = SW_LP + 3 * 8 * 16 * 4;
static_assert(SW_OP + 8 * 3 * 16 * 64 * 4 <= RING_BYTES, "sample NSA LDS map");
__device__ __forceinline__ void nsa_sample_wg(Frame& F, int id) {
    int lane_ = F.lane; asm volatile("" : "+v"(lane_));
    const int lane = lane_, fr = lane & 15, fq = lane >> 4, w = F.wave, g = id & 3, bs = id >> 2;
    LAS unsigned char* L = F.lds; asm volatile("" : "+v"(L));
    LAS bf16* qw = (LAS bf16*)(L + SW_Q);
    LAS float* impP = (LAS float*)(L + SW_IMPP) + w * 528; LAS float* impT = (LAS float*)(L + SW_IMPT);
    LAS float* LP = (LAS float*)(L + SW_LP); LAS float* OP = (LAS float*)(L + SW_OP);
    const int t = PAST + (fr >> 2), row0 = MP + bs * 4, trow = fr >> 2, hd = g * 4 + (fr & 3);
    if (F.tid < 128) { const int rr = F.tid >> 3, c8 = F.tid & 7;
        *(LAS v4u*)(qw + rr * NSA_QLD + 8 * c8) = *(const v4u*)(WSP(bf16, WS_QN) + (size_t)(row0 + (rr >> 2)) * 1024 + (g * 4 + (rr & 3)) * 64 + 8 * c8); }
    for (int i = lane; i < 528; i += 64) impP[i] = 0.f;
    __syncthreads();
    float slope[1] = {ex2(-0.5f * (float)(hd + 1)) * LOG2E};
    const LAS bf16* qrow = qw + fr * NSA_QLD;
    f32x4 O[1][4]; float m[1], l[1], invl[1] = {0.f};
#define SW_PUT_O(br) { _Pragma("unroll") for (int dt = 0; dt < 4; ++dt) *(LAS f32x4*)(OP + ((w * 3 + (br)) * 16 + fr) * 64 + 16 * dt + 4 * fq) = O[0][dt]; }
#define SW_PUT_L(br) { const float lt_ = x32_sum(x16_sum(l[0])); if (fq == 0) LP[((br) * 8 + w) * 16 + fr] = lt_; }
    {
        KvBf16 kv{WSP(bf16, WS_SKCMP) + (size_t)id * 512 * 64, WSP(bf16, WS_SVCMPT) + (size_t)id * 64 * 512, 512};
        nsa_zero<1>(O, m, l);
#pragma unroll 1
        for (int tl = w; tl < 16; tl += 8) nsa_tile<1, 1>(kv, 32 * tl, qrow, 0, O, m, l, invl, slope, t, 16, 31, 1 << 30, true, impP + trow * 132, fr, fq);
        SW_PUT_L(0)
        __syncthreads();
        { float lt = 0.f;
#pragma unroll
          for (int ww = 0; ww < 8; ++ww) lt += LP[(0 * 8 + ww) * 16 + fr];
          invl[0] = lt > 0.f ? 1.f / lt : 0.f; }
#pragma unroll 1
        for (int tl = w; tl < 16; tl += 8) nsa_tile<1, 2>(kv, 32 * tl, qrow, 0, O, m, l, invl, slope, t, 16, 31, 1 << 30, true, impP + trow * 132, fr, fq);
        SW_PUT_O(0)
    }
    __syncthreads();
    for (int i = F.tid; i < 528; i += 512) { float s = 0.f;
#pragma unroll
        for (int ww = 0; ww < 8; ++ww) s += ((LAS float*)(L + SW_IMPP))[ww * 528 + i];
        impT[i] = s; }
    __syncthreads();
    unsigned selm[4] = {1u, 0u, 0u, 1u << 31};
    {
        const int li = (fr & 3) * 4 + fq;
        unsigned v[8];
#pragma unroll
        for (int i = 0; i < 8; ++i) { const int j = li * 8 + i; v[i] = (j >= 1 && j <= 126) ? (((f2u(impT[trow * 132 + j]) & ~127u) | (unsigned)(127 - j)) + 128u) : 0u; }
#pragma unroll 1
        for (int rd = 0; rd < 13; ++rd) {
            unsigned mx = v[0];
#pragma unroll
            for (int i = 1; i < 8; ++i) mx = mx > v[i] ? mx : v[i];
            { unsigned o = dpp_u<DPP_XOR1>(mx); mx = mx > o ? mx : o; o = dpp_u<DPP_XOR2>(mx); mx = mx > o ? mx : o; mx = x32_umax(x16_umax(mx)); }
#pragma unroll
            for (int i = 0; i < 8; ++i) v[i] = (v[i] == mx) ? 0u : v[i];
            if (mx != 0u) { const int js = 127 - (int)(mx & 127u);
#pragma unroll
                for (int wd = 0; wd < 4; ++wd) selm[wd] |= ((js >> 5) == wd) ? (1u << (js & 31)) : 0u; }
        }
    }
    {
        nsa_zero<1>(O, m, l);
        unsigned un[4];
#pragma unroll
        for (int wd = 0; wd < 4; ++wd) { unsigned x = selm[wd]; x |= dpp_u<DPP_XOR1>(x); x |= dpp_u<DPP_XOR2>(x); x |= dpp_u<DPP_HMIR>(x); x |= dpp_u<DPP_MIR>(x); un[wd] = (unsigned)__builtin_amdgcn_readfirstlane((int)x); }
        KvSampleSel kvs{FIN(2) + g * 64, (const int*)FIN(6) + bs * NPAGES, WSP(float, WS_SNEW) + (size_t)bs * 2048 + g * 64, g};
        int q = 0;
#pragma unroll 1
        for (int wd = 0; wd < 4; ++wd) {
            unsigned mm = un[wd];
            const unsigned mine = wd == 0 ? selm[0] : wd == 1 ? selm[1] : wd == 2 ? selm[2] : selm[3];
            while (mm) {
                const int bit = __builtin_ctz(mm); mm &= mm - 1u; const int j = 32 * wd + bit;
                const bool ok = (mine >> bit) & 1u;
#pragma unroll 1
                for (int hh = 0; hh < 2; ++hh, ++q) if ((q & 7) == w) { nsa_tile<1, 0>(kvs, 64 * j + 32 * hh, qrow, 0, O, m, l, invl, slope, t, 1, 0, 1 << 30, ok, impP, fr, fq); __builtin_amdgcn_sched_barrier(0); }
            }
        }
        if ((q & 7) == w) nsa_tile<1, 0>(kvs, 64 * 128, qrow, 0, O, m, l, invl, slope, t, 1, 0, 1 << 30, true, impP, fr, fq);
        SW_PUT_O(1) SW_PUT_L(1)
    }
    {
        nsa_zero<1>(O, m, l);
        KvBf16 kv{WSP(bf16, WS_SKWIN) + (size_t)id * 544 * 64, WSP(bf16, WS_SVWINT) + (size_t)id * 64 * 544, 544};
#pragma unroll 1
        for (int kk = 32 * w; kk < 544; kk += 256) nsa_tile<1, 0>(kv, kk, qrow, 0, O, m, l, invl, slope, t, 1, PAST - WINDOW, WINDOW, true, impP, fr, fq);
        SW_PUT_O(2) SW_PUT_L(2)
    }
    __syncthreads();
    {
        const int r = F.tid >> 5, d0 = (F.tid & 31) * 2, rowg = row0 + (r >> 2), hdr = g * 4 + (r & 3);
        float o0 = 0.f, o1 = 0.f;
#pragma unroll
        for (int br = 0; br < 3; ++br) { float a0 = 0.f, a1 = 0.f, lt = 0.f;
#pragma unroll
            for (int ww = 0; ww < 8; ++ww) { const f32x2 x = *(const LAS f32x2*)(OP + ((ww * 3 + br) * 16 + r) * 64 + d0); a0 += x.x; a1 += x.y; if (br > 0) lt += LP[(br * 8 + ww) * 16 + r]; }
            const float sc = WSP(float, WS_GATES)[(size_t)rowg * 48 + br * 16 + hdr] * (br == 0 ? 1.f : 1.f / fmaxf(lt, 1e-30f));
            o0 += a0 * sc; o1 += a1 * sc; }
        *(unsigned*)(WSP(bf16, WS_OG) + (size_t)rowg * 1024 + hdr * 64 + d0) = pk2(o0, o1);
    }
    __syncthreads();
#undef SW_PUT_O
#undef SW_PUT_L
}


#ifndef MK_SINGLE
#define MK_SINGLE 1
#endif
constexpr int NPHASE = 21;
struct Args { const float* in[29]; float* out; unsigned char* ws; int ph_lo, ph_hi; };
static_assert(sizeof(Args) == 31 * 8 + 8, "Args has no padding");

__global__ void __launch_bounds__(512, 2) mk_fwd(Args args) {
    extern __shared__ __attribute__((aligned(16))) unsigned char lds_raw[];
    Frame F;
    F.lds = (LAS unsigned char*)lds_raw;
    F.tid = threadIdx.x; F.lane = F.tid & 63; F.wave = __builtin_amdgcn_readfirstlane(F.tid >> 6);
    F.G = gridDim.x; F.bid = blockIdx.x;
    F.ka = (const __attribute__((address_space(4))) char*)__builtin_amdgcn_kernarg_segment_ptr();
    F.out = args.out; F.ws = args.ws;
    volatile LAS unsigned* MISC = (volatile LAS unsigned*)(F.lds + MISC_OFF);
    for (int u = F.tid; u < (LDS_BYTES - LDSCTL_OFF) / 4; u += 512) ((LAS unsigned*)(F.lds + LDSCTL_OFF))[u] = 0u;
    __syncthreads();
    unsigned* barw = (unsigned*)(F.ws + WS_CTL) + 4096;
    XcdBarrier bar; bar.bar = barw; bar.x = 0; bar.st = nullptr;
    const int lo = args.ph_lo, hi = args.ph_hi;
    if (hi - lo > 1) bar = xcd_barrier_post(barw, MISC + 8);
#ifndef PH_MASK
#define PH_MASK 0xFFFFFFFFu
#endif
#define IN(k) (((PH_MASK >> (k)) & 1u) && lo <= (k) && (k) < hi)
#define SEAM(k) do { if (IN(k) && IN((k) + 1)) xcd_barrier(bar); } while (0)
    const int gw = F.bid * 8 + F.wave, NGW = F.G * 8;

#ifndef REPX
#define REPX 0
#endif
#ifndef REPY
#define REPY 0
#endif
#ifndef REP_MASK
#define REP_MASK 0u
#endif
#define PHASE(k, ...) if (IN(k)) { _Pragma("unroll 1") for (int rep_ = 0; rep_ < (int)((REP_MASK >> (k)) & 1u) + 1; ++rep_) { if (rep_) xcd_barrier(bar); __VA_ARGS__ } } SEAM(k);
    PHASE(0, p0_prologue(F);)
    if (IN(1) && F.G != 256) { for (int task = F.bid; task < 512; task += F.G) fs_direct_task(F, task); }
    if (IN(1) && IN(2) && F.G != 256) xcd_barrier(bar);
    PHASE(2, gemm_all(F, WSP(bf16, WS_XNA), WSP(bf16, WS_WIN_T), 4096, FnBf16{WSP(bf16, WS_PROJ), 4096});)
    PHASE(3, for (int u = F.bid; u < 2048 + 256; u += F.G) { if (u < 2048) p2_chunk(F, u); else p2_sample(F, u - 2048); })
    PHASE(4, if (F.G == 256) { const int x = F.bid & 7, idx = F.bid >> 3;
                 if (idx < 8) p3_scan(F, x * 2 + (idx >> 2), idx & 3);
                 else { const int j = (idx - 8) * 8 + x;
                        const size_t n8 = (size_t)2 * NEXP * DM / 8; const int p0 = j < 128 ? 6 * j : 768 + 13 * (j - 128), p1 = p0 + (j < 128 ? 6 : 13);
                        peer_tables_to_fp8(F, (size_t)F.tid, (size_t)512, n8 * p0 / 1600, n8 * p1 / 1600);
                        __syncthreads();
                        for (int task = j; task < 512; task += 192) fs_direct_task(F, task); } }
             else { for (int u = F.bid; u < 64; u += F.G) p3_scan(F, u >> 2, u & 3); })
    PHASE(5, p4_rows(F, gw, NGW);
             for (int id = gw; id < 8192; id += NGW) compress_sample(F, id);)
    PHASE(6, gemm_all(F, WSP(bf16, WS_OG), WSP(bf16, WS_WOA_T), 1024, FnResid{WSP(float, WS_XS), FIN(0), FIN(1)});)
    PHASE(7, rms_rows_phase(F, gw, NGW);)
    PHASE(8, gemm_all(F, WSP(bf16, WS_XNB), WSP(bf16, WS_WPQ_T), 2048, FnBf16{WSP(bf16, WS_QPEER), 2048});)
    PHASE(9, p8_phase(F, 0);)
    int pg_slice = F.bid & 7, pg_first = (F.bid >> 3) * 8 + F.wave, pg_stride = ((F.G - (F.bid & 7) + 7) >> 3) * 8;
#define PEER_GROUPS() do { if (MISC[8 + 3] != 0u && (F.G & 7) == 0) { const unsigned c_ = xb_ld(&barw[XB_XCNT(F.lane & 15)]); const bool ok_ = (F.lane & 15) < 8 ? c_ == (unsigned)(F.G >> 3) : c_ == 0u; \
        if (__builtin_amdgcn_ballot_w64(ok_) == ~0ull && bar.x < 8u) { pg_slice = (int)bar.x; pg_first = (int)MISC[8 + 2] * 8 + F.wave; pg_stride = F.G; } } } while (0)
    PHASE(10, PEER_GROUPS(); p9u_wave(F, 0, pg_slice, pg_first, pg_stride);)
    PHASE(11, PEER_GROUPS(); p9v2_wave(F, 0, pg_slice, pg_first, pg_stride, 0);)
    PHASE(12, gemm_all(F, WSP(bf16, WS_XNA), WSP(bf16, WS_WKVQ_T), NKVQ, FnKvq{WSP(bf16, WS_KVQ), WSP(float, WS_SSQ)});)
    PHASE(13, for (int u = F.bid; u < 256; u += F.G) pp_prompt_tile(F, u);
              if (F.G == 256) { compress_prompt_split(F, F.bid * 2 + (F.wave >> 2)); if (F.bid < MS) pp_sample_row(F, F.bid, F.wave); }
              else { for (int r = gw; r < MS; r += NGW) pp_sample_row(F, r); for (int id = gw; id < 512; id += NGW) compress_prompt(F, id); })
    PHASE(14, if (F.G == 256) {
                  _Pragma("unroll 1") for (int q_ = 0; q_ < 1 + REPX; ++q_) { if (F.bid < 128) nsa_sample_wg(F, F.bid); }
                  __syncthreads();
                  { const int i_ = F.bid >> 3;
                    if (i_ < 16) { nsa_wg(F, F.bid & 7, i_); nsa_wg(F, F.bid & 7, 31 - i_); } else { nsa_wg(F, F.bid & 7, 16 + i_); nsa_wg(F, F.bid & 7, 79 - i_); } }
              } else { for (int id = gw; id < 128 + 4096; id += NGW) { if (id < 128) nsa_unit<true>(F, id); else nsa_unit<false>(F, id - 128); } })
    PHASE(15, gemm_all(F, WSP(bf16, WS_OG), WSP(bf16, WS_WOB_T), 1024, FnResid{WSP(float, WS_XS), WSP(float, WS_XS), WSP(float, WS_XS) + (size_t)MP * DM});)
    PHASE(16, rms_rows_phase(F, gw, NGW);)
    PHASE(17, gemm_all(F, WSP(bf16, WS_XNB), WSP(bf16, WS_WPQ_T) + (size_t)2048 * 1024, 2048, FnBf16{WSP(bf16, WS_QPEER), 2048});)
    PHASE(18, p8_phase(F, 1);)
    PHASE(19, PEER_GROUPS(); p9u_wave(F, 1, pg_slice, pg_first, pg_stride);)
    PHASE(20, PEER_GROUPS(); p9v2_wave(F, 1, pg_slice, pg_first, pg_stride, 1);)
#undef IN
#undef SEAM
}

extern "C" void kernel_launch(void* const* d_in, const int* in_sizes, int n_in, void* d_out, int out_size, void* d_ws, size_t ws_size, hipStream_t stream) {
    static int grid = 0;
    if (grid == 0) {
        if (n_in != 29 || (size_t)out_size != O_END || ws_size < WS_END) { fprintf(stderr, "kernel_launch: unexpected shapes n_in %d out %d ws %zu (need %zu)\n", n_in, out_size, ws_size, (size_t)WS_END); grid = -1; return; }
        int dev = 0, cus = 0, per_cu = 0;
        if (hipGetDevice(&dev) != hipSuccess || hipDeviceGetAttribute(&cus, hipDeviceAttributeMultiprocessorCount, dev) != hipSuccess) { grid = -1; return; }
        if (hipFuncSetAttribute((const void*)mk_fwd, hipFuncAttributeMaxDynamicSharedMemorySize, LDS_BYTES) != hipSuccess) { fprintf(stderr, "kernel_launch: hipFuncSetAttribute failed\n"); grid = -1; return; }
        if (hipOccupancyMaxActiveBlocksPerMultiprocessor(&per_cu, (const void*)mk_fwd, 512, LDS_BYTES) != hipSuccess || per_cu < 1) fprintf(stderr, "kernel_launch: occupancy query reports %d\n", per_cu);
        (void)hipGetLastError();
        grid = cus;
    }
    if (grid < 0) return;
    if (hipMemsetAsync((char*)d_ws + WS_CTL, 0, CTL_BYTES, stream) != hipSuccess) return;
    Args a{};
    for (int i = 0; i < 29; ++i) a.in[i] = (const float*)d_in[i];
    a.out = (float*)d_out; a.ws = (unsigned char*)d_ws;
#if MK_SINGLE
    a.ph_lo = 0; a.ph_hi = NPHASE;
    hipLaunchKernelGGL(mk_fwd, dim3(grid), dim3(512), LDS_BYTES, stream, a);
#else
    for (int p = 0; p < NPHASE; ++p) { a.ph_lo = p; a.ph_hi = p + 1; hipLaunchKernelGGL(mk_fwd, dim3(grid), dim3(512), LDS_BYTES, stream, a); }
#endif
    const hipError_t le = hipPeekAtLastError();
    if (le != hipSuccess) fprintf(stderr, "kernel_launch: launch failed: %s\n", hipGetErrorName(le));
}
```

```cpp
#include <hip/hip_runtime.h>
#include <cstdio>
#include <cstdint>

constexpr int DM = 1024, PB = 2, PT = 8192, SB = 32, SL = 4, PAST = 8192, PAGE = 128;
constexpr int MP = PB * PT;
constexpr int MS = SB * SL;
constexpr int MTOK = MP + MS;
constexpr int GH = 8, GDK = 128, GDV = 128, GCONV = 3072, GPROJ = 4112, CHUNK = 64, NCH = PT / CHUNK;
constexpr int NH = 16, NG = 4, HPG = 4, DH = 64, NQG = 1072, NKV = 1536, NKVQ = 2816, NKVQ_REAL = 2608;
constexpr int WINDOW = 512, NSELP = 128, NSELS = 129, NCMP = 511;
constexpr int PEH = 8, PEDQ = 256, PEHALF = 128, NKEYS = 128, NEXP = 16384, PETOP = 16;
constexpr int NPAGES = PAST / PAGE;
constexpr float EPS = 1e-6f;

constexpr size_t O_YP = 0;
constexpr size_t O_YS = O_YP + (size_t)MP * DM;
constexpr size_t O_KVP = O_YS + (size_t)MS * DM;
constexpr size_t O_WINP = O_KVP + (size_t)MP * 1024;
constexpr size_t O_GDNP = O_WINP + (size_t)PB * 512 * 512;
constexpr size_t O_CONVP = O_GDNP + (size_t)PB * GH * 128 * 128;
constexpr size_t O_KVS = O_CONVP + (size_t)PB * 3 * GCONV;
constexpr size_t O_WINS = O_KVS + (size_t)MS * 1024;
constexpr size_t O_GDNS = O_WINS + (size_t)SB * 512 * 512;
constexpr size_t O_CONVS = O_GDNS + (size_t)SB * GH * 128 * 128;
constexpr size_t O_END = O_CONVS + (size_t)SB * 3 * GCONV;

constexpr size_t MiB = 1u << 20;
constexpr size_t al(size_t x) { return (x + 4095) & ~(size_t)4095; }
constexpr size_t WS_CTL = 0, CTL_BYTES = 1 * MiB;
constexpr size_t WS_WIN_T = WS_CTL + CTL_BYTES;
constexpr size_t WS_WOA_T = WS_WIN_T + (size_t)4096 * 1024 * 2;
constexpr size_t WS_WKVQ_T = WS_WOA_T + (size_t)1024 * 1024 * 2;
constexpr size_t WS_WOB_T = WS_WKVQ_T + (size_t)NKVQ * 1024 * 2;
constexpr size_t WS_WPQ_T = WS_WOB_T + (size_t)1024 * 1024 * 2;
constexpr size_t WS_WAB = WS_WPQ_T + (size_t)2 * 2048 * 1024 * 2;
constexpr size_t WS_SUBK = WS_WAB + (size_t)16 * 1024 * 4;
constexpr size_t WS_W1T = WS_SUBK + (size_t)2 * 8 * 2 * 128 * 128 * 2;
constexpr size_t WS_PETERM = WS_W1T + (size_t)2 * 128 * 1024 * 2;
constexpr size_t WS_PU = al(WS_PETERM + 512);
constexpr size_t WS_PV = WS_PU + (size_t)2 * NEXP * DM * 2;
constexpr size_t WS_XNA = WS_PV + (size_t)2 * NEXP * DM * 2;
constexpr size_t WS_XNB = al(WS_XNA + (size_t)MTOK * DM * 2);
constexpr size_t WS_PROJ = al(WS_XNB + (size_t)MTOK * DM * 2);
constexpr size_t WS_GW = al(WS_PROJ + (size_t)MTOK * 4096 * 2);
constexpr size_t WS_GQ = WS_GW + (size_t)2048 * 64 * 128 * 2;
constexpr size_t WS_GKT = WS_GQ + (size_t)2048 * 64 * 128 * 2;
constexpr size_t WS_GQK = WS_GKT + (size_t)2048 * 64 * 128 * 2;
constexpr size_t WS_GU = WS_GQK + (size_t)2048 * 64 * 64 * 2;
constexpr size_t WS_GDEC = WS_GU + (size_t)2048 * 64 * 128 * 4;
constexpr size_t WS_OGDN = al(WS_GDEC + 2048 * 4);
constexpr size_t WS_OG = al(WS_OGDN + (size_t)MTOK * DM * 4);
constexpr size_t WS_XS = al(WS_OG + (size_t)MTOK * DM * 2);
constexpr size_t WS_QPEER = al(WS_XS + (size_t)MTOK * DM * 4);
constexpr size_t WS_PEI = al(WS_QPEER + (size_t)MTOK * 2048 * 2);
constexpr size_t WS_PEG = al(WS_PEI + (size_t)MTOK * 128 * 4);
constexpr size_t WS_KVQ = al(WS_PEG + (size_t)MTOK * 128 * 4);
constexpr size_t WS_KSEL = al(WS_KVQ + (size_t)MTOK * NKVQ * 4);
constexpr size_t WS_VSELT = WS_KSEL + (size_t)PB * NG * PT * 64 * 2;
constexpr size_t WS_KWIN = WS_VSELT + (size_t)PB * NG * PT * 64 * 2;
constexpr size_t WS_VWINT = WS_KWIN + (size_t)PB * NG * PT * 64 * 2;
constexpr size_t WS_KCMP = WS_VWINT + (size_t)PB * NG * PT * 64 * 2;
constexpr size_t WS_VCMPT = WS_KCMP + (size_t)PB * NG * 512 * 64 * 2;
constexpr size_t WS_SKCMP = WS_VCMPT + (size_t)PB * NG * 512 * 64 * 2;
constexpr size_t WS_SVCMPT = WS_SKCMP + (size_t)SB * NG * 512 * 64 * 2;
constexpr size_t WS_SKWIN = WS_SVCMPT + (size_t)SB * NG * 512 * 64 * 2;
constexpr size_t WS_SVWINT = WS_SKWIN + (size_t)SB * NG * 544 * 64 * 2;
constexpr size_t WS_SNEW = WS_SVWINT + (size_t)SB * NG * 544 * 64 * 2;
constexpr size_t WS_QN = al(WS_SNEW + (size_t)SB * 4 * 2 * 4 * 64 * 4);
constexpr size_t WS_GATES = al(WS_QN + (size_t)MTOK * 1024 * 2);
constexpr size_t WS_OACC = al(WS_GATES + (size_t)MTOK * 48 * 4);
constexpr size_t WS_CKA = al(WS_OACC + (size_t)MTOK * DM * 4);
constexpr size_t WS_W1BD = al(WS_CKA + (size_t)65536 * 2048 * 2);
constexpr size_t WS_FS = al(WS_W1BD + (size_t)256 * 2048 * 2);
constexpr size_t WS_PA = al(WS_FS + (size_t)65536 * 256 * 4);
constexpr size_t WS_SSQ = al(WS_PA + (size_t)MTOK * 8 * 64 * 4);
constexpr size_t WS_W2F = al(WS_SSQ + (size_t)MTOK * 8 * 4);
constexpr size_t WS_XN8 = al(WS_W2F + 2 * 4 * 2 * 64 * 8 * 2);
constexpr size_t WS_HS = al(WS_XN8 + (size_t)MTOK * DM);
constexpr size_t WS_END = al(WS_HS + (size_t)MTOK * 4);

constexpr int RING_BYTES = 143360;
constexpr int LDSCTL_OFF = RING_BYTES, MISC_OFF = LDSCTL_OFF + 320;
constexpr int LDS_BYTES = 147456;

#define GAS __attribute__((address_space(1)))
#define LAS __attribute__((address_space(3)))
typedef unsigned short bf16;
typedef unsigned v4u __attribute__((ext_vector_type(4)));
typedef unsigned v2u __attribute__((ext_vector_type(2)));
typedef float f32x4 __attribute__((ext_vector_type(4)));
typedef float f32x2 __attribute__((ext_vector_type(2)));
typedef short bf16x8 __attribute__((ext_vector_type(8)));
typedef GAS unsigned gu32;
#define RLX_AGENT __ATOMIC_RELAXED, __HIP_MEMORY_SCOPE_AGENT
#define LDS_WAIT() asm volatile("s_waitcnt lgkmcnt(0)" ::: "memory")
#define VM_WAIT() asm volatile("s_waitcnt vmcnt(0)" ::: "memory")

__device__ __forceinline__ unsigned f2bf(float f) { unsigned u = __builtin_bit_cast(unsigned, f); return (u + 0x7fffu + ((u >> 16) & 1u)) >> 16; }
typedef __bf16 hwbf16x2 __attribute__((ext_vector_type(2)));
__device__ __forceinline__ unsigned pk2(float lo, float hi) { const f32x2 v = {lo, hi}; return __builtin_bit_cast(unsigned, __builtin_convertvector(v, hwbf16x2)); }
__device__ __forceinline__ float bf2f(unsigned b) { return __builtin_bit_cast(float, b << 16); }
__device__ __forceinline__ float bflo(unsigned w) { return __builtin_bit_cast(float, w << 16); }
__device__ __forceinline__ float bfhi(unsigned w) { return __builtin_bit_cast(float, w & 0xffff0000u); }
#ifndef USE_PERMSWAP
#define USE_PERMSWAP 1
#endif
template <int CTRL> __device__ __forceinline__ float dpp_f(float x) { return __builtin_bit_cast(float, __builtin_amdgcn_update_dpp(0, __builtin_bit_cast(int, x), CTRL, 0xF, 0xF, true)); }
template <int CTRL> __device__ __forceinline__ unsigned dpp_u(unsigned x) { return (unsigned)__builtin_amdgcn_update_dpp(0, (int)x, CTRL, 0xF, 0xF, true); }
#define DPP_XOR1 0xB1
#define DPP_XOR2 0x4E
#define DPP_HMIR 0x141
#define DPP_MIR 0x140
#define DPP_ROR4 0x124
#define DPP_ROR8 0x128
#if USE_PERMSWAP
#define PSWAP16(a, b) asm volatile("s_nop 1\n\tv_permlane16_swap_b32 %0, %1" : "+v"(a), "+v"(b))
#define PSWAP32(a, b) asm volatile("s_nop 1\n\tv_permlane32_swap_b32 %0, %1" : "+v"(a), "+v"(b))
__device__ __forceinline__ float x16_sum(float x) { unsigned a = __builtin_bit_cast(unsigned, x), b = a; PSWAP16(a, b); return __builtin_bit_cast(float, a) + __builtin_bit_cast(float, b); }
__device__ __forceinline__ float x32_sum(float x) { unsigned a = __builtin_bit_cast(unsigned, x), b = a; PSWAP32(a, b); return __builtin_bit_cast(float, a) + __builtin_bit_cast(float, b); }
__device__ __forceinline__ float x16_max(float x) { unsigned a = __builtin_bit_cast(unsigned, x), b = a; PSWAP16(a, b); return fmaxf(__builtin_bit_cast(float, a), __builtin_bit_cast(float, b)); }
__device__ __forceinline__ float x32_max(float x) { unsigned a = __builtin_bit_cast(unsigned, x), b = a; PSWAP32(a, b); return fmaxf(__builtin_bit_cast(float, a), __builtin_bit_cast(float, b)); }
__device__ __forceinline__ unsigned x16_umax(unsigned u) { unsigned a = u, b = u; PSWAP16(a, b); return a > b ? a : b; }
__device__ __forceinline__ unsigned x32_umax(unsigned u) { unsigned a = u, b = u; PSWAP32(a, b); return a > b ? a : b; }
#else
__device__ __forceinline__ float x16_sum(float x) { return x + __shfl_xor(x, 16); }
__device__ __forceinline__ float x32_sum(float x) { return x + __shfl_xor(x, 32); }
__device__ __forceinline__ float x16_max(float x) { return fmaxf(x, __shfl_xor(x, 16)); }
__device__ __forceinline__ float x32_max(float x) { return fmaxf(x, __shfl_xor(x, 32)); }
__device__ __forceinline__ unsigned x16_umax(unsigned u) { const unsigned o = __shfl_xor(u, 16); return u > o ? u : o; }
__device__ __forceinline__ unsigned x32_umax(unsigned u) { const unsigned o = __shfl_xor(u, 32); return u > o ? u : o; }
#endif
__device__ __forceinline__ float row_sum16(float x) { x += dpp_f<DPP_XOR1>(x); x += dpp_f<DPP_XOR2>(x); x += dpp_f<DPP_HMIR>(x); x += dpp_f<DPP_MIR>(x); return x; }
__device__ __forceinline__ float wave_sum(float v) { return x32_sum(x16_sum(row_sum16(v))); }
__device__ __forceinline__ float frcp(float x) { return __builtin_amdgcn_rcpf(x); }
__device__ __forceinline__ float frsq(float x) { return __builtin_amdgcn_rsqf(x); }
__device__ __forceinline__ unsigned pk_i8(f32x4 v) {
    const int q0 = (int)__builtin_rintf(fminf(fmaxf(v.x, -127.f), 127.f)), q1 = (int)__builtin_rintf(fminf(fmaxf(v.y, -127.f), 127.f));
    const int q2 = (int)__builtin_rintf(fminf(fmaxf(v.z, -127.f), 127.f)), q3 = (int)__builtin_rintf(fminf(fmaxf(v.w, -127.f), 127.f));
    return (unsigned)(q0 & 255) | ((unsigned)(q1 & 255) << 8) | ((unsigned)(q2 & 255) << 16) | ((unsigned)q3 << 24);
}
__device__ __forceinline__ float silu_f(float x) { return x * frcp(1.f + __expf(-x)); }
__device__ __forceinline__ float sigmoid_f(float x) { return frcp(1.f + __expf(-x)); }
__device__ __forceinline__ float gelu_tanh(float x) {
    const float u = 0.7978845608028654f * (x + 0.044715f * x * x * x);
    const float e = __expf(2.f * u);
    const float th = 1.f - 2.f * frcp(e + 1.f);
    return 0.5f * x * (1.f + th);
}
__device__ __forceinline__ bf16x8 ld8(const bf16* p) { return *(const bf16x8*)p; }
__device__ __forceinline__ bf16x8 ld8l(const LAS bf16* p) { return *(const LAS bf16x8*)p; }
#define MFMA16(a, b, c) __builtin_amdgcn_mfma_f32_16x16x32_bf16((a), (b), (c), 0, 0, 0)
__device__ __forceinline__ bf16x8 cvt8(f32x4 a, f32x4 b) {
    v4u r; r.x = pk2(a.x, a.y); r.y = pk2(a.z, a.w); r.z = pk2(b.x, b.y); r.w = pk2(b.z, b.w); return __builtin_bit_cast(bf16x8, r);
}

struct Frame {
    LAS unsigned char* lds;
    int tid, lane, wave, G, bid;
    const __attribute__((address_space(4))) char* ka;
    float* out;
    unsigned char* ws;
};
#define WSP(T, off) ((T*)(F.ws + (off)))
__device__ __forceinline__ const float* fin_(const __attribute__((address_space(4))) char* ka, int i) {
    const __attribute__((address_space(4))) char* p = ka; asm volatile("" : "+s"(p));
    return *(const float* const __attribute__((address_space(4)))*)(p + 8 * i);
}
#define FIN(i) fin_(F.ka, (i))
namespace pg8 {
#define PG8_LAS __attribute__((address_space(3)))
typedef unsigned short bf16_t;
typedef short bf16x8 __attribute__((ext_vector_type(8)));
typedef float f32x4 __attribute__((ext_vector_type(4)));
typedef unsigned u32x4 __attribute__((ext_vector_type(4)));
constexpr int BM = 256, BK = 64, HALF = 128, HTB = HALF * BK * 2  , STAGE_BYTES = 8 * HTB, NXCD = 8, WGM = 8;

__host__ __device__ __forceinline__ int lds_byte(int r, int c) { const int st = (r >> 4) * 2 + (c >> 5), rr = r & 15, cc = c & 31, ob = rr * 64 + cc * 2; return st * 1024 + (ob ^ (((ob >> 9) & 1) << 5)); }
__host__ __device__ __forceinline__ void stage_rc(int b, int& R, int& C) { const int st = b / 1024, sb = b % 1024, swz = sb ^ (((sb >> 9) & 1) << 5); R = (st >> 1) * 16 + swz / 64; C = (st & 1) * 32 + (swz % 64) / 2; }
__host__ __device__ __forceinline__ int perm32(int rho) { const int n = rho >> 4, i = rho & 15; return 8 * (i >> 2) + 4 * n + (i & 3); }

struct Unit { int pm, pn; };
struct Gemm { const bf16_t* A; const bf16_t* Bt; int M, N, K; };

struct StaticOrder {
    int nM, nN, nwg, G, c;
    __host__ __device__ void init(int M, int N, int G_, int c_) { nM = M / BM; nN = N / BM; nwg = nM * nN; G = G_; c = c_; }
    __host__ __device__ bool next(int i, Unit& u) const {
        const long L = (long)i * G + c; if (L >= nwg) return false;
        int wgid = (int)L; { const int q = nwg / NXCD, r = nwg % NXCD, xcd = wgid % NXCD, off = wgid / NXCD; wgid = (xcd < r ? xcd * (q + 1) : r * (q + 1) + (xcd - r) * q) + off; }
        const int nig = WGM * nN, gid = wgid / nig, fm = gid * WGM, gsz = (nM - fm) < WGM ? (nM - fm) : WGM;
        u.pm = fm + ((wgid % nig) % gsz); u.pn = (wgid % nig) / gsz; return true;
    }
    __device__ __forceinline__ void a_ready(const Unit&) const {}
    __device__ __forceinline__ void done(const Unit&) const {}
};
template <class Epi, class Sched, bool ALIGN_EPI = false, bool SP2 = false>
__device__ __forceinline__ void gemm_phase(PG8_LAS unsigned char* lds, const Gemm g, const Sched& S, const Epi& E) {
    const int tid = threadIdx.x, wid = __builtin_amdgcn_readfirstlane(tid >> 6), lane = tid & 63, wr = wid >> 2, wc = wid & 3, fr = lane & 15, fq = lane >> 4;
    const int K = g.K, nt = K / BK;
    unsigned voffA[2], voffB[2];
#pragma unroll
    for (int i = 0; i < 2; ++i) { int R, C; stage_rc(tid * 16 + i * 8192, R, C); const int Rb = Epi::PERM ? ((R & ~31) + perm32(R & 31)) : R;
        voffA[i] = (unsigned)(R * K + C) * 2u; voffB[i] = (unsigned)(Rb * K + C) * 2u; }
    const size_t kstep = (size_t)(BK * 2);
    const size_t hstep = (size_t)HALF * K * 2;
    const size_t tstep = 2 * hstep;
    const unsigned ldsw = (unsigned)wid * 1024u;
    const int aoff = lds_byte(wr * 64 + fr, fq * 8), boff = lds_byte(wc * 32 + fr, fq * 8);
#define PG8_SA(b, h) (((b) * 2 + (h)) * HTB)
#define PG8_SB(b, h) ((4 + (b) * 2 + (h)) * HTB)
#define PG8_STAGE(bufoff, gbase, voff) do { _Pragma("unroll") for (int _i = 0; _i < 2; ++_i) \
        __builtin_amdgcn_global_load_lds((const unsigned*)((const char*)(gbase) + (voff)[_i]), (PG8_LAS unsigned*)(lds + (bufoff) + ldsw + _i * 8192), 16, 0, 0); } while (0)
#define PG8_LDA(dst, b, h) do { _Pragma("unroll") for (int m = 0; m < 4; ++m) _Pragma("unroll") for (int k = 0; k < 2; ++k) dst[m][k] = *(const PG8_LAS bf16x8*)(lds + PG8_SA(b, h) + aoff + m * 2048 + k * 1024); } while (0)
#define PG8_LDB(dst, b, h) do { _Pragma("unroll") for (int n = 0; n < 2; ++n) _Pragma("unroll") for (int k = 0; k < 2; ++k) dst[n][k] = *(const PG8_LAS bf16x8*)(lds + PG8_SB(b, h) + boff + n * 2048 + k * 1024); } while (0)
#define PG8_MMA(ai, bj, At, Bt) do { __builtin_amdgcn_s_setprio(1); _Pragma("unroll") for (int m = 0; m < 4; ++m) _Pragma("unroll") for (int n = 0; n < 2; ++n) _Pragma("unroll") for (int k = 0; k < 2; ++k) \
        acc[ai][bj][m][n] = __builtin_amdgcn_mfma_f32_16x16x32_bf16(Bt[n][k], At[m][k], acc[ai][bj][m][n], 0, 0, 0); __builtin_amdgcn_s_setprio(0); } while (0)
#define PG8_WAIT_V(n) asm volatile("s_waitcnt vmcnt(" #n ")" ::: "memory")
#define PG8_WAIT_L(n) asm volatile("s_waitcnt lgkmcnt(" #n ")" ::: "memory")
#define PG8_BAR __builtin_amdgcn_s_barrier()
#define PG8_SCHED __builtin_amdgcn_sched_barrier(0)
    Unit cur, nxt; int ui = 0;
    if (!S.next(0, cur)) return;
    f32x4 acc[2][2][4][2];
#pragma unroll
    for (int a = 0; a < 2; ++a)
#pragma unroll
        for (int b = 0; b < 2; ++b)
#pragma unroll
            for (int m = 0; m < 4; ++m)
#pragma unroll
                for (int n = 0; n < 2; ++n) acc[a][b][m][n] = (f32x4){0.f, 0.f, 0.f, 0.f};
    bf16x8 At[4][2], B0[2][2], B1[2][2];
    const char* cA = (const char*)g.A + (size_t)cur.pm * tstep; const char* cB = (const char*)g.Bt + (size_t)cur.pn * tstep;
    S.a_ready(cur);
    if constexpr (SP2) {
        PG8_STAGE(PG8_SB(0, 0), cB, voffB); PG8_STAGE(PG8_SB(0, 1), cB + hstep, voffB); PG8_STAGE(PG8_SA(0, 0), cA, voffA); PG8_STAGE(PG8_SA(0, 1), cA + hstep, voffA);
        if (wr == 1) PG8_BAR;
        PG8_WAIT_V(2); PG8_BAR;
        PG8_STAGE(PG8_SB(1, 0), cB + kstep, voffB); PG8_STAGE(PG8_SA(1, 0), cA + kstep, voffA); PG8_STAGE(PG8_SB(1, 1), cB + hstep + kstep, voffB);
        PG8_WAIT_V(6); PG8_BAR;
    } else {
        PG8_STAGE(PG8_SB(0, 0), cB, voffB); PG8_STAGE(PG8_SA(0, 0), cA, voffA); PG8_STAGE(PG8_SB(0, 1), cB + hstep, voffB); PG8_STAGE(PG8_SA(0, 1), cA + hstep, voffA);
        if (wr == 1) PG8_BAR;
        PG8_WAIT_V(4); PG8_BAR;
        PG8_STAGE(PG8_SB(1, 0), cB + kstep, voffB); PG8_STAGE(PG8_SA(1, 0), cA + kstep, voffA); PG8_STAGE(PG8_SB(1, 1), cB + hstep + kstep, voffB);
        PG8_WAIT_V(6); PG8_BAR;
    }
    for (;;) {
        const bool has_next = S.next(ui + 1, nxt);
        const char* nA = has_next ? (const char*)g.A + (size_t)nxt.pm * tstep : cA; const char* nB = has_next ? (const char*)g.Bt + (size_t)nxt.pn * tstep : cB;
        for (int t = 0; t < nt; t += 2) {
            const bool last = (t == nt - 2);
            const char* a1 = cA + (size_t)(t + 1) * kstep;
            const char* a2 = last ? nA : cA + (size_t)(t + 2) * kstep; const char* b2 = last ? nB : cB + (size_t)(t + 2) * kstep;
            const char* a3 = a2 + kstep; const char* b3 = b2 + kstep;
            if (last && has_next) S.a_ready(nxt);
            if constexpr (SP2) {
            PG8_LDB(B0, 0, 0); PG8_LDB(B1, 0, 1); PG8_SCHED; PG8_LDA(At, 0, 0); PG8_STAGE(PG8_SA(1, 1), a1 + hstep, voffA);
            PG8_WAIT_V(8); PG8_WAIT_L(0); PG8_BAR; PG8_MMA(0, 0, At, B0); PG8_MMA(0, 1, At, B1); PG8_BAR; PG8_SCHED;
            PG8_LDA(At, 0, 1); PG8_STAGE(PG8_SB(0, 0), b2, voffB); PG8_STAGE(PG8_SB(0, 1), b2 + hstep, voffB); PG8_STAGE(PG8_SA(0, 0), a2, voffA);
            PG8_WAIT_V(8); PG8_WAIT_L(0); PG8_BAR; PG8_MMA(1, 0, At, B0); PG8_MMA(1, 1, At, B1); PG8_BAR; PG8_SCHED;
            PG8_LDB(B0, 1, 0); PG8_LDB(B1, 1, 1); PG8_SCHED; PG8_LDA(At, 1, 0); PG8_STAGE(PG8_SA(0, 1), a2 + hstep, voffA);
            PG8_WAIT_V(8); PG8_WAIT_L(0); PG8_BAR; PG8_MMA(0, 0, At, B0); PG8_MMA(0, 1, At, B1); PG8_BAR; PG8_SCHED;
            PG8_LDA(At, 1, 1); PG8_STAGE(PG8_SB(1, 0), b3, voffB); PG8_STAGE(PG8_SB(1, 1), b3 + hstep, voffB); PG8_STAGE(PG8_SA(1, 0), a3, voffA);
            PG8_WAIT_V(8); PG8_WAIT_L(0); PG8_BAR; PG8_MMA(1, 0, At, B0); PG8_MMA(1, 1, At, B1); PG8_BAR; PG8_SCHED;
            } else {
            PG8_LDB(B0, 0, 0); PG8_SCHED; PG8_LDA(At, 0, 0); PG8_STAGE(PG8_SA(1, 1), a1 + hstep, voffA);
            PG8_WAIT_L(8); PG8_BAR; PG8_WAIT_L(0); PG8_MMA(0, 0, At, B0); PG8_BAR; PG8_SCHED;
            PG8_LDB(B1, 0, 1); PG8_STAGE(PG8_SB(0, 0), b2, voffB);
            PG8_BAR; PG8_WAIT_L(0); PG8_MMA(0, 1, At, B1); PG8_BAR;
            PG8_LDA(At, 0, 1); PG8_STAGE(PG8_SA(0, 0), a2, voffA);
            PG8_BAR; PG8_WAIT_L(0); PG8_MMA(1, 0, At, B0); PG8_BAR; PG8_SCHED;
            PG8_STAGE(PG8_SB(0, 1), b2 + hstep, voffB);
            PG8_WAIT_V(6); PG8_BAR; PG8_MMA(1, 1, At, B1); PG8_BAR;
            PG8_LDB(B0, 1, 0); PG8_SCHED; PG8_LDA(At, 1, 0); PG8_STAGE(PG8_SA(0, 1), a2 + hstep, voffA);
            PG8_WAIT_L(8); PG8_BAR; PG8_WAIT_L(0); PG8_MMA(0, 0, At, B0); PG8_BAR; PG8_SCHED;
            PG8_LDB(B1, 1, 1); PG8_STAGE(PG8_SB(1, 0), b3, voffB);
            PG8_BAR; PG8_WAIT_L(0); PG8_MMA(0, 1, At, B1); PG8_BAR;
            PG8_LDA(At, 1, 1); PG8_STAGE(PG8_SA(1, 0), a3, voffA);
            PG8_BAR; PG8_WAIT_L(0); PG8_MMA(1, 0, At, B0); PG8_BAR; PG8_SCHED;
            PG8_STAGE(PG8_SB(1, 1), b3 + hstep, voffB);
            PG8_WAIT_V(6); PG8_BAR; PG8_MMA(1, 1, At, B1); PG8_BAR;
            }
        }
        if constexpr (ALIGN_EPI) { if (wr == 0) PG8_BAR; }
        if constexpr (!Epi::AFTER_DRAIN) { E(acc, cur, wr, wc, fr, fq); S.done(cur); }
        if (!has_next) break;
#pragma unroll
        for (int a = 0; a < 2; ++a)
#pragma unroll
            for (int b = 0; b < 2; ++b)
#pragma unroll
                for (int m = 0; m < 4; ++m)
#pragma unroll
                    for (int n = 0; n < 2; ++n) acc[a][b][m][n] = (f32x4){0.f, 0.f, 0.f, 0.f};
        cur = nxt; cA = nA; cB = nB; ++ui;
        if constexpr (ALIGN_EPI) { if (wr == 1) PG8_BAR; }
    }
    PG8_WAIT_V(0);
    if constexpr (!ALIGN_EPI) { if (wr == 0) PG8_BAR; }
    PG8_BAR;
    if constexpr (Epi::AFTER_DRAIN) { E.fused(acc, cur, wr, wc, fr, fq, lds, wid, lane); S.done(cur); }
#undef PG8_SA
#undef PG8_SB
#undef PG8_STAGE
#undef PG8_LDA
#undef PG8_LDB
#undef PG8_MMA
#undef PG8_WAIT_V
#undef PG8_WAIT_L
#undef PG8_BAR
#undef PG8_SCHED
}
}
#define XB_TMO      128
#define XB_XCNT(j)  (256  + 64 * (j))
#define XB_XSUB(j)  (1280 + 64 * (j))
#define XB_XGEN(j)  (2304 + 64 * (j))
#define XB_TOP      3328
#define XB_TOPGEN   3392
#define XCD_BAR_WORDS 3456
#define XB_SPIN_CAP (1u << 18)

__device__ __forceinline__ unsigned xb_ld(unsigned* p)              { return __hip_atomic_load(p, __ATOMIC_RELAXED, __HIP_MEMORY_SCOPE_AGENT); }
__device__ __forceinline__ unsigned xb_add(unsigned* p, unsigned v) { return __hip_atomic_fetch_add(p, v, __ATOMIC_RELAXED, __HIP_MEMORY_SCOPE_AGENT); }
__device__ __forceinline__ unsigned xb_xcc_id() { return (unsigned)__builtin_amdgcn_s_getreg((3 << 11) | 20) & 0xFu; }
#define XB_SPIN(cond, bar) do { unsigned _sp = 0; while (cond) { __builtin_amdgcn_s_sleep(1); \
    if ((++_sp & 255u) == 0u) { if (xb_ld(&(bar)[XB_TMO])) break; if (_sp > XB_SPIN_CAP) { atomicAdd(&(bar)[XB_TMO], 1u); break; } } } } while (0)

struct XcdBarrier {
    unsigned* bar; unsigned x;
    volatile LAS unsigned* st;
};

__device__ __forceinline__ XcdBarrier xcd_barrier_post(unsigned* bar, volatile LAS unsigned* st) {
    XcdBarrier b; b.bar = bar; b.x = xb_xcc_id(); b.st = st;
    if (threadIdx.x == 0) { st[2] = xb_add(&bar[XB_XCNT(b.x)], 1u); st[3] = 1u; }
    return b;
}
__device__ __forceinline__ void xcd_barrier_complete(unsigned* bar, unsigned x, unsigned& nloc, unsigned& nx) {
    const unsigned G = gridDim.x * gridDim.y * gridDim.z;
    unsigned sum, cnt, mine, sp = 0u;
    for (;;) {
        sum = 0u; cnt = 0u; mine = 0u;
#pragma unroll
        for (unsigned j = 0; j < 16; ++j) { const unsigned c = xb_ld(&bar[XB_XCNT(j)]); sum += c; cnt += (c > 0u) ? 1u : 0u; mine = (j == x) ? c : mine; }
        if (sum == G) break;
        __builtin_amdgcn_s_sleep(1);
        if ((++sp & 255u) == 0u) { if (xb_ld(&bar[XB_TMO])) break; if (sp > XB_SPIN_CAP) { atomicAdd(&bar[XB_TMO], 1u); break; } }
    }
    nloc = mine > 0u ? mine : 1u; nx = cnt > 0u ? cnt : 1u;
}

__device__ __forceinline__ void xcd_barrier(const XcdBarrier& b) {
    asm volatile("s_waitcnt vmcnt(0)" ::: "memory");
    __syncthreads();
    if (threadIdx.x == 0) {
        unsigned* bar = b.bar;
        __builtin_amdgcn_s_waitcnt(0);
        unsigned nloc = b.st[0], nx = b.st[1];
        if (nloc == 0u) { xcd_barrier_complete(bar, b.x, nloc, nx); b.st[0] = nloc; b.st[1] = nx; }
        const unsigned old = xb_add(&bar[XB_XSUB(b.x)], 1u);
        const unsigned gen = old / nloc;
        if (old + 1u == (gen + 1u) * nloc) {
            __builtin_amdgcn_fence(__ATOMIC_RELEASE, "agent");
            asm volatile("s_waitcnt vmcnt(0)" ::: "memory");
            const unsigned og = xb_add(&bar[XB_TOP], 1u);
            const unsigned tg = og / nx;
            if (og + 1u == (tg + 1u) * nx) xb_add(&bar[XB_TOPGEN], 1u);
            else XB_SPIN(xb_ld(&bar[XB_TOPGEN]) == tg, bar);
            __builtin_amdgcn_fence(__ATOMIC_ACQUIRE, "agent");
            xb_add(&bar[XB_XGEN(b.x)], 1u);
            asm volatile("s_waitcnt vmcnt(0)" ::: "memory");
        } else {
            XB_SPIN(xb_ld(&bar[XB_XGEN(b.x)]) == gen, bar);
            __builtin_amdgcn_fence(__ATOMIC_ACQUIRE, "agent");
            asm volatile("s_waitcnt vmcnt(0)" ::: "memory");
        }
    }
    __syncthreads();
}

namespace pg8 {
template <class Fn> struct EpiFn {
    static constexpr bool PERM = true, AFTER_DRAIN = false;
    Fn f;
    __device__ __forceinline__ void operator()(const f32x4 (&acc)[2][2][4][2], const Unit& u, int wr, int wc, int fr, int fq) const {
        const int row0 = u.pm * BM + wr * 64 + fr, col0 = u.pn * BM + wc * 32 + 8 * fq;
#pragma unroll
        for (int ai = 0; ai < 2; ++ai)
#pragma unroll
            for (int m = 0; m < 4; ++m)
#pragma unroll
                for (int bj = 0; bj < 2; ++bj) f.e8(row0 + ai * HALF + m * 16, col0 + bj * HALF, acc[ai][bj][m][0], acc[ai][bj][m][1]);
    }
};
}

struct FnBf16 {
    bf16* O; int ld;
    __device__ __forceinline__ void e8(int row, int col, f32x4 a, f32x4 b) const {
        v4u w; w.x = pk2(a.x, a.y); w.y = pk2(a.z, a.w); w.z = pk2(b.x, b.y); w.w = pk2(b.z, b.w);
        *(v4u*)(O + (size_t)row * ld + col) = w;
    }
    __device__ __forceinline__ void e4(int row, int col, f32x4 a) const {
        v2u w; w.x = pk2(a.x, a.y); w.y = pk2(a.z, a.w);
        *(v2u*)(O + (size_t)row * ld + col) = w;
    }
};
struct FnResid {
    float* XS; const float* baseP; const float* baseS;
    __device__ __forceinline__ const float* brow(int row) const { return row < MP ? baseP + (size_t)row * DM : baseS + (size_t)(row - MP) * DM; }
    __device__ __forceinline__ void e8(int row, int col, f32x4 a, f32x4 b) const {
        const float* br = brow(row) + col; float* o = XS + (size_t)row * DM + col;
        const f32x4 x0 = *(const f32x4*)br, x1 = *(const f32x4*)(br + 4);
        *(f32x4*)o = x0 + a; *(f32x4*)(o + 4) = x1 + b;
    }
    __device__ __forceinline__ void e4(int row, int col, f32x4 a) const {
        const float* br = brow(row) + col; float* o = XS + (size_t)row * DM + col;
        *(f32x4*)o = *(const f32x4*)br + a;
    }
};
struct FnF32 {
    float* O; int ld;
    __device__ __forceinline__ void e8(int row, int col, f32x4 a, f32x4 b) const { float* o = O + (size_t)row * ld + col; *(f32x4*)o = a; *(f32x4*)(o + 4) = b; }
    __device__ __forceinline__ void e4(int row, int col, f32x4 a) const { *(f32x4*)(O + (size_t)row * ld + col) = a; }
};
struct FnKvq {
    bf16* O; const float* ssq;
    __device__ __forceinline__ float rstd(int row) const { const f32x4 s0 = *(const f32x4*)(ssq + (size_t)row * 8), s1 = *(const f32x4*)(ssq + (size_t)row * 8 + 4);
        return frsq((((s0.x + s0.y) + (s0.z + s0.w)) + ((s1.x + s1.y) + (s1.z + s1.w))) * (1.f / DM) + EPS); }
    __device__ __forceinline__ void e8(int row, int col, f32x4 a, f32x4 b) const {
        if (col < NKVQ_REAL) { const float rs = rstd(row); a = a * rs; b = b * rs; *(v4u*)(O + (size_t)row * NKVQ + col) = (v4u){pk2(a.x, a.y), pk2(a.z, a.w), pk2(b.x, b.y), pk2(b.z, b.w)}; }
    }
    __device__ __forceinline__ void e4(int row, int col, f32x4 a) const {
        if (col < NKVQ_REAL) { a = a * rstd(row); *(v2u*)(O + (size_t)row * NKVQ + col) = (v2u){pk2(a.x, a.y), pk2(a.z, a.w)}; }
    }
};

template <class Fn>
__device__ __forceinline__ void skinny_gemm(Frame& F, const bf16* A, const bf16* Bt, int N, int row_base, const Fn& fn) {
    const int fr = F.lane & 15, fq = F.lane >> 4;
    const int nun = N / 16;
    for (int u = F.bid; u < nun; u += F.G) {
        const bf16* ap = Bt + (size_t)(u * 16 + fr) * DM + fq * 8;
        const bf16* bp = A + (size_t)(F.wave * 16 + fr) * DM + fq * 8;
        f32x4 acc = {0.f, 0.f, 0.f, 0.f};
#pragma unroll 8
        for (int ks = 0; ks < 32; ++ks) acc = MFMA16(ld8(ap + ks * 32), ld8(bp + ks * 32), acc);
        fn.e4(row_base + F.wave * 16 + fr, u * 16 + 4 * fq, acc);
    }
}

template <class Fn>
__device__ __forceinline__ void gemm_all(Frame& F, const bf16* A, const bf16* Bt, int N, const Fn& fn) {
    pg8::Gemm g{A, Bt, MP, N, DM}; pg8::StaticOrder S; S.init(MP, N, F.G, F.bid);
    pg8::EpiFn<Fn> E{fn};
    pg8::gemm_phase<pg8::EpiFn<Fn>, pg8::StaticOrder, true, true>(F.lds, g, S, E);
    skinny_gemm(F, A + (size_t)MP * DM, Bt, N, MP, fn);
}

__device__ __forceinline__ void p0_transpose_item(const float* W, int N, bf16* WT, int row_off, const float* gain, LAS float* scr, int item, int lane) {
    const int nblk = (N + 31) / 32, kb = item / nblk, nb = item % nblk, k0 = 64 * kb, n0 = 32 * nb;
    const int n_ = n0 + (lane & 31); const bool inb = n_ < N; const float* wp = W + (size_t)(k0 + (lane >> 5)) * N + (inb ? n_ : N - 1); const float* gp = gain ? gain + k0 + (lane >> 5) : W;
#pragma unroll 8
    for (int i = 0; i < 32; ++i) { float v = wp[(size_t)(2 * i) * N]; if (gain) v *= gp[2 * i];
        scr[(2 * i + (lane >> 5)) * 33 + (lane & 31)] = inb ? v : 0.f; }
    LDS_WAIT(); asm volatile("" ::: "memory");
    const int c = lane & 7;
#pragma unroll
    for (int j = 0; j < 4; ++j) { const int n = (lane >> 3) + 8 * j; const LAS float* s = scr + (8 * c) * 33 + n;
        v4u o; o.x = pk2(s[0 * 33], s[1 * 33]); o.y = pk2(s[2 * 33], s[3 * 33]); o.z = pk2(s[4 * 33], s[5 * 33]); o.w = pk2(s[6 * 33], s[7 * 33]);
        if (n0 + n < N) *(v4u*)(WT + (size_t)(row_off + n0 + n) * DM + k0 + 8 * c) = o; }
    LDS_WAIT(); asm volatile("" ::: "memory");
}
__device__ __forceinline__ void rms_row_to_bf16(const float* xrow, bf16* orow, int lane) {
    const f32x4* xr = (const f32x4*)xrow + lane;
    f32x4 v[4]; float s = 0.f;
#pragma unroll
    for (int j = 0; j < 4; ++j) { v[j] = xr[64 * j]; s += (v[j].x * v[j].x + v[j].y * v[j].y) + (v[j].z * v[j].z + v[j].w * v[j].w); }
    const float rstd = frsq(wave_sum(s) * (1.f / DM) + EPS);
    v2u* o8 = (v2u*)orow + lane;
#pragma unroll
    for (int j = 0; j < 4; ++j) { v2u w; w.x = pk2(v[j].x * rstd, v[j].y * rstd); w.y = pk2(v[j].z * rstd, v[j].w * rstd); o8[64 * j] = w; }
}
__device__ __forceinline__ void rms_fin_bf16(const f32x4 v0, const f32x4 v1, const f32x4 v2, const f32x4 v3, bf16* orow, int lane) {
    const f32x4 v[4] = {v0, v1, v2, v3}; float s = 0.f;
#pragma unroll
    for (int j = 0; j < 4; ++j) s += (v[j].x * v[j].x + v[j].y * v[j].y) + (v[j].z * v[j].z + v[j].w * v[j].w);
    const float rstd = frsq(wave_sum(s) * (1.f / DM) + EPS);
    v2u* o8 = (v2u*)orow + lane;
#pragma unroll
    for (int j = 0; j < 4; ++j) { v2u w; w.x = pk2(v[j].x * rstd, v[j].y * rstd); w.y = pk2(v[j].z * rstd, v[j].w * rstd); o8[64 * j] = w; }
}
__device__ __forceinline__ void rms_row_to_bf16_i8(const float* xrow, bf16* orow, unsigned* o8row, float* hs, int lane) {
    const f32x4* xr = (const f32x4*)xrow + lane;
    f32x4 v[4]; float s = 0.f, mx = 0.f;
#pragma unroll
    for (int j = 0; j < 4; ++j) { v[j] = xr[64 * j]; s += (v[j].x * v[j].x + v[j].y * v[j].y) + (v[j].z * v[j].z + v[j].w * v[j].w);
        mx = fmaxf(mx, fmaxf(fmaxf(fabsf(v[j].x), fabsf(v[j].y)), fmaxf(fabsf(v[j].z), fabsf(v[j].w)))); }
    const float rstd = frsq(wave_sum(s) * (1.f / DM) + EPS);
    mx = fmaxf(mx, dpp_f<DPP_XOR1>(mx)); mx = fmaxf(mx, dpp_f<DPP_XOR2>(mx)); mx = fmaxf(mx, dpp_f<DPP_HMIR>(mx)); mx = fmaxf(mx, dpp_f<DPP_MIR>(mx)); mx = x32_max(x16_max(mx));
    const float hmax = fmaxf(mx * rstd, 1e-20f), qs = 127.f * frcp(hmax);
    if (lane == 0) *hs = hmax * (1.f / 127.f);
    v2u* o16 = (v2u*)orow + lane;
#pragma unroll
    for (int j = 0; j < 4; ++j) { const f32x4 y = v[j] * rstd; v2u w; w.x = pk2(y.x, y.y); w.y = pk2(y.z, y.w); o16[64 * j] = w; o8row[lane + 64 * j] = pk_i8(y * qs); }
}
__device__ __forceinline__ void rms_fin_bf16_i8(const f32x4 v0, const f32x4 v1, const f32x4 v2, const f32x4 v3, bf16* orow, unsigned* o8row, float* hs, int lane) {
    const f32x4 v[4] = {v0, v1, v2, v3}; float s = 0.f, mx = 0.f;
#pragma unroll
    for (int j = 0; j < 4; ++j) { s += (v[j].x * v[j].x + v[j].y * v[j].y) + (v[j].z * v[j].z + v[j].w * v[j].w);
        mx = fmaxf(mx, fmaxf(fmaxf(fabsf(v[j].x), fabsf(v[j].y)), fmaxf(fabsf(v[j].z), fabsf(v[j].w)))); }
    const float rstd = frsq(wave_sum(s) * (1.f / DM) + EPS);
    mx = fmaxf(mx, dpp_f<DPP_XOR1>(mx)); mx = fmaxf(mx, dpp_f<DPP_XOR2>(mx)); mx = fmaxf(mx, dpp_f<DPP_HMIR>(mx)); mx = fmaxf(mx, dpp_f<DPP_MIR>(mx)); mx = x32_max(x16_max(mx));
    const float hmax = fmaxf(mx * rstd, 1e-20f), qs = 127.f * frcp(hmax);
    if (lane == 0) *hs = hmax * (1.f / 127.f);
    v2u* o16 = (v2u*)orow + lane;
#pragma unroll
    for (int j = 0; j < 4; ++j) { const f32x4 y = v[j] * rstd; v2u w; w.x = pk2(y.x, y.y); w.y = pk2(y.z, y.w); o16[64 * j] = w; o8row[lane + 64 * j] = pk_i8(y * qs); }
}
__device__ __forceinline__ void rms_rows_phase(Frame& F, int gw, int ngw) {
    int r = gw;
    for (; r + 3 * ngw < MTOK; r += 4 * ngw) {
        const f32x4* xa = (const f32x4*)(WSP(float, WS_XS) + (size_t)r * DM) + F.lane; const f32x4* xb = xa + (size_t)ngw * (DM / 4); const f32x4* xc = xb + (size_t)ngw * (DM / 4); const f32x4* xd = xc + (size_t)ngw * (DM / 4);
        const f32x4 a0 = xa[0], a1 = xa[64], a2 = xa[128], a3 = xa[192], b0 = xb[0], b1 = xb[64], b2 = xb[128], b3 = xb[192];
        const f32x4 c0 = xc[0], c1 = xc[64], c2 = xc[128], c3 = xc[192], d0 = xd[0], d1 = xd[64], d2 = xd[128], d3 = xd[192];
        const bool five = r + 4 * ngw < MTOK && r + 7 * ngw >= MTOK;
        f32x4 e0 = a0, e1 = a1, e2 = a2, e3 = a3; if (five) { const f32x4* xe = xd + (size_t)ngw * (DM / 4); e0 = xe[0]; e1 = xe[64]; e2 = xe[128]; e3 = xe[192]; }
        rms_fin_bf16_i8(a0, a1, a2, a3, WSP(bf16, WS_XNB) + (size_t)r * DM, WSP(unsigned, WS_XN8) + (size_t)r * (DM / 4), WSP(float, WS_HS) + r, F.lane);
        rms_fin_bf16_i8(b0, b1, b2, b3, WSP(bf16, WS_XNB) + (size_t)(r + ngw) * DM, WSP(unsigned, WS_XN8) + (size_t)(r + ngw) * (DM / 4), WSP(float, WS_HS) + r + ngw, F.lane);
        rms_fin_bf16_i8(c0, c1, c2, c3, WSP(bf16, WS_XNB) + (size_t)(r + 2 * ngw) * DM, WSP(unsigned, WS_XN8) + (size_t)(r + 2 * ngw) * (DM / 4), WSP(float, WS_HS) + r + 2 * ngw, F.lane);
        rms_fin_bf16_i8(d0, d1, d2, d3, WSP(bf16, WS_XNB) + (size_t)(r + 3 * ngw) * DM, WSP(unsigned, WS_XN8) + (size_t)(r + 3 * ngw) * (DM / 4), WSP(float, WS_HS) + r + 3 * ngw, F.lane);
        if (five) { rms_fin_bf16_i8(e0, e1, e2, e3, WSP(bf16, WS_XNB) + (size_t)(r + 4 * ngw) * DM, WSP(unsigned, WS_XN8) + (size_t)(r + 4 * ngw) * (DM / 4), WSP(float, WS_HS) + r + 4 * ngw, F.lane); r += ngw; }
    }
    for (; r + ngw < MTOK; r += 2 * ngw) {
        const f32x4* xa = (const f32x4*)(WSP(float, WS_XS) + (size_t)r * DM) + F.lane; const f32x4* xb = (const f32x4*)(WSP(float, WS_XS) + (size_t)(r + ngw) * DM) + F.lane;
        const f32x4 a0 = xa[0], a1 = xa[64], a2 = xa[128], a3 = xa[192], b0 = xb[0], b1 = xb[64], b2 = xb[128], b3 = xb[192];
        rms_fin_bf16_i8(a0, a1, a2, a3, WSP(bf16, WS_XNB) + (size_t)r * DM, WSP(unsigned, WS_XN8) + (size_t)r * (DM / 4), WSP(float, WS_HS) + r, F.lane);
        rms_fin_bf16_i8(b0, b1, b2, b3, WSP(bf16, WS_XNB) + (size_t)(r + ngw) * DM, WSP(unsigned, WS_XN8) + (size_t)(r + ngw) * (DM / 4), WSP(float, WS_HS) + r + ngw, F.lane);
    }
    if (r < MTOK) rms_row_to_bf16_i8(WSP(float, WS_XS) + (size_t)r * DM, WSP(bf16, WS_XNB) + (size_t)r * DM, WSP(unsigned, WS_XN8) + (size_t)r * (DM / 4), WSP(float, WS_HS) + r, F.lane);
}
__device__ __forceinline__ const float* xin_row(Frame& F, int row) { return row < MP ? FIN(0) + (size_t)row * DM : FIN(1) + (size_t)(row - MP) * DM; }

__device__ __forceinline__ void peer_tables_to_fp8(Frame& F, size_t thr, size_t nthr, size_t lo = 0, size_t hi = (size_t)2 * NEXP * DM / 8) {
    const size_t gt = thr, NGT = nthr;
        for (int t = 0; t < 2; ++t) { const f32x4* src = (const f32x4*)FIN(27 + t); v2u* dst = (v2u*)WSP(unsigned char, t == 0 ? WS_PU : WS_PV); const float* pln = FIN(24);
            for (size_t i0 = lo + gt; i0 < hi; i0 += (size_t)4 * NGT) {
                f32x4 a[4], b[4];
#pragma unroll
                for (int u = 0; u < 4; ++u) { const size_t i = i0 + (size_t)u * NGT; if (i < hi) { a[u] = src[2 * i]; b[u] = src[2 * i + 1]; } }
#pragma unroll
                for (int u = 0; u < 4; ++u) { const size_t i = i0 + (size_t)u * NGT; if (i < hi) {
                    if (t == 0) { const float* gp = pln + ((i >> 21) << 10) + ((i & 127) << 3); a[u] = a[u] * *(const f32x4*)gp * 32.f; b[u] = b[u] * *(const f32x4*)(gp + 4) * 32.f; }
                    else { a[u] = a[u] * 16.f; b[u] = b[u] * 16.f; }
                    int w0, w1;
                    if (t == 0) { w0 = (int)pk_i8(a[u] * 19.f); w1 = (int)pk_i8(b[u] * 19.f); }
                    else { w0 = __builtin_amdgcn_cvt_pk_fp8_f32(a[u].x, a[u].y, 0, false); w0 = __builtin_amdgcn_cvt_pk_fp8_f32(a[u].z, a[u].w, w0, true);
                           w1 = __builtin_amdgcn_cvt_pk_fp8_f32(b[u].x, b[u].y, 0, false); w1 = __builtin_amdgcn_cvt_pk_fp8_f32(b[u].z, b[u].w, w1, true); }
                    dst[((((i >> 21) * 8 + ((i & 127) >> 4)) * (size_t)NEXP + ((i >> 7) & (NEXP - 1))) << 4) + (i & 15)] = (v2u){(unsigned)w0, (unsigned)w1}; } } } }
}

constexpr int FD_BUF = 16384;
__device__ __forceinline__ void fs_direct_task(Frame& F, int task) {
    int lane_ = F.lane; asm volatile("" : "+v"(lane_));
    const int lane = lane_, w = F.wave, fr = lane & 15, fq = lane >> 4, kv = w >> 2, g = w & 3, bs = task >> 4, c0 = (task & 15) * 32;
    LAS unsigned char* L = F.lds; asm volatile("" : "+v"(L));
    const float* cache = FIN(2); const int* pt = (const int*)FIN(6) + bs * NPAGES;
    const float* base[2];
#pragma unroll
    for (int nt = 0; nt < 2; ++nt) { const int t0 = 16 * (c0 + 16 * nt + fr); base[nt] = cache + ((size_t)pt[t0 >> 7] * PAGE + (t0 & 127)) * 1024 + kv * 256 + g * 64 + 8 * fq; }
    const bf16* wsrc[2]; int wdst[2];
#pragma unroll
    for (int q = 0; q < 2; ++q) { const int item = F.tid + 512 * q, kvw = item >> 9, n = (item >> 2) & 127, kq = item & 3;
        wsrc[q] = WSP(bf16, WS_W1BD) + (size_t)(kvw * 128 + n) * 2048 + kvw * 1024 + 8 * kq; wdst[q] = ((kvw * 8 + (n >> 4)) * 64 + kq * 16 + (n & 15)) * 16; }
    f32x4 acc[2][8];
#pragma unroll
    for (int nt = 0; nt < 2; ++nt)
#pragma unroll
        for (int mt = 0; mt < 8; ++mt) acc[nt][mt] = (f32x4){0.f, 0.f, 0.f, 0.f};
    f32x4 S0[2][4], S1[2][4]; v4u wr[2];
#define FD_DATA(S, r) do { const int r_ = (r) < 16 ? (r) : 15; _Pragma("unroll") for (int nt_ = 0; nt_ < 2; ++nt_) { const float* p_ = base[nt_] + r_ * 1024; \
        S[nt_][0] = *(const f32x4*)p_; S[nt_][1] = *(const f32x4*)(p_ + 4); S[nt_][2] = *(const f32x4*)(p_ + 32); S[nt_][3] = *(const f32x4*)(p_ + 36); } } while (0)
#define FD_WLOAD(ks) do { const int ks_ = (ks) < 32 ? (ks) : 31; wr[0] = *(const v4u*)(wsrc[0] + 32 * ks_); wr[1] = *(const v4u*)(wsrc[1] + 32 * ks_); } while (0)
#define FD_WSTORE(buf) do { *(LAS v4u*)(L + (buf) * FD_BUF + wdst[0]) = wr[0]; *(LAS v4u*)(L + (buf) * FD_BUF + wdst[1]) = wr[1]; } while (0)
#define FD_KSTEP(bq, ks, buf) do { \
        _Pragma("unroll") for (int mt_ = 0; mt_ < 8; ++mt_) { const bf16x8 a_ = *(const LAS bf16x8*)(L + (buf) * FD_BUF + ((kv * 8 + mt_) * 64 + lane) * 16); \
            acc[0][mt_] = MFMA16(a_, bq[0], acc[0][mt_]); acc[1][mt_] = MFMA16(a_, bq[1], acc[1][mt_]); } \
        FD_WSTORE((buf) ^ 1); FD_WLOAD((ks) + 2); \
        __syncthreads(); } while (0)
#define FD_ROW(S, r) do { bf16x8 b0_[2], b1_[2]; _Pragma("unroll") for (int nt_ = 0; nt_ < 2; ++nt_) { b0_[nt_] = cvt8(S[nt_][0], S[nt_][1]); b1_[nt_] = cvt8(S[nt_][2], S[nt_][3]); } \
        FD_DATA(S, (r) + 2); \
        FD_KSTEP(b0_, 2 * (r), 0); FD_KSTEP(b1_, 2 * (r) + 1, 1); } while (0)
    FD_WLOAD(0); FD_WSTORE(0); FD_WLOAD(1); FD_DATA(S0, 0); FD_DATA(S1, 1);
    __syncthreads();
#pragma unroll 1
    for (int r = 0; r < 16; r += 2) { FD_ROW(S0, r); FD_ROW(S1, r + 1); }
#undef FD_KSTEP
#undef FD_ROW
#undef FD_DATA
#undef FD_WLOAD
#undef FD_WSTORE
    bf16* fs = WSP(bf16, WS_FS) + ((size_t)(bs * 4 + g) * 512 + c0 + fr) * 256 + kv * 128 + 4 * fq;
#pragma unroll
    for (int nt = 0; nt < 2; ++nt)
#pragma unroll
        for (int mt = 0; mt < 8; ++mt) *(v2u*)(fs + (size_t)nt * 16 * 256 + 16 * mt) = (v2u){pk2(acc[nt][mt][0], acc[nt][mt][1]), pk2(acc[nt][mt][2], acc[nt][mt][3])};
    __syncthreads();
}

__device__ __forceinline__ void p0_prologue(Frame& F) {
    LAS float* scr = (LAS float*)(F.lds + F.wave * 16384);
    const int gw = F.bid * 8 + F.wave, NGW = F.G * 8;
    const int gt = F.bid * 512 + F.tid, NGT = F.G * 512;
    {
        constexpr int I_IN = 128 * 16, I_OA = 32 * 16, I_KV = 48 * 16, I_QG = 34 * 16, I_OB = 32 * 16, I_PQ = 64 * 16;
        constexpr int NITEMS = I_IN + I_OA + I_KV + I_QG + I_OB + 2 * I_PQ;
        for (int it = gw; it < NITEMS; it += NGW) {
            int r = it;
            if (r < I_IN) {
                const int kb = r / 128, nb = r % 128, k0 = 64 * kb, n0 = 32 * nb; const float* W = FIN(8); const float* gain = FIN(7);
#pragma unroll 8
                for (int i = 0; i < 32; ++i) { const int kk = 2 * i + (F.lane >> 5); scr[kk * 33 + (F.lane & 31)] = W[(size_t)(k0 + kk) * GPROJ + n0 + (F.lane & 31)] * gain[k0 + kk]; }
                LDS_WAIT(); asm volatile("" ::: "memory");
                const int c = F.lane & 7;
#pragma unroll
                for (int j = 0; j < 4; ++j) { const int n = (F.lane >> 3) + 8 * j; const LAS float* s = scr + (8 * c) * 33 + n;
                    v4u o; o.x = pk2(s[0 * 33], s[1 * 33]); o.y = pk2(s[2 * 33], s[3 * 33]); o.z = pk2(s[4 * 33], s[5 * 33]); o.w = pk2(s[6 * 33], s[7 * 33]);
                    *(v4u*)(WSP(bf16, WS_WIN_T) + (size_t)(n0 + n) * DM + k0 + 8 * c) = o; }
                LDS_WAIT(); asm volatile("" ::: "memory");
                continue; }
            r -= I_IN;
            if (r < I_OA) { p0_transpose_item(FIN(13), 1024, WSP(bf16, WS_WOA_T), 0, nullptr, scr, r, F.lane); continue; } r -= I_OA;
            if (r < I_KV) { p0_transpose_item(FIN(15), NKV, WSP(bf16, WS_WKVQ_T), 0, FIN(14), scr, r, F.lane); continue; } r -= I_KV;
            if (r < I_QG) { p0_transpose_item(FIN(21), NQG, WSP(bf16, WS_WKVQ_T), NKV, FIN(20), scr, r, F.lane); continue; } r -= I_QG;
            if (r < I_OB) { p0_transpose_item(FIN(23), 1024, WSP(bf16, WS_WOB_T), 0, nullptr, scr, r, F.lane); continue; } r -= I_OB;
            if (r < I_PQ) { p0_transpose_item(FIN(25), 2048, WSP(bf16, WS_WPQ_T), 0, FIN(24), scr, r, F.lane); continue; } r -= I_PQ;
            p0_transpose_item(FIN(25) + (size_t)1024 * 2048, 2048, WSP(bf16, WS_WPQ_T) + (size_t)2048 * 1024, 0, FIN(24) + 1024, scr, r, F.lane);
        }
        for (int i = gt; i < (NKVQ - NKVQ_REAL) * DM / 8; i += NGT) ((v4u*)(WSP(bf16, WS_WKVQ_T) + (size_t)NKVQ_REAL * DM))[i] = (v4u){0u, 0u, 0u, 0u};
        for (int i = gt; i < 16 * 1024; i += NGT) { const int j = i >> 10, k = i & 1023; WSP(float, WS_WAB)[i] = FIN(7)[k] * FIN(8)[(size_t)k * GPROJ + 4096 + j]; }
    }
    { int m = gw;
      for (; m + 3 * NGW < MTOK; m += 4 * NGW) {
          const f32x4* xa = (const f32x4*)xin_row(F, m) + F.lane; const f32x4* xb = (const f32x4*)xin_row(F, m + NGW) + F.lane; const f32x4* xc = (const f32x4*)xin_row(F, m + 2 * NGW) + F.lane; const f32x4* xd = (const f32x4*)xin_row(F, m + 3 * NGW) + F.lane;
          const f32x4 a0 = xa[0], a1 = xa[64], a2 = xa[128], a3 = xa[192], b0 = xb[0], b1 = xb[64], b2 = xb[128], b3 = xb[192];
          const f32x4 c0 = xc[0], c1 = xc[64], c2 = xc[128], c3 = xc[192], d0 = xd[0], d1 = xd[64], d2 = xd[128], d3 = xd[192];
          rms_fin_bf16(a0, a1, a2, a3, WSP(bf16, WS_XNA) + (size_t)m * DM, F.lane); rms_fin_bf16(b0, b1, b2, b3, WSP(bf16, WS_XNA) + (size_t)(m + NGW) * DM, F.lane);
          rms_fin_bf16(c0, c1, c2, c3, WSP(bf16, WS_XNA) + (size_t)(m + 2 * NGW) * DM, F.lane); rms_fin_bf16(d0, d1, d2, d3, WSP(bf16, WS_XNA) + (size_t)(m + 3 * NGW) * DM, F.lane); }
      for (; m < MTOK; m += NGW) rms_row_to_bf16(xin_row(F, m), WSP(bf16, WS_XNA) + (size_t)m * DM, F.lane); }
    {
        if (F.G != 256) peer_tables_to_fp8(F, (size_t)gt, (size_t)NGT);
        const f32x4* sk = (const f32x4*)FIN(26); v4u* dk = (v4u*)WSP(bf16, WS_SUBK);
        for (int i = gt; i < 2 * 8 * 2 * 128 * 128 / 8; i += NGT) { const f32x4 a = sk[2 * i], b = sk[2 * i + 1]; v4u w; w.x = pk2(a.x, a.y); w.y = pk2(a.z, a.w); w.z = pk2(b.x, b.y); w.w = pk2(b.z, b.w); dk[i] = w; }
    }
    for (int i = gt; i < 2 * 64 * 2048; i += NGT) { const int kv = i >> 17, hh = (i >> 11) & 63, k = i & 2047;
        WSP(bf16, WS_W1T)[i] = (bf16)f2bf(FIN(17)[((size_t)kv * 2048 + k) * 64 + hh]); }
    for (int i = gt; i < 2 * 4 * 2 * 64 * 8; i += NGT) { const int e = i & 7, ln = (i >> 3) & 63, sx = (i >> 9) & 1, dt = (i >> 10) & 3, kv = i >> 12, fr_ = ln & 15, fq_ = ln >> 4;
        WSP(bf16, WS_W2F)[i] = (bf16)f2bf(FIN(19)[((size_t)kv * 64 + 16 * (2 * sx + (e >> 2)) + 4 * fq_ + (e & 3)) * 64 + 16 * dt + fr_]); }
    for (int it = gw; it < 128; it += NGW) { const int kv = it >> 6, h = it & 63; float s = 0.f;
        for (int k = F.lane; k < 2048; k += 64) s += FIN(18)[(size_t)kv * 2048 + k] * FIN(17)[((size_t)kv * 2048 + k) * 64 + h];
        s = wave_sum(s); if (F.lane == 0) WSP(float, WS_PETERM)[it] = s; }
    {
        bf16* wbd = WSP(bf16, WS_W1BD);
        for (int i = gt; i < 256 * 2048; i += NGT) { const int n = i >> 11, col = i & 2047, kv = n >> 7, sec = (n >> 6) & 1, hh = n & 63;
            float v = 0.f; if ((col >> 10) == kv) { const int k = col & 1023, r = (k >> 6) + 16 * sec, d = k & 63; v = FIN(17)[(((size_t)kv * 32 + r) * 64 + d) * 64 + hh]; }
            wbd[i] = (bf16)f2bf(v); }
    }
    {
        const f32x4* src = (const f32x4*)FIN(3); f32x4* dst = (f32x4*)(F.out + O_WINS);
        const int per_b = 508 * 512 / 4;
        for (int i = gt; i < SB * per_b; i += NGT) { const int b = i / per_b, r = i % per_b; dst[(size_t)b * (512 * 512 / 4) + r] = src[(size_t)b * (512 * 512 / 4) + 4 * 512 / 4 + r]; }
    }
    for (int i = gt; i < SB * NG * 544 * 64; i += NGT) {
        const int d = i & 63, r = (i >> 6) % 544, bg = (i >> 6) / 544, g = bg & 3, b = bg >> 2;
        if (r < 512) { const float* cw = FIN(3) + (((size_t)b * 512 + r) * 2) * 256 + g * 64 + d;
            WSP(bf16, WS_SKWIN)[i] = (bf16)f2bf(cw[0]);
            WSP(bf16, WS_SVWINT)[((size_t)bg * 64 + d) * 544 + r] = (bf16)f2bf(cw[256]); }
        else if (r >= 516) { WSP(bf16, WS_SKWIN)[i] = 0; WSP(bf16, WS_SVWINT)[((size_t)bg * 64 + d) * 544 + r] = 0; }
    }
}

constexpr int P2_QS = 0, P2_KS = 17408, P2_KBGT = 34816, P2_VBT = 53248, P2_AM = 71680, P2_TB = 89088, P2_G = 98304, P2_TF = 99328, P2_XF = 116736;
constexpr int QS_LD = 136, KT_LD = 72, AM_LD = 68, TB_LD = 72;

__device__ __forceinline__ float softplus_f(float x) { return fmaxf(x, 0.f) + __logf(1.f + __expf(-fabsf(x))); }

__device__ __forceinline__ void p2_chunk(Frame& F, int unit) {
    const int c = unit & 127, h = (unit >> 7) & 7, b = unit >> 10;
    const int t0 = c * CHUNK, lane = F.lane, w = F.wave, fr = lane & 15, fq = lane >> 4;
    LAS unsigned char* L = F.lds; asm volatile("" : "+v"(L));
    LAS bf16* qs = (LAS bf16*)(L + P2_QS); LAS bf16* ks = (LAS bf16*)(L + P2_KS);
    LAS bf16* kbgT = (LAS bf16*)(L + P2_KBGT); LAS bf16* vbT = (LAS bf16*)(L + P2_VBT);
    LAS float* Am = (LAS float*)(L + P2_AM); LAS bf16* Tb = (LAS bf16*)(L + P2_TB);
    LAS float* Gs = (LAS float*)(L + P2_G);
    const bf16* PROJ = WSP(bf16, WS_PROJ); const bf16* XNA = WSP(bf16, WS_XNA); const float* WAB = WSP(float, WS_WAB);
    const size_t rowb = (size_t)b * PT;
    float beta_r[8];
    {
        f32x4 wa[4], wb[4];
        const float* pa = WAB + (size_t)h * DM + 8 * lane; const float* pb = WAB + (size_t)(8 + h) * DM + 8 * lane;
        wa[0] = *(const f32x4*)pa; wa[1] = *(const f32x4*)(pa + 4); wa[2] = *(const f32x4*)(pa + 512); wa[3] = *(const f32x4*)(pa + 516);
        wb[0] = *(const f32x4*)pb; wb[1] = *(const f32x4*)(pb + 4); wb[2] = *(const f32x4*)(pb + 512); wb[3] = *(const f32x4*)(pb + 516);
        const float Aneg = -expf(FIN(10)[h]), dtb = FIN(11)[h];
#pragma unroll
        for (int tk = 0; tk < 8; ++tk) {
            const int tok = 8 * w + tk; const bf16* xr = XNA + (rowb + t0 + tok) * DM + 8 * lane;
            const v4u x0 = *(const v4u*)xr, x1 = *(const v4u*)(xr + 512);
            float sa = 0.f, sb = 0.f;
#define ACC2(xw, wv0, wv1, i0) { const float lo = bflo(xw), hi = bfhi(xw); sa += lo * wv0[i0] + hi * wv0[i0 + 1]; sb += lo * wv1[i0] + hi * wv1[i0 + 1]; }
            ACC2(x0.x, wa[0], wb[0], 0) ACC2(x0.y, wa[0], wb[0], 2) ACC2(x0.z, wa[1], wb[1], 0) ACC2(x0.w, wa[1], wb[1], 2)
            ACC2(x1.x, wa[2], wb[2], 0) ACC2(x1.y, wa[2], wb[2], 2) ACC2(x1.z, wa[3], wb[3], 0) ACC2(x1.w, wa[3], wb[3], 2)
#undef ACC2
            sa = wave_sum(sa); sb = wave_sum(sb);
            const float g = Aneg * softplus_f(sa + dtb), be = sigmoid_f(sb);
            beta_r[tk] = be;
            if (lane == 0) { Gs[tok] = g; Gs[64 + tok] = be; }
        }
    }
#pragma unroll
    for (int p = 0; p < 3; ++p) {
        const int col0 = p * 1024 + h * 128 + 2 * lane;
        float cw0[4], cw1[4];
#pragma unroll
        for (int i = 0; i < 4; ++i) { const f32x2 cv = *(const f32x2*)(FIN(9) + (size_t)i * GCONV + col0); cw0[i] = cv.x; cw1[i] = cv.y; }
        unsigned xw[11];
#pragma unroll
        for (int rr = 0; rr < 11; ++rr) { const int t = t0 + 8 * w - 3 + rr; xw[rr] = (t >= 0) ? *(const unsigned*)(PROJ + (rowb + t) * 4096 + col0) : 0u; }
        if (c == 127 && w == 7) {
#pragma unroll
            for (int r = 0; r < 3; ++r) { float* o = F.out + O_CONVP + ((size_t)b * 3 + r) * GCONV + col0; o[0] = bflo(xw[8 + r]); o[1] = bfhi(xw[8 + r]); }
        }
#pragma unroll
        for (int tk = 0; tk < 8; ++tk) {
            const int tok = 8 * w + tk;
            float y0 = 0.f, y1 = 0.f;
#pragma unroll
            for (int i = 0; i < 4; ++i) { y0 += cw0[i] * bflo(xw[tk + i]); y1 += cw1[i] * bfhi(xw[tk + i]); }
            y0 = silu_f(y0); y1 = silu_f(y1);
            if (p < 2) {
                const float ss = wave_sum(y0 * y0 + y1 * y1);
                const float rs = (frsq(ss + EPS)) * (p == 0 ? 0.08838834764831845f : 1.f);
                *(LAS unsigned*)((p == 0 ? qs : ks) + tok * QS_LD + 2 * lane) = pk2(y0 * rs, y1 * rs);
            } else {
                vbT[(2 * lane) * KT_LD + tok] = (bf16)f2bf(y0 * beta_r[tk]); vbT[(2 * lane + 1) * KT_LD + tok] = (bf16)f2bf(y1 * beta_r[tk]);
            }
        }
    }
    __syncthreads();
    if (w == 0) { float g = Gs[lane];
#pragma unroll
        for (int o = 1; o < 64; o <<= 1) { const float up = __shfl_up(g, o); if (lane >= o) g += up; }
        Gs[128 + lane] = g; }
    __syncthreads();
    const float glast = Gs[128 + 63];
    const size_t chunk = (size_t)unit;
    if (w < 4) {
        const int mt = w;
        bf16x8 a[4];
#pragma unroll
        for (int kk = 0; kk < 4; ++kk) a[kk] = ld8l(ks + (16 * mt + fr) * QS_LD + 32 * kk + 8 * fq);
#pragma unroll
        for (int nt = 0; nt < 4; ++nt) {
            f32x4 acc = {0.f, 0.f, 0.f, 0.f};
            if (nt <= mt) {
#pragma unroll
                for (int kk = 0; kk < 4; ++kk) acc = MFMA16(a[kk], ld8l(ks + (16 * nt + fr) * QS_LD + 32 * kk + 8 * fq), acc);
            }
            const int j = 16 * nt + fr; const float gj = Gs[128 + j];
#pragma unroll
            for (int r = 0; r < 4; ++r) { const int i = 16 * mt + 4 * fq + r;
                Am[i * AM_LD + j] = (i > j) ? Gs[64 + i] * acc[r] * __expf(Gs[128 + i] - gj) : 0.f; }
        }
    } else {
        const int nt = w - 4;
        bf16x8 bq[4];
#pragma unroll
        for (int kk = 0; kk < 4; ++kk) bq[kk] = ld8l(qs + (16 * nt + fr) * QS_LD + 32 * kk + 8 * fq);
        const int i = 16 * nt + fr; const float gi = Gs[128 + i];
        bf16* gqk = WSP(bf16, WS_GQK) + chunk * 4096;
#pragma unroll
        for (int mt = 0; mt < 4; ++mt) {
            f32x4 acc = {0.f, 0.f, 0.f, 0.f};
            if (mt <= nt) {
#pragma unroll
                for (int kk = 0; kk < 4; ++kk) acc = MFMA16(ld8l(ks + (16 * mt + fr) * QS_LD + 32 * kk + 8 * fq), bq[kk], acc);
            }
            float v[4];
#pragma unroll
            for (int r = 0; r < 4; ++r) { const int j = 16 * mt + 4 * fq + r; v[r] = (i >= j) ? acc[r] * __expf(gi - Gs[128 + j]) : 0.f; }
            v2u o; o.x = pk2(v[0], v[1]); o.y = pk2(v[2], v[3]);
            *(v2u*)(gqk + (((nt * 2 + (mt >> 1)) * 64 + (2 * (mt & 1) + (fq >> 1)) * 16 + fr) * 8 + 4 * (fq & 1))) = o;
        }
    }
    {
        const int tok = F.tid >> 3, d0 = (F.tid & 7) * 16; const float e = __expf(Gs[128 + tok]);
        bf16* gq = WSP(bf16, WS_GQ) + chunk * 8192;
#pragma unroll
        for (int hh = 0; hh < 2; ++hh) { const v4u q = *(const LAS v4u*)(qs + tok * QS_LD + d0 + 8 * hh); v4u o;
            o.x = pk2(bflo(q.x) * e, bfhi(q.x) * e); o.y = pk2(bflo(q.y) * e, bfhi(q.y) * e); o.z = pk2(bflo(q.z) * e, bfhi(q.z) * e); o.w = pk2(bflo(q.w) * e, bfhi(q.w) * e);
            *(v4u*)(gq + ((((tok >> 4) * 4 + ((F.tid & 7) >> 1)) * 64 + (2 * (F.tid & 1) + hh) * 16 + (tok & 15)) * 8)) = o; }
    }
    {
        const int dk = F.tid & 127, tg = F.tid >> 7;
        unsigned o1[8], o2[8];
#pragma unroll
        for (int i = 0; i < 8; ++i) {
            const int ta = 16 * tg + 2 * i, tb2 = ta + 1;
            const float ka = bf2f(ks[ta * QS_LD + dk]), kb = bf2f(ks[tb2 * QS_LD + dk]);
            const float ga = Gs[128 + ta], gb = Gs[128 + tb2];
            o1[i] = pk2(ka * Gs[64 + ta] * __expf(ga), kb * Gs[64 + tb2] * __expf(gb));
            o2[i] = pk2(ka * __expf(glast - ga), kb * __expf(glast - gb));
        }
        LAS v4u* d1 = (LAS v4u*)(kbgT + dk * KT_LD + 16 * tg); d1[0] = (v4u){o1[0], o1[1], o1[2], o1[3]}; d1[1] = (v4u){o1[4], o1[5], o1[6], o1[7]};
        bf16* d2 = WSP(bf16, WS_GKT) + chunk * 8192 + ((((dk >> 4) * 2 + (tg >> 1)) * 64 + (2 * (tg & 1)) * 16 + (dk & 15)) * 8);
        *(v4u*)d2 = (v4u){o2[0], o2[1], o2[2], o2[3]}; *(v4u*)(d2 + 16 * 8) = (v4u){o2[4], o2[5], o2[6], o2[7]};
    }
    if (F.tid == 0) WSP(float, WS_GDEC)[chunk] = __expf(glast);
    __syncthreads();
    LAS float* Tf = (LAS float*)(L + P2_TF); LAS float* Xf = (LAS float*)(L + P2_XF);
    if (w == 0) {
        const int blk = lane >> 5, cc = lane & 31; const LAS float* Ab = Am + (32 * blk) * AM_LD + 32 * blk;
        float t[32];
#pragma unroll
        for (int i = 0; i < 32; ++i) {
            float acc0 = (i == cc) ? 1.f : 0.f, acc1 = 0.f, acc2 = 0.f, acc3 = 0.f;
#pragma unroll
            for (int j4 = 0; j4 < (i + 3) / 4; ++j4) {
                const f32x4 a = *(const LAS f32x4*)(Ab + i * AM_LD + 4 * j4);
                if (4 * j4 + 0 < i) acc0 = __builtin_fmaf(-a.x, t[4 * j4 + 0], acc0);
                if (4 * j4 + 1 < i) acc1 = __builtin_fmaf(-a.y, t[4 * j4 + 1], acc1);
                if (4 * j4 + 2 < i) acc2 = __builtin_fmaf(-a.z, t[4 * j4 + 2], acc2);
                if (4 * j4 + 3 < i) acc3 = __builtin_fmaf(-a.w, t[4 * j4 + 3], acc3);
            }
            t[i] = (acc0 + acc1) + (acc2 + acc3);
            asm volatile("" : "+v"(t[i]));
            __builtin_amdgcn_sched_barrier(0);
        }
#pragma unroll
        for (int i = 0; i < 32; ++i) { Tf[(32 * blk + i) * AM_LD + 32 * blk + cc] = t[i]; if (blk == 0) Tf[i * AM_LD + 32 + cc] = 0.f; }
    }
    __syncthreads();
    {
        const int i = F.tid >> 4, c0 = (F.tid & 15) * 2; float x0 = 0.f, x1 = 0.f;
#pragma unroll 8
        for (int k = 0; k < 32; ++k) { const float a = Am[(32 + i) * AM_LD + k]; x0 = __builtin_fmaf(a, Tf[k * AM_LD + c0], x0); x1 = __builtin_fmaf(a, Tf[k * AM_LD + c0 + 1], x1); }
        Xf[i * 34 + c0] = x0; Xf[i * 34 + c0 + 1] = x1;
    }
    __syncthreads();
    {
        const int i = F.tid >> 4, c0 = (F.tid & 15) * 2; float x0 = 0.f, x1 = 0.f;
#pragma unroll 8
        for (int k = 0; k < 32; ++k) { const float a = Tf[(32 + i) * AM_LD + 32 + k]; x0 = __builtin_fmaf(a, Xf[k * 34 + c0], x0); x1 = __builtin_fmaf(a, Xf[k * 34 + c0 + 1], x1); }
        Tf[(32 + i) * AM_LD + c0] = -x0; Tf[(32 + i) * AM_LD + c0 + 1] = -x1;
    }
    __syncthreads();
    {
        const int i = F.tid >> 3, c0 = (F.tid & 7) * 8; const f32x4 a = *(const LAS f32x4*)(Tf + i * AM_LD + c0), b2 = *(const LAS f32x4*)(Tf + i * AM_LD + c0 + 4);
        *(LAS v4u*)(Tb + i * TB_LD + c0) = (v4u){pk2(a.x, a.y), pk2(a.z, a.w), pk2(b2.x, b2.y), pk2(b2.z, b2.w)};
    }
    __syncthreads();
    {
        bf16x8 tb[4][2];
#pragma unroll
        for (int x = 0; x < 4; ++x)
#pragma unroll
            for (int s = 0; s < 2; ++s) tb[x][s] = ld8l(Tb + (16 * x + fr) * TB_LD + 32 * s + 8 * fq);
        const bf16x8 bv0 = ld8l(vbT + (16 * w + fr) * KT_LD + 8 * fq), bv1 = ld8l(vbT + (16 * w + fr) * KT_LD + 32 + 8 * fq);
        bf16* gu = WSP(bf16, WS_GU) + chunk * 8192 + ((size_t)((w >> 1) * 4 * 64 + lane) * 2 + (w & 1)) * 4;
#pragma unroll
        for (int mt = 0; mt < 4; ++mt) { f32x4 acc = {0.f, 0.f, 0.f, 0.f}; acc = MFMA16(tb[mt][0], bv0, acc); acc = MFMA16(tb[mt][1], bv1, acc); *(v2u*)(gu + mt * 64 * 8) = (v2u){pk2(acc[0], acc[1]), pk2(acc[2], acc[3])}; }
        const bf16x8 ak0 = ld8l(kbgT + (16 * w + fr) * KT_LD + 8 * fq), ak1 = ld8l(kbgT + (16 * w + fr) * KT_LD + 32 + 8 * fq);
        bf16* gw = WSP(bf16, WS_GW) + chunk * 8192;
#pragma unroll
        for (int nt = 0; nt < 4; ++nt) { f32x4 acc = {0.f, 0.f, 0.f, 0.f}; acc = MFMA16(ak0, tb[nt][0], acc); acc = MFMA16(ak1, tb[nt][1], acc);
            v2u o; o.x = pk2(acc[0], acc[1]); o.y = pk2(acc[2], acc[3]);
            *(v2u*)(gw + (((nt * 4 + (w >> 1)) * 64 + (2 * (w & 1) + (fq >> 1)) * 16 + fr) * 8 + 4 * (fq & 1))) = o; }
    }
    __syncthreads();
}

constexpr int S2_Y = 0;
constexpr int S2_AB = 6144;
constexpr int S2_DOT = 6400;
constexpr int S2_U = 6656;
constexpr int S2_W = 8704;
constexpr int S2_VN = 10752;
__device__ __forceinline__ void p2_sample(Frame& F, int unit) {
    const int h = unit & 7, bs = unit >> 3, tid = F.tid, lane = F.lane, w = F.wave;
    LAS unsigned char* L = F.lds; asm volatile("" : "+v"(L));
    LAS float* Y = (LAS float*)(L + S2_Y); LAS float* AB = (LAS float*)(L + S2_AB); LAS float* DOT = (LAS float*)(L + S2_DOT);
    LAS float* U = (LAS float*)(L + S2_U); LAS float* W = (LAS float*)(L + S2_W); LAS float* VN = (LAS float*)(L + S2_VN);
    const bf16* PROJ = WSP(bf16, WS_PROJ); const bf16* XNA = WSP(bf16, WS_XNA); const float* WAB = WSP(float, WS_WAB);
    const size_t row0 = (size_t)MP + bs * 4;
    if (tid < 384) {
        const int part = tid >> 7, cc = tid & 127, col = part * 1024 + h * 128 + cc;
        float buf[7];
#pragma unroll
        for (int r = 0; r < 3; ++r) buf[r] = FIN(5)[((size_t)bs * 3 + r) * GCONV + col];
#pragma unroll
        for (int i = 0; i < 4; ++i) buf[3 + i] = bf2f(PROJ[(row0 + i) * 4096 + col]);
#pragma unroll
        for (int r = 0; r < 3; ++r) F.out[O_CONVS + ((size_t)bs * 3 + r) * GCONV + col] = buf[4 + r];
        float cw[4];
#pragma unroll
        for (int i = 0; i < 4; ++i) cw[i] = FIN(9)[(size_t)i * GCONV + col];
#pragma unroll
        for (int i = 0; i < 4; ++i) { float y = 0.f;
#pragma unroll
            for (int k = 0; k < 4; ++k) y += cw[k] * buf[i + k];
            Y[(part * 4 + i) * 128 + cc] = silu_f(y); }
    }
    {
        const int i = w >> 1, which = w & 1; const bf16* xr = XNA + (row0 + i) * DM; const float* wr = WAB + (size_t)(which * 8 + h) * DM; float s = 0.f;
        for (int k = lane; k < DM; k += 64) s += bf2f(xr[k]) * wr[k];
        s = wave_sum(s); if (lane == 0) AB[which * 4 + i] = s;
    }
    __syncthreads();
    {
        const int part = w >> 2, i = w & 3; LAS float* y = Y + (part * 4 + i) * 128; const float a = y[lane], bq = y[64 + lane];
        const float ss = wave_sum(a * a + bq * bq); const float rs = (frsq(ss + EPS)) * (part == 0 ? 0.08838834764831845f : 1.f);
        y[lane] = a * rs; y[64 + lane] = bq * rs;
    }
    if (tid == 0) { const float Aneg = -expf(FIN(10)[h]), dtb = FIN(11)[h]; float gc = 0.f;
        for (int i = 0; i < 4; ++i) { const float g = Aneg * softplus_f(AB[i] + dtb); gc += g; AB[8 + i] = g; AB[12 + i] = 1.f / (1.f + expf(-AB[4 + i])); AB[16 + i] = gc; } }
    __syncthreads();
    {
#pragma unroll
        for (int pp = 0; pp < 4; ++pp) { const int pr = 4 * w + pp, which = pr >> 4, i = (pr >> 2) & 3, j = pr & 3;
            const LAS float* x = Y + ((which == 0 ? 1 : 0) * 4 + i) * 128; const LAS float* y = Y + (1 * 4 + j) * 128;
            float s = x[lane] * y[lane] + x[64 + lane] * y[64 + lane]; s = wave_sum(s); if (lane == 0) DOT[pr] = s; }
    }
    __syncthreads();
    float g_[4], be[4], gc[4];
#pragma unroll
    for (int i = 0; i < 4; ++i) { g_[i] = AB[8 + i]; be[i] = AB[12 + i]; gc[i] = AB[16 + i]; }
    float Tm[4][4];
    {
        float A[4][4];
#pragma unroll
        for (int i = 0; i < 4; ++i)
#pragma unroll
            for (int j = 0; j < 4; ++j) A[i][j] = (i > j) ? be[i] * DOT[i * 4 + j] * expf(gc[i] - gc[j]) : 0.f;
#pragma unroll
        for (int cc = 0; cc < 4; ++cc)
#pragma unroll
            for (int i = 0; i < 4; ++i) { float acc = (i == cc) ? 1.f : 0.f;
#pragma unroll
                for (int j = 0; j < 4; ++j) if (j < i) acc -= A[i][j] * Tm[j][cc];
                Tm[i][cc] = acc; }
    }
    {
        const int i = tid >> 7, x = tid & 127; float su = 0.f, sw = 0.f;
#pragma unroll
        for (int j = 0; j < 4; ++j) { su += Tm[i][j] * Y[(2 * 4 + j) * 128 + x] * be[j]; sw += Tm[i][j] * Y[(1 * 4 + j) * 128 + x] * be[j] * expf(gc[j]); }
        U[i * 128 + x] = su; W[i * 128 + x] = sw;
    }
    __syncthreads();
    const float* S0 = FIN(4) + ((size_t)bs * GH + h) * 128 * 128;
    const int dv = tid & 127, dg = tid >> 7;
    LAS float* SL = (LAS float*)(L + 32768);
#pragma unroll 16
    for (int r = 0; r < 32; ++r) SL[(32 * dg + r) * 128 + dv] = S0[(size_t)(32 * dg + r) * 128 + dv];
    LAS float* PP = (LAS float*)(L + 16384); LAS float* PQ = (LAS float*)(L + 16384 + 8192);
    {
        float pp[4] = {0.f, 0.f, 0.f, 0.f}, qp[4] = {0.f, 0.f, 0.f, 0.f};
#pragma unroll
        for (int r = 0; r < 32; ++r) { const int dk = 32 * dg + r; const float sv = SL[dk * 128 + dv];
#pragma unroll
            for (int i = 0; i < 4; ++i) { pp[i] += W[i * 128 + dk] * sv; qp[i] += Y[(0 * 4 + i) * 128 + dk] * sv; } }
#pragma unroll
        for (int i = 0; i < 4; ++i) { PP[(dg * 4 + i) * 128 + dv] = pp[i]; PQ[(dg * 4 + i) * 128 + dv] = qp[i]; }
    }
    __syncthreads();
    float qs_acc;
    {
        const int i = tid >> 7;
        const float p = (PP[(0 * 4 + i) * 128 + dv] + PP[(1 * 4 + i) * 128 + dv]) + (PP[(2 * 4 + i) * 128 + dv] + PP[(3 * 4 + i) * 128 + dv]);
        const float qq = (PQ[(0 * 4 + i) * 128 + dv] + PQ[(1 * 4 + i) * 128 + dv]) + (PQ[(2 * 4 + i) * 128 + dv] + PQ[(3 * 4 + i) * 128 + dv]);
        VN[i * 128 + dv] = U[i * 128 + dv] - p; qs_acc = qq * expf(gc[i]);
    }
    __syncthreads();
    {
        const int i = tid >> 7; float o = qs_acc;
#pragma unroll
        for (int j = 0; j < 4; ++j) if (j <= i) o += DOT[16 + i * 4 + j] * expf(gc[i] - gc[j]) * VN[j * 128 + dv];
        WSP(bf16, WS_OGDN)[(row0 + i) * DM + h * 128 + dv] = (bf16)f2bf(o);
    }
    {
        const float el = expf(gc[3]);
        float kd[4], vn[4];
#pragma unroll
        for (int j = 0; j < 4; ++j) { kd[j] = expf(gc[3] - gc[j]); vn[j] = VN[j * 128 + dv]; }
        float* So = F.out + O_GDNS + ((size_t)bs * GH + h) * 128 * 128;
#pragma unroll
        for (int r = 0; r < 32; ++r) { const int dk = 32 * dg + r; float sv = SL[dk * 128 + dv] * el;
#pragma unroll
            for (int j = 0; j < 4; ++j) sv += Y[(1 * 4 + j) * 128 + dk] * kd[j] * vn[j];
            So[(size_t)dk * 128 + dv] = sv; }
    }
    (void)g_;
    __syncthreads();
}

constexpr int P3_S = 0;
constexpr int P3_VN = 16384;
__device__ __forceinline__ void p3_scan(Frame& F, int bh, int s) {
    const int lane = F.lane, w = F.wave, fr = lane & 15, fq = lane >> 4;
    const int b = bh >> 3, h = bh & 7;
    LAS bf16* Sl = (LAS bf16*)(F.lds + P3_S); LAS bf16* Vl = (LAS bf16*)(F.lds + P3_VN);
    const bf16* GW = WSP(bf16, WS_GW); const bf16* GQ = WSP(bf16, WS_GQ); const bf16* GKT = WSP(bf16, WS_GKT); const bf16* GQK = WSP(bf16, WS_GQK);
    const bf16* GU = WSP(bf16, WS_GU); const float* GDEC = WSP(float, WS_GDEC);
    bf16* OG = WSP(bf16, WS_OGDN);
    f32x4 Sacc[2];
#pragma unroll
    for (int n = 0; n < 2; ++n) { Sacc[n] = (f32x4){0.f, 0.f, 0.f, 0.f}; v2u z = {0u, 0u}; *(LAS v2u*)(Sl + (n * 16 + fr) * 136 + 16 * w + 4 * fq) = z; }
    __syncthreads();
    const int m = w & 3;
    struct P3Ops { bf16x8 a1[4], ak0, ak1; v4u x0, x1; float dec; };
    P3Ops R0, R1, R2;
#define P3_FETCH(R, cc) do { const size_t ch_ = (size_t)bh * NCH + (cc); \
        const bf16* p1_ = (w < 4 ? GW : GQ) + ch_ * 8192 + (size_t)(m * 4 * 64 + lane) * 8;        \
        _Pragma("unroll") for (int k_ = 0; k_ < 4; ++k_) R.a1[k_] = ld8(p1_ + 512 * k_); \
        const bf16* pk_ = GKT + ch_ * 8192 + (size_t)(w * 2 * 64 + lane) * 8; R.ak0 = ld8(pk_); R.ak1 = ld8(pk_ + 512); \
        const unsigned char* px_ = w < 4 ? (const unsigned char*)(GU + ch_ * 8192 + ((size_t)(s * 4 + m) * 64 + lane) * 8) : (const unsigned char*)(GQK + ch_ * 4096 + (size_t)(m * 2 * 64 + lane) * 8); \
        R.x0 = *(const v4u*)px_; R.x1 = *(const v4u*)(px_ + (w < 4 ? 0 : 1024));        \
        R.dec = GDEC[ch_]; } while (0)
#define P3_STEP(R, c) do { \
        f32x4 acc[2]; \
        _Pragma("unroll") for (int n = 0; n < 2; ++n) { acc[n] = (f32x4){0.f, 0.f, 0.f, 0.f}; \
            _Pragma("unroll") for (int k = 0; k < 4; ++k) acc[n] = MFMA16(R.a1[k], ld8l(Sl + (n * 16 + fr) * 136 + 32 * k + 8 * fq), acc[n]); } \
        if (w < 4) { _Pragma("unroll") for (int n = 0; n < 2; ++n) { const unsigned ua_ = n == 0 ? R.x0.x : R.x0.z, ub_ = n == 0 ? R.x0.y : R.x0.w; const f32x4 vn = (f32x4){bflo(ua_), bfhi(ua_), bflo(ub_), bfhi(ub_)} - acc[n]; v2u o; o.x = pk2(vn[0], vn[1]); o.y = pk2(vn[2], vn[3]); \
            *(LAS v2u*)(Vl + (n * 16 + fr) * 72 + 16 * m + 4 * fq) = o; } } \
        asm volatile("s_waitcnt lgkmcnt(0)\n\ts_barrier" ::: "memory"); \
        bf16x8 v0[2], v1[2]; \
        _Pragma("unroll") for (int n = 0; n < 2; ++n) { v0[n] = ld8l(Vl + (n * 16 + fr) * 72 + 8 * fq); v1[n] = ld8l(Vl + (n * 16 + fr) * 72 + 32 + 8 * fq); } \
        if (w >= 4) { _Pragma("unroll") for (int n = 0; n < 2; ++n) { acc[n] = MFMA16(__builtin_bit_cast(bf16x8, R.x0), v0[n], acc[n]); acc[n] = MFMA16(__builtin_bit_cast(bf16x8, R.x1), v1[n], acc[n]); \
            bf16* o = OG + ((size_t)b * PT + (c) * CHUNK + 16 * m + 4 * fq) * DM + h * 128 + 32 * s + 16 * n + fr; \
            _Pragma("unroll") for (int r = 0; r < 4; ++r) o[(size_t)r * DM] = (bf16)f2bf(acc[n][r]); } } \
        { float d_ = R.dec;        \
          _Pragma("unroll") for (int n = 0; n < 2; ++n) asm volatile("v_mul_f32 %0, %0, %4\n\tv_mul_f32 %1, %1, %4\n\tv_mul_f32 %2, %2, %4\n\tv_mul_f32 %3, %3, %4" : "+v"(Sacc[n][0]), "+v"(Sacc[n][1]), "+v"(Sacc[n][2]), "+v"(Sacc[n][3]) : "v"(d_)); } \
        _Pragma("unroll") for (int n = 0; n < 2; ++n) { Sacc[n] = MFMA16(R.ak0, v0[n], Sacc[n]); Sacc[n] = MFMA16(R.ak1, v1[n], Sacc[n]); \
            v2u o; o.x = pk2(Sacc[n][0], Sacc[n][1]); o.y = pk2(Sacc[n][2], Sacc[n][3]); *(LAS v2u*)(Sl + (n * 16 + fr) * 136 + 16 * w + 4 * fq) = o; } \
        asm volatile("s_waitcnt lgkmcnt(0)\n\ts_barrier" ::: "memory"); } while (0)
    P3_FETCH(R0, 0); __builtin_amdgcn_sched_barrier(0); P3_FETCH(R1, 1); __builtin_amdgcn_sched_barrier(0); P3_FETCH(R2, 2); __builtin_amdgcn_sched_barrier(0);
    static_assert(NCH % 3 == 2, "ring schedule below assumes NCH = 3k + 2");
#pragma unroll 1
    for (int c = 0; c + 3 <= NCH; c += 3) {
        P3_STEP(R0, c);     P3_FETCH(R0, (c + 3 < NCH ? c + 3 : NCH - 1));
        P3_STEP(R1, c + 1); P3_FETCH(R1, (c + 4 < NCH ? c + 4 : NCH - 1));
        P3_STEP(R2, c + 2); P3_FETCH(R2, (c + 5 < NCH ? c + 5 : NCH - 1));
    }
    P3_STEP(R0, NCH - 2); P3_STEP(R1, NCH - 1);
#undef P3_FETCH
#undef P3_STEP
    float* So = F.out + O_GDNP + ((size_t)bh * 128) * 128;
#pragma unroll
    for (int n = 0; n < 2; ++n)
#pragma unroll
        for (int r = 0; r < 4; ++r) So[(size_t)(16 * w + 4 * fq + r) * 128 + 32 * s + 16 * n + fr] = Sacc[n][r];
}

__device__ __forceinline__ void p4_rows(Frame& F, int first, int stride) {
    const int lane = F.lane;
    if (first >= MTOK) return;
    float gn[16];
    { const f32x4* gp = (const f32x4*)(FIN(12) + (16 * lane & 127));
#pragma unroll
      for (int j = 0; j < 4; ++j) { const f32x4 g4 = gp[j]; gn[4 * j] = g4.x; gn[4 * j + 1] = g4.y; gn[4 * j + 2] = g4.z; gn[4 * j + 3] = g4.w; } }
    v4u no0, no1, nz0, nz1;
#define P4_FETCH(rw) do { const bf16* o_ = WSP(bf16, WS_OGDN) + (size_t)(rw) * DM + 16 * lane; const bf16* z_ = WSP(bf16, WS_PROJ) + (size_t)(rw) * 4096 + 3072 + 16 * lane; \
        no0 = *(const v4u*)o_; no1 = *(const v4u*)(o_ + 8); nz0 = *(const v4u*)z_; nz1 = *(const v4u*)(z_ + 8); } while (0)
    P4_FETCH(first);
#pragma unroll 1
    for (int row = first; row < MTOK; row += stride) {
        f32x4 v[4]; const v4u z0 = nz0, z1 = nz1; float ss = 0.f;
#pragma unroll
        for (int j = 0; j < 4; ++j) { const unsigned wa = j < 2 ? (j == 0 ? no0.x : no0.z) : (j == 2 ? no1.x : no1.z), wb = j < 2 ? (j == 0 ? no0.y : no0.w) : (j == 2 ? no1.y : no1.w);
            v[j] = (f32x4){bflo(wa), bfhi(wa), bflo(wb), bfhi(wb)}; ss += (v[j].x * v[j].x + v[j].y * v[j].y) + (v[j].z * v[j].z + v[j].w * v[j].w); }
        { const int nr = row + stride < MTOK ? row + stride : row; P4_FETCH(nr); }
        ss += dpp_f<DPP_XOR1>(ss); ss += dpp_f<DPP_XOR2>(ss); ss += dpp_f<DPP_HMIR>(ss);
        const float rstd = frsq(ss * (1.f / 128.f) + EPS);
        float zz[16] = {bflo(z0.x), bfhi(z0.x), bflo(z0.y), bfhi(z0.y), bflo(z0.z), bfhi(z0.z), bflo(z0.w), bfhi(z0.w),
                        bflo(z1.x), bfhi(z1.x), bflo(z1.y), bfhi(z1.y), bflo(z1.z), bfhi(z1.z), bflo(z1.w), bfhi(z1.w)};
        unsigned ow[8];
#pragma unroll
        for (int j = 0; j < 8; ++j) { const float a = v[j >> 1][(2 * j) & 3] * rstd * gn[2 * j] * silu_f(zz[2 * j]), bq = v[j >> 1][(2 * j + 1) & 3] * rstd * gn[2 * j + 1] * silu_f(zz[2 * j + 1]); ow[j] = pk2(a, bq); }
        v4u* dst = (v4u*)(WSP(bf16, WS_OG) + (size_t)row * DM + 16 * lane);
        dst[0] = (v4u){ow[0], ow[1], ow[2], ow[3]}; dst[1] = (v4u){ow[4], ow[5], ow[6], ow[7]};
    }
#undef P4_FETCH
}

typedef __bf16 bf16x2_t __attribute__((ext_vector_type(2)));
__device__ __forceinline__ float dot2_bf16(unsigned w, unsigned x, float acc) { return __builtin_amdgcn_fdot2_f32_bf16(__builtin_bit_cast(bf16x2_t, w), __builtin_bit_cast(bf16x2_t, x), acc, false); }
__device__ __forceinline__ float u2f(unsigned u) { return __builtin_bit_cast(float, u); }
__device__ __forceinline__ unsigned f2u(float f) { return __builtin_bit_cast(unsigned, f); }

constexpr int P8_MAXU = 4;
constexpr int P8_WAVE = P8_MAXU * 2048 + 1024;
constexpr int P8_TOP = 0;
constexpr int P8_TAB = 8 * P8_WAVE;
__device__ __forceinline__ void p8_init_tab(Frame& F) {
    LAS unsigned char* tab = F.lds + P8_TAB;
    if (F.tid < 64) { const int k = F.tid; int i = 0, j = 0;
        if (k < 16) { i = 0; j = k; } else if (k < 24) { i = 1; j = k - 16; } else if (k < 29) { i = 2; j = k - 24; } else if (k < 33) { i = 3; j = k - 29; }
        else if (k < 36) { i = 4; j = k - 33; } else if (k < 38) { i = 5; j = k - 36; } else if (k < 40) { i = 6; j = k - 38; } else if (k < 42) { i = 7; j = k - 40; } else if (k < 50) { i = k - 34; j = 0; }
        tab[k] = (unsigned char)i; tab[64 + k] = (unsigned char)j; }
    __syncthreads();
}
__device__ __forceinline__ int fkey(float x) { const int b = __builtin_bit_cast(int, x); return b ^ ((b >> 31) & 0x7fffffff); }
__device__ __forceinline__ float fkey_inv(int k) { return __builtin_bit_cast(float, k ^ ((k >> 31) & 0x7fffffff)); }
template <int CTRL> __device__ __forceinline__ int dpp_i(int x) { return __builtin_amdgcn_update_dpp(0, x, CTRL, 0xF, 0xF, true); }
__device__ __forceinline__ int imax(int a, int b) { return a > b ? a : b; }
__device__ __forceinline__ int imin(int a, int b) { return a < b ? a : b; }
__device__ __forceinline__ int row_imax16(int x) {
    x = imax(x, dpp_i<0xB1>(x)); x = imax(x, dpp_i<0x4E>(x)); x = imax(x, dpp_i<0x141>(x)); x = imax(x, dpp_i<0x140>(x)); return x;
}
#define ICSWAP(a, b) { const int hi_ = imax(a, b), lo_ = imin(a, b); a = hi_; b = lo_; }
constexpr int IKEY_MIN = (int)0x80000000;
template <int NR>
__device__ __forceinline__ void p8_run(Frame& F, int layer, int w, int rq, int u0, int ustride, int nu) {
    int lane_ = F.lane; asm volatile("" : "+v"(lane_));
    const int lane = lane_, fr = lane & 15, fq = lane >> 4;
    LAS unsigned char* L = F.lds; asm volatile("" : "+v"(L));
    LAS int* toplw = (LAS int*)(L + P8_TOP + F.wave * P8_WAVE);
    LAS float* wins = (LAS float*)(L + P8_TOP + F.wave * P8_WAVE + P8_MAXU * 2048);
    const LAS unsigned char* tab = L + P8_TAB;
    const bf16* Qb = WSP(bf16, WS_QPEER) + (size_t)fr * 2048 + w * 256 + 8 * fq;
    const bf16* SK = WSP(bf16, WS_SUBK) + (size_t)((layer * 8 + w) * 2) * 16384 + (size_t)fr * 128 + 8 * fq;
#pragma unroll 1
    for (int p = 0; p < 2; ++p) {
        bf16x8 bk[32], aq[4];
#pragma unroll
        for (int i = 0; i < 32; ++i) bk[i] = ld8(SK + (size_t)p * 16384 + (size_t)(i >> 2) * 2048 + 32 * (i & 3));
#pragma unroll
        for (int ks = 0; ks < 4; ++ks) aq[ks] = ld8(Qb + (size_t)u0 * 16 * 2048 + p * 128 + 32 * ks);
#pragma unroll 1
        for (int k = 0; k < nu; ++k) {
            LAS int* topl = toplw + k * 512;
            int s[NR][8];
#pragma unroll
            for (int nt = 0; nt < 8; ++nt) { f32x4 acc = {0.f, 0.f, 0.f, 0.f};
#pragma unroll
                for (int ks = 0; ks < 4; ++ks) acc = MFMA16(aq[ks], bk[nt * 4 + ks], acc);
                if (NR == 4) {
#pragma unroll
                    for (int r = 0; r < NR; ++r) s[r][nt] = fkey(u2f((f2u(acc[r]) & ~127u) | (unsigned)(16 * nt + fr)));
                } else { const float av = rq == 0 ? acc[0] : rq == 1 ? acc[1] : rq == 2 ? acc[2] : acc[3]; s[0][nt] = fkey(u2f((f2u(av) & ~127u) | (unsigned)(16 * nt + fr))); } }
            { const int un = u0 + (k + 1 < nu ? k + 1 : k) * ustride;
#pragma unroll
              for (int ks = 0; ks < 4; ++ks) aq[ks] = ld8(Qb + (size_t)un * 16 * 2048 + p * 128 + 32 * ks); }
#pragma unroll
            for (int r = 0; r < NR; ++r) {
                ICSWAP(s[r][0], s[r][1]) ICSWAP(s[r][2], s[r][3]) ICSWAP(s[r][4], s[r][5]) ICSWAP(s[r][6], s[r][7])
                ICSWAP(s[r][0], s[r][2]) ICSWAP(s[r][1], s[r][3]) ICSWAP(s[r][4], s[r][6]) ICSWAP(s[r][5], s[r][7])
                ICSWAP(s[r][1], s[r][2]) ICSWAP(s[r][5], s[r][6]) ICSWAP(s[r][0], s[r][4]) ICSWAP(s[r][3], s[r][7])
                ICSWAP(s[r][1], s[r][5]) ICSWAP(s[r][2], s[r][6]) ICSWAP(s[r][1], s[r][4]) ICSWAP(s[r][3], s[r][6])
                ICSWAP(s[r][2], s[r][4]) ICSWAP(s[r][3], s[r][5]) ICSWAP(s[r][3], s[r][4]) }
            int mine[NR];
#pragma unroll
            for (int r = 0; r < NR; ++r) mine[r] = IKEY_MIN;
#pragma unroll 1
            for (int rd = 0; rd < 16; ++rd) {
                const bool me = fr == rd;
#pragma unroll
                for (int r = 0; r < NR; ++r) {
                    const int mx = row_imax16(s[r][0]);
                    const bool pop = s[r][0] == mx;
#pragma unroll
                    for (int i = 0; i < 7; ++i) s[r][i] = pop ? s[r][i + 1] : s[r][i];
                    s[r][7] = pop ? IKEY_MIN : s[r][7];
                    mine[r] = me ? mx : mine[r];
                }
            }
#pragma unroll
            for (int r = 0; r < NR; ++r) topl[((4 * fq + (NR == 4 ? r : rq)) * 2 + p) * 16 + fr] = mine[r];
        }
    }
    LDS_WAIT();
#pragma unroll 1
    for (int k = 0; k < nu; ++k) {
    LAS int* topl = toplw + k * 512;
    const int r0 = (u0 + k * ustride) * 16;
    int c[NR][4];
#pragma unroll
    for (int r = 0; r < NR; ++r) { const int tk = 4 * fq + (NR == 4 ? r : rq);
#pragma unroll
        for (int m = 0; m < 4; ++m) { const int kc = fr + 16 * m; int cv = IKEY_MIN;
            if (kc < 50) { const int i = tab[kc], j = tab[64 + kc]; const float s1 = u2f(f2u(fkey_inv(topl[(tk * 2 + 0) * 16 + i])) & ~127u), s2 = u2f(f2u(fkey_inv(topl[(tk * 2 + 1) * 16 + j])) & ~127u);
                cv = fkey(u2f((f2u(s1 + s2) & ~63u) | (unsigned)kc)); }
            c[r][m] = cv; }
        ICSWAP(c[r][0], c[r][1]) ICSWAP(c[r][2], c[r][3]) ICSWAP(c[r][0], c[r][2]) ICSWAP(c[r][1], c[r][3]) ICSWAP(c[r][1], c[r][2]) }
    int minec[NR];
#pragma unroll
    for (int r = 0; r < NR; ++r) minec[r] = IKEY_MIN;
#pragma unroll 1
    for (int rd = 0; rd < 16; ++rd) {
        const bool me = fr == rd;
#pragma unroll
        for (int r = 0; r < NR; ++r) {
            const int mx = row_imax16(c[r][0]);
            const bool pop = c[r][0] == mx;
            c[r][0] = pop ? c[r][1] : c[r][0]; c[r][1] = pop ? c[r][2] : c[r][1]; c[r][2] = pop ? c[r][3] : c[r][2]; c[r][3] = pop ? IKEY_MIN : c[r][3];
            minec[r] = me ? mx : minec[r];
        }
    }
#pragma unroll
    for (int r = 0; r < NR; ++r) wins[(4 * fq + (NR == 4 ? r : rq)) * 16 + fr] = fkey_inv(minec[r]);
    LDS_WAIT();
    if (NR == 4 || (fr >> 2) == rq) {
        const int tk = 4 * fq + (fr >> 2), q4 = fr & 3;
        const float w0 = wins[tk * 16]; float den = 0.f;
#pragma unroll
        for (int rd = 0; rd < 16; ++rd) den += __expf(wins[tk * 16 + rd] - w0);
        const float inv = 1.f / den;
        int e[4]; float g[4];
#pragma unroll
        for (int x = 0; x < 4; ++x) { const float wv = wins[tk * 16 + 4 * q4 + x]; const int kc = (int)(f2u(wv) & 63u); const int i = tab[kc], j = tab[64 + kc];
            e[x] = (int)(f2u(fkey_inv(topl[(tk * 2 + 0) * 16 + i])) & 127u) * 128 + (int)(f2u(fkey_inv(topl[(tk * 2 + 1) * 16 + j])) & 127u); g[x] = __expf(wv - w0) * inv; }
        unsigned short* pei = WSP(unsigned short, WS_PEI) + (size_t)(r0 + tk) * 128 + w * 16 + 4 * q4; float* peg = WSP(float, WS_PEG) + (size_t)(r0 + tk) * 128 + w * 16 + 4 * q4;
        *(v2u*)pei = (v2u){(unsigned)e[0] | ((unsigned)e[1] << 16), (unsigned)e[2] | ((unsigned)e[3] << 16)};
        *(f32x4*)peg = (f32x4){g[0], g[1], g[2], g[3]};
    }
    LDS_WAIT();
    }
}
__device__ __forceinline__ void p8_phase(Frame& F, int layer) {
    p8_init_tab(F);
    for (int ub = F.bid; ub < MP / 16; ub += F.G * P8_MAXU) { const int left = (MP / 16 - ub + F.G - 1) / F.G; p8_run<4>(F, layer, F.wave, 0, ub, F.G, left < P8_MAXU ? left : P8_MAXU); }
    for (int qu = F.bid * 8 + F.wave; qu < (MS / 16) * 8 * 4 * 8; qu += F.G * 8) { if ((qu & 7) == 0) { const int x = qu >> 3; p8_run<1>(F, layer, (x >> 2) & 7, x & 3, MP / 16 + (x >> 5), 0, 1); } }
}

constexpr size_t PE_SLICE_BYTES = (size_t)NEXP * 128;
__device__ __forceinline__ f32x2 p9_cvt(unsigned w, bool hi) { return hi ? __builtin_amdgcn_cvt_pk_f32_fp8((int)w, true) : __builtin_amdgcn_cvt_pk_f32_fp8((int)w, false); }
__device__ __forceinline__ f32x2 fma2(f32x2 a, f32x2 b, f32x2 c) { return __builtin_elementwise_fma(a, b, c); }
__device__ __forceinline__ float p9_dot16(const v4u u, const f32x2 (&h)[8]) {
    f32x2 a = {0.f, 0.f}, b = {0.f, 0.f};
    a = fma2(p9_cvt(u.x, false), h[0], a); b = fma2(p9_cvt(u.x, true), h[1], b); a = fma2(p9_cvt(u.y, false), h[2], a); b = fma2(p9_cvt(u.y, true), h[3], b);
    a = fma2(p9_cvt(u.z, false), h[4], a); b = fma2(p9_cvt(u.z, true), h[5], b); a = fma2(p9_cvt(u.w, false), h[6], a); b = fma2(p9_cvt(u.w, true), h[7], b);
    a = a + b; return a.x + a.y;
}
__device__ __forceinline__ void p9_axpy16(const v4u v, float c, f32x2 (&o)[8]) {
    const f32x2 cc = {c, c};
    o[0] = fma2(p9_cvt(v.x, false), cc, o[0]); o[1] = fma2(p9_cvt(v.x, true), cc, o[1]); o[2] = fma2(p9_cvt(v.y, false), cc, o[2]); o[3] = fma2(p9_cvt(v.y, true), cc, o[3]);
    o[4] = fma2(p9_cvt(v.z, false), cc, o[4]); o[5] = fma2(p9_cvt(v.z, true), cc, o[5]); o[6] = fma2(p9_cvt(v.w, false), cc, o[6]); o[7] = fma2(p9_cvt(v.w, true), cc, o[7]);
}
#define P9_GATHER(S, iw) do { _Pragma("unroll") for (int j_ = 0; j_ < 8; ++j_) { const unsigned w_ = (iw)[j_ >> 1]; const unsigned id_ = (j_ & 1) ? (w_ >> 16) : (w_ & 0xffffu); \
        S[j_] = *(const v4u*)(tab + ((id_ << 7) + sub16)); } } while (0)
__device__ __forceinline__ float swapsum16(float x, float y) { unsigned a = __builtin_bit_cast(unsigned, x), b = __builtin_bit_cast(unsigned, y); PSWAP16(a, b); return __builtin_bit_cast(float, a) + __builtin_bit_cast(float, b); }
__device__ __forceinline__ float swapsum32(float x, float y) { unsigned a = __builtin_bit_cast(unsigned, x), b = __builtin_bit_cast(unsigned, y); PSWAP32(a, b); return __builtin_bit_cast(float, a) + __builtin_bit_cast(float, b); }

__device__ __forceinline__ int p9_idot16(const v4u u, const v4u h) {
    int a = __builtin_amdgcn_sdot4((int)u.x, (int)h.x, 0, false); a = __builtin_amdgcn_sdot4((int)u.y, (int)h.y, a, false);
    a = __builtin_amdgcn_sdot4((int)u.z, (int)h.z, a, false); return __builtin_amdgcn_sdot4((int)u.w, (int)h.w, a, false);
}
__device__ __forceinline__ void p9u_wave(Frame& F, int layer, int slice, int first, int stride) {
    int lane_ = F.lane; asm volatile("" : "+v"(lane_));
    const int lane = lane_, gi = lane >> 3, sub = lane & 7;
    const unsigned char* tab = WSP(unsigned char, WS_PU) + (size_t)(layer * 8 + slice) * PE_SLICE_BYTES;
    const unsigned sub16 = (unsigned)sub * 16u;
    const unsigned char* hbase = WSP(unsigned char, WS_XN8) + slice * 128 + sub * 16;
    const unsigned char* ibase = (const unsigned char*)(WSP(unsigned short, WS_PEI) + gi * 16);
    const float* hsb = WSP(float, WS_HS);
    unsigned* pa = WSP(unsigned, WS_PA) + slice * 64 + lane;
    int t = first; if (t >= MTOK) return;
    v4u ia, ib, hq, nia, nib, nhq, A[8], B[8]; float hs, nhs;
#define P9U_META(tt, xa, xb, yq, ys) do { const v4u* ip_ = (const v4u*)(ibase + (size_t)(tt) * 256); xa = ip_[0]; xb = ip_[1]; yq = *(const v4u*)(hbase + (size_t)(tt) * 1024); ys = hsb[(tt)]; } while (0)
    P9U_META(t, ia, ib, hq, hs);
    P9_GATHER(A, ia);
    const bool b0 = sub & 1, b1 = sub & 2, b2 = sub & 4;
#pragma unroll 1
    for (;;) {
        const int tn = t + stride; const bool more = tn < MTOK; const int tl = more ? tn : t;
        P9U_META(tl, nia, nib, nhq, nhs);
        P9_GATHER(B, ib);
        int p[16];
#pragma unroll
        for (int j = 0; j < 8; ++j) p[j] = p9_idot16(A[j], hq);
        P9_GATHER(A, nia);
#pragma unroll
        for (int j = 0; j < 8; ++j) p[8 + j] = p9_idot16(B[j], hq);
        int q[8], r[4], sv[2];
#pragma unroll
        for (int i = 0; i < 8; ++i) { const int keep = b2 ? p[8 + i] : p[i], send = b2 ? p[i] : p[8 + i]; q[i] = keep + dpp_i<DPP_HMIR>(send); }
#pragma unroll
        for (int i = 0; i < 4; ++i) { const int keep = b0 ? q[2 * i + 1] : q[2 * i], send = b0 ? q[2 * i] : q[2 * i + 1]; r[i] = keep + dpp_i<DPP_XOR1>(send); }
#pragma unroll
        for (int i = 0; i < 2; ++i) { const int keep = b1 ? r[2 * i + 1] : r[2 * i], send = b1 ? r[2 * i] : r[2 * i + 1]; sv[i] = keep + dpp_i<DPP_XOR2>(send); }
        const float sc = hs * (1.f / 19.f);
        pa[(size_t)t * 512] = pk2((float)sv[0] * sc, (float)sv[1] * sc);
        if (!more) break;
        t = tn; ia = nia; ib = nib; hq = nhq; hs = nhs;
    }
#undef P9U_META
}

__device__ __forceinline__ void p9v_wave(Frame& F, int layer, int slice, int first, int stride, int mode) {
    int lane_ = F.lane; asm volatile("" : "+v"(lane_));
    const int lane = lane_, gi = lane >> 3, sub = lane & 7, j0 = 8 * (sub >> 2) + (sub & 3);
    const unsigned char* tab = WSP(unsigned char, WS_PV) + (size_t)(layer * 8 + slice) * PE_SLICE_BYTES;
    const unsigned sub16 = (unsigned)sub * 16u;
    const unsigned char* ibase = (const unsigned char*)(WSP(unsigned short, WS_PEI) + gi * 16);
    const unsigned* pab = WSP(unsigned, WS_PA) + lane;
    const float* pegb = WSP(float, WS_PEG) + gi * 16 + j0;
    const int eoff = slice * 128 + sub * 16 + gi;
    float* xsb = WSP(float, WS_XS) + eoff;
    int t = first; if (t >= MTOK) return;
    v4u ia, ib, nia, nib, A[8], B[8];
    unsigned pw[8], npw[8]; float g0, g1, ng0, ng1, x0, x1, nx0, nx1;
#define P9V_META(tt, xa, xb, pp, ga, gb, ya, yb) do { const v4u* ip_ = (const v4u*)(ibase + (size_t)(tt) * 256); xa = ip_[0]; xb = ip_[1]; \
        _Pragma("unroll") for (int x_ = 0; x_ < 8; ++x_) pp[x_] = pab[(size_t)(tt) * 512 + x_ * 64]; \
        ga = pegb[(size_t)(tt) * 128]; gb = pegb[(size_t)(tt) * 128 + 4]; ya = xsb[(size_t)(tt) * DM]; yb = xsb[(size_t)(tt) * DM + 8]; } while (0)
    P9V_META(t, ia, ib, pw, g0, g1, x0, x1);
    P9_GATHER(A, ia);
#pragma unroll 1
    for (;;) {
        const int tn = t + stride; const bool more = tn < MTOK; const int tl = more ? tn : t;
        P9V_META(tl, nia, nib, npw, ng0, ng1, nx0, nx1);
        P9_GATHER(B, ib);
        float alo = 0.f, ahi = 0.f;
#pragma unroll
        for (int x = 0; x < 8; ++x) { alo += bflo(pw[x]); ahi += bfhi(pw[x]); }
        const float c0 = gelu_tanh(alo * 0.03125f) * g0 * 0.0625f, c1 = gelu_tanh(ahi * 0.03125f) * g1 * 0.0625f;
        f32x2 o[8];
#pragma unroll
        for (int i = 0; i < 8; ++i) o[i] = (f32x2){0.f, 0.f};
#define P9V_C(j) __builtin_bit_cast(float, __builtin_amdgcn_ds_swizzle(__builtin_bit_cast(int, (((j) >> 2) & 1) ? c1 : c0), ((4 * ((j) >> 3) + ((j) & 3)) << 5) | 0x18))
        { const float cj[8] = {P9V_C(0), P9V_C(1), P9V_C(2), P9V_C(3), P9V_C(4), P9V_C(5), P9V_C(6), P9V_C(7)};
#pragma unroll
          for (int j = 0; j < 8; ++j) p9_axpy16(A[j], cj[j], o); }
        P9_GATHER(A, nia);
        { const float cj[8] = {P9V_C(8), P9V_C(9), P9V_C(10), P9V_C(11), P9V_C(12), P9V_C(13), P9V_C(14), P9V_C(15)};
#pragma unroll
          for (int j = 0; j < 8; ++j) p9_axpy16(B[j], cj[j], o); }
#undef P9V_C
        const bool g0b = lane & 8;
        float q[8], r[4], sv[2];
#pragma unroll
        for (int i = 0; i < 8; ++i) { const float keep = g0b ? o[i].y : o[i].x, send = g0b ? o[i].x : o[i].y; q[i] = keep + dpp_f<DPP_ROR8>(send); }
#pragma unroll
        for (int i = 0; i < 4; ++i) r[i] = swapsum16(q[2 * i], q[2 * i + 1]);
#pragma unroll
        for (int i = 0; i < 2; ++i) sv[i] = swapsum32(r[2 * i], r[2 * i + 1]);
        const float y0 = x0 + sv[0], y1 = x1 + sv[1];
        if (mode == 0) {
            float* xs = xsb + (size_t)t * DM; xs[0] = y0; xs[8] = y1;
            bf16* xn = WSP(bf16, WS_XNA) + (size_t)t * DM + eoff; xn[0] = (bf16)f2bf(y0); xn[8] = (bf16)f2bf(y1);
            const float ss = wave_sum(y0 * y0 + y1 * y1);
            if (lane == 0) WSP(float, WS_SSQ)[(size_t)t * 8 + slice] = ss;
        } else {
            float* y = (t < MP ? F.out + O_YP + (size_t)t * DM : F.out + O_YS + (size_t)(t - MP) * DM) + eoff;
            y[0] = y0; y[8] = y1;
        }
        if (!more) break;
        t = tn; ia = nia; ib = nib; g0 = ng0; g1 = ng1; x0 = nx0; x1 = nx1;
#pragma unroll
        for (int x = 0; x < 8; ++x) pw[x] = npw[x];
    }
#undef P9V_META
}
#undef P9_GATHER

__device__ __forceinline__ void glds16_asm(const void* g, unsigned lds_base) {
    unsigned sv; asm volatile("s_mov_b32 %0, m0\n\ts_mov_b32 m0, %2\n\ts_nop 0\n\tglobal_load_lds_dwordx4 %1, off\n\ts_mov_b32 m0, %0" : "=&s"(sv) : "v"(g), "s"(lds_base) : "memory"); }
constexpr int PV_TILE = 16384, PV_CB = 8 * PV_TILE;
typedef short s16x4 __attribute__((ext_vector_type(4)));
struct P9M { v4u ia, ib; unsigned pw[8]; float g0, g1; f32x2 x; };
#define P9V2_ALD(dst, ptr, off) asm volatile("global_load_dword %0, %1, off offset:" #off : "=v"(dst) : "v"(ptr) : "memory")
#define P9V2_LAUNDER(M) "+v"(M.ia), "+v"(M.ib), "+v"(M.pw[0]), "+v"(M.pw[1]), "+v"(M.pw[2]), "+v"(M.pw[3]), "+v"(M.pw[4]), "+v"(M.pw[5]), "+v"(M.pw[6]), "+v"(M.pw[7]), "+v"(M.g0), "+v"(M.g1), "+v"(M.x)
__device__ __forceinline__ void p9v2_wave(Frame& F, int layer, int slice, int first, int stride, int mode) {
    int lane_ = F.lane; asm volatile("" : "+v"(lane_));
    const int lane = lane_, gi = lane >> 3, sub = lane & 7, j0 = 8 * (sub >> 2) + (sub & 3), fr = lane & 15, fq = lane >> 4;
    const unsigned char* tab = WSP(unsigned char, WS_PV) + (size_t)(layer * 8 + slice) * PE_SLICE_BYTES;
    const unsigned sub16 = (unsigned)sub * 16u;
    LAS unsigned char* Tu = F.lds + F.wave * PV_TILE;
    LAS unsigned char* Tl = Tu + (4 * fq + (fr >> 2)) * 128 + 8 * (fr & 3);
    LAS unsigned char* Cb = F.lds + PV_CB + F.wave * 128;
    const unsigned char* ibase = (const unsigned char*)(WSP(unsigned short, WS_PEI) + gi * 16);
    const unsigned* pab = WSP(unsigned, WS_PA) + lane;
    const float* pegb = WSP(float, WS_PEG) + gi * 16 + j0;
    const int eoff = slice * 128 + 32 * fq + 2 * fr;
    float* xsb = WSP(float, WS_XS) + eoff;
    int t = first; if (t >= MTOK) return;
    P9M C, N1, N2;
#define P9V2_META(M, tt) do { const unsigned char* ip_ = ibase + (size_t)(tt) * 256; const unsigned* pp_ = pab + (size_t)(tt) * 512; const float* gp_ = pegb + (size_t)(tt) * 128; const float* xp_ = xsb + (size_t)(tt) * DM; \
        asm volatile("global_load_dwordx4 %0, %1, off" : "=v"(M.ia) : "v"(ip_) : "memory"); asm volatile("global_load_dwordx4 %0, %1, off offset:16" : "=v"(M.ib) : "v"(ip_) : "memory"); \
        P9V2_ALD(M.pw[0], pp_, 0); P9V2_ALD(M.pw[1], pp_, 256); P9V2_ALD(M.pw[2], pp_, 512); P9V2_ALD(M.pw[3], pp_, 768); P9V2_ALD(M.pw[4], pp_, 1024); P9V2_ALD(M.pw[5], pp_, 1280); P9V2_ALD(M.pw[6], pp_, 1536); P9V2_ALD(M.pw[7], pp_, 1792); \
        P9V2_ALD(M.g0, gp_, 0); P9V2_ALD(M.g1, gp_, 16); asm volatile("global_load_dwordx2 %0, %1, off" : "=v"(M.x) : "v"(xp_) : "memory"); } while (0)
#define P9V2_DMA2(ks, M) do { const unsigned w_ = (ks) < 4 ? M.ia[(ks) & 3] : M.ib[(ks) & 3]; \
        glds16_asm(tab + (((w_ & 0xffffu) << 7) + sub16), tu + (unsigned)((2 * (ks)) * 1024)); glds16_asm(tab + (((w_ >> 16) << 7) + sub16), tu + (unsigned)((2 * (ks) + 1) * 1024)); } while (0)
#define P9V2_MM(ks) do { const unsigned cw_ = *(const LAS unsigned*)(Cb + 16 * (ks) + 4 * fq); \
        const long ae_ = __builtin_bit_cast(long, (v2u){__builtin_amdgcn_perm(0u, cw_, 0x0c010c00u), __builtin_amdgcn_perm(0u, cw_, 0x0c030c02u)}); \
        const long ao_ = __builtin_bit_cast(long, (v2u){__builtin_amdgcn_perm(0u, cw_, 0x010c000cu), __builtin_amdgcn_perm(0u, cw_, 0x030c020cu)}); \
        _Pragma("unroll") for (int nt_ = 0; nt_ < 4; ++nt_) { const long b_ = __builtin_bit_cast(long, __builtin_amdgcn_ds_read_tr16_b64_v4i16((LAS s16x4*)(Tl + (ks) * 2048 + nt_ * 32))); \
            acc_e[nt_] = __builtin_amdgcn_mfma_f32_16x16x32_fp8_fp8(ae_, b_, acc_e[nt_], 0, 0, 0); acc_o[nt_] = __builtin_amdgcn_mfma_f32_16x16x32_fp8_fp8(ao_, b_, acc_o[nt_], 0, 0, 0); } } while (0)
#define P9V2_STEP(ks, NXT) do { asm volatile("s_waitcnt vmcnt(27)" ::: "memory"); P9V2_MM(ks); asm volatile("s_waitcnt lgkmcnt(0)" ::: "memory"); P9V2_DMA2(ks, NXT); } while (0)
    const unsigned tu = __builtin_amdgcn_readfirstlane((unsigned)(size_t)Tu);
    bool more = false; int tn = 0;
#define P9V2_UNIT(CUR, NXT, NN) do { \
        tn = t + stride; more = tn < MTOK; const int t2_ = tn + stride < MTOK ? tn + stride : (more ? tn : t);        \
        P9V2_META(NN, t2_);                   \
        float alo_ = 0.f, ahi_ = 0.f; \
        _Pragma("unroll") for (int x_ = 0; x_ < 8; ++x_) { alo_ += bflo(CUR.pw[x_]); ahi_ += bfhi(CUR.pw[x_]); } \
        const float c0_ = gelu_tanh(alo_ * 0.03125f) * CUR.g0 * 0.0625f, c1_ = gelu_tanh(ahi_ * 0.03125f) * CUR.g1 * 0.0625f;        \
        { const int pk_ = __builtin_amdgcn_cvt_pk_fp8_f32(c0_ * 256.f, c1_ * 256.f, 0, false); Cb[8 * j0 + gi] = (unsigned char)(pk_ & 255); Cb[8 * (j0 + 4) + gi] = (unsigned char)((pk_ >> 8) & 255); } \
        f32x4 acc_e[4], acc_o[4]; \
        _Pragma("unroll") for (int i_ = 0; i_ < 4; ++i_) { acc_e[i_] = (f32x4){0.f, 0.f, 0.f, 0.f}; acc_o[i_] = (f32x4){0.f, 0.f, 0.f, 0.f}; } \
        asm volatile("s_waitcnt vmcnt(27)" : P9V2_LAUNDER(NXT) :: "memory");        \
        P9V2_MM(0); asm volatile("s_waitcnt lgkmcnt(0)" ::: "memory"); P9V2_DMA2(0, NXT); \
        P9V2_STEP(1, NXT); P9V2_STEP(2, NXT); P9V2_STEP(3, NXT); P9V2_STEP(4, NXT); P9V2_STEP(5, NXT); P9V2_STEP(6, NXT); P9V2_STEP(7, NXT); \
        const f32x4 se_ = fq == 0 ? acc_e[0] : fq == 1 ? acc_e[1] : fq == 2 ? acc_e[2] : acc_e[3], so_ = fq == 0 ? acc_o[0] : fq == 1 ? acc_o[1] : fq == 2 ? acc_o[2] : acc_o[3]; \
        const float y0_ = CUR.x.x + se_[0] * (1.f / 256.f), y1_ = CUR.x.y + so_[0] * (1.f / 256.f); \
        if (mode == 0) { \
            *(f32x2*)(xsb + (size_t)t * DM) = (f32x2){y0_, y1_}; \
            *(unsigned*)(WSP(bf16, WS_XNA) + (size_t)t * DM + eoff) = pk2(y0_, y1_); \
            const float ss_ = wave_sum(y0_ * y0_ + y1_ * y1_); \
            if (lane == 0) WSP(float, WS_SSQ)[(size_t)t * 8 + slice] = ss_; \
        } else { \
            float* y_ = (t < MP ? F.out + O_YP + (size_t)t * DM : F.out + O_YS + (size_t)(t - MP) * DM) + eoff; \
            *(f32x2*)y_ = (f32x2){y0_, y1_}; \
        } \
    } while (0)
    P9V2_META(C, t);
    { const int t1 = t + stride < MTOK ? t + stride : t; P9V2_META(N1, t1); }
    asm volatile("s_waitcnt vmcnt(13)" : P9V2_LAUNDER(C) :: "memory");
    P9V2_DMA2(0, C); P9V2_DMA2(1, C); P9V2_DMA2(2, C); P9V2_DMA2(3, C); P9V2_DMA2(4, C); P9V2_DMA2(5, C); P9V2_DMA2(6, C); P9V2_DMA2(7, C);
#pragma unroll 1
    for (;;) {
        P9V2_UNIT(C, N1, N2); if (!more) break; t = tn;
        P9V2_UNIT(N1, N2, C); if (!more) break; t = tn;
        P9V2_UNIT(N2, C, N1); if (!more) break; t = tn;
    }
    asm volatile("s_waitcnt vmcnt(0)" ::: "memory");
#undef P9V2_UNIT
#undef P9V2_STEP
#undef P9V2_MM
#undef P9V2_DMA2
#undef P9V2_META
}

constexpr float QSCALE = 0.125f * 1.4426950408889634f;
constexpr int PP_VT = 0;
__device__ __forceinline__ float rms64(float v) { return frsq(wave_sum(v * v) * (1.f / 64.f) + EPS); }

__device__ __forceinline__ void pp_q_row(Frame& F, int row, const bf16* kvq, const float qg) {
    const int lane = F.lane;
    bf16* qn = WSP(bf16, WS_QN) + (size_t)row * 1024;
#pragma unroll 4
    for (int hd = 0; hd < 16; ++hd) { const float v = bf2f(kvq[NKV + hd * 64 + lane]); qn[hd * 64 + lane] = (bf16)f2bf(v * rms64(v) * qg); }
    if (lane < 48) WSP(float, WS_GATES)[(size_t)row * 48 + lane] = sigmoid_f(bf2f(kvq[NKV + 1024 + lane]));
}
__device__ __forceinline__ f32x4 rms64x4(f32x4 v) { const float ss = row_sum16((v.x * v.x + v.y * v.y) + (v.z * v.z + v.w * v.w)); return v * (frsq(ss * (1.f / 64.f) + EPS)); }
__device__ __forceinline__ v2u pk4(f32x4 v) { return (v2u){pk2(v.x, v.y), pk2(v.z, v.w)}; }
__device__ __forceinline__ void pp_prompt_tile(Frame& F, int unit) {
    const int lane = F.lane, w = F.wave, b = unit >> 7, t0 = (unit & 127) * 64, g = lane >> 4, d4 = (lane & 15) * 4;
    LAS unsigned char* L = F.lds; asm volatile("" : "+v"(L));
    LAS bf16* vt = (LAS bf16*)(L + PP_VT);
    const f32x4 kg1 = *(const f32x4*)(FIN(16) + 64 + d4), kg2 = *(const f32x4*)(FIN(16) + 128 + d4), qg = *(const f32x4*)(FIN(22) + d4) * QSCALE;
    v2u nv[6], nq[4], ngl;
#define PP_FETCH(rr_) do { const int row_ = b * PT + t0 + 8 * w + ((rr_) < 8 ? (rr_) : 7); const v2u* kvq_ = (const v2u*)(WSP(bf16, WS_KVQ) + (size_t)row_ * NKVQ) + lane;        \
        _Pragma("unroll") for (int sidx_ = 0; sidx_ < 6; ++sidx_) nv[sidx_] = kvq_[64 * sidx_]; \
        _Pragma("unroll") for (int i_ = 0; i_ < 4; ++i_) nq[i_] = kvq_[64 * (6 + i_)]; \
        ngl = ((const v2u*)(WSP(bf16, WS_KVQ) + (size_t)row_ * NKVQ))[640 + (lane & 15)]; } while (0)
    PP_FETCH(0);
#pragma unroll 1
    for (int rr = 0; rr < 8; ++rr) {
        const int tl = 8 * w + rr, t = t0 + tl, row = b * PT + t;
        f32x4 v[6], q[4]; const f32x4 gl = {bflo(ngl.x), bfhi(ngl.x), bflo(ngl.y), bfhi(ngl.y)};
#pragma unroll
        for (int sidx = 0; sidx < 6; ++sidx) v[sidx] = (f32x4){bflo(nv[sidx].x), bfhi(nv[sidx].x), bflo(nv[sidx].y), bfhi(nv[sidx].y)};
#pragma unroll
        for (int i = 0; i < 4; ++i) q[i] = (f32x4){bflo(nq[i].x), bfhi(nq[i].x), bflo(nq[i].y), bfhi(nq[i].y)};
        PP_FETCH(rr + 1);
        const f32x4 ks = rms64x4(v[2]) * kg1, kw = rms64x4(v[4]) * kg2;
        f32x4* okv = (f32x4*)(F.out + O_KVP + (size_t)row * 1024) + lane;
        okv[0] = v[0]; okv[64] = v[1]; okv[128] = ks; okv[192] = v[3];
        if (t >= PT - WINDOW) { f32x4* owin = (f32x4*)(F.out + O_WINP + ((size_t)b * 512 + (t - (PT - WINDOW))) * 512) + lane; owin[0] = kw; owin[64] = v[5]; }
        const size_t kidx = (((size_t)b * NG + g) * PT + t) * 64 + d4;
        *(v2u*)(WSP(bf16, WS_KSEL) + kidx) = pk4(ks); *(v2u*)(WSP(bf16, WS_KWIN) + kidx) = pk4(kw);
#pragma unroll
        for (int j = 0; j < 4; ++j) { vt[((0 * 4 + g) * 64 + d4 + j) * 72 + tl] = (bf16)f2bf(v[3][j]); vt[((1 * 4 + g) * 64 + d4 + j) * 72 + tl] = (bf16)f2bf(v[5][j]); }
        bf16* qn = WSP(bf16, WS_QN) + (size_t)row * 1024 + g * 64 + d4;
#pragma unroll
        for (int i = 0; i < 4; ++i) *(v2u*)(qn + i * 256) = pk4(rms64x4(q[i]) * qg);
        if (lane < 12) *(f32x4*)(WSP(float, WS_GATES) + (size_t)row * 48 + 4 * lane) = (f32x4){sigmoid_f(gl.x), sigmoid_f(gl.y), sigmoid_f(gl.z), sigmoid_f(gl.w)};
    }
#undef PP_FETCH
    __syncthreads();
    {
        const int which = F.tid >> 8, gd = F.tid & 255;
        bf16* dst = WSP(bf16, which == 0 ? WS_VSELT : WS_VWINT) + (((size_t)b * NG * 64 + gd) * PT + t0);
        const LAS bf16* src = vt + ((which * 256 + gd) * 72);
#pragma unroll
        for (int i = 0; i < 8; ++i) *(v4u*)(dst + 8 * i) = *(const LAS v4u*)(src + 8 * i);
    }
    __syncthreads();
}
__device__ __forceinline__ void pp_sample_row(Frame& F, int sr, int part = -1) {
    const int lane = F.lane, bs = sr >> 2, i = sr & 3, row = MP + sr;
    const float kg1 = FIN(16)[64 + lane], kg2 = FIN(16)[128 + lane], qg = FIN(22)[lane] * QSCALE;
    const bf16* kvq = WSP(bf16, WS_KVQ) + (size_t)row * NKVQ;
    float* okv = F.out + O_KVS + (size_t)sr * 1024;
    float* owin = F.out + O_WINS + ((size_t)bs * 512 + 508 + i) * 512;
#pragma unroll
    for (int g = 0; g < 4; ++g) { if (part >= 0 && part != g) continue;
        const float v0 = bf2f(kvq[0 * 256 + g * 64 + lane]), v1 = bf2f(kvq[1 * 256 + g * 64 + lane]), v2 = bf2f(kvq[2 * 256 + g * 64 + lane]);
        const float v3 = bf2f(kvq[3 * 256 + g * 64 + lane]), v4 = bf2f(kvq[4 * 256 + g * 64 + lane]), v5 = bf2f(kvq[5 * 256 + g * 64 + lane]);
        const float ks = v2 * rms64(v2) * kg1, kw = v4 * rms64(v4) * kg2;
        okv[0 * 256 + g * 64 + lane] = v0; okv[1 * 256 + g * 64 + lane] = v1; okv[2 * 256 + g * 64 + lane] = ks; okv[3 * 256 + g * 64 + lane] = v3;
        owin[g * 64 + lane] = kw; owin[256 + g * 64 + lane] = v5;
        const size_t bg = (size_t)bs * NG + g;
        WSP(bf16, WS_SKWIN)[(bg * 544 + 512 + i) * 64 + lane] = (bf16)f2bf(kw);
        WSP(bf16, WS_SVWINT)[(bg * 64 + lane) * 544 + 512 + i] = (bf16)f2bf(v5);
        float* sn = WSP(float, WS_SNEW) + (((size_t)bs * 4 + i) * 2) * 256 + g * 64 + lane;
        sn[0] = ks; sn[256] = v3;
    }
    bf16* qn = WSP(bf16, WS_QN) + (size_t)row * 1024;
#pragma unroll 4
    for (int hd = 0; hd < 16; ++hd) { if (part >= 0 && (hd >> 2) != part - 4) continue; const float v = bf2f(kvq[NKV + hd * 64 + lane]); qn[hd * 64 + lane] = (bf16)f2bf(v * rms64(v) * qg); }
    if ((part < 0 || part == 7) && lane < 48) WSP(float, WS_GATES)[(size_t)row * 48 + lane] = sigmoid_f(bf2f(kvq[NKV + 1024 + lane]));
}

struct RowPPrompt { static constexpr bool BF = true; const bf16* base; __device__ __forceinline__ const bf16* operator()(int t) const { return base + (size_t)t * NKVQ; } };
struct RowPSample { static constexpr bool BF = false; const float* cache; const int* pt; __device__ __forceinline__ const float* operator()(int t) const { return cache + ((size_t)pt[t >> 7] * PAGE + (t & 127)) * 1024; } };
template <class RowP> __device__ __forceinline__ bf16x8 rowp_frag(const RowP& rowp, int t, int off) {
    if constexpr (RowP::BF) return ld8(rowp(t) + off);
    else { const float* rp = rowp(t) + off; return cvt8(*(const f32x4*)rp, *(const f32x4*)(rp + 4)); }
}
__device__ __forceinline__ void compress_finish(Frame& F, const f32x4 (&acc)[4], int kv, int blk, bf16* KC, bf16* VCT) {
    const int lane = F.lane, fr = lane & 15, fq = lane >> 4;
    const float* pet = WSP(float, WS_PETERM) + kv * 64;
    bf16x8 hb[2];
#pragma unroll
    for (int s = 0; s < 2; ++s) { f32x4 h0, h1;
#pragma unroll
        for (int r = 0; r < 4; ++r) { h0[r] = gelu_tanh(acc[2 * s][r] + pet[16 * (2 * s) + 4 * fq + r]); h1[r] = gelu_tanh(acc[2 * s + 1][r] + pet[16 * (2 * s + 1) + 4 * fq + r]); }
        hb[s] = cvt8(h0, h1); }
    const bf16* w2f = WSP(bf16, WS_W2F) + (size_t)kv * 4096 + lane * 8;
    f32x4 o[4];
#pragma unroll
    for (int dt = 0; dt < 4; ++dt) { o[dt] = (f32x4){0.f, 0.f, 0.f, 0.f};
#pragma unroll
        for (int s = 0; s < 2; ++s) o[dt] = MFMA16(ld8(w2f + (dt * 2 + s) * 512), hb[s], o[dt]); }
    if (kv == 0) {
        float ss = 0.f;
#pragma unroll
        for (int dt = 0; dt < 4; ++dt) ss += (o[dt][0] * o[dt][0] + o[dt][1] * o[dt][1]) + (o[dt][2] * o[dt][2] + o[dt][3] * o[dt][3]);
        ss = x32_sum(x16_sum(ss));
        const float rstd = frsq(ss * (1.f / 64.f) + EPS);
        const float* kg0 = FIN(16);
        if (blk < NCMP) {
#pragma unroll
            for (int dt = 0; dt < 4; ++dt) { const int d = 16 * dt + 4 * fq; v2u ov; ov.x = pk2(o[dt][0] * rstd * kg0[d], o[dt][1] * rstd * kg0[d + 1]); ov.y = pk2(o[dt][2] * rstd * kg0[d + 2], o[dt][3] * rstd * kg0[d + 3]);
                *(v2u*)(KC + (size_t)blk * 64 + d) = ov; }
        } else {
#pragma unroll
            for (int dt = 0; dt < 4; ++dt) *(v2u*)(KC + (size_t)blk * 64 + 16 * dt + 4 * fq) = (v2u){0u, 0u};
        }
    } else {
#pragma unroll
        for (int dt = 0; dt < 4; ++dt)
#pragma unroll
            for (int r = 0; r < 4; ++r) VCT[(size_t)(16 * dt + 4 * fq + r) * 512 + blk] = (blk < NCMP) ? (bf16)f2bf(o[dt][r]) : (bf16)0;
    }
}

template <class RowP>
__device__ __forceinline__ void compress_part(Frame& F, const RowP& rowp, int kv, int j, int r_lo, int r_hi, f32x4 (&acc)[4]) {
    const int lane = F.lane, fr = lane & 15, fq = lane >> 4;
    const bf16* W1 = WSP(bf16, WS_W1T) + (size_t)kv * 64 * 2048 + (size_t)fr * 2048 + 8 * fq;
    const int blk = 16 * j + fr;
#pragma unroll
    for (int mt = 0; mt < 4; ++mt) acc[mt] = (f32x4){0.f, 0.f, 0.f, 0.f};
#pragma unroll 2
    for (int r = r_lo; r < r_hi; ++r) {
        int t = 16 * blk + r; t = t < PAST ? t : PAST - 1;
#pragma unroll
        for (int hf = 0; hf < 2; ++hf) {
            const bf16x8 bfrag = rowp_frag(rowp, t, 8 * fq + 32 * hf);
            const int ks = 2 * r + hf;
#pragma unroll
            for (int mt = 0; mt < 4; ++mt) acc[mt] = MFMA16(ld8(W1 + (size_t)mt * 16 * 2048 + 32 * ks), bfrag, acc[mt]);
        }
    }
}
template <class RowP>
__device__ __forceinline__ void compress_tile(Frame& F, const RowP& rowp, int kv, int j, bf16* KC, bf16* VCT) {
    const int lane = F.lane, fr = lane & 15, fq = lane >> 4;
    const bf16* W1 = WSP(bf16, WS_W1T) + (size_t)kv * 64 * 2048 + (size_t)fr * 2048 + 8 * fq;
    const int blk = 16 * j + fr;
    f32x4 acc[4];
#pragma unroll
    for (int mt = 0; mt < 4; ++mt) acc[mt] = (f32x4){0.f, 0.f, 0.f, 0.f};
#pragma unroll 2
    for (int r = 0; r < 32; ++r) {
        int t = 16 * blk + r; t = t < PAST ? t : PAST - 1;
#pragma unroll
        for (int hf = 0; hf < 2; ++hf) {
            const bf16x8 bfrag = rowp_frag(rowp, t, 8 * fq + 32 * hf);
            const int ks = 2 * r + hf;
#pragma unroll
            for (int mt = 0; mt < 4; ++mt) acc[mt] = MFMA16(ld8(W1 + (size_t)mt * 16 * 2048 + 32 * ks), bfrag, acc[mt]);
        }
    }
    compress_finish(F, acc, kv, blk, KC, VCT);
}


__device__ __forceinline__ void compress_prompt(Frame& F, int id) {
    const int kv = id & 1, j = (id >> 1) & 31, bg = id >> 6, b = bg >> 2, g = bg & 3;
    RowPPrompt rp{WSP(bf16, WS_KVQ) + (size_t)b * PT * NKVQ + kv * 256 + g * 64};
    compress_tile(F, rp, kv, j, WSP(bf16, WS_KCMP) + (size_t)bg * 512 * 64, WSP(bf16, WS_VCMPT) + (size_t)bg * 64 * 512);
}
constexpr int CP_PART = 81920;
__device__ __forceinline__ void compress_prompt_split(Frame& F, int id) {
    const int kv = id & 1, j = (id >> 1) & 31, bg = id >> 6, b = bg >> 2, g = bg & 3, q = F.wave & 3, lane = F.lane;
    RowPPrompt rp{WSP(bf16, WS_KVQ) + (size_t)b * PT * NKVQ + kv * 256 + g * 64};
    f32x4 acc[4];
    compress_part(F, rp, kv, j, 8 * q, 8 * q + 8, acc);
    LAS f32x4* part = (LAS f32x4*)(F.lds + CP_PART) + (F.wave >> 2) * 1024;
#pragma unroll
    for (int mt = 0; mt < 4; ++mt) part[(q * 4 + mt) * 64 + lane] = acc[mt];
    __syncthreads();
    if (q == 0) {
#pragma unroll
        for (int mt = 0; mt < 4; ++mt) acc[mt] = (part[(0 * 4 + mt) * 64 + lane] + part[(1 * 4 + mt) * 64 + lane]) + (part[(2 * 4 + mt) * 64 + lane] + part[(3 * 4 + mt) * 64 + lane]);
        compress_finish(F, acc, kv, 16 * j + (lane & 15), WSP(bf16, WS_KCMP) + (size_t)bg * 512 * 64, WSP(bf16, WS_VCMPT) + (size_t)bg * 64 * 512);
    }
    __syncthreads();
}
__device__ __forceinline__ void compress_sample(Frame& F, int id) {
    const int kv = id & 1, j = (id >> 1) & 31, bg = id >> 6, lane = F.lane, fr = lane & 15, fq = lane >> 4;
    const int blk = 16 * j + fr, nb = blk < 511 ? blk + 1 : 511;
    const bf16* f1 = WSP(bf16, WS_FS) + ((size_t)bg * 512 + blk) * 256 + kv * 128 + 4 * fq;
    const bf16* f2 = WSP(bf16, WS_FS) + ((size_t)bg * 512 + nb) * 256 + kv * 128 + 64 + 4 * fq;
    f32x4 acc[4];
#pragma unroll
    for (int mt = 0; mt < 4; ++mt) { const v2u a = *(const v2u*)(f1 + 16 * mt), b = *(const v2u*)(f2 + 16 * mt);
        acc[mt] = (f32x4){bflo(a.x) + bflo(b.x), bfhi(a.x) + bfhi(b.x), bflo(a.y) + bflo(b.y), bfhi(a.y) + bfhi(b.y)}; }
    compress_finish(F, acc, kv, blk, WSP(bf16, WS_SKCMP) + (size_t)bg * 512 * 64, WSP(bf16, WS_SVCMPT) + (size_t)bg * 64 * 512);
}

constexpr int NSA_IMP = 0;
constexpr int NSA_Q = 67584;
constexpr int NSA_QLD = 68;
constexpr float LOG2E = 1.4426950408889634f;
#ifndef NSA_SUBUNITS
#define NSA_SUBUNITS 0
#endif
__device__ __forceinline__ float ex2(float x) { return __builtin_amdgcn_exp2f(x); }

struct KvBf16 {
    const bf16* K; const bf16* VT; int ld;
    __device__ __forceinline__ void lane_offsets(int fr, int fq, unsigned& ko, unsigned& vo) const {
        ko = (unsigned)(((8 * (fr >> 2) + (fr & 3)) * 64 + 8 * fq) * 2); vo = (unsigned)((fr * ld + 8 * fq) * 2);
        asm volatile("" : "+v"(ko), "+v"(vo));
    }
    __device__ __forceinline__ bf16x8 kf(int key0, int mt, int ks, unsigned ko) const {
        return *(const bf16x8*)((const char*)K + (size_t)key0 * 128 + (ko + (unsigned)((4 * mt * 64 + 32 * ks) * 2))); }
    __device__ __forceinline__ bf16x8 vf(int key0, int dt, unsigned vo) const {
        return *(const bf16x8*)((const char*)VT + (size_t)key0 * 2 + (vo + (unsigned)(16 * dt * ld * 2))); }
};
struct KvSampleSel {
    const float* cache; const int* pt; const float* snew; int g;
    __device__ __forceinline__ const float* krow(int pos, int slot) const {
        if (pos < PAST) return cache + ((size_t)pt[pos >> 7] * PAGE + (pos & 127)) * 1024 + slot * 256;
        int i = pos - PAST; i = i < 3 ? i : 3; return snew + (size_t)i * 512 + (slot - 2) * 256; }
    __device__ __forceinline__ void lane_offsets(int fr, int fq, unsigned& ko, unsigned& vo) const { ko = (unsigned)(fr | (fq << 8)); vo = ko; asm volatile("" : "+v"(ko), "+v"(vo)); }
    __device__ __forceinline__ bf16x8 kf(int key0, int mt, int ks, unsigned ko) const { const int fr = ko & 255, fq = ko >> 8;
        const float* p = krow(key0 + 8 * (fr >> 2) + 4 * mt + (fr & 3), 2) + 32 * ks + 8 * fq; return cvt8(*(const f32x4*)p, *(const f32x4*)(p + 4)); }
    __device__ __forceinline__ bf16x8 vf(int key0, int dt, unsigned vo) const { const int fr = vo & 255, fq = vo >> 8; f32x4 a, b;
#pragma unroll
        for (int j = 0; j < 4; ++j) { a[j] = krow(key0 + 8 * fq + j, 3)[16 * dt + fr]; b[j] = krow(key0 + 8 * fq + 4 + j, 3)[16 * dt + fr]; }
        return cvt8(a, b); }
};
struct KvFrags { bf16x8 k[2][2]; bf16x8 v[4]; };
template <bool WITHV, class KV>
__device__ __forceinline__ void nsa_load(const KV& kv, int key0, int fr, int fq, KvFrags& f) {
    unsigned ko, vo; kv.lane_offsets(fr, fq, ko, vo);
#pragma unroll
    for (int mt = 0; mt < 2; ++mt)
#pragma unroll
        for (int ks = 0; ks < 2; ++ks) f.k[mt][ks] = kv.kf(key0, mt, ks, ko);
    if (WITHV) {
#pragma unroll
        for (int dt = 0; dt < 4; ++dt) f.v[dt] = kv.vf(key0, dt, vo);
    }
}

template <int NT, int MODE, bool QREG = false>
__device__ __forceinline__ void nsa_core(const KvFrags& f, int key0, const LAS bf16* qrow, int qnt, f32x4 (&O)[NT][4], float (&m)[NT], float (&l)[NT], const float (&invl)[NT], const float (&slope)[NT],
                                         int t, int pmul, int padd, int wlim, bool selok, LAS float* improw, int fq, const bf16x8* qreg = nullptr) {
    float dist[2][4]; bool val[2][4];
#pragma unroll
    for (int mt = 0; mt < 2; ++mt)
#pragma unroll
        for (int r = 0; r < 4; ++r) { const int kk = key0 + 8 * fq + 4 * mt + r; const int dd = t - (pmul * kk + padd); val[mt][r] = selok && dd >= 0 && dd < wlim; dist[mt][r] = val[mt][r] ? (float)dd : 1e6f; }
    float imp_main[2] = {0.f, 0.f}, imp_spill[2] = {0.f, 0.f};
    f32x4 sc[NT][2]; bf16x8 pfr[NT];
    __builtin_amdgcn_s_setprio(1);
#pragma unroll
    for (int nt = 0; nt < NT; ++nt) {
        bf16x8 q0, q1; if (QREG) { q0 = qreg[nt * 2]; q1 = qreg[nt * 2 + 1]; } else { q0 = ld8l(qrow + nt * qnt + 8 * fq); q1 = ld8l(qrow + nt * qnt + 32 + 8 * fq); }
#pragma unroll
        for (int mt = 0; mt < 2; ++mt) { sc[nt][mt] = (f32x4){0.f, 0.f, 0.f, 0.f}; sc[nt][mt] = MFMA16(f.k[mt][0], q0, sc[nt][mt]); sc[nt][mt] = MFMA16(f.k[mt][1], q1, sc[nt][mt]); }
    }
    __builtin_amdgcn_s_setprio(0);
#pragma unroll
    for (int nt = 0; nt < NT; ++nt) {
        f32x4 p[2]; float ps = 0.f;
#pragma unroll
        for (int mt = 0; mt < 2; ++mt)
#pragma unroll
            for (int r = 0; r < 4; ++r) { float pv = ex2(sc[nt][mt][r] - slope[nt] * dist[mt][r]); if (MODE == 2) pv *= invl[nt]; p[mt][r] = pv; ps += pv; }
        if (MODE != 2) l[nt] += ps;
        if (MODE == 2) {
#pragma unroll
            for (int mt = 0; mt < 2; ++mt) { imp_main[mt] += (p[mt][0] + p[mt][1]) + (p[mt][2] + p[mt][3]); imp_spill[mt] += p[mt][3]; }
        }
        if (MODE != 1) pfr[nt] = cvt8(p[0], p[1]);
    }
    if (MODE != 1) {
        __builtin_amdgcn_s_setprio(1);
#pragma unroll
        for (int nt = 0; nt < NT; ++nt)
#pragma unroll
            for (int dt = 0; dt < 4; ++dt) O[nt][dt] = MFMA16(f.v[dt], pfr[nt], O[nt][dt]);
        __builtin_amdgcn_s_setprio(0);
    }
    if (MODE == 2) {
#pragma unroll
        for (int mt = 0; mt < 2; ++mt) { const int j = key0 / 4 + 2 * fq + mt;
            __hip_atomic_fetch_add(improw + j, imp_main[mt], __ATOMIC_RELAXED, __HIP_MEMORY_SCOPE_WORKGROUP);
            __hip_atomic_fetch_add(improw + j + 1, imp_spill[mt], __ATOMIC_RELAXED, __HIP_MEMORY_SCOPE_WORKGROUP); }
    }
}
template <int NT, int MODE, class KV>
__device__ __forceinline__ void nsa_tile(const KV& kv, int key0, const LAS bf16* qrow, int qnt, f32x4 (&O)[NT][4], float (&m)[NT], float (&l)[NT], const float (&invl)[NT], const float (&slope)[NT],
                                         int t, int pmul, int padd, int wlim, bool selok, LAS float* improw, int fr, int fq) {
    KvFrags f; nsa_load<MODE != 1>(kv, key0, fr, fq, f);
    nsa_core<NT, MODE>(f, key0, qrow, qnt, O, m, l, invl, slope, t, pmul, padd, wlim, selok, improw, fq);
}

template <int NT>
__device__ __forceinline__ void nsa_zero(f32x4 (&O)[NT][4], float (&m)[NT], float (&l)[NT]) {
#pragma unroll
    for (int nt = 0; nt < NT; ++nt) { m[nt] = -1e30f; l[nt] = 0.f;
#pragma unroll
        for (int dt = 0; dt < 4; ++dt) O[nt][dt] = (f32x4){0.f, 0.f, 0.f, 0.f}; }
}

template <bool SAMPLE>
__device__ __forceinline__ void nsa_unit(Frame& F, int id) {
    constexpr int NT = SAMPLE ? 1 : 4;
    int lane_ = F.lane; asm volatile("" : "+v"(lane_));
    const int lane = lane_, fr = lane & 15, fq = lane >> 4;
    LAS unsigned char* L = F.lds; asm volatile("" : "+v"(L));
    LAS float* imp = (LAS float*)(L + NSA_IMP + F.wave * 8448);
    LAS bf16* qw = (LAS bf16*)(L + NSA_Q + F.wave * 8704);
    int bg, g, t, row, trow, tmax, row0;
    if (SAMPLE) { bg = id; g = id & 3; t = PAST + (fr >> 2); row0 = MP + (id >> 2) * 4; row = row0 + (fr >> 2); trow = fr >> 2; tmax = PAST + 3; }
    else { bg = id >> 9; g = bg & 3; const int tt = id & 511; t = 16 * tt + fr; row0 = (bg >> 2) * PT + 16 * tt; row = row0 + fr; trow = fr; tmax = 16 * tt + 15; }
    {
        const int nrow = SAMPLE ? 16 : 64;
        for (int i = lane; i < nrow * 8; i += 64) { const int rr = i >> 3, c8 = i & 7;
            *(LAS v4u*)(qw + rr * NSA_QLD + 8 * c8) = *(const v4u*)(WSP(bf16, WS_QN) + (size_t)(row0 + (rr >> 2)) * 1024 + (g * 4 + (rr & 3)) * 64 + 8 * c8); }
    }
    float slope[NT]; int hd[NT];
#pragma unroll
    for (int nt = 0; nt < NT; ++nt) { hd[nt] = g * 4 + (SAMPLE ? (fr & 3) : nt); slope[nt] = ex2(-0.5f * (float)(hd[nt] + 1)) * LOG2E; }
    const LAS bf16* qrow = qw + (SAMPLE ? fr : fr * 4) * NSA_QLD; const int qnt = SAMPLE ? 0 : NSA_QLD;
    const float* gates = WSP(float, WS_GATES) + (size_t)row * 48;
    float* oacc = WSP(float, WS_OACC) + (size_t)row * 1024;
    for (int i = lane; i < 16 * 132; i += 64) imp[i] = 0.f;
    LDS_WAIT();
    f32x4 O[NT][4]; float m[NT], l[NT], invl[NT];
    {
        KvBf16 kv{WSP(bf16, SAMPLE ? WS_SKCMP : WS_KCMP) + (size_t)bg * 512 * 64, WSP(bf16, SAMPLE ? WS_SVCMPT : WS_VCMPT) + (size_t)bg * 64 * 512, 512};
        const int cmax = (tmax - 31) >> 4;
        const int ntile = (tmax >= 31) ? ((cmax < 510 ? cmax : 510) / 32 + 1) : 0;
#pragma unroll
        for (int nt = 0; nt < NT; ++nt) invl[nt] = 0.f;
        nsa_zero<NT>(O, m, l);
        { KvFrags fa, fb; if (ntile > 0) nsa_load<false>(kv, 0, fr, fq, fa);
#pragma unroll 1
          for (int tl = 0; tl < ntile; ++tl) { if (tl + 1 < ntile) nsa_load<false>(kv, 32 * (tl + 1), fr, fq, fb);
            nsa_core<NT, 1>(fa, 32 * tl, qrow, qnt, O, m, l, invl, slope, t, 16, 31, 1 << 30, true, imp + trow * 132, fq); fa = fb; } }
#pragma unroll
        for (int nt = 0; nt < NT; ++nt) { float lt = l[nt]; lt = x32_sum(x16_sum(lt)); invl[nt] = lt > 0.f ? 1.f / lt : 0.f; }
        { KvFrags fa, fb; if (ntile > 0) nsa_load<true>(kv, 0, fr, fq, fa);
#pragma unroll 1
          for (int tl = 0; tl < ntile; ++tl) { if (tl + 1 < ntile) nsa_load<true>(kv, 32 * (tl + 1), fr, fq, fb);
            nsa_core<NT, 2>(fa, 32 * tl, qrow, qnt, O, m, l, invl, slope, t, 16, 31, 1 << 30, true, imp + trow * 132, fq); fa = fb; } }
#pragma unroll
        for (int nt = 0; nt < NT; ++nt) { const float gc = gates[0 * 16 + hd[nt]];
#pragma unroll
            for (int dt = 0; dt < 4; ++dt) *(f32x4*)(oacc + hd[nt] * 64 + 16 * dt + 4 * fq) = O[nt][dt] * gc; }
    }
    LDS_WAIT();
    unsigned selm[4] = {0u, 0u, 0u, 0u};
    {
        const int cur = t >> 6;
        if (!SAMPLE) {
            unsigned v[32];
#pragma unroll
            for (int i = 0; i < 32; ++i) { const int j = 32 * fq + i; const bool forced = (j == 0) | (j == cur) | (j == cur - 1);
                const unsigned key = ((f2u(imp[trow * 132 + j]) & ~127u) | (unsigned)(127 - j)) + 128u;
                v[i] = (!forced && j <= cur) ? key : 0u;
                if (forced) selm[fq] |= 1u << i; }
            unsigned fw = selm[0] | selm[1] | selm[2] | selm[3];
            const unsigned w16 = __shfl_xor(fw, 16), w32 = __shfl_xor(fw, 32), w48 = __shfl_xor(fw, 48);
#pragma unroll
            for (int wd = 0; wd < 4; ++wd) selm[wd] = (fq == wd) ? fw : ((fq ^ 1) == wd) ? w16 : ((fq ^ 2) == wd) ? w32 : w48;
            const int nforced = cur >= 2 ? 3 : cur + 1;
#pragma unroll 1
            for (int rd = 0; rd < 15; ++rd) {
                unsigned mx = v[0];
#pragma unroll
                for (int i = 1; i < 32; ++i) mx = mx > v[i] ? mx : v[i];
                mx = x32_umax(x16_umax(mx));
#pragma unroll
                for (int i = 0; i < 32; ++i) v[i] = (v[i] == mx) ? 0u : v[i];
                if (mx != 0u && rd < 16 - nforced) { const int js = 127 - (int)(mx & 127u);
#pragma unroll
                    for (int wd = 0; wd < 4; ++wd) selm[wd] |= ((js >> 5) == wd) ? (1u << (js & 31)) : 0u; }
            }
        } else {
            const int li = (fr & 3) * 4 + fq;
            unsigned v[8];
#pragma unroll
            for (int i = 0; i < 8; ++i) { const int j = li * 8 + i; v[i] = (j >= 1 && j <= 126) ? (((f2u(imp[trow * 132 + j]) & ~127u) | (unsigned)(127 - j)) + 128u) : 0u; }
            selm[0] = 1u; selm[3] = 1u << 31;
#pragma unroll 1
            for (int rd = 0; rd < 13; ++rd) {
                unsigned mx = v[0];
#pragma unroll
                for (int i = 1; i < 8; ++i) mx = mx > v[i] ? mx : v[i];
                { unsigned o = dpp_u<DPP_XOR1>(mx); mx = mx > o ? mx : o; o = dpp_u<DPP_XOR2>(mx); mx = mx > o ? mx : o; mx = x32_umax(x16_umax(mx)); }
#pragma unroll
                for (int i = 0; i < 8; ++i) v[i] = (v[i] == mx) ? 0u : v[i];
                if (mx != 0u) { const int js = 127 - (int)(mx & 127u);
#pragma unroll
                    for (int wd = 0; wd < 4; ++wd) selm[wd] |= ((js >> 5) == wd) ? (1u << (js & 31)) : 0u; }
            }
        }
    }
    if (SAMPLE || !NSA_SUBUNITS) {
        nsa_zero<NT>(O, m, l);
        unsigned un[4];
#pragma unroll
        for (int wd = 0; wd < 4; ++wd) { unsigned x = selm[wd]; x |= __shfl_xor(x, 1); x |= __shfl_xor(x, 2); x |= __shfl_xor(x, 4); x |= __shfl_xor(x, 8); un[wd] = (unsigned)__builtin_amdgcn_readfirstlane((int)x); }
        KvSampleSel kvs{FIN(2) + g * 64, (const int*)FIN(6) + (SAMPLE ? (id >> 2) : 0) * NPAGES, WSP(float, WS_SNEW) + (size_t)(SAMPLE ? (id >> 2) : 0) * 2048 + g * 64, g};
        KvBf16 kvp{WSP(bf16, WS_KSEL) + (size_t)bg * PT * 64, WSP(bf16, WS_VSELT) + (size_t)bg * 64 * PT, PT};
        if (SAMPLE) {
#pragma unroll 1
        for (int wd = 0; wd < 4; ++wd) {
            unsigned mm = un[wd];
            const unsigned mine = wd == 0 ? selm[0] : wd == 1 ? selm[1] : wd == 2 ? selm[2] : selm[3];
            while (mm) {
                const int bit = __builtin_ctz(mm); mm &= mm - 1u; const int j = 32 * wd + bit;
                const bool ok = (mine >> bit) & 1u;
#pragma unroll 1
                for (int hh = 0; hh < 2; ++hh) { nsa_tile<NT, 0>(kvs, 64 * j + 32 * hh, qrow, qnt, O, m, l, invl, slope, t, 1, 0, 1 << 30, ok, imp, fr, fq); __builtin_amdgcn_sched_barrier(0); }
            }
        }
        } else {
            int wdc = 0; unsigned mmc = un[0];
            while (wdc < 3 && mmc == 0u) { ++wdc; mmc = wdc == 1 ? un[1] : wdc == 2 ? un[2] : un[3]; }
            KvFrags fa, fb; int jc = -1, hc = 0;
            if (mmc) { jc = 32 * wdc + __builtin_ctz(mmc); mmc &= mmc - 1u; nsa_load<true>(kvp, 64 * jc, fr, fq, fa); }
#pragma unroll 1
            while (jc >= 0) {
                int jn = jc, hn = hc + 1;
                if (hn == 2) { hn = 0;
                    while (wdc < 3 && mmc == 0u) { ++wdc; mmc = wdc == 1 ? un[1] : wdc == 2 ? un[2] : un[3]; }
                    if (mmc) { jn = 32 * wdc + __builtin_ctz(mmc); mmc &= mmc - 1u; } else jn = -1; }
                if (jn >= 0) nsa_load<true>(kvp, 64 * jn + 32 * hn, fr, fq, fb);
                const int wj = jc >> 5, bj = jc & 31;
                const unsigned mine = wj == 0 ? selm[0] : wj == 1 ? selm[1] : wj == 2 ? selm[2] : selm[3];
                nsa_core<NT, 0>(fa, 64 * jc + 32 * hc, qrow, qnt, O, m, l, invl, slope, t, 1, 0, 1 << 30, (mine >> bj) & 1u, imp, fq);
                fa = fb; jc = jn; hc = hn;
            }
        }
        if (SAMPLE) nsa_tile<NT, 0>(kvs, 64 * 128, qrow, qnt, O, m, l, invl, slope, t, 1, 0, 1 << 30, true, imp, fr, fq);
#pragma unroll
        for (int nt = 0; nt < NT; ++nt) { float lt = l[nt]; lt = x32_sum(x16_sum(lt)); const float sc = gates[1 * 16 + hd[nt]] / fmaxf(lt, 1e-30f);
#pragma unroll
            for (int dt = 0; dt < 4; ++dt) { f32x4* o = (f32x4*)(oacc + hd[nt] * 64 + 16 * dt + 4 * fq); *o = *o + O[nt][dt] * sc; } }
    } else {
        unsigned ms[4][4];
#pragma unroll
        for (int s = 0; s < 4; ++s)
#pragma unroll
            for (int wd = 0; wd < 4; ++wd) ms[s][wd] = __shfl(selm[wd], 4 * s + (fr >> 2));
        unsigned su[4][4], un[4];
#pragma unroll
        for (int wd = 0; wd < 4; ++wd) { un[wd] = 0u;
#pragma unroll
            for (int s = 0; s < 4; ++s) { unsigned x = ms[s][wd]; x |= __shfl_xor(x, 4); x |= __shfl_xor(x, 8); su[s][wd] = (unsigned)__builtin_amdgcn_readfirstlane((int)x); un[wd] |= su[s][wd]; } }
        const int hds = g * 4 + (fr & 3); float slp[1]; slp[0] = ex2(-0.5f * (float)(hds + 1)) * LOG2E;
        const int tb = (id & 511) * 16 + (fr >> 2);
        f32x4 Os[4][1][4]; float mS[4][1], lS[4][1]; float inv1[1] = {0.f};
#pragma unroll
        for (int s = 0; s < 4; ++s) nsa_zero<1>(Os[s], mS[s], lS[s]);
        KvBf16 kvp{WSP(bf16, WS_KSEL) + (size_t)bg * PT * 64, WSP(bf16, WS_VSELT) + (size_t)bg * 64 * PT, PT};
        int wdc = 0; unsigned mmc = un[0];
        while (wdc < 3 && mmc == 0u) { ++wdc; mmc = wdc == 1 ? un[1] : wdc == 2 ? un[2] : un[3]; }
        KvFrags fa, fb;
        int jc = -1, hc = 0;
        if (mmc) { jc = 32 * wdc + __builtin_ctz(mmc); mmc &= mmc - 1u; nsa_load<true>(kvp, 64 * jc, fr, fq, fa); }
#pragma unroll 1
        while (jc >= 0) {
            int jn = jc, hn = hc + 1;
            if (hn == 2) { hn = 0;
                while (wdc < 3 && mmc == 0u) { ++wdc; mmc = wdc == 1 ? un[1] : wdc == 2 ? un[2] : un[3]; }
                if (mmc) { jn = 32 * wdc + __builtin_ctz(mmc); mmc &= mmc - 1u; } else jn = -1; }
            if (jn >= 0) nsa_load<true>(kvp, 64 * jn + 32 * hn, fr, fq, fb);
            const int wj = jc >> 5, bj = jc & 31;
#pragma unroll
            for (int s = 0; s < 4; ++s) {
                const unsigned suw = wj == 0 ? su[s][0] : wj == 1 ? su[s][1] : wj == 2 ? su[s][2] : su[s][3];
                if ((suw >> bj) & 1u) {
                    const unsigned mw = wj == 0 ? ms[s][0] : wj == 1 ? ms[s][1] : wj == 2 ? ms[s][2] : ms[s][3];
                    nsa_core<1, 0>(fa, 64 * jc + 32 * hc, qw + (16 * s + fr) * NSA_QLD, 0, Os[s], mS[s], lS[s], inv1, slp, tb + 4 * s, 1, 0, 1 << 30, (mw >> bj) & 1u, imp, fq);
                }
            }
            fa = fb; jc = jn; hc = hn;
        }
#pragma unroll
        for (int s = 0; s < 4; ++s) { float lt = lS[s][0]; lt = x32_sum(x16_sum(lt));
            const size_t rs = (size_t)(row0 + 4 * s + (fr >> 2));
            const float sc = WSP(float, WS_GATES)[rs * 48 + 16 + hds] / fmaxf(lt, 1e-30f);
#pragma unroll
            for (int dt = 0; dt < 4; ++dt) { f32x4* o = (f32x4*)(WSP(float, WS_OACC) + rs * 1024 + hds * 64 + 16 * dt + 4 * fq); *o = *o + Os[s][0][dt] * sc; } }
    }
    {
        nsa_zero<NT>(O, m, l);
        KvBf16 kv = SAMPLE ? KvBf16{WSP(bf16, WS_SKWIN) + (size_t)bg * 544 * 64, WSP(bf16, WS_SVWINT) + (size_t)bg * 64 * 544, 544}
                           : KvBf16{WSP(bf16, WS_KWIN) + (size_t)bg * PT * 64, WSP(bf16, WS_VWINT) + (size_t)bg * 64 * PT, PT};
        int k0, k1, padd;
        if (SAMPLE) { k0 = 0; k1 = 544; padd = PAST - WINDOW; }
        else { const int lo = tmax - 15 - (WINDOW - 1); k0 = (lo > 0 ? lo : 0) & ~31; k1 = tmax + 1; padd = 0; }
        { KvFrags fa, fb; nsa_load<true>(kv, k0, fr, fq, fa);
#pragma unroll 1
          for (int kk = k0; kk < k1; kk += 32) { if (kk + 32 < k1) nsa_load<true>(kv, kk + 32, fr, fq, fb);
            nsa_core<NT, 0>(fa, kk, qrow, qnt, O, m, l, invl, slope, t, 1, padd, WINDOW, true, imp, fq); fa = fb; } }
        bf16* on = WSP(bf16, WS_OG) + (size_t)row * 1024;
#pragma unroll
        for (int nt = 0; nt < NT; ++nt) { float lt = l[nt]; lt = x32_sum(x16_sum(lt)); const float sc = gates[2 * 16 + hd[nt]] / fmaxf(lt, 1e-30f);
#pragma unroll
            for (int dt = 0; dt < 4; ++dt) { const f32x4 o = *(const f32x4*)(oacc + hd[nt] * 64 + 16 * dt + 4 * fq) + O[nt][dt] * sc;
                *(v2u*)(on + hd[nt] * 64 + 16 * dt + 4 * fq) = (v2u){pk2(o[0], o[1]), pk2(o[2], o[3])}; } }
    }
}

constexpr int NW_STG = 67584;
constexpr int NW_STG_BYTES = 18432;
constexpr int NW_UN = NW_STG + 2 * NW_STG_BYTES;
struct NwStage { v4u k, v; };
__device__ __forceinline__ void nw_load(const bf16* K, const bf16* VT, int ld, int key0, int tid, NwStage& s) {
    s.k = *(const v4u*)(K + (size_t)(key0 + (tid >> 3)) * 64 + 8 * (tid & 7));
    s.v = *(const v4u*)(VT + (size_t)(tid >> 3) * ld + key0 + 8 * (tid & 7));
}
__device__ __forceinline__ void nw_store(LAS unsigned char* buf, int tid, const NwStage& s) {
    const int kk = tid >> 3, c8 = tid & 7, k32 = kk & 31;
    const int rho = 32 * (kk >> 5) + 16 * ((k32 >> 2) & 1) + 4 * (k32 >> 3) + (k32 & 3);
    *(LAS v4u*)(buf + rho * 144 + c8 * 16) = s.k;
    *(LAS v4u*)(buf + 9216 + kk * 144 + c8 * 16) = s.v;
}
template <bool WITHV>
__device__ __forceinline__ void nw_frags(const LAS unsigned char* buf, int th, int fr, int fq, KvFrags& f) {
#pragma unroll
    for (int mt = 0; mt < 2; ++mt)
#pragma unroll
        for (int ks = 0; ks < 2; ++ks) f.k[mt][ks] = *(const LAS bf16x8*)(buf + (32 * th + 16 * mt + fr) * 144 + (32 * ks + 8 * fq) * 2);
    if (WITHV) {
#pragma unroll
        for (int dt = 0; dt < 4; ++dt) f.v[dt] = *(const LAS bf16x8*)(buf + 9216 + (16 * dt + fr) * 144 + (32 * th + 8 * fq) * 2);
    }
}
#define NW_PIPE(Kp, VTp, ldv, NB, BLK, BODY) do { const int nb_ = (NB); \
        if (nb_ > 0) { NwStage st_; nw_load(Kp, VTp, ldv, BLK(0), F.tid, st_); nw_store(stg, F.tid, st_); } \
        __syncthreads(); \
        _Pragma("unroll 1") for (int ib_ = 0; ib_ < nb_; ++ib_) { \
            NwStage st_; const bool more_ = ib_ + 1 < nb_; if (more_) nw_load(Kp, VTp, ldv, BLK(ib_ + 1), F.tid, st_); \
            const LAS unsigned char* buf_ = stg + (ib_ & 1) * NW_STG_BYTES; const int key0_ = BLK(ib_); \
            BODY(buf_, key0_) \
            if (more_) nw_store(stg + ((ib_ + 1) & 1) * NW_STG_BYTES, F.tid, st_); \
            __syncthreads(); } } while (0)

__device__ __forceinline__ void nsa_wg(Frame& F, int bg, int qb) {
    int lane_ = F.lane; asm volatile("" : "+v"(lane_));
    const int lane = lane_, fr = lane & 15, fq = lane >> 4, w = F.wave, g = bg & 3;
    LAS unsigned char* L = F.lds; asm volatile("" : "+v"(L));
    LAS float* imp = (LAS float*)(L + NSA_IMP + w * 8448);
    LAS unsigned char* stg = L + NW_STG;
    LAS unsigned* wun = (LAS unsigned*)(L + NW_UN); volatile LAS unsigned char* blist = (volatile LAS unsigned char*)(L + NW_UN + 16);
    const int tt = qb * 8 + w, t = 16 * tt + fr, row0 = (bg >> 2) * PT + 16 * tt, row = row0 + fr, tw0 = 16 * tt, tw1 = tw0 + 15;
    float slope[4]; bf16x8 qreg[8];
#pragma unroll
    for (int nt = 0; nt < 4; ++nt) { slope[nt] = ex2(-0.5f * (float)(g * 4 + nt + 1)) * LOG2E;
        const bf16* qp = WSP(bf16, WS_QN) + (size_t)row * 1024 + (g * 4 + nt) * 64 + 8 * fq; qreg[2 * nt] = ld8(qp); qreg[2 * nt + 1] = ld8(qp + 32); }
    const float* gates = WSP(float, WS_GATES) + (size_t)row * 48;
    float* oacc = WSP(float, WS_OACC) + (size_t)row * 1024;
    for (int i = lane; i < 16 * 132; i += 64) imp[i] = 0.f;
    if (F.tid < 4) wun[F.tid] = 0u;
    f32x4 O[4][4]; float m[4], l[4], invl[4];
    {
        const bf16* Kc = WSP(bf16, WS_KCMP) + (size_t)bg * 512 * 64; const bf16* Vc = WSP(bf16, WS_VCMPT) + (size_t)bg * 64 * 512;
        const int cmax = (128 * qb + 127 - 31) >> 4, ncb = (cmax < 510 ? cmax : 510) / 64 + 1;
#pragma unroll
        for (int nt = 0; nt < 4; ++nt) invl[nt] = 0.f;
        nsa_zero<4>(O, m, l);
#define NW_BLK(i) (64 * (i))
#define NW_CMP1(buf, k0) { _Pragma("unroll 1") for (int th = 0; th < 2; ++th) if (16 * ((k0) + 32 * th) + 31 <= tw1) { KvFrags f; nw_frags<false>(buf, th, fr, fq, f); \
            nsa_core<4, 1, true>(f, (k0) + 32 * th, nullptr, 0, O, m, l, invl, slope, t, 16, 31, 1 << 30, true, imp + fr * 132, fq, qreg); } }
        NW_PIPE(Kc, Vc, 512, ncb, NW_BLK, NW_CMP1);
#pragma unroll
        for (int nt = 0; nt < 4; ++nt) { const float lt = x32_sum(x16_sum(l[nt])); invl[nt] = lt > 0.f ? 1.f / lt : 0.f; }
#define NW_CMP2(buf, k0) { _Pragma("unroll 1") for (int th = 0; th < 2; ++th) if (16 * ((k0) + 32 * th) + 31 <= tw1) { KvFrags f; nw_frags<true>(buf, th, fr, fq, f); \
            nsa_core<4, 2, true>(f, (k0) + 32 * th, nullptr, 0, O, m, l, invl, slope, t, 16, 31, 1 << 30, true, imp + fr * 132, fq, qreg); } }
        NW_PIPE(Kc, Vc, 512, ncb, NW_BLK, NW_CMP2);
#pragma unroll
        for (int nt = 0; nt < 4; ++nt) { const float gc = gates[0 * 16 + g * 4 + nt];
#pragma unroll
            for (int dt = 0; dt < 4; ++dt) *(f32x4*)(oacc + (g * 4 + nt) * 64 + 16 * dt + 4 * fq) = O[nt][dt] * gc; }
    }
    LDS_WAIT();
    unsigned selm[4] = {0u, 0u, 0u, 0u};
    {
        const int cur = t >> 6;
        unsigned v[32];
#pragma unroll
        for (int i = 0; i < 32; ++i) { const int j = 32 * fq + i; const bool forced = (j == 0) | (j == cur) | (j == cur - 1);
            const unsigned key = ((f2u(imp[fr * 132 + j]) & ~127u) | (unsigned)(127 - j)) + 128u;
            v[i] = (!forced && j <= cur) ? key : 0u;
            if (forced) selm[fq] |= 1u << i; }
        unsigned fw = selm[0] | selm[1] | selm[2] | selm[3];
        const unsigned w16 = __shfl_xor(fw, 16), w32 = __shfl_xor(fw, 32), w48 = __shfl_xor(fw, 48);
#pragma unroll
        for (int wd = 0; wd < 4; ++wd) selm[wd] = (fq == wd) ? fw : ((fq ^ 1) == wd) ? w16 : ((fq ^ 2) == wd) ? w32 : w48;
        const int nforced = cur >= 2 ? 3 : cur + 1;
#pragma unroll 1
        for (int rd = 0; rd < 15; ++rd) {
            unsigned mx = v[0];
#pragma unroll
            for (int i = 1; i < 32; ++i) mx = mx > v[i] ? mx : v[i];
            mx = x32_umax(x16_umax(mx));
#pragma unroll
            for (int i = 0; i < 32; ++i) v[i] = (v[i] == mx) ? 0u : v[i];
            if (mx != 0u && rd < 16 - nforced) { const int js = 127 - (int)(mx & 127u);
#pragma unroll
                for (int wd = 0; wd < 4; ++wd) selm[wd] |= ((js >> 5) == wd) ? (1u << (js & 31)) : 0u; }
        }
    }
    unsigned un[4];
#pragma unroll
    for (int wd = 0; wd < 4; ++wd) { unsigned x = selm[wd]; x |= dpp_u<DPP_XOR1>(x); x |= dpp_u<DPP_XOR2>(x); x |= dpp_u<DPP_HMIR>(x); x |= dpp_u<DPP_MIR>(x); un[wd] = (unsigned)__builtin_amdgcn_readfirstlane((int)x); }
    if (lane < 4) __hip_atomic_fetch_or(wun + lane, lane == 0 ? un[0] : lane == 1 ? un[1] : lane == 2 ? un[2] : un[3], __ATOMIC_RELAXED, __HIP_MEMORY_SCOPE_WORKGROUP);
    __syncthreads();
    unsigned wu[4];
#pragma unroll
    for (int wd = 0; wd < 4; ++wd) wu[wd] = (unsigned)__builtin_amdgcn_readfirstlane((int)wun[wd]);
    {
        nsa_zero<4>(O, m, l);
        const bf16* Ks = WSP(bf16, WS_KSEL) + (size_t)bg * PT * 64; const bf16* Vs = WSP(bf16, WS_VSELT) + (size_t)bg * 64 * PT;
        const int nsb = __builtin_popcount(wu[0]) + __builtin_popcount(wu[1]) + __builtin_popcount(wu[2]) + __builtin_popcount(wu[3]);
        if (F.tid < 128) { const int j = F.tid, wj = j >> 5, bj = j & 31; const unsigned ww = wj == 0 ? wu[0] : wj == 1 ? wu[1] : wj == 2 ? wu[2] : wu[3];
            if ((ww >> bj) & 1u) { int pos = __builtin_popcount(ww & ((1u << bj) - 1u)); if (wj > 0) pos += __builtin_popcount(wu[0]); if (wj > 1) pos += __builtin_popcount(wu[1]); if (wj > 2) pos += __builtin_popcount(wu[2]);
                blist[pos] = (unsigned char)j; } }
        __syncthreads();
#define NW_SBLK(i) (64 * (int)blist[(i)])
#define NW_SEL(buf, k0) { const int j_ = (k0) >> 6, wj_ = j_ >> 5, bj_ = j_ & 31; const unsigned uw_ = wj_ == 0 ? un[0] : wj_ == 1 ? un[1] : wj_ == 2 ? un[2] : un[3]; \
            if ((uw_ >> bj_) & 1u) { const unsigned mine_ = wj_ == 0 ? selm[0] : wj_ == 1 ? selm[1] : wj_ == 2 ? selm[2] : selm[3]; const bool ok_ = (mine_ >> bj_) & 1u; \
                _Pragma("unroll 1") for (int th = 0; th < 2; ++th) { KvFrags f; nw_frags<true>(buf, th, fr, fq, f); \
                    nsa_core<4, 0, true>(f, (k0) + 32 * th, nullptr, 0, O, m, l, invl, slope, t, 1, 0, 1 << 30, ok_, imp, fq, qreg); } } }
        NW_PIPE(Ks, Vs, PT, nsb, NW_SBLK, NW_SEL);
#pragma unroll
        for (int nt = 0; nt < 4; ++nt) { const float lt = x32_sum(x16_sum(l[nt])); const float sc = gates[1 * 16 + g * 4 + nt] / fmaxf(lt, 1e-30f);
#pragma unroll
            for (int dt = 0; dt < 4; ++dt) { f32x4* o = (f32x4*)(oacc + (g * 4 + nt) * 64 + 16 * dt + 4 * fq); *o = *o + O[nt][dt] * sc; } }
    }
    {
        nsa_zero<4>(O, m, l);
        const bf16* Kw = WSP(bf16, WS_KWIN) + (size_t)bg * PT * 64; const bf16* Vw = WSP(bf16, WS_VWINT) + (size_t)bg * 64 * PT;
        const int lo = 128 * qb - (WINDOW - 1), kb0 = (lo > 0 ? lo : 0) >> 6, kb1 = (128 * qb + 127) >> 6, nwb = kb1 - kb0 + 1;
#define NW_WBLK(i) (64 * (kb0 + (i)))
#define NW_WIN(buf, k0) { _Pragma("unroll 1") for (int th = 0; th < 2; ++th) { const int kk_ = (k0) + 32 * th; if (kk_ <= tw1 && kk_ + 31 >= tw0 - (WINDOW - 1)) { KvFrags f; nw_frags<true>(buf, th, fr, fq, f); \
                nsa_core<4, 0, true>(f, kk_, nullptr, 0, O, m, l, invl, slope, t, 1, 0, WINDOW, true, imp, fq, qreg); } } }
        NW_PIPE(Kw, Vw, PT, nwb, NW_WBLK, NW_WIN);
        bf16* on = WSP(bf16, WS_OG) + (size_t)row * 1024;
#pragma unroll
        for (int nt = 0; nt < 4; ++nt) { const float lt = x32_sum(x16_sum(l[nt])); const float sc = gates[2 * 16 + g * 4 + nt] / fmaxf(lt, 1e-30f);
#pragma unroll
            for (int dt = 0; dt < 4; ++dt) { const f32x4 o = *(const f32x4*)(oacc + (g * 4 + nt) * 64 + 16 * dt + 4 * fq) + O[nt][dt] * sc;
                *(v2u*)(on + (g * 4 + nt) * 64 + 16 * dt + 4 * fq) = (v2u){pk2(o[0], o[1]), pk2(o[2], o[3])}; } }
    }
    __syncthreads();
}

constexpr int SW_Q = 0;
constexpr int SW_IMPP = 2304;
constexpr int SW_IMPT = SW_IMPP + 8 * 2112;
constexpr int SW_LP = SW_IMPT + 2112;
constexpr int SW_OP = SW_LP + 3 * 8 * 16 * 4;
static_assert(SW_OP + 8 * 3 * 16 * 64 * 4 <= RING_BYTES, "sample NSA LDS map");
__device__ __forceinline__ void nsa_sample_wg(Frame& F, int id) {
    int lane_ = F.lane; asm volatile("" : "+v"(lane_));
    const int lane = lane_, fr = lane & 15, fq = lane >> 4, w = F.wave, g = id & 3, bs = id >> 2;
    LAS unsigned char* L = F.lds; asm volatile("" : "+v"(L));
    LAS bf16* qw = (LAS bf16*)(L + SW_Q);
    LAS float* impP = (LAS float*)(L + SW_IMPP) + w * 528; LAS float* impT = (LAS float*)(L + SW_IMPT);
    LAS float* LP = (LAS float*)(L + SW_LP); LAS float* OP = (LAS float*)(L + SW_OP);
    const int t = PAST + (fr >> 2), row0 = MP + bs * 4, trow = fr >> 2, hd = g * 4 + (fr & 3);
    if (F.tid < 128) { const int rr = F.tid >> 3, c8 = F.tid & 7;
        *(LAS v4u*)(qw + rr * NSA_QLD + 8 * c8) = *(const v4u*)(WSP(bf16, WS_QN) + (size_t)(row0 + (rr >> 2)) * 1024 + (g * 4 + (rr & 3)) * 64 + 8 * c8); }
    for (int i = lane; i < 528; i += 64) impP[i] = 0.f;
    __syncthreads();
    float slope[1] = {ex2(-0.5f * (float)(hd + 1)) * LOG2E};
    const LAS bf16* qrow = qw + fr * NSA_QLD;
    f32x4 O[1][4]; float m[1], l[1], invl[1] = {0.f};
#define SW_PUT_O(br) { _Pragma("unroll") for (int dt = 0; dt < 4; ++dt) *(LAS f32x4*)(OP + ((w * 3 + (br)) * 16 + fr) * 64 + 16 * dt + 4 * fq) = O[0][dt]; }
#define SW_PUT_L(br) { const float lt_ = x32_sum(x16_sum(l[0])); if (fq == 0) LP[((br) * 8 + w) * 16 + fr] = lt_; }
    {
        KvBf16 kv{WSP(bf16, WS_SKCMP) + (size_t)id * 512 * 64, WSP(bf16, WS_SVCMPT) + (size_t)id * 64 * 512, 512};
        nsa_zero<1>(O, m, l);
#pragma unroll 1
        for (int tl = w; tl < 16; tl += 8) nsa_tile<1, 1>(kv, 32 * tl, qrow, 0, O, m, l, invl, slope, t, 16, 31, 1 << 30, true, impP + trow * 132, fr, fq);
        SW_PUT_L(0)
        __syncthreads();
        { float lt = 0.f;
#pragma unroll
          for (int ww = 0; ww < 8; ++ww) lt += LP[(0 * 8 + ww) * 16 + fr];
          invl[0] = lt > 0.f ? 1.f / lt : 0.f; }
#pragma unroll 1
        for (int tl = w; tl < 16; tl += 8) nsa_tile<1, 2>(kv, 32 * tl, qrow, 0, O, m, l, invl, slope, t, 16, 31, 1 << 30, true, impP + trow * 132, fr, fq);
        SW_PUT_O(0)
    }
    __syncthreads();
    for (int i = F.tid; i < 528; i += 512) { float s = 0.f;
#pragma unroll
        for (int ww = 0; ww < 8; ++ww) s += ((LAS float*)(L + SW_IMPP))[ww * 528 + i];
        impT[i] = s; }
    __syncthreads();
    unsigned selm[4] = {1u, 0u, 0u, 1u << 31};
    {
        const int li = (fr & 3) * 4 + fq;
        unsigned v[8];
#pragma unroll
        for (int i = 0; i < 8; ++i) { const int j = li * 8 + i; v[i] = (j >= 1 && j <= 126) ? (((f2u(impT[trow * 132 + j]) & ~127u) | (unsigned)(127 - j)) + 128u) : 0u; }
#pragma unroll 1
        for (int rd = 0; rd < 13; ++rd) {
            unsigned mx = v[0];
#pragma unroll
            for (int i = 1; i < 8; ++i) mx = mx > v[i] ? mx : v[i];
            { unsigned o = dpp_u<DPP_XOR1>(mx); mx = mx > o ? mx : o; o = dpp_u<DPP_XOR2>(mx); mx = mx > o ? mx : o; mx = x32_umax(x16_umax(mx)); }
#pragma unroll
            for (int i = 0; i < 8; ++i) v[i] = (v[i] == mx) ? 0u : v[i];
            if (mx != 0u) { const int js = 127 - (int)(mx & 127u);
#pragma unroll
                for (int wd = 0; wd < 4; ++wd) selm[wd] |= ((js >> 5) == wd) ? (1u << (js & 31)) : 0u; }
        }
    }
    {
        nsa_zero<1>(O, m, l);
        unsigned un[4];
#pragma unroll
        for (int wd = 0; wd < 4; ++wd) { unsigned x = selm[wd]; x |= dpp_u<DPP_XOR1>(x); x |= dpp_u<DPP_XOR2>(x); x |= dpp_u<DPP_HMIR>(x); x |= dpp_u<DPP_MIR>(x); un[wd] = (unsigned)__builtin_amdgcn_readfirstlane((int)x); }
        KvSampleSel kvs{FIN(2) + g * 64, (const int*)FIN(6) + bs * NPAGES, WSP(float, WS_SNEW) + (size_t)bs * 2048 + g * 64, g};
        int q = 0;
#pragma unroll 1
        for (int wd = 0; wd < 4; ++wd) {
            unsigned mm = un[wd];
            const unsigned mine = wd == 0 ? selm[0] : wd == 1 ? selm[1] : wd == 2 ? selm[2] : selm[3];
            while (mm) {
                const int bit = __builtin_ctz(mm); mm &= mm - 1u; const int j = 32 * wd + bit;
                const bool ok = (mine >> bit) & 1u;
#pragma unroll 1
                for (int hh = 0; hh < 2; ++hh, ++q) if ((q & 7) == w) { nsa_tile<1, 0>(kvs, 64 * j + 32 * hh, qrow, 0, O, m, l, invl, slope, t, 1, 0, 1 << 30, ok, impP, fr, fq); __builtin_amdgcn_sched_barrier(0); }
            }
        }
        if ((q & 7) == w) nsa_tile<1, 0>(kvs, 64 * 128, qrow, 0, O, m, l, invl, slope, t, 1, 0, 1 << 30, true, impP, fr, fq);
        SW_PUT_O(1) SW_PUT_L(1)
    }
    {
        nsa_zero<1>(O, m, l);
        KvBf16 kv{WSP(bf16, WS_SKWIN) + (size_t)id * 544 * 64, WSP(bf16, WS_SVWINT) + (size_t)id * 64 * 544, 544};
#pragma unroll 1
        for (int kk = 32 * w; kk < 544; kk += 256) nsa_tile<1, 0>(kv, kk, qrow, 0, O, m, l, invl, slope, t, 1, PAST - WINDOW, WINDOW, true, impP, fr, fq);
        SW_PUT_O(2) SW_PUT_L(2)
    }
    __syncthreads();
    {
        const int r = F.tid >> 5, d0 = (F.tid & 31) * 2, rowg = row0 + (r >> 2), hdr = g * 4 + (r & 3);
        float o0 = 0.f, o1 = 0.f;
#pragma unroll
        for (int br = 0; br < 3; ++br) { float a0 = 0.f, a1 = 0.f, lt = 0.f;
#pragma unroll
            for (int ww = 0; ww < 8; ++ww) { const f32x2 x = *(const LAS f32x2*)(OP + ((ww * 3 + br) * 16 + r) * 64 + d0); a0 += x.x; a1 += x.y; if (br > 0) lt += LP[(br * 8 + ww) * 16 + r]; }
            const float sc = WSP(float, WS_GATES)[(size_t)rowg * 48 + br * 16 + hdr] * (br == 0 ? 1.f : 1.f / fmaxf(lt, 1e-30f));
            o0 += a0 * sc; o1 += a1 * sc; }
        *(unsigned*)(WSP(bf16, WS_OG) + (size_t)rowg * 1024 + hdr * 64 + d0) = pk2(o0, o1);
    }
    __syncthreads();
#undef SW_PUT_O
#undef SW_PUT_L
}


#ifndef MK_SINGLE
#define MK_SINGLE 1
#endif
constexpr int NPHASE = 21;
struct Args { const float* in[29]; float* out; unsigned char* ws; int ph_lo, ph_hi; };
static_assert(sizeof(Args) == 31 * 8 + 8, "Args has no padding");

__global__ void __launch_bounds__(512, 2) mk_fwd(Args args) {
    extern __shared__ __attribute__((aligned(16))) unsigned char lds_raw[];
    Frame F;
    F.lds = (LAS unsigned char*)lds_raw;
    F.tid = threadIdx.x; F.lane = F.tid & 63; F.wave = __builtin_amdgcn_readfirstlane(F.tid >> 6);
    F.G = gridDim.x; F.bid = blockIdx.x;
    F.ka = (const __attribute__((address_space(4))) char*)__builtin_amdgcn_kernarg_segment_ptr();
    F.out = args.out; F.ws = args.ws;
    volatile LAS unsigned* MISC = (volatile LAS unsigned*)(F.lds + MISC_OFF);
    for (int u = F.tid; u < (LDS_BYTES - LDSCTL_OFF) / 4; u += 512) ((LAS unsigned*)(F.lds + LDSCTL_OFF))[u] = 0u;
    __syncthreads();
    unsigned* barw = (unsigned*)(F.ws + WS_CTL) + 4096;
    XcdBarrier bar; bar.bar = barw; bar.x = 0; bar.st = nullptr;
    const int lo = args.ph_lo, hi = args.ph_hi;
    if (hi - lo > 1) bar = xcd_barrier_post(barw, MISC + 8);
#ifndef PH_MASK
#define PH_MASK 0xFFFFFFFFu
#endif
#define IN(k) (((PH_MASK >> (k)) & 1u) && lo <= (k) && (k) < hi)
#define SEAM(k) do { if (IN(k) && IN((k) + 1)) xcd_barrier(bar); } while (0)
    const int gw = F.bid * 8 + F.wave, NGW = F.G * 8;

#ifndef REPX
#define REPX 0
#endif
#ifndef REPY
#define REPY 0
#endif
#ifndef REP_MASK
#define REP_MASK 0u
#endif
#define PHASE(k, ...) if (IN(k)) { _Pragma("unroll 1") for (int rep_ = 0; rep_ < (int)((REP_MASK >> (k)) & 1u) + 1; ++rep_) { if (rep_) xcd_barrier(bar); __VA_ARGS__ } } SEAM(k);
    PHASE(0, p0_prologue(F);)
    if (IN(1) && F.G != 256) { for (int task = F.bid; task < 512; task += F.G) fs_direct_task(F, task); }
    if (IN(1) && IN(2) && F.G != 256) xcd_barrier(bar);
    PHASE(2, gemm_all(F, WSP(bf16, WS_XNA), WSP(bf16, WS_WIN_T), 4096, FnBf16{WSP(bf16, WS_PROJ), 4096});)
    PHASE(3, for (int u = F.bid; u < 2048 + 256; u += F.G) { if (u < 2048) p2_chunk(F, u); else p2_sample(F, u - 2048); })
    PHASE(4, if (F.G == 256) { const int x = F.bid & 7, idx = F.bid >> 3;
                 if (idx < 8) p3_scan(F, x * 2 + (idx >> 2), idx & 3);
                 else { const int j = (idx - 8) * 8 + x;
                        const size_t n8 = (size_t)2 * NEXP * DM / 8; const int p0 = j < 128 ? 6 * j : 768 + 13 * (j - 128), p1 = p0 + (j < 128 ? 6 : 13);
                        peer_tables_to_fp8(F, (size_t)F.tid, (size_t)512, n8 * p0 / 1600, n8 * p1 / 1600);
                        __syncthreads();
                        for (int task = j; task < 512; task += 192) fs_direct_task(F, task); } }
             else { for (int u = F.bid; u < 64; u += F.G) p3_scan(F, u >> 2, u & 3); })
    PHASE(5, p4_rows(F, gw, NGW);
             for (int id = gw; id < 8192; id += NGW) compress_sample(F, id);)
    PHASE(6, gemm_all(F, WSP(bf16, WS_OG), WSP(bf16, WS_WOA_T), 1024, FnResid{WSP(float, WS_XS), FIN(0), FIN(1)});)
    PHASE(7, rms_rows_phase(F, gw, NGW);)
    PHASE(8, gemm_all(F, WSP(bf16, WS_XNB), WSP(bf16, WS_WPQ_T), 2048, FnBf16{WSP(bf16, WS_QPEER), 2048});)
    PHASE(9, p8_phase(F, 0);)
    int pg_slice = F.bid & 7, pg_first = (F.bid >> 3) * 8 + F.wave, pg_stride = ((F.G - (F.bid & 7) + 7) >> 3) * 8;
#define PEER_GROUPS() do { if (MISC[8 + 3] != 0u && (F.G & 7) == 0) { const unsigned c_ = xb_ld(&barw[XB_XCNT(F.lane & 15)]); const bool ok_ = (F.lane & 15) < 8 ? c_ == (unsigned)(F.G >> 3) : c_ == 0u; \
        if (__builtin_amdgcn_ballot_w64(ok_) == ~0ull && bar.x < 8u) { pg_slice = (int)bar.x; pg_first = (int)MISC[8 + 2] * 8 + F.wave; pg_stride = F.G; } } } while (0)
    PHASE(10, PEER_GROUPS(); p9u_wave(F, 0, pg_slice, pg_first, pg_stride);)
    PHASE(11, PEER_GROUPS(); p9v2_wave(F, 0, pg_slice, pg_first, pg_stride, 0);)
    PHASE(12, gemm_all(F, WSP(bf16, WS_XNA), WSP(bf16, WS_WKVQ_T), NKVQ, FnKvq{WSP(bf16, WS_KVQ), WSP(float, WS_SSQ)});)
    PHASE(13, for (int u = F.bid; u < 256; u += F.G) pp_prompt_tile(F, u);
              if (F.G == 256) { compress_prompt_split(F, F.bid * 2 + (F.wave >> 2)); if (F.bid < MS) pp_sample_row(F, F.bid, F.wave); }
              else { for (int r = gw; r < MS; r += NGW) pp_sample_row(F, r); for (int id = gw; id < 512; id += NGW) compress_prompt(F, id); })
    PHASE(14, if (F.G == 256) {
                  _Pragma("unroll 1") for (int q_ = 0; q_ < 1 + REPX; ++q_) { if (F.bid < 128) nsa_sample_wg(F, F.bid); }
                  __syncthreads();
                  { const int i_ = F.bid >> 3;
                    if (i_ < 16) { nsa_wg(F, F.bid & 7, i_); nsa_wg(F, F.bid & 7, 31 - i_); } else { nsa_wg(F, F.bid & 7, 16 + i_); nsa_wg(F, F.bid & 7, 79 - i_); } }
              } else { for (int id = gw; id < 128 + 4096; id += NGW) { if (id < 128) nsa_unit<true>(F, id); else nsa_unit<false>(F, id - 128); } })
    PHASE(15, gemm_all(F, WSP(bf16, WS_OG), WSP(bf16, WS_WOB_T), 1024, FnResid{WSP(float, WS_XS), WSP(float, WS_XS), WSP(float, WS_XS) + (size_t)MP * DM});)
    PHASE(16, rms_rows_phase(F, gw, NGW);)
    PHASE(17, gemm_all(F, WSP(bf16, WS_XNB), WSP(bf16, WS_WPQ_T) + (size_t)2048 * 1024, 2048, FnBf16{WSP(bf16, WS_QPEER), 2048});)
    PHASE(18, p8_phase(F, 1);)
    PHASE(19, PEER_GROUPS(); p9u_wave(F, 1, pg_slice, pg_first, pg_stride);)
    PHASE(20, PEER_GROUPS(); p9v2_wave(F, 1, pg_slice, pg_first, pg_stride, 1);)
#undef IN
#undef SEAM
}

extern "C" void kernel_launch(void* const* d_in, const int* in_sizes, int n_in, void* d_out, int out_size, void* d_ws, size_t ws_size, hipStream_t stream) {
    static int grid = 0;
    if (grid == 0) {
        if (n_in != 29 || (size_t)out_size != O_END || ws_size < WS_END) { fprintf(stderr, "kernel_launch: unexpected shapes n_in %d out %d ws %zu (need %zu)\n", n_in, out_size, ws_size, (size_t)WS_END); grid = -1; return; }
        int dev = 0, cus = 0, per_cu = 0;
        if (hipGetDevice(&dev) != hipSuccess || hipDeviceGetAttribute(&cus, hipDeviceAttributeMultiprocessorCount, dev) != hipSuccess) { grid = -1; return; }
        if (hipFuncSetAttribute((const void*)mk_fwd, hipFuncAttributeMaxDynamicSharedMemorySize, LDS_BYTES) != hipSuccess) { fprintf(stderr, "kernel_launch: hipFuncSetAttribute failed\n"); grid = -1; return; }
        if (hipOccupancyMaxActiveBlocksPerMultiprocessor(&per_cu, (const void*)mk_fwd, 512, LDS_BYTES) != hipSuccess || per_cu < 1) fprintf(stderr, "kernel_launch: occupancy query reports %d\n", per_cu);
        (void)hipGetLastError();
        grid = cus;
    }
    if (grid < 0) return;
    if (hipMemsetAsync((char*)d_ws + WS_CTL, 0, CTL_BYTES, stream) != hipSuccess) return;
    Args a{};
    for (int i = 0; i < 29; ++i) a.in[i] = (const float*)d_in[i];
    a.out = (float*)d_out; a.ws = (unsigned char*)d_ws;
#if MK_SINGLE
    a.ph_lo = 0; a.ph_hi = NPHASE;
    hipLaunchKernelGGL(mk_fwd, dim3(grid), dim3(512), LDS_BYTES, stream, a);
#else
    for (int p = 0; p < NPHASE; ++p) { a.ph_lo = p; a.ph_hi = p + 1; hipLaunchKernelGGL(mk_fwd, dim3(grid), dim3(512), LDS_BYTES, stream, a); }
#endif
    const hipError_t le = hipPeekAtLastError();
    if (le != hipSuccess) fprintf(stderr, "kernel_launch: launch failed: %s\n", hipGetErrorName(le));
}
```
